# Optimizing an MI355X kernel written in HIP

```python
import math
import jax, jax.numpy as jnp
from jax import lax
import numpy as np

D_MODEL = 1024
BATCH = 8
SEQ = 8192
DEPTH = 2

GRID_W = 64
N_MEM = 256
N_BRANCH = 4
BRANCH_W = 512
NA_HEADS = 8
NA_HEAD_DIM = 64
NA_WIN_R = 8
NA_WIN_C = 16
HY_W = 512
HY_CONV = 3
HY_EMB_BANDS = 16
HY_EMB = 1 + 2 * HY_EMB_BANDS
HY_FILTER_HID = 64
HY_INNER_MLPS = 2
HY_SIN_FREQ = 1.0
HY_DECAY_TARGET = 1e-2
HY_FAST_DECAY_PCT = 0.3
HY_SLOW_DECAY_PCT = 1.5
HY_MAX_DECAY = math.log(HY_DECAY_TARGET) / HY_FAST_DECAY_PCT
HY_MIN_DECAY = math.log(HY_DECAY_TARGET) / HY_SLOW_DECAY_PCT
GLA_HEADS = 4
GLA_DK = 64
GLA_DV = 128
GLA_RANK = 16
GLA_TAU = 16.0
GLA_CHUNK = 64
MEM_HEADS = 4
MEM_HEAD_DIM = 128
LN_EPS = 1e-5
RMS_EPS = 1e-6
DN_ALPHA = (2 * DEPTH) ** 0.25
DN_BETA = (8 * DEPTH) ** -0.25

IN_SIZES = (
    NA_HEADS * NA_HEAD_DIM, NA_HEADS * NA_HEAD_DIM, NA_HEADS * NA_HEAD_DIM,
    3 * HY_W,
    GLA_HEADS * GLA_DK, GLA_HEADS * GLA_DK, GLA_HEADS * GLA_DV,
    GLA_RANK, GLA_RANK,
    MEM_HEADS * MEM_HEAD_DIM,
    N_BRANCH * BRANCH_W,
    N_BRANCH * D_MODEL,
)
N_IN = sum(IN_SIZES)

kernel_name = "hybrid_na_hyena_gla_mem_encoder"


def layer_norm(x, g, b):
    xf = x.astype(jnp.float32)
    mu = jnp.mean(xf, -1, keepdims=True)
    var = jnp.mean(jnp.square(xf - mu), -1, keepdims=True)
    return ((xf - mu) * lax.rsqrt(var + LN_EPS) * g.astype(jnp.float32) + b.astype(jnp.float32)).astype(x.dtype)


def neighbourhood_attention(q, k, v, rpb):
    B, L, H, dh = q.shape
    rows = L // GRID_W
    wr = min(NA_WIN_R, rows)
    wc = NA_WIN_C
    grid = lambda t: t.reshape(B, rows, GRID_W, H, dh).transpose(1, 0, 3, 2, 4)
    qg = grid(q) * (dh ** -0.5)
    kg = grid(k)
    vg = grid(v)
    cols = jnp.arange(GRID_W)
    col_start = jnp.clip(cols - wc // 2, 0, GRID_W - wc)
    col_idx = col_start[:, None] + jnp.arange(wc)[None, :]
    dcol = col_idx - cols[:, None] + NA_WIN_C - 1
    rpb32 = rpb.astype(jnp.float32)

    def row_block(args):
        r, q_r = args
        rs = jnp.clip(r - wr // 2, 0, rows - wr)
        k_sel = lax.dynamic_slice_in_dim(kg, rs, wr, axis=0)[:, :, :, col_idx, :]
        v_sel = lax.dynamic_slice_in_dim(vg, rs, wr, axis=0)[:, :, :, col_idx, :]
        drow = rs + jnp.arange(wr) - r + NA_WIN_R - 1
        bias = rpb32[:, drow[:, None, None], dcol[None, :, :]]
        s = jnp.einsum('bhqd,ibhqjd->bhqij', q_r, k_sel).astype(jnp.float32)
        s = s + bias.transpose(0, 2, 1, 3)[None]
        p = jax.nn.softmax(s.reshape(B, H, GRID_W, wr * wc), axis=-1)
        p = p.reshape(B, H, GRID_W, wr, wc).astype(v.dtype)
        return jnp.einsum('bhqij,ibhqjd->bhqd', p, v_sel)

    out = lax.map(row_block, (jnp.arange(rows), qg))
    return out.transpose(1, 0, 3, 2, 4).reshape(B, L, H * dh)


def short_conv(u, w, b):
    L = u.shape[1]
    pad = HY_CONV // 2
    up = jnp.pad(u, ((0, 0), (pad, pad), (0, 0)))
    out = b
    for j in range(HY_CONV):
        out = out + up[:, j:j + L] * w[j]
    return out


def hyena_implicit_filter(L, w1, b1, wm, bm, w3):
    f32 = jnp.float32
    n = jnp.arange(L, dtype=f32)
    t01 = n / (L - 1)
    freqs = jnp.linspace(1e-4, HY_EMB_BANDS - 1, HY_EMB_BANDS, dtype=f32)
    ang = (2.0 * math.pi / L) * n[:, None] * freqs[None, :]
    z = jnp.concatenate([t01[:, None], jnp.cos(ang), -jnp.sin(ang)], axis=-1)
    h = jnp.sin(HY_SIN_FREQ * (z @ w1.astype(f32) + b1.astype(f32)))
    for j in range(HY_INNER_MLPS):
        h = jnp.sin(HY_SIN_FREQ * (h @ wm[j].astype(f32) + bm[j].astype(f32)))
    h = h @ w3.astype(f32)
    deltas = jnp.abs(jnp.linspace(HY_MIN_DECAY, HY_MAX_DECAY, HY_W, dtype=f32))
    window = jnp.exp(-t01[:, None] * deltas[None, :])
    h_f = h[:, :HY_W] * window
    h_b = h[:, HY_W:] * window
    energy = jnp.sum(jnp.square(h_f), 0) + jnp.sum(jnp.square(h_b[1:]), 0)
    scale = lax.rsqrt(energy + 1e-6)
    return h_f * scale, h_b * scale


def bidirectional_long_conv(u, h_f, h_b, skip):
    B, L, C = u.shape
    kern = jnp.concatenate([h_f, jnp.zeros((1, C), jnp.float32), h_b[1:][::-1]], axis=0)
    uf = jnp.fft.rfft(u.astype(jnp.float32), n=2 * L, axis=1)
    kf = jnp.fft.rfft(kern, n=2 * L, axis=0)
    y = jnp.fft.irfft(uf * kf[None], n=2 * L, axis=1)[:, :L]
    return (y + skip.astype(jnp.float32) * u.astype(jnp.float32)).astype(u.dtype)


def gla_chunked(q, k, v, log_a, strict):
    B, L, H, dk = q.shape
    dv = v.shape[-1]
    C = GLA_CHUNK
    n = L // C
    f32 = jnp.float32
    qc = q.astype(f32).reshape(B, n, C, H, dk)
    kc = k.astype(f32).reshape(B, n, C, H, dk)
    vc = v.astype(f32).reshape(B, n, C, H, dv)
    b = jnp.cumsum(log_a.astype(f32).reshape(B, n, C, H, dk), axis=2)
    b_last = b[:, :, -1:]
    m = b[:, :, C // 2 - 1:C // 2]
    att = jnp.einsum('bnchd,bnshd->bnhcs', qc * jnp.exp(b - m), kc * jnp.exp(m - b))
    mask = jnp.tril(jnp.ones((C, C), bool), -1 if strict else 0)
    att = jnp.where(mask, att, 0.0)
    o_intra = jnp.einsum('bnhcs,bnshe->bnche', att, vc)
    U = jnp.einsum('bnshd,bnshe->bnhde', kc * jnp.exp(b_last - b), vc)
    decay = jnp.exp(b_last[:, :, 0])

    def step(S, inp):
        dec, u = inp
        return dec[..., None] * S + u, S

    S0 = jnp.zeros((B, H, dk, dv), f32)
    _, S_prev = lax.scan(step, S0, (jnp.moveaxis(decay, 1, 0), jnp.moveaxis(U, 1, 0)))
    S_prev = jnp.moveaxis(S_prev, 0, 1)
    o_inter = jnp.einsum('bnchd,bnhde->bnche', qc * jnp.exp(b), S_prev)
    return (o_intra + o_inter).reshape(B, L, H, dv)


def gla_bidirectional(q, k, v, lr_f, lr_b, up_f, bias_f, up_b, bias_b, norm_g):
    B, L, _ = q.shape
    qh = q.reshape(B, L, GLA_HEADS, GLA_DK) * (GLA_DK ** -0.5)
    kh = k.reshape(B, L, GLA_HEADS, GLA_DK)
    vh = v.reshape(B, L, GLA_HEADS, GLA_DV)
    gate = lambda lr, up, bias: (jax.nn.log_sigmoid((lr @ up + bias).astype(jnp.float32)) / GLA_TAU
                                 ).reshape(B, L, GLA_HEADS, GLA_DK)
    la_f = gate(lr_f, up_f, bias_f)
    la_b = gate(lr_b, up_b, bias_b)
    o_f = gla_chunked(qh, kh, vh, la_f, strict=False)
    fl = lambda t: jnp.flip(t, axis=1)
    o_b = fl(gla_chunked(fl(qh), fl(kh), fl(vh), fl(la_b), strict=True))
    o = o_f + o_b
    o = o * lax.rsqrt(jnp.mean(jnp.square(o), -1, keepdims=True) + RMS_EPS)
    return (o.reshape(B, L, GLA_HEADS * GLA_DV) * norm_g.astype(jnp.float32)).astype(q.dtype)


def memory_cross_attention(q, mem, w_kv):
    B, L, _ = q.shape
    M = mem.shape[1]
    k, v = jnp.split(mem @ w_kv, 2, axis=-1)
    qh = q.reshape(B, L, MEM_HEADS, MEM_HEAD_DIM) * (MEM_HEAD_DIM ** -0.5)
    kh = k.reshape(B, M, MEM_HEADS, MEM_HEAD_DIM)
    vh = v.reshape(B, M, MEM_HEADS, MEM_HEAD_DIM)
    s = jnp.einsum('blhd,bmhd->bhlm', qh, kh).astype(jnp.float32)
    p = jax.nn.softmax(s, axis=-1).astype(v.dtype)
    return jnp.einsum('bhlm,bmhd->blhd', p, vh).reshape(B, L, MEM_HEADS * MEM_HEAD_DIM)


def hybrid_layer(x, mem, w_in, b_in, na_rpb, hy_conv_w, hy_conv_b, hy_w1, hy_b1, hy_wm, hy_bm,
                 hy_w3, hy_skip, gla_up_f, gla_bias_f, gla_up_b, gla_bias_b, gla_norm_g,
                 mem_w_kv, w_br, w_out, b_out, ln_g, ln_b):
    B, L, _ = x.shape
    proj = x @ w_in + b_in
    points = np.cumsum(IN_SIZES)[:-1].tolist()
    (na_q, na_k, na_v, hy_in, gla_q, gla_k, gla_v, gla_lr_f, gla_lr_b,
     mem_q, z_all, g_all) = jnp.split(proj, points, axis=-1)
    heads = lambda t: t.reshape(B, L, NA_HEADS, NA_HEAD_DIM)
    o_na = neighbourhood_attention(heads(na_q), heads(na_k), heads(na_v), na_rpb)
    hy_v, hy_x0, hy_x1 = jnp.split(short_conv(hy_in, hy_conv_w, hy_conv_b), 3, axis=-1)
    h_f, h_b = hyena_implicit_filter(L, hy_w1, hy_b1, hy_wm, hy_bm, hy_w3)
    o_hy = hy_x0 * bidirectional_long_conv(hy_x1 * hy_v, h_f, h_b, hy_skip)
    o_gla = gla_bidirectional(gla_q, gla_k, gla_v, gla_lr_f, gla_lr_b,
                              gla_up_f, gla_bias_f, gla_up_b, gla_bias_b, gla_norm_g)
    o_mem = memory_cross_attention(mem_q, mem, mem_w_kv)
    branches = (o_na, o_hy, o_gla, o_mem)
    z = jnp.split(z_all, N_BRANCH, axis=-1)
    g = jnp.split(g_all, N_BRANCH, axis=-1)
    merged = jax.nn.sigmoid(g[0]) * ((branches[0] * jax.nn.silu(z[0])) @ w_br[0])
    for j in range(1, N_BRANCH):
        merged = merged + jax.nn.sigmoid(g[j]) * ((branches[j] * jax.nn.silu(z[j])) @ w_br[j])
    out = merged @ w_out + b_out
    return layer_norm(DN_ALPHA * x + out, ln_g, ln_b)


def setup_inputs(seed: int = 0) -> dict:
    key = jax.random.key(seed)
    ks = jax.random.split(key, 32)
    f32 = jnp.float32
    nrm = lambda k, shape, s: jax.random.normal(k, shape, f32) * s
    return {
        "x": nrm(ks[0], (BATCH, SEQ, D_MODEL), 1.0),
        "mem": nrm(ks[1], (BATCH, N_MEM, D_MODEL), 1.0),
        "ln_in_g": 1.0 + nrm(ks[2], (D_MODEL,), 0.02),
        "ln_in_b": nrm(ks[3], (D_MODEL,), 0.02),
        "w_in": nrm(ks[4], (DEPTH, D_MODEL, N_IN), D_MODEL ** -0.5),
        "b_in": nrm(ks[5], (DEPTH, N_IN), 0.02),
        "na_rpb": nrm(ks[6], (DEPTH, NA_HEADS, 2 * NA_WIN_R - 1, 2 * NA_WIN_C - 1), 0.02),
        "hy_conv_w": nrm(ks[7], (DEPTH, HY_CONV, 3 * HY_W), HY_CONV ** -0.5),
        "hy_conv_b": nrm(ks[8], (DEPTH, 3 * HY_W), 0.02),
        "hy_w1": nrm(ks[9], (DEPTH, HY_EMB, HY_FILTER_HID), HY_EMB ** -0.5),
        "hy_b1": nrm(ks[10], (DEPTH, HY_FILTER_HID), 0.02),
        "hy_wm": nrm(ks[11], (DEPTH, HY_INNER_MLPS, HY_FILTER_HID, HY_FILTER_HID), HY_FILTER_HID ** -0.5),
        "hy_bm": nrm(ks[12], (DEPTH, HY_INNER_MLPS, HY_FILTER_HID), 0.02),
        "hy_w3": nrm(ks[13], (DEPTH, HY_FILTER_HID, 2 * HY_W), HY_FILTER_HID ** -0.5),
        "hy_skip": nrm(ks[14], (DEPTH, HY_W), 0.5),
        "gla_up_f": nrm(ks[15], (DEPTH, GLA_RANK, GLA_HEADS * GLA_DK), GLA_RANK ** -0.5),
        "gla_bias_f": nrm(ks[16], (DEPTH, GLA_HEADS * GLA_DK), 0.02),
        "gla_up_b": nrm(ks[17], (DEPTH, GLA_RANK, GLA_HEADS * GLA_DK), GLA_RANK ** -0.5),
        "gla_bias_b": nrm(ks[18], (DEPTH, GLA_HEADS * GLA_DK), 0.02),
        "gla_norm_g": 1.0 + nrm(ks[19], (DEPTH, GLA_HEADS * GLA_DV), 0.02),
        "mem_w_kv": nrm(ks[20], (DEPTH, D_MODEL, 2 * MEM_HEADS * MEM_HEAD_DIM), D_MODEL ** -0.5),
        "w_br": nrm(ks[21], (DEPTH, N_BRANCH, BRANCH_W, D_MODEL), DN_BETA * BRANCH_W ** -0.5),
        "w_out": nrm(ks[22], (DEPTH, D_MODEL, D_MODEL), DN_BETA * D_MODEL ** -0.5),
        "b_out": nrm(ks[23], (DEPTH, D_MODEL), 0.02),
        "ln_g": 1.0 + nrm(ks[24], (DEPTH, D_MODEL), 0.02),
        "ln_b": nrm(ks[25], (DEPTH, D_MODEL), 0.02),
    }


def reference(x, mem, ln_in_g, ln_in_b, w_in, b_in, na_rpb, hy_conv_w, hy_conv_b, hy_w1, hy_b1,
              hy_wm, hy_bm, hy_w3, hy_skip, gla_up_f, gla_bias_f, gla_up_b, gla_bias_b, gla_norm_g,
              mem_w_kv, w_br, w_out, b_out, ln_g, ln_b):
    h = layer_norm(x, ln_in_g, ln_in_b)
    for i in range(DEPTH):
        h = hybrid_layer(h, mem, w_in[i], b_in[i], na_rpb[i], hy_conv_w[i], hy_conv_b[i],
                         hy_w1[i], hy_b1[i], hy_wm[i], hy_bm[i], hy_w3[i], hy_skip[i],
                         gla_up_f[i], gla_bias_f[i], gla_up_b[i], gla_bias_b[i], gla_norm_g[i],
                         mem_w_kv[i], w_br[i], w_out[i], b_out[i], ln_g[i], ln_b[i])
    return h
```

```cpp
#include <hip/hip_runtime.h>
#include <hip/hip_cooperative_groups.h>
#include <cstdio>
#include <unistd.h>
#include <cmath>
namespace cg = cooperative_groups;

#define HD __host__ __device__
typedef unsigned short bf16_t;
typedef short bf16x8 __attribute__((ext_vector_type(8)));
typedef float f32x4 __attribute__((ext_vector_type(4)));
typedef unsigned u32x2 __attribute__((ext_vector_type(2)));
typedef unsigned u32x4 __attribute__((ext_vector_type(4)));

constexpr int NTOK = 65536, DM = 1024, SEQ = 8192, NB = 8;
constexpr int BG = 2;
constexpr int NGRP = NB / BG;
constexpr int TG = BG * SEQ;
constexpr int PS = 10752;
constexpr int NIN = 10784, NINP = 10880;
constexpr int C_NAQ = 0, C_NAK = 512, C_NAV = 1024, C_HY = 1536, C_GQ = 3072, C_GK = 3328, C_GV = 3584, C_MQ = 4096, C_Z = 4608, C_SG = 6656, C_LR = 10752;
constexpr int FN = 16384;
constexpr int NITEM = BG * 128 * 4;
constexpr int LDS_BYTES = 160 * 1024;
constexpr int NTHR = 512;
constexpr float DN_ALPHA = 1.41421356237309515f;

constexpr size_t al256(size_t x) { return (x + 255) & ~(size_t)255; }
constexpr size_t OFF_HB = 0;
constexpr size_t OFF_STATS = OFF_HB + (size_t)NTOK * DM * 2;
constexpr size_t OFF_TW = OFF_STATS + (size_t)NTOK * 8;
constexpr size_t OFF_MEMBF = OFF_TW + (size_t)FN * 8;
constexpr size_t OFF_ENERGY = OFF_MEMBF + (size_t)2048 * 1024 * 2;
constexpr size_t OFF_WTIN = OFF_ENERGY + 4096;
constexpr size_t OFF_WTBR = OFF_WTIN + (size_t)NINP * 1024 * 2;
constexpr size_t OFF_WTOUT = OFF_WTBR + (size_t)4 * 1024 * 512 * 2;
constexpr size_t OFF_WTKV = OFF_WTOUT + (size_t)1024 * 1024 * 2;
constexpr size_t OFF_KMAT = OFF_WTKV + (size_t)2048 * 1024 * 2;
constexpr size_t OFF_VT = OFF_KMAT + (size_t)2048 * 1024 * 2;
constexpr size_t OFF_HFILT = OFF_VT + (size_t)2048 * 1024 * 2;
constexpr size_t OFF_PQ = OFF_HFILT + (size_t)1024 * 8192 * 4;
constexpr size_t OFF_P = OFF_PQ + (size_t)256 * FN * 16;
constexpr size_t OFF_LR = OFF_P + (size_t)TG * PS * 2;
constexpr size_t OFF_GS = OFF_LR + (size_t)TG * 32 * 4;
constexpr size_t OFF_GDEC = OFF_GS + (size_t)2 * NITEM * 8192 * 4;
constexpr size_t OFF_MERGED = OFF_GDEC + (size_t)2 * NITEM * 64 * 4;
constexpr size_t OFF_PRE = OFF_MERGED + (size_t)TG * 1024 * 2;
constexpr size_t WS_END = OFF_PRE + (size_t)TG * 1024 * 4;

struct Params {
    const float *x, *mem, *ln_in_g, *ln_in_b, *w_in, *b_in, *na_rpb, *hy_conv_w, *hy_conv_b, *hy_w1, *hy_b1, *hy_wm, *hy_bm, *hy_w3, *hy_skip,
        *gla_up_f, *gla_bias_f, *gla_up_b, *gla_bias_b, *gla_norm_g, *mem_w_kv, *w_br, *w_out, *b_out, *ln_g, *ln_b;
    float* out;
    unsigned char* ws;
};

HD inline float bf2f(bf16_t b) {
    union { unsigned u; float f; } c; c.u = (unsigned)b << 16; return c.f;
}
HD inline bf16_t f2bf(float f) {
    union { unsigned u; float f; } c; c.f = f; unsigned u = c.u; u += 0x7fffu + ((u >> 16) & 1u); return (bf16_t)(u >> 16);
}
__device__ __forceinline__ unsigned pk2(float lo, float hi) { return (unsigned)f2bf(lo) | ((unsigned)f2bf(hi) << 16); }
__device__ __forceinline__ float lo16(unsigned u) { return __uint_as_float(u << 16); }
__device__ __forceinline__ float hi16(unsigned u) { return __uint_as_float(u & 0xffff0000u); }
__device__ __forceinline__ float wave_sum(float v) {
#pragma unroll
    for (int o = 32; o >= 1; o >>= 1) v += __shfl_xor(v, o);
    return v;
}
__device__ __forceinline__ float sigmoidf_(float x) { return 1.0f / (1.0f + __expf(-x)); }
__device__ __forceinline__ float siluf_(float x) { return x / (1.0f + __expf(-x)); }
__device__ __forceinline__ float logsigf_(float x) { return fminf(x, 0.0f) - log1pf(expf(-fabsf(x))); }
__device__ __forceinline__ bf16x8 mkfrag(u32x4 v) { return __builtin_bit_cast(bf16x8, v); }
__device__ __forceinline__ bf16x8 mkfrag2(u32x2 a, u32x2 b) { u32x4 v = {a.x, a.y, b.x, b.y}; return __builtin_bit_cast(bf16x8, v); }
#define MFMA(a, b, c) __builtin_amdgcn_mfma_f32_16x16x32_bf16((a), (b), (c), 0, 0, 0)
HD inline int iclamp(int v, int lo, int hi) { return v < lo ? lo : (v > hi ? hi : v); }

HD inline float2 cmulf(float2 a, float2 b) { float2 r; r.x = a.x * b.x - a.y * b.y; r.y = a.x * b.y + a.y * b.x; return r; }
HD inline float2 cmulcf(float2 a, float2 b) { float2 r; r.x = a.x * b.x + a.y * b.y; r.y = a.y * b.x - a.x * b.y; return r; }
HD inline void fft_fwd_bfly(float2* d, const float2* tw, int lgm, int q) {
    const int m = 1 << lgm, blk = q >> lgm, j = q & (m - 1), i0 = (blk << (lgm + 2)) + j;
    const int ti = j << (12 - lgm);
    const float2 W1 = tw[ti], W2 = tw[2 * ti];
    const float2 x0 = d[i0], x1 = d[i0 + m], x2 = d[i0 + 2 * m], x3 = d[i0 + 3 * m];
    float2 a0, a1, a2, a3, t;
    a0.x = x0.x + x2.x; a0.y = x0.y + x2.y;
    t.x = x0.x - x2.x; t.y = x0.y - x2.y; a2 = cmulf(t, W1);
    a1.x = x1.x + x3.x; a1.y = x1.y + x3.y;
    t.x = x1.x - x3.x; t.y = x1.y - x3.y; t = cmulf(t, W1); a3.x = t.y; a3.y = -t.x;
    float2 r;
    r.x = a0.x + a1.x; r.y = a0.y + a1.y; d[i0] = r;
    t.x = a0.x - a1.x; t.y = a0.y - a1.y; d[i0 + m] = cmulf(t, W2);
    r.x = a2.x + a3.x; r.y = a2.y + a3.y; d[i0 + 2 * m] = r;
    t.x = a2.x - a3.x; t.y = a2.y - a3.y; d[i0 + 3 * m] = cmulf(t, W2);
}
HD inline void fft_inv_bfly(float2* d, const float2* tw, int lgm, int q) {
    const int m = 1 << lgm, blk = q >> lgm, j = q & (m - 1), i0 = (blk << (lgm + 2)) + j;
    const int ti = j << (12 - lgm);
    const float2 W1 = tw[ti], W2 = tw[2 * ti];
    const float2 x0 = d[i0], x1 = d[i0 + m], x2 = d[i0 + 2 * m], x3 = d[i0 + 3 * m];
    const float2 b1 = cmulcf(x1, W2), b3 = cmulcf(x3, W2);
    float2 y0, y1, y2, y3;
    y0.x = x0.x + b1.x; y0.y = x0.y + b1.y; y1.x = x0.x - b1.x; y1.y = x0.y - b1.y;
    y2.x = x2.x + b3.x; y2.y = x2.y + b3.y; y3.x = x2.x - b3.x; y3.y = x2.y - b3.y;
    const float2 c2 = cmulcf(y2, W1); float2 c3 = cmulcf(y3, W1); { const float tx = -c3.y, ty = c3.x; c3.x = tx; c3.y = ty; }
    float2 r;
    r.x = y0.x + c2.x; r.y = y0.y + c2.y; d[i0] = r;
    r.x = y0.x - c2.x; r.y = y0.y - c2.y; d[i0 + 2 * m] = r;
    r.x = y1.x + c3.x; r.y = y1.y + c3.y; d[i0 + m] = r;
    r.x = y1.x - c3.x; r.y = y1.y - c3.y; d[i0 + 3 * m] = r;
}
HD inline int brev14(int k) {
    unsigned v = (unsigned)k;
    v = ((v >> 1) & 0x55555555u) | ((v & 0x55555555u) << 1);
    v = ((v >> 2) & 0x33333333u) | ((v & 0x33333333u) << 2);
    v = ((v >> 4) & 0x0f0f0f0fu) | ((v & 0x0f0f0f0fu) << 4);
    v = ((v >> 8) & 0x00ff00ffu) | ((v & 0x00ff00ffu) << 8);
    v = (v >> 16) | (v << 16);
    return (int)(v >> 18);
}
HD inline void conv_pointwise(float2* d, const float4* pq, int kf) {
    const int k2 = (FN - kf) & (FN - 1), p1 = brev14(kf), p2 = brev14(k2);
    const float2 Z1 = d[p1], Z2 = d[p2];
    const float4 A = pq[p1], B = pq[p2];
    float2 P1, Q1, P2, Q2; P1.x = A.x; P1.y = A.y; Q1.x = A.z; Q1.y = A.w; P2.x = B.x; P2.y = B.y; Q2.x = B.z; Q2.y = B.w;
    float2 c1, c2; c1.x = Z1.x; c1.y = -Z1.y; c2.x = Z2.x; c2.y = -Z2.y;
    const float2 a = cmulf(Z1, P1), b = cmulf(c2, Q1), c = cmulf(Z2, P2), e = cmulf(c1, Q2);
    float2 w1, w2; w1.x = a.x + b.x; w1.y = a.y + b.y; w2.x = c.x + e.x; w2.y = c.y + e.y;
    d[p1] = w1;
    if (p2 != p1) d[p2] = w2;
}
HD inline void filt_pointwise(const float2* d, float4* pq, int kf) {
    const int k2 = (FN - kf) & (FN - 1), p1 = brev14(kf), p2 = brev14(k2);
    const float2 Z1 = d[p1], Z2 = d[p2];
    const float gcx = 0.5f * (Z1.x + Z2.x), gcy = 0.5f * (Z1.y - Z2.y);
    const float gdx = 0.5f * (Z1.y + Z2.y), gdy = -0.5f * (Z1.x - Z2.x);
    const float s = 0.5f / (float)FN;
    float4 A; A.x = s * (gcx + gdx); A.y = s * (gcy + gdy); A.z = s * (gcx - gdx); A.w = s * (gcy - gdy);
    pq[p1] = A;
    float4 B; B.x = A.x; B.y = -A.y; B.z = A.z; B.w = -A.w;
    if (p2 != p1) pq[p2] = B;
}

#ifndef FFT_HOST_TEST
__device__ void fft_forward(float2* d, const float2* tw) {
    int tid = threadIdx.x; asm volatile("" : "+v"(tid));
    for (int lgm = 12; lgm >= 0; lgm -= 2) {
        for (int q = tid; q < FN / 4; q += NTHR) fft_fwd_bfly(d, tw, lgm, q);
        __syncthreads();
    }
}
__device__ void fft_inverse(float2* d, const float2* tw) {
    int tid = threadIdx.x; asm volatile("" : "+v"(tid));
    for (int lgm = 0; lgm <= 12; lgm += 2) {
        for (int q = tid; q < FN / 4; q += NTHR) fft_inv_bfly(d, tw, lgm, q);
        __syncthreads();
    }
}

constexpr int STG = 49152;
__device__ __forceinline__ int swz(int row, int ch) { return row * 128 + ((ch ^ ((row >> 1) & 7)) << 4); }
__device__ __forceinline__ void gemm_core(f32x4 (&acc)[4][4], const bf16_t* A, int lda, const bf16_t* Bt, int ldb, int K, unsigned char* lds) {
    int tid_ = threadIdx.x; asm volatile("" : "+v"(tid_)); const int tid = tid_, lane = tid & 63, w = tid >> 6, wm = w & 3, wn = w >> 2, l15 = lane & 15, q4 = lane >> 4;
    const int crow = tid >> 3, cch = tid & 7;
    u32x4 ra[4], rb[2];
#pragma unroll
    for (int mi = 0; mi < 4; ++mi)
#pragma unroll
        for (int ni = 0; ni < 4; ++ni) acc[mi][ni] = (f32x4){0.f, 0.f, 0.f, 0.f};
    const bf16_t* ap = A + (size_t)crow * lda + cch * 8;
    const bf16_t* bp = Bt + (size_t)crow * ldb + cch * 8;
#pragma unroll
    for (int i = 0; i < 4; ++i) ra[i] = *(const u32x4*)(ap + (size_t)(64 * i) * lda);
#pragma unroll
    for (int i = 0; i < 2; ++i) rb[i] = *(const u32x4*)(bp + (size_t)(64 * i) * ldb);
#pragma unroll
    for (int i = 0; i < 4; ++i) *(u32x4*)(lds + swz(crow + 64 * i, cch)) = ra[i];
#pragma unroll
    for (int i = 0; i < 2; ++i) *(u32x4*)(lds + 32768 + swz(crow + 64 * i, cch)) = rb[i];
    __syncthreads();
    const int nk = K >> 6;
    for (int kt = 0; kt < nk; ++kt) {
        if (kt + 1 < nk) {
            const int k0 = (kt + 1) << 6;
#pragma unroll
            for (int i = 0; i < 4; ++i) ra[i] = *(const u32x4*)(ap + (size_t)(64 * i) * lda + k0);
#pragma unroll
            for (int i = 0; i < 2; ++i) rb[i] = *(const u32x4*)(bp + (size_t)(64 * i) * ldb + k0);
        }
        const unsigned char* sa = lds + (kt & 1) * STG;
        const unsigned char* sb = sa + 32768;
#pragma unroll
        for (int ks = 0; ks < 2; ++ks) {
            bf16x8 af[4], bfr[4];
#pragma unroll
            for (int mi = 0; mi < 4; ++mi) af[mi] = *(const bf16x8*)(sa + swz(wm * 64 + mi * 16 + l15, ks * 4 + q4));
#pragma unroll
            for (int ni = 0; ni < 4; ++ni) bfr[ni] = *(const bf16x8*)(sb + swz(wn * 64 + ni * 16 + l15, ks * 4 + q4));
#pragma unroll
            for (int mi = 0; mi < 4; ++mi)
#pragma unroll
                for (int ni = 0; ni < 4; ++ni) acc[mi][ni] = MFMA(bfr[ni], af[mi], acc[mi][ni]);
        }
        if (kt + 1 < nk) {
            unsigned char* da = lds + ((kt + 1) & 1) * STG;
#pragma unroll
            for (int i = 0; i < 4; ++i) *(u32x4*)(da + swz(crow + 64 * i, cch)) = ra[i];
#pragma unroll
            for (int i = 0; i < 2; ++i) *(u32x4*)(da + 32768 + swz(crow + 64 * i, cch)) = rb[i];
        }
        __syncthreads();
    }
}
#define EPI_LOOP(body)                                                                                                  \
    {                                                                                                                   \
        int e_t = threadIdx.x; asm volatile("" : "+v"(e_t)); const int e_lane = e_t & 63, e_w = e_t >> 6;                                                    \
        _Pragma("unroll") for (int mi = 0; mi < 4; ++mi) _Pragma("unroll") for (int ni = 0; ni < 4; ++ni) {             \
            const int row = m0 + (e_w & 3) * 64 + mi * 16 + (e_lane & 15);                                              \
            const int col = n0 + (e_w >> 2) * 64 + ni * 16 + 4 * (e_lane >> 4);                                         \
            f32x4& v = acc[mi][ni];                                                                                     \
            body                                                                                                        \
        }                                                                                                               \
    }
__device__ __forceinline__ void st_bf4(bf16_t* dst, f32x4 v) {
    u32x2 o; o.x = pk2(v[0], v[1]); o.y = pk2(v[2], v[3]); *(u32x2*)dst = o;
}
__device__ __forceinline__ f32x4 ld_bf4(const bf16_t* src) {
    const u32x2 u = *(const u32x2*)src; f32x4 r = {lo16(u.x), hi16(u.x), lo16(u.y), hi16(u.y)}; return r;
}

__device__ __forceinline__ int orig_col(int n) {
    if (n < 4096) return n;
    if (n < 4608) return n + 32;
    if (n < 6656) return n + 32;
    if (n < 10752) return n + 32;
    return n - 10752 + 4096;
}

__device__ void ln_rows(const float* src, size_t src_row0, int nrows, const float* g, const float* b, float* dst32, bf16_t* dst16, size_t dst_row0, float2* stats) {
    int tid_ = threadIdx.x; asm volatile("" : "+v"(tid_));
    const int lane = tid_ & 63;
    const int gw = blockIdx.x * (NTHR / 64) + (tid_ >> 6), nw = gridDim.x * (NTHR / 64);
    for (int r = gw; r < nrows; r += nw) {
        const float4* xr = (const float4*)(src + (src_row0 + r) * 1024);
        float4 v[4]; float s = 0.f;
#pragma unroll
        for (int i = 0; i < 4; ++i) { v[i] = xr[lane + 64 * i]; s += (v[i].x + v[i].y) + (v[i].z + v[i].w); }
        s = wave_sum(s);
        const float mean = s * (1.0f / 1024.0f);
        float q = 0.f;
#pragma unroll
        for (int i = 0; i < 4; ++i) { const float a = v[i].x - mean, bb = v[i].y - mean, c = v[i].z - mean, d = v[i].w - mean; q += (a * a + bb * bb) + (c * c + d * d); }
        q = wave_sum(q);
        const float rstd = 1.0f / sqrtf(q * (1.0f / 1024.0f) + 1e-5f);
        if (stats && lane == 0) { float2 st; st.x = mean; st.y = rstd; stats[dst_row0 + r] = st; }
#pragma unroll
        for (int i = 0; i < 4; ++i) {
            const float4 g4 = ((const float4*)g)[lane + 64 * i], b4 = ((const float4*)b)[lane + 64 * i];
            float4 y; y.x = (v[i].x - mean) * rstd * g4.x + b4.x; y.y = (v[i].y - mean) * rstd * g4.y + b4.y; y.z = (v[i].z - mean) * rstd * g4.z + b4.z; y.w = (v[i].w - mean) * rstd * g4.w + b4.w;
            if (dst32) ((float4*)(dst32 + (dst_row0 + r) * 1024))[lane + 64 * i] = y;
            if (dst16) { u32x2 o; o.x = pk2(y.x, y.y); o.y = pk2(y.z, y.w); *(u32x2*)(dst16 + (dst_row0 + r) * 1024 + (lane + 64 * i) * 4) = o; }
        }
    }
}
__device__ void phase0(const Params& p) {
    ln_rows(p.x, 0, NTOK, p.ln_in_g, p.ln_in_b, nullptr, (bf16_t*)(p.ws + OFF_HB), 0, (float2*)(p.ws + OFF_STATS));
    int tid_ = threadIdx.x; asm volatile("" : "+v"(tid_)); const int gt = blockIdx.x * NTHR + tid_, nt = gridDim.x * NTHR;
    float2* tw = (float2*)(p.ws + OFF_TW);
    for (int k = gt; k < FN; k += nt) { double s, c; sincospi(-2.0 * (double)k / (double)FN, &s, &c); float2 t; t.x = (float)c; t.y = (float)s; tw[k] = t; }
    bf16_t* mb = (bf16_t*)(p.ws + OFF_MEMBF);
    for (int i = gt; i < 2048 * 1024 / 4; i += nt) { const float4 v = ((const float4*)p.mem)[i]; u32x2 o; o.x = pk2(v.x, v.y); o.y = pk2(v.z, v.w); ((u32x2*)mb)[i] = o; }
    float* en = (float*)(p.ws + OFF_ENERGY);
    for (int i = gt; i < 1024; i += nt) en[i] = 0.f;
}

__device__ void wt_tile(const float* src, int src_ld, int k0, int on0, bf16_t* dst, int dst_ld, int dn0, bool zero, float* tile) {
    int tid_ = threadIdx.x; asm volatile("" : "+v"(tid_)); const int tid = tid_;
    if (!zero) {
#pragma unroll
        for (int i = 0; i < 2; ++i) {
            const int k = (tid >> 3) + 64 * i, c4 = (tid & 7) * 4;
            const float4 v = *(const float4*)(src + (size_t)(k0 + k) * src_ld + on0 + c4);
            float* t = tile + k * 33 + c4; t[0] = v.x; t[1] = v.y; t[2] = v.z; t[3] = v.w;
        }
    }
    __syncthreads();
    const int n = tid >> 4, kc = (tid & 15) * 8;
    float f[8];
#pragma unroll
    for (int e = 0; e < 8; ++e) f[e] = zero ? 0.f : tile[(kc + e) * 33 + n];
    u32x4 o; o.x = pk2(f[0], f[1]); o.y = pk2(f[2], f[3]); o.z = pk2(f[4], f[5]); o.w = pk2(f[6], f[7]);
    *(u32x4*)(dst + (size_t)(dn0 + n) * dst_ld + k0 + kc) = o;
    __syncthreads();
}
__device__ void phase_weights(const Params& p, int l, unsigned char* lds) {
    float* tile = (float*)lds;
    for (int it = blockIdx.x; it < 3744; it += gridDim.x) {
        if (it < 2720) {
            const int nt = it >> 3, kt = it & 7, dn0 = nt * 32;
            wt_tile(p.w_in + (size_t)l * 1024 * NIN, NIN, kt * 128, orig_col(dn0), (bf16_t*)(p.ws + OFF_WTIN), 1024, dn0, dn0 >= NIN, tile);
        } else if (it < 3232) {
            const int r = it - 2720, j = r >> 7, nt = (r >> 2) & 31, kt = r & 3;
            wt_tile(p.w_br + (size_t)(l * 4 + j) * 512 * 1024, 1024, kt * 128, nt * 32, (bf16_t*)(p.ws + OFF_WTBR) + (size_t)j * 1024 * 512, 512, nt * 32, false, tile);
        } else if (it < 3488) {
            const int r = it - 3232, nt = r >> 3, kt = r & 7;
            wt_tile(p.w_out + (size_t)l * 1024 * 1024, 1024, kt * 128, nt * 32, (bf16_t*)(p.ws + OFF_WTOUT), 1024, nt * 32, false, tile);
        } else {
            const int r = it - 3488, nt = r >> 3, kt = r & 7;
            wt_tile(p.mem_w_kv + (size_t)l * 1024 * 1024, 1024, kt * 128, nt * 32, (bf16_t*)(p.ws + OFF_WTKV), 1024, nt * 32, false, tile);
        }
    }
}

__device__ void phase_filter_gen(const Params& p, int l, unsigned char* lds) {
    float* zt = (float*)lds;
    float* ha = zt + 32 * 33;
    float* hbuf = ha + 32 * 64;
    int tid_ = threadIdx.x; asm volatile("" : "+v"(tid_)); const int tid = tid_;
    const float* w1 = p.hy_w1 + (size_t)l * 33 * 64; const float* b1 = p.hy_b1 + l * 64;
    const float* wm = p.hy_wm + (size_t)l * 2 * 64 * 64; const float* bm = p.hy_bm + l * 2 * 64;
    const float* w3 = p.hy_w3 + (size_t)l * 64 * 1024;
    float* hf = (float*)(p.ws + OFF_HFILT);
    float* en = (float*)(p.ws + OFF_ENERGY) + l * 512;
    for (int it = blockIdx.x; it < 256; it += gridDim.x) {
        const int n0 = it * 32;
        for (int idx = tid; idx < 32 * 33; idx += NTHR) {
            const int pos = idx / 33, e = idx - pos * 33, n = n0 + pos;
            float v;
            if (e == 0) v = (float)n / 8191.0f;
            else {
                const int i = (e - 1) & 15;
                const double fr = 1e-4 + (double)i * ((15.0 - 1e-4) / 15.0);
                const double ang = (2.0 * 3.14159265358979323846 / 8192.0) * (double)n * fr;
                v = (e <= 16) ? (float)cos(ang) : (float)(-sin(ang));
            }
            zt[idx] = v;
        }
        __syncthreads();
        for (int idx = tid; idx < 2048; idx += NTHR) {
            const int pos = idx >> 6, j = idx & 63; float s = b1[j];
            for (int e = 0; e < 33; ++e) s += zt[pos * 33 + e] * w1[e * 64 + j];
            ha[idx] = sinf(s);
        }
        __syncthreads();
        for (int idx = tid; idx < 2048; idx += NTHR) {
            const int pos = idx >> 6, j = idx & 63; float s = bm[j];
            for (int e = 0; e < 64; ++e) s += ha[pos * 64 + e] * wm[e * 64 + j];
            hbuf[idx] = sinf(s);
        }
        __syncthreads();
        for (int idx = tid; idx < 2048; idx += NTHR) {
            const int pos = idx >> 6, j = idx & 63; float s = bm[64 + j];
            for (int e = 0; e < 64; ++e) s += hbuf[pos * 64 + e] * wm[4096 + e * 64 + j];
            ha[idx] = sinf(s);
        }
        __syncthreads();
        {
            const int c = tid;
            float af[32], ab[32];
#pragma unroll
            for (int i = 0; i < 32; ++i) { af[i] = 0.f; ab[i] = 0.f; }
            for (int k = 0; k < 64; ++k) {
                const float wf = w3[k * 1024 + c], wb = w3[k * 1024 + 512 + c];
#pragma unroll
                for (int i = 0; i < 32; ++i) { const float h = ha[i * 64 + k]; af[i] += h * wf; ab[i] += h * wb; }
            }
            const float dmin = -3.0701134573253945f, dmax = -15.350567286626973f;
            const float delta = fabsf(dmin + (float)c * ((dmax - dmin) / 511.0f));
            float e = 0.f;
#pragma unroll
            for (int i = 0; i < 32; ++i) {
                const int n = n0 + i; const float t01 = (float)n / 8191.0f; const float win = expf(-t01 * delta);
                af[i] *= win; ab[i] *= win; e += af[i] * af[i]; if (n >= 1) e += ab[i] * ab[i];
            }
#pragma unroll
            for (int i = 0; i < 8; ++i) {
                float4 a; a.x = af[4 * i]; a.y = af[4 * i + 1]; a.z = af[4 * i + 2]; a.w = af[4 * i + 3];
                float4 b; b.x = ab[4 * i]; b.y = ab[4 * i + 1]; b.z = ab[4 * i + 2]; b.w = ab[4 * i + 3];
                *(float4*)(hf + (size_t)c * 8192 + n0 + 4 * i) = a;
                *(float4*)(hf + (size_t)(512 + c) * 8192 + n0 + 4 * i) = b;
            }
            atomicAdd(en + c, e);
        }
        __syncthreads();
    }
}

__device__ void phase_filter_fft(const Params& p, int l, unsigned char* lds) {
    float2* d = (float2*)lds;
    const float2* tw = (const float2*)(p.ws + OFF_TW);
    const float* hf = (const float*)(p.ws + OFF_HFILT);
    const float* en = (const float*)(p.ws + OFF_ENERGY) + l * 512;
    float4* pqa = (float4*)(p.ws + OFF_PQ);
    int tid_ = threadIdx.x; asm volatile("" : "+v"(tid_)); const int tid = tid_;
    for (int pr = blockIdx.x; pr < 256; pr += gridDim.x) {
        const int c0 = 2 * pr, c1 = c0 + 1;
        const float s0 = 1.0f / sqrtf(en[c0] + 1e-6f), s1 = 1.0f / sqrtf(en[c1] + 1e-6f);
        const float k0 = p.hy_skip[l * 512 + c0], k1 = p.hy_skip[l * 512 + c1];
        for (int n = tid; n < FN; n += NTHR) {
            float2 v;
            if (n < 8192) { v.x = hf[(size_t)c0 * 8192 + n] * s0; v.y = hf[(size_t)c1 * 8192 + n] * s1; if (n == 0) { v.x += k0; v.y += k1; } }
            else if (n == 8192) { v.x = 0.f; v.y = 0.f; }
            else { v.x = hf[(size_t)(512 + c0) * 8192 + (FN - n)] * s0; v.y = hf[(size_t)(512 + c1) * 8192 + (FN - n)] * s1; }
            d[n] = v;
        }
        __syncthreads();
        fft_forward(d, tw);
        for (int kf = tid; kf <= FN / 2; kf += NTHR) filt_pointwise(d, pqa + (size_t)pr * FN, kf);
        __syncthreads();
    }
}

__device__ void hyena_conv_item(const Params& p, int l, bf16_t* P, int bl, int pr, unsigned char* lds) {
    float2* d = (float2*)lds;
    const float2* tw = (const float2*)(p.ws + OFF_TW);
    const float4* pq = (const float4*)(p.ws + OFF_PQ) + (size_t)pr * FN;
    int tid_ = threadIdx.x; asm volatile("" : "+v"(tid_)); const int tid = tid_, c0 = 2 * pr;
    const float* cw = p.hy_conv_w + (size_t)l * 3 * 1536; const float* cb = p.hy_conv_b + l * 1536;
    float wv[2][3], wx0[2][3], wx1[2][3], bv[2], bx0[2], bx1[2];
#pragma unroll
    for (int ch = 0; ch < 2; ++ch) {
#pragma unroll
        for (int j = 0; j < 3; ++j) { wv[ch][j] = cw[j * 1536 + c0 + ch]; wx0[ch][j] = cw[j * 1536 + 512 + c0 + ch]; wx1[ch][j] = cw[j * 1536 + 1024 + c0 + ch]; }
        bv[ch] = cb[c0 + ch]; bx0[ch] = cb[512 + c0 + ch]; bx1[ch] = cb[1024 + c0 + ch];
    }
    const bf16_t* base = P + (size_t)(bl * SEQ) * PS + C_HY + c0;
    for (int t = tid; t < SEQ; t += NTHR) {
        float sv0 = bv[0], sv1 = bv[1], sx0 = bx1[0], sx1 = bx1[1];
#pragma unroll
        for (int j = 0; j < 3; ++j) {
            const int tt = t + j - 1;
            if (tt >= 0 && tt < SEQ) {
                const unsigned uv = *(const unsigned*)(base + (size_t)tt * PS), ux = *(const unsigned*)(base + (size_t)tt * PS + 1024);
                sv0 += wv[0][j] * lo16(uv); sv1 += wv[1][j] * hi16(uv); sx0 += wx1[0][j] * lo16(ux); sx1 += wx1[1][j] * hi16(ux);
            }
        }
        float2 u; u.x = sv0 * sx0; u.y = sv1 * sx1; d[t] = u;
        float2 z; z.x = 0.f; z.y = 0.f; d[t + SEQ] = z;
    }
    __syncthreads();
    fft_forward(d, tw);
    for (int kf = tid; kf <= FN / 2; kf += NTHR) conv_pointwise(d, pq, kf);
    __syncthreads();
    fft_inverse(d, tw);
    for (int t = tid; t < SEQ; t += NTHR) {
        float a0 = bx0[0], a1 = bx0[1];
#pragma unroll
        for (int j = 0; j < 3; ++j) {
            const int tt = t + j - 1;
            if (tt >= 0 && tt < SEQ) { const unsigned ux = *(const unsigned*)(base + (size_t)tt * PS + 512); a0 += wx0[0][j] * lo16(ux); a1 += wx0[1][j] * hi16(ux); }
        }
        const unsigned uz = *(const unsigned*)(P + (size_t)(bl * SEQ + t) * PS + C_Z + 512 + c0);
        const float2 y = d[t];
        *(unsigned*)(P + (size_t)(bl * SEQ + t) * PS + C_HY + c0) = pk2(y.x * a0 * lo16(uz), y.y * a1 * hi16(uz));
    }
    __syncthreads();
}

__device__ void na_item(const Params& p, int l, bf16_t* P, int bl, int rp, int head, unsigned char* lds) {
    bf16_t* Kimg = (bf16_t*)lds;
    bf16_t* VT = (bf16_t*)(lds + 82944);
    int tid_ = threadIdx.x; asm volatile("" : "+v"(tid_)); const int tid = tid_, lane = tid & 63, w = tid >> 6, l15 = lane & 15, q4 = lane >> 4;
    const int r0 = 2 * rp, rs0 = iclamp(r0 - 4, 0, 120);
#pragma unroll 1
    for (int i = 0; i < 9; ++i) {
        const int idx = tid + NTHR * i, ch = idx / 576, key = idx - ch * 576, wr = key >> 6, col = key & 63;
        const int grow = min(rs0 + wr, 127);
        const bf16_t* src = P + (size_t)(bl * SEQ + grow * 64 + col) * PS + head * 64 + ch * 8;
        const u32x4 kv = *(const u32x4*)(src + C_NAK), vv = *(const u32x4*)(src + C_NAV);
        *(u32x4*)(Kimg + key * 72 + ch * 8) = kv;
        bf16_t* vd = VT + (ch * 8) * 584 + key;
        vd[0 * 584] = (bf16_t)(vv.x & 0xffffu); vd[1 * 584] = (bf16_t)(vv.x >> 16);
        vd[2 * 584] = (bf16_t)(vv.y & 0xffffu); vd[3 * 584] = (bf16_t)(vv.y >> 16);
        vd[4 * 584] = (bf16_t)(vv.z & 0xffffu); vd[5 * 584] = (bf16_t)(vv.z >> 16);
        vd[6 * 584] = (bf16_t)(vv.w & 0xffffu); vd[7 * 584] = (bf16_t)(vv.w >> 16);
    }
    __syncthreads();
    const int rr = w >> 2, g = w & 3, r = r0 + rr, rs = iclamp(r - 4, 0, 120), lo = rs - rs0;
    const int cb = iclamp(16 * g - 8, 0, 32), c = 16 * g + l15, cs = iclamp(c - 8, 0, 48);
    bf16_t* qrow = P + (size_t)(bl * SEQ + r * 64 + c) * PS + head * 64;
    bf16x8 qf[2];
#pragma unroll
    for (int ks = 0; ks < 2; ++ks) qf[ks] = *(const bf16x8*)(qrow + ks * 32 + q4 * 8);
    f32x4 sc[16];
#pragma unroll
    for (int t = 0; t < 16; ++t) {
        const int kb = (lo + (t >> 1)) * 64 + cb + 16 * (t & 1);
        f32x4 a = {0.f, 0.f, 0.f, 0.f};
#pragma unroll
        for (int ks = 0; ks < 2; ++ks) { const bf16x8 kf = *(const bf16x8*)(Kimg + (kb + l15) * 72 + ks * 32 + q4 * 8); a = MFMA(kf, qf[ks], a); }
        sc[t] = a;
    }
    const float* rpb = p.na_rpb + (size_t)(l * 8 + head) * 15 * 31;
    float mx = -1e30f;
#pragma unroll
    for (int t = 0; t < 16; ++t) {
        const int drow = rs + (t >> 1) - r + 7;
#pragma unroll
        for (int e = 0; e < 4; ++e) {
            const int col = cb + 16 * (t & 1) + 4 * q4 + e;
            const bool ok = (col >= cs) && (col < cs + 16);
            const int dcol = ok ? (col - c + 15) : 0;
            const float v = ok ? (sc[t][e] + rpb[drow * 31 + dcol]) : -1e30f;
            sc[t][e] = v; mx = fmaxf(mx, v);
        }
    }
    mx = fmaxf(mx, __shfl_xor(mx, 16)); mx = fmaxf(mx, __shfl_xor(mx, 32));
    float sum = 0.f;
#pragma unroll
    for (int t = 0; t < 16; ++t)
#pragma unroll
        for (int e = 0; e < 4; ++e) { const float pe = __expf(sc[t][e] - mx); sc[t][e] = pe; sum += pe; }
    sum += __shfl_xor(sum, 16); sum += __shfl_xor(sum, 32);
    f32x4 o[4];
#pragma unroll
    for (int dt = 0; dt < 4; ++dt) o[dt] = (f32x4){0.f, 0.f, 0.f, 0.f};
#pragma unroll
    for (int kk = 0; kk < 8; ++kk) {
        u32x4 pu; pu.x = pk2(sc[2 * kk][0], sc[2 * kk][1]); pu.y = pk2(sc[2 * kk][2], sc[2 * kk][3]); pu.z = pk2(sc[2 * kk + 1][0], sc[2 * kk + 1][1]); pu.w = pk2(sc[2 * kk + 1][2], sc[2 * kk + 1][3]);
        const bf16x8 pf = mkfrag(pu);
        const int kbA = (lo + kk) * 64 + cb + 4 * q4;
#pragma unroll
        for (int dt = 0; dt < 4; ++dt) {
            const bf16_t* vr = VT + (dt * 16 + l15) * 584 + kbA;
            const bf16x8 vf = mkfrag2(*(const u32x2*)vr, *(const u32x2*)(vr + 16));
            o[dt] = MFMA(vf, pf, o[dt]);
        }
    }
    const float inv = 1.0f / sum;
    const bf16_t* zrow = P + (size_t)(bl * SEQ + r * 64 + c) * PS + C_Z + head * 64;
#pragma unroll
    for (int dt = 0; dt < 4; ++dt) {
        const int dd = dt * 16 + 4 * q4;
        const f32x4 z = ld_bf4(zrow + dd);
        st_bf4(qrow + dd, o[dt] * inv * z);
    }
    __syncthreads();
}

__device__ void memattn_load(const Params& p, int b, int h, unsigned char* lds) {
    bf16_t* Kimg = (bf16_t*)lds;
    bf16_t* VT = (bf16_t*)(lds + 69632);
    const bf16_t* Km = (const bf16_t*)(p.ws + OFF_KMAT); const bf16_t* Vm = (const bf16_t*)(p.ws + OFF_VT);
    int tid_ = threadIdx.x; asm volatile("" : "+v"(tid_)); const int tid = tid_;
#pragma unroll
    for (int i = 0; i < 8; ++i) {
        const int idx = tid + NTHR * i;
        { const int key = idx >> 4, ch = idx & 15; *(u32x4*)(Kimg + key * 136 + ch * 8) = *(const u32x4*)(Km + (size_t)(b * 256 + key) * 512 + h * 128 + ch * 8); }
        { const int dd = idx >> 5, ch = idx & 31; *(u32x4*)(VT + dd * 264 + ch * 8) = *(const u32x4*)(Vm + (size_t)(h * 128 + dd) * 2048 + b * 256 + ch * 8); }
    }
    __syncthreads();
}
__device__ void memattn_item(bf16_t* P, int bl, int h, int qt, unsigned char* lds) {
    const bf16_t* Kimg = (const bf16_t*)lds; const bf16_t* VT = (const bf16_t*)(lds + 69632);
    int tid_ = threadIdx.x; asm volatile("" : "+v"(tid_)); const int tid = tid_, lane = tid & 63, w = tid >> 6, l15 = lane & 15, q4 = lane >> 4;
    const int tok = bl * SEQ + qt * 128 + w * 16 + l15;
    bf16_t* qrow = P + (size_t)tok * PS + C_MQ + h * 128;
    bf16x8 qf[4];
#pragma unroll
    for (int ks = 0; ks < 4; ++ks) qf[ks] = *(const bf16x8*)(qrow + ks * 32 + q4 * 8);
    f32x4 sc[16];
    float mx = -1e30f;
#pragma unroll
    for (int t = 0; t < 16; ++t) {
        f32x4 a = {0.f, 0.f, 0.f, 0.f};
#pragma unroll
        for (int ks = 0; ks < 4; ++ks) { const bf16x8 kf = *(const bf16x8*)(Kimg + (t * 16 + l15) * 136 + ks * 32 + q4 * 8); a = MFMA(kf, qf[ks], a); }
        sc[t] = a;
        mx = fmaxf(mx, fmaxf(fmaxf(a[0], a[1]), fmaxf(a[2], a[3])));
    }
    mx = fmaxf(mx, __shfl_xor(mx, 16)); mx = fmaxf(mx, __shfl_xor(mx, 32));
    float sum = 0.f;
#pragma unroll
    for (int t = 0; t < 16; ++t)
#pragma unroll
        for (int e = 0; e < 4; ++e) { const float pe = __expf(sc[t][e] - mx); sc[t][e] = pe; sum += pe; }
    sum += __shfl_xor(sum, 16); sum += __shfl_xor(sum, 32);
    f32x4 o[8];
#pragma unroll
    for (int dt = 0; dt < 8; ++dt) o[dt] = (f32x4){0.f, 0.f, 0.f, 0.f};
#pragma unroll
    for (int kk = 0; kk < 8; ++kk) {
        u32x4 pu; pu.x = pk2(sc[2 * kk][0], sc[2 * kk][1]); pu.y = pk2(sc[2 * kk][2], sc[2 * kk][3]); pu.z = pk2(sc[2 * kk + 1][0], sc[2 * kk + 1][1]); pu.w = pk2(sc[2 * kk + 1][2], sc[2 * kk + 1][3]);
        const bf16x8 pf = mkfrag(pu);
#pragma unroll
        for (int dt = 0; dt < 8; ++dt) {
            const bf16_t* vr = VT + (dt * 16 + l15) * 264 + kk * 32 + 4 * q4;
            const bf16x8 vf = mkfrag2(*(const u32x2*)vr, *(const u32x2*)(vr + 16));
            o[dt] = MFMA(vf, pf, o[dt]);
        }
    }
    const float inv = 1.0f / sum;
    const bf16_t* zrow = P + (size_t)tok * PS + C_Z + 3 * 512 + h * 128;
#pragma unroll
    for (int dt = 0; dt < 8; ++dt) {
        const int dd = dt * 16 + 4 * q4;
        const f32x4 z = ld_bf4(zrow + dd);
        st_bf4(qrow + dd, o[dt] * inv * z);
    }
}

constexpr int G_LRT = 0, G_BF = 8192, G_BB = 24576, G_TOT = 40960, G_IMG = 45056;
__device__ void gla_tables(const Params& p, int l, const float* LR, int t0, int h, unsigned char* lds) {
    float* LRT = (float*)(lds + G_LRT); float* BF = (float*)(lds + G_BF); float* BB = (float*)(lds + G_BB); float* TOT = (float*)(lds + G_TOT);
    int tid_ = threadIdx.x; asm volatile("" : "+v"(tid_)); const int tid = tid_;
    ((float4*)LRT)[tid] = ((const float4*)(LR + (size_t)t0 * 32))[tid];
    __syncthreads();
    const int dk = tid & 63, cgp = tid >> 6;
    float uf[16], ub[16];
#pragma unroll
    for (int r = 0; r < 16; ++r) { uf[r] = p.gla_up_f[(size_t)(l * 16 + r) * 256 + h * 64 + dk]; ub[r] = p.gla_up_b[(size_t)(l * 16 + r) * 256 + h * 64 + dk]; }
    const float bif = p.gla_bias_f[l * 256 + h * 64 + dk], bib = p.gla_bias_b[l * 256 + h * 64 + dk];
    float lf[8], lb[8];
#pragma unroll
    for (int i = 0; i < 8; ++i) {
        const int c = cgp * 8 + i; float sf = bif, sb = bib;
#pragma unroll
        for (int r = 0; r < 16; ++r) { sf += LRT[c * 32 + r] * uf[r]; sb += LRT[c * 32 + 16 + r] * ub[r]; }
        lf[i] = logsigf_(sf) * (1.0f / 16.0f); lb[i] = logsigf_(sb) * (1.0f / 16.0f);
    }
#pragma unroll
    for (int i = 1; i < 8; ++i) lf[i] += lf[i - 1];
#pragma unroll
    for (int i = 6; i >= 0; --i) lb[i] += lb[i + 1];
    TOT[cgp * 64 + dk] = lf[7]; TOT[512 + cgp * 64 + dk] = lb[0];
    __syncthreads();
    float of = 0.f, ob = 0.f;
#pragma unroll
    for (int g2 = 0; g2 < 8; ++g2) { if (g2 < cgp) of += TOT[g2 * 64 + dk]; if (g2 > cgp) ob += TOT[512 + g2 * 64 + dk]; }
#pragma unroll
    for (int i = 0; i < 8; ++i) { BF[(cgp * 8 + i) * 64 + dk] = lf[i] + of; BB[(cgp * 8 + i) * 64 + dk] = lb[i] + ob; }
    __syncthreads();
}
__device__ void gla_vt(const bf16_t* P, int t0, int h, bf16_t* VT) {
    int tid_ = threadIdx.x; asm volatile("" : "+v"(tid_)); const int tid = tid_;
#pragma unroll
    for (int i = 0; i < 2; ++i) {
        const int idx = tid + NTHR * i, chn = idx >> 6, c = idx & 63;
        const u32x4 vv = *(const u32x4*)(P + (size_t)(t0 + c) * PS + C_GV + h * 128 + chn * 8);
        bf16_t* vd = VT + (chn * 8) * 72 + c;
        vd[0 * 72] = (bf16_t)(vv.x & 0xffffu); vd[1 * 72] = (bf16_t)(vv.x >> 16);
        vd[2 * 72] = (bf16_t)(vv.y & 0xffffu); vd[3 * 72] = (bf16_t)(vv.y >> 16);
        vd[4 * 72] = (bf16_t)(vv.z & 0xffffu); vd[5 * 72] = (bf16_t)(vv.z >> 16);
        vd[6 * 72] = (bf16_t)(vv.w & 0xffffu); vd[7 * 72] = (bf16_t)(vv.w >> 16);
    }
}
__device__ void gla_part1_item(const Params& p, int l, const bf16_t* P, const float* LR, int item, unsigned char* lds) {
    const int h = item & 3, n = (item >> 2) & 127, bl = item >> 9, t0 = bl * SEQ + n * 64;
    const float* BF = (const float*)(lds + G_BF); const float* BB = (const float*)(lds + G_BB);
    bf16_t* KDT0 = (bf16_t*)(lds + G_IMG); bf16_t* KDT1 = KDT0 + 64 * 72; bf16_t* VT = KDT1 + 64 * 72;
    float* GS = (float*)(p.ws + OFF_GS); float* GD = (float*)(p.ws + OFF_GDEC);
    int tid_ = threadIdx.x; asm volatile("" : "+v"(tid_)); const int tid = tid_, lane = tid & 63, w = tid >> 6, l15 = lane & 15, q4 = lane >> 4;
    gla_tables(p, l, LR, t0, h, lds);
#pragma unroll
    for (int i = 0; i < 8; ++i) {
        const int idx = tid + NTHR * i, c = idx >> 6, dk = idx & 63;
        const float kv = bf2f(P[(size_t)(t0 + c) * PS + C_GK + h * 64 + dk]);
        KDT0[dk * 72 + c] = f2bf(kv * __expf(BF[63 * 64 + dk] - BF[c * 64 + dk]));
        KDT1[dk * 72 + c] = f2bf(kv * __expf(BB[dk] - BB[c * 64 + dk]));
    }
    gla_vt(P, t0, h, VT);
    if (tid < 64) GD[(size_t)item * 64 + tid] = __expf(BF[63 * 64 + tid]);
    else if (tid < 128) GD[(size_t)(NITEM + item) * 64 + tid - 64] = __expf(BB[tid - 64]);
    __syncthreads();
    const int dir = w >> 2, dkt = w & 3;
    const bf16_t* KD = dir ? KDT1 : KDT0;
    bf16x8 kf[2];
#pragma unroll
    for (int ks = 0; ks < 2; ++ks) kf[ks] = *(const bf16x8*)(KD + (16 * dkt + l15) * 72 + 32 * ks + 8 * q4);
    float* dst = GS + ((size_t)dir * NITEM + item) * 8192;
#pragma unroll
    for (int dvt = 0; dvt < 8; ++dvt) {
        f32x4 a = {0.f, 0.f, 0.f, 0.f};
#pragma unroll
        for (int ks = 0; ks < 2; ++ks) { const bf16x8 vf = *(const bf16x8*)(VT + (16 * dvt + l15) * 72 + 32 * ks + 8 * q4); a = MFMA(kf[ks], vf, a); }
        *(f32x4*)(dst + (16 * dvt + l15) * 64 + 16 * dkt + 4 * q4) = a;
    }
    __syncthreads();
}
__device__ void gla_scan(const Params& p) {
    float* GS = (float*)(p.ws + OFF_GS); const float* GD = (const float*)(p.ws + OFF_GDEC);
    const int total = 2 * BG * 4 * 8192;
    int tid_ = threadIdx.x; asm volatile("" : "+v"(tid_));
    for (int id = blockIdx.x * NTHR + tid_; id < total; id += gridDim.x * NTHR) {
        const int e = id & 8191, comb = id >> 13, h = comb & 3, bl = (comb >> 2) % BG, dir = comb / (4 * BG), dk = e & 63;
        float S = 0.f;
        for (int s = 0; s < 128; ++s) {
            const int n = dir ? 127 - s : s;
            const size_t item = (size_t)dir * NITEM + (size_t)((bl * 128 + n) * 4 + h);
            const float u = GS[item * 8192 + e], dec = GD[item * 64 + dk];
            GS[item * 8192 + e] = S;
            S = dec * S + u;
        }
    }
}
__device__ void gla_part2_item(const Params& p, int l, bf16_t* P, const float* LR, int item, unsigned char* lds) {
    const int h = item & 3, n = (item >> 2) & 127, bl = item >> 9, t0 = bl * SEQ + n * 64;
    const float* BF = (const float*)(lds + G_BF); const float* BB = (const float*)(lds + G_BB);
    bf16_t* QF = (bf16_t*)(lds + G_IMG);
    bf16_t* KF = QF + 2 * 64 * 72;
    bf16_t* QD = KF + 2 * 64 * 72;
    bf16_t* VT = QD + 2 * 64 * 72;
    bf16_t* ST = VT + 128 * 72;
    float* OX = (float*)lds;
    const float* GS = (const float*)(p.ws + OFF_GS);
    int tid_ = threadIdx.x; asm volatile("" : "+v"(tid_)); const int tid = tid_, lane = tid & 63, w = tid >> 6, l15 = lane & 15, q4 = lane >> 4;
    gla_tables(p, l, LR, t0, h, lds);
#pragma unroll
    for (int i = 0; i < 8; ++i) {
        const int idx = tid + NTHR * i, c = idx >> 6, dk = idx & 63;
        const float qv = bf2f(P[(size_t)(t0 + c) * PS + C_GQ + h * 64 + dk]);
        const float kv = bf2f(P[(size_t)(t0 + c) * PS + C_GK + h * 64 + dk]);
        const float bf = BF[c * 64 + dk], mf = BF[31 * 64 + dk], bb = BB[c * 64 + dk], mb = BB[32 * 64 + dk];
        QF[c * 72 + dk] = f2bf(qv * __expf(bf - mf)); KF[c * 72 + dk] = f2bf(kv * __expf(mf - bf)); QD[c * 72 + dk] = f2bf(qv * __expf(bf));
        QF[4608 + c * 72 + dk] = f2bf(qv * __expf(bb - mb)); KF[4608 + c * 72 + dk] = f2bf(kv * __expf(mb - bb)); QD[4608 + c * 72 + dk] = f2bf(qv * __expf(bb));
    }
    gla_vt(P, t0, h, VT);
#pragma unroll
    for (int dir = 0; dir < 2; ++dir) {
        const float* src = GS + ((size_t)dir * NITEM + item) * 8192;
#pragma unroll
        for (int i = 0; i < 4; ++i) {
            const int idx = tid + NTHR * i, dv = idx >> 4, dk4 = (idx & 15) * 4;
            const float4 s = *(const float4*)(src + dv * 64 + dk4);
            u32x2 o; o.x = pk2(s.x, s.y); o.y = pk2(s.z, s.w);
            *(u32x2*)(ST + dir * 9216 + dv * 72 + dk4) = o;
        }
    }
    __syncthreads();
    const int dir = w >> 2, ct = w & 3;
    const bf16_t* qfp = QF + dir * 4608; const bf16_t* kfp = KF + dir * 4608; const bf16_t* qdp = QD + dir * 4608; const bf16_t* stp = ST + dir * 9216;
    bf16x8 qf[2], qd[2];
#pragma unroll
    for (int ks = 0; ks < 2; ++ks) { qf[ks] = *(const bf16x8*)(qfp + (16 * ct + l15) * 72 + 32 * ks + 8 * q4); qd[ks] = *(const bf16x8*)(qdp + (16 * ct + l15) * 72 + 32 * ks + 8 * q4); }
    f32x4 sc[4];
    const int cq = 16 * ct + l15;
#pragma unroll
    for (int st = 0; st < 4; ++st) {
        f32x4 a = {0.f, 0.f, 0.f, 0.f};
#pragma unroll
        for (int ks = 0; ks < 2; ++ks) { const bf16x8 kf = *(const bf16x8*)(kfp + (16 * st + l15) * 72 + 32 * ks + 8 * q4); a = MFMA(kf, qf[ks], a); }
#pragma unroll
        for (int e = 0; e < 4; ++e) { const int s = 16 * st + 4 * q4 + e; const bool ok = dir ? (s > cq) : (s <= cq); a[e] = ok ? a[e] : 0.f; }
        sc[st] = a;
    }
    f32x4 o[8];
#pragma unroll
    for (int dt = 0; dt < 8; ++dt) o[dt] = (f32x4){0.f, 0.f, 0.f, 0.f};
#pragma unroll
    for (int kk = 0; kk < 2; ++kk) {
        u32x4 pu; pu.x = pk2(sc[2 * kk][0], sc[2 * kk][1]); pu.y = pk2(sc[2 * kk][2], sc[2 * kk][3]); pu.z = pk2(sc[2 * kk + 1][0], sc[2 * kk + 1][1]); pu.w = pk2(sc[2 * kk + 1][2], sc[2 * kk + 1][3]);
        const bf16x8 pf = mkfrag(pu);
#pragma unroll
        for (int dt = 0; dt < 8; ++dt) {
            const bf16_t* vr = VT + (dt * 16 + l15) * 72 + kk * 32 + 4 * q4;
            const bf16x8 vf = mkfrag2(*(const u32x2*)vr, *(const u32x2*)(vr + 16));
            o[dt] = MFMA(vf, pf, o[dt]);
        }
    }
#pragma unroll
    for (int ks = 0; ks < 2; ++ks)
#pragma unroll
        for (int dt = 0; dt < 8; ++dt) { const bf16x8 sf = *(const bf16x8*)(stp + (dt * 16 + l15) * 72 + 32 * ks + 8 * q4); o[dt] = MFMA(sf, qd[ks], o[dt]); }
    if (dir == 1) {
#pragma unroll
        for (int dt = 0; dt < 8; ++dt) *(f32x4*)(OX + cq * 132 + 16 * dt + 4 * q4) = o[dt];
    }
    __syncthreads();
    if (dir == 0) {
        float ss = 0.f;
#pragma unroll
        for (int dt = 0; dt < 8; ++dt) { o[dt] += *(const f32x4*)(OX + cq * 132 + 16 * dt + 4 * q4); ss += (o[dt][0] * o[dt][0] + o[dt][1] * o[dt][1]) + (o[dt][2] * o[dt][2] + o[dt][3] * o[dt][3]); }
        ss += __shfl_xor(ss, 16); ss += __shfl_xor(ss, 32);
        const float rms = 1.0f / sqrtf(ss * (1.0f / 128.0f) + 1e-6f);
        const float* ng = p.gla_norm_g + l * 512 + h * 128;
        const bf16_t* zrow = P + (size_t)(t0 + cq) * PS + C_Z + 2 * 512 + h * 128;
        bf16_t* orow = P + (size_t)(t0 + cq) * PS + C_GV + h * 128;
#pragma unroll
        for (int dt = 0; dt < 8; ++dt) {
            const int dd = 16 * dt + 4 * q4;
            const f32x4 z = ld_bf4(zrow + dd); const f32x4 g4 = *(const f32x4*)(ng + dd);
            st_bf4(orow + dd, o[dt] * rms * g4 * z);
        }
    }
    __syncthreads();
}

__global__ void __launch_bounds__(NTHR) mega(Params p) {
    extern __shared__ __attribute__((aligned(16))) unsigned char lds[];
    cg::grid_group grid = cg::this_grid();
    const int G = gridDim.x, bid = blockIdx.x;
    bf16_t* hb = (bf16_t*)(p.ws + OFF_HB);
    bf16_t* P = (bf16_t*)(p.ws + OFF_P);
    float* LR = (float*)(p.ws + OFF_LR);
    bf16_t* merged = (bf16_t*)(p.ws + OFF_MERGED);
    float* pre = (float*)(p.ws + OFF_PRE);
    const bf16_t* WtIn = (const bf16_t*)(p.ws + OFF_WTIN);
    const bf16_t* WtBr = (const bf16_t*)(p.ws + OFF_WTBR);
    const bf16_t* WtOut = (const bf16_t*)(p.ws + OFF_WTOUT);
    const bf16_t* WtKV = (const bf16_t*)(p.ws + OFF_WTKV);
    const bf16_t* membf = (const bf16_t*)(p.ws + OFF_MEMBF);
    const float2* stats = (const float2*)(p.ws + OFF_STATS);

    phase0(p);
    grid.sync();
#if defined(STOP_AFTER)
    if (STOP_AFTER == 0) return;
#endif
    for (int l = 0; l < 2; ++l) {
        phase_weights(p, l, lds);
        __syncthreads();
#ifndef SKIP_FG
        phase_filter_gen(p, l, lds);
#endif
        grid.sync();
#if defined(STOP_AFTER)
        if (STOP_AFTER == 1 && l == STOP_L) return;
#endif
        phase_filter_fft(p, l, lds);
#ifndef SKIP_KV
        for (int t = bid; t < 64; t += G) {
            f32x4 acc[4][4];
            if (t < 32) {
                const int m0 = (t >> 2) * 256, n0 = (t & 3) * 128;
                gemm_core(acc, membf + (size_t)m0 * 1024, 1024, WtKV + (size_t)n0 * 1024, 1024, 1024, lds);
                bf16_t* Km = (bf16_t*)(p.ws + OFF_KMAT);
                EPI_LOOP(st_bf4(Km + (size_t)row * 512 + col, v);)
            } else {
                const int t2 = t - 32, m0 = (t2 >> 4) * 256, n0 = (t2 & 15) * 128;
                gemm_core(acc, WtKV + (size_t)(512 + m0) * 1024, 1024, membf + (size_t)n0 * 1024, 1024, 1024, lds);
                bf16_t* Vm = (bf16_t*)(p.ws + OFF_VT);
                EPI_LOOP(st_bf4(Vm + (size_t)row * 2048 + col, v);)
            }
        }
#endif
        grid.sync();
#if defined(STOP_AFTER)
        if (STOP_AFTER == 2 && l == STOP_L) return;
#endif
        for (int g = 0; g < NGRP; ++g) {
            const size_t tok0 = (size_t)g * TG;
#ifndef SKIP_INP
            for (int s = bid; s < 5632; s += G) {
                const int R = (s >> 8) * 8 + (s & 7), j = (s & 255) >> 3;
                const int tm = (R & 15) * 4 + (j & 3), tn = (R >> 4) * 8 + (j >> 2);
                if (tn >= 85) continue;
                const int m0 = tm * 256, n0 = tn * 128;
                f32x4 acc[4][4];
                gemm_core(acc, hb + (tok0 + m0) * 1024, 1024, WtIn + (size_t)n0 * 1024, 1024, 1024, lds);
                const float* bias = p.b_in + (size_t)l * NIN;
                EPI_LOOP(
                    if (col < NIN) {
                        const f32x4 b4 = *(const f32x4*)(bias + orig_col(col));
                        v += b4;
                        if (n0 < 512 || (n0 >= C_GQ && n0 < C_GK)) v *= 0.125f;
                        else if (n0 >= C_MQ && n0 < C_Z) v *= 0.08838834764831845f;
                        else if (n0 >= C_Z && n0 < C_SG) { v[0] = siluf_(v[0]); v[1] = siluf_(v[1]); v[2] = siluf_(v[2]); v[3] = siluf_(v[3]); }
                        else if (n0 >= C_SG && n0 < C_LR) { v[0] = sigmoidf_(v[0]); v[1] = sigmoidf_(v[1]); v[2] = sigmoidf_(v[2]); v[3] = sigmoidf_(v[3]); }
                        if (n0 < C_LR) st_bf4(P + (size_t)row * PS + col, v);
                        else *(f32x4*)(LR + (size_t)row * 32 + (col - C_LR)) = v;
                    })
            }
#endif
            grid.sync();
#if defined(STOP_AFTER)
            if (STOP_AFTER == 3 && l == STOP_L) return;
#endif
#ifndef SKIP_NA
            for (int it = bid; it < BG * 64 * 8; it += G) na_item(p, l, P, it >> 9, (it >> 3) & 63, it & 7, lds);
#endif
#ifndef SKIP_HY
            for (int it = bid; it < BG * 256; it += G) hyena_conv_item(p, l, P, it >> 8, it & 255, lds);
#endif
#ifndef SKIP_G1
            for (int it = bid; it < NITEM; it += G) gla_part1_item(p, l, P, LR, it, lds);
#endif
            {
                const int nit = BG * 4 * 64, per = (nit + G - 1) / G;
                int last = -1;
                for (int it = bid * per; it < min(nit, (bid + 1) * per); ++it) {
                    const int bh = it >> 6, bl = bh >> 2, h = bh & 3;
                    if (bh != last) { __syncthreads(); memattn_load(p, g * BG + bl, h, lds); last = bh; }
#ifndef SKIP_MA
                    memattn_item(P, bl, h, it & 63, lds);
#endif
                }
                __syncthreads();
            }
            grid.sync();
#if defined(STOP_AFTER)
            if (STOP_AFTER == 4 && l == STOP_L) return;
#endif
            gla_scan(p);
            grid.sync();
#if defined(STOP_AFTER)
            if (STOP_AFTER == 5 && l == STOP_L) return;
#endif
#ifndef SKIP_G2
            for (int it = bid; it < NITEM; it += G) gla_part2_item(p, l, P, LR, it, lds);
#endif
            grid.sync();
#if defined(STOP_AFTER)
            if (STOP_AFTER == 6 && l == STOP_L) return;
#endif
#ifndef SKIP_MG
            for (int t = bid; t < 512; t += G) {
                const int m0 = (t >> 3) * 256, n0 = (t & 7) * 128;
                f32x4 macc[4][4];
#pragma unroll
                for (int mi = 0; mi < 4; ++mi)
#pragma unroll
                    for (int ni = 0; ni < 4; ++ni) macc[mi][ni] = (f32x4){0.f, 0.f, 0.f, 0.f};
#pragma unroll 1
                for (int j = 0; j < 4; ++j) {
                    const int acol = (j == 0) ? C_NAQ : (j == 1) ? C_HY : (j == 2) ? C_GV : C_MQ;
                    f32x4 acc[4][4];
                    gemm_core(acc, P + (size_t)m0 * PS + acol, PS, WtBr + (size_t)j * 1024 * 512 + (size_t)n0 * 512, 512, 512, lds);
                    EPI_LOOP(macc[mi][ni] += ld_bf4(P + (size_t)row * PS + C_SG + 1024 * j + col) * v;)
                }
                {
                    f32x4 (&acc)[4][4] = macc;
                    EPI_LOOP(st_bf4(merged + (size_t)row * 1024 + col, v);)
                }
            }
#endif
            grid.sync();
#if defined(STOP_AFTER)
            if (STOP_AFTER == 7 && l == STOP_L) return;
#endif
#ifndef SKIP_OUT
            for (int t = bid; t < 512; t += G) {
                const int m0 = (t >> 3) * 256, n0 = (t & 7) * 128;
                f32x4 acc[4][4];
                gemm_core(acc, merged + (size_t)m0 * 1024, 1024, WtOut + (size_t)n0 * 1024, 1024, 1024, lds);
                const float* bo = p.b_out + l * 1024;
                EPI_LOOP(
                    const size_t T = tok0 + row;
                    f32x4 res;
                    if (l == 0) {
                        const f32x4 x4 = *(const f32x4*)(p.x + T * 1024 + col); const float2 st = stats[T];
                        res = (x4 - st.x) * st.y * *(const f32x4*)(p.ln_in_g + col) + *(const f32x4*)(p.ln_in_b + col);
                    } else res = *(const f32x4*)(p.out + T * 1024 + col);
                    v += *(const f32x4*)(bo + col) + DN_ALPHA * res;
                    *(f32x4*)(pre + (size_t)row * 1024 + col) = v;)
            }
#endif
            grid.sync();
#if defined(STOP_AFTER)
            if (STOP_AFTER == 8 && l == STOP_L) return;
#endif
            ln_rows(pre, 0, TG, p.ln_g + l * 1024, p.ln_b + l * 1024, p.out, hb, tok0, nullptr);
#if defined(STOP_AFTER)
            if (STOP_AFTER == 9) { grid.sync(); return; }
            if (STOP_AFTER == 10 && g == 1) { grid.sync(); return; }
            if (STOP_AFTER == 11 && g == 3) { grid.sync(); return; }
#endif
        }
        grid.sync();
    }
}

extern "C" void kernel_launch(void* const* d_in, const int* in_sizes, int n_in, void* d_out, int out_size, void* d_ws, size_t ws_size, hipStream_t stream) {
    static int grid_blocks = 0;
    if (!grid_blocks) {
        if (ws_size < WS_END) { fprintf(stderr, "kernel_launch: workspace too small: %zu < %zu\n", ws_size, (size_t)WS_END); grid_blocks = -1; return; }
        {
            const long long ex[26] = {67108864LL, 2097152LL, 1024, 1024, 2LL * 1024 * 10784, 2 * 10784, 2 * 8 * 15 * 31, 2 * 3 * 1536, 2 * 1536, 2 * 33 * 64, 2 * 64, 2 * 2 * 64 * 64, 2 * 2 * 64,
                                      2 * 64 * 1024, 2 * 512, 2 * 16 * 256, 2 * 256, 2 * 16 * 256, 2 * 256, 2 * 512, 2LL * 1024 * 1024, 2LL * 4 * 512 * 1024, 2LL * 1024 * 1024, 2 * 1024, 2 * 1024, 2 * 1024};
            bool bad = (n_in != 26) || (out_size != 67108864);
            for (int i = 0; i < 26 && !bad; ++i) if ((long long)in_sizes[i] != ex[i]) { fprintf(stderr, "kernel_launch: input %d has %d elements, expected %lld\n", i, in_sizes[i], ex[i]); bad = true; }
            if (bad) { fprintf(stderr, "kernel_launch: unexpected shapes; nothing launched\n"); grid_blocks = -1; return; }
        }
        int dev = 0, cus = 0, per_cu = 0;
        hipGetDevice(&dev);
        hipDeviceGetAttribute(&cus, hipDeviceAttributeMultiprocessorCount, dev);
        if (hipFuncSetAttribute((const void*)mega, hipFuncAttributeMaxDynamicSharedMemorySize, LDS_BYTES) != hipSuccess) fprintf(stderr, "kernel_launch: hipFuncSetAttribute failed\n");
        if (hipOccupancyMaxActiveBlocksPerMultiprocessor(&per_cu, (const void*)mega, NTHR, LDS_BYTES) != hipSuccess || per_cu < 1) { fprintf(stderr, "kernel_launch: occupancy query gave %d\n", per_cu); per_cu = 1; }
        (void)hipGetLastError();
        if (per_cu > 1) per_cu = 1;
        grid_blocks = cus * per_cu;
    }
    if (grid_blocks < 0) return;
    Params p{};
    const float** pp = (const float**)&p;
    for (int i = 0; i < 26; ++i) pp[i] = (const float*)d_in[i];
    p.out = (float*)d_out; p.ws = (unsigned char*)d_ws;
    void* args[] = {&p};
    hipError_t e = hipLaunchCooperativeKernel((const void*)mega, dim3(grid_blocks), dim3(NTHR), args, LDS_BYTES, stream);
    if (e != hipSuccess) fprintf(stderr, "cooperative launch failed: %s (grid %d)\n", hipGetErrorString(e), grid_blocks);
}
#endif
```

```cpp
#include <hip/hip_runtime.h>
#include <hip/hip_cooperative_groups.h>
#include <cstdio>
#include <unistd.h>
#include <cmath>
namespace cg = cooperative_groups;

#define HD __host__ __device__
typedef unsigned short bf16_t;
typedef short bf16x8 __attribute__((ext_vector_type(8)));
typedef float f32x4 __attribute__((ext_vector_type(4)));
typedef unsigned u32x2 __attribute__((ext_vector_type(2)));
typedef unsigned u32x4 __attribute__((ext_vector_type(4)));

constexpr int NTOK = 65536, DM = 1024, SEQ = 8192, NB = 8;
constexpr int BG = 2;
constexpr int NGRP = NB / BG;
constexpr int TG = BG * SEQ;
constexpr int PS = 10752;
constexpr int NIN = 10784, NINP = 11008;
constexpr int C_NAQ = 0, C_NAK = 512, C_NAV = 1024, C_HY = 1536, C_GQ = 3072, C_GK = 3328, C_GV = 3584, C_MQ = 4096, C_Z = 4608, C_SG = 6656, C_LR = 10752;
constexpr int FN = 16384;
constexpr int NITEM = BG * 128 * 4;
constexpr int LDS_BYTES = 160 * 1024;
constexpr int NTHR = 512;
constexpr float DN_ALPHA = 1.41421356237309515f;

constexpr size_t al256(size_t x) { return (x + 255) & ~(size_t)255; }
constexpr size_t OFF_HB = 0;
constexpr size_t OFF_STATS = OFF_HB + (size_t)NTOK * DM * 2;
constexpr size_t OFF_TW = OFF_STATS + (size_t)NTOK * 8;
constexpr size_t OFF_MEMBF = OFF_TW + (size_t)FN * 8;
constexpr size_t OFF_ENERGY = OFF_MEMBF + (size_t)2048 * 1024 * 2;
constexpr size_t OFF_WTIN = OFF_ENERGY + 4096;
constexpr size_t OFF_WTBR = OFF_WTIN + (size_t)NINP * 1024 * 2;
constexpr size_t OFF_WTOUT = OFF_WTBR + (size_t)4 * 1024 * 512 * 2;
constexpr size_t OFF_WTKV = OFF_WTOUT + (size_t)1024 * 1024 * 2;
constexpr size_t OFF_KMAT = OFF_WTKV + (size_t)2048 * 1024 * 2;
constexpr size_t OFF_VT = OFF_KMAT + (size_t)2048 * 1024 * 2;
constexpr size_t OFF_HFILT = OFF_VT + (size_t)2048 * 1024 * 2;
constexpr size_t OFF_PQ = OFF_HFILT + (size_t)1024 * 8192 * 4;
constexpr size_t OFF_P = OFF_PQ + (size_t)256 * FN * 16;
constexpr size_t OFF_LR = OFF_P + (size_t)TG * PS * 2;
constexpr size_t OFF_GS = OFF_LR + (size_t)TG * 32 * 4;
constexpr size_t OFF_GDEC = OFF_GS + (size_t)2 * NITEM * 8192 * 4;
constexpr size_t OFF_MERGED = OFF_GDEC + (size_t)2 * NITEM * 64 * 4;
constexpr size_t OFF_PRE = OFF_MERGED + (size_t)TG * 1024 * 2;
constexpr size_t OFF_UT = OFF_PRE + (size_t)TG * 1024 * 4;
constexpr size_t OFF_GT = OFF_UT + (size_t)BG * 512 * 8192 * 4;
constexpr size_t WS_END = OFF_GT + (size_t)BG * 512 * 8192 * 2;

struct Params {
    const float *x, *mem, *ln_in_g, *ln_in_b, *w_in, *b_in, *na_rpb, *hy_conv_w, *hy_conv_b, *hy_w1, *hy_b1, *hy_wm, *hy_bm, *hy_w3, *hy_skip,
        *gla_up_f, *gla_bias_f, *gla_up_b, *gla_bias_b, *gla_norm_g, *mem_w_kv, *w_br, *w_out, *b_out, *ln_g, *ln_b;
    float* out;
    unsigned char* ws;
};

HD inline float bf2f(bf16_t b) {
    union { unsigned u; float f; } c; c.u = (unsigned)b << 16; return c.f;
}
HD inline bf16_t f2bf(float f) {
    union { unsigned u; float f; } c; c.f = f; unsigned u = c.u; u += 0x7fffu + ((u >> 16) & 1u); return (bf16_t)(u >> 16);
}
__device__ __forceinline__ unsigned pk2(float lo, float hi) { return (unsigned)f2bf(lo) | ((unsigned)f2bf(hi) << 16); }
__device__ __forceinline__ float lo16(unsigned u) { return __uint_as_float(u << 16); }
__device__ __forceinline__ float hi16(unsigned u) { return __uint_as_float(u & 0xffff0000u); }
__device__ __forceinline__ float wave_sum(float v) {
#pragma unroll
    for (int o = 32; o >= 1; o >>= 1) v += __shfl_xor(v, o);
    return v;
}
__device__ __forceinline__ float sigmoidf_(float x) { return 1.0f / (1.0f + __expf(-x)); }
__device__ __forceinline__ float siluf_(float x) { return x / (1.0f + __expf(-x)); }
__device__ __forceinline__ float logsigf_(float x) { return fminf(x, 0.0f) - log1pf(expf(-fabsf(x))); }
__device__ __forceinline__ bf16x8 mkfrag(u32x4 v) { return __builtin_bit_cast(bf16x8, v); }
__device__ __forceinline__ bf16x8 mkfrag2(u32x2 a, u32x2 b) { u32x4 v = {a.x, a.y, b.x, b.y}; return __builtin_bit_cast(bf16x8, v); }
#define MFMA(a, b, c) __builtin_amdgcn_mfma_f32_16x16x32_bf16((a), (b), (c), 0, 0, 0)
HD inline int iclamp(int v, int lo, int hi) { return v < lo ? lo : (v > hi ? hi : v); }

HD inline float2 cmulf(float2 a, float2 b) { float2 r; r.x = a.x * b.x - a.y * b.y; r.y = a.x * b.y + a.y * b.x; return r; }
HD inline float2 cmulcf(float2 a, float2 b) { float2 r; r.x = a.x * b.x + a.y * b.y; r.y = a.y * b.x - a.x * b.y; return r; }
HD inline void fft_fwd_bfly(float2* d, const float2* tw, int lgm, int q) {
    const int m = 1 << lgm, blk = q >> lgm, j = q & (m - 1), i0 = (blk << (lgm + 2)) + j;
    const int ti = j << (12 - lgm);
    const float2 W1 = tw[ti], W2 = tw[2 * ti];
    const float2 x0 = d[i0], x1 = d[i0 + m], x2 = d[i0 + 2 * m], x3 = d[i0 + 3 * m];
    float2 a0, a1, a2, a3, t;
    a0.x = x0.x + x2.x; a0.y = x0.y + x2.y;
    t.x = x0.x - x2.x; t.y = x0.y - x2.y; a2 = cmulf(t, W1);
    a1.x = x1.x + x3.x; a1.y = x1.y + x3.y;
    t.x = x1.x - x3.x; t.y = x1.y - x3.y; t = cmulf(t, W1); a3.x = t.y; a3.y = -t.x;
    float2 r;
    r.x = a0.x + a1.x; r.y = a0.y + a1.y; d[i0] = r;
    t.x = a0.x - a1.x; t.y = a0.y - a1.y; d[i0 + m] = cmulf(t, W2);
    r.x = a2.x + a3.x; r.y = a2.y + a3.y; d[i0 + 2 * m] = r;
    t.x = a2.x - a3.x; t.y = a2.y - a3.y; d[i0 + 3 * m] = cmulf(t, W2);
}
HD inline void fft_inv_bfly(float2* d, const float2* tw, int lgm, int q) {
    const int m = 1 << lgm, blk = q >> lgm, j = q & (m - 1), i0 = (blk << (lgm + 2)) + j;
    const int ti = j << (12 - lgm);
    const float2 W1 = tw[ti], W2 = tw[2 * ti];
    const float2 x0 = d[i0], x1 = d[i0 + m], x2 = d[i0 + 2 * m], x3 = d[i0 + 3 * m];
    const float2 b1 = cmulcf(x1, W2), b3 = cmulcf(x3, W2);
    float2 y0, y1, y2, y3;
    y0.x = x0.x + b1.x; y0.y = x0.y + b1.y; y1.x = x0.x - b1.x; y1.y = x0.y - b1.y;
    y2.x = x2.x + b3.x; y2.y = x2.y + b3.y; y3.x = x2.x - b3.x; y3.y = x2.y - b3.y;
    const float2 c2 = cmulcf(y2, W1); float2 c3 = cmulcf(y3, W1); { const float tx = -c3.y, ty = c3.x; c3.x = tx; c3.y = ty; }
    float2 r;
    r.x = y0.x + c2.x; r.y = y0.y + c2.y; d[i0] = r;
    r.x = y0.x - c2.x; r.y = y0.y - c2.y; d[i0 + 2 * m] = r;
    r.x = y1.x + c3.x; r.y = y1.y + c3.y; d[i0 + m] = r;
    r.x = y1.x - c3.x; r.y = y1.y - c3.y; d[i0 + 3 * m] = r;
}
HD inline int brev14(int k) {
    unsigned v = (unsigned)k;
    v = ((v >> 1) & 0x55555555u) | ((v & 0x55555555u) << 1);
    v = ((v >> 2) & 0x33333333u) | ((v & 0x33333333u) << 2);
    v = ((v >> 4) & 0x0f0f0f0fu) | ((v & 0x0f0f0f0fu) << 4);
    v = ((v >> 8) & 0x00ff00ffu) | ((v & 0x00ff00ffu) << 8);
    v = (v >> 16) | (v << 16);
    return (int)(v >> 18);
}
HD inline void conv_pointwise(float2* d, const float4* pq, int kf) {
    const int k2 = (FN - kf) & (FN - 1), p1 = brev14(kf), p2 = brev14(k2);
    const float2 Z1 = d[p1], Z2 = d[p2];
    const float4 A = pq[p1], B = pq[p2];
    float2 P1, Q1, P2, Q2; P1.x = A.x; P1.y = A.y; Q1.x = A.z; Q1.y = A.w; P2.x = B.x; P2.y = B.y; Q2.x = B.z; Q2.y = B.w;
    float2 c1, c2; c1.x = Z1.x; c1.y = -Z1.y; c2.x = Z2.x; c2.y = -Z2.y;
    const float2 a = cmulf(Z1, P1), b = cmulf(c2, Q1), c = cmulf(Z2, P2), e = cmulf(c1, Q2);
    float2 w1, w2; w1.x = a.x + b.x; w1.y = a.y + b.y; w2.x = c.x + e.x; w2.y = c.y + e.y;
    d[p1] = w1;
    if (p2 != p1) d[p2] = w2;
}
HD inline void filt_pointwise(const float2* d, float4* pq, int kf) {
    const int k2 = (FN - kf) & (FN - 1), p1 = brev14(kf), p2 = brev14(k2);
    const float2 Z1 = d[p1], Z2 = d[p2];
    const float gcx = 0.5f * (Z1.x + Z2.x), gcy = 0.5f * (Z1.y - Z2.y);
    const float gdx = 0.5f * (Z1.y + Z2.y), gdy = -0.5f * (Z1.x - Z2.x);
    const float s = 0.5f / (float)FN;
    float4 A; A.x = s * (gcx + gdx); A.y = s * (gcy + gdy); A.z = s * (gcx - gdx); A.w = s * (gcy - gdy);
    pq[p1] = A;
    float4 B; B.x = A.x; B.y = -A.y; B.z = A.z; B.w = -A.w;
    if (p2 != p1) pq[p2] = B;
}

#ifndef FFT_HOST_TEST
__device__ void fft_forward(float2* d, const float2* tw) {
    int tid = threadIdx.x; asm volatile("" : "+v"(tid));
    for (int lgm = 12; lgm >= 0; lgm -= 2) {
        for (int q = tid; q < FN / 4; q += NTHR) fft_fwd_bfly(d, tw, lgm, q);
        __syncthreads();
    }
}
__device__ void fft_inverse(float2* d, const float2* tw) {
    int tid = threadIdx.x; asm volatile("" : "+v"(tid));
    for (int lgm = 0; lgm <= 12; lgm += 2) {
        for (int q = tid; q < FN / 4; q += NTHR) fft_inv_bfly(d, tw, lgm, q);
        __syncthreads();
    }
}

constexpr int STG = 49152;
__device__ __forceinline__ int swz(int row, int ch) { return row * 128 + ((ch ^ ((row >> 1) & 7)) << 4); }
__device__ __forceinline__ void gemm_core(f32x4 (&acc)[4][4], const bf16_t* A, int lda, const bf16_t* Bt, int ldb, int K, unsigned char* lds) {
    int tid_ = threadIdx.x; asm volatile("" : "+v"(tid_)); const int tid = tid_, lane = tid & 63, w = tid >> 6, wm = w & 3, wn = w >> 2, l15 = lane & 15, q4 = lane >> 4;
    const int crow = tid >> 3, cch = tid & 7;
    u32x4 ra[4], rb[2];
#pragma unroll
    for (int mi = 0; mi < 4; ++mi)
#pragma unroll
        for (int ni = 0; ni < 4; ++ni) acc[mi][ni] = (f32x4){0.f, 0.f, 0.f, 0.f};
    const bf16_t* ap = A + (size_t)crow * lda + cch * 8;
    const bf16_t* bp = Bt + (size_t)crow * ldb + cch * 8;
#pragma unroll
    for (int i = 0; i < 4; ++i) ra[i] = *(const u32x4*)(ap + (size_t)(64 * i) * lda);
#pragma unroll
    for (int i = 0; i < 2; ++i) rb[i] = *(const u32x4*)(bp + (size_t)(64 * i) * ldb);
#pragma unroll
    for (int i = 0; i < 4; ++i) *(u32x4*)(lds + swz(crow + 64 * i, cch)) = ra[i];
#pragma unroll
    for (int i = 0; i < 2; ++i) *(u32x4*)(lds + 32768 + swz(crow + 64 * i, cch)) = rb[i];
    __syncthreads();
    const int nk = K >> 6;
    for (int kt = 0; kt < nk; ++kt) {
        if (kt + 1 < nk) {
            const int k0 = (kt + 1) << 6;
#pragma unroll
            for (int i = 0; i < 4; ++i) ra[i] = *(const u32x4*)(ap + (size_t)(64 * i) * lda + k0);
#pragma unroll
            for (int i = 0; i < 2; ++i) rb[i] = *(const u32x4*)(bp + (size_t)(64 * i) * ldb + k0);
        }
        const unsigned char* sa = lds + (kt & 1) * STG;
        const unsigned char* sb = sa + 32768;
#pragma unroll
        for (int ks = 0; ks < 2; ++ks) {
            bf16x8 af[4], bfr[4];
#pragma unroll
            for (int mi = 0; mi < 4; ++mi) af[mi] = *(const bf16x8*)(sa + swz(wm * 64 + mi * 16 + l15, ks * 4 + q4));
#pragma unroll
            for (int ni = 0; ni < 4; ++ni) bfr[ni] = *(const bf16x8*)(sb + swz(wn * 64 + ni * 16 + l15, ks * 4 + q4));
#pragma unroll
            for (int mi = 0; mi < 4; ++mi)
#pragma unroll
                for (int ni = 0; ni < 4; ++ni) acc[mi][ni] = MFMA(bfr[ni], af[mi], acc[mi][ni]);
        }
        if (kt + 1 < nk) {
            unsigned char* da = lds + ((kt + 1) & 1) * STG;
#pragma unroll
            for (int i = 0; i < 4; ++i) *(u32x4*)(da + swz(crow + 64 * i, cch)) = ra[i];
#pragma unroll
            for (int i = 0; i < 2; ++i) *(u32x4*)(da + 32768 + swz(crow + 64 * i, cch)) = rb[i];
        }
        __syncthreads();
    }
}
#define EPI_LOOP(body)                                                                                                  \
    {                                                                                                                   \
        int e_t = threadIdx.x; asm volatile("" : "+v"(e_t)); const int e_lane = e_t & 63, e_w = e_t >> 6;                                                    \
        _Pragma("unroll") for (int mi = 0; mi < 4; ++mi) _Pragma("unroll") for (int ni = 0; ni < 4; ++ni) {             \
            const int row = m0 + (e_w & 3) * 64 + mi * 16 + (e_lane & 15);                                              \
            const int col = n0 + (e_w >> 2) * 64 + ni * 16 + 4 * (e_lane >> 4);                                         \
            f32x4& v = acc[mi][ni];                                                                                     \
            body                                                                                                        \
        }                                                                                                               \
    }
__device__ __forceinline__ void st_bf4(bf16_t* dst, f32x4 v) {
    u32x2 o; o.x = pk2(v[0], v[1]); o.y = pk2(v[2], v[3]); *(u32x2*)dst = o;
}
__device__ __forceinline__ f32x4 ld_bf4(const bf16_t* src) {
    const u32x2 u = *(const u32x2*)src; f32x4 r = {lo16(u.x), hi16(u.x), lo16(u.y), hi16(u.y)}; return r;
}

__device__ __forceinline__ int orig_col(int n) {
    if (n < 4096) return n;
    if (n < 4608) return n + 32;
    if (n < 6656) return n + 32;
    if (n < 10752) return n + 32;
    return n - 10752 + 4096;
}

__device__ void ln_rows(const float* src, size_t src_row0, int nrows, const float* g, const float* b, float* dst32, bf16_t* dst16, size_t dst_row0, float2* stats) {
    int tid_ = threadIdx.x; asm volatile("" : "+v"(tid_));
    const int lane = tid_ & 63;
    const int gw = blockIdx.x * (NTHR / 64) + (tid_ >> 6), nw = gridDim.x * (NTHR / 64);
    for (int r = gw; r < nrows; r += nw) {
        const float4* xr = (const float4*)(src + (src_row0 + r) * 1024);
        float4 v[4]; float s = 0.f;
#pragma unroll
        for (int i = 0; i < 4; ++i) { v[i] = xr[lane + 64 * i]; s += (v[i].x + v[i].y) + (v[i].z + v[i].w); }
        s = wave_sum(s);
        const float mean = s * (1.0f / 1024.0f);
        float q = 0.f;
#pragma unroll
        for (int i = 0; i < 4; ++i) { const float a = v[i].x - mean, bb = v[i].y - mean, c = v[i].z - mean, d = v[i].w - mean; q += (a * a + bb * bb) + (c * c + d * d); }
        q = wave_sum(q);
        const float rstd = 1.0f / sqrtf(q * (1.0f / 1024.0f) + 1e-5f);
        if (stats && lane == 0) { float2 st; st.x = mean; st.y = rstd; stats[dst_row0 + r] = st; }
#pragma unroll
        for (int i = 0; i < 4; ++i) {
            const float4 g4 = ((const float4*)g)[lane + 64 * i], b4 = ((const float4*)b)[lane + 64 * i];
            float4 y; y.x = (v[i].x - mean) * rstd * g4.x + b4.x; y.y = (v[i].y - mean) * rstd * g4.y + b4.y; y.z = (v[i].z - mean) * rstd * g4.z + b4.z; y.w = (v[i].w - mean) * rstd * g4.w + b4.w;
            if (dst32) ((float4*)(dst32 + (dst_row0 + r) * 1024))[lane + 64 * i] = y;
            if (dst16) { u32x2 o; o.x = pk2(y.x, y.y); o.y = pk2(y.z, y.w); *(u32x2*)(dst16 + (dst_row0 + r) * 1024 + (lane + 64 * i) * 4) = o; }
        }
    }
}
__device__ void phase0(const Params& p) {
    ln_rows(p.x, 0, NTOK, p.ln_in_g, p.ln_in_b, nullptr, (bf16_t*)(p.ws + OFF_HB), 0, (float2*)(p.ws + OFF_STATS));
    int tid_ = threadIdx.x; asm volatile("" : "+v"(tid_)); const int gt = blockIdx.x * NTHR + tid_, nt = gridDim.x * NTHR;
    float2* tw = (float2*)(p.ws + OFF_TW);
    for (int k = gt; k < FN; k += nt) { double s, c; sincospi(-2.0 * (double)k / (double)FN, &s, &c); float2 t; t.x = (float)c; t.y = (float)s; tw[k] = t; }
    bf16_t* mb = (bf16_t*)(p.ws + OFF_MEMBF);
    for (int i = gt; i < 2048 * 1024 / 4; i += nt) { const float4 v = ((const float4*)p.mem)[i]; u32x2 o; o.x = pk2(v.x, v.y); o.y = pk2(v.z, v.w); ((u32x2*)mb)[i] = o; }
    float* en = (float*)(p.ws + OFF_ENERGY);
    for (int i = gt; i < 1024; i += nt) en[i] = 0.f;
}

__device__ void wt_tile(const float* src, int src_ld, int k0, int on0, bf16_t* dst, int dst_ld, int dn0, bool zero, float* tile) {
    int tid_ = threadIdx.x; asm volatile("" : "+v"(tid_)); const int tid = tid_;
    if (!zero) {
#pragma unroll
        for (int i = 0; i < 2; ++i) {
            const int k = (tid >> 3) + 64 * i, c4 = (tid & 7) * 4;
            const float4 v = *(const float4*)(src + (size_t)(k0 + k) * src_ld + on0 + c4);
            float* t = tile + k * 33 + c4; t[0] = v.x; t[1] = v.y; t[2] = v.z; t[3] = v.w;
        }
    }
    __syncthreads();
    const int n = tid >> 4, kc = (tid & 15) * 8;
    float f[8];
#pragma unroll
    for (int e = 0; e < 8; ++e) f[e] = zero ? 0.f : tile[(kc + e) * 33 + n];
    u32x4 o; o.x = pk2(f[0], f[1]); o.y = pk2(f[2], f[3]); o.z = pk2(f[4], f[5]); o.w = pk2(f[6], f[7]);
    *(u32x4*)(dst + (size_t)(dn0 + n) * dst_ld + k0 + kc) = o;
    __syncthreads();
}
__device__ void phase_weights(const Params& p, int l, unsigned char* lds) {
    float* tile = (float*)lds;
    for (int it = blockIdx.x; it < 3776; it += gridDim.x) {
        if (it < 2752) {
            const int nt = it >> 3, kt = it & 7, dn0 = nt * 32;
            wt_tile(p.w_in + (size_t)l * 1024 * NIN, NIN, kt * 128, orig_col(dn0), (bf16_t*)(p.ws + OFF_WTIN), 1024, dn0, dn0 >= NIN, tile);
        } else if (it < 3264) {
            const int r = it - 2752, j = r >> 7, nt = (r >> 2) & 31, kt = r & 3;
            wt_tile(p.w_br + (size_t)(l * 4 + j) * 512 * 1024, 1024, kt * 128, nt * 32, (bf16_t*)(p.ws + OFF_WTBR) + (size_t)j * 1024 * 512, 512, nt * 32, false, tile);
        } else if (it < 3520) {
            const int r = it - 3264, nt = r >> 3, kt = r & 7;
            wt_tile(p.w_out + (size_t)l * 1024 * 1024, 1024, kt * 128, nt * 32, (bf16_t*)(p.ws + OFF_WTOUT), 1024, nt * 32, false, tile);
        } else {
            const int r = it - 3520, nt = r >> 3, kt = r & 7;
            wt_tile(p.mem_w_kv + (size_t)l * 1024 * 1024, 1024, kt * 128, nt * 32, (bf16_t*)(p.ws + OFF_WTKV), 1024, nt * 32, false, tile);
        }
    }
}

__device__ void phase_filter_gen(const Params& p, int l, unsigned char* lds) {
    float* zt = (float*)lds;
    float* ha = zt + 32 * 33;
    float* hbuf = ha + 32 * 64;
    int tid_ = threadIdx.x; asm volatile("" : "+v"(tid_)); const int tid = tid_;
    const float* w1 = p.hy_w1 + (size_t)l * 33 * 64; const float* b1 = p.hy_b1 + l * 64;
    const float* wm = p.hy_wm + (size_t)l * 2 * 64 * 64; const float* bm = p.hy_bm + l * 2 * 64;
    const float* w3 = p.hy_w3 + (size_t)l * 64 * 1024;
    float* hf = (float*)(p.ws + OFF_HFILT);
    float* en = (float*)(p.ws + OFF_ENERGY) + l * 512;
    for (int it = blockIdx.x; it < 256; it += gridDim.x) {
        const int n0 = it * 32;
        for (int idx = tid; idx < 32 * 33; idx += NTHR) {
            const int pos = idx / 33, e = idx - pos * 33, n = n0 + pos;
            float v;
            if (e == 0) v = (float)n / 8191.0f;
            else {
                const int i = (e - 1) & 15;
                const double fr = 1e-4 + (double)i * ((15.0 - 1e-4) / 15.0);
                const double ang = (2.0 * 3.14159265358979323846 / 8192.0) * (double)n * fr;
                v = (e <= 16) ? (float)cos(ang) : (float)(-sin(ang));
            }
            zt[idx] = v;
        }
        __syncthreads();
        for (int idx = tid; idx < 2048; idx += NTHR) {
            const int pos = idx >> 6, j = idx & 63; float s = b1[j];
            for (int e = 0; e < 33; ++e) s += zt[pos * 33 + e] * w1[e * 64 + j];
            ha[idx] = sinf(s);
        }
        __syncthreads();
        for (int idx = tid; idx < 2048; idx += NTHR) {
            const int pos = idx >> 6, j = idx & 63; float s = bm[j];
            for (int e = 0; e < 64; ++e) s += ha[pos * 64 + e] * wm[e * 64 + j];
            hbuf[idx] = sinf(s);
        }
        __syncthreads();
        for (int idx = tid; idx < 2048; idx += NTHR) {
            const int pos = idx >> 6, j = idx & 63; float s = bm[64 + j];
            for (int e = 0; e < 64; ++e) s += hbuf[pos * 64 + e] * wm[4096 + e * 64 + j];
            ha[idx] = sinf(s);
        }
        __syncthreads();
        {
            const int c = tid;
            float af[32], ab[32];
#pragma unroll
            for (int i = 0; i < 32; ++i) { af[i] = 0.f; ab[i] = 0.f; }
            for (int k = 0; k < 64; ++k) {
                const float wf = w3[k * 1024 + c], wb = w3[k * 1024 + 512 + c];
#pragma unroll
                for (int i = 0; i < 32; ++i) { const float h = ha[i * 64 + k]; af[i] += h * wf; ab[i] += h * wb; }
            }
            const float dmin = -3.0701134573253945f, dmax = -15.350567286626973f;
            const float delta = fabsf(dmin + (float)c * ((dmax - dmin) / 511.0f));
            float e = 0.f;
#pragma unroll
            for (int i = 0; i < 32; ++i) {
                const int n = n0 + i; const float t01 = (float)n / 8191.0f; const float win = expf(-t01 * delta);
                af[i] *= win; ab[i] *= win; e += af[i] * af[i]; if (n >= 1) e += ab[i] * ab[i];
            }
#pragma unroll
            for (int i = 0; i < 8; ++i) {
                float4 a; a.x = af[4 * i]; a.y = af[4 * i + 1]; a.z = af[4 * i + 2]; a.w = af[4 * i + 3];
                float4 b; b.x = ab[4 * i]; b.y = ab[4 * i + 1]; b.z = ab[4 * i + 2]; b.w = ab[4 * i + 3];
                *(float4*)(hf + (size_t)c * 8192 + n0 + 4 * i) = a;
                *(float4*)(hf + (size_t)(512 + c) * 8192 + n0 + 4 * i) = b;
            }
            atomicAdd(en + c, e);
        }
        __syncthreads();
    }
}

__device__ void phase_filter_fft(const Params& p, int l, unsigned char* lds) {
    float2* d = (float2*)lds;
    const float2* tw = (const float2*)(p.ws + OFF_TW);
    const float* hf = (const float*)(p.ws + OFF_HFILT);
    const float* en = (const float*)(p.ws + OFF_ENERGY) + l * 512;
    float4* pqa = (float4*)(p.ws + OFF_PQ);
    int tid_ = threadIdx.x; asm volatile("" : "+v"(tid_)); const int tid = tid_;
    for (int pr = blockIdx.x; pr < 256; pr += gridDim.x) {
        const int c0 = 2 * pr, c1 = c0 + 1;
        const float s0 = 1.0f / sqrtf(en[c0] + 1e-6f), s1 = 1.0f / sqrtf(en[c1] + 1e-6f);
        const float k0 = p.hy_skip[l * 512 + c0], k1 = p.hy_skip[l * 512 + c1];
        for (int n = tid; n < FN; n += NTHR) {
            float2 v;
            if (n < 8192) { v.x = hf[(size_t)c0 * 8192 + n] * s0; v.y = hf[(size_t)c1 * 8192 + n] * s1; if (n == 0) { v.x += k0; v.y += k1; } }
            else if (n == 8192) { v.x = 0.f; v.y = 0.f; }
            else { v.x = hf[(size_t)(512 + c0) * 8192 + (FN - n)] * s0; v.y = hf[(size_t)(512 + c1) * 8192 + (FN - n)] * s1; }
            d[n] = v;
        }
        __syncthreads();
        fft_forward(d, tw);
        for (int kf = tid; kf <= FN / 2; kf += NTHR) filt_pointwise(d, pqa + (size_t)pr * FN, kf);
        __syncthreads();
    }
}

__device__ void hy_pre_item(const Params& p, int l, const bf16_t* P, float* UT, bf16_t* GT, int bl, int tt, int ct, unsigned char* lds) {
    float* tU = (float*)lds;
    float* tG = tU + 64 * 65;
    int tid_ = threadIdx.x; asm volatile("" : "+v"(tid_)); const int tid = tid_;
    const int t = tid >> 3, cc = (tid & 7) * 8, c = ct * 64 + cc, tb = tt * 64 + t;
    const float* cw = p.hy_conv_w + (size_t)l * 3 * 1536; const float* cb = p.hy_conv_b + l * 1536;
    float av[8], a0[8], a1[8];
#pragma unroll
    for (int h = 0; h < 2; ++h) {
        const f32x4 bv = *(const f32x4*)(cb + c + 4 * h), b0 = *(const f32x4*)(cb + 512 + c + 4 * h), b1 = *(const f32x4*)(cb + 1024 + c + 4 * h);
#pragma unroll
        for (int e = 0; e < 4; ++e) { av[4 * h + e] = bv[e]; a0[4 * h + e] = b0[e]; a1[4 * h + e] = b1[e]; }
    }
#pragma unroll
    for (int j = 0; j < 3; ++j) {
        const int ts = tb + j - 1;
        if (ts >= 0 && ts < SEQ) {
            const bf16_t* row = P + (size_t)(bl * SEQ + ts) * PS + C_HY + c;
            const u32x4 rv = *(const u32x4*)row, r0 = *(const u32x4*)(row + 512), r1 = *(const u32x4*)(row + 1024);
#pragma unroll
            for (int h = 0; h < 2; ++h) {
                const f32x4 wv = *(const f32x4*)(cw + j * 1536 + c + 4 * h), w0 = *(const f32x4*)(cw + j * 1536 + 512 + c + 4 * h), w1 = *(const f32x4*)(cw + j * 1536 + 1024 + c + 4 * h);
#pragma unroll
                for (int e = 0; e < 4; ++e) {
                    const int k = 4 * h + e; const unsigned uv = rv[k >> 1], u0 = r0[k >> 1], u1 = r1[k >> 1];
                    av[k] += wv[e] * ((k & 1) ? hi16(uv) : lo16(uv)); a0[k] += w0[e] * ((k & 1) ? hi16(u0) : lo16(u0)); a1[k] += w1[e] * ((k & 1) ? hi16(u1) : lo16(u1));
                }
            }
        }
    }
    const u32x4 rz = *(const u32x4*)(P + (size_t)(bl * SEQ + tb) * PS + C_Z + 512 + c);
#pragma unroll
    for (int k = 0; k < 8; ++k) {
        const unsigned uz = rz[k >> 1]; const float z = (k & 1) ? hi16(uz) : lo16(uz);
        tU[(cc + k) * 65 + t] = av[k] * a1[k]; tG[(cc + k) * 65 + t] = a0[k] * z;
    }
    __syncthreads();
    const int c2 = tid >> 3, t8 = (tid & 7) * 8;
    const size_t o = (size_t)(bl * 512 + ct * 64 + c2) * SEQ + tt * 64 + t8;
    const float* su = tU + c2 * 65 + t8; const float* sg = tG + c2 * 65 + t8;
    f32x4 ua = {su[0], su[1], su[2], su[3]}, ub = {su[4], su[5], su[6], su[7]};
    *(f32x4*)(UT + o) = ua; *(f32x4*)(UT + o + 4) = ub;
    u32x4 g; g.x = pk2(sg[0], sg[1]); g.y = pk2(sg[2], sg[3]); g.z = pk2(sg[4], sg[5]); g.w = pk2(sg[6], sg[7]);
    *(u32x4*)(GT + o) = g;
    __syncthreads();
}
__device__ void hy_post_item(bf16_t* P, const bf16_t* GT, int bl, int tt, int ct, unsigned char* lds) {
    bf16_t* tl = (bf16_t*)lds;
    int tid_ = threadIdx.x; asm volatile("" : "+v"(tid_)); const int tid = tid_;
    const int c2 = tid >> 3, t8 = (tid & 7) * 8;
    const u32x4 v = *(const u32x4*)(GT + (size_t)(bl * 512 + ct * 64 + c2) * SEQ + tt * 64 + t8);
    bf16_t* d0 = tl + t8 * 72 + c2;
    d0[0 * 72] = (bf16_t)(v.x & 0xffffu); d0[1 * 72] = (bf16_t)(v.x >> 16); d0[2 * 72] = (bf16_t)(v.y & 0xffffu); d0[3 * 72] = (bf16_t)(v.y >> 16);
    d0[4 * 72] = (bf16_t)(v.z & 0xffffu); d0[5 * 72] = (bf16_t)(v.z >> 16); d0[6 * 72] = (bf16_t)(v.w & 0xffffu); d0[7 * 72] = (bf16_t)(v.w >> 16);
    __syncthreads();
    const int t = tid >> 3, cc = (tid & 7) * 8;
    *(u32x4*)(P + (size_t)(bl * SEQ + tt * 64 + t) * PS + C_HY + ct * 64 + cc) = *(const u32x4*)(tl + t * 72 + cc);
    __syncthreads();
}
__device__ void hyena_conv_item(const Params& p, const float* UT, bf16_t* GT, int bl, int pr, unsigned char* lds) {
    float2* d = (float2*)lds;
    const float2* tw = (const float2*)(p.ws + OFF_TW);
    const float4* pq = (const float4*)(p.ws + OFF_PQ) + (size_t)pr * FN;
    int tid_ = threadIdx.x; asm volatile("" : "+v"(tid_)); const int tid = tid_;
    const float* u0 = UT + (size_t)(bl * 512 + 2 * pr) * SEQ; const float* u1 = u0 + SEQ;
    bf16_t* g0 = GT + (size_t)(bl * 512 + 2 * pr) * SEQ; bf16_t* g1 = g0 + SEQ;
    for (int t = tid; t < SEQ; t += NTHR) {
        float2 u; u.x = u0[t]; u.y = u1[t]; d[t] = u;
        float2 z; z.x = 0.f; z.y = 0.f; d[t + SEQ] = z;
    }
    __syncthreads();
    fft_forward(d, tw);
    for (int kf = tid; kf <= FN / 2; kf += NTHR) conv_pointwise(d, pq, kf);
    __syncthreads();
    fft_inverse(d, tw);
    for (int t = tid; t < SEQ; t += NTHR) {
        const float2 y = d[t];
        g0[t] = f2bf(y.x * bf2f(g0[t])); g1[t] = f2bf(y.y * bf2f(g1[t]));
    }
    __syncthreads();
}

__device__ void na_item(const Params& p, int l, bf16_t* P, int bl, int rp, int head, unsigned char* lds) {
    bf16_t* Kimg = (bf16_t*)lds;
    bf16_t* VT = (bf16_t*)(lds + 82944);
    int tid_ = threadIdx.x; asm volatile("" : "+v"(tid_)); const int tid = tid_, lane = tid & 63, w = tid >> 6, l15 = lane & 15, q4 = lane >> 4;
    const int r0 = 2 * rp, rs0 = iclamp(r0 - 4, 0, 120);
#pragma unroll 1
    for (int i = 0; i < 9; ++i) {
        const int idx = tid + NTHR * i, ch = idx / 576, key = idx - ch * 576, wr = key >> 6, col = key & 63;
        const int grow = min(rs0 + wr, 127);
        const bf16_t* src = P + (size_t)(bl * SEQ + grow * 64 + col) * PS + head * 64 + ch * 8;
        const u32x4 kv = *(const u32x4*)(src + C_NAK), vv = *(const u32x4*)(src + C_NAV);
        *(u32x4*)(Kimg + key * 72 + ch * 8) = kv;
        bf16_t* vd = VT + (ch * 8) * 584 + key;
        vd[0 * 584] = (bf16_t)(vv.x & 0xffffu); vd[1 * 584] = (bf16_t)(vv.x >> 16);
        vd[2 * 584] = (bf16_t)(vv.y & 0xffffu); vd[3 * 584] = (bf16_t)(vv.y >> 16);
        vd[4 * 584] = (bf16_t)(vv.z & 0xffffu); vd[5 * 584] = (bf16_t)(vv.z >> 16);
        vd[6 * 584] = (bf16_t)(vv.w & 0xffffu); vd[7 * 584] = (bf16_t)(vv.w >> 16);
    }
    __syncthreads();
    const int rr = w >> 2, g = w & 3, r = r0 + rr, rs = iclamp(r - 4, 0, 120), lo = rs - rs0;
    const int cb = iclamp(16 * g - 8, 0, 32), c = 16 * g + l15, cs = iclamp(c - 8, 0, 48);
    bf16_t* qrow = P + (size_t)(bl * SEQ + r * 64 + c) * PS + head * 64;
    bf16x8 qf[2];
#pragma unroll
    for (int ks = 0; ks < 2; ++ks) qf[ks] = *(const bf16x8*)(qrow + ks * 32 + q4 * 8);
    f32x4 sc[16];
#pragma unroll
    for (int t = 0; t < 16; ++t) {
        const int kb = (lo + (t >> 1)) * 64 + cb + 16 * (t & 1);
        f32x4 a = {0.f, 0.f, 0.f, 0.f};
#pragma unroll
        for (int ks = 0; ks < 2; ++ks) { const bf16x8 kf = *(const bf16x8*)(Kimg + (kb + l15) * 72 + ks * 32 + q4 * 8); a = MFMA(kf, qf[ks], a); }
        sc[t] = a;
    }
    const float* rpb = p.na_rpb + (size_t)(l * 8 + head) * 15 * 31;
    float mx = -1e30f;
#pragma unroll
    for (int t = 0; t < 16; ++t) {
        const int drow = rs + (t >> 1) - r + 7;
#pragma unroll
        for (int e = 0; e < 4; ++e) {
            const int col = cb + 16 * (t & 1) + 4 * q4 + e;
            const bool ok = (col >= cs) && (col < cs + 16);
            const int dcol = ok ? (col - c + 15) : 0;
            const float v = ok ? (sc[t][e] + rpb[drow * 31 + dcol]) : -1e30f;
            sc[t][e] = v; mx = fmaxf(mx, v);
        }
    }
    mx = fmaxf(mx, __shfl_xor(mx, 16)); mx = fmaxf(mx, __shfl_xor(mx, 32));
    float sum = 0.f;
#pragma unroll
    for (int t = 0; t < 16; ++t)
#pragma unroll
        for (int e = 0; e < 4; ++e) { const float pe = __expf(sc[t][e] - mx); sc[t][e] = pe; sum += pe; }
    sum += __shfl_xor(sum, 16); sum += __shfl_xor(sum, 32);
    f32x4 o[4];
#pragma unroll
    for (int dt = 0; dt < 4; ++dt) o[dt] = (f32x4){0.f, 0.f, 0.f, 0.f};
#pragma unroll
    for (int kk = 0; kk < 8; ++kk) {
        u32x4 pu; pu.x = pk2(sc[2 * kk][0], sc[2 * kk][1]); pu.y = pk2(sc[2 * kk][2], sc[2 * kk][3]); pu.z = pk2(sc[2 * kk + 1][0], sc[2 * kk + 1][1]); pu.w = pk2(sc[2 * kk + 1][2], sc[2 * kk + 1][3]);
        const bf16x8 pf = mkfrag(pu);
        const int kbA = (lo + kk) * 64 + cb + 4 * q4;
#pragma unroll
        for (int dt = 0; dt < 4; ++dt) {
            const bf16_t* vr = VT + (dt * 16 + l15) * 584 + kbA;
            const bf16x8 vf = mkfrag2(*(const u32x2*)vr, *(const u32x2*)(vr + 16));
            o[dt] = MFMA(vf, pf, o[dt]);
        }
    }
    const float inv = 1.0f / sum;
    const bf16_t* zrow = P + (size_t)(bl * SEQ + r * 64 + c) * PS + C_Z + head * 64;
#pragma unroll
    for (int dt = 0; dt < 4; ++dt) {
        const int dd = dt * 16 + 4 * q4;
        const f32x4 z = ld_bf4(zrow + dd);
        st_bf4(qrow + dd, o[dt] * inv * z);
    }
    __syncthreads();
}

__device__ void memattn_load(const Params& p, int b, int h, unsigned char* lds) {
    bf16_t* Kimg = (bf16_t*)lds;
    bf16_t* VT = (bf16_t*)(lds + 69632);
    const bf16_t* Km = (const bf16_t*)(p.ws + OFF_KMAT); const bf16_t* Vm = (const bf16_t*)(p.ws + OFF_VT);
    int tid_ = threadIdx.x; asm volatile("" : "+v"(tid_)); const int tid = tid_;
#pragma unroll
    for (int i = 0; i < 8; ++i) {
        const int idx = tid + NTHR * i;
        { const int key = idx >> 4, ch = idx & 15; *(u32x4*)(Kimg + key * 136 + ch * 8) = *(const u32x4*)(Km + (size_t)(b * 256 + key) * 512 + h * 128 + ch * 8); }
        { const int dd = idx >> 5, ch = idx & 31; *(u32x4*)(VT + dd * 264 + ch * 8) = *(const u32x4*)(Vm + (size_t)(h * 128 + dd) * 2048 + b * 256 + ch * 8); }
    }
    __syncthreads();
}
__device__ void memattn_item(bf16_t* P, int bl, int h, int qt, unsigned char* lds) {
    const bf16_t* Kimg = (const bf16_t*)lds; const bf16_t* VT = (const bf16_t*)(lds + 69632);
    int tid_ = threadIdx.x; asm volatile("" : "+v"(tid_)); const int tid = tid_, lane = tid & 63, w = tid >> 6, l15 = lane & 15, q4 = lane >> 4;
    const int tok = bl * SEQ + qt * 128 + w * 16 + l15;
    bf16_t* qrow = P + (size_t)tok * PS + C_MQ + h * 128;
    bf16x8 qf[4];
#pragma unroll
    for (int ks = 0; ks < 4; ++ks) qf[ks] = *(const bf16x8*)(qrow + ks * 32 + q4 * 8);
    f32x4 sc[16];
    float mx = -1e30f;
#pragma unroll
    for (int t = 0; t < 16; ++t) {
        f32x4 a = {0.f, 0.f, 0.f, 0.f};
#pragma unroll
        for (int ks = 0; ks < 4; ++ks) { const bf16x8 kf = *(const bf16x8*)(Kimg + (t * 16 + l15) * 136 + ks * 32 + q4 * 8); a = MFMA(kf, qf[ks], a); }
        sc[t] = a;
        mx = fmaxf(mx, fmaxf(fmaxf(a[0], a[1]), fmaxf(a[2], a[3])));
    }
    mx = fmaxf(mx, __shfl_xor(mx, 16)); mx = fmaxf(mx, __shfl_xor(mx, 32));
    float sum = 0.f;
#pragma unroll
    for (int t = 0; t < 16; ++t)
#pragma unroll
        for (int e = 0; e < 4; ++e) { const float pe = __expf(sc[t][e] - mx); sc[t][e] = pe; sum += pe; }
    sum += __shfl_xor(sum, 16); sum += __shfl_xor(sum, 32);
    f32x4 o[8];
#pragma unroll
    for (int dt = 0; dt < 8; ++dt) o[dt] = (f32x4){0.f, 0.f, 0.f, 0.f};
#pragma unroll
    for (int kk = 0; kk < 8; ++kk) {
        u32x4 pu; pu.x = pk2(sc[2 * kk][0], sc[2 * kk][1]); pu.y = pk2(sc[2 * kk][2], sc[2 * kk][3]); pu.z = pk2(sc[2 * kk + 1][0], sc[2 * kk + 1][1]); pu.w = pk2(sc[2 * kk + 1][2], sc[2 * kk + 1][3]);
        const bf16x8 pf = mkfrag(pu);
#pragma unroll
        for (int dt = 0; dt < 8; ++dt) {
            const bf16_t* vr = VT + (dt * 16 + l15) * 264 + kk * 32 + 4 * q4;
            const bf16x8 vf = mkfrag2(*(const u32x2*)vr, *(const u32x2*)(vr + 16));
            o[dt] = MFMA(vf, pf, o[dt]);
        }
    }
    const float inv = 1.0f / sum;
    const bf16_t* zrow = P + (size_t)tok * PS + C_Z + 3 * 512 + h * 128;
#pragma unroll
    for (int dt = 0; dt < 8; ++dt) {
        const int dd = dt * 16 + 4 * q4;
        const f32x4 z = ld_bf4(zrow + dd);
        st_bf4(qrow + dd, o[dt] * inv * z);
    }
}

constexpr int G_LRT = 0, G_BF = 8192, G_BB = 24576, G_TOT = 40960, G_IMG = 45056;
__device__ void gla_tables(const Params& p, int l, const float* LR, int t0, int h, unsigned char* lds) {
    float* LRT = (float*)(lds + G_LRT); float* BF = (float*)(lds + G_BF); float* BB = (float*)(lds + G_BB); float* TOT = (float*)(lds + G_TOT);
    int tid_ = threadIdx.x; asm volatile("" : "+v"(tid_)); const int tid = tid_;
    ((float4*)LRT)[tid] = ((const float4*)(LR + (size_t)t0 * 32))[tid];
    __syncthreads();
    const int dk = tid & 63, cgp = tid >> 6;
    float uf[16], ub[16];
#pragma unroll
    for (int r = 0; r < 16; ++r) { uf[r] = p.gla_up_f[(size_t)(l * 16 + r) * 256 + h * 64 + dk]; ub[r] = p.gla_up_b[(size_t)(l * 16 + r) * 256 + h * 64 + dk]; }
    const float bif = p.gla_bias_f[l * 256 + h * 64 + dk], bib = p.gla_bias_b[l * 256 + h * 64 + dk];
    float lf[8], lb[8];
#pragma unroll
    for (int i = 0; i < 8; ++i) {
        const int c = cgp * 8 + i; float sf = bif, sb = bib;
#pragma unroll
        for (int r = 0; r < 16; ++r) { sf += LRT[c * 32 + r] * uf[r]; sb += LRT[c * 32 + 16 + r] * ub[r]; }
        lf[i] = logsigf_(sf) * (1.0f / 16.0f); lb[i] = logsigf_(sb) * (1.0f / 16.0f);
    }
#pragma unroll
    for (int i = 1; i < 8; ++i) lf[i] += lf[i - 1];
#pragma unroll
    for (int i = 6; i >= 0; --i) lb[i] += lb[i + 1];
    TOT[cgp * 64 + dk] = lf[7]; TOT[512 + cgp * 64 + dk] = lb[0];
    __syncthreads();
    float of = 0.f, ob = 0.f;
#pragma unroll
    for (int g2 = 0; g2 < 8; ++g2) { if (g2 < cgp) of += TOT[g2 * 64 + dk]; if (g2 > cgp) ob += TOT[512 + g2 * 64 + dk]; }
#pragma unroll
    for (int i = 0; i < 8; ++i) { BF[(cgp * 8 + i) * 64 + dk] = lf[i] + of; BB[(cgp * 8 + i) * 64 + dk] = lb[i] + ob; }
    __syncthreads();
}
__device__ void gla_vt(const bf16_t* P, int t0, int h, bf16_t* VT) {
    int tid_ = threadIdx.x; asm volatile("" : "+v"(tid_)); const int tid = tid_;
#pragma unroll
    for (int i = 0; i < 2; ++i) {
        const int idx = tid + NTHR * i, chn = idx >> 6, c = idx & 63;
        const u32x4 vv = *(const u32x4*)(P + (size_t)(t0 + c) * PS + C_GV + h * 128 + chn * 8);
        bf16_t* vd = VT + (chn * 8) * 72 + c;
        vd[0 * 72] = (bf16_t)(vv.x & 0xffffu); vd[1 * 72] = (bf16_t)(vv.x >> 16);
        vd[2 * 72] = (bf16_t)(vv.y & 0xffffu); vd[3 * 72] = (bf16_t)(vv.y >> 16);
        vd[4 * 72] = (bf16_t)(vv.z & 0xffffu); vd[5 * 72] = (bf16_t)(vv.z >> 16);
        vd[6 * 72] = (bf16_t)(vv.w & 0xffffu); vd[7 * 72] = (bf16_t)(vv.w >> 16);
    }
}
__device__ void gla_part1_item(const Params& p, int l, const bf16_t* P, const float* LR, int item, unsigned char* lds) {
    const int h = item & 3, n = (item >> 2) & 127, bl = item >> 9, t0 = bl * SEQ + n * 64;
    const float* BF = (const float*)(lds + G_BF); const float* BB = (const float*)(lds + G_BB);
    bf16_t* KDT0 = (bf16_t*)(lds + G_IMG); bf16_t* KDT1 = KDT0 + 64 * 72; bf16_t* VT = KDT1 + 64 * 72;
    float* GS = (float*)(p.ws + OFF_GS); float* GD = (float*)(p.ws + OFF_GDEC);
    int tid_ = threadIdx.x; asm volatile("" : "+v"(tid_)); const int tid = tid_, lane = tid & 63, w = tid >> 6, l15 = lane & 15, q4 = lane >> 4;
    gla_tables(p, l, LR, t0, h, lds);
#pragma unroll
    for (int i = 0; i < 8; ++i) {
        const int idx = tid + NTHR * i, c = idx >> 6, dk = idx & 63;
        const float kv = bf2f(P[(size_t)(t0 + c) * PS + C_GK + h * 64 + dk]);
        KDT0[dk * 72 + c] = f2bf(kv * __expf(BF[63 * 64 + dk] - BF[c * 64 + dk]));
        KDT1[dk * 72 + c] = f2bf(kv * __expf(BB[dk] - BB[c * 64 + dk]));
    }
    gla_vt(P, t0, h, VT);
    if (tid < 64) GD[(size_t)item * 64 + tid] = __expf(BF[63 * 64 + tid]);
    else if (tid < 128) GD[(size_t)(NITEM + item) * 64 + tid - 64] = __expf(BB[tid - 64]);
    __syncthreads();
    const int dir = w >> 2, dkt = w & 3;
    const bf16_t* KD = dir ? KDT1 : KDT0;
    bf16x8 kf[2];
#pragma unroll
    for (int ks = 0; ks < 2; ++ks) kf[ks] = *(const bf16x8*)(KD + (16 * dkt + l15) * 72 + 32 * ks + 8 * q4);
    float* dst = GS + ((size_t)dir * NITEM + item) * 8192;
#pragma unroll
    for (int dvt = 0; dvt < 8; ++dvt) {
        f32x4 a = {0.f, 0.f, 0.f, 0.f};
#pragma unroll
        for (int ks = 0; ks < 2; ++ks) { const bf16x8 vf = *(const bf16x8*)(VT + (16 * dvt + l15) * 72 + 32 * ks + 8 * q4); a = MFMA(kf[ks], vf, a); }
        *(f32x4*)(dst + (16 * dvt + l15) * 64 + 16 * dkt + 4 * q4) = a;
    }
    __syncthreads();
}
__device__ void gla_scan(const Params& p) {
    float* GS = (float*)(p.ws + OFF_GS); const float* GD = (const float*)(p.ws + OFF_GDEC);
    const int total = 2 * BG * 4 * 8192;
    int tid_ = threadIdx.x; asm volatile("" : "+v"(tid_));
    for (int id = blockIdx.x * NTHR + tid_; id < total; id += gridDim.x * NTHR) {
        const int e = id & 8191, comb = id >> 13, h = comb & 3, bl = (comb >> 2) % BG, dir = comb / (4 * BG), dk = e & 63;
        float S = 0.f;
        const size_t ibase = (size_t)dir * NITEM + (size_t)(bl * 128) * 4 + h;
        for (int s0 = 0; s0 < 128; s0 += 16) {
            float u[16], dc[16];
#pragma unroll
            for (int i = 0; i < 16; ++i) {
                const int n = dir ? 127 - (s0 + i) : s0 + i;
                const size_t item = ibase + (size_t)n * 4;
                u[i] = GS[item * 8192 + e]; dc[i] = GD[item * 64 + dk];
            }
#pragma unroll
            for (int i = 0; i < 16; ++i) {
                const int n = dir ? 127 - (s0 + i) : s0 + i;
                const size_t item = ibase + (size_t)n * 4;
                GS[item * 8192 + e] = S;
                S = dc[i] * S + u[i];
            }
        }
    }
}
__device__ void gla_part2_item(const Params& p, int l, bf16_t* P, const float* LR, int item, unsigned char* lds) {
    const int h = item & 3, n = (item >> 2) & 127, bl = item >> 9, t0 = bl * SEQ + n * 64;
    const float* BF = (const float*)(lds + G_BF); const float* BB = (const float*)(lds + G_BB);
    bf16_t* QF = (bf16_t*)(lds + G_IMG);
    bf16_t* KF = QF + 2 * 64 * 72;
    bf16_t* QD = KF + 2 * 64 * 72;
    bf16_t* VT = QD + 2 * 64 * 72;
    bf16_t* ST = VT + 128 * 72;
    float* OX = (float*)lds;
    const float* GS = (const float*)(p.ws + OFF_GS);
    int tid_ = threadIdx.x; asm volatile("" : "+v"(tid_)); const int tid = tid_, lane = tid & 63, w = tid >> 6, l15 = lane & 15, q4 = lane >> 4;
    gla_tables(p, l, LR, t0, h, lds);
#pragma unroll
    for (int i = 0; i < 8; ++i) {
        const int idx = tid + NTHR * i, c = idx >> 6, dk = idx & 63;
        const float qv = bf2f(P[(size_t)(t0 + c) * PS + C_GQ + h * 64 + dk]);
        const float kv = bf2f(P[(size_t)(t0 + c) * PS + C_GK + h * 64 + dk]);
        const float bf = BF[c * 64 + dk], mf = BF[31 * 64 + dk], bb = BB[c * 64 + dk], mb = BB[32 * 64 + dk];
        QF[c * 72 + dk] = f2bf(qv * __expf(bf - mf)); KF[c * 72 + dk] = f2bf(kv * __expf(mf - bf)); QD[c * 72 + dk] = f2bf(qv * __expf(bf));
        QF[4608 + c * 72 + dk] = f2bf(qv * __expf(bb - mb)); KF[4608 + c * 72 + dk] = f2bf(kv * __expf(mb - bb)); QD[4608 + c * 72 + dk] = f2bf(qv * __expf(bb));
    }
    gla_vt(P, t0, h, VT);
#pragma unroll
    for (int dir = 0; dir < 2; ++dir) {
        const float* src = GS + ((size_t)dir * NITEM + item) * 8192;
#pragma unroll
        for (int i = 0; i < 4; ++i) {
            const int idx = tid + NTHR * i, dv = idx >> 4, dk4 = (idx & 15) * 4;
            const float4 s = *(const float4*)(src + dv * 64 + dk4);
            u32x2 o; o.x = pk2(s.x, s.y); o.y = pk2(s.z, s.w);
            *(u32x2*)(ST + dir * 9216 + dv * 72 + dk4) = o;
        }
    }
    __syncthreads();
    const int dir = w >> 2, ct = w & 3;
    const bf16_t* qfp = QF + dir * 4608; const bf16_t* kfp = KF + dir * 4608; const bf16_t* qdp = QD + dir * 4608; const bf16_t* stp = ST + dir * 9216;
    bf16x8 qf[2], qd[2];
#pragma unroll
    for (int ks = 0; ks < 2; ++ks) { qf[ks] = *(const bf16x8*)(qfp + (16 * ct + l15) * 72 + 32 * ks + 8 * q4); qd[ks] = *(const bf16x8*)(qdp + (16 * ct + l15) * 72 + 32 * ks + 8 * q4); }
    f32x4 sc[4];
    const int cq = 16 * ct + l15;
#pragma unroll
    for (int st = 0; st < 4; ++st) {
        f32x4 a = {0.f, 0.f, 0.f, 0.f};
#pragma unroll
        for (int ks = 0; ks < 2; ++ks) { const bf16x8 kf = *(const bf16x8*)(kfp + (16 * st + l15) * 72 + 32 * ks + 8 * q4); a = MFMA(kf, qf[ks], a); }
#pragma unroll
        for (int e = 0; e < 4; ++e) { const int s = 16 * st + 4 * q4 + e; const bool ok = dir ? (s > cq) : (s <= cq); a[e] = ok ? a[e] : 0.f; }
        sc[st] = a;
    }
    f32x4 o[8];
#pragma unroll
    for (int dt = 0; dt < 8; ++dt) o[dt] = (f32x4){0.f, 0.f, 0.f, 0.f};
#pragma unroll
    for (int kk = 0; kk < 2; ++kk) {
        u32x4 pu; pu.x = pk2(sc[2 * kk][0], sc[2 * kk][1]); pu.y = pk2(sc[2 * kk][2], sc[2 * kk][3]); pu.z = pk2(sc[2 * kk + 1][0], sc[2 * kk + 1][1]); pu.w = pk2(sc[2 * kk + 1][2], sc[2 * kk + 1][3]);
        const bf16x8 pf = mkfrag(pu);
#pragma unroll
        for (int dt = 0; dt < 8; ++dt) {
            const bf16_t* vr = VT + (dt * 16 + l15) * 72 + kk * 32 + 4 * q4;
            const bf16x8 vf = mkfrag2(*(const u32x2*)vr, *(const u32x2*)(vr + 16));
            o[dt] = MFMA(vf, pf, o[dt]);
        }
    }
#pragma unroll
    for (int ks = 0; ks < 2; ++ks)
#pragma unroll
        for (int dt = 0; dt < 8; ++dt) { const bf16x8 sf = *(const bf16x8*)(stp + (dt * 16 + l15) * 72 + 32 * ks + 8 * q4); o[dt] = MFMA(sf, qd[ks], o[dt]); }
    if (dir == 1) {
#pragma unroll
        for (int dt = 0; dt < 8; ++dt) *(f32x4*)(OX + cq * 132 + 16 * dt + 4 * q4) = o[dt];
    }
    __syncthreads();
    if (dir == 0) {
        float ss = 0.f;
#pragma unroll
        for (int dt = 0; dt < 8; ++dt) { o[dt] += *(const f32x4*)(OX + cq * 132 + 16 * dt + 4 * q4); ss += (o[dt][0] * o[dt][0] + o[dt][1] * o[dt][1]) + (o[dt][2] * o[dt][2] + o[dt][3] * o[dt][3]); }
        ss += __shfl_xor(ss, 16); ss += __shfl_xor(ss, 32);
        const float rms = 1.0f / sqrtf(ss * (1.0f / 128.0f) + 1e-6f);
        const float* ng = p.gla_norm_g + l * 512 + h * 128;
        const bf16_t* zrow = P + (size_t)(t0 + cq) * PS + C_Z + 2 * 512 + h * 128;
        bf16_t* orow = P + (size_t)(t0 + cq) * PS + C_GV + h * 128;
#pragma unroll
        for (int dt = 0; dt < 8; ++dt) {
            const int dd = 16 * dt + 4 * q4;
            const f32x4 z = ld_bf4(zrow + dd); const f32x4 g4 = *(const f32x4*)(ng + dd);
            st_bf4(orow + dd, o[dt] * rms * g4 * z);
        }
    }
    __syncthreads();
}

namespace pg8 {
#define PG8_LAS __attribute__((address_space(3)))
typedef unsigned short bf16_t;
typedef short bf16x8 __attribute__((ext_vector_type(8)));
typedef float f32x4 __attribute__((ext_vector_type(4)));
typedef unsigned u32x4 __attribute__((ext_vector_type(4)));
constexpr int BM = 256, BK = 64, HALF = 128, HTB = HALF * BK * 2  , STAGE_BYTES = 8 * HTB, NXCD = 8, WGM = 8;

__host__ __device__ __forceinline__ int lds_byte(int r, int c) { const int st = (r >> 4) * 2 + (c >> 5), rr = r & 15, cc = c & 31, ob = rr * 64 + cc * 2; return st * 1024 + (ob ^ (((ob >> 9) & 1) << 5)); }
__host__ __device__ __forceinline__ void stage_rc(int b, int& R, int& C) { const int st = b / 1024, sb = b % 1024, swz = sb ^ (((sb >> 9) & 1) << 5); R = (st >> 1) * 16 + swz / 64; C = (st & 1) * 32 + (swz % 64) / 2; }
__host__ __device__ __forceinline__ int perm32(int rho) { const int n = rho >> 4, i = rho & 15; return 8 * (i >> 2) + 4 * n + (i & 3); }

struct Unit { int pm, pn; };
struct Gemm { const bf16_t* A; const bf16_t* Bt; int M, N, K; };

struct StaticOrder {
    int nM, nN, nwg, G, c;
    __host__ __device__ void init(int M, int N, int G_, int c_) { nM = M / BM; nN = N / BM; nwg = nM * nN; G = G_; c = c_; }
    __host__ __device__ bool next(int i, Unit& u) const {
        const long L = (long)i * G + c; if (L >= nwg) return false;
        int wgid = (int)L; { const int q = nwg / NXCD, r = nwg % NXCD, xcd = wgid % NXCD, off = wgid / NXCD; wgid = (xcd < r ? xcd * (q + 1) : r * (q + 1) + (xcd - r) * q) + off; }
        const int nig = WGM * nN, gid = wgid / nig, fm = gid * WGM, gsz = (nM - fm) < WGM ? (nM - fm) : WGM;
        u.pm = fm + ((wgid % nig) % gsz); u.pn = (wgid % nig) / gsz; return true;
    }
    __device__ __forceinline__ void a_ready(const Unit&) const {}
    __device__ __forceinline__ void done(const Unit&) const {}
};
__device__ __forceinline__ unsigned cvt_pk_bf16(float lo, float hi) { unsigned r; asm volatile("v_cvt_pk_bf16_f32 %0, %1, %2" : "=v"(r) : "v"(lo), "v"(hi)); return r; }
template <class Epi, class Sched, bool STAMP = false>
__device__ __forceinline__ void gemm_phase(PG8_LAS unsigned char* lds, const Gemm g, const Sched& S, const Epi& E, unsigned long long* stamps) {
    int tid_l = threadIdx.x; asm volatile("" : "+v"(tid_l)); const int tid = tid_l, wid = __builtin_amdgcn_readfirstlane(tid >> 6), lane = tid & 63, wr = wid >> 2, wc = wid & 3, fr = lane & 15, fq = lane >> 4;
    const int K = g.K, nt = K / BK;
    int ts_lo = 0, ts_hi = 0, nts = 0; const unsigned long long rt_entry = STAMP ? (unsigned long long)wall_clock64() : 0ull;
#define PG8_STAMP() do { if (STAMP && wid == 0 && nts < 64) { const unsigned long long _c = (unsigned long long)clock64(); \
        ts_lo = (lane == nts) ? (int)(unsigned)_c : ts_lo; ts_hi = (lane == nts) ? (int)(unsigned)(_c >> 32) : ts_hi; ++nts; } } while (0)
    PG8_STAMP();
    unsigned voffA[2], voffB[2];
#pragma unroll
    for (int i = 0; i < 2; ++i) { int R, C; stage_rc(tid * 16 + i * 8192, R, C); const int Rb = Epi::PERM ? ((R & ~31) + perm32(R & 31)) : R;
        voffA[i] = (unsigned)(R * K + C) * 2u; voffB[i] = (unsigned)(Rb * K + C) * 2u; }
    const size_t kstep = (size_t)(BK * 2);
    const size_t hstep = (size_t)HALF * K * 2;
    const size_t tstep = 2 * hstep;
    const unsigned ldsw = (unsigned)wid * 1024u;
    const int aoff = lds_byte(wr * 64 + fr, fq * 8), boff = lds_byte(wc * 32 + fr, fq * 8);
#define PG8_SA(b, h) (((b) * 2 + (h)) * HTB)
#define PG8_SB(b, h) ((4 + (b) * 2 + (h)) * HTB)
#define PG8_STAGE(bufoff, gbase, voff) do { _Pragma("unroll") for (int _i = 0; _i < 2; ++_i) \
        __builtin_amdgcn_global_load_lds((const unsigned*)((const char*)(gbase) + (voff)[_i]), (PG8_LAS unsigned*)(lds + (bufoff) + ldsw + _i * 8192), 16, 0, 0); } while (0)
#define PG8_LDA(dst, b, h) do { _Pragma("unroll") for (int m = 0; m < 4; ++m) _Pragma("unroll") for (int k = 0; k < 2; ++k) dst[m][k] = *(const PG8_LAS bf16x8*)(lds + PG8_SA(b, h) + aoff + m * 2048 + k * 1024); } while (0)
#define PG8_LDB(dst, b, h) do { _Pragma("unroll") for (int n = 0; n < 2; ++n) _Pragma("unroll") for (int k = 0; k < 2; ++k) dst[n][k] = *(const PG8_LAS bf16x8*)(lds + PG8_SB(b, h) + boff + n * 2048 + k * 1024); } while (0)
#define PG8_MMA(ai, bj, At, Bt) do { __builtin_amdgcn_s_setprio(1); _Pragma("unroll") for (int m = 0; m < 4; ++m) _Pragma("unroll") for (int n = 0; n < 2; ++n) _Pragma("unroll") for (int k = 0; k < 2; ++k) \
        acc[ai][bj][m][n] = __builtin_amdgcn_mfma_f32_16x16x32_bf16(Bt[n][k], At[m][k], acc[ai][bj][m][n], 0, 0, 0); __builtin_amdgcn_s_setprio(0); } while (0)
#define PG8_WAIT_V(n) asm volatile("s_waitcnt vmcnt(" #n ")" ::: "memory")
#define PG8_WAIT_L(n) asm volatile("s_waitcnt lgkmcnt(" #n ")" ::: "memory")
#define PG8_BAR __builtin_amdgcn_s_barrier()
#define PG8_SCHED __builtin_amdgcn_sched_barrier(0)
    Unit cur, nxt; int ui = 0;
    if (!S.next(0, cur)) return;
    f32x4 acc[2][2][4][2];
#pragma unroll
    for (int a = 0; a < 2; ++a)
#pragma unroll
        for (int b = 0; b < 2; ++b)
#pragma unroll
            for (int m = 0; m < 4; ++m)
#pragma unroll
                for (int n = 0; n < 2; ++n) acc[a][b][m][n] = (f32x4){0.f, 0.f, 0.f, 0.f};
    bf16x8 At[4][2], B0[2][2], B1[2][2];
    const char* cA = (const char*)g.A + (size_t)cur.pm * tstep; const char* cB = (const char*)g.Bt + (size_t)cur.pn * tstep;
    S.a_ready(cur);
    PG8_STAGE(PG8_SB(0, 0), cB, voffB); PG8_STAGE(PG8_SA(0, 0), cA, voffA); PG8_STAGE(PG8_SB(0, 1), cB + hstep, voffB); PG8_STAGE(PG8_SA(0, 1), cA + hstep, voffA);
    if (wr == 1) PG8_BAR;
    PG8_WAIT_V(4); PG8_BAR;
    PG8_STAGE(PG8_SB(1, 0), cB + kstep, voffB); PG8_STAGE(PG8_SA(1, 0), cA + kstep, voffA); PG8_STAGE(PG8_SB(1, 1), cB + hstep + kstep, voffB);
    PG8_WAIT_V(6); PG8_BAR;
    PG8_STAMP();
    for (;;) {
        const bool has_next = S.next(ui + 1, nxt);
        const char* nA = has_next ? (const char*)g.A + (size_t)nxt.pm * tstep : cA; const char* nB = has_next ? (const char*)g.Bt + (size_t)nxt.pn * tstep : cB;
        for (int t = 0; t < nt; t += 2) {
            const bool last = (t == nt - 2);
            const char* a1 = cA + (size_t)(t + 1) * kstep;
            const char* a2 = last ? nA : cA + (size_t)(t + 2) * kstep; const char* b2 = last ? nB : cB + (size_t)(t + 2) * kstep;
            const char* a3 = a2 + kstep; const char* b3 = b2 + kstep;
            if (last && has_next) S.a_ready(nxt);
            PG8_LDB(B0, 0, 0); PG8_SCHED; PG8_LDA(At, 0, 0); PG8_STAGE(PG8_SA(1, 1), a1 + hstep, voffA);
            PG8_WAIT_L(8); PG8_BAR; PG8_WAIT_L(0); PG8_MMA(0, 0, At, B0); PG8_BAR; PG8_SCHED;
            PG8_LDB(B1, 0, 1); PG8_STAGE(PG8_SB(0, 0), b2, voffB);
            PG8_BAR; PG8_WAIT_L(0); PG8_MMA(0, 1, At, B1); PG8_BAR;
            PG8_LDA(At, 0, 1); PG8_STAGE(PG8_SA(0, 0), a2, voffA);
            PG8_BAR; PG8_WAIT_L(0); PG8_MMA(1, 0, At, B0); PG8_BAR; PG8_SCHED;
            PG8_STAGE(PG8_SB(0, 1), b2 + hstep, voffB);
            PG8_WAIT_V(6); PG8_BAR; PG8_MMA(1, 1, At, B1); PG8_BAR;
            PG8_LDB(B0, 1, 0); PG8_SCHED; PG8_LDA(At, 1, 0); PG8_STAGE(PG8_SA(0, 1), a2 + hstep, voffA);
            PG8_WAIT_L(8); PG8_BAR; PG8_WAIT_L(0); PG8_MMA(0, 0, At, B0); PG8_BAR; PG8_SCHED;
            PG8_LDB(B1, 1, 1); PG8_STAGE(PG8_SB(1, 0), b3, voffB);
            PG8_BAR; PG8_WAIT_L(0); PG8_MMA(0, 1, At, B1); PG8_BAR;
            PG8_LDA(At, 1, 1); PG8_STAGE(PG8_SA(1, 0), a3, voffA);
            PG8_BAR; PG8_WAIT_L(0); PG8_MMA(1, 0, At, B0); PG8_BAR; PG8_SCHED;
            PG8_STAGE(PG8_SB(1, 1), b3 + hstep, voffB);
            PG8_WAIT_V(6); PG8_BAR; PG8_MMA(1, 1, At, B1); PG8_BAR;
        }
        PG8_STAMP();
        if constexpr (!Epi::AFTER_DRAIN) { E(acc, cur, wr, wc, fr, fq); S.done(cur); }
        PG8_STAMP();
        if (!has_next) break;
#pragma unroll
        for (int a = 0; a < 2; ++a)
#pragma unroll
            for (int b = 0; b < 2; ++b)
#pragma unroll
                for (int m = 0; m < 4; ++m)
#pragma unroll
                    for (int n = 0; n < 2; ++n) acc[a][b][m][n] = (f32x4){0.f, 0.f, 0.f, 0.f};
        cur = nxt; cA = nA; cB = nB; ++ui;
    }
    PG8_WAIT_V(0);
    if (wr == 0) PG8_BAR;
    PG8_BAR;
    if constexpr (Epi::AFTER_DRAIN) { E.fused(acc, cur, wr, wc, fr, fq, lds, wid, lane); S.done(cur); }
    PG8_STAMP();
    if (STAMP && wid == 0) { stamps[lane] = lane < nts ? (((unsigned long long)(unsigned)ts_hi << 32) | (unsigned)ts_lo) : 0ull;
        if (lane == 62) stamps[62] = rt_entry; if (lane == 63) stamps[63] = (unsigned long long)wall_clock64(); }
#undef PG8_STAMP
#undef PG8_SA
#undef PG8_SB
#undef PG8_STAGE
#undef PG8_LDA
#undef PG8_LDB
#undef PG8_MMA
#undef PG8_WAIT_V
#undef PG8_WAIT_L
#undef PG8_BAR
#undef PG8_SCHED
}
}

struct EpiInProj {
    static constexpr bool PERM = false, AFTER_DRAIN = false;
    bf16_t* P; const float* bias; float* LR;
    __device__ __forceinline__ void operator()(const f32x4 (&acc)[2][2][4][2], const pg8::Unit& u, int wr, int wc, int fr, int fq) const {
        const int row0 = u.pm * 256 + wr * 64 + fr, colt = u.pn * 256, col0 = colt + wc * 32 + 4 * fq;
        if (colt == C_LR) {
            if (wc == 0) {
#pragma unroll
                for (int n = 0; n < 2; ++n) {
                    const int cl = 4 * fq + n * 16;
                    const f32x4 b0 = *(const f32x4*)(bias + 4096 + cl);
#pragma unroll
                    for (int ai = 0; ai < 2; ++ai)
#pragma unroll
                        for (int m = 0; m < 4; ++m) *(f32x4*)(LR + (size_t)(row0 + ai * 128 + m * 16) * 32 + cl) = acc[ai][0][m][n] + b0;
                }
            }
            return;
        }
        const int mode = (colt < 512 || colt == C_GQ) ? 1 : (colt >= C_MQ && colt < C_Z) ? 2 : (colt >= C_Z && colt < C_SG) ? 3 : (colt >= C_SG) ? 4 : 0;
#pragma unroll
        for (int bj = 0; bj < 2; ++bj)
#pragma unroll
            for (int n = 0; n < 2; ++n) {
                const int col = col0 + bj * 128 + n * 16;
                const f32x4 b0 = *(const f32x4*)(bias + orig_col(col));
#pragma unroll
                for (int ai = 0; ai < 2; ++ai)
#pragma unroll
                    for (int m = 0; m < 4; ++m) {
                        f32x4 v0 = acc[ai][bj][m][n] + b0;
                        if (mode == 1) v0 *= 0.125f;
                        else if (mode == 2) v0 *= 0.08838834764831845f;
                        else if (mode == 3) {
#pragma unroll
                            for (int e = 0; e < 4; ++e) v0[e] = siluf_(v0[e]);
                        } else if (mode == 4) {
#pragma unroll
                            for (int e = 0; e < 4; ++e) v0[e] = sigmoidf_(v0[e]);
                        }
                        st_bf4(P + (size_t)(row0 + ai * 128 + m * 16) * PS + col, v0);
                    }
            }
    }
};
struct EpiOut {
    static constexpr bool PERM = false, AFTER_DRAIN = false;
    float* pre; const float* bo; const float* x; const float2* stats; const float* g0; const float* b0; const float* hres; size_t tok0; int l;
    __device__ __forceinline__ void operator()(const f32x4 (&acc)[2][2][4][2], const pg8::Unit& u, int wr, int wc, int fr, int fq) const {
        const int row0 = u.pm * 256 + wr * 64 + fr, col0 = u.pn * 256 + wc * 32 + 4 * fq;
#pragma unroll
        for (int ai = 0; ai < 2; ++ai)
#pragma unroll
            for (int m = 0; m < 4; ++m) {
                const int row = row0 + ai * 128 + m * 16; const size_t T = tok0 + row;
                float2 st; st.x = 0.f; st.y = 0.f; if (l == 0) st = stats[T];
#pragma unroll
                for (int bj = 0; bj < 2; ++bj)
#pragma unroll
                    for (int n = 0; n < 2; ++n) {
                        const int col = col0 + bj * 128 + n * 16;
                        f32x4 res;
                        if (l == 0) res = (*(const f32x4*)(x + T * 1024 + col) - st.x) * st.y * *(const f32x4*)(g0 + col) + *(const f32x4*)(b0 + col);
                        else res = *(const f32x4*)(hres + T * 1024 + col);
                        *(f32x4*)(pre + (size_t)row * 1024 + col) = acc[ai][bj][m][n] + *(const f32x4*)(bo + col) + DN_ALPHA * res;
                    }
            }
    }
};

__global__ void __launch_bounds__(NTHR) mega(Params p) {
    extern __shared__ __attribute__((aligned(16))) unsigned char lds[];
    cg::grid_group grid = cg::this_grid();
    const int G = gridDim.x, bid = blockIdx.x;
    bf16_t* hb = (bf16_t*)(p.ws + OFF_HB);
    bf16_t* P = (bf16_t*)(p.ws + OFF_P);
    float* LR = (float*)(p.ws + OFF_LR);
    bf16_t* merged = (bf16_t*)(p.ws + OFF_MERGED);
    float* pre = (float*)(p.ws + OFF_PRE);
    float* UT = (float*)(p.ws + OFF_UT);
    bf16_t* GT = (bf16_t*)(p.ws + OFF_GT);
    const bf16_t* WtIn = (const bf16_t*)(p.ws + OFF_WTIN);
    const bf16_t* WtBr = (const bf16_t*)(p.ws + OFF_WTBR);
    const bf16_t* WtOut = (const bf16_t*)(p.ws + OFF_WTOUT);
    const bf16_t* WtKV = (const bf16_t*)(p.ws + OFF_WTKV);
    const bf16_t* membf = (const bf16_t*)(p.ws + OFF_MEMBF);
    const float2* stats = (const float2*)(p.ws + OFF_STATS);

    phase0(p);
    grid.sync();
#if defined(STOP_AFTER)
    if (STOP_AFTER == 0) return;
#endif
    for (int l = 0; l < 2; ++l) {
        phase_weights(p, l, lds);
        __syncthreads();
#ifndef SKIP_FG
        phase_filter_gen(p, l, lds);
#endif
        grid.sync();
#if defined(STOP_AFTER)
        if (STOP_AFTER == 1 && l == STOP_L) return;
#endif
        phase_filter_fft(p, l, lds);
#ifndef SKIP_KV
        for (int t = bid; t < 64; t += G) {
            f32x4 acc[4][4];
            if (t < 32) {
                const int m0 = (t >> 2) * 256, n0 = (t & 3) * 128;
                gemm_core(acc, membf + (size_t)m0 * 1024, 1024, WtKV + (size_t)n0 * 1024, 1024, 1024, lds);
                bf16_t* Km = (bf16_t*)(p.ws + OFF_KMAT);
                EPI_LOOP(st_bf4(Km + (size_t)row * 512 + col, v);)
            } else {
                const int t2 = t - 32, m0 = (t2 >> 4) * 256, n0 = (t2 & 15) * 128;
                gemm_core(acc, WtKV + (size_t)(512 + m0) * 1024, 1024, membf + (size_t)n0 * 1024, 1024, 1024, lds);
                bf16_t* Vm = (bf16_t*)(p.ws + OFF_VT);
                EPI_LOOP(st_bf4(Vm + (size_t)row * 2048 + col, v);)
            }
        }
#endif
        grid.sync();
#if defined(STOP_AFTER)
        if (STOP_AFTER == 2 && l == STOP_L) return;
#endif
        for (int g = 0; g < NGRP; ++g) {
            const size_t tok0 = (size_t)g * TG;
#ifndef SKIP_INP
            {
                pg8::Gemm gm; gm.A = hb + tok0 * 1024; gm.Bt = WtIn; gm.M = TG; gm.N = NINP; gm.K = 1024;
                pg8::StaticOrder S; S.init(TG, NINP, G, bid);
                EpiInProj E; E.P = P; E.bias = p.b_in + (size_t)l * NIN; E.LR = LR;
                pg8::gemm_phase<EpiInProj, pg8::StaticOrder, false>((PG8_LAS unsigned char*)lds, gm, S, E, nullptr);
                __syncthreads();
            }
#endif
            grid.sync();
#if defined(STOP_AFTER)
            if (STOP_AFTER == 3 && l == STOP_L) return;
#endif
#ifndef SKIP_NA
            for (int it = bid; it < BG * 64 * 8; it += G) na_item(p, l, P, it >> 9, (it >> 3) & 63, it & 7, lds);
#endif
#ifndef SKIP_HY
            for (int it = bid; it < BG * 128 * 8; it += G) hy_pre_item(p, l, P, UT, GT, it >> 10, (it >> 3) & 127, it & 7, lds);
#endif
#ifndef SKIP_G1
            for (int it = bid; it < NITEM; it += G) gla_part1_item(p, l, P, LR, it, lds);
#endif
            {
                const int nit = BG * 4 * 64, per = (nit + G - 1) / G;
                int last = -1;
                for (int it = bid * per; it < min(nit, (bid + 1) * per); ++it) {
                    const int bh = it >> 6, bl = bh >> 2, h = bh & 3;
                    if (bh != last) { __syncthreads(); memattn_load(p, g * BG + bl, h, lds); last = bh; }
#ifndef SKIP_MA
                    memattn_item(P, bl, h, it & 63, lds);
#endif
                }
                __syncthreads();
            }
            grid.sync();
#if defined(STOP_AFTER)
            if (STOP_AFTER == 4 && l == STOP_L) return;
#endif
#ifndef SKIP_HY
            for (int it = bid; it < BG * 256; it += G) hyena_conv_item(p, UT, GT, it >> 8, it & 255, lds);
#endif
            gla_scan(p);
            grid.sync();
#if defined(STOP_AFTER)
            if (STOP_AFTER == 5 && l == STOP_L) return;
#endif
#ifndef SKIP_G2
            for (int it = bid; it < NITEM; it += G) gla_part2_item(p, l, P, LR, it, lds);
#endif
#ifndef SKIP_HY
            for (int it = bid; it < BG * 128 * 8; it += G) hy_post_item(P, GT, it >> 10, (it >> 3) & 127, it & 7, lds);
#endif
            grid.sync();
#if defined(STOP_AFTER)
            if (STOP_AFTER == 6 && l == STOP_L) return;
#endif
#ifndef SKIP_MG
            for (int t = bid; t < 512; t += G) {
                const int m0 = (t >> 3) * 256, n0 = (t & 7) * 128;
                f32x4 macc[4][4];
#pragma unroll
                for (int mi = 0; mi < 4; ++mi)
#pragma unroll
                    for (int ni = 0; ni < 4; ++ni) macc[mi][ni] = (f32x4){0.f, 0.f, 0.f, 0.f};
#pragma unroll 1
                for (int j = 0; j < 4; ++j) {
                    const int acol = (j == 0) ? C_NAQ : (j == 1) ? C_HY : (j == 2) ? C_GV : C_MQ;
                    f32x4 acc[4][4];
                    gemm_core(acc, P + (size_t)m0 * PS + acol, PS, WtBr + (size_t)j * 1024 * 512 + (size_t)n0 * 512, 512, 512, lds);
                    EPI_LOOP(macc[mi][ni] += ld_bf4(P + (size_t)row * PS + C_SG + 1024 * j + col) * v;)
                }
                {
                    f32x4 (&acc)[4][4] = macc;
                    EPI_LOOP(st_bf4(merged + (size_t)row * 1024 + col, v);)
                }
            }
#endif
            grid.sync();
#if defined(STOP_AFTER)
            if (STOP_AFTER == 7 && l == STOP_L) return;
#endif
#ifndef SKIP_OUT
            {
                pg8::Gemm gm; gm.A = merged; gm.Bt = WtOut; gm.M = TG; gm.N = 1024; gm.K = 1024;
                pg8::StaticOrder S; S.init(TG, 1024, G, bid);
                EpiOut E; E.pre = pre; E.bo = p.b_out + l * 1024; E.x = p.x; E.stats = stats; E.g0 = p.ln_in_g; E.b0 = p.ln_in_b; E.hres = p.out; E.tok0 = tok0; E.l = l;
                pg8::gemm_phase<EpiOut, pg8::StaticOrder, false>((PG8_LAS unsigned char*)lds, gm, S, E, nullptr);
                __syncthreads();
            }
#endif
            grid.sync();
#if defined(STOP_AFTER)
            if (STOP_AFTER == 8 && l == STOP_L) return;
#endif
            ln_rows(pre, 0, TG, p.ln_g + l * 1024, p.ln_b + l * 1024, p.out, hb, tok0, nullptr);
#if defined(STOP_AFTER)
            if (STOP_AFTER == 9) { grid.sync(); return; }
            if (STOP_AFTER == 10 && g == 1) { grid.sync(); return; }
            if (STOP_AFTER == 11 && g == 3) { grid.sync(); return; }
#endif
        }
        grid.sync();
    }
}

extern "C" void kernel_launch(void* const* d_in, const int* in_sizes, int n_in, void* d_out, int out_size, void* d_ws, size_t ws_size, hipStream_t stream) {
    static int grid_blocks = 0;
    if (!grid_blocks) {
        if (ws_size < WS_END) { fprintf(stderr, "kernel_launch: workspace too small: %zu < %zu\n", ws_size, (size_t)WS_END); grid_blocks = -1; return; }
        {
            const long long ex[26] = {67108864LL, 2097152LL, 1024, 1024, 2LL * 1024 * 10784, 2 * 10784, 2 * 8 * 15 * 31, 2 * 3 * 1536, 2 * 1536, 2 * 33 * 64, 2 * 64, 2 * 2 * 64 * 64, 2 * 2 * 64,
                                      2 * 64 * 1024, 2 * 512, 2 * 16 * 256, 2 * 256, 2 * 16 * 256, 2 * 256, 2 * 512, 2LL * 1024 * 1024, 2LL * 4 * 512 * 1024, 2LL * 1024 * 1024, 2 * 1024, 2 * 1024, 2 * 1024};
            bool bad = (n_in != 26) || (out_size != 67108864);
            for (int i = 0; i < 26 && !bad; ++i) if ((long long)in_sizes[i] != ex[i]) { fprintf(stderr, "kernel_launch: input %d has %d elements, expected %lld\n", i, in_sizes[i], ex[i]); bad = true; }
            if (bad) { fprintf(stderr, "kernel_launch: unexpected shapes; nothing launched\n"); grid_blocks = -1; return; }
        }
        int dev = 0, cus = 0, per_cu = 0;
        hipGetDevice(&dev);
        hipDeviceGetAttribute(&cus, hipDeviceAttributeMultiprocessorCount, dev);
        if (hipFuncSetAttribute((const void*)mega, hipFuncAttributeMaxDynamicSharedMemorySize, LDS_BYTES) != hipSuccess) fprintf(stderr, "kernel_launch: hipFuncSetAttribute failed\n");
        if (hipOccupancyMaxActiveBlocksPerMultiprocessor(&per_cu, (const void*)mega, NTHR, LDS_BYTES) != hipSuccess || per_cu < 1) { fprintf(stderr, "kernel_launch: occupancy query gave %d\n", per_cu); per_cu = 1; }
        (void)hipGetLastError();
        if (per_cu > 1) per_cu = 1;
        grid_blocks = cus * per_cu;
    }
    if (grid_blocks < 0) return;
    Params p{};
    const float** pp = (const float**)&p;
    for (int i = 0; i < 26; ++i) pp[i] = (const float*)d_in[i];
    p.out = (float*)d_out; p.ws = (unsigned char*)d_ws;
    void* args[] = {&p};
    hipError_t e = hipLaunchCooperativeKernel((const void*)mega, dim3(grid_blocks), dim3(NTHR), args, LDS_BYTES, stream);
    if (e != hipSuccess) fprintf(stderr, "cooperative launch failed: %s (grid %d)\n", hipGetErrorString(e), grid_blocks);
}
#endif
```

```cpp
#ifndef PROBE_REP_MIX
#define PROBE_REP_MIX 1
#endif
#ifndef PROBE_REP_INPROJ
#define PROBE_REP_INPROJ 1
#endif
#include <hip/hip_runtime.h>
#include <hip/hip_cooperative_groups.h>
#include <cstdio>
#include <unistd.h>
#include <cmath>
namespace cg = cooperative_groups;

#define HD __host__ __device__
typedef unsigned short bf16_t;
typedef short bf16x8 __attribute__((ext_vector_type(8)));
typedef float f32x4 __attribute__((ext_vector_type(4)));
typedef unsigned u32x2 __attribute__((ext_vector_type(2)));
typedef unsigned u32x4 __attribute__((ext_vector_type(4)));

constexpr int NTOK = 65536, DM = 1024, SEQ = 8192, NB = 8;
constexpr int BG = 2;
constexpr int NGRP = NB / BG;
constexpr int TG = BG * SEQ;
constexpr int PS = 10752;
constexpr int NIN = 10784, NINP = 11008;
constexpr int C_NAQ = 0, C_NAK = 512, C_NAV = 1024, C_HY = 1536, C_GQ = 3072, C_GK = 3328, C_GV = 3584, C_MQ = 4096, C_Z = 4608, C_SG = 6656, C_LR = 10752;
constexpr int FN = 16384;
constexpr int NITEM = BG * 128 * 4;
constexpr int LDS_BYTES = 160 * 1024;
constexpr int NTHR = 512;
constexpr float DN_ALPHA = 1.41421356237309515f;

constexpr size_t al256(size_t x) { return (x + 255) & ~(size_t)255; }
constexpr size_t OFF_HB = 0;
constexpr size_t OFF_STATS = OFF_HB + (size_t)NTOK * DM * 2;
constexpr size_t OFF_TW = OFF_STATS + (size_t)NTOK * 8;
constexpr size_t OFF_MEMBF = OFF_TW + (size_t)FN * 8;
constexpr size_t OFF_ENERGY = OFF_MEMBF + (size_t)2048 * 1024 * 2;
constexpr size_t OFF_WTIN = OFF_ENERGY + 4096;
constexpr size_t OFF_WTBR = OFF_WTIN + (size_t)NINP * 1024 * 2;
constexpr size_t OFF_WTOUT = OFF_WTBR + (size_t)4 * 1024 * 512 * 2;
constexpr size_t OFF_WTKV = OFF_WTOUT + (size_t)1024 * 1024 * 2;
constexpr size_t OFF_KMAT = OFF_WTKV + (size_t)2048 * 1024 * 2;
constexpr size_t OFF_VT = OFF_KMAT + (size_t)2048 * 1024 * 2;
constexpr size_t OFF_HFILT = OFF_VT + (size_t)2048 * 1024 * 2;
constexpr size_t OFF_PQ = OFF_HFILT + (size_t)1024 * 8192 * 4;
constexpr size_t OFF_P = OFF_PQ + (size_t)256 * FN * 16;
constexpr size_t OFF_LR = OFF_P + (size_t)TG * PS * 2;
constexpr size_t OFF_GS = OFF_LR + (size_t)TG * 32 * 4;
constexpr size_t OFF_GDEC = OFF_GS + (size_t)2 * NITEM * 8192 * 4;
constexpr size_t OFF_MERGED = OFF_GDEC + (size_t)2 * NITEM * 64 * 4;
constexpr size_t OFF_PRE = OFF_MERGED + (size_t)TG * 1024 * 2;
constexpr size_t OFF_UT = OFF_PRE + (size_t)TG * 1024 * 4;
constexpr size_t OFF_GT = OFF_UT + (size_t)BG * 512 * 8192 * 4;
constexpr size_t OFF_BAR = OFF_GT + (size_t)BG * 512 * 8192 * 2;
constexpr size_t OFF_ZT = OFF_BAR + 256;
constexpr size_t WS_END = OFF_ZT + (size_t)8192 * 33 * 4;

struct Params {
    const float *x, *mem, *ln_in_g, *ln_in_b, *w_in, *b_in, *na_rpb, *hy_conv_w, *hy_conv_b, *hy_w1, *hy_b1, *hy_wm, *hy_bm, *hy_w3, *hy_skip,
        *gla_up_f, *gla_bias_f, *gla_up_b, *gla_bias_b, *gla_norm_g, *mem_w_kv, *w_br, *w_out, *b_out, *ln_g, *ln_b;
    float* out;
    unsigned char* ws;
};

HD inline float bf2f(bf16_t b) {
    union { unsigned u; float f; } c; c.u = (unsigned)b << 16; return c.f;
}
HD inline bf16_t f2bf(float f) {
    union { unsigned u; float f; } c; c.f = f; unsigned u = c.u; u += 0x7fffu + ((u >> 16) & 1u); return (bf16_t)(u >> 16);
}
__device__ __forceinline__ unsigned pk2(float lo, float hi) { return (unsigned)f2bf(lo) | ((unsigned)f2bf(hi) << 16); }
__device__ __forceinline__ float lo16(unsigned u) { return __uint_as_float(u << 16); }
__device__ __forceinline__ float hi16(unsigned u) { return __uint_as_float(u & 0xffff0000u); }
__device__ __forceinline__ float wave_sum(float v) {
#pragma unroll
    for (int o = 32; o >= 1; o >>= 1) v += __shfl_xor(v, o);
    return v;
}
__device__ __forceinline__ float sigmoidf_(float x) { return 1.0f / (1.0f + __expf(-x)); }
__device__ __forceinline__ float siluf_(float x) { return x / (1.0f + __expf(-x)); }
__device__ __forceinline__ float logsigf_(float x) { return fminf(x, 0.0f) - log1pf(expf(-fabsf(x))); }
__device__ __forceinline__ bf16x8 mkfrag(u32x4 v) { return __builtin_bit_cast(bf16x8, v); }
__device__ __forceinline__ bf16x8 mkfrag2(u32x2 a, u32x2 b) { u32x4 v = {a.x, a.y, b.x, b.y}; return __builtin_bit_cast(bf16x8, v); }
#define MFMA(a, b, c) __builtin_amdgcn_mfma_f32_16x16x32_bf16((a), (b), (c), 0, 0, 0)
HD inline int iclamp(int v, int lo, int hi) { return v < lo ? lo : (v > hi ? hi : v); }

HD inline float2 cmulf(float2 a, float2 b) { float2 r; r.x = a.x * b.x - a.y * b.y; r.y = a.x * b.y + a.y * b.x; return r; }
HD inline float2 cmulcf(float2 a, float2 b) { float2 r; r.x = a.x * b.x + a.y * b.y; r.y = a.y * b.x - a.x * b.y; return r; }
struct Bfly { float2 x0, x1, x2, x3, W1; int i0; };
HD inline void bfly_load(Bfly& b, const float2* d, const float2* tw, int lgm, int q) {
    const int m = 1 << lgm, blk = q >> lgm, j = q & (m - 1);
    b.i0 = (blk << (lgm + 2)) + j;
    b.W1 = tw[j];
    b.x0 = d[b.i0]; b.x1 = d[b.i0 + m]; b.x2 = d[b.i0 + 2 * m]; b.x3 = d[b.i0 + 3 * m];
}
HD inline void bfly_fwd_store(const Bfly& b, float2* d, int lgm) {
    const int m = 1 << lgm, i0 = b.i0;
    const float2 W1 = b.W1, W2 = cmulf(W1, W1);
    const float2 x0 = b.x0, x1 = b.x1, x2 = b.x2, x3 = b.x3;
    float2 a0, a1, a2, a3, t;
    a0.x = x0.x + x2.x; a0.y = x0.y + x2.y;
    t.x = x0.x - x2.x; t.y = x0.y - x2.y; a2 = cmulf(t, W1);
    a1.x = x1.x + x3.x; a1.y = x1.y + x3.y;
    t.x = x1.x - x3.x; t.y = x1.y - x3.y; t = cmulf(t, W1); a3.x = t.y; a3.y = -t.x;
    float2 r;
    r.x = a0.x + a1.x; r.y = a0.y + a1.y; d[i0] = r;
    t.x = a0.x - a1.x; t.y = a0.y - a1.y; d[i0 + m] = cmulf(t, W2);
    r.x = a2.x + a3.x; r.y = a2.y + a3.y; d[i0 + 2 * m] = r;
    t.x = a2.x - a3.x; t.y = a2.y - a3.y; d[i0 + 3 * m] = cmulf(t, W2);
}
HD inline void bfly_inv_store(const Bfly& b, float2* d, int lgm) {
    const int m = 1 << lgm, i0 = b.i0;
    const float2 W1 = b.W1, W2 = cmulf(W1, W1);
    const float2 x0 = b.x0, x1 = b.x1, x2 = b.x2, x3 = b.x3;
    const float2 b1 = cmulcf(x1, W2), b3 = cmulcf(x3, W2);
    float2 y0, y1, y2, y3;
    y0.x = x0.x + b1.x; y0.y = x0.y + b1.y; y1.x = x0.x - b1.x; y1.y = x0.y - b1.y;
    y2.x = x2.x + b3.x; y2.y = x2.y + b3.y; y3.x = x2.x - b3.x; y3.y = x2.y - b3.y;
    const float2 c2 = cmulcf(y2, W1); float2 c3 = cmulcf(y3, W1); { const float tx = -c3.y, ty = c3.x; c3.x = tx; c3.y = ty; }
    float2 r;
    r.x = y0.x + c2.x; r.y = y0.y + c2.y; d[i0] = r;
    r.x = y0.x - c2.x; r.y = y0.y - c2.y; d[i0 + 2 * m] = r;
    r.x = y1.x + c3.x; r.y = y1.y + c3.y; d[i0 + m] = r;
    r.x = y1.x - c3.x; r.y = y1.y - c3.y; d[i0 + 3 * m] = r;
}
HD inline void fft_fwd_bfly(float2* d, const float2* tw, int lgm, int q) { Bfly b; bfly_load(b, d, tw, lgm, q); bfly_fwd_store(b, d, lgm); }
HD inline void fft_inv_bfly(float2* d, const float2* tw, int lgm, int q) { Bfly b; bfly_load(b, d, tw, lgm, q); bfly_inv_store(b, d, lgm); }
HD inline int brev14(int k) {
    unsigned v = (unsigned)k;
    v = ((v >> 1) & 0x55555555u) | ((v & 0x55555555u) << 1);
    v = ((v >> 2) & 0x33333333u) | ((v & 0x33333333u) << 2);
    v = ((v >> 4) & 0x0f0f0f0fu) | ((v & 0x0f0f0f0fu) << 4);
    v = ((v >> 8) & 0x00ff00ffu) | ((v & 0x00ff00ffu) << 8);
    v = (v >> 16) | (v << 16);
    return (int)(v >> 18);
}
struct PwIn { float2 Z1, Z2; float4 A, B; int p1, p2; };
HD inline void pw_load(PwIn& w, const float2* d, const float4* pq, int kf) {
    const int k2 = (FN - kf) & (FN - 1); w.p1 = brev14(kf); w.p2 = brev14(k2);
    w.Z1 = d[w.p1]; w.Z2 = d[w.p2]; w.A = pq[w.p1]; w.B = pq[w.p2];
}
HD inline void pw_store(const PwIn& w, float2* d) {
    const float2 Z1 = w.Z1, Z2 = w.Z2;
    float2 P1, Q1, P2, Q2; P1.x = w.A.x; P1.y = w.A.y; Q1.x = w.A.z; Q1.y = w.A.w; P2.x = w.B.x; P2.y = w.B.y; Q2.x = w.B.z; Q2.y = w.B.w;
    float2 c1, c2; c1.x = Z1.x; c1.y = -Z1.y; c2.x = Z2.x; c2.y = -Z2.y;
    const float2 a = cmulf(Z1, P1), b = cmulf(c2, Q1), c = cmulf(Z2, P2), e = cmulf(c1, Q2);
    float2 w1, w2; w1.x = a.x + b.x; w1.y = a.y + b.y; w2.x = c.x + e.x; w2.y = c.y + e.y;
    d[w.p1] = w1;
    if (w.p2 != w.p1) d[w.p2] = w2;
}
HD inline void conv_pointwise(float2* d, const float4* pq, int kf) { PwIn w; pw_load(w, d, pq, kf); pw_store(w, d); }
HD inline void filt_pointwise(const float2* d, float4* pq, int kf) {
    const int k2 = (FN - kf) & (FN - 1), p1 = brev14(kf), p2 = brev14(k2);
    const float2 Z1 = d[p1], Z2 = d[p2];
    const float gcx = 0.5f * (Z1.x + Z2.x), gcy = 0.5f * (Z1.y - Z2.y);
    const float gdx = 0.5f * (Z1.y + Z2.y), gdy = -0.5f * (Z1.x - Z2.x);
    const float s = 0.5f / (float)FN;
    float4 A; A.x = s * (gcx + gdx); A.y = s * (gcy + gdy); A.z = s * (gcx - gdx); A.w = s * (gcy - gdy);
    pq[p1] = A;
    float4 B; B.x = A.x; B.y = -A.y; B.z = A.z; B.w = -A.w;
    if (p2 != p1) pq[p2] = B;
}

HD inline int tw_off(int lgm) { return lgm == 10 ? 0 : lgm == 8 ? 1024 : lgm == 6 ? 1280 : lgm == 4 ? 1344 : lgm == 2 ? 1360 : 1364; }
#ifndef FFT_HOST_TEST
__device__ void fft_forward(float2* d, const float2* twl, const float2* twg) {
    int tid = threadIdx.x; asm volatile("" : "+v"(tid));
    for (int lgm = 12; lgm >= 0; lgm -= 2) {
        const float2* tw = (lgm == 12) ? twg : twl + tw_off(lgm);
#pragma unroll 1
        for (int q = tid; q < FN / 4; q += 4 * NTHR) {
            Bfly b0, b1, b2, b3;
            bfly_load(b0, d, tw, lgm, q); bfly_load(b1, d, tw, lgm, q + NTHR); bfly_load(b2, d, tw, lgm, q + 2 * NTHR); bfly_load(b3, d, tw, lgm, q + 3 * NTHR);
            bfly_fwd_store(b0, d, lgm); bfly_fwd_store(b1, d, lgm); bfly_fwd_store(b2, d, lgm); bfly_fwd_store(b3, d, lgm);
        }
        __syncthreads();
    }
}
__device__ void fft_inverse(float2* d, const float2* twl, const float2* twg) {
    int tid = threadIdx.x; asm volatile("" : "+v"(tid));
    for (int lgm = 0; lgm <= 12; lgm += 2) {
        const float2* tw = (lgm == 12) ? twg : twl + tw_off(lgm);
#pragma unroll 1
        for (int q = tid; q < FN / 4; q += 4 * NTHR) {
            Bfly b0, b1, b2, b3;
            bfly_load(b0, d, tw, lgm, q); bfly_load(b1, d, tw, lgm, q + NTHR); bfly_load(b2, d, tw, lgm, q + 2 * NTHR); bfly_load(b3, d, tw, lgm, q + 3 * NTHR);
            bfly_inv_store(b0, d, lgm); bfly_inv_store(b1, d, lgm); bfly_inv_store(b2, d, lgm); bfly_inv_store(b3, d, lgm);
        }
        __syncthreads();
    }
}
__device__ float2* fft_lds_twiddles(const float2* twg, unsigned char* lds) {
    int tid = threadIdx.x; asm volatile("" : "+v"(tid));
    float2* t = (float2*)(lds + 131072);
    for (int k = tid; k < 1365; k += NTHR) {
        const int lgm = k < 1024 ? 10 : k < 1280 ? 8 : k < 1344 ? 6 : k < 1360 ? 4 : k < 1364 ? 2 : 0;
        t[k] = twg[(k - tw_off(lgm)) << (12 - lgm)];
    }
    __syncthreads();
    return t;
}

constexpr int STG = 49152;
__device__ __forceinline__ int swz(int row, int ch) { return row * 128 + ((ch ^ ((row >> 1) & 7)) << 4); }
__device__ __forceinline__ void gemm_core(f32x4 (&acc)[4][4], const bf16_t* A, int lda, const bf16_t* Bt, int ldb, int K, unsigned char* lds) {
    int tid_ = threadIdx.x; asm volatile("" : "+v"(tid_)); const int tid = tid_, lane = tid & 63, w = tid >> 6, wm = w & 3, wn = w >> 2, l15 = lane & 15, q4 = lane >> 4;
    const int crow = tid >> 3, cch = tid & 7;
    u32x4 ra[4], rb[2];
#pragma unroll
    for (int mi = 0; mi < 4; ++mi)
#pragma unroll
        for (int ni = 0; ni < 4; ++ni) acc[mi][ni] = (f32x4){0.f, 0.f, 0.f, 0.f};
    const bf16_t* ap = A + (size_t)crow * lda + cch * 8;
    const bf16_t* bp = Bt + (size_t)crow * ldb + cch * 8;
#pragma unroll
    for (int i = 0; i < 4; ++i) ra[i] = *(const u32x4*)(ap + (size_t)(64 * i) * lda);
#pragma unroll
    for (int i = 0; i < 2; ++i) rb[i] = *(const u32x4*)(bp + (size_t)(64 * i) * ldb);
#pragma unroll
    for (int i = 0; i < 4; ++i) *(u32x4*)(lds + swz(crow + 64 * i, cch)) = ra[i];
#pragma unroll
    for (int i = 0; i < 2; ++i) *(u32x4*)(lds + 32768 + swz(crow + 64 * i, cch)) = rb[i];
    __syncthreads();
    const int nk = K >> 6;
    for (int kt = 0; kt < nk; ++kt) {
        if (kt + 1 < nk) {
            const int k0 = (kt + 1) << 6;
#pragma unroll
            for (int i = 0; i < 4; ++i) ra[i] = *(const u32x4*)(ap + (size_t)(64 * i) * lda + k0);
#pragma unroll
            for (int i = 0; i < 2; ++i) rb[i] = *(const u32x4*)(bp + (size_t)(64 * i) * ldb + k0);
        }
        const unsigned char* sa = lds + (kt & 1) * STG;
        const unsigned char* sb = sa + 32768;
#pragma unroll
        for (int ks = 0; ks < 2; ++ks) {
            bf16x8 af[4], bfr[4];
#pragma unroll
            for (int mi = 0; mi < 4; ++mi) af[mi] = *(const bf16x8*)(sa + swz(wm * 64 + mi * 16 + l15, ks * 4 + q4));
#pragma unroll
            for (int ni = 0; ni < 4; ++ni) bfr[ni] = *(const bf16x8*)(sb + swz(wn * 64 + ni * 16 + l15, ks * 4 + q4));
#pragma unroll
            for (int mi = 0; mi < 4; ++mi)
#pragma unroll
                for (int ni = 0; ni < 4; ++ni) acc[mi][ni] = MFMA(bfr[ni], af[mi], acc[mi][ni]);
        }
        if (kt + 1 < nk) {
            unsigned char* da = lds + ((kt + 1) & 1) * STG;
#pragma unroll
            for (int i = 0; i < 4; ++i) *(u32x4*)(da + swz(crow + 64 * i, cch)) = ra[i];
#pragma unroll
            for (int i = 0; i < 2; ++i) *(u32x4*)(da + 32768 + swz(crow + 64 * i, cch)) = rb[i];
        }
        __syncthreads();
    }
}
#define EPI_LOOP(body)                                                                                                  \
    {                                                                                                                   \
        int e_t = threadIdx.x; asm volatile("" : "+v"(e_t)); const int e_lane = e_t & 63, e_w = e_t >> 6;                                                    \
        _Pragma("unroll") for (int mi = 0; mi < 4; ++mi) _Pragma("unroll") for (int ni = 0; ni < 4; ++ni) {             \
            const int row = m0 + (e_w & 3) * 64 + mi * 16 + (e_lane & 15);                                              \
            const int col = n0 + (e_w >> 2) * 64 + ni * 16 + 4 * (e_lane >> 4);                                         \
            f32x4& v = acc[mi][ni];                                                                                     \
            body                                                                                                        \
        }                                                                                                               \
    }
__device__ __forceinline__ void st_bf4(bf16_t* dst, f32x4 v) {
    u32x2 o; o.x = pk2(v[0], v[1]); o.y = pk2(v[2], v[3]); *(u32x2*)dst = o;
}
__device__ __forceinline__ f32x4 ld_bf4(const bf16_t* src) {
    const u32x2 u = *(const u32x2*)src; f32x4 r = {lo16(u.x), hi16(u.x), lo16(u.y), hi16(u.y)}; return r;
}

__device__ __forceinline__ int orig_col(int n) {
    if (n < 4096) return n;
    if (n < 4608) return n + 32;
    if (n < 6656) return n + 32;
    if (n < 10752) return n + 32;
    return n - 10752 + 4096;
}

__device__ void ln_rows(const float* src, size_t src_row0, int nrows, const float* g, const float* b, float* dst32, bf16_t* dst16, size_t dst_row0, float2* stats) {
    int tid_ = threadIdx.x; asm volatile("" : "+v"(tid_));
    const int lane = tid_ & 63;
    const int gw = blockIdx.x * (NTHR / 64) + (tid_ >> 6), nw = gridDim.x * (NTHR / 64);
    for (int r = gw; r < nrows; r += nw) {
        const float4* xr = (const float4*)(src + (src_row0 + r) * 1024);
        float4 v[4]; float s = 0.f;
#pragma unroll
        for (int i = 0; i < 4; ++i) { v[i] = xr[lane + 64 * i]; s += (v[i].x + v[i].y) + (v[i].z + v[i].w); }
        s = wave_sum(s);
        const float mean = s * (1.0f / 1024.0f);
        float q = 0.f;
#pragma unroll
        for (int i = 0; i < 4; ++i) { const float a = v[i].x - mean, bb = v[i].y - mean, c = v[i].z - mean, d = v[i].w - mean; q += (a * a + bb * bb) + (c * c + d * d); }
        q = wave_sum(q);
        const float rstd = 1.0f / sqrtf(q * (1.0f / 1024.0f) + 1e-5f);
        if (stats && lane == 0) { float2 st; st.x = mean; st.y = rstd; stats[dst_row0 + r] = st; }
#pragma unroll
        for (int i = 0; i < 4; ++i) {
            const float4 g4 = ((const float4*)g)[lane + 64 * i], b4 = ((const float4*)b)[lane + 64 * i];
            float4 y; y.x = (v[i].x - mean) * rstd * g4.x + b4.x; y.y = (v[i].y - mean) * rstd * g4.y + b4.y; y.z = (v[i].z - mean) * rstd * g4.z + b4.z; y.w = (v[i].w - mean) * rstd * g4.w + b4.w;
            if (dst32) ((float4*)(dst32 + (dst_row0 + r) * 1024))[lane + 64 * i] = y;
            if (dst16) { u32x2 o; o.x = pk2(y.x, y.y); o.y = pk2(y.z, y.w); *(u32x2*)(dst16 + (dst_row0 + r) * 1024 + (lane + 64 * i) * 4) = o; }
        }
    }
}
__device__ void phase0(const Params& p) {
    ln_rows(p.x, 0, NTOK, p.ln_in_g, p.ln_in_b, nullptr, (bf16_t*)(p.ws + OFF_HB), 0, (float2*)(p.ws + OFF_STATS));
    int tid_ = threadIdx.x; asm volatile("" : "+v"(tid_)); const int gt = blockIdx.x * NTHR + tid_, nt = gridDim.x * NTHR;
    float2* tw = (float2*)(p.ws + OFF_TW);
    for (int k = gt; k < FN; k += nt) { double s, c; sincospi(-2.0 * (double)k / (double)FN, &s, &c); float2 t; t.x = (float)c; t.y = (float)s; tw[k] = t; }
    bf16_t* mb = (bf16_t*)(p.ws + OFF_MEMBF);
    for (int i = gt; i < 2048 * 1024 / 4; i += nt) { const float4 v = ((const float4*)p.mem)[i]; u32x2 o; o.x = pk2(v.x, v.y); o.y = pk2(v.z, v.w); ((u32x2*)mb)[i] = o; }
    float* en = (float*)(p.ws + OFF_ENERGY);
    for (int i = gt; i < 1024; i += nt) en[i] = 0.f;
    float* ztab = (float*)(p.ws + OFF_ZT);
    for (int idx = gt; idx < 8192 * 33; idx += nt) {
        const int n = idx / 33, e = idx - n * 33;
        float v;
        if (e == 0) v = (float)n / 8191.0f;
        else {
            const int i = (e - 1) & 15;
            const double fr = 1e-4 + (double)i * ((15.0 - 1e-4) / 15.0);
            const double ang = (2.0 * 3.14159265358979323846 / 8192.0) * (double)n * fr;
            v = (e <= 16) ? (float)cos(ang) : (float)(-sin(ang));
        }
        ztab[idx] = v;
    }
}

__device__ void wt_tile(const float* src, int src_ld, int k0, int on0, bf16_t* dst, int dst_ld, int dn0, bool zero, float* tile) {
    int tid_ = threadIdx.x; asm volatile("" : "+v"(tid_)); const int tid = tid_;
    if (!zero) {
#pragma unroll
        for (int i = 0; i < 2; ++i) {
            const int k = (tid >> 3) + 64 * i, c4 = (tid & 7) * 4;
            const float4 v = *(const float4*)(src + (size_t)(k0 + k) * src_ld + on0 + c4);
            float* t = tile + k * 33 + c4; t[0] = v.x; t[1] = v.y; t[2] = v.z; t[3] = v.w;
        }
    }
    __syncthreads();
    const int n = tid >> 4, kc = (tid & 15) * 8;
    float f[8];
#pragma unroll
    for (int e = 0; e < 8; ++e) f[e] = zero ? 0.f : tile[(kc + e) * 33 + n];
    u32x4 o; o.x = pk2(f[0], f[1]); o.y = pk2(f[2], f[3]); o.z = pk2(f[4], f[5]); o.w = pk2(f[6], f[7]);
    *(u32x4*)(dst + (size_t)(dn0 + n) * dst_ld + k0 + kc) = o;
    __syncthreads();
}
__device__ void phase_weights(const Params& p, int l, unsigned char* lds) {
    float* tile = (float*)lds;
    for (int it = blockIdx.x; it < 3776; it += gridDim.x) {
        if (it < 2752) {
            const int nt = it >> 3, kt = it & 7, dn0 = nt * 32;
            wt_tile(p.w_in + (size_t)l * 1024 * NIN, NIN, kt * 128, orig_col(dn0), (bf16_t*)(p.ws + OFF_WTIN), 1024, dn0, dn0 >= NIN, tile);
        } else if (it < 3264) {
            const int r = it - 2752, j = r >> 7, nt = (r >> 2) & 31, kt = r & 3;
            wt_tile(p.w_br + (size_t)(l * 4 + j) * 512 * 1024, 1024, kt * 128, nt * 32, (bf16_t*)(p.ws + OFF_WTBR) + (size_t)j * 1024 * 512, 512, nt * 32, false, tile);
        } else if (it < 3520) {
            const int r = it - 3264, nt = r >> 3, kt = r & 7;
            wt_tile(p.w_out + (size_t)l * 1024 * 1024, 1024, kt * 128, nt * 32, (bf16_t*)(p.ws + OFF_WTOUT), 1024, nt * 32, false, tile);
        } else {
            const int r = it - 3520, nt = r >> 3, kt = r & 7;
            wt_tile(p.mem_w_kv + (size_t)l * 1024 * 1024, 1024, kt * 128, nt * 32, (bf16_t*)(p.ws + OFF_WTKV), 1024, nt * 32, false, tile);
        }
    }
}

__device__ void phase_filter_gen(const Params& p, int l, unsigned char* lds) {
    float* zt = (float*)lds;
    float* ha = zt + 32 * 33;
    float* hbuf = ha + 32 * 64;
    int tid_ = threadIdx.x; asm volatile("" : "+v"(tid_)); const int tid = tid_;
    const float* w1 = p.hy_w1 + (size_t)l * 33 * 64; const float* b1 = p.hy_b1 + l * 64;
    const float* wm = p.hy_wm + (size_t)l * 2 * 64 * 64; const float* bm = p.hy_bm + l * 2 * 64;
    const float* w3 = p.hy_w3 + (size_t)l * 64 * 1024;
    float* hf = (float*)(p.ws + OFF_HFILT);
    float* en = (float*)(p.ws + OFF_ENERGY) + l * 512;
    const float* ztab = (const float*)(p.ws + OFF_ZT);
    for (int it = blockIdx.x; it < 256; it += gridDim.x) {
        const int n0 = it * 32;
        for (int idx = tid; idx < 32 * 33; idx += NTHR) zt[idx] = ztab[(size_t)n0 * 33 + idx];
        __syncthreads();
        for (int idx = tid; idx < 2048; idx += NTHR) {
            const int pos = idx >> 6, j = idx & 63; float s = b1[j];
            for (int e = 0; e < 33; ++e) s += zt[pos * 33 + e] * w1[e * 64 + j];
            ha[idx] = sinf(s);
        }
        __syncthreads();
        for (int idx = tid; idx < 2048; idx += NTHR) {
            const int pos = idx >> 6, j = idx & 63; float s = bm[j];
            for (int e = 0; e < 64; ++e) s += ha[pos * 64 + e] * wm[e * 64 + j];
            hbuf[idx] = sinf(s);
        }
        __syncthreads();
        for (int idx = tid; idx < 2048; idx += NTHR) {
            const int pos = idx >> 6, j = idx & 63; float s = bm[64 + j];
            for (int e = 0; e < 64; ++e) s += hbuf[pos * 64 + e] * wm[4096 + e * 64 + j];
            ha[idx] = sinf(s);
        }
        __syncthreads();
        {
            const int c = tid;
            float af[32], ab[32];
#pragma unroll
            for (int i = 0; i < 32; ++i) { af[i] = 0.f; ab[i] = 0.f; }
            for (int k = 0; k < 64; ++k) {
                const float wf = w3[k * 1024 + c], wb = w3[k * 1024 + 512 + c];
#pragma unroll
                for (int i = 0; i < 32; ++i) { const float h = ha[i * 64 + k]; af[i] += h * wf; ab[i] += h * wb; }
            }
            const float dmin = -3.0701134573253945f, dmax = -15.350567286626973f;
            const float delta = fabsf(dmin + (float)c * ((dmax - dmin) / 511.0f));
            float e = 0.f;
#pragma unroll
            for (int i = 0; i < 32; ++i) {
                const int n = n0 + i; const float t01 = (float)n / 8191.0f; const float win = expf(-t01 * delta);
                af[i] *= win; ab[i] *= win; e += af[i] * af[i]; if (n >= 1) e += ab[i] * ab[i];
            }
#pragma unroll
            for (int i = 0; i < 8; ++i) {
                float4 a; a.x = af[4 * i]; a.y = af[4 * i + 1]; a.z = af[4 * i + 2]; a.w = af[4 * i + 3];
                float4 b; b.x = ab[4 * i]; b.y = ab[4 * i + 1]; b.z = ab[4 * i + 2]; b.w = ab[4 * i + 3];
                *(float4*)(hf + (size_t)c * 8192 + n0 + 4 * i) = a;
                *(float4*)(hf + (size_t)(512 + c) * 8192 + n0 + 4 * i) = b;
            }
            atomicAdd(en + c, e);
        }
        __syncthreads();
    }
}

__device__ void phase_filter_fft(const Params& p, int l, unsigned char* lds) {
    float2* d = (float2*)lds;
    const float2* tw = fft_lds_twiddles((const float2*)(p.ws + OFF_TW), lds);
    const float* hf = (const float*)(p.ws + OFF_HFILT);
    const float* en = (const float*)(p.ws + OFF_ENERGY) + l * 512;
    float4* pqa = (float4*)(p.ws + OFF_PQ);
    int tid_ = threadIdx.x; asm volatile("" : "+v"(tid_)); const int tid = tid_;
    for (int pr = blockIdx.x; pr < 256; pr += gridDim.x) {
        const int c0 = 2 * pr, c1 = c0 + 1;
        const float s0 = 1.0f / sqrtf(en[c0] + 1e-6f), s1 = 1.0f / sqrtf(en[c1] + 1e-6f);
        const float k0 = p.hy_skip[l * 512 + c0], k1 = p.hy_skip[l * 512 + c1];
        for (int n = tid; n < FN; n += NTHR) {
            float2 v;
            if (n < 8192) { v.x = hf[(size_t)c0 * 8192 + n] * s0; v.y = hf[(size_t)c1 * 8192 + n] * s1; if (n == 0) { v.x += k0; v.y += k1; } }
            else if (n == 8192) { v.x = 0.f; v.y = 0.f; }
            else { v.x = hf[(size_t)(512 + c0) * 8192 + (FN - n)] * s0; v.y = hf[(size_t)(512 + c1) * 8192 + (FN - n)] * s1; }
            d[n] = v;
        }
        __syncthreads();
        fft_forward(d, tw, (const float2*)(p.ws + OFF_TW));
        for (int kf = tid; kf <= FN / 2; kf += NTHR) filt_pointwise(d, pqa + (size_t)pr * FN, kf);
        __syncthreads();
    }
}

__device__ void hy_pre_item(const Params& p, int l, const bf16_t* P, float* UT, bf16_t* GT, int bl, int tt, int ct, unsigned char* lds) {
    float* tU = (float*)lds;
    float* tG = tU + 64 * 65;
    int tid_ = threadIdx.x; asm volatile("" : "+v"(tid_)); const int tid = tid_;
    const int t = tid >> 3, cc = (tid & 7) * 8, c = ct * 64 + cc, tb = tt * 64 + t;
    const float* cw = p.hy_conv_w + (size_t)l * 3 * 1536; const float* cb = p.hy_conv_b + l * 1536;
    float av[8], a0[8], a1[8];
#pragma unroll
    for (int h = 0; h < 2; ++h) {
        const f32x4 bv = *(const f32x4*)(cb + c + 4 * h), b0 = *(const f32x4*)(cb + 512 + c + 4 * h), b1 = *(const f32x4*)(cb + 1024 + c + 4 * h);
#pragma unroll
        for (int e = 0; e < 4; ++e) { av[4 * h + e] = bv[e]; a0[4 * h + e] = b0[e]; a1[4 * h + e] = b1[e]; }
    }
#pragma unroll
    for (int j = 0; j < 3; ++j) {
        const int ts = tb + j - 1;
        if (ts >= 0 && ts < SEQ) {
            const bf16_t* row = P + (size_t)(bl * SEQ + ts) * PS + C_HY + c;
            const u32x4 rv = *(const u32x4*)row, r0 = *(const u32x4*)(row + 512), r1 = *(const u32x4*)(row + 1024);
#pragma unroll
            for (int h = 0; h < 2; ++h) {
                const f32x4 wv = *(const f32x4*)(cw + j * 1536 + c + 4 * h), w0 = *(const f32x4*)(cw + j * 1536 + 512 + c + 4 * h), w1 = *(const f32x4*)(cw + j * 1536 + 1024 + c + 4 * h);
#pragma unroll
                for (int e = 0; e < 4; ++e) {
                    const int k = 4 * h + e; const unsigned uv = rv[k >> 1], u0 = r0[k >> 1], u1 = r1[k >> 1];
                    av[k] += wv[e] * ((k & 1) ? hi16(uv) : lo16(uv)); a0[k] += w0[e] * ((k & 1) ? hi16(u0) : lo16(u0)); a1[k] += w1[e] * ((k & 1) ? hi16(u1) : lo16(u1));
                }
            }
        }
    }
    const u32x4 rz = *(const u32x4*)(P + (size_t)(bl * SEQ + tb) * PS + C_Z + 512 + c);
#pragma unroll
    for (int k = 0; k < 8; ++k) {
        const unsigned uz = rz[k >> 1]; const float z = (k & 1) ? hi16(uz) : lo16(uz);
        tU[(cc + k) * 65 + t] = av[k] * a1[k]; tG[(cc + k) * 65 + t] = a0[k] * z;
    }
    __syncthreads();
    const int c2 = tid >> 3, t8 = (tid & 7) * 8;
    const size_t o = (size_t)(bl * 512 + ct * 64 + c2) * SEQ + tt * 64 + t8;
    const float* su = tU + c2 * 65 + t8; const float* sg = tG + c2 * 65 + t8;
    f32x4 ua = {su[0], su[1], su[2], su[3]}, ub = {su[4], su[5], su[6], su[7]};
    *(f32x4*)(UT + o) = ua; *(f32x4*)(UT + o + 4) = ub;
    u32x4 g; g.x = pk2(sg[0], sg[1]); g.y = pk2(sg[2], sg[3]); g.z = pk2(sg[4], sg[5]); g.w = pk2(sg[6], sg[7]);
    *(u32x4*)(GT + o) = g;
    __syncthreads();
}
__device__ void hy_post_item(bf16_t* P, const bf16_t* GT, int bl, int tt, int ct, unsigned char* lds, int dry = 0) {
    bf16_t* tl = (bf16_t*)lds;
    int tid_ = threadIdx.x; asm volatile("" : "+v"(tid_)); const int tid = tid_;
    const int c2 = tid >> 3, t8 = (tid & 7) * 8;
    const u32x4 v = *(const u32x4*)(GT + (size_t)(bl * 512 + ct * 64 + c2) * SEQ + tt * 64 + t8);
    bf16_t* d0 = tl + t8 * 72 + c2;
    d0[0 * 72] = (bf16_t)(v.x & 0xffffu); d0[1 * 72] = (bf16_t)(v.x >> 16); d0[2 * 72] = (bf16_t)(v.y & 0xffffu); d0[3 * 72] = (bf16_t)(v.y >> 16);
    d0[4 * 72] = (bf16_t)(v.z & 0xffffu); d0[5 * 72] = (bf16_t)(v.z >> 16); d0[6 * 72] = (bf16_t)(v.w & 0xffffu); d0[7 * 72] = (bf16_t)(v.w >> 16);
    __syncthreads();
    const int t = tid >> 3, cc = (tid & 7) * 8;
    const u32x4 ov = *(const u32x4*)(tl + t * 72 + cc);
    if (!dry) *(u32x4*)(P + (size_t)(bl * SEQ + tt * 64 + t) * PS + C_HY + ct * 64 + cc) = ov;
    __syncthreads();
}
__device__ void hyena_conv_item(const Params& p, const float* UT, bf16_t* GT, int bl, int pr, unsigned char* lds, const float2* tw, int dry = 0) {
    float2* d = (float2*)lds;
    const float4* pq = (const float4*)(p.ws + OFF_PQ) + (size_t)pr * FN;
    int tid_ = threadIdx.x; asm volatile("" : "+v"(tid_)); const int tid = tid_;
    const float* u0 = UT + (size_t)(bl * 512 + 2 * pr) * SEQ; const float* u1 = u0 + SEQ;
    bf16_t* g0 = GT + (size_t)(bl * 512 + 2 * pr) * SEQ; bf16_t* g1 = g0 + SEQ;
    for (int t = tid; t < SEQ; t += NTHR) {
        float2 u; u.x = u0[t]; u.y = u1[t]; d[t] = u;
        float2 z; z.x = 0.f; z.y = 0.f; d[t + SEQ] = z;
    }
    __syncthreads();
    fft_forward(d, tw, (const float2*)(p.ws + OFF_TW));
#pragma unroll 1
    for (int kf = tid; kf < FN / 2; kf += 4 * NTHR) {
        PwIn w0, w1, w2, w3;
        pw_load(w0, d, pq, kf); pw_load(w1, d, pq, kf + NTHR); pw_load(w2, d, pq, kf + 2 * NTHR); pw_load(w3, d, pq, kf + 3 * NTHR);
        pw_store(w0, d); pw_store(w1, d); pw_store(w2, d); pw_store(w3, d);
    }
    if (tid == 0) conv_pointwise(d, pq, FN / 2);
    __syncthreads();
    fft_inverse(d, tw, (const float2*)(p.ws + OFF_TW));
    for (int t = tid; t < SEQ; t += NTHR) {
        const float2 y = d[t];
        const bf16_t r0 = f2bf(y.x * bf2f(g0[t])), r1 = f2bf(y.y * bf2f(g1[t]));
        if (!dry) { g0[t] = r0; g1[t] = r1; }
    }
    __syncthreads();
}

__device__ void na_item(const Params& p, int l, bf16_t* P, int bl, int rp, int head, unsigned char* lds, int dry = 0) {
    bf16_t* Kimg = (bf16_t*)lds;
    bf16_t* VT = (bf16_t*)(lds + 82944);
    int tid_ = threadIdx.x; asm volatile("" : "+v"(tid_)); const int tid = tid_, lane = tid & 63, w = tid >> 6, l15 = lane & 15, q4 = lane >> 4;
    const int r0 = 2 * rp, rs0 = iclamp(r0 - 4, 0, 120);
#pragma unroll 3
    for (int i = 0; i < 9; ++i) {
        const int idx = tid + NTHR * i, key = idx >> 3, ch = idx & 7, grow = min(rs0 + (key >> 6), 127);
        const u32x4 kv = *(const u32x4*)(P + (size_t)(bl * SEQ + grow * 64 + (key & 63)) * PS + C_NAK + head * 64 + ch * 8);
        *(u32x4*)(Kimg + key * 72 + ch * 8) = kv;
    }
#pragma unroll 3
    for (int i = 0; i < 9; ++i) {
        const int idx = tid + NTHR * i, keyp = idx >> 2, chh = keyp >= 576 ? 1 : 0, key = keyp - chh * 576, ch = chh * 4 + (idx & 3), grow = min(rs0 + (key >> 6), 127);
        const u32x4 vv = *(const u32x4*)(P + (size_t)(bl * SEQ + grow * 64 + (key & 63)) * PS + C_NAV + head * 64 + ch * 8);
        bf16_t* vd = VT + (ch * 8) * 584 + key;
        vd[0 * 584] = (bf16_t)(vv.x & 0xffffu); vd[1 * 584] = (bf16_t)(vv.x >> 16);
        vd[2 * 584] = (bf16_t)(vv.y & 0xffffu); vd[3 * 584] = (bf16_t)(vv.y >> 16);
        vd[4 * 584] = (bf16_t)(vv.z & 0xffffu); vd[5 * 584] = (bf16_t)(vv.z >> 16);
        vd[6 * 584] = (bf16_t)(vv.w & 0xffffu); vd[7 * 584] = (bf16_t)(vv.w >> 16);
    }
    __syncthreads();
    const int rr = w >> 2, g = w & 3, r = r0 + rr, rs = iclamp(r - 4, 0, 120), lo = rs - rs0;
    const int cb = iclamp(16 * g - 8, 0, 32), c = 16 * g + l15, cs = iclamp(c - 8, 0, 48);
    bf16_t* qrow = P + (size_t)(bl * SEQ + r * 64 + c) * PS + head * 64;
    bf16x8 qf[2];
#pragma unroll
    for (int ks = 0; ks < 2; ++ks) qf[ks] = *(const bf16x8*)(qrow + ks * 32 + q4 * 8);
    f32x4 sc[16];
#pragma unroll
    for (int t = 0; t < 16; ++t) {
        const int kb = (lo + (t >> 1)) * 64 + cb + 16 * (t & 1);
        f32x4 a = {0.f, 0.f, 0.f, 0.f};
#pragma unroll
        for (int ks = 0; ks < 2; ++ks) { const bf16x8 kf = *(const bf16x8*)(Kimg + (kb + l15) * 72 + ks * 32 + q4 * 8); a = MFMA(kf, qf[ks], a); }
        sc[t] = a;
    }
    const float* rpb = p.na_rpb + (size_t)(l * 8 + head) * 15 * 31;
    float mx = -1e30f;
#pragma unroll
    for (int t = 0; t < 16; ++t) {
        const int drow = rs + (t >> 1) - r + 7;
#pragma unroll
        for (int e = 0; e < 4; ++e) {
            const int col = cb + 16 * (t & 1) + 4 * q4 + e;
            const bool ok = (col >= cs) && (col < cs + 16);
            const int dcol = ok ? (col - c + 15) : 0;
            const float v = ok ? (sc[t][e] + rpb[drow * 31 + dcol]) : -1e30f;
            sc[t][e] = v; mx = fmaxf(mx, v);
        }
    }
    mx = fmaxf(mx, __shfl_xor(mx, 16)); mx = fmaxf(mx, __shfl_xor(mx, 32));
    float sum = 0.f;
#pragma unroll
    for (int t = 0; t < 16; ++t)
#pragma unroll
        for (int e = 0; e < 4; ++e) { const float pe = __expf(sc[t][e] - mx); sc[t][e] = pe; sum += pe; }
    sum += __shfl_xor(sum, 16); sum += __shfl_xor(sum, 32);
    f32x4 o[4];
#pragma unroll
    for (int dt = 0; dt < 4; ++dt) o[dt] = (f32x4){0.f, 0.f, 0.f, 0.f};
#pragma unroll
    for (int kk = 0; kk < 8; ++kk) {
        u32x4 pu; pu.x = pk2(sc[2 * kk][0], sc[2 * kk][1]); pu.y = pk2(sc[2 * kk][2], sc[2 * kk][3]); pu.z = pk2(sc[2 * kk + 1][0], sc[2 * kk + 1][1]); pu.w = pk2(sc[2 * kk + 1][2], sc[2 * kk + 1][3]);
        const bf16x8 pf = mkfrag(pu);
        const int kbA = (lo + kk) * 64 + cb + 4 * q4;
#pragma unroll
        for (int dt = 0; dt < 4; ++dt) {
            const bf16_t* vr = VT + (dt * 16 + l15) * 584 + kbA;
            const bf16x8 vf = mkfrag2(*(const u32x2*)vr, *(const u32x2*)(vr + 16));
            o[dt] = MFMA(vf, pf, o[dt]);
        }
    }
    const float inv = 1.0f / sum;
    const bf16_t* zrow = P + (size_t)(bl * SEQ + r * 64 + c) * PS + C_Z + head * 64;
#pragma unroll
    for (int dt = 0; dt < 4; ++dt) {
        const int dd = dt * 16 + 4 * q4;
        const f32x4 z = ld_bf4(zrow + dd);
        if (!dry) st_bf4(qrow + dd, o[dt] * inv * z);
    }
    __syncthreads();
}

__device__ void memattn_load(const Params& p, int b, int h, unsigned char* lds) {
    bf16_t* Kimg = (bf16_t*)lds;
    bf16_t* VT = (bf16_t*)(lds + 69632);
    const bf16_t* Km = (const bf16_t*)(p.ws + OFF_KMAT); const bf16_t* Vm = (const bf16_t*)(p.ws + OFF_VT);
    int tid_ = threadIdx.x; asm volatile("" : "+v"(tid_)); const int tid = tid_;
#pragma unroll
    for (int i = 0; i < 8; ++i) {
        const int idx = tid + NTHR * i;
        { const int key = idx >> 4, ch = idx & 15; *(u32x4*)(Kimg + key * 136 + ch * 8) = *(const u32x4*)(Km + (size_t)(b * 256 + key) * 512 + h * 128 + ch * 8); }
        { const int dd = idx >> 5, ch = idx & 31; *(u32x4*)(VT + dd * 264 + ch * 8) = *(const u32x4*)(Vm + (size_t)(h * 128 + dd) * 2048 + b * 256 + ch * 8); }
    }
    __syncthreads();
}
__device__ void memattn_item(bf16_t* P, int bl, int h, int qt, unsigned char* lds, int dry = 0) {
    const bf16_t* Kimg = (const bf16_t*)lds; const bf16_t* VT = (const bf16_t*)(lds + 69632);
    int tid_ = threadIdx.x; asm volatile("" : "+v"(tid_)); const int tid = tid_, lane = tid & 63, w = tid >> 6, l15 = lane & 15, q4 = lane >> 4;
    const int tok = bl * SEQ + qt * 128 + w * 16 + l15;
    bf16_t* qrow = P + (size_t)tok * PS + C_MQ + h * 128;
    bf16x8 qf[4];
#pragma unroll
    for (int ks = 0; ks < 4; ++ks) qf[ks] = *(const bf16x8*)(qrow + ks * 32 + q4 * 8);
    f32x4 sc[16];
    float mx = -1e30f;
#pragma unroll
    for (int t = 0; t < 16; ++t) {
        f32x4 a = {0.f, 0.f, 0.f, 0.f};
#pragma unroll
        for (int ks = 0; ks < 4; ++ks) { const bf16x8 kf = *(const bf16x8*)(Kimg + (t * 16 + l15) * 136 + ks * 32 + q4 * 8); a = MFMA(kf, qf[ks], a); }
        sc[t] = a;
        mx = fmaxf(mx, fmaxf(fmaxf(a[0], a[1]), fmaxf(a[2], a[3])));
    }
    mx = fmaxf(mx, __shfl_xor(mx, 16)); mx = fmaxf(mx, __shfl_xor(mx, 32));
    float sum = 0.f;
#pragma unroll
    for (int t = 0; t < 16; ++t)
#pragma unroll
        for (int e = 0; e < 4; ++e) { const float pe = __expf(sc[t][e] - mx); sc[t][e] = pe; sum += pe; }
    sum += __shfl_xor(sum, 16); sum += __shfl_xor(sum, 32);
    f32x4 o[8];
#pragma unroll
    for (int dt = 0; dt < 8; ++dt) o[dt] = (f32x4){0.f, 0.f, 0.f, 0.f};
#pragma unroll
    for (int kk = 0; kk < 8; ++kk) {
        u32x4 pu; pu.x = pk2(sc[2 * kk][0], sc[2 * kk][1]); pu.y = pk2(sc[2 * kk][2], sc[2 * kk][3]); pu.z = pk2(sc[2 * kk + 1][0], sc[2 * kk + 1][1]); pu.w = pk2(sc[2 * kk + 1][2], sc[2 * kk + 1][3]);
        const bf16x8 pf = mkfrag(pu);
#pragma unroll
        for (int dt = 0; dt < 8; ++dt) {
            const bf16_t* vr = VT + (dt * 16 + l15) * 264 + kk * 32 + 4 * q4;
            const bf16x8 vf = mkfrag2(*(const u32x2*)vr, *(const u32x2*)(vr + 16));
            o[dt] = MFMA(vf, pf, o[dt]);
        }
    }
    const float inv = 1.0f / sum;
    const bf16_t* zrow = P + (size_t)tok * PS + C_Z + 3 * 512 + h * 128;
#pragma unroll
    for (int dt = 0; dt < 8; ++dt) {
        const int dd = dt * 16 + 4 * q4;
        const f32x4 z = ld_bf4(zrow + dd);
        if (!dry) st_bf4(qrow + dd, o[dt] * inv * z);
    }
}

constexpr int G_LRT = 0, G_BF = 8192, G_BB = 24576, G_TOT = 40960, G_IMG = 45056;
__device__ void gla_tables(const Params& p, int l, const float* LR, int t0, int h, unsigned char* lds) {
    float* LRT = (float*)(lds + G_LRT); float* BF = (float*)(lds + G_BF); float* BB = (float*)(lds + G_BB); float* TOT = (float*)(lds + G_TOT);
    int tid_ = threadIdx.x; asm volatile("" : "+v"(tid_)); const int tid = tid_;
    ((float4*)LRT)[tid] = ((const float4*)(LR + (size_t)t0 * 32))[tid];
    __syncthreads();
    const int dk = tid & 63, cgp = tid >> 6;
    float uf[16], ub[16];
#pragma unroll
    for (int r = 0; r < 16; ++r) { uf[r] = p.gla_up_f[(size_t)(l * 16 + r) * 256 + h * 64 + dk]; ub[r] = p.gla_up_b[(size_t)(l * 16 + r) * 256 + h * 64 + dk]; }
    const float bif = p.gla_bias_f[l * 256 + h * 64 + dk], bib = p.gla_bias_b[l * 256 + h * 64 + dk];
    float lf[8], lb[8];
#pragma unroll
    for (int i = 0; i < 8; ++i) {
        const int c = cgp * 8 + i; float sf = bif, sb = bib;
#pragma unroll
        for (int r = 0; r < 16; ++r) { sf += LRT[c * 32 + r] * uf[r]; sb += LRT[c * 32 + 16 + r] * ub[r]; }
        lf[i] = logsigf_(sf) * (1.0f / 16.0f); lb[i] = logsigf_(sb) * (1.0f / 16.0f);
    }
#pragma unroll
    for (int i = 1; i < 8; ++i) lf[i] += lf[i - 1];
#pragma unroll
    for (int i = 6; i >= 0; --i) lb[i] += lb[i + 1];
    TOT[cgp * 64 + dk] = lf[7]; TOT[512 + cgp * 64 + dk] = lb[0];
    __syncthreads();
    float of = 0.f, ob = 0.f;
#pragma unroll
    for (int g2 = 0; g2 < 8; ++g2) { if (g2 < cgp) of += TOT[g2 * 64 + dk]; if (g2 > cgp) ob += TOT[512 + g2 * 64 + dk]; }
#pragma unroll
    for (int i = 0; i < 8; ++i) { BF[(cgp * 8 + i) * 64 + dk] = lf[i] + of; BB[(cgp * 8 + i) * 64 + dk] = lb[i] + ob; }
    __syncthreads();
}
__device__ void gla_vt(const bf16_t* P, int t0, int h, bf16_t* VT) {
    int tid_ = threadIdx.x; asm volatile("" : "+v"(tid_)); const int tid = tid_;
#pragma unroll
    for (int i = 0; i < 2; ++i) {
        const int idx = tid + NTHR * i, chn = idx >> 6, c = idx & 63;
        const u32x4 vv = *(const u32x4*)(P + (size_t)(t0 + c) * PS + C_GV + h * 128 + chn * 8);
        bf16_t* vd = VT + (chn * 8) * 72 + c;
        vd[0 * 72] = (bf16_t)(vv.x & 0xffffu); vd[1 * 72] = (bf16_t)(vv.x >> 16);
        vd[2 * 72] = (bf16_t)(vv.y & 0xffffu); vd[3 * 72] = (bf16_t)(vv.y >> 16);
        vd[4 * 72] = (bf16_t)(vv.z & 0xffffu); vd[5 * 72] = (bf16_t)(vv.z >> 16);
        vd[6 * 72] = (bf16_t)(vv.w & 0xffffu); vd[7 * 72] = (bf16_t)(vv.w >> 16);
    }
}
__device__ void gla_part1_item(const Params& p, int l, const bf16_t* P, const float* LR, int item, unsigned char* lds) {
    const int h = item & 3, n = (item >> 2) & 127, bl = item >> 9, t0 = bl * SEQ + n * 64;
    const float* BF = (const float*)(lds + G_BF); const float* BB = (const float*)(lds + G_BB);
    bf16_t* KDT0 = (bf16_t*)(lds + G_IMG); bf16_t* KDT1 = KDT0 + 64 * 72; bf16_t* VT = KDT1 + 64 * 72;
    float* GS = (float*)(p.ws + OFF_GS); float* GD = (float*)(p.ws + OFF_GDEC);
    int tid_ = threadIdx.x; asm volatile("" : "+v"(tid_)); const int tid = tid_, lane = tid & 63, w = tid >> 6, l15 = lane & 15, q4 = lane >> 4;
    gla_tables(p, l, LR, t0, h, lds);
#pragma unroll
    for (int i = 0; i < 8; ++i) {
        const int idx = tid + NTHR * i, c = idx >> 6, dk = idx & 63;
        const float kv = bf2f(P[(size_t)(t0 + c) * PS + C_GK + h * 64 + dk]);
        KDT0[dk * 72 + c] = f2bf(kv * __expf(BF[63 * 64 + dk] - BF[c * 64 + dk]));
        KDT1[dk * 72 + c] = f2bf(kv * __expf(BB[dk] - BB[c * 64 + dk]));
    }
    gla_vt(P, t0, h, VT);
    if (tid < 64) GD[(size_t)item * 64 + tid] = __expf(BF[63 * 64 + tid]);
    else if (tid < 128) GD[(size_t)(NITEM + item) * 64 + tid - 64] = __expf(BB[tid - 64]);
    __syncthreads();
    const int dir = w >> 2, dkt = w & 3;
    const bf16_t* KD = dir ? KDT1 : KDT0;
    bf16x8 kf[2];
#pragma unroll
    for (int ks = 0; ks < 2; ++ks) kf[ks] = *(const bf16x8*)(KD + (16 * dkt + l15) * 72 + 32 * ks + 8 * q4);
    float* dst = GS + ((size_t)dir * NITEM + item) * 8192;
#pragma unroll
    for (int dvt = 0; dvt < 8; ++dvt) {
        f32x4 a = {0.f, 0.f, 0.f, 0.f};
#pragma unroll
        for (int ks = 0; ks < 2; ++ks) { const bf16x8 vf = *(const bf16x8*)(VT + (16 * dvt + l15) * 72 + 32 * ks + 8 * q4); a = MFMA(kf[ks], vf, a); }
        *(f32x4*)(dst + (16 * dvt + l15) * 64 + 16 * dkt + 4 * q4) = a;
    }
    __syncthreads();
}
__device__ void gla_scan(const Params& p, int dry = 0) {
    float* GS = (float*)(p.ws + OFF_GS); const float* GD = (const float*)(p.ws + OFF_GDEC);
    const int total = 2 * BG * 4 * 8192;
    int tid_ = threadIdx.x; asm volatile("" : "+v"(tid_));
    for (int id = blockIdx.x * NTHR + tid_; id < total; id += gridDim.x * NTHR) {
        const int e = id & 8191, comb = id >> 13, h = comb & 3, bl = (comb >> 2) % BG, dir = comb / (4 * BG), dk = e & 63;
        float S = 0.f;
        const size_t ibase = (size_t)dir * NITEM + (size_t)(bl * 128) * 4 + h;
        for (int s0 = 0; s0 < 128; s0 += 16) {
            float u[16], dc[16];
#pragma unroll
            for (int i = 0; i < 16; ++i) {
                const int n = dir ? 127 - (s0 + i) : s0 + i;
                const size_t item = ibase + (size_t)n * 4;
                u[i] = GS[item * 8192 + e]; dc[i] = GD[item * 64 + dk];
            }
#pragma unroll
            for (int i = 0; i < 16; ++i) {
                const int n = dir ? 127 - (s0 + i) : s0 + i;
                const size_t item = ibase + (size_t)n * 4;
                if (!dry) GS[item * 8192 + e] = S;
                S = dc[i] * S + u[i];
            }
        }
    }
}
__device__ void gla_part2_item(const Params& p, int l, bf16_t* P, const float* LR, int item, unsigned char* lds, int dry = 0) {
    const int h = item & 3, n = (item >> 2) & 127, bl = item >> 9, t0 = bl * SEQ + n * 64;
    const float* BF = (const float*)(lds + G_BF); const float* BB = (const float*)(lds + G_BB);
    bf16_t* QF = (bf16_t*)(lds + G_IMG);
    bf16_t* KF = QF + 2 * 64 * 72;
    bf16_t* QD = KF + 2 * 64 * 72;
    bf16_t* VT = QD + 2 * 64 * 72;
    bf16_t* ST = VT + 128 * 72;
    float* OX = (float*)lds;
    const float* GS = (const float*)(p.ws + OFF_GS);
    int tid_ = threadIdx.x; asm volatile("" : "+v"(tid_)); const int tid = tid_, lane = tid & 63, w = tid >> 6, l15 = lane & 15, q4 = lane >> 4;
    gla_tables(p, l, LR, t0, h, lds);
#pragma unroll
    for (int i = 0; i < 8; ++i) {
        const int idx = tid + NTHR * i, c = idx >> 6, dk = idx & 63;
        const float qv = bf2f(P[(size_t)(t0 + c) * PS + C_GQ + h * 64 + dk]);
        const float kv = bf2f(P[(size_t)(t0 + c) * PS + C_GK + h * 64 + dk]);
        const float bf = BF[c * 64 + dk], mf = BF[31 * 64 + dk], bb = BB[c * 64 + dk], mb = BB[32 * 64 + dk];
        QF[c * 72 + dk] = f2bf(qv * __expf(bf - mf)); KF[c * 72 + dk] = f2bf(kv * __expf(mf - bf)); QD[c * 72 + dk] = f2bf(qv * __expf(bf));
        QF[4608 + c * 72 + dk] = f2bf(qv * __expf(bb - mb)); KF[4608 + c * 72 + dk] = f2bf(kv * __expf(mb - bb)); QD[4608 + c * 72 + dk] = f2bf(qv * __expf(bb));
    }
    gla_vt(P, t0, h, VT);
#pragma unroll
    for (int dir = 0; dir < 2; ++dir) {
        const float* src = GS + ((size_t)dir * NITEM + item) * 8192;
#pragma unroll
        for (int i = 0; i < 4; ++i) {
            const int idx = tid + NTHR * i, dv = idx >> 4, dk4 = (idx & 15) * 4;
            const float4 s = *(const float4*)(src + dv * 64 + dk4);
            u32x2 o; o.x = pk2(s.x, s.y); o.y = pk2(s.z, s.w);
            *(u32x2*)(ST + dir * 9216 + dv * 72 + dk4) = o;
        }
    }
    __syncthreads();
    const int dir = w >> 2, ct = w & 3;
    const bf16_t* qfp = QF + dir * 4608; const bf16_t* kfp = KF + dir * 4608; const bf16_t* qdp = QD + dir * 4608; const bf16_t* stp = ST + dir * 9216;
    bf16x8 qf[2], qd[2];
#pragma unroll
    for (int ks = 0; ks < 2; ++ks) { qf[ks] = *(const bf16x8*)(qfp + (16 * ct + l15) * 72 + 32 * ks + 8 * q4); qd[ks] = *(const bf16x8*)(qdp + (16 * ct + l15) * 72 + 32 * ks + 8 * q4); }
    f32x4 sc[4];
    const int cq = 16 * ct + l15;
#pragma unroll
    for (int st = 0; st < 4; ++st) {
        f32x4 a = {0.f, 0.f, 0.f, 0.f};
#pragma unroll
        for (int ks = 0; ks < 2; ++ks) { const bf16x8 kf = *(const bf16x8*)(kfp + (16 * st + l15) * 72 + 32 * ks + 8 * q4); a = MFMA(kf, qf[ks], a); }
#pragma unroll
        for (int e = 0; e < 4; ++e) { const int s = 16 * st + 4 * q4 + e; const bool ok = dir ? (s > cq) : (s <= cq); a[e] = ok ? a[e] : 0.f; }
        sc[st] = a;
    }
    f32x4 o[8];
#pragma unroll
    for (int dt = 0; dt < 8; ++dt) o[dt] = (f32x4){0.f, 0.f, 0.f, 0.f};
#pragma unroll
    for (int kk = 0; kk < 2; ++kk) {
        u32x4 pu; pu.x = pk2(sc[2 * kk][0], sc[2 * kk][1]); pu.y = pk2(sc[2 * kk][2], sc[2 * kk][3]); pu.z = pk2(sc[2 * kk + 1][0], sc[2 * kk + 1][1]); pu.w = pk2(sc[2 * kk + 1][2], sc[2 * kk + 1][3]);
        const bf16x8 pf = mkfrag(pu);
#pragma unroll
        for (int dt = 0; dt < 8; ++dt) {
            const bf16_t* vr = VT + (dt * 16 + l15) * 72 + kk * 32 + 4 * q4;
            const bf16x8 vf = mkfrag2(*(const u32x2*)vr, *(const u32x2*)(vr + 16));
            o[dt] = MFMA(vf, pf, o[dt]);
        }
    }
#pragma unroll
    for (int ks = 0; ks < 2; ++ks)
#pragma unroll
        for (int dt = 0; dt < 8; ++dt) { const bf16x8 sf = *(const bf16x8*)(stp + (dt * 16 + l15) * 72 + 32 * ks + 8 * q4); o[dt] = MFMA(sf, qd[ks], o[dt]); }
    if (dir == 1) {
#pragma unroll
        for (int dt = 0; dt < 8; ++dt) *(f32x4*)(OX + cq * 132 + 16 * dt + 4 * q4) = o[dt];
    }
    __syncthreads();
    if (dir == 0) {
        float ss = 0.f;
#pragma unroll
        for (int dt = 0; dt < 8; ++dt) { o[dt] += *(const f32x4*)(OX + cq * 132 + 16 * dt + 4 * q4); ss += (o[dt][0] * o[dt][0] + o[dt][1] * o[dt][1]) + (o[dt][2] * o[dt][2] + o[dt][3] * o[dt][3]); }
        ss += __shfl_xor(ss, 16); ss += __shfl_xor(ss, 32);
        const float rms = 1.0f / sqrtf(ss * (1.0f / 128.0f) + 1e-6f);
        const float* ng = p.gla_norm_g + l * 512 + h * 128;
        const bf16_t* zrow = P + (size_t)(t0 + cq) * PS + C_Z + 2 * 512 + h * 128;
        bf16_t* orow = P + (size_t)(t0 + cq) * PS + C_GV + h * 128;
#pragma unroll
        for (int dt = 0; dt < 8; ++dt) {
            const int dd = 16 * dt + 4 * q4;
            const f32x4 z = ld_bf4(zrow + dd); const f32x4 g4 = *(const f32x4*)(ng + dd);
            if (!dry) st_bf4(orow + dd, o[dt] * rms * g4 * z);
        }
    }
    __syncthreads();
}

namespace pg8 {
#define PG8_LAS __attribute__((address_space(3)))
typedef unsigned short bf16_t;
typedef short bf16x8 __attribute__((ext_vector_type(8)));
typedef float f32x4 __attribute__((ext_vector_type(4)));
typedef unsigned u32x4 __attribute__((ext_vector_type(4)));
constexpr int BM = 256, BK = 64, HALF = 128, HTB = HALF * BK * 2  , STAGE_BYTES = 8 * HTB, NXCD = 8, WGM = 8;

__host__ __device__ __forceinline__ int lds_byte(int r, int c) { const int st = (r >> 4) * 2 + (c >> 5), rr = r & 15, cc = c & 31, ob = rr * 64 + cc * 2; return st * 1024 + (ob ^ (((ob >> 9) & 1) << 5)); }
__host__ __device__ __forceinline__ void stage_rc(int b, int& R, int& C) { const int st = b / 1024, sb = b % 1024, swz = sb ^ (((sb >> 9) & 1) << 5); R = (st >> 1) * 16 + swz / 64; C = (st & 1) * 32 + (swz % 64) / 2; }
__host__ __device__ __forceinline__ int perm32(int rho) { const int n = rho >> 4, i = rho & 15; return 8 * (i >> 2) + 4 * n + (i & 3); }

struct Unit { int pm, pn; };
struct Gemm { const bf16_t* A; const bf16_t* Bt; int M, N, K; };

struct StaticOrder {
    int nM, nN, nwg, G, c;
    __host__ __device__ void init(int M, int N, int G_, int c_) { nM = M / BM; nN = N / BM; nwg = nM * nN; G = G_; c = c_; }
    __host__ __device__ bool next(int i, Unit& u) const {
        const long L = (long)i * G + c; if (L >= nwg) return false;
        int wgid = (int)L; { const int q = nwg / NXCD, r = nwg % NXCD, xcd = wgid % NXCD, off = wgid / NXCD; wgid = (xcd < r ? xcd * (q + 1) : r * (q + 1) + (xcd - r) * q) + off; }
        const int nig = WGM * nN, gid = wgid / nig, fm = gid * WGM, gsz = (nM - fm) < WGM ? (nM - fm) : WGM;
        u.pm = fm + ((wgid % nig) % gsz); u.pn = (wgid % nig) / gsz; return true;
    }
    __device__ __forceinline__ void a_ready(const Unit&) const {}
    __device__ __forceinline__ void done(const Unit&) const {}
};
__device__ __forceinline__ unsigned cvt_pk_bf16(float lo, float hi) { unsigned r; asm volatile("v_cvt_pk_bf16_f32 %0, %1, %2" : "=v"(r) : "v"(lo), "v"(hi)); return r; }
template <class Epi, class Sched, bool STAMP = false>
__device__ __forceinline__ void gemm_phase(PG8_LAS unsigned char* lds, const Gemm g, const Sched& S, const Epi& E, unsigned long long* stamps) {
    int tid_l = threadIdx.x; asm volatile("" : "+v"(tid_l)); const int tid = tid_l, wid = __builtin_amdgcn_readfirstlane(tid >> 6), lane = tid & 63, wr = wid >> 2, wc = wid & 3, fr = lane & 15, fq = lane >> 4;
    const int K = g.K, nt = K / BK;
    int ts_lo = 0, ts_hi = 0, nts = 0; const unsigned long long rt_entry = STAMP ? (unsigned long long)wall_clock64() : 0ull;
#define PG8_STAMP() do { if (STAMP && wid == 0 && nts < 64) { const unsigned long long _c = (unsigned long long)clock64(); \
        ts_lo = (lane == nts) ? (int)(unsigned)_c : ts_lo; ts_hi = (lane == nts) ? (int)(unsigned)(_c >> 32) : ts_hi; ++nts; } } while (0)
    PG8_STAMP();
    unsigned voffA[2], voffB[2];
#pragma unroll
    for (int i = 0; i < 2; ++i) { int R, C; stage_rc(tid * 16 + i * 8192, R, C); const int Rb = Epi::PERM ? ((R & ~31) + perm32(R & 31)) : R;
        voffA[i] = (unsigned)(R * K + C) * 2u; voffB[i] = (unsigned)(Rb * K + C) * 2u; }
    const size_t kstep = (size_t)(BK * 2);
    const size_t hstep = (size_t)HALF * K * 2;
    const size_t tstep = 2 * hstep;
    const unsigned ldsw = (unsigned)wid * 1024u;
    const int aoff = lds_byte(wr * 64 + fr, fq * 8), boff = lds_byte(wc * 32 + fr, fq * 8);
#define PG8_SA(b, h) (((b) * 2 + (h)) * HTB)
#define PG8_SB(b, h) ((4 + (b) * 2 + (h)) * HTB)
#define PG8_STAGE(bufoff, gbase, voff) do { _Pragma("unroll") for (int _i = 0; _i < 2; ++_i) \
        __builtin_amdgcn_global_load_lds((const unsigned*)((const char*)(gbase) + (voff)[_i]), (PG8_LAS unsigned*)(lds + (bufoff) + ldsw + _i * 8192), 16, 0, 0); } while (0)
#define PG8_LDA(dst, b, h) do { _Pragma("unroll") for (int m = 0; m < 4; ++m) _Pragma("unroll") for (int k = 0; k < 2; ++k) dst[m][k] = *(const PG8_LAS bf16x8*)(lds + PG8_SA(b, h) + aoff + m * 2048 + k * 1024); } while (0)
#define PG8_LDB(dst, b, h) do { _Pragma("unroll") for (int n = 0; n < 2; ++n) _Pragma("unroll") for (int k = 0; k < 2; ++k) dst[n][k] = *(const PG8_LAS bf16x8*)(lds + PG8_SB(b, h) + boff + n * 2048 + k * 1024); } while (0)
#define PG8_MMA(ai, bj, At, Bt) do { __builtin_amdgcn_s_setprio(1); _Pragma("unroll") for (int m = 0; m < 4; ++m) _Pragma("unroll") for (int n = 0; n < 2; ++n) _Pragma("unroll") for (int k = 0; k < 2; ++k) \
        acc[ai][bj][m][n] = __builtin_amdgcn_mfma_f32_16x16x32_bf16(Bt[n][k], At[m][k], acc[ai][bj][m][n], 0, 0, 0); __builtin_amdgcn_s_setprio(0); } while (0)
#define PG8_WAIT_V(n) asm volatile("s_waitcnt vmcnt(" #n ")" ::: "memory")
#define PG8_WAIT_L(n) asm volatile("s_waitcnt lgkmcnt(" #n ")" ::: "memory")
#define PG8_BAR __builtin_amdgcn_s_barrier()
#define PG8_SCHED __builtin_amdgcn_sched_barrier(0)
    Unit cur, nxt; int ui = 0;
    if (!S.next(0, cur)) return;
    f32x4 acc[2][2][4][2];
#pragma unroll
    for (int a = 0; a < 2; ++a)
#pragma unroll
        for (int b = 0; b < 2; ++b)
#pragma unroll
            for (int m = 0; m < 4; ++m)
#pragma unroll
                for (int n = 0; n < 2; ++n) acc[a][b][m][n] = (f32x4){0.f, 0.f, 0.f, 0.f};
    bf16x8 At[4][2], B0[2][2], B1[2][2];
    const char* cA = (const char*)g.A + (size_t)cur.pm * tstep; const char* cB = (const char*)g.Bt + (size_t)cur.pn * tstep;
    S.a_ready(cur);
    PG8_STAGE(PG8_SB(0, 0), cB, voffB); PG8_STAGE(PG8_SA(0, 0), cA, voffA); PG8_STAGE(PG8_SB(0, 1), cB + hstep, voffB); PG8_STAGE(PG8_SA(0, 1), cA + hstep, voffA);
    if (wr == 1) PG8_BAR;
    PG8_WAIT_V(4); PG8_BAR;
    PG8_STAGE(PG8_SB(1, 0), cB + kstep, voffB); PG8_STAGE(PG8_SA(1, 0), cA + kstep, voffA); PG8_STAGE(PG8_SB(1, 1), cB + hstep + kstep, voffB);
    PG8_WAIT_V(6); PG8_BAR;
    PG8_STAMP();
    for (;;) {
        const bool has_next = S.next(ui + 1, nxt);
        const char* nA = has_next ? (const char*)g.A + (size_t)nxt.pm * tstep : cA; const char* nB = has_next ? (const char*)g.Bt + (size_t)nxt.pn * tstep : cB;
        for (int t = 0; t < nt; t += 2) {
            const bool last = (t == nt - 2);
            const char* a1 = cA + (size_t)(t + 1) * kstep;
            const char* a2 = last ? nA : cA + (size_t)(t + 2) * kstep; const char* b2 = last ? nB : cB + (size_t)(t + 2) * kstep;
            const char* a3 = a2 + kstep; const char* b3 = b2 + kstep;
            if (last && has_next) S.a_ready(nxt);
            PG8_LDB(B0, 0, 0); PG8_SCHED; PG8_LDA(At, 0, 0); PG8_STAGE(PG8_SA(1, 1), a1 + hstep, voffA);
            PG8_WAIT_L(8); PG8_BAR; PG8_WAIT_L(0); PG8_MMA(0, 0, At, B0); PG8_BAR; PG8_SCHED;
            PG8_LDB(B1, 0, 1); PG8_STAGE(PG8_SB(0, 0), b2, voffB);
            PG8_BAR; PG8_WAIT_L(0); PG8_MMA(0, 1, At, B1); PG8_BAR;
            PG8_LDA(At, 0, 1); PG8_STAGE(PG8_SA(0, 0), a2, voffA);
            PG8_BAR; PG8_WAIT_L(0); PG8_MMA(1, 0, At, B0); PG8_BAR; PG8_SCHED;
            PG8_STAGE(PG8_SB(0, 1), b2 + hstep, voffB);
            PG8_WAIT_V(6); PG8_BAR; PG8_MMA(1, 1, At, B1); PG8_BAR;
            PG8_LDB(B0, 1, 0); PG8_SCHED; PG8_LDA(At, 1, 0); PG8_STAGE(PG8_SA(0, 1), a2 + hstep, voffA);
            PG8_WAIT_L(8); PG8_BAR; PG8_WAIT_L(0); PG8_MMA(0, 0, At, B0); PG8_BAR; PG8_SCHED;
            PG8_LDB(B1, 1, 1); PG8_STAGE(PG8_SB(1, 0), b3, voffB);
            PG8_BAR; PG8_WAIT_L(0); PG8_MMA(0, 1, At, B1); PG8_BAR;
            PG8_LDA(At, 1, 1); PG8_STAGE(PG8_SA(1, 0), a3, voffA);
            PG8_BAR; PG8_WAIT_L(0); PG8_MMA(1, 0, At, B0); PG8_BAR; PG8_SCHED;
            PG8_STAGE(PG8_SB(1, 1), b3 + hstep, voffB);
            PG8_WAIT_V(6); PG8_BAR; PG8_MMA(1, 1, At, B1); PG8_BAR;
        }
        PG8_STAMP();
        if constexpr (!Epi::AFTER_DRAIN) { E(acc, cur, wr, wc, fr, fq); S.done(cur); }
        PG8_STAMP();
        if (!has_next) break;
#pragma unroll
        for (int a = 0; a < 2; ++a)
#pragma unroll
            for (int b = 0; b < 2; ++b)
#pragma unroll
                for (int m = 0; m < 4; ++m)
#pragma unroll
                    for (int n = 0; n < 2; ++n) acc[a][b][m][n] = (f32x4){0.f, 0.f, 0.f, 0.f};
        cur = nxt; cA = nA; cB = nB; ++ui;
    }
    PG8_WAIT_V(0);
    if (wr == 0) PG8_BAR;
    PG8_BAR;
    if constexpr (Epi::AFTER_DRAIN) { E.fused(acc, cur, wr, wc, fr, fq, lds, wid, lane); S.done(cur); }
    PG8_STAMP();
    if (STAMP && wid == 0) { stamps[lane] = lane < nts ? (((unsigned long long)(unsigned)ts_hi << 32) | (unsigned)ts_lo) : 0ull;
        if (lane == 62) stamps[62] = rt_entry; if (lane == 63) stamps[63] = (unsigned long long)wall_clock64(); }
#undef PG8_STAMP
#undef PG8_SA
#undef PG8_SB
#undef PG8_STAGE
#undef PG8_LDA
#undef PG8_LDB
#undef PG8_MMA
#undef PG8_WAIT_V
#undef PG8_WAIT_L
#undef PG8_BAR
#undef PG8_SCHED
}
}

struct EpiInProj {
    static constexpr bool PERM = false, AFTER_DRAIN = false;
    bf16_t* P; const float* bias; float* LR;
    __device__ __forceinline__ void operator()(const f32x4 (&acc)[2][2][4][2], const pg8::Unit& u, int wr, int wc, int fr, int fq) const {
        const int row0 = u.pm * 256 + wr * 64 + fr, colt = u.pn * 256, col0 = colt + wc * 32 + 4 * fq;
        if (colt == C_LR) {
            if (wc == 0) {
#pragma unroll
                for (int n = 0; n < 2; ++n) {
                    const int cl = 4 * fq + n * 16;
                    const f32x4 b0 = *(const f32x4*)(bias + 4096 + cl);
#pragma unroll
                    for (int ai = 0; ai < 2; ++ai)
#pragma unroll
                        for (int m = 0; m < 4; ++m) *(f32x4*)(LR + (size_t)(row0 + ai * 128 + m * 16) * 32 + cl) = acc[ai][0][m][n] + b0;
                }
            }
            return;
        }
        const int mode = (colt < 512 || colt == C_GQ) ? 1 : (colt >= C_MQ && colt < C_Z) ? 2 : (colt >= C_Z && colt < C_SG) ? 3 : (colt >= C_SG) ? 4 : 0;
#pragma unroll
        for (int bj = 0; bj < 2; ++bj)
#pragma unroll
            for (int n = 0; n < 2; ++n) {
                const int col = col0 + bj * 128 + n * 16;
                const f32x4 b0 = *(const f32x4*)(bias + orig_col(col));
#pragma unroll
                for (int ai = 0; ai < 2; ++ai)
#pragma unroll
                    for (int m = 0; m < 4; ++m) {
                        f32x4 v0 = acc[ai][bj][m][n] + b0;
                        if (mode == 1) v0 *= 0.125f;
                        else if (mode == 2) v0 *= 0.08838834764831845f;
                        else if (mode == 3) {
#pragma unroll
                            for (int e = 0; e < 4; ++e) v0[e] = siluf_(v0[e]);
                        } else if (mode == 4) {
#pragma unroll
                            for (int e = 0; e < 4; ++e) v0[e] = sigmoidf_(v0[e]);
                        }
                        st_bf4(P + (size_t)(row0 + ai * 128 + m * 16) * PS + col, v0);
                    }
            }
    }
};
struct EpiOut {
    static constexpr bool PERM = false, AFTER_DRAIN = false;
    float* pre; const float* bo; const float* x; const float2* stats; const float* g0; const float* b0; const float* hres; size_t tok0; int l;
    __device__ __forceinline__ void operator()(const f32x4 (&acc)[2][2][4][2], const pg8::Unit& u, int wr, int wc, int fr, int fq) const {
        const int row0 = u.pm * 256 + wr * 64 + fr, col0 = u.pn * 256 + wc * 32 + 4 * fq;
#pragma unroll
        for (int ai = 0; ai < 2; ++ai)
#pragma unroll
            for (int m = 0; m < 4; ++m) {
                const int row = row0 + ai * 128 + m * 16; const size_t T = tok0 + row;
                float2 st; st.x = 0.f; st.y = 0.f; if (l == 0) st = stats[T];
#pragma unroll
                for (int bj = 0; bj < 2; ++bj)
#pragma unroll
                    for (int n = 0; n < 2; ++n) {
                        const int col = col0 + bj * 128 + n * 16;
                        f32x4 res;
                        if (l == 0) res = (*(const f32x4*)(x + T * 1024 + col) - st.x) * st.y * *(const f32x4*)(g0 + col) + *(const f32x4*)(b0 + col);
                        else res = *(const f32x4*)(hres + T * 1024 + col);
                        *(f32x4*)(pre + (size_t)row * 1024 + col) = acc[ai][bj][m][n] + *(const f32x4*)(bo + col) + DN_ALPHA * res;
                    }
            }
    }
};

__device__ __forceinline__ void gbar(unsigned* ctr, unsigned& gen, int G) {
    __syncthreads();
    gen += (unsigned)G;
    if (threadIdx.x == 0) {
        __threadfence();
        __hip_atomic_fetch_add(ctr, 1u, __ATOMIC_RELAXED, __HIP_MEMORY_SCOPE_AGENT);
        while (__hip_atomic_load(ctr, __ATOMIC_RELAXED, __HIP_MEMORY_SCOPE_AGENT) < gen) __builtin_amdgcn_s_sleep(1);
        __threadfence();
    }
    __syncthreads();
}
typedef const Params __attribute__((address_space(4))) KParams;
#define KP4 __attribute__((address_space(4)))
__device__ __forceinline__ Params fresh_params() {
#if defined(__HIP_DEVICE_COMPILE__)
    KParams* kp = (KParams*)__builtin_amdgcn_kernarg_segment_ptr();
    asm volatile("" : "+s"(kp));
    Params r;
    const float* KP4 const* src = (const float* KP4 const*)kp;
    const float** dst = (const float**)&r;
#pragma unroll
    for (int i = 0; i < 28; ++i) dst[i] = src[i];
    return r;
#else
    return Params{};
#endif
}
__global__ void __launch_bounds__(NTHR) mega(Params p_unused) {
    extern __shared__ __attribute__((aligned(16))) unsigned char lds[];
    cg::grid_group grid = cg::this_grid();
    const int G = gridDim.x, bid = blockIdx.x;
    unsigned bar_gen = 0;
    unsigned* bar_ctr;
    { const Params p = fresh_params(); bar_ctr = (unsigned*)(p.ws + OFF_BAR); }
    { const Params p = fresh_params(); phase0(p); }
    grid.sync();
#pragma unroll 1
    for (int l = 0; l < 2; ++l) {
        { const Params p = fresh_params(); phase_weights(p, l, lds); __syncthreads(); phase_filter_gen(p, l, lds); }
        gbar(bar_ctr, bar_gen, G);
        {
            const Params p = fresh_params();
            phase_filter_fft(p, l, lds);
            const bf16_t* WtKV = (const bf16_t*)(p.ws + OFF_WTKV); const bf16_t* membf = (const bf16_t*)(p.ws + OFF_MEMBF);
            for (int t = bid; t < 64; t += G) {
                f32x4 acc[4][4];
                if (t < 32) {
                    const int m0 = (t >> 2) * 256, n0 = (t & 3) * 128;
                    gemm_core(acc, membf + (size_t)m0 * 1024, 1024, WtKV + (size_t)n0 * 1024, 1024, 1024, lds);
                    bf16_t* Km = (bf16_t*)(p.ws + OFF_KMAT);
                    EPI_LOOP(st_bf4(Km + (size_t)row * 512 + col, v);)
                } else {
                    const int t2 = t - 32, m0 = (t2 >> 4) * 256, n0 = (t2 & 15) * 128;
                    gemm_core(acc, WtKV + (size_t)(512 + m0) * 1024, 1024, membf + (size_t)n0 * 1024, 1024, 1024, lds);
                    bf16_t* Vm = (bf16_t*)(p.ws + OFF_VT);
                    EPI_LOOP(st_bf4(Vm + (size_t)row * 2048 + col, v);)
                }
            }
        }
        gbar(bar_ctr, bar_gen, G);
#pragma unroll 1
        for (int g = 0; g < NGRP; ++g) {
            const size_t tok0 = (size_t)g * TG;
#pragma unroll 1
            for (int rep = 0; rep < PROBE_REP_INPROJ; ++rep) {
                const Params p = fresh_params();
                pg8::Gemm gm; gm.A = (const bf16_t*)(p.ws + OFF_HB) + tok0 * 1024; gm.Bt = (const bf16_t*)(p.ws + OFF_WTIN); gm.M = TG; gm.N = NINP; gm.K = 1024;
                pg8::StaticOrder S; S.init(TG, NINP, G, bid);
                EpiInProj E; E.P = (bf16_t*)(p.ws + OFF_P); E.bias = p.b_in + (size_t)l * NIN; E.LR = (float*)(p.ws + OFF_LR);
                pg8::gemm_phase<EpiInProj, pg8::StaticOrder, false>((PG8_LAS unsigned char*)lds, gm, S, E, nullptr);
                __syncthreads();
            }
            gbar(bar_ctr, bar_gen, G);
#pragma unroll 1
            for (int rep = 0; rep < PROBE_REP_MIX; ++rep) {
            int dry = (rep + 1 < PROBE_REP_MIX) ? 1 : 0; asm volatile("" : "+s"(dry));
            {
                const Params p = fresh_params();
                bf16_t* P = (bf16_t*)(p.ws + OFF_P);
                for (int it = bid; it < BG * 64 * 8; it += G) na_item(p, l, P, it >> 9, (it >> 3) & 63, it & 7, lds, dry);
            }
            {
                const Params p = fresh_params();
                bf16_t* P = (bf16_t*)(p.ws + OFF_P);
                for (int it = bid; it < BG * 128 * 8; it += G) hy_pre_item(p, l, P, (float*)(p.ws + OFF_UT), (bf16_t*)(p.ws + OFF_GT), it >> 10, (it >> 3) & 127, it & 7, lds);
            }
            {
                const Params p = fresh_params();
                for (int it = bid; it < NITEM; it += G) gla_part1_item(p, l, (const bf16_t*)(p.ws + OFF_P), (const float*)(p.ws + OFF_LR), it, lds);
            }
            {
                const Params p = fresh_params();
                bf16_t* P = (bf16_t*)(p.ws + OFF_P);
                const int nit = BG * 4 * 64, per = (nit + G - 1) / G;
                int last = -1;
                for (int it = bid * per; it < min(nit, (bid + 1) * per); ++it) {
                    const int bh = it >> 6, bl = bh >> 2, h = bh & 3;
                    if (bh != last) { __syncthreads(); memattn_load(p, g * BG + bl, h, lds); last = bh; }
                    memattn_item(P, bl, h, it & 63, lds, dry);
                }
                __syncthreads();
            }
            gbar(bar_ctr, bar_gen, G);
            {
                const Params p = fresh_params();
                const float2* twl = fft_lds_twiddles((const float2*)(p.ws + OFF_TW), lds);
                for (int it = bid; it < BG * 256; it += G) hyena_conv_item(p, (const float*)(p.ws + OFF_UT), (bf16_t*)(p.ws + OFF_GT), it >> 8, it & 255, lds, twl, dry);
                __syncthreads();
                gla_scan(p, dry);
            }
            gbar(bar_ctr, bar_gen, G);
            {
                const Params p = fresh_params();
                for (int it = bid; it < NITEM; it += G) gla_part2_item(p, l, (bf16_t*)(p.ws + OFF_P), (const float*)(p.ws + OFF_LR), it, lds, dry);
            }
            {
                const Params p = fresh_params();
                for (int it = bid; it < BG * 128 * 8; it += G) hy_post_item((bf16_t*)(p.ws + OFF_P), (const bf16_t*)(p.ws + OFF_GT), it >> 10, (it >> 3) & 127, it & 7, lds, dry);
            }
            gbar(bar_ctr, bar_gen, G);
            }
            {
                const Params p = fresh_params();
                const bf16_t* P = (const bf16_t*)(p.ws + OFF_P); const bf16_t* WtBr = (const bf16_t*)(p.ws + OFF_WTBR); bf16_t* merged = (bf16_t*)(p.ws + OFF_MERGED);
                for (int t = bid; t < 512; t += G) {
                    const int m0 = (t >> 3) * 256, n0 = (t & 7) * 128;
                    f32x4 macc[4][4];
#pragma unroll
                    for (int mi = 0; mi < 4; ++mi)
#pragma unroll
                        for (int ni = 0; ni < 4; ++ni) macc[mi][ni] = (f32x4){0.f, 0.f, 0.f, 0.f};
#pragma unroll 1
                    for (int j = 0; j < 4; ++j) {
                        const int acol = (j == 0) ? C_NAQ : (j == 1) ? C_HY : (j == 2) ? C_GV : C_MQ;
                        f32x4 acc[4][4];
                        gemm_core(acc, P + (size_t)m0 * PS + acol, PS, WtBr + (size_t)j * 1024 * 512 + (size_t)n0 * 512, 512, 512, lds);
                        EPI_LOOP(macc[mi][ni] += ld_bf4(P + (size_t)row * PS + C_SG + 1024 * j + col) * v;)
                    }
                    {
                        f32x4 (&acc)[4][4] = macc;
                        EPI_LOOP(st_bf4(merged + (size_t)row * 1024 + col, v);)
                    }
                }
            }
            gbar(bar_ctr, bar_gen, G);
            {
                const Params p = fresh_params();
                pg8::Gemm gm; gm.A = (const bf16_t*)(p.ws + OFF_MERGED); gm.Bt = (const bf16_t*)(p.ws + OFF_WTOUT); gm.M = TG; gm.N = 1024; gm.K = 1024;
                pg8::StaticOrder S; S.init(TG, 1024, G, bid);
                EpiOut E; E.pre = (float*)(p.ws + OFF_PRE); E.bo = p.b_out + l * 1024; E.x = p.x; E.stats = (const float2*)(p.ws + OFF_STATS); E.g0 = p.ln_in_g; E.b0 = p.ln_in_b; E.hres = p.out; E.tok0 = tok0; E.l = l;
                pg8::gemm_phase<EpiOut, pg8::StaticOrder, false>((PG8_LAS unsigned char*)lds, gm, S, E, nullptr);
                __syncthreads();
            }
            gbar(bar_ctr, bar_gen, G);
            {
                const Params p = fresh_params();
                ln_rows((const float*)(p.ws + OFF_PRE), 0, TG, p.ln_g + l * 1024, p.ln_b + l * 1024, p.out, (bf16_t*)(p.ws + OFF_HB), tok0, nullptr);
            }
        }
        gbar(bar_ctr, bar_gen, G);
    }
}

extern "C" void kernel_launch(void* const* d_in, const int* in_sizes, int n_in, void* d_out, int out_size, void* d_ws, size_t ws_size, hipStream_t stream) {
    static int grid_blocks = 0;
    if (!grid_blocks) {
        if (ws_size < WS_END) { fprintf(stderr, "kernel_launch: workspace too small: %zu < %zu\n", ws_size, (size_t)WS_END); grid_blocks = -1; return; }
        {
            const long long ex[26] = {67108864LL, 2097152LL, 1024, 1024, 2LL * 1024 * 10784, 2 * 10784, 2 * 8 * 15 * 31, 2 * 3 * 1536, 2 * 1536, 2 * 33 * 64, 2 * 64, 2 * 2 * 64 * 64, 2 * 2 * 64,
                                      2 * 64 * 1024, 2 * 512, 2 * 16 * 256, 2 * 256, 2 * 16 * 256, 2 * 256, 2 * 512, 2LL * 1024 * 1024, 2LL * 4 * 512 * 1024, 2LL * 1024 * 1024, 2 * 1024, 2 * 1024, 2 * 1024};
            bool bad = (n_in != 26) || (out_size != 67108864);
            for (int i = 0; i < 26 && !bad; ++i) if ((long long)in_sizes[i] != ex[i]) { fprintf(stderr, "kernel_launch: input %d has %d elements, expected %lld\n", i, in_sizes[i], ex[i]); bad = true; }
            if (bad) { fprintf(stderr, "kernel_launch: unexpected shapes; nothing launched\n"); grid_blocks = -1; return; }
        }
        int dev = 0, cus = 0, per_cu = 0;
        hipGetDevice(&dev);
        hipDeviceGetAttribute(&cus, hipDeviceAttributeMultiprocessorCount, dev);
        if (hipFuncSetAttribute((const void*)mega, hipFuncAttributeMaxDynamicSharedMemorySize, LDS_BYTES) != hipSuccess) fprintf(stderr, "kernel_launch: hipFuncSetAttribute failed\n");
        if (hipOccupancyMaxActiveBlocksPerMultiprocessor(&per_cu, (const void*)mega, NTHR, LDS_BYTES) != hipSuccess || per_cu < 1) { fprintf(stderr, "kernel_launch: occupancy query gave %d\n", per_cu); per_cu = 1; }
        (void)hipGetLastError();
        if (per_cu > 1) per_cu = 1;
        grid_blocks = cus * per_cu;
    }
    if (grid_blocks < 0) return;
    Params p{};
    const float** pp = (const float**)&p;
    for (int i = 0; i < 26; ++i) pp[i] = (const float*)d_in[i];
    p.out = (float*)d_out; p.ws = (unsigned char*)d_ws;
    if (hipMemsetAsync((unsigned char*)d_ws + OFF_BAR, 0, 256, stream) != hipSuccess) fprintf(stderr, "kernel_launch: memset of the barrier word failed\n");
    void* args[] = {&p};
    hipError_t e = hipLaunchCooperativeKernel((const void*)mega, dim3(grid_blocks), dim3(NTHR), args, LDS_BYTES, stream);
    if (e != hipSuccess) fprintf(stderr, "cooperative launch failed: %s (grid %d)\n", hipGetErrorString(e), grid_blocks);
}
#endif
```

```cpp
#ifndef PROBE_REP_MIX
#define PROBE_REP_MIX 1
#endif
#ifndef PROBE_REP_INPROJ
#define PROBE_REP_INPROJ 1
#endif
#include <hip/hip_runtime.h>
#include <hip/hip_cooperative_groups.h>
#include <cstdio>
#include <unistd.h>
#include <cmath>
namespace cg = cooperative_groups;

#define HD __host__ __device__
typedef unsigned short bf16_t;
typedef short bf16x8 __attribute__((ext_vector_type(8)));
typedef float f32x4 __attribute__((ext_vector_type(4)));
typedef unsigned u32x2 __attribute__((ext_vector_type(2)));
typedef unsigned u32x4 __attribute__((ext_vector_type(4)));

constexpr int NTOK = 65536, DM = 1024, SEQ = 8192, NB = 8;
constexpr int BG = 2;
constexpr int NGRP = NB / BG;
constexpr int TG = BG * SEQ;
constexpr int PS = 10752;
constexpr int NIN = 10784, NINP = 11008;
constexpr int C_NAQ = 0, C_NAK = 512, C_NAV = 1024, C_HY = 1536, C_GQ = 3072, C_GK = 3328, C_GV = 3584, C_MQ = 4096, C_Z = 4608, C_SG = 6656, C_LR = 10752;
constexpr int FN = 16384;
constexpr int NITEM = BG * 128 * 4;
constexpr int LDS_BYTES = 160 * 1024;
constexpr int NTHR = 512;
constexpr float DN_ALPHA = 1.41421356237309515f;

constexpr size_t al256(size_t x) { return (x + 255) & ~(size_t)255; }
constexpr size_t OFF_HB = 0;
constexpr size_t OFF_STATS = OFF_HB + (size_t)NTOK * DM * 2;
constexpr size_t OFF_TW = OFF_STATS + (size_t)NTOK * 8;
constexpr size_t OFF_MEMBF = OFF_TW + (size_t)FN * 8;
constexpr size_t OFF_ENERGY = OFF_MEMBF + (size_t)2048 * 1024 * 2;
constexpr size_t OFF_WTIN = OFF_ENERGY + 4096;
constexpr size_t OFF_WTBR = OFF_WTIN + (size_t)NINP * 1024 * 2;
constexpr size_t OFF_WTOUT = OFF_WTBR + (size_t)4 * 1024 * 512 * 2;
constexpr size_t OFF_WTKV = OFF_WTOUT + (size_t)1024 * 1024 * 2;
constexpr size_t OFF_KMAT = OFF_WTKV + (size_t)2048 * 1024 * 2;
constexpr size_t OFF_VT = OFF_KMAT + (size_t)2048 * 1024 * 2;
constexpr size_t OFF_HFILT = OFF_VT + (size_t)2048 * 1024 * 2;
constexpr size_t OFF_PQ = OFF_HFILT + (size_t)1024 * 8192 * 4;
constexpr size_t OFF_P = OFF_PQ + (size_t)256 * FN * 16;
constexpr size_t OFF_LR = OFF_P + (size_t)TG * PS * 2;
constexpr size_t OFF_GS = OFF_LR + (size_t)TG * 32 * 4;
constexpr size_t OFF_GDEC = OFF_GS + (size_t)2 * NITEM * 8192 * 4;
constexpr size_t OFF_MERGED = OFF_GDEC + (size_t)2 * NITEM * 64 * 4;
constexpr size_t OFF_PRE = OFF_MERGED + (size_t)TG * 1024 * 2;
constexpr size_t OFF_UT = OFF_PRE + (size_t)TG * 1024 * 4;
constexpr size_t OFF_GT = OFF_UT + (size_t)BG * 512 * 8192 * 4;
constexpr size_t OFF_BAR = OFF_GT + (size_t)BG * 512 * 8192 * 2;
constexpr size_t OFF_ZT = OFF_BAR + 16384;
constexpr size_t WS_END = OFF_ZT + (size_t)8192 * 33 * 4;

struct Params {
    const float *x, *mem, *ln_in_g, *ln_in_b, *w_in, *b_in, *na_rpb, *hy_conv_w, *hy_conv_b, *hy_w1, *hy_b1, *hy_wm, *hy_bm, *hy_w3, *hy_skip,
        *gla_up_f, *gla_bias_f, *gla_up_b, *gla_bias_b, *gla_norm_g, *mem_w_kv, *w_br, *w_out, *b_out, *ln_g, *ln_b;
    float* out;
    unsigned char* ws;
};

HD inline float bf2f(bf16_t b) {
    union { unsigned u; float f; } c; c.u = (unsigned)b << 16; return c.f;
}
HD inline bf16_t f2bf(float f) {
    union { unsigned u; float f; } c; c.f = f; unsigned u = c.u; u += 0x7fffu + ((u >> 16) & 1u); return (bf16_t)(u >> 16);
}
__device__ __forceinline__ unsigned pk2(float lo, float hi) { return (unsigned)f2bf(lo) | ((unsigned)f2bf(hi) << 16); }
__device__ __forceinline__ float lo16(unsigned u) { return __uint_as_float(u << 16); }
__device__ __forceinline__ float hi16(unsigned u) { return __uint_as_float(u & 0xffff0000u); }
__device__ __forceinline__ float wave_sum(float v) {
#pragma unroll
    for (int o = 32; o >= 1; o >>= 1) v += __shfl_xor(v, o);
    return v;
}
__device__ __forceinline__ float sigmoidf_(float x) { return 1.0f / (1.0f + __expf(-x)); }
__device__ __forceinline__ float siluf_(float x) { return x / (1.0f + __expf(-x)); }
__device__ __forceinline__ float logsigf_(float x) { return fminf(x, 0.0f) - log1pf(expf(-fabsf(x))); }
__device__ __forceinline__ bf16x8 mkfrag(u32x4 v) { return __builtin_bit_cast(bf16x8, v); }
__device__ __forceinline__ bf16x8 mkfrag2(u32x2 a, u32x2 b) { u32x4 v = {a.x, a.y, b.x, b.y}; return __builtin_bit_cast(bf16x8, v); }
#define MFMA(a, b, c) __builtin_amdgcn_mfma_f32_16x16x32_bf16((a), (b), (c), 0, 0, 0)
HD inline int iclamp(int v, int lo, int hi) { return v < lo ? lo : (v > hi ? hi : v); }

HD inline float2 cmulf(float2 a, float2 b) { float2 r; r.x = a.x * b.x - a.y * b.y; r.y = a.x * b.y + a.y * b.x; return r; }
HD inline float2 cmulcf(float2 a, float2 b) { float2 r; r.x = a.x * b.x + a.y * b.y; r.y = a.y * b.x - a.x * b.y; return r; }
struct Bfly { float2 x0, x1, x2, x3, W1; int i0; };
HD inline void bfly_load(Bfly& b, const float2* d, const float2* tw, int lgm, int q) {
    const int m = 1 << lgm, blk = q >> lgm, j = q & (m - 1);
    b.i0 = (blk << (lgm + 2)) + j;
    b.W1 = tw[j];
    b.x0 = d[b.i0]; b.x1 = d[b.i0 + m]; b.x2 = d[b.i0 + 2 * m]; b.x3 = d[b.i0 + 3 * m];
}
HD inline void bfly_fwd_store(const Bfly& b, float2* d, int lgm) {
    const int m = 1 << lgm, i0 = b.i0;
    const float2 W1 = b.W1, W2 = cmulf(W1, W1);
    const float2 x0 = b.x0, x1 = b.x1, x2 = b.x2, x3 = b.x3;
    float2 a0, a1, a2, a3, t;
    a0.x = x0.x + x2.x; a0.y = x0.y + x2.y;
    t.x = x0.x - x2.x; t.y = x0.y - x2.y; a2 = cmulf(t, W1);
    a1.x = x1.x + x3.x; a1.y = x1.y + x3.y;
    t.x = x1.x - x3.x; t.y = x1.y - x3.y; t = cmulf(t, W1); a3.x = t.y; a3.y = -t.x;
    float2 r;
    r.x = a0.x + a1.x; r.y = a0.y + a1.y; d[i0] = r;
    t.x = a0.x - a1.x; t.y = a0.y - a1.y; d[i0 + m] = cmulf(t, W2);
    r.x = a2.x + a3.x; r.y = a2.y + a3.y; d[i0 + 2 * m] = r;
    t.x = a2.x - a3.x; t.y = a2.y - a3.y; d[i0 + 3 * m] = cmulf(t, W2);
}
HD inline void bfly_inv_store(const Bfly& b, float2* d, int lgm) {
    const int m = 1 << lgm, i0 = b.i0;
    const float2 W1 = b.W1, W2 = cmulf(W1, W1);
    const float2 x0 = b.x0, x1 = b.x1, x2 = b.x2, x3 = b.x3;
    const float2 b1 = cmulcf(x1, W2), b3 = cmulcf(x3, W2);
    float2 y0, y1, y2, y3;
    y0.x = x0.x + b1.x; y0.y = x0.y + b1.y; y1.x = x0.x - b1.x; y1.y = x0.y - b1.y;
    y2.x = x2.x + b3.x; y2.y = x2.y + b3.y; y3.x = x2.x - b3.x; y3.y = x2.y - b3.y;
    const float2 c2 = cmulcf(y2, W1); float2 c3 = cmulcf(y3, W1); { const float tx = -c3.y, ty = c3.x; c3.x = tx; c3.y = ty; }
    float2 r;
    r.x = y0.x + c2.x; r.y = y0.y + c2.y; d[i0] = r;
    r.x = y0.x - c2.x; r.y = y0.y - c2.y; d[i0 + 2 * m] = r;
    r.x = y1.x + c3.x; r.y = y1.y + c3.y; d[i0 + m] = r;
    r.x = y1.x - c3.x; r.y = y1.y - c3.y; d[i0 + 3 * m] = r;
}
HD inline void fft_fwd_bfly(float2* d, const float2* tw, int lgm, int q) { Bfly b; bfly_load(b, d, tw, lgm, q); bfly_fwd_store(b, d, lgm); }
HD inline void fft_inv_bfly(float2* d, const float2* tw, int lgm, int q) { Bfly b; bfly_load(b, d, tw, lgm, q); bfly_inv_store(b, d, lgm); }
HD inline int brev14(int k) {
    unsigned v = (unsigned)k;
    v = ((v >> 1) & 0x55555555u) | ((v & 0x55555555u) << 1);
    v = ((v >> 2) & 0x33333333u) | ((v & 0x33333333u) << 2);
    v = ((v >> 4) & 0x0f0f0f0fu) | ((v & 0x0f0f0f0fu) << 4);
    v = ((v >> 8) & 0x00ff00ffu) | ((v & 0x00ff00ffu) << 8);
    v = (v >> 16) | (v << 16);
    return (int)(v >> 18);
}
struct PwIn { float2 Z1, Z2; float4 A, B; int p1, p2; };
HD inline void pw_load(PwIn& w, const float2* d, const float4* pq, int kf) {
    const int k2 = (FN - kf) & (FN - 1); w.p1 = brev14(kf); w.p2 = brev14(k2);
    w.Z1 = d[w.p1]; w.Z2 = d[w.p2]; w.A = pq[w.p1]; w.B = pq[w.p2];
}
HD inline void pw_store(const PwIn& w, float2* d) {
    const float2 Z1 = w.Z1, Z2 = w.Z2;
    float2 P1, Q1, P2, Q2; P1.x = w.A.x; P1.y = w.A.y; Q1.x = w.A.z; Q1.y = w.A.w; P2.x = w.B.x; P2.y = w.B.y; Q2.x = w.B.z; Q2.y = w.B.w;
    float2 c1, c2; c1.x = Z1.x; c1.y = -Z1.y; c2.x = Z2.x; c2.y = -Z2.y;
    const float2 a = cmulf(Z1, P1), b = cmulf(c2, Q1), c = cmulf(Z2, P2), e = cmulf(c1, Q2);
    float2 w1, w2; w1.x = a.x + b.x; w1.y = a.y + b.y; w2.x = c.x + e.x; w2.y = c.y + e.y;
    d[w.p1] = w1;
    if (w.p2 != w.p1) d[w.p2] = w2;
}
HD inline void conv_pointwise(float2* d, const float4* pq, int kf) { PwIn w; pw_load(w, d, pq, kf); pw_store(w, d); }
HD inline void filt_pointwise(const float2* d, float4* pq, int kf) {
    const int k2 = (FN - kf) & (FN - 1), p1 = brev14(kf), p2 = brev14(k2);
    const float2 Z1 = d[p1], Z2 = d[p2];
    const float gcx = 0.5f * (Z1.x + Z2.x), gcy = 0.5f * (Z1.y - Z2.y);
    const float gdx = 0.5f * (Z1.y + Z2.y), gdy = -0.5f * (Z1.x - Z2.x);
    const float s = 0.5f / (float)FN;
    float4 A; A.x = s * (gcx + gdx); A.y = s * (gcy + gdy); A.z = s * (gcx - gdx); A.w = s * (gcy - gdy);
    pq[p1] = A;
    float4 B; B.x = A.x; B.y = -A.y; B.z = A.z; B.w = -A.w;
    if (p2 != p1) pq[p2] = B;
}

HD inline int tw_off(int lgm) { return lgm == 10 ? 0 : lgm == 8 ? 1024 : lgm == 6 ? 1280 : lgm == 4 ? 1344 : lgm == 2 ? 1360 : 1364; }
#ifndef FFT_HOST_TEST
template <int LGM, bool INV>
__device__ __forceinline__ void fft_pass(float2* d, const float2* twl, const float2* twg, int tid) {
    const float2* tw = (LGM == 12) ? twg : twl + tw_off(LGM);
#pragma unroll
    for (int it = 0; it < 2; ++it) {
        const int q = tid + it * 4 * NTHR;
        Bfly b0, b1, b2, b3;
        bfly_load(b0, d, tw, LGM, q); bfly_load(b1, d, tw, LGM, q + NTHR); bfly_load(b2, d, tw, LGM, q + 2 * NTHR); bfly_load(b3, d, tw, LGM, q + 3 * NTHR);
        if (INV) { bfly_inv_store(b0, d, LGM); bfly_inv_store(b1, d, LGM); bfly_inv_store(b2, d, LGM); bfly_inv_store(b3, d, LGM); }
        else { bfly_fwd_store(b0, d, LGM); bfly_fwd_store(b1, d, LGM); bfly_fwd_store(b2, d, LGM); bfly_fwd_store(b3, d, LGM); }
    }
    __syncthreads();
}
__device__ __forceinline__ void fft_forward(float2* d, const float2* twl, const float2* twg) {
    int tid = threadIdx.x; asm volatile("" : "+v"(tid));
    fft_pass<12, false>(d, twl, twg, tid); fft_pass<10, false>(d, twl, twg, tid); fft_pass<8, false>(d, twl, twg, tid); fft_pass<6, false>(d, twl, twg, tid);
    fft_pass<4, false>(d, twl, twg, tid); fft_pass<2, false>(d, twl, twg, tid); fft_pass<0, false>(d, twl, twg, tid);
}
__device__ __forceinline__ void fft_inverse(float2* d, const float2* twl, const float2* twg) {
    int tid = threadIdx.x; asm volatile("" : "+v"(tid));
    fft_pass<0, true>(d, twl, twg, tid); fft_pass<2, true>(d, twl, twg, tid); fft_pass<4, true>(d, twl, twg, tid); fft_pass<6, true>(d, twl, twg, tid);
    fft_pass<8, true>(d, twl, twg, tid); fft_pass<10, true>(d, twl, twg, tid); fft_pass<12, true>(d, twl, twg, tid);
}
__device__ __forceinline__ float2* fft_lds_twiddles(const float2* twg, unsigned char* lds) {
    int tid = threadIdx.x; asm volatile("" : "+v"(tid));
    float2* t = (float2*)(lds + 131072);
    for (int k = tid; k < 1365; k += NTHR) {
        const int lgm = k < 1024 ? 10 : k < 1280 ? 8 : k < 1344 ? 6 : k < 1360 ? 4 : k < 1364 ? 2 : 0;
        t[k] = twg[(k - tw_off(lgm)) << (12 - lgm)];
    }
    __syncthreads();
    return t;
}

constexpr int STG = 49152;
__device__ __forceinline__ int swz(int row, int ch) { return row * 128 + ((ch ^ ((row >> 1) & 7)) << 4); }
__device__ __forceinline__ void gemm_core(f32x4 (&acc)[4][4], const bf16_t* A, int lda, const bf16_t* Bt, int ldb, int K, unsigned char* lds) {
    int tid_ = threadIdx.x; asm volatile("" : "+v"(tid_)); const int tid = tid_, lane = tid & 63, w = tid >> 6, wm = w & 3, wn = w >> 2, l15 = lane & 15, q4 = lane >> 4;
    const int crow = tid >> 3, cch = tid & 7;
    u32x4 ra[4], rb[2];
#pragma unroll
    for (int mi = 0; mi < 4; ++mi)
#pragma unroll
        for (int ni = 0; ni < 4; ++ni) acc[mi][ni] = (f32x4){0.f, 0.f, 0.f, 0.f};
    const bf16_t* ap = A + (size_t)crow * lda + cch * 8;
    const bf16_t* bp = Bt + (size_t)crow * ldb + cch * 8;
#pragma unroll
    for (int i = 0; i < 4; ++i) ra[i] = *(const u32x4*)(ap + (size_t)(64 * i) * lda);
#pragma unroll
    for (int i = 0; i < 2; ++i) rb[i] = *(const u32x4*)(bp + (size_t)(64 * i) * ldb);
#pragma unroll
    for (int i = 0; i < 4; ++i) *(u32x4*)(lds + swz(crow + 64 * i, cch)) = ra[i];
#pragma unroll
    for (int i = 0; i < 2; ++i) *(u32x4*)(lds + 32768 + swz(crow + 64 * i, cch)) = rb[i];
    __syncthreads();
    const int nk = K >> 6;
    for (int kt = 0; kt < nk; ++kt) {
        if (kt + 1 < nk) {
            const int k0 = (kt + 1) << 6;
#pragma unroll
            for (int i = 0; i < 4; ++i) ra[i] = *(const u32x4*)(ap + (size_t)(64 * i) * lda + k0);
#pragma unroll
            for (int i = 0; i < 2; ++i) rb[i] = *(const u32x4*)(bp + (size_t)(64 * i) * ldb + k0);
        }
        const unsigned char* sa = lds + (kt & 1) * STG;
        const unsigned char* sb = sa + 32768;
#pragma unroll
        for (int ks = 0; ks < 2; ++ks) {
            bf16x8 af[4], bfr[4];
#pragma unroll
            for (int mi = 0; mi < 4; ++mi) af[mi] = *(const bf16x8*)(sa + swz(wm * 64 + mi * 16 + l15, ks * 4 + q4));
#pragma unroll
            for (int ni = 0; ni < 4; ++ni) bfr[ni] = *(const bf16x8*)(sb + swz(wn * 64 + ni * 16 + l15, ks * 4 + q4));
#pragma unroll
            for (int mi = 0; mi < 4; ++mi)
#pragma unroll
                for (int ni = 0; ni < 4; ++ni) acc[mi][ni] = MFMA(bfr[ni], af[mi], acc[mi][ni]);
        }
        if (kt + 1 < nk) {
            unsigned char* da = lds + ((kt + 1) & 1) * STG;
#pragma unroll
            for (int i = 0; i < 4; ++i) *(u32x4*)(da + swz(crow + 64 * i, cch)) = ra[i];
#pragma unroll
            for (int i = 0; i < 2; ++i) *(u32x4*)(da + 32768 + swz(crow + 64 * i, cch)) = rb[i];
        }
        __syncthreads();
    }
}
#define EPI_LOOP(body)                                                                                                  \
    {                                                                                                                   \
        int e_t = threadIdx.x; asm volatile("" : "+v"(e_t)); const int e_lane = e_t & 63, e_w = e_t >> 6;                                                    \
        _Pragma("unroll") for (int mi = 0; mi < 4; ++mi) _Pragma("unroll") for (int ni = 0; ni < 4; ++ni) {             \
            const int row = m0 + (e_w & 3) * 64 + mi * 16 + (e_lane & 15);                                              \
            const int col = n0 + (e_w >> 2) * 64 + ni * 16 + 4 * (e_lane >> 4);                                         \
            f32x4& v = acc[mi][ni];                                                                                     \
            body                                                                                                        \
        }                                                                                                               \
    }
__device__ __forceinline__ void st_bf4(bf16_t* dst, f32x4 v) {
    u32x2 o; o.x = pk2(v[0], v[1]); o.y = pk2(v[2], v[3]); *(u32x2*)dst = o;
}
__device__ __forceinline__ f32x4 ld_bf4(const bf16_t* src) {
    const u32x2 u = *(const u32x2*)src; f32x4 r = {lo16(u.x), hi16(u.x), lo16(u.y), hi16(u.y)}; return r;
}

__device__ __forceinline__ int orig_col(int n) {
    if (n < 4096) return n;
    if (n < 4608) return n + 32;
    if (n < 6656) return n + 32;
    if (n < 10752) return n + 32;
    return n - 10752 + 4096;
}

__device__ __forceinline__ void ln_rows(const float* src, size_t src_row0, int nrows, const float* g, const float* b, float* dst32, bf16_t* dst16, size_t dst_row0, float2* stats) {
    int tid_ = threadIdx.x; asm volatile("" : "+v"(tid_));
    const int lane = tid_ & 63;
    const int gw = blockIdx.x * (NTHR / 64) + (tid_ >> 6), nw = gridDim.x * (NTHR / 64);
    for (int r = gw; r < nrows; r += nw) {
        const float4* xr = (const float4*)(src + (src_row0 + r) * 1024);
        float4 v[4]; float s = 0.f;
#pragma unroll
        for (int i = 0; i < 4; ++i) { v[i] = xr[lane + 64 * i]; s += (v[i].x + v[i].y) + (v[i].z + v[i].w); }
        s = wave_sum(s);
        const float mean = s * (1.0f / 1024.0f);
        float q = 0.f;
#pragma unroll
        for (int i = 0; i < 4; ++i) { const float a = v[i].x - mean, bb = v[i].y - mean, c = v[i].z - mean, d = v[i].w - mean; q += (a * a + bb * bb) + (c * c + d * d); }
        q = wave_sum(q);
        const float rstd = 1.0f / sqrtf(q * (1.0f / 1024.0f) + 1e-5f);
        if (stats && lane == 0) { float2 st; st.x = mean; st.y = rstd; stats[dst_row0 + r] = st; }
#pragma unroll
        for (int i = 0; i < 4; ++i) {
            const float4 g4 = ((const float4*)g)[lane + 64 * i], b4 = ((const float4*)b)[lane + 64 * i];
            float4 y; y.x = (v[i].x - mean) * rstd * g4.x + b4.x; y.y = (v[i].y - mean) * rstd * g4.y + b4.y; y.z = (v[i].z - mean) * rstd * g4.z + b4.z; y.w = (v[i].w - mean) * rstd * g4.w + b4.w;
            if (dst32) ((float4*)(dst32 + (dst_row0 + r) * 1024))[lane + 64 * i] = y;
            if (dst16) { u32x2 o; o.x = pk2(y.x, y.y); o.y = pk2(y.z, y.w); *(u32x2*)(dst16 + (dst_row0 + r) * 1024 + (lane + 64 * i) * 4) = o; }
        }
    }
}
__device__ __forceinline__ void phase0(const Params& p) {
    ln_rows(p.x, 0, NTOK, p.ln_in_g, p.ln_in_b, nullptr, (bf16_t*)(p.ws + OFF_HB), 0, (float2*)(p.ws + OFF_STATS));
    int tid_ = threadIdx.x; asm volatile("" : "+v"(tid_)); const int gt = blockIdx.x * NTHR + tid_, nt = gridDim.x * NTHR;
    float2* tw = (float2*)(p.ws + OFF_TW);
    for (int k = gt; k < FN; k += nt) { double s, c; sincospi(-2.0 * (double)k / (double)FN, &s, &c); float2 t; t.x = (float)c; t.y = (float)s; tw[k] = t; }
    bf16_t* mb = (bf16_t*)(p.ws + OFF_MEMBF);
    for (int i = gt; i < 2048 * 1024 / 4; i += nt) { const float4 v = ((const float4*)p.mem)[i]; u32x2 o; o.x = pk2(v.x, v.y); o.y = pk2(v.z, v.w); ((u32x2*)mb)[i] = o; }
    float* en = (float*)(p.ws + OFF_ENERGY);
    for (int i = gt; i < 1024; i += nt) en[i] = 0.f;
    float* ztab = (float*)(p.ws + OFF_ZT);
    for (int idx = gt; idx < 8192 * 33; idx += nt) {
        const int n = idx / 33, e = idx - n * 33;
        float v;
        if (e == 0) v = (float)n / 8191.0f;
        else {
            const int i = (e - 1) & 15;
            const double fr = 1e-4 + (double)i * ((15.0 - 1e-4) / 15.0);
            const double ang = (2.0 * 3.14159265358979323846 / 8192.0) * (double)n * fr;
            v = (e <= 16) ? (float)cos(ang) : (float)(-sin(ang));
        }
        ztab[idx] = v;
    }
}

__device__ __forceinline__ void wt_tile(const float* src, int src_ld, int k0, int on0, bf16_t* dst, int dst_ld, int dn0, bool zero, float* tile) {
    int tid_ = threadIdx.x; asm volatile("" : "+v"(tid_)); const int tid = tid_;
    if (!zero) {
#pragma unroll
        for (int i = 0; i < 2; ++i) {
            const int k = (tid >> 3) + 64 * i, c4 = (tid & 7) * 4;
            const float4 v = *(const float4*)(src + (size_t)(k0 + k) * src_ld + on0 + c4);
            float* t = tile + k * 33 + c4; t[0] = v.x; t[1] = v.y; t[2] = v.z; t[3] = v.w;
        }
    }
    __syncthreads();
    const int n = tid >> 4, kc = (tid & 15) * 8;
    float f[8];
#pragma unroll
    for (int e = 0; e < 8; ++e) f[e] = zero ? 0.f : tile[(kc + e) * 33 + n];
    u32x4 o; o.x = pk2(f[0], f[1]); o.y = pk2(f[2], f[3]); o.z = pk2(f[4], f[5]); o.w = pk2(f[6], f[7]);
    *(u32x4*)(dst + (size_t)(dn0 + n) * dst_ld + k0 + kc) = o;
    __syncthreads();
}
__device__ __forceinline__ void phase_weights(const Params& p, int l, unsigned char* lds) {
    float* tile = (float*)lds;
    for (int it = blockIdx.x; it < 3776; it += gridDim.x) {
        if (it < 2752) {
            const int nt = it >> 3, kt = it & 7, dn0 = nt * 32;
            wt_tile(p.w_in + (size_t)l * 1024 * NIN, NIN, kt * 128, orig_col(dn0), (bf16_t*)(p.ws + OFF_WTIN), 1024, dn0, dn0 >= NIN, tile);
        } else if (it < 3264) {
            const int r = it - 2752, j = r >> 7, nt = (r >> 2) & 31, kt = r & 3;
            wt_tile(p.w_br + (size_t)(l * 4 + j) * 512 * 1024, 1024, kt * 128, nt * 32, (bf16_t*)(p.ws + OFF_WTBR) + (size_t)j * 1024 * 512, 512, nt * 32, false, tile);
        } else if (it < 3520) {
            const int r = it - 3264, nt = r >> 3, kt = r & 7;
            wt_tile(p.w_out + (size_t)l * 1024 * 1024, 1024, kt * 128, nt * 32, (bf16_t*)(p.ws + OFF_WTOUT), 1024, nt * 32, false, tile);
        } else {
            const int r = it - 3520, nt = r >> 3, kt = r & 7;
            wt_tile(p.mem_w_kv + (size_t)l * 1024 * 1024, 1024, kt * 128, nt * 32, (bf16_t*)(p.ws + OFF_WTKV), 1024, nt * 32, false, tile);
        }
    }
}

__device__ __forceinline__ void phase_filter_gen(const Params& p, int l, unsigned char* lds) {
    float* zt = (float*)lds;
    float* ha = zt + 32 * 33;
    float* hbuf = ha + 32 * 64;
    int tid_ = threadIdx.x; asm volatile("" : "+v"(tid_)); const int tid = tid_;
    const float* w1 = p.hy_w1 + (size_t)l * 33 * 64; const float* b1 = p.hy_b1 + l * 64;
    const float* wm = p.hy_wm + (size_t)l * 2 * 64 * 64; const float* bm = p.hy_bm + l * 2 * 64;
    const float* w3 = p.hy_w3 + (size_t)l * 64 * 1024;
    float* hf = (float*)(p.ws + OFF_HFILT);
    float* en = (float*)(p.ws + OFF_ENERGY) + l * 512;
    const float* ztab = (const float*)(p.ws + OFF_ZT);
    for (int it = blockIdx.x; it < 256; it += gridDim.x) {
        const int n0 = it * 32;
        for (int idx = tid; idx < 32 * 33; idx += NTHR) zt[idx] = ztab[(size_t)n0 * 33 + idx];
        __syncthreads();
        for (int idx = tid; idx < 2048; idx += NTHR) {
            const int pos = idx >> 6, j = idx & 63; float s = b1[j];
            for (int e = 0; e < 33; ++e) s += zt[pos * 33 + e] * w1[e * 64 + j];
            ha[idx] = sinf(s);
        }
        __syncthreads();
        for (int idx = tid; idx < 2048; idx += NTHR) {
            const int pos = idx >> 6, j = idx & 63; float s = bm[j];
            for (int e = 0; e < 64; ++e) s += ha[pos * 64 + e] * wm[e * 64 + j];
            hbuf[idx] = sinf(s);
        }
        __syncthreads();
        for (int idx = tid; idx < 2048; idx += NTHR) {
            const int pos = idx >> 6, j = idx & 63; float s = bm[64 + j];
            for (int e = 0; e < 64; ++e) s += hbuf[pos * 64 + e] * wm[4096 + e * 64 + j];
            ha[idx] = sinf(s);
        }
        __syncthreads();
        {
            const int c = tid;
            float af[32], ab[32];
#pragma unroll
            for (int i = 0; i < 32; ++i) { af[i] = 0.f; ab[i] = 0.f; }
            for (int k = 0; k < 64; ++k) {
                const float wf = w3[k * 1024 + c], wb = w3[k * 1024 + 512 + c];
#pragma unroll
                for (int i = 0; i < 32; ++i) { const float h = ha[i * 64 + k]; af[i] += h * wf; ab[i] += h * wb; }
            }
            const float dmin = -3.0701134573253945f, dmax = -15.350567286626973f;
            const float delta = fabsf(dmin + (float)c * ((dmax - dmin) / 511.0f));
            float e = 0.f;
#pragma unroll
            for (int i = 0; i < 32; ++i) {
                const int n = n0 + i; const float t01 = (float)n / 8191.0f; const float win = expf(-t01 * delta);
                af[i] *= win; ab[i] *= win; e += af[i] * af[i]; if (n >= 1) e += ab[i] * ab[i];
            }
#pragma unroll
            for (int i = 0; i < 8; ++i) {
                float4 a; a.x = af[4 * i]; a.y = af[4 * i + 1]; a.z = af[4 * i + 2]; a.w = af[4 * i + 3];
                float4 b; b.x = ab[4 * i]; b.y = ab[4 * i + 1]; b.z = ab[4 * i + 2]; b.w = ab[4 * i + 3];
                *(float4*)(hf + (size_t)c * 8192 + n0 + 4 * i) = a;
                *(float4*)(hf + (size_t)(512 + c) * 8192 + n0 + 4 * i) = b;
            }
            atomicAdd(en + c, e);
        }
        __syncthreads();
    }
}

__device__ __forceinline__ void phase_filter_fft(const Params& p, int l, unsigned char* lds) {
    float2* d = (float2*)lds;
    const float2* tw = fft_lds_twiddles((const float2*)(p.ws + OFF_TW), lds);
    const float* hf = (const float*)(p.ws + OFF_HFILT);
    const float* en = (const float*)(p.ws + OFF_ENERGY) + l * 512;
    float4* pqa = (float4*)(p.ws + OFF_PQ);
    int tid_ = threadIdx.x; asm volatile("" : "+v"(tid_)); const int tid = tid_;
    for (int pr = blockIdx.x; pr < 256; pr += gridDim.x) {
        const int c0 = 2 * pr, c1 = c0 + 1;
        const float s0 = 1.0f / sqrtf(en[c0] + 1e-6f), s1 = 1.0f / sqrtf(en[c1] + 1e-6f);
        const float k0 = p.hy_skip[l * 512 + c0], k1 = p.hy_skip[l * 512 + c1];
        for (int n = tid; n < FN; n += NTHR) {
            float2 v;
            if (n < 8192) { v.x = hf[(size_t)c0 * 8192 + n] * s0; v.y = hf[(size_t)c1 * 8192 + n] * s1; if (n == 0) { v.x += k0; v.y += k1; } }
            else if (n == 8192) { v.x = 0.f; v.y = 0.f; }
            else { v.x = hf[(size_t)(512 + c0) * 8192 + (FN - n)] * s0; v.y = hf[(size_t)(512 + c1) * 8192 + (FN - n)] * s1; }
            d[n] = v;
        }
        __syncthreads();
        fft_forward(d, tw, (const float2*)(p.ws + OFF_TW));
        for (int kf = tid; kf <= FN / 2; kf += NTHR) filt_pointwise(d, pqa + (size_t)pr * FN, kf);
        __syncthreads();
    }
}

__device__ __forceinline__ void hy_pre_item(const Params& p, int l, const bf16_t* P, float* UT, bf16_t* GT, int bl, int tt, int ct, unsigned char* lds) {
    float* tU = (float*)lds;
    float* tG = tU + 64 * 65;
    int tid_ = threadIdx.x; asm volatile("" : "+v"(tid_)); const int tid = tid_;
    const int t = tid >> 3, cc = (tid & 7) * 8, c = ct * 64 + cc, tb = tt * 64 + t;
    const float* cw = p.hy_conv_w + (size_t)l * 3 * 1536; const float* cb = p.hy_conv_b + l * 1536;
    float av[8], a0[8], a1[8];
#pragma unroll
    for (int h = 0; h < 2; ++h) {
        const f32x4 bv = *(const f32x4*)(cb + c + 4 * h), b0 = *(const f32x4*)(cb + 512 + c + 4 * h), b1 = *(const f32x4*)(cb + 1024 + c + 4 * h);
#pragma unroll
        for (int e = 0; e < 4; ++e) { av[4 * h + e] = bv[e]; a0[4 * h + e] = b0[e]; a1[4 * h + e] = b1[e]; }
    }
#pragma unroll
    for (int j = 0; j < 3; ++j) {
        const int ts = tb + j - 1;
        if (ts >= 0 && ts < SEQ) {
            const bf16_t* row = P + (size_t)(bl * SEQ + ts) * PS + C_HY + c;
            const u32x4 rv = *(const u32x4*)row, r0 = *(const u32x4*)(row + 512), r1 = *(const u32x4*)(row + 1024);
#pragma unroll
            for (int h = 0; h < 2; ++h) {
                const f32x4 wv = *(const f32x4*)(cw + j * 1536 + c + 4 * h), w0 = *(const f32x4*)(cw + j * 1536 + 512 + c + 4 * h), w1 = *(const f32x4*)(cw + j * 1536 + 1024 + c + 4 * h);
#pragma unroll
                for (int e = 0; e < 4; ++e) {
                    const int k = 4 * h + e; const unsigned uv = rv[k >> 1], u0 = r0[k >> 1], u1 = r1[k >> 1];
                    av[k] += wv[e] * ((k & 1) ? hi16(uv) : lo16(uv)); a0[k] += w0[e] * ((k & 1) ? hi16(u0) : lo16(u0)); a1[k] += w1[e] * ((k & 1) ? hi16(u1) : lo16(u1));
                }
            }
        }
    }
    const u32x4 rz = *(const u32x4*)(P + (size_t)(bl * SEQ + tb) * PS + C_Z + 512 + c);
#pragma unroll
    for (int k = 0; k < 8; ++k) {
        const unsigned uz = rz[k >> 1]; const float z = (k & 1) ? hi16(uz) : lo16(uz);
        tU[(cc + k) * 65 + t] = av[k] * a1[k]; tG[(cc + k) * 65 + t] = a0[k] * z;
    }
    __syncthreads();
    const int c2 = tid >> 3, t8 = (tid & 7) * 8;
    const size_t o = (size_t)(bl * 512 + ct * 64 + c2) * SEQ + tt * 64 + t8;
    const float* su = tU + c2 * 65 + t8; const float* sg = tG + c2 * 65 + t8;
    f32x4 ua = {su[0], su[1], su[2], su[3]}, ub = {su[4], su[5], su[6], su[7]};
    *(f32x4*)(UT + o) = ua; *(f32x4*)(UT + o + 4) = ub;
    u32x4 g; g.x = pk2(sg[0], sg[1]); g.y = pk2(sg[2], sg[3]); g.z = pk2(sg[4], sg[5]); g.w = pk2(sg[6], sg[7]);
    *(u32x4*)(GT + o) = g;
    __syncthreads();
}
__device__ __forceinline__ void hy_post_item(bf16_t* P, const bf16_t* GT, int bl, int tt, int ct, unsigned char* lds, int dry = 0) {
    bf16_t* tl = (bf16_t*)lds;
    int tid_ = threadIdx.x; asm volatile("" : "+v"(tid_)); const int tid = tid_;
    const int c2 = tid >> 3, t8 = (tid & 7) * 8;
    const u32x4 v = *(const u32x4*)(GT + (size_t)(bl * 512 + ct * 64 + c2) * SEQ + tt * 64 + t8);
    bf16_t* d0 = tl + t8 * 72 + c2;
    d0[0 * 72] = (bf16_t)(v.x & 0xffffu); d0[1 * 72] = (bf16_t)(v.x >> 16); d0[2 * 72] = (bf16_t)(v.y & 0xffffu); d0[3 * 72] = (bf16_t)(v.y >> 16);
    d0[4 * 72] = (bf16_t)(v.z & 0xffffu); d0[5 * 72] = (bf16_t)(v.z >> 16); d0[6 * 72] = (bf16_t)(v.w & 0xffffu); d0[7 * 72] = (bf16_t)(v.w >> 16);
    __syncthreads();
    const int t = tid >> 3, cc = (tid & 7) * 8;
    const u32x4 ov = *(const u32x4*)(tl + t * 72 + cc);
    if (!dry) *(u32x4*)(P + (size_t)(bl * SEQ + tt * 64 + t) * PS + C_HY + ct * 64 + cc) = ov;
    __syncthreads();
}
__device__ __forceinline__ void hyena_conv_item(const Params& p, const float* UT, bf16_t* GT, int bl, int pr, unsigned char* lds, const float2* tw, int dry = 0) {
    float2* d = (float2*)lds;
    const float4* pq = (const float4*)(p.ws + OFF_PQ) + (size_t)pr * FN;
    int tid_ = threadIdx.x; asm volatile("" : "+v"(tid_)); const int tid = tid_;
    const float* u0 = UT + (size_t)(bl * 512 + 2 * pr) * SEQ; const float* u1 = u0 + SEQ;
    bf16_t* g0 = GT + (size_t)(bl * 512 + 2 * pr) * SEQ; bf16_t* g1 = g0 + SEQ;
    {
        float f0[16], f1[16];
#pragma unroll
        for (int i = 0; i < 16; ++i) { f0[i] = u0[tid + NTHR * i]; f1[i] = u1[tid + NTHR * i]; }
#pragma unroll
        for (int i = 0; i < 16; ++i) {
            float2 u; u.x = f0[i]; u.y = f1[i]; d[tid + NTHR * i] = u;
            float2 z; z.x = 0.f; z.y = 0.f; d[tid + NTHR * i + SEQ] = z;
        }
    }
    __syncthreads();
    fft_forward(d, tw, (const float2*)(p.ws + OFF_TW));
#pragma unroll 1
    for (int kf = tid; kf < FN / 2; kf += 4 * NTHR) {
        PwIn w0, w1, w2, w3;
        pw_load(w0, d, pq, kf); pw_load(w1, d, pq, kf + NTHR); pw_load(w2, d, pq, kf + 2 * NTHR); pw_load(w3, d, pq, kf + 3 * NTHR);
        pw_store(w0, d); pw_store(w1, d); pw_store(w2, d); pw_store(w3, d);
    }
    if (tid == 0) conv_pointwise(d, pq, FN / 2);
    __syncthreads();
    fft_inverse(d, tw, (const float2*)(p.ws + OFF_TW));
    {
        bf16_t a0[16], a1[16];
#pragma unroll
        for (int i = 0; i < 16; ++i) { a0[i] = g0[tid + NTHR * i]; a1[i] = g1[tid + NTHR * i]; }
#pragma unroll
        for (int i = 0; i < 16; ++i) {
            const int t = tid + NTHR * i;
            const float2 y = d[t];
            const bf16_t r0 = f2bf(y.x * bf2f(a0[i])), r1 = f2bf(y.y * bf2f(a1[i]));
            if (!dry) { g0[t] = r0; g1[t] = r1; }
        }
    }
    __syncthreads();
}

__device__ __forceinline__ void na_item(const Params& p, int l, bf16_t* P, int bl, int rp, int head, unsigned char* lds, int dry = 0) {
    bf16_t* Kimg = (bf16_t*)lds;
    bf16_t* VT = (bf16_t*)(lds + 82944);
    int tid_ = threadIdx.x; asm volatile("" : "+v"(tid_)); const int tid = tid_, lane = tid & 63, w = tid >> 6, l15 = lane & 15, q4 = lane >> 4;
    const int r0 = 2 * rp, rs0 = iclamp(r0 - 4, 0, 120);
#pragma unroll 3
    for (int i = 0; i < 9; ++i) {
        const int idx = tid + NTHR * i, key = idx >> 3, ch = idx & 7, grow = min(rs0 + (key >> 6), 127);
        const u32x4 kv = *(const u32x4*)(P + (size_t)(bl * SEQ + grow * 64 + (key & 63)) * PS + C_NAK + head * 64 + ch * 8);
        *(u32x4*)(Kimg + key * 72 + ch * 8) = kv;
    }
#pragma unroll 3
    for (int i = 0; i < 9; ++i) {
        const int idx = tid + NTHR * i, keyp = idx >> 2, chh = keyp >= 576 ? 1 : 0, key = keyp - chh * 576, ch = chh * 4 + (idx & 3), grow = min(rs0 + (key >> 6), 127);
        const u32x4 vv = *(const u32x4*)(P + (size_t)(bl * SEQ + grow * 64 + (key & 63)) * PS + C_NAV + head * 64 + ch * 8);
        bf16_t* vd = VT + (ch * 8) * 584 + key;
        vd[0 * 584] = (bf16_t)(vv.x & 0xffffu); vd[1 * 584] = (bf16_t)(vv.x >> 16);
        vd[2 * 584] = (bf16_t)(vv.y & 0xffffu); vd[3 * 584] = (bf16_t)(vv.y >> 16);
        vd[4 * 584] = (bf16_t)(vv.z & 0xffffu); vd[5 * 584] = (bf16_t)(vv.z >> 16);
        vd[6 * 584] = (bf16_t)(vv.w & 0xffffu); vd[7 * 584] = (bf16_t)(vv.w >> 16);
    }
    __syncthreads();
    const int rr = w >> 2, g = w & 3, r = r0 + rr, rs = iclamp(r - 4, 0, 120), lo = rs - rs0;
    const int cb = iclamp(16 * g - 8, 0, 32), c = 16 * g + l15, cs = iclamp(c - 8, 0, 48);
    bf16_t* qrow = P + (size_t)(bl * SEQ + r * 64 + c) * PS + head * 64;
    bf16x8 qf[2];
#pragma unroll
    for (int ks = 0; ks < 2; ++ks) qf[ks] = *(const bf16x8*)(qrow + ks * 32 + q4 * 8);
    f32x4 sc[16];
#pragma unroll
    for (int t = 0; t < 16; ++t) {
        const int kb = (lo + (t >> 1)) * 64 + cb + 16 * (t & 1);
        f32x4 a = {0.f, 0.f, 0.f, 0.f};
#pragma unroll
        for (int ks = 0; ks < 2; ++ks) { const bf16x8 kf = *(const bf16x8*)(Kimg + (kb + l15) * 72 + ks * 32 + q4 * 8); a = MFMA(kf, qf[ks], a); }
        sc[t] = a;
    }
    const float* rpb = p.na_rpb + (size_t)(l * 8 + head) * 15 * 31;
    float mx = -1e30f;
#pragma unroll
    for (int t = 0; t < 16; ++t) {
        const int drow = rs + (t >> 1) - r + 7;
#pragma unroll
        for (int e = 0; e < 4; ++e) {
            const int col = cb + 16 * (t & 1) + 4 * q4 + e;
            const bool ok = (col >= cs) && (col < cs + 16);
            const int dcol = ok ? (col - c + 15) : 0;
            const float v = ok ? (sc[t][e] + rpb[drow * 31 + dcol]) : -1e30f;
            sc[t][e] = v; mx = fmaxf(mx, v);
        }
    }
    mx = fmaxf(mx, __shfl_xor(mx, 16)); mx = fmaxf(mx, __shfl_xor(mx, 32));
    float sum = 0.f;
#pragma unroll
    for (int t = 0; t < 16; ++t)
#pragma unroll
        for (int e = 0; e < 4; ++e) { const float pe = __expf(sc[t][e] - mx); sc[t][e] = pe; sum += pe; }
    sum += __shfl_xor(sum, 16); sum += __shfl_xor(sum, 32);
    f32x4 o[4];
#pragma unroll
    for (int dt = 0; dt < 4; ++dt) o[dt] = (f32x4){0.f, 0.f, 0.f, 0.f};
#pragma unroll
    for (int kk = 0; kk < 8; ++kk) {
        u32x4 pu; pu.x = pk2(sc[2 * kk][0], sc[2 * kk][1]); pu.y = pk2(sc[2 * kk][2], sc[2 * kk][3]); pu.z = pk2(sc[2 * kk + 1][0], sc[2 * kk + 1][1]); pu.w = pk2(sc[2 * kk + 1][2], sc[2 * kk + 1][3]);
        const bf16x8 pf = mkfrag(pu);
        const int kbA = (lo + kk) * 64 + cb + 4 * q4;
#pragma unroll
        for (int dt = 0; dt < 4; ++dt) {
            const bf16_t* vr = VT + (dt * 16 + l15) * 584 + kbA;
            const bf16x8 vf = mkfrag2(*(const u32x2*)vr, *(const u32x2*)(vr + 16));
            o[dt] = MFMA(vf, pf, o[dt]);
        }
    }
    const float inv = 1.0f / sum;
    const bf16_t* zrow = P + (size_t)(bl * SEQ + r * 64 + c) * PS + C_Z + head * 64;
#pragma unroll
    for (int dt = 0; dt < 4; ++dt) {
        const int dd = dt * 16 + 4 * q4;
        const f32x4 z = ld_bf4(zrow + dd);
        if (!dry) st_bf4(qrow + dd, o[dt] * inv * z);
    }
    __syncthreads();
}

__device__ __forceinline__ void memattn_load(const Params& p, int b, int h, unsigned char* lds) {
    bf16_t* Kimg = (bf16_t*)lds;
    bf16_t* VT = (bf16_t*)(lds + 69632);
    const bf16_t* Km = (const bf16_t*)(p.ws + OFF_KMAT); const bf16_t* Vm = (const bf16_t*)(p.ws + OFF_VT);
    int tid_ = threadIdx.x; asm volatile("" : "+v"(tid_)); const int tid = tid_;
#pragma unroll
    for (int i = 0; i < 8; ++i) {
        const int idx = tid + NTHR * i;
        { const int key = idx >> 4, ch = idx & 15; *(u32x4*)(Kimg + key * 136 + ch * 8) = *(const u32x4*)(Km + (size_t)(b * 256 + key) * 512 + h * 128 + ch * 8); }
        { const int dd = idx >> 5, ch = idx & 31; *(u32x4*)(VT + dd * 264 + ch * 8) = *(const u32x4*)(Vm + (size_t)(h * 128 + dd) * 2048 + b * 256 + ch * 8); }
    }
    __syncthreads();
}
__device__ __forceinline__ void memattn_item(bf16_t* P, int bl, int h, int qt, unsigned char* lds, int dry = 0) {
    const bf16_t* Kimg = (const bf16_t*)lds; const bf16_t* VT = (const bf16_t*)(lds + 69632);
    int tid_ = threadIdx.x; asm volatile("" : "+v"(tid_)); const int tid = tid_, lane = tid & 63, w = tid >> 6, l15 = lane & 15, q4 = lane >> 4;
    const int tok = bl * SEQ + qt * 128 + w * 16 + l15;
    bf16_t* qrow = P + (size_t)tok * PS + C_MQ + h * 128;
    bf16x8 qf[4];
#pragma unroll
    for (int ks = 0; ks < 4; ++ks) qf[ks] = *(const bf16x8*)(qrow + ks * 32 + q4 * 8);
    f32x4 sc[16];
    float mx = -1e30f;
#pragma unroll
    for (int t = 0; t < 16; ++t) {
        f32x4 a = {0.f, 0.f, 0.f, 0.f};
#pragma unroll
        for (int ks = 0; ks < 4; ++ks) { const bf16x8 kf = *(const bf16x8*)(Kimg + (t * 16 + l15) * 136 + ks * 32 + q4 * 8); a = MFMA(kf, qf[ks], a); }
        sc[t] = a;
        mx = fmaxf(mx, fmaxf(fmaxf(a[0], a[1]), fmaxf(a[2], a[3])));
    }
    mx = fmaxf(mx, __shfl_xor(mx, 16)); mx = fmaxf(mx, __shfl_xor(mx, 32));
    float sum = 0.f;
#pragma unroll
    for (int t = 0; t < 16; ++t)
#pragma unroll
        for (int e = 0; e < 4; ++e) { const float pe = __expf(sc[t][e] - mx); sc[t][e] = pe; sum += pe; }
    sum += __shfl_xor(sum, 16); sum += __shfl_xor(sum, 32);
    f32x4 o[8];
#pragma unroll
    for (int dt = 0; dt < 8; ++dt) o[dt] = (f32x4){0.f, 0.f, 0.f, 0.f};
#pragma unroll
    for (int kk = 0; kk < 8; ++kk) {
        u32x4 pu; pu.x = pk2(sc[2 * kk][0], sc[2 * kk][1]); pu.y = pk2(sc[2 * kk][2], sc[2 * kk][3]); pu.z = pk2(sc[2 * kk + 1][0], sc[2 * kk + 1][1]); pu.w = pk2(sc[2 * kk + 1][2], sc[2 * kk + 1][3]);
        const bf16x8 pf = mkfrag(pu);
#pragma unroll
        for (int dt = 0; dt < 8; ++dt) {
            const bf16_t* vr = VT + (dt * 16 + l15) * 264 + kk * 32 + 4 * q4;
            const bf16x8 vf = mkfrag2(*(const u32x2*)vr, *(const u32x2*)(vr + 16));
            o[dt] = MFMA(vf, pf, o[dt]);
        }
    }
    const float inv = 1.0f / sum;
    const bf16_t* zrow = P + (size_t)tok * PS + C_Z + 3 * 512 + h * 128;
#pragma unroll
    for (int dt = 0; dt < 8; ++dt) {
        const int dd = dt * 16 + 4 * q4;
        const f32x4 z = ld_bf4(zrow + dd);
        if (!dry) st_bf4(qrow + dd, o[dt] * inv * z);
    }
}

constexpr int G_LRT = 0, G_BF = 8192, G_BB = 24576, G_TOT = 40960, G_IMG = 45056;
__device__ __forceinline__ void gla_tables(const Params& p, int l, const float* LR, int t0, int h, unsigned char* lds) {
    float* LRT = (float*)(lds + G_LRT); float* BF = (float*)(lds + G_BF); float* BB = (float*)(lds + G_BB); float* TOT = (float*)(lds + G_TOT);
    int tid_ = threadIdx.x; asm volatile("" : "+v"(tid_)); const int tid = tid_;
    ((float4*)LRT)[tid] = ((const float4*)(LR + (size_t)t0 * 32))[tid];
    __syncthreads();
    const int dk = tid & 63, cgp = tid >> 6;
    float uf[16], ub[16];
#pragma unroll
    for (int r = 0; r < 16; ++r) { uf[r] = p.gla_up_f[(size_t)(l * 16 + r) * 256 + h * 64 + dk]; ub[r] = p.gla_up_b[(size_t)(l * 16 + r) * 256 + h * 64 + dk]; }
    const float bif = p.gla_bias_f[l * 256 + h * 64 + dk], bib = p.gla_bias_b[l * 256 + h * 64 + dk];
    float lf[8], lb[8];
#pragma unroll
    for (int i = 0; i < 8; ++i) {
        const int c = cgp * 8 + i; float sf = bif, sb = bib;
#pragma unroll
        for (int r = 0; r < 16; ++r) { sf += LRT[c * 32 + r] * uf[r]; sb += LRT[c * 32 + 16 + r] * ub[r]; }
        lf[i] = logsigf_(sf) * (1.0f / 16.0f); lb[i] = logsigf_(sb) * (1.0f / 16.0f);
    }
#pragma unroll
    for (int i = 1; i < 8; ++i) lf[i] += lf[i - 1];
#pragma unroll
    for (int i = 6; i >= 0; --i) lb[i] += lb[i + 1];
    TOT[cgp * 64 + dk] = lf[7]; TOT[512 + cgp * 64 + dk] = lb[0];
    __syncthreads();
    float of = 0.f, ob = 0.f;
#pragma unroll
    for (int g2 = 0; g2 < 8; ++g2) { if (g2 < cgp) of += TOT[g2 * 64 + dk]; if (g2 > cgp) ob += TOT[512 + g2 * 64 + dk]; }
#pragma unroll
    for (int i = 0; i < 8; ++i) { BF[(cgp * 8 + i) * 64 + dk] = lf[i] + of; BB[(cgp * 8 + i) * 64 + dk] = lb[i] + ob; }
    __syncthreads();
}
__device__ __forceinline__ void gla_vt(const bf16_t* P, int t0, int h, bf16_t* VT) {
    int tid_ = threadIdx.x; asm volatile("" : "+v"(tid_)); const int tid = tid_;
#pragma unroll
    for (int i = 0; i < 2; ++i) {
        const int idx = tid + NTHR * i, chn = idx >> 6, c = idx & 63;
        const u32x4 vv = *(const u32x4*)(P + (size_t)(t0 + c) * PS + C_GV + h * 128 + chn * 8);
        bf16_t* vd = VT + (chn * 8) * 72 + c;
        vd[0 * 72] = (bf16_t)(vv.x & 0xffffu); vd[1 * 72] = (bf16_t)(vv.x >> 16);
        vd[2 * 72] = (bf16_t)(vv.y & 0xffffu); vd[3 * 72] = (bf16_t)(vv.y >> 16);
        vd[4 * 72] = (bf16_t)(vv.z & 0xffffu); vd[5 * 72] = (bf16_t)(vv.z >> 16);
        vd[6 * 72] = (bf16_t)(vv.w & 0xffffu); vd[7 * 72] = (bf16_t)(vv.w >> 16);
    }
}
__device__ __forceinline__ void gla_part1_item(const Params& p, int l, const bf16_t* P, const float* LR, int item, unsigned char* lds) {
    const int h = item & 3, n = (item >> 2) & 127, bl = item >> 9, t0 = bl * SEQ + n * 64;
    const float* BF = (const float*)(lds + G_BF); const float* BB = (const float*)(lds + G_BB);
    bf16_t* KDT0 = (bf16_t*)(lds + G_IMG); bf16_t* KDT1 = KDT0 + 64 * 72; bf16_t* VT = KDT1 + 64 * 72;
    float* GS = (float*)(p.ws + OFF_GS); float* GD = (float*)(p.ws + OFF_GDEC);
    int tid_ = threadIdx.x; asm volatile("" : "+v"(tid_)); const int tid = tid_, lane = tid & 63, w = tid >> 6, l15 = lane & 15, q4 = lane >> 4;
    gla_tables(p, l, LR, t0, h, lds);
#pragma unroll
    for (int i = 0; i < 8; ++i) {
        const int idx = tid + NTHR * i, c = idx >> 6, dk = idx & 63;
        const float kv = bf2f(P[(size_t)(t0 + c) * PS + C_GK + h * 64 + dk]);
        KDT0[dk * 72 + c] = f2bf(kv * __expf(BF[63 * 64 + dk] - BF[c * 64 + dk]));
        KDT1[dk * 72 + c] = f2bf(kv * __expf(BB[dk] - BB[c * 64 + dk]));
    }
    gla_vt(P, t0, h, VT);
    if (tid < 64) GD[(size_t)item * 64 + tid] = __expf(BF[63 * 64 + tid]);
    else if (tid < 128) GD[(size_t)(NITEM + item) * 64 + tid - 64] = __expf(BB[tid - 64]);
    __syncthreads();
    const int dir = w >> 2, dkt = w & 3;
    const bf16_t* KD = dir ? KDT1 : KDT0;
    bf16x8 kf[2];
#pragma unroll
    for (int ks = 0; ks < 2; ++ks) kf[ks] = *(const bf16x8*)(KD + (16 * dkt + l15) * 72 + 32 * ks + 8 * q4);
    float* dst = GS + ((size_t)dir * NITEM + item) * 8192;
#pragma unroll
    for (int dvt = 0; dvt < 8; ++dvt) {
        f32x4 a = {0.f, 0.f, 0.f, 0.f};
#pragma unroll
        for (int ks = 0; ks < 2; ++ks) { const bf16x8 vf = *(const bf16x8*)(VT + (16 * dvt + l15) * 72 + 32 * ks + 8 * q4); a = MFMA(kf[ks], vf, a); }
        *(f32x4*)(dst + (16 * dvt + l15) * 64 + 16 * dkt + 4 * q4) = a;
    }
    __syncthreads();
}
__device__ __forceinline__ void gla_scan(const Params& p, int dry = 0) {
    float* GS = (float*)(p.ws + OFF_GS); const float* GD = (const float*)(p.ws + OFF_GDEC);
    const int total = 2 * BG * 4 * 8192;
    int tid_ = threadIdx.x; asm volatile("" : "+v"(tid_));
    for (int id = blockIdx.x * NTHR + tid_; id < total; id += gridDim.x * NTHR) {
        const int e = id & 8191, comb = id >> 13, h = comb & 3, bl = (comb >> 2) % BG, dir = comb / (4 * BG), dk = e & 63;
        float S = 0.f;
        const size_t ibase = (size_t)dir * NITEM + (size_t)(bl * 128) * 4 + h;
        for (int s0 = 0; s0 < 128; s0 += 16) {
            float u[16], dc[16];
#pragma unroll
            for (int i = 0; i < 16; ++i) {
                const int n = dir ? 127 - (s0 + i) : s0 + i;
                const size_t item = ibase + (size_t)n * 4;
                u[i] = GS[item * 8192 + e]; dc[i] = GD[item * 64 + dk];
            }
#pragma unroll
            for (int i = 0; i < 16; ++i) {
                const int n = dir ? 127 - (s0 + i) : s0 + i;
                const size_t item = ibase + (size_t)n * 4;
                if (!dry) GS[item * 8192 + e] = S;
                S = dc[i] * S + u[i];
            }
        }
    }
}
__device__ __forceinline__ void gla_part2_item(const Params& p, int l, bf16_t* P, const float* LR, int item, unsigned char* lds, int dry = 0) {
    const int h = item & 3, n = (item >> 2) & 127, bl = item >> 9, t0 = bl * SEQ + n * 64;
    const float* BF = (const float*)(lds + G_BF); const float* BB = (const float*)(lds + G_BB);
    bf16_t* QF = (bf16_t*)(lds + G_IMG);
    bf16_t* KF = QF + 2 * 64 * 72;
    bf16_t* QD = KF + 2 * 64 * 72;
    bf16_t* VT = QD + 2 * 64 * 72;
    bf16_t* ST = VT + 128 * 72;
    float* OX = (float*)lds;
    const float* GS = (const float*)(p.ws + OFF_GS);
    int tid_ = threadIdx.x; asm volatile("" : "+v"(tid_)); const int tid = tid_, lane = tid & 63, w = tid >> 6, l15 = lane & 15, q4 = lane >> 4;
    gla_tables(p, l, LR, t0, h, lds);
#pragma unroll
    for (int i = 0; i < 8; ++i) {
        const int idx = tid + NTHR * i, c = idx >> 6, dk = idx & 63;
        const float qv = bf2f(P[(size_t)(t0 + c) * PS + C_GQ + h * 64 + dk]);
        const float kv = bf2f(P[(size_t)(t0 + c) * PS + C_GK + h * 64 + dk]);
        const float bf = BF[c * 64 + dk], mf = BF[31 * 64 + dk], bb = BB[c * 64 + dk], mb = BB[32 * 64 + dk];
        QF[c * 72 + dk] = f2bf(qv * __expf(bf - mf)); KF[c * 72 + dk] = f2bf(kv * __expf(mf - bf)); QD[c * 72 + dk] = f2bf(qv * __expf(bf));
        QF[4608 + c * 72 + dk] = f2bf(qv * __expf(bb - mb)); KF[4608 + c * 72 + dk] = f2bf(kv * __expf(mb - bb)); QD[4608 + c * 72 + dk] = f2bf(qv * __expf(bb));
    }
    gla_vt(P, t0, h, VT);
#pragma unroll
    for (int dir = 0; dir < 2; ++dir) {
        const float* src = GS + ((size_t)dir * NITEM + item) * 8192;
#pragma unroll
        for (int i = 0; i < 4; ++i) {
            const int idx = tid + NTHR * i, dv = idx >> 4, dk4 = (idx & 15) * 4;
            const float4 s = *(const float4*)(src + dv * 64 + dk4);
            u32x2 o; o.x = pk2(s.x, s.y); o.y = pk2(s.z, s.w);
            *(u32x2*)(ST + dir * 9216 + dv * 72 + dk4) = o;
        }
    }
    __syncthreads();
    const int dir = w >> 2, ct = w & 3;
    const bf16_t* qfp = QF + dir * 4608; const bf16_t* kfp = KF + dir * 4608; const bf16_t* qdp = QD + dir * 4608; const bf16_t* stp = ST + dir * 9216;
    bf16x8 qf[2], qd[2];
#pragma unroll
    for (int ks = 0; ks < 2; ++ks) { qf[ks] = *(const bf16x8*)(qfp + (16 * ct + l15) * 72 + 32 * ks + 8 * q4); qd[ks] = *(const bf16x8*)(qdp + (16 * ct + l15) * 72 + 32 * ks + 8 * q4); }
    f32x4 sc[4];
    const int cq = 16 * ct + l15;
#pragma unroll
    for (int st = 0; st < 4; ++st) {
        f32x4 a = {0.f, 0.f, 0.f, 0.f};
#pragma unroll
        for (int ks = 0; ks < 2; ++ks) { const bf16x8 kf = *(const bf16x8*)(kfp + (16 * st + l15) * 72 + 32 * ks + 8 * q4); a = MFMA(kf, qf[ks], a); }
#pragma unroll
        for (int e = 0; e < 4; ++e) { const int s = 16 * st + 4 * q4 + e; const bool ok = dir ? (s > cq) : (s <= cq); a[e] = ok ? a[e] : 0.f; }
        sc[st] = a;
    }
    f32x4 o[8];
#pragma unroll
    for (int dt = 0; dt < 8; ++dt) o[dt] = (f32x4){0.f, 0.f, 0.f, 0.f};
#pragma unroll
    for (int kk = 0; kk < 2; ++kk) {
        u32x4 pu; pu.x = pk2(sc[2 * kk][0], sc[2 * kk][1]); pu.y = pk2(sc[2 * kk][2], sc[2 * kk][3]); pu.z = pk2(sc[2 * kk + 1][0], sc[2 * kk + 1][1]); pu.w = pk2(sc[2 * kk + 1][2], sc[2 * kk + 1][3]);
        const bf16x8 pf = mkfrag(pu);
#pragma unroll
        for (int dt = 0; dt < 8; ++dt) {
            const bf16_t* vr = VT + (dt * 16 + l15) * 72 + kk * 32 + 4 * q4;
            const bf16x8 vf = mkfrag2(*(const u32x2*)vr, *(const u32x2*)(vr + 16));
            o[dt] = MFMA(vf, pf, o[dt]);
        }
    }
#pragma unroll
    for (int ks = 0; ks < 2; ++ks)
#pragma unroll
        for (int dt = 0; dt < 8; ++dt) { const bf16x8 sf = *(const bf16x8*)(stp + (dt * 16 + l15) * 72 + 32 * ks + 8 * q4); o[dt] = MFMA(sf, qd[ks], o[dt]); }
    if (dir == 1) {
#pragma unroll
        for (int dt = 0; dt < 8; ++dt) *(f32x4*)(OX + cq * 132 + 16 * dt + 4 * q4) = o[dt];
    }
    __syncthreads();
    if (dir == 0) {
        float ss = 0.f;
#pragma unroll
        for (int dt = 0; dt < 8; ++dt) { o[dt] += *(const f32x4*)(OX + cq * 132 + 16 * dt + 4 * q4); ss += (o[dt][0] * o[dt][0] + o[dt][1] * o[dt][1]) + (o[dt][2] * o[dt][2] + o[dt][3] * o[dt][3]); }
        ss += __shfl_xor(ss, 16); ss += __shfl_xor(ss, 32);
        const float rms = 1.0f / sqrtf(ss * (1.0f / 128.0f) + 1e-6f);
        const float* ng = p.gla_norm_g + l * 512 + h * 128;
        const bf16_t* zrow = P + (size_t)(t0 + cq) * PS + C_Z + 2 * 512 + h * 128;
        bf16_t* orow = P + (size_t)(t0 + cq) * PS + C_GV + h * 128;
#pragma unroll
        for (int dt = 0; dt < 8; ++dt) {
            const int dd = 16 * dt + 4 * q4;
            const f32x4 z = ld_bf4(zrow + dd); const f32x4 g4 = *(const f32x4*)(ng + dd);
            if (!dry) st_bf4(orow + dd, o[dt] * rms * g4 * z);
        }
    }
    __syncthreads();
}

namespace pg8 {
#define PG8_LAS __attribute__((address_space(3)))
typedef unsigned short bf16_t;
typedef short bf16x8 __attribute__((ext_vector_type(8)));
typedef float f32x4 __attribute__((ext_vector_type(4)));
typedef unsigned u32x4 __attribute__((ext_vector_type(4)));
constexpr int BM = 256, BK = 64, HALF = 128, HTB = HALF * BK * 2  , STAGE_BYTES = 8 * HTB, NXCD = 8, WGM = 8;

__host__ __device__ __forceinline__ int lds_byte(int r, int c) { const int st = (r >> 4) * 2 + (c >> 5), rr = r & 15, cc = c & 31, ob = rr * 64 + cc * 2; return st * 1024 + (ob ^ (((ob >> 9) & 1) << 5)); }
__host__ __device__ __forceinline__ void stage_rc(int b, int& R, int& C) { const int st = b / 1024, sb = b % 1024, swz = sb ^ (((sb >> 9) & 1) << 5); R = (st >> 1) * 16 + swz / 64; C = (st & 1) * 32 + (swz % 64) / 2; }
__host__ __device__ __forceinline__ int perm32(int rho) { const int n = rho >> 4, i = rho & 15; return 8 * (i >> 2) + 4 * n + (i & 3); }

struct Unit { int pm, pn; };
struct Gemm { const bf16_t* A; const bf16_t* Bt; int M, N, K; };

struct StaticOrder {
    int nM, nN, nwg, G, c;
    __host__ __device__ __forceinline__ void init(int M, int N, int G_, int c_) { nM = M / BM; nN = N / BM; nwg = nM * nN; G = G_; c = c_; }
    __host__ __device__ bool next(int i, Unit& u) const {
        const long L = (long)i * G + c; if (L >= nwg) return false;
        int wgid = (int)L; { const int q = nwg / NXCD, r = nwg % NXCD, xcd = wgid % NXCD, off = wgid / NXCD; wgid = (xcd < r ? xcd * (q + 1) : r * (q + 1) + (xcd - r) * q) + off; }
        const int nig = WGM * nN, gid = wgid / nig, fm = gid * WGM, gsz = (nM - fm) < WGM ? (nM - fm) : WGM;
        u.pm = fm + ((wgid % nig) % gsz); u.pn = (wgid % nig) / gsz; return true;
    }
    __device__ __forceinline__ void a_ready(const Unit&) const {}
    __device__ __forceinline__ void done(const Unit&) const {}
};
__device__ __forceinline__ unsigned cvt_pk_bf16(float lo, float hi) { unsigned r; asm volatile("v_cvt_pk_bf16_f32 %0, %1, %2" : "=v"(r) : "v"(lo), "v"(hi)); return r; }
template <class Epi, class Sched, bool STAMP = false>
__device__ __forceinline__ void gemm_phase(PG8_LAS unsigned char* lds, const Gemm g, const Sched& S, const Epi& E, unsigned long long* stamps) {
    int tid_l = threadIdx.x; asm volatile("" : "+v"(tid_l)); const int tid = tid_l, wid = __builtin_amdgcn_readfirstlane(tid >> 6), lane = tid & 63, wr = wid >> 2, wc = wid & 3, fr = lane & 15, fq = lane >> 4;
    const int K = g.K, nt = K / BK;
    int ts_lo = 0, ts_hi = 0, nts = 0; const unsigned long long rt_entry = STAMP ? (unsigned long long)wall_clock64() : 0ull;
#define PG8_STAMP() do { if (STAMP && wid == 0 && nts < 64) { const unsigned long long _c = (unsigned long long)clock64(); \
        ts_lo = (lane == nts) ? (int)(unsigned)_c : ts_lo; ts_hi = (lane == nts) ? (int)(unsigned)(_c >> 32) : ts_hi; ++nts; } } while (0)
    PG8_STAMP();
    unsigned voffA[2], voffB[2];
#pragma unroll
    for (int i = 0; i < 2; ++i) { int R, C; stage_rc(tid * 16 + i * 8192, R, C); const int Rb = Epi::PERM ? ((R & ~31) + perm32(R & 31)) : R;
        voffA[i] = (unsigned)(R * K + C) * 2u; voffB[i] = (unsigned)(Rb * K + C) * 2u; }
    const size_t kstep = (size_t)(BK * 2);
    const size_t hstep = (size_t)HALF * K * 2;
    const size_t tstep = 2 * hstep;
    const unsigned ldsw = (unsigned)wid * 1024u;
    const int aoff = lds_byte(wr * 64 + fr, fq * 8), boff = lds_byte(wc * 32 + fr, fq * 8);
#define PG8_SA(b, h) (((b) * 2 + (h)) * HTB)
#define PG8_SB(b, h) ((4 + (b) * 2 + (h)) * HTB)
#define PG8_STAGE(bufoff, gbase, voff) do { _Pragma("unroll") for (int _i = 0; _i < 2; ++_i) \
        __builtin_amdgcn_global_load_lds((const unsigned*)((const char*)(gbase) + (voff)[_i]), (PG8_LAS unsigned*)(lds + (bufoff) + ldsw + _i * 8192), 16, 0, 0); } while (0)
#define PG8_LDA(dst, b, h) do { _Pragma("unroll") for (int m = 0; m < 4; ++m) _Pragma("unroll") for (int k = 0; k < 2; ++k) dst[m][k] = *(const PG8_LAS bf16x8*)(lds + PG8_SA(b, h) + aoff + m * 2048 + k * 1024); } while (0)
#define PG8_LDB(dst, b, h) do { _Pragma("unroll") for (int n = 0; n < 2; ++n) _Pragma("unroll") for (int k = 0; k < 2; ++k) dst[n][k] = *(const PG8_LAS bf16x8*)(lds + PG8_SB(b, h) + boff + n * 2048 + k * 1024); } while (0)
#define PG8_MMA(ai, bj, At, Bt) do { __builtin_amdgcn_s_setprio(1); _Pragma("unroll") for (int m = 0; m < 4; ++m) _Pragma("unroll") for (int n = 0; n < 2; ++n) _Pragma("unroll") for (int k = 0; k < 2; ++k) \
        acc[ai][bj][m][n] = __builtin_amdgcn_mfma_f32_16x16x32_bf16(Bt[n][k], At[m][k], acc[ai][bj][m][n], 0, 0, 0); __builtin_amdgcn_s_setprio(0); } while (0)
#define PG8_WAIT_V(n) asm volatile("s_waitcnt vmcnt(" #n ")" ::: "memory")
#define PG8_WAIT_L(n) asm volatile("s_waitcnt lgkmcnt(" #n ")" ::: "memory")
#define PG8_BAR __builtin_amdgcn_s_barrier()
#define PG8_SCHED __builtin_amdgcn_sched_barrier(0)
    Unit cur, nxt; int ui = 0;
    if (!S.next(0, cur)) return;
    f32x4 acc[2][2][4][2];
#pragma unroll
    for (int a = 0; a < 2; ++a)
#pragma unroll
        for (int b = 0; b < 2; ++b)
#pragma unroll
            for (int m = 0; m < 4; ++m)
#pragma unroll
                for (int n = 0; n < 2; ++n) acc[a][b][m][n] = (f32x4){0.f, 0.f, 0.f, 0.f};
    bf16x8 At[4][2], B0[2][2], B1[2][2];
    const char* cA = (const char*)g.A + (size_t)cur.pm * tstep; const char* cB = (const char*)g.Bt + (size_t)cur.pn * tstep;
    S.a_ready(cur);
    PG8_STAGE(PG8_SB(0, 0), cB, voffB); PG8_STAGE(PG8_SA(0, 0), cA, voffA); PG8_STAGE(PG8_SB(0, 1), cB + hstep, voffB); PG8_STAGE(PG8_SA(0, 1), cA + hstep, voffA);
    if (wr == 1) PG8_BAR;
    PG8_WAIT_V(4); PG8_BAR;
    PG8_STAGE(PG8_SB(1, 0), cB + kstep, voffB); PG8_STAGE(PG8_SA(1, 0), cA + kstep, voffA); PG8_STAGE(PG8_SB(1, 1), cB + hstep + kstep, voffB);
    PG8_WAIT_V(6); PG8_BAR;
    PG8_STAMP();
    for (;;) {
        const bool has_next = S.next(ui + 1, nxt);
        const char* nA = has_next ? (const char*)g.A + (size_t)nxt.pm * tstep : cA; const char* nB = has_next ? (const char*)g.Bt + (size_t)nxt.pn * tstep : cB;
        for (int t = 0; t < nt; t += 2) {
            const bool last = (t == nt - 2);
            const char* a1 = cA + (size_t)(t + 1) * kstep;
            const char* a2 = last ? nA : cA + (size_t)(t + 2) * kstep; const char* b2 = last ? nB : cB + (size_t)(t + 2) * kstep;
            const char* a3 = a2 + kstep; const char* b3 = b2 + kstep;
            if (last && has_next) S.a_ready(nxt);
            PG8_LDB(B0, 0, 0); PG8_SCHED; PG8_LDA(At, 0, 0); PG8_STAGE(PG8_SA(1, 1), a1 + hstep, voffA);
            PG8_WAIT_L(8); PG8_BAR; PG8_WAIT_L(0); PG8_MMA(0, 0, At, B0); PG8_BAR; PG8_SCHED;
            PG8_LDB(B1, 0, 1); PG8_STAGE(PG8_SB(0, 0), b2, voffB);
            PG8_BAR; PG8_WAIT_L(0); PG8_MMA(0, 1, At, B1); PG8_BAR;
            PG8_LDA(At, 0, 1); PG8_STAGE(PG8_SA(0, 0), a2, voffA);
            PG8_BAR; PG8_WAIT_L(0); PG8_MMA(1, 0, At, B0); PG8_BAR; PG8_SCHED;
            PG8_STAGE(PG8_SB(0, 1), b2 + hstep, voffB);
            PG8_WAIT_V(6); PG8_BAR; PG8_MMA(1, 1, At, B1); PG8_BAR;
            PG8_LDB(B0, 1, 0); PG8_SCHED; PG8_LDA(At, 1, 0); PG8_STAGE(PG8_SA(0, 1), a2 + hstep, voffA);
            PG8_WAIT_L(8); PG8_BAR; PG8_WAIT_L(0); PG8_MMA(0, 0, At, B0); PG8_BAR; PG8_SCHED;
            PG8_LDB(B1, 1, 1); PG8_STAGE(PG8_SB(1, 0), b3, voffB);
            PG8_BAR; PG8_WAIT_L(0); PG8_MMA(0, 1, At, B1); PG8_BAR;
            PG8_LDA(At, 1, 1); PG8_STAGE(PG8_SA(1, 0), a3, voffA);
            PG8_BAR; PG8_WAIT_L(0); PG8_MMA(1, 0, At, B0); PG8_BAR; PG8_SCHED;
            PG8_STAGE(PG8_SB(1, 1), b3 + hstep, voffB);
            PG8_WAIT_V(6); PG8_BAR; PG8_MMA(1, 1, At, B1); PG8_BAR;
        }
        PG8_STAMP();
        if constexpr (!Epi::AFTER_DRAIN) { E(acc, cur, wr, wc, fr, fq); S.done(cur); }
        PG8_STAMP();
        if (!has_next) break;
#pragma unroll
        for (int a = 0; a < 2; ++a)
#pragma unroll
            for (int b = 0; b < 2; ++b)
#pragma unroll
                for (int m = 0; m < 4; ++m)
#pragma unroll
                    for (int n = 0; n < 2; ++n) acc[a][b][m][n] = (f32x4){0.f, 0.f, 0.f, 0.f};
        cur = nxt; cA = nA; cB = nB; ++ui;
    }
    PG8_WAIT_V(0);
    if (wr == 0) PG8_BAR;
    PG8_BAR;
    if constexpr (Epi::AFTER_DRAIN) { E.fused(acc, cur, wr, wc, fr, fq, lds, wid, lane); S.done(cur); }
    PG8_STAMP();
    if (STAMP && wid == 0) { stamps[lane] = lane < nts ? (((unsigned long long)(unsigned)ts_hi << 32) | (unsigned)ts_lo) : 0ull;
        if (lane == 62) stamps[62] = rt_entry; if (lane == 63) stamps[63] = (unsigned long long)wall_clock64(); }
#undef PG8_STAMP
#undef PG8_SA
#undef PG8_SB
#undef PG8_STAGE
#undef PG8_LDA
#undef PG8_LDB
#undef PG8_MMA
#undef PG8_WAIT_V
#undef PG8_WAIT_L
#undef PG8_BAR
#undef PG8_SCHED
}
}

struct EpiInProj {
    static constexpr bool PERM = false, AFTER_DRAIN = false;
    bf16_t* P; const float* bias; float* LR;
    __device__ __forceinline__ void operator()(const f32x4 (&acc)[2][2][4][2], const pg8::Unit& u, int wr, int wc, int fr, int fq) const {
        const int row0 = u.pm * 256 + wr * 64 + fr, colt = u.pn * 256, col0 = colt + wc * 32 + 4 * fq;
        if (colt == C_LR) {
            if (wc == 0) {
#pragma unroll
                for (int n = 0; n < 2; ++n) {
                    const int cl = 4 * fq + n * 16;
                    const f32x4 b0 = *(const f32x4*)(bias + 4096 + cl);
#pragma unroll
                    for (int ai = 0; ai < 2; ++ai)
#pragma unroll
                        for (int m = 0; m < 4; ++m) *(f32x4*)(LR + (size_t)(row0 + ai * 128 + m * 16) * 32 + cl) = acc[ai][0][m][n] + b0;
                }
            }
            return;
        }
        const int mode = (colt < 512 || colt == C_GQ) ? 1 : (colt >= C_MQ && colt < C_Z) ? 2 : (colt >= C_Z && colt < C_SG) ? 3 : (colt >= C_SG) ? 4 : 0;
#pragma unroll
        for (int bj = 0; bj < 2; ++bj)
#pragma unroll
            for (int n = 0; n < 2; ++n) {
                const int col = col0 + bj * 128 + n * 16;
                const f32x4 b0 = *(const f32x4*)(bias + orig_col(col));
#pragma unroll
                for (int ai = 0; ai < 2; ++ai)
#pragma unroll
                    for (int m = 0; m < 4; ++m) {
                        f32x4 v0 = acc[ai][bj][m][n] + b0;
                        if (mode == 1) v0 *= 0.125f;
                        else if (mode == 2) v0 *= 0.08838834764831845f;
                        else if (mode == 3) {
#pragma unroll
                            for (int e = 0; e < 4; ++e) v0[e] = siluf_(v0[e]);
                        } else if (mode == 4) {
#pragma unroll
                            for (int e = 0; e < 4; ++e) v0[e] = sigmoidf_(v0[e]);
                        }
                        st_bf4(P + (size_t)(row0 + ai * 128 + m * 16) * PS + col, v0);
                    }
            }
    }
};
struct EpiOut {
    static constexpr bool PERM = false, AFTER_DRAIN = false;
    float* pre; const float* bo; const float* x; const float2* stats; const float* g0; const float* b0; const float* hres; size_t tok0; int l;
    __device__ __forceinline__ void operator()(const f32x4 (&acc)[2][2][4][2], const pg8::Unit& u, int wr, int wc, int fr, int fq) const {
        const int row0 = u.pm * 256 + wr * 64 + fr, col0 = u.pn * 256 + wc * 32 + 4 * fq;
#pragma unroll
        for (int ai = 0; ai < 2; ++ai)
#pragma unroll
            for (int m = 0; m < 4; ++m) {
                const int row = row0 + ai * 128 + m * 16; const size_t T = tok0 + row;
                float2 st; st.x = 0.f; st.y = 0.f; if (l == 0) st = stats[T];
#pragma unroll
                for (int bj = 0; bj < 2; ++bj)
#pragma unroll
                    for (int n = 0; n < 2; ++n) {
                        const int col = col0 + bj * 128 + n * 16;
                        f32x4 res;
                        if (l == 0) res = (*(const f32x4*)(x + T * 1024 + col) - st.x) * st.y * *(const f32x4*)(g0 + col) + *(const f32x4*)(b0 + col);
                        else res = *(const f32x4*)(hres + T * 1024 + col);
                        *(f32x4*)(pre + (size_t)row * 1024 + col) = acc[ai][bj][m][n] + *(const f32x4*)(bo + col) + DN_ALPHA * res;
                    }
            }
    }
};

#define XB_TMO      128
#define XB_XCNT(j)  (256  + 64 * (j))
#define XB_XSUB(j)  (1280 + 64 * (j))
#define XB_XGEN(j)  (2304 + 64 * (j))
#define XB_TOP      3328
#define XB_TOPGEN   3392
#define XCD_BAR_WORDS 3456
#define XB_SPIN_CAP (1u << 18)
#define LAS __attribute__((address_space(3)))

__device__ __forceinline__ unsigned xb_ld(unsigned* p)              { return __hip_atomic_load(p, __ATOMIC_RELAXED, __HIP_MEMORY_SCOPE_AGENT); }
__device__ __forceinline__ unsigned xb_add(unsigned* p, unsigned v) { return __hip_atomic_fetch_add(p, v, __ATOMIC_RELAXED, __HIP_MEMORY_SCOPE_AGENT); }
__device__ __forceinline__ unsigned xb_xcc_id() { return (unsigned)__builtin_amdgcn_s_getreg((3 << 11) | 20) & 0xFu; }
#define XB_SPIN(cond, bar) do { unsigned _sp = 0; while (cond) { __builtin_amdgcn_s_sleep(1); \
    if ((++_sp & 255u) == 0u) { if (xb_ld(&(bar)[XB_TMO])) break; if (_sp > XB_SPIN_CAP) { atomicAdd(&(bar)[XB_TMO], 1u); break; } } } } while (0)

struct XcdBarrier {
    unsigned* bar; unsigned x;
    volatile LAS unsigned* st;
};

__device__ __forceinline__ XcdBarrier xcd_barrier_post(unsigned* bar, volatile LAS unsigned* st) {
    XcdBarrier b; b.bar = bar; b.x = xb_xcc_id(); b.st = st;
    if (threadIdx.x == 0) (void)xb_add(&bar[XB_XCNT(b.x)], 1u);
    return b;
}
__device__ __forceinline__ void xcd_barrier_complete(unsigned* bar, unsigned x, unsigned& nloc, unsigned& nx) {
    const unsigned G = gridDim.x * gridDim.y * gridDim.z;
    unsigned sum, cnt, mine, sp = 0u;
    for (;;) {
        sum = 0u; cnt = 0u; mine = 0u;
#pragma unroll
        for (unsigned j = 0; j < 16; ++j) { const unsigned c = xb_ld(&bar[XB_XCNT(j)]); sum += c; cnt += (c > 0u) ? 1u : 0u; mine = (j == x) ? c : mine; }
        if (sum == G) break;
        __builtin_amdgcn_s_sleep(1);
        if ((++sp & 255u) == 0u) { if (xb_ld(&bar[XB_TMO])) break; if (sp > XB_SPIN_CAP) { atomicAdd(&bar[XB_TMO], 1u); break; } }
    }
    nloc = mine > 0u ? mine : 1u; nx = cnt > 0u ? cnt : 1u;
}

__device__ __forceinline__ void xcd_barrier(unsigned* b_bar, unsigned b_x, volatile LAS unsigned* b_st) {
    asm volatile("s_waitcnt vmcnt(0)" ::: "memory");
    __syncthreads();
    if (threadIdx.x == 0) {
        unsigned* bar = b_bar;
        __builtin_amdgcn_s_waitcnt(0);
        unsigned nloc = b_st[0], nx = b_st[1];
        if (nloc == 0u) { xcd_barrier_complete(bar, b_x, nloc, nx); b_st[0] = nloc; b_st[1] = nx; }
        const unsigned old = xb_add(&bar[XB_XSUB(b_x)], 1u);
        const unsigned gen = old / nloc;
        if (old + 1u == (gen + 1u) * nloc) {
            __builtin_amdgcn_fence(__ATOMIC_RELEASE, "agent");
            asm volatile("s_waitcnt vmcnt(0)" ::: "memory");
            const unsigned og = xb_add(&bar[XB_TOP], 1u);
            const unsigned tg = og / nx;
            if (og + 1u == (tg + 1u) * nx) xb_add(&bar[XB_TOPGEN], 1u);
            else XB_SPIN(xb_ld(&bar[XB_TOPGEN]) == tg, bar);
            __builtin_amdgcn_fence(__ATOMIC_ACQUIRE, "agent");
            xb_add(&bar[XB_XGEN(b_x)], 1u);
            asm volatile("s_waitcnt vmcnt(0)" ::: "memory");
        } else {
            XB_SPIN(xb_ld(&bar[XB_XGEN(b_x)]) == gen, bar);
            __builtin_amdgcn_fence(__ATOMIC_ACQUIRE, "agent");
            asm volatile("s_waitcnt vmcnt(0)" ::: "memory");
        }
    }
    __syncthreads();
}

__device__ __forceinline__ void gbar(unsigned* ctr, unsigned& gen, int G) {
    __syncthreads();
    gen += (unsigned)G;
    if (threadIdx.x == 0) {
        __threadfence();
        __hip_atomic_fetch_add(ctr, 1u, __ATOMIC_RELAXED, __HIP_MEMORY_SCOPE_AGENT);
        while (__hip_atomic_load(ctr, __ATOMIC_RELAXED, __HIP_MEMORY_SCOPE_AGENT) < gen) __builtin_amdgcn_s_sleep(1);
        __threadfence();
    }
    __syncthreads();
}
typedef const Params __attribute__((address_space(4))) KParams;
#define KP4 __attribute__((address_space(4)))
__device__ __forceinline__ Params fresh_params() {
#if defined(__HIP_DEVICE_COMPILE__)
    KParams* kp = (KParams*)__builtin_amdgcn_kernarg_segment_ptr();
    asm volatile("" : "+s"(kp));
    Params r;
    const float* KP4 const* src = (const float* KP4 const*)kp;
    const float** dst = (const float**)&r;
#pragma unroll
    for (int i = 0; i < 28; ++i) dst[i] = src[i];
    return r;
#else
    return Params{};
#endif
}
__global__ void __launch_bounds__(NTHR) mega(Params p_unused) {
    extern __shared__ __attribute__((aligned(16))) unsigned char lds[];
    cg::grid_group grid = cg::this_grid();
    const int G = gridDim.x, bid = blockIdx.x;
    volatile LAS unsigned* xst = (volatile LAS unsigned*)((LAS unsigned char*)lds + (LDS_BYTES - 16));
    if (threadIdx.x == 0) { xst[0] = 0u; xst[1] = 0u; }
    __syncthreads();
    unsigned* xbar; unsigned xx;
    { const Params p = fresh_params(); xbar = (unsigned*)(p.ws + OFF_BAR); xx = xb_xcc_id(); if (threadIdx.x == 0) (void)xb_add(&xbar[XB_XCNT(xx)], 1u); }
    { const Params p = fresh_params(); phase0(p); }
    grid.sync();
#pragma unroll 1
    for (int l = 0; l < 2; ++l) {
        { const Params p = fresh_params(); phase_weights(p, l, lds); __syncthreads(); phase_filter_gen(p, l, lds); }
        xcd_barrier(xbar, xx, xst);
        {
            const Params p = fresh_params();
            phase_filter_fft(p, l, lds);
            const bf16_t* WtKV = (const bf16_t*)(p.ws + OFF_WTKV); const bf16_t* membf = (const bf16_t*)(p.ws + OFF_MEMBF);
            for (int t = bid; t < 64; t += G) {
                f32x4 acc[4][4];
                if (t < 32) {
                    const int m0 = (t >> 2) * 256, n0 = (t & 3) * 128;
                    gemm_core(acc, membf + (size_t)m0 * 1024, 1024, WtKV + (size_t)n0 * 1024, 1024, 1024, lds);
                    bf16_t* Km = (bf16_t*)(p.ws + OFF_KMAT);
                    EPI_LOOP(st_bf4(Km + (size_t)row * 512 + col, v);)
                } else {
                    const int t2 = t - 32, m0 = (t2 >> 4) * 256, n0 = (t2 & 15) * 128;
                    gemm_core(acc, WtKV + (size_t)(512 + m0) * 1024, 1024, membf + (size_t)n0 * 1024, 1024, 1024, lds);
                    bf16_t* Vm = (bf16_t*)(p.ws + OFF_VT);
                    EPI_LOOP(st_bf4(Vm + (size_t)row * 2048 + col, v);)
                }
            }
        }
        xcd_barrier(xbar, xx, xst);
#pragma unroll 1
        for (int g = 0; g < NGRP; ++g) {
            const size_t tok0 = (size_t)g * TG;
#pragma unroll 1
            for (int rep = 0; rep < PROBE_REP_INPROJ; ++rep) {
                const Params p = fresh_params();
                pg8::Gemm gm; gm.A = (const bf16_t*)(p.ws + OFF_HB) + tok0 * 1024; gm.Bt = (const bf16_t*)(p.ws + OFF_WTIN); gm.M = TG; gm.N = NINP; gm.K = 1024;
                pg8::StaticOrder S; S.init(TG, NINP, G, bid);
                EpiInProj E; E.P = (bf16_t*)(p.ws + OFF_P); E.bias = p.b_in + (size_t)l * NIN; E.LR = (float*)(p.ws + OFF_LR);
                pg8::gemm_phase<EpiInProj, pg8::StaticOrder, false>((PG8_LAS unsigned char*)lds, gm, S, E, nullptr);
                __syncthreads();
            }
            xcd_barrier(xbar, xx, xst);
#pragma unroll 1
            for (int rep = 0; rep < PROBE_REP_MIX; ++rep) {
            int dry = (rep + 1 < PROBE_REP_MIX) ? 1 : 0; asm volatile("" : "+s"(dry));
            {
                const Params p = fresh_params();
                bf16_t* P = (bf16_t*)(p.ws + OFF_P);
                for (int it = bid; it < BG * 64 * 8; it += G) na_item(p, l, P, it >> 9, (it >> 3) & 63, it & 7, lds, dry);
            }
            {
                const Params p = fresh_params();
                bf16_t* P = (bf16_t*)(p.ws + OFF_P);
                for (int it = bid; it < BG * 128 * 8; it += G) hy_pre_item(p, l, P, (float*)(p.ws + OFF_UT), (bf16_t*)(p.ws + OFF_GT), it >> 10, (it >> 3) & 127, it & 7, lds);
            }
            {
                const Params p = fresh_params();
                for (int it = bid; it < NITEM; it += G) gla_part1_item(p, l, (const bf16_t*)(p.ws + OFF_P), (const float*)(p.ws + OFF_LR), it, lds);
            }
            {
                const Params p = fresh_params();
                bf16_t* P = (bf16_t*)(p.ws + OFF_P);
                const int nit = BG * 4 * 64, per = (nit + G - 1) / G;
                int last = -1;
                for (int it = bid * per; it < min(nit, (bid + 1) * per); ++it) {
                    const int bh = it >> 6, bl = bh >> 2, h = bh & 3;
                    if (bh != last) { __syncthreads(); memattn_load(p, g * BG + bl, h, lds); last = bh; }
                    memattn_item(P, bl, h, it & 63, lds, dry);
                }
                __syncthreads();
            }
            xcd_barrier(xbar, xx, xst);
            {
                const Params p = fresh_params();
                const float2* twl = fft_lds_twiddles((const float2*)(p.ws + OFF_TW), lds);
                for (int it = bid; it < BG * 256; it += G) hyena_conv_item(p, (const float*)(p.ws + OFF_UT), (bf16_t*)(p.ws + OFF_GT), it >> 8, it & 255, lds, twl, dry);
                __syncthreads();
                gla_scan(p, dry);
            }
            xcd_barrier(xbar, xx, xst);
            {
                const Params p = fresh_params();
                for (int it = bid; it < NITEM; it += G) gla_part2_item(p, l, (bf16_t*)(p.ws + OFF_P), (const float*)(p.ws + OFF_LR), it, lds, dry);
            }
            {
                const Params p = fresh_params();
                for (int it = bid; it < BG * 128 * 8; it += G) hy_post_item((bf16_t*)(p.ws + OFF_P), (const bf16_t*)(p.ws + OFF_GT), it >> 10, (it >> 3) & 127, it & 7, lds, dry);
            }
            xcd_barrier(xbar, xx, xst);
            }
            {
                const Params p = fresh_params();
                const bf16_t* P = (const bf16_t*)(p.ws + OFF_P); const bf16_t* WtBr = (const bf16_t*)(p.ws + OFF_WTBR); bf16_t* merged = (bf16_t*)(p.ws + OFF_MERGED);
                for (int t = bid; t < 512; t += G) {
                    const int m0 = (t >> 3) * 256, n0 = (t & 7) * 128;
                    f32x4 macc[4][4];
#pragma unroll
                    for (int mi = 0; mi < 4; ++mi)
#pragma unroll
                        for (int ni = 0; ni < 4; ++ni) macc[mi][ni] = (f32x4){0.f, 0.f, 0.f, 0.f};
#pragma unroll 1
                    for (int j = 0; j < 4; ++j) {
                        const int acol = (j == 0) ? C_NAQ : (j == 1) ? C_HY : (j == 2) ? C_GV : C_MQ;
                        f32x4 acc[4][4];
                        gemm_core(acc, P + (size_t)m0 * PS + acol, PS, WtBr + (size_t)j * 1024 * 512 + (size_t)n0 * 512, 512, 512, lds);
                        EPI_LOOP(macc[mi][ni] += ld_bf4(P + (size_t)row * PS + C_SG + 1024 * j + col) * v;)
                    }
                    {
                        f32x4 (&acc)[4][4] = macc;
                        EPI_LOOP(st_bf4(merged + (size_t)row * 1024 + col, v);)
                    }
                }
            }
            xcd_barrier(xbar, xx, xst);
            {
                const Params p = fresh_params();
                pg8::Gemm gm; gm.A = (const bf16_t*)(p.ws + OFF_MERGED); gm.Bt = (const bf16_t*)(p.ws + OFF_WTOUT); gm.M = TG; gm.N = 1024; gm.K = 1024;
                pg8::StaticOrder S; S.init(TG, 1024, G, bid);
                EpiOut E; E.pre = (float*)(p.ws + OFF_PRE); E.bo = p.b_out + l * 1024; E.x = p.x; E.stats = (const float2*)(p.ws + OFF_STATS); E.g0 = p.ln_in_g; E.b0 = p.ln_in_b; E.hres = p.out; E.tok0 = tok0; E.l = l;
                pg8::gemm_phase<EpiOut, pg8::StaticOrder, false>((PG8_LAS unsigned char*)lds, gm, S, E, nullptr);
                __syncthreads();
            }
            xcd_barrier(xbar, xx, xst);
            {
                const Params p = fresh_params();
                ln_rows((const float*)(p.ws + OFF_PRE), 0, TG, p.ln_g + l * 1024, p.ln_b + l * 1024, p.out, (bf16_t*)(p.ws + OFF_HB), tok0, nullptr);
            }
        }
        xcd_barrier(xbar, xx, xst);
    }
}

extern "C" void kernel_launch(void* const* d_in, const int* in_sizes, int n_in, void* d_out, int out_size, void* d_ws, size_t ws_size, hipStream_t stream) {
    static int grid_blocks = 0;
    if (!grid_blocks) {
        if (ws_size < WS_END) { fprintf(stderr, "kernel_launch: workspace too small: %zu < %zu\n", ws_size, (size_t)WS_END); grid_blocks = -1; return; }
        {
            const long long ex[26] = {67108864LL, 2097152LL, 1024, 1024, 2LL * 1024 * 10784, 2 * 10784, 2 * 8 * 15 * 31, 2 * 3 * 1536, 2 * 1536, 2 * 33 * 64, 2 * 64, 2 * 2 * 64 * 64, 2 * 2 * 64,
                                      2 * 64 * 1024, 2 * 512, 2 * 16 * 256, 2 * 256, 2 * 16 * 256, 2 * 256, 2 * 512, 2LL * 1024 * 1024, 2LL * 4 * 512 * 1024, 2LL * 1024 * 1024, 2 * 1024, 2 * 1024, 2 * 1024};
            bool bad = (n_in != 26) || (out_size != 67108864);
            for (int i = 0; i < 26 && !bad; ++i) if ((long long)in_sizes[i] != ex[i]) { fprintf(stderr, "kernel_launch: input %d has %d elements, expected %lld\n", i, in_sizes[i], ex[i]); bad = true; }
            if (bad) { fprintf(stderr, "kernel_launch: unexpected shapes; nothing launched\n"); grid_blocks = -1; return; }
        }
        int dev = 0, cus = 0, per_cu = 0;
        hipGetDevice(&dev);
        hipDeviceGetAttribute(&cus, hipDeviceAttributeMultiprocessorCount, dev);
        if (hipFuncSetAttribute((const void*)mega, hipFuncAttributeMaxDynamicSharedMemorySize, LDS_BYTES) != hipSuccess) fprintf(stderr, "kernel_launch: hipFuncSetAttribute failed\n");
        if (hipOccupancyMaxActiveBlocksPerMultiprocessor(&per_cu, (const void*)mega, NTHR, LDS_BYTES) != hipSuccess || per_cu < 1) { fprintf(stderr, "kernel_launch: occupancy query gave %d\n", per_cu); per_cu = 1; }
        (void)hipGetLastError();
        if (per_cu > 1) per_cu = 1;
        grid_blocks = cus * per_cu;
    }
    if (grid_blocks < 0) return;
    Params p{};
    const float** pp = (const float**)&p;
    for (int i = 0; i < 26; ++i) pp[i] = (const float*)d_in[i];
    p.out = (float*)d_out; p.ws = (unsigned char*)d_ws;
    if (hipMemsetAsync((unsigned char*)d_ws + OFF_BAR, 0, 16384, stream) != hipSuccess) fprintf(stderr, "kernel_launch: memset of the barrier word failed\n");
    void* args[] = {&p};
    hipError_t e = hipLaunchCooperativeKernel((const void*)mega, dim3(grid_blocks), dim3(NTHR), args, LDS_BYTES, stream);
    if (e != hipSuccess) fprintf(stderr, "cooperative launch failed: %s (grid %d)\n", hipGetErrorString(e), grid_blocks);
}
#endif
```

```cpp
#ifndef PROBE_REP_MIX
#define PROBE_REP_MIX 1
#endif
#ifndef PROBE_REP_INPROJ
#define PROBE_REP_INPROJ 1
#endif
#include <hip/hip_runtime.h>
#include <hip/hip_cooperative_groups.h>
#include <cstdio>
#include <unistd.h>
#include <cmath>
namespace cg = cooperative_groups;

#define HD __host__ __device__
typedef unsigned short bf16_t;
typedef short bf16x8 __attribute__((ext_vector_type(8)));
typedef float f32x4 __attribute__((ext_vector_type(4)));
typedef unsigned u32x2 __attribute__((ext_vector_type(2)));
typedef unsigned u32x4 __attribute__((ext_vector_type(4)));

constexpr int NTOK = 65536, DM = 1024, SEQ = 8192, NB = 8;
constexpr int BG = 2;
constexpr int NGRP = NB / BG;
constexpr int TG = BG * SEQ;
constexpr int PS = 10752;
constexpr int NIN = 10784, NINP = 11008;
constexpr int C_NAQ = 0, C_NAK = 512, C_NAV = 1024, C_HY = 1536, C_GQ = 3072, C_GK = 3328, C_GV = 3584, C_MQ = 4096, C_Z = 4608, C_SG = 6656, C_LR = 10752;
constexpr int FN = 16384;
constexpr int NITEM = BG * 128 * 4;
constexpr int LDS_BYTES = 160 * 1024;
constexpr int NTHR = 512;
constexpr float DN_ALPHA = 1.41421356237309515f;

constexpr size_t al256(size_t x) { return (x + 255) & ~(size_t)255; }
constexpr size_t OFF_HB = 0;
constexpr size_t OFF_STATS = OFF_HB + (size_t)NTOK * DM * 2;
constexpr size_t OFF_TW = OFF_STATS + (size_t)NTOK * 8;
constexpr size_t OFF_MEMBF = OFF_TW + (size_t)FN * 8;
constexpr size_t OFF_ENERGY = OFF_MEMBF + (size_t)2048 * 1024 * 2;
constexpr size_t OFF_WTIN = OFF_ENERGY + 4096;
constexpr size_t OFF_WTBR = OFF_WTIN + (size_t)NINP * 1024 * 2;
constexpr size_t OFF_WTOUT = OFF_WTBR + (size_t)4 * 1024 * 512 * 2;
constexpr size_t OFF_WTKV = OFF_WTOUT + (size_t)1024 * 1024 * 2;
constexpr size_t OFF_KMAT = OFF_WTKV + (size_t)2048 * 1024 * 2;
constexpr size_t OFF_VT = OFF_KMAT + (size_t)2048 * 1024 * 2;
constexpr size_t OFF_HFILT = OFF_VT + (size_t)2048 * 1024 * 2;
constexpr size_t OFF_PQ = OFF_HFILT + (size_t)1024 * 8192 * 4;
constexpr size_t OFF_P = OFF_PQ + (size_t)256 * FN * 16;
constexpr size_t OFF_LR = OFF_P + (size_t)TG * PS * 2;
constexpr size_t OFF_GS = OFF_LR + (size_t)TG * 32 * 4;
constexpr size_t OFF_GDEC = OFF_GS + (size_t)2 * NITEM * 8192 * 4;
constexpr size_t OFF_MERGED = OFF_GDEC + (size_t)2 * NITEM * 64 * 4;
constexpr size_t OFF_PRE = OFF_MERGED + (size_t)TG * 1024 * 2;
constexpr size_t OFF_UT = OFF_PRE + (size_t)TG * 1024 * 4;
constexpr size_t OFF_GT = OFF_UT + (size_t)BG * 512 * 8192 * 4;
constexpr size_t OFF_BAR = OFF_GT + (size_t)BG * 512 * 8192 * 2;
constexpr size_t OFF_ZT = OFF_BAR + 16384;
constexpr size_t WS_END = OFF_ZT + (size_t)8192 * 33 * 4;

struct Params {
    const float *x, *mem, *ln_in_g, *ln_in_b, *w_in, *b_in, *na_rpb, *hy_conv_w, *hy_conv_b, *hy_w1, *hy_b1, *hy_wm, *hy_bm, *hy_w3, *hy_skip,
        *gla_up_f, *gla_bias_f, *gla_up_b, *gla_bias_b, *gla_norm_g, *mem_w_kv, *w_br, *w_out, *b_out, *ln_g, *ln_b;
    float* out;
    unsigned char* ws;
};

HD inline float bf2f(bf16_t b) {
    union { unsigned u; float f; } c; c.u = (unsigned)b << 16; return c.f;
}
HD inline bf16_t f2bf(float f) {
    union { unsigned u; float f; } c; c.f = f; unsigned u = c.u; u += 0x7fffu + ((u >> 16) & 1u); return (bf16_t)(u >> 16);
}
__device__ __forceinline__ unsigned pk2(float lo, float hi) { return (unsigned)f2bf(lo) | ((unsigned)f2bf(hi) << 16); }
__device__ __forceinline__ float lo16(unsigned u) { return __uint_as_float(u << 16); }
__device__ __forceinline__ float hi16(unsigned u) { return __uint_as_float(u & 0xffff0000u); }
__device__ __forceinline__ float wave_sum(float v) {
#pragma unroll
    for (int o = 32; o >= 1; o >>= 1) v += __shfl_xor(v, o);
    return v;
}
__device__ __forceinline__ float sigmoidf_(float x) { return __builtin_amdgcn_rcpf(1.0f + __expf(-x)); }
__device__ __forceinline__ float siluf_(float x) { return x * __builtin_amdgcn_rcpf(1.0f + __expf(-x)); }
__device__ __forceinline__ float logsigf_(float x) { return fminf(x, 0.0f) - log1pf(expf(-fabsf(x))); }
__device__ __forceinline__ bf16x8 mkfrag(u32x4 v) { return __builtin_bit_cast(bf16x8, v); }
__device__ __forceinline__ bf16x8 mkfrag2(u32x2 a, u32x2 b) { u32x4 v = {a.x, a.y, b.x, b.y}; return __builtin_bit_cast(bf16x8, v); }
#define MFMA(a, b, c) __builtin_amdgcn_mfma_f32_16x16x32_bf16((a), (b), (c), 0, 0, 0)
HD inline int iclamp(int v, int lo, int hi) { return v < lo ? lo : (v > hi ? hi : v); }

HD inline float2 cmulf(float2 a, float2 b) { float2 r; r.x = a.x * b.x - a.y * b.y; r.y = a.x * b.y + a.y * b.x; return r; }
HD inline float2 cmulcf(float2 a, float2 b) { float2 r; r.x = a.x * b.x + a.y * b.y; r.y = a.y * b.x - a.x * b.y; return r; }
struct Bfly { float2 x0, x1, x2, x3, W1; int i0; };
HD inline void bfly_load(Bfly& b, const float2* d, const float2* tw, int lgm, int q) {
    const int m = 1 << lgm, blk = q >> lgm, j = q & (m - 1);
    b.i0 = (blk << (lgm + 2)) + j;
    b.W1 = tw[j];
    b.x0 = d[b.i0]; b.x1 = d[b.i0 + m]; b.x2 = d[b.i0 + 2 * m]; b.x3 = d[b.i0 + 3 * m];
}
HD inline void bfly_fwd_store(const Bfly& b, float2* d, int lgm) {
    const int m = 1 << lgm, i0 = b.i0;
    const float2 W1 = b.W1, W2 = cmulf(W1, W1);
    const float2 x0 = b.x0, x1 = b.x1, x2 = b.x2, x3 = b.x3;
    float2 a0, a1, a2, a3, t;
    a0.x = x0.x + x2.x; a0.y = x0.y + x2.y;
    t.x = x0.x - x2.x; t.y = x0.y - x2.y; a2 = cmulf(t, W1);
    a1.x = x1.x + x3.x; a1.y = x1.y + x3.y;
    t.x = x1.x - x3.x; t.y = x1.y - x3.y; t = cmulf(t, W1); a3.x = t.y; a3.y = -t.x;
    float2 r;
    r.x = a0.x + a1.x; r.y = a0.y + a1.y; d[i0] = r;
    t.x = a0.x - a1.x; t.y = a0.y - a1.y; d[i0 + m] = cmulf(t, W2);
    r.x = a2.x + a3.x; r.y = a2.y + a3.y; d[i0 + 2 * m] = r;
    t.x = a2.x - a3.x; t.y = a2.y - a3.y; d[i0 + 3 * m] = cmulf(t, W2);
}
HD inline void bfly_inv_store(const Bfly& b, float2* d, int lgm) {
    const int m = 1 << lgm, i0 = b.i0;
    const float2 W1 = b.W1, W2 = cmulf(W1, W1);
    const float2 x0 = b.x0, x1 = b.x1, x2 = b.x2, x3 = b.x3;
    const float2 b1 = cmulcf(x1, W2), b3 = cmulcf(x3, W2);
    float2 y0, y1, y2, y3;
    y0.x = x0.x + b1.x; y0.y = x0.y + b1.y; y1.x = x0.x - b1.x; y1.y = x0.y - b1.y;
    y2.x = x2.x + b3.x; y2.y = x2.y + b3.y; y3.x = x2.x - b3.x; y3.y = x2.y - b3.y;
    const float2 c2 = cmulcf(y2, W1); float2 c3 = cmulcf(y3, W1); { const float tx = -c3.y, ty = c3.x; c3.x = tx; c3.y = ty; }
    float2 r;
    r.x = y0.x + c2.x; r.y = y0.y + c2.y; d[i0] = r;
    r.x = y0.x - c2.x; r.y = y0.y - c2.y; d[i0 + 2 * m] = r;
    r.x = y1.x + c3.x; r.y = y1.y + c3.y; d[i0 + m] = r;
    r.x = y1.x - c3.x; r.y = y1.y - c3.y; d[i0 + 3 * m] = r;
}
HD inline void fft_fwd_bfly(float2* d, const float2* tw, int lgm, int q) { Bfly b; bfly_load(b, d, tw, lgm, q); bfly_fwd_store(b, d, lgm); }
HD inline void fft_inv_bfly(float2* d, const float2* tw, int lgm, int q) { Bfly b; bfly_load(b, d, tw, lgm, q); bfly_inv_store(b, d, lgm); }
HD inline int brev14(int k) {
    unsigned v = (unsigned)k;
    v = ((v >> 1) & 0x55555555u) | ((v & 0x55555555u) << 1);
    v = ((v >> 2) & 0x33333333u) | ((v & 0x33333333u) << 2);
    v = ((v >> 4) & 0x0f0f0f0fu) | ((v & 0x0f0f0f0fu) << 4);
    v = ((v >> 8) & 0x00ff00ffu) | ((v & 0x00ff00ffu) << 8);
    v = (v >> 16) | (v << 16);
    return (int)(v >> 18);
}
struct PwIn { float2 Z1, Z2; float4 A, B; int p1, p2; };
HD inline void pw_load(PwIn& w, const float2* d, const float4* pq, int kf) {
    const int k2 = (FN - kf) & (FN - 1); w.p1 = brev14(kf); w.p2 = brev14(k2);
    w.Z1 = d[w.p1]; w.Z2 = d[w.p2]; w.A = pq[w.p1]; w.B = pq[w.p2];
}
HD inline void pw_store(const PwIn& w, float2* d) {
    const float2 Z1 = w.Z1, Z2 = w.Z2;
    float2 P1, Q1, P2, Q2; P1.x = w.A.x; P1.y = w.A.y; Q1.x = w.A.z; Q1.y = w.A.w; P2.x = w.B.x; P2.y = w.B.y; Q2.x = w.B.z; Q2.y = w.B.w;
    float2 c1, c2; c1.x = Z1.x; c1.y = -Z1.y; c2.x = Z2.x; c2.y = -Z2.y;
    const float2 a = cmulf(Z1, P1), b = cmulf(c2, Q1), c = cmulf(Z2, P2), e = cmulf(c1, Q2);
    float2 w1, w2; w1.x = a.x + b.x; w1.y = a.y + b.y; w2.x = c.x + e.x; w2.y = c.y + e.y;
    d[w.p1] = w1;
    if (w.p2 != w.p1) d[w.p2] = w2;
}
HD inline void conv_pointwise(float2* d, const float4* pq, int kf) { PwIn w; pw_load(w, d, pq, kf); pw_store(w, d); }
HD inline void filt_pointwise(const float2* d, float4* pq, int kf) {
    const int k2 = (FN - kf) & (FN - 1), p1 = brev14(kf), p2 = brev14(k2);
    const float2 Z1 = d[p1], Z2 = d[p2];
    const float gcx = 0.5f * (Z1.x + Z2.x), gcy = 0.5f * (Z1.y - Z2.y);
    const float gdx = 0.5f * (Z1.y + Z2.y), gdy = -0.5f * (Z1.x - Z2.x);
    const float s = 0.5f / (float)FN;
    float4 A; A.x = s * (gcx + gdx); A.y = s * (gcy + gdy); A.z = s * (gcx - gdx); A.w = s * (gcy - gdy);
    pq[p1] = A;
    float4 B; B.x = A.x; B.y = -A.y; B.z = A.z; B.w = -A.w;
    if (p2 != p1) pq[p2] = B;
}

HD inline int tw_off(int lgm) { return lgm == 10 ? 0 : lgm == 8 ? 1024 : lgm == 6 ? 1280 : lgm == 4 ? 1344 : lgm == 2 ? 1360 : 1364; }
#ifndef FFT_HOST_TEST
template <int LGM, bool INV>
__device__ __forceinline__ void fft_pass(float2* d, const float2* twl, const float2* twg, int tid) {
    const float2* tw = (LGM == 12) ? twg : twl + tw_off(LGM);
#pragma unroll
    for (int it = 0; it < 2; ++it) {
        const int q = tid + it * 4 * NTHR;
        Bfly b0, b1, b2, b3;
        bfly_load(b0, d, tw, LGM, q); bfly_load(b1, d, tw, LGM, q + NTHR); bfly_load(b2, d, tw, LGM, q + 2 * NTHR); bfly_load(b3, d, tw, LGM, q + 3 * NTHR);
        if (INV) { bfly_inv_store(b0, d, LGM); bfly_inv_store(b1, d, LGM); bfly_inv_store(b2, d, LGM); bfly_inv_store(b3, d, LGM); }
        else { bfly_fwd_store(b0, d, LGM); bfly_fwd_store(b1, d, LGM); bfly_fwd_store(b2, d, LGM); bfly_fwd_store(b3, d, LGM); }
    }
    __syncthreads();
}
__device__ __forceinline__ void fft_forward(float2* d, const float2* twl, const float2* twg) {
    int tid = threadIdx.x; asm volatile("" : "+v"(tid));
    fft_pass<12, false>(d, twl, twg, tid); fft_pass<10, false>(d, twl, twg, tid); fft_pass<8, false>(d, twl, twg, tid); fft_pass<6, false>(d, twl, twg, tid);
    fft_pass<4, false>(d, twl, twg, tid); fft_pass<2, false>(d, twl, twg, tid); fft_pass<0, false>(d, twl, twg, tid);
}
__device__ __forceinline__ void fft_inverse(float2* d, const float2* twl, const float2* twg) {
    int tid = threadIdx.x; asm volatile("" : "+v"(tid));
    fft_pass<0, true>(d, twl, twg, tid); fft_pass<2, true>(d, twl, twg, tid); fft_pass<4, true>(d, twl, twg, tid); fft_pass<6, true>(d, twl, twg, tid);
    fft_pass<8, true>(d, twl, twg, tid); fft_pass<10, true>(d, twl, twg, tid); fft_pass<12, true>(d, twl, twg, tid);
}
__device__ __forceinline__ float2* fft_lds_twiddles(const float2* twg, unsigned char* lds) {
    int tid = threadIdx.x; asm volatile("" : "+v"(tid));
    float2* t = (float2*)(lds + 131072);
    for (int k = tid; k < 1365; k += NTHR) {
        const int lgm = k < 1024 ? 10 : k < 1280 ? 8 : k < 1344 ? 6 : k < 1360 ? 4 : k < 1364 ? 2 : 0;
        t[k] = twg[(k - tw_off(lgm)) << (12 - lgm)];
    }
    __syncthreads();
    return t;
}

constexpr int STG = 49152;
__device__ __forceinline__ int swz(int row, int ch) { return row * 128 + ((ch ^ ((row >> 1) & 7)) << 4); }
__device__ __forceinline__ void gemm_core(f32x4 (&acc)[4][4], const bf16_t* A, int lda, const bf16_t* Bt, int ldb, int K, unsigned char* lds) {
    int tid_ = threadIdx.x; asm volatile("" : "+v"(tid_)); const int tid = tid_, lane = tid & 63, w = tid >> 6, wm = w & 3, wn = w >> 2, l15 = lane & 15, q4 = lane >> 4;
    const int wu = __builtin_amdgcn_readfirstlane(w);
    __attribute__((address_space(3))) unsigned char* l3 = (__attribute__((address_space(3))) unsigned char*)lds;
#pragma unroll
    for (int mi = 0; mi < 4; ++mi)
#pragma unroll
        for (int ni = 0; ni < 4; ++ni) acc[mi][ni] = (f32x4){0.f, 0.f, 0.f, 0.f};
    const int r8 = lane >> 3, sch = (lane & 7) ^ ((((w & 1) << 2) + (r8 >> 1)) & 7);
    const bf16_t* ap = A + (size_t)(w * 8 + r8) * lda + sch * 8;
    const bf16_t* bp = Bt + (size_t)(w * 8 + r8) * ldb + sch * 8;
#define GC_STAGE(buf, k0)                                                                                                                         \
    {                                                                                                                                             \
        _Pragma("unroll") for (int i = 0; i < 4; ++i)                                                                                             \
            __builtin_amdgcn_global_load_lds((const unsigned*)(ap + (size_t)(64 * i) * lda + (k0)), (__attribute__((address_space(3))) unsigned*)(l3 + (buf) * STG + (wu + 8 * i) * 1024), 16, 0, 0);          \
        _Pragma("unroll") for (int i = 0; i < 2; ++i)                                                                                             \
            __builtin_amdgcn_global_load_lds((const unsigned*)(bp + (size_t)(64 * i) * ldb + (k0)), (__attribute__((address_space(3))) unsigned*)(l3 + (buf) * STG + 32768 + (wu + 8 * i) * 1024), 16, 0, 0);  \
    }
    GC_STAGE(0, 0)
    asm volatile("s_waitcnt vmcnt(0)" ::: "memory");
    __syncthreads();
    const int nk = K >> 6;
    for (int kt = 0; kt < nk; ++kt) {
        if (kt + 1 < nk) GC_STAGE((kt + 1) & 1, (kt + 1) << 6)
        const unsigned char* sa = lds + (kt & 1) * STG;
        const unsigned char* sb = sa + 32768;
#pragma unroll
        for (int ks = 0; ks < 2; ++ks) {
            bf16x8 af[4], bfr[4];
#pragma unroll
            for (int mi = 0; mi < 4; ++mi) af[mi] = *(const bf16x8*)(sa + swz(wm * 64 + mi * 16 + l15, ks * 4 + q4));
#pragma unroll
            for (int ni = 0; ni < 4; ++ni) bfr[ni] = *(const bf16x8*)(sb + swz(wn * 64 + ni * 16 + l15, ks * 4 + q4));
#pragma unroll
            for (int mi = 0; mi < 4; ++mi)
#pragma unroll
                for (int ni = 0; ni < 4; ++ni) acc[mi][ni] = MFMA(bfr[ni], af[mi], acc[mi][ni]);
        }
        asm volatile("s_waitcnt vmcnt(0)" ::: "memory");
        __syncthreads();
    }
#undef GC_STAGE
}
#define EPI_LOOP(body)                                                                                                  \
    {                                                                                                                   \
        int e_t = threadIdx.x; asm volatile("" : "+v"(e_t)); const int e_lane = e_t & 63, e_w = e_t >> 6;                                                    \
        _Pragma("unroll") for (int mi = 0; mi < 4; ++mi) _Pragma("unroll") for (int ni = 0; ni < 4; ++ni) {             \
            const int row = m0 + (e_w & 3) * 64 + mi * 16 + (e_lane & 15);                                              \
            const int col = n0 + (e_w >> 2) * 64 + ni * 16 + 4 * (e_lane >> 4);                                         \
            f32x4& v = acc[mi][ni];                                                                                     \
            body                                                                                                        \
        }                                                                                                               \
    }
__device__ __forceinline__ void st_bf4(bf16_t* dst, f32x4 v) {
    u32x2 o; o.x = pk2(v[0], v[1]); o.y = pk2(v[2], v[3]); *(u32x2*)dst = o;
}
__device__ __forceinline__ f32x4 ld_bf4(const bf16_t* src) {
    const u32x2 u = *(const u32x2*)src; f32x4 r = {lo16(u.x), hi16(u.x), lo16(u.y), hi16(u.y)}; return r;
}

__device__ __forceinline__ int orig_col(int n) {
    if (n < 4096) return n;
    if (n < 4608) return n + 32;
    if (n < 6656) return n + 32;
    if (n < 10752) return n + 32;
    return n - 10752 + 4096;
}

__device__ __forceinline__ void ln_rows(const float* src, size_t src_row0, int nrows, const float* g, const float* b, float* dst32, bf16_t* dst16, size_t dst_row0, float2* stats) {
    int tid_ = threadIdx.x; asm volatile("" : "+v"(tid_));
    const int lane = tid_ & 63;
    const int gw = blockIdx.x * (NTHR / 64) + (tid_ >> 6), nw = gridDim.x * (NTHR / 64);
    for (int r = gw; r < nrows; r += nw) {
        const float4* xr = (const float4*)(src + (src_row0 + r) * 1024);
        float4 v[4]; float s = 0.f;
#pragma unroll
        for (int i = 0; i < 4; ++i) { v[i] = xr[lane + 64 * i]; s += (v[i].x + v[i].y) + (v[i].z + v[i].w); }
        s = wave_sum(s);
        const float mean = s * (1.0f / 1024.0f);
        float q = 0.f;
#pragma unroll
        for (int i = 0; i < 4; ++i) { const float a = v[i].x - mean, bb = v[i].y - mean, c = v[i].z - mean, d = v[i].w - mean; q += (a * a + bb * bb) + (c * c + d * d); }
        q = wave_sum(q);
        const float rstd = 1.0f / sqrtf(q * (1.0f / 1024.0f) + 1e-5f);
        if (stats && lane == 0) { float2 st; st.x = mean; st.y = rstd; stats[dst_row0 + r] = st; }
#pragma unroll
        for (int i = 0; i < 4; ++i) {
            const float4 g4 = ((const float4*)g)[lane + 64 * i], b4 = ((const float4*)b)[lane + 64 * i];
            float4 y; y.x = (v[i].x - mean) * rstd * g4.x + b4.x; y.y = (v[i].y - mean) * rstd * g4.y + b4.y; y.z = (v[i].z - mean) * rstd * g4.z + b4.z; y.w = (v[i].w - mean) * rstd * g4.w + b4.w;
            if (dst32) ((float4*)(dst32 + (dst_row0 + r) * 1024))[lane + 64 * i] = y;
            if (dst16) { u32x2 o; o.x = pk2(y.x, y.y); o.y = pk2(y.z, y.w); *(u32x2*)(dst16 + (dst_row0 + r) * 1024 + (lane + 64 * i) * 4) = o; }
        }
    }
}
__device__ __forceinline__ void phase0(const Params& p) {
    ln_rows(p.x, 0, NTOK, p.ln_in_g, p.ln_in_b, nullptr, (bf16_t*)(p.ws + OFF_HB), 0, (float2*)(p.ws + OFF_STATS));
    int tid_ = threadIdx.x; asm volatile("" : "+v"(tid_)); const int gt = blockIdx.x * NTHR + tid_, nt = gridDim.x * NTHR;
    float2* tw = (float2*)(p.ws + OFF_TW);
    for (int k = gt; k < FN; k += nt) { double s, c; sincospi(-2.0 * (double)k / (double)FN, &s, &c); float2 t; t.x = (float)c; t.y = (float)s; tw[k] = t; }
    bf16_t* mb = (bf16_t*)(p.ws + OFF_MEMBF);
    for (int i = gt; i < 2048 * 1024 / 4; i += nt) { const float4 v = ((const float4*)p.mem)[i]; u32x2 o; o.x = pk2(v.x, v.y); o.y = pk2(v.z, v.w); ((u32x2*)mb)[i] = o; }
    float* en = (float*)(p.ws + OFF_ENERGY);
    for (int i = gt; i < 1024; i += nt) en[i] = 0.f;
    float* ztab = (float*)(p.ws + OFF_ZT);
    for (int idx = gt; idx < 8192 * 33; idx += nt) {
        const int n = idx / 33, e = idx - n * 33;
        float v;
        if (e == 0) v = (float)n / 8191.0f;
        else {
            const int i = (e - 1) & 15;
            const double fr = 1e-4 + (double)i * ((15.0 - 1e-4) / 15.0);
            const double ang = (2.0 * 3.14159265358979323846 / 8192.0) * (double)n * fr;
            v = (e <= 16) ? (float)cos(ang) : (float)(-sin(ang));
        }
        ztab[idx] = v;
    }
}

__device__ __forceinline__ void wt_tile(const float* src, int src_ld, int k0, int on0, bf16_t* dst, int dst_ld, int dn0, bool zero, float* tile) {
    int tid_ = threadIdx.x; asm volatile("" : "+v"(tid_)); const int tid = tid_;
    if (!zero) {
#pragma unroll
        for (int i = 0; i < 2; ++i) {
            const int k = (tid >> 3) + 64 * i, c4 = (tid & 7) * 4;
            const float4 v = *(const float4*)(src + (size_t)(k0 + k) * src_ld + on0 + c4);
            float* t = tile + k * 33 + c4; t[0] = v.x; t[1] = v.y; t[2] = v.z; t[3] = v.w;
        }
    }
    __syncthreads();
    const int n = tid >> 4, kc = (tid & 15) * 8;
    float f[8];
#pragma unroll
    for (int e = 0; e < 8; ++e) f[e] = zero ? 0.f : tile[(kc + e) * 33 + n];
    u32x4 o; o.x = pk2(f[0], f[1]); o.y = pk2(f[2], f[3]); o.z = pk2(f[4], f[5]); o.w = pk2(f[6], f[7]);
    *(u32x4*)(dst + (size_t)(dn0 + n) * dst_ld + k0 + kc) = o;
    __syncthreads();
}
__device__ __forceinline__ void phase_weights(const Params& p, int l, unsigned char* lds) {
    float* tile = (float*)lds;
    for (int it = blockIdx.x; it < 3776; it += gridDim.x) {
        if (it < 2752) {
            const int nt = it >> 3, kt = it & 7, dn0 = nt * 32;
            wt_tile(p.w_in + (size_t)l * 1024 * NIN, NIN, kt * 128, orig_col(dn0), (bf16_t*)(p.ws + OFF_WTIN), 1024, dn0, dn0 >= NIN, tile);
        } else if (it < 3264) {
            const int r = it - 2752, j = r >> 7, nt = (r >> 2) & 31, kt = r & 3;
            wt_tile(p.w_br + (size_t)(l * 4 + j) * 512 * 1024, 1024, kt * 128, nt * 32, (bf16_t*)(p.ws + OFF_WTBR) + (size_t)j * 1024 * 512, 512, nt * 32, false, tile);
        } else if (it < 3520) {
            const int r = it - 3264, nt = r >> 3, kt = r & 7;
            wt_tile(p.w_out + (size_t)l * 1024 * 1024, 1024, kt * 128, nt * 32, (bf16_t*)(p.ws + OFF_WTOUT), 1024, nt * 32, false, tile);
        } else {
            const int r = it - 3520, nt = r >> 3, kt = r & 7;
            wt_tile(p.mem_w_kv + (size_t)l * 1024 * 1024, 1024, kt * 128, nt * 32, (bf16_t*)(p.ws + OFF_WTKV), 1024, nt * 32, false, tile);
        }
    }
}

__device__ __forceinline__ void phase_filter_gen(const Params& p, int l, unsigned char* lds) {
    float* zt = (float*)lds;
    float* ha = zt + 32 * 33;
    float* hbuf = ha + 32 * 64;
    int tid_ = threadIdx.x; asm volatile("" : "+v"(tid_)); const int tid = tid_;
    const float* w1 = p.hy_w1 + (size_t)l * 33 * 64; const float* b1 = p.hy_b1 + l * 64;
    const float* wm = p.hy_wm + (size_t)l * 2 * 64 * 64; const float* bm = p.hy_bm + l * 2 * 64;
    const float* w3 = p.hy_w3 + (size_t)l * 64 * 1024;
    float* hf = (float*)(p.ws + OFF_HFILT);
    float* en = (float*)(p.ws + OFF_ENERGY) + l * 512;
    const float* ztab = (const float*)(p.ws + OFF_ZT);
    for (int it = blockIdx.x; it < 256; it += gridDim.x) {
        const int n0 = it * 32;
        for (int idx = tid; idx < 32 * 33; idx += NTHR) zt[idx] = ztab[(size_t)n0 * 33 + idx];
        __syncthreads();
        for (int idx = tid; idx < 2048; idx += NTHR) {
            const int pos = idx >> 6, j = idx & 63; float s = b1[j];
            for (int e = 0; e < 33; ++e) s += zt[pos * 33 + e] * w1[e * 64 + j];
            ha[idx] = sinf(s);
        }
        __syncthreads();
        for (int idx = tid; idx < 2048; idx += NTHR) {
            const int pos = idx >> 6, j = idx & 63; float s = bm[j];
            for (int e = 0; e < 64; ++e) s += ha[pos * 64 + e] * wm[e * 64 + j];
            hbuf[idx] = sinf(s);
        }
        __syncthreads();
        for (int idx = tid; idx < 2048; idx += NTHR) {
            const int pos = idx >> 6, j = idx & 63; float s = bm[64 + j];
            for (int e = 0; e < 64; ++e) s += hbuf[pos * 64 + e] * wm[4096 + e * 64 + j];
            ha[idx] = sinf(s);
        }
        __syncthreads();
        {
            const int c = tid;
            float af[32], ab[32];
#pragma unroll
            for (int i = 0; i < 32; ++i) { af[i] = 0.f; ab[i] = 0.f; }
            for (int k = 0; k < 64; ++k) {
                const float wf = w3[k * 1024 + c], wb = w3[k * 1024 + 512 + c];
#pragma unroll
                for (int i = 0; i < 32; ++i) { const float h = ha[i * 64 + k]; af[i] += h * wf; ab[i] += h * wb; }
            }
            const float dmin = -3.0701134573253945f, dmax = -15.350567286626973f;
            const float delta = fabsf(dmin + (float)c * ((dmax - dmin) / 511.0f));
            float e = 0.f;
#pragma unroll
            for (int i = 0; i < 32; ++i) {
                const int n = n0 + i; const float t01 = (float)n / 8191.0f; const float win = expf(-t01 * delta);
                af[i] *= win; ab[i] *= win; e += af[i] * af[i]; if (n >= 1) e += ab[i] * ab[i];
            }
#pragma unroll
            for (int i = 0; i < 8; ++i) {
                float4 a; a.x = af[4 * i]; a.y = af[4 * i + 1]; a.z = af[4 * i + 2]; a.w = af[4 * i + 3];
                float4 b; b.x = ab[4 * i]; b.y = ab[4 * i + 1]; b.z = ab[4 * i + 2]; b.w = ab[4 * i + 3];
                *(float4*)(hf + (size_t)c * 8192 + n0 + 4 * i) = a;
                *(float4*)(hf + (size_t)(512 + c) * 8192 + n0 + 4 * i) = b;
            }
            atomicAdd(en + c, e);
        }
        __syncthreads();
    }
}

__device__ __forceinline__ void phase_filter_fft(const Params& p, int l, unsigned char* lds) {
    float2* d = (float2*)lds;
    const float2* tw = fft_lds_twiddles((const float2*)(p.ws + OFF_TW), lds);
    const float* hf = (const float*)(p.ws + OFF_HFILT);
    const float* en = (const float*)(p.ws + OFF_ENERGY) + l * 512;
    float4* pqa = (float4*)(p.ws + OFF_PQ);
    int tid_ = threadIdx.x; asm volatile("" : "+v"(tid_)); const int tid = tid_;
    for (int pr = blockIdx.x; pr < 256; pr += gridDim.x) {
        const int c0 = 2 * pr, c1 = c0 + 1;
        const float s0 = 1.0f / sqrtf(en[c0] + 1e-6f), s1 = 1.0f / sqrtf(en[c1] + 1e-6f);
        const float k0 = p.hy_skip[l * 512 + c0], k1 = p.hy_skip[l * 512 + c1];
        for (int n = tid; n < FN; n += NTHR) {
            float2 v;
            if (n < 8192) { v.x = hf[(size_t)c0 * 8192 + n] * s0; v.y = hf[(size_t)c1 * 8192 + n] * s1; if (n == 0) { v.x += k0; v.y += k1; } }
            else if (n == 8192) { v.x = 0.f; v.y = 0.f; }
            else { v.x = hf[(size_t)(512 + c0) * 8192 + (FN - n)] * s0; v.y = hf[(size_t)(512 + c1) * 8192 + (FN - n)] * s1; }
            d[n] = v;
        }
        __syncthreads();
        fft_forward(d, tw, (const float2*)(p.ws + OFF_TW));
        for (int kf = tid; kf <= FN / 2; kf += NTHR) filt_pointwise(d, pqa + (size_t)pr * FN, kf);
        __syncthreads();
    }
}

__device__ __forceinline__ void hy_pre_item(const Params& p, int l, const bf16_t* P, float* UT, bf16_t* GT, int bl, int tt, int ct, unsigned char* lds) {
    float* tU = (float*)lds;
    float* tG = tU + 64 * 65;
    int tid_ = threadIdx.x; asm volatile("" : "+v"(tid_)); const int tid = tid_;
    const int t = tid >> 3, cc = (tid & 7) * 8, c = ct * 64 + cc, tb = tt * 64 + t;
    const float* cw = p.hy_conv_w + (size_t)l * 3 * 1536; const float* cb = p.hy_conv_b + l * 1536;
    float av[8], a0[8], a1[8];
#pragma unroll
    for (int h = 0; h < 2; ++h) {
        const f32x4 bv = *(const f32x4*)(cb + c + 4 * h), b0 = *(const f32x4*)(cb + 512 + c + 4 * h), b1 = *(const f32x4*)(cb + 1024 + c + 4 * h);
#pragma unroll
        for (int e = 0; e < 4; ++e) { av[4 * h + e] = bv[e]; a0[4 * h + e] = b0[e]; a1[4 * h + e] = b1[e]; }
    }
#pragma unroll
    for (int j = 0; j < 3; ++j) {
        const int ts = tb + j - 1;
        if (ts >= 0 && ts < SEQ) {
            const bf16_t* row = P + (size_t)(bl * SEQ + ts) * PS + C_HY + c;
            const u32x4 rv = *(const u32x4*)row, r0 = *(const u32x4*)(row + 512), r1 = *(const u32x4*)(row + 1024);
#pragma unroll
            for (int h = 0; h < 2; ++h) {
                const f32x4 wv = *(const f32x4*)(cw + j * 1536 + c + 4 * h), w0 = *(const f32x4*)(cw + j * 1536 + 512 + c + 4 * h), w1 = *(const f32x4*)(cw + j * 1536 + 1024 + c + 4 * h);
#pragma unroll
                for (int e = 0; e < 4; ++e) {
                    const int k = 4 * h + e; const unsigned uv = rv[k >> 1], u0 = r0[k >> 1], u1 = r1[k >> 1];
                    av[k] += wv[e] * ((k & 1) ? hi16(uv) : lo16(uv)); a0[k] += w0[e] * ((k & 1) ? hi16(u0) : lo16(u0)); a1[k] += w1[e] * ((k & 1) ? hi16(u1) : lo16(u1));
                }
            }
        }
    }
    const u32x4 rz = *(const u32x4*)(P + (size_t)(bl * SEQ + tb) * PS + C_Z + 512 + c);
#pragma unroll
    for (int k = 0; k < 8; ++k) {
        const unsigned uz = rz[k >> 1]; const float z = (k & 1) ? hi16(uz) : lo16(uz);
        tU[(cc + k) * 65 + t] = av[k] * a1[k]; tG[(cc + k) * 65 + t] = a0[k] * z;
    }
    __syncthreads();
    const int c2 = tid >> 3, t8 = (tid & 7) * 8;
    const size_t o = (size_t)(bl * 512 + ct * 64 + c2) * SEQ + tt * 64 + t8;
    const float* su = tU + c2 * 65 + t8; const float* sg = tG + c2 * 65 + t8;
    f32x4 ua = {su[0], su[1], su[2], su[3]}, ub = {su[4], su[5], su[6], su[7]};
    *(f32x4*)(UT + o) = ua; *(f32x4*)(UT + o + 4) = ub;
    u32x4 g; g.x = pk2(sg[0], sg[1]); g.y = pk2(sg[2], sg[3]); g.z = pk2(sg[4], sg[5]); g.w = pk2(sg[6], sg[7]);
    *(u32x4*)(GT + o) = g;
    __syncthreads();
}
__device__ __forceinline__ void hy_post_item(bf16_t* P, const bf16_t* GT, int bl, int tt, int ct, unsigned char* lds, int dry = 0) {
    bf16_t* tl = (bf16_t*)lds;
    int tid_ = threadIdx.x; asm volatile("" : "+v"(tid_)); const int tid = tid_;
    const int c2 = tid >> 3, t8 = (tid & 7) * 8;
    const u32x4 v = *(const u32x4*)(GT + (size_t)(bl * 512 + ct * 64 + c2) * SEQ + tt * 64 + t8);
    bf16_t* d0 = tl + t8 * 72 + c2;
    d0[0 * 72] = (bf16_t)(v.x & 0xffffu); d0[1 * 72] = (bf16_t)(v.x >> 16); d0[2 * 72] = (bf16_t)(v.y & 0xffffu); d0[3 * 72] = (bf16_t)(v.y >> 16);
    d0[4 * 72] = (bf16_t)(v.z & 0xffffu); d0[5 * 72] = (bf16_t)(v.z >> 16); d0[6 * 72] = (bf16_t)(v.w & 0xffffu); d0[7 * 72] = (bf16_t)(v.w >> 16);
    __syncthreads();
    const int t = tid >> 3, cc = (tid & 7) * 8;
    const u32x4 ov = *(const u32x4*)(tl + t * 72 + cc);
    if (!dry) *(u32x4*)(P + (size_t)(bl * SEQ + tt * 64 + t) * PS + C_HY + ct * 64 + cc) = ov;
    __syncthreads();
}
__device__ __forceinline__ void hyena_conv_item(const Params& p, const float* UT, bf16_t* GT, int bl, int pr, unsigned char* lds, const float2* tw, int dry = 0) {
    float2* d = (float2*)lds;
    const float4* pq = (const float4*)(p.ws + OFF_PQ) + (size_t)pr * FN;
    int tid_ = threadIdx.x; asm volatile("" : "+v"(tid_)); const int tid = tid_;
    const float* u0 = UT + (size_t)(bl * 512 + 2 * pr) * SEQ; const float* u1 = u0 + SEQ;
    bf16_t* g0 = GT + (size_t)(bl * 512 + 2 * pr) * SEQ; bf16_t* g1 = g0 + SEQ;
    {
        float f0[16], f1[16];
#pragma unroll
        for (int i = 0; i < 16; ++i) { f0[i] = u0[tid + NTHR * i]; f1[i] = u1[tid + NTHR * i]; }
#pragma unroll
        for (int i = 0; i < 16; ++i) {
            float2 u; u.x = f0[i]; u.y = f1[i]; d[tid + NTHR * i] = u;
            float2 z; z.x = 0.f; z.y = 0.f; d[tid + NTHR * i + SEQ] = z;
        }
    }
    __syncthreads();
    fft_forward(d, tw, (const float2*)(p.ws + OFF_TW));
#pragma unroll 1
    for (int kf = tid; kf < FN / 2; kf += 4 * NTHR) {
        PwIn w0, w1, w2, w3;
        pw_load(w0, d, pq, kf); pw_load(w1, d, pq, kf + NTHR); pw_load(w2, d, pq, kf + 2 * NTHR); pw_load(w3, d, pq, kf + 3 * NTHR);
        pw_store(w0, d); pw_store(w1, d); pw_store(w2, d); pw_store(w3, d);
    }
    if (tid == 0) conv_pointwise(d, pq, FN / 2);
    __syncthreads();
    fft_inverse(d, tw, (const float2*)(p.ws + OFF_TW));
    {
        bf16_t a0[16], a1[16];
#pragma unroll
        for (int i = 0; i < 16; ++i) { a0[i] = g0[tid + NTHR * i]; a1[i] = g1[tid + NTHR * i]; }
#pragma unroll
        for (int i = 0; i < 16; ++i) {
            const int t = tid + NTHR * i;
            const float2 y = d[t];
            const bf16_t r0 = f2bf(y.x * bf2f(a0[i])), r1 = f2bf(y.y * bf2f(a1[i]));
            if (!dry) { g0[t] = r0; g1[t] = r1; }
        }
    }
    __syncthreads();
}

__device__ __forceinline__ void na_item(const Params& p, int l, bf16_t* P, int bl, int rp, int head, unsigned char* lds, int dry = 0) {
    bf16_t* Kimg = (bf16_t*)lds;
    bf16_t* VT = (bf16_t*)(lds + 82944);
    int tid_ = threadIdx.x; asm volatile("" : "+v"(tid_)); const int tid = tid_, lane = tid & 63, w = tid >> 6, l15 = lane & 15, q4 = lane >> 4;
    const int r0 = 2 * rp, rs0 = iclamp(r0 - 4, 0, 120);
#pragma unroll
    for (int i = 0; i < 9; ++i) {
        const int idx = tid + NTHR * i, key = idx >> 3, ch = idx & 7, grow = min(rs0 + (key >> 6), 127);
        const u32x4 kv = *(const u32x4*)(P + (size_t)(bl * SEQ + grow * 64 + (key & 63)) * PS + C_NAK + head * 64 + ch * 8);
        *(u32x4*)(Kimg + key * 72 + ch * 8) = kv;
    }
#pragma unroll
    for (int i = 0; i < 9; ++i) {
        const int idx = tid + NTHR * i, keyp = idx >> 2, chh = keyp >= 576 ? 1 : 0, key = keyp - chh * 576, ch = chh * 4 + (idx & 3), grow = min(rs0 + (key >> 6), 127);
        const u32x4 vv = *(const u32x4*)(P + (size_t)(bl * SEQ + grow * 64 + (key & 63)) * PS + C_NAV + head * 64 + ch * 8);
        bf16_t* vd = VT + (ch * 8) * 584 + key;
        vd[0 * 584] = (bf16_t)(vv.x & 0xffffu); vd[1 * 584] = (bf16_t)(vv.x >> 16);
        vd[2 * 584] = (bf16_t)(vv.y & 0xffffu); vd[3 * 584] = (bf16_t)(vv.y >> 16);
        vd[4 * 584] = (bf16_t)(vv.z & 0xffffu); vd[5 * 584] = (bf16_t)(vv.z >> 16);
        vd[6 * 584] = (bf16_t)(vv.w & 0xffffu); vd[7 * 584] = (bf16_t)(vv.w >> 16);
    }
    __syncthreads();
    const int rr = w >> 2, g = w & 3, r = r0 + rr, rs = iclamp(r - 4, 0, 120), lo = rs - rs0;
    const int cb = iclamp(16 * g - 8, 0, 32), c = 16 * g + l15, cs = iclamp(c - 8, 0, 48);
    bf16_t* qrow = P + (size_t)(bl * SEQ + r * 64 + c) * PS + head * 64;
    bf16x8 qf[2];
#pragma unroll
    for (int ks = 0; ks < 2; ++ks) qf[ks] = *(const bf16x8*)(qrow + ks * 32 + q4 * 8);
    f32x4 sc[16];
#pragma unroll
    for (int t = 0; t < 16; ++t) {
        const int kb = (lo + (t >> 1)) * 64 + cb + 16 * (t & 1);
        f32x4 a = {0.f, 0.f, 0.f, 0.f};
#pragma unroll
        for (int ks = 0; ks < 2; ++ks) { const bf16x8 kf = *(const bf16x8*)(Kimg + (kb + l15) * 72 + ks * 32 + q4 * 8); a = MFMA(kf, qf[ks], a); }
        sc[t] = a;
    }
    const float* rpb = p.na_rpb + (size_t)(l * 8 + head) * 15 * 31;
    float mx = -1e30f;
#pragma unroll
    for (int t = 0; t < 16; ++t) {
        const int drow = rs + (t >> 1) - r + 7;
#pragma unroll
        for (int e = 0; e < 4; ++e) {
            const int col = cb + 16 * (t & 1) + 4 * q4 + e;
            const bool ok = (col >= cs) && (col < cs + 16);
            const int dcol = ok ? (col - c + 15) : 0;
            const float v = ok ? (sc[t][e] + rpb[drow * 31 + dcol]) : -1e30f;
            sc[t][e] = v; mx = fmaxf(mx, v);
        }
    }
    mx = fmaxf(mx, __shfl_xor(mx, 16)); mx = fmaxf(mx, __shfl_xor(mx, 32));
    float sum = 0.f;
#pragma unroll
    for (int t = 0; t < 16; ++t)
#pragma unroll
        for (int e = 0; e < 4; ++e) { const float pe = __expf(sc[t][e] - mx); sc[t][e] = pe; sum += pe; }
    sum += __shfl_xor(sum, 16); sum += __shfl_xor(sum, 32);
    f32x4 o[4];
#pragma unroll
    for (int dt = 0; dt < 4; ++dt) o[dt] = (f32x4){0.f, 0.f, 0.f, 0.f};
#pragma unroll
    for (int kk = 0; kk < 8; ++kk) {
        u32x4 pu; pu.x = pk2(sc[2 * kk][0], sc[2 * kk][1]); pu.y = pk2(sc[2 * kk][2], sc[2 * kk][3]); pu.z = pk2(sc[2 * kk + 1][0], sc[2 * kk + 1][1]); pu.w = pk2(sc[2 * kk + 1][2], sc[2 * kk + 1][3]);
        const bf16x8 pf = mkfrag(pu);
        const int kbA = (lo + kk) * 64 + cb + 4 * q4;
#pragma unroll
        for (int dt = 0; dt < 4; ++dt) {
            const bf16_t* vr = VT + (dt * 16 + l15) * 584 + kbA;
            const bf16x8 vf = mkfrag2(*(const u32x2*)vr, *(const u32x2*)(vr + 16));
            o[dt] = MFMA(vf, pf, o[dt]);
        }
    }
    const float inv = 1.0f / sum;
    const bf16_t* zrow = P + (size_t)(bl * SEQ + r * 64 + c) * PS + C_Z + head * 64;
#pragma unroll
    for (int dt = 0; dt < 4; ++dt) {
        const int dd = dt * 16 + 4 * q4;
        const f32x4 z = ld_bf4(zrow + dd);
        if (!dry) st_bf4(qrow + dd, o[dt] * inv * z);
    }
    __syncthreads();
}

__device__ __forceinline__ void memattn_load(const Params& p, int b, int h, unsigned char* lds) {
    bf16_t* Kimg = (bf16_t*)lds;
    bf16_t* VT = (bf16_t*)(lds + 69632);
    const bf16_t* Km = (const bf16_t*)(p.ws + OFF_KMAT); const bf16_t* Vm = (const bf16_t*)(p.ws + OFF_VT);
    int tid_ = threadIdx.x; asm volatile("" : "+v"(tid_)); const int tid = tid_;
#pragma unroll
    for (int i = 0; i < 8; ++i) {
        const int idx = tid + NTHR * i;
        { const int key = idx >> 4, ch = idx & 15; *(u32x4*)(Kimg + key * 136 + ch * 8) = *(const u32x4*)(Km + (size_t)(b * 256 + key) * 512 + h * 128 + ch * 8); }
        { const int dd = idx >> 5, ch = idx & 31; *(u32x4*)(VT + dd * 264 + ch * 8) = *(const u32x4*)(Vm + (size_t)(h * 128 + dd) * 2048 + b * 256 + ch * 8); }
    }
    __syncthreads();
}
__device__ __forceinline__ void memattn_item(bf16_t* P, int bl, int h, int qt, unsigned char* lds, int dry = 0) {
    const bf16_t* Kimg = (const bf16_t*)lds; const bf16_t* VT = (const bf16_t*)(lds + 69632);
    int tid_ = threadIdx.x; asm volatile("" : "+v"(tid_)); const int tid = tid_, lane = tid & 63, w = tid >> 6, l15 = lane & 15, q4 = lane >> 4;
    const int tok = bl * SEQ + qt * 128 + w * 16 + l15;
    bf16_t* qrow = P + (size_t)tok * PS + C_MQ + h * 128;
    bf16x8 qf[4];
#pragma unroll
    for (int ks = 0; ks < 4; ++ks) qf[ks] = *(const bf16x8*)(qrow + ks * 32 + q4 * 8);
    f32x4 sc[16];
    float mx = -1e30f;
#pragma unroll
    for (int t = 0; t < 16; ++t) {
        f32x4 a = {0.f, 0.f, 0.f, 0.f};
#pragma unroll
        for (int ks = 0; ks < 4; ++ks) { const bf16x8 kf = *(const bf16x8*)(Kimg + (t * 16 + l15) * 136 + ks * 32 + q4 * 8); a = MFMA(kf, qf[ks], a); }
        sc[t] = a;
        mx = fmaxf(mx, fmaxf(fmaxf(a[0], a[1]), fmaxf(a[2], a[3])));
    }
    mx = fmaxf(mx, __shfl_xor(mx, 16)); mx = fmaxf(mx, __shfl_xor(mx, 32));
    float sum = 0.f;
#pragma unroll
    for (int t = 0; t < 16; ++t)
#pragma unroll
        for (int e = 0; e < 4; ++e) { const float pe = __expf(sc[t][e] - mx); sc[t][e] = pe; sum += pe; }
    sum += __shfl_xor(sum, 16); sum += __shfl_xor(sum, 32);
    f32x4 o[8];
#pragma unroll
    for (int dt = 0; dt < 8; ++dt) o[dt] = (f32x4){0.f, 0.f, 0.f, 0.f};
#pragma unroll
    for (int kk = 0; kk < 8; ++kk) {
        u32x4 pu; pu.x = pk2(sc[2 * kk][0], sc[2 * kk][1]); pu.y = pk2(sc[2 * kk][2], sc[2 * kk][3]); pu.z = pk2(sc[2 * kk + 1][0], sc[2 * kk + 1][1]); pu.w = pk2(sc[2 * kk + 1][2], sc[2 * kk + 1][3]);
        const bf16x8 pf = mkfrag(pu);
#pragma unroll
        for (int dt = 0; dt < 8; ++dt) {
            const bf16_t* vr = VT + (dt * 16 + l15) * 264 + kk * 32 + 4 * q4;
            const bf16x8 vf = mkfrag2(*(const u32x2*)vr, *(const u32x2*)(vr + 16));
            o[dt] = MFMA(vf, pf, o[dt]);
        }
    }
    const float inv = 1.0f / sum;
    const bf16_t* zrow = P + (size_t)tok * PS + C_Z + 3 * 512 + h * 128;
#pragma unroll
    for (int dt = 0; dt < 8; ++dt) {
        const int dd = dt * 16 + 4 * q4;
        const f32x4 z = ld_bf4(zrow + dd);
        if (!dry) st_bf4(qrow + dd, o[dt] * inv * z);
    }
}

constexpr int G_LRT = 0, G_BF = 8192, G_BB = 24576, G_TOT = 40960, G_IMG = 45056;
__device__ __forceinline__ void gla_tables(const Params& p, int l, const float* LR, int t0, int h, unsigned char* lds) {
    float* LRT = (float*)(lds + G_LRT); float* BF = (float*)(lds + G_BF); float* BB = (float*)(lds + G_BB); float* TOT = (float*)(lds + G_TOT);
    int tid_ = threadIdx.x; asm volatile("" : "+v"(tid_)); const int tid = tid_;
    ((float4*)LRT)[tid] = ((const float4*)(LR + (size_t)t0 * 32))[tid];
    __syncthreads();
    const int dk = tid & 63, cgp = tid >> 6;
    float uf[16], ub[16];
#pragma unroll
    for (int r = 0; r < 16; ++r) { uf[r] = p.gla_up_f[(size_t)(l * 16 + r) * 256 + h * 64 + dk]; ub[r] = p.gla_up_b[(size_t)(l * 16 + r) * 256 + h * 64 + dk]; }
    const float bif = p.gla_bias_f[l * 256 + h * 64 + dk], bib = p.gla_bias_b[l * 256 + h * 64 + dk];
    float lf[8], lb[8];
#pragma unroll
    for (int i = 0; i < 8; ++i) {
        const int c = cgp * 8 + i; float sf = bif, sb = bib;
#pragma unroll
        for (int r = 0; r < 16; ++r) { sf += LRT[c * 32 + r] * uf[r]; sb += LRT[c * 32 + 16 + r] * ub[r]; }
        lf[i] = logsigf_(sf) * (1.0f / 16.0f); lb[i] = logsigf_(sb) * (1.0f / 16.0f);
    }
#pragma unroll
    for (int i = 1; i < 8; ++i) lf[i] += lf[i - 1];
#pragma unroll
    for (int i = 6; i >= 0; --i) lb[i] += lb[i + 1];
    TOT[cgp * 64 + dk] = lf[7]; TOT[512 + cgp * 64 + dk] = lb[0];
    __syncthreads();
    float of = 0.f, ob = 0.f;
#pragma unroll
    for (int g2 = 0; g2 < 8; ++g2) { if (g2 < cgp) of += TOT[g2 * 64 + dk]; if (g2 > cgp) ob += TOT[512 + g2 * 64 + dk]; }
#pragma unroll
    for (int i = 0; i < 8; ++i) { BF[(cgp * 8 + i) * 64 + dk] = lf[i] + of; BB[(cgp * 8 + i) * 64 + dk] = lb[i] + ob; }
    __syncthreads();
}
struct GlaPre { u32x4 vv[2]; bf16_t q[8], k[8]; };
__device__ __forceinline__ void gla_prefetch(GlaPre& g, const bf16_t* P, int t0, int h, int tid) {
#pragma unroll
    for (int i = 0; i < 2; ++i) { const int idx = tid + NTHR * i, chn = idx >> 6, c = idx & 63; g.vv[i] = *(const u32x4*)(P + (size_t)(t0 + c) * PS + C_GV + h * 128 + chn * 8); }
#pragma unroll
    for (int i = 0; i < 8; ++i) { const int idx = tid + NTHR * i, c = idx >> 6, dk = idx & 63; g.q[i] = P[(size_t)(t0 + c) * PS + C_GQ + h * 64 + dk]; g.k[i] = P[(size_t)(t0 + c) * PS + C_GK + h * 64 + dk]; }
}
__device__ __forceinline__ void gla_vt_store(const GlaPre& g, bf16_t* VT, int tid) {
#pragma unroll
    for (int i = 0; i < 2; ++i) {
        const int idx = tid + NTHR * i, chn = idx >> 6, c = idx & 63;
        const u32x4 vv = g.vv[i];
        bf16_t* vd = VT + (chn * 8) * 72 + c;
        vd[0 * 72] = (bf16_t)(vv.x & 0xffffu); vd[1 * 72] = (bf16_t)(vv.x >> 16);
        vd[2 * 72] = (bf16_t)(vv.y & 0xffffu); vd[3 * 72] = (bf16_t)(vv.y >> 16);
        vd[4 * 72] = (bf16_t)(vv.z & 0xffffu); vd[5 * 72] = (bf16_t)(vv.z >> 16);
        vd[6 * 72] = (bf16_t)(vv.w & 0xffffu); vd[7 * 72] = (bf16_t)(vv.w >> 16);
    }
}
__device__ __forceinline__ void gla_part1_item(const Params& p, int l, const bf16_t* P, const float* LR, int item, unsigned char* lds) {
    const int h = item & 3, n = (item >> 2) & 127, bl = item >> 9, t0 = bl * SEQ + n * 64;
    const float* BF = (const float*)(lds + G_BF); const float* BB = (const float*)(lds + G_BB);
    bf16_t* KDT0 = (bf16_t*)(lds + G_IMG); bf16_t* KDT1 = KDT0 + 64 * 72; bf16_t* VT = KDT1 + 64 * 72;
    float* GS = (float*)(p.ws + OFF_GS); float* GD = (float*)(p.ws + OFF_GDEC);
    int tid_ = threadIdx.x; asm volatile("" : "+v"(tid_)); const int tid = tid_, lane = tid & 63, w = tid >> 6, l15 = lane & 15, q4 = lane >> 4;
    GlaPre gp; gla_prefetch(gp, P, t0, h, tid);
    gla_tables(p, l, LR, t0, h, lds);
#pragma unroll
    for (int i = 0; i < 8; ++i) {
        const int idx = tid + NTHR * i, c = idx >> 6, dk = idx & 63;
        const float kv = bf2f(gp.k[i]);
        KDT0[dk * 72 + c] = f2bf(kv * __expf(BF[63 * 64 + dk] - BF[c * 64 + dk]));
        KDT1[dk * 72 + c] = f2bf(kv * __expf(BB[dk] - BB[c * 64 + dk]));
    }
    gla_vt_store(gp, VT, tid);
    if (tid < 64) GD[(size_t)item * 64 + tid] = __expf(BF[63 * 64 + tid]);
    else if (tid < 128) GD[(size_t)(NITEM + item) * 64 + tid - 64] = __expf(BB[tid - 64]);
    __syncthreads();
    const int dir = w >> 2, dkt = w & 3;
    const bf16_t* KD = dir ? KDT1 : KDT0;
    bf16x8 kf[2];
#pragma unroll
    for (int ks = 0; ks < 2; ++ks) kf[ks] = *(const bf16x8*)(KD + (16 * dkt + l15) * 72 + 32 * ks + 8 * q4);
    float* dst = GS + ((size_t)dir * NITEM + item) * 8192;
#pragma unroll
    for (int dvt = 0; dvt < 8; ++dvt) {
        f32x4 a = {0.f, 0.f, 0.f, 0.f};
#pragma unroll
        for (int ks = 0; ks < 2; ++ks) { const bf16x8 vf = *(const bf16x8*)(VT + (16 * dvt + l15) * 72 + 32 * ks + 8 * q4); a = MFMA(kf[ks], vf, a); }
        *(f32x4*)(dst + (16 * dvt + l15) * 64 + 16 * dkt + 4 * q4) = a;
    }
    __syncthreads();
}
__device__ __forceinline__ void gla_scan(const Params& p, int dry = 0) {
    float* GS = (float*)(p.ws + OFF_GS); const float* GD = (const float*)(p.ws + OFF_GDEC);
    const int total = 2 * BG * 4 * 8192;
    int tid_ = threadIdx.x; asm volatile("" : "+v"(tid_));
    for (int id = blockIdx.x * NTHR + tid_; id < total; id += gridDim.x * NTHR) {
        const int e = id & 8191, comb = id >> 13, h = comb & 3, bl = (comb >> 2) % BG, dir = comb / (4 * BG), dk = e & 63;
        float S = 0.f;
        const size_t ibase = (size_t)dir * NITEM + (size_t)(bl * 128) * 4 + h;
        for (int s0 = 0; s0 < 128; s0 += 16) {
            float u[16], dc[16];
#pragma unroll
            for (int i = 0; i < 16; ++i) {
                const int n = dir ? 127 - (s0 + i) : s0 + i;
                const size_t item = ibase + (size_t)n * 4;
                u[i] = GS[item * 8192 + e]; dc[i] = GD[item * 64 + dk];
            }
#pragma unroll
            for (int i = 0; i < 16; ++i) {
                const int n = dir ? 127 - (s0 + i) : s0 + i;
                const size_t item = ibase + (size_t)n * 4;
                if (!dry) GS[item * 8192 + e] = S;
                S = dc[i] * S + u[i];
            }
        }
    }
}
__device__ __forceinline__ void gla_part2_item(const Params& p, int l, bf16_t* P, const float* LR, int item, unsigned char* lds, int dry = 0) {
    const int h = item & 3, n = (item >> 2) & 127, bl = item >> 9, t0 = bl * SEQ + n * 64;
    const float* BF = (const float*)(lds + G_BF); const float* BB = (const float*)(lds + G_BB);
    bf16_t* QF = (bf16_t*)(lds + G_IMG);
    bf16_t* KF = QF + 2 * 64 * 72;
    bf16_t* QD = KF + 2 * 64 * 72;
    bf16_t* VT = QD + 2 * 64 * 72;
    bf16_t* ST = VT + 128 * 72;
    float* OX = (float*)lds;
    const float* GS = (const float*)(p.ws + OFF_GS);
    int tid_ = threadIdx.x; asm volatile("" : "+v"(tid_)); const int tid = tid_, lane = tid & 63, w = tid >> 6, l15 = lane & 15, q4 = lane >> 4;
    GlaPre gp; gla_prefetch(gp, P, t0, h, tid);
    float4 sp[2][4];
#pragma unroll
    for (int dir = 0; dir < 2; ++dir)
#pragma unroll
        for (int i = 0; i < 4; ++i) { const int idx = tid + NTHR * i; sp[dir][i] = *(const float4*)(GS + ((size_t)dir * NITEM + item) * 8192 + (idx >> 4) * 64 + (idx & 15) * 4); }
    gla_tables(p, l, LR, t0, h, lds);
#pragma unroll
    for (int i = 0; i < 8; ++i) {
        const int idx = tid + NTHR * i, c = idx >> 6, dk = idx & 63;
        const float qv = bf2f(gp.q[i]);
        const float kv = bf2f(gp.k[i]);
        const float bf = BF[c * 64 + dk], mf = BF[31 * 64 + dk], bb = BB[c * 64 + dk], mb = BB[32 * 64 + dk];
        QF[c * 72 + dk] = f2bf(qv * __expf(bf - mf)); KF[c * 72 + dk] = f2bf(kv * __expf(mf - bf)); QD[c * 72 + dk] = f2bf(qv * __expf(bf));
        QF[4608 + c * 72 + dk] = f2bf(qv * __expf(bb - mb)); KF[4608 + c * 72 + dk] = f2bf(kv * __expf(mb - bb)); QD[4608 + c * 72 + dk] = f2bf(qv * __expf(bb));
    }
    gla_vt_store(gp, VT, tid);
#pragma unroll
    for (int dir = 0; dir < 2; ++dir) {
#pragma unroll
        for (int i = 0; i < 4; ++i) {
            const int idx = tid + NTHR * i, dv = idx >> 4, dk4 = (idx & 15) * 4;
            const float4 s = sp[dir][i];
            u32x2 o; o.x = pk2(s.x, s.y); o.y = pk2(s.z, s.w);
            *(u32x2*)(ST + dir * 9216 + dv * 72 + dk4) = o;
        }
    }
    __syncthreads();
    const int dir = w >> 2, ct = w & 3;
    const bf16_t* qfp = QF + dir * 4608; const bf16_t* kfp = KF + dir * 4608; const bf16_t* qdp = QD + dir * 4608; const bf16_t* stp = ST + dir * 9216;
    bf16x8 qf[2], qd[2];
#pragma unroll
    for (int ks = 0; ks < 2; ++ks) { qf[ks] = *(const bf16x8*)(qfp + (16 * ct + l15) * 72 + 32 * ks + 8 * q4); qd[ks] = *(const bf16x8*)(qdp + (16 * ct + l15) * 72 + 32 * ks + 8 * q4); }
    f32x4 sc[4];
    const int cq = 16 * ct + l15;
#pragma unroll
    for (int st = 0; st < 4; ++st) {
        f32x4 a = {0.f, 0.f, 0.f, 0.f};
#pragma unroll
        for (int ks = 0; ks < 2; ++ks) { const bf16x8 kf = *(const bf16x8*)(kfp + (16 * st + l15) * 72 + 32 * ks + 8 * q4); a = MFMA(kf, qf[ks], a); }
#pragma unroll
        for (int e = 0; e < 4; ++e) { const int s = 16 * st + 4 * q4 + e; const bool ok = dir ? (s > cq) : (s <= cq); a[e] = ok ? a[e] : 0.f; }
        sc[st] = a;
    }
    f32x4 o[8];
#pragma unroll
    for (int dt = 0; dt < 8; ++dt) o[dt] = (f32x4){0.f, 0.f, 0.f, 0.f};
#pragma unroll
    for (int kk = 0; kk < 2; ++kk) {
        u32x4 pu; pu.x = pk2(sc[2 * kk][0], sc[2 * kk][1]); pu.y = pk2(sc[2 * kk][2], sc[2 * kk][3]); pu.z = pk2(sc[2 * kk + 1][0], sc[2 * kk + 1][1]); pu.w = pk2(sc[2 * kk + 1][2], sc[2 * kk + 1][3]);
        const bf16x8 pf = mkfrag(pu);
#pragma unroll
        for (int dt = 0; dt < 8; ++dt) {
            const bf16_t* vr = VT + (dt * 16 + l15) * 72 + kk * 32 + 4 * q4;
            const bf16x8 vf = mkfrag2(*(const u32x2*)vr, *(const u32x2*)(vr + 16));
            o[dt] = MFMA(vf, pf, o[dt]);
        }
    }
#pragma unroll
    for (int ks = 0; ks < 2; ++ks)
#pragma unroll
        for (int dt = 0; dt < 8; ++dt) { const bf16x8 sf = *(const bf16x8*)(stp + (dt * 16 + l15) * 72 + 32 * ks + 8 * q4); o[dt] = MFMA(sf, qd[ks], o[dt]); }
    if (dir == 1) {
#pragma unroll
        for (int dt = 0; dt < 8; ++dt) *(f32x4*)(OX + cq * 132 + 16 * dt + 4 * q4) = o[dt];
    }
    __syncthreads();
    if (dir == 0) {
        float ss = 0.f;
#pragma unroll
        for (int dt = 0; dt < 8; ++dt) { o[dt] += *(const f32x4*)(OX + cq * 132 + 16 * dt + 4 * q4); ss += (o[dt][0] * o[dt][0] + o[dt][1] * o[dt][1]) + (o[dt][2] * o[dt][2] + o[dt][3] * o[dt][3]); }
        ss += __shfl_xor(ss, 16); ss += __shfl_xor(ss, 32);
        const float rms = 1.0f / sqrtf(ss * (1.0f / 128.0f) + 1e-6f);
        const float* ng = p.gla_norm_g + l * 512 + h * 128;
        const bf16_t* zrow = P + (size_t)(t0 + cq) * PS + C_Z + 2 * 512 + h * 128;
        bf16_t* orow = P + (size_t)(t0 + cq) * PS + C_GV + h * 128;
#pragma unroll
        for (int dt = 0; dt < 8; ++dt) {
            const int dd = 16 * dt + 4 * q4;
            const f32x4 z = ld_bf4(zrow + dd); const f32x4 g4 = *(const f32x4*)(ng + dd);
            if (!dry) st_bf4(orow + dd, o[dt] * rms * g4 * z);
        }
    }
    __syncthreads();
}

namespace pg8 {
#define PG8_LAS __attribute__((address_space(3)))
typedef unsigned short bf16_t;
typedef short bf16x8 __attribute__((ext_vector_type(8)));
typedef float f32x4 __attribute__((ext_vector_type(4)));
typedef unsigned u32x4 __attribute__((ext_vector_type(4)));
constexpr int BM = 256, BK = 64, HALF = 128, HTB = HALF * BK * 2  , STAGE_BYTES = 8 * HTB, NXCD = 8, WGM = 8;

__host__ __device__ __forceinline__ int lds_byte(int r, int c) { const int st = (r >> 4) * 2 + (c >> 5), rr = r & 15, cc = c & 31, ob = rr * 64 + cc * 2; return st * 1024 + (ob ^ (((ob >> 9) & 1) << 5)); }
__host__ __device__ __forceinline__ void stage_rc(int b, int& R, int& C) { const int st = b / 1024, sb = b % 1024, swz = sb ^ (((sb >> 9) & 1) << 5); R = (st >> 1) * 16 + swz / 64; C = (st & 1) * 32 + (swz % 64) / 2; }
__host__ __device__ __forceinline__ int perm32(int rho) { const int n = rho >> 4, i = rho & 15; return 8 * (i >> 2) + 4 * n + (i & 3); }

struct Unit { int pm, pn; };
struct Gemm { const bf16_t* A; const bf16_t* Bt; int M, N, K; };

struct StaticOrder {
    int nM, nN, nwg, G, c;
    __host__ __device__ __forceinline__ void init(int M, int N, int G_, int c_) { nM = M / BM; nN = N / BM; nwg = nM * nN; G = G_; c = c_; }
    __host__ __device__ bool next(int i, Unit& u) const {
        const long L = (long)i * G + c; if (L >= nwg) return false;
        int wgid = (int)L; { const int q = nwg / NXCD, r = nwg % NXCD, xcd = wgid % NXCD, off = wgid / NXCD; wgid = (xcd < r ? xcd * (q + 1) : r * (q + 1) + (xcd - r) * q) + off; }
        const int nig = WGM * nN, gid = wgid / nig, fm = gid * WGM, gsz = (nM - fm) < WGM ? (nM - fm) : WGM;
        u.pm = fm + ((wgid % nig) % gsz); u.pn = (wgid % nig) / gsz; return true;
    }
    __device__ __forceinline__ void a_ready(const Unit&) const {}
    __device__ __forceinline__ void done(const Unit&) const {}
};
__device__ __forceinline__ unsigned cvt_pk_bf16(float lo, float hi) { unsigned r; asm volatile("v_cvt_pk_bf16_f32 %0, %1, %2" : "=v"(r) : "v"(lo), "v"(hi)); return r; }
template <class Epi, class Sched, bool STAMP = false>
__device__ __forceinline__ void gemm_phase(PG8_LAS unsigned char* lds, const Gemm g, const Sched& S, const Epi& E, unsigned long long* stamps) {
    int tid_l = threadIdx.x; asm volatile("" : "+v"(tid_l)); const int tid = tid_l, wid = __builtin_amdgcn_readfirstlane(tid >> 6), lane = tid & 63, wr = wid >> 2, wc = wid & 3, fr = lane & 15, fq = lane >> 4;
    const int K = g.K, nt = K / BK;
    int ts_lo = 0, ts_hi = 0, nts = 0; const unsigned long long rt_entry = STAMP ? (unsigned long long)wall_clock64() : 0ull;
#define PG8_STAMP() do { if (STAMP && wid == 0 && nts < 64) { const unsigned long long _c = (unsigned long long)clock64(); \
        ts_lo = (lane == nts) ? (int)(unsigned)_c : ts_lo; ts_hi = (lane == nts) ? (int)(unsigned)(_c >> 32) : ts_hi; ++nts; } } while (0)
    PG8_STAMP();
    unsigned voffA[2], voffB[2];
#pragma unroll
    for (int i = 0; i < 2; ++i) { int R, C; stage_rc(tid * 16 + i * 8192, R, C); const int Rb = Epi::PERM ? ((R & ~31) + perm32(R & 31)) : R;
        voffA[i] = (unsigned)(R * K + C) * 2u; voffB[i] = (unsigned)(Rb * K + C) * 2u; }
    const size_t kstep = (size_t)(BK * 2);
    const size_t hstep = (size_t)HALF * K * 2;
    const size_t tstep = 2 * hstep;
    const unsigned ldsw = (unsigned)wid * 1024u;
    const int aoff = lds_byte(wr * 64 + fr, fq * 8), boff = lds_byte(wc * 32 + fr, fq * 8);
#define PG8_SA(b, h) (((b) * 2 + (h)) * HTB)
#define PG8_SB(b, h) ((4 + (b) * 2 + (h)) * HTB)
#define PG8_STAGE(bufoff, gbase, voff) do { _Pragma("unroll") for (int _i = 0; _i < 2; ++_i) \
        __builtin_amdgcn_global_load_lds((const unsigned*)((const char*)(gbase) + (voff)[_i]), (PG8_LAS unsigned*)(lds + (bufoff) + ldsw + _i * 8192), 16, 0, 0); } while (0)
#define PG8_LDA(dst, b, h) do { _Pragma("unroll") for (int m = 0; m < 4; ++m) _Pragma("unroll") for (int k = 0; k < 2; ++k) dst[m][k] = *(const PG8_LAS bf16x8*)(lds + PG8_SA(b, h) + aoff + m * 2048 + k * 1024); } while (0)
#define PG8_LDB(dst, b, h) do { _Pragma("unroll") for (int n = 0; n < 2; ++n) _Pragma("unroll") for (int k = 0; k < 2; ++k) dst[n][k] = *(const PG8_LAS bf16x8*)(lds + PG8_SB(b, h) + boff + n * 2048 + k * 1024); } while (0)
#define PG8_MMA(ai, bj, At, Bt) do { __builtin_amdgcn_s_setprio(1); _Pragma("unroll") for (int m = 0; m < 4; ++m) _Pragma("unroll") for (int n = 0; n < 2; ++n) _Pragma("unroll") for (int k = 0; k < 2; ++k) \
        acc[ai][bj][m][n] = __builtin_amdgcn_mfma_f32_16x16x32_bf16(Bt[n][k], At[m][k], acc[ai][bj][m][n], 0, 0, 0); __builtin_amdgcn_s_setprio(0); } while (0)
#define PG8_WAIT_V(n) asm volatile("s_waitcnt vmcnt(" #n ")" ::: "memory")
#define PG8_WAIT_L(n) asm volatile("s_waitcnt lgkmcnt(" #n ")" ::: "memory")
#define PG8_BAR __builtin_amdgcn_s_barrier()
#define PG8_SCHED __builtin_amdgcn_sched_barrier(0)
    Unit cur, nxt; int ui = 0;
    if (!S.next(0, cur)) return;
    f32x4 acc[2][2][4][2];
#pragma unroll
    for (int a = 0; a < 2; ++a)
#pragma unroll
        for (int b = 0; b < 2; ++b)
#pragma unroll
            for (int m = 0; m < 4; ++m)
#pragma unroll
                for (int n = 0; n < 2; ++n) acc[a][b][m][n] = (f32x4){0.f, 0.f, 0.f, 0.f};
    bf16x8 At[4][2], B0[2][2], B1[2][2];
    const char* cA = (const char*)g.A + (size_t)cur.pm * tstep; const char* cB = (const char*)g.Bt + (size_t)cur.pn * tstep;
    S.a_ready(cur);
    PG8_STAGE(PG8_SB(0, 0), cB, voffB); PG8_STAGE(PG8_SA(0, 0), cA, voffA); PG8_STAGE(PG8_SB(0, 1), cB + hstep, voffB); PG8_STAGE(PG8_SA(0, 1), cA + hstep, voffA);
    if (wr == 1) PG8_BAR;
    PG8_WAIT_V(4); PG8_BAR;
    PG8_STAGE(PG8_SB(1, 0), cB + kstep, voffB); PG8_STAGE(PG8_SA(1, 0), cA + kstep, voffA); PG8_STAGE(PG8_SB(1, 1), cB + hstep + kstep, voffB);
    PG8_WAIT_V(6); PG8_BAR;
    PG8_STAMP();
    for (;;) {
        const bool has_next = S.next(ui + 1, nxt);
        const char* nA = has_next ? (const char*)g.A + (size_t)nxt.pm * tstep : cA; const char* nB = has_next ? (const char*)g.Bt + (size_t)nxt.pn * tstep : cB;
        for (int t = 0; t < nt; t += 2) {
            const bool last = (t == nt - 2);
            const char* a1 = cA + (size_t)(t + 1) * kstep;
            const char* a2 = last ? nA : cA + (size_t)(t + 2) * kstep; const char* b2 = last ? nB : cB + (size_t)(t + 2) * kstep;
            const char* a3 = a2 + kstep; const char* b3 = b2 + kstep;
            if (last && has_next) S.a_ready(nxt);
            PG8_LDB(B0, 0, 0); PG8_SCHED; PG8_LDA(At, 0, 0); PG8_STAGE(PG8_SA(1, 1), a1 + hstep, voffA);
            PG8_WAIT_L(8); PG8_BAR; PG8_WAIT_L(0); PG8_MMA(0, 0, At, B0); PG8_BAR; PG8_SCHED;
            PG8_LDB(B1, 0, 1); PG8_STAGE(PG8_SB(0, 0), b2, voffB);
            PG8_BAR; PG8_WAIT_L(0); PG8_MMA(0, 1, At, B1); PG8_BAR;
            PG8_LDA(At, 0, 1); PG8_STAGE(PG8_SA(0, 0), a2, voffA);
            PG8_BAR; PG8_WAIT_L(0); PG8_MMA(1, 0, At, B0); PG8_BAR; PG8_SCHED;
            PG8_STAGE(PG8_SB(0, 1), b2 + hstep, voffB);
            PG8_WAIT_V(6); PG8_BAR; PG8_MMA(1, 1, At, B1); PG8_BAR;
            PG8_LDB(B0, 1, 0); PG8_SCHED; PG8_LDA(At, 1, 0); PG8_STAGE(PG8_SA(0, 1), a2 + hstep, voffA);
            PG8_WAIT_L(8); PG8_BAR; PG8_WAIT_L(0); PG8_MMA(0, 0, At, B0); PG8_BAR; PG8_SCHED;
            PG8_LDB(B1, 1, 1); PG8_STAGE(PG8_SB(1, 0), b3, voffB);
            PG8_BAR; PG8_WAIT_L(0); PG8_MMA(0, 1, At, B1); PG8_BAR;
            PG8_LDA(At, 1, 1); PG8_STAGE(PG8_SA(1, 0), a3, voffA);
            PG8_BAR; PG8_WAIT_L(0); PG8_MMA(1, 0, At, B0); PG8_BAR; PG8_SCHED;
            PG8_STAGE(PG8_SB(1, 1), b3 + hstep, voffB);
            PG8_WAIT_V(6); PG8_BAR; PG8_MMA(1, 1, At, B1); PG8_BAR;
        }
        PG8_STAMP();
        if constexpr (!Epi::AFTER_DRAIN) { E(acc, cur, wr, wc, fr, fq); S.done(cur); }
        PG8_STAMP();
        if (!has_next) break;
#pragma unroll
        for (int a = 0; a < 2; ++a)
#pragma unroll
            for (int b = 0; b < 2; ++b)
#pragma unroll
                for (int m = 0; m < 4; ++m)
#pragma unroll
                    for (int n = 0; n < 2; ++n) acc[a][b][m][n] = (f32x4){0.f, 0.f, 0.f, 0.f};
        cur = nxt; cA = nA; cB = nB; ++ui;
    }
    PG8_WAIT_V(0);
    if (wr == 0) PG8_BAR;
    PG8_BAR;
    if constexpr (Epi::AFTER_DRAIN) { E.fused(acc, cur, wr, wc, fr, fq, lds, wid, lane); S.done(cur); }
    PG8_STAMP();
    if (STAMP && wid == 0) { stamps[lane] = lane < nts ? (((unsigned long long)(unsigned)ts_hi << 32) | (unsigned)ts_lo) : 0ull;
        if (lane == 62) stamps[62] = rt_entry; if (lane == 63) stamps[63] = (unsigned long long)wall_clock64(); }
#undef PG8_STAMP
#undef PG8_SA
#undef PG8_SB
#undef PG8_STAGE
#undef PG8_LDA
#undef PG8_LDB
#undef PG8_MMA
#undef PG8_WAIT_V
#undef PG8_WAIT_L
#undef PG8_BAR
#undef PG8_SCHED
}
}

struct EpiInProj {
    static constexpr bool PERM = false, AFTER_DRAIN = false;
    bf16_t* P; const float* bias; float* LR;
    __device__ __forceinline__ void operator()(const f32x4 (&acc)[2][2][4][2], const pg8::Unit& u, int wr, int wc, int fr, int fq) const {
        const int row0 = u.pm * 256 + wr * 64 + fr, colt = u.pn * 256, col0 = colt + wc * 32 + 4 * fq;
        if (colt == C_LR) {
            if (wc == 0) {
#pragma unroll
                for (int n = 0; n < 2; ++n) {
                    const int cl = 4 * fq + n * 16;
                    const f32x4 b0 = *(const f32x4*)(bias + 4096 + cl);
#pragma unroll
                    for (int ai = 0; ai < 2; ++ai)
#pragma unroll
                        for (int m = 0; m < 4; ++m) *(f32x4*)(LR + (size_t)(row0 + ai * 128 + m * 16) * 32 + cl) = acc[ai][0][m][n] + b0;
                }
            }
            return;
        }
        const int mode = (colt < 512 || colt == C_GQ) ? 1 : (colt >= C_MQ && colt < C_Z) ? 2 : (colt >= C_Z && colt < C_SG) ? 3 : (colt >= C_SG) ? 4 : 0;
#pragma unroll
        for (int bj = 0; bj < 2; ++bj)
#pragma unroll
            for (int n = 0; n < 2; ++n) {
                const int col = col0 + bj * 128 + n * 16;
                const f32x4 b0 = *(const f32x4*)(bias + orig_col(col));
#pragma unroll
                for (int ai = 0; ai < 2; ++ai)
#pragma unroll
                    for (int m = 0; m < 4; ++m) {
                        f32x4 v0 = acc[ai][bj][m][n] + b0;
                        if (mode == 1) v0 *= 0.125f;
                        else if (mode == 2) v0 *= 0.08838834764831845f;
                        else if (mode == 3) {
#pragma unroll
                            for (int e = 0; e < 4; ++e) v0[e] = siluf_(v0[e]);
                        } else if (mode == 4) {
#pragma unroll
                            for (int e = 0; e < 4; ++e) v0[e] = sigmoidf_(v0[e]);
                        }
                        st_bf4(P + (size_t)(row0 + ai * 128 + m * 16) * PS + col, v0);
                    }
            }
    }
};
struct EpiOut {
    static constexpr bool PERM = false, AFTER_DRAIN = false;
    float* pre; const float* bo; const float* x; const float2* stats; const float* g0; const float* b0; const float* hres; size_t tok0; int l;
    __device__ __forceinline__ void operator()(const f32x4 (&acc)[2][2][4][2], const pg8::Unit& u, int wr, int wc, int fr, int fq) const {
        const int row0 = u.pm * 256 + wr * 64 + fr, col0 = u.pn * 256 + wc * 32 + 4 * fq;
#pragma unroll
        for (int ai = 0; ai < 2; ++ai)
#pragma unroll
            for (int m = 0; m < 4; ++m) {
                const int row = row0 + ai * 128 + m * 16; const size_t T = tok0 + row;
                float2 st; st.x = 0.f; st.y = 0.f; if (l == 0) st = stats[T];
#pragma unroll
                for (int bj = 0; bj < 2; ++bj)
#pragma unroll
                    for (int n = 0; n < 2; ++n) {
                        const int col = col0 + bj * 128 + n * 16;
                        f32x4 res;
                        if (l == 0) res = (*(const f32x4*)(x + T * 1024 + col) - st.x) * st.y * *(const f32x4*)(g0 + col) + *(const f32x4*)(b0 + col);
                        else res = *(const f32x4*)(hres + T * 1024 + col);
                        *(f32x4*)(pre + (size_t)row * 1024 + col) = acc[ai][bj][m][n] + *(const f32x4*)(bo + col) + DN_ALPHA * res;
                    }
            }
    }
};

#define XB_TMO      128
#define XB_XCNT(j)  (256  + 64 * (j))
#define XB_XSUB(j)  (1280 + 64 * (j))
#define XB_XGEN(j)  (2304 + 64 * (j))
#define XB_TOP      3328
#define XB_TOPGEN   3392
#define XCD_BAR_WORDS 3456
#define XB_SPIN_CAP (1u << 18)
#define LAS __attribute__((address_space(3)))

__device__ __forceinline__ unsigned xb_ld(unsigned* p)              { return __hip_atomic_load(p, __ATOMIC_RELAXED, __HIP_MEMORY_SCOPE_AGENT); }
__device__ __forceinline__ unsigned xb_add(unsigned* p, unsigned v) { return __hip_atomic_fetch_add(p, v, __ATOMIC_RELAXED, __HIP_MEMORY_SCOPE_AGENT); }
__device__ __forceinline__ unsigned xb_xcc_id() { return (unsigned)__builtin_amdgcn_s_getreg((3 << 11) | 20) & 0xFu; }
#define XB_SPIN(cond, bar) do { unsigned _sp = 0; while (cond) { __builtin_amdgcn_s_sleep(1); \
    if ((++_sp & 255u) == 0u) { if (xb_ld(&(bar)[XB_TMO])) break; if (_sp > XB_SPIN_CAP) { atomicAdd(&(bar)[XB_TMO], 1u); break; } } } } while (0)

struct XcdBarrier {
    unsigned* bar; unsigned x;
    volatile LAS unsigned* st;
};

__device__ __forceinline__ XcdBarrier xcd_barrier_post(unsigned* bar, volatile LAS unsigned* st) {
    XcdBarrier b; b.bar = bar; b.x = xb_xcc_id(); b.st = st;
    if (threadIdx.x == 0) (void)xb_add(&bar[XB_XCNT(b.x)], 1u);
    return b;
}
__device__ __forceinline__ void xcd_barrier_complete(unsigned* bar, unsigned x, unsigned& nloc, unsigned& nx) {
    const unsigned G = gridDim.x * gridDim.y * gridDim.z;
    unsigned sum, cnt, mine, sp = 0u;
    for (;;) {
        sum = 0u; cnt = 0u; mine = 0u;
#pragma unroll
        for (unsigned j = 0; j < 16; ++j) { const unsigned c = xb_ld(&bar[XB_XCNT(j)]); sum += c; cnt += (c > 0u) ? 1u : 0u; mine = (j == x) ? c : mine; }
        if (sum == G) break;
        __builtin_amdgcn_s_sleep(1);
        if ((++sp & 255u) == 0u) { if (xb_ld(&bar[XB_TMO])) break; if (sp > XB_SPIN_CAP) { atomicAdd(&bar[XB_TMO], 1u); break; } }
    }
    nloc = mine > 0u ? mine : 1u; nx = cnt > 0u ? cnt : 1u;
}

__device__ __forceinline__ void xcd_barrier(unsigned* b_bar, unsigned b_x, volatile LAS unsigned* b_st) {
    asm volatile("s_waitcnt vmcnt(0)" ::: "memory");
    __syncthreads();
    if (threadIdx.x == 0) {
        unsigned* bar = b_bar;
        __builtin_amdgcn_s_waitcnt(0);
        unsigned nloc = b_st[0], nx = b_st[1];
        if (nloc == 0u) { xcd_barrier_complete(bar, b_x, nloc, nx); b_st[0] = nloc; b_st[1] = nx; }
        const unsigned old = xb_add(&bar[XB_XSUB(b_x)], 1u);
        const unsigned gen = old / nloc;
        if (old + 1u == (gen + 1u) * nloc) {
            __builtin_amdgcn_fence(__ATOMIC_RELEASE, "agent");
            asm volatile("s_waitcnt vmcnt(0)" ::: "memory");
            const unsigned og = xb_add(&bar[XB_TOP], 1u);
            const unsigned tg = og / nx;
            if (og + 1u == (tg + 1u) * nx) xb_add(&bar[XB_TOPGEN], 1u);
            else XB_SPIN(xb_ld(&bar[XB_TOPGEN]) == tg, bar);
            __builtin_amdgcn_fence(__ATOMIC_ACQUIRE, "agent");
            xb_add(&bar[XB_XGEN(b_x)], 1u);
            asm volatile("s_waitcnt vmcnt(0)" ::: "memory");
        } else {
            XB_SPIN(xb_ld(&bar[XB_XGEN(b_x)]) == gen, bar);
            __builtin_amdgcn_fence(__ATOMIC_ACQUIRE, "agent");
            asm volatile("s_waitcnt vmcnt(0)" ::: "memory");
        }
    }
    __syncthreads();
}

__device__ __forceinline__ void gbar(unsigned* ctr, unsigned& gen, int G) {
    __syncthreads();
    gen += (unsigned)G;
    if (threadIdx.x == 0) {
        __threadfence();
        __hip_atomic_fetch_add(ctr, 1u, __ATOMIC_RELAXED, __HIP_MEMORY_SCOPE_AGENT);
        while (__hip_atomic_load(ctr, __ATOMIC_RELAXED, __HIP_MEMORY_SCOPE_AGENT) < gen) __builtin_amdgcn_s_sleep(1);
        __threadfence();
    }
    __syncthreads();
}
typedef const Params __attribute__((address_space(4))) KParams;
#define KP4 __attribute__((address_space(4)))
__device__ __forceinline__ Params fresh_params() {
#if defined(__HIP_DEVICE_COMPILE__)
    KParams* kp = (KParams*)__builtin_amdgcn_kernarg_segment_ptr();
    asm volatile("" : "+s"(kp));
    Params r;
    const float* KP4 const* src = (const float* KP4 const*)kp;
    const float** dst = (const float**)&r;
#pragma unroll
    for (int i = 0; i < 28; ++i) dst[i] = src[i];
    return r;
#else
    return Params{};
#endif
}
__global__ void __launch_bounds__(NTHR) mega(Params p_unused) {
    extern __shared__ __attribute__((aligned(16))) unsigned char lds[];
    cg::grid_group grid = cg::this_grid();
    const int G = gridDim.x, bid = blockIdx.x;
    volatile LAS unsigned* xst = (volatile LAS unsigned*)((LAS unsigned char*)lds + (LDS_BYTES - 16));
    if (threadIdx.x == 0) { xst[0] = 0u; xst[1] = 0u; }
    __syncthreads();
    unsigned* xbar; unsigned xx;
    { const Params p = fresh_params(); xbar = (unsigned*)(p.ws + OFF_BAR); xx = xb_xcc_id(); if (threadIdx.x == 0) (void)xb_add(&xbar[XB_XCNT(xx)], 1u); }
    { const Params p = fresh_params(); phase0(p); }
    grid.sync();
#pragma unroll 1
    for (int l = 0; l < 2; ++l) {
        { const Params p = fresh_params(); phase_weights(p, l, lds); __syncthreads(); phase_filter_gen(p, l, lds); }
        xcd_barrier(xbar, xx, xst);
        {
            const Params p = fresh_params();
            phase_filter_fft(p, l, lds);
            const bf16_t* WtKV = (const bf16_t*)(p.ws + OFF_WTKV); const bf16_t* membf = (const bf16_t*)(p.ws + OFF_MEMBF);
            for (int t = bid; t < 64; t += G) {
                f32x4 acc[4][4];
                if (t < 32) {
                    const int m0 = (t >> 2) * 256, n0 = (t & 3) * 128;
                    gemm_core(acc, membf + (size_t)m0 * 1024, 1024, WtKV + (size_t)n0 * 1024, 1024, 1024, lds);
                    bf16_t* Km = (bf16_t*)(p.ws + OFF_KMAT);
                    EPI_LOOP(st_bf4(Km + (size_t)row * 512 + col, v);)
                } else {
                    const int t2 = t - 32, m0 = (t2 >> 4) * 256, n0 = (t2 & 15) * 128;
                    gemm_core(acc, WtKV + (size_t)(512 + m0) * 1024, 1024, membf + (size_t)n0 * 1024, 1024, 1024, lds);
                    bf16_t* Vm = (bf16_t*)(p.ws + OFF_VT);
                    EPI_LOOP(st_bf4(Vm + (size_t)row * 2048 + col, v);)
                }
            }
        }
        xcd_barrier(xbar, xx, xst);
#pragma unroll 1
        for (int g = 0; g < NGRP; ++g) {
            const size_t tok0 = (size_t)g * TG;
#pragma unroll 1
            for (int rep = 0; rep < PROBE_REP_INPROJ; ++rep) {
                const Params p = fresh_params();
                pg8::Gemm gm; gm.A = (const bf16_t*)(p.ws + OFF_HB) + tok0 * 1024; gm.Bt = (const bf16_t*)(p.ws + OFF_WTIN); gm.M = TG; gm.N = NINP; gm.K = 1024;
                pg8::StaticOrder S; S.init(TG, NINP, G, bid);
                EpiInProj E; E.P = (bf16_t*)(p.ws + OFF_P); E.bias = p.b_in + (size_t)l * NIN; E.LR = (float*)(p.ws + OFF_LR);
                pg8::gemm_phase<EpiInProj, pg8::StaticOrder, false>((PG8_LAS unsigned char*)lds, gm, S, E, nullptr);
                __syncthreads();
            }
            xcd_barrier(xbar, xx, xst);
#pragma unroll 1
            for (int rep = 0; rep < PROBE_REP_MIX; ++rep) {
            int dry = (rep + 1 < PROBE_REP_MIX) ? 1 : 0; asm volatile("" : "+s"(dry));
            {
                const Params p = fresh_params();
                bf16_t* P = (bf16_t*)(p.ws + OFF_P);
                for (int it = bid; it < BG * 64 * 8; it += G) na_item(p, l, P, it >> 9, (it >> 3) & 63, it & 7, lds, dry);
            }
            {
                const Params p = fresh_params();
                bf16_t* P = (bf16_t*)(p.ws + OFF_P);
                for (int it = bid; it < BG * 128 * 8; it += G) hy_pre_item(p, l, P, (float*)(p.ws + OFF_UT), (bf16_t*)(p.ws + OFF_GT), it >> 10, (it >> 3) & 127, it & 7, lds);
            }
            {
                const Params p = fresh_params();
                for (int it = bid; it < NITEM; it += G) gla_part1_item(p, l, (const bf16_t*)(p.ws + OFF_P), (const float*)(p.ws + OFF_LR), it, lds);
            }
            {
                const Params p = fresh_params();
                bf16_t* P = (bf16_t*)(p.ws + OFF_P);
                const int nit = BG * 4 * 64, per = (nit + G - 1) / G;
                int last = -1;
                for (int it = bid * per; it < min(nit, (bid + 1) * per); ++it) {
                    const int bh = it >> 6, bl = bh >> 2, h = bh & 3;
                    if (bh != last) { __syncthreads(); memattn_load(p, g * BG + bl, h, lds); last = bh; }
                    memattn_item(P, bl, h, it & 63, lds, dry);
                }
                __syncthreads();
            }
            xcd_barrier(xbar, xx, xst);
            {
                const Params p = fresh_params();
                const float2* twl = fft_lds_twiddles((const float2*)(p.ws + OFF_TW), lds);
                for (int it = bid; it < BG * 256; it += G) hyena_conv_item(p, (const float*)(p.ws + OFF_UT), (bf16_t*)(p.ws + OFF_GT), it >> 8, it & 255, lds, twl, dry);
                __syncthreads();
                gla_scan(p, dry);
            }
            xcd_barrier(xbar, xx, xst);
            {
                const Params p = fresh_params();
                for (int it = bid; it < NITEM; it += G) gla_part2_item(p, l, (bf16_t*)(p.ws + OFF_P), (const float*)(p.ws + OFF_LR), it, lds, dry);
            }
            {
                const Params p = fresh_params();
                for (int it = bid; it < BG * 128 * 8; it += G) hy_post_item((bf16_t*)(p.ws + OFF_P), (const bf16_t*)(p.ws + OFF_GT), it >> 10, (it >> 3) & 127, it & 7, lds, dry);
            }
            xcd_barrier(xbar, xx, xst);
            }
            {
                const Params p = fresh_params();
                const bf16_t* P = (const bf16_t*)(p.ws + OFF_P); const bf16_t* WtBr = (const bf16_t*)(p.ws + OFF_WTBR); bf16_t* merged = (bf16_t*)(p.ws + OFF_MERGED);
                for (int t = bid; t < 512; t += G) {
                    const int sr = t >> 8, sb = t & 255, sx = sb & 7, sk = sb >> 3;
                    const int m0 = (sr * 32 + (sk >> 3) * 8 + sx) * 256, n0 = (sk & 7) * 128;
                    f32x4 macc[4][4];
#pragma unroll
                    for (int mi = 0; mi < 4; ++mi)
#pragma unroll
                        for (int ni = 0; ni < 4; ++ni) macc[mi][ni] = (f32x4){0.f, 0.f, 0.f, 0.f};
#pragma unroll 1
                    for (int j = 0; j < 4; ++j) {
                        const int acol = (j == 0) ? C_NAQ : (j == 1) ? C_HY : (j == 2) ? C_GV : C_MQ;
                        f32x4 acc[4][4];
                        gemm_core(acc, P + (size_t)m0 * PS + acol, PS, WtBr + (size_t)j * 1024 * 512 + (size_t)n0 * 512, 512, 512, lds);
                        EPI_LOOP(macc[mi][ni] += ld_bf4(P + (size_t)row * PS + C_SG + 1024 * j + col) * v;)
                    }
                    {
                        f32x4 (&acc)[4][4] = macc;
                        EPI_LOOP(st_bf4(merged + (size_t)row * 1024 + col, v);)
                    }
                }
            }
            xcd_barrier(xbar, xx, xst);
            {
                const Params p = fresh_params();
                pg8::Gemm gm; gm.A = (const bf16_t*)(p.ws + OFF_MERGED); gm.Bt = (const bf16_t*)(p.ws + OFF_WTOUT); gm.M = TG; gm.N = 1024; gm.K = 1024;
                pg8::StaticOrder S; S.init(TG, 1024, G, bid);
                EpiOut E; E.pre = (float*)(p.ws + OFF_PRE); E.bo = p.b_out + l * 1024; E.x = p.x; E.stats = (const float2*)(p.ws + OFF_STATS); E.g0 = p.ln_in_g; E.b0 = p.ln_in_b; E.hres = p.out; E.tok0 = tok0; E.l = l;
                pg8::gemm_phase<EpiOut, pg8::StaticOrder, false>((PG8_LAS unsigned char*)lds, gm, S, E, nullptr);
                __syncthreads();
            }
            xcd_barrier(xbar, xx, xst);
            {
                const Params p = fresh_params();
                ln_rows((const float*)(p.ws + OFF_PRE), 0, TG, p.ln_g + l * 1024, p.ln_b + l * 1024, p.out, (bf16_t*)(p.ws + OFF_HB), tok0, nullptr);
            }
        }
        xcd_barrier(xbar, xx, xst);
    }
}

extern "C" void kernel_launch(void* const* d_in, const int* in_sizes, int n_in, void* d_out, int out_size, void* d_ws, size_t ws_size, hipStream_t stream) {
    static int grid_blocks = 0;
    if (!grid_blocks) {
        if (ws_size < WS_END) { fprintf(stderr, "kernel_launch: workspace too small: %zu < %zu\n", ws_size, (size_t)WS_END); grid_blocks = -1; return; }
        {
            const long long ex[26] = {67108864LL, 2097152LL, 1024, 1024, 2LL * 1024 * 10784, 2 * 10784, 2 * 8 * 15 * 31, 2 * 3 * 1536, 2 * 1536, 2 * 33 * 64, 2 * 64, 2 * 2 * 64 * 64, 2 * 2 * 64,
                                      2 * 64 * 1024, 2 * 512, 2 * 16 * 256, 2 * 256, 2 * 16 * 256, 2 * 256, 2 * 512, 2LL * 1024 * 1024, 2LL * 4 * 512 * 1024, 2LL * 1024 * 1024, 2 * 1024, 2 * 1024, 2 * 1024};
            bool bad = (n_in != 26) || (out_size != 67108864);
            for (int i = 0; i < 26 && !bad; ++i) if ((long long)in_sizes[i] != ex[i]) { fprintf(stderr, "kernel_launch: input %d has %d elements, expected %lld\n", i, in_sizes[i], ex[i]); bad = true; }
            if (bad) { fprintf(stderr, "kernel_launch: unexpected shapes; nothing launched\n"); grid_blocks = -1; return; }
        }
        int dev = 0, cus = 0, per_cu = 0;
        hipGetDevice(&dev);
        hipDeviceGetAttribute(&cus, hipDeviceAttributeMultiprocessorCount, dev);
        if (hipFuncSetAttribute((const void*)mega, hipFuncAttributeMaxDynamicSharedMemorySize, LDS_BYTES) != hipSuccess) fprintf(stderr, "kernel_launch: hipFuncSetAttribute failed\n");
        if (hipOccupancyMaxActiveBlocksPerMultiprocessor(&per_cu, (const void*)mega, NTHR, LDS_BYTES) != hipSuccess || per_cu < 1) { fprintf(stderr, "kernel_launch: occupancy query gave %d\n", per_cu); per_cu = 1; }
        (void)hipGetLastError();
        if (per_cu > 1) per_cu = 1;
        grid_blocks = cus * per_cu;
    }
    if (grid_blocks < 0) return;
    Params p{};
    const float** pp = (const float**)&p;
    for (int i = 0; i < 26; ++i) pp[i] = (const float*)d_in[i];
    p.out = (float*)d_out; p.ws = (unsigned char*)d_ws;
    if (hipMemsetAsync((unsigned char*)d_ws + OFF_BAR, 0, 16384, stream) != hipSuccess) fprintf(stderr, "kernel_launch: memset of the barrier word failed\n");
    void* args[] = {&p};
    hipError_t e = hipLaunchCooperativeKernel((const void*)mega, dim3(grid_blocks), dim3(NTHR), args, LDS_BYTES, stream);
    if (e != hipSuccess) fprintf(stderr, "cooperative launch failed: %s (grid %d)\n", hipGetErrorString(e), grid_blocks);
}
#endif
```

```cpp
#ifndef PROBE_REP_MIX
#define PROBE_REP_MIX 1
#endif
#ifndef PROBE_REP_INPROJ
#define PROBE_REP_INPROJ 1
#endif
#include <hip/hip_runtime.h>
#include <hip/hip_cooperative_groups.h>
#include <cstdio>
#include <unistd.h>
#include <cmath>
namespace cg = cooperative_groups;

#define HD __host__ __device__
typedef unsigned short bf16_t;
typedef short bf16x8 __attribute__((ext_vector_type(8)));
typedef float f32x4 __attribute__((ext_vector_type(4)));
typedef unsigned u32x2 __attribute__((ext_vector_type(2)));
typedef unsigned u32x4 __attribute__((ext_vector_type(4)));

constexpr int NTOK = 65536, DM = 1024, SEQ = 8192, NB = 8;
constexpr int BG = 2;
constexpr int NGRP = NB / BG;
constexpr int TG = BG * SEQ;
constexpr int PS = 10752;
constexpr int NIN = 10784, NINP = 11008;
constexpr int C_NAQ = 0, C_NAK = 512, C_NAV = 1024, C_HY = 1536, C_GQ = 3072, C_GK = 3328, C_GV = 3584, C_MQ = 4096, C_Z = 4608, C_SG = 6656, C_LR = 10752;
constexpr int FN = 16384;
constexpr int NITEM = BG * 128 * 4;
constexpr int LDS_BYTES = 160 * 1024;
constexpr int NTHR = 512;
constexpr float DN_ALPHA = 1.41421356237309515f;

constexpr size_t al256(size_t x) { return (x + 255) & ~(size_t)255; }
constexpr size_t OFF_HB = 0;
constexpr size_t OFF_STATS = OFF_HB + (size_t)NTOK * DM * 2;
constexpr size_t OFF_TW = OFF_STATS + (size_t)NTOK * 8;
constexpr size_t OFF_MEMBF = OFF_TW + (size_t)FN * 8;
constexpr size_t OFF_ENERGY = OFF_MEMBF + (size_t)2048 * 1024 * 2;
constexpr size_t OFF_WTIN = OFF_ENERGY + 4096;
constexpr size_t OFF_WTBR = OFF_WTIN + (size_t)NINP * 1024 * 2;
constexpr size_t OFF_WTOUT = OFF_WTBR + (size_t)4 * 1024 * 512 * 2;
constexpr size_t OFF_WTKV = OFF_WTOUT + (size_t)1024 * 1024 * 2;
constexpr size_t OFF_KMAT = OFF_WTKV + (size_t)2048 * 1024 * 2;
constexpr size_t OFF_VT = OFF_KMAT + (size_t)2048 * 1024 * 2;
constexpr size_t OFF_HFILT = OFF_VT + (size_t)2048 * 1024 * 2;
constexpr size_t OFF_PQ = OFF_HFILT + (size_t)1024 * 8192 * 4;
constexpr size_t OFF_P = OFF_PQ + (size_t)256 * FN * 16;
constexpr size_t OFF_LR = OFF_P + (size_t)TG * PS * 2;
constexpr size_t OFF_GS = OFF_LR + (size_t)TG * 32 * 4;
constexpr size_t OFF_GDEC = OFF_GS + (size_t)2 * NITEM * 8192 * 4;
constexpr size_t OFF_MERGED = OFF_GDEC + (size_t)2 * NITEM * 64 * 4;
constexpr size_t OFF_PRE = OFF_MERGED + (size_t)TG * 1024 * 2;
constexpr size_t OFF_UT = OFF_PRE + (size_t)TG * 1024 * 4;
constexpr size_t OFF_GT = OFF_UT + (size_t)BG * 512 * 8192 * 4;
constexpr size_t OFF_BAR = OFF_GT + (size_t)BG * 512 * 8192 * 2;
constexpr size_t OFF_ZT = OFF_BAR + 16384;
constexpr size_t WS_END = OFF_ZT + (size_t)8192 * 33 * 4;

struct Params {
    const float *x, *mem, *ln_in_g, *ln_in_b, *w_in, *b_in, *na_rpb, *hy_conv_w, *hy_conv_b, *hy_w1, *hy_b1, *hy_wm, *hy_bm, *hy_w3, *hy_skip,
        *gla_up_f, *gla_bias_f, *gla_up_b, *gla_bias_b, *gla_norm_g, *mem_w_kv, *w_br, *w_out, *b_out, *ln_g, *ln_b;
    float* out;
    unsigned char* ws;
};

HD inline float bf2f(bf16_t b) {
    union { unsigned u; float f; } c; c.u = (unsigned)b << 16; return c.f;
}
HD inline bf16_t f2bf(float f) {
    union { unsigned u; float f; } c; c.f = f; unsigned u = c.u; u += 0x7fffu + ((u >> 16) & 1u); return (bf16_t)(u >> 16);
}
__device__ __forceinline__ unsigned pk2(float lo, float hi) { return (unsigned)f2bf(lo) | ((unsigned)f2bf(hi) << 16); }
__device__ __forceinline__ float lo16(unsigned u) { return __uint_as_float(u << 16); }
__device__ __forceinline__ float hi16(unsigned u) { return __uint_as_float(u & 0xffff0000u); }
__device__ __forceinline__ float wave_sum(float v) {
#pragma unroll
    for (int o = 32; o >= 1; o >>= 1) v += __shfl_xor(v, o);
    return v;
}
__device__ __forceinline__ float sigmoidf_(float x) { return __builtin_amdgcn_rcpf(1.0f + __expf(-x)); }
__device__ __forceinline__ float siluf_(float x) { return x * __builtin_amdgcn_rcpf(1.0f + __expf(-x)); }
__device__ __forceinline__ float logsigf_(float x) { return fminf(x, 0.0f) - log1pf(expf(-fabsf(x))); }
__device__ __forceinline__ bf16x8 mkfrag(u32x4 v) { return __builtin_bit_cast(bf16x8, v); }
__device__ __forceinline__ bf16x8 mkfrag2(u32x2 a, u32x2 b) { u32x4 v = {a.x, a.y, b.x, b.y}; return __builtin_bit_cast(bf16x8, v); }
#define MFMA(a, b, c) __builtin_amdgcn_mfma_f32_16x16x32_bf16((a), (b), (c), 0, 0, 0)
HD inline int iclamp(int v, int lo, int hi) { return v < lo ? lo : (v > hi ? hi : v); }

HD inline float2 cmulf(float2 a, float2 b) { float2 r; r.x = a.x * b.x - a.y * b.y; r.y = a.x * b.y + a.y * b.x; return r; }
HD inline float2 cmulcf(float2 a, float2 b) { float2 r; r.x = a.x * b.x + a.y * b.y; r.y = a.y * b.x - a.x * b.y; return r; }
struct Bfly { float2 x0, x1, x2, x3, W1; int i0; };
HD inline void bfly_load(Bfly& b, const float2* d, const float2* tw, int lgm, int q) {
    const int m = 1 << lgm, blk = q >> lgm, j = q & (m - 1);
    b.i0 = (blk << (lgm + 2)) + j;
    b.W1 = tw[j];
    b.x0 = d[b.i0]; b.x1 = d[b.i0 + m]; b.x2 = d[b.i0 + 2 * m]; b.x3 = d[b.i0 + 3 * m];
}
HD inline void bfly_fwd_store(const Bfly& b, float2* d, int lgm) {
    const int m = 1 << lgm, i0 = b.i0;
    const float2 W1 = b.W1, W2 = cmulf(W1, W1);
    const float2 x0 = b.x0, x1 = b.x1, x2 = b.x2, x3 = b.x3;
    float2 a0, a1, a2, a3, t;
    a0.x = x0.x + x2.x; a0.y = x0.y + x2.y;
    t.x = x0.x - x2.x; t.y = x0.y - x2.y; a2 = cmulf(t, W1);
    a1.x = x1.x + x3.x; a1.y = x1.y + x3.y;
    t.x = x1.x - x3.x; t.y = x1.y - x3.y; t = cmulf(t, W1); a3.x = t.y; a3.y = -t.x;
    float2 r;
    r.x = a0.x + a1.x; r.y = a0.y + a1.y; d[i0] = r;
    t.x = a0.x - a1.x; t.y = a0.y - a1.y; d[i0 + m] = cmulf(t, W2);
    r.x = a2.x + a3.x; r.y = a2.y + a3.y; d[i0 + 2 * m] = r;
    t.x = a2.x - a3.x; t.y = a2.y - a3.y; d[i0 + 3 * m] = cmulf(t, W2);
}
HD inline void bfly_inv_store(const Bfly& b, float2* d, int lgm) {
    const int m = 1 << lgm, i0 = b.i0;
    const float2 W1 = b.W1, W2 = cmulf(W1, W1);
    const float2 x0 = b.x0, x1 = b.x1, x2 = b.x2, x3 = b.x3;
    const float2 b1 = cmulcf(x1, W2), b3 = cmulcf(x3, W2);
    float2 y0, y1, y2, y3;
    y0.x = x0.x + b1.x; y0.y = x0.y + b1.y; y1.x = x0.x - b1.x; y1.y = x0.y - b1.y;
    y2.x = x2.x + b3.x; y2.y = x2.y + b3.y; y3.x = x2.x - b3.x; y3.y = x2.y - b3.y;
    const float2 c2 = cmulcf(y2, W1); float2 c3 = cmulcf(y3, W1); { const float tx = -c3.y, ty = c3.x; c3.x = tx; c3.y = ty; }
    float2 r;
    r.x = y0.x + c2.x; r.y = y0.y + c2.y; d[i0] = r;
    r.x = y0.x - c2.x; r.y = y0.y - c2.y; d[i0 + 2 * m] = r;
    r.x = y1.x + c3.x; r.y = y1.y + c3.y; d[i0 + m] = r;
    r.x = y1.x - c3.x; r.y = y1.y - c3.y; d[i0 + 3 * m] = r;
}
HD inline void fft_fwd_bfly(float2* d, const float2* tw, int lgm, int q) { Bfly b; bfly_load(b, d, tw, lgm, q); bfly_fwd_store(b, d, lgm); }
HD inline void fft_inv_bfly(float2* d, const float2* tw, int lgm, int q) { Bfly b; bfly_load(b, d, tw, lgm, q); bfly_inv_store(b, d, lgm); }
HD inline int brev14(int k) {
    unsigned v = (unsigned)k;
    v = ((v >> 1) & 0x55555555u) | ((v & 0x55555555u) << 1);
    v = ((v >> 2) & 0x33333333u) | ((v & 0x33333333u) << 2);
    v = ((v >> 4) & 0x0f0f0f0fu) | ((v & 0x0f0f0f0fu) << 4);
    v = ((v >> 8) & 0x00ff00ffu) | ((v & 0x00ff00ffu) << 8);
    v = (v >> 16) | (v << 16);
    return (int)(v >> 18);
}
struct PwIn { float2 Z1, Z2; float4 A, B; int p1, p2; };
HD inline void pw_load(PwIn& w, const float2* d, const float4* pq, int kf) {
    const int k2 = (FN - kf) & (FN - 1); w.p1 = brev14(kf); w.p2 = brev14(k2);
    w.Z1 = d[w.p1]; w.Z2 = d[w.p2]; w.A = pq[w.p1]; w.B = pq[w.p2];
}
HD inline void pw_store(const PwIn& w, float2* d) {
    const float2 Z1 = w.Z1, Z2 = w.Z2;
    float2 P1, Q1, P2, Q2; P1.x = w.A.x; P1.y = w.A.y; Q1.x = w.A.z; Q1.y = w.A.w; P2.x = w.B.x; P2.y = w.B.y; Q2.x = w.B.z; Q2.y = w.B.w;
    float2 c1, c2; c1.x = Z1.x; c1.y = -Z1.y; c2.x = Z2.x; c2.y = -Z2.y;
    const float2 a = cmulf(Z1, P1), b = cmulf(c2, Q1), c = cmulf(Z2, P2), e = cmulf(c1, Q2);
    float2 w1, w2; w1.x = a.x + b.x; w1.y = a.y + b.y; w2.x = c.x + e.x; w2.y = c.y + e.y;
    d[w.p1] = w1;
    if (w.p2 != w.p1) d[w.p2] = w2;
}
HD inline void conv_pointwise(float2* d, const float4* pq, int kf) { PwIn w; pw_load(w, d, pq, kf); pw_store(w, d); }
HD inline void filt_pointwise(const float2* d, float4* pq, int kf) {
    const int k2 = (FN - kf) & (FN - 1), p1 = brev14(kf), p2 = brev14(k2);
    const float2 Z1 = d[p1], Z2 = d[p2];
    const float gcx = 0.5f * (Z1.x + Z2.x), gcy = 0.5f * (Z1.y - Z2.y);
    const float gdx = 0.5f * (Z1.y + Z2.y), gdy = -0.5f * (Z1.x - Z2.x);
    const float s = 0.5f / (float)FN;
    float4 A; A.x = s * (gcx + gdx); A.y = s * (gcy + gdy); A.z = s * (gcx - gdx); A.w = s * (gcy - gdy);
    pq[p1] = A;
    float4 B; B.x = A.x; B.y = -A.y; B.z = A.z; B.w = -A.w;
    if (p2 != p1) pq[p2] = B;
}

HD inline int tw_off(int lgm) { return lgm == 10 ? 0 : lgm == 8 ? 1024 : lgm == 6 ? 1280 : lgm == 4 ? 1344 : lgm == 2 ? 1360 : 1364; }
#ifndef FFT_HOST_TEST
template <int LGM, bool INV>
__device__ __forceinline__ void fft_pass(float2* d, const float2* twl, const float2* twg, int tid) {
    const float2* tw = (LGM == 12) ? twg : twl + tw_off(LGM);
#pragma unroll
    for (int it = 0; it < 2; ++it) {
        const int q = tid + it * 4 * NTHR;
        Bfly b0, b1, b2, b3;
        bfly_load(b0, d, tw, LGM, q); bfly_load(b1, d, tw, LGM, q + NTHR); bfly_load(b2, d, tw, LGM, q + 2 * NTHR); bfly_load(b3, d, tw, LGM, q + 3 * NTHR);
        if (INV) { bfly_inv_store(b0, d, LGM); bfly_inv_store(b1, d, LGM); bfly_inv_store(b2, d, LGM); bfly_inv_store(b3, d, LGM); }
        else { bfly_fwd_store(b0, d, LGM); bfly_fwd_store(b1, d, LGM); bfly_fwd_store(b2, d, LGM); bfly_fwd_store(b3, d, LGM); }
    }
    __syncthreads();
}
__device__ __forceinline__ void fft_forward(float2* d, const float2* twl, const float2* twg) {
    int tid = threadIdx.x; asm volatile("" : "+v"(tid));
    fft_pass<12, false>(d, twl, twg, tid); fft_pass<10, false>(d, twl, twg, tid); fft_pass<8, false>(d, twl, twg, tid); fft_pass<6, false>(d, twl, twg, tid);
    fft_pass<4, false>(d, twl, twg, tid); fft_pass<2, false>(d, twl, twg, tid); fft_pass<0, false>(d, twl, twg, tid);
}
__device__ __forceinline__ void fft_inverse(float2* d, const float2* twl, const float2* twg) {
    int tid = threadIdx.x; asm volatile("" : "+v"(tid));
    fft_pass<0, true>(d, twl, twg, tid); fft_pass<2, true>(d, twl, twg, tid); fft_pass<4, true>(d, twl, twg, tid); fft_pass<6, true>(d, twl, twg, tid);
    fft_pass<8, true>(d, twl, twg, tid); fft_pass<10, true>(d, twl, twg, tid); fft_pass<12, true>(d, twl, twg, tid);
}
__device__ __forceinline__ float2* fft_lds_twiddles(const float2* twg, unsigned char* lds) {
    int tid = threadIdx.x; asm volatile("" : "+v"(tid));
    float2* t = (float2*)(lds + 131072);
    for (int k = tid; k < 1365; k += NTHR) {
        const int lgm = k < 1024 ? 10 : k < 1280 ? 8 : k < 1344 ? 6 : k < 1360 ? 4 : k < 1364 ? 2 : 0;
        t[k] = twg[(k - tw_off(lgm)) << (12 - lgm)];
    }
    __syncthreads();
    return t;
}

constexpr int STG = 49152;
__device__ __forceinline__ int swz(int row, int ch) { return row * 128 + ((ch ^ ((row >> 1) & 7)) << 4); }
__device__ __forceinline__ void gemm_core(f32x4 (&acc)[4][4], const bf16_t* A, int lda, const bf16_t* Bt, int ldb, int K, unsigned char* lds) {
    int tid_ = threadIdx.x; asm volatile("" : "+v"(tid_)); const int tid = tid_, lane = tid & 63, w = tid >> 6, wm = w & 3, wn = w >> 2, l15 = lane & 15, q4 = lane >> 4;
    const int wu = __builtin_amdgcn_readfirstlane(w);
    __attribute__((address_space(3))) unsigned char* l3 = (__attribute__((address_space(3))) unsigned char*)lds;
#pragma unroll
    for (int mi = 0; mi < 4; ++mi)
#pragma unroll
        for (int ni = 0; ni < 4; ++ni) acc[mi][ni] = (f32x4){0.f, 0.f, 0.f, 0.f};
    const int r8 = lane >> 3, sch = (lane & 7) ^ ((((w & 1) << 2) + (r8 >> 1)) & 7);
    const bf16_t* ap = A + (size_t)(w * 8 + r8) * lda + sch * 8;
    const bf16_t* bp = Bt + (size_t)(w * 8 + r8) * ldb + sch * 8;
#define GC_STAGE(buf, k0)                                                                                                                         \
    {                                                                                                                                             \
        _Pragma("unroll") for (int i = 0; i < 4; ++i)                                                                                             \
            __builtin_amdgcn_global_load_lds((const unsigned*)(ap + (size_t)(64 * i) * lda + (k0)), (__attribute__((address_space(3))) unsigned*)(l3 + (buf) * STG + (wu + 8 * i) * 1024), 16, 0, 0);          \
        _Pragma("unroll") for (int i = 0; i < 2; ++i)                                                                                             \
            __builtin_amdgcn_global_load_lds((const unsigned*)(bp + (size_t)(64 * i) * ldb + (k0)), (__attribute__((address_space(3))) unsigned*)(l3 + (buf) * STG + 32768 + (wu + 8 * i) * 1024), 16, 0, 0);  \
    }
    GC_STAGE(0, 0)
    asm volatile("s_waitcnt vmcnt(0)" ::: "memory");
    __syncthreads();
    const int nk = K >> 6;
    for (int kt = 0; kt < nk; ++kt) {
        if (kt + 1 < nk) GC_STAGE((kt + 1) & 1, (kt + 1) << 6)
        const unsigned char* sa = lds + (kt & 1) * STG;
        const unsigned char* sb = sa + 32768;
#pragma unroll
        for (int ks = 0; ks < 2; ++ks) {
            bf16x8 af[4], bfr[4];
#pragma unroll
            for (int mi = 0; mi < 4; ++mi) af[mi] = *(const bf16x8*)(sa + swz(wm * 64 + mi * 16 + l15, ks * 4 + q4));
#pragma unroll
            for (int ni = 0; ni < 4; ++ni) bfr[ni] = *(const bf16x8*)(sb + swz(wn * 64 + ni * 16 + l15, ks * 4 + q4));
#pragma unroll
            for (int mi = 0; mi < 4; ++mi)
#pragma unroll
                for (int ni = 0; ni < 4; ++ni) acc[mi][ni] = MFMA(bfr[ni], af[mi], acc[mi][ni]);
        }
        asm volatile("s_waitcnt vmcnt(0)" ::: "memory");
        __syncthreads();
    }
#undef GC_STAGE
}
#define EPI_LOOP(body)                                                                                                  \
    {                                                                                                                   \
        int e_t = threadIdx.x; asm volatile("" : "+v"(e_t)); const int e_lane = e_t & 63, e_w = e_t >> 6;                                                    \
        _Pragma("unroll") for (int mi = 0; mi < 4; ++mi) _Pragma("unroll") for (int ni = 0; ni < 4; ++ni) {             \
            const int row = m0 + (e_w & 3) * 64 + mi * 16 + (e_lane & 15);                                              \
            const int col = n0 + (e_w >> 2) * 64 + ni * 16 + 4 * (e_lane >> 4);                                         \
            f32x4& v = acc[mi][ni];                                                                                     \
            body                                                                                                        \
        }                                                                                                               \
    }
__device__ __forceinline__ void st_bf4(bf16_t* dst, f32x4 v) {
    u32x2 o; o.x = pk2(v[0], v[1]); o.y = pk2(v[2], v[3]); *(u32x2*)dst = o;
}
__device__ __forceinline__ f32x4 ld_bf4(const bf16_t* src) {
    const u32x2 u = *(const u32x2*)src; f32x4 r = {lo16(u.x), hi16(u.x), lo16(u.y), hi16(u.y)}; return r;
}

__device__ __forceinline__ int orig_col(int n) {
    if (n < 4096) return n;
    if (n < 4608) return n + 32;
    if (n < 6656) return n + 32;
    if (n < 10752) return n + 32;
    return n - 10752 + 4096;
}

__device__ __forceinline__ void ln_rows(const float* src, size_t src_row0, int nrows, const float* g, const float* b, float* dst32, bf16_t* dst16, size_t dst_row0, float2* stats) {
    int tid_ = threadIdx.x; asm volatile("" : "+v"(tid_));
    const int lane = tid_ & 63;
    const int gw = blockIdx.x * (NTHR / 64) + (tid_ >> 6), nw = gridDim.x * (NTHR / 64);
    for (int r = gw; r < nrows; r += nw) {
        const float4* xr = (const float4*)(src + (src_row0 + r) * 1024);
        float4 v[4]; float s = 0.f;
#pragma unroll
        for (int i = 0; i < 4; ++i) { v[i] = xr[lane + 64 * i]; s += (v[i].x + v[i].y) + (v[i].z + v[i].w); }
        s = wave_sum(s);
        const float mean = s * (1.0f / 1024.0f);
        float q = 0.f;
#pragma unroll
        for (int i = 0; i < 4; ++i) { const float a = v[i].x - mean, bb = v[i].y - mean, c = v[i].z - mean, d = v[i].w - mean; q += (a * a + bb * bb) + (c * c + d * d); }
        q = wave_sum(q);
        const float rstd = 1.0f / sqrtf(q * (1.0f / 1024.0f) + 1e-5f);
        if (stats && lane == 0) { float2 st; st.x = mean; st.y = rstd; stats[dst_row0 + r] = st; }
#pragma unroll
        for (int i = 0; i < 4; ++i) {
            const float4 g4 = ((const float4*)g)[lane + 64 * i], b4 = ((const float4*)b)[lane + 64 * i];
            float4 y; y.x = (v[i].x - mean) * rstd * g4.x + b4.x; y.y = (v[i].y - mean) * rstd * g4.y + b4.y; y.z = (v[i].z - mean) * rstd * g4.z + b4.z; y.w = (v[i].w - mean) * rstd * g4.w + b4.w;
            if (dst32) ((float4*)(dst32 + (dst_row0 + r) * 1024))[lane + 64 * i] = y;
            if (dst16) { u32x2 o; o.x = pk2(y.x, y.y); o.y = pk2(y.z, y.w); *(u32x2*)(dst16 + (dst_row0 + r) * 1024 + (lane + 64 * i) * 4) = o; }
        }
    }
}
__device__ __forceinline__ void phase0(const Params& p) {
    ln_rows(p.x, 0, NTOK, p.ln_in_g, p.ln_in_b, nullptr, (bf16_t*)(p.ws + OFF_HB), 0, (float2*)(p.ws + OFF_STATS));
    int tid_ = threadIdx.x; asm volatile("" : "+v"(tid_)); const int gt = blockIdx.x * NTHR + tid_, nt = gridDim.x * NTHR;
    float2* tw = (float2*)(p.ws + OFF_TW);
    for (int k = gt; k < FN; k += nt) { double s, c; sincospi(-2.0 * (double)k / (double)FN, &s, &c); float2 t; t.x = (float)c; t.y = (float)s; tw[k] = t; }
    bf16_t* mb = (bf16_t*)(p.ws + OFF_MEMBF);
    for (int i = gt; i < 2048 * 1024 / 4; i += nt) { const float4 v = ((const float4*)p.mem)[i]; u32x2 o; o.x = pk2(v.x, v.y); o.y = pk2(v.z, v.w); ((u32x2*)mb)[i] = o; }
    float* en = (float*)(p.ws + OFF_ENERGY);
    for (int i = gt; i < 1024; i += nt) en[i] = 0.f;
    float* ztab = (float*)(p.ws + OFF_ZT);
    for (int idx = gt; idx < 8192 * 33; idx += nt) {
        const int n = idx / 33, e = idx - n * 33;
        float v;
        if (e == 0) v = (float)n / 8191.0f;
        else {
            const int i = (e - 1) & 15;
            const double fr = 1e-4 + (double)i * ((15.0 - 1e-4) / 15.0);
            const double ang = (2.0 * 3.14159265358979323846 / 8192.0) * (double)n * fr;
            v = (e <= 16) ? (float)cos(ang) : (float)(-sin(ang));
        }
        ztab[idx] = v;
    }
}

__device__ __forceinline__ void wt_tile(const float* src, int src_ld, int k0, int on0, bf16_t* dst, int dst_ld, int dn0, bool zero, float* tile) {
    int tid_ = threadIdx.x; asm volatile("" : "+v"(tid_)); const int tid = tid_;
    if (!zero) {
#pragma unroll
        for (int i = 0; i < 2; ++i) {
            const int k = (tid >> 3) + 64 * i, c4 = (tid & 7) * 4;
            const float4 v = *(const float4*)(src + (size_t)(k0 + k) * src_ld + on0 + c4);
            float* t = tile + k * 33 + c4; t[0] = v.x; t[1] = v.y; t[2] = v.z; t[3] = v.w;
        }
    }
    __syncthreads();
    const int n = tid >> 4, kc = (tid & 15) * 8;
    float f[8];
#pragma unroll
    for (int e = 0; e < 8; ++e) f[e] = zero ? 0.f : tile[(kc + e) * 33 + n];
    u32x4 o; o.x = pk2(f[0], f[1]); o.y = pk2(f[2], f[3]); o.z = pk2(f[4], f[5]); o.w = pk2(f[6], f[7]);
    *(u32x4*)(dst + (size_t)(dn0 + n) * dst_ld + k0 + kc) = o;
    __syncthreads();
}
__device__ __forceinline__ void phase_weights(const Params& p, int l, unsigned char* lds) {
    float* tile = (float*)lds;
    for (int it = blockIdx.x; it < 3776; it += gridDim.x) {
        if (it < 2752) {
            const int nt = it >> 3, kt = it & 7, dn0 = nt * 32;
            wt_tile(p.w_in + (size_t)l * 1024 * NIN, NIN, kt * 128, orig_col(dn0), (bf16_t*)(p.ws + OFF_WTIN), 1024, dn0, dn0 >= NIN, tile);
        } else if (it < 3264) {
            const int r = it - 2752, j = r >> 7, nt = (r >> 2) & 31, kt = r & 3;
            wt_tile(p.w_br + (size_t)(l * 4 + j) * 512 * 1024, 1024, kt * 128, nt * 32, (bf16_t*)(p.ws + OFF_WTBR) + (size_t)j * 1024 * 512, 512, nt * 32, false, tile);
        } else if (it < 3520) {
            const int r = it - 3264, nt = r >> 3, kt = r & 7;
            wt_tile(p.w_out + (size_t)l * 1024 * 1024, 1024, kt * 128, nt * 32, (bf16_t*)(p.ws + OFF_WTOUT), 1024, nt * 32, false, tile);
        } else {
            const int r = it - 3520, nt = r >> 3, kt = r & 7;
            wt_tile(p.mem_w_kv + (size_t)l * 1024 * 1024, 1024, kt * 128, nt * 32, (bf16_t*)(p.ws + OFF_WTKV), 1024, nt * 32, false, tile);
        }
    }
}

__device__ __forceinline__ void phase_filter_gen(const Params& p, int l, unsigned char* lds) {
    float* zt = (float*)lds;
    float* ha = zt + 32 * 33;
    float* hbuf = ha + 32 * 64;
    int tid_ = threadIdx.x; asm volatile("" : "+v"(tid_)); const int tid = tid_;
    const float* w1 = p.hy_w1 + (size_t)l * 33 * 64; const float* b1 = p.hy_b1 + l * 64;
    const float* wm = p.hy_wm + (size_t)l * 2 * 64 * 64; const float* bm = p.hy_bm + l * 2 * 64;
    const float* w3 = p.hy_w3 + (size_t)l * 64 * 1024;
    float* hf = (float*)(p.ws + OFF_HFILT);
    float* en = (float*)(p.ws + OFF_ENERGY) + l * 512;
    const float* ztab = (const float*)(p.ws + OFF_ZT);
    for (int it = blockIdx.x; it < 256; it += gridDim.x) {
        const int n0 = it * 32;
        for (int idx = tid; idx < 32 * 33; idx += NTHR) zt[idx] = ztab[(size_t)n0 * 33 + idx];
        __syncthreads();
        for (int idx = tid; idx < 2048; idx += NTHR) {
            const int pos = idx >> 6, j = idx & 63; float s = b1[j];
            for (int e = 0; e < 33; ++e) s += zt[pos * 33 + e] * w1[e * 64 + j];
            ha[idx] = sinf(s);
        }
        __syncthreads();
        for (int idx = tid; idx < 2048; idx += NTHR) {
            const int pos = idx >> 6, j = idx & 63; float s = bm[j];
            for (int e = 0; e < 64; ++e) s += ha[pos * 64 + e] * wm[e * 64 + j];
            hbuf[idx] = sinf(s);
        }
        __syncthreads();
        for (int idx = tid; idx < 2048; idx += NTHR) {
            const int pos = idx >> 6, j = idx & 63; float s = bm[64 + j];
            for (int e = 0; e < 64; ++e) s += hbuf[pos * 64 + e] * wm[4096 + e * 64 + j];
            ha[idx] = sinf(s);
        }
        __syncthreads();
        {
            const int c = tid;
            float af[32], ab[32];
#pragma unroll
            for (int i = 0; i < 32; ++i) { af[i] = 0.f; ab[i] = 0.f; }
            for (int k = 0; k < 64; ++k) {
                const float wf = w3[k * 1024 + c], wb = w3[k * 1024 + 512 + c];
#pragma unroll
                for (int i = 0; i < 32; ++i) { const float h = ha[i * 64 + k]; af[i] += h * wf; ab[i] += h * wb; }
            }
            const float dmin = -3.0701134573253945f, dmax = -15.350567286626973f;
            const float delta = fabsf(dmin + (float)c * ((dmax - dmin) / 511.0f));
            float e = 0.f;
#pragma unroll
            for (int i = 0; i < 32; ++i) {
                const int n = n0 + i; const float t01 = (float)n / 8191.0f; const float win = expf(-t01 * delta);
                af[i] *= win; ab[i] *= win; e += af[i] * af[i]; if (n >= 1) e += ab[i] * ab[i];
            }
#pragma unroll
            for (int i = 0; i < 8; ++i) {
                float4 a; a.x = af[4 * i]; a.y = af[4 * i + 1]; a.z = af[4 * i + 2]; a.w = af[4 * i + 3];
                float4 b; b.x = ab[4 * i]; b.y = ab[4 * i + 1]; b.z = ab[4 * i + 2]; b.w = ab[4 * i + 3];
                *(float4*)(hf + (size_t)c * 8192 + n0 + 4 * i) = a;
                *(float4*)(hf + (size_t)(512 + c) * 8192 + n0 + 4 * i) = b;
            }
            atomicAdd(en + c, e);
        }
        __syncthreads();
    }
}

__device__ __forceinline__ void phase_filter_fft(const Params& p, int l, unsigned char* lds) {
    float2* d = (float2*)lds;
    const float2* tw = fft_lds_twiddles((const float2*)(p.ws + OFF_TW), lds);
    const float* hf = (const float*)(p.ws + OFF_HFILT);
    const float* en = (const float*)(p.ws + OFF_ENERGY) + l * 512;
    float4* pqa = (float4*)(p.ws + OFF_PQ);
    int tid_ = threadIdx.x; asm volatile("" : "+v"(tid_)); const int tid = tid_;
    for (int pr = blockIdx.x; pr < 256; pr += gridDim.x) {
        const int c0 = 2 * pr, c1 = c0 + 1;
        const float s0 = 1.0f / sqrtf(en[c0] + 1e-6f), s1 = 1.0f / sqrtf(en[c1] + 1e-6f);
        const float k0 = p.hy_skip[l * 512 + c0], k1 = p.hy_skip[l * 512 + c1];
        for (int n = tid; n < FN; n += NTHR) {
            float2 v;
            if (n < 8192) { v.x = hf[(size_t)c0 * 8192 + n] * s0; v.y = hf[(size_t)c1 * 8192 + n] * s1; if (n == 0) { v.x += k0; v.y += k1; } }
            else if (n == 8192) { v.x = 0.f; v.y = 0.f; }
            else { v.x = hf[(size_t)(512 + c0) * 8192 + (FN - n)] * s0; v.y = hf[(size_t)(512 + c1) * 8192 + (FN - n)] * s1; }
            d[n] = v;
        }
        __syncthreads();
        fft_forward(d, tw, (const float2*)(p.ws + OFF_TW));
        for (int kf = tid; kf <= FN / 2; kf += NTHR) filt_pointwise(d, pqa + (size_t)pr * FN, kf);
        __syncthreads();
    }
}

__device__ __forceinline__ void hy_pre_item(const Params& p, int l, const bf16_t* P, float* UT, bf16_t* GT, int bl, int tt, int ct, unsigned char* lds) {
    float* tU = (float*)lds;
    float* tG = tU + 64 * 65;
    int tid_ = threadIdx.x; asm volatile("" : "+v"(tid_)); const int tid = tid_;
    const int t = tid >> 3, cc = (tid & 7) * 8, c = ct * 64 + cc, tb = tt * 64 + t;
    const float* cw = p.hy_conv_w + (size_t)l * 3 * 1536; const float* cb = p.hy_conv_b + l * 1536;
    float av[8], a0[8], a1[8];
#pragma unroll
    for (int h = 0; h < 2; ++h) {
        const f32x4 bv = *(const f32x4*)(cb + c + 4 * h), b0 = *(const f32x4*)(cb + 512 + c + 4 * h), b1 = *(const f32x4*)(cb + 1024 + c + 4 * h);
#pragma unroll
        for (int e = 0; e < 4; ++e) { av[4 * h + e] = bv[e]; a0[4 * h + e] = b0[e]; a1[4 * h + e] = b1[e]; }
    }
#pragma unroll
    for (int j = 0; j < 3; ++j) {
        const int ts = tb + j - 1;
        if (ts >= 0 && ts < SEQ) {
            const bf16_t* row = P + (size_t)(bl * SEQ + ts) * PS + C_HY + c;
            const u32x4 rv = *(const u32x4*)row, r0 = *(const u32x4*)(row + 512), r1 = *(const u32x4*)(row + 1024);
#pragma unroll
            for (int h = 0; h < 2; ++h) {
                const f32x4 wv = *(const f32x4*)(cw + j * 1536 + c + 4 * h), w0 = *(const f32x4*)(cw + j * 1536 + 512 + c + 4 * h), w1 = *(const f32x4*)(cw + j * 1536 + 1024 + c + 4 * h);
#pragma unroll
                for (int e = 0; e < 4; ++e) {
                    const int k = 4 * h + e; const unsigned uv = rv[k >> 1], u0 = r0[k >> 1], u1 = r1[k >> 1];
                    av[k] += wv[e] * ((k & 1) ? hi16(uv) : lo16(uv)); a0[k] += w0[e] * ((k & 1) ? hi16(u0) : lo16(u0)); a1[k] += w1[e] * ((k & 1) ? hi16(u1) : lo16(u1));
                }
            }
        }
    }
    const u32x4 rz = *(const u32x4*)(P + (size_t)(bl * SEQ + tb) * PS + C_Z + 512 + c);
#pragma unroll
    for (int k = 0; k < 8; ++k) {
        const unsigned uz = rz[k >> 1]; const float z = (k & 1) ? hi16(uz) : lo16(uz);
        tU[(cc + k) * 65 + t] = av[k] * a1[k]; tG[(cc + k) * 65 + t] = a0[k] * z;
    }
    __syncthreads();
    const int c2 = tid >> 3, t8 = (tid & 7) * 8;
    const size_t o = (size_t)(bl * 512 + ct * 64 + c2) * SEQ + tt * 64 + t8;
    const float* su = tU + c2 * 65 + t8; const float* sg = tG + c2 * 65 + t8;
    f32x4 ua = {su[0], su[1], su[2], su[3]}, ub = {su[4], su[5], su[6], su[7]};
    *(f32x4*)(UT + o) = ua; *(f32x4*)(UT + o + 4) = ub;
    u32x4 g; g.x = pk2(sg[0], sg[1]); g.y = pk2(sg[2], sg[3]); g.z = pk2(sg[4], sg[5]); g.w = pk2(sg[6], sg[7]);
    *(u32x4*)(GT + o) = g;
    __syncthreads();
}
__device__ __forceinline__ void hy_post_item(bf16_t* P, const bf16_t* GT, int bl, int tt, int ct, unsigned char* lds, int dry = 0) {
    bf16_t* tl = (bf16_t*)lds;
    int tid_ = threadIdx.x; asm volatile("" : "+v"(tid_)); const int tid = tid_;
    const int c2 = tid >> 3, t8 = (tid & 7) * 8;
    const u32x4 v = *(const u32x4*)(GT + (size_t)(bl * 512 + ct * 64 + c2) * SEQ + tt * 64 + t8);
    bf16_t* d0 = tl + t8 * 72 + c2;
    d0[0 * 72] = (bf16_t)(v.x & 0xffffu); d0[1 * 72] = (bf16_t)(v.x >> 16); d0[2 * 72] = (bf16_t)(v.y & 0xffffu); d0[3 * 72] = (bf16_t)(v.y >> 16);
    d0[4 * 72] = (bf16_t)(v.z & 0xffffu); d0[5 * 72] = (bf16_t)(v.z >> 16); d0[6 * 72] = (bf16_t)(v.w & 0xffffu); d0[7 * 72] = (bf16_t)(v.w >> 16);
    __syncthreads();
    const int t = tid >> 3, cc = (tid & 7) * 8;
    const u32x4 ov = *(const u32x4*)(tl + t * 72 + cc);
    if (!dry) *(u32x4*)(P + (size_t)(bl * SEQ + tt * 64 + t) * PS + C_HY + ct * 64 + cc) = ov;
    __syncthreads();
}
__device__ __forceinline__ void hyena_conv_item(const Params& p, const float* UT, bf16_t* GT, int bl, int pr, unsigned char* lds, const float2* tw, int dry = 0) {
    float2* d = (float2*)lds;
    const float4* pq = (const float4*)(p.ws + OFF_PQ) + (size_t)pr * FN;
    int tid_ = threadIdx.x; asm volatile("" : "+v"(tid_)); const int tid = tid_;
    const float* u0 = UT + (size_t)(bl * 512 + 2 * pr) * SEQ; const float* u1 = u0 + SEQ;
    bf16_t* g0 = GT + (size_t)(bl * 512 + 2 * pr) * SEQ; bf16_t* g1 = g0 + SEQ;
    {
        float f0[16], f1[16];
#pragma unroll
        for (int i = 0; i < 16; ++i) { f0[i] = u0[tid + NTHR * i]; f1[i] = u1[tid + NTHR * i]; }
#pragma unroll
        for (int i = 0; i < 16; ++i) {
            float2 u; u.x = f0[i]; u.y = f1[i]; d[tid + NTHR * i] = u;
            float2 z; z.x = 0.f; z.y = 0.f; d[tid + NTHR * i + SEQ] = z;
        }
    }
    __syncthreads();
    fft_forward(d, tw, (const float2*)(p.ws + OFF_TW));
#pragma unroll 1
    for (int kf = tid; kf < FN / 2; kf += 4 * NTHR) {
        PwIn w0, w1, w2, w3;
        pw_load(w0, d, pq, kf); pw_load(w1, d, pq, kf + NTHR); pw_load(w2, d, pq, kf + 2 * NTHR); pw_load(w3, d, pq, kf + 3 * NTHR);
        pw_store(w0, d); pw_store(w1, d); pw_store(w2, d); pw_store(w3, d);
    }
    if (tid == 0) conv_pointwise(d, pq, FN / 2);
    __syncthreads();
    fft_inverse(d, tw, (const float2*)(p.ws + OFF_TW));
    {
        bf16_t a0[16], a1[16];
#pragma unroll
        for (int i = 0; i < 16; ++i) { a0[i] = g0[tid + NTHR * i]; a1[i] = g1[tid + NTHR * i]; }
#pragma unroll
        for (int i = 0; i < 16; ++i) {
            const int t = tid + NTHR * i;
            const float2 y = d[t];
            const bf16_t r0 = f2bf(y.x * bf2f(a0[i])), r1 = f2bf(y.y * bf2f(a1[i]));
            if (!dry) { g0[t] = r0; g1[t] = r1; }
        }
    }
    __syncthreads();
}

__device__ __forceinline__ void na_item(const Params& p, int l, bf16_t* P, int bl, int rp, int head, unsigned char* lds, int dry = 0) {
    bf16_t* Kimg = (bf16_t*)lds;
    bf16_t* VT = (bf16_t*)(lds + 82944);
    int tid_ = threadIdx.x; asm volatile("" : "+v"(tid_)); const int tid = tid_, lane = tid & 63, w = tid >> 6, l15 = lane & 15, q4 = lane >> 4;
    const int r0 = 2 * rp, rs0 = iclamp(r0 - 4, 0, 120);
#pragma unroll
    for (int i = 0; i < 9; ++i) {
        const int idx = tid + NTHR * i, key = idx >> 3, ch = idx & 7, grow = min(rs0 + (key >> 6), 127);
        const u32x4 kv = *(const u32x4*)(P + (size_t)(bl * SEQ + grow * 64 + (key & 63)) * PS + C_NAK + head * 64 + ch * 8);
        *(u32x4*)(Kimg + key * 72 + ch * 8) = kv;
    }
#pragma unroll
    for (int i = 0; i < 9; ++i) {
        const int idx = tid + NTHR * i, keyp = idx >> 2, chh = keyp >= 576 ? 1 : 0, key = keyp - chh * 576, ch = chh * 4 + (idx & 3), grow = min(rs0 + (key >> 6), 127);
        const u32x4 vv = *(const u32x4*)(P + (size_t)(bl * SEQ + grow * 64 + (key & 63)) * PS + C_NAV + head * 64 + ch * 8);
        bf16_t* vd = VT + (ch * 8) * 584 + key;
        vd[0 * 584] = (bf16_t)(vv.x & 0xffffu); vd[1 * 584] = (bf16_t)(vv.x >> 16);
        vd[2 * 584] = (bf16_t)(vv.y & 0xffffu); vd[3 * 584] = (bf16_t)(vv.y >> 16);
        vd[4 * 584] = (bf16_t)(vv.z & 0xffffu); vd[5 * 584] = (bf16_t)(vv.z >> 16);
        vd[6 * 584] = (bf16_t)(vv.w & 0xffffu); vd[7 * 584] = (bf16_t)(vv.w >> 16);
    }
    __syncthreads();
    const int rr = w >> 2, g = w & 3, r = r0 + rr, rs = iclamp(r - 4, 0, 120), lo = rs - rs0;
    const int cb = iclamp(16 * g - 8, 0, 32), c = 16 * g + l15, cs = iclamp(c - 8, 0, 48);
    bf16_t* qrow = P + (size_t)(bl * SEQ + r * 64 + c) * PS + head * 64;
    bf16x8 qf[2];
#pragma unroll
    for (int ks = 0; ks < 2; ++ks) qf[ks] = *(const bf16x8*)(qrow + ks * 32 + q4 * 8);
    f32x4 sc[16];
#pragma unroll
    for (int t = 0; t < 16; ++t) {
        const int kb = (lo + (t >> 1)) * 64 + cb + 16 * (t & 1);
        f32x4 a = {0.f, 0.f, 0.f, 0.f};
#pragma unroll
        for (int ks = 0; ks < 2; ++ks) { const bf16x8 kf = *(const bf16x8*)(Kimg + (kb + l15) * 72 + ks * 32 + q4 * 8); a = MFMA(kf, qf[ks], a); }
        sc[t] = a;
    }
    const float* rpb = p.na_rpb + (size_t)(l * 8 + head) * 15 * 31;
    float mx = -1e30f;
#pragma unroll
    for (int t = 0; t < 16; ++t) {
        const int drow = rs + (t >> 1) - r + 7;
#pragma unroll
        for (int e = 0; e < 4; ++e) {
            const int col = cb + 16 * (t & 1) + 4 * q4 + e;
            const bool ok = (col >= cs) && (col < cs + 16);
            const int dcol = ok ? (col - c + 15) : 0;
            const float v = ok ? (sc[t][e] + rpb[drow * 31 + dcol]) : -1e30f;
            sc[t][e] = v; mx = fmaxf(mx, v);
        }
    }
    mx = fmaxf(mx, __shfl_xor(mx, 16)); mx = fmaxf(mx, __shfl_xor(mx, 32));
    float sum = 0.f;
#pragma unroll
    for (int t = 0; t < 16; ++t)
#pragma unroll
        for (int e = 0; e < 4; ++e) { const float pe = __expf(sc[t][e] - mx); sc[t][e] = pe; sum += pe; }
    sum += __shfl_xor(sum, 16); sum += __shfl_xor(sum, 32);
    f32x4 o[4];
#pragma unroll
    for (int dt = 0; dt < 4; ++dt) o[dt] = (f32x4){0.f, 0.f, 0.f, 0.f};
#pragma unroll
    for (int kk = 0; kk < 8; ++kk) {
        u32x4 pu; pu.x = pk2(sc[2 * kk][0], sc[2 * kk][1]); pu.y = pk2(sc[2 * kk][2], sc[2 * kk][3]); pu.z = pk2(sc[2 * kk + 1][0], sc[2 * kk + 1][1]); pu.w = pk2(sc[2 * kk + 1][2], sc[2 * kk + 1][3]);
        const bf16x8 pf = mkfrag(pu);
        const int kbA = (lo + kk) * 64 + cb + 4 * q4;
#pragma unroll
        for (int dt = 0; dt < 4; ++dt) {
            const bf16_t* vr = VT + (dt * 16 + l15) * 584 + kbA;
            const bf16x8 vf = mkfrag2(*(const u32x2*)vr, *(const u32x2*)(vr + 16));
            o[dt] = MFMA(vf, pf, o[dt]);
        }
    }
    const float inv = 1.0f / sum;
    const bf16_t* zrow = P + (size_t)(bl * SEQ + r * 64 + c) * PS + C_Z + head * 64;
#pragma unroll
    for (int dt = 0; dt < 4; ++dt) {
        const int dd = dt * 16 + 4 * q4;
        const f32x4 z = ld_bf4(zrow + dd);
        if (!dry) st_bf4(qrow + dd, o[dt] * inv * z);
    }
    __syncthreads();
}

__device__ __forceinline__ void memattn_load(const Params& p, int b, int h, unsigned char* lds) {
    bf16_t* Kimg = (bf16_t*)lds;
    bf16_t* VT = (bf16_t*)(lds + 69632);
    const bf16_t* Km = (const bf16_t*)(p.ws + OFF_KMAT); const bf16_t* Vm = (const bf16_t*)(p.ws + OFF_VT);
    int tid_ = threadIdx.x; asm volatile("" : "+v"(tid_)); const int tid = tid_;
#pragma unroll
    for (int i = 0; i < 8; ++i) {
        const int idx = tid + NTHR * i;
        { const int key = idx >> 4, ch = idx & 15; *(u32x4*)(Kimg + key * 136 + ch * 8) = *(const u32x4*)(Km + (size_t)(b * 256 + key) * 512 + h * 128 + ch * 8); }
        { const int dd = idx >> 5, ch = idx & 31; *(u32x4*)(VT + dd * 264 + ch * 8) = *(const u32x4*)(Vm + (size_t)(h * 128 + dd) * 2048 + b * 256 + ch * 8); }
    }
    __syncthreads();
}
__device__ __forceinline__ void memattn_item(bf16_t* P, int bl, int h, int qt, unsigned char* lds, int dry = 0) {
    const bf16_t* Kimg = (const bf16_t*)lds; const bf16_t* VT = (const bf16_t*)(lds + 69632);
    int tid_ = threadIdx.x; asm volatile("" : "+v"(tid_)); const int tid = tid_, lane = tid & 63, w = tid >> 6, l15 = lane & 15, q4 = lane >> 4;
    const int tok = bl * SEQ + qt * 128 + w * 16 + l15;
    bf16_t* qrow = P + (size_t)tok * PS + C_MQ + h * 128;
    bf16x8 qf[4];
#pragma unroll
    for (int ks = 0; ks < 4; ++ks) qf[ks] = *(const bf16x8*)(qrow + ks * 32 + q4 * 8);
    f32x4 sc[16];
    float mx = -1e30f;
#pragma unroll
    for (int t = 0; t < 16; ++t) {
        f32x4 a = {0.f, 0.f, 0.f, 0.f};
#pragma unroll
        for (int ks = 0; ks < 4; ++ks) { const bf16x8 kf = *(const bf16x8*)(Kimg + (t * 16 + l15) * 136 + ks * 32 + q4 * 8); a = MFMA(kf, qf[ks], a); }
        sc[t] = a;
        mx = fmaxf(mx, fmaxf(fmaxf(a[0], a[1]), fmaxf(a[2], a[3])));
    }
    mx = fmaxf(mx, __shfl_xor(mx, 16)); mx = fmaxf(mx, __shfl_xor(mx, 32));
    float sum = 0.f;
#pragma unroll
    for (int t = 0; t < 16; ++t)
#pragma unroll
        for (int e = 0; e < 4; ++e) { const float pe = __expf(sc[t][e] - mx); sc[t][e] = pe; sum += pe; }
    sum += __shfl_xor(sum, 16); sum += __shfl_xor(sum, 32);
    f32x4 o[8];
#pragma unroll
    for (int dt = 0; dt < 8; ++dt) o[dt] = (f32x4){0.f, 0.f, 0.f, 0.f};
#pragma unroll
    for (int kk = 0; kk < 8; ++kk) {
        u32x4 pu; pu.x = pk2(sc[2 * kk][0], sc[2 * kk][1]); pu.y = pk2(sc[2 * kk][2], sc[2 * kk][3]); pu.z = pk2(sc[2 * kk + 1][0], sc[2 * kk + 1][1]); pu.w = pk2(sc[2 * kk + 1][2], sc[2 * kk + 1][3]);
        const bf16x8 pf = mkfrag(pu);
#pragma unroll
        for (int dt = 0; dt < 8; ++dt) {
            const bf16_t* vr = VT + (dt * 16 + l15) * 264 + kk * 32 + 4 * q4;
            const bf16x8 vf = mkfrag2(*(const u32x2*)vr, *(const u32x2*)(vr + 16));
            o[dt] = MFMA(vf, pf, o[dt]);
        }
    }
    const float inv = 1.0f / sum;
    const bf16_t* zrow = P + (size_t)tok * PS + C_Z + 3 * 512 + h * 128;
#pragma unroll
    for (int dt = 0; dt < 8; ++dt) {
        const int dd = dt * 16 + 4 * q4;
        const f32x4 z = ld_bf4(zrow + dd);
        if (!dry) st_bf4(qrow + dd, o[dt] * inv * z);
    }
}

constexpr int G_LRT = 0, G_BF = 8192, G_BB = 24576, G_TOT = 40960, G_IMG = 45056;
__device__ __forceinline__ void gla_tables(const Params& p, int l, const float* LR, int t0, int h, unsigned char* lds) {
    float* LRT = (float*)(lds + G_LRT); float* BF = (float*)(lds + G_BF); float* BB = (float*)(lds + G_BB); float* TOT = (float*)(lds + G_TOT);
    int tid_ = threadIdx.x; asm volatile("" : "+v"(tid_)); const int tid = tid_;
    ((float4*)LRT)[tid] = ((const float4*)(LR + (size_t)t0 * 32))[tid];
    __syncthreads();
    const int dk = tid & 63, cgp = tid >> 6;
    float uf[16], ub[16];
#pragma unroll
    for (int r = 0; r < 16; ++r) { uf[r] = p.gla_up_f[(size_t)(l * 16 + r) * 256 + h * 64 + dk]; ub[r] = p.gla_up_b[(size_t)(l * 16 + r) * 256 + h * 64 + dk]; }
    const float bif = p.gla_bias_f[l * 256 + h * 64 + dk], bib = p.gla_bias_b[l * 256 + h * 64 + dk];
    float lf[8], lb[8];
#pragma unroll
    for (int i = 0; i < 8; ++i) {
        const int c = cgp * 8 + i; float sf = bif, sb = bib;
#pragma unroll
        for (int r = 0; r < 16; ++r) { sf += LRT[c * 32 + r] * uf[r]; sb += LRT[c * 32 + 16 + r] * ub[r]; }
        lf[i] = logsigf_(sf) * (1.0f / 16.0f); lb[i] = logsigf_(sb) * (1.0f / 16.0f);
    }
#pragma unroll
    for (int i = 1; i < 8; ++i) lf[i] += lf[i - 1];
#pragma unroll
    for (int i = 6; i >= 0; --i) lb[i] += lb[i + 1];
    TOT[cgp * 64 + dk] = lf[7]; TOT[512 + cgp * 64 + dk] = lb[0];
    __syncthreads();
    float of = 0.f, ob = 0.f;
#pragma unroll
    for (int g2 = 0; g2 < 8; ++g2) { if (g2 < cgp) of += TOT[g2 * 64 + dk]; if (g2 > cgp) ob += TOT[512 + g2 * 64 + dk]; }
#pragma unroll
    for (int i = 0; i < 8; ++i) { BF[(cgp * 8 + i) * 64 + dk] = lf[i] + of; BB[(cgp * 8 + i) * 64 + dk] = lb[i] + ob; }
    __syncthreads();
}
struct GlaPre { u32x4 vv[2]; bf16_t q[8], k[8]; };
__device__ __forceinline__ void gla_prefetch(GlaPre& g, const bf16_t* P, int t0, int h, int tid) {
#pragma unroll
    for (int i = 0; i < 2; ++i) { const int idx = tid + NTHR * i, chn = idx >> 6, c = idx & 63; g.vv[i] = *(const u32x4*)(P + (size_t)(t0 + c) * PS + C_GV + h * 128 + chn * 8); }
#pragma unroll
    for (int i = 0; i < 8; ++i) { const int idx = tid + NTHR * i, c = idx >> 6, dk = idx & 63; g.q[i] = P[(size_t)(t0 + c) * PS + C_GQ + h * 64 + dk]; g.k[i] = P[(size_t)(t0 + c) * PS + C_GK + h * 64 + dk]; }
}
__device__ __forceinline__ void gla_vt_store(const GlaPre& g, bf16_t* VT, int tid) {
#pragma unroll
    for (int i = 0; i < 2; ++i) {
        const int idx = tid + NTHR * i, chn = idx >> 6, c = idx & 63;
        const u32x4 vv = g.vv[i];
        bf16_t* vd = VT + (chn * 8) * 72 + c;
        vd[0 * 72] = (bf16_t)(vv.x & 0xffffu); vd[1 * 72] = (bf16_t)(vv.x >> 16);
        vd[2 * 72] = (bf16_t)(vv.y & 0xffffu); vd[3 * 72] = (bf16_t)(vv.y >> 16);
        vd[4 * 72] = (bf16_t)(vv.z & 0xffffu); vd[5 * 72] = (bf16_t)(vv.z >> 16);
        vd[6 * 72] = (bf16_t)(vv.w & 0xffffu); vd[7 * 72] = (bf16_t)(vv.w >> 16);
    }
}
__device__ __forceinline__ void gla_part1_item(const Params& p, int l, const bf16_t* P, const float* LR, int item, unsigned char* lds) {
    const int h = item & 3, n = (item >> 2) & 127, bl = item >> 9, t0 = bl * SEQ + n * 64;
    const float* BF = (const float*)(lds + G_BF); const float* BB = (const float*)(lds + G_BB);
    bf16_t* KDT0 = (bf16_t*)(lds + G_IMG); bf16_t* KDT1 = KDT0 + 64 * 72; bf16_t* VT = KDT1 + 64 * 72;
    float* GS = (float*)(p.ws + OFF_GS); float* GD = (float*)(p.ws + OFF_GDEC);
    int tid_ = threadIdx.x; asm volatile("" : "+v"(tid_)); const int tid = tid_, lane = tid & 63, w = tid >> 6, l15 = lane & 15, q4 = lane >> 4;
    GlaPre gp; gla_prefetch(gp, P, t0, h, tid);
    gla_tables(p, l, LR, t0, h, lds);
#pragma unroll
    for (int i = 0; i < 8; ++i) {
        const int idx = tid + NTHR * i, c = idx >> 6, dk = idx & 63;
        const float kv = bf2f(gp.k[i]);
        KDT0[dk * 72 + c] = f2bf(kv * __expf(BF[63 * 64 + dk] - BF[c * 64 + dk]));
        KDT1[dk * 72 + c] = f2bf(kv * __expf(BB[dk] - BB[c * 64 + dk]));
    }
    gla_vt_store(gp, VT, tid);
    if (tid < 64) GD[(size_t)item * 64 + tid] = __expf(BF[63 * 64 + tid]);
    else if (tid < 128) GD[(size_t)(NITEM + item) * 64 + tid - 64] = __expf(BB[tid - 64]);
    __syncthreads();
    const int dir = w >> 2, dkt = w & 3;
    const bf16_t* KD = dir ? KDT1 : KDT0;
    bf16x8 kf[2];
#pragma unroll
    for (int ks = 0; ks < 2; ++ks) kf[ks] = *(const bf16x8*)(KD + (16 * dkt + l15) * 72 + 32 * ks + 8 * q4);
    float* dst = GS + ((size_t)dir * NITEM + item) * 8192;
#pragma unroll
    for (int dvt = 0; dvt < 8; ++dvt) {
        f32x4 a = {0.f, 0.f, 0.f, 0.f};
#pragma unroll
        for (int ks = 0; ks < 2; ++ks) { const bf16x8 vf = *(const bf16x8*)(VT + (16 * dvt + l15) * 72 + 32 * ks + 8 * q4); a = MFMA(kf[ks], vf, a); }
        *(f32x4*)(dst + (16 * dvt + l15) * 64 + 16 * dkt + 4 * q4) = a;
    }
    __syncthreads();
}
__device__ __forceinline__ void gla_scan(const Params& p, int dry = 0) {
    float* GS = (float*)(p.ws + OFF_GS); const float* GD = (const float*)(p.ws + OFF_GDEC);
    const int total = 2 * BG * 4 * 8192;
    int tid_ = threadIdx.x; asm volatile("" : "+v"(tid_));
    for (int id = blockIdx.x * NTHR + tid_; id < total; id += gridDim.x * NTHR) {
        const int e = id & 8191, comb = id >> 13, h = comb & 3, bl = (comb >> 2) % BG, dir = comb / (4 * BG), dk = e & 63;
        float S = 0.f;
        const size_t ibase = (size_t)dir * NITEM + (size_t)(bl * 128) * 4 + h;
        for (int s0 = 0; s0 < 128; s0 += 16) {
            float u[16], dc[16];
#pragma unroll
            for (int i = 0; i < 16; ++i) {
                const int n = dir ? 127 - (s0 + i) : s0 + i;
                const size_t item = ibase + (size_t)n * 4;
                u[i] = GS[item * 8192 + e]; dc[i] = GD[item * 64 + dk];
            }
#pragma unroll
            for (int i = 0; i < 16; ++i) {
                const int n = dir ? 127 - (s0 + i) : s0 + i;
                const size_t item = ibase + (size_t)n * 4;
                if (!dry) GS[item * 8192 + e] = S;
                S = dc[i] * S + u[i];
            }
        }
    }
}
__device__ __forceinline__ void gla_part2_item(const Params& p, int l, bf16_t* P, const float* LR, int item, unsigned char* lds, int dry = 0) {
    const int h = item & 3, n = (item >> 2) & 127, bl = item >> 9, t0 = bl * SEQ + n * 64;
    const float* BF = (const float*)(lds + G_BF); const float* BB = (const float*)(lds + G_BB);
    bf16_t* QF = (bf16_t*)(lds + G_IMG);
    bf16_t* KF = QF + 2 * 64 * 72;
    bf16_t* QD = KF + 2 * 64 * 72;
    bf16_t* VT = QD + 2 * 64 * 72;
    bf16_t* ST = VT + 128 * 72;
    float* OX = (float*)lds;
    const float* GS = (const float*)(p.ws + OFF_GS);
    int tid_ = threadIdx.x; asm volatile("" : "+v"(tid_)); const int tid = tid_, lane = tid & 63, w = tid >> 6, l15 = lane & 15, q4 = lane >> 4;
    GlaPre gp; gla_prefetch(gp, P, t0, h, tid);
    float4 sp[2][4];
#pragma unroll
    for (int dir = 0; dir < 2; ++dir)
#pragma unroll
        for (int i = 0; i < 4; ++i) { const int idx = tid + NTHR * i; sp[dir][i] = *(const float4*)(GS + ((size_t)dir * NITEM + item) * 8192 + (idx >> 4) * 64 + (idx & 15) * 4); }
    gla_tables(p, l, LR, t0, h, lds);
#pragma unroll
    for (int i = 0; i < 8; ++i) {
        const int idx = tid + NTHR * i, c = idx >> 6, dk = idx & 63;
        const float qv = bf2f(gp.q[i]);
        const float kv = bf2f(gp.k[i]);
        const float bf = BF[c * 64 + dk], mf = BF[31 * 64 + dk], bb = BB[c * 64 + dk], mb = BB[32 * 64 + dk];
        QF[c * 72 + dk] = f2bf(qv * __expf(bf - mf)); KF[c * 72 + dk] = f2bf(kv * __expf(mf - bf)); QD[c * 72 + dk] = f2bf(qv * __expf(bf));
        QF[4608 + c * 72 + dk] = f2bf(qv * __expf(bb - mb)); KF[4608 + c * 72 + dk] = f2bf(kv * __expf(mb - bb)); QD[4608 + c * 72 + dk] = f2bf(qv * __expf(bb));
    }
    gla_vt_store(gp, VT, tid);
#pragma unroll
    for (int dir = 0; dir < 2; ++dir) {
#pragma unroll
        for (int i = 0; i < 4; ++i) {
            const int idx = tid + NTHR * i, dv = idx >> 4, dk4 = (idx & 15) * 4;
            const float4 s = sp[dir][i];
            u32x2 o; o.x = pk2(s.x, s.y); o.y = pk2(s.z, s.w);
            *(u32x2*)(ST + dir * 9216 + dv * 72 + dk4) = o;
        }
    }
    __syncthreads();
    const int dir = w >> 2, ct = w & 3;
    const bf16_t* qfp = QF + dir * 4608; const bf16_t* kfp = KF + dir * 4608; const bf16_t* qdp = QD + dir * 4608; const bf16_t* stp = ST + dir * 9216;
    bf16x8 qf[2], qd[2];
#pragma unroll
    for (int ks = 0; ks < 2; ++ks) { qf[ks] = *(const bf16x8*)(qfp + (16 * ct + l15) * 72 + 32 * ks + 8 * q4); qd[ks] = *(const bf16x8*)(qdp + (16 * ct + l15) * 72 + 32 * ks + 8 * q4); }
    f32x4 sc[4];
    const int cq = 16 * ct + l15;
#pragma unroll
    for (int st = 0; st < 4; ++st) {
        f32x4 a = {0.f, 0.f, 0.f, 0.f};
#pragma unroll
        for (int ks = 0; ks < 2; ++ks) { const bf16x8 kf = *(const bf16x8*)(kfp + (16 * st + l15) * 72 + 32 * ks + 8 * q4); a = MFMA(kf, qf[ks], a); }
#pragma unroll
        for (int e = 0; e < 4; ++e) { const int s = 16 * st + 4 * q4 + e; const bool ok = dir ? (s > cq) : (s <= cq); a[e] = ok ? a[e] : 0.f; }
        sc[st] = a;
    }
    f32x4 o[8];
#pragma unroll
    for (int dt = 0; dt < 8; ++dt) o[dt] = (f32x4){0.f, 0.f, 0.f, 0.f};
#pragma unroll
    for (int kk = 0; kk < 2; ++kk) {
        u32x4 pu; pu.x = pk2(sc[2 * kk][0], sc[2 * kk][1]); pu.y = pk2(sc[2 * kk][2], sc[2 * kk][3]); pu.z = pk2(sc[2 * kk + 1][0], sc[2 * kk + 1][1]); pu.w = pk2(sc[2 * kk + 1][2], sc[2 * kk + 1][3]);
        const bf16x8 pf = mkfrag(pu);
#pragma unroll
        for (int dt = 0; dt < 8; ++dt) {
            const bf16_t* vr = VT + (dt * 16 + l15) * 72 + kk * 32 + 4 * q4;
            const bf16x8 vf = mkfrag2(*(const u32x2*)vr, *(const u32x2*)(vr + 16));
            o[dt] = MFMA(vf, pf, o[dt]);
        }
    }
#pragma unroll
    for (int ks = 0; ks < 2; ++ks)
#pragma unroll
        for (int dt = 0; dt < 8; ++dt) { const bf16x8 sf = *(const bf16x8*)(stp + (dt * 16 + l15) * 72 + 32 * ks + 8 * q4); o[dt] = MFMA(sf, qd[ks], o[dt]); }
    if (dir == 1) {
#pragma unroll
        for (int dt = 0; dt < 8; ++dt) *(f32x4*)(OX + cq * 132 + 16 * dt + 4 * q4) = o[dt];
    }
    __syncthreads();
    if (dir == 0) {
        float ss = 0.f;
#pragma unroll
        for (int dt = 0; dt < 8; ++dt) { o[dt] += *(const f32x4*)(OX + cq * 132 + 16 * dt + 4 * q4); ss += (o[dt][0] * o[dt][0] + o[dt][1] * o[dt][1]) + (o[dt][2] * o[dt][2] + o[dt][3] * o[dt][3]); }
        ss += __shfl_xor(ss, 16); ss += __shfl_xor(ss, 32);
        const float rms = 1.0f / sqrtf(ss * (1.0f / 128.0f) + 1e-6f);
        const float* ng = p.gla_norm_g + l * 512 + h * 128;
        const bf16_t* zrow = P + (size_t)(t0 + cq) * PS + C_Z + 2 * 512 + h * 128;
        bf16_t* orow = P + (size_t)(t0 + cq) * PS + C_GV + h * 128;
#pragma unroll
        for (int dt = 0; dt < 8; ++dt) {
            const int dd = 16 * dt + 4 * q4;
            const f32x4 z = ld_bf4(zrow + dd); const f32x4 g4 = *(const f32x4*)(ng + dd);
            if (!dry) st_bf4(orow + dd, o[dt] * rms * g4 * z);
        }
    }
    __syncthreads();
}

namespace pg8 {
#define PG8_LAS __attribute__((address_space(3)))
typedef unsigned short bf16_t;
typedef short bf16x8 __attribute__((ext_vector_type(8)));
typedef float f32x4 __attribute__((ext_vector_type(4)));
typedef unsigned u32x4 __attribute__((ext_vector_type(4)));
constexpr int BM = 256, BK = 64, HALF = 128, HTB = HALF * BK * 2  , STAGE_BYTES = 8 * HTB, NXCD = 8, WGM = 8;

__host__ __device__ __forceinline__ int lds_byte(int r, int c) { const int st = (r >> 4) * 2 + (c >> 5), rr = r & 15, cc = c & 31, ob = rr * 64 + cc * 2; return st * 1024 + (ob ^ (((ob >> 9) & 1) << 5)); }
__host__ __device__ __forceinline__ void stage_rc(int b, int& R, int& C) { const int st = b / 1024, sb = b % 1024, swz = sb ^ (((sb >> 9) & 1) << 5); R = (st >> 1) * 16 + swz / 64; C = (st & 1) * 32 + (swz % 64) / 2; }
__host__ __device__ __forceinline__ int perm32(int rho) { const int n = rho >> 4, i = rho & 15; return 8 * (i >> 2) + 4 * n + (i & 3); }

struct Unit { int pm, pn; };
struct Gemm { const bf16_t* A; const bf16_t* Bt; int M, N, K; };

struct StaticOrder {
    int nM, nN, nwg, G, c;
    __host__ __device__ __forceinline__ void init(int M, int N, int G_, int c_) { nM = M / BM; nN = N / BM; nwg = nM * nN; G = G_; c = c_; }
    __host__ __device__ bool next(int i, Unit& u) const {
        const long L = (long)i * G + c; if (L >= nwg) return false;
        int wgid = (int)L; { const int q = nwg / NXCD, r = nwg % NXCD, xcd = wgid % NXCD, off = wgid / NXCD; wgid = (xcd < r ? xcd * (q + 1) : r * (q + 1) + (xcd - r) * q) + off; }
        const int nig = WGM * nN, gid = wgid / nig, fm = gid * WGM, gsz = (nM - fm) < WGM ? (nM - fm) : WGM;
        u.pm = fm + ((wgid % nig) % gsz); u.pn = (wgid % nig) / gsz; return true;
    }
    __device__ __forceinline__ void a_ready(const Unit&) const {}
    __device__ __forceinline__ void done(const Unit&) const {}
};
__device__ __forceinline__ unsigned cvt_pk_bf16(float lo, float hi) { unsigned r; asm volatile("v_cvt_pk_bf16_f32 %0, %1, %2" : "=v"(r) : "v"(lo), "v"(hi)); return r; }
template <class Epi, class Sched, bool STAMP = false>
__device__ __forceinline__ void gemm_phase(PG8_LAS unsigned char* lds, const Gemm g, const Sched& S, const Epi& E, unsigned long long* stamps) {
    int tid_l = threadIdx.x; asm volatile("" : "+v"(tid_l)); const int tid = tid_l, wid = __builtin_amdgcn_readfirstlane(tid >> 6), lane = tid & 63, wr = wid >> 2, wc = wid & 3, fr = lane & 15, fq = lane >> 4;
    const int K = g.K, nt = K / BK;
    int ts_lo = 0, ts_hi = 0, nts = 0; const unsigned long long rt_entry = STAMP ? (unsigned long long)wall_clock64() : 0ull;
#define PG8_STAMP() do { if (STAMP && wid == 0 && nts < 64) { const unsigned long long _c = (unsigned long long)clock64(); \
        ts_lo = (lane == nts) ? (int)(unsigned)_c : ts_lo; ts_hi = (lane == nts) ? (int)(unsigned)(_c >> 32) : ts_hi; ++nts; } } while (0)
    PG8_STAMP();
    unsigned voffA[2], voffB[2];
#pragma unroll
    for (int i = 0; i < 2; ++i) { int R, C; stage_rc(tid * 16 + i * 8192, R, C); const int Rb = Epi::PERM ? ((R & ~31) + perm32(R & 31)) : R;
        voffA[i] = (unsigned)(R * K + C) * 2u; voffB[i] = (unsigned)(Rb * K + C) * 2u; }
    const size_t kstep = (size_t)(BK * 2);
    const size_t hstep = (size_t)HALF * K * 2;
    const size_t tstep = 2 * hstep;
    const unsigned ldsw = (unsigned)wid * 1024u;
    const int aoff = lds_byte(wr * 64 + fr, fq * 8), boff = lds_byte(wc * 32 + fr, fq * 8);
#define PG8_SA(b, h) (((b) * 2 + (h)) * HTB)
#define PG8_SB(b, h) ((4 + (b) * 2 + (h)) * HTB)
#define PG8_STAGE(bufoff, gbase, voff) do { _Pragma("unroll") for (int _i = 0; _i < 2; ++_i) \
        __builtin_amdgcn_global_load_lds((const unsigned*)((const char*)(gbase) + (voff)[_i]), (PG8_LAS unsigned*)(lds + (bufoff) + ldsw + _i * 8192), 16, 0, 0); } while (0)
#define PG8_LDA(dst, b, h) do { _Pragma("unroll") for (int m = 0; m < 4; ++m) _Pragma("unroll") for (int k = 0; k < 2; ++k) dst[m][k] = *(const PG8_LAS bf16x8*)(lds + PG8_SA(b, h) + aoff + m * 2048 + k * 1024); } while (0)
#define PG8_LDB(dst, b, h) do { _Pragma("unroll") for (int n = 0; n < 2; ++n) _Pragma("unroll") for (int k = 0; k < 2; ++k) dst[n][k] = *(const PG8_LAS bf16x8*)(lds + PG8_SB(b, h) + boff + n * 2048 + k * 1024); } while (0)
#define PG8_MMA(ai, bj, At, Bt) do { __builtin_amdgcn_s_setprio(1); _Pragma("unroll") for (int m = 0; m < 4; ++m) _Pragma("unroll") for (int n = 0; n < 2; ++n) _Pragma("unroll") for (int k = 0; k < 2; ++k) \
        acc[ai][bj][m][n] = __builtin_amdgcn_mfma_f32_16x16x32_bf16(Bt[n][k], At[m][k], acc[ai][bj][m][n], 0, 0, 0); __builtin_amdgcn_s_setprio(0); } while (0)
#define PG8_WAIT_V(n) asm volatile("s_waitcnt vmcnt(" #n ")" ::: "memory")
#define PG8_WAIT_L(n) asm volatile("s_waitcnt lgkmcnt(" #n ")" ::: "memory")
#define PG8_BAR __builtin_amdgcn_s_barrier()
#define PG8_SCHED __builtin_amdgcn_sched_barrier(0)
    Unit cur, nxt; int ui = 0;
    if (!S.next(0, cur)) return;
    f32x4 acc[2][2][4][2];
#pragma unroll
    for (int a = 0; a < 2; ++a)
#pragma unroll
        for (int b = 0; b < 2; ++b)
#pragma unroll
            for (int m = 0; m < 4; ++m)
#pragma unroll
                for (int n = 0; n < 2; ++n) acc[a][b][m][n] = (f32x4){0.f, 0.f, 0.f, 0.f};
    bf16x8 At[4][2], B0[2][2], B1[2][2];
    const char* cA = (const char*)g.A + (size_t)cur.pm * tstep; const char* cB = (const char*)g.Bt + (size_t)cur.pn * tstep;
    S.a_ready(cur);
    PG8_STAGE(PG8_SB(0, 0), cB, voffB); PG8_STAGE(PG8_SA(0, 0), cA, voffA); PG8_STAGE(PG8_SB(0, 1), cB + hstep, voffB); PG8_STAGE(PG8_SA(0, 1), cA + hstep, voffA);
    if (wr == 1) PG8_BAR;
    PG8_WAIT_V(4); PG8_BAR;
    PG8_STAGE(PG8_SB(1, 0), cB + kstep, voffB); PG8_STAGE(PG8_SA(1, 0), cA + kstep, voffA); PG8_STAGE(PG8_SB(1, 1), cB + hstep + kstep, voffB);
    PG8_WAIT_V(6); PG8_BAR;
    PG8_STAMP();
    for (;;) {
        const bool has_next = S.next(ui + 1, nxt);
        const char* nA = has_next ? (const char*)g.A + (size_t)nxt.pm * tstep : cA; const char* nB = has_next ? (const char*)g.Bt + (size_t)nxt.pn * tstep : cB;
        for (int t = 0; t < nt; t += 2) {
            const bool last = (t == nt - 2);
            const char* a1 = cA + (size_t)(t + 1) * kstep;
            const char* a2 = last ? nA : cA + (size_t)(t + 2) * kstep; const char* b2 = last ? nB : cB + (size_t)(t + 2) * kstep;
            const char* a3 = a2 + kstep; const char* b3 = b2 + kstep;
            if (last && has_next) S.a_ready(nxt);
            PG8_LDB(B0, 0, 0); PG8_SCHED; PG8_LDA(At, 0, 0); PG8_STAGE(PG8_SA(1, 1), a1 + hstep, voffA);
            PG8_WAIT_L(8); PG8_BAR; PG8_WAIT_L(0); PG8_MMA(0, 0, At, B0); PG8_BAR; PG8_SCHED;
            PG8_LDB(B1, 0, 1); PG8_STAGE(PG8_SB(0, 0), b2, voffB);
            PG8_BAR; PG8_WAIT_L(0); PG8_MMA(0, 1, At, B1); PG8_BAR;
            PG8_LDA(At, 0, 1); PG8_STAGE(PG8_SA(0, 0), a2, voffA);
            PG8_BAR; PG8_WAIT_L(0); PG8_MMA(1, 0, At, B0); PG8_BAR; PG8_SCHED;
            PG8_STAGE(PG8_SB(0, 1), b2 + hstep, voffB);
            PG8_WAIT_V(6); PG8_BAR; PG8_MMA(1, 1, At, B1); PG8_BAR;
            PG8_LDB(B0, 1, 0); PG8_SCHED; PG8_LDA(At, 1, 0); PG8_STAGE(PG8_SA(0, 1), a2 + hstep, voffA);
            PG8_WAIT_L(8); PG8_BAR; PG8_WAIT_L(0); PG8_MMA(0, 0, At, B0); PG8_BAR; PG8_SCHED;
            PG8_LDB(B1, 1, 1); PG8_STAGE(PG8_SB(1, 0), b3, voffB);
            PG8_BAR; PG8_WAIT_L(0); PG8_MMA(0, 1, At, B1); PG8_BAR;
            PG8_LDA(At, 1, 1); PG8_STAGE(PG8_SA(1, 0), a3, voffA);
            PG8_BAR; PG8_WAIT_L(0); PG8_MMA(1, 0, At, B0); PG8_BAR; PG8_SCHED;
            PG8_STAGE(PG8_SB(1, 1), b3 + hstep, voffB);
            PG8_WAIT_V(6); PG8_BAR; PG8_MMA(1, 1, At, B1); PG8_BAR;
        }
        PG8_STAMP();
        if constexpr (!Epi::AFTER_DRAIN) { E(acc, cur, wr, wc, fr, fq); S.done(cur); }
        PG8_STAMP();
        if (!has_next) break;
#pragma unroll
        for (int a = 0; a < 2; ++a)
#pragma unroll
            for (int b = 0; b < 2; ++b)
#pragma unroll
                for (int m = 0; m < 4; ++m)
#pragma unroll
                    for (int n = 0; n < 2; ++n) acc[a][b][m][n] = (f32x4){0.f, 0.f, 0.f, 0.f};
        cur = nxt; cA = nA; cB = nB; ++ui;
    }
    PG8_WAIT_V(0);
    if (wr == 0) PG8_BAR;
    PG8_BAR;
    if constexpr (Epi::AFTER_DRAIN) { E.fused(acc, cur, wr, wc, fr, fq, lds, wid, lane); S.done(cur); }
    PG8_STAMP();
    if (STAMP && wid == 0) { stamps[lane] = lane < nts ? (((unsigned long long)(unsigned)ts_hi << 32) | (unsigned)ts_lo) : 0ull;
        if (lane == 62) stamps[62] = rt_entry; if (lane == 63) stamps[63] = (unsigned long long)wall_clock64(); }
#undef PG8_STAMP
#undef PG8_SA
#undef PG8_SB
#undef PG8_STAGE
#undef PG8_LDA
#undef PG8_LDB
#undef PG8_MMA
#undef PG8_WAIT_V
#undef PG8_WAIT_L
#undef PG8_BAR
#undef PG8_SCHED
}
}

struct EpiInProj {
    static constexpr bool PERM = true, AFTER_DRAIN = false;
    bf16_t* P; const float* bias; float* LR;
    __device__ __forceinline__ void operator()(const f32x4 (&acc)[2][2][4][2], const pg8::Unit& u, int wr, int wc, int fr, int fq) const {
        const int row0 = u.pm * 256 + wr * 64 + fr, colt = u.pn * 256, col0 = colt + wc * 32 + 8 * fq;
        if (colt == C_LR) {
            if (wc == 0) {
                const int cl = 8 * fq;
                const f32x4 b0 = *(const f32x4*)(bias + 4096 + cl), b1 = *(const f32x4*)(bias + 4096 + cl + 4);
#pragma unroll
                for (int ai = 0; ai < 2; ++ai)
#pragma unroll
                    for (int m = 0; m < 4; ++m) {
                        float* d = LR + (size_t)(row0 + ai * 128 + m * 16) * 32 + cl;
                        *(f32x4*)d = acc[ai][0][m][0] + b0; *(f32x4*)(d + 4) = acc[ai][0][m][1] + b1;
                    }
            }
            return;
        }
        const int mode = (colt < 512 || colt == C_GQ) ? 1 : (colt >= C_MQ && colt < C_Z) ? 2 : (colt >= C_Z && colt < C_SG) ? 3 : (colt >= C_SG) ? 4 : 0;
#pragma unroll
        for (int bj = 0; bj < 2; ++bj) {
            const int col = col0 + bj * 128;
            const f32x4 b0 = *(const f32x4*)(bias + orig_col(col)), b1 = *(const f32x4*)(bias + orig_col(col) + 4);
#pragma unroll
            for (int ai = 0; ai < 2; ++ai)
#pragma unroll
                for (int m = 0; m < 4; ++m) {
                    f32x4 v0 = acc[ai][bj][m][0] + b0, v1 = acc[ai][bj][m][1] + b1;
                    if (mode == 1) { v0 *= 0.125f; v1 *= 0.125f; }
                    else if (mode == 2) { v0 *= 0.08838834764831845f; v1 *= 0.08838834764831845f; }
                    else if (mode == 3) {
#pragma unroll
                        for (int e = 0; e < 4; ++e) { v0[e] = siluf_(v0[e]); v1[e] = siluf_(v1[e]); }
                    } else if (mode == 4) {
#pragma unroll
                        for (int e = 0; e < 4; ++e) { v0[e] = sigmoidf_(v0[e]); v1[e] = sigmoidf_(v1[e]); }
                    }
                    u32x4 o; o.x = pk2(v0[0], v0[1]); o.y = pk2(v0[2], v0[3]); o.z = pk2(v1[0], v1[1]); o.w = pk2(v1[2], v1[3]);
                    *(u32x4*)(P + (size_t)(row0 + ai * 128 + m * 16) * PS + col) = o;
                }
        }
    }
};
struct EpiOut {
    static constexpr bool PERM = false, AFTER_DRAIN = false;
    float* pre; const float* bo; const float* x; const float2* stats; const float* g0; const float* b0; const float* hres; size_t tok0; int l;
    __device__ __forceinline__ void operator()(const f32x4 (&acc)[2][2][4][2], const pg8::Unit& u, int wr, int wc, int fr, int fq) const {
        const int row0 = u.pm * 256 + wr * 64 + fr, col0 = u.pn * 256 + wc * 32 + 4 * fq;
#pragma unroll
        for (int ai = 0; ai < 2; ++ai)
#pragma unroll
            for (int m = 0; m < 4; ++m) {
                const int row = row0 + ai * 128 + m * 16; const size_t T = tok0 + row;
                float2 st; st.x = 0.f; st.y = 0.f; if (l == 0) st = stats[T];
#pragma unroll
                for (int bj = 0; bj < 2; ++bj)
#pragma unroll
                    for (int n = 0; n < 2; ++n) {
                        const int col = col0 + bj * 128 + n * 16;
                        f32x4 res;
                        if (l == 0) res = (*(const f32x4*)(x + T * 1024 + col) - st.x) * st.y * *(const f32x4*)(g0 + col) + *(const f32x4*)(b0 + col);
                        else res = *(const f32x4*)(hres + T * 1024 + col);
                        *(f32x4*)(pre + (size_t)row * 1024 + col) = acc[ai][bj][m][n] + *(const f32x4*)(bo + col) + DN_ALPHA * res;
                    }
            }
    }
};

#define XB_TMO      128
#define XB_XCNT(j)  (256  + 64 * (j))
#define XB_XSUB(j)  (1280 + 64 * (j))
#define XB_XGEN(j)  (2304 + 64 * (j))
#define XB_TOP      3328
#define XB_TOPGEN   3392
#define XCD_BAR_WORDS 3456
#define XB_SPIN_CAP (1u << 18)
#define LAS __attribute__((address_space(3)))

__device__ __forceinline__ unsigned xb_ld(unsigned* p)              { return __hip_atomic_load(p, __ATOMIC_RELAXED, __HIP_MEMORY_SCOPE_AGENT); }
__device__ __forceinline__ unsigned xb_add(unsigned* p, unsigned v) { return __hip_atomic_fetch_add(p, v, __ATOMIC_RELAXED, __HIP_MEMORY_SCOPE_AGENT); }
__device__ __forceinline__ unsigned xb_xcc_id() { return (unsigned)__builtin_amdgcn_s_getreg((3 << 11) | 20) & 0xFu; }
#define XB_SPIN(cond, bar) do { unsigned _sp = 0; while (cond) { __builtin_amdgcn_s_sleep(1); \
    if ((++_sp & 255u) == 0u) { if (xb_ld(&(bar)[XB_TMO])) break; if (_sp > XB_SPIN_CAP) { atomicAdd(&(bar)[XB_TMO], 1u); break; } } } } while (0)

struct XcdBarrier {
    unsigned* bar; unsigned x;
    volatile LAS unsigned* st;
};

__device__ __forceinline__ XcdBarrier xcd_barrier_post(unsigned* bar, volatile LAS unsigned* st) {
    XcdBarrier b; b.bar = bar; b.x = xb_xcc_id(); b.st = st;
    if (threadIdx.x == 0) (void)xb_add(&bar[XB_XCNT(b.x)], 1u);
    return b;
}
__device__ __forceinline__ void xcd_barrier_complete(unsigned* bar, unsigned x, unsigned& nloc, unsigned& nx) {
    const unsigned G = gridDim.x * gridDim.y * gridDim.z;
    unsigned sum, cnt, mine, sp = 0u;
    for (;;) {
        sum = 0u; cnt = 0u; mine = 0u;
#pragma unroll
        for (unsigned j = 0; j < 16; ++j) { const unsigned c = xb_ld(&bar[XB_XCNT(j)]); sum += c; cnt += (c > 0u) ? 1u : 0u; mine = (j == x) ? c : mine; }
        if (sum == G) break;
        __builtin_amdgcn_s_sleep(1);
        if ((++sp & 255u) == 0u) { if (xb_ld(&bar[XB_TMO])) break; if (sp > XB_SPIN_CAP) { atomicAdd(&bar[XB_TMO], 1u); break; } }
    }
    nloc = mine > 0u ? mine : 1u; nx = cnt > 0u ? cnt : 1u;
}

__device__ __forceinline__ void xcd_barrier(unsigned* b_bar, unsigned b_x, volatile LAS unsigned* b_st) {
    asm volatile("s_waitcnt vmcnt(0)" ::: "memory");
    __syncthreads();
    if (threadIdx.x == 0) {
        unsigned* bar = b_bar;
        __builtin_amdgcn_s_waitcnt(0);
        unsigned nloc = b_st[0], nx = b_st[1];
        if (nloc == 0u) { xcd_barrier_complete(bar, b_x, nloc, nx); b_st[0] = nloc; b_st[1] = nx; }
        const unsigned old = xb_add(&bar[XB_XSUB(b_x)], 1u);
        const unsigned gen = old / nloc;
        if (old + 1u == (gen + 1u) * nloc) {
            __builtin_amdgcn_fence(__ATOMIC_RELEASE, "agent");
            asm volatile("s_waitcnt vmcnt(0)" ::: "memory");
            const unsigned og = xb_add(&bar[XB_TOP], 1u);
            const unsigned tg = og / nx;
            if (og + 1u == (tg + 1u) * nx) xb_add(&bar[XB_TOPGEN], 1u);
            else XB_SPIN(xb_ld(&bar[XB_TOPGEN]) == tg, bar);
            __builtin_amdgcn_fence(__ATOMIC_ACQUIRE, "agent");
            xb_add(&bar[XB_XGEN(b_x)], 1u);
            asm volatile("s_waitcnt vmcnt(0)" ::: "memory");
        } else {
            XB_SPIN(xb_ld(&bar[XB_XGEN(b_x)]) == gen, bar);
            __builtin_amdgcn_fence(__ATOMIC_ACQUIRE, "agent");
            asm volatile("s_waitcnt vmcnt(0)" ::: "memory");
        }
    }
    __syncthreads();
}

__device__ __forceinline__ void gbar(unsigned* ctr, unsigned& gen, int G) {
    __syncthreads();
    gen += (unsigned)G;
    if (threadIdx.x == 0) {
        __threadfence();
        __hip_atomic_fetch_add(ctr, 1u, __ATOMIC_RELAXED, __HIP_MEMORY_SCOPE_AGENT);
        while (__hip_atomic_load(ctr, __ATOMIC_RELAXED, __HIP_MEMORY_SCOPE_AGENT) < gen) __builtin_amdgcn_s_sleep(1);
        __threadfence();
    }
    __syncthreads();
}
typedef const Params __attribute__((address_space(4))) KParams;
#define KP4 __attribute__((address_space(4)))
__device__ __forceinline__ Params fresh_params() {
#if defined(__HIP_DEVICE_COMPILE__)
    KParams* kp = (KParams*)__builtin_amdgcn_kernarg_segment_ptr();
    asm volatile("" : "+s"(kp));
    Params r;
    const float* KP4 const* src = (const float* KP4 const*)kp;
    const float** dst = (const float**)&r;
#pragma unroll
    for (int i = 0; i < 28; ++i) dst[i] = src[i];
    return r;
#else
    return Params{};
#endif
}
__global__ void __launch_bounds__(NTHR) mega(Params p_unused) {
    extern __shared__ __attribute__((aligned(16))) unsigned char lds[];
    cg::grid_group grid = cg::this_grid();
    const int G = gridDim.x, bid = blockIdx.x;
    volatile LAS unsigned* xst = (volatile LAS unsigned*)((LAS unsigned char*)lds + (LDS_BYTES - 16));
    if (threadIdx.x == 0) { xst[0] = 0u; xst[1] = 0u; }
    __syncthreads();
    unsigned* xbar; unsigned xx;
    { const Params p = fresh_params(); xbar = (unsigned*)(p.ws + OFF_BAR); xx = xb_xcc_id(); if (threadIdx.x == 0) (void)xb_add(&xbar[XB_XCNT(xx)], 1u); }
    { const Params p = fresh_params(); phase0(p); }
    grid.sync();
#pragma unroll 1
    for (int l = 0; l < 2; ++l) {
        { const Params p = fresh_params(); phase_weights(p, l, lds); __syncthreads(); phase_filter_gen(p, l, lds); }
        xcd_barrier(xbar, xx, xst);
        {
            const Params p = fresh_params();
            phase_filter_fft(p, l, lds);
            const bf16_t* WtKV = (const bf16_t*)(p.ws + OFF_WTKV); const bf16_t* membf = (const bf16_t*)(p.ws + OFF_MEMBF);
            for (int t = bid; t < 64; t += G) {
                f32x4 acc[4][4];
                if (t < 32) {
                    const int m0 = (t >> 2) * 256, n0 = (t & 3) * 128;
                    gemm_core(acc, membf + (size_t)m0 * 1024, 1024, WtKV + (size_t)n0 * 1024, 1024, 1024, lds);
                    bf16_t* Km = (bf16_t*)(p.ws + OFF_KMAT);
                    EPI_LOOP(st_bf4(Km + (size_t)row * 512 + col, v);)
                } else {
                    const int t2 = t - 32, m0 = (t2 >> 4) * 256, n0 = (t2 & 15) * 128;
                    gemm_core(acc, WtKV + (size_t)(512 + m0) * 1024, 1024, membf + (size_t)n0 * 1024, 1024, 1024, lds);
                    bf16_t* Vm = (bf16_t*)(p.ws + OFF_VT);
                    EPI_LOOP(st_bf4(Vm + (size_t)row * 2048 + col, v);)
                }
            }
        }
        xcd_barrier(xbar, xx, xst);
#pragma unroll 1
        for (int g = 0; g < NGRP; ++g) {
            const size_t tok0 = (size_t)g * TG;
#pragma unroll 1
            for (int rep = 0; rep < PROBE_REP_INPROJ; ++rep) {
                const Params p = fresh_params();
                pg8::Gemm gm; gm.A = (const bf16_t*)(p.ws + OFF_HB) + tok0 * 1024; gm.Bt = (const bf16_t*)(p.ws + OFF_WTIN); gm.M = TG; gm.N = NINP; gm.K = 1024;
                pg8::StaticOrder S; S.init(TG, NINP, G, bid);
                EpiInProj E; E.P = (bf16_t*)(p.ws + OFF_P); E.bias = p.b_in + (size_t)l * NIN; E.LR = (float*)(p.ws + OFF_LR);
                pg8::gemm_phase<EpiInProj, pg8::StaticOrder, false>((PG8_LAS unsigned char*)lds, gm, S, E, nullptr);
                __syncthreads();
            }
            xcd_barrier(xbar, xx, xst);
#pragma unroll 1
            for (int rep = 0; rep < PROBE_REP_MIX; ++rep) {
            int dry = (rep + 1 < PROBE_REP_MIX) ? 1 : 0; asm volatile("" : "+s"(dry));
            {
                const Params p = fresh_params();
                bf16_t* P = (bf16_t*)(p.ws + OFF_P);
                for (int it = bid; it < BG * 64 * 8; it += G) na_item(p, l, P, it >> 9, (it >> 3) & 63, it & 7, lds, dry);
            }
            {
                const Params p = fresh_params();
                bf16_t* P = (bf16_t*)(p.ws + OFF_P);
                for (int it = bid; it < BG * 128 * 8; it += G) hy_pre_item(p, l, P, (float*)(p.ws + OFF_UT), (bf16_t*)(p.ws + OFF_GT), it >> 10, (it >> 3) & 127, it & 7, lds);
            }
            {
                const Params p = fresh_params();
                for (int it = bid; it < NITEM; it += G) gla_part1_item(p, l, (const bf16_t*)(p.ws + OFF_P), (const float*)(p.ws + OFF_LR), it, lds);
            }
            {
                const Params p = fresh_params();
                bf16_t* P = (bf16_t*)(p.ws + OFF_P);
                const int nit = BG * 4 * 64, per = (nit + G - 1) / G;
                int last = -1;
                for (int it = bid * per; it < min(nit, (bid + 1) * per); ++it) {
                    const int bh = it >> 6, bl = bh >> 2, h = bh & 3;
                    if (bh != last) { __syncthreads(); memattn_load(p, g * BG + bl, h, lds); last = bh; }
                    memattn_item(P, bl, h, it & 63, lds, dry);
                }
                __syncthreads();
            }
            xcd_barrier(xbar, xx, xst);
            {
                const Params p = fresh_params();
                const float2* twl = fft_lds_twiddles((const float2*)(p.ws + OFF_TW), lds);
                for (int it = bid; it < BG * 256; it += G) hyena_conv_item(p, (const float*)(p.ws + OFF_UT), (bf16_t*)(p.ws + OFF_GT), it >> 8, it & 255, lds, twl, dry);
                __syncthreads();
                gla_scan(p, dry);
            }
            xcd_barrier(xbar, xx, xst);
            {
                const Params p = fresh_params();
                for (int it = bid; it < NITEM; it += G) gla_part2_item(p, l, (bf16_t*)(p.ws + OFF_P), (const float*)(p.ws + OFF_LR), it, lds, dry);
            }
            {
                const Params p = fresh_params();
                for (int it = bid; it < BG * 128 * 8; it += G) hy_post_item((bf16_t*)(p.ws + OFF_P), (const bf16_t*)(p.ws + OFF_GT), it >> 10, (it >> 3) & 127, it & 7, lds, dry);
            }
            xcd_barrier(xbar, xx, xst);
            }
            {
                const Params p = fresh_params();
                const bf16_t* P = (const bf16_t*)(p.ws + OFF_P); const bf16_t* WtBr = (const bf16_t*)(p.ws + OFF_WTBR); bf16_t* merged = (bf16_t*)(p.ws + OFF_MERGED);
                for (int t = bid; t < 512; t += G) {
                    const int sr = t >> 8, sb = t & 255, sx = sb & 7, sk = sb >> 3;
                    const int m0 = (sr * 32 + (sk >> 3) * 8 + sx) * 256, n0 = (sk & 7) * 128;
                    f32x4 macc[4][4];
#pragma unroll
                    for (int mi = 0; mi < 4; ++mi)
#pragma unroll
                        for (int ni = 0; ni < 4; ++ni) macc[mi][ni] = (f32x4){0.f, 0.f, 0.f, 0.f};
#pragma unroll 1
                    for (int j = 0; j < 4; ++j) {
                        const int acol = (j == 0) ? C_NAQ : (j == 1) ? C_HY : (j == 2) ? C_GV : C_MQ;
                        f32x4 acc[4][4];
                        gemm_core(acc, P + (size_t)m0 * PS + acol, PS, WtBr + (size_t)j * 1024 * 512 + (size_t)n0 * 512, 512, 512, lds);
                        EPI_LOOP(macc[mi][ni] += ld_bf4(P + (size_t)row * PS + C_SG + 1024 * j + col) * v;)
                    }
                    {
                        f32x4 (&acc)[4][4] = macc;
                        EPI_LOOP(st_bf4(merged + (size_t)row * 1024 + col, v);)
                    }
                }
            }
            xcd_barrier(xbar, xx, xst);
            {
                const Params p = fresh_params();
                pg8::Gemm gm; gm.A = (const bf16_t*)(p.ws + OFF_MERGED); gm.Bt = (const bf16_t*)(p.ws + OFF_WTOUT); gm.M = TG; gm.N = 1024; gm.K = 1024;
                pg8::StaticOrder S; S.init(TG, 1024, G, bid);
                EpiOut E; E.pre = (float*)(p.ws + OFF_PRE); E.bo = p.b_out + l * 1024; E.x = p.x; E.stats = (const float2*)(p.ws + OFF_STATS); E.g0 = p.ln_in_g; E.b0 = p.ln_in_b; E.hres = p.out; E.tok0 = tok0; E.l = l;
                pg8::gemm_phase<EpiOut, pg8::StaticOrder, false>((PG8_LAS unsigned char*)lds, gm, S, E, nullptr);
                __syncthreads();
            }
            xcd_barrier(xbar, xx, xst);
            {
                const Params p = fresh_params();
                ln_rows((const float*)(p.ws + OFF_PRE), 0, TG, p.ln_g + l * 1024, p.ln_b + l * 1024, p.out, (bf16_t*)(p.ws + OFF_HB), tok0, nullptr);
            }
        }
        xcd_barrier(xbar, xx, xst);
    }
}

extern "C" void kernel_launch(void* const* d_in, const int* in_sizes, int n_in, void* d_out, int out_size, void* d_ws, size_t ws_size, hipStream_t stream) {
    static int grid_blocks = 0;
    if (!grid_blocks) {
        if (ws_size < WS_END) { fprintf(stderr, "kernel_launch: workspace too small: %zu < %zu\n", ws_size, (size_t)WS_END); grid_blocks = -1; return; }
        {
            const long long ex[26] = {67108864LL, 2097152LL, 1024, 1024, 2LL * 1024 * 10784, 2 * 10784, 2 * 8 * 15 * 31, 2 * 3 * 1536, 2 * 1536, 2 * 33 * 64, 2 * 64, 2 * 2 * 64 * 64, 2 * 2 * 64,
                                      2 * 64 * 1024, 2 * 512, 2 * 16 * 256, 2 * 256, 2 * 16 * 256, 2 * 256, 2 * 512, 2LL * 1024 * 1024, 2LL * 4 * 512 * 1024, 2LL * 1024 * 1024, 2 * 1024, 2 * 1024, 2 * 1024};
            bool bad = (n_in != 26) || (out_size != 67108864);
            for (int i = 0; i < 26 && !bad; ++i) if ((long long)in_sizes[i] != ex[i]) { fprintf(stderr, "kernel_launch: input %d has %d elements, expected %lld\n", i, in_sizes[i], ex[i]); bad = true; }
            if (bad) { fprintf(stderr, "kernel_launch: unexpected shapes; nothing launched\n"); grid_blocks = -1; return; }
        }
        int dev = 0, cus = 0, per_cu = 0;
        hipGetDevice(&dev);
        hipDeviceGetAttribute(&cus, hipDeviceAttributeMultiprocessorCount, dev);
        if (hipFuncSetAttribute((const void*)mega, hipFuncAttributeMaxDynamicSharedMemorySize, LDS_BYTES) != hipSuccess) fprintf(stderr, "kernel_launch: hipFuncSetAttribute failed\n");
        if (hipOccupancyMaxActiveBlocksPerMultiprocessor(&per_cu, (const void*)mega, NTHR, LDS_BYTES) != hipSuccess || per_cu < 1) { fprintf(stderr, "kernel_launch: occupancy query gave %d\n", per_cu); per_cu = 1; }
        (void)hipGetLastError();
        if (per_cu > 1) per_cu = 1;
        grid_blocks = cus * per_cu;
    }
    if (grid_blocks < 0) return;
    Params p{};
    const float** pp = (const float**)&p;
    for (int i = 0; i < 26; ++i) pp[i] = (const float*)d_in[i];
    p.out = (float*)d_out; p.ws = (unsigned char*)d_ws;
    if (hipMemsetAsync((unsigned char*)d_ws + OFF_BAR, 0, 16384, stream) != hipSuccess) fprintf(stderr, "kernel_launch: memset of the barrier word failed\n");
    void* args[] = {&p};
    hipError_t e = hipLaunchCooperativeKernel((const void*)mega, dim3(grid_blocks), dim3(NTHR), args, LDS_BYTES, stream);
    if (e != hipSuccess) fprintf(stderr, "cooperative launch failed: %s (grid %d)\n", hipGetErrorString(e), grid_blocks);
}
#endif
```

```cpp
#ifndef PROBE_REP_MIX
#define PROBE_REP_MIX 1
#endif
#ifndef PROBE_REP_INPROJ
#define PROBE_REP_INPROJ 1
#endif
#include <hip/hip_runtime.h>
#include <hip/hip_cooperative_groups.h>
#include <cstdio>
#include <unistd.h>
#include <cmath>
namespace cg = cooperative_groups;

#define HD __host__ __device__
typedef unsigned short bf16_t;
typedef short bf16x8 __attribute__((ext_vector_type(8)));
typedef float f32x4 __attribute__((ext_vector_type(4)));
typedef unsigned u32x2 __attribute__((ext_vector_type(2)));
typedef unsigned u32x4 __attribute__((ext_vector_type(4)));

constexpr int NTOK = 65536, DM = 1024, SEQ = 8192, NB = 8;
constexpr int BG = 2;
constexpr int NGRP = NB / BG;
constexpr int TG = BG * SEQ;
constexpr int PS = 10752;
constexpr int NIN = 10784, NINP = 11008;
constexpr int C_NAQ = 0, C_NAK = 512, C_NAV = 1024, C_HY = 1536, C_GQ = 3072, C_GK = 3328, C_GV = 3584, C_MQ = 4096, C_Z = 4608, C_SG = 6656, C_LR = 10752;
constexpr int FN = 16384;
constexpr int NITEM = BG * 128 * 4;
constexpr int LDS_BYTES = 160 * 1024;
constexpr int NTHR = 512;
constexpr float DN_ALPHA = 1.41421356237309515f;

constexpr size_t al256(size_t x) { return (x + 255) & ~(size_t)255; }
constexpr size_t OFF_HB = 0;
constexpr size_t OFF_STATS = OFF_HB + (size_t)NTOK * DM * 2;
constexpr size_t OFF_TW = OFF_STATS + (size_t)NTOK * 8;
constexpr size_t OFF_MEMBF = OFF_TW + (size_t)FN * 8;
constexpr size_t OFF_ENERGY = OFF_MEMBF + (size_t)2048 * 1024 * 2;
constexpr size_t OFF_WTIN = OFF_ENERGY + 4096;
constexpr size_t OFF_WTBR = OFF_WTIN + (size_t)NINP * 1024 * 2;
constexpr size_t OFF_WTOUT = OFF_WTBR + (size_t)4 * 1024 * 512 * 2;
constexpr size_t OFF_WTKV = OFF_WTOUT + (size_t)1024 * 1024 * 2;
constexpr size_t OFF_KMAT = OFF_WTKV + (size_t)2048 * 1024 * 2;
constexpr size_t OFF_VT = OFF_KMAT + (size_t)2048 * 1024 * 2;
constexpr size_t OFF_HFILT = OFF_VT + (size_t)2048 * 1024 * 2;
constexpr size_t OFF_PQ = OFF_HFILT + (size_t)1024 * 8192 * 4;
constexpr size_t OFF_P = OFF_PQ + (size_t)256 * FN * 16;
constexpr size_t OFF_LR = OFF_P + (size_t)TG * PS * 2;
constexpr size_t OFF_GS = OFF_LR + (size_t)TG * 32 * 4;
constexpr size_t OFF_GDEC = OFF_GS + (size_t)2 * NITEM * 8192 * 4;
constexpr size_t OFF_MERGED = OFF_GDEC + (size_t)2 * NITEM * 64 * 4;
constexpr size_t OFF_PRE = OFF_MERGED + (size_t)TG * 1024 * 2;
constexpr size_t OFF_UT = OFF_PRE + (size_t)TG * 1024 * 4;
constexpr size_t OFF_GT = OFF_UT + (size_t)BG * 512 * 8192 * 4;
constexpr size_t OFF_BAR = OFF_GT + (size_t)BG * 512 * 8192 * 2;
constexpr size_t OFF_ZT = OFF_BAR + 16384;
constexpr size_t WS_END = OFF_ZT + (size_t)8192 * 33 * 4;

struct Params {
    const float *x, *mem, *ln_in_g, *ln_in_b, *w_in, *b_in, *na_rpb, *hy_conv_w, *hy_conv_b, *hy_w1, *hy_b1, *hy_wm, *hy_bm, *hy_w3, *hy_skip,
        *gla_up_f, *gla_bias_f, *gla_up_b, *gla_bias_b, *gla_norm_g, *mem_w_kv, *w_br, *w_out, *b_out, *ln_g, *ln_b;
    float* out;
    unsigned char* ws;
};

HD inline float bf2f(bf16_t b) {
    union { unsigned u; float f; } c; c.u = (unsigned)b << 16; return c.f;
}
HD inline bf16_t f2bf(float f) {
    union { unsigned u; float f; } c; c.f = f; unsigned u = c.u; u += 0x7fffu + ((u >> 16) & 1u); return (bf16_t)(u >> 16);
}
__device__ __forceinline__ unsigned pk2(float lo, float hi) { return (unsigned)f2bf(lo) | ((unsigned)f2bf(hi) << 16); }
__device__ __forceinline__ float lo16(unsigned u) { return __uint_as_float(u << 16); }
__device__ __forceinline__ float hi16(unsigned u) { return __uint_as_float(u & 0xffff0000u); }
__device__ __forceinline__ float wave_sum(float v) {
#pragma unroll
    for (int o = 32; o >= 1; o >>= 1) v += __shfl_xor(v, o);
    return v;
}
__device__ __forceinline__ float sigmoidf_(float x) { return __builtin_amdgcn_rcpf(1.0f + __expf(-x)); }
__device__ __forceinline__ float siluf_(float x) { return x * __builtin_amdgcn_rcpf(1.0f + __expf(-x)); }
__device__ __forceinline__ float logsigf_(float x) { return fminf(x, 0.0f) - log1pf(expf(-fabsf(x))); }
__device__ __forceinline__ bf16x8 mkfrag(u32x4 v) { return __builtin_bit_cast(bf16x8, v); }
__device__ __forceinline__ bf16x8 mkfrag2(u32x2 a, u32x2 b) { u32x4 v = {a.x, a.y, b.x, b.y}; return __builtin_bit_cast(bf16x8, v); }
#define MFMA(a, b, c) __builtin_amdgcn_mfma_f32_16x16x32_bf16((a), (b), (c), 0, 0, 0)
HD inline int iclamp(int v, int lo, int hi) { return v < lo ? lo : (v > hi ? hi : v); }

HD inline float2 cmulf(float2 a, float2 b) { float2 r; r.x = a.x * b.x - a.y * b.y; r.y = a.x * b.y + a.y * b.x; return r; }
HD inline float2 cmulcf(float2 a, float2 b) { float2 r; r.x = a.x * b.x + a.y * b.y; r.y = a.y * b.x - a.x * b.y; return r; }
struct Bfly { float2 x0, x1, x2, x3, W1; int i0; };
HD inline void bfly_load(Bfly& b, const float2* d, const float2* tw, int lgm, int q) {
    const int m = 1 << lgm, blk = q >> lgm, j = q & (m - 1);
    b.i0 = (blk << (lgm + 2)) + j;
    b.W1 = tw[j];
    b.x0 = d[b.i0]; b.x1 = d[b.i0 + m]; b.x2 = d[b.i0 + 2 * m]; b.x3 = d[b.i0 + 3 * m];
}
HD inline void bfly_fwd_store(const Bfly& b, float2* d, int lgm) {
    const int m = 1 << lgm, i0 = b.i0;
    const float2 W1 = b.W1, W2 = cmulf(W1, W1);
    const float2 x0 = b.x0, x1 = b.x1, x2 = b.x2, x3 = b.x3;
    float2 a0, a1, a2, a3, t;
    a0.x = x0.x + x2.x; a0.y = x0.y + x2.y;
    t.x = x0.x - x2.x; t.y = x0.y - x2.y; a2 = cmulf(t, W1);
    a1.x = x1.x + x3.x; a1.y = x1.y + x3.y;
    t.x = x1.x - x3.x; t.y = x1.y - x3.y; t = cmulf(t, W1); a3.x = t.y; a3.y = -t.x;
    float2 r;
    r.x = a0.x + a1.x; r.y = a0.y + a1.y; d[i0] = r;
    t.x = a0.x - a1.x; t.y = a0.y - a1.y; d[i0 + m] = cmulf(t, W2);
    r.x = a2.x + a3.x; r.y = a2.y + a3.y; d[i0 + 2 * m] = r;
    t.x = a2.x - a3.x; t.y = a2.y - a3.y; d[i0 + 3 * m] = cmulf(t, W2);
}
HD inline void bfly_inv_store(const Bfly& b, float2* d, int lgm) {
    const int m = 1 << lgm, i0 = b.i0;
    const float2 W1 = b.W1, W2 = cmulf(W1, W1);
    const float2 x0 = b.x0, x1 = b.x1, x2 = b.x2, x3 = b.x3;
    const float2 b1 = cmulcf(x1, W2), b3 = cmulcf(x3, W2);
    float2 y0, y1, y2, y3;
    y0.x = x0.x + b1.x; y0.y = x0.y + b1.y; y1.x = x0.x - b1.x; y1.y = x0.y - b1.y;
    y2.x = x2.x + b3.x; y2.y = x2.y + b3.y; y3.x = x2.x - b3.x; y3.y = x2.y - b3.y;
    const float2 c2 = cmulcf(y2, W1); float2 c3 = cmulcf(y3, W1); { const float tx = -c3.y, ty = c3.x; c3.x = tx; c3.y = ty; }
    float2 r;
    r.x = y0.x + c2.x; r.y = y0.y + c2.y; d[i0] = r;
    r.x = y0.x - c2.x; r.y = y0.y - c2.y; d[i0 + 2 * m] = r;
    r.x = y1.x + c3.x; r.y = y1.y + c3.y; d[i0 + m] = r;
    r.x = y1.x - c3.x; r.y = y1.y - c3.y; d[i0 + 3 * m] = r;
}
HD inline void fft_fwd_bfly(float2* d, const float2* tw, int lgm, int q) { Bfly b; bfly_load(b, d, tw, lgm, q); bfly_fwd_store(b, d, lgm); }
HD inline void fft_inv_bfly(float2* d, const float2* tw, int lgm, int q) { Bfly b; bfly_load(b, d, tw, lgm, q); bfly_inv_store(b, d, lgm); }
HD inline int brev14(int k) {
    unsigned v = (unsigned)k;
    v = ((v >> 1) & 0x55555555u) | ((v & 0x55555555u) << 1);
    v = ((v >> 2) & 0x33333333u) | ((v & 0x33333333u) << 2);
    v = ((v >> 4) & 0x0f0f0f0fu) | ((v & 0x0f0f0f0fu) << 4);
    v = ((v >> 8) & 0x00ff00ffu) | ((v & 0x00ff00ffu) << 8);
    v = (v >> 16) | (v << 16);
    return (int)(v >> 18);
}
struct PwIn { float2 Z1, Z2; float4 A, B; int p1, p2; };
HD inline void pw_load(PwIn& w, const float2* d, const float4* pq, int kf) {
    const int k2 = (FN - kf) & (FN - 1); w.p1 = brev14(kf); w.p2 = brev14(k2);
    w.Z1 = d[w.p1]; w.Z2 = d[w.p2]; w.A = pq[w.p1]; w.B = pq[w.p2];
}
HD inline void pw_store(const PwIn& w, float2* d) {
    const float2 Z1 = w.Z1, Z2 = w.Z2;
    float2 P1, Q1, P2, Q2; P1.x = w.A.x; P1.y = w.A.y; Q1.x = w.A.z; Q1.y = w.A.w; P2.x = w.B.x; P2.y = w.B.y; Q2.x = w.B.z; Q2.y = w.B.w;
    float2 c1, c2; c1.x = Z1.x; c1.y = -Z1.y; c2.x = Z2.x; c2.y = -Z2.y;
    const float2 a = cmulf(Z1, P1), b = cmulf(c2, Q1), c = cmulf(Z2, P2), e = cmulf(c1, Q2);
    float2 w1, w2; w1.x = a.x + b.x; w1.y = a.y + b.y; w2.x = c.x + e.x; w2.y = c.y + e.y;
    d[w.p1] = w1;
    if (w.p2 != w.p1) d[w.p2] = w2;
}
HD inline void conv_pointwise(float2* d, const float4* pq, int kf) { PwIn w; pw_load(w, d, pq, kf); pw_store(w, d); }
HD inline void filt_pointwise(const float2* d, float4* pq, int kf) {
    const int k2 = (FN - kf) & (FN - 1), p1 = brev14(kf), p2 = brev14(k2);
    const float2 Z1 = d[p1], Z2 = d[p2];
    const float gcx = 0.5f * (Z1.x + Z2.x), gcy = 0.5f * (Z1.y - Z2.y);
    const float gdx = 0.5f * (Z1.y + Z2.y), gdy = -0.5f * (Z1.x - Z2.x);
    const float s = 0.5f / (float)FN;
    float4 A; A.x = s * (gcx + gdx); A.y = s * (gcy + gdy); A.z = s * (gcx - gdx); A.w = s * (gcy - gdy);
    pq[p1] = A;
    float4 B; B.x = A.x; B.y = -A.y; B.z = A.z; B.w = -A.w;
    if (p2 != p1) pq[p2] = B;
}

HD inline int tw_off(int lgm) { return lgm == 10 ? 0 : lgm == 8 ? 1024 : lgm == 6 ? 1280 : lgm == 4 ? 1344 : lgm == 2 ? 1360 : 1364; }
#ifndef FFT_HOST_TEST
template <int LGM, bool INV>
__device__ __forceinline__ void fft_pass(float2* d, const float2* twl, const float2* twg, int tid) {
    const float2* tw = (LGM == 12) ? twg : twl + tw_off(LGM);
#pragma unroll
    for (int it = 0; it < 2; ++it) {
        const int q = tid + it * 4 * NTHR;
        Bfly b0, b1, b2, b3;
        bfly_load(b0, d, tw, LGM, q); bfly_load(b1, d, tw, LGM, q + NTHR); bfly_load(b2, d, tw, LGM, q + 2 * NTHR); bfly_load(b3, d, tw, LGM, q + 3 * NTHR);
        if (INV) { bfly_inv_store(b0, d, LGM); bfly_inv_store(b1, d, LGM); bfly_inv_store(b2, d, LGM); bfly_inv_store(b3, d, LGM); }
        else { bfly_fwd_store(b0, d, LGM); bfly_fwd_store(b1, d, LGM); bfly_fwd_store(b2, d, LGM); bfly_fwd_store(b3, d, LGM); }
    }
    __syncthreads();
}
__device__ __forceinline__ void fft_forward(float2* d, const float2* twl, const float2* twg) {
    int tid = threadIdx.x; asm volatile("" : "+v"(tid));
    fft_pass<12, false>(d, twl, twg, tid); fft_pass<10, false>(d, twl, twg, tid); fft_pass<8, false>(d, twl, twg, tid); fft_pass<6, false>(d, twl, twg, tid);
    fft_pass<4, false>(d, twl, twg, tid); fft_pass<2, false>(d, twl, twg, tid); fft_pass<0, false>(d, twl, twg, tid);
}
__device__ __forceinline__ void fft_inverse(float2* d, const float2* twl, const float2* twg) {
    int tid = threadIdx.x; asm volatile("" : "+v"(tid));
    fft_pass<0, true>(d, twl, twg, tid); fft_pass<2, true>(d, twl, twg, tid); fft_pass<4, true>(d, twl, twg, tid); fft_pass<6, true>(d, twl, twg, tid);
    fft_pass<8, true>(d, twl, twg, tid); fft_pass<10, true>(d, twl, twg, tid); fft_pass<12, true>(d, twl, twg, tid);
}
__device__ __forceinline__ float2* fft_lds_twiddles(const float2* twg, unsigned char* lds) {
    int tid = threadIdx.x; asm volatile("" : "+v"(tid));
    float2* t = (float2*)(lds + 131072);
    for (int k = tid; k < 1365; k += NTHR) {
        const int lgm = k < 1024 ? 10 : k < 1280 ? 8 : k < 1344 ? 6 : k < 1360 ? 4 : k < 1364 ? 2 : 0;
        t[k] = twg[(k - tw_off(lgm)) << (12 - lgm)];
    }
    __syncthreads();
    return t;
}

constexpr int STG = 49152;
__device__ __forceinline__ int swz(int row, int ch) { return row * 128 + ((ch ^ ((row >> 1) & 7)) << 4); }
__device__ __forceinline__ void gemm_core(f32x4 (&acc)[4][4], const bf16_t* A, int lda, const bf16_t* Bt, int ldb, int K, unsigned char* lds) {
    int tid_ = threadIdx.x; asm volatile("" : "+v"(tid_)); const int tid = tid_, lane = tid & 63, w = tid >> 6, wm = w & 3, wn = w >> 2, l15 = lane & 15, q4 = lane >> 4;
    const int wu = __builtin_amdgcn_readfirstlane(w);
    __attribute__((address_space(3))) unsigned char* l3 = (__attribute__((address_space(3))) unsigned char*)lds;
#pragma unroll
    for (int mi = 0; mi < 4; ++mi)
#pragma unroll
        for (int ni = 0; ni < 4; ++ni) acc[mi][ni] = (f32x4){0.f, 0.f, 0.f, 0.f};
    const int r8 = lane >> 3, sch = (lane & 7) ^ ((((w & 1) << 2) + (r8 >> 1)) & 7);
    const bf16_t* ap = A + (size_t)(w * 8 + r8) * lda + sch * 8;
    const bf16_t* bp = Bt + (size_t)(w * 8 + r8) * ldb + sch * 8;
#define GC_STAGE(buf, k0)                                                                                                                         \
    {                                                                                                                                             \
        _Pragma("unroll") for (int i = 0; i < 4; ++i)                                                                                             \
            __builtin_amdgcn_global_load_lds((const unsigned*)(ap + (size_t)(64 * i) * lda + (k0)), (__attribute__((address_space(3))) unsigned*)(l3 + (buf) * STG + (wu + 8 * i) * 1024), 16, 0, 0);          \
        _Pragma("unroll") for (int i = 0; i < 2; ++i)                                                                                             \
            __builtin_amdgcn_global_load_lds((const unsigned*)(bp + (size_t)(64 * i) * ldb + (k0)), (__attribute__((address_space(3))) unsigned*)(l3 + (buf) * STG + 32768 + (wu + 8 * i) * 1024), 16, 0, 0);  \
    }
    GC_STAGE(0, 0)
    asm volatile("s_waitcnt vmcnt(0)" ::: "memory");
    __syncthreads();
    const int nk = K >> 6;
    for (int kt = 0; kt < nk; ++kt) {
        if (kt + 1 < nk) GC_STAGE((kt + 1) & 1, (kt + 1) << 6)
        const unsigned char* sa = lds + (kt & 1) * STG;
        const unsigned char* sb = sa + 32768;
#pragma unroll
        for (int ks = 0; ks < 2; ++ks) {
            bf16x8 af[4], bfr[4];
#pragma unroll
            for (int mi = 0; mi < 4; ++mi) af[mi] = *(const bf16x8*)(sa + swz(wm * 64 + mi * 16 + l15, ks * 4 + q4));
#pragma unroll
            for (int ni = 0; ni < 4; ++ni) bfr[ni] = *(const bf16x8*)(sb + swz(wn * 64 + ni * 16 + l15, ks * 4 + q4));
#pragma unroll
            for (int mi = 0; mi < 4; ++mi)
#pragma unroll
                for (int ni = 0; ni < 4; ++ni) acc[mi][ni] = MFMA(bfr[ni], af[mi], acc[mi][ni]);
        }
        asm volatile("s_waitcnt vmcnt(0)" ::: "memory");
        __syncthreads();
    }
#undef GC_STAGE
}
#define EPI_LOOP(body)                                                                                                  \
    {                                                                                                                   \
        int e_t = threadIdx.x; asm volatile("" : "+v"(e_t)); const int e_lane = e_t & 63, e_w = e_t >> 6;                                                    \
        _Pragma("unroll") for (int mi = 0; mi < 4; ++mi) _Pragma("unroll") for (int ni = 0; ni < 4; ++ni) {             \
            const int row = m0 + (e_w & 3) * 64 + mi * 16 + (e_lane & 15);                                              \
            const int col = n0 + (e_w >> 2) * 64 + ni * 16 + 4 * (e_lane >> 4);                                         \
            f32x4& v = acc[mi][ni];                                                                                     \
            body                                                                                                        \
        }                                                                                                               \
    }
__device__ __forceinline__ void st_bf4(bf16_t* dst, f32x4 v) {
    u32x2 o; o.x = pk2(v[0], v[1]); o.y = pk2(v[2], v[3]); *(u32x2*)dst = o;
}
__device__ __forceinline__ f32x4 ld_bf4(const bf16_t* src) {
    const u32x2 u = *(const u32x2*)src; f32x4 r = {lo16(u.x), hi16(u.x), lo16(u.y), hi16(u.y)}; return r;
}


__device__ __forceinline__ void merge_tile(const bf16_t* P, const bf16_t* WtBr, bf16_t* merged, int m0, int n0, unsigned char* lds) {
    int tid_ = threadIdx.x; asm volatile("" : "+v"(tid_)); const int tid = tid_, lane = tid & 63, w = tid >> 6, wm = w & 3, wn = w >> 2, l15 = lane & 15, q4 = lane >> 4;
    const int wu = __builtin_amdgcn_readfirstlane(w);
    __attribute__((address_space(3))) unsigned char* l3 = (__attribute__((address_space(3))) unsigned char*)lds;
    f32x4 acc[4][4], macc[4][4];
#pragma unroll
    for (int mi = 0; mi < 4; ++mi)
#pragma unroll
        for (int ni = 0; ni < 4; ++ni) { acc[mi][ni] = (f32x4){0.f, 0.f, 0.f, 0.f}; macc[mi][ni] = (f32x4){0.f, 0.f, 0.f, 0.f}; }
    const int r8 = lane >> 3, sch = (lane & 7) ^ ((((w & 1) << 2) + (r8 >> 1)) & 7);
    const bf16_t* ap = P + (size_t)(m0 + w * 8 + r8) * PS + sch * 8;
    const bf16_t* bp = WtBr + (size_t)(n0 + w * 8 + r8) * 512 + sch * 8;
    const bf16_t* sgp = P + (size_t)(m0 + wm * 64 + l15) * PS + C_SG + n0 + wn * 64 + 4 * q4;
#define MG_STAGE(buf, kt_)                                                                                                                        \
    {                                                                                                                                             \
        const int j_ = (kt_) >> 3, k0_ = ((kt_) & 7) << 6;                                                                                        \
        const int acol_ = (j_ == 0) ? C_NAQ : (j_ == 1) ? C_HY : (j_ == 2) ? C_GV : C_MQ;                                                        \
        _Pragma("unroll") for (int i = 0; i < 4; ++i)                                                                                             \
            __builtin_amdgcn_global_load_lds((const unsigned*)(ap + (size_t)(64 * i) * PS + acol_ + k0_), (__attribute__((address_space(3))) unsigned*)(l3 + (buf) * STG + (wu + 8 * i) * 1024), 16, 0, 0);      \
        _Pragma("unroll") for (int i = 0; i < 2; ++i)                                                                                             \
            __builtin_amdgcn_global_load_lds((const unsigned*)(bp + (size_t)j_ * 1024 * 512 + (size_t)(64 * i) * 512 + k0_), (__attribute__((address_space(3))) unsigned*)(l3 + (buf) * STG + 32768 + (wu + 8 * i) * 1024), 16, 0, 0);  \
    }
    MG_STAGE(0, 0)
    asm volatile("s_waitcnt vmcnt(0)" ::: "memory");
    __syncthreads();
#pragma unroll 1
    for (int kt = 0; kt < 32; ++kt) {
        if (kt + 1 < 32) MG_STAGE((kt + 1) & 1, kt + 1)
        const bool last = (kt & 7) == 7;
        u32x2 sg[4][4];
        if (last) {
            const bf16_t* sp = sgp + 1024 * (kt >> 3);
#pragma unroll
            for (int mi = 0; mi < 4; ++mi)
#pragma unroll
                for (int ni = 0; ni < 4; ++ni) sg[mi][ni] = *(const u32x2*)(sp + (size_t)(mi * 16) * PS + ni * 16);
        }
        const unsigned char* sa = lds + (kt & 1) * STG;
        const unsigned char* sb = sa + 32768;
#pragma unroll
        for (int ks = 0; ks < 2; ++ks) {
            bf16x8 af[4], bfr[4];
#pragma unroll
            for (int mi = 0; mi < 4; ++mi) af[mi] = *(const bf16x8*)(sa + swz(wm * 64 + mi * 16 + l15, ks * 4 + q4));
#pragma unroll
            for (int ni = 0; ni < 4; ++ni) bfr[ni] = *(const bf16x8*)(sb + swz(wn * 64 + ni * 16 + l15, ks * 4 + q4));
#pragma unroll
            for (int mi = 0; mi < 4; ++mi)
#pragma unroll
                for (int ni = 0; ni < 4; ++ni) acc[mi][ni] = MFMA(bfr[ni], af[mi], acc[mi][ni]);
        }
        asm volatile("s_waitcnt vmcnt(0)" ::: "memory");
        if (last) {
#pragma unroll
            for (int mi = 0; mi < 4; ++mi)
#pragma unroll
                for (int ni = 0; ni < 4; ++ni) {
                    const u32x2 u = sg[mi][ni]; const f32x4 g4 = {lo16(u.x), hi16(u.x), lo16(u.y), hi16(u.y)};
                    macc[mi][ni] += g4 * acc[mi][ni]; acc[mi][ni] = (f32x4){0.f, 0.f, 0.f, 0.f};
                }
        }
        __syncthreads();
    }
#undef MG_STAGE
#pragma unroll
    for (int mi = 0; mi < 4; ++mi)
#pragma unroll
        for (int ni = 0; ni < 4; ++ni) st_bf4(merged + (size_t)(m0 + wm * 64 + mi * 16 + l15) * 1024 + n0 + wn * 64 + ni * 16 + 4 * q4, macc[mi][ni]);
}

__device__ __forceinline__ int orig_col(int n) {
    if (n < 4096) return n;
    if (n < 4608) return n + 32;
    if (n < 6656) return n + 32;
    if (n < 10752) return n + 32;
    return n - 10752 + 4096;
}

__device__ __forceinline__ void ln_rows(const float* src, size_t src_row0, int nrows, const float* g, const float* b, float* dst32, bf16_t* dst16, size_t dst_row0, float2* stats) {
    int tid_ = threadIdx.x; asm volatile("" : "+v"(tid_));
    const int lane = tid_ & 63;
    const int gw = blockIdx.x * (NTHR / 64) + (tid_ >> 6), nw = gridDim.x * (NTHR / 64);
    for (int r = gw; r < nrows; r += nw) {
        const float4* xr = (const float4*)(src + (src_row0 + r) * 1024);
        float4 v[4]; float s = 0.f;
#pragma unroll
        for (int i = 0; i < 4; ++i) { v[i] = xr[lane + 64 * i]; s += (v[i].x + v[i].y) + (v[i].z + v[i].w); }
        s = wave_sum(s);
        const float mean = s * (1.0f / 1024.0f);
        float q = 0.f;
#pragma unroll
        for (int i = 0; i < 4; ++i) { const float a = v[i].x - mean, bb = v[i].y - mean, c = v[i].z - mean, d = v[i].w - mean; q += (a * a + bb * bb) + (c * c + d * d); }
        q = wave_sum(q);
        const float rstd = 1.0f / sqrtf(q * (1.0f / 1024.0f) + 1e-5f);
        if (stats && lane == 0) { float2 st; st.x = mean; st.y = rstd; stats[dst_row0 + r] = st; }
#pragma unroll
        for (int i = 0; i < 4; ++i) {
            const float4 g4 = ((const float4*)g)[lane + 64 * i], b4 = ((const float4*)b)[lane + 64 * i];
            float4 y; y.x = (v[i].x - mean) * rstd * g4.x + b4.x; y.y = (v[i].y - mean) * rstd * g4.y + b4.y; y.z = (v[i].z - mean) * rstd * g4.z + b4.z; y.w = (v[i].w - mean) * rstd * g4.w + b4.w;
            if (dst32) ((float4*)(dst32 + (dst_row0 + r) * 1024))[lane + 64 * i] = y;
            if (dst16) { u32x2 o; o.x = pk2(y.x, y.y); o.y = pk2(y.z, y.w); *(u32x2*)(dst16 + (dst_row0 + r) * 1024 + (lane + 64 * i) * 4) = o; }
        }
    }
}
__device__ __forceinline__ void phase0(const Params& p) {
    ln_rows(p.x, 0, NTOK, p.ln_in_g, p.ln_in_b, nullptr, (bf16_t*)(p.ws + OFF_HB), 0, (float2*)(p.ws + OFF_STATS));
    int tid_ = threadIdx.x; asm volatile("" : "+v"(tid_)); const int gt = blockIdx.x * NTHR + tid_, nt = gridDim.x * NTHR;
    float2* tw = (float2*)(p.ws + OFF_TW);
    for (int k = gt; k < FN; k += nt) { double s, c; sincospi(-2.0 * (double)k / (double)FN, &s, &c); float2 t; t.x = (float)c; t.y = (float)s; tw[k] = t; }
    bf16_t* mb = (bf16_t*)(p.ws + OFF_MEMBF);
    for (int i = gt; i < 2048 * 1024 / 4; i += nt) { const float4 v = ((const float4*)p.mem)[i]; u32x2 o; o.x = pk2(v.x, v.y); o.y = pk2(v.z, v.w); ((u32x2*)mb)[i] = o; }
    float* en = (float*)(p.ws + OFF_ENERGY);
    for (int i = gt; i < 1024; i += nt) en[i] = 0.f;
    float* ztab = (float*)(p.ws + OFF_ZT);
    for (int idx = gt; idx < 8192 * 33; idx += nt) {
        const int n = idx / 33, e = idx - n * 33;
        float v;
        if (e == 0) v = (float)n / 8191.0f;
        else {
            const int i = (e - 1) & 15;
            const double fr = 1e-4 + (double)i * ((15.0 - 1e-4) / 15.0);
            const double ang = (2.0 * 3.14159265358979323846 / 8192.0) * (double)n * fr;
            v = (e <= 16) ? (float)cos(ang) : (float)(-sin(ang));
        }
        ztab[idx] = v;
    }
}

__device__ __forceinline__ void wt_tile(const float* src, int src_ld, int k0, int on0, bf16_t* dst, int dst_ld, int dn0, bool zero, float* tile) {
    int tid_ = threadIdx.x; asm volatile("" : "+v"(tid_)); const int tid = tid_;
    if (!zero) {
#pragma unroll
        for (int i = 0; i < 2; ++i) {
            const int k = (tid >> 3) + 64 * i, c4 = (tid & 7) * 4;
            const float4 v = *(const float4*)(src + (size_t)(k0 + k) * src_ld + on0 + c4);
            float* t = tile + k * 33 + c4; t[0] = v.x; t[1] = v.y; t[2] = v.z; t[3] = v.w;
        }
    }
    __syncthreads();
    const int n = tid >> 4, kc = (tid & 15) * 8;
    float f[8];
#pragma unroll
    for (int e = 0; e < 8; ++e) f[e] = zero ? 0.f : tile[(kc + e) * 33 + n];
    u32x4 o; o.x = pk2(f[0], f[1]); o.y = pk2(f[2], f[3]); o.z = pk2(f[4], f[5]); o.w = pk2(f[6], f[7]);
    *(u32x4*)(dst + (size_t)(dn0 + n) * dst_ld + k0 + kc) = o;
    __syncthreads();
}
__device__ __forceinline__ void phase_weights(const Params& p, int l, unsigned char* lds) {
    float* tile = (float*)lds;
    for (int it = blockIdx.x; it < 3776; it += gridDim.x) {
        if (it < 2752) {
            const int nt = it >> 3, kt = it & 7, dn0 = nt * 32;
            wt_tile(p.w_in + (size_t)l * 1024 * NIN, NIN, kt * 128, orig_col(dn0), (bf16_t*)(p.ws + OFF_WTIN), 1024, dn0, dn0 >= NIN, tile);
        } else if (it < 3264) {
            const int r = it - 2752, j = r >> 7, nt = (r >> 2) & 31, kt = r & 3;
            wt_tile(p.w_br + (size_t)(l * 4 + j) * 512 * 1024, 1024, kt * 128, nt * 32, (bf16_t*)(p.ws + OFF_WTBR) + (size_t)j * 1024 * 512, 512, nt * 32, false, tile);
        } else if (it < 3520) {
            const int r = it - 3264, nt = r >> 3, kt = r & 7;
            wt_tile(p.w_out + (size_t)l * 1024 * 1024, 1024, kt * 128, nt * 32, (bf16_t*)(p.ws + OFF_WTOUT), 1024, nt * 32, false, tile);
        } else {
            const int r = it - 3520, nt = r >> 3, kt = r & 7;
            wt_tile(p.mem_w_kv + (size_t)l * 1024 * 1024, 1024, kt * 128, nt * 32, (bf16_t*)(p.ws + OFF_WTKV), 1024, nt * 32, false, tile);
        }
    }
}

__device__ __forceinline__ void phase_filter_gen(const Params& p, int l, unsigned char* lds) {
    float* zt = (float*)lds;
    float* ha = zt + 32 * 33;
    float* hbuf = ha + 32 * 64;
    int tid_ = threadIdx.x; asm volatile("" : "+v"(tid_)); const int tid = tid_;
    const float* w1 = p.hy_w1 + (size_t)l * 33 * 64; const float* b1 = p.hy_b1 + l * 64;
    const float* wm = p.hy_wm + (size_t)l * 2 * 64 * 64; const float* bm = p.hy_bm + l * 2 * 64;
    const float* w3 = p.hy_w3 + (size_t)l * 64 * 1024;
    float* hf = (float*)(p.ws + OFF_HFILT);
    float* en = (float*)(p.ws + OFF_ENERGY) + l * 512;
    const float* ztab = (const float*)(p.ws + OFF_ZT);
    for (int it = blockIdx.x; it < 256; it += gridDim.x) {
        const int n0 = it * 32;
        for (int idx = tid; idx < 32 * 33; idx += NTHR) zt[idx] = ztab[(size_t)n0 * 33 + idx];
        __syncthreads();
        for (int idx = tid; idx < 2048; idx += NTHR) {
            const int pos = idx >> 6, j = idx & 63; float s = b1[j];
            for (int e = 0; e < 33; ++e) s += zt[pos * 33 + e] * w1[e * 64 + j];
            ha[idx] = sinf(s);
        }
        __syncthreads();
        for (int idx = tid; idx < 2048; idx += NTHR) {
            const int pos = idx >> 6, j = idx & 63; float s = bm[j];
            for (int e = 0; e < 64; ++e) s += ha[pos * 64 + e] * wm[e * 64 + j];
            hbuf[idx] = sinf(s);
        }
        __syncthreads();
        for (int idx = tid; idx < 2048; idx += NTHR) {
            const int pos = idx >> 6, j = idx & 63; float s = bm[64 + j];
            for (int e = 0; e < 64; ++e) s += hbuf[pos * 64 + e] * wm[4096 + e * 64 + j];
            ha[idx] = sinf(s);
        }
        __syncthreads();
        {
            const int c = tid;
            float af[32], ab[32];
#pragma unroll
            for (int i = 0; i < 32; ++i) { af[i] = 0.f; ab[i] = 0.f; }
            for (int k = 0; k < 64; ++k) {
                const float wf = w3[k * 1024 + c], wb = w3[k * 1024 + 512 + c];
#pragma unroll
                for (int i = 0; i < 32; ++i) { const float h = ha[i * 64 + k]; af[i] += h * wf; ab[i] += h * wb; }
            }
            const float dmin = -3.0701134573253945f, dmax = -15.350567286626973f;
            const float delta = fabsf(dmin + (float)c * ((dmax - dmin) / 511.0f));
            float e = 0.f;
#pragma unroll
            for (int i = 0; i < 32; ++i) {
                const int n = n0 + i; const float t01 = (float)n / 8191.0f; const float win = expf(-t01 * delta);
                af[i] *= win; ab[i] *= win; e += af[i] * af[i]; if (n >= 1) e += ab[i] * ab[i];
            }
#pragma unroll
            for (int i = 0; i < 8; ++i) {
                float4 a; a.x = af[4 * i]; a.y = af[4 * i + 1]; a.z = af[4 * i + 2]; a.w = af[4 * i + 3];
                float4 b; b.x = ab[4 * i]; b.y = ab[4 * i + 1]; b.z = ab[4 * i + 2]; b.w = ab[4 * i + 3];
                *(float4*)(hf + (size_t)c * 8192 + n0 + 4 * i) = a;
                *(float4*)(hf + (size_t)(512 + c) * 8192 + n0 + 4 * i) = b;
            }
            atomicAdd(en + c, e);
        }
        __syncthreads();
    }
}

__device__ __forceinline__ void phase_filter_fft(const Params& p, int l, unsigned char* lds) {
    float2* d = (float2*)lds;
    const float2* tw = fft_lds_twiddles((const float2*)(p.ws + OFF_TW), lds);
    const float* hf = (const float*)(p.ws + OFF_HFILT);
    const float* en = (const float*)(p.ws + OFF_ENERGY) + l * 512;
    float4* pqa = (float4*)(p.ws + OFF_PQ);
    int tid_ = threadIdx.x; asm volatile("" : "+v"(tid_)); const int tid = tid_;
    for (int pr = blockIdx.x; pr < 256; pr += gridDim.x) {
        const int c0 = 2 * pr, c1 = c0 + 1;
        const float s0 = 1.0f / sqrtf(en[c0] + 1e-6f), s1 = 1.0f / sqrtf(en[c1] + 1e-6f);
        const float k0 = p.hy_skip[l * 512 + c0], k1 = p.hy_skip[l * 512 + c1];
        for (int n = tid; n < FN; n += NTHR) {
            float2 v;
            if (n < 8192) { v.x = hf[(size_t)c0 * 8192 + n] * s0; v.y = hf[(size_t)c1 * 8192 + n] * s1; if (n == 0) { v.x += k0; v.y += k1; } }
            else if (n == 8192) { v.x = 0.f; v.y = 0.f; }
            else { v.x = hf[(size_t)(512 + c0) * 8192 + (FN - n)] * s0; v.y = hf[(size_t)(512 + c1) * 8192 + (FN - n)] * s1; }
            d[n] = v;
        }
        __syncthreads();
        fft_forward(d, tw, (const float2*)(p.ws + OFF_TW));
        for (int kf = tid; kf <= FN / 2; kf += NTHR) filt_pointwise(d, pqa + (size_t)pr * FN, kf);
        __syncthreads();
    }
}

__device__ __forceinline__ void hy_pre_item(const Params& p, int l, const bf16_t* P, float* UT, bf16_t* GT, int bl, int tt, int ct, unsigned char* lds) {
    float* tU = (float*)lds;
    float* tG = tU + 64 * 65;
    int tid_ = threadIdx.x; asm volatile("" : "+v"(tid_)); const int tid = tid_;
    const int t = tid >> 3, cc = (tid & 7) * 8, c = ct * 64 + cc, tb = tt * 64 + t;
    const float* cw = p.hy_conv_w + (size_t)l * 3 * 1536; const float* cb = p.hy_conv_b + l * 1536;
    float av[8], a0[8], a1[8];
#pragma unroll
    for (int h = 0; h < 2; ++h) {
        const f32x4 bv = *(const f32x4*)(cb + c + 4 * h), b0 = *(const f32x4*)(cb + 512 + c + 4 * h), b1 = *(const f32x4*)(cb + 1024 + c + 4 * h);
#pragma unroll
        for (int e = 0; e < 4; ++e) { av[4 * h + e] = bv[e]; a0[4 * h + e] = b0[e]; a1[4 * h + e] = b1[e]; }
    }
#pragma unroll
    for (int j = 0; j < 3; ++j) {
        const int ts = tb + j - 1;
        if (ts >= 0 && ts < SEQ) {
            const bf16_t* row = P + (size_t)(bl * SEQ + ts) * PS + C_HY + c;
            const u32x4 rv = *(const u32x4*)row, r0 = *(const u32x4*)(row + 512), r1 = *(const u32x4*)(row + 1024);
#pragma unroll
            for (int h = 0; h < 2; ++h) {
                const f32x4 wv = *(const f32x4*)(cw + j * 1536 + c + 4 * h), w0 = *(const f32x4*)(cw + j * 1536 + 512 + c + 4 * h), w1 = *(const f32x4*)(cw + j * 1536 + 1024 + c + 4 * h);
#pragma unroll
                for (int e = 0; e < 4; ++e) {
                    const int k = 4 * h + e; const unsigned uv = rv[k >> 1], u0 = r0[k >> 1], u1 = r1[k >> 1];
                    av[k] += wv[e] * ((k & 1) ? hi16(uv) : lo16(uv)); a0[k] += w0[e] * ((k & 1) ? hi16(u0) : lo16(u0)); a1[k] += w1[e] * ((k & 1) ? hi16(u1) : lo16(u1));
                }
            }
        }
    }
    const u32x4 rz = *(const u32x4*)(P + (size_t)(bl * SEQ + tb) * PS + C_Z + 512 + c);
#pragma unroll
    for (int k = 0; k < 8; ++k) {
        const unsigned uz = rz[k >> 1]; const float z = (k & 1) ? hi16(uz) : lo16(uz);
        tU[(cc + k) * 65 + t] = av[k] * a1[k]; tG[(cc + k) * 65 + t] = a0[k] * z;
    }
    __syncthreads();
    const int c2 = tid >> 3, t8 = (tid & 7) * 8;
    const size_t o = (size_t)(bl * 512 + ct * 64 + c2) * SEQ + tt * 64 + t8;
    const float* su = tU + c2 * 65 + t8; const float* sg = tG + c2 * 65 + t8;
    f32x4 ua = {su[0], su[1], su[2], su[3]}, ub = {su[4], su[5], su[6], su[7]};
    *(f32x4*)(UT + o) = ua; *(f32x4*)(UT + o + 4) = ub;
    u32x4 g; g.x = pk2(sg[0], sg[1]); g.y = pk2(sg[2], sg[3]); g.z = pk2(sg[4], sg[5]); g.w = pk2(sg[6], sg[7]);
    *(u32x4*)(GT + o) = g;
    __syncthreads();
}
__device__ __forceinline__ void hy_post_item(bf16_t* P, const bf16_t* GT, int bl, int tt, int ct, unsigned char* lds, int dry = 0) {
    bf16_t* tl = (bf16_t*)lds;
    int tid_ = threadIdx.x; asm volatile("" : "+v"(tid_)); const int tid = tid_;
    const int c2 = tid >> 3, t8 = (tid & 7) * 8;
    const u32x4 v = *(const u32x4*)(GT + (size_t)(bl * 512 + ct * 64 + c2) * SEQ + tt * 64 + t8);
    bf16_t* d0 = tl + t8 * 72 + c2;
    d0[0 * 72] = (bf16_t)(v.x & 0xffffu); d0[1 * 72] = (bf16_t)(v.x >> 16); d0[2 * 72] = (bf16_t)(v.y & 0xffffu); d0[3 * 72] = (bf16_t)(v.y >> 16);
    d0[4 * 72] = (bf16_t)(v.z & 0xffffu); d0[5 * 72] = (bf16_t)(v.z >> 16); d0[6 * 72] = (bf16_t)(v.w & 0xffffu); d0[7 * 72] = (bf16_t)(v.w >> 16);
    __syncthreads();
    const int t = tid >> 3, cc = (tid & 7) * 8;
    const u32x4 ov = *(const u32x4*)(tl + t * 72 + cc);
    if (!dry) *(u32x4*)(P + (size_t)(bl * SEQ + tt * 64 + t) * PS + C_HY + ct * 64 + cc) = ov;
    __syncthreads();
}
__device__ __forceinline__ void hyena_conv_item(const Params& p, const float* UT, bf16_t* GT, int bl, int pr, unsigned char* lds, const float2* tw, int dry = 0) {
    float2* d = (float2*)lds;
    const float4* pq = (const float4*)(p.ws + OFF_PQ) + (size_t)pr * FN;
    int tid_ = threadIdx.x; asm volatile("" : "+v"(tid_)); const int tid = tid_;
    const float* u0 = UT + (size_t)(bl * 512 + 2 * pr) * SEQ; const float* u1 = u0 + SEQ;
    bf16_t* g0 = GT + (size_t)(bl * 512 + 2 * pr) * SEQ; bf16_t* g1 = g0 + SEQ;
    {
        float f0[16], f1[16];
#pragma unroll
        for (int i = 0; i < 16; ++i) { f0[i] = u0[tid + NTHR * i]; f1[i] = u1[tid + NTHR * i]; }
#pragma unroll
        for (int i = 0; i < 16; ++i) {
            float2 u; u.x = f0[i]; u.y = f1[i]; d[tid + NTHR * i] = u;
            float2 z; z.x = 0.f; z.y = 0.f; d[tid + NTHR * i + SEQ] = z;
        }
    }
    __syncthreads();
    fft_forward(d, tw, (const float2*)(p.ws + OFF_TW));
#pragma unroll 1
    for (int kf = tid; kf < FN / 2; kf += 4 * NTHR) {
        PwIn w0, w1, w2, w3;
        pw_load(w0, d, pq, kf); pw_load(w1, d, pq, kf + NTHR); pw_load(w2, d, pq, kf + 2 * NTHR); pw_load(w3, d, pq, kf + 3 * NTHR);
        pw_store(w0, d); pw_store(w1, d); pw_store(w2, d); pw_store(w3, d);
    }
    if (tid == 0) conv_pointwise(d, pq, FN / 2);
    __syncthreads();
    fft_inverse(d, tw, (const float2*)(p.ws + OFF_TW));
    {
        bf16_t a0[16], a1[16];
#pragma unroll
        for (int i = 0; i < 16; ++i) { a0[i] = g0[tid + NTHR * i]; a1[i] = g1[tid + NTHR * i]; }
#pragma unroll
        for (int i = 0; i < 16; ++i) {
            const int t = tid + NTHR * i;
            const float2 y = d[t];
            const bf16_t r0 = f2bf(y.x * bf2f(a0[i])), r1 = f2bf(y.y * bf2f(a1[i]));
            if (!dry) { g0[t] = r0; g1[t] = r1; }
        }
    }
    __syncthreads();
}

__device__ __forceinline__ void na_item(const Params& p, int l, bf16_t* P, int bl, int rp, int head, unsigned char* lds, int dry = 0) {
    bf16_t* Kimg = (bf16_t*)lds;
    bf16_t* VT = (bf16_t*)(lds + 82944);
    int tid_ = threadIdx.x; asm volatile("" : "+v"(tid_)); const int tid = tid_, lane = tid & 63, w = tid >> 6, l15 = lane & 15, q4 = lane >> 4;
    const int r0 = 2 * rp, rs0 = iclamp(r0 - 4, 0, 120);
#pragma unroll
    for (int i = 0; i < 9; ++i) {
        const int idx = tid + NTHR * i, key = idx >> 3, ch = idx & 7, grow = min(rs0 + (key >> 6), 127);
        const u32x4 kv = *(const u32x4*)(P + (size_t)(bl * SEQ + grow * 64 + (key & 63)) * PS + C_NAK + head * 64 + ch * 8);
        *(u32x4*)(Kimg + key * 72 + ch * 8) = kv;
    }
#pragma unroll
    for (int i = 0; i < 9; ++i) {
        const int idx = tid + NTHR * i, keyp = idx >> 2, chh = keyp >= 576 ? 1 : 0, key = keyp - chh * 576, ch = chh * 4 + (idx & 3), grow = min(rs0 + (key >> 6), 127);
        const u32x4 vv = *(const u32x4*)(P + (size_t)(bl * SEQ + grow * 64 + (key & 63)) * PS + C_NAV + head * 64 + ch * 8);
        bf16_t* vd = VT + (ch * 8) * 584 + key;
        vd[0 * 584] = (bf16_t)(vv.x & 0xffffu); vd[1 * 584] = (bf16_t)(vv.x >> 16);
        vd[2 * 584] = (bf16_t)(vv.y & 0xffffu); vd[3 * 584] = (bf16_t)(vv.y >> 16);
        vd[4 * 584] = (bf16_t)(vv.z & 0xffffu); vd[5 * 584] = (bf16_t)(vv.z >> 16);
        vd[6 * 584] = (bf16_t)(vv.w & 0xffffu); vd[7 * 584] = (bf16_t)(vv.w >> 16);
    }
    __syncthreads();
    const int rr = w >> 2, g = w & 3, r = r0 + rr, rs = iclamp(r - 4, 0, 120), lo = rs - rs0;
    const int cb = iclamp(16 * g - 8, 0, 32), c = 16 * g + l15, cs = iclamp(c - 8, 0, 48);
    bf16_t* qrow = P + (size_t)(bl * SEQ + r * 64 + c) * PS + head * 64;
    bf16x8 qf[2];
#pragma unroll
    for (int ks = 0; ks < 2; ++ks) qf[ks] = *(const bf16x8*)(qrow + ks * 32 + q4 * 8);
    f32x4 sc[16];
#pragma unroll
    for (int t = 0; t < 16; ++t) {
        const int kb = (lo + (t >> 1)) * 64 + cb + 16 * (t & 1);
        f32x4 a = {0.f, 0.f, 0.f, 0.f};
#pragma unroll
        for (int ks = 0; ks < 2; ++ks) { const bf16x8 kf = *(const bf16x8*)(Kimg + (kb + l15) * 72 + ks * 32 + q4 * 8); a = MFMA(kf, qf[ks], a); }
        sc[t] = a;
    }
    const float* rpb = p.na_rpb + (size_t)(l * 8 + head) * 15 * 31;
    float mx = -1e30f;
#pragma unroll
    for (int t = 0; t < 16; ++t) {
        const int drow = rs + (t >> 1) - r + 7;
#pragma unroll
        for (int e = 0; e < 4; ++e) {
            const int col = cb + 16 * (t & 1) + 4 * q4 + e;
            const bool ok = (col >= cs) && (col < cs + 16);
            const int dcol = ok ? (col - c + 15) : 0;
            const float v = ok ? (sc[t][e] + rpb[drow * 31 + dcol]) : -1e30f;
            sc[t][e] = v; mx = fmaxf(mx, v);
        }
    }
    mx = fmaxf(mx, __shfl_xor(mx, 16)); mx = fmaxf(mx, __shfl_xor(mx, 32));
    float sum = 0.f;
#pragma unroll
    for (int t = 0; t < 16; ++t)
#pragma unroll
        for (int e = 0; e < 4; ++e) { const float pe = __expf(sc[t][e] - mx); sc[t][e] = pe; sum += pe; }
    sum += __shfl_xor(sum, 16); sum += __shfl_xor(sum, 32);
    f32x4 o[4];
#pragma unroll
    for (int dt = 0; dt < 4; ++dt) o[dt] = (f32x4){0.f, 0.f, 0.f, 0.f};
#pragma unroll
    for (int kk = 0; kk < 8; ++kk) {
        u32x4 pu; pu.x = pk2(sc[2 * kk][0], sc[2 * kk][1]); pu.y = pk2(sc[2 * kk][2], sc[2 * kk][3]); pu.z = pk2(sc[2 * kk + 1][0], sc[2 * kk + 1][1]); pu.w = pk2(sc[2 * kk + 1][2], sc[2 * kk + 1][3]);
        const bf16x8 pf = mkfrag(pu);
        const int kbA = (lo + kk) * 64 + cb + 4 * q4;
#pragma unroll
        for (int dt = 0; dt < 4; ++dt) {
            const bf16_t* vr = VT + (dt * 16 + l15) * 584 + kbA;
            const bf16x8 vf = mkfrag2(*(const u32x2*)vr, *(const u32x2*)(vr + 16));
            o[dt] = MFMA(vf, pf, o[dt]);
        }
    }
    const float inv = 1.0f / sum;
    const bf16_t* zrow = P + (size_t)(bl * SEQ + r * 64 + c) * PS + C_Z + head * 64;
#pragma unroll
    for (int dt = 0; dt < 4; ++dt) {
        const int dd = dt * 16 + 4 * q4;
        const f32x4 z = ld_bf4(zrow + dd);
        if (!dry) st_bf4(qrow + dd, o[dt] * inv * z);
    }
    __syncthreads();
}

__device__ __forceinline__ void memattn_load(const Params& p, int b, int h, unsigned char* lds) {
    bf16_t* Kimg = (bf16_t*)lds;
    bf16_t* VT = (bf16_t*)(lds + 69632);
    const bf16_t* Km = (const bf16_t*)(p.ws + OFF_KMAT); const bf16_t* Vm = (const bf16_t*)(p.ws + OFF_VT);
    int tid_ = threadIdx.x; asm volatile("" : "+v"(tid_)); const int tid = tid_;
#pragma unroll
    for (int i = 0; i < 8; ++i) {
        const int idx = tid + NTHR * i;
        { const int key = idx >> 4, ch = idx & 15; *(u32x4*)(Kimg + key * 136 + ch * 8) = *(const u32x4*)(Km + (size_t)(b * 256 + key) * 512 + h * 128 + ch * 8); }
        { const int dd = idx >> 5, ch = idx & 31; *(u32x4*)(VT + dd * 264 + ch * 8) = *(const u32x4*)(Vm + (size_t)(h * 128 + dd) * 2048 + b * 256 + ch * 8); }
    }
    __syncthreads();
}
__device__ __forceinline__ void memattn_item(bf16_t* P, int bl, int h, int qt, unsigned char* lds, int dry = 0) {
    const bf16_t* Kimg = (const bf16_t*)lds; const bf16_t* VT = (const bf16_t*)(lds + 69632);
    int tid_ = threadIdx.x; asm volatile("" : "+v"(tid_)); const int tid = tid_, lane = tid & 63, w = tid >> 6, l15 = lane & 15, q4 = lane >> 4;
    const int tok = bl * SEQ + qt * 128 + w * 16 + l15;
    bf16_t* qrow = P + (size_t)tok * PS + C_MQ + h * 128;
    bf16x8 qf[4];
#pragma unroll
    for (int ks = 0; ks < 4; ++ks) qf[ks] = *(const bf16x8*)(qrow + ks * 32 + q4 * 8);
    f32x4 sc[16];
    float mx = -1e30f;
#pragma unroll
    for (int t = 0; t < 16; ++t) {
        f32x4 a = {0.f, 0.f, 0.f, 0.f};
#pragma unroll
        for (int ks = 0; ks < 4; ++ks) { const bf16x8 kf = *(const bf16x8*)(Kimg + (t * 16 + l15) * 136 + ks * 32 + q4 * 8); a = MFMA(kf, qf[ks], a); }
        sc[t] = a;
        mx = fmaxf(mx, fmaxf(fmaxf(a[0], a[1]), fmaxf(a[2], a[3])));
    }
    mx = fmaxf(mx, __shfl_xor(mx, 16)); mx = fmaxf(mx, __shfl_xor(mx, 32));
    float sum = 0.f;
#pragma unroll
    for (int t = 0; t < 16; ++t)
#pragma unroll
        for (int e = 0; e < 4; ++e) { const float pe = __expf(sc[t][e] - mx); sc[t][e] = pe; sum += pe; }
    sum += __shfl_xor(sum, 16); sum += __shfl_xor(sum, 32);
    f32x4 o[8];
#pragma unroll
    for (int dt = 0; dt < 8; ++dt) o[dt] = (f32x4){0.f, 0.f, 0.f, 0.f};
#pragma unroll
    for (int kk = 0; kk < 8; ++kk) {
        u32x4 pu; pu.x = pk2(sc[2 * kk][0], sc[2 * kk][1]); pu.y = pk2(sc[2 * kk][2], sc[2 * kk][3]); pu.z = pk2(sc[2 * kk + 1][0], sc[2 * kk + 1][1]); pu.w = pk2(sc[2 * kk + 1][2], sc[2 * kk + 1][3]);
        const bf16x8 pf = mkfrag(pu);
#pragma unroll
        for (int dt = 0; dt < 8; ++dt) {
            const bf16_t* vr = VT + (dt * 16 + l15) * 264 + kk * 32 + 4 * q4;
            const bf16x8 vf = mkfrag2(*(const u32x2*)vr, *(const u32x2*)(vr + 16));
            o[dt] = MFMA(vf, pf, o[dt]);
        }
    }
    const float inv = 1.0f / sum;
    const bf16_t* zrow = P + (size_t)tok * PS + C_Z + 3 * 512 + h * 128;
#pragma unroll
    for (int dt = 0; dt < 8; ++dt) {
        const int dd = dt * 16 + 4 * q4;
        const f32x4 z = ld_bf4(zrow + dd);
        if (!dry) st_bf4(qrow + dd, o[dt] * inv * z);
    }
}

constexpr int G_LRT = 0, G_BF = 8192, G_BB = 24576, G_TOT = 40960, G_IMG = 45056;
__device__ __forceinline__ void gla_tables(const Params& p, int l, const float* LR, int t0, int h, unsigned char* lds) {
    float* LRT = (float*)(lds + G_LRT); float* BF = (float*)(lds + G_BF); float* BB = (float*)(lds + G_BB); float* TOT = (float*)(lds + G_TOT);
    int tid_ = threadIdx.x; asm volatile("" : "+v"(tid_)); const int tid = tid_;
    ((float4*)LRT)[tid] = ((const float4*)(LR + (size_t)t0 * 32))[tid];
    __syncthreads();
    const int dk = tid & 63, cgp = tid >> 6;
    float uf[16], ub[16];
#pragma unroll
    for (int r = 0; r < 16; ++r) { uf[r] = p.gla_up_f[(size_t)(l * 16 + r) * 256 + h * 64 + dk]; ub[r] = p.gla_up_b[(size_t)(l * 16 + r) * 256 + h * 64 + dk]; }
    const float bif = p.gla_bias_f[l * 256 + h * 64 + dk], bib = p.gla_bias_b[l * 256 + h * 64 + dk];
    float lf[8], lb[8];
#pragma unroll
    for (int i = 0; i < 8; ++i) {
        const int c = cgp * 8 + i; float sf = bif, sb = bib;
#pragma unroll
        for (int r = 0; r < 16; ++r) { sf += LRT[c * 32 + r] * uf[r]; sb += LRT[c * 32 + 16 + r] * ub[r]; }
        lf[i] = logsigf_(sf) * (1.0f / 16.0f); lb[i] = logsigf_(sb) * (1.0f / 16.0f);
    }
#pragma unroll
    for (int i = 1; i < 8; ++i) lf[i] += lf[i - 1];
#pragma unroll
    for (int i = 6; i >= 0; --i) lb[i] += lb[i + 1];
    TOT[cgp * 64 + dk] = lf[7]; TOT[512 + cgp * 64 + dk] = lb[0];
    __syncthreads();
    float of = 0.f, ob = 0.f;
#pragma unroll
    for (int g2 = 0; g2 < 8; ++g2) { if (g2 < cgp) of += TOT[g2 * 64 + dk]; if (g2 > cgp) ob += TOT[512 + g2 * 64 + dk]; }
#pragma unroll
    for (int i = 0; i < 8; ++i) { BF[(cgp * 8 + i) * 64 + dk] = lf[i] + of; BB[(cgp * 8 + i) * 64 + dk] = lb[i] + ob; }
    __syncthreads();
}
struct GlaPre { u32x4 vv[2]; bf16_t q[8], k[8]; };
__device__ __forceinline__ void gla_prefetch(GlaPre& g, const bf16_t* P, int t0, int h, int tid) {
#pragma unroll
    for (int i = 0; i < 2; ++i) { const int idx = tid + NTHR * i, chn = idx >> 6, c = idx & 63; g.vv[i] = *(const u32x4*)(P + (size_t)(t0 + c) * PS + C_GV + h * 128 + chn * 8); }
#pragma unroll
    for (int i = 0; i < 8; ++i) { const int idx = tid + NTHR * i, c = idx >> 6, dk = idx & 63; g.q[i] = P[(size_t)(t0 + c) * PS + C_GQ + h * 64 + dk]; g.k[i] = P[(size_t)(t0 + c) * PS + C_GK + h * 64 + dk]; }
}
__device__ __forceinline__ void gla_vt_store(const GlaPre& g, bf16_t* VT, int tid) {
#pragma unroll
    for (int i = 0; i < 2; ++i) {
        const int idx = tid + NTHR * i, chn = idx >> 6, c = idx & 63;
        const u32x4 vv = g.vv[i];
        bf16_t* vd = VT + (chn * 8) * 72 + c;
        vd[0 * 72] = (bf16_t)(vv.x & 0xffffu); vd[1 * 72] = (bf16_t)(vv.x >> 16);
        vd[2 * 72] = (bf16_t)(vv.y & 0xffffu); vd[3 * 72] = (bf16_t)(vv.y >> 16);
        vd[4 * 72] = (bf16_t)(vv.z & 0xffffu); vd[5 * 72] = (bf16_t)(vv.z >> 16);
        vd[6 * 72] = (bf16_t)(vv.w & 0xffffu); vd[7 * 72] = (bf16_t)(vv.w >> 16);
    }
}
__device__ __forceinline__ void gla_part1_item(const Params& p, int l, const bf16_t* P, const float* LR, int item, unsigned char* lds) {
    const int h = item & 3, n = (item >> 2) & 127, bl = item >> 9, t0 = bl * SEQ + n * 64;
    const float* BF = (const float*)(lds + G_BF); const float* BB = (const float*)(lds + G_BB);
    bf16_t* KDT0 = (bf16_t*)(lds + G_IMG); bf16_t* KDT1 = KDT0 + 64 * 72; bf16_t* VT = KDT1 + 64 * 72;
    float* GS = (float*)(p.ws + OFF_GS); float* GD = (float*)(p.ws + OFF_GDEC);
    int tid_ = threadIdx.x; asm volatile("" : "+v"(tid_)); const int tid = tid_, lane = tid & 63, w = tid >> 6, l15 = lane & 15, q4 = lane >> 4;
    GlaPre gp; gla_prefetch(gp, P, t0, h, tid);
    gla_tables(p, l, LR, t0, h, lds);
#pragma unroll
    for (int i = 0; i < 8; ++i) {
        const int idx = tid + NTHR * i, c = idx >> 6, dk = idx & 63;
        const float kv = bf2f(gp.k[i]);
        KDT0[dk * 72 + c] = f2bf(kv * __expf(BF[63 * 64 + dk] - BF[c * 64 + dk]));
        KDT1[dk * 72 + c] = f2bf(kv * __expf(BB[dk] - BB[c * 64 + dk]));
    }
    gla_vt_store(gp, VT, tid);
    if (tid < 64) GD[(size_t)item * 64 + tid] = __expf(BF[63 * 64 + tid]);
    else if (tid < 128) GD[(size_t)(NITEM + item) * 64 + tid - 64] = __expf(BB[tid - 64]);
    __syncthreads();
    const int dir = w >> 2, dkt = w & 3;
    const bf16_t* KD = dir ? KDT1 : KDT0;
    bf16x8 kf[2];
#pragma unroll
    for (int ks = 0; ks < 2; ++ks) kf[ks] = *(const bf16x8*)(KD + (16 * dkt + l15) * 72 + 32 * ks + 8 * q4);
    float* dst = GS + ((size_t)dir * NITEM + item) * 8192;
#pragma unroll
    for (int dvt = 0; dvt < 8; ++dvt) {
        f32x4 a = {0.f, 0.f, 0.f, 0.f};
#pragma unroll
        for (int ks = 0; ks < 2; ++ks) { const bf16x8 vf = *(const bf16x8*)(VT + (16 * dvt + l15) * 72 + 32 * ks + 8 * q4); a = MFMA(kf[ks], vf, a); }
        *(f32x4*)(dst + (16 * dvt + l15) * 64 + 16 * dkt + 4 * q4) = a;
    }
    __syncthreads();
}
__device__ __forceinline__ void gla_scan(const Params& p, int dry = 0) {
    float* GS = (float*)(p.ws + OFF_GS); const float* GD = (const float*)(p.ws + OFF_GDEC);
    const int total = 2 * BG * 4 * 8192;
    int tid_ = threadIdx.x; asm volatile("" : "+v"(tid_));
    for (int id = blockIdx.x * NTHR + tid_; id < total; id += gridDim.x * NTHR) {
        const int e = id & 8191, comb = id >> 13, h = comb & 3, bl = (comb >> 2) % BG, dir = comb / (4 * BG), dk = e & 63;
        float S = 0.f;
        const size_t ibase = (size_t)dir * NITEM + (size_t)(bl * 128) * 4 + h;
        for (int s0 = 0; s0 < 128; s0 += 16) {
            float u[16], dc[16];
#pragma unroll
            for (int i = 0; i < 16; ++i) {
                const int n = dir ? 127 - (s0 + i) : s0 + i;
                const size_t item = ibase + (size_t)n * 4;
                u[i] = GS[item * 8192 + e]; dc[i] = GD[item * 64 + dk];
            }
#pragma unroll
            for (int i = 0; i < 16; ++i) {
                const int n = dir ? 127 - (s0 + i) : s0 + i;
                const size_t item = ibase + (size_t)n * 4;
                if (!dry) GS[item * 8192 + e] = S;
                S = dc[i] * S + u[i];
            }
        }
    }
}
__device__ __forceinline__ void gla_part2_item(const Params& p, int l, bf16_t* P, const float* LR, int item, unsigned char* lds, int dry = 0) {
    const int h = item & 3, n = (item >> 2) & 127, bl = item >> 9, t0 = bl * SEQ + n * 64;
    const float* BF = (const float*)(lds + G_BF); const float* BB = (const float*)(lds + G_BB);
    bf16_t* QF = (bf16_t*)(lds + G_IMG);
    bf16_t* KF = QF + 2 * 64 * 72;
    bf16_t* QD = KF + 2 * 64 * 72;
    bf16_t* VT = QD + 2 * 64 * 72;
    bf16_t* ST = VT + 128 * 72;
    float* OX = (float*)lds;
    const float* GS = (const float*)(p.ws + OFF_GS);
    int tid_ = threadIdx.x; asm volatile("" : "+v"(tid_)); const int tid = tid_, lane = tid & 63, w = tid >> 6, l15 = lane & 15, q4 = lane >> 4;
    GlaPre gp; gla_prefetch(gp, P, t0, h, tid);
    float4 sp[2][4];
#pragma unroll
    for (int dir = 0; dir < 2; ++dir)
#pragma unroll
        for (int i = 0; i < 4; ++i) { const int idx = tid + NTHR * i; sp[dir][i] = *(const float4*)(GS + ((size_t)dir * NITEM + item) * 8192 + (idx >> 4) * 64 + (idx & 15) * 4); }
    gla_tables(p, l, LR, t0, h, lds);
#pragma unroll
    for (int i = 0; i < 8; ++i) {
        const int idx = tid + NTHR * i, c = idx >> 6, dk = idx & 63;
        const float qv = bf2f(gp.q[i]);
        const float kv = bf2f(gp.k[i]);
        const float bf = BF[c * 64 + dk], mf = BF[31 * 64 + dk], bb = BB[c * 64 + dk], mb = BB[32 * 64 + dk];
        QF[c * 72 + dk] = f2bf(qv * __expf(bf - mf)); KF[c * 72 + dk] = f2bf(kv * __expf(mf - bf)); QD[c * 72 + dk] = f2bf(qv * __expf(bf));
        QF[4608 + c * 72 + dk] = f2bf(qv * __expf(bb - mb)); KF[4608 + c * 72 + dk] = f2bf(kv * __expf(mb - bb)); QD[4608 + c * 72 + dk] = f2bf(qv * __expf(bb));
    }
    gla_vt_store(gp, VT, tid);
#pragma unroll
    for (int dir = 0; dir < 2; ++dir) {
#pragma unroll
        for (int i = 0; i < 4; ++i) {
            const int idx = tid + NTHR * i, dv = idx >> 4, dk4 = (idx & 15) * 4;
            const float4 s = sp[dir][i];
            u32x2 o; o.x = pk2(s.x, s.y); o.y = pk2(s.z, s.w);
            *(u32x2*)(ST + dir * 9216 + dv * 72 + dk4) = o;
        }
    }
    __syncthreads();
    const int dir = w >> 2, ct = w & 3;
    const bf16_t* qfp = QF + dir * 4608; const bf16_t* kfp = KF + dir * 4608; const bf16_t* qdp = QD + dir * 4608; const bf16_t* stp = ST + dir * 9216;
    bf16x8 qf[2], qd[2];
#pragma unroll
    for (int ks = 0; ks < 2; ++ks) { qf[ks] = *(const bf16x8*)(qfp + (16 * ct + l15) * 72 + 32 * ks + 8 * q4); qd[ks] = *(const bf16x8*)(qdp + (16 * ct + l15) * 72 + 32 * ks + 8 * q4); }
    f32x4 sc[4];
    const int cq = 16 * ct + l15;
#pragma unroll
    for (int st = 0; st < 4; ++st) {
        f32x4 a = {0.f, 0.f, 0.f, 0.f};
#pragma unroll
        for (int ks = 0; ks < 2; ++ks) { const bf16x8 kf = *(const bf16x8*)(kfp + (16 * st + l15) * 72 + 32 * ks + 8 * q4); a = MFMA(kf, qf[ks], a); }
#pragma unroll
        for (int e = 0; e < 4; ++e) { const int s = 16 * st + 4 * q4 + e; const bool ok = dir ? (s > cq) : (s <= cq); a[e] = ok ? a[e] : 0.f; }
        sc[st] = a;
    }
    f32x4 o[8];
#pragma unroll
    for (int dt = 0; dt < 8; ++dt) o[dt] = (f32x4){0.f, 0.f, 0.f, 0.f};
#pragma unroll
    for (int kk = 0; kk < 2; ++kk) {
        u32x4 pu; pu.x = pk2(sc[2 * kk][0], sc[2 * kk][1]); pu.y = pk2(sc[2 * kk][2], sc[2 * kk][3]); pu.z = pk2(sc[2 * kk + 1][0], sc[2 * kk + 1][1]); pu.w = pk2(sc[2 * kk + 1][2], sc[2 * kk + 1][3]);
        const bf16x8 pf = mkfrag(pu);
#pragma unroll
        for (int dt = 0; dt < 8; ++dt) {
            const bf16_t* vr = VT + (dt * 16 + l15) * 72 + kk * 32 + 4 * q4;
            const bf16x8 vf = mkfrag2(*(const u32x2*)vr, *(const u32x2*)(vr + 16));
            o[dt] = MFMA(vf, pf, o[dt]);
        }
    }
#pragma unroll
    for (int ks = 0; ks < 2; ++ks)
#pragma unroll
        for (int dt = 0; dt < 8; ++dt) { const bf16x8 sf = *(const bf16x8*)(stp + (dt * 16 + l15) * 72 + 32 * ks + 8 * q4); o[dt] = MFMA(sf, qd[ks], o[dt]); }
    if (dir == 1) {
#pragma unroll
        for (int dt = 0; dt < 8; ++dt) *(f32x4*)(OX + cq * 132 + 16 * dt + 4 * q4) = o[dt];
    }
    __syncthreads();
    if (dir == 0) {
        float ss = 0.f;
#pragma unroll
        for (int dt = 0; dt < 8; ++dt) { o[dt] += *(const f32x4*)(OX + cq * 132 + 16 * dt + 4 * q4); ss += (o[dt][0] * o[dt][0] + o[dt][1] * o[dt][1]) + (o[dt][2] * o[dt][2] + o[dt][3] * o[dt][3]); }
        ss += __shfl_xor(ss, 16); ss += __shfl_xor(ss, 32);
        const float rms = 1.0f / sqrtf(ss * (1.0f / 128.0f) + 1e-6f);
        const float* ng = p.gla_norm_g + l * 512 + h * 128;
        const bf16_t* zrow = P + (size_t)(t0 + cq) * PS + C_Z + 2 * 512 + h * 128;
        bf16_t* orow = P + (size_t)(t0 + cq) * PS + C_GV + h * 128;
#pragma unroll
        for (int dt = 0; dt < 8; ++dt) {
            const int dd = 16 * dt + 4 * q4;
            const f32x4 z = ld_bf4(zrow + dd); const f32x4 g4 = *(const f32x4*)(ng + dd);
            if (!dry) st_bf4(orow + dd, o[dt] * rms * g4 * z);
        }
    }
    __syncthreads();
}

namespace pg8 {
#define PG8_LAS __attribute__((address_space(3)))
typedef unsigned short bf16_t;
typedef short bf16x8 __attribute__((ext_vector_type(8)));
typedef float f32x4 __attribute__((ext_vector_type(4)));
typedef unsigned u32x4 __attribute__((ext_vector_type(4)));
constexpr int BM = 256, BK = 64, HALF = 128, HTB = HALF * BK * 2  , STAGE_BYTES = 8 * HTB, NXCD = 8, WGM = 8;

__host__ __device__ __forceinline__ int lds_byte(int r, int c) { const int st = (r >> 4) * 2 + (c >> 5), rr = r & 15, cc = c & 31, ob = rr * 64 + cc * 2; return st * 1024 + (ob ^ (((ob >> 9) & 1) << 5)); }
__host__ __device__ __forceinline__ void stage_rc(int b, int& R, int& C) { const int st = b / 1024, sb = b % 1024, swz = sb ^ (((sb >> 9) & 1) << 5); R = (st >> 1) * 16 + swz / 64; C = (st & 1) * 32 + (swz % 64) / 2; }
__host__ __device__ __forceinline__ int perm32(int rho) { const int n = rho >> 4, i = rho & 15; return 8 * (i >> 2) + 4 * n + (i & 3); }

struct Unit { int pm, pn; };
struct Gemm { const bf16_t* A; const bf16_t* Bt; int M, N, K; };

struct StaticOrder {
    int nM, nN, nwg, G, c;
    __host__ __device__ __forceinline__ void init(int M, int N, int G_, int c_) { nM = M / BM; nN = N / BM; nwg = nM * nN; G = G_; c = c_; }
    __host__ __device__ bool next(int i, Unit& u) const {
        const long L = (long)i * G + c; if (L >= nwg) return false;
        int wgid = (int)L; { const int q = nwg / NXCD, r = nwg % NXCD, xcd = wgid % NXCD, off = wgid / NXCD; wgid = (xcd < r ? xcd * (q + 1) : r * (q + 1) + (xcd - r) * q) + off; }
        const int nig = WGM * nN, gid = wgid / nig, fm = gid * WGM, gsz = (nM - fm) < WGM ? (nM - fm) : WGM;
        u.pm = fm + ((wgid % nig) % gsz); u.pn = (wgid % nig) / gsz; return true;
    }
    __device__ __forceinline__ void a_ready(const Unit&) const {}
    __device__ __forceinline__ void done(const Unit&) const {}
};
__device__ __forceinline__ unsigned cvt_pk_bf16(float lo, float hi) { unsigned r; asm volatile("v_cvt_pk_bf16_f32 %0, %1, %2" : "=v"(r) : "v"(lo), "v"(hi)); return r; }
template <class Epi, class Sched, bool STAMP = false>
__device__ __forceinline__ void gemm_phase(PG8_LAS unsigned char* lds, const Gemm g, const Sched& S, const Epi& E, unsigned long long* stamps) {
    int tid_l = threadIdx.x; asm volatile("" : "+v"(tid_l)); const int tid = tid_l, wid = __builtin_amdgcn_readfirstlane(tid >> 6), lane = tid & 63, wr = wid >> 2, wc = wid & 3, fr = lane & 15, fq = lane >> 4;
    const int K = g.K, nt = K / BK;
    int ts_lo = 0, ts_hi = 0, nts = 0; const unsigned long long rt_entry = STAMP ? (unsigned long long)wall_clock64() : 0ull;
#define PG8_STAMP() do { if (STAMP && wid == 0 && nts < 64) { const unsigned long long _c = (unsigned long long)clock64(); \
        ts_lo = (lane == nts) ? (int)(unsigned)_c : ts_lo; ts_hi = (lane == nts) ? (int)(unsigned)(_c >> 32) : ts_hi; ++nts; } } while (0)
    PG8_STAMP();
    unsigned voffA[2], voffB[2];
#pragma unroll
    for (int i = 0; i < 2; ++i) { int R, C; stage_rc(tid * 16 + i * 8192, R, C); const int Rb = Epi::PERM ? ((R & ~31) + perm32(R & 31)) : R;
        voffA[i] = (unsigned)(R * K + C) * 2u; voffB[i] = (unsigned)(Rb * K + C) * 2u; }
    const size_t kstep = (size_t)(BK * 2);
    const size_t hstep = (size_t)HALF * K * 2;
    const size_t tstep = 2 * hstep;
    const unsigned ldsw = (unsigned)wid * 1024u;
    const int aoff = lds_byte(wr * 64 + fr, fq * 8), boff = lds_byte(wc * 32 + fr, fq * 8);
#define PG8_SA(b, h) (((b) * 2 + (h)) * HTB)
#define PG8_SB(b, h) ((4 + (b) * 2 + (h)) * HTB)
#define PG8_STAGE(bufoff, gbase, voff) do { _Pragma("unroll") for (int _i = 0; _i < 2; ++_i) \
        __builtin_amdgcn_global_load_lds((const unsigned*)((const char*)(gbase) + (voff)[_i]), (PG8_LAS unsigned*)(lds + (bufoff) + ldsw + _i * 8192), 16, 0, 0); } while (0)
#define PG8_LDA(dst, b, h) do { _Pragma("unroll") for (int m = 0; m < 4; ++m) _Pragma("unroll") for (int k = 0; k < 2; ++k) dst[m][k] = *(const PG8_LAS bf16x8*)(lds + PG8_SA(b, h) + aoff + m * 2048 + k * 1024); } while (0)
#define PG8_LDB(dst, b, h) do { _Pragma("unroll") for (int n = 0; n < 2; ++n) _Pragma("unroll") for (int k = 0; k < 2; ++k) dst[n][k] = *(const PG8_LAS bf16x8*)(lds + PG8_SB(b, h) + boff + n * 2048 + k * 1024); } while (0)
#define PG8_MMA(ai, bj, At, Bt) do { __builtin_amdgcn_s_setprio(1); _Pragma("unroll") for (int m = 0; m < 4; ++m) _Pragma("unroll") for (int n = 0; n < 2; ++n) _Pragma("unroll") for (int k = 0; k < 2; ++k) \
        acc[ai][bj][m][n] = __builtin_amdgcn_mfma_f32_16x16x32_bf16(Bt[n][k], At[m][k], acc[ai][bj][m][n], 0, 0, 0); __builtin_amdgcn_s_setprio(0); } while (0)
#define PG8_WAIT_V(n) asm volatile("s_waitcnt vmcnt(" #n ")" ::: "memory")
#define PG8_WAIT_L(n) asm volatile("s_waitcnt lgkmcnt(" #n ")" ::: "memory")
#define PG8_BAR __builtin_amdgcn_s_barrier()
#define PG8_SCHED __builtin_amdgcn_sched_barrier(0)
    Unit cur, nxt; int ui = 0;
    if (!S.next(0, cur)) return;
    f32x4 acc[2][2][4][2];
#pragma unroll
    for (int a = 0; a < 2; ++a)
#pragma unroll
        for (int b = 0; b < 2; ++b)
#pragma unroll
            for (int m = 0; m < 4; ++m)
#pragma unroll
                for (int n = 0; n < 2; ++n) acc[a][b][m][n] = (f32x4){0.f, 0.f, 0.f, 0.f};
    bf16x8 At[4][2], B0[2][2], B1[2][2];
    const char* cA = (const char*)g.A + (size_t)cur.pm * tstep; const char* cB = (const char*)g.Bt + (size_t)cur.pn * tstep;
    S.a_ready(cur);
    PG8_STAGE(PG8_SB(0, 0), cB, voffB); PG8_STAGE(PG8_SA(0, 0), cA, voffA); PG8_STAGE(PG8_SB(0, 1), cB + hstep, voffB); PG8_STAGE(PG8_SA(0, 1), cA + hstep, voffA);
    if (wr == 1) PG8_BAR;
    PG8_WAIT_V(4); PG8_BAR;
    PG8_STAGE(PG8_SB(1, 0), cB + kstep, voffB); PG8_STAGE(PG8_SA(1, 0), cA + kstep, voffA); PG8_STAGE(PG8_SB(1, 1), cB + hstep + kstep, voffB);
    PG8_WAIT_V(6); PG8_BAR;
    PG8_STAMP();
    for (;;) {
        const bool has_next = S.next(ui + 1, nxt);
        const char* nA = has_next ? (const char*)g.A + (size_t)nxt.pm * tstep : cA; const char* nB = has_next ? (const char*)g.Bt + (size_t)nxt.pn * tstep : cB;
        for (int t = 0; t < nt; t += 2) {
            const bool last = (t == nt - 2);
            const char* a1 = cA + (size_t)(t + 1) * kstep;
            const char* a2 = last ? nA : cA + (size_t)(t + 2) * kstep; const char* b2 = last ? nB : cB + (size_t)(t + 2) * kstep;
            const char* a3 = a2 + kstep; const char* b3 = b2 + kstep;
            if (last && has_next) S.a_ready(nxt);
            PG8_LDB(B0, 0, 0); PG8_SCHED; PG8_LDA(At, 0, 0); PG8_STAGE(PG8_SA(1, 1), a1 + hstep, voffA);
            PG8_WAIT_L(8); PG8_BAR; PG8_WAIT_L(0); PG8_MMA(0, 0, At, B0); PG8_BAR; PG8_SCHED;
            PG8_LDB(B1, 0, 1); PG8_STAGE(PG8_SB(0, 0), b2, voffB);
            PG8_BAR; PG8_WAIT_L(0); PG8_MMA(0, 1, At, B1); PG8_BAR;
            PG8_LDA(At, 0, 1); PG8_STAGE(PG8_SA(0, 0), a2, voffA);
            PG8_BAR; PG8_WAIT_L(0); PG8_MMA(1, 0, At, B0); PG8_BAR; PG8_SCHED;
            PG8_STAGE(PG8_SB(0, 1), b2 + hstep, voffB);
            PG8_WAIT_V(6); PG8_BAR; PG8_MMA(1, 1, At, B1); PG8_BAR;
            PG8_LDB(B0, 1, 0); PG8_SCHED; PG8_LDA(At, 1, 0); PG8_STAGE(PG8_SA(0, 1), a2 + hstep, voffA);
            PG8_WAIT_L(8); PG8_BAR; PG8_WAIT_L(0); PG8_MMA(0, 0, At, B0); PG8_BAR; PG8_SCHED;
            PG8_LDB(B1, 1, 1); PG8_STAGE(PG8_SB(1, 0), b3, voffB);
            PG8_BAR; PG8_WAIT_L(0); PG8_MMA(0, 1, At, B1); PG8_BAR;
            PG8_LDA(At, 1, 1); PG8_STAGE(PG8_SA(1, 0), a3, voffA);
            PG8_BAR; PG8_WAIT_L(0); PG8_MMA(1, 0, At, B0); PG8_BAR; PG8_SCHED;
            PG8_STAGE(PG8_SB(1, 1), b3 + hstep, voffB);
            PG8_WAIT_V(6); PG8_BAR; PG8_MMA(1, 1, At, B1); PG8_BAR;
        }
        PG8_STAMP();
        if constexpr (!Epi::AFTER_DRAIN) { E(acc, cur, wr, wc, fr, fq); S.done(cur); }
        PG8_STAMP();
        if (!has_next) break;
#pragma unroll
        for (int a = 0; a < 2; ++a)
#pragma unroll
            for (int b = 0; b < 2; ++b)
#pragma unroll
                for (int m = 0; m < 4; ++m)
#pragma unroll
                    for (int n = 0; n < 2; ++n) acc[a][b][m][n] = (f32x4){0.f, 0.f, 0.f, 0.f};
        cur = nxt; cA = nA; cB = nB; ++ui;
    }
    PG8_WAIT_V(0);
    if (wr == 0) PG8_BAR;
    PG8_BAR;
    if constexpr (Epi::AFTER_DRAIN) { E.fused(acc, cur, wr, wc, fr, fq, lds, wid, lane); S.done(cur); }
    PG8_STAMP();
    if (STAMP && wid == 0) { stamps[lane] = lane < nts ? (((unsigned long long)(unsigned)ts_hi << 32) | (unsigned)ts_lo) : 0ull;
        if (lane == 62) stamps[62] = rt_entry; if (lane == 63) stamps[63] = (unsigned long long)wall_clock64(); }
#undef PG8_STAMP
#undef PG8_SA
#undef PG8_SB
#undef PG8_STAGE
#undef PG8_LDA
#undef PG8_LDB
#undef PG8_MMA
#undef PG8_WAIT_V
#undef PG8_WAIT_L
#undef PG8_BAR
#undef PG8_SCHED
}
}

struct EpiInProj {
    static constexpr bool PERM = true, AFTER_DRAIN = false;
    bf16_t* P; const float* bias; float* LR;
    __device__ __forceinline__ void operator()(const f32x4 (&acc)[2][2][4][2], const pg8::Unit& u, int wr, int wc, int fr, int fq) const {
        const int row0 = u.pm * 256 + wr * 64 + fr, colt = u.pn * 256, col0 = colt + wc * 32 + 8 * fq;
        if (colt == C_LR) {
            if (wc == 0) {
                const int cl = 8 * fq;
                const f32x4 b0 = *(const f32x4*)(bias + 4096 + cl), b1 = *(const f32x4*)(bias + 4096 + cl + 4);
#pragma unroll
                for (int ai = 0; ai < 2; ++ai)
#pragma unroll
                    for (int m = 0; m < 4; ++m) {
                        float* d = LR + (size_t)(row0 + ai * 128 + m * 16) * 32 + cl;
                        *(f32x4*)d = acc[ai][0][m][0] + b0; *(f32x4*)(d + 4) = acc[ai][0][m][1] + b1;
                    }
            }
            return;
        }
        const int mode = (colt < 512 || colt == C_GQ) ? 1 : (colt >= C_MQ && colt < C_Z) ? 2 : (colt >= C_Z && colt < C_SG) ? 3 : (colt >= C_SG) ? 4 : 0;
#pragma unroll
        for (int bj = 0; bj < 2; ++bj) {
            const int col = col0 + bj * 128;
            const f32x4 b0 = *(const f32x4*)(bias + orig_col(col)), b1 = *(const f32x4*)(bias + orig_col(col) + 4);
#pragma unroll
            for (int ai = 0; ai < 2; ++ai)
#pragma unroll
                for (int m = 0; m < 4; ++m) {
                    f32x4 v0 = acc[ai][bj][m][0] + b0, v1 = acc[ai][bj][m][1] + b1;
                    if (mode == 1) { v0 *= 0.125f; v1 *= 0.125f; }
                    else if (mode == 2) { v0 *= 0.08838834764831845f; v1 *= 0.08838834764831845f; }
                    else if (mode == 3) {
#pragma unroll
                        for (int e = 0; e < 4; ++e) { v0[e] = siluf_(v0[e]); v1[e] = siluf_(v1[e]); }
                    } else if (mode == 4) {
#pragma unroll
                        for (int e = 0; e < 4; ++e) { v0[e] = sigmoidf_(v0[e]); v1[e] = sigmoidf_(v1[e]); }
                    }
                    u32x4 o; o.x = pk2(v0[0], v0[1]); o.y = pk2(v0[2], v0[3]); o.z = pk2(v1[0], v1[1]); o.w = pk2(v1[2], v1[3]);
                    *(u32x4*)(P + (size_t)(row0 + ai * 128 + m * 16) * PS + col) = o;
                }
        }
    }
};
struct EpiOut {
    static constexpr bool PERM = false, AFTER_DRAIN = false;
    float* pre; const float* bo; const float* x; const float2* stats; const float* g0; const float* b0; const float* hres; size_t tok0; int l;
    __device__ __forceinline__ void operator()(const f32x4 (&acc)[2][2][4][2], const pg8::Unit& u, int wr, int wc, int fr, int fq) const {
        const int row0 = u.pm * 256 + wr * 64 + fr, col0 = u.pn * 256 + wc * 32 + 4 * fq;
#pragma unroll
        for (int ai = 0; ai < 2; ++ai)
#pragma unroll
            for (int m = 0; m < 4; ++m) {
                const int row = row0 + ai * 128 + m * 16; const size_t T = tok0 + row;
                float2 st; st.x = 0.f; st.y = 0.f; if (l == 0) st = stats[T];
#pragma unroll
                for (int bj = 0; bj < 2; ++bj)
#pragma unroll
                    for (int n = 0; n < 2; ++n) {
                        const int col = col0 + bj * 128 + n * 16;
                        f32x4 res;
                        if (l == 0) res = (*(const f32x4*)(x + T * 1024 + col) - st.x) * st.y * *(const f32x4*)(g0 + col) + *(const f32x4*)(b0 + col);
                        else res = *(const f32x4*)(hres + T * 1024 + col);
                        *(f32x4*)(pre + (size_t)row * 1024 + col) = acc[ai][bj][m][n] + *(const f32x4*)(bo + col) + DN_ALPHA * res;
                    }
            }
    }
};

#define XB_TMO      128
#define XB_XCNT(j)  (256  + 64 * (j))
#define XB_XSUB(j)  (1280 + 64 * (j))
#define XB_XGEN(j)  (2304 + 64 * (j))
#define XB_TOP      3328
#define XB_TOPGEN   3392
#define XCD_BAR_WORDS 3456
#define XB_SPIN_CAP (1u << 18)
#define LAS __attribute__((address_space(3)))

__device__ __forceinline__ unsigned xb_ld(unsigned* p)              { return __hip_atomic_load(p, __ATOMIC_RELAXED, __HIP_MEMORY_SCOPE_AGENT); }
__device__ __forceinline__ unsigned xb_add(unsigned* p, unsigned v) { return __hip_atomic_fetch_add(p, v, __ATOMIC_RELAXED, __HIP_MEMORY_SCOPE_AGENT); }
__device__ __forceinline__ unsigned xb_xcc_id() { return (unsigned)__builtin_amdgcn_s_getreg((3 << 11) | 20) & 0xFu; }
#define XB_SPIN(cond, bar) do { unsigned _sp = 0; while (cond) { __builtin_amdgcn_s_sleep(1); \
    if ((++_sp & 255u) == 0u) { if (xb_ld(&(bar)[XB_TMO])) break; if (_sp > XB_SPIN_CAP) { atomicAdd(&(bar)[XB_TMO], 1u); break; } } } } while (0)

struct XcdBarrier {
    unsigned* bar; unsigned x;
    volatile LAS unsigned* st;
};

__device__ __forceinline__ XcdBarrier xcd_barrier_post(unsigned* bar, volatile LAS unsigned* st) {
    XcdBarrier b; b.bar = bar; b.x = xb_xcc_id(); b.st = st;
    if (threadIdx.x == 0) (void)xb_add(&bar[XB_XCNT(b.x)], 1u);
    return b;
}
__device__ __forceinline__ void xcd_barrier_complete(unsigned* bar, unsigned x, unsigned& nloc, unsigned& nx) {
    const unsigned G = gridDim.x * gridDim.y * gridDim.z;
    unsigned sum, cnt, mine, sp = 0u;
    for (;;) {
        sum = 0u; cnt = 0u; mine = 0u;
#pragma unroll
        for (unsigned j = 0; j < 16; ++j) { const unsigned c = xb_ld(&bar[XB_XCNT(j)]); sum += c; cnt += (c > 0u) ? 1u : 0u; mine = (j == x) ? c : mine; }
        if (sum == G) break;
        __builtin_amdgcn_s_sleep(1);
        if ((++sp & 255u) == 0u) { if (xb_ld(&bar[XB_TMO])) break; if (sp > XB_SPIN_CAP) { atomicAdd(&bar[XB_TMO], 1u); break; } }
    }
    nloc = mine > 0u ? mine : 1u; nx = cnt > 0u ? cnt : 1u;
}

__device__ __forceinline__ void xcd_barrier(unsigned* b_bar, unsigned b_x, volatile LAS unsigned* b_st) {
    asm volatile("s_waitcnt vmcnt(0)" ::: "memory");
    __syncthreads();
    if (threadIdx.x == 0) {
        unsigned* bar = b_bar;
        __builtin_amdgcn_s_waitcnt(0);
        unsigned nloc = b_st[0], nx = b_st[1];
        if (nloc == 0u) { xcd_barrier_complete(bar, b_x, nloc, nx); b_st[0] = nloc; b_st[1] = nx; }
        const unsigned old = xb_add(&bar[XB_XSUB(b_x)], 1u);
        const unsigned gen = old / nloc;
        if (old + 1u == (gen + 1u) * nloc) {
            __builtin_amdgcn_fence(__ATOMIC_RELEASE, "agent");
            asm volatile("s_waitcnt vmcnt(0)" ::: "memory");
            const unsigned og = xb_add(&bar[XB_TOP], 1u);
            const unsigned tg = og / nx;
            if (og + 1u == (tg + 1u) * nx) xb_add(&bar[XB_TOPGEN], 1u);
            else XB_SPIN(xb_ld(&bar[XB_TOPGEN]) == tg, bar);
            __builtin_amdgcn_fence(__ATOMIC_ACQUIRE, "agent");
            xb_add(&bar[XB_XGEN(b_x)], 1u);
            asm volatile("s_waitcnt vmcnt(0)" ::: "memory");
        } else {
            XB_SPIN(xb_ld(&bar[XB_XGEN(b_x)]) == gen, bar);
            __builtin_amdgcn_fence(__ATOMIC_ACQUIRE, "agent");
            asm volatile("s_waitcnt vmcnt(0)" ::: "memory");
        }
    }
    __syncthreads();
}

__device__ __forceinline__ void gbar(unsigned* ctr, unsigned& gen, int G) {
    __syncthreads();
    gen += (unsigned)G;
    if (threadIdx.x == 0) {
        __threadfence();
        __hip_atomic_fetch_add(ctr, 1u, __ATOMIC_RELAXED, __HIP_MEMORY_SCOPE_AGENT);
        while (__hip_atomic_load(ctr, __ATOMIC_RELAXED, __HIP_MEMORY_SCOPE_AGENT) < gen) __builtin_amdgcn_s_sleep(1);
        __threadfence();
    }
    __syncthreads();
}
typedef const Params __attribute__((address_space(4))) KParams;
#define KP4 __attribute__((address_space(4)))
__device__ __forceinline__ Params fresh_params() {
#if defined(__HIP_DEVICE_COMPILE__)
    KParams* kp = (KParams*)__builtin_amdgcn_kernarg_segment_ptr();
    asm volatile("" : "+s"(kp));
    Params r;
    const float* KP4 const* src = (const float* KP4 const*)kp;
    const float** dst = (const float**)&r;
#pragma unroll
    for (int i = 0; i < 28; ++i) dst[i] = src[i];
    return r;
#else
    return Params{};
#endif
}
__global__ void __launch_bounds__(NTHR) mega(Params p_unused) {
    extern __shared__ __attribute__((aligned(16))) unsigned char lds[];
    cg::grid_group grid = cg::this_grid();
    const int G = gridDim.x, bid = blockIdx.x;
    volatile LAS unsigned* xst = (volatile LAS unsigned*)((LAS unsigned char*)lds + (LDS_BYTES - 16));
    if (threadIdx.x == 0) { xst[0] = 0u; xst[1] = 0u; }
    __syncthreads();
    unsigned* xbar; unsigned xx;
    { const Params p = fresh_params(); xbar = (unsigned*)(p.ws + OFF_BAR); xx = xb_xcc_id(); if (threadIdx.x == 0) (void)xb_add(&xbar[XB_XCNT(xx)], 1u); }
    { const Params p = fresh_params(); phase0(p); }
    grid.sync();
#pragma unroll 1
    for (int l = 0; l < 2; ++l) {
        { const Params p = fresh_params(); phase_weights(p, l, lds); __syncthreads(); phase_filter_gen(p, l, lds); }
        xcd_barrier(xbar, xx, xst);
        {
            const Params p = fresh_params();
            phase_filter_fft(p, l, lds);
            const bf16_t* WtKV = (const bf16_t*)(p.ws + OFF_WTKV); const bf16_t* membf = (const bf16_t*)(p.ws + OFF_MEMBF);
            for (int t = bid; t < 64; t += G) {
                f32x4 acc[4][4];
                if (t < 32) {
                    const int m0 = (t >> 2) * 256, n0 = (t & 3) * 128;
                    gemm_core(acc, membf + (size_t)m0 * 1024, 1024, WtKV + (size_t)n0 * 1024, 1024, 1024, lds);
                    bf16_t* Km = (bf16_t*)(p.ws + OFF_KMAT);
                    EPI_LOOP(st_bf4(Km + (size_t)row * 512 + col, v);)
                } else {
                    const int t2 = t - 32, m0 = (t2 >> 4) * 256, n0 = (t2 & 15) * 128;
                    gemm_core(acc, WtKV + (size_t)(512 + m0) * 1024, 1024, membf + (size_t)n0 * 1024, 1024, 1024, lds);
                    bf16_t* Vm = (bf16_t*)(p.ws + OFF_VT);
                    EPI_LOOP(st_bf4(Vm + (size_t)row * 2048 + col, v);)
                }
            }
        }
        xcd_barrier(xbar, xx, xst);
#pragma unroll 1
        for (int g = 0; g < NGRP; ++g) {
            const size_t tok0 = (size_t)g * TG;
#pragma unroll 1
            for (int rep = 0; rep < PROBE_REP_INPROJ; ++rep) {
                const Params p = fresh_params();
                pg8::Gemm gm; gm.A = (const bf16_t*)(p.ws + OFF_HB) + tok0 * 1024; gm.Bt = (const bf16_t*)(p.ws + OFF_WTIN); gm.M = TG; gm.N = NINP; gm.K = 1024;
                pg8::StaticOrder S; S.init(TG, NINP, G, bid);
                EpiInProj E; E.P = (bf16_t*)(p.ws + OFF_P); E.bias = p.b_in + (size_t)l * NIN; E.LR = (float*)(p.ws + OFF_LR);
                pg8::gemm_phase<EpiInProj, pg8::StaticOrder, false>((PG8_LAS unsigned char*)lds, gm, S, E, nullptr);
                __syncthreads();
            }
            xcd_barrier(xbar, xx, xst);
#pragma unroll 1
            for (int rep = 0; rep < PROBE_REP_MIX; ++rep) {
            int dry = (rep + 1 < PROBE_REP_MIX) ? 1 : 0; asm volatile("" : "+s"(dry));
            {
                const Params p = fresh_params();
                bf16_t* P = (bf16_t*)(p.ws + OFF_P);
                for (int it = bid; it < BG * 64 * 8; it += G) na_item(p, l, P, it >> 9, (it >> 3) & 63, it & 7, lds, dry);
            }
            {
                const Params p = fresh_params();
                bf16_t* P = (bf16_t*)(p.ws + OFF_P);
                for (int it = bid; it < BG * 128 * 8; it += G) hy_pre_item(p, l, P, (float*)(p.ws + OFF_UT), (bf16_t*)(p.ws + OFF_GT), it >> 10, (it >> 3) & 127, it & 7, lds);
            }
            {
                const Params p = fresh_params();
                for (int it = bid; it < NITEM; it += G) gla_part1_item(p, l, (const bf16_t*)(p.ws + OFF_P), (const float*)(p.ws + OFF_LR), it, lds);
            }
            {
                const Params p = fresh_params();
                bf16_t* P = (bf16_t*)(p.ws + OFF_P);
                const int nit = BG * 4 * 64, per = (nit + G - 1) / G;
                int last = -1;
                for (int it = bid * per; it < min(nit, (bid + 1) * per); ++it) {
                    const int bh = it >> 6, bl = bh >> 2, h = bh & 3;
                    if (bh != last) { __syncthreads(); memattn_load(p, g * BG + bl, h, lds); last = bh; }
                    memattn_item(P, bl, h, it & 63, lds, dry);
                }
                __syncthreads();
            }
            xcd_barrier(xbar, xx, xst);
            {
                const Params p = fresh_params();
                const float2* twl = fft_lds_twiddles((const float2*)(p.ws + OFF_TW), lds);
                for (int it = bid; it < BG * 256; it += G) hyena_conv_item(p, (const float*)(p.ws + OFF_UT), (bf16_t*)(p.ws + OFF_GT), it >> 8, it & 255, lds, twl, dry);
                __syncthreads();
                gla_scan(p, dry);
            }
            xcd_barrier(xbar, xx, xst);
            {
                const Params p = fresh_params();
                for (int it = bid; it < NITEM; it += G) gla_part2_item(p, l, (bf16_t*)(p.ws + OFF_P), (const float*)(p.ws + OFF_LR), it, lds, dry);
            }
            {
                const Params p = fresh_params();
                for (int it = bid; it < BG * 128 * 8; it += G) hy_post_item((bf16_t*)(p.ws + OFF_P), (const bf16_t*)(p.ws + OFF_GT), it >> 10, (it >> 3) & 127, it & 7, lds, dry);
            }
            xcd_barrier(xbar, xx, xst);
            }
            {
                const Params p = fresh_params();
                const bf16_t* P = (const bf16_t*)(p.ws + OFF_P); const bf16_t* WtBr = (const bf16_t*)(p.ws + OFF_WTBR); bf16_t* merged = (bf16_t*)(p.ws + OFF_MERGED);
                for (int t = bid; t < 512; t += G) {
                    const int sr = t >> 8, sb = t & 255, sx = sb & 7, sk = sb >> 3;
                    const int m0 = (sr * 32 + (sk >> 3) * 8 + sx) * 256, n0 = (sk & 7) * 128;
                    merge_tile(P, WtBr, merged, m0, n0, lds);
                }
            }
            xcd_barrier(xbar, xx, xst);
            {
                const Params p = fresh_params();
                pg8::Gemm gm; gm.A = (const bf16_t*)(p.ws + OFF_MERGED); gm.Bt = (const bf16_t*)(p.ws + OFF_WTOUT); gm.M = TG; gm.N = 1024; gm.K = 1024;
                pg8::StaticOrder S; S.init(TG, 1024, G, bid);
                EpiOut E; E.pre = (float*)(p.ws + OFF_PRE); E.bo = p.b_out + l * 1024; E.x = p.x; E.stats = (const float2*)(p.ws + OFF_STATS); E.g0 = p.ln_in_g; E.b0 = p.ln_in_b; E.hres = p.out; E.tok0 = tok0; E.l = l;
                pg8::gemm_phase<EpiOut, pg8::StaticOrder, false>((PG8_LAS unsigned char*)lds, gm, S, E, nullptr);
                __syncthreads();
            }
            xcd_barrier(xbar, xx, xst);
            {
                const Params p = fresh_params();
                ln_rows((const float*)(p.ws + OFF_PRE), 0, TG, p.ln_g + l * 1024, p.ln_b + l * 1024, p.out, (bf16_t*)(p.ws + OFF_HB), tok0, nullptr);
            }
        }
        xcd_barrier(xbar, xx, xst);
    }
}

extern "C" void kernel_launch(void* const* d_in, const int* in_sizes, int n_in, void* d_out, int out_size, void* d_ws, size_t ws_size, hipStream_t stream) {
    static int grid_blocks = 0;
    if (!grid_blocks) {
        if (ws_size < WS_END) { fprintf(stderr, "kernel_launch: workspace too small: %zu < %zu\n", ws_size, (size_t)WS_END); grid_blocks = -1; return; }
        {
            const long long ex[26] = {67108864LL, 2097152LL, 1024, 1024, 2LL * 1024 * 10784, 2 * 10784, 2 * 8 * 15 * 31, 2 * 3 * 1536, 2 * 1536, 2 * 33 * 64, 2 * 64, 2 * 2 * 64 * 64, 2 * 2 * 64,
                                      2 * 64 * 1024, 2 * 512, 2 * 16 * 256, 2 * 256, 2 * 16 * 256, 2 * 256, 2 * 512, 2LL * 1024 * 1024, 2LL * 4 * 512 * 1024, 2LL * 1024 * 1024, 2 * 1024, 2 * 1024, 2 * 1024};
            bool bad = (n_in != 26) || (out_size != 67108864);
            for (int i = 0; i < 26 && !bad; ++i) if ((long long)in_sizes[i] != ex[i]) { fprintf(stderr, "kernel_launch: input %d has %d elements, expected %lld\n", i, in_sizes[i], ex[i]); bad = true; }
            if (bad) { fprintf(stderr, "kernel_launch: unexpected shapes; nothing launched\n"); grid_blocks = -1; return; }
        }
        int dev = 0, cus = 0, per_cu = 0;
        hipGetDevice(&dev);
        hipDeviceGetAttribute(&cus, hipDeviceAttributeMultiprocessorCount, dev);
        if (hipFuncSetAttribute((const void*)mega, hipFuncAttributeMaxDynamicSharedMemorySize, LDS_BYTES) != hipSuccess) fprintf(stderr, "kernel_launch: hipFuncSetAttribute failed\n");
        if (hipOccupancyMaxActiveBlocksPerMultiprocessor(&per_cu, (const void*)mega, NTHR, LDS_BYTES) != hipSuccess || per_cu < 1) { fprintf(stderr, "kernel_launch: occupancy query gave %d\n", per_cu); per_cu = 1; }
        (void)hipGetLastError();
        if (per_cu > 1) per_cu = 1;
        grid_blocks = cus * per_cu;
    }
    if (grid_blocks < 0) return;
    Params p{};
    const float** pp = (const float**)&p;
    for (int i = 0; i < 26; ++i) pp[i] = (const float*)d_in[i];
    p.out = (float*)d_out; p.ws = (unsigned char*)d_ws;
    if (hipMemsetAsync((unsigned char*)d_ws + OFF_BAR, 0, 16384, stream) != hipSuccess) fprintf(stderr, "kernel_launch: memset of the barrier word failed\n");
    void* args[] = {&p};
    hipError_t e = hipLaunchCooperativeKernel((const void*)mega, dim3(grid_blocks), dim3(NTHR), args, LDS_BYTES, stream);
    if (e != hipSuccess) fprintf(stderr, "cooperative launch failed: %s (grid %d)\n", hipGetErrorString(e), grid_blocks);
}
#endif
```

```cpp
#ifndef PROBE_REP_MIX
#define PROBE_REP_MIX 1
#endif
#ifndef PROBE_REP_INPROJ
#define PROBE_REP_INPROJ 1
#endif
#include <hip/hip_runtime.h>
#include <hip/hip_cooperative_groups.h>
#include <cstdio>
#include <unistd.h>
#include <cmath>
namespace cg = cooperative_groups;

#define HD __host__ __device__
typedef unsigned short bf16_t;
typedef short bf16x8 __attribute__((ext_vector_type(8)));
typedef float f32x4 __attribute__((ext_vector_type(4)));
typedef unsigned u32x2 __attribute__((ext_vector_type(2)));
typedef unsigned u32x4 __attribute__((ext_vector_type(4)));

constexpr int NTOK = 65536, DM = 1024, SEQ = 8192, NB = 8;
constexpr int BG = 2;
constexpr int NGRP = NB / BG;
constexpr int TG = BG * SEQ;
constexpr int PS = 10752;
constexpr int NIN = 10784, NINP = 11008;
constexpr int C_NAQ = 0, C_NAK = 512, C_NAV = 1024, C_HY = 1536, C_GQ = 3072, C_GK = 3328, C_GV = 3584, C_MQ = 4096, C_Z = 4608, C_SG = 6656, C_LR = 10752;
constexpr int FN = 16384;
constexpr int NITEM = BG * 128 * 4;
constexpr int LDS_BYTES = 160 * 1024;
constexpr int NTHR = 512;
constexpr float DN_ALPHA = 1.41421356237309515f;

constexpr size_t al256(size_t x) { return (x + 255) & ~(size_t)255; }
constexpr size_t OFF_HB = 0;
constexpr size_t OFF_STATS = OFF_HB + (size_t)NTOK * DM * 2;
constexpr size_t OFF_TW = OFF_STATS + (size_t)NTOK * 8;
constexpr size_t OFF_MEMBF = OFF_TW + (size_t)FN * 8;
constexpr size_t OFF_ENERGY = OFF_MEMBF + (size_t)2048 * 1024 * 2;
constexpr size_t OFF_WTIN = OFF_ENERGY + 4096;
constexpr size_t OFF_WTBR = OFF_WTIN + (size_t)NINP * 1024 * 2;
constexpr size_t OFF_WTOUT = OFF_WTBR + (size_t)4 * 1024 * 512 * 2;
constexpr size_t OFF_WTKV = OFF_WTOUT + (size_t)1024 * 1024 * 2;
constexpr size_t OFF_KMAT = OFF_WTKV + (size_t)2048 * 1024 * 2;
constexpr size_t OFF_VT = OFF_KMAT + (size_t)2048 * 1024 * 2;
constexpr size_t OFF_HFILT = OFF_VT + (size_t)2048 * 1024 * 2;
constexpr size_t OFF_PQ = OFF_HFILT + (size_t)1024 * 8192 * 4;
constexpr size_t OFF_P = OFF_PQ + (size_t)256 * FN * 16;
constexpr size_t OFF_LR = OFF_P + (size_t)TG * PS * 2;
constexpr size_t OFF_GS = OFF_LR + (size_t)TG * 32 * 4;
constexpr size_t OFF_GDEC = OFF_GS + (size_t)2 * NITEM * 8192 * 4;
constexpr size_t OFF_MERGED = OFF_GDEC + (size_t)2 * NITEM * 64 * 4;
constexpr size_t OFF_PRE = OFF_MERGED + (size_t)TG * 1024 * 2;
constexpr size_t OFF_UT = OFF_PRE + (size_t)TG * 1024 * 4;
constexpr size_t OFF_GT = OFF_UT + (size_t)BG * 512 * 8192 * 4;
constexpr size_t OFF_BAR = OFF_GT + (size_t)BG * 512 * 8192 * 2;
constexpr size_t OFF_ZT = OFF_BAR + 16384;
constexpr size_t WS_END = OFF_ZT + (size_t)8192 * 33 * 4;

struct Params {
    const float *x, *mem, *ln_in_g, *ln_in_b, *w_in, *b_in, *na_rpb, *hy_conv_w, *hy_conv_b, *hy_w1, *hy_b1, *hy_wm, *hy_bm, *hy_w3, *hy_skip,
        *gla_up_f, *gla_bias_f, *gla_up_b, *gla_bias_b, *gla_norm_g, *mem_w_kv, *w_br, *w_out, *b_out, *ln_g, *ln_b;
    float* out;
    unsigned char* ws;
};

HD inline float bf2f(bf16_t b) {
    union { unsigned u; float f; } c; c.u = (unsigned)b << 16; return c.f;
}
HD inline bf16_t f2bf(float f) {
    union { unsigned u; float f; } c; c.f = f; unsigned u = c.u; u += 0x7fffu + ((u >> 16) & 1u); return (bf16_t)(u >> 16);
}
__device__ __forceinline__ unsigned pk2(float lo, float hi) { return (unsigned)f2bf(lo) | ((unsigned)f2bf(hi) << 16); }
__device__ __forceinline__ float lo16(unsigned u) { return __uint_as_float(u << 16); }
__device__ __forceinline__ float hi16(unsigned u) { return __uint_as_float(u & 0xffff0000u); }
__device__ __forceinline__ float wave_sum(float v) {
#pragma unroll
    for (int o = 32; o >= 1; o >>= 1) v += __shfl_xor(v, o);
    return v;
}
__device__ __forceinline__ float sigmoidf_(float x) { return __builtin_amdgcn_rcpf(1.0f + __expf(-x)); }
__device__ __forceinline__ float siluf_(float x) { return x * __builtin_amdgcn_rcpf(1.0f + __expf(-x)); }
__device__ __forceinline__ float logsigf_(float x) { return fminf(x, 0.0f) - log1pf(expf(-fabsf(x))); }
__device__ __forceinline__ bf16x8 mkfrag(u32x4 v) { return __builtin_bit_cast(bf16x8, v); }
__device__ __forceinline__ bf16x8 mkfrag2(u32x2 a, u32x2 b) { u32x4 v = {a.x, a.y, b.x, b.y}; return __builtin_bit_cast(bf16x8, v); }
#define MFMA(a, b, c) __builtin_amdgcn_mfma_f32_16x16x32_bf16((a), (b), (c), 0, 0, 0)
HD inline int iclamp(int v, int lo, int hi) { return v < lo ? lo : (v > hi ? hi : v); }

HD inline float2 cmulf(float2 a, float2 b) { float2 r; r.x = a.x * b.x - a.y * b.y; r.y = a.x * b.y + a.y * b.x; return r; }
HD inline float2 cmulcf(float2 a, float2 b) { float2 r; r.x = a.x * b.x + a.y * b.y; r.y = a.y * b.x - a.x * b.y; return r; }
struct Bfly { float2 x0, x1, x2, x3, W1; int i0; };
HD inline void bfly_load(Bfly& b, const float2* d, const float2* tw, int lgm, int q) {
    const int m = 1 << lgm, blk = q >> lgm, j = q & (m - 1);
    b.i0 = (blk << (lgm + 2)) + j;
    b.W1 = tw[j];
    b.x0 = d[b.i0]; b.x1 = d[b.i0 + m]; b.x2 = d[b.i0 + 2 * m]; b.x3 = d[b.i0 + 3 * m];
}
HD inline void bfly_fwd_store(const Bfly& b, float2* d, int lgm) {
    const int m = 1 << lgm, i0 = b.i0;
    const float2 W1 = b.W1, W2 = cmulf(W1, W1);
    const float2 x0 = b.x0, x1 = b.x1, x2 = b.x2, x3 = b.x3;
    float2 a0, a1, a2, a3, t;
    a0.x = x0.x + x2.x; a0.y = x0.y + x2.y;
    t.x = x0.x - x2.x; t.y = x0.y - x2.y; a2 = cmulf(t, W1);
    a1.x = x1.x + x3.x; a1.y = x1.y + x3.y;
    t.x = x1.x - x3.x; t.y = x1.y - x3.y; t = cmulf(t, W1); a3.x = t.y; a3.y = -t.x;
    float2 r;
    r.x = a0.x + a1.x; r.y = a0.y + a1.y; d[i0] = r;
    t.x = a0.x - a1.x; t.y = a0.y - a1.y; d[i0 + m] = cmulf(t, W2);
    r.x = a2.x + a3.x; r.y = a2.y + a3.y; d[i0 + 2 * m] = r;
    t.x = a2.x - a3.x; t.y = a2.y - a3.y; d[i0 + 3 * m] = cmulf(t, W2);
}
HD inline void bfly_inv_store(const Bfly& b, float2* d, int lgm) {
    const int m = 1 << lgm, i0 = b.i0;
    const float2 W1 = b.W1, W2 = cmulf(W1, W1);
    const float2 x0 = b.x0, x1 = b.x1, x2 = b.x2, x3 = b.x3;
    const float2 b1 = cmulcf(x1, W2), b3 = cmulcf(x3, W2);
    float2 y0, y1, y2, y3;
    y0.x = x0.x + b1.x; y0.y = x0.y + b1.y; y1.x = x0.x - b1.x; y1.y = x0.y - b1.y;
    y2.x = x2.x + b3.x; y2.y = x2.y + b3.y; y3.x = x2.x - b3.x; y3.y = x2.y - b3.y;
    const float2 c2 = cmulcf(y2, W1); float2 c3 = cmulcf(y3, W1); { const float tx = -c3.y, ty = c3.x; c3.x = tx; c3.y = ty; }
    float2 r;
    r.x = y0.x + c2.x; r.y = y0.y + c2.y; d[i0] = r;
    r.x = y0.x - c2.x; r.y = y0.y - c2.y; d[i0 + 2 * m] = r;
    r.x = y1.x + c3.x; r.y = y1.y + c3.y; d[i0 + m] = r;
    r.x = y1.x - c3.x; r.y = y1.y - c3.y; d[i0 + 3 * m] = r;
}
HD inline void fft_fwd_bfly(float2* d, const float2* tw, int lgm, int q) { Bfly b; bfly_load(b, d, tw, lgm, q); bfly_fwd_store(b, d, lgm); }
HD inline void fft_inv_bfly(float2* d, const float2* tw, int lgm, int q) { Bfly b; bfly_load(b, d, tw, lgm, q); bfly_inv_store(b, d, lgm); }
HD inline void r4_fwd(float2& x0, float2& x1, float2& x2, float2& x3, const float2 W1) {
    const float2 W2 = cmulf(W1, W1);
    float2 a0, a1, a2, a3, t;
    a0.x = x0.x + x2.x; a0.y = x0.y + x2.y;
    t.x = x0.x - x2.x; t.y = x0.y - x2.y; a2 = cmulf(t, W1);
    a1.x = x1.x + x3.x; a1.y = x1.y + x3.y;
    t.x = x1.x - x3.x; t.y = x1.y - x3.y; t = cmulf(t, W1); a3.x = t.y; a3.y = -t.x;
    x0.x = a0.x + a1.x; x0.y = a0.y + a1.y;
    t.x = a0.x - a1.x; t.y = a0.y - a1.y; x1 = cmulf(t, W2);
    x2.x = a2.x + a3.x; x2.y = a2.y + a3.y;
    t.x = a2.x - a3.x; t.y = a2.y - a3.y; x3 = cmulf(t, W2);
}
HD inline void r4_inv(float2& x0, float2& x1, float2& x2, float2& x3, const float2 W1) {
    const float2 W2 = cmulf(W1, W1);
    const float2 b1 = cmulcf(x1, W2), b3 = cmulcf(x3, W2);
    float2 y0, y1, y2, y3;
    y0.x = x0.x + b1.x; y0.y = x0.y + b1.y; y1.x = x0.x - b1.x; y1.y = x0.y - b1.y;
    y2.x = x2.x + b3.x; y2.y = x2.y + b3.y; y3.x = x2.x - b3.x; y3.y = x2.y - b3.y;
    const float2 c2 = cmulcf(y2, W1); float2 c3 = cmulcf(y3, W1); { const float tx = -c3.y, ty = c3.x; c3.x = tx; c3.y = ty; }
    x0.x = y0.x + c2.x; x0.y = y0.y + c2.y; x2.x = y0.x - c2.x; x2.y = y0.y - c2.y;
    x1.x = y1.x + c3.x; x1.y = y1.y + c3.y; x3.x = y1.x - c3.x; x3.y = y1.y - c3.y;
}
template <bool INV, bool HALF>
HD inline void r16_bfly(float2* d, const float2* twO, const float2* twI, int lgm, int q) {
    const int m = 1 << lgm, blk = q >> lgm, j = q & (m - 1), base = (blk << (lgm + 4)) + j;
    float2 e[4][4];
#pragma unroll
    for (int a = 0; a < 4; ++a)
#pragma unroll
        for (int b = 0; b < 4; ++b) {
            if (!INV && HALF && a >= 2) { e[a][b].x = 0.f; e[a][b].y = 0.f; }
            else e[a][b] = d[base + ((4 * a + b) << lgm)];
        }
    const float2 wI = twI[j];
    float2 wO[4];
#pragma unroll
    for (int b = 0; b < 4; ++b) wO[b] = twO[j + (b << lgm)];
    if (!INV) {
#pragma unroll
        for (int b = 0; b < 4; ++b) r4_fwd(e[0][b], e[1][b], e[2][b], e[3][b], wO[b]);
#pragma unroll
        for (int a = 0; a < 4; ++a) r4_fwd(e[a][0], e[a][1], e[a][2], e[a][3], wI);
    } else {
#pragma unroll
        for (int a = 0; a < 4; ++a) r4_inv(e[a][0], e[a][1], e[a][2], e[a][3], wI);
#pragma unroll
        for (int b = 0; b < 4; ++b) r4_inv(e[0][b], e[1][b], e[2][b], e[3][b], wO[b]);
    }
#pragma unroll
    for (int a = 0; a < 4; ++a)
#pragma unroll
        for (int b = 0; b < 4; ++b)
            if (!(INV && HALF && a >= 2)) d[base + ((4 * a + b) << lgm)] = e[a][b];
}
HD inline int brev14(int k) {
    unsigned v = (unsigned)k;
    v = ((v >> 1) & 0x55555555u) | ((v & 0x55555555u) << 1);
    v = ((v >> 2) & 0x33333333u) | ((v & 0x33333333u) << 2);
    v = ((v >> 4) & 0x0f0f0f0fu) | ((v & 0x0f0f0f0fu) << 4);
    v = ((v >> 8) & 0x00ff00ffu) | ((v & 0x00ff00ffu) << 8);
    v = (v >> 16) | (v << 16);
    return (int)(v >> 18);
}
struct PwIn { float2 Z1, Z2; float4 A, B; int p1, p2; };
HD inline void pw_load(PwIn& w, const float2* d, const float4* pq, int kf) {
    const int k2 = (FN - kf) & (FN - 1); w.p1 = brev14(kf); w.p2 = brev14(k2);
    w.Z1 = d[w.p1]; w.Z2 = d[w.p2]; w.A = pq[w.p1]; w.B = pq[w.p2];
}
HD inline void pw_store(const PwIn& w, float2* d) {
    const float2 Z1 = w.Z1, Z2 = w.Z2;
    float2 P1, Q1, P2, Q2; P1.x = w.A.x; P1.y = w.A.y; Q1.x = w.A.z; Q1.y = w.A.w; P2.x = w.B.x; P2.y = w.B.y; Q2.x = w.B.z; Q2.y = w.B.w;
    float2 c1, c2; c1.x = Z1.x; c1.y = -Z1.y; c2.x = Z2.x; c2.y = -Z2.y;
    const float2 a = cmulf(Z1, P1), b = cmulf(c2, Q1), c = cmulf(Z2, P2), e = cmulf(c1, Q2);
    float2 w1, w2; w1.x = a.x + b.x; w1.y = a.y + b.y; w2.x = c.x + e.x; w2.y = c.y + e.y;
    d[w.p1] = w1;
    if (w.p2 != w.p1) d[w.p2] = w2;
}
HD inline void conv_pointwise(float2* d, const float4* pq, int kf) { PwIn w; pw_load(w, d, pq, kf); pw_store(w, d); }
HD inline void filt_pointwise(const float2* d, float4* pq, int kf) {
    const int k2 = (FN - kf) & (FN - 1), p1 = brev14(kf), p2 = brev14(k2);
    const float2 Z1 = d[p1], Z2 = d[p2];
    const float gcx = 0.5f * (Z1.x + Z2.x), gcy = 0.5f * (Z1.y - Z2.y);
    const float gdx = 0.5f * (Z1.y + Z2.y), gdy = -0.5f * (Z1.x - Z2.x);
    const float s = 0.5f / (float)FN;
    float4 A; A.x = s * (gcx + gdx); A.y = s * (gcy + gdy); A.z = s * (gcx - gdx); A.w = s * (gcy - gdy);
    pq[p1] = A;
    float4 B; B.x = A.x; B.y = -A.y; B.z = A.z; B.w = -A.w;
    if (p2 != p1) pq[p2] = B;
}

HD inline int tw_off(int lgm) { return lgm == 10 ? 0 : lgm == 8 ? 1024 : lgm == 6 ? 1280 : lgm == 4 ? 1344 : lgm == 2 ? 1360 : 1364; }
#ifndef FFT_HOST_TEST
template <int LGM, bool INV>
__device__ __forceinline__ void fft_pass(float2* d, const float2* twl, const float2* twg, int tid) {
    const float2* tw = (LGM == 12) ? twg : twl + tw_off(LGM);
#pragma unroll
    for (int it = 0; it < 2; ++it) {
        const int q = tid + it * 4 * NTHR;
        Bfly b0, b1, b2, b3;
        bfly_load(b0, d, tw, LGM, q); bfly_load(b1, d, tw, LGM, q + NTHR); bfly_load(b2, d, tw, LGM, q + 2 * NTHR); bfly_load(b3, d, tw, LGM, q + 3 * NTHR);
        if (INV) { bfly_inv_store(b0, d, LGM); bfly_inv_store(b1, d, LGM); bfly_inv_store(b2, d, LGM); bfly_inv_store(b3, d, LGM); }
        else { bfly_fwd_store(b0, d, LGM); bfly_fwd_store(b1, d, LGM); bfly_fwd_store(b2, d, LGM); bfly_fwd_store(b3, d, LGM); }
    }
    __syncthreads();
}
template <int LGM, bool INV, bool HALF>
__device__ __forceinline__ void fft_pass16(float2* d, const float2* twl, const float2* twg, int tid) {
    const float2* twO = (LGM + 2 == 12) ? twg : twl + tw_off(LGM + 2);
    const float2* twI = twl + tw_off(LGM);
    r16_bfly<INV, HALF>(d, twO, twI, LGM, tid);
    r16_bfly<INV, HALF>(d, twO, twI, LGM, tid + NTHR);
    __syncthreads();
}
template <bool HALF>
__device__ __forceinline__ void fft_forward(float2* d, const float2* twl, const float2* twg) {
    int tid = threadIdx.x; asm volatile("" : "+v"(tid));
    fft_pass16<10, false, HALF>(d, twl, twg, tid); fft_pass16<6, false, false>(d, twl, twg, tid);
    fft_pass<4, false>(d, twl, twg, tid); fft_pass<2, false>(d, twl, twg, tid); fft_pass<0, false>(d, twl, twg, tid);
}
template <bool HALF>
__device__ __forceinline__ void fft_inverse(float2* d, const float2* twl, const float2* twg) {
    int tid = threadIdx.x; asm volatile("" : "+v"(tid));
    fft_pass<0, true>(d, twl, twg, tid); fft_pass<2, true>(d, twl, twg, tid); fft_pass<4, true>(d, twl, twg, tid);
    fft_pass16<6, true, false>(d, twl, twg, tid); fft_pass16<10, true, HALF>(d, twl, twg, tid);
}
__device__ __forceinline__ float2* fft_lds_twiddles(const float2* twg, unsigned char* lds) {
    int tid = threadIdx.x; asm volatile("" : "+v"(tid));
    float2* t = (float2*)(lds + 131072);
    for (int k = tid; k < 1365; k += NTHR) {
        const int lgm = k < 1024 ? 10 : k < 1280 ? 8 : k < 1344 ? 6 : k < 1360 ? 4 : k < 1364 ? 2 : 0;
        t[k] = twg[(k - tw_off(lgm)) << (12 - lgm)];
    }
    __syncthreads();
    return t;
}

constexpr int STG = 49152;
__device__ __forceinline__ int swz(int row, int ch) { return row * 128 + ((ch ^ ((row >> 1) & 7)) << 4); }
__device__ __forceinline__ void gemm_core(f32x4 (&acc)[4][4], const bf16_t* A, int lda, const bf16_t* Bt, int ldb, int K, unsigned char* lds) {
    int tid_ = threadIdx.x; asm volatile("" : "+v"(tid_)); const int tid = tid_, lane = tid & 63, w = tid >> 6, wm = w & 3, wn = w >> 2, l15 = lane & 15, q4 = lane >> 4;
    const int wu = __builtin_amdgcn_readfirstlane(w);
    __attribute__((address_space(3))) unsigned char* l3 = (__attribute__((address_space(3))) unsigned char*)lds;
#pragma unroll
    for (int mi = 0; mi < 4; ++mi)
#pragma unroll
        for (int ni = 0; ni < 4; ++ni) acc[mi][ni] = (f32x4){0.f, 0.f, 0.f, 0.f};
    const int r8 = lane >> 3, sch = (lane & 7) ^ ((((w & 1) << 2) + (r8 >> 1)) & 7);
    const bf16_t* ap = A + (size_t)(w * 8 + r8) * lda + sch * 8;
    const bf16_t* bp = Bt + (size_t)(w * 8 + r8) * ldb + sch * 8;
#define GC_STAGE(buf, k0)                                                                                                                         \
    {                                                                                                                                             \
        _Pragma("unroll") for (int i = 0; i < 4; ++i)                                                                                             \
            __builtin_amdgcn_global_load_lds((const unsigned*)(ap + (size_t)(64 * i) * lda + (k0)), (__attribute__((address_space(3))) unsigned*)(l3 + (buf) * STG + (wu + 8 * i) * 1024), 16, 0, 0);          \
        _Pragma("unroll") for (int i = 0; i < 2; ++i)                                                                                             \
            __builtin_amdgcn_global_load_lds((const unsigned*)(bp + (size_t)(64 * i) * ldb + (k0)), (__attribute__((address_space(3))) unsigned*)(l3 + (buf) * STG + 32768 + (wu + 8 * i) * 1024), 16, 0, 0);  \
    }
    GC_STAGE(0, 0)
    asm volatile("s_waitcnt vmcnt(0)" ::: "memory");
    __syncthreads();
    const int nk = K >> 6;
    for (int kt = 0; kt < nk; ++kt) {
        if (kt + 1 < nk) GC_STAGE((kt + 1) & 1, (kt + 1) << 6)
        const unsigned char* sa = lds + (kt & 1) * STG;
        const unsigned char* sb = sa + 32768;
#pragma unroll
        for (int ks = 0; ks < 2; ++ks) {
            bf16x8 af[4], bfr[4];
#pragma unroll
            for (int mi = 0; mi < 4; ++mi) af[mi] = *(const bf16x8*)(sa + swz(wm * 64 + mi * 16 + l15, ks * 4 + q4));
#pragma unroll
            for (int ni = 0; ni < 4; ++ni) bfr[ni] = *(const bf16x8*)(sb + swz(wn * 64 + ni * 16 + l15, ks * 4 + q4));
#pragma unroll
            for (int mi = 0; mi < 4; ++mi)
#pragma unroll
                for (int ni = 0; ni < 4; ++ni) acc[mi][ni] = MFMA(bfr[ni], af[mi], acc[mi][ni]);
        }
        asm volatile("s_waitcnt vmcnt(0)" ::: "memory");
        __syncthreads();
    }
#undef GC_STAGE
}
#define EPI_LOOP(body)                                                                                                  \
    {                                                                                                                   \
        int e_t = threadIdx.x; asm volatile("" : "+v"(e_t)); const int e_lane = e_t & 63, e_w = e_t >> 6;                                                    \
        _Pragma("unroll") for (int mi = 0; mi < 4; ++mi) _Pragma("unroll") for (int ni = 0; ni < 4; ++ni) {             \
            const int row = m0 + (e_w & 3) * 64 + mi * 16 + (e_lane & 15);                                              \
            const int col = n0 + (e_w >> 2) * 64 + ni * 16 + 4 * (e_lane >> 4);                                         \
            f32x4& v = acc[mi][ni];                                                                                     \
            body                                                                                                        \
        }                                                                                                               \
    }
__device__ __forceinline__ void st_bf4(bf16_t* dst, f32x4 v) {
    u32x2 o; o.x = pk2(v[0], v[1]); o.y = pk2(v[2], v[3]); *(u32x2*)dst = o;
}
__device__ __forceinline__ f32x4 ld_bf4(const bf16_t* src) {
    const u32x2 u = *(const u32x2*)src; f32x4 r = {lo16(u.x), hi16(u.x), lo16(u.y), hi16(u.y)}; return r;
}


__device__ __forceinline__ void merge_tile(const bf16_t* P, const bf16_t* WtBr, bf16_t* merged, int m0, int n0, unsigned char* lds) {
    int tid_ = threadIdx.x; asm volatile("" : "+v"(tid_)); const int tid = tid_, lane = tid & 63, w = tid >> 6, wm = w & 3, wn = w >> 2, l15 = lane & 15, q4 = lane >> 4;
    const int wu = __builtin_amdgcn_readfirstlane(w);
    __attribute__((address_space(3))) unsigned char* l3 = (__attribute__((address_space(3))) unsigned char*)lds;
    f32x4 acc[4][4], macc[4][4];
#pragma unroll
    for (int mi = 0; mi < 4; ++mi)
#pragma unroll
        for (int ni = 0; ni < 4; ++ni) { acc[mi][ni] = (f32x4){0.f, 0.f, 0.f, 0.f}; macc[mi][ni] = (f32x4){0.f, 0.f, 0.f, 0.f}; }
    const int r8 = lane >> 3, sch = (lane & 7) ^ ((((w & 1) << 2) + (r8 >> 1)) & 7);
    const bf16_t* ap = P + (size_t)(m0 + w * 8 + r8) * PS + sch * 8;
    const bf16_t* bp = WtBr + (size_t)(n0 + w * 8 + r8) * 512 + sch * 8;
    const bf16_t* sgp = P + (size_t)(m0 + wm * 64 + l15) * PS + C_SG + n0 + wn * 64 + 4 * q4;
#define MG_STAGE(buf, kt_)                                                                                                                        \
    {                                                                                                                                             \
        const int j_ = (kt_) >> 3, k0_ = ((kt_) & 7) << 6;                                                                                        \
        const int acol_ = (j_ == 0) ? C_NAQ : (j_ == 1) ? C_HY : (j_ == 2) ? C_GV : C_MQ;                                                        \
        _Pragma("unroll") for (int i = 0; i < 4; ++i)                                                                                             \
            __builtin_amdgcn_global_load_lds((const unsigned*)(ap + (size_t)(64 * i) * PS + acol_ + k0_), (__attribute__((address_space(3))) unsigned*)(l3 + (buf) * STG + (wu + 8 * i) * 1024), 16, 0, 0);      \
        _Pragma("unroll") for (int i = 0; i < 2; ++i)                                                                                             \
            __builtin_amdgcn_global_load_lds((const unsigned*)(bp + (size_t)j_ * 1024 * 512 + (size_t)(64 * i) * 512 + k0_), (__attribute__((address_space(3))) unsigned*)(l3 + (buf) * STG + 32768 + (wu + 8 * i) * 1024), 16, 0, 0);  \
    }
    MG_STAGE(0, 0)
    asm volatile("s_waitcnt vmcnt(0)" ::: "memory");
    __syncthreads();
#pragma unroll 1
    for (int kt = 0; kt < 32; ++kt) {
        if (kt + 1 < 32) MG_STAGE((kt + 1) & 1, kt + 1)
        const bool last = (kt & 7) == 7;
        u32x2 sg[4][4];
        if (last) {
            const bf16_t* sp = sgp + 1024 * (kt >> 3);
#pragma unroll
            for (int mi = 0; mi < 4; ++mi)
#pragma unroll
                for (int ni = 0; ni < 4; ++ni) sg[mi][ni] = *(const u32x2*)(sp + (size_t)(mi * 16) * PS + ni * 16);
        }
        const unsigned char* sa = lds + (kt & 1) * STG;
        const unsigned char* sb = sa + 32768;
#pragma unroll
        for (int ks = 0; ks < 2; ++ks) {
            bf16x8 af[4], bfr[4];
#pragma unroll
            for (int mi = 0; mi < 4; ++mi) af[mi] = *(const bf16x8*)(sa + swz(wm * 64 + mi * 16 + l15, ks * 4 + q4));
#pragma unroll
            for (int ni = 0; ni < 4; ++ni) bfr[ni] = *(const bf16x8*)(sb + swz(wn * 64 + ni * 16 + l15, ks * 4 + q4));
#pragma unroll
            for (int mi = 0; mi < 4; ++mi)
#pragma unroll
                for (int ni = 0; ni < 4; ++ni) acc[mi][ni] = MFMA(bfr[ni], af[mi], acc[mi][ni]);
        }
        asm volatile("s_waitcnt vmcnt(0)" ::: "memory");
        if (last) {
#pragma unroll
            for (int mi = 0; mi < 4; ++mi)
#pragma unroll
                for (int ni = 0; ni < 4; ++ni) {
                    const u32x2 u = sg[mi][ni]; const f32x4 g4 = {lo16(u.x), hi16(u.x), lo16(u.y), hi16(u.y)};
                    macc[mi][ni] += g4 * acc[mi][ni]; acc[mi][ni] = (f32x4){0.f, 0.f, 0.f, 0.f};
                }
        }
        __syncthreads();
    }
#undef MG_STAGE
#pragma unroll
    for (int mi = 0; mi < 4; ++mi)
#pragma unroll
        for (int ni = 0; ni < 4; ++ni) st_bf4(merged + (size_t)(m0 + wm * 64 + mi * 16 + l15) * 1024 + n0 + wn * 64 + ni * 16 + 4 * q4, macc[mi][ni]);
}

__device__ __forceinline__ int orig_col(int n) {
    if (n < 4096) return n;
    if (n < 4608) return n + 32;
    if (n < 6656) return n + 32;
    if (n < 10752) return n + 32;
    return n - 10752 + 4096;
}

__device__ __forceinline__ void ln_rows(const float* src, size_t src_row0, int nrows, const float* g, const float* b, float* dst32, bf16_t* dst16, size_t dst_row0, float2* stats) {
    int tid_ = threadIdx.x; asm volatile("" : "+v"(tid_));
    const int lane = tid_ & 63;
    const int gw = blockIdx.x * (NTHR / 64) + (tid_ >> 6), nw = gridDim.x * (NTHR / 64);
    for (int r = gw; r < nrows; r += nw) {
        const float4* xr = (const float4*)(src + (src_row0 + r) * 1024);
        float4 v[4]; float s = 0.f;
#pragma unroll
        for (int i = 0; i < 4; ++i) { v[i] = xr[lane + 64 * i]; s += (v[i].x + v[i].y) + (v[i].z + v[i].w); }
        s = wave_sum(s);
        const float mean = s * (1.0f / 1024.0f);
        float q = 0.f;
#pragma unroll
        for (int i = 0; i < 4; ++i) { const float a = v[i].x - mean, bb = v[i].y - mean, c = v[i].z - mean, d = v[i].w - mean; q += (a * a + bb * bb) + (c * c + d * d); }
        q = wave_sum(q);
        const float rstd = 1.0f / sqrtf(q * (1.0f / 1024.0f) + 1e-5f);
        if (stats && lane == 0) { float2 st; st.x = mean; st.y = rstd; stats[dst_row0 + r] = st; }
#pragma unroll
        for (int i = 0; i < 4; ++i) {
            const float4 g4 = ((const float4*)g)[lane + 64 * i], b4 = ((const float4*)b)[lane + 64 * i];
            float4 y; y.x = (v[i].x - mean) * rstd * g4.x + b4.x; y.y = (v[i].y - mean) * rstd * g4.y + b4.y; y.z = (v[i].z - mean) * rstd * g4.z + b4.z; y.w = (v[i].w - mean) * rstd * g4.w + b4.w;
            if (dst32) ((float4*)(dst32 + (dst_row0 + r) * 1024))[lane + 64 * i] = y;
            if (dst16) { u32x2 o; o.x = pk2(y.x, y.y); o.y = pk2(y.z, y.w); *(u32x2*)(dst16 + (dst_row0 + r) * 1024 + (lane + 64 * i) * 4) = o; }
        }
    }
}
__device__ __forceinline__ void phase0(const Params& p) {
    ln_rows(p.x, 0, NTOK, p.ln_in_g, p.ln_in_b, nullptr, (bf16_t*)(p.ws + OFF_HB), 0, (float2*)(p.ws + OFF_STATS));
    int tid_ = threadIdx.x; asm volatile("" : "+v"(tid_)); const int gt = blockIdx.x * NTHR + tid_, nt = gridDim.x * NTHR;
    float2* tw = (float2*)(p.ws + OFF_TW);
    for (int k = gt; k < FN; k += nt) { double s, c; sincospi(-2.0 * (double)k / (double)FN, &s, &c); float2 t; t.x = (float)c; t.y = (float)s; tw[k] = t; }
    bf16_t* mb = (bf16_t*)(p.ws + OFF_MEMBF);
    for (int i = gt; i < 2048 * 1024 / 4; i += nt) { const float4 v = ((const float4*)p.mem)[i]; u32x2 o; o.x = pk2(v.x, v.y); o.y = pk2(v.z, v.w); ((u32x2*)mb)[i] = o; }
    float* en = (float*)(p.ws + OFF_ENERGY);
    for (int i = gt; i < 1024; i += nt) en[i] = 0.f;
    float* ztab = (float*)(p.ws + OFF_ZT);
    for (int idx = gt; idx < 8192 * 33; idx += nt) {
        const int n = idx / 33, e = idx - n * 33;
        float v;
        if (e == 0) v = (float)n / 8191.0f;
        else {
            const int i = (e - 1) & 15;
            const double fr = 1e-4 + (double)i * ((15.0 - 1e-4) / 15.0);
            const double ang = (2.0 * 3.14159265358979323846 / 8192.0) * (double)n * fr;
            v = (e <= 16) ? (float)cos(ang) : (float)(-sin(ang));
        }
        ztab[idx] = v;
    }
}

__device__ __forceinline__ void wt_tile(const float* src, int src_ld, int k0, int on0, bf16_t* dst, int dst_ld, int dn0, bool zero, float* tile) {
    int tid_ = threadIdx.x; asm volatile("" : "+v"(tid_)); const int tid = tid_;
    if (!zero) {
#pragma unroll
        for (int i = 0; i < 2; ++i) {
            const int k = (tid >> 3) + 64 * i, c4 = (tid & 7) * 4;
            const float4 v = *(const float4*)(src + (size_t)(k0 + k) * src_ld + on0 + c4);
            float* t = tile + k * 33 + c4; t[0] = v.x; t[1] = v.y; t[2] = v.z; t[3] = v.w;
        }
    }
    __syncthreads();
    const int n = tid >> 4, kc = (tid & 15) * 8;
    float f[8];
#pragma unroll
    for (int e = 0; e < 8; ++e) f[e] = zero ? 0.f : tile[(kc + e) * 33 + n];
    u32x4 o; o.x = pk2(f[0], f[1]); o.y = pk2(f[2], f[3]); o.z = pk2(f[4], f[5]); o.w = pk2(f[6], f[7]);
    *(u32x4*)(dst + (size_t)(dn0 + n) * dst_ld + k0 + kc) = o;
    __syncthreads();
}
__device__ __forceinline__ void phase_weights(const Params& p, int l, unsigned char* lds) {
    float* tile = (float*)lds;
    for (int it = blockIdx.x; it < 3776; it += gridDim.x) {
        if (it < 2752) {
            const int nt = it >> 3, kt = it & 7, dn0 = nt * 32;
            wt_tile(p.w_in + (size_t)l * 1024 * NIN, NIN, kt * 128, orig_col(dn0), (bf16_t*)(p.ws + OFF_WTIN), 1024, dn0, dn0 >= NIN, tile);
        } else if (it < 3264) {
            const int r = it - 2752, j = r >> 7, nt = (r >> 2) & 31, kt = r & 3;
            wt_tile(p.w_br + (size_t)(l * 4 + j) * 512 * 1024, 1024, kt * 128, nt * 32, (bf16_t*)(p.ws + OFF_WTBR) + (size_t)j * 1024 * 512, 512, nt * 32, false, tile);
        } else if (it < 3520) {
            const int r = it - 3264, nt = r >> 3, kt = r & 7;
            wt_tile(p.w_out + (size_t)l * 1024 * 1024, 1024, kt * 128, nt * 32, (bf16_t*)(p.ws + OFF_WTOUT), 1024, nt * 32, false, tile);
        } else {
            const int r = it - 3520, nt = r >> 3, kt = r & 7;
            wt_tile(p.mem_w_kv + (size_t)l * 1024 * 1024, 1024, kt * 128, nt * 32, (bf16_t*)(p.ws + OFF_WTKV), 1024, nt * 32, false, tile);
        }
    }
}

__device__ __forceinline__ void phase_filter_gen(const Params& p, int l, unsigned char* lds) {
    float* zt = (float*)lds;
    float* ha = zt + 32 * 33;
    float* hbuf = ha + 32 * 64;
    int tid_ = threadIdx.x; asm volatile("" : "+v"(tid_)); const int tid = tid_;
    const float* w1 = p.hy_w1 + (size_t)l * 33 * 64; const float* b1 = p.hy_b1 + l * 64;
    const float* wm = p.hy_wm + (size_t)l * 2 * 64 * 64; const float* bm = p.hy_bm + l * 2 * 64;
    const float* w3 = p.hy_w3 + (size_t)l * 64 * 1024;
    float* hf = (float*)(p.ws + OFF_HFILT);
    float* en = (float*)(p.ws + OFF_ENERGY) + l * 512;
    const float* ztab = (const float*)(p.ws + OFF_ZT);
    for (int it = blockIdx.x; it < 256; it += gridDim.x) {
        const int n0 = it * 32;
        for (int idx = tid; idx < 32 * 33; idx += NTHR) zt[idx] = ztab[(size_t)n0 * 33 + idx];
        __syncthreads();
        for (int idx = tid; idx < 2048; idx += NTHR) {
            const int pos = idx >> 6, j = idx & 63; float s = b1[j];
            for (int e = 0; e < 33; ++e) s += zt[pos * 33 + e] * w1[e * 64 + j];
            ha[idx] = sinf(s);
        }
        __syncthreads();
        for (int idx = tid; idx < 2048; idx += NTHR) {
            const int pos = idx >> 6, j = idx & 63; float s = bm[j];
            for (int e = 0; e < 64; ++e) s += ha[pos * 64 + e] * wm[e * 64 + j];
            hbuf[idx] = sinf(s);
        }
        __syncthreads();
        for (int idx = tid; idx < 2048; idx += NTHR) {
            const int pos = idx >> 6, j = idx & 63; float s = bm[64 + j];
            for (int e = 0; e < 64; ++e) s += hbuf[pos * 64 + e] * wm[4096 + e * 64 + j];
            ha[idx] = sinf(s);
        }
        __syncthreads();
        {
            const int c = tid;
            float af[32], ab[32];
#pragma unroll
            for (int i = 0; i < 32; ++i) { af[i] = 0.f; ab[i] = 0.f; }
            for (int k = 0; k < 64; ++k) {
                const float wf = w3[k * 1024 + c], wb = w3[k * 1024 + 512 + c];
#pragma unroll
                for (int i = 0; i < 32; ++i) { const float h = ha[i * 64 + k]; af[i] += h * wf; ab[i] += h * wb; }
            }
            const float dmin = -3.0701134573253945f, dmax = -15.350567286626973f;
            const float delta = fabsf(dmin + (float)c * ((dmax - dmin) / 511.0f));
            float e = 0.f;
#pragma unroll
            for (int i = 0; i < 32; ++i) {
                const int n = n0 + i; const float t01 = (float)n / 8191.0f; const float win = expf(-t01 * delta);
                af[i] *= win; ab[i] *= win; e += af[i] * af[i]; if (n >= 1) e += ab[i] * ab[i];
            }
#pragma unroll
            for (int i = 0; i < 8; ++i) {
                float4 a; a.x = af[4 * i]; a.y = af[4 * i + 1]; a.z = af[4 * i + 2]; a.w = af[4 * i + 3];
                float4 b; b.x = ab[4 * i]; b.y = ab[4 * i + 1]; b.z = ab[4 * i + 2]; b.w = ab[4 * i + 3];
                *(float4*)(hf + (size_t)c * 8192 + n0 + 4 * i) = a;
                *(float4*)(hf + (size_t)(512 + c) * 8192 + n0 + 4 * i) = b;
            }
            atomicAdd(en + c, e);
        }
        __syncthreads();
    }
}

__device__ __forceinline__ void phase_filter_fft(const Params& p, int l, unsigned char* lds) {
    float2* d = (float2*)lds;
    const float2* tw = fft_lds_twiddles((const float2*)(p.ws + OFF_TW), lds);
    const float* hf = (const float*)(p.ws + OFF_HFILT);
    const float* en = (const float*)(p.ws + OFF_ENERGY) + l * 512;
    float4* pqa = (float4*)(p.ws + OFF_PQ);
    int tid_ = threadIdx.x; asm volatile("" : "+v"(tid_)); const int tid = tid_;
    for (int pr = blockIdx.x; pr < 256; pr += gridDim.x) {
        const int c0 = 2 * pr, c1 = c0 + 1;
        const float s0 = 1.0f / sqrtf(en[c0] + 1e-6f), s1 = 1.0f / sqrtf(en[c1] + 1e-6f);
        const float k0 = p.hy_skip[l * 512 + c0], k1 = p.hy_skip[l * 512 + c1];
        for (int n = tid; n < FN; n += NTHR) {
            float2 v;
            if (n < 8192) { v.x = hf[(size_t)c0 * 8192 + n] * s0; v.y = hf[(size_t)c1 * 8192 + n] * s1; if (n == 0) { v.x += k0; v.y += k1; } }
            else if (n == 8192) { v.x = 0.f; v.y = 0.f; }
            else { v.x = hf[(size_t)(512 + c0) * 8192 + (FN - n)] * s0; v.y = hf[(size_t)(512 + c1) * 8192 + (FN - n)] * s1; }
            d[n] = v;
        }
        __syncthreads();
        fft_forward<false>(d, tw, (const float2*)(p.ws + OFF_TW));
        for (int kf = tid; kf <= FN / 2; kf += NTHR) filt_pointwise(d, pqa + (size_t)pr * FN, kf);
        __syncthreads();
    }
}

__device__ __forceinline__ void hy_pre_item(const Params& p, int l, const bf16_t* P, float* UT, bf16_t* GT, int bl, int tt, int ct, unsigned char* lds) {
    float* tU = (float*)lds;
    float* tG = tU + 64 * 65;
    int tid_ = threadIdx.x; asm volatile("" : "+v"(tid_)); const int tid = tid_;
    const int t = tid >> 3, cc = (tid & 7) * 8, c = ct * 64 + cc, tb = tt * 64 + t;
    const float* cw = p.hy_conv_w + (size_t)l * 3 * 1536; const float* cb = p.hy_conv_b + l * 1536;
    float av[8], a0[8], a1[8];
#pragma unroll
    for (int h = 0; h < 2; ++h) {
        const f32x4 bv = *(const f32x4*)(cb + c + 4 * h), b0 = *(const f32x4*)(cb + 512 + c + 4 * h), b1 = *(const f32x4*)(cb + 1024 + c + 4 * h);
#pragma unroll
        for (int e = 0; e < 4; ++e) { av[4 * h + e] = bv[e]; a0[4 * h + e] = b0[e]; a1[4 * h + e] = b1[e]; }
    }
#pragma unroll
    for (int j = 0; j < 3; ++j) {
        const int ts = tb + j - 1;
        if (ts >= 0 && ts < SEQ) {
            const bf16_t* row = P + (size_t)(bl * SEQ + ts) * PS + C_HY + c;
            const u32x4 rv = *(const u32x4*)row, r0 = *(const u32x4*)(row + 512), r1 = *(const u32x4*)(row + 1024);
#pragma unroll
            for (int h = 0; h < 2; ++h) {
                const f32x4 wv = *(const f32x4*)(cw + j * 1536 + c + 4 * h), w0 = *(const f32x4*)(cw + j * 1536 + 512 + c + 4 * h), w1 = *(const f32x4*)(cw + j * 1536 + 1024 + c + 4 * h);
#pragma unroll
                for (int e = 0; e < 4; ++e) {
                    const int k = 4 * h + e; const unsigned uv = rv[k >> 1], u0 = r0[k >> 1], u1 = r1[k >> 1];
                    av[k] += wv[e] * ((k & 1) ? hi16(uv) : lo16(uv)); a0[k] += w0[e] * ((k & 1) ? hi16(u0) : lo16(u0)); a1[k] += w1[e] * ((k & 1) ? hi16(u1) : lo16(u1));
                }
            }
        }
    }
    const u32x4 rz = *(const u32x4*)(P + (size_t)(bl * SEQ + tb) * PS + C_Z + 512 + c);
#pragma unroll
    for (int k = 0; k < 8; ++k) {
        const unsigned uz = rz[k >> 1]; const float z = (k & 1) ? hi16(uz) : lo16(uz);
        tU[(cc + k) * 65 + t] = av[k] * a1[k]; tG[(cc + k) * 65 + t] = a0[k] * z;
    }
    __syncthreads();
    const int c2 = tid >> 3, t8 = (tid & 7) * 8;
    const size_t o = (size_t)(bl * 512 + ct * 64 + c2) * SEQ + tt * 64 + t8;
    const float* su = tU + c2 * 65 + t8; const float* sg = tG + c2 * 65 + t8;
    f32x4 ua = {su[0], su[1], su[2], su[3]}, ub = {su[4], su[5], su[6], su[7]};
    *(f32x4*)(UT + o) = ua; *(f32x4*)(UT + o + 4) = ub;
    u32x4 g; g.x = pk2(sg[0], sg[1]); g.y = pk2(sg[2], sg[3]); g.z = pk2(sg[4], sg[5]); g.w = pk2(sg[6], sg[7]);
    *(u32x4*)(GT + o) = g;
    __syncthreads();
}
__device__ __forceinline__ void hy_post_item(bf16_t* P, const bf16_t* GT, int bl, int tt, int ct, unsigned char* lds, int dry = 0) {
    bf16_t* tl = (bf16_t*)lds;
    int tid_ = threadIdx.x; asm volatile("" : "+v"(tid_)); const int tid = tid_;
    const int c2 = tid >> 3, t8 = (tid & 7) * 8;
    const u32x4 v = *(const u32x4*)(GT + (size_t)(bl * 512 + ct * 64 + c2) * SEQ + tt * 64 + t8);
    bf16_t* d0 = tl + t8 * 72 + c2;
    d0[0 * 72] = (bf16_t)(v.x & 0xffffu); d0[1 * 72] = (bf16_t)(v.x >> 16); d0[2 * 72] = (bf16_t)(v.y & 0xffffu); d0[3 * 72] = (bf16_t)(v.y >> 16);
    d0[4 * 72] = (bf16_t)(v.z & 0xffffu); d0[5 * 72] = (bf16_t)(v.z >> 16); d0[6 * 72] = (bf16_t)(v.w & 0xffffu); d0[7 * 72] = (bf16_t)(v.w >> 16);
    __syncthreads();
    const int t = tid >> 3, cc = (tid & 7) * 8;
    const u32x4 ov = *(const u32x4*)(tl + t * 72 + cc);
    if (!dry) *(u32x4*)(P + (size_t)(bl * SEQ + tt * 64 + t) * PS + C_HY + ct * 64 + cc) = ov;
    __syncthreads();
}
__device__ __forceinline__ void hyena_conv_item(const Params& p, const float* UT, bf16_t* GT, int bl, int pr, unsigned char* lds, const float2* tw, int dry = 0) {
    float2* d = (float2*)lds;
    const float4* pq = (const float4*)(p.ws + OFF_PQ) + (size_t)pr * FN;
    int tid_ = threadIdx.x; asm volatile("" : "+v"(tid_)); const int tid = tid_;
    const float* u0 = UT + (size_t)(bl * 512 + 2 * pr) * SEQ; const float* u1 = u0 + SEQ;
    bf16_t* g0 = GT + (size_t)(bl * 512 + 2 * pr) * SEQ; bf16_t* g1 = g0 + SEQ;
    {
        float f0[16], f1[16];
#pragma unroll
        for (int i = 0; i < 16; ++i) { f0[i] = u0[tid + NTHR * i]; f1[i] = u1[tid + NTHR * i]; }
#pragma unroll
        for (int i = 0; i < 16; ++i) {
            float2 u; u.x = f0[i]; u.y = f1[i]; d[tid + NTHR * i] = u;
        }
    }
    __syncthreads();
    fft_forward<true>(d, tw, (const float2*)(p.ws + OFF_TW));
#pragma unroll 1
    for (int kf = tid; kf < FN / 2; kf += 4 * NTHR) {
        PwIn w0, w1, w2, w3;
        pw_load(w0, d, pq, kf); pw_load(w1, d, pq, kf + NTHR); pw_load(w2, d, pq, kf + 2 * NTHR); pw_load(w3, d, pq, kf + 3 * NTHR);
        pw_store(w0, d); pw_store(w1, d); pw_store(w2, d); pw_store(w3, d);
    }
    if (tid == 0) conv_pointwise(d, pq, FN / 2);
    __syncthreads();
    fft_inverse<true>(d, tw, (const float2*)(p.ws + OFF_TW));
    {
        bf16_t a0[16], a1[16];
#pragma unroll
        for (int i = 0; i < 16; ++i) { a0[i] = g0[tid + NTHR * i]; a1[i] = g1[tid + NTHR * i]; }
#pragma unroll
        for (int i = 0; i < 16; ++i) {
            const int t = tid + NTHR * i;
            const float2 y = d[t];
            const bf16_t r0 = f2bf(y.x * bf2f(a0[i])), r1 = f2bf(y.y * bf2f(a1[i]));
            if (!dry) { g0[t] = r0; g1[t] = r1; }
        }
    }
    __syncthreads();
}

__device__ __forceinline__ void na_item(const Params& p, int l, bf16_t* P, int bl, int rp, int head, unsigned char* lds, int dry = 0) {
    bf16_t* Kimg = (bf16_t*)lds;
    bf16_t* VT = (bf16_t*)(lds + 82944);
    int tid_ = threadIdx.x; asm volatile("" : "+v"(tid_)); const int tid = tid_, lane = tid & 63, w = tid >> 6, l15 = lane & 15, q4 = lane >> 4;
    const int r0 = 2 * rp, rs0 = iclamp(r0 - 4, 0, 120);
#pragma unroll
    for (int i = 0; i < 9; ++i) {
        const int idx = tid + NTHR * i, key = idx >> 3, ch = idx & 7, grow = min(rs0 + (key >> 6), 127);
        const u32x4 kv = *(const u32x4*)(P + (size_t)(bl * SEQ + grow * 64 + (key & 63)) * PS + C_NAK + head * 64 + ch * 8);
        *(u32x4*)(Kimg + key * 72 + ch * 8) = kv;
    }
#pragma unroll
    for (int i = 0; i < 9; ++i) {
        const int idx = tid + NTHR * i, keyp = idx >> 2, chh = keyp >= 576 ? 1 : 0, key = keyp - chh * 576, ch = chh * 4 + (idx & 3), grow = min(rs0 + (key >> 6), 127);
        const u32x4 vv = *(const u32x4*)(P + (size_t)(bl * SEQ + grow * 64 + (key & 63)) * PS + C_NAV + head * 64 + ch * 8);
        bf16_t* vd = VT + (ch * 8) * 584 + key;
        vd[0 * 584] = (bf16_t)(vv.x & 0xffffu); vd[1 * 584] = (bf16_t)(vv.x >> 16);
        vd[2 * 584] = (bf16_t)(vv.y & 0xffffu); vd[3 * 584] = (bf16_t)(vv.y >> 16);
        vd[4 * 584] = (bf16_t)(vv.z & 0xffffu); vd[5 * 584] = (bf16_t)(vv.z >> 16);
        vd[6 * 584] = (bf16_t)(vv.w & 0xffffu); vd[7 * 584] = (bf16_t)(vv.w >> 16);
    }
    __syncthreads();
    const int rr = w >> 2, g = w & 3, r = r0 + rr, rs = iclamp(r - 4, 0, 120), lo = rs - rs0;
    const int cb = iclamp(16 * g - 8, 0, 32), c = 16 * g + l15, cs = iclamp(c - 8, 0, 48);
    bf16_t* qrow = P + (size_t)(bl * SEQ + r * 64 + c) * PS + head * 64;
    bf16x8 qf[2];
#pragma unroll
    for (int ks = 0; ks < 2; ++ks) qf[ks] = *(const bf16x8*)(qrow + ks * 32 + q4 * 8);
    f32x4 sc[16];
#pragma unroll
    for (int t = 0; t < 16; ++t) {
        const int kb = (lo + (t >> 1)) * 64 + cb + 16 * (t & 1);
        f32x4 a = {0.f, 0.f, 0.f, 0.f};
#pragma unroll
        for (int ks = 0; ks < 2; ++ks) { const bf16x8 kf = *(const bf16x8*)(Kimg + (kb + l15) * 72 + ks * 32 + q4 * 8); a = MFMA(kf, qf[ks], a); }
        sc[t] = a;
    }
    const float* rpb = p.na_rpb + (size_t)(l * 8 + head) * 15 * 31;
    float mx = -1e30f;
#pragma unroll
    for (int t = 0; t < 16; ++t) {
        const int drow = rs + (t >> 1) - r + 7;
#pragma unroll
        for (int e = 0; e < 4; ++e) {
            const int col = cb + 16 * (t & 1) + 4 * q4 + e;
            const bool ok = (col >= cs) && (col < cs + 16);
            const int dcol = ok ? (col - c + 15) : 0;
            const float v = ok ? (sc[t][e] + rpb[drow * 31 + dcol]) : -1e30f;
            sc[t][e] = v; mx = fmaxf(mx, v);
        }
    }
    mx = fmaxf(mx, __shfl_xor(mx, 16)); mx = fmaxf(mx, __shfl_xor(mx, 32));
    float sum = 0.f;
#pragma unroll
    for (int t = 0; t < 16; ++t)
#pragma unroll
        for (int e = 0; e < 4; ++e) { const float pe = __expf(sc[t][e] - mx); sc[t][e] = pe; sum += pe; }
    sum += __shfl_xor(sum, 16); sum += __shfl_xor(sum, 32);
    f32x4 o[4];
#pragma unroll
    for (int dt = 0; dt < 4; ++dt) o[dt] = (f32x4){0.f, 0.f, 0.f, 0.f};
#pragma unroll
    for (int kk = 0; kk < 8; ++kk) {
        u32x4 pu; pu.x = pk2(sc[2 * kk][0], sc[2 * kk][1]); pu.y = pk2(sc[2 * kk][2], sc[2 * kk][3]); pu.z = pk2(sc[2 * kk + 1][0], sc[2 * kk + 1][1]); pu.w = pk2(sc[2 * kk + 1][2], sc[2 * kk + 1][3]);
        const bf16x8 pf = mkfrag(pu);
        const int kbA = (lo + kk) * 64 + cb + 4 * q4;
#pragma unroll
        for (int dt = 0; dt < 4; ++dt) {
            const bf16_t* vr = VT + (dt * 16 + l15) * 584 + kbA;
            const bf16x8 vf = mkfrag2(*(const u32x2*)vr, *(const u32x2*)(vr + 16));
            o[dt] = MFMA(vf, pf, o[dt]);
        }
    }
    const float inv = 1.0f / sum;
    const bf16_t* zrow = P + (size_t)(bl * SEQ + r * 64 + c) * PS + C_Z + head * 64;
#pragma unroll
    for (int dt = 0; dt < 4; ++dt) {
        const int dd = dt * 16 + 4 * q4;
        const f32x4 z = ld_bf4(zrow + dd);
        if (!dry) st_bf4(qrow + dd, o[dt] * inv * z);
    }
    __syncthreads();
}

__device__ __forceinline__ void memattn_load(const Params& p, int b, int h, unsigned char* lds) {
    bf16_t* Kimg = (bf16_t*)lds;
    bf16_t* VT = (bf16_t*)(lds + 69632);
    const bf16_t* Km = (const bf16_t*)(p.ws + OFF_KMAT); const bf16_t* Vm = (const bf16_t*)(p.ws + OFF_VT);
    int tid_ = threadIdx.x; asm volatile("" : "+v"(tid_)); const int tid = tid_;
#pragma unroll
    for (int i = 0; i < 8; ++i) {
        const int idx = tid + NTHR * i;
        { const int key = idx >> 4, ch = idx & 15; *(u32x4*)(Kimg + key * 136 + ch * 8) = *(const u32x4*)(Km + (size_t)(b * 256 + key) * 512 + h * 128 + ch * 8); }
        { const int dd = idx >> 5, ch = idx & 31; *(u32x4*)(VT + dd * 264 + ch * 8) = *(const u32x4*)(Vm + (size_t)(h * 128 + dd) * 2048 + b * 256 + ch * 8); }
    }
    __syncthreads();
}
__device__ __forceinline__ void memattn_item(bf16_t* P, int bl, int h, int qt, unsigned char* lds, int dry = 0) {
    const bf16_t* Kimg = (const bf16_t*)lds; const bf16_t* VT = (const bf16_t*)(lds + 69632);
    int tid_ = threadIdx.x; asm volatile("" : "+v"(tid_)); const int tid = tid_, lane = tid & 63, w = tid >> 6, l15 = lane & 15, q4 = lane >> 4;
    const int tok = bl * SEQ + qt * 128 + w * 16 + l15;
    bf16_t* qrow = P + (size_t)tok * PS + C_MQ + h * 128;
    bf16x8 qf[4];
#pragma unroll
    for (int ks = 0; ks < 4; ++ks) qf[ks] = *(const bf16x8*)(qrow + ks * 32 + q4 * 8);
    f32x4 sc[16];
    float mx = -1e30f;
#pragma unroll
    for (int t = 0; t < 16; ++t) {
        f32x4 a = {0.f, 0.f, 0.f, 0.f};
#pragma unroll
        for (int ks = 0; ks < 4; ++ks) { const bf16x8 kf = *(const bf16x8*)(Kimg + (t * 16 + l15) * 136 + ks * 32 + q4 * 8); a = MFMA(kf, qf[ks], a); }
        sc[t] = a;
        mx = fmaxf(mx, fmaxf(fmaxf(a[0], a[1]), fmaxf(a[2], a[3])));
    }
    mx = fmaxf(mx, __shfl_xor(mx, 16)); mx = fmaxf(mx, __shfl_xor(mx, 32));
    float sum = 0.f;
#pragma unroll
    for (int t = 0; t < 16; ++t)
#pragma unroll
        for (int e = 0; e < 4; ++e) { const float pe = __expf(sc[t][e] - mx); sc[t][e] = pe; sum += pe; }
    sum += __shfl_xor(sum, 16); sum += __shfl_xor(sum, 32);
    f32x4 o[8];
#pragma unroll
    for (int dt = 0; dt < 8; ++dt) o[dt] = (f32x4){0.f, 0.f, 0.f, 0.f};
#pragma unroll
    for (int kk = 0; kk < 8; ++kk) {
        u32x4 pu; pu.x = pk2(sc[2 * kk][0], sc[2 * kk][1]); pu.y = pk2(sc[2 * kk][2], sc[2 * kk][3]); pu.z = pk2(sc[2 * kk + 1][0], sc[2 * kk + 1][1]); pu.w = pk2(sc[2 * kk + 1][2], sc[2 * kk + 1][3]);
        const bf16x8 pf = mkfrag(pu);
#pragma unroll
        for (int dt = 0; dt < 8; ++dt) {
            const bf16_t* vr = VT + (dt * 16 + l15) * 264 + kk * 32 + 4 * q4;
            const bf16x8 vf = mkfrag2(*(const u32x2*)vr, *(const u32x2*)(vr + 16));
            o[dt] = MFMA(vf, pf, o[dt]);
        }
    }
    const float inv = 1.0f / sum;
    const bf16_t* zrow = P + (size_t)tok * PS + C_Z + 3 * 512 + h * 128;
#pragma unroll
    for (int dt = 0; dt < 8; ++dt) {
        const int dd = dt * 16 + 4 * q4;
        const f32x4 z = ld_bf4(zrow + dd);
        if (!dry) st_bf4(qrow + dd, o[dt] * inv * z);
    }
}

constexpr int G_LRT = 0, G_BF = 8192, G_BB = 24576, G_TOT = 40960, G_IMG = 45056;
__device__ __forceinline__ void gla_tables(const Params& p, int l, const float* LR, int t0, int h, unsigned char* lds) {
    float* LRT = (float*)(lds + G_LRT); float* BF = (float*)(lds + G_BF); float* BB = (float*)(lds + G_BB); float* TOT = (float*)(lds + G_TOT);
    int tid_ = threadIdx.x; asm volatile("" : "+v"(tid_)); const int tid = tid_;
    ((float4*)LRT)[tid] = ((const float4*)(LR + (size_t)t0 * 32))[tid];
    __syncthreads();
    const int dk = tid & 63, cgp = tid >> 6;
    float uf[16], ub[16];
#pragma unroll
    for (int r = 0; r < 16; ++r) { uf[r] = p.gla_up_f[(size_t)(l * 16 + r) * 256 + h * 64 + dk]; ub[r] = p.gla_up_b[(size_t)(l * 16 + r) * 256 + h * 64 + dk]; }
    const float bif = p.gla_bias_f[l * 256 + h * 64 + dk], bib = p.gla_bias_b[l * 256 + h * 64 + dk];
    float lf[8], lb[8];
#pragma unroll
    for (int i = 0; i < 8; ++i) {
        const int c = cgp * 8 + i; float sf = bif, sb = bib;
#pragma unroll
        for (int r = 0; r < 16; ++r) { sf += LRT[c * 32 + r] * uf[r]; sb += LRT[c * 32 + 16 + r] * ub[r]; }
        lf[i] = logsigf_(sf) * (1.0f / 16.0f); lb[i] = logsigf_(sb) * (1.0f / 16.0f);
    }
#pragma unroll
    for (int i = 1; i < 8; ++i) lf[i] += lf[i - 1];
#pragma unroll
    for (int i = 6; i >= 0; --i) lb[i] += lb[i + 1];
    TOT[cgp * 64 + dk] = lf[7]; TOT[512 + cgp * 64 + dk] = lb[0];
    __syncthreads();
    float of = 0.f, ob = 0.f;
#pragma unroll
    for (int g2 = 0; g2 < 8; ++g2) { if (g2 < cgp) of += TOT[g2 * 64 + dk]; if (g2 > cgp) ob += TOT[512 + g2 * 64 + dk]; }
#pragma unroll
    for (int i = 0; i < 8; ++i) { BF[(cgp * 8 + i) * 64 + dk] = lf[i] + of; BB[(cgp * 8 + i) * 64 + dk] = lb[i] + ob; }
    __syncthreads();
}
struct GlaPre { u32x4 vv[2]; bf16_t q[8], k[8]; };
__device__ __forceinline__ void gla_prefetch(GlaPre& g, const bf16_t* P, int t0, int h, int tid) {
#pragma unroll
    for (int i = 0; i < 2; ++i) { const int idx = tid + NTHR * i, chn = idx >> 6, c = idx & 63; g.vv[i] = *(const u32x4*)(P + (size_t)(t0 + c) * PS + C_GV + h * 128 + chn * 8); }
#pragma unroll
    for (int i = 0; i < 8; ++i) { const int idx = tid + NTHR * i, c = idx >> 6, dk = idx & 63; g.q[i] = P[(size_t)(t0 + c) * PS + C_GQ + h * 64 + dk]; g.k[i] = P[(size_t)(t0 + c) * PS + C_GK + h * 64 + dk]; }
}
__device__ __forceinline__ void gla_vt_store(const GlaPre& g, bf16_t* VT, int tid) {
#pragma unroll
    for (int i = 0; i < 2; ++i) {
        const int idx = tid + NTHR * i, chn = idx >> 6, c = idx & 63;
        const u32x4 vv = g.vv[i];
        bf16_t* vd = VT + (chn * 8) * 72 + c;
        vd[0 * 72] = (bf16_t)(vv.x & 0xffffu); vd[1 * 72] = (bf16_t)(vv.x >> 16);
        vd[2 * 72] = (bf16_t)(vv.y & 0xffffu); vd[3 * 72] = (bf16_t)(vv.y >> 16);
        vd[4 * 72] = (bf16_t)(vv.z & 0xffffu); vd[5 * 72] = (bf16_t)(vv.z >> 16);
        vd[6 * 72] = (bf16_t)(vv.w & 0xffffu); vd[7 * 72] = (bf16_t)(vv.w >> 16);
    }
}
__device__ __forceinline__ void gla_part1_item(const Params& p, int l, const bf16_t* P, const float* LR, int item, unsigned char* lds) {
    const int h = item & 3, n = (item >> 2) & 127, bl = item >> 9, t0 = bl * SEQ + n * 64;
    const float* BF = (const float*)(lds + G_BF); const float* BB = (const float*)(lds + G_BB);
    bf16_t* KDT0 = (bf16_t*)(lds + G_IMG); bf16_t* KDT1 = KDT0 + 64 * 72; bf16_t* VT = KDT1 + 64 * 72;
    float* GS = (float*)(p.ws + OFF_GS); float* GD = (float*)(p.ws + OFF_GDEC);
    int tid_ = threadIdx.x; asm volatile("" : "+v"(tid_)); const int tid = tid_, lane = tid & 63, w = tid >> 6, l15 = lane & 15, q4 = lane >> 4;
    GlaPre gp; gla_prefetch(gp, P, t0, h, tid);
    gla_tables(p, l, LR, t0, h, lds);
#pragma unroll
    for (int i = 0; i < 8; ++i) {
        const int idx = tid + NTHR * i, c = idx >> 6, dk = idx & 63;
        const float kv = bf2f(gp.k[i]);
        KDT0[dk * 72 + c] = f2bf(kv * __expf(BF[63 * 64 + dk] - BF[c * 64 + dk]));
        KDT1[dk * 72 + c] = f2bf(kv * __expf(BB[dk] - BB[c * 64 + dk]));
    }
    gla_vt_store(gp, VT, tid);
    if (tid < 64) GD[(size_t)item * 64 + tid] = __expf(BF[63 * 64 + tid]);
    else if (tid < 128) GD[(size_t)(NITEM + item) * 64 + tid - 64] = __expf(BB[tid - 64]);
    __syncthreads();
    const int dir = w >> 2, dkt = w & 3;
    const bf16_t* KD = dir ? KDT1 : KDT0;
    bf16x8 kf[2];
#pragma unroll
    for (int ks = 0; ks < 2; ++ks) kf[ks] = *(const bf16x8*)(KD + (16 * dkt + l15) * 72 + 32 * ks + 8 * q4);
    float* dst = GS + ((size_t)dir * NITEM + item) * 8192;
#pragma unroll
    for (int dvt = 0; dvt < 8; ++dvt) {
        f32x4 a = {0.f, 0.f, 0.f, 0.f};
#pragma unroll
        for (int ks = 0; ks < 2; ++ks) { const bf16x8 vf = *(const bf16x8*)(VT + (16 * dvt + l15) * 72 + 32 * ks + 8 * q4); a = MFMA(kf[ks], vf, a); }
        *(f32x4*)(dst + (16 * dvt + l15) * 64 + 16 * dkt + 4 * q4) = a;
    }
    __syncthreads();
}
__device__ __forceinline__ void gla_scan(const Params& p, int dry = 0) {
    float* GS = (float*)(p.ws + OFF_GS); const float* GD = (const float*)(p.ws + OFF_GDEC);
    const int total = 2 * BG * 4 * 8192;
    int tid_ = threadIdx.x; asm volatile("" : "+v"(tid_));
    for (int id = blockIdx.x * NTHR + tid_; id < total; id += gridDim.x * NTHR) {
        const int e = id & 8191, comb = id >> 13, h = comb & 3, bl = (comb >> 2) % BG, dir = comb / (4 * BG), dk = e & 63;
        float S = 0.f;
        const size_t ibase = (size_t)dir * NITEM + (size_t)(bl * 128) * 4 + h;
        for (int s0 = 0; s0 < 128; s0 += 16) {
            float u[16], dc[16];
#pragma unroll
            for (int i = 0; i < 16; ++i) {
                const int n = dir ? 127 - (s0 + i) : s0 + i;
                const size_t item = ibase + (size_t)n * 4;
                u[i] = GS[item * 8192 + e]; dc[i] = GD[item * 64 + dk];
            }
#pragma unroll
            for (int i = 0; i < 16; ++i) {
                const int n = dir ? 127 - (s0 + i) : s0 + i;
                const size_t item = ibase + (size_t)n * 4;
                if (!dry) GS[item * 8192 + e] = S;
                S = dc[i] * S + u[i];
            }
        }
    }
}
__device__ __forceinline__ void gla_part2_item(const Params& p, int l, bf16_t* P, const float* LR, int item, unsigned char* lds, int dry = 0) {
    const int h = item & 3, n = (item >> 2) & 127, bl = item >> 9, t0 = bl * SEQ + n * 64;
    const float* BF = (const float*)(lds + G_BF); const float* BB = (const float*)(lds + G_BB);
    bf16_t* QF = (bf16_t*)(lds + G_IMG);
    bf16_t* KF = QF + 2 * 64 * 72;
    bf16_t* QD = KF + 2 * 64 * 72;
    bf16_t* VT = QD + 2 * 64 * 72;
    bf16_t* ST = VT + 128 * 72;
    float* OX = (float*)lds;
    const float* GS = (const float*)(p.ws + OFF_GS);
    int tid_ = threadIdx.x; asm volatile("" : "+v"(tid_)); const int tid = tid_, lane = tid & 63, w = tid >> 6, l15 = lane & 15, q4 = lane >> 4;
    GlaPre gp; gla_prefetch(gp, P, t0, h, tid);
    float4 sp[2][4];
#pragma unroll
    for (int dir = 0; dir < 2; ++dir)
#pragma unroll
        for (int i = 0; i < 4; ++i) { const int idx = tid + NTHR * i; sp[dir][i] = *(const float4*)(GS + ((size_t)dir * NITEM + item) * 8192 + (idx >> 4) * 64 + (idx & 15) * 4); }
    gla_tables(p, l, LR, t0, h, lds);
#pragma unroll
    for (int i = 0; i < 8; ++i) {
        const int idx = tid + NTHR * i, c = idx >> 6, dk = idx & 63;
        const float qv = bf2f(gp.q[i]);
        const float kv = bf2f(gp.k[i]);
        const float bf = BF[c * 64 + dk], mf = BF[31 * 64 + dk], bb = BB[c * 64 + dk], mb = BB[32 * 64 + dk];
        QF[c * 72 + dk] = f2bf(qv * __expf(bf - mf)); KF[c * 72 + dk] = f2bf(kv * __expf(mf - bf)); QD[c * 72 + dk] = f2bf(qv * __expf(bf));
        QF[4608 + c * 72 + dk] = f2bf(qv * __expf(bb - mb)); KF[4608 + c * 72 + dk] = f2bf(kv * __expf(mb - bb)); QD[4608 + c * 72 + dk] = f2bf(qv * __expf(bb));
    }
    gla_vt_store(gp, VT, tid);
#pragma unroll
    for (int dir = 0; dir < 2; ++dir) {
#pragma unroll
        for (int i = 0; i < 4; ++i) {
            const int idx = tid + NTHR * i, dv = idx >> 4, dk4 = (idx & 15) * 4;
            const float4 s = sp[dir][i];
            u32x2 o; o.x = pk2(s.x, s.y); o.y = pk2(s.z, s.w);
            *(u32x2*)(ST + dir * 9216 + dv * 72 + dk4) = o;
        }
    }
    __syncthreads();
    const int dir = w >> 2, ct = w & 3;
    const bf16_t* qfp = QF + dir * 4608; const bf16_t* kfp = KF + dir * 4608; const bf16_t* qdp = QD + dir * 4608; const bf16_t* stp = ST + dir * 9216;
    bf16x8 qf[2], qd[2];
#pragma unroll
    for (int ks = 0; ks < 2; ++ks) { qf[ks] = *(const bf16x8*)(qfp + (16 * ct + l15) * 72 + 32 * ks + 8 * q4); qd[ks] = *(const bf16x8*)(qdp + (16 * ct + l15) * 72 + 32 * ks + 8 * q4); }
    f32x4 sc[4];
    const int cq = 16 * ct + l15;
#pragma unroll
    for (int st = 0; st < 4; ++st) {
        f32x4 a = {0.f, 0.f, 0.f, 0.f};
#pragma unroll
        for (int ks = 0; ks < 2; ++ks) { const bf16x8 kf = *(const bf16x8*)(kfp + (16 * st + l15) * 72 + 32 * ks + 8 * q4); a = MFMA(kf, qf[ks], a); }
#pragma unroll
        for (int e = 0; e < 4; ++e) { const int s = 16 * st + 4 * q4 + e; const bool ok = dir ? (s > cq) : (s <= cq); a[e] = ok ? a[e] : 0.f; }
        sc[st] = a;
    }
    f32x4 o[8];
#pragma unroll
    for (int dt = 0; dt < 8; ++dt) o[dt] = (f32x4){0.f, 0.f, 0.f, 0.f};
#pragma unroll
    for (int kk = 0; kk < 2; ++kk) {
        u32x4 pu; pu.x = pk2(sc[2 * kk][0], sc[2 * kk][1]); pu.y = pk2(sc[2 * kk][2], sc[2 * kk][3]); pu.z = pk2(sc[2 * kk + 1][0], sc[2 * kk + 1][1]); pu.w = pk2(sc[2 * kk + 1][2], sc[2 * kk + 1][3]);
        const bf16x8 pf = mkfrag(pu);
#pragma unroll
        for (int dt = 0; dt < 8; ++dt) {
            const bf16_t* vr = VT + (dt * 16 + l15) * 72 + kk * 32 + 4 * q4;
            const bf16x8 vf = mkfrag2(*(const u32x2*)vr, *(const u32x2*)(vr + 16));
            o[dt] = MFMA(vf, pf, o[dt]);
        }
    }
#pragma unroll
    for (int ks = 0; ks < 2; ++ks)
#pragma unroll
        for (int dt = 0; dt < 8; ++dt) { const bf16x8 sf = *(const bf16x8*)(stp + (dt * 16 + l15) * 72 + 32 * ks + 8 * q4); o[dt] = MFMA(sf, qd[ks], o[dt]); }
    if (dir == 1) {
#pragma unroll
        for (int dt = 0; dt < 8; ++dt) *(f32x4*)(OX + cq * 132 + 16 * dt + 4 * q4) = o[dt];
    }
    __syncthreads();
    if (dir == 0) {
        float ss = 0.f;
#pragma unroll
        for (int dt = 0; dt < 8; ++dt) { o[dt] += *(const f32x4*)(OX + cq * 132 + 16 * dt + 4 * q4); ss += (o[dt][0] * o[dt][0] + o[dt][1] * o[dt][1]) + (o[dt][2] * o[dt][2] + o[dt][3] * o[dt][3]); }
        ss += __shfl_xor(ss, 16); ss += __shfl_xor(ss, 32);
        const float rms = 1.0f / sqrtf(ss * (1.0f / 128.0f) + 1e-6f);
        const float* ng = p.gla_norm_g + l * 512 + h * 128;
        const bf16_t* zrow = P + (size_t)(t0 + cq) * PS + C_Z + 2 * 512 + h * 128;
        bf16_t* orow = P + (size_t)(t0 + cq) * PS + C_GV + h * 128;
#pragma unroll
        for (int dt = 0; dt < 8; ++dt) {
            const int dd = 16 * dt + 4 * q4;
            const f32x4 z = ld_bf4(zrow + dd); const f32x4 g4 = *(const f32x4*)(ng + dd);
            if (!dry) st_bf4(orow + dd, o[dt] * rms * g4 * z);
        }
    }
    __syncthreads();
}

namespace pg8 {
#define PG8_LAS __attribute__((address_space(3)))
typedef unsigned short bf16_t;
typedef short bf16x8 __attribute__((ext_vector_type(8)));
typedef float f32x4 __attribute__((ext_vector_type(4)));
typedef unsigned u32x4 __attribute__((ext_vector_type(4)));
constexpr int BM = 256, BK = 64, HALF = 128, HTB = HALF * BK * 2  , STAGE_BYTES = 8 * HTB, NXCD = 8, WGM = 8;

__host__ __device__ __forceinline__ int lds_byte(int r, int c) { const int st = (r >> 4) * 2 + (c >> 5), rr = r & 15, cc = c & 31, ob = rr * 64 + cc * 2; return st * 1024 + (ob ^ (((ob >> 9) & 1) << 5)); }
__host__ __device__ __forceinline__ void stage_rc(int b, int& R, int& C) { const int st = b / 1024, sb = b % 1024, swz = sb ^ (((sb >> 9) & 1) << 5); R = (st >> 1) * 16 + swz / 64; C = (st & 1) * 32 + (swz % 64) / 2; }
__host__ __device__ __forceinline__ int perm32(int rho) { const int n = rho >> 4, i = rho & 15; return 8 * (i >> 2) + 4 * n + (i & 3); }

struct Unit { int pm, pn; };
struct Gemm { const bf16_t* A; const bf16_t* Bt; int M, N, K; };

struct StaticOrder {
    int nM, nN, nwg, G, c;
    __host__ __device__ __forceinline__ void init(int M, int N, int G_, int c_) { nM = M / BM; nN = N / BM; nwg = nM * nN; G = G_; c = c_; }
    __host__ __device__ bool next(int i, Unit& u) const {
        const long L = (long)i * G + c; if (L >= nwg) return false;
        int wgid = (int)L; { const int q = nwg / NXCD, r = nwg % NXCD, xcd = wgid % NXCD, off = wgid / NXCD; wgid = (xcd < r ? xcd * (q + 1) : r * (q + 1) + (xcd - r) * q) + off; }
        const int nig = WGM * nN, gid = wgid / nig, fm = gid * WGM, gsz = (nM - fm) < WGM ? (nM - fm) : WGM;
        u.pm = fm + ((wgid % nig) % gsz); u.pn = (wgid % nig) / gsz; return true;
    }
    __device__ __forceinline__ void a_ready(const Unit&) const {}
    __device__ __forceinline__ void done(const Unit&) const {}
};
__device__ __forceinline__ unsigned cvt_pk_bf16(float lo, float hi) { unsigned r; asm volatile("v_cvt_pk_bf16_f32 %0, %1, %2" : "=v"(r) : "v"(lo), "v"(hi)); return r; }
template <class Epi, class Sched, bool STAMP = false>
__device__ __forceinline__ void gemm_phase(PG8_LAS unsigned char* lds, const Gemm g, const Sched& S, const Epi& E, unsigned long long* stamps) {
    int tid_l = threadIdx.x; asm volatile("" : "+v"(tid_l)); const int tid = tid_l, wid = __builtin_amdgcn_readfirstlane(tid >> 6), lane = tid & 63, wr = wid >> 2, wc = wid & 3, fr = lane & 15, fq = lane >> 4;
    const int K = g.K, nt = K / BK;
    int ts_lo = 0, ts_hi = 0, nts = 0; const unsigned long long rt_entry = STAMP ? (unsigned long long)wall_clock64() : 0ull;
#define PG8_STAMP() do { if (STAMP && wid == 0 && nts < 64) { const unsigned long long _c = (unsigned long long)clock64(); \
        ts_lo = (lane == nts) ? (int)(unsigned)_c : ts_lo; ts_hi = (lane == nts) ? (int)(unsigned)(_c >> 32) : ts_hi; ++nts; } } while (0)
    PG8_STAMP();
    unsigned voffA[2], voffB[2];
#pragma unroll
    for (int i = 0; i < 2; ++i) { int R, C; stage_rc(tid * 16 + i * 8192, R, C); const int Rb = Epi::PERM ? ((R & ~31) + perm32(R & 31)) : R;
        voffA[i] = (unsigned)(R * K + C) * 2u; voffB[i] = (unsigned)(Rb * K + C) * 2u; }
    const size_t kstep = (size_t)(BK * 2);
    const size_t hstep = (size_t)HALF * K * 2;
    const size_t tstep = 2 * hstep;
    const unsigned ldsw = (unsigned)wid * 1024u;
    const int aoff = lds_byte(wr * 64 + fr, fq * 8), boff = lds_byte(wc * 32 + fr, fq * 8);
#define PG8_SA(b, h) (((b) * 2 + (h)) * HTB)
#define PG8_SB(b, h) ((4 + (b) * 2 + (h)) * HTB)
#define PG8_STAGE(bufoff, gbase, voff) do { _Pragma("unroll") for (int _i = 0; _i < 2; ++_i) \
        __builtin_amdgcn_global_load_lds((const unsigned*)((const char*)(gbase) + (voff)[_i]), (PG8_LAS unsigned*)(lds + (bufoff) + ldsw + _i * 8192), 16, 0, 0); } while (0)
#define PG8_LDA(dst, b, h) do { _Pragma("unroll") for (int m = 0; m < 4; ++m) _Pragma("unroll") for (int k = 0; k < 2; ++k) dst[m][k] = *(const PG8_LAS bf16x8*)(lds + PG8_SA(b, h) + aoff + m * 2048 + k * 1024); } while (0)
#define PG8_LDB(dst, b, h) do { _Pragma("unroll") for (int n = 0; n < 2; ++n) _Pragma("unroll") for (int k = 0; k < 2; ++k) dst[n][k] = *(const PG8_LAS bf16x8*)(lds + PG8_SB(b, h) + boff + n * 2048 + k * 1024); } while (0)
#define PG8_MMA(ai, bj, At, Bt) do { __builtin_amdgcn_s_setprio(1); _Pragma("unroll") for (int m = 0; m < 4; ++m) _Pragma("unroll") for (int n = 0; n < 2; ++n) _Pragma("unroll") for (int k = 0; k < 2; ++k) \
        acc[ai][bj][m][n] = __builtin_amdgcn_mfma_f32_16x16x32_bf16(Bt[n][k], At[m][k], acc[ai][bj][m][n], 0, 0, 0); __builtin_amdgcn_s_setprio(0); } while (0)
#define PG8_WAIT_V(n) asm volatile("s_waitcnt vmcnt(" #n ")" ::: "memory")
#define PG8_WAIT_L(n) asm volatile("s_waitcnt lgkmcnt(" #n ")" ::: "memory")
#define PG8_BAR __builtin_amdgcn_s_barrier()
#define PG8_SCHED __builtin_amdgcn_sched_barrier(0)
    Unit cur, nxt; int ui = 0;
    if (!S.next(0, cur)) return;
    f32x4 acc[2][2][4][2];
#pragma unroll
    for (int a = 0; a < 2; ++a)
#pragma unroll
        for (int b = 0; b < 2; ++b)
#pragma unroll
            for (int m = 0; m < 4; ++m)
#pragma unroll
                for (int n = 0; n < 2; ++n) acc[a][b][m][n] = (f32x4){0.f, 0.f, 0.f, 0.f};
    bf16x8 At[4][2], B0[2][2], B1[2][2];
    const char* cA = (const char*)g.A + (size_t)cur.pm * tstep; const char* cB = (const char*)g.Bt + (size_t)cur.pn * tstep;
    S.a_ready(cur);
    PG8_STAGE(PG8_SB(0, 0), cB, voffB); PG8_STAGE(PG8_SA(0, 0), cA, voffA); PG8_STAGE(PG8_SB(0, 1), cB + hstep, voffB); PG8_STAGE(PG8_SA(0, 1), cA + hstep, voffA);
    if (wr == 1) PG8_BAR;
    PG8_WAIT_V(4); PG8_BAR;
    PG8_STAGE(PG8_SB(1, 0), cB + kstep, voffB); PG8_STAGE(PG8_SA(1, 0), cA + kstep, voffA); PG8_STAGE(PG8_SB(1, 1), cB + hstep + kstep, voffB);
    PG8_WAIT_V(6); PG8_BAR;
    PG8_STAMP();
    for (;;) {
        const bool has_next = S.next(ui + 1, nxt);
        const char* nA = has_next ? (const char*)g.A + (size_t)nxt.pm * tstep : cA; const char* nB = has_next ? (const char*)g.Bt + (size_t)nxt.pn * tstep : cB;
        for (int t = 0; t < nt; t += 2) {
            const bool last = (t == nt - 2);
            const char* a1 = cA + (size_t)(t + 1) * kstep;
            const char* a2 = last ? nA : cA + (size_t)(t + 2) * kstep; const char* b2 = last ? nB : cB + (size_t)(t + 2) * kstep;
            const char* a3 = a2 + kstep; const char* b3 = b2 + kstep;
            if (last && has_next) S.a_ready(nxt);
            PG8_LDB(B0, 0, 0); PG8_SCHED; PG8_LDA(At, 0, 0); PG8_STAGE(PG8_SA(1, 1), a1 + hstep, voffA);
            PG8_WAIT_L(8); PG8_BAR; PG8_WAIT_L(0); PG8_MMA(0, 0, At, B0); PG8_BAR; PG8_SCHED;
            PG8_LDB(B1, 0, 1); PG8_STAGE(PG8_SB(0, 0), b2, voffB);
            PG8_BAR; PG8_WAIT_L(0); PG8_MMA(0, 1, At, B1); PG8_BAR;
            PG8_LDA(At, 0, 1); PG8_STAGE(PG8_SA(0, 0), a2, voffA);
            PG8_BAR; PG8_WAIT_L(0); PG8_MMA(1, 0, At, B0); PG8_BAR; PG8_SCHED;
            PG8_STAGE(PG8_SB(0, 1), b2 + hstep, voffB);
            PG8_WAIT_V(6); PG8_BAR; PG8_MMA(1, 1, At, B1); PG8_BAR;
            PG8_LDB(B0, 1, 0); PG8_SCHED; PG8_LDA(At, 1, 0); PG8_STAGE(PG8_SA(0, 1), a2 + hstep, voffA);
            PG8_WAIT_L(8); PG8_BAR; PG8_WAIT_L(0); PG8_MMA(0, 0, At, B0); PG8_BAR; PG8_SCHED;
            PG8_LDB(B1, 1, 1); PG8_STAGE(PG8_SB(1, 0), b3, voffB);
            PG8_BAR; PG8_WAIT_L(0); PG8_MMA(0, 1, At, B1); PG8_BAR;
            PG8_LDA(At, 1, 1); PG8_STAGE(PG8_SA(1, 0), a3, voffA);
            PG8_BAR; PG8_WAIT_L(0); PG8_MMA(1, 0, At, B0); PG8_BAR; PG8_SCHED;
            PG8_STAGE(PG8_SB(1, 1), b3 + hstep, voffB);
            PG8_WAIT_V(6); PG8_BAR; PG8_MMA(1, 1, At, B1); PG8_BAR;
        }
        PG8_STAMP();
        if constexpr (!Epi::AFTER_DRAIN) { E(acc, cur, wr, wc, fr, fq); S.done(cur); }
        PG8_STAMP();
        if (!has_next) break;
#pragma unroll
        for (int a = 0; a < 2; ++a)
#pragma unroll
            for (int b = 0; b < 2; ++b)
#pragma unroll
                for (int m = 0; m < 4; ++m)
#pragma unroll
                    for (int n = 0; n < 2; ++n) acc[a][b][m][n] = (f32x4){0.f, 0.f, 0.f, 0.f};
        cur = nxt; cA = nA; cB = nB; ++ui;
    }
    PG8_WAIT_V(0);
    if (wr == 0) PG8_BAR;
    PG8_BAR;
    if constexpr (Epi::AFTER_DRAIN) { E.fused(acc, cur, wr, wc, fr, fq, lds, wid, lane); S.done(cur); }
    PG8_STAMP();
    if (STAMP && wid == 0) { stamps[lane] = lane < nts ? (((unsigned long long)(unsigned)ts_hi << 32) | (unsigned)ts_lo) : 0ull;
        if (lane == 62) stamps[62] = rt_entry; if (lane == 63) stamps[63] = (unsigned long long)wall_clock64(); }
#undef PG8_STAMP
#undef PG8_SA
#undef PG8_SB
#undef PG8_STAGE
#undef PG8_LDA
#undef PG8_LDB
#undef PG8_MMA
#undef PG8_WAIT_V
#undef PG8_WAIT_L
#undef PG8_BAR
#undef PG8_SCHED
}
}

struct EpiInProj {
    static constexpr bool PERM = true, AFTER_DRAIN = false;
    bf16_t* P; const float* bias; float* LR;
    __device__ __forceinline__ void operator()(const f32x4 (&acc)[2][2][4][2], const pg8::Unit& u, int wr, int wc, int fr, int fq) const {
        const int row0 = u.pm * 256 + wr * 64 + fr, colt = u.pn * 256, col0 = colt + wc * 32 + 8 * fq;
        if (colt == C_LR) {
            if (wc == 0) {
                const int cl = 8 * fq;
                const f32x4 b0 = *(const f32x4*)(bias + 4096 + cl), b1 = *(const f32x4*)(bias + 4096 + cl + 4);
#pragma unroll
                for (int ai = 0; ai < 2; ++ai)
#pragma unroll
                    for (int m = 0; m < 4; ++m) {
                        float* d = LR + (size_t)(row0 + ai * 128 + m * 16) * 32 + cl;
                        *(f32x4*)d = acc[ai][0][m][0] + b0; *(f32x4*)(d + 4) = acc[ai][0][m][1] + b1;
                    }
            }
            return;
        }
        const int mode = (colt < 512 || colt == C_GQ) ? 1 : (colt >= C_MQ && colt < C_Z) ? 2 : (colt >= C_Z && colt < C_SG) ? 3 : (colt >= C_SG) ? 4 : 0;
#pragma unroll
        for (int bj = 0; bj < 2; ++bj) {
            const int col = col0 + bj * 128;
            const f32x4 b0 = *(const f32x4*)(bias + orig_col(col)), b1 = *(const f32x4*)(bias + orig_col(col) + 4);
#pragma unroll
            for (int ai = 0; ai < 2; ++ai)
#pragma unroll
                for (int m = 0; m < 4; ++m) {
                    f32x4 v0 = acc[ai][bj][m][0] + b0, v1 = acc[ai][bj][m][1] + b1;
                    if (mode == 1) { v0 *= 0.125f; v1 *= 0.125f; }
                    else if (mode == 2) { v0 *= 0.08838834764831845f; v1 *= 0.08838834764831845f; }
                    else if (mode == 3) {
#pragma unroll
                        for (int e = 0; e < 4; ++e) { v0[e] = siluf_(v0[e]); v1[e] = siluf_(v1[e]); }
                    } else if (mode == 4) {
#pragma unroll
                        for (int e = 0; e < 4; ++e) { v0[e] = sigmoidf_(v0[e]); v1[e] = sigmoidf_(v1[e]); }
                    }
                    u32x4 o; o.x = pk2(v0[0], v0[1]); o.y = pk2(v0[2], v0[3]); o.z = pk2(v1[0], v1[1]); o.w = pk2(v1[2], v1[3]);
                    *(u32x4*)(P + (size_t)(row0 + ai * 128 + m * 16) * PS + col) = o;
                }
        }
    }
};
struct EpiOut {
    static constexpr bool PERM = false, AFTER_DRAIN = false;
    float* pre; const float* bo; const float* x; const float2* stats; const float* g0; const float* b0; const float* hres; size_t tok0; int l;
    __device__ __forceinline__ void operator()(const f32x4 (&acc)[2][2][4][2], const pg8::Unit& u, int wr, int wc, int fr, int fq) const {
        const int row0 = u.pm * 256 + wr * 64 + fr, col0 = u.pn * 256 + wc * 32 + 4 * fq;
#pragma unroll
        for (int ai = 0; ai < 2; ++ai)
#pragma unroll
            for (int m = 0; m < 4; ++m) {
                const int row = row0 + ai * 128 + m * 16; const size_t T = tok0 + row;
                float2 st; st.x = 0.f; st.y = 0.f; if (l == 0) st = stats[T];
#pragma unroll
                for (int bj = 0; bj < 2; ++bj)
#pragma unroll
                    for (int n = 0; n < 2; ++n) {
                        const int col = col0 + bj * 128 + n * 16;
                        f32x4 res;
                        if (l == 0) res = (*(const f32x4*)(x + T * 1024 + col) - st.x) * st.y * *(const f32x4*)(g0 + col) + *(const f32x4*)(b0 + col);
                        else res = *(const f32x4*)(hres + T * 1024 + col);
                        *(f32x4*)(pre + (size_t)row * 1024 + col) = acc[ai][bj][m][n] + *(const f32x4*)(bo + col) + DN_ALPHA * res;
                    }
            }
    }
};

#define XB_TMO      128
#define XB_XCNT(j)  (256  + 64 * (j))
#define XB_XSUB(j)  (1280 + 64 * (j))
#define XB_XGEN(j)  (2304 + 64 * (j))
#define XB_TOP      3328
#define XB_TOPGEN   3392
#define XCD_BAR_WORDS 3456
#define XB_SPIN_CAP (1u << 18)
#define LAS __attribute__((address_space(3)))

__device__ __forceinline__ unsigned xb_ld(unsigned* p)              { return __hip_atomic_load(p, __ATOMIC_RELAXED, __HIP_MEMORY_SCOPE_AGENT); }
__device__ __forceinline__ unsigned xb_add(unsigned* p, unsigned v) { return __hip_atomic_fetch_add(p, v, __ATOMIC_RELAXED, __HIP_MEMORY_SCOPE_AGENT); }
__device__ __forceinline__ unsigned xb_xcc_id() { return (unsigned)__builtin_amdgcn_s_getreg((3 << 11) | 20) & 0xFu; }
#define XB_SPIN(cond, bar) do { unsigned _sp = 0; while (cond) { __builtin_amdgcn_s_sleep(1); \
    if ((++_sp & 255u) == 0u) { if (xb_ld(&(bar)[XB_TMO])) break; if (_sp > XB_SPIN_CAP) { atomicAdd(&(bar)[XB_TMO], 1u); break; } } } } while (0)

struct XcdBarrier {
    unsigned* bar; unsigned x;
    volatile LAS unsigned* st;
};

__device__ __forceinline__ XcdBarrier xcd_barrier_post(unsigned* bar, volatile LAS unsigned* st) {
    XcdBarrier b; b.bar = bar; b.x = xb_xcc_id(); b.st = st;
    if (threadIdx.x == 0) (void)xb_add(&bar[XB_XCNT(b.x)], 1u);
    return b;
}
__device__ __forceinline__ void xcd_barrier_complete(unsigned* bar, unsigned x, unsigned& nloc, unsigned& nx) {
    const unsigned G = gridDim.x * gridDim.y * gridDim.z;
    unsigned sum, cnt, mine, sp = 0u;
    for (;;) {
        sum = 0u; cnt = 0u; mine = 0u;
#pragma unroll
        for (unsigned j = 0; j < 16; ++j) { const unsigned c = xb_ld(&bar[XB_XCNT(j)]); sum += c; cnt += (c > 0u) ? 1u : 0u; mine = (j == x) ? c : mine; }
        if (sum == G) break;
        __builtin_amdgcn_s_sleep(1);
        if ((++sp & 255u) == 0u) { if (xb_ld(&bar[XB_TMO])) break; if (sp > XB_SPIN_CAP) { atomicAdd(&bar[XB_TMO], 1u); break; } }
    }
    nloc = mine > 0u ? mine : 1u; nx = cnt > 0u ? cnt : 1u;
}

__device__ __forceinline__ void xcd_barrier(unsigned* b_bar, unsigned b_x, volatile LAS unsigned* b_st) {
    asm volatile("s_waitcnt vmcnt(0)" ::: "memory");
    __syncthreads();
    if (threadIdx.x == 0) {
        unsigned* bar = b_bar;
        __builtin_amdgcn_s_waitcnt(0);
        unsigned nloc = b_st[0], nx = b_st[1];
        if (nloc == 0u) { xcd_barrier_complete(bar, b_x, nloc, nx); b_st[0] = nloc; b_st[1] = nx; }
        const unsigned old = xb_add(&bar[XB_XSUB(b_x)], 1u);
        const unsigned gen = old / nloc;
        if (old + 1u == (gen + 1u) * nloc) {
            __builtin_amdgcn_fence(__ATOMIC_RELEASE, "agent");
            asm volatile("s_waitcnt vmcnt(0)" ::: "memory");
            const unsigned og = xb_add(&bar[XB_TOP], 1u);
            const unsigned tg = og / nx;
            if (og + 1u == (tg + 1u) * nx) xb_add(&bar[XB_TOPGEN], 1u);
            else XB_SPIN(xb_ld(&bar[XB_TOPGEN]) == tg, bar);
            __builtin_amdgcn_fence(__ATOMIC_ACQUIRE, "agent");
            xb_add(&bar[XB_XGEN(b_x)], 1u);
            asm volatile("s_waitcnt vmcnt(0)" ::: "memory");
        } else {
            XB_SPIN(xb_ld(&bar[XB_XGEN(b_x)]) == gen, bar);
            __builtin_amdgcn_fence(__ATOMIC_ACQUIRE, "agent");
            asm volatile("s_waitcnt vmcnt(0)" ::: "memory");
        }
    }
    __syncthreads();
}

__device__ __forceinline__ void gbar(unsigned* ctr, unsigned& gen, int G) {
    __syncthreads();
    gen += (unsigned)G;
    if (threadIdx.x == 0) {
        __threadfence();
        __hip_atomic_fetch_add(ctr, 1u, __ATOMIC_RELAXED, __HIP_MEMORY_SCOPE_AGENT);
        while (__hip_atomic_load(ctr, __ATOMIC_RELAXED, __HIP_MEMORY_SCOPE_AGENT) < gen) __builtin_amdgcn_s_sleep(1);
        __threadfence();
    }
    __syncthreads();
}
typedef const Params __attribute__((address_space(4))) KParams;
#define KP4 __attribute__((address_space(4)))
__device__ __forceinline__ Params fresh_params() {
#if defined(__HIP_DEVICE_COMPILE__)
    KParams* kp = (KParams*)__builtin_amdgcn_kernarg_segment_ptr();
    asm volatile("" : "+s"(kp));
    Params r;
    const float* KP4 const* src = (const float* KP4 const*)kp;
    const float** dst = (const float**)&r;
#pragma unroll
    for (int i = 0; i < 28; ++i) dst[i] = src[i];
    return r;
#else
    return Params{};
#endif
}
__global__ void __launch_bounds__(NTHR) mega(Params p_unused) {
    extern __shared__ __attribute__((aligned(16))) unsigned char lds[];
    cg::grid_group grid = cg::this_grid();
    const int G = gridDim.x, bid = blockIdx.x;
    volatile LAS unsigned* xst = (volatile LAS unsigned*)((LAS unsigned char*)lds + (LDS_BYTES - 16));
    if (threadIdx.x == 0) { xst[0] = 0u; xst[1] = 0u; }
    __syncthreads();
    unsigned* xbar; unsigned xx;
    { const Params p = fresh_params(); xbar = (unsigned*)(p.ws + OFF_BAR); xx = xb_xcc_id(); if (threadIdx.x == 0) (void)xb_add(&xbar[XB_XCNT(xx)], 1u); }
    { const Params p = fresh_params(); phase0(p); }
    grid.sync();
#pragma unroll 1
    for (int l = 0; l < 2; ++l) {
        { const Params p = fresh_params(); phase_weights(p, l, lds); __syncthreads(); phase_filter_gen(p, l, lds); }
        xcd_barrier(xbar, xx, xst);
        {
            const Params p = fresh_params();
            phase_filter_fft(p, l, lds);
            const bf16_t* WtKV = (const bf16_t*)(p.ws + OFF_WTKV); const bf16_t* membf = (const bf16_t*)(p.ws + OFF_MEMBF);
            for (int t = bid; t < 64; t += G) {
                f32x4 acc[4][4];
                if (t < 32) {
                    const int m0 = (t >> 2) * 256, n0 = (t & 3) * 128;
                    gemm_core(acc, membf + (size_t)m0 * 1024, 1024, WtKV + (size_t)n0 * 1024, 1024, 1024, lds);
                    bf16_t* Km = (bf16_t*)(p.ws + OFF_KMAT);
                    EPI_LOOP(st_bf4(Km + (size_t)row * 512 + col, v);)
                } else {
                    const int t2 = t - 32, m0 = (t2 >> 4) * 256, n0 = (t2 & 15) * 128;
                    gemm_core(acc, WtKV + (size_t)(512 + m0) * 1024, 1024, membf + (size_t)n0 * 1024, 1024, 1024, lds);
                    bf16_t* Vm = (bf16_t*)(p.ws + OFF_VT);
                    EPI_LOOP(st_bf4(Vm + (size_t)row * 2048 + col, v);)
                }
            }
        }
        xcd_barrier(xbar, xx, xst);
#pragma unroll 1
        for (int g = 0; g < NGRP; ++g) {
            const size_t tok0 = (size_t)g * TG;
#pragma unroll 1
            for (int rep = 0; rep < PROBE_REP_INPROJ; ++rep) {
                const Params p = fresh_params();
                pg8::Gemm gm; gm.A = (const bf16_t*)(p.ws + OFF_HB) + tok0 * 1024; gm.Bt = (const bf16_t*)(p.ws + OFF_WTIN); gm.M = TG; gm.N = NINP; gm.K = 1024;
                pg8::StaticOrder S; S.init(TG, NINP, G, bid);
                EpiInProj E; E.P = (bf16_t*)(p.ws + OFF_P); E.bias = p.b_in + (size_t)l * NIN; E.LR = (float*)(p.ws + OFF_LR);
                pg8::gemm_phase<EpiInProj, pg8::StaticOrder, false>((PG8_LAS unsigned char*)lds, gm, S, E, nullptr);
                __syncthreads();
            }
            xcd_barrier(xbar, xx, xst);
#pragma unroll 1
            for (int rep = 0; rep < PROBE_REP_MIX; ++rep) {
            int dry = (rep + 1 < PROBE_REP_MIX) ? 1 : 0; asm volatile("" : "+s"(dry));
            {
                const Params p = fresh_params();
                bf16_t* P = (bf16_t*)(p.ws + OFF_P);
                for (int it = bid; it < BG * 64 * 8; it += G) na_item(p, l, P, it >> 9, (it >> 3) & 63, it & 7, lds, dry);
            }
            {
                const Params p = fresh_params();
                bf16_t* P = (bf16_t*)(p.ws + OFF_P);
                for (int it = bid; it < BG * 128 * 8; it += G) hy_pre_item(p, l, P, (float*)(p.ws + OFF_UT), (bf16_t*)(p.ws + OFF_GT), it >> 10, (it >> 3) & 127, it & 7, lds);
            }
            {
                const Params p = fresh_params();
                for (int it = bid; it < NITEM; it += G) gla_part1_item(p, l, (const bf16_t*)(p.ws + OFF_P), (const float*)(p.ws + OFF_LR), it, lds);
            }
            {
                const Params p = fresh_params();
                bf16_t* P = (bf16_t*)(p.ws + OFF_P);
                const int nit = BG * 4 * 64, per = (nit + G - 1) / G;
                int last = -1;
                for (int it = bid * per; it < min(nit, (bid + 1) * per); ++it) {
                    const int bh = it >> 6, bl = bh >> 2, h = bh & 3;
                    if (bh != last) { __syncthreads(); memattn_load(p, g * BG + bl, h, lds); last = bh; }
                    memattn_item(P, bl, h, it & 63, lds, dry);
                }
                __syncthreads();
            }
            xcd_barrier(xbar, xx, xst);
            {
                const Params p = fresh_params();
                const float2* twl = fft_lds_twiddles((const float2*)(p.ws + OFF_TW), lds);
                for (int it = bid; it < BG * 256; it += G) hyena_conv_item(p, (const float*)(p.ws + OFF_UT), (bf16_t*)(p.ws + OFF_GT), it >> 8, it & 255, lds, twl, dry);
                __syncthreads();
                gla_scan(p, dry);
            }
            xcd_barrier(xbar, xx, xst);
            {
                const Params p = fresh_params();
                for (int it = bid; it < NITEM; it += G) gla_part2_item(p, l, (bf16_t*)(p.ws + OFF_P), (const float*)(p.ws + OFF_LR), it, lds, dry);
            }
            {
                const Params p = fresh_params();
                for (int it = bid; it < BG * 128 * 8; it += G) hy_post_item((bf16_t*)(p.ws + OFF_P), (const bf16_t*)(p.ws + OFF_GT), it >> 10, (it >> 3) & 127, it & 7, lds, dry);
            }
            xcd_barrier(xbar, xx, xst);
            }
            {
                const Params p = fresh_params();
                const bf16_t* P = (const bf16_t*)(p.ws + OFF_P); const bf16_t* WtBr = (const bf16_t*)(p.ws + OFF_WTBR); bf16_t* merged = (bf16_t*)(p.ws + OFF_MERGED);
                for (int t = bid; t < 512; t += G) {
                    const int sr = t >> 8, sb = t & 255, sx = sb & 7, sk = sb >> 3;
                    const int m0 = (sr * 32 + (sk >> 3) * 8 + sx) * 256, n0 = (sk & 7) * 128;
                    merge_tile(P, WtBr, merged, m0, n0, lds);
                }
            }
            xcd_barrier(xbar, xx, xst);
            {
                const Params p = fresh_params();
                pg8::Gemm gm; gm.A = (const bf16_t*)(p.ws + OFF_MERGED); gm.Bt = (const bf16_t*)(p.ws + OFF_WTOUT); gm.M = TG; gm.N = 1024; gm.K = 1024;
                pg8::StaticOrder S; S.init(TG, 1024, G, bid);
                EpiOut E; E.pre = (float*)(p.ws + OFF_PRE); E.bo = p.b_out + l * 1024; E.x = p.x; E.stats = (const float2*)(p.ws + OFF_STATS); E.g0 = p.ln_in_g; E.b0 = p.ln_in_b; E.hres = p.out; E.tok0 = tok0; E.l = l;
                pg8::gemm_phase<EpiOut, pg8::StaticOrder, false>((PG8_LAS unsigned char*)lds, gm, S, E, nullptr);
                __syncthreads();
            }
            xcd_barrier(xbar, xx, xst);
            {
                const Params p = fresh_params();
                ln_rows((const float*)(p.ws + OFF_PRE), 0, TG, p.ln_g + l * 1024, p.ln_b + l * 1024, p.out, (bf16_t*)(p.ws + OFF_HB), tok0, nullptr);
            }
        }
        xcd_barrier(xbar, xx, xst);
    }
}

extern "C" void kernel_launch(void* const* d_in, const int* in_sizes, int n_in, void* d_out, int out_size, void* d_ws, size_t ws_size, hipStream_t stream) {
    static int grid_blocks = 0;
    if (!grid_blocks) {
        if (ws_size < WS_END) { fprintf(stderr, "kernel_launch: workspace too small: %zu < %zu\n", ws_size, (size_t)WS_END); grid_blocks = -1; return; }
        {
            const long long ex[26] = {67108864LL, 2097152LL, 1024, 1024, 2LL * 1024 * 10784, 2 * 10784, 2 * 8 * 15 * 31, 2 * 3 * 1536, 2 * 1536, 2 * 33 * 64, 2 * 64, 2 * 2 * 64 * 64, 2 * 2 * 64,
                                      2 * 64 * 1024, 2 * 512, 2 * 16 * 256, 2 * 256, 2 * 16 * 256, 2 * 256, 2 * 512, 2LL * 1024 * 1024, 2LL * 4 * 512 * 1024, 2LL * 1024 * 1024, 2 * 1024, 2 * 1024, 2 * 1024};
            bool bad = (n_in != 26) || (out_size != 67108864);
            for (int i = 0; i < 26 && !bad; ++i) if ((long long)in_sizes[i] != ex[i]) { fprintf(stderr, "kernel_launch: input %d has %d elements, expected %lld\n", i, in_sizes[i], ex[i]); bad = true; }
            if (bad) { fprintf(stderr, "kernel_launch: unexpected shapes; nothing launched\n"); grid_blocks = -1; return; }
        }
        int dev = 0, cus = 0, per_cu = 0;
        hipGetDevice(&dev);
        hipDeviceGetAttribute(&cus, hipDeviceAttributeMultiprocessorCount, dev);
        if (hipFuncSetAttribute((const void*)mega, hipFuncAttributeMaxDynamicSharedMemorySize, LDS_BYTES) != hipSuccess) fprintf(stderr, "kernel_launch: hipFuncSetAttribute failed\n");
        if (hipOccupancyMaxActiveBlocksPerMultiprocessor(&per_cu, (const void*)mega, NTHR, LDS_BYTES) != hipSuccess || per_cu < 1) { fprintf(stderr, "kernel_launch: occupancy query gave %d\n", per_cu); per_cu = 1; }
        (void)hipGetLastError();
        if (per_cu > 1) per_cu = 1;
        grid_blocks = cus * per_cu;
    }
    if (grid_blocks < 0) return;
    Params p{};
    const float** pp = (const float**)&p;
    for (int i = 0; i < 26; ++i) pp[i] = (const float*)d_in[i];
    p.out = (float*)d_out; p.ws = (unsigned char*)d_ws;
    if (hipMemsetAsync((unsigned char*)d_ws + OFF_BAR, 0, 16384, stream) != hipSuccess) fprintf(stderr, "kernel_launch: memset of the barrier word failed\n");
    void* args[] = {&p};
    hipError_t e = hipLaunchCooperativeKernel((const void*)mega, dim3(grid_blocks), dim3(NTHR), args, LDS_BYTES, stream);
    if (e != hipSuccess) fprintf(stderr, "cooperative launch failed: %s (grid %d)\n", hipGetErrorString(e), grid_blocks);
}
#endif
```

```cpp
#ifndef PROBE_REP_MIX
#define PROBE_REP_MIX 1
#endif
#ifndef PROBE_REP_INPROJ
#define PROBE_REP_INPROJ 1
#endif
#include <hip/hip_runtime.h>
#include <hip/hip_cooperative_groups.h>
#include <cstdio>
#include <unistd.h>
#include <cmath>
namespace cg = cooperative_groups;

#define HD __host__ __device__
typedef unsigned short bf16_t;
typedef short bf16x8 __attribute__((ext_vector_type(8)));
typedef float f32x4 __attribute__((ext_vector_type(4)));
typedef unsigned u32x2 __attribute__((ext_vector_type(2)));
typedef unsigned u32x4 __attribute__((ext_vector_type(4)));

constexpr int NTOK = 65536, DM = 1024, SEQ = 8192, NB = 8;
constexpr int BG = 2;
constexpr int NGRP = NB / BG;
constexpr int TG = BG * SEQ;
constexpr int PS = 10752;
constexpr int NIN = 10784, NINP = 11008;
constexpr int C_NAQ = 0, C_NAK = 512, C_NAV = 1024, C_HY = 1536, C_GQ = 3072, C_GK = 3328, C_GV = 3584, C_MQ = 4096, C_Z = 4608, C_SG = 6656, C_LR = 10752;
constexpr int FN = 16384;
constexpr int NITEM = BG * 128 * 4;
constexpr int LDS_BYTES = 160 * 1024;
constexpr int NTHR = 512;
constexpr float DN_ALPHA = 1.41421356237309515f;

constexpr size_t al256(size_t x) { return (x + 255) & ~(size_t)255; }
constexpr size_t OFF_HB = 0;
constexpr size_t OFF_STATS = OFF_HB + (size_t)NTOK * DM * 2;
constexpr size_t OFF_TW = OFF_STATS + (size_t)NTOK * 8;
constexpr size_t OFF_MEMBF = OFF_TW + (size_t)FN * 8;
constexpr size_t OFF_ENERGY = OFF_MEMBF + (size_t)2048 * 1024 * 2;
constexpr size_t OFF_WTIN = OFF_ENERGY + 4096;
constexpr size_t OFF_WTBR = OFF_WTIN + (size_t)NINP * 1024 * 2;
constexpr size_t OFF_WTOUT = OFF_WTBR + (size_t)4 * 1024 * 512 * 2;
constexpr size_t OFF_WTKV = OFF_WTOUT + (size_t)1024 * 1024 * 2;
constexpr size_t OFF_KMAT = OFF_WTKV + (size_t)2048 * 1024 * 2;
constexpr size_t OFF_VT = OFF_KMAT + (size_t)2048 * 1024 * 2;
constexpr size_t OFF_HFILT = OFF_VT + (size_t)2048 * 1024 * 2;
constexpr size_t OFF_PQ = OFF_HFILT + (size_t)1024 * 8192 * 4;
constexpr size_t OFF_P = OFF_PQ + (size_t)256 * FN * 16;
constexpr size_t OFF_LR = OFF_P + (size_t)TG * PS * 2;
constexpr size_t OFF_GS = OFF_LR + (size_t)TG * 32 * 4;
constexpr size_t OFF_GDEC = OFF_GS + (size_t)2 * NITEM * 8192 * 4;
constexpr size_t OFF_MERGED = OFF_GDEC + (size_t)2 * NITEM * 64 * 4;
constexpr size_t OFF_PRE = OFF_MERGED + (size_t)TG * 1024 * 2;
constexpr size_t OFF_UT = OFF_PRE + (size_t)TG * 1024 * 4;
constexpr size_t OFF_GT = OFF_UT + (size_t)BG * 512 * 8192 * 4;
constexpr size_t OFF_BAR = OFF_GT + (size_t)BG * 512 * 8192 * 2;
constexpr size_t OFF_ZT = OFF_BAR + 16384;
constexpr size_t WS_END = OFF_ZT + (size_t)8192 * 33 * 4;

struct Params {
    const float *x, *mem, *ln_in_g, *ln_in_b, *w_in, *b_in, *na_rpb, *hy_conv_w, *hy_conv_b, *hy_w1, *hy_b1, *hy_wm, *hy_bm, *hy_w3, *hy_skip,
        *gla_up_f, *gla_bias_f, *gla_up_b, *gla_bias_b, *gla_norm_g, *mem_w_kv, *w_br, *w_out, *b_out, *ln_g, *ln_b;
    float* out;
    unsigned char* ws;
};

HD inline float bf2f(bf16_t b) {
    union { unsigned u; float f; } c; c.u = (unsigned)b << 16; return c.f;
}
HD inline bf16_t f2bf(float f) {
    union { unsigned u; float f; } c; c.f = f; unsigned u = c.u; u += 0x7fffu + ((u >> 16) & 1u); return (bf16_t)(u >> 16);
}
__device__ __forceinline__ unsigned pk2(float lo, float hi) { return (unsigned)f2bf(lo) | ((unsigned)f2bf(hi) << 16); }
__device__ __forceinline__ float lo16(unsigned u) { return __uint_as_float(u << 16); }
__device__ __forceinline__ float hi16(unsigned u) { return __uint_as_float(u & 0xffff0000u); }
__device__ __forceinline__ float wave_sum(float v) {
#pragma unroll
    for (int o = 32; o >= 1; o >>= 1) v += __shfl_xor(v, o);
    return v;
}
__device__ __forceinline__ float sigmoidf_(float x) { return __builtin_amdgcn_rcpf(1.0f + __expf(-x)); }
__device__ __forceinline__ float siluf_(float x) { return x * __builtin_amdgcn_rcpf(1.0f + __expf(-x)); }
__device__ __forceinline__ float logsigf_(float x) { return fminf(x, 0.0f) - log1pf(expf(-fabsf(x))); }
__device__ __forceinline__ bf16x8 mkfrag(u32x4 v) { return __builtin_bit_cast(bf16x8, v); }
__device__ __forceinline__ bf16x8 mkfrag2(u32x2 a, u32x2 b) { u32x4 v = {a.x, a.y, b.x, b.y}; return __builtin_bit_cast(bf16x8, v); }
#define MFMA(a, b, c) __builtin_amdgcn_mfma_f32_16x16x32_bf16((a), (b), (c), 0, 0, 0)
HD inline int iclamp(int v, int lo, int hi) { return v < lo ? lo : (v > hi ? hi : v); }

HD inline float2 cmulf(float2 a, float2 b) { float2 r; r.x = a.x * b.x - a.y * b.y; r.y = a.x * b.y + a.y * b.x; return r; }
HD inline float2 cmulcf(float2 a, float2 b) { float2 r; r.x = a.x * b.x + a.y * b.y; r.y = a.y * b.x - a.x * b.y; return r; }
struct Bfly { float2 x0, x1, x2, x3, W1; int i0; };
HD inline void bfly_load(Bfly& b, const float2* d, const float2* tw, int lgm, int q) {
    const int m = 1 << lgm, blk = q >> lgm, j = q & (m - 1);
    b.i0 = (blk << (lgm + 2)) + j;
    b.W1 = tw[j];
    b.x0 = d[b.i0]; b.x1 = d[b.i0 + m]; b.x2 = d[b.i0 + 2 * m]; b.x3 = d[b.i0 + 3 * m];
}
HD inline void bfly_fwd_store(const Bfly& b, float2* d, int lgm) {
    const int m = 1 << lgm, i0 = b.i0;
    const float2 W1 = b.W1, W2 = cmulf(W1, W1);
    const float2 x0 = b.x0, x1 = b.x1, x2 = b.x2, x3 = b.x3;
    float2 a0, a1, a2, a3, t;
    a0.x = x0.x + x2.x; a0.y = x0.y + x2.y;
    t.x = x0.x - x2.x; t.y = x0.y - x2.y; a2 = cmulf(t, W1);
    a1.x = x1.x + x3.x; a1.y = x1.y + x3.y;
    t.x = x1.x - x3.x; t.y = x1.y - x3.y; t = cmulf(t, W1); a3.x = t.y; a3.y = -t.x;
    float2 r;
    r.x = a0.x + a1.x; r.y = a0.y + a1.y; d[i0] = r;
    t.x = a0.x - a1.x; t.y = a0.y - a1.y; d[i0 + m] = cmulf(t, W2);
    r.x = a2.x + a3.x; r.y = a2.y + a3.y; d[i0 + 2 * m] = r;
    t.x = a2.x - a3.x; t.y = a2.y - a3.y; d[i0 + 3 * m] = cmulf(t, W2);
}
HD inline void bfly_inv_store(const Bfly& b, float2* d, int lgm) {
    const int m = 1 << lgm, i0 = b.i0;
    const float2 W1 = b.W1, W2 = cmulf(W1, W1);
    const float2 x0 = b.x0, x1 = b.x1, x2 = b.x2, x3 = b.x3;
    const float2 b1 = cmulcf(x1, W2), b3 = cmulcf(x3, W2);
    float2 y0, y1, y2, y3;
    y0.x = x0.x + b1.x; y0.y = x0.y + b1.y; y1.x = x0.x - b1.x; y1.y = x0.y - b1.y;
    y2.x = x2.x + b3.x; y2.y = x2.y + b3.y; y3.x = x2.x - b3.x; y3.y = x2.y - b3.y;
    const float2 c2 = cmulcf(y2, W1); float2 c3 = cmulcf(y3, W1); { const float tx = -c3.y, ty = c3.x; c3.x = tx; c3.y = ty; }
    float2 r;
    r.x = y0.x + c2.x; r.y = y0.y + c2.y; d[i0] = r;
    r.x = y0.x - c2.x; r.y = y0.y - c2.y; d[i0 + 2 * m] = r;
    r.x = y1.x + c3.x; r.y = y1.y + c3.y; d[i0 + m] = r;
    r.x = y1.x - c3.x; r.y = y1.y - c3.y; d[i0 + 3 * m] = r;
}
HD inline void fft_fwd_bfly(float2* d, const float2* tw, int lgm, int q) { Bfly b; bfly_load(b, d, tw, lgm, q); bfly_fwd_store(b, d, lgm); }
HD inline void fft_inv_bfly(float2* d, const float2* tw, int lgm, int q) { Bfly b; bfly_load(b, d, tw, lgm, q); bfly_inv_store(b, d, lgm); }
HD inline void r4_fwd(float2& x0, float2& x1, float2& x2, float2& x3, const float2 W1) {
    const float2 W2 = cmulf(W1, W1);
    float2 a0, a1, a2, a3, t;
    a0.x = x0.x + x2.x; a0.y = x0.y + x2.y;
    t.x = x0.x - x2.x; t.y = x0.y - x2.y; a2 = cmulf(t, W1);
    a1.x = x1.x + x3.x; a1.y = x1.y + x3.y;
    t.x = x1.x - x3.x; t.y = x1.y - x3.y; t = cmulf(t, W1); a3.x = t.y; a3.y = -t.x;
    x0.x = a0.x + a1.x; x0.y = a0.y + a1.y;
    t.x = a0.x - a1.x; t.y = a0.y - a1.y; x1 = cmulf(t, W2);
    x2.x = a2.x + a3.x; x2.y = a2.y + a3.y;
    t.x = a2.x - a3.x; t.y = a2.y - a3.y; x3 = cmulf(t, W2);
}
HD inline void r4_inv(float2& x0, float2& x1, float2& x2, float2& x3, const float2 W1) {
    const float2 W2 = cmulf(W1, W1);
    const float2 b1 = cmulcf(x1, W2), b3 = cmulcf(x3, W2);
    float2 y0, y1, y2, y3;
    y0.x = x0.x + b1.x; y0.y = x0.y + b1.y; y1.x = x0.x - b1.x; y1.y = x0.y - b1.y;
    y2.x = x2.x + b3.x; y2.y = x2.y + b3.y; y3.x = x2.x - b3.x; y3.y = x2.y - b3.y;
    const float2 c2 = cmulcf(y2, W1); float2 c3 = cmulcf(y3, W1); { const float tx = -c3.y, ty = c3.x; c3.x = tx; c3.y = ty; }
    x0.x = y0.x + c2.x; x0.y = y0.y + c2.y; x2.x = y0.x - c2.x; x2.y = y0.y - c2.y;
    x1.x = y1.x + c3.x; x1.y = y1.y + c3.y; x3.x = y1.x - c3.x; x3.y = y1.y - c3.y;
}
template <bool INV, bool HALF>
HD inline void r16_bfly(float2* d, const float2* twO, const float2* twI, int lgm, int q) {
    const int m = 1 << lgm, blk = q >> lgm, j = q & (m - 1), base = (blk << (lgm + 4)) + j;
    float2 e[4][4];
#pragma unroll
    for (int a = 0; a < 4; ++a)
#pragma unroll
        for (int b = 0; b < 4; ++b) {
            if (!INV && HALF && a >= 2) { e[a][b].x = 0.f; e[a][b].y = 0.f; }
            else e[a][b] = d[base + ((4 * a + b) << lgm)];
        }
    const float2 wI = twI[j];
    float2 wO[4];
#pragma unroll
    for (int b = 0; b < 4; ++b) wO[b] = twO[j + (b << lgm)];
    if (!INV) {
#pragma unroll
        for (int b = 0; b < 4; ++b) r4_fwd(e[0][b], e[1][b], e[2][b], e[3][b], wO[b]);
#pragma unroll
        for (int a = 0; a < 4; ++a) r4_fwd(e[a][0], e[a][1], e[a][2], e[a][3], wI);
    } else {
#pragma unroll
        for (int a = 0; a < 4; ++a) r4_inv(e[a][0], e[a][1], e[a][2], e[a][3], wI);
#pragma unroll
        for (int b = 0; b < 4; ++b) r4_inv(e[0][b], e[1][b], e[2][b], e[3][b], wO[b]);
    }
#pragma unroll
    for (int a = 0; a < 4; ++a)
#pragma unroll
        for (int b = 0; b < 4; ++b)
            if (!(INV && HALF && a >= 2)) d[base + ((4 * a + b) << lgm)] = e[a][b];
}
HD inline int brev14(int k) {
    unsigned v = (unsigned)k;
    v = ((v >> 1) & 0x55555555u) | ((v & 0x55555555u) << 1);
    v = ((v >> 2) & 0x33333333u) | ((v & 0x33333333u) << 2);
    v = ((v >> 4) & 0x0f0f0f0fu) | ((v & 0x0f0f0f0fu) << 4);
    v = ((v >> 8) & 0x00ff00ffu) | ((v & 0x00ff00ffu) << 8);
    v = (v >> 16) | (v << 16);
    return (int)(v >> 18);
}
struct PwIn { float2 Z1, Z2; float4 A, B; int p1, p2; };
HD inline void pw_load(PwIn& w, const float2* d, const float4* pq, int p1) {
    const int kf = brev14(p1), k2 = (FN - kf) & (FN - 1); w.p1 = p1; w.p2 = brev14(k2);
    w.Z1 = d[w.p1]; w.Z2 = d[w.p2]; w.A = pq[w.p1]; w.B.x = w.A.x; w.B.y = -w.A.y; w.B.z = w.A.z; w.B.w = -w.A.w;
}
HD inline void pw_store(const PwIn& w, float2* d) {
    const float2 Z1 = w.Z1, Z2 = w.Z2;
    float2 P1, Q1, P2, Q2; P1.x = w.A.x; P1.y = w.A.y; Q1.x = w.A.z; Q1.y = w.A.w; P2.x = w.B.x; P2.y = w.B.y; Q2.x = w.B.z; Q2.y = w.B.w;
    float2 c1, c2; c1.x = Z1.x; c1.y = -Z1.y; c2.x = Z2.x; c2.y = -Z2.y;
    const float2 a = cmulf(Z1, P1), b = cmulf(c2, Q1), c = cmulf(Z2, P2), e = cmulf(c1, Q2);
    float2 w1, w2; w1.x = a.x + b.x; w1.y = a.y + b.y; w2.x = c.x + e.x; w2.y = c.y + e.y;
    d[w.p1] = w1;
    if (w.p2 != w.p1) d[w.p2] = w2;
}
HD inline void conv_pointwise(float2* d, const float4* pq, int p1) { PwIn w; pw_load(w, d, pq, p1); pw_store(w, d); }
HD inline void filt_pointwise(const float2* d, float4* pq, int p1) {
    const int kf = brev14(p1), k2 = (FN - kf) & (FN - 1), p2 = brev14(k2);
    const float2 Z1 = d[p1], Z2 = d[p2];
    const float gcx = 0.5f * (Z1.x + Z2.x), gcy = 0.5f * (Z1.y - Z2.y);
    const float gdx = 0.5f * (Z1.y + Z2.y), gdy = -0.5f * (Z1.x - Z2.x);
    const float s = 0.5f / (float)FN;
    float4 A; A.x = s * (gcx + gdx); A.y = s * (gcy + gdy); A.z = s * (gcx - gdx); A.w = s * (gcy - gdy);
    pq[p1] = A;
}
HD inline int tw_off(int lgm) { return lgm == 10 ? 0 : lgm == 8 ? 1024 : lgm == 6 ? 1280 : lgm == 4 ? 1344 : lgm == 2 ? 1360 : 1364; }
#ifndef FFT_HOST_TEST
template <int LGM, bool INV>
__device__ __forceinline__ void fft_pass(float2* d, const float2* twl, const float2* twg, int tid) {
    const float2* tw = (LGM == 12) ? twg : twl + tw_off(LGM);
#pragma unroll
    for (int it = 0; it < 2; ++it) {
        const int q = tid + it * 4 * NTHR;
        Bfly b0, b1, b2, b3;
        bfly_load(b0, d, tw, LGM, q); bfly_load(b1, d, tw, LGM, q + NTHR); bfly_load(b2, d, tw, LGM, q + 2 * NTHR); bfly_load(b3, d, tw, LGM, q + 3 * NTHR);
        if (INV) { bfly_inv_store(b0, d, LGM); bfly_inv_store(b1, d, LGM); bfly_inv_store(b2, d, LGM); bfly_inv_store(b3, d, LGM); }
        else { bfly_fwd_store(b0, d, LGM); bfly_fwd_store(b1, d, LGM); bfly_fwd_store(b2, d, LGM); bfly_fwd_store(b3, d, LGM); }
    }
    __syncthreads();
}
template <int LGM, bool INV, bool HALF>
__device__ __forceinline__ void fft_pass16(float2* d, const float2* twl, const float2* twg, int tid) {
    const float2* twO = (LGM + 2 == 12) ? twg : twl + tw_off(LGM + 2);
    const float2* twI = twl + tw_off(LGM);
    r16_bfly<INV, HALF>(d, twO, twI, LGM, tid);
    r16_bfly<INV, HALF>(d, twO, twI, LGM, tid + NTHR);
    __syncthreads();
}
template <bool HALF>
__device__ __forceinline__ void fft_forward(float2* d, const float2* twl, const float2* twg) {
    int tid = threadIdx.x; asm volatile("" : "+v"(tid));
    fft_pass16<10, false, HALF>(d, twl, twg, tid); fft_pass16<6, false, false>(d, twl, twg, tid);
    fft_pass<4, false>(d, twl, twg, tid); fft_pass<2, false>(d, twl, twg, tid); fft_pass<0, false>(d, twl, twg, tid);
}
template <bool HALF>
__device__ __forceinline__ void fft_inverse(float2* d, const float2* twl, const float2* twg) {
    int tid = threadIdx.x; asm volatile("" : "+v"(tid));
    fft_pass<0, true>(d, twl, twg, tid); fft_pass<2, true>(d, twl, twg, tid); fft_pass<4, true>(d, twl, twg, tid);
    fft_pass16<6, true, false>(d, twl, twg, tid); fft_pass16<10, true, HALF>(d, twl, twg, tid);
}
__device__ __forceinline__ float2* fft_lds_twiddles(const float2* twg, unsigned char* lds) {
    int tid = threadIdx.x; asm volatile("" : "+v"(tid));
    float2* t = (float2*)(lds + 131072);
    for (int k = tid; k < 1365; k += NTHR) {
        const int lgm = k < 1024 ? 10 : k < 1280 ? 8 : k < 1344 ? 6 : k < 1360 ? 4 : k < 1364 ? 2 : 0;
        t[k] = twg[(k - tw_off(lgm)) << (12 - lgm)];
    }
    __syncthreads();
    return t;
}

constexpr int STG = 49152;
__device__ __forceinline__ int swz(int row, int ch) { return row * 128 + ((ch ^ ((row >> 1) & 7)) << 4); }
__device__ __forceinline__ void gemm_core(f32x4 (&acc)[4][4], const bf16_t* A, int lda, const bf16_t* Bt, int ldb, int K, unsigned char* lds) {
    int tid_ = threadIdx.x; asm volatile("" : "+v"(tid_)); const int tid = tid_, lane = tid & 63, w = tid >> 6, wm = w & 3, wn = w >> 2, l15 = lane & 15, q4 = lane >> 4;
    const int wu = __builtin_amdgcn_readfirstlane(w);
    __attribute__((address_space(3))) unsigned char* l3 = (__attribute__((address_space(3))) unsigned char*)lds;
#pragma unroll
    for (int mi = 0; mi < 4; ++mi)
#pragma unroll
        for (int ni = 0; ni < 4; ++ni) acc[mi][ni] = (f32x4){0.f, 0.f, 0.f, 0.f};
    const int r8 = lane >> 3, sch = (lane & 7) ^ ((((w & 1) << 2) + (r8 >> 1)) & 7);
    const bf16_t* ap = A + (size_t)(w * 8 + r8) * lda + sch * 8;
    const bf16_t* bp = Bt + (size_t)(w * 8 + r8) * ldb + sch * 8;
#define GC_STAGE(buf, k0)                                                                                                                         \
    {                                                                                                                                             \
        _Pragma("unroll") for (int i = 0; i < 4; ++i)                                                                                             \
            __builtin_amdgcn_global_load_lds((const unsigned*)(ap + (size_t)(64 * i) * lda + (k0)), (__attribute__((address_space(3))) unsigned*)(l3 + (buf) * STG + (wu + 8 * i) * 1024), 16, 0, 0);          \
        _Pragma("unroll") for (int i = 0; i < 2; ++i)                                                                                             \
            __builtin_amdgcn_global_load_lds((const unsigned*)(bp + (size_t)(64 * i) * ldb + (k0)), (__attribute__((address_space(3))) unsigned*)(l3 + (buf) * STG + 32768 + (wu + 8 * i) * 1024), 16, 0, 0);  \
    }
    GC_STAGE(0, 0)
    asm volatile("s_waitcnt vmcnt(0)" ::: "memory");
    __syncthreads();
    const int nk = K >> 6;
    for (int kt = 0; kt < nk; ++kt) {
        if (kt + 1 < nk) GC_STAGE((kt + 1) & 1, (kt + 1) << 6)
        const unsigned char* sa = lds + (kt & 1) * STG;
        const unsigned char* sb = sa + 32768;
#pragma unroll
        for (int ks = 0; ks < 2; ++ks) {
            bf16x8 af[4], bfr[4];
#pragma unroll
            for (int mi = 0; mi < 4; ++mi) af[mi] = *(const bf16x8*)(sa + swz(wm * 64 + mi * 16 + l15, ks * 4 + q4));
#pragma unroll
            for (int ni = 0; ni < 4; ++ni) bfr[ni] = *(const bf16x8*)(sb + swz(wn * 64 + ni * 16 + l15, ks * 4 + q4));
#pragma unroll
            for (int mi = 0; mi < 4; ++mi)
#pragma unroll
                for (int ni = 0; ni < 4; ++ni) acc[mi][ni] = MFMA(bfr[ni], af[mi], acc[mi][ni]);
        }
        asm volatile("s_waitcnt vmcnt(0)" ::: "memory");
        __syncthreads();
    }
#undef GC_STAGE
}
#define EPI_LOOP(body)                                                                                                  \
    {                                                                                                                   \
        int e_t = threadIdx.x; asm volatile("" : "+v"(e_t)); const int e_lane = e_t & 63, e_w = e_t >> 6;                                                    \
        _Pragma("unroll") for (int mi = 0; mi < 4; ++mi) _Pragma("unroll") for (int ni = 0; ni < 4; ++ni) {             \
            const int row = m0 + (e_w & 3) * 64 + mi * 16 + (e_lane & 15);                                              \
            const int col = n0 + (e_w >> 2) * 64 + ni * 16 + 4 * (e_lane >> 4);                                         \
            f32x4& v = acc[mi][ni];                                                                                     \
            body                                                                                                        \
        }                                                                                                               \
    }
__device__ __forceinline__ void st_bf4(bf16_t* dst, f32x4 v) {
    u32x2 o; o.x = pk2(v[0], v[1]); o.y = pk2(v[2], v[3]); *(u32x2*)dst = o;
}
__device__ __forceinline__ f32x4 ld_bf4(const bf16_t* src) {
    const u32x2 u = *(const u32x2*)src; f32x4 r = {lo16(u.x), hi16(u.x), lo16(u.y), hi16(u.y)}; return r;
}


__device__ __forceinline__ void merge_tile(const bf16_t* P, const bf16_t* WtBr, bf16_t* merged, int m0, int n0, unsigned char* lds) {
    int tid_ = threadIdx.x; asm volatile("" : "+v"(tid_)); const int tid = tid_, lane = tid & 63, w = tid >> 6, wm = w & 3, wn = w >> 2, l15 = lane & 15, q4 = lane >> 4;
    const int wu = __builtin_amdgcn_readfirstlane(w);
    __attribute__((address_space(3))) unsigned char* l3 = (__attribute__((address_space(3))) unsigned char*)lds;
    f32x4 acc[4][4], macc[4][4];
#pragma unroll
    for (int mi = 0; mi < 4; ++mi)
#pragma unroll
        for (int ni = 0; ni < 4; ++ni) { acc[mi][ni] = (f32x4){0.f, 0.f, 0.f, 0.f}; macc[mi][ni] = (f32x4){0.f, 0.f, 0.f, 0.f}; }
    const int r8 = lane >> 3, sch = (lane & 7) ^ ((((w & 1) << 2) + (r8 >> 1)) & 7);
    const bf16_t* ap = P + (size_t)(m0 + w * 8 + r8) * PS + sch * 8;
    const bf16_t* bp = WtBr + (size_t)(n0 + w * 8 + r8) * 512 + sch * 8;
    const bf16_t* sgp = P + (size_t)(m0 + wm * 64 + l15) * PS + C_SG + n0 + wn * 64 + 4 * q4;
#define MG_STAGE(buf, kt_)                                                                                                                        \
    {                                                                                                                                             \
        const int j_ = (kt_) >> 3, k0_ = ((kt_) & 7) << 6;                                                                                        \
        const int acol_ = (j_ == 0) ? C_NAQ : (j_ == 1) ? C_HY : (j_ == 2) ? C_GV : C_MQ;                                                        \
        _Pragma("unroll") for (int i = 0; i < 4; ++i)                                                                                             \
            __builtin_amdgcn_global_load_lds((const unsigned*)(ap + (size_t)(64 * i) * PS + acol_ + k0_), (__attribute__((address_space(3))) unsigned*)(l3 + (buf) * STG + (wu + 8 * i) * 1024), 16, 0, 0);      \
        _Pragma("unroll") for (int i = 0; i < 2; ++i)                                                                                             \
            __builtin_amdgcn_global_load_lds((const unsigned*)(bp + (size_t)j_ * 1024 * 512 + (size_t)(64 * i) * 512 + k0_), (__attribute__((address_space(3))) unsigned*)(l3 + (buf) * STG + 32768 + (wu + 8 * i) * 1024), 16, 0, 0);  \
    }
    MG_STAGE(0, 0)
    asm volatile("s_waitcnt vmcnt(0)" ::: "memory");
    __syncthreads();
#pragma unroll 1
    for (int kt = 0; kt < 32; ++kt) {
        if (kt + 1 < 32) MG_STAGE((kt + 1) & 1, kt + 1)
        const bool last = (kt & 7) == 7;
        u32x2 sg[4][4];
        if (last) {
            const bf16_t* sp = sgp + 1024 * (kt >> 3);
#pragma unroll
            for (int mi = 0; mi < 4; ++mi)
#pragma unroll
                for (int ni = 0; ni < 4; ++ni) sg[mi][ni] = *(const u32x2*)(sp + (size_t)(mi * 16) * PS + ni * 16);
        }
        const unsigned char* sa = lds + (kt & 1) * STG;
        const unsigned char* sb = sa + 32768;
#pragma unroll
        for (int ks = 0; ks < 2; ++ks) {
            bf16x8 af[4], bfr[4];
#pragma unroll
            for (int mi = 0; mi < 4; ++mi) af[mi] = *(const bf16x8*)(sa + swz(wm * 64 + mi * 16 + l15, ks * 4 + q4));
#pragma unroll
            for (int ni = 0; ni < 4; ++ni) bfr[ni] = *(const bf16x8*)(sb + swz(wn * 64 + ni * 16 + l15, ks * 4 + q4));
#pragma unroll
            for (int mi = 0; mi < 4; ++mi)
#pragma unroll
                for (int ni = 0; ni < 4; ++ni) acc[mi][ni] = MFMA(bfr[ni], af[mi], acc[mi][ni]);
        }
        asm volatile("s_waitcnt vmcnt(0)" ::: "memory");
        if (last) {
#pragma unroll
            for (int mi = 0; mi < 4; ++mi)
#pragma unroll
                for (int ni = 0; ni < 4; ++ni) {
                    const u32x2 u = sg[mi][ni]; const f32x4 g4 = {lo16(u.x), hi16(u.x), lo16(u.y), hi16(u.y)};
                    macc[mi][ni] += g4 * acc[mi][ni]; acc[mi][ni] = (f32x4){0.f, 0.f, 0.f, 0.f};
                }
        }
        __syncthreads();
    }
#undef MG_STAGE
#pragma unroll
    for (int mi = 0; mi < 4; ++mi)
#pragma unroll
        for (int ni = 0; ni < 4; ++ni) st_bf4(merged + (size_t)(m0 + wm * 64 + mi * 16 + l15) * 1024 + n0 + wn * 64 + ni * 16 + 4 * q4, macc[mi][ni]);
}

__device__ __forceinline__ int orig_col(int n) {
    if (n < 4096) return n;
    if (n < 4608) return n + 32;
    if (n < 6656) return n + 32;
    if (n < 10752) return n + 32;
    return n - 10752 + 4096;
}

__device__ __forceinline__ void ln_rows(const float* src, size_t src_row0, int nrows, const float* g, const float* b, float* dst32, bf16_t* dst16, size_t dst_row0, float2* stats) {
    int tid_ = threadIdx.x; asm volatile("" : "+v"(tid_));
    const int lane = tid_ & 63;
    const int gw = blockIdx.x * (NTHR / 64) + (tid_ >> 6), nw = gridDim.x * (NTHR / 64);
    for (int r = gw; r < nrows; r += nw) {
        const float4* xr = (const float4*)(src + (src_row0 + r) * 1024);
        float4 v[4]; float s = 0.f;
#pragma unroll
        for (int i = 0; i < 4; ++i) { v[i] = xr[lane + 64 * i]; s += (v[i].x + v[i].y) + (v[i].z + v[i].w); }
        s = wave_sum(s);
        const float mean = s * (1.0f / 1024.0f);
        float q = 0.f;
#pragma unroll
        for (int i = 0; i < 4; ++i) { const float a = v[i].x - mean, bb = v[i].y - mean, c = v[i].z - mean, d = v[i].w - mean; q += (a * a + bb * bb) + (c * c + d * d); }
        q = wave_sum(q);
        const float rstd = 1.0f / sqrtf(q * (1.0f / 1024.0f) + 1e-5f);
        if (stats && lane == 0) { float2 st; st.x = mean; st.y = rstd; stats[dst_row0 + r] = st; }
#pragma unroll
        for (int i = 0; i < 4; ++i) {
            const float4 g4 = ((const float4*)g)[lane + 64 * i], b4 = ((const float4*)b)[lane + 64 * i];
            float4 y; y.x = (v[i].x - mean) * rstd * g4.x + b4.x; y.y = (v[i].y - mean) * rstd * g4.y + b4.y; y.z = (v[i].z - mean) * rstd * g4.z + b4.z; y.w = (v[i].w - mean) * rstd * g4.w + b4.w;
            if (dst32) ((float4*)(dst32 + (dst_row0 + r) * 1024))[lane + 64 * i] = y;
            if (dst16) { u32x2 o; o.x = pk2(y.x, y.y); o.y = pk2(y.z, y.w); *(u32x2*)(dst16 + (dst_row0 + r) * 1024 + (lane + 64 * i) * 4) = o; }
        }
    }
}
__device__ __forceinline__ void phase0(const Params& p) {
    ln_rows(p.x, 0, NTOK, p.ln_in_g, p.ln_in_b, nullptr, (bf16_t*)(p.ws + OFF_HB), 0, (float2*)(p.ws + OFF_STATS));
    int tid_ = threadIdx.x; asm volatile("" : "+v"(tid_)); const int gt = blockIdx.x * NTHR + tid_, nt = gridDim.x * NTHR;
    float2* tw = (float2*)(p.ws + OFF_TW);
    for (int k = gt; k < FN; k += nt) { double s, c; sincospi(-2.0 * (double)k / (double)FN, &s, &c); float2 t; t.x = (float)c; t.y = (float)s; tw[k] = t; }
    bf16_t* mb = (bf16_t*)(p.ws + OFF_MEMBF);
    for (int i = gt; i < 2048 * 1024 / 4; i += nt) { const float4 v = ((const float4*)p.mem)[i]; u32x2 o; o.x = pk2(v.x, v.y); o.y = pk2(v.z, v.w); ((u32x2*)mb)[i] = o; }
    float* en = (float*)(p.ws + OFF_ENERGY);
    for (int i = gt; i < 1024; i += nt) en[i] = 0.f;
    float* ztab = (float*)(p.ws + OFF_ZT);
    for (int idx = gt; idx < 8192 * 33; idx += nt) {
        const int n = idx / 33, e = idx - n * 33;
        float v;
        if (e == 0) v = (float)n / 8191.0f;
        else {
            const int i = (e - 1) & 15;
            const double fr = 1e-4 + (double)i * ((15.0 - 1e-4) / 15.0);
            const double ang = (2.0 * 3.14159265358979323846 / 8192.0) * (double)n * fr;
            v = (e <= 16) ? (float)cos(ang) : (float)(-sin(ang));
        }
        ztab[idx] = v;
    }
}

__device__ __forceinline__ void wt_tile(const float* src, int src_ld, int k0, int on0, bf16_t* dst, int dst_ld, int dn0, bool zero, float* tile) {
    int tid_ = threadIdx.x; asm volatile("" : "+v"(tid_)); const int tid = tid_;
    if (!zero) {
#pragma unroll
        for (int i = 0; i < 2; ++i) {
            const int k = (tid >> 3) + 64 * i, c4 = (tid & 7) * 4;
            const float4 v = *(const float4*)(src + (size_t)(k0 + k) * src_ld + on0 + c4);
            float* t = tile + k * 33 + c4; t[0] = v.x; t[1] = v.y; t[2] = v.z; t[3] = v.w;
        }
    }
    __syncthreads();
    const int n = tid >> 4, kc = (tid & 15) * 8;
    float f[8];
#pragma unroll
    for (int e = 0; e < 8; ++e) f[e] = zero ? 0.f : tile[(kc + e) * 33 + n];
    u32x4 o; o.x = pk2(f[0], f[1]); o.y = pk2(f[2], f[3]); o.z = pk2(f[4], f[5]); o.w = pk2(f[6], f[7]);
    *(u32x4*)(dst + (size_t)(dn0 + n) * dst_ld + k0 + kc) = o;
    __syncthreads();
}
__device__ __forceinline__ void phase_weights(const Params& p, int l, unsigned char* lds) {
    float* tile = (float*)lds;
    for (int it = blockIdx.x; it < 3776; it += gridDim.x) {
        if (it < 2752) {
            const int nt = it >> 3, kt = it & 7, dn0 = nt * 32;
            wt_tile(p.w_in + (size_t)l * 1024 * NIN, NIN, kt * 128, orig_col(dn0), (bf16_t*)(p.ws + OFF_WTIN), 1024, dn0, dn0 >= NIN, tile);
        } else if (it < 3264) {
            const int r = it - 2752, j = r >> 7, nt = (r >> 2) & 31, kt = r & 3;
            wt_tile(p.w_br + (size_t)(l * 4 + j) * 512 * 1024, 1024, kt * 128, nt * 32, (bf16_t*)(p.ws + OFF_WTBR) + (size_t)j * 1024 * 512, 512, nt * 32, false, tile);
        } else if (it < 3520) {
            const int r = it - 3264, nt = r >> 3, kt = r & 7;
            wt_tile(p.w_out + (size_t)l * 1024 * 1024, 1024, kt * 128, nt * 32, (bf16_t*)(p.ws + OFF_WTOUT), 1024, nt * 32, false, tile);
        } else {
            const int r = it - 3520, nt = r >> 3, kt = r & 7;
            wt_tile(p.mem_w_kv + (size_t)l * 1024 * 1024, 1024, kt * 128, nt * 32, (bf16_t*)(p.ws + OFF_WTKV), 1024, nt * 32, false, tile);
        }
    }
}

__device__ __forceinline__ void phase_filter_gen(const Params& p, int l, unsigned char* lds) {
    float* zt = (float*)lds;
    float* ha = zt + 32 * 33;
    float* hbuf = ha + 32 * 64;
    int tid_ = threadIdx.x; asm volatile("" : "+v"(tid_)); const int tid = tid_;
    const float* w1 = p.hy_w1 + (size_t)l * 33 * 64; const float* b1 = p.hy_b1 + l * 64;
    const float* wm = p.hy_wm + (size_t)l * 2 * 64 * 64; const float* bm = p.hy_bm + l * 2 * 64;
    const float* w3 = p.hy_w3 + (size_t)l * 64 * 1024;
    float* hf = (float*)(p.ws + OFF_HFILT);
    float* en = (float*)(p.ws + OFF_ENERGY) + l * 512;
    const float* ztab = (const float*)(p.ws + OFF_ZT);
    for (int it = blockIdx.x; it < 256; it += gridDim.x) {
        const int n0 = it * 32;
        for (int idx = tid; idx < 32 * 33; idx += NTHR) zt[idx] = ztab[(size_t)n0 * 33 + idx];
        __syncthreads();
        for (int idx = tid; idx < 2048; idx += NTHR) {
            const int pos = idx >> 6, j = idx & 63; float s = b1[j];
            for (int e = 0; e < 33; ++e) s += zt[pos * 33 + e] * w1[e * 64 + j];
            ha[idx] = sinf(s);
        }
        __syncthreads();
        for (int idx = tid; idx < 2048; idx += NTHR) {
            const int pos = idx >> 6, j = idx & 63; float s = bm[j];
            for (int e = 0; e < 64; ++e) s += ha[pos * 64 + e] * wm[e * 64 + j];
            hbuf[idx] = sinf(s);
        }
        __syncthreads();
        for (int idx = tid; idx < 2048; idx += NTHR) {
            const int pos = idx >> 6, j = idx & 63; float s = bm[64 + j];
            for (int e = 0; e < 64; ++e) s += hbuf[pos * 64 + e] * wm[4096 + e * 64 + j];
            ha[idx] = sinf(s);
        }
        __syncthreads();
        {
            const int c = tid;
            float af[32], ab[32];
#pragma unroll
            for (int i = 0; i < 32; ++i) { af[i] = 0.f; ab[i] = 0.f; }
            for (int k = 0; k < 64; ++k) {
                const float wf = w3[k * 1024 + c], wb = w3[k * 1024 + 512 + c];
#pragma unroll
                for (int i = 0; i < 32; ++i) { const float h = ha[i * 64 + k]; af[i] += h * wf; ab[i] += h * wb; }
            }
            const float dmin = -3.0701134573253945f, dmax = -15.350567286626973f;
            const float delta = fabsf(dmin + (float)c * ((dmax - dmin) / 511.0f));
            float e = 0.f;
#pragma unroll
            for (int i = 0; i < 32; ++i) {
                const int n = n0 + i; const float t01 = (float)n / 8191.0f; const float win = expf(-t01 * delta);
                af[i] *= win; ab[i] *= win; e += af[i] * af[i]; if (n >= 1) e += ab[i] * ab[i];
            }
#pragma unroll
            for (int i = 0; i < 8; ++i) {
                float4 a; a.x = af[4 * i]; a.y = af[4 * i + 1]; a.z = af[4 * i + 2]; a.w = af[4 * i + 3];
                float4 b; b.x = ab[4 * i]; b.y = ab[4 * i + 1]; b.z = ab[4 * i + 2]; b.w = ab[4 * i + 3];
                *(float4*)(hf + (size_t)c * 8192 + n0 + 4 * i) = a;
                *(float4*)(hf + (size_t)(512 + c) * 8192 + n0 + 4 * i) = b;
            }
            atomicAdd(en + c, e);
        }
        __syncthreads();
    }
}

__device__ __forceinline__ void phase_filter_fft(const Params& p, int l, unsigned char* lds) {
    float2* d = (float2*)lds;
    const float2* tw = fft_lds_twiddles((const float2*)(p.ws + OFF_TW), lds);
    const float* hf = (const float*)(p.ws + OFF_HFILT);
    const float* en = (const float*)(p.ws + OFF_ENERGY) + l * 512;
    float4* pqa = (float4*)(p.ws + OFF_PQ);
    int tid_ = threadIdx.x; asm volatile("" : "+v"(tid_)); const int tid = tid_;
    for (int pr = blockIdx.x; pr < 256; pr += gridDim.x) {
        const int c0 = 2 * pr, c1 = c0 + 1;
        const float s0 = 1.0f / sqrtf(en[c0] + 1e-6f), s1 = 1.0f / sqrtf(en[c1] + 1e-6f);
        const float k0 = p.hy_skip[l * 512 + c0], k1 = p.hy_skip[l * 512 + c1];
        for (int n = tid; n < FN; n += NTHR) {
            float2 v;
            if (n < 8192) { v.x = hf[(size_t)c0 * 8192 + n] * s0; v.y = hf[(size_t)c1 * 8192 + n] * s1; if (n == 0) { v.x += k0; v.y += k1; } }
            else if (n == 8192) { v.x = 0.f; v.y = 0.f; }
            else { v.x = hf[(size_t)(512 + c0) * 8192 + (FN - n)] * s0; v.y = hf[(size_t)(512 + c1) * 8192 + (FN - n)] * s1; }
            d[n] = v;
        }
        __syncthreads();
        fft_forward<false>(d, tw, (const float2*)(p.ws + OFF_TW));
        for (int h = tid; h < FN / 2; h += NTHR) filt_pointwise(d, pqa + (size_t)pr * FN, 2 * h);
        if (tid == 0) filt_pointwise(d, pqa + (size_t)pr * FN, 1);
        __syncthreads();
    }
}

__device__ __forceinline__ void hy_pre_item(const Params& p, int l, const bf16_t* P, float* UT, bf16_t* GT, int bl, int tt, int ct, unsigned char* lds) {
    float* tU = (float*)lds;
    float* tG = tU + 64 * 65;
    int tid_ = threadIdx.x; asm volatile("" : "+v"(tid_)); const int tid = tid_;
    const int t = tid >> 3, cc = (tid & 7) * 8, c = ct * 64 + cc, tb = tt * 64 + t;
    const float* cw = p.hy_conv_w + (size_t)l * 3 * 1536; const float* cb = p.hy_conv_b + l * 1536;
    float av[8], a0[8], a1[8];
#pragma unroll
    for (int h = 0; h < 2; ++h) {
        const f32x4 bv = *(const f32x4*)(cb + c + 4 * h), b0 = *(const f32x4*)(cb + 512 + c + 4 * h), b1 = *(const f32x4*)(cb + 1024 + c + 4 * h);
#pragma unroll
        for (int e = 0; e < 4; ++e) { av[4 * h + e] = bv[e]; a0[4 * h + e] = b0[e]; a1[4 * h + e] = b1[e]; }
    }
#pragma unroll
    for (int j = 0; j < 3; ++j) {
        const int ts = tb + j - 1;
        if (ts >= 0 && ts < SEQ) {
            const bf16_t* row = P + (size_t)(bl * SEQ + ts) * PS + C_HY + c;
            const u32x4 rv = *(const u32x4*)row, r0 = *(const u32x4*)(row + 512), r1 = *(const u32x4*)(row + 1024);
#pragma unroll
            for (int h = 0; h < 2; ++h) {
                const f32x4 wv = *(const f32x4*)(cw + j * 1536 + c + 4 * h), w0 = *(const f32x4*)(cw + j * 1536 + 512 + c + 4 * h), w1 = *(const f32x4*)(cw + j * 1536 + 1024 + c + 4 * h);
#pragma unroll
                for (int e = 0; e < 4; ++e) {
                    const int k = 4 * h + e; const unsigned uv = rv[k >> 1], u0 = r0[k >> 1], u1 = r1[k >> 1];
                    av[k] += wv[e] * ((k & 1) ? hi16(uv) : lo16(uv)); a0[k] += w0[e] * ((k & 1) ? hi16(u0) : lo16(u0)); a1[k] += w1[e] * ((k & 1) ? hi16(u1) : lo16(u1));
                }
            }
        }
    }
    const u32x4 rz = *(const u32x4*)(P + (size_t)(bl * SEQ + tb) * PS + C_Z + 512 + c);
#pragma unroll
    for (int k = 0; k < 8; ++k) {
        const unsigned uz = rz[k >> 1]; const float z = (k & 1) ? hi16(uz) : lo16(uz);
        tU[(cc + k) * 65 + t] = av[k] * a1[k]; tG[(cc + k) * 65 + t] = a0[k] * z;
    }
    __syncthreads();
    const int c2 = tid >> 3, t8 = (tid & 7) * 8;
    const size_t o = (size_t)(bl * 512 + ct * 64 + c2) * SEQ + tt * 64 + t8;
    const float* su = tU + c2 * 65 + t8; const float* sg = tG + c2 * 65 + t8;
    f32x4 ua = {su[0], su[1], su[2], su[3]}, ub = {su[4], su[5], su[6], su[7]};
    *(f32x4*)(UT + o) = ua; *(f32x4*)(UT + o + 4) = ub;
    u32x4 g; g.x = pk2(sg[0], sg[1]); g.y = pk2(sg[2], sg[3]); g.z = pk2(sg[4], sg[5]); g.w = pk2(sg[6], sg[7]);
    *(u32x4*)(GT + o) = g;
    __syncthreads();
}
__device__ __forceinline__ void hy_post_item(bf16_t* P, const bf16_t* GT, int bl, int tt, int ct, unsigned char* lds, int dry = 0) {
    bf16_t* tl = (bf16_t*)lds;
    int tid_ = threadIdx.x; asm volatile("" : "+v"(tid_)); const int tid = tid_;
    const int c2 = tid >> 3, t8 = (tid & 7) * 8;
    const u32x4 v = *(const u32x4*)(GT + (size_t)(bl * 512 + ct * 64 + c2) * SEQ + tt * 64 + t8);
    bf16_t* d0 = tl + t8 * 72 + c2;
    d0[0 * 72] = (bf16_t)(v.x & 0xffffu); d0[1 * 72] = (bf16_t)(v.x >> 16); d0[2 * 72] = (bf16_t)(v.y & 0xffffu); d0[3 * 72] = (bf16_t)(v.y >> 16);
    d0[4 * 72] = (bf16_t)(v.z & 0xffffu); d0[5 * 72] = (bf16_t)(v.z >> 16); d0[6 * 72] = (bf16_t)(v.w & 0xffffu); d0[7 * 72] = (bf16_t)(v.w >> 16);
    __syncthreads();
    const int t = tid >> 3, cc = (tid & 7) * 8;
    const u32x4 ov = *(const u32x4*)(tl + t * 72 + cc);
    if (!dry) *(u32x4*)(P + (size_t)(bl * SEQ + tt * 64 + t) * PS + C_HY + ct * 64 + cc) = ov;
    __syncthreads();
}
__device__ __forceinline__ void hyena_conv_item(const Params& p, const float* UT, bf16_t* GT, int bl, int pr, unsigned char* lds, const float2* tw, int dry = 0) {
    float2* d = (float2*)lds;
    const float4* pq = (const float4*)(p.ws + OFF_PQ) + (size_t)pr * FN;
    int tid_ = threadIdx.x; asm volatile("" : "+v"(tid_)); const int tid = tid_;
    const float* u0 = UT + (size_t)(bl * 512 + 2 * pr) * SEQ; const float* u1 = u0 + SEQ;
    bf16_t* g0 = GT + (size_t)(bl * 512 + 2 * pr) * SEQ; bf16_t* g1 = g0 + SEQ;
    {
        float f0[16], f1[16];
#pragma unroll
        for (int i = 0; i < 16; ++i) { f0[i] = u0[tid + NTHR * i]; f1[i] = u1[tid + NTHR * i]; }
#pragma unroll
        for (int i = 0; i < 16; ++i) {
            float2 u; u.x = f0[i]; u.y = f1[i]; d[tid + NTHR * i] = u;
        }
    }
    __syncthreads();
    fft_forward<true>(d, tw, (const float2*)(p.ws + OFF_TW));
#pragma unroll 1
    for (int h = tid; h < FN / 2; h += 4 * NTHR) {
        PwIn w0, w1, w2, w3;
        pw_load(w0, d, pq, 2 * h); pw_load(w1, d, pq, 2 * (h + NTHR)); pw_load(w2, d, pq, 2 * (h + 2 * NTHR)); pw_load(w3, d, pq, 2 * (h + 3 * NTHR));
        pw_store(w0, d); pw_store(w1, d); pw_store(w2, d); pw_store(w3, d);
    }
    if (tid == 0) conv_pointwise(d, pq, 1);
    __syncthreads();
    fft_inverse<true>(d, tw, (const float2*)(p.ws + OFF_TW));
    {
        bf16_t a0[16], a1[16];
#pragma unroll
        for (int i = 0; i < 16; ++i) { a0[i] = g0[tid + NTHR * i]; a1[i] = g1[tid + NTHR * i]; }
#pragma unroll
        for (int i = 0; i < 16; ++i) {
            const int t = tid + NTHR * i;
            const float2 y = d[t];
            const bf16_t r0 = f2bf(y.x * bf2f(a0[i])), r1 = f2bf(y.y * bf2f(a1[i]));
            if (!dry) { g0[t] = r0; g1[t] = r1; }
        }
    }
    __syncthreads();
}

__device__ __forceinline__ void na_item(const Params& p, int l, bf16_t* P, int bl, int rp, int head, unsigned char* lds, int dry = 0) {
    bf16_t* Kimg = (bf16_t*)lds;
    bf16_t* VT = (bf16_t*)(lds + 82944);
    int tid_ = threadIdx.x; asm volatile("" : "+v"(tid_)); const int tid = tid_, lane = tid & 63, w = tid >> 6, l15 = lane & 15, q4 = lane >> 4;
    const int r0 = 2 * rp, rs0 = iclamp(r0 - 4, 0, 120);
#pragma unroll
    for (int i = 0; i < 9; ++i) {
        const int idx = tid + NTHR * i, key = idx >> 3, ch = idx & 7, grow = min(rs0 + (key >> 6), 127);
        const u32x4 kv = *(const u32x4*)(P + (size_t)(bl * SEQ + grow * 64 + (key & 63)) * PS + C_NAK + head * 64 + ch * 8);
        *(u32x4*)(Kimg + key * 72 + ch * 8) = kv;
    }
#pragma unroll
    for (int i = 0; i < 9; ++i) {
        const int idx = tid + NTHR * i, keyp = idx >> 2, chh = keyp >= 576 ? 1 : 0, key = keyp - chh * 576, ch = chh * 4 + (idx & 3), grow = min(rs0 + (key >> 6), 127);
        const u32x4 vv = *(const u32x4*)(P + (size_t)(bl * SEQ + grow * 64 + (key & 63)) * PS + C_NAV + head * 64 + ch * 8);
        bf16_t* vd = VT + (ch * 8) * 584 + key;
        vd[0 * 584] = (bf16_t)(vv.x & 0xffffu); vd[1 * 584] = (bf16_t)(vv.x >> 16);
        vd[2 * 584] = (bf16_t)(vv.y & 0xffffu); vd[3 * 584] = (bf16_t)(vv.y >> 16);
        vd[4 * 584] = (bf16_t)(vv.z & 0xffffu); vd[5 * 584] = (bf16_t)(vv.z >> 16);
        vd[6 * 584] = (bf16_t)(vv.w & 0xffffu); vd[7 * 584] = (bf16_t)(vv.w >> 16);
    }
    __syncthreads();
    const int rr = w >> 2, g = w & 3, r = r0 + rr, rs = iclamp(r - 4, 0, 120), lo = rs - rs0;
    const int cb = iclamp(16 * g - 8, 0, 32), c = 16 * g + l15, cs = iclamp(c - 8, 0, 48);
    bf16_t* qrow = P + (size_t)(bl * SEQ + r * 64 + c) * PS + head * 64;
    bf16x8 qf[2];
#pragma unroll
    for (int ks = 0; ks < 2; ++ks) qf[ks] = *(const bf16x8*)(qrow + ks * 32 + q4 * 8);
    f32x4 sc[16];
#pragma unroll
    for (int t = 0; t < 16; ++t) {
        const int kb = (lo + (t >> 1)) * 64 + cb + 16 * (t & 1);
        f32x4 a = {0.f, 0.f, 0.f, 0.f};
#pragma unroll
        for (int ks = 0; ks < 2; ++ks) { const bf16x8 kf = *(const bf16x8*)(Kimg + (kb + l15) * 72 + ks * 32 + q4 * 8); a = MFMA(kf, qf[ks], a); }
        sc[t] = a;
    }
    const float* rpb = p.na_rpb + (size_t)(l * 8 + head) * 15 * 31;
    float mx = -1e30f;
#pragma unroll
    for (int t = 0; t < 16; ++t) {
        const int drow = rs + (t >> 1) - r + 7;
#pragma unroll
        for (int e = 0; e < 4; ++e) {
            const int col = cb + 16 * (t & 1) + 4 * q4 + e;
            const bool ok = (col >= cs) && (col < cs + 16);
            const int dcol = ok ? (col - c + 15) : 0;
            const float v = ok ? (sc[t][e] + rpb[drow * 31 + dcol]) : -1e30f;
            sc[t][e] = v; mx = fmaxf(mx, v);
        }
    }
    mx = fmaxf(mx, __shfl_xor(mx, 16)); mx = fmaxf(mx, __shfl_xor(mx, 32));
    float sum = 0.f;
#pragma unroll
    for (int t = 0; t < 16; ++t)
#pragma unroll
        for (int e = 0; e < 4; ++e) { const float pe = __expf(sc[t][e] - mx); sc[t][e] = pe; sum += pe; }
    sum += __shfl_xor(sum, 16); sum += __shfl_xor(sum, 32);
    f32x4 o[4];
#pragma unroll
    for (int dt = 0; dt < 4; ++dt) o[dt] = (f32x4){0.f, 0.f, 0.f, 0.f};
#pragma unroll
    for (int kk = 0; kk < 8; ++kk) {
        u32x4 pu; pu.x = pk2(sc[2 * kk][0], sc[2 * kk][1]); pu.y = pk2(sc[2 * kk][2], sc[2 * kk][3]); pu.z = pk2(sc[2 * kk + 1][0], sc[2 * kk + 1][1]); pu.w = pk2(sc[2 * kk + 1][2], sc[2 * kk + 1][3]);
        const bf16x8 pf = mkfrag(pu);
        const int kbA = (lo + kk) * 64 + cb + 4 * q4;
#pragma unroll
        for (int dt = 0; dt < 4; ++dt) {
            const bf16_t* vr = VT + (dt * 16 + l15) * 584 + kbA;
            const bf16x8 vf = mkfrag2(*(const u32x2*)vr, *(const u32x2*)(vr + 16));
            o[dt] = MFMA(vf, pf, o[dt]);
        }
    }
    const float inv = 1.0f / sum;
    const bf16_t* zrow = P + (size_t)(bl * SEQ + r * 64 + c) * PS + C_Z + head * 64;
#pragma unroll
    for (int dt = 0; dt < 4; ++dt) {
        const int dd = dt * 16 + 4 * q4;
        const f32x4 z = ld_bf4(zrow + dd);
        if (!dry) st_bf4(qrow + dd, o[dt] * inv * z);
    }
    __syncthreads();
}

__device__ __forceinline__ void memattn_load(const Params& p, int b, int h, unsigned char* lds) {
    bf16_t* Kimg = (bf16_t*)lds;
    bf16_t* VT = (bf16_t*)(lds + 69632);
    const bf16_t* Km = (const bf16_t*)(p.ws + OFF_KMAT); const bf16_t* Vm = (const bf16_t*)(p.ws + OFF_VT);
    int tid_ = threadIdx.x; asm volatile("" : "+v"(tid_)); const int tid = tid_;
#pragma unroll
    for (int i = 0; i < 8; ++i) {
        const int idx = tid + NTHR * i;
        { const int key = idx >> 4, ch = idx & 15; *(u32x4*)(Kimg + key * 136 + ch * 8) = *(const u32x4*)(Km + (size_t)(b * 256 + key) * 512 + h * 128 + ch * 8); }
        { const int dd = idx >> 5, ch = idx & 31; *(u32x4*)(VT + dd * 264 + ch * 8) = *(const u32x4*)(Vm + (size_t)(h * 128 + dd) * 2048 + b * 256 + ch * 8); }
    }
    __syncthreads();
}
__device__ __forceinline__ void memattn_item(bf16_t* P, int bl, int h, int qt, unsigned char* lds, int dry = 0) {
    const bf16_t* Kimg = (const bf16_t*)lds; const bf16_t* VT = (const bf16_t*)(lds + 69632);
    int tid_ = threadIdx.x; asm volatile("" : "+v"(tid_)); const int tid = tid_, lane = tid & 63, w = tid >> 6, l15 = lane & 15, q4 = lane >> 4;
    const int tok = bl * SEQ + qt * 128 + w * 16 + l15;
    bf16_t* qrow = P + (size_t)tok * PS + C_MQ + h * 128;
    bf16x8 qf[4];
#pragma unroll
    for (int ks = 0; ks < 4; ++ks) qf[ks] = *(const bf16x8*)(qrow + ks * 32 + q4 * 8);
    f32x4 sc[16];
    float mx = -1e30f;
#pragma unroll
    for (int t = 0; t < 16; ++t) {
        f32x4 a = {0.f, 0.f, 0.f, 0.f};
#pragma unroll
        for (int ks = 0; ks < 4; ++ks) { const bf16x8 kf = *(const bf16x8*)(Kimg + (t * 16 + l15) * 136 + ks * 32 + q4 * 8); a = MFMA(kf, qf[ks], a); }
        sc[t] = a;
        mx = fmaxf(mx, fmaxf(fmaxf(a[0], a[1]), fmaxf(a[2], a[3])));
    }
    mx = fmaxf(mx, __shfl_xor(mx, 16)); mx = fmaxf(mx, __shfl_xor(mx, 32));
    float sum = 0.f;
#pragma unroll
    for (int t = 0; t < 16; ++t)
#pragma unroll
        for (int e = 0; e < 4; ++e) { const float pe = __expf(sc[t][e] - mx); sc[t][e] = pe; sum += pe; }
    sum += __shfl_xor(sum, 16); sum += __shfl_xor(sum, 32);
    f32x4 o[8];
#pragma unroll
    for (int dt = 0; dt < 8; ++dt) o[dt] = (f32x4){0.f, 0.f, 0.f, 0.f};
#pragma unroll
    for (int kk = 0; kk < 8; ++kk) {
        u32x4 pu; pu.x = pk2(sc[2 * kk][0], sc[2 * kk][1]); pu.y = pk2(sc[2 * kk][2], sc[2 * kk][3]); pu.z = pk2(sc[2 * kk + 1][0], sc[2 * kk + 1][1]); pu.w = pk2(sc[2 * kk + 1][2], sc[2 * kk + 1][3]);
        const bf16x8 pf = mkfrag(pu);
#pragma unroll
        for (int dt = 0; dt < 8; ++dt) {
            const bf16_t* vr = VT + (dt * 16 + l15) * 264 + kk * 32 + 4 * q4;
            const bf16x8 vf = mkfrag2(*(const u32x2*)vr, *(const u32x2*)(vr + 16));
            o[dt] = MFMA(vf, pf, o[dt]);
        }
    }
    const float inv = 1.0f / sum;
    const bf16_t* zrow = P + (size_t)tok * PS + C_Z + 3 * 512 + h * 128;
#pragma unroll
    for (int dt = 0; dt < 8; ++dt) {
        const int dd = dt * 16 + 4 * q4;
        const f32x4 z = ld_bf4(zrow + dd);
        if (!dry) st_bf4(qrow + dd, o[dt] * inv * z);
    }
}

constexpr int G_LRT = 0, G_BF = 8192, G_BB = 24576, G_TOT = 40960, G_IMG = 45056;
__device__ __forceinline__ void gla_tables(const Params& p, int l, const float* LR, int t0, int h, unsigned char* lds) {
    float* LRT = (float*)(lds + G_LRT); float* BF = (float*)(lds + G_BF); float* BB = (float*)(lds + G_BB); float* TOT = (float*)(lds + G_TOT);
    int tid_ = threadIdx.x; asm volatile("" : "+v"(tid_)); const int tid = tid_;
    ((float4*)LRT)[tid] = ((const float4*)(LR + (size_t)t0 * 32))[tid];
    __syncthreads();
    const int dk = tid & 63, cgp = tid >> 6;
    float uf[16], ub[16];
#pragma unroll
    for (int r = 0; r < 16; ++r) { uf[r] = p.gla_up_f[(size_t)(l * 16 + r) * 256 + h * 64 + dk]; ub[r] = p.gla_up_b[(size_t)(l * 16 + r) * 256 + h * 64 + dk]; }
    const float bif = p.gla_bias_f[l * 256 + h * 64 + dk], bib = p.gla_bias_b[l * 256 + h * 64 + dk];
    float lf[8], lb[8];
#pragma unroll
    for (int i = 0; i < 8; ++i) {
        const int c = cgp * 8 + i; float sf = bif, sb = bib;
#pragma unroll
        for (int r = 0; r < 16; ++r) { sf += LRT[c * 32 + r] * uf[r]; sb += LRT[c * 32 + 16 + r] * ub[r]; }
        lf[i] = logsigf_(sf) * (1.0f / 16.0f); lb[i] = logsigf_(sb) * (1.0f / 16.0f);
    }
#pragma unroll
    for (int i = 1; i < 8; ++i) lf[i] += lf[i - 1];
#pragma unroll
    for (int i = 6; i >= 0; --i) lb[i] += lb[i + 1];
    TOT[cgp * 64 + dk] = lf[7]; TOT[512 + cgp * 64 + dk] = lb[0];
    __syncthreads();
    float of = 0.f, ob = 0.f;
#pragma unroll
    for (int g2 = 0; g2 < 8; ++g2) { if (g2 < cgp) of += TOT[g2 * 64 + dk]; if (g2 > cgp) ob += TOT[512 + g2 * 64 + dk]; }
#pragma unroll
    for (int i = 0; i < 8; ++i) { BF[(cgp * 8 + i) * 64 + dk] = lf[i] + of; BB[(cgp * 8 + i) * 64 + dk] = lb[i] + ob; }
    __syncthreads();
}
struct GlaPre { u32x4 vv[2]; bf16_t q[8], k[8]; };
__device__ __forceinline__ void gla_prefetch(GlaPre& g, const bf16_t* P, int t0, int h, int tid) {
#pragma unroll
    for (int i = 0; i < 2; ++i) { const int idx = tid + NTHR * i, chn = idx >> 6, c = idx & 63; g.vv[i] = *(const u32x4*)(P + (size_t)(t0 + c) * PS + C_GV + h * 128 + chn * 8); }
#pragma unroll
    for (int i = 0; i < 8; ++i) { const int idx = tid + NTHR * i, c = idx >> 6, dk = idx & 63; g.q[i] = P[(size_t)(t0 + c) * PS + C_GQ + h * 64 + dk]; g.k[i] = P[(size_t)(t0 + c) * PS + C_GK + h * 64 + dk]; }
}
__device__ __forceinline__ void gla_vt_store(const GlaPre& g, bf16_t* VT, int tid) {
#pragma unroll
    for (int i = 0; i < 2; ++i) {
        const int idx = tid + NTHR * i, chn = idx >> 6, c = idx & 63;
        const u32x4 vv = g.vv[i];
        bf16_t* vd = VT + (chn * 8) * 72 + c;
        vd[0 * 72] = (bf16_t)(vv.x & 0xffffu); vd[1 * 72] = (bf16_t)(vv.x >> 16);
        vd[2 * 72] = (bf16_t)(vv.y & 0xffffu); vd[3 * 72] = (bf16_t)(vv.y >> 16);
        vd[4 * 72] = (bf16_t)(vv.z & 0xffffu); vd[5 * 72] = (bf16_t)(vv.z >> 16);
        vd[6 * 72] = (bf16_t)(vv.w & 0xffffu); vd[7 * 72] = (bf16_t)(vv.w >> 16);
    }
}
__device__ __forceinline__ void gla_part1_item(const Params& p, int l, const bf16_t* P, const float* LR, int item, unsigned char* lds) {
    const int h = item & 3, n = (item >> 2) & 127, bl = item >> 9, t0 = bl * SEQ + n * 64;
    const float* BF = (const float*)(lds + G_BF); const float* BB = (const float*)(lds + G_BB);
    bf16_t* KDT0 = (bf16_t*)(lds + G_IMG); bf16_t* KDT1 = KDT0 + 64 * 72; bf16_t* VT = KDT1 + 64 * 72;
    float* GS = (float*)(p.ws + OFF_GS); float* GD = (float*)(p.ws + OFF_GDEC);
    int tid_ = threadIdx.x; asm volatile("" : "+v"(tid_)); const int tid = tid_, lane = tid & 63, w = tid >> 6, l15 = lane & 15, q4 = lane >> 4;
    GlaPre gp; gla_prefetch(gp, P, t0, h, tid);
    gla_tables(p, l, LR, t0, h, lds);
#pragma unroll
    for (int i = 0; i < 8; ++i) {
        const int idx = tid + NTHR * i, c = idx >> 6, dk = idx & 63;
        const float kv = bf2f(gp.k[i]);
        KDT0[dk * 72 + c] = f2bf(kv * __expf(BF[63 * 64 + dk] - BF[c * 64 + dk]));
        KDT1[dk * 72 + c] = f2bf(kv * __expf(BB[dk] - BB[c * 64 + dk]));
    }
    gla_vt_store(gp, VT, tid);
    if (tid < 64) GD[(size_t)item * 64 + tid] = __expf(BF[63 * 64 + tid]);
    else if (tid < 128) GD[(size_t)(NITEM + item) * 64 + tid - 64] = __expf(BB[tid - 64]);
    __syncthreads();
    const int dir = w >> 2, dkt = w & 3;
    const bf16_t* KD = dir ? KDT1 : KDT0;
    bf16x8 kf[2];
#pragma unroll
    for (int ks = 0; ks < 2; ++ks) kf[ks] = *(const bf16x8*)(KD + (16 * dkt + l15) * 72 + 32 * ks + 8 * q4);
    float* dst = GS + ((size_t)dir * NITEM + item) * 8192;
#pragma unroll
    for (int dvt = 0; dvt < 8; ++dvt) {
        f32x4 a = {0.f, 0.f, 0.f, 0.f};
#pragma unroll
        for (int ks = 0; ks < 2; ++ks) { const bf16x8 vf = *(const bf16x8*)(VT + (16 * dvt + l15) * 72 + 32 * ks + 8 * q4); a = MFMA(kf[ks], vf, a); }
        *(f32x4*)(dst + (16 * dvt + l15) * 64 + 16 * dkt + 4 * q4) = a;
    }
    __syncthreads();
}
__device__ __forceinline__ void gla_scan(const Params& p, int dry = 0) {
    float* GS = (float*)(p.ws + OFF_GS); const float* GD = (const float*)(p.ws + OFF_GDEC);
    const int total = 2 * BG * 4 * 8192;
    int tid_ = threadIdx.x; asm volatile("" : "+v"(tid_));
    for (int id = blockIdx.x * NTHR + tid_; id < total; id += gridDim.x * NTHR) {
        const int e = id & 8191, comb = id >> 13, h = comb & 3, bl = (comb >> 2) % BG, dir = comb / (4 * BG), dk = e & 63;
        float S = 0.f;
        const size_t ibase = (size_t)dir * NITEM + (size_t)(bl * 128) * 4 + h;
        for (int s0 = 0; s0 < 128; s0 += 16) {
            float u[16], dc[16];
#pragma unroll
            for (int i = 0; i < 16; ++i) {
                const int n = dir ? 127 - (s0 + i) : s0 + i;
                const size_t item = ibase + (size_t)n * 4;
                u[i] = GS[item * 8192 + e]; dc[i] = GD[item * 64 + dk];
            }
#pragma unroll
            for (int i = 0; i < 16; ++i) {
                const int n = dir ? 127 - (s0 + i) : s0 + i;
                const size_t item = ibase + (size_t)n * 4;
                if (!dry) GS[item * 8192 + e] = S;
                S = dc[i] * S + u[i];
            }
        }
    }
}
__device__ __forceinline__ void gla_part2_item(const Params& p, int l, bf16_t* P, const float* LR, int item, unsigned char* lds, int dry = 0) {
    const int h = item & 3, n = (item >> 2) & 127, bl = item >> 9, t0 = bl * SEQ + n * 64;
    const float* BF = (const float*)(lds + G_BF); const float* BB = (const float*)(lds + G_BB);
    bf16_t* QF = (bf16_t*)(lds + G_IMG);
    bf16_t* KF = QF + 2 * 64 * 72;
    bf16_t* QD = KF + 2 * 64 * 72;
    bf16_t* VT = QD + 2 * 64 * 72;
    bf16_t* ST = VT + 128 * 72;
    float* OX = (float*)lds;
    const float* GS = (const float*)(p.ws + OFF_GS);
    int tid_ = threadIdx.x; asm volatile("" : "+v"(tid_)); const int tid = tid_, lane = tid & 63, w = tid >> 6, l15 = lane & 15, q4 = lane >> 4;
    GlaPre gp; gla_prefetch(gp, P, t0, h, tid);
    float4 sp[2][4];
#pragma unroll
    for (int dir = 0; dir < 2; ++dir)
#pragma unroll
        for (int i = 0; i < 4; ++i) { const int idx = tid + NTHR * i; sp[dir][i] = *(const float4*)(GS + ((size_t)dir * NITEM + item) * 8192 + (idx >> 4) * 64 + (idx & 15) * 4); }
    gla_tables(p, l, LR, t0, h, lds);
#pragma unroll
    for (int i = 0; i < 8; ++i) {
        const int idx = tid + NTHR * i, c = idx >> 6, dk = idx & 63;
        const float qv = bf2f(gp.q[i]);
        const float kv = bf2f(gp.k[i]);
        const float bf = BF[c * 64 + dk], mf = BF[31 * 64 + dk], bb = BB[c * 64 + dk], mb = BB[32 * 64 + dk];
        QF[c * 72 + dk] = f2bf(qv * __expf(bf - mf)); KF[c * 72 + dk] = f2bf(kv * __expf(mf - bf)); QD[c * 72 + dk] = f2bf(qv * __expf(bf));
        QF[4608 + c * 72 + dk] = f2bf(qv * __expf(bb - mb)); KF[4608 + c * 72 + dk] = f2bf(kv * __expf(mb - bb)); QD[4608 + c * 72 + dk] = f2bf(qv * __expf(bb));
    }
    gla_vt_store(gp, VT, tid);
#pragma unroll
    for (int dir = 0; dir < 2; ++dir) {
#pragma unroll
        for (int i = 0; i < 4; ++i) {
            const int idx = tid + NTHR * i, dv = idx >> 4, dk4 = (idx & 15) * 4;
            const float4 s = sp[dir][i];
            u32x2 o; o.x = pk2(s.x, s.y); o.y = pk2(s.z, s.w);
            *(u32x2*)(ST + dir * 9216 + dv * 72 + dk4) = o;
        }
    }
    __syncthreads();
    const int dir = w >> 2, ct = w & 3;
    const bf16_t* qfp = QF + dir * 4608; const bf16_t* kfp = KF + dir * 4608; const bf16_t* qdp = QD + dir * 4608; const bf16_t* stp = ST + dir * 9216;
    bf16x8 qf[2], qd[2];
#pragma unroll
    for (int ks = 0; ks < 2; ++ks) { qf[ks] = *(const bf16x8*)(qfp + (16 * ct + l15) * 72 + 32 * ks + 8 * q4); qd[ks] = *(const bf16x8*)(qdp + (16 * ct + l15) * 72 + 32 * ks + 8 * q4); }
    f32x4 sc[4];
    const int cq = 16 * ct + l15;
#pragma unroll
    for (int st = 0; st < 4; ++st) {
        f32x4 a = {0.f, 0.f, 0.f, 0.f};
#pragma unroll
        for (int ks = 0; ks < 2; ++ks) { const bf16x8 kf = *(const bf16x8*)(kfp + (16 * st + l15) * 72 + 32 * ks + 8 * q4); a = MFMA(kf, qf[ks], a); }
#pragma unroll
        for (int e = 0; e < 4; ++e) { const int s = 16 * st + 4 * q4 + e; const bool ok = dir ? (s > cq) : (s <= cq); a[e] = ok ? a[e] : 0.f; }
        sc[st] = a;
    }
    f32x4 o[8];
#pragma unroll
    for (int dt = 0; dt < 8; ++dt) o[dt] = (f32x4){0.f, 0.f, 0.f, 0.f};
#pragma unroll
    for (int kk = 0; kk < 2; ++kk) {
        u32x4 pu; pu.x = pk2(sc[2 * kk][0], sc[2 * kk][1]); pu.y = pk2(sc[2 * kk][2], sc[2 * kk][3]); pu.z = pk2(sc[2 * kk + 1][0], sc[2 * kk + 1][1]); pu.w = pk2(sc[2 * kk + 1][2], sc[2 * kk + 1][3]);
        const bf16x8 pf = mkfrag(pu);
#pragma unroll
        for (int dt = 0; dt < 8; ++dt) {
            const bf16_t* vr = VT + (dt * 16 + l15) * 72 + kk * 32 + 4 * q4;
            const bf16x8 vf = mkfrag2(*(const u32x2*)vr, *(const u32x2*)(vr + 16));
            o[dt] = MFMA(vf, pf, o[dt]);
        }
    }
#pragma unroll
    for (int ks = 0; ks < 2; ++ks)
#pragma unroll
        for (int dt = 0; dt < 8; ++dt) { const bf16x8 sf = *(const bf16x8*)(stp + (dt * 16 + l15) * 72 + 32 * ks + 8 * q4); o[dt] = MFMA(sf, qd[ks], o[dt]); }
    if (dir == 1) {
#pragma unroll
        for (int dt = 0; dt < 8; ++dt) *(f32x4*)(OX + cq * 132 + 16 * dt + 4 * q4) = o[dt];
    }
    __syncthreads();
    if (dir == 0) {
        float ss = 0.f;
#pragma unroll
        for (int dt = 0; dt < 8; ++dt) { o[dt] += *(const f32x4*)(OX + cq * 132 + 16 * dt + 4 * q4); ss += (o[dt][0] * o[dt][0] + o[dt][1] * o[dt][1]) + (o[dt][2] * o[dt][2] + o[dt][3] * o[dt][3]); }
        ss += __shfl_xor(ss, 16); ss += __shfl_xor(ss, 32);
        const float rms = 1.0f / sqrtf(ss * (1.0f / 128.0f) + 1e-6f);
        const float* ng = p.gla_norm_g + l * 512 + h * 128;
        const bf16_t* zrow = P + (size_t)(t0 + cq) * PS + C_Z + 2 * 512 + h * 128;
        bf16_t* orow = P + (size_t)(t0 + cq) * PS + C_GV + h * 128;
#pragma unroll
        for (int dt = 0; dt < 8; ++dt) {
            const int dd = 16 * dt + 4 * q4;
            const f32x4 z = ld_bf4(zrow + dd); const f32x4 g4 = *(const f32x4*)(ng + dd);
            if (!dry) st_bf4(orow + dd, o[dt] * rms * g4 * z);
        }
    }
    __syncthreads();
}

namespace pg8 {
#define PG8_LAS __attribute__((address_space(3)))
typedef unsigned short bf16_t;
typedef short bf16x8 __attribute__((ext_vector_type(8)));
typedef float f32x4 __attribute__((ext_vector_type(4)));
typedef unsigned u32x4 __attribute__((ext_vector_type(4)));
constexpr int BM = 256, BK = 64, HALF = 128, HTB = HALF * BK * 2  , STAGE_BYTES = 8 * HTB, NXCD = 8, WGM = 8;

__host__ __device__ __forceinline__ int lds_byte(int r, int c) { const int st = (r >> 4) * 2 + (c >> 5), rr = r & 15, cc = c & 31, ob = rr * 64 + cc * 2; return st * 1024 + (ob ^ (((ob >> 9) & 1) << 5)); }
__host__ __device__ __forceinline__ void stage_rc(int b, int& R, int& C) { const int st = b / 1024, sb = b % 1024, swz = sb ^ (((sb >> 9) & 1) << 5); R = (st >> 1) * 16 + swz / 64; C = (st & 1) * 32 + (swz % 64) / 2; }
__host__ __device__ __forceinline__ int perm32(int rho) { const int n = rho >> 4, i = rho & 15; return 8 * (i >> 2) + 4 * n + (i & 3); }

struct Unit { int pm, pn; };
struct Gemm { const bf16_t* A; const bf16_t* Bt; int M, N, K; };

struct StaticOrder {
    int nM, nN, nwg, G, c;
    __host__ __device__ __forceinline__ void init(int M, int N, int G_, int c_) { nM = M / BM; nN = N / BM; nwg = nM * nN; G = G_; c = c_; }
    __host__ __device__ bool next(int i, Unit& u) const {
        const long L = (long)i * G + c; if (L >= nwg) return false;
        int wgid = (int)L; { const int q = nwg / NXCD, r = nwg % NXCD, xcd = wgid % NXCD, off = wgid / NXCD; wgid = (xcd < r ? xcd * (q + 1) : r * (q + 1) + (xcd - r) * q) + off; }
        const int nig = WGM * nN, gid = wgid / nig, fm = gid * WGM, gsz = (nM - fm) < WGM ? (nM - fm) : WGM;
        u.pm = fm + ((wgid % nig) % gsz); u.pn = (wgid % nig) / gsz; return true;
    }
    __device__ __forceinline__ void a_ready(const Unit&) const {}
    __device__ __forceinline__ void done(const Unit&) const {}
};
__device__ __forceinline__ unsigned cvt_pk_bf16(float lo, float hi) { unsigned r; asm volatile("v_cvt_pk_bf16_f32 %0, %1, %2" : "=v"(r) : "v"(lo), "v"(hi)); return r; }
template <class Epi, class Sched, bool STAMP = false>
__device__ __forceinline__ void gemm_phase(PG8_LAS unsigned char* lds, const Gemm g, const Sched& S, const Epi& E, unsigned long long* stamps) {
    int tid_l = threadIdx.x; asm volatile("" : "+v"(tid_l)); const int tid = tid_l, wid = __builtin_amdgcn_readfirstlane(tid >> 6), lane = tid & 63, wr = wid >> 2, wc = wid & 3, fr = lane & 15, fq = lane >> 4;
    const int K = g.K, nt = K / BK;
    int ts_lo = 0, ts_hi = 0, nts = 0; const unsigned long long rt_entry = STAMP ? (unsigned long long)wall_clock64() : 0ull;
#define PG8_STAMP() do { if (STAMP && wid == 0 && nts < 64) { const unsigned long long _c = (unsigned long long)clock64(); \
        ts_lo = (lane == nts) ? (int)(unsigned)_c : ts_lo; ts_hi = (lane == nts) ? (int)(unsigned)(_c >> 32) : ts_hi; ++nts; } } while (0)
    PG8_STAMP();
    unsigned voffA[2], voffB[2];
#pragma unroll
    for (int i = 0; i < 2; ++i) { int R, C; stage_rc(tid * 16 + i * 8192, R, C); const int Rb = Epi::PERM ? ((R & ~31) + perm32(R & 31)) : R;
        voffA[i] = (unsigned)(R * K + C) * 2u; voffB[i] = (unsigned)(Rb * K + C) * 2u; }
    const size_t kstep = (size_t)(BK * 2);
    const size_t hstep = (size_t)HALF * K * 2;
    const size_t tstep = 2 * hstep;
    const unsigned ldsw = (unsigned)wid * 1024u;
    const int aoff = lds_byte(wr * 64 + fr, fq * 8), boff = lds_byte(wc * 32 + fr, fq * 8);
#define PG8_SA(b, h) (((b) * 2 + (h)) * HTB)
#define PG8_SB(b, h) ((4 + (b) * 2 + (h)) * HTB)
#define PG8_STAGE(bufoff, gbase, voff) do { _Pragma("unroll") for (int _i = 0; _i < 2; ++_i) \
        __builtin_amdgcn_global_load_lds((const unsigned*)((const char*)(gbase) + (voff)[_i]), (PG8_LAS unsigned*)(lds + (bufoff) + ldsw + _i * 8192), 16, 0, 0); } while (0)
#define PG8_LDA(dst, b, h) do { _Pragma("unroll") for (int m = 0; m < 4; ++m) _Pragma("unroll") for (int k = 0; k < 2; ++k) dst[m][k] = *(const PG8_LAS bf16x8*)(lds + PG8_SA(b, h) + aoff + m * 2048 + k * 1024); } while (0)
#define PG8_LDB(dst, b, h) do { _Pragma("unroll") for (int n = 0; n < 2; ++n) _Pragma("unroll") for (int k = 0; k < 2; ++k) dst[n][k] = *(const PG8_LAS bf16x8*)(lds + PG8_SB(b, h) + boff + n * 2048 + k * 1024); } while (0)
#define PG8_MMA(ai, bj, At, Bt) do { __builtin_amdgcn_s_setprio(1); _Pragma("unroll") for (int m = 0; m < 4; ++m) _Pragma("unroll") for (int n = 0; n < 2; ++n) _Pragma("unroll") for (int k = 0; k < 2; ++k) \
        acc[ai][bj][m][n] = __builtin_amdgcn_mfma_f32_16x16x32_bf16(Bt[n][k], At[m][k], acc[ai][bj][m][n], 0, 0, 0); __builtin_amdgcn_s_setprio(0); } while (0)
#define PG8_WAIT_V(n) asm volatile("s_waitcnt vmcnt(" #n ")" ::: "memory")
#define PG8_WAIT_L(n) asm volatile("s_waitcnt lgkmcnt(" #n ")" ::: "memory")
#define PG8_BAR __builtin_amdgcn_s_barrier()
#define PG8_SCHED __builtin_amdgcn_sched_barrier(0)
    Unit cur, nxt; int ui = 0;
    if (!S.next(0, cur)) return;
    f32x4 acc[2][2][4][2];
#pragma unroll
    for (int a = 0; a < 2; ++a)
#pragma unroll
        for (int b = 0; b < 2; ++b)
#pragma unroll
            for (int m = 0; m < 4; ++m)
#pragma unroll
                for (int n = 0; n < 2; ++n) acc[a][b][m][n] = (f32x4){0.f, 0.f, 0.f, 0.f};
    bf16x8 At[4][2], B0[2][2], B1[2][2];
    const char* cA = (const char*)g.A + (size_t)cur.pm * tstep; const char* cB = (const char*)g.Bt + (size_t)cur.pn * tstep;
    S.a_ready(cur);
    PG8_STAGE(PG8_SB(0, 0), cB, voffB); PG8_STAGE(PG8_SA(0, 0), cA, voffA); PG8_STAGE(PG8_SB(0, 1), cB + hstep, voffB); PG8_STAGE(PG8_SA(0, 1), cA + hstep, voffA);
    if (wr == 1) PG8_BAR;
    PG8_WAIT_V(4); PG8_BAR;
    PG8_STAGE(PG8_SB(1, 0), cB + kstep, voffB); PG8_STAGE(PG8_SA(1, 0), cA + kstep, voffA); PG8_STAGE(PG8_SB(1, 1), cB + hstep + kstep, voffB);
    PG8_WAIT_V(6); PG8_BAR;
    PG8_STAMP();
    for (;;) {
        const bool has_next = S.next(ui + 1, nxt);
        const char* nA = has_next ? (const char*)g.A + (size_t)nxt.pm * tstep : cA; const char* nB = has_next ? (const char*)g.Bt + (size_t)nxt.pn * tstep : cB;
        for (int t = 0; t < nt; t += 2) {
            const bool last = (t == nt - 2);
            const char* a1 = cA + (size_t)(t + 1) * kstep;
            const char* a2 = last ? nA : cA + (size_t)(t + 2) * kstep; const char* b2 = last ? nB : cB + (size_t)(t + 2) * kstep;
            const char* a3 = a2 + kstep; const char* b3 = b2 + kstep;
            if (last && has_next) S.a_ready(nxt);
            PG8_LDB(B0, 0, 0); PG8_SCHED; PG8_LDA(At, 0, 0); PG8_STAGE(PG8_SA(1, 1), a1 + hstep, voffA);
            PG8_WAIT_L(8); PG8_BAR; PG8_WAIT_L(0); PG8_MMA(0, 0, At, B0); PG8_BAR; PG8_SCHED;
            PG8_LDB(B1, 0, 1); PG8_STAGE(PG8_SB(0, 0), b2, voffB);
            PG8_BAR; PG8_WAIT_L(0); PG8_MMA(0, 1, At, B1); PG8_BAR;
            PG8_LDA(At, 0, 1); PG8_STAGE(PG8_SA(0, 0), a2, voffA);
            PG8_BAR; PG8_WAIT_L(0); PG8_MMA(1, 0, At, B0); PG8_BAR; PG8_SCHED;
            PG8_STAGE(PG8_SB(0, 1), b2 + hstep, voffB);
            PG8_WAIT_V(6); PG8_BAR; PG8_MMA(1, 1, At, B1); PG8_BAR;
            PG8_LDB(B0, 1, 0); PG8_SCHED; PG8_LDA(At, 1, 0); PG8_STAGE(PG8_SA(0, 1), a2 + hstep, voffA);
            PG8_WAIT_L(8); PG8_BAR; PG8_WAIT_L(0); PG8_MMA(0, 0, At, B0); PG8_BAR; PG8_SCHED;
            PG8_LDB(B1, 1, 1); PG8_STAGE(PG8_SB(1, 0), b3, voffB);
            PG8_BAR; PG8_WAIT_L(0); PG8_MMA(0, 1, At, B1); PG8_BAR;
            PG8_LDA(At, 1, 1); PG8_STAGE(PG8_SA(1, 0), a3, voffA);
            PG8_BAR; PG8_WAIT_L(0); PG8_MMA(1, 0, At, B0); PG8_BAR; PG8_SCHED;
            PG8_STAGE(PG8_SB(1, 1), b3 + hstep, voffB);
            PG8_WAIT_V(6); PG8_BAR; PG8_MMA(1, 1, At, B1); PG8_BAR;
        }
        PG8_STAMP();
        if constexpr (!Epi::AFTER_DRAIN) { E(acc, cur, wr, wc, fr, fq); S.done(cur); }
        PG8_STAMP();
        if (!has_next) break;
#pragma unroll
        for (int a = 0; a < 2; ++a)
#pragma unroll
            for (int b = 0; b < 2; ++b)
#pragma unroll
                for (int m = 0; m < 4; ++m)
#pragma unroll
                    for (int n = 0; n < 2; ++n) acc[a][b][m][n] = (f32x4){0.f, 0.f, 0.f, 0.f};
        cur = nxt; cA = nA; cB = nB; ++ui;
    }
    PG8_WAIT_V(0);
    if (wr == 0) PG8_BAR;
    PG8_BAR;
    if constexpr (Epi::AFTER_DRAIN) { E.fused(acc, cur, wr, wc, fr, fq, lds, wid, lane); S.done(cur); }
    PG8_STAMP();
    if (STAMP && wid == 0) { stamps[lane] = lane < nts ? (((unsigned long long)(unsigned)ts_hi << 32) | (unsigned)ts_lo) : 0ull;
        if (lane == 62) stamps[62] = rt_entry; if (lane == 63) stamps[63] = (unsigned long long)wall_clock64(); }
#undef PG8_STAMP
#undef PG8_SA
#undef PG8_SB
#undef PG8_STAGE
#undef PG8_LDA
#undef PG8_LDB
#undef PG8_MMA
#undef PG8_WAIT_V
#undef PG8_WAIT_L
#undef PG8_BAR
#undef PG8_SCHED
}
}

struct EpiInProj {
    static constexpr bool PERM = true, AFTER_DRAIN = false;
    bf16_t* P; const float* bias; float* LR;
    __device__ __forceinline__ void operator()(const f32x4 (&acc)[2][2][4][2], const pg8::Unit& u, int wr, int wc, int fr, int fq) const {
        const int row0 = u.pm * 256 + wr * 64 + fr, colt = u.pn * 256, col0 = colt + wc * 32 + 8 * fq;
        if (colt == C_LR) {
            if (wc == 0) {
                const int cl = 8 * fq;
                const f32x4 b0 = *(const f32x4*)(bias + 4096 + cl), b1 = *(const f32x4*)(bias + 4096 + cl + 4);
#pragma unroll
                for (int ai = 0; ai < 2; ++ai)
#pragma unroll
                    for (int m = 0; m < 4; ++m) {
                        float* d = LR + (size_t)(row0 + ai * 128 + m * 16) * 32 + cl;
                        *(f32x4*)d = acc[ai][0][m][0] + b0; *(f32x4*)(d + 4) = acc[ai][0][m][1] + b1;
                    }
            }
            return;
        }
        const int mode = (colt < 512 || colt == C_GQ) ? 1 : (colt >= C_MQ && colt < C_Z) ? 2 : (colt >= C_Z && colt < C_SG) ? 3 : (colt >= C_SG) ? 4 : 0;
#pragma unroll
        for (int bj = 0; bj < 2; ++bj) {
            const int col = col0 + bj * 128;
            const f32x4 b0 = *(const f32x4*)(bias + orig_col(col)), b1 = *(const f32x4*)(bias + orig_col(col) + 4);
#pragma unroll
            for (int ai = 0; ai < 2; ++ai)
#pragma unroll
                for (int m = 0; m < 4; ++m) {
                    f32x4 v0 = acc[ai][bj][m][0] + b0, v1 = acc[ai][bj][m][1] + b1;
                    if (mode == 1) { v0 *= 0.125f; v1 *= 0.125f; }
                    else if (mode == 2) { v0 *= 0.08838834764831845f; v1 *= 0.08838834764831845f; }
                    else if (mode == 3) {
#pragma unroll
                        for (int e = 0; e < 4; ++e) { v0[e] = siluf_(v0[e]); v1[e] = siluf_(v1[e]); }
                    } else if (mode == 4) {
#pragma unroll
                        for (int e = 0; e < 4; ++e) { v0[e] = sigmoidf_(v0[e]); v1[e] = sigmoidf_(v1[e]); }
                    }
                    u32x4 o; o.x = pk2(v0[0], v0[1]); o.y = pk2(v0[2], v0[3]); o.z = pk2(v1[0], v1[1]); o.w = pk2(v1[2], v1[3]);
                    *(u32x4*)(P + (size_t)(row0 + ai * 128 + m * 16) * PS + col) = o;
                }
        }
    }
};
struct EpiOut {
    static constexpr bool PERM = false, AFTER_DRAIN = false;
    float* pre; const float* bo; const float* x; const float2* stats; const float* g0; const float* b0; const float* hres; size_t tok0; int l;
    __device__ __forceinline__ void operator()(const f32x4 (&acc)[2][2][4][2], const pg8::Unit& u, int wr, int wc, int fr, int fq) const {
        const int row0 = u.pm * 256 + wr * 64 + fr, col0 = u.pn * 256 + wc * 32 + 4 * fq;
#pragma unroll
        for (int ai = 0; ai < 2; ++ai)
#pragma unroll
            for (int m = 0; m < 4; ++m) {
                const int row = row0 + ai * 128 + m * 16; const size_t T = tok0 + row;
                float2 st; st.x = 0.f; st.y = 0.f; if (l == 0) st = stats[T];
#pragma unroll
                for (int bj = 0; bj < 2; ++bj)
#pragma unroll
                    for (int n = 0; n < 2; ++n) {
                        const int col = col0 + bj * 128 + n * 16;
                        f32x4 res;
                        if (l == 0) res = (*(const f32x4*)(x + T * 1024 + col) - st.x) * st.y * *(const f32x4*)(g0 + col) + *(const f32x4*)(b0 + col);
                        else res = *(const f32x4*)(hres + T * 1024 + col);
                        *(f32x4*)(pre + (size_t)row * 1024 + col) = acc[ai][bj][m][n] + *(const f32x4*)(bo + col) + DN_ALPHA * res;
                    }
            }
    }
};

#define XB_TMO      128
#define XB_XCNT(j)  (256  + 64 * (j))
#define XB_XSUB(j)  (1280 + 64 * (j))
#define XB_XGEN(j)  (2304 + 64 * (j))
#define XB_TOP      3328
#define XB_TOPGEN   3392
#define XCD_BAR_WORDS 3456
#define XB_SPIN_CAP (1u << 18)
#define LAS __attribute__((address_space(3)))

__device__ __forceinline__ unsigned xb_ld(unsigned* p)              { return __hip_atomic_load(p, __ATOMIC_RELAXED, __HIP_MEMORY_SCOPE_AGENT); }
__device__ __forceinline__ unsigned xb_add(unsigned* p, unsigned v) { return __hip_atomic_fetch_add(p, v, __ATOMIC_RELAXED, __HIP_MEMORY_SCOPE_AGENT); }
__device__ __forceinline__ unsigned xb_xcc_id() { return (unsigned)__builtin_amdgcn_s_getreg((3 << 11) | 20) & 0xFu; }
#define XB_SPIN(cond, bar) do { unsigned _sp = 0; while (cond) { __builtin_amdgcn_s_sleep(1); \
    if ((++_sp & 255u) == 0u) { if (xb_ld(&(bar)[XB_TMO])) break; if (_sp > XB_SPIN_CAP) { atomicAdd(&(bar)[XB_TMO], 1u); break; } } } } while (0)

struct XcdBarrier {
    unsigned* bar; unsigned x;
    volatile LAS unsigned* st;
};

__device__ __forceinline__ XcdBarrier xcd_barrier_post(unsigned* bar, volatile LAS unsigned* st) {
    XcdBarrier b; b.bar = bar; b.x = xb_xcc_id(); b.st = st;
    if (threadIdx.x == 0) (void)xb_add(&bar[XB_XCNT(b.x)], 1u);
    return b;
}
__device__ __forceinline__ void xcd_barrier_complete(unsigned* bar, unsigned x, unsigned& nloc, unsigned& nx) {
    const unsigned G = gridDim.x * gridDim.y * gridDim.z;
    unsigned sum, cnt, mine, sp = 0u;
    for (;;) {
        sum = 0u; cnt = 0u; mine = 0u;
#pragma unroll
        for (unsigned j = 0; j < 16; ++j) { const unsigned c = xb_ld(&bar[XB_XCNT(j)]); sum += c; cnt += (c > 0u) ? 1u : 0u; mine = (j == x) ? c : mine; }
        if (sum == G) break;
        __builtin_amdgcn_s_sleep(1);
        if ((++sp & 255u) == 0u) { if (xb_ld(&bar[XB_TMO])) break; if (sp > XB_SPIN_CAP) { atomicAdd(&bar[XB_TMO], 1u); break; } }
    }
    nloc = mine > 0u ? mine : 1u; nx = cnt > 0u ? cnt : 1u;
}

__device__ __forceinline__ void xcd_barrier(unsigned* b_bar, unsigned b_x, volatile LAS unsigned* b_st) {
    asm volatile("s_waitcnt vmcnt(0)" ::: "memory");
    __syncthreads();
    if (threadIdx.x == 0) {
        unsigned* bar = b_bar;
        __builtin_amdgcn_s_waitcnt(0);
        unsigned nloc = b_st[0], nx = b_st[1];
        if (nloc == 0u) { xcd_barrier_complete(bar, b_x, nloc, nx); b_st[0] = nloc; b_st[1] = nx; }
        const unsigned old = xb_add(&bar[XB_XSUB(b_x)], 1u);
        const unsigned gen = old / nloc;
        if (old + 1u == (gen + 1u) * nloc) {
            __builtin_amdgcn_fence(__ATOMIC_RELEASE, "agent");
            asm volatile("s_waitcnt vmcnt(0)" ::: "memory");
            const unsigned og = xb_add(&bar[XB_TOP], 1u);
            const unsigned tg = og / nx;
            if (og + 1u == (tg + 1u) * nx) xb_add(&bar[XB_TOPGEN], 1u);
            else XB_SPIN(xb_ld(&bar[XB_TOPGEN]) == tg, bar);
            __builtin_amdgcn_fence(__ATOMIC_ACQUIRE, "agent");
            xb_add(&bar[XB_XGEN(b_x)], 1u);
            asm volatile("s_waitcnt vmcnt(0)" ::: "memory");
        } else {
            XB_SPIN(xb_ld(&bar[XB_XGEN(b_x)]) == gen, bar);
            __builtin_amdgcn_fence(__ATOMIC_ACQUIRE, "agent");
            asm volatile("s_waitcnt vmcnt(0)" ::: "memory");
        }
    }
    __syncthreads();
}

__device__ __forceinline__ void gbar(unsigned* ctr, unsigned& gen, int G) {
    __syncthreads();
    gen += (unsigned)G;
    if (threadIdx.x == 0) {
        __threadfence();
        __hip_atomic_fetch_add(ctr, 1u, __ATOMIC_RELAXED, __HIP_MEMORY_SCOPE_AGENT);
        while (__hip_atomic_load(ctr, __ATOMIC_RELAXED, __HIP_MEMORY_SCOPE_AGENT) < gen) __builtin_amdgcn_s_sleep(1);
        __threadfence();
    }
    __syncthreads();
}
typedef const Params __attribute__((address_space(4))) KParams;
#define KP4 __attribute__((address_space(4)))
__device__ __forceinline__ Params fresh_params() {
#if defined(__HIP_DEVICE_COMPILE__)
    KParams* kp = (KParams*)__builtin_amdgcn_kernarg_segment_ptr();
    asm volatile("" : "+s"(kp));
    Params r;
    const float* KP4 const* src = (const float* KP4 const*)kp;
    const float** dst = (const float**)&r;
#pragma unroll
    for (int i = 0; i < 28; ++i) dst[i] = src[i];
    return r;
#else
    return Params{};
#endif
}
__global__ void __launch_bounds__(NTHR) mega(Params p_unused) {
    extern __shared__ __attribute__((aligned(16))) unsigned char lds[];
    cg::grid_group grid = cg::this_grid();
    const int G = gridDim.x, bid = blockIdx.x;
    volatile LAS unsigned* xst = (volatile LAS unsigned*)((LAS unsigned char*)lds + (LDS_BYTES - 16));
    if (threadIdx.x == 0) { xst[0] = 0u; xst[1] = 0u; }
    __syncthreads();
    unsigned* xbar; unsigned xx;
    { const Params p = fresh_params(); xbar = (unsigned*)(p.ws + OFF_BAR); xx = xb_xcc_id(); if (threadIdx.x == 0) (void)xb_add(&xbar[XB_XCNT(xx)], 1u); }
    { const Params p = fresh_params(); phase0(p); }
    grid.sync();
#pragma unroll 1
    for (int l = 0; l < 2; ++l) {
        { const Params p = fresh_params(); phase_weights(p, l, lds); __syncthreads(); phase_filter_gen(p, l, lds); }
        xcd_barrier(xbar, xx, xst);
        {
            const Params p = fresh_params();
            phase_filter_fft(p, l, lds);
            const bf16_t* WtKV = (const bf16_t*)(p.ws + OFF_WTKV); const bf16_t* membf = (const bf16_t*)(p.ws + OFF_MEMBF);
            for (int t = bid; t < 64; t += G) {
                f32x4 acc[4][4];
                if (t < 32) {
                    const int m0 = (t >> 2) * 256, n0 = (t & 3) * 128;
                    gemm_core(acc, membf + (size_t)m0 * 1024, 1024, WtKV + (size_t)n0 * 1024, 1024, 1024, lds);
                    bf16_t* Km = (bf16_t*)(p.ws + OFF_KMAT);
                    EPI_LOOP(st_bf4(Km + (size_t)row * 512 + col, v);)
                } else {
                    const int t2 = t - 32, m0 = (t2 >> 4) * 256, n0 = (t2 & 15) * 128;
                    gemm_core(acc, WtKV + (size_t)(512 + m0) * 1024, 1024, membf + (size_t)n0 * 1024, 1024, 1024, lds);
                    bf16_t* Vm = (bf16_t*)(p.ws + OFF_VT);
                    EPI_LOOP(st_bf4(Vm + (size_t)row * 2048 + col, v);)
                }
            }
        }
        xcd_barrier(xbar, xx, xst);
#pragma unroll 1
        for (int g = 0; g < NGRP; ++g) {
            const size_t tok0 = (size_t)g * TG;
#pragma unroll 1
            for (int rep = 0; rep < PROBE_REP_INPROJ; ++rep) {
                const Params p = fresh_params();
                pg8::Gemm gm; gm.A = (const bf16_t*)(p.ws + OFF_HB) + tok0 * 1024; gm.Bt = (const bf16_t*)(p.ws + OFF_WTIN); gm.M = TG; gm.N = NINP; gm.K = 1024;
                pg8::StaticOrder S; S.init(TG, NINP, G, bid);
                EpiInProj E; E.P = (bf16_t*)(p.ws + OFF_P); E.bias = p.b_in + (size_t)l * NIN; E.LR = (float*)(p.ws + OFF_LR);
                pg8::gemm_phase<EpiInProj, pg8::StaticOrder, false>((PG8_LAS unsigned char*)lds, gm, S, E, nullptr);
                __syncthreads();
            }
            xcd_barrier(xbar, xx, xst);
#pragma unroll 1
            for (int rep = 0; rep < PROBE_REP_MIX; ++rep) {
            int dry = (rep + 1 < PROBE_REP_MIX) ? 1 : 0; asm volatile("" : "+s"(dry));
            {
                const Params p = fresh_params();
                bf16_t* P = (bf16_t*)(p.ws + OFF_P);
                for (int it = bid; it < BG * 64 * 8; it += G) na_item(p, l, P, it >> 9, (it >> 3) & 63, it & 7, lds, dry);
            }
            {
                const Params p = fresh_params();
                bf16_t* P = (bf16_t*)(p.ws + OFF_P);
                for (int it = bid; it < BG * 128 * 8; it += G) hy_pre_item(p, l, P, (float*)(p.ws + OFF_UT), (bf16_t*)(p.ws + OFF_GT), it >> 10, (it >> 3) & 127, it & 7, lds);
            }
            {
                const Params p = fresh_params();
                for (int it = bid; it < NITEM; it += G) gla_part1_item(p, l, (const bf16_t*)(p.ws + OFF_P), (const float*)(p.ws + OFF_LR), it, lds);
            }
            {
                const Params p = fresh_params();
                bf16_t* P = (bf16_t*)(p.ws + OFF_P);
                const int nit = BG * 4 * 64, per = (nit + G - 1) / G;
                int last = -1;
                for (int it = bid * per; it < min(nit, (bid + 1) * per); ++it) {
                    const int bh = it >> 6, bl = bh >> 2, h = bh & 3;
                    if (bh != last) { __syncthreads(); memattn_load(p, g * BG + bl, h, lds); last = bh; }
                    memattn_item(P, bl, h, it & 63, lds, dry);
                }
                __syncthreads();
            }
            xcd_barrier(xbar, xx, xst);
            {
                const Params p = fresh_params();
                const float2* twl = fft_lds_twiddles((const float2*)(p.ws + OFF_TW), lds);
                for (int it = bid; it < BG * 256; it += G) hyena_conv_item(p, (const float*)(p.ws + OFF_UT), (bf16_t*)(p.ws + OFF_GT), it >> 8, it & 255, lds, twl, dry);
                __syncthreads();
                gla_scan(p, dry);
            }
            xcd_barrier(xbar, xx, xst);
            {
                const Params p = fresh_params();
                for (int it = bid; it < NITEM; it += G) gla_part2_item(p, l, (bf16_t*)(p.ws + OFF_P), (const float*)(p.ws + OFF_LR), it, lds, dry);
            }
            {
                const Params p = fresh_params();
                for (int it = bid; it < BG * 128 * 8; it += G) hy_post_item((bf16_t*)(p.ws + OFF_P), (const bf16_t*)(p.ws + OFF_GT), it >> 10, (it >> 3) & 127, it & 7, lds, dry);
            }
            xcd_barrier(xbar, xx, xst);
            }
            {
                const Params p = fresh_params();
                const bf16_t* P = (const bf16_t*)(p.ws + OFF_P); const bf16_t* WtBr = (const bf16_t*)(p.ws + OFF_WTBR); bf16_t* merged = (bf16_t*)(p.ws + OFF_MERGED);
                for (int t = bid; t < 512; t += G) {
                    const int sr = t >> 8, sb = t & 255, sx = sb & 7, sk = sb >> 3;
                    const int m0 = (sr * 32 + (sk >> 3) * 8 + sx) * 256, n0 = (sk & 7) * 128;
                    merge_tile(P, WtBr, merged, m0, n0, lds);
                }
            }
            xcd_barrier(xbar, xx, xst);
            {
                const Params p = fresh_params();
                pg8::Gemm gm; gm.A = (const bf16_t*)(p.ws + OFF_MERGED); gm.Bt = (const bf16_t*)(p.ws + OFF_WTOUT); gm.M = TG; gm.N = 1024; gm.K = 1024;
                pg8::StaticOrder S; S.init(TG, 1024, G, bid);
                EpiOut E; E.pre = (float*)(p.ws + OFF_PRE); E.bo = p.b_out + l * 1024; E.x = p.x; E.stats = (const float2*)(p.ws + OFF_STATS); E.g0 = p.ln_in_g; E.b0 = p.ln_in_b; E.hres = p.out; E.tok0 = tok0; E.l = l;
                pg8::gemm_phase<EpiOut, pg8::StaticOrder, false>((PG8_LAS unsigned char*)lds, gm, S, E, nullptr);
                __syncthreads();
            }
            xcd_barrier(xbar, xx, xst);
            {
                const Params p = fresh_params();
                ln_rows((const float*)(p.ws + OFF_PRE), 0, TG, p.ln_g + l * 1024, p.ln_b + l * 1024, p.out, (bf16_t*)(p.ws + OFF_HB), tok0, nullptr);
            }
        }
        xcd_barrier(xbar, xx, xst);
    }
}

extern "C" void kernel_launch(void* const* d_in, const int* in_sizes, int n_in, void* d_out, int out_size, void* d_ws, size_t ws_size, hipStream_t stream) {
    static int grid_blocks = 0;
    if (!grid_blocks) {
        if (ws_size < WS_END) { fprintf(stderr, "kernel_launch: workspace too small: %zu < %zu\n", ws_size, (size_t)WS_END); grid_blocks = -1; return; }
        {
            const long long ex[26] = {67108864LL, 2097152LL, 1024, 1024, 2LL * 1024 * 10784, 2 * 10784, 2 * 8 * 15 * 31, 2 * 3 * 1536, 2 * 1536, 2 * 33 * 64, 2 * 64, 2 * 2 * 64 * 64, 2 * 2 * 64,
                                      2 * 64 * 1024, 2 * 512, 2 * 16 * 256, 2 * 256, 2 * 16 * 256, 2 * 256, 2 * 512, 2LL * 1024 * 1024, 2LL * 4 * 512 * 1024, 2LL * 1024 * 1024, 2 * 1024, 2 * 1024, 2 * 1024};
            bool bad = (n_in != 26) || (out_size != 67108864);
            for (int i = 0; i < 26 && !bad; ++i) if ((long long)in_sizes[i] != ex[i]) { fprintf(stderr, "kernel_launch: input %d has %d elements, expected %lld\n", i, in_sizes[i], ex[i]); bad = true; }
            if (bad) { fprintf(stderr, "kernel_launch: unexpected shapes; nothing launched\n"); grid_blocks = -1; return; }
        }
        int dev = 0, cus = 0, per_cu = 0;
        hipGetDevice(&dev);
        hipDeviceGetAttribute(&cus, hipDeviceAttributeMultiprocessorCount, dev);
        if (hipFuncSetAttribute((const void*)mega, hipFuncAttributeMaxDynamicSharedMemorySize, LDS_BYTES) != hipSuccess) fprintf(stderr, "kernel_launch: hipFuncSetAttribute failed\n");
        if (hipOccupancyMaxActiveBlocksPerMultiprocessor(&per_cu, (const void*)mega, NTHR, LDS_BYTES) != hipSuccess || per_cu < 1) { fprintf(stderr, "kernel_launch: occupancy query gave %d\n", per_cu); per_cu = 1; }
        (void)hipGetLastError();
        if (per_cu > 1) per_cu = 1;
        grid_blocks = cus * per_cu;
    }
    if (grid_blocks < 0) return;
    Params p{};
    const float** pp = (const float**)&p;
    for (int i = 0; i < 26; ++i) pp[i] = (const float*)d_in[i];
    p.out = (float*)d_out; p.ws = (unsigned char*)d_ws;
    if (hipMemsetAsync((unsigned char*)d_ws + OFF_BAR, 0, 16384, stream) != hipSuccess) fprintf(stderr, "kernel_launch: memset of the barrier word failed\n");
    void* args[] = {&p};
    hipError_t e = hipLaunchCooperativeKernel((const void*)mega, dim3(grid_blocks), dim3(NTHR), args, LDS_BYTES, stream);
    if (e != hipSuccess) fprintf(stderr, "cooperative launch failed: %s (grid %d)\n", hipGetErrorString(e), grid_blocks);
}
#endif
```

```cpp
#ifndef PROBE_REP_MIX
#define PROBE_REP_MIX 1
#endif
#ifndef PROBE_REP_INPROJ
#define PROBE_REP_INPROJ 1
#endif
#include <hip/hip_runtime.h>
#include <hip/hip_cooperative_groups.h>
#include <cstdio>
#include <unistd.h>
#include <cmath>
namespace cg = cooperative_groups;

#define HD __host__ __device__
typedef unsigned short bf16_t;
typedef short bf16x8 __attribute__((ext_vector_type(8)));
typedef float f32x4 __attribute__((ext_vector_type(4)));
typedef unsigned u32x2 __attribute__((ext_vector_type(2)));
typedef unsigned u32x4 __attribute__((ext_vector_type(4)));

constexpr int NTOK = 65536, DM = 1024, SEQ = 8192, NB = 8;
constexpr int BG = 2;
constexpr int NGRP = NB / BG;
constexpr int TG = BG * SEQ;
constexpr int PS = 10752;
constexpr int NIN = 10784, NINP = 11008;
constexpr int C_NAQ = 0, C_NAK = 512, C_NAV = 1024, C_HY = 1536, C_GQ = 3072, C_GK = 3328, C_GV = 3584, C_MQ = 4096, C_Z = 4608, C_SG = 6656, C_LR = 10752;
constexpr int FN = 16384;
constexpr int NITEM = BG * 128 * 4;
constexpr int LDS_BYTES = 160 * 1024;
constexpr int NTHR = 512;
constexpr float DN_ALPHA = 1.41421356237309515f;

constexpr size_t al256(size_t x) { return (x + 255) & ~(size_t)255; }
constexpr size_t OFF_HB = 0;
constexpr size_t OFF_STATS = OFF_HB + (size_t)NTOK * DM * 2;
constexpr size_t OFF_TW = OFF_STATS + (size_t)NTOK * 8;
constexpr size_t OFF_MEMBF = OFF_TW + (size_t)FN * 8;
constexpr size_t OFF_ENERGY = OFF_MEMBF + (size_t)2048 * 1024 * 2;
constexpr size_t OFF_WTIN = OFF_ENERGY + 4096;
constexpr size_t OFF_WTBR = OFF_WTIN + (size_t)NINP * 1024 * 2;
constexpr size_t OFF_WTOUT = OFF_WTBR + (size_t)4 * 1024 * 512 * 2;
constexpr size_t OFF_WTKV = OFF_WTOUT + (size_t)1024 * 1024 * 2;
constexpr size_t OFF_KMAT = OFF_WTKV + (size_t)2048 * 1024 * 2;
constexpr size_t OFF_VT = OFF_KMAT + (size_t)2048 * 1024 * 2;
constexpr size_t OFF_HFILT = OFF_VT + (size_t)2048 * 1024 * 2;
constexpr size_t OFF_PQ = OFF_HFILT + (size_t)1024 * 8192 * 4;
constexpr size_t OFF_P = OFF_PQ + (size_t)256 * FN * 16;
constexpr size_t OFF_LR = OFF_P + (size_t)TG * PS * 2;
constexpr size_t OFF_GS = OFF_LR + (size_t)TG * 32 * 4;
constexpr size_t OFF_GDEC = OFF_GS + (size_t)2 * NITEM * 8192 * 4;
constexpr size_t OFF_MERGED = OFF_GDEC + (size_t)2 * NITEM * 64 * 4;
constexpr size_t OFF_PRE = OFF_MERGED + (size_t)TG * 1024 * 2;
constexpr size_t OFF_UT = OFF_PRE + (size_t)TG * 1024 * 4;
constexpr size_t OFF_GT = OFF_UT + (size_t)BG * 512 * 8192 * 4;
constexpr size_t OFF_BAR = OFF_GT + (size_t)BG * 512 * 8192 * 2;
constexpr size_t OFF_ZT = OFF_BAR + 16384;
constexpr size_t WS_END = OFF_ZT + (size_t)8192 * 33 * 4;

struct Params {
    const float *x, *mem, *ln_in_g, *ln_in_b, *w_in, *b_in, *na_rpb, *hy_conv_w, *hy_conv_b, *hy_w1, *hy_b1, *hy_wm, *hy_bm, *hy_w3, *hy_skip,
        *gla_up_f, *gla_bias_f, *gla_up_b, *gla_bias_b, *gla_norm_g, *mem_w_kv, *w_br, *w_out, *b_out, *ln_g, *ln_b;
    float* out;
    unsigned char* ws;
};

HD inline float bf2f(bf16_t b) {
    union { unsigned u; float f; } c; c.u = (unsigned)b << 16; return c.f;
}
HD inline bf16_t f2bf(float f) {
    union { unsigned u; float f; } c; c.f = f; unsigned u = c.u; u += 0x7fffu + ((u >> 16) & 1u); return (bf16_t)(u >> 16);
}
typedef float f32x2_t __attribute__((ext_vector_type(2)));
typedef __bf16 bf16x2_t __attribute__((ext_vector_type(2)));
__device__ __forceinline__ unsigned pk2(float lo, float hi) { const f32x2_t v = {lo, hi}; const bf16x2_t b = __builtin_convertvector(v, bf16x2_t); return __builtin_bit_cast(unsigned, b); }
__device__ __forceinline__ bf16_t f2bf_d(float f) { return (bf16_t)(pk2(f, f) & 0xffffu); }
__device__ __forceinline__ float lo16(unsigned u) { return __uint_as_float(u << 16); }
__device__ __forceinline__ float hi16(unsigned u) { return __uint_as_float(u & 0xffff0000u); }
__device__ __forceinline__ float wave_sum(float v) {
#pragma unroll
    for (int o = 32; o >= 1; o >>= 1) v += __shfl_xor(v, o);
    return v;
}
__device__ __forceinline__ float sigmoidf_(float x) { return __builtin_amdgcn_rcpf(1.0f + __expf(-x)); }
__device__ __forceinline__ float siluf_(float x) { return x * __builtin_amdgcn_rcpf(1.0f + __expf(-x)); }
__device__ __forceinline__ float logsigf_(float x) { return fminf(x, 0.0f) - __logf(1.0f + __expf(-fabsf(x))); }
__device__ __forceinline__ bf16x8 mkfrag(u32x4 v) { return __builtin_bit_cast(bf16x8, v); }
__device__ __forceinline__ bf16x8 mkfrag2(u32x2 a, u32x2 b) { u32x4 v = {a.x, a.y, b.x, b.y}; return __builtin_bit_cast(bf16x8, v); }
#define MFMA(a, b, c) __builtin_amdgcn_mfma_f32_16x16x32_bf16((a), (b), (c), 0, 0, 0)
HD inline int iclamp(int v, int lo, int hi) { return v < lo ? lo : (v > hi ? hi : v); }

HD inline float2 cmulf(float2 a, float2 b) { float2 r; r.x = a.x * b.x - a.y * b.y; r.y = a.x * b.y + a.y * b.x; return r; }
HD inline float2 cmulcf(float2 a, float2 b) { float2 r; r.x = a.x * b.x + a.y * b.y; r.y = a.y * b.x - a.x * b.y; return r; }
struct Bfly { float2 x0, x1, x2, x3, W1; int i0; };
HD inline void bfly_load(Bfly& b, const float2* d, const float2* tw, int lgm, int q) {
    const int m = 1 << lgm, blk = q >> lgm, j = q & (m - 1);
    b.i0 = (blk << (lgm + 2)) + j;
    b.W1 = tw[j];
    b.x0 = d[b.i0]; b.x1 = d[b.i0 + m]; b.x2 = d[b.i0 + 2 * m]; b.x3 = d[b.i0 + 3 * m];
}
HD inline void bfly_fwd_store(const Bfly& b, float2* d, int lgm) {
    const int m = 1 << lgm, i0 = b.i0;
    const float2 W1 = b.W1, W2 = cmulf(W1, W1);
    const float2 x0 = b.x0, x1 = b.x1, x2 = b.x2, x3 = b.x3;
    float2 a0, a1, a2, a3, t;
    a0.x = x0.x + x2.x; a0.y = x0.y + x2.y;
    t.x = x0.x - x2.x; t.y = x0.y - x2.y; a2 = cmulf(t, W1);
    a1.x = x1.x + x3.x; a1.y = x1.y + x3.y;
    t.x = x1.x - x3.x; t.y = x1.y - x3.y; t = cmulf(t, W1); a3.x = t.y; a3.y = -t.x;
    float2 r;
    r.x = a0.x + a1.x; r.y = a0.y + a1.y; d[i0] = r;
    t.x = a0.x - a1.x; t.y = a0.y - a1.y; d[i0 + m] = cmulf(t, W2);
    r.x = a2.x + a3.x; r.y = a2.y + a3.y; d[i0 + 2 * m] = r;
    t.x = a2.x - a3.x; t.y = a2.y - a3.y; d[i0 + 3 * m] = cmulf(t, W2);
}
HD inline void bfly_inv_store(const Bfly& b, float2* d, int lgm) {
    const int m = 1 << lgm, i0 = b.i0;
    const float2 W1 = b.W1, W2 = cmulf(W1, W1);
    const float2 x0 = b.x0, x1 = b.x1, x2 = b.x2, x3 = b.x3;
    const float2 b1 = cmulcf(x1, W2), b3 = cmulcf(x3, W2);
    float2 y0, y1, y2, y3;
    y0.x = x0.x + b1.x; y0.y = x0.y + b1.y; y1.x = x0.x - b1.x; y1.y = x0.y - b1.y;
    y2.x = x2.x + b3.x; y2.y = x2.y + b3.y; y3.x = x2.x - b3.x; y3.y = x2.y - b3.y;
    const float2 c2 = cmulcf(y2, W1); float2 c3 = cmulcf(y3, W1); { const float tx = -c3.y, ty = c3.x; c3.x = tx; c3.y = ty; }
    float2 r;
    r.x = y0.x + c2.x; r.y = y0.y + c2.y; d[i0] = r;
    r.x = y0.x - c2.x; r.y = y0.y - c2.y; d[i0 + 2 * m] = r;
    r.x = y1.x + c3.x; r.y = y1.y + c3.y; d[i0 + m] = r;
    r.x = y1.x - c3.x; r.y = y1.y - c3.y; d[i0 + 3 * m] = r;
}
HD inline void fft_fwd_bfly(float2* d, const float2* tw, int lgm, int q) { Bfly b; bfly_load(b, d, tw, lgm, q); bfly_fwd_store(b, d, lgm); }
HD inline void fft_inv_bfly(float2* d, const float2* tw, int lgm, int q) { Bfly b; bfly_load(b, d, tw, lgm, q); bfly_inv_store(b, d, lgm); }
HD inline void r4_fwd(float2& x0, float2& x1, float2& x2, float2& x3, const float2 W1) {
    const float2 W2 = cmulf(W1, W1);
    float2 a0, a1, a2, a3, t;
    a0.x = x0.x + x2.x; a0.y = x0.y + x2.y;
    t.x = x0.x - x2.x; t.y = x0.y - x2.y; a2 = cmulf(t, W1);
    a1.x = x1.x + x3.x; a1.y = x1.y + x3.y;
    t.x = x1.x - x3.x; t.y = x1.y - x3.y; t = cmulf(t, W1); a3.x = t.y; a3.y = -t.x;
    x0.x = a0.x + a1.x; x0.y = a0.y + a1.y;
    t.x = a0.x - a1.x; t.y = a0.y - a1.y; x1 = cmulf(t, W2);
    x2.x = a2.x + a3.x; x2.y = a2.y + a3.y;
    t.x = a2.x - a3.x; t.y = a2.y - a3.y; x3 = cmulf(t, W2);
}
HD inline void r4_inv(float2& x0, float2& x1, float2& x2, float2& x3, const float2 W1) {
    const float2 W2 = cmulf(W1, W1);
    const float2 b1 = cmulcf(x1, W2), b3 = cmulcf(x3, W2);
    float2 y0, y1, y2, y3;
    y0.x = x0.x + b1.x; y0.y = x0.y + b1.y; y1.x = x0.x - b1.x; y1.y = x0.y - b1.y;
    y2.x = x2.x + b3.x; y2.y = x2.y + b3.y; y3.x = x2.x - b3.x; y3.y = x2.y - b3.y;
    const float2 c2 = cmulcf(y2, W1); float2 c3 = cmulcf(y3, W1); { const float tx = -c3.y, ty = c3.x; c3.x = tx; c3.y = ty; }
    x0.x = y0.x + c2.x; x0.y = y0.y + c2.y; x2.x = y0.x - c2.x; x2.y = y0.y - c2.y;
    x1.x = y1.x + c3.x; x1.y = y1.y + c3.y; x3.x = y1.x - c3.x; x3.y = y1.y - c3.y;
}
template <bool INV, bool HALF>
HD inline void r16_bfly(float2* d, const float2* twO, const float2* twI, int lgm, int q) {
    const int m = 1 << lgm, blk = q >> lgm, j = q & (m - 1), base = (blk << (lgm + 4)) + j;
    float2 e[4][4];
#pragma unroll
    for (int a = 0; a < 4; ++a)
#pragma unroll
        for (int b = 0; b < 4; ++b) {
            if (!INV && HALF && a >= 2) { e[a][b].x = 0.f; e[a][b].y = 0.f; }
            else e[a][b] = d[base + ((4 * a + b) << lgm)];
        }
    const float2 wI = twI[j];
    float2 wO[4];
#pragma unroll
    for (int b = 0; b < 4; ++b) wO[b] = twO[j + (b << lgm)];
    if (!INV) {
#pragma unroll
        for (int b = 0; b < 4; ++b) r4_fwd(e[0][b], e[1][b], e[2][b], e[3][b], wO[b]);
#pragma unroll
        for (int a = 0; a < 4; ++a) r4_fwd(e[a][0], e[a][1], e[a][2], e[a][3], wI);
    } else {
#pragma unroll
        for (int a = 0; a < 4; ++a) r4_inv(e[a][0], e[a][1], e[a][2], e[a][3], wI);
#pragma unroll
        for (int b = 0; b < 4; ++b) r4_inv(e[0][b], e[1][b], e[2][b], e[3][b], wO[b]);
    }
#pragma unroll
    for (int a = 0; a < 4; ++a)
#pragma unroll
        for (int b = 0; b < 4; ++b)
            if (!(INV && HALF && a >= 2)) d[base + ((4 * a + b) << lgm)] = e[a][b];
}
HD inline int brev14(int k) {
    unsigned v = (unsigned)k;
    v = ((v >> 1) & 0x55555555u) | ((v & 0x55555555u) << 1);
    v = ((v >> 2) & 0x33333333u) | ((v & 0x33333333u) << 2);
    v = ((v >> 4) & 0x0f0f0f0fu) | ((v & 0x0f0f0f0fu) << 4);
    v = ((v >> 8) & 0x00ff00ffu) | ((v & 0x00ff00ffu) << 8);
    v = (v >> 16) | (v << 16);
    return (int)(v >> 18);
}
struct PwIn { float2 Z1, Z2; float4 A, B; int p1, p2; };
HD inline void pw_load(PwIn& w, const float2* d, const float4* pq, int p1) {
    const int kf = brev14(p1), k2 = (FN - kf) & (FN - 1); w.p1 = p1; w.p2 = brev14(k2);
    w.Z1 = d[w.p1]; w.Z2 = d[w.p2]; w.A = pq[w.p1]; w.B.x = w.A.x; w.B.y = -w.A.y; w.B.z = w.A.z; w.B.w = -w.A.w;
}
HD inline void pw_store(const PwIn& w, float2* d) {
    const float2 Z1 = w.Z1, Z2 = w.Z2;
    float2 P1, Q1, P2, Q2; P1.x = w.A.x; P1.y = w.A.y; Q1.x = w.A.z; Q1.y = w.A.w; P2.x = w.B.x; P2.y = w.B.y; Q2.x = w.B.z; Q2.y = w.B.w;
    float2 c1, c2; c1.x = Z1.x; c1.y = -Z1.y; c2.x = Z2.x; c2.y = -Z2.y;
    const float2 a = cmulf(Z1, P1), b = cmulf(c2, Q1), c = cmulf(Z2, P2), e = cmulf(c1, Q2);
    float2 w1, w2; w1.x = a.x + b.x; w1.y = a.y + b.y; w2.x = c.x + e.x; w2.y = c.y + e.y;
    d[w.p1] = w1;
    if (w.p2 != w.p1) d[w.p2] = w2;
}
HD inline void conv_pointwise(float2* d, const float4* pq, int p1) { PwIn w; pw_load(w, d, pq, p1); pw_store(w, d); }
HD inline void filt_pointwise(const float2* d, float4* pq, int p1) {
    const int kf = brev14(p1), k2 = (FN - kf) & (FN - 1), p2 = brev14(k2);
    const float2 Z1 = d[p1], Z2 = d[p2];
    const float gcx = 0.5f * (Z1.x + Z2.x), gcy = 0.5f * (Z1.y - Z2.y);
    const float gdx = 0.5f * (Z1.y + Z2.y), gdy = -0.5f * (Z1.x - Z2.x);
    const float s = 0.5f / (float)FN;
    float4 A; A.x = s * (gcx + gdx); A.y = s * (gcy + gdy); A.z = s * (gcx - gdx); A.w = s * (gcy - gdy);
    pq[p1] = A;
}
HD inline int tw_off(int lgm) { return lgm == 10 ? 0 : lgm == 8 ? 1024 : lgm == 6 ? 1280 : lgm == 4 ? 1344 : lgm == 2 ? 1360 : 1364; }
#ifndef FFT_HOST_TEST
template <int LGM, bool INV>
__device__ __forceinline__ void fft_pass(float2* d, const float2* twl, const float2* twg, int tid) {
    const float2* tw = (LGM == 12) ? twg : twl + tw_off(LGM);
#pragma unroll
    for (int it = 0; it < 2; ++it) {
        const int q = tid + it * 4 * NTHR;
        Bfly b0, b1, b2, b3;
        bfly_load(b0, d, tw, LGM, q); bfly_load(b1, d, tw, LGM, q + NTHR); bfly_load(b2, d, tw, LGM, q + 2 * NTHR); bfly_load(b3, d, tw, LGM, q + 3 * NTHR);
        if (INV) { bfly_inv_store(b0, d, LGM); bfly_inv_store(b1, d, LGM); bfly_inv_store(b2, d, LGM); bfly_inv_store(b3, d, LGM); }
        else { bfly_fwd_store(b0, d, LGM); bfly_fwd_store(b1, d, LGM); bfly_fwd_store(b2, d, LGM); bfly_fwd_store(b3, d, LGM); }
    }
    __syncthreads();
}
template <int LGM, bool INV, bool HALF>
__device__ __forceinline__ void fft_pass16(float2* d, const float2* twl, const float2* twg, int tid) {
    const float2* twO = (LGM + 2 == 12) ? twg : twl + tw_off(LGM + 2);
    const float2* twI = twl + tw_off(LGM);
    r16_bfly<INV, HALF>(d, twO, twI, LGM, tid);
    r16_bfly<INV, HALF>(d, twO, twI, LGM, tid + NTHR);
    __syncthreads();
}
template <bool HALF>
__device__ __forceinline__ void fft_forward(float2* d, const float2* twl, const float2* twg) {
    int tid = threadIdx.x; asm volatile("" : "+v"(tid));
    fft_pass16<10, false, HALF>(d, twl, twg, tid); fft_pass16<6, false, false>(d, twl, twg, tid);
    fft_pass<4, false>(d, twl, twg, tid); fft_pass<2, false>(d, twl, twg, tid); fft_pass<0, false>(d, twl, twg, tid);
}
template <bool HALF>
__device__ __forceinline__ void fft_inverse(float2* d, const float2* twl, const float2* twg) {
    int tid = threadIdx.x; asm volatile("" : "+v"(tid));
    fft_pass<0, true>(d, twl, twg, tid); fft_pass<2, true>(d, twl, twg, tid); fft_pass<4, true>(d, twl, twg, tid);
    fft_pass16<6, true, false>(d, twl, twg, tid); fft_pass16<10, true, HALF>(d, twl, twg, tid);
}
__device__ __forceinline__ float2* fft_lds_twiddles(const float2* twg, unsigned char* lds) {
    int tid = threadIdx.x; asm volatile("" : "+v"(tid));
    float2* t = (float2*)(lds + 131072);
    for (int k = tid; k < 1365; k += NTHR) {
        const int lgm = k < 1024 ? 10 : k < 1280 ? 8 : k < 1344 ? 6 : k < 1360 ? 4 : k < 1364 ? 2 : 0;
        t[k] = twg[(k - tw_off(lgm)) << (12 - lgm)];
    }
    __syncthreads();
    return t;
}

constexpr int STG = 49152;
__device__ __forceinline__ int swz(int row, int ch) { return row * 128 + ((ch ^ ((row >> 1) & 7)) << 4); }
__device__ __forceinline__ void gemm_core(f32x4 (&acc)[4][4], const bf16_t* A, int lda, const bf16_t* Bt, int ldb, int K, unsigned char* lds) {
    int tid_ = threadIdx.x; asm volatile("" : "+v"(tid_)); const int tid = tid_, lane = tid & 63, w = tid >> 6, wm = w & 3, wn = w >> 2, l15 = lane & 15, q4 = lane >> 4;
    const int wu = __builtin_amdgcn_readfirstlane(w);
    __attribute__((address_space(3))) unsigned char* l3 = (__attribute__((address_space(3))) unsigned char*)lds;
#pragma unroll
    for (int mi = 0; mi < 4; ++mi)
#pragma unroll
        for (int ni = 0; ni < 4; ++ni) acc[mi][ni] = (f32x4){0.f, 0.f, 0.f, 0.f};
    const int r8 = lane >> 3, sch = (lane & 7) ^ ((((w & 1) << 2) + (r8 >> 1)) & 7);
    const bf16_t* ap = A + (size_t)(w * 8 + r8) * lda + sch * 8;
    const bf16_t* bp = Bt + (size_t)(w * 8 + r8) * ldb + sch * 8;
#define GC_STAGE(buf, k0)                                                                                                                         \
    {                                                                                                                                             \
        _Pragma("unroll") for (int i = 0; i < 4; ++i)                                                                                             \
            __builtin_amdgcn_global_load_lds((const unsigned*)(ap + (size_t)(64 * i) * lda + (k0)), (__attribute__((address_space(3))) unsigned*)(l3 + (buf) * STG + (wu + 8 * i) * 1024), 16, 0, 0);          \
        _Pragma("unroll") for (int i = 0; i < 2; ++i)                                                                                             \
            __builtin_amdgcn_global_load_lds((const unsigned*)(bp + (size_t)(64 * i) * ldb + (k0)), (__attribute__((address_space(3))) unsigned*)(l3 + (buf) * STG + 32768 + (wu + 8 * i) * 1024), 16, 0, 0);  \
    }
    GC_STAGE(0, 0)
    asm volatile("s_waitcnt vmcnt(0)" ::: "memory");
    __syncthreads();
    const int nk = K >> 6;
    for (int kt = 0; kt < nk; ++kt) {
        if (kt + 1 < nk) GC_STAGE((kt + 1) & 1, (kt + 1) << 6)
        const unsigned char* sa = lds + (kt & 1) * STG;
        const unsigned char* sb = sa + 32768;
#pragma unroll
        for (int ks = 0; ks < 2; ++ks) {
            bf16x8 af[4], bfr[4];
#pragma unroll
            for (int mi = 0; mi < 4; ++mi) af[mi] = *(const bf16x8*)(sa + swz(wm * 64 + mi * 16 + l15, ks * 4 + q4));
#pragma unroll
            for (int ni = 0; ni < 4; ++ni) bfr[ni] = *(const bf16x8*)(sb + swz(wn * 64 + ni * 16 + l15, ks * 4 + q4));
#pragma unroll
            for (int mi = 0; mi < 4; ++mi)
#pragma unroll
                for (int ni = 0; ni < 4; ++ni) acc[mi][ni] = MFMA(bfr[ni], af[mi], acc[mi][ni]);
        }
        asm volatile("s_waitcnt vmcnt(0)" ::: "memory");
        __syncthreads();
    }
#undef GC_STAGE
}
#define EPI_LOOP(body)                                                                                                  \
    {                                                                                                                   \
        int e_t = threadIdx.x; asm volatile("" : "+v"(e_t)); const int e_lane = e_t & 63, e_w = e_t >> 6;                                                    \
        _Pragma("unroll") for (int mi = 0; mi < 4; ++mi) _Pragma("unroll") for (int ni = 0; ni < 4; ++ni) {             \
            const int row = m0 + (e_w & 3) * 64 + mi * 16 + (e_lane & 15);                                              \
            const int col = n0 + (e_w >> 2) * 64 + ni * 16 + 4 * (e_lane >> 4);                                         \
            f32x4& v = acc[mi][ni];                                                                                     \
            body                                                                                                        \
        }                                                                                                               \
    }
__device__ __forceinline__ void st_bf4(bf16_t* dst, f32x4 v) {
    u32x2 o; o.x = pk2(v[0], v[1]); o.y = pk2(v[2], v[3]); *(u32x2*)dst = o;
}
__device__ __forceinline__ f32x4 ld_bf4(const bf16_t* src) {
    const u32x2 u = *(const u32x2*)src; f32x4 r = {lo16(u.x), hi16(u.x), lo16(u.y), hi16(u.y)}; return r;
}


__device__ __forceinline__ void merge_tile(const bf16_t* P, const bf16_t* WtBr, bf16_t* merged, int m0, int n0, unsigned char* lds) {
    int tid_ = threadIdx.x; asm volatile("" : "+v"(tid_)); const int tid = tid_, lane = tid & 63, w = tid >> 6, wm = w & 3, wn = w >> 2, l15 = lane & 15, q4 = lane >> 4;
    const int wu = __builtin_amdgcn_readfirstlane(w);
    __attribute__((address_space(3))) unsigned char* l3 = (__attribute__((address_space(3))) unsigned char*)lds;
    f32x4 acc[4][4], macc[4][4];
#pragma unroll
    for (int mi = 0; mi < 4; ++mi)
#pragma unroll
        for (int ni = 0; ni < 4; ++ni) { acc[mi][ni] = (f32x4){0.f, 0.f, 0.f, 0.f}; macc[mi][ni] = (f32x4){0.f, 0.f, 0.f, 0.f}; }
    const int r8 = lane >> 3, sch = (lane & 7) ^ ((((w & 1) << 2) + (r8 >> 1)) & 7);
    const bf16_t* ap = P + (size_t)(m0 + w * 8 + r8) * PS + sch * 8;
    const bf16_t* bp = WtBr + (size_t)(n0 + w * 8 + r8) * 512 + sch * 8;
    const bf16_t* sgp = P + (size_t)(m0 + wm * 64 + l15) * PS + C_SG + n0 + wn * 64 + 4 * q4;
#define MG_STAGE(buf, kt_)                                                                                                                        \
    {                                                                                                                                             \
        const int j_ = (kt_) >> 3, k0_ = ((kt_) & 7) << 6;                                                                                        \
        const int acol_ = (j_ == 0) ? C_NAQ : (j_ == 1) ? C_HY : (j_ == 2) ? C_GV : C_MQ;                                                        \
        _Pragma("unroll") for (int i = 0; i < 4; ++i)                                                                                             \
            __builtin_amdgcn_global_load_lds((const unsigned*)(ap + (size_t)(64 * i) * PS + acol_ + k0_), (__attribute__((address_space(3))) unsigned*)(l3 + (buf) * STG + (wu + 8 * i) * 1024), 16, 0, 0);      \
        _Pragma("unroll") for (int i = 0; i < 2; ++i)                                                                                             \
            __builtin_amdgcn_global_load_lds((const unsigned*)(bp + (size_t)j_ * 1024 * 512 + (size_t)(64 * i) * 512 + k0_), (__attribute__((address_space(3))) unsigned*)(l3 + (buf) * STG + 32768 + (wu + 8 * i) * 1024), 16, 0, 0);  \
    }
    MG_STAGE(0, 0)
    asm volatile("s_waitcnt vmcnt(0)" ::: "memory");
    __syncthreads();
#pragma unroll 1
    for (int kt = 0; kt < 32; ++kt) {
        if (kt + 1 < 32) MG_STAGE((kt + 1) & 1, kt + 1)
        const bool last = (kt & 7) == 7;
        u32x2 sg[4][4];
        if (last) {
            const bf16_t* sp = sgp + 1024 * (kt >> 3);
#pragma unroll
            for (int mi = 0; mi < 4; ++mi)
#pragma unroll
                for (int ni = 0; ni < 4; ++ni) sg[mi][ni] = *(const u32x2*)(sp + (size_t)(mi * 16) * PS + ni * 16);
        }
        const unsigned char* sa = lds + (kt & 1) * STG;
        const unsigned char* sb = sa + 32768;
#pragma unroll
        for (int ks = 0; ks < 2; ++ks) {
            bf16x8 af[4], bfr[4];
#pragma unroll
            for (int mi = 0; mi < 4; ++mi) af[mi] = *(const bf16x8*)(sa + swz(wm * 64 + mi * 16 + l15, ks * 4 + q4));
#pragma unroll
            for (int ni = 0; ni < 4; ++ni) bfr[ni] = *(const bf16x8*)(sb + swz(wn * 64 + ni * 16 + l15, ks * 4 + q4));
#pragma unroll
            for (int mi = 0; mi < 4; ++mi)
#pragma unroll
                for (int ni = 0; ni < 4; ++ni) acc[mi][ni] = MFMA(bfr[ni], af[mi], acc[mi][ni]);
        }
        asm volatile("s_waitcnt vmcnt(0)" ::: "memory");
        if (last) {
#pragma unroll
            for (int mi = 0; mi < 4; ++mi)
#pragma unroll
                for (int ni = 0; ni < 4; ++ni) {
                    const u32x2 u = sg[mi][ni]; const f32x4 g4 = {lo16(u.x), hi16(u.x), lo16(u.y), hi16(u.y)};
                    macc[mi][ni] += g4 * acc[mi][ni]; acc[mi][ni] = (f32x4){0.f, 0.f, 0.f, 0.f};
                }
        }
        __syncthreads();
    }
#undef MG_STAGE
#pragma unroll
    for (int mi = 0; mi < 4; ++mi)
#pragma unroll
        for (int ni = 0; ni < 4; ++ni) st_bf4(merged + (size_t)(m0 + wm * 64 + mi * 16 + l15) * 1024 + n0 + wn * 64 + ni * 16 + 4 * q4, macc[mi][ni]);
}

__device__ __forceinline__ int orig_col(int n) {
    if (n < 4096) return n;
    if (n < 4608) return n + 32;
    if (n < 6656) return n + 32;
    if (n < 10752) return n + 32;
    return n - 10752 + 4096;
}

__device__ __forceinline__ void ln_rows(const float* src, size_t src_row0, int nrows, const float* g, const float* b, float* dst32, bf16_t* dst16, size_t dst_row0, float2* stats) {
    int tid_ = threadIdx.x; asm volatile("" : "+v"(tid_));
    const int lane = tid_ & 63;
    const int gw = blockIdx.x * (NTHR / 64) + (tid_ >> 6), nw = gridDim.x * (NTHR / 64);
    for (int r = gw; r < nrows; r += nw) {
        const float4* xr = (const float4*)(src + (src_row0 + r) * 1024);
        float4 v[4]; float s = 0.f;
#pragma unroll
        for (int i = 0; i < 4; ++i) { v[i] = xr[lane + 64 * i]; s += (v[i].x + v[i].y) + (v[i].z + v[i].w); }
        s = wave_sum(s);
        const float mean = s * (1.0f / 1024.0f);
        float q = 0.f;
#pragma unroll
        for (int i = 0; i < 4; ++i) { const float a = v[i].x - mean, bb = v[i].y - mean, c = v[i].z - mean, d = v[i].w - mean; q += (a * a + bb * bb) + (c * c + d * d); }
        q = wave_sum(q);
        const float rstd = 1.0f / sqrtf(q * (1.0f / 1024.0f) + 1e-5f);
        if (stats && lane == 0) { float2 st; st.x = mean; st.y = rstd; stats[dst_row0 + r] = st; }
#pragma unroll
        for (int i = 0; i < 4; ++i) {
            const float4 g4 = ((const float4*)g)[lane + 64 * i], b4 = ((const float4*)b)[lane + 64 * i];
            float4 y; y.x = (v[i].x - mean) * rstd * g4.x + b4.x; y.y = (v[i].y - mean) * rstd * g4.y + b4.y; y.z = (v[i].z - mean) * rstd * g4.z + b4.z; y.w = (v[i].w - mean) * rstd * g4.w + b4.w;
            if (dst32) ((float4*)(dst32 + (dst_row0 + r) * 1024))[lane + 64 * i] = y;
            if (dst16) { u32x2 o; o.x = pk2(y.x, y.y); o.y = pk2(y.z, y.w); *(u32x2*)(dst16 + (dst_row0 + r) * 1024 + (lane + 64 * i) * 4) = o; }
        }
    }
}
__device__ __forceinline__ void phase0(const Params& p) {
    ln_rows(p.x, 0, NTOK, p.ln_in_g, p.ln_in_b, nullptr, (bf16_t*)(p.ws + OFF_HB), 0, (float2*)(p.ws + OFF_STATS));
    int tid_ = threadIdx.x; asm volatile("" : "+v"(tid_)); const int gt = blockIdx.x * NTHR + tid_, nt = gridDim.x * NTHR;
    float2* tw = (float2*)(p.ws + OFF_TW);
    for (int k = gt; k < FN; k += nt) { double s, c; sincospi(-2.0 * (double)k / (double)FN, &s, &c); float2 t; t.x = (float)c; t.y = (float)s; tw[k] = t; }
    bf16_t* mb = (bf16_t*)(p.ws + OFF_MEMBF);
    for (int i = gt; i < 2048 * 1024 / 4; i += nt) { const float4 v = ((const float4*)p.mem)[i]; u32x2 o; o.x = pk2(v.x, v.y); o.y = pk2(v.z, v.w); ((u32x2*)mb)[i] = o; }
    float* en = (float*)(p.ws + OFF_ENERGY);
    for (int i = gt; i < 1024; i += nt) en[i] = 0.f;
    float* ztab = (float*)(p.ws + OFF_ZT);
    for (int idx = gt; idx < 8192 * 33; idx += nt) {
        const int n = idx / 33, e = idx - n * 33;
        float v;
        if (e == 0) v = (float)n / 8191.0f;
        else {
            const int i = (e - 1) & 15;
            const double fr = 1e-4 + (double)i * ((15.0 - 1e-4) / 15.0);
            const double ang = (2.0 * 3.14159265358979323846 / 8192.0) * (double)n * fr;
            v = (e <= 16) ? (float)cos(ang) : (float)(-sin(ang));
        }
        ztab[idx] = v;
    }
}

__device__ __forceinline__ void wt_tile(const float* src, int src_ld, int k0, int on0, bf16_t* dst, int dst_ld, int dn0, bool zero, float* tile) {
    int tid_ = threadIdx.x; asm volatile("" : "+v"(tid_)); const int tid = tid_;
    if (!zero) {
#pragma unroll
        for (int i = 0; i < 2; ++i) {
            const int k = (tid >> 3) + 64 * i, c4 = (tid & 7) * 4;
            const float4 v = *(const float4*)(src + (size_t)(k0 + k) * src_ld + on0 + c4);
            float* t = tile + k * 33 + c4; t[0] = v.x; t[1] = v.y; t[2] = v.z; t[3] = v.w;
        }
    }
    __syncthreads();
    const int n = tid >> 4, kc = (tid & 15) * 8;
    float f[8];
#pragma unroll
    for (int e = 0; e < 8; ++e) f[e] = zero ? 0.f : tile[(kc + e) * 33 + n];
    u32x4 o; o.x = pk2(f[0], f[1]); o.y = pk2(f[2], f[3]); o.z = pk2(f[4], f[5]); o.w = pk2(f[6], f[7]);
    *(u32x4*)(dst + (size_t)(dn0 + n) * dst_ld + k0 + kc) = o;
    __syncthreads();
}
__device__ __forceinline__ void phase_weights(const Params& p, int l, unsigned char* lds) {
    float* tile = (float*)lds;
    for (int it = blockIdx.x; it < 3776; it += gridDim.x) {
        if (it < 2752) {
            const int nt = it >> 3, kt = it & 7, dn0 = nt * 32;
            wt_tile(p.w_in + (size_t)l * 1024 * NIN, NIN, kt * 128, orig_col(dn0), (bf16_t*)(p.ws + OFF_WTIN), 1024, dn0, dn0 >= NIN, tile);
        } else if (it < 3264) {
            const int r = it - 2752, j = r >> 7, nt = (r >> 2) & 31, kt = r & 3;
            wt_tile(p.w_br + (size_t)(l * 4 + j) * 512 * 1024, 1024, kt * 128, nt * 32, (bf16_t*)(p.ws + OFF_WTBR) + (size_t)j * 1024 * 512, 512, nt * 32, false, tile);
        } else if (it < 3520) {
            const int r = it - 3264, nt = r >> 3, kt = r & 7;
            wt_tile(p.w_out + (size_t)l * 1024 * 1024, 1024, kt * 128, nt * 32, (bf16_t*)(p.ws + OFF_WTOUT), 1024, nt * 32, false, tile);
        } else {
            const int r = it - 3520, nt = r >> 3, kt = r & 7;
            wt_tile(p.mem_w_kv + (size_t)l * 1024 * 1024, 1024, kt * 128, nt * 32, (bf16_t*)(p.ws + OFF_WTKV), 1024, nt * 32, false, tile);
        }
    }
}

__device__ __forceinline__ void phase_filter_gen(const Params& p, int l, unsigned char* lds) {
    float* zt = (float*)lds;
    float* ha = zt + 32 * 33;
    float* hbuf = ha + 32 * 64;
    int tid_ = threadIdx.x; asm volatile("" : "+v"(tid_)); const int tid = tid_;
    const float* w1 = p.hy_w1 + (size_t)l * 33 * 64; const float* b1 = p.hy_b1 + l * 64;
    const float* wm = p.hy_wm + (size_t)l * 2 * 64 * 64; const float* bm = p.hy_bm + l * 2 * 64;
    const float* w3 = p.hy_w3 + (size_t)l * 64 * 1024;
    float* hf = (float*)(p.ws + OFF_HFILT);
    float* en = (float*)(p.ws + OFF_ENERGY) + l * 512;
    const float* ztab = (const float*)(p.ws + OFF_ZT);
    for (int it = blockIdx.x; it < 256; it += gridDim.x) {
        const int n0 = it * 32;
        for (int idx = tid; idx < 32 * 33; idx += NTHR) zt[idx] = ztab[(size_t)n0 * 33 + idx];
        __syncthreads();
        for (int idx = tid; idx < 2048; idx += NTHR) {
            const int pos = idx >> 6, j = idx & 63; float s = b1[j];
            for (int e = 0; e < 33; ++e) s += zt[pos * 33 + e] * w1[e * 64 + j];
            ha[idx] = sinf(s);
        }
        __syncthreads();
        for (int idx = tid; idx < 2048; idx += NTHR) {
            const int pos = idx >> 6, j = idx & 63; float s = bm[j];
            for (int e = 0; e < 64; ++e) s += ha[pos * 64 + e] * wm[e * 64 + j];
            hbuf[idx] = sinf(s);
        }
        __syncthreads();
        for (int idx = tid; idx < 2048; idx += NTHR) {
            const int pos = idx >> 6, j = idx & 63; float s = bm[64 + j];
            for (int e = 0; e < 64; ++e) s += hbuf[pos * 64 + e] * wm[4096 + e * 64 + j];
            ha[idx] = sinf(s);
        }
        __syncthreads();
        {
            const int c = tid;
            float af[32], ab[32];
#pragma unroll
            for (int i = 0; i < 32; ++i) { af[i] = 0.f; ab[i] = 0.f; }
            for (int k = 0; k < 64; ++k) {
                const float wf = w3[k * 1024 + c], wb = w3[k * 1024 + 512 + c];
#pragma unroll
                for (int i = 0; i < 32; ++i) { const float h = ha[i * 64 + k]; af[i] += h * wf; ab[i] += h * wb; }
            }
            const float dmin = -3.0701134573253945f, dmax = -15.350567286626973f;
            const float delta = fabsf(dmin + (float)c * ((dmax - dmin) / 511.0f));
            float e = 0.f;
#pragma unroll
            for (int i = 0; i < 32; ++i) {
                const int n = n0 + i; const float t01 = (float)n / 8191.0f; const float win = expf(-t01 * delta);
                af[i] *= win; ab[i] *= win; e += af[i] * af[i]; if (n >= 1) e += ab[i] * ab[i];
            }
#pragma unroll
            for (int i = 0; i < 8; ++i) {
                float4 a; a.x = af[4 * i]; a.y = af[4 * i + 1]; a.z = af[4 * i + 2]; a.w = af[4 * i + 3];
                float4 b; b.x = ab[4 * i]; b.y = ab[4 * i + 1]; b.z = ab[4 * i + 2]; b.w = ab[4 * i + 3];
                *(float4*)(hf + (size_t)c * 8192 + n0 + 4 * i) = a;
                *(float4*)(hf + (size_t)(512 + c) * 8192 + n0 + 4 * i) = b;
            }
            atomicAdd(en + c, e);
        }
        __syncthreads();
    }
}

__device__ __forceinline__ void phase_filter_fft(const Params& p, int l, unsigned char* lds) {
    float2* d = (float2*)lds;
    const float2* tw = fft_lds_twiddles((const float2*)(p.ws + OFF_TW), lds);
    const float* hf = (const float*)(p.ws + OFF_HFILT);
    const float* en = (const float*)(p.ws + OFF_ENERGY) + l * 512;
    float4* pqa = (float4*)(p.ws + OFF_PQ);
    int tid_ = threadIdx.x; asm volatile("" : "+v"(tid_)); const int tid = tid_;
    for (int pr = blockIdx.x; pr < 256; pr += gridDim.x) {
        const int c0 = 2 * pr, c1 = c0 + 1;
        const float s0 = 1.0f / sqrtf(en[c0] + 1e-6f), s1 = 1.0f / sqrtf(en[c1] + 1e-6f);
        const float k0 = p.hy_skip[l * 512 + c0], k1 = p.hy_skip[l * 512 + c1];
        for (int n = tid; n < FN; n += NTHR) {
            float2 v;
            if (n < 8192) { v.x = hf[(size_t)c0 * 8192 + n] * s0; v.y = hf[(size_t)c1 * 8192 + n] * s1; if (n == 0) { v.x += k0; v.y += k1; } }
            else if (n == 8192) { v.x = 0.f; v.y = 0.f; }
            else { v.x = hf[(size_t)(512 + c0) * 8192 + (FN - n)] * s0; v.y = hf[(size_t)(512 + c1) * 8192 + (FN - n)] * s1; }
            d[n] = v;
        }
        __syncthreads();
        fft_forward<false>(d, tw, (const float2*)(p.ws + OFF_TW));
        for (int h = tid; h < FN / 2; h += NTHR) filt_pointwise(d, pqa + (size_t)pr * FN, 2 * h);
        if (tid == 0) filt_pointwise(d, pqa + (size_t)pr * FN, 1);
        __syncthreads();
    }
}

__device__ __forceinline__ void hy_pre_item(const Params& p, int l, const bf16_t* P, float* UT, bf16_t* GT, int bl, int tt, int ct, unsigned char* lds) {
    float* tU = (float*)lds;
    float* tG = tU + 64 * 65;
    int tid_ = threadIdx.x; asm volatile("" : "+v"(tid_)); const int tid = tid_;
    const int t = tid >> 3, cc = (tid & 7) * 8, c = ct * 64 + cc, tb = tt * 64 + t;
    const float* cw = p.hy_conv_w + (size_t)l * 3 * 1536; const float* cb = p.hy_conv_b + l * 1536;
    float av[8], a0[8], a1[8];
#pragma unroll
    for (int h = 0; h < 2; ++h) {
        const f32x4 bv = *(const f32x4*)(cb + c + 4 * h), b0 = *(const f32x4*)(cb + 512 + c + 4 * h), b1 = *(const f32x4*)(cb + 1024 + c + 4 * h);
#pragma unroll
        for (int e = 0; e < 4; ++e) { av[4 * h + e] = bv[e]; a0[4 * h + e] = b0[e]; a1[4 * h + e] = b1[e]; }
    }
#pragma unroll
    for (int j = 0; j < 3; ++j) {
        const int ts = tb + j - 1;
        if (ts >= 0 && ts < SEQ) {
            const bf16_t* row = P + (size_t)(bl * SEQ + ts) * PS + C_HY + c;
            const u32x4 rv = *(const u32x4*)row, r0 = *(const u32x4*)(row + 512), r1 = *(const u32x4*)(row + 1024);
#pragma unroll
            for (int h = 0; h < 2; ++h) {
                const f32x4 wv = *(const f32x4*)(cw + j * 1536 + c + 4 * h), w0 = *(const f32x4*)(cw + j * 1536 + 512 + c + 4 * h), w1 = *(const f32x4*)(cw + j * 1536 + 1024 + c + 4 * h);
#pragma unroll
                for (int e = 0; e < 4; ++e) {
                    const int k = 4 * h + e; const unsigned uv = rv[k >> 1], u0 = r0[k >> 1], u1 = r1[k >> 1];
                    av[k] += wv[e] * ((k & 1) ? hi16(uv) : lo16(uv)); a0[k] += w0[e] * ((k & 1) ? hi16(u0) : lo16(u0)); a1[k] += w1[e] * ((k & 1) ? hi16(u1) : lo16(u1));
                }
            }
        }
    }
    const u32x4 rz = *(const u32x4*)(P + (size_t)(bl * SEQ + tb) * PS + C_Z + 512 + c);
#pragma unroll
    for (int k = 0; k < 8; ++k) {
        const unsigned uz = rz[k >> 1]; const float z = (k & 1) ? hi16(uz) : lo16(uz);
        tU[(cc + k) * 65 + t] = av[k] * a1[k]; tG[(cc + k) * 65 + t] = a0[k] * z;
    }
    __syncthreads();
    const int c2 = tid >> 3, t8 = (tid & 7) * 8;
    const size_t o = (size_t)(bl * 512 + ct * 64 + c2) * SEQ + tt * 64 + t8;
    const float* su = tU + c2 * 65 + t8; const float* sg = tG + c2 * 65 + t8;
    f32x4 ua = {su[0], su[1], su[2], su[3]}, ub = {su[4], su[5], su[6], su[7]};
    *(f32x4*)(UT + o) = ua; *(f32x4*)(UT + o + 4) = ub;
    u32x4 g; g.x = pk2(sg[0], sg[1]); g.y = pk2(sg[2], sg[3]); g.z = pk2(sg[4], sg[5]); g.w = pk2(sg[6], sg[7]);
    *(u32x4*)(GT + o) = g;
    __syncthreads();
}
__device__ __forceinline__ void hy_post_item(bf16_t* P, const bf16_t* GT, int bl, int tt, int ct, unsigned char* lds, int dry = 0) {
    bf16_t* tl = (bf16_t*)lds;
    int tid_ = threadIdx.x; asm volatile("" : "+v"(tid_)); const int tid = tid_;
    const int c2 = tid >> 3, t8 = (tid & 7) * 8;
    const u32x4 v = *(const u32x4*)(GT + (size_t)(bl * 512 + ct * 64 + c2) * SEQ + tt * 64 + t8);
    bf16_t* d0 = tl + t8 * 72 + c2;
    d0[0 * 72] = (bf16_t)(v.x & 0xffffu); d0[1 * 72] = (bf16_t)(v.x >> 16); d0[2 * 72] = (bf16_t)(v.y & 0xffffu); d0[3 * 72] = (bf16_t)(v.y >> 16);
    d0[4 * 72] = (bf16_t)(v.z & 0xffffu); d0[5 * 72] = (bf16_t)(v.z >> 16); d0[6 * 72] = (bf16_t)(v.w & 0xffffu); d0[7 * 72] = (bf16_t)(v.w >> 16);
    __syncthreads();
    const int t = tid >> 3, cc = (tid & 7) * 8;
    const u32x4 ov = *(const u32x4*)(tl + t * 72 + cc);
    if (!dry) *(u32x4*)(P + (size_t)(bl * SEQ + tt * 64 + t) * PS + C_HY + ct * 64 + cc) = ov;
    __syncthreads();
}
__device__ __forceinline__ void hyena_conv_item(const Params& p, const float* UT, bf16_t* GT, int bl, int pr, unsigned char* lds, const float2* tw, int dry = 0) {
    float2* d = (float2*)lds;
    const float4* pq = (const float4*)(p.ws + OFF_PQ) + (size_t)pr * FN;
    int tid_ = threadIdx.x; asm volatile("" : "+v"(tid_)); const int tid = tid_;
    const float* u0 = UT + (size_t)(bl * 512 + 2 * pr) * SEQ; const float* u1 = u0 + SEQ;
    bf16_t* g0 = GT + (size_t)(bl * 512 + 2 * pr) * SEQ; bf16_t* g1 = g0 + SEQ;
    {
        float f0[16], f1[16];
#pragma unroll
        for (int i = 0; i < 16; ++i) { f0[i] = u0[tid + NTHR * i]; f1[i] = u1[tid + NTHR * i]; }
#pragma unroll
        for (int i = 0; i < 16; ++i) {
            float2 u; u.x = f0[i]; u.y = f1[i]; d[tid + NTHR * i] = u;
        }
    }
    __syncthreads();
    fft_forward<true>(d, tw, (const float2*)(p.ws + OFF_TW));
#pragma unroll 1
    for (int h = tid; h < FN / 2; h += 4 * NTHR) {
        PwIn w0, w1, w2, w3;
        pw_load(w0, d, pq, 2 * h); pw_load(w1, d, pq, 2 * (h + NTHR)); pw_load(w2, d, pq, 2 * (h + 2 * NTHR)); pw_load(w3, d, pq, 2 * (h + 3 * NTHR));
        pw_store(w0, d); pw_store(w1, d); pw_store(w2, d); pw_store(w3, d);
    }
    if (tid == 0) conv_pointwise(d, pq, 1);
    __syncthreads();
    fft_inverse<true>(d, tw, (const float2*)(p.ws + OFF_TW));
    {
        bf16_t a0[16], a1[16];
#pragma unroll
        for (int i = 0; i < 16; ++i) { a0[i] = g0[tid + NTHR * i]; a1[i] = g1[tid + NTHR * i]; }
#pragma unroll
        for (int i = 0; i < 16; ++i) {
            const int t = tid + NTHR * i;
            const float2 y = d[t];
            const bf16_t r0 = f2bf_d(y.x * bf2f(a0[i])), r1 = f2bf_d(y.y * bf2f(a1[i]));
            if (!dry) { g0[t] = r0; g1[t] = r1; }
        }
    }
    __syncthreads();
}

__device__ __forceinline__ void na_item(const Params& p, int l, bf16_t* P, int bl, int rp, int head, unsigned char* lds, int dry = 0) {
    bf16_t* Kimg = (bf16_t*)lds;
    bf16_t* VT = (bf16_t*)(lds + 82944);
    int tid_ = threadIdx.x; asm volatile("" : "+v"(tid_)); const int tid = tid_, lane = tid & 63, w = tid >> 6, l15 = lane & 15, q4 = lane >> 4;
    const int r0 = 2 * rp, rs0 = iclamp(r0 - 4, 0, 120);
#pragma unroll
    for (int i = 0; i < 9; ++i) {
        const int idx = tid + NTHR * i, key = idx >> 3, ch = idx & 7, grow = min(rs0 + (key >> 6), 127);
        const u32x4 kv = *(const u32x4*)(P + (size_t)(bl * SEQ + grow * 64 + (key & 63)) * PS + C_NAK + head * 64 + ch * 8);
        *(u32x4*)(Kimg + key * 72 + ch * 8) = kv;
    }
#pragma unroll
    for (int i = 0; i < 9; ++i) {
        const int idx = tid + NTHR * i, keyp = idx >> 2, chh = keyp >= 576 ? 1 : 0, key = keyp - chh * 576, ch = chh * 4 + (idx & 3), grow = min(rs0 + (key >> 6), 127);
        const u32x4 vv = *(const u32x4*)(P + (size_t)(bl * SEQ + grow * 64 + (key & 63)) * PS + C_NAV + head * 64 + ch * 8);
        bf16_t* vd = VT + (ch * 8) * 584 + key;
        vd[0 * 584] = (bf16_t)(vv.x & 0xffffu); vd[1 * 584] = (bf16_t)(vv.x >> 16);
        vd[2 * 584] = (bf16_t)(vv.y & 0xffffu); vd[3 * 584] = (bf16_t)(vv.y >> 16);
        vd[4 * 584] = (bf16_t)(vv.z & 0xffffu); vd[5 * 584] = (bf16_t)(vv.z >> 16);
        vd[6 * 584] = (bf16_t)(vv.w & 0xffffu); vd[7 * 584] = (bf16_t)(vv.w >> 16);
    }
    __syncthreads();
    const int rr = w >> 2, g = w & 3, r = r0 + rr, rs = iclamp(r - 4, 0, 120), lo = rs - rs0;
    const int cb = iclamp(16 * g - 8, 0, 32), c = 16 * g + l15, cs = iclamp(c - 8, 0, 48);
    bf16_t* qrow = P + (size_t)(bl * SEQ + r * 64 + c) * PS + head * 64;
    bf16x8 qf[2];
#pragma unroll
    for (int ks = 0; ks < 2; ++ks) qf[ks] = *(const bf16x8*)(qrow + ks * 32 + q4 * 8);
    f32x4 sc[16];
#pragma unroll
    for (int t = 0; t < 16; ++t) {
        const int kb = (lo + (t >> 1)) * 64 + cb + 16 * (t & 1);
        f32x4 a = {0.f, 0.f, 0.f, 0.f};
#pragma unroll
        for (int ks = 0; ks < 2; ++ks) { const bf16x8 kf = *(const bf16x8*)(Kimg + (kb + l15) * 72 + ks * 32 + q4 * 8); a = MFMA(kf, qf[ks], a); }
        sc[t] = a;
    }
    const float* rpb = p.na_rpb + (size_t)(l * 8 + head) * 15 * 31;
    float mx = -1e30f;
#pragma unroll
    for (int t = 0; t < 16; ++t) {
        const int drow = rs + (t >> 1) - r + 7;
#pragma unroll
        for (int e = 0; e < 4; ++e) {
            const int col = cb + 16 * (t & 1) + 4 * q4 + e;
            const bool ok = (col >= cs) && (col < cs + 16);
            const int dcol = ok ? (col - c + 15) : 0;
            const float v = ok ? (sc[t][e] + rpb[drow * 31 + dcol]) : -1e30f;
            sc[t][e] = v; mx = fmaxf(mx, v);
        }
    }
    mx = fmaxf(mx, __shfl_xor(mx, 16)); mx = fmaxf(mx, __shfl_xor(mx, 32));
    float sum = 0.f;
#pragma unroll
    for (int t = 0; t < 16; ++t)
#pragma unroll
        for (int e = 0; e < 4; ++e) { const float pe = __expf(sc[t][e] - mx); sc[t][e] = pe; sum += pe; }
    sum += __shfl_xor(sum, 16); sum += __shfl_xor(sum, 32);
    f32x4 o[4];
#pragma unroll
    for (int dt = 0; dt < 4; ++dt) o[dt] = (f32x4){0.f, 0.f, 0.f, 0.f};
#pragma unroll
    for (int kk = 0; kk < 8; ++kk) {
        u32x4 pu; pu.x = pk2(sc[2 * kk][0], sc[2 * kk][1]); pu.y = pk2(sc[2 * kk][2], sc[2 * kk][3]); pu.z = pk2(sc[2 * kk + 1][0], sc[2 * kk + 1][1]); pu.w = pk2(sc[2 * kk + 1][2], sc[2 * kk + 1][3]);
        const bf16x8 pf = mkfrag(pu);
        const int kbA = (lo + kk) * 64 + cb + 4 * q4;
#pragma unroll
        for (int dt = 0; dt < 4; ++dt) {
            const bf16_t* vr = VT + (dt * 16 + l15) * 584 + kbA;
            const bf16x8 vf = mkfrag2(*(const u32x2*)vr, *(const u32x2*)(vr + 16));
            o[dt] = MFMA(vf, pf, o[dt]);
        }
    }
    const float inv = 1.0f / sum;
    const bf16_t* zrow = P + (size_t)(bl * SEQ + r * 64 + c) * PS + C_Z + head * 64;
#pragma unroll
    for (int dt = 0; dt < 4; ++dt) {
        const int dd = dt * 16 + 4 * q4;
        const f32x4 z = ld_bf4(zrow + dd);
        if (!dry) st_bf4(qrow + dd, o[dt] * inv * z);
    }
    __syncthreads();
}

__device__ __forceinline__ void memattn_load(const Params& p, int b, int h, unsigned char* lds) {
    bf16_t* Kimg = (bf16_t*)lds;
    bf16_t* VT = (bf16_t*)(lds + 69632);
    const bf16_t* Km = (const bf16_t*)(p.ws + OFF_KMAT); const bf16_t* Vm = (const bf16_t*)(p.ws + OFF_VT);
    int tid_ = threadIdx.x; asm volatile("" : "+v"(tid_)); const int tid = tid_;
#pragma unroll
    for (int i = 0; i < 8; ++i) {
        const int idx = tid + NTHR * i;
        { const int key = idx >> 4, ch = idx & 15; *(u32x4*)(Kimg + key * 136 + ch * 8) = *(const u32x4*)(Km + (size_t)(b * 256 + key) * 512 + h * 128 + ch * 8); }
        { const int dd = idx >> 5, ch = idx & 31; *(u32x4*)(VT + dd * 264 + ch * 8) = *(const u32x4*)(Vm + (size_t)(h * 128 + dd) * 2048 + b * 256 + ch * 8); }
    }
    __syncthreads();
}
__device__ __forceinline__ void memattn_item(bf16_t* P, int bl, int h, int qt, unsigned char* lds, int dry = 0) {
    const bf16_t* Kimg = (const bf16_t*)lds; const bf16_t* VT = (const bf16_t*)(lds + 69632);
    int tid_ = threadIdx.x; asm volatile("" : "+v"(tid_)); const int tid = tid_, lane = tid & 63, w = tid >> 6, l15 = lane & 15, q4 = lane >> 4;
    const int tok = bl * SEQ + qt * 128 + w * 16 + l15;
    bf16_t* qrow = P + (size_t)tok * PS + C_MQ + h * 128;
    bf16x8 qf[4];
#pragma unroll
    for (int ks = 0; ks < 4; ++ks) qf[ks] = *(const bf16x8*)(qrow + ks * 32 + q4 * 8);
    f32x4 sc[16];
    float mx = -1e30f;
#pragma unroll
    for (int t = 0; t < 16; ++t) {
        f32x4 a = {0.f, 0.f, 0.f, 0.f};
#pragma unroll
        for (int ks = 0; ks < 4; ++ks) { const bf16x8 kf = *(const bf16x8*)(Kimg + (t * 16 + l15) * 136 + ks * 32 + q4 * 8); a = MFMA(kf, qf[ks], a); }
        sc[t] = a;
        mx = fmaxf(mx, fmaxf(fmaxf(a[0], a[1]), fmaxf(a[2], a[3])));
    }
    mx = fmaxf(mx, __shfl_xor(mx, 16)); mx = fmaxf(mx, __shfl_xor(mx, 32));
    float sum = 0.f;
#pragma unroll
    for (int t = 0; t < 16; ++t)
#pragma unroll
        for (int e = 0; e < 4; ++e) { const float pe = __expf(sc[t][e] - mx); sc[t][e] = pe; sum += pe; }
    sum += __shfl_xor(sum, 16); sum += __shfl_xor(sum, 32);
    f32x4 o[8];
#pragma unroll
    for (int dt = 0; dt < 8; ++dt) o[dt] = (f32x4){0.f, 0.f, 0.f, 0.f};
#pragma unroll
    for (int kk = 0; kk < 8; ++kk) {
        u32x4 pu; pu.x = pk2(sc[2 * kk][0], sc[2 * kk][1]); pu.y = pk2(sc[2 * kk][2], sc[2 * kk][3]); pu.z = pk2(sc[2 * kk + 1][0], sc[2 * kk + 1][1]); pu.w = pk2(sc[2 * kk + 1][2], sc[2 * kk + 1][3]);
        const bf16x8 pf = mkfrag(pu);
#pragma unroll
        for (int dt = 0; dt < 8; ++dt) {
            const bf16_t* vr = VT + (dt * 16 + l15) * 264 + kk * 32 + 4 * q4;
            const bf16x8 vf = mkfrag2(*(const u32x2*)vr, *(const u32x2*)(vr + 16));
            o[dt] = MFMA(vf, pf, o[dt]);
        }
    }
    const float inv = 1.0f / sum;
    const bf16_t* zrow = P + (size_t)tok * PS + C_Z + 3 * 512 + h * 128;
#pragma unroll
    for (int dt = 0; dt < 8; ++dt) {
        const int dd = dt * 16 + 4 * q4;
        const f32x4 z = ld_bf4(zrow + dd);
        if (!dry) st_bf4(qrow + dd, o[dt] * inv * z);
    }
}

constexpr int G_LRT = 0, G_BF = 8192, G_BB = 24576, G_TOT = 40960, G_IMG = 45056;
__device__ __forceinline__ void gla_tables(const Params& p, int l, const float* LR, int t0, int h, unsigned char* lds) {
    float* LRT = (float*)(lds + G_LRT); float* BF = (float*)(lds + G_BF); float* BB = (float*)(lds + G_BB); float* TOT = (float*)(lds + G_TOT);
    int tid_ = threadIdx.x; asm volatile("" : "+v"(tid_)); const int tid = tid_;
    ((float4*)LRT)[tid] = ((const float4*)(LR + (size_t)t0 * 32))[tid];
    __syncthreads();
    const int dk = tid & 63, cgp = tid >> 6;
    float uf[16], ub[16];
#pragma unroll
    for (int r = 0; r < 16; ++r) { uf[r] = p.gla_up_f[(size_t)(l * 16 + r) * 256 + h * 64 + dk]; ub[r] = p.gla_up_b[(size_t)(l * 16 + r) * 256 + h * 64 + dk]; }
    const float bif = p.gla_bias_f[l * 256 + h * 64 + dk], bib = p.gla_bias_b[l * 256 + h * 64 + dk];
    float lf[8], lb[8];
#pragma unroll
    for (int i = 0; i < 8; ++i) {
        const int c = cgp * 8 + i; float sf = bif, sb = bib;
#pragma unroll
        for (int r = 0; r < 16; ++r) { sf += LRT[c * 32 + r] * uf[r]; sb += LRT[c * 32 + 16 + r] * ub[r]; }
        lf[i] = logsigf_(sf) * (1.0f / 16.0f); lb[i] = logsigf_(sb) * (1.0f / 16.0f);
    }
#pragma unroll
    for (int i = 1; i < 8; ++i) lf[i] += lf[i - 1];
#pragma unroll
    for (int i = 6; i >= 0; --i) lb[i] += lb[i + 1];
    TOT[cgp * 64 + dk] = lf[7]; TOT[512 + cgp * 64 + dk] = lb[0];
    __syncthreads();
    float of = 0.f, ob = 0.f;
#pragma unroll
    for (int g2 = 0; g2 < 8; ++g2) { if (g2 < cgp) of += TOT[g2 * 64 + dk]; if (g2 > cgp) ob += TOT[512 + g2 * 64 + dk]; }
#pragma unroll
    for (int i = 0; i < 8; ++i) { BF[(cgp * 8 + i) * 64 + dk] = lf[i] + of; BB[(cgp * 8 + i) * 64 + dk] = lb[i] + ob; }
    __syncthreads();
}
struct GlaPre { u32x4 vv[2]; bf16_t q[8], k[8]; };
__device__ __forceinline__ void gla_prefetch(GlaPre& g, const bf16_t* P, int t0, int h, int tid) {
#pragma unroll
    for (int i = 0; i < 2; ++i) { const int idx = tid + NTHR * i, chn = idx >> 6, c = idx & 63; g.vv[i] = *(const u32x4*)(P + (size_t)(t0 + c) * PS + C_GV + h * 128 + chn * 8); }
#pragma unroll
    for (int i = 0; i < 8; ++i) { const int idx = tid + NTHR * i, c = idx >> 6, dk = idx & 63; g.q[i] = P[(size_t)(t0 + c) * PS + C_GQ + h * 64 + dk]; g.k[i] = P[(size_t)(t0 + c) * PS + C_GK + h * 64 + dk]; }
}
__device__ __forceinline__ void gla_vt_store(const GlaPre& g, bf16_t* VT, int tid) {
#pragma unroll
    for (int i = 0; i < 2; ++i) {
        const int idx = tid + NTHR * i, chn = idx >> 6, c = idx & 63;
        const u32x4 vv = g.vv[i];
        bf16_t* vd = VT + (chn * 8) * 72 + c;
        vd[0 * 72] = (bf16_t)(vv.x & 0xffffu); vd[1 * 72] = (bf16_t)(vv.x >> 16);
        vd[2 * 72] = (bf16_t)(vv.y & 0xffffu); vd[3 * 72] = (bf16_t)(vv.y >> 16);
        vd[4 * 72] = (bf16_t)(vv.z & 0xffffu); vd[5 * 72] = (bf16_t)(vv.z >> 16);
        vd[6 * 72] = (bf16_t)(vv.w & 0xffffu); vd[7 * 72] = (bf16_t)(vv.w >> 16);
    }
}
__device__ __forceinline__ void gla_part1_item(const Params& p, int l, const bf16_t* P, const float* LR, int item, unsigned char* lds) {
    const int h = item & 3, n = (item >> 2) & 127, bl = item >> 9, t0 = bl * SEQ + n * 64;
    const float* BF = (const float*)(lds + G_BF); const float* BB = (const float*)(lds + G_BB);
    bf16_t* KDT0 = (bf16_t*)(lds + G_IMG); bf16_t* KDT1 = KDT0 + 64 * 72; bf16_t* VT = KDT1 + 64 * 72;
    float* GS = (float*)(p.ws + OFF_GS); float* GD = (float*)(p.ws + OFF_GDEC);
    int tid_ = threadIdx.x; asm volatile("" : "+v"(tid_)); const int tid = tid_, lane = tid & 63, w = tid >> 6, l15 = lane & 15, q4 = lane >> 4;
    GlaPre gp; gla_prefetch(gp, P, t0, h, tid);
    gla_tables(p, l, LR, t0, h, lds);
#pragma unroll
    for (int i = 0; i < 8; ++i) {
        const int idx = tid + NTHR * i, c = idx >> 6, dk = idx & 63;
        const float kv = bf2f(gp.k[i]);
        KDT0[dk * 72 + c] = f2bf_d(kv * __expf(BF[63 * 64 + dk] - BF[c * 64 + dk]));
        KDT1[dk * 72 + c] = f2bf_d(kv * __expf(BB[dk] - BB[c * 64 + dk]));
    }
    gla_vt_store(gp, VT, tid);
    if (tid < 64) GD[(size_t)item * 64 + tid] = __expf(BF[63 * 64 + tid]);
    else if (tid < 128) GD[(size_t)(NITEM + item) * 64 + tid - 64] = __expf(BB[tid - 64]);
    __syncthreads();
    const int dir = w >> 2, dkt = w & 3;
    const bf16_t* KD = dir ? KDT1 : KDT0;
    bf16x8 kf[2];
#pragma unroll
    for (int ks = 0; ks < 2; ++ks) kf[ks] = *(const bf16x8*)(KD + (16 * dkt + l15) * 72 + 32 * ks + 8 * q4);
    float* dst = GS + ((size_t)dir * NITEM + item) * 8192;
#pragma unroll
    for (int dvt = 0; dvt < 8; ++dvt) {
        f32x4 a = {0.f, 0.f, 0.f, 0.f};
#pragma unroll
        for (int ks = 0; ks < 2; ++ks) { const bf16x8 vf = *(const bf16x8*)(VT + (16 * dvt + l15) * 72 + 32 * ks + 8 * q4); a = MFMA(kf[ks], vf, a); }
        *(f32x4*)(dst + (16 * dvt + l15) * 64 + 16 * dkt + 4 * q4) = a;
    }
    __syncthreads();
}
__device__ __forceinline__ void gla_scan(const Params& p, int dry = 0) {
    float* GS = (float*)(p.ws + OFF_GS); const float* GD = (const float*)(p.ws + OFF_GDEC);
    const int total = 2 * BG * 4 * 8192;
    int tid_ = threadIdx.x; asm volatile("" : "+v"(tid_));
    for (int id = blockIdx.x * NTHR + tid_; id < total; id += gridDim.x * NTHR) {
        const int e = id & 8191, comb = id >> 13, h = comb & 3, bl = (comb >> 2) % BG, dir = comb / (4 * BG), dk = e & 63;
        float S = 0.f;
        const size_t ibase = (size_t)dir * NITEM + (size_t)(bl * 128) * 4 + h;
        for (int s0 = 0; s0 < 128; s0 += 16) {
            float u[16], dc[16];
#pragma unroll
            for (int i = 0; i < 16; ++i) {
                const int n = dir ? 127 - (s0 + i) : s0 + i;
                const size_t item = ibase + (size_t)n * 4;
                u[i] = GS[item * 8192 + e]; dc[i] = GD[item * 64 + dk];
            }
#pragma unroll
            for (int i = 0; i < 16; ++i) {
                const int n = dir ? 127 - (s0 + i) : s0 + i;
                const size_t item = ibase + (size_t)n * 4;
                if (!dry) GS[item * 8192 + e] = S;
                S = dc[i] * S + u[i];
            }
        }
    }
}
__device__ __forceinline__ void gla_part2_item(const Params& p, int l, bf16_t* P, const float* LR, int item, unsigned char* lds, int dry = 0) {
    const int h = item & 3, n = (item >> 2) & 127, bl = item >> 9, t0 = bl * SEQ + n * 64;
    const float* BF = (const float*)(lds + G_BF); const float* BB = (const float*)(lds + G_BB);
    bf16_t* QF = (bf16_t*)(lds + G_IMG);
    bf16_t* KF = QF + 2 * 64 * 72;
    bf16_t* QD = KF + 2 * 64 * 72;
    bf16_t* VT = QD + 2 * 64 * 72;
    bf16_t* ST = VT + 128 * 72;
    float* OX = (float*)lds;
    const float* GS = (const float*)(p.ws + OFF_GS);
    int tid_ = threadIdx.x; asm volatile("" : "+v"(tid_)); const int tid = tid_, lane = tid & 63, w = tid >> 6, l15 = lane & 15, q4 = lane >> 4;
    GlaPre gp; gla_prefetch(gp, P, t0, h, tid);
    float4 sp[2][4];
#pragma unroll
    for (int dir = 0; dir < 2; ++dir)
#pragma unroll
        for (int i = 0; i < 4; ++i) { const int idx = tid + NTHR * i; sp[dir][i] = *(const float4*)(GS + ((size_t)dir * NITEM + item) * 8192 + (idx >> 4) * 64 + (idx & 15) * 4); }
    gla_tables(p, l, LR, t0, h, lds);
#pragma unroll
    for (int i = 0; i < 8; ++i) {
        const int idx = tid + NTHR * i, c = idx >> 6, dk = idx & 63;
        const float qv = bf2f(gp.q[i]);
        const float kv = bf2f(gp.k[i]);
        const float bf = BF[c * 64 + dk], mf = BF[31 * 64 + dk], bb = BB[c * 64 + dk], mb = BB[32 * 64 + dk];
        QF[c * 72 + dk] = f2bf_d(qv * __expf(bf - mf)); KF[c * 72 + dk] = f2bf_d(kv * __expf(mf - bf)); QD[c * 72 + dk] = f2bf_d(qv * __expf(bf));
        QF[4608 + c * 72 + dk] = f2bf_d(qv * __expf(bb - mb)); KF[4608 + c * 72 + dk] = f2bf_d(kv * __expf(mb - bb)); QD[4608 + c * 72 + dk] = f2bf_d(qv * __expf(bb));
    }
    gla_vt_store(gp, VT, tid);
#pragma unroll
    for (int dir = 0; dir < 2; ++dir) {
#pragma unroll
        for (int i = 0; i < 4; ++i) {
            const int idx = tid + NTHR * i, dv = idx >> 4, dk4 = (idx & 15) * 4;
            const float4 s = sp[dir][i];
            u32x2 o; o.x = pk2(s.x, s.y); o.y = pk2(s.z, s.w);
            *(u32x2*)(ST + dir * 9216 + dv * 72 + dk4) = o;
        }
    }
    __syncthreads();
    const int dir = w >> 2, ct = w & 3;
    const bf16_t* qfp = QF + dir * 4608; const bf16_t* kfp = KF + dir * 4608; const bf16_t* qdp = QD + dir * 4608; const bf16_t* stp = ST + dir * 9216;
    bf16x8 qf[2], qd[2];
#pragma unroll
    for (int ks = 0; ks < 2; ++ks) { qf[ks] = *(const bf16x8*)(qfp + (16 * ct + l15) * 72 + 32 * ks + 8 * q4); qd[ks] = *(const bf16x8*)(qdp + (16 * ct + l15) * 72 + 32 * ks + 8 * q4); }
    f32x4 sc[4];
    const int cq = 16 * ct + l15;
#pragma unroll
    for (int st = 0; st < 4; ++st) {
        f32x4 a = {0.f, 0.f, 0.f, 0.f};
#pragma unroll
        for (int ks = 0; ks < 2; ++ks) { const bf16x8 kf = *(const bf16x8*)(kfp + (16 * st + l15) * 72 + 32 * ks + 8 * q4); a = MFMA(kf, qf[ks], a); }
#pragma unroll
        for (int e = 0; e < 4; ++e) { const int s = 16 * st + 4 * q4 + e; const bool ok = dir ? (s > cq) : (s <= cq); a[e] = ok ? a[e] : 0.f; }
        sc[st] = a;
    }
    f32x4 o[8];
#pragma unroll
    for (int dt = 0; dt < 8; ++dt) o[dt] = (f32x4){0.f, 0.f, 0.f, 0.f};
#pragma unroll
    for (int kk = 0; kk < 2; ++kk) {
        u32x4 pu; pu.x = pk2(sc[2 * kk][0], sc[2 * kk][1]); pu.y = pk2(sc[2 * kk][2], sc[2 * kk][3]); pu.z = pk2(sc[2 * kk + 1][0], sc[2 * kk + 1][1]); pu.w = pk2(sc[2 * kk + 1][2], sc[2 * kk + 1][3]);
        const bf16x8 pf = mkfrag(pu);
#pragma unroll
        for (int dt = 0; dt < 8; ++dt) {
            const bf16_t* vr = VT + (dt * 16 + l15) * 72 + kk * 32 + 4 * q4;
            const bf16x8 vf = mkfrag2(*(const u32x2*)vr, *(const u32x2*)(vr + 16));
            o[dt] = MFMA(vf, pf, o[dt]);
        }
    }
#pragma unroll
    for (int ks = 0; ks < 2; ++ks)
#pragma unroll
        for (int dt = 0; dt < 8; ++dt) { const bf16x8 sf = *(const bf16x8*)(stp + (dt * 16 + l15) * 72 + 32 * ks + 8 * q4); o[dt] = MFMA(sf, qd[ks], o[dt]); }
    if (dir == 1) {
#pragma unroll
        for (int dt = 0; dt < 8; ++dt) *(f32x4*)(OX + cq * 132 + 16 * dt + 4 * q4) = o[dt];
    }
    __syncthreads();
    if (dir == 0) {
        float ss = 0.f;
#pragma unroll
        for (int dt = 0; dt < 8; ++dt) { o[dt] += *(const f32x4*)(OX + cq * 132 + 16 * dt + 4 * q4); ss += (o[dt][0] * o[dt][0] + o[dt][1] * o[dt][1]) + (o[dt][2] * o[dt][2] + o[dt][3] * o[dt][3]); }
        ss += __shfl_xor(ss, 16); ss += __shfl_xor(ss, 32);
        const float rms = 1.0f / sqrtf(ss * (1.0f / 128.0f) + 1e-6f);
        const float* ng = p.gla_norm_g + l * 512 + h * 128;
        const bf16_t* zrow = P + (size_t)(t0 + cq) * PS + C_Z + 2 * 512 + h * 128;
        bf16_t* orow = P + (size_t)(t0 + cq) * PS + C_GV + h * 128;
#pragma unroll
        for (int dt = 0; dt < 8; ++dt) {
            const int dd = 16 * dt + 4 * q4;
            const f32x4 z = ld_bf4(zrow + dd); const f32x4 g4 = *(const f32x4*)(ng + dd);
            if (!dry) st_bf4(orow + dd, o[dt] * rms * g4 * z);
        }
    }
    __syncthreads();
}

namespace pg8 {
#define PG8_LAS __attribute__((address_space(3)))
typedef unsigned short bf16_t;
typedef short bf16x8 __attribute__((ext_vector_type(8)));
typedef float f32x4 __attribute__((ext_vector_type(4)));
typedef unsigned u32x4 __attribute__((ext_vector_type(4)));
constexpr int BM = 256, BK = 64, HALF = 128, HTB = HALF * BK * 2  , STAGE_BYTES = 8 * HTB, NXCD = 8, WGM = 8;

__host__ __device__ __forceinline__ int lds_byte(int r, int c) { const int st = (r >> 4) * 2 + (c >> 5), rr = r & 15, cc = c & 31, ob = rr * 64 + cc * 2; return st * 1024 + (ob ^ (((ob >> 9) & 1) << 5)); }
__host__ __device__ __forceinline__ void stage_rc(int b, int& R, int& C) { const int st = b / 1024, sb = b % 1024, swz = sb ^ (((sb >> 9) & 1) << 5); R = (st >> 1) * 16 + swz / 64; C = (st & 1) * 32 + (swz % 64) / 2; }
__host__ __device__ __forceinline__ int perm32(int rho) { const int n = rho >> 4, i = rho & 15; return 8 * (i >> 2) + 4 * n + (i & 3); }

struct Unit { int pm, pn; };
struct Gemm { const bf16_t* A; const bf16_t* Bt; int M, N, K; };

struct StaticOrder {
    int nM, nN, nwg, G, c;
    __host__ __device__ __forceinline__ void init(int M, int N, int G_, int c_) { nM = M / BM; nN = N / BM; nwg = nM * nN; G = G_; c = c_; }
    __host__ __device__ bool next(int i, Unit& u) const {
        const long L = (long)i * G + c; if (L >= nwg) return false;
        int wgid = (int)L; { const int q = nwg / NXCD, r = nwg % NXCD, xcd = wgid % NXCD, off = wgid / NXCD; wgid = (xcd < r ? xcd * (q + 1) : r * (q + 1) + (xcd - r) * q) + off; }
        const int nig = WGM * nN, gid = wgid / nig, fm = gid * WGM, gsz = (nM - fm) < WGM ? (nM - fm) : WGM;
        u.pm = fm + ((wgid % nig) % gsz); u.pn = (wgid % nig) / gsz; return true;
    }
    __device__ __forceinline__ void a_ready(const Unit&) const {}
    __device__ __forceinline__ void done(const Unit&) const {}
};
__device__ __forceinline__ unsigned cvt_pk_bf16(float lo, float hi) { unsigned r; asm volatile("v_cvt_pk_bf16_f32 %0, %1, %2" : "=v"(r) : "v"(lo), "v"(hi)); return r; }
template <class Epi, class Sched, bool STAMP = false>
__device__ __forceinline__ void gemm_phase(PG8_LAS unsigned char* lds, const Gemm g, const Sched& S, const Epi& E, unsigned long long* stamps) {
    int tid_l = threadIdx.x; asm volatile("" : "+v"(tid_l)); const int tid = tid_l, wid = __builtin_amdgcn_readfirstlane(tid >> 6), lane = tid & 63, wr = wid >> 2, wc = wid & 3, fr = lane & 15, fq = lane >> 4;
    const int K = g.K, nt = K / BK;
    int ts_lo = 0, ts_hi = 0, nts = 0; const unsigned long long rt_entry = STAMP ? (unsigned long long)wall_clock64() : 0ull;
#define PG8_STAMP() do { if (STAMP && wid == 0 && nts < 64) { const unsigned long long _c = (unsigned long long)clock64(); \
        ts_lo = (lane == nts) ? (int)(unsigned)_c : ts_lo; ts_hi = (lane == nts) ? (int)(unsigned)(_c >> 32) : ts_hi; ++nts; } } while (0)
    PG8_STAMP();
    unsigned voffA[2], voffB[2];
#pragma unroll
    for (int i = 0; i < 2; ++i) { int R, C; stage_rc(tid * 16 + i * 8192, R, C); const int Rb = Epi::PERM ? ((R & ~31) + perm32(R & 31)) : R;
        voffA[i] = (unsigned)(R * K + C) * 2u; voffB[i] = (unsigned)(Rb * K + C) * 2u; }
    const size_t kstep = (size_t)(BK * 2);
    const size_t hstep = (size_t)HALF * K * 2;
    const size_t tstep = 2 * hstep;
    const unsigned ldsw = (unsigned)wid * 1024u;
    const int aoff = lds_byte(wr * 64 + fr, fq * 8), boff = lds_byte(wc * 32 + fr, fq * 8);
#define PG8_SA(b, h) (((b) * 2 + (h)) * HTB)
#define PG8_SB(b, h) ((4 + (b) * 2 + (h)) * HTB)
#define PG8_STAGE(bufoff, gbase, voff) do { _Pragma("unroll") for (int _i = 0; _i < 2; ++_i) \
        __builtin_amdgcn_global_load_lds((const unsigned*)((const char*)(gbase) + (voff)[_i]), (PG8_LAS unsigned*)(lds + (bufoff) + ldsw + _i * 8192), 16, 0, 0); } while (0)
#define PG8_LDA(dst, b, h) do { _Pragma("unroll") for (int m = 0; m < 4; ++m) _Pragma("unroll") for (int k = 0; k < 2; ++k) dst[m][k] = *(const PG8_LAS bf16x8*)(lds + PG8_SA(b, h) + aoff + m * 2048 + k * 1024); } while (0)
#define PG8_LDB(dst, b, h) do { _Pragma("unroll") for (int n = 0; n < 2; ++n) _Pragma("unroll") for (int k = 0; k < 2; ++k) dst[n][k] = *(const PG8_LAS bf16x8*)(lds + PG8_SB(b, h) + boff + n * 2048 + k * 1024); } while (0)
#define PG8_MMA(ai, bj, At, Bt) do { __builtin_amdgcn_s_setprio(1); _Pragma("unroll") for (int m = 0; m < 4; ++m) _Pragma("unroll") for (int n = 0; n < 2; ++n) _Pragma("unroll") for (int k = 0; k < 2; ++k) \
        acc[ai][bj][m][n] = __builtin_amdgcn_mfma_f32_16x16x32_bf16(Bt[n][k], At[m][k], acc[ai][bj][m][n], 0, 0, 0); __builtin_amdgcn_s_setprio(0); } while (0)
#define PG8_WAIT_V(n) asm volatile("s_waitcnt vmcnt(" #n ")" ::: "memory")
#define PG8_WAIT_L(n) asm volatile("s_waitcnt lgkmcnt(" #n ")" ::: "memory")
#define PG8_BAR __builtin_amdgcn_s_barrier()
#define PG8_SCHED __builtin_amdgcn_sched_barrier(0)
    Unit cur, nxt; int ui = 0;
    if (!S.next(0, cur)) return;
    f32x4 acc[2][2][4][2];
#pragma unroll
    for (int a = 0; a < 2; ++a)
#pragma unroll
        for (int b = 0; b < 2; ++b)
#pragma unroll
            for (int m = 0; m < 4; ++m)
#pragma unroll
                for (int n = 0; n < 2; ++n) acc[a][b][m][n] = (f32x4){0.f, 0.f, 0.f, 0.f};
    bf16x8 At[4][2], B0[2][2], B1[2][2];
    const char* cA = (const char*)g.A + (size_t)cur.pm * tstep; const char* cB = (const char*)g.Bt + (size_t)cur.pn * tstep;
    S.a_ready(cur);
    PG8_STAGE(PG8_SB(0, 0), cB, voffB); PG8_STAGE(PG8_SA(0, 0), cA, voffA); PG8_STAGE(PG8_SB(0, 1), cB + hstep, voffB); PG8_STAGE(PG8_SA(0, 1), cA + hstep, voffA);
    if (wr == 1) PG8_BAR;
    PG8_WAIT_V(4); PG8_BAR;
    PG8_STAGE(PG8_SB(1, 0), cB + kstep, voffB); PG8_STAGE(PG8_SA(1, 0), cA + kstep, voffA); PG8_STAGE(PG8_SB(1, 1), cB + hstep + kstep, voffB);
    PG8_WAIT_V(6); PG8_BAR;
    PG8_STAMP();
    for (;;) {
        const bool has_next = S.next(ui + 1, nxt);
        const char* nA = has_next ? (const char*)g.A + (size_t)nxt.pm * tstep : cA; const char* nB = has_next ? (const char*)g.Bt + (size_t)nxt.pn * tstep : cB;
        for (int t = 0; t < nt; t += 2) {
            const bool last = (t == nt - 2);
            const char* a1 = cA + (size_t)(t + 1) * kstep;
            const char* a2 = last ? nA : cA + (size_t)(t + 2) * kstep; const char* b2 = last ? nB : cB + (size_t)(t + 2) * kstep;
            const char* a3 = a2 + kstep; const char* b3 = b2 + kstep;
            if (last && has_next) S.a_ready(nxt);
            PG8_LDB(B0, 0, 0); PG8_SCHED; PG8_LDA(At, 0, 0); PG8_STAGE(PG8_SA(1, 1), a1 + hstep, voffA);
            PG8_WAIT_L(8); PG8_BAR; PG8_WAIT_L(0); PG8_MMA(0, 0, At, B0); PG8_BAR; PG8_SCHED;
            PG8_LDB(B1, 0, 1); PG8_STAGE(PG8_SB(0, 0), b2, voffB);
            PG8_BAR; PG8_WAIT_L(0); PG8_MMA(0, 1, At, B1); PG8_BAR;
            PG8_LDA(At, 0, 1); PG8_STAGE(PG8_SA(0, 0), a2, voffA);
            PG8_BAR; PG8_WAIT_L(0); PG8_MMA(1, 0, At, B0); PG8_BAR; PG8_SCHED;
            PG8_STAGE(PG8_SB(0, 1), b2 + hstep, voffB);
            PG8_WAIT_V(6); PG8_BAR; PG8_MMA(1, 1, At, B1); PG8_BAR;
            PG8_LDB(B0, 1, 0); PG8_SCHED; PG8_LDA(At, 1, 0); PG8_STAGE(PG8_SA(0, 1), a2 + hstep, voffA);
            PG8_WAIT_L(8); PG8_BAR; PG8_WAIT_L(0); PG8_MMA(0, 0, At, B0); PG8_BAR; PG8_SCHED;
            PG8_LDB(B1, 1, 1); PG8_STAGE(PG8_SB(1, 0), b3, voffB);
            PG8_BAR; PG8_WAIT_L(0); PG8_MMA(0, 1, At, B1); PG8_BAR;
            PG8_LDA(At, 1, 1); PG8_STAGE(PG8_SA(1, 0), a3, voffA);
            PG8_BAR; PG8_WAIT_L(0); PG8_MMA(1, 0, At, B0); PG8_BAR; PG8_SCHED;
            PG8_STAGE(PG8_SB(1, 1), b3 + hstep, voffB);
            PG8_WAIT_V(6); PG8_BAR; PG8_MMA(1, 1, At, B1); PG8_BAR;
        }
        PG8_STAMP();
        if constexpr (!Epi::AFTER_DRAIN) { E(acc, cur, wr, wc, fr, fq); S.done(cur); }
        PG8_STAMP();
        if (!has_next) break;
#pragma unroll
        for (int a = 0; a < 2; ++a)
#pragma unroll
            for (int b = 0; b < 2; ++b)
#pragma unroll
                for (int m = 0; m < 4; ++m)
#pragma unroll
                    for (int n = 0; n < 2; ++n) acc[a][b][m][n] = (f32x4){0.f, 0.f, 0.f, 0.f};
        cur = nxt; cA = nA; cB = nB; ++ui;
    }
    PG8_WAIT_V(0);
    if (wr == 0) PG8_BAR;
    PG8_BAR;
    if constexpr (Epi::AFTER_DRAIN) { E.fused(acc, cur, wr, wc, fr, fq, lds, wid, lane); S.done(cur); }
    PG8_STAMP();
    if (STAMP && wid == 0) { stamps[lane] = lane < nts ? (((unsigned long long)(unsigned)ts_hi << 32) | (unsigned)ts_lo) : 0ull;
        if (lane == 62) stamps[62] = rt_entry; if (lane == 63) stamps[63] = (unsigned long long)wall_clock64(); }
#undef PG8_STAMP
#undef PG8_SA
#undef PG8_SB
#undef PG8_STAGE
#undef PG8_LDA
#undef PG8_LDB
#undef PG8_MMA
#undef PG8_WAIT_V
#undef PG8_WAIT_L
#undef PG8_BAR
#undef PG8_SCHED
}
}

struct EpiInProj {
    static constexpr bool PERM = true, AFTER_DRAIN = false;
    bf16_t* P; const float* bias; float* LR;
    __device__ __forceinline__ void operator()(const f32x4 (&acc)[2][2][4][2], const pg8::Unit& u, int wr, int wc, int fr, int fq) const {
        const int row0 = u.pm * 256 + wr * 64 + fr, colt = u.pn * 256, col0 = colt + wc * 32 + 8 * fq;
        if (colt == C_LR) {
            if (wc == 0) {
                const int cl = 8 * fq;
                const f32x4 b0 = *(const f32x4*)(bias + 4096 + cl), b1 = *(const f32x4*)(bias + 4096 + cl + 4);
#pragma unroll
                for (int ai = 0; ai < 2; ++ai)
#pragma unroll
                    for (int m = 0; m < 4; ++m) {
                        float* d = LR + (size_t)(row0 + ai * 128 + m * 16) * 32 + cl;
                        *(f32x4*)d = acc[ai][0][m][0] + b0; *(f32x4*)(d + 4) = acc[ai][0][m][1] + b1;
                    }
            }
            return;
        }
        const int mode = (colt < 512 || colt == C_GQ) ? 1 : (colt >= C_MQ && colt < C_Z) ? 2 : (colt >= C_Z && colt < C_SG) ? 3 : (colt >= C_SG) ? 4 : 0;
#pragma unroll
        for (int bj = 0; bj < 2; ++bj) {
            const int col = col0 + bj * 128;
            const f32x4 b0 = *(const f32x4*)(bias + orig_col(col)), b1 = *(const f32x4*)(bias + orig_col(col) + 4);
#pragma unroll
            for (int ai = 0; ai < 2; ++ai)
#pragma unroll
                for (int m = 0; m < 4; ++m) {
                    f32x4 v0 = acc[ai][bj][m][0] + b0, v1 = acc[ai][bj][m][1] + b1;
                    if (mode == 1) { v0 *= 0.125f; v1 *= 0.125f; }
                    else if (mode == 2) { v0 *= 0.08838834764831845f; v1 *= 0.08838834764831845f; }
                    else if (mode == 3) {
#pragma unroll
                        for (int e = 0; e < 4; ++e) { v0[e] = siluf_(v0[e]); v1[e] = siluf_(v1[e]); }
                    } else if (mode == 4) {
#pragma unroll
                        for (int e = 0; e < 4; ++e) { v0[e] = sigmoidf_(v0[e]); v1[e] = sigmoidf_(v1[e]); }
                    }
                    u32x4 o; o.x = pk2(v0[0], v0[1]); o.y = pk2(v0[2], v0[3]); o.z = pk2(v1[0], v1[1]); o.w = pk2(v1[2], v1[3]);
                    *(u32x4*)(P + (size_t)(row0 + ai * 128 + m * 16) * PS + col) = o;
                }
        }
    }
};
struct EpiOut {
    static constexpr bool PERM = false, AFTER_DRAIN = false;
    float* pre; const float* bo; const float* x; const float2* stats; const float* g0; const float* b0; const float* hres; size_t tok0; int l;
    __device__ __forceinline__ void operator()(const f32x4 (&acc)[2][2][4][2], const pg8::Unit& u, int wr, int wc, int fr, int fq) const {
        const int row0 = u.pm * 256 + wr * 64 + fr, col0 = u.pn * 256 + wc * 32 + 4 * fq;
#pragma unroll
        for (int ai = 0; ai < 2; ++ai)
#pragma unroll
            for (int m = 0; m < 4; ++m) {
                const int row = row0 + ai * 128 + m * 16; const size_t T = tok0 + row;
                float2 st; st.x = 0.f; st.y = 0.f; if (l == 0) st = stats[T];
#pragma unroll
                for (int bj = 0; bj < 2; ++bj)
#pragma unroll
                    for (int n = 0; n < 2; ++n) {
                        const int col = col0 + bj * 128 + n * 16;
                        f32x4 res;
                        if (l == 0) res = (*(const f32x4*)(x + T * 1024 + col) - st.x) * st.y * *(const f32x4*)(g0 + col) + *(const f32x4*)(b0 + col);
                        else res = *(const f32x4*)(hres + T * 1024 + col);
                        *(f32x4*)(pre + (size_t)row * 1024 + col) = acc[ai][bj][m][n] + *(const f32x4*)(bo + col) + DN_ALPHA * res;
                    }
            }
    }
};

#define XB_TMO      128
#define XB_XCNT(j)  (256  + 64 * (j))
#define XB_XSUB(j)  (1280 + 64 * (j))
#define XB_XGEN(j)  (2304 + 64 * (j))
#define XB_TOP      3328
#define XB_TOPGEN   3392
#define XCD_BAR_WORDS 3456
#define XB_SPIN_CAP (1u << 18)
#define LAS __attribute__((address_space(3)))

__device__ __forceinline__ unsigned xb_ld(unsigned* p)              { return __hip_atomic_load(p, __ATOMIC_RELAXED, __HIP_MEMORY_SCOPE_AGENT); }
__device__ __forceinline__ unsigned xb_add(unsigned* p, unsigned v) { return __hip_atomic_fetch_add(p, v, __ATOMIC_RELAXED, __HIP_MEMORY_SCOPE_AGENT); }
__device__ __forceinline__ unsigned xb_xcc_id() { return (unsigned)__builtin_amdgcn_s_getreg((3 << 11) | 20) & 0xFu; }
#define XB_SPIN(cond, bar) do { unsigned _sp = 0; while (cond) { __builtin_amdgcn_s_sleep(1); \
    if ((++_sp & 255u) == 0u) { if (xb_ld(&(bar)[XB_TMO])) break; if (_sp > XB_SPIN_CAP) { atomicAdd(&(bar)[XB_TMO], 1u); break; } } } } while (0)

struct XcdBarrier {
    unsigned* bar; unsigned x;
    volatile LAS unsigned* st;
};

__device__ __forceinline__ XcdBarrier xcd_barrier_post(unsigned* bar, volatile LAS unsigned* st) {
    XcdBarrier b; b.bar = bar; b.x = xb_xcc_id(); b.st = st;
    if (threadIdx.x == 0) (void)xb_add(&bar[XB_XCNT(b.x)], 1u);
    return b;
}
__device__ __forceinline__ void xcd_barrier_complete(unsigned* bar, unsigned x, unsigned& nloc, unsigned& nx) {
    const unsigned G = gridDim.x * gridDim.y * gridDim.z;
    unsigned sum, cnt, mine, sp = 0u;
    for (;;) {
        sum = 0u; cnt = 0u; mine = 0u;
#pragma unroll
        for (unsigned j = 0; j < 16; ++j) { const unsigned c = xb_ld(&bar[XB_XCNT(j)]); sum += c; cnt += (c > 0u) ? 1u : 0u; mine = (j == x) ? c : mine; }
        if (sum == G) break;
        __builtin_amdgcn_s_sleep(1);
        if ((++sp & 255u) == 0u) { if (xb_ld(&bar[XB_TMO])) break; if (sp > XB_SPIN_CAP) { atomicAdd(&bar[XB_TMO], 1u); break; } }
    }
    nloc = mine > 0u ? mine : 1u; nx = cnt > 0u ? cnt : 1u;
}

__device__ __forceinline__ void xcd_barrier(unsigned* b_bar, unsigned b_x, volatile LAS unsigned* b_st) {
    asm volatile("s_waitcnt vmcnt(0)" ::: "memory");
    __syncthreads();
    if (threadIdx.x == 0) {
        unsigned* bar = b_bar;
        __builtin_amdgcn_s_waitcnt(0);
        unsigned nloc = b_st[0], nx = b_st[1];
        if (nloc == 0u) { xcd_barrier_complete(bar, b_x, nloc, nx); b_st[0] = nloc; b_st[1] = nx; }
        const unsigned old = xb_add(&bar[XB_XSUB(b_x)], 1u);
        const unsigned gen = old / nloc;
        if (old + 1u == (gen + 1u) * nloc) {
            __builtin_amdgcn_fence(__ATOMIC_RELEASE, "agent");
            asm volatile("s_waitcnt vmcnt(0)" ::: "memory");
            const unsigned og = xb_add(&bar[XB_TOP], 1u);
            const unsigned tg = og / nx;
            if (og + 1u == (tg + 1u) * nx) xb_add(&bar[XB_TOPGEN], 1u);
            else XB_SPIN(xb_ld(&bar[XB_TOPGEN]) == tg, bar);
            __builtin_amdgcn_fence(__ATOMIC_ACQUIRE, "agent");
            xb_add(&bar[XB_XGEN(b_x)], 1u);
            asm volatile("s_waitcnt vmcnt(0)" ::: "memory");
        } else {
            XB_SPIN(xb_ld(&bar[XB_XGEN(b_x)]) == gen, bar);
            __builtin_amdgcn_fence(__ATOMIC_ACQUIRE, "agent");
            asm volatile("s_waitcnt vmcnt(0)" ::: "memory");
        }
    }
    __syncthreads();
}

__device__ __forceinline__ void gbar(unsigned* ctr, unsigned& gen, int G) {
    __syncthreads();
    gen += (unsigned)G;
    if (threadIdx.x == 0) {
        __threadfence();
        __hip_atomic_fetch_add(ctr, 1u, __ATOMIC_RELAXED, __HIP_MEMORY_SCOPE_AGENT);
        while (__hip_atomic_load(ctr, __ATOMIC_RELAXED, __HIP_MEMORY_SCOPE_AGENT) < gen) __builtin_amdgcn_s_sleep(1);
        __threadfence();
    }
    __syncthreads();
}
typedef const Params __attribute__((address_space(4))) KParams;
#define KP4 __attribute__((address_space(4)))
__device__ __forceinline__ Params fresh_params() {
#if defined(__HIP_DEVICE_COMPILE__)
    KParams* kp = (KParams*)__builtin_amdgcn_kernarg_segment_ptr();
    asm volatile("" : "+s"(kp));
    Params r;
    const float* KP4 const* src = (const float* KP4 const*)kp;
    const float** dst = (const float**)&r;
#pragma unroll
    for (int i = 0; i < 28; ++i) dst[i] = src[i];
    return r;
#else
    return Params{};
#endif
}
__global__ void __launch_bounds__(NTHR) mega(Params p_unused) {
    extern __shared__ __attribute__((aligned(16))) unsigned char lds[];
    cg::grid_group grid = cg::this_grid();
    const int G = gridDim.x, bid = blockIdx.x;
    volatile LAS unsigned* xst = (volatile LAS unsigned*)((LAS unsigned char*)lds + (LDS_BYTES - 16));
    if (threadIdx.x == 0) { xst[0] = 0u; xst[1] = 0u; }
    __syncthreads();
    unsigned* xbar; unsigned xx;
    { const Params p = fresh_params(); xbar = (unsigned*)(p.ws + OFF_BAR); xx = xb_xcc_id(); if (threadIdx.x == 0) (void)xb_add(&xbar[XB_XCNT(xx)], 1u); }
    { const Params p = fresh_params(); phase0(p); }
    grid.sync();
#pragma unroll 1
    for (int l = 0; l < 2; ++l) {
        { const Params p = fresh_params(); phase_weights(p, l, lds); __syncthreads(); phase_filter_gen(p, l, lds); }
        xcd_barrier(xbar, xx, xst);
        {
            const Params p = fresh_params();
            phase_filter_fft(p, l, lds);
            const bf16_t* WtKV = (const bf16_t*)(p.ws + OFF_WTKV); const bf16_t* membf = (const bf16_t*)(p.ws + OFF_MEMBF);
            for (int t = bid; t < 64; t += G) {
                f32x4 acc[4][4];
                if (t < 32) {
                    const int m0 = (t >> 2) * 256, n0 = (t & 3) * 128;
                    gemm_core(acc, membf + (size_t)m0 * 1024, 1024, WtKV + (size_t)n0 * 1024, 1024, 1024, lds);
                    bf16_t* Km = (bf16_t*)(p.ws + OFF_KMAT);
                    EPI_LOOP(st_bf4(Km + (size_t)row * 512 + col, v);)
                } else {
                    const int t2 = t - 32, m0 = (t2 >> 4) * 256, n0 = (t2 & 15) * 128;
                    gemm_core(acc, WtKV + (size_t)(512 + m0) * 1024, 1024, membf + (size_t)n0 * 1024, 1024, 1024, lds);
                    bf16_t* Vm = (bf16_t*)(p.ws + OFF_VT);
                    EPI_LOOP(st_bf4(Vm + (size_t)row * 2048 + col, v);)
                }
            }
        }
        xcd_barrier(xbar, xx, xst);
#pragma unroll 1
        for (int g = 0; g < NGRP; ++g) {
            const size_t tok0 = (size_t)g * TG;
#pragma unroll 1
            for (int rep = 0; rep < PROBE_REP_INPROJ; ++rep) {
                const Params p = fresh_params();
                pg8::Gemm gm; gm.A = (const bf16_t*)(p.ws + OFF_HB) + tok0 * 1024; gm.Bt = (const bf16_t*)(p.ws + OFF_WTIN); gm.M = TG; gm.N = NINP; gm.K = 1024;
                pg8::StaticOrder S; S.init(TG, NINP, G, bid);
                EpiInProj E; E.P = (bf16_t*)(p.ws + OFF_P); E.bias = p.b_in + (size_t)l * NIN; E.LR = (float*)(p.ws + OFF_LR);
                pg8::gemm_phase<EpiInProj, pg8::StaticOrder, false>((PG8_LAS unsigned char*)lds, gm, S, E, nullptr);
                __syncthreads();
            }
            xcd_barrier(xbar, xx, xst);
#pragma unroll 1
            for (int rep = 0; rep < PROBE_REP_MIX; ++rep) {
            int dry = (rep + 1 < PROBE_REP_MIX) ? 1 : 0; asm volatile("" : "+s"(dry));
            {
                const Params p = fresh_params();
                bf16_t* P = (bf16_t*)(p.ws + OFF_P);
                for (int it = bid; it < BG * 64 * 8; it += G) na_item(p, l, P, it >> 9, (it >> 3) & 63, it & 7, lds, dry);
            }
            {
                const Params p = fresh_params();
                bf16_t* P = (bf16_t*)(p.ws + OFF_P);
                for (int it = bid; it < BG * 128 * 8; it += G) hy_pre_item(p, l, P, (float*)(p.ws + OFF_UT), (bf16_t*)(p.ws + OFF_GT), it >> 10, (it >> 3) & 127, it & 7, lds);
            }
            {
                const Params p = fresh_params();
                for (int it = bid; it < NITEM; it += G) gla_part1_item(p, l, (const bf16_t*)(p.ws + OFF_P), (const float*)(p.ws + OFF_LR), it, lds);
            }
            {
                const Params p = fresh_params();
                bf16_t* P = (bf16_t*)(p.ws + OFF_P);
                const int nit = BG * 4 * 64, per = (nit + G - 1) / G;
                int last = -1;
                for (int it = bid * per; it < min(nit, (bid + 1) * per); ++it) {
                    const int bh = it >> 6, bl = bh >> 2, h = bh & 3;
                    if (bh != last) { __syncthreads(); memattn_load(p, g * BG + bl, h, lds); last = bh; }
                    memattn_item(P, bl, h, it & 63, lds, dry);
                }
                __syncthreads();
            }
            xcd_barrier(xbar, xx, xst);
            {
                const Params p = fresh_params();
                const float2* twl = fft_lds_twiddles((const float2*)(p.ws + OFF_TW), lds);
                for (int it = bid; it < BG * 256; it += G) hyena_conv_item(p, (const float*)(p.ws + OFF_UT), (bf16_t*)(p.ws + OFF_GT), it >> 8, it & 255, lds, twl, dry);
                __syncthreads();
                gla_scan(p, dry);
            }
            xcd_barrier(xbar, xx, xst);
            {
                const Params p = fresh_params();
                for (int it = bid; it < NITEM; it += G) gla_part2_item(p, l, (bf16_t*)(p.ws + OFF_P), (const float*)(p.ws + OFF_LR), it, lds, dry);
            }
            {
                const Params p = fresh_params();
                for (int it = bid; it < BG * 128 * 8; it += G) hy_post_item((bf16_t*)(p.ws + OFF_P), (const bf16_t*)(p.ws + OFF_GT), it >> 10, (it >> 3) & 127, it & 7, lds, dry);
            }
            xcd_barrier(xbar, xx, xst);
            }
            {
                const Params p = fresh_params();
                const bf16_t* P = (const bf16_t*)(p.ws + OFF_P); const bf16_t* WtBr = (const bf16_t*)(p.ws + OFF_WTBR); bf16_t* merged = (bf16_t*)(p.ws + OFF_MERGED);
                for (int t = bid; t < 512; t += G) {
                    const int sr = t >> 8, sb = t & 255, sx = sb & 7, sk = sb >> 3;
                    const int m0 = (sr * 32 + (sk >> 3) * 8 + sx) * 256, n0 = (sk & 7) * 128;
                    merge_tile(P, WtBr, merged, m0, n0, lds);
                }
            }
            xcd_barrier(xbar, xx, xst);
            {
                const Params p = fresh_params();
                pg8::Gemm gm; gm.A = (const bf16_t*)(p.ws + OFF_MERGED); gm.Bt = (const bf16_t*)(p.ws + OFF_WTOUT); gm.M = TG; gm.N = 1024; gm.K = 1024;
                pg8::StaticOrder S; S.init(TG, 1024, G, bid);
                EpiOut E; E.pre = (float*)(p.ws + OFF_PRE); E.bo = p.b_out + l * 1024; E.x = p.x; E.stats = (const float2*)(p.ws + OFF_STATS); E.g0 = p.ln_in_g; E.b0 = p.ln_in_b; E.hres = p.out; E.tok0 = tok0; E.l = l;
                pg8::gemm_phase<EpiOut, pg8::StaticOrder, false>((PG8_LAS unsigned char*)lds, gm, S, E, nullptr);
                __syncthreads();
            }
            xcd_barrier(xbar, xx, xst);
            {
                const Params p = fresh_params();
                ln_rows((const float*)(p.ws + OFF_PRE), 0, TG, p.ln_g + l * 1024, p.ln_b + l * 1024, p.out, (bf16_t*)(p.ws + OFF_HB), tok0, nullptr);
            }
        }
        xcd_barrier(xbar, xx, xst);
    }
}

extern "C" void kernel_launch(void* const* d_in, const int* in_sizes, int n_in, void* d_out, int out_size, void* d_ws, size_t ws_size, hipStream_t stream) {
    static int grid_blocks = 0;
    if (!grid_blocks) {
        if (ws_size < WS_END) { fprintf(stderr, "kernel_launch: workspace too small: %zu < %zu\n", ws_size, (size_t)WS_END); grid_blocks = -1; return; }
        {
            const long long ex[26] = {67108864LL, 2097152LL, 1024, 1024, 2LL * 1024 * 10784, 2 * 10784, 2 * 8 * 15 * 31, 2 * 3 * 1536, 2 * 1536, 2 * 33 * 64, 2 * 64, 2 * 2 * 64 * 64, 2 * 2 * 64,
                                      2 * 64 * 1024, 2 * 512, 2 * 16 * 256, 2 * 256, 2 * 16 * 256, 2 * 256, 2 * 512, 2LL * 1024 * 1024, 2LL * 4 * 512 * 1024, 2LL * 1024 * 1024, 2 * 1024, 2 * 1024, 2 * 1024};
            bool bad = (n_in != 26) || (out_size != 67108864);
            for (int i = 0; i < 26 && !bad; ++i) if ((long long)in_sizes[i] != ex[i]) { fprintf(stderr, "kernel_launch: input %d has %d elements, expected %lld\n", i, in_sizes[i], ex[i]); bad = true; }
            if (bad) { fprintf(stderr, "kernel_launch: unexpected shapes; nothing launched\n"); grid_blocks = -1; return; }
        }
        int dev = 0, cus = 0, per_cu = 0;
        hipGetDevice(&dev);
        hipDeviceGetAttribute(&cus, hipDeviceAttributeMultiprocessorCount, dev);
        if (hipFuncSetAttribute((const void*)mega, hipFuncAttributeMaxDynamicSharedMemorySize, LDS_BYTES) != hipSuccess) fprintf(stderr, "kernel_launch: hipFuncSetAttribute failed\n");
        if (hipOccupancyMaxActiveBlocksPerMultiprocessor(&per_cu, (const void*)mega, NTHR, LDS_BYTES) != hipSuccess || per_cu < 1) { fprintf(stderr, "kernel_launch: occupancy query gave %d\n", per_cu); per_cu = 1; }
        (void)hipGetLastError();
        if (per_cu > 1) per_cu = 1;
        grid_blocks = cus * per_cu;
    }
    if (grid_blocks < 0) return;
    Params p{};
    const float** pp = (const float**)&p;
    for (int i = 0; i < 26; ++i) pp[i] = (const float*)d_in[i];
    p.out = (float*)d_out; p.ws = (unsigned char*)d_ws;
    if (hipMemsetAsync((unsigned char*)d_ws + OFF_BAR, 0, 16384, stream) != hipSuccess) fprintf(stderr, "kernel_launch: memset of the barrier word failed\n");
    void* args[] = {&p};
    hipError_t e = hipLaunchCooperativeKernel((const void*)mega, dim3(grid_blocks), dim3(NTHR), args, LDS_BYTES, stream);
    if (e != hipSuccess) fprintf(stderr, "cooperative launch failed: %s (grid %d)\n", hipGetErrorString(e), grid_blocks);
}
#endif
```

```cpp
#ifndef PROBE_REP_MIX
#define PROBE_REP_MIX 1
#endif
#ifndef PROBE_REP_INPROJ
#define PROBE_REP_INPROJ 1
#endif
#include <hip/hip_runtime.h>
#include <hip/hip_cooperative_groups.h>
#include <cstdio>
#include <unistd.h>
#include <cmath>
namespace cg = cooperative_groups;

#define HD __host__ __device__
typedef unsigned short bf16_t;
typedef short bf16x8 __attribute__((ext_vector_type(8)));
typedef float f32x4 __attribute__((ext_vector_type(4)));
typedef unsigned u32x2 __attribute__((ext_vector_type(2)));
typedef unsigned u32x4 __attribute__((ext_vector_type(4)));

constexpr int NTOK = 65536, DM = 1024, SEQ = 8192, NB = 8;
constexpr int BG = 2;
constexpr int NGRP = NB / BG;
constexpr int TG = BG * SEQ;
constexpr int PS = 10752;
constexpr int NIN = 10784, NINP = 11008;
constexpr int C_NAQ = 0, C_NAK = 512, C_NAV = 1024, C_HY = 1536, C_GQ = 3072, C_GK = 3328, C_GV = 3584, C_MQ = 4096, C_Z = 4608, C_SG = 6656, C_LR = 10752;
constexpr int FN = 16384;
constexpr int NITEM = BG * 128 * 4;
constexpr int LDS_BYTES = 160 * 1024;
constexpr int NTHR = 512;
constexpr float DN_ALPHA = 1.41421356237309515f;

constexpr size_t al256(size_t x) { return (x + 255) & ~(size_t)255; }
constexpr size_t OFF_HB = 0;
constexpr size_t OFF_STATS = OFF_HB + (size_t)NTOK * DM * 2;
constexpr size_t OFF_TW = OFF_STATS + (size_t)NTOK * 8;
constexpr size_t OFF_MEMBF = OFF_TW + (size_t)FN * 8;
constexpr size_t OFF_ENERGY = OFF_MEMBF + (size_t)2048 * 1024 * 2;
constexpr size_t OFF_WTIN = OFF_ENERGY + 4096;
constexpr size_t OFF_WTBR = OFF_WTIN + (size_t)NINP * 1024 * 2;
constexpr size_t OFF_WTOUT = OFF_WTBR + (size_t)4 * 1024 * 512 * 2;
constexpr size_t OFF_WTKV = OFF_WTOUT + (size_t)1024 * 1024 * 2;
constexpr size_t OFF_KMAT = OFF_WTKV + (size_t)2048 * 1024 * 2;
constexpr size_t OFF_VT = OFF_KMAT + (size_t)2048 * 1024 * 2;
constexpr size_t OFF_HFILT = OFF_VT + (size_t)2048 * 1024 * 2;
constexpr size_t OFF_PQ = OFF_HFILT + (size_t)1024 * 8192 * 4;
constexpr size_t OFF_P = OFF_PQ + (size_t)256 * FN * 16;
constexpr size_t OFF_LR = OFF_P + (size_t)TG * PS * 2;
constexpr size_t OFF_GS = OFF_LR + (size_t)TG * 32 * 4;
constexpr size_t OFF_GDEC = OFF_GS + (size_t)2 * NITEM * 8192 * 4;
constexpr size_t OFF_MERGED = OFF_GDEC + (size_t)2 * NITEM * 64 * 4;
constexpr size_t OFF_PRE = OFF_MERGED + (size_t)TG * 1024 * 2;
constexpr size_t OFF_UT = OFF_PRE + (size_t)TG * 1024 * 4;
constexpr size_t OFF_GT = OFF_UT + (size_t)BG * 512 * 8192 * 4;
constexpr size_t OFF_BAR = OFF_GT + (size_t)BG * 512 * 8192 * 2;
constexpr size_t OFF_ZT = OFF_BAR + 16384;
constexpr size_t WS_END = OFF_ZT + (size_t)8192 * 33 * 4;

struct Params {
    const float *x, *mem, *ln_in_g, *ln_in_b, *w_in, *b_in, *na_rpb, *hy_conv_w, *hy_conv_b, *hy_w1, *hy_b1, *hy_wm, *hy_bm, *hy_w3, *hy_skip,
        *gla_up_f, *gla_bias_f, *gla_up_b, *gla_bias_b, *gla_norm_g, *mem_w_kv, *w_br, *w_out, *b_out, *ln_g, *ln_b;
    float* out;
    unsigned char* ws;
};

HD inline float bf2f(bf16_t b) {
    union { unsigned u; float f; } c; c.u = (unsigned)b << 16; return c.f;
}
HD inline bf16_t f2bf(float f) {
    union { unsigned u; float f; } c; c.f = f; unsigned u = c.u; u += 0x7fffu + ((u >> 16) & 1u); return (bf16_t)(u >> 16);
}
typedef float f32x2_t __attribute__((ext_vector_type(2)));
typedef __bf16 bf16x2_t __attribute__((ext_vector_type(2)));
__device__ __forceinline__ unsigned pk2(float lo, float hi) { const f32x2_t v = {lo, hi}; const bf16x2_t b = __builtin_convertvector(v, bf16x2_t); return __builtin_bit_cast(unsigned, b); }
__device__ __forceinline__ bf16_t f2bf_d(float f) { return (bf16_t)(pk2(f, f) & 0xffffu); }
__device__ __forceinline__ float lo16(unsigned u) { return __uint_as_float(u << 16); }
__device__ __forceinline__ float hi16(unsigned u) { return __uint_as_float(u & 0xffff0000u); }
__device__ __forceinline__ float wave_sum(float v) {
#pragma unroll
    for (int o = 32; o >= 1; o >>= 1) v += __shfl_xor(v, o);
    return v;
}
__device__ __forceinline__ float sigmoidf_(float x) { return __builtin_amdgcn_rcpf(1.0f + __expf(-x)); }
__device__ __forceinline__ float siluf_(float x) { return x * __builtin_amdgcn_rcpf(1.0f + __expf(-x)); }
__device__ __forceinline__ float logsigf_(float x) { return fminf(x, 0.0f) - __logf(1.0f + __expf(-fabsf(x))); }
__device__ __forceinline__ bf16x8 mkfrag(u32x4 v) { return __builtin_bit_cast(bf16x8, v); }
__device__ __forceinline__ bf16x8 mkfrag2(u32x2 a, u32x2 b) { u32x4 v = {a.x, a.y, b.x, b.y}; return __builtin_bit_cast(bf16x8, v); }
#define MFMA(a, b, c) __builtin_amdgcn_mfma_f32_16x16x32_bf16((a), (b), (c), 0, 0, 0)
HD inline int iclamp(int v, int lo, int hi) { return v < lo ? lo : (v > hi ? hi : v); }

HD inline float2 cmulf(float2 a, float2 b) { float2 r; r.x = a.x * b.x - a.y * b.y; r.y = a.x * b.y + a.y * b.x; return r; }
HD inline float2 cmulcf(float2 a, float2 b) { float2 r; r.x = a.x * b.x + a.y * b.y; r.y = a.y * b.x - a.x * b.y; return r; }
struct Bfly { float2 x0, x1, x2, x3, W1; int i0; };
HD inline void bfly_load(Bfly& b, const float2* d, const float2* tw, int lgm, int q) {
    const int m = 1 << lgm, blk = q >> lgm, j = q & (m - 1);
    b.i0 = (blk << (lgm + 2)) + j;
    b.W1 = tw[j];
    b.x0 = d[b.i0]; b.x1 = d[b.i0 + m]; b.x2 = d[b.i0 + 2 * m]; b.x3 = d[b.i0 + 3 * m];
}
HD inline void bfly_fwd_store(const Bfly& b, float2* d, int lgm) {
    const int m = 1 << lgm, i0 = b.i0;
    const float2 W1 = b.W1, W2 = cmulf(W1, W1);
    const float2 x0 = b.x0, x1 = b.x1, x2 = b.x2, x3 = b.x3;
    float2 a0, a1, a2, a3, t;
    a0.x = x0.x + x2.x; a0.y = x0.y + x2.y;
    t.x = x0.x - x2.x; t.y = x0.y - x2.y; a2 = cmulf(t, W1);
    a1.x = x1.x + x3.x; a1.y = x1.y + x3.y;
    t.x = x1.x - x3.x; t.y = x1.y - x3.y; t = cmulf(t, W1); a3.x = t.y; a3.y = -t.x;
    float2 r;
    r.x = a0.x + a1.x; r.y = a0.y + a1.y; d[i0] = r;
    t.x = a0.x - a1.x; t.y = a0.y - a1.y; d[i0 + m] = cmulf(t, W2);
    r.x = a2.x + a3.x; r.y = a2.y + a3.y; d[i0 + 2 * m] = r;
    t.x = a2.x - a3.x; t.y = a2.y - a3.y; d[i0 + 3 * m] = cmulf(t, W2);
}
HD inline void bfly_inv_store(const Bfly& b, float2* d, int lgm) {
    const int m = 1 << lgm, i0 = b.i0;
    const float2 W1 = b.W1, W2 = cmulf(W1, W1);
    const float2 x0 = b.x0, x1 = b.x1, x2 = b.x2, x3 = b.x3;
    const float2 b1 = cmulcf(x1, W2), b3 = cmulcf(x3, W2);
    float2 y0, y1, y2, y3;
    y0.x = x0.x + b1.x; y0.y = x0.y + b1.y; y1.x = x0.x - b1.x; y1.y = x0.y - b1.y;
    y2.x = x2.x + b3.x; y2.y = x2.y + b3.y; y3.x = x2.x - b3.x; y3.y = x2.y - b3.y;
    const float2 c2 = cmulcf(y2, W1); float2 c3 = cmulcf(y3, W1); { const float tx = -c3.y, ty = c3.x; c3.x = tx; c3.y = ty; }
    float2 r;
    r.x = y0.x + c2.x; r.y = y0.y + c2.y; d[i0] = r;
    r.x = y0.x - c2.x; r.y = y0.y - c2.y; d[i0 + 2 * m] = r;
    r.x = y1.x + c3.x; r.y = y1.y + c3.y; d[i0 + m] = r;
    r.x = y1.x - c3.x; r.y = y1.y - c3.y; d[i0 + 3 * m] = r;
}
HD inline void fft_fwd_bfly(float2* d, const float2* tw, int lgm, int q) { Bfly b; bfly_load(b, d, tw, lgm, q); bfly_fwd_store(b, d, lgm); }
HD inline void fft_inv_bfly(float2* d, const float2* tw, int lgm, int q) { Bfly b; bfly_load(b, d, tw, lgm, q); bfly_inv_store(b, d, lgm); }
HD inline void r4_fwd(float2& x0, float2& x1, float2& x2, float2& x3, const float2 W1) {
    const float2 W2 = cmulf(W1, W1);
    float2 a0, a1, a2, a3, t;
    a0.x = x0.x + x2.x; a0.y = x0.y + x2.y;
    t.x = x0.x - x2.x; t.y = x0.y - x2.y; a2 = cmulf(t, W1);
    a1.x = x1.x + x3.x; a1.y = x1.y + x3.y;
    t.x = x1.x - x3.x; t.y = x1.y - x3.y; t = cmulf(t, W1); a3.x = t.y; a3.y = -t.x;
    x0.x = a0.x + a1.x; x0.y = a0.y + a1.y;
    t.x = a0.x - a1.x; t.y = a0.y - a1.y; x1 = cmulf(t, W2);
    x2.x = a2.x + a3.x; x2.y = a2.y + a3.y;
    t.x = a2.x - a3.x; t.y = a2.y - a3.y; x3 = cmulf(t, W2);
}
HD inline void r4_inv(float2& x0, float2& x1, float2& x2, float2& x3, const float2 W1) {
    const float2 W2 = cmulf(W1, W1);
    const float2 b1 = cmulcf(x1, W2), b3 = cmulcf(x3, W2);
    float2 y0, y1, y2, y3;
    y0.x = x0.x + b1.x; y0.y = x0.y + b1.y; y1.x = x0.x - b1.x; y1.y = x0.y - b1.y;
    y2.x = x2.x + b3.x; y2.y = x2.y + b3.y; y3.x = x2.x - b3.x; y3.y = x2.y - b3.y;
    const float2 c2 = cmulcf(y2, W1); float2 c3 = cmulcf(y3, W1); { const float tx = -c3.y, ty = c3.x; c3.x = tx; c3.y = ty; }
    x0.x = y0.x + c2.x; x0.y = y0.y + c2.y; x2.x = y0.x - c2.x; x2.y = y0.y - c2.y;
    x1.x = y1.x + c3.x; x1.y = y1.y + c3.y; x3.x = y1.x - c3.x; x3.y = y1.y - c3.y;
}
template <bool INV, bool HALF>
HD inline void r16_bfly(float2* d, const float2* twO, const float2* twI, int lgm, int q) {
    const int m = 1 << lgm, blk = q >> lgm, j = q & (m - 1), base = (blk << (lgm + 4)) + j;
    float2 e[4][4];
#pragma unroll
    for (int a = 0; a < 4; ++a)
#pragma unroll
        for (int b = 0; b < 4; ++b) {
            if (!INV && HALF && a >= 2) { e[a][b].x = 0.f; e[a][b].y = 0.f; }
            else e[a][b] = d[base + ((4 * a + b) << lgm)];
        }
    const float2 wI = twI[j];
    float2 wO[4];
#pragma unroll
    for (int b = 0; b < 4; ++b) wO[b] = twO[j + (b << lgm)];
    if (!INV) {
#pragma unroll
        for (int b = 0; b < 4; ++b) r4_fwd(e[0][b], e[1][b], e[2][b], e[3][b], wO[b]);
#pragma unroll
        for (int a = 0; a < 4; ++a) r4_fwd(e[a][0], e[a][1], e[a][2], e[a][3], wI);
    } else {
#pragma unroll
        for (int a = 0; a < 4; ++a) r4_inv(e[a][0], e[a][1], e[a][2], e[a][3], wI);
#pragma unroll
        for (int b = 0; b < 4; ++b) r4_inv(e[0][b], e[1][b], e[2][b], e[3][b], wO[b]);
    }
#pragma unroll
    for (int a = 0; a < 4; ++a)
#pragma unroll
        for (int b = 0; b < 4; ++b)
            if (!(INV && HALF && a >= 2)) d[base + ((4 * a + b) << lgm)] = e[a][b];
}
HD inline int brev14(int k) {
#if defined(__HIP_DEVICE_COMPILE__)
    return (int)(__brev((unsigned)k) >> 18);
#endif
    unsigned v = (unsigned)k;
    v = ((v >> 1) & 0x55555555u) | ((v & 0x55555555u) << 1);
    v = ((v >> 2) & 0x33333333u) | ((v & 0x33333333u) << 2);
    v = ((v >> 4) & 0x0f0f0f0fu) | ((v & 0x0f0f0f0fu) << 4);
    v = ((v >> 8) & 0x00ff00ffu) | ((v & 0x00ff00ffu) << 8);
    v = (v >> 16) | (v << 16);
    return (int)(v >> 18);
}
struct PwIn { float2 Z1, Z2; float4 A, B; int p1, p2; };
HD inline void pw_load(PwIn& w, const float2* d, const float4* pq, int p1) {
    const int kf = brev14(p1), k2 = (FN - kf) & (FN - 1); w.p1 = p1; w.p2 = brev14(k2);
    w.Z1 = d[w.p1]; w.Z2 = d[w.p2]; w.A = pq[w.p1]; w.B.x = w.A.x; w.B.y = -w.A.y; w.B.z = w.A.z; w.B.w = -w.A.w;
}
HD inline void pw_store(const PwIn& w, float2* d) {
    const float2 Z1 = w.Z1, Z2 = w.Z2;
    float2 P1, Q1, P2, Q2; P1.x = w.A.x; P1.y = w.A.y; Q1.x = w.A.z; Q1.y = w.A.w; P2.x = w.B.x; P2.y = w.B.y; Q2.x = w.B.z; Q2.y = w.B.w;
    float2 c1, c2; c1.x = Z1.x; c1.y = -Z1.y; c2.x = Z2.x; c2.y = -Z2.y;
    const float2 a = cmulf(Z1, P1), b = cmulf(c2, Q1), c = cmulf(Z2, P2), e = cmulf(c1, Q2);
    float2 w1, w2; w1.x = a.x + b.x; w1.y = a.y + b.y; w2.x = c.x + e.x; w2.y = c.y + e.y;
    d[w.p1] = w1;
    if (w.p2 != w.p1) d[w.p2] = w2;
}
HD inline void conv_pointwise(float2* d, const float4* pq, int p1) { PwIn w; pw_load(w, d, pq, p1); pw_store(w, d); }
HD inline void filt_pointwise(const float2* d, float4* pq, int p1) {
    const int kf = brev14(p1), k2 = (FN - kf) & (FN - 1), p2 = brev14(k2);
    const float2 Z1 = d[p1], Z2 = d[p2];
    const float gcx = 0.5f * (Z1.x + Z2.x), gcy = 0.5f * (Z1.y - Z2.y);
    const float gdx = 0.5f * (Z1.y + Z2.y), gdy = -0.5f * (Z1.x - Z2.x);
    const float s = 0.5f / (float)FN;
    float4 A; A.x = s * (gcx + gdx); A.y = s * (gcy + gdy); A.z = s * (gcx - gdx); A.w = s * (gcy - gdy);
    pq[p1] = A;
}
HD inline int tw_off(int lgm) { return lgm == 10 ? 0 : lgm == 8 ? 1024 : lgm == 6 ? 1280 : lgm == 4 ? 1344 : lgm == 2 ? 1360 : 1364; }
#ifndef FFT_HOST_TEST
template <int LGM, bool INV>
__device__ __forceinline__ void fft_pass(float2* d, const float2* twl, const float2* twg, int tid) {
    const float2* tw = (LGM == 12) ? twg : twl + tw_off(LGM);
#pragma unroll
    for (int it = 0; it < 2; ++it) {
        const int q = tid + it * 4 * NTHR;
        Bfly b0, b1, b2, b3;
        bfly_load(b0, d, tw, LGM, q); bfly_load(b1, d, tw, LGM, q + NTHR); bfly_load(b2, d, tw, LGM, q + 2 * NTHR); bfly_load(b3, d, tw, LGM, q + 3 * NTHR);
        if (INV) { bfly_inv_store(b0, d, LGM); bfly_inv_store(b1, d, LGM); bfly_inv_store(b2, d, LGM); bfly_inv_store(b3, d, LGM); }
        else { bfly_fwd_store(b0, d, LGM); bfly_fwd_store(b1, d, LGM); bfly_fwd_store(b2, d, LGM); bfly_fwd_store(b3, d, LGM); }
    }
    __syncthreads();
}
template <int LGM, bool INV, bool HALF>
__device__ __forceinline__ void fft_pass16(float2* d, const float2* twl, const float2* twg, int tid) {
    const float2* twO = (LGM + 2 == 12) ? twg : twl + tw_off(LGM + 2);
    const float2* twI = twl + tw_off(LGM);
    r16_bfly<INV, HALF>(d, twO, twI, LGM, tid);
    r16_bfly<INV, HALF>(d, twO, twI, LGM, tid + NTHR);
    __syncthreads();
}
template <bool HALF>
__device__ __forceinline__ void fft_forward(float2* d, const float2* twl, const float2* twg) {
    int tid = threadIdx.x; asm volatile("" : "+v"(tid));
    fft_pass16<10, false, HALF>(d, twl, twg, tid); fft_pass16<6, false, false>(d, twl, twg, tid);
    fft_pass<4, false>(d, twl, twg, tid); fft_pass<2, false>(d, twl, twg, tid); fft_pass<0, false>(d, twl, twg, tid);
}
template <bool HALF>
__device__ __forceinline__ void fft_inverse(float2* d, const float2* twl, const float2* twg) {
    int tid = threadIdx.x; asm volatile("" : "+v"(tid));
    fft_pass<0, true>(d, twl, twg, tid); fft_pass<2, true>(d, twl, twg, tid); fft_pass<4, true>(d, twl, twg, tid);
    fft_pass16<6, true, false>(d, twl, twg, tid); fft_pass16<10, true, HALF>(d, twl, twg, tid);
}
__device__ __forceinline__ float2* fft_lds_twiddles(const float2* twg, unsigned char* lds) {
    int tid = threadIdx.x; asm volatile("" : "+v"(tid));
    float2* t = (float2*)(lds + 131072);
    for (int k = tid; k < 1365; k += NTHR) {
        const int lgm = k < 1024 ? 10 : k < 1280 ? 8 : k < 1344 ? 6 : k < 1360 ? 4 : k < 1364 ? 2 : 0;
        t[k] = twg[(k - tw_off(lgm)) << (12 - lgm)];
    }
    __syncthreads();
    return t;
}

constexpr int STG = 49152;
__device__ __forceinline__ int swz(int row, int ch) { return row * 128 + ((ch ^ ((row >> 1) & 7)) << 4); }
__device__ __forceinline__ void gemm_core(f32x4 (&acc)[4][4], const bf16_t* A, int lda, const bf16_t* Bt, int ldb, int K, unsigned char* lds) {
    int tid_ = threadIdx.x; asm volatile("" : "+v"(tid_)); const int tid = tid_, lane = tid & 63, w = tid >> 6, wm = w & 3, wn = w >> 2, l15 = lane & 15, q4 = lane >> 4;
    const int wu = __builtin_amdgcn_readfirstlane(w);
    __attribute__((address_space(3))) unsigned char* l3 = (__attribute__((address_space(3))) unsigned char*)lds;
#pragma unroll
    for (int mi = 0; mi < 4; ++mi)
#pragma unroll
        for (int ni = 0; ni < 4; ++ni) acc[mi][ni] = (f32x4){0.f, 0.f, 0.f, 0.f};
    const int r8 = lane >> 3, sch = (lane & 7) ^ ((((w & 1) << 2) + (r8 >> 1)) & 7);
    const bf16_t* ap = A + (size_t)(w * 8 + r8) * lda + sch * 8;
    const bf16_t* bp = Bt + (size_t)(w * 8 + r8) * ldb + sch * 8;
#define GC_STAGE(buf, k0)                                                                                                                         \
    {                                                                                                                                             \
        _Pragma("unroll") for (int i = 0; i < 4; ++i)                                                                                             \
            __builtin_amdgcn_global_load_lds((const unsigned*)(ap + (size_t)(64 * i) * lda + (k0)), (__attribute__((address_space(3))) unsigned*)(l3 + (buf) * STG + (wu + 8 * i) * 1024), 16, 0, 0);          \
        _Pragma("unroll") for (int i = 0; i < 2; ++i)                                                                                             \
            __builtin_amdgcn_global_load_lds((const unsigned*)(bp + (size_t)(64 * i) * ldb + (k0)), (__attribute__((address_space(3))) unsigned*)(l3 + (buf) * STG + 32768 + (wu + 8 * i) * 1024), 16, 0, 0);  \
    }
    GC_STAGE(0, 0)
    asm volatile("s_waitcnt vmcnt(0)" ::: "memory");
    __syncthreads();
    const int nk = K >> 6;
    for (int kt = 0; kt < nk; ++kt) {
        if (kt + 1 < nk) GC_STAGE((kt + 1) & 1, (kt + 1) << 6)
        const unsigned char* sa = lds + (kt & 1) * STG;
        const unsigned char* sb = sa + 32768;
#pragma unroll
        for (int ks = 0; ks < 2; ++ks) {
            bf16x8 af[4], bfr[4];
#pragma unroll
            for (int mi = 0; mi < 4; ++mi) af[mi] = *(const bf16x8*)(sa + swz(wm * 64 + mi * 16 + l15, ks * 4 + q4));
#pragma unroll
            for (int ni = 0; ni < 4; ++ni) bfr[ni] = *(const bf16x8*)(sb + swz(wn * 64 + ni * 16 + l15, ks * 4 + q4));
#pragma unroll
            for (int mi = 0; mi < 4; ++mi)
#pragma unroll
                for (int ni = 0; ni < 4; ++ni) acc[mi][ni] = MFMA(bfr[ni], af[mi], acc[mi][ni]);
        }
        asm volatile("s_waitcnt vmcnt(0)" ::: "memory");
        __syncthreads();
    }
#undef GC_STAGE
}
#define EPI_LOOP(body)                                                                                                  \
    {                                                                                                                   \
        int e_t = threadIdx.x; asm volatile("" : "+v"(e_t)); const int e_lane = e_t & 63, e_w = e_t >> 6;                                                    \
        _Pragma("unroll") for (int mi = 0; mi < 4; ++mi) _Pragma("unroll") for (int ni = 0; ni < 4; ++ni) {             \
            const int row = m0 + (e_w & 3) * 64 + mi * 16 + (e_lane & 15);                                              \
            const int col = n0 + (e_w >> 2) * 64 + ni * 16 + 4 * (e_lane >> 4);                                         \
            f32x4& v = acc[mi][ni];                                                                                     \
            body                                                                                                        \
        }                                                                                                               \
    }
__device__ __forceinline__ void st_bf4(bf16_t* dst, f32x4 v) {
    u32x2 o; o.x = pk2(v[0], v[1]); o.y = pk2(v[2], v[3]); *(u32x2*)dst = o;
}
__device__ __forceinline__ f32x4 ld_bf4(const bf16_t* src) {
    const u32x2 u = *(const u32x2*)src; f32x4 r = {lo16(u.x), hi16(u.x), lo16(u.y), hi16(u.y)}; return r;
}


__device__ __forceinline__ void merge_tile(const bf16_t* P, const bf16_t* WtBr, bf16_t* merged, int m0, int n0, unsigned char* lds) {
    int tid_ = threadIdx.x; asm volatile("" : "+v"(tid_)); const int tid = tid_, lane = tid & 63, w = tid >> 6, wm = w & 3, wn = w >> 2, l15 = lane & 15, q4 = lane >> 4;
    const int wu = __builtin_amdgcn_readfirstlane(w);
    __attribute__((address_space(3))) unsigned char* l3 = (__attribute__((address_space(3))) unsigned char*)lds;
    f32x4 acc[4][4], macc[4][4];
#pragma unroll
    for (int mi = 0; mi < 4; ++mi)
#pragma unroll
        for (int ni = 0; ni < 4; ++ni) { acc[mi][ni] = (f32x4){0.f, 0.f, 0.f, 0.f}; macc[mi][ni] = (f32x4){0.f, 0.f, 0.f, 0.f}; }
    const int r8 = lane >> 3, sch = (lane & 7) ^ ((((w & 1) << 2) + (r8 >> 1)) & 7);
    const bf16_t* ap = P + (size_t)(m0 + w * 8 + r8) * PS + sch * 8;
    const bf16_t* bp = WtBr + (size_t)(n0 + w * 8 + r8) * 512 + sch * 8;
    const bf16_t* sgp = P + (size_t)(m0 + wm * 64 + l15) * PS + C_SG + n0 + wn * 64 + 4 * q4;
#define MG_STAGE(buf, kt_)                                                                                                                        \
    {                                                                                                                                             \
        const int j_ = (kt_) >> 3, k0_ = ((kt_) & 7) << 6;                                                                                        \
        const int acol_ = (j_ == 0) ? C_NAQ : (j_ == 1) ? C_HY : (j_ == 2) ? C_GV : C_MQ;                                                        \
        _Pragma("unroll") for (int i = 0; i < 4; ++i)                                                                                             \
            __builtin_amdgcn_global_load_lds((const unsigned*)(ap + (size_t)(64 * i) * PS + acol_ + k0_), (__attribute__((address_space(3))) unsigned*)(l3 + (buf) * STG + (wu + 8 * i) * 1024), 16, 0, 0);      \
        _Pragma("unroll") for (int i = 0; i < 2; ++i)                                                                                             \
            __builtin_amdgcn_global_load_lds((const unsigned*)(bp + (size_t)j_ * 1024 * 512 + (size_t)(64 * i) * 512 + k0_), (__attribute__((address_space(3))) unsigned*)(l3 + (buf) * STG + 32768 + (wu + 8 * i) * 1024), 16, 0, 0);  \
    }
    MG_STAGE(0, 0)
    MG_STAGE(1, 1)
    asm volatile("s_waitcnt vmcnt(6)" ::: "memory");
    __builtin_amdgcn_s_barrier(); asm volatile("" ::: "memory");
    int cb = 0;
#pragma unroll 1
    for (int kt = 0; kt < 32; ++kt) {
        const bool last = (kt & 7) == 7;
        u32x2 sg[4][4];
        if (last) {
            const bf16_t* sp = sgp + 1024 * (kt >> 3);
#pragma unroll
            for (int mi = 0; mi < 4; ++mi)
#pragma unroll
                for (int ni = 0; ni < 4; ++ni) sg[mi][ni] = *(const u32x2*)(sp + (size_t)(mi * 16) * PS + ni * 16);
        }
        const int nb = (cb == 0) ? 2 : cb - 1;
        if (kt + 2 < 32) MG_STAGE(nb, kt + 2)
        const unsigned char* sa = lds + cb * STG;
        const unsigned char* sb = sa + 32768;
#pragma unroll
        for (int ks = 0; ks < 2; ++ks) {
            bf16x8 af[4], bfr[4];
#pragma unroll
            for (int mi = 0; mi < 4; ++mi) af[mi] = *(const bf16x8*)(sa + swz(wm * 64 + mi * 16 + l15, ks * 4 + q4));
#pragma unroll
            for (int ni = 0; ni < 4; ++ni) bfr[ni] = *(const bf16x8*)(sb + swz(wn * 64 + ni * 16 + l15, ks * 4 + q4));
#pragma unroll
            for (int mi = 0; mi < 4; ++mi)
#pragma unroll
                for (int ni = 0; ni < 4; ++ni) acc[mi][ni] = MFMA(bfr[ni], af[mi], acc[mi][ni]);
        }
        if (kt + 2 < 32) asm volatile("s_waitcnt vmcnt(6)" ::: "memory"); else asm volatile("s_waitcnt vmcnt(0)" ::: "memory");
        if (last) {
#pragma unroll
            for (int mi = 0; mi < 4; ++mi)
#pragma unroll
                for (int ni = 0; ni < 4; ++ni) {
                    const u32x2 u = sg[mi][ni]; const f32x4 g4 = {lo16(u.x), hi16(u.x), lo16(u.y), hi16(u.y)};
                    macc[mi][ni] += g4 * acc[mi][ni]; acc[mi][ni] = (f32x4){0.f, 0.f, 0.f, 0.f};
                }
        }
        asm volatile("" ::: "memory"); __builtin_amdgcn_s_barrier(); asm volatile("" ::: "memory");
        cb = (cb == 2) ? 0 : cb + 1;
    }
#undef MG_STAGE
    __syncthreads();
#pragma unroll
    for (int mi = 0; mi < 4; ++mi)
#pragma unroll
        for (int ni = 0; ni < 4; ++ni) st_bf4(merged + (size_t)(m0 + wm * 64 + mi * 16 + l15) * 1024 + n0 + wn * 64 + ni * 16 + 4 * q4, macc[mi][ni]);
}

__device__ __forceinline__ int orig_col(int n) {
    if (n < 4096) return n;
    if (n < 4608) return n + 32;
    if (n < 6656) return n + 32;
    if (n < 10752) return n + 32;
    return n - 10752 + 4096;
}

__device__ __forceinline__ void ln_rows(const float* src, size_t src_row0, int nrows, const float* g, const float* b, float* dst32, bf16_t* dst16, size_t dst_row0, float2* stats) {
    int tid_ = threadIdx.x; asm volatile("" : "+v"(tid_));
    const int lane = tid_ & 63;
    const int gw = blockIdx.x * (NTHR / 64) + (tid_ >> 6), nw = gridDim.x * (NTHR / 64);
    for (int r = gw; r < nrows; r += nw) {
        const float4* xr = (const float4*)(src + (src_row0 + r) * 1024);
        float4 v[4]; float s = 0.f;
#pragma unroll
        for (int i = 0; i < 4; ++i) { v[i] = xr[lane + 64 * i]; s += (v[i].x + v[i].y) + (v[i].z + v[i].w); }
        s = wave_sum(s);
        const float mean = s * (1.0f / 1024.0f);
        float q = 0.f;
#pragma unroll
        for (int i = 0; i < 4; ++i) { const float a = v[i].x - mean, bb = v[i].y - mean, c = v[i].z - mean, d = v[i].w - mean; q += (a * a + bb * bb) + (c * c + d * d); }
        q = wave_sum(q);
        const float rstd = 1.0f / sqrtf(q * (1.0f / 1024.0f) + 1e-5f);
        if (stats && lane == 0) { float2 st; st.x = mean; st.y = rstd; stats[dst_row0 + r] = st; }
#pragma unroll
        for (int i = 0; i < 4; ++i) {
            const float4 g4 = ((const float4*)g)[lane + 64 * i], b4 = ((const float4*)b)[lane + 64 * i];
            float4 y; y.x = (v[i].x - mean) * rstd * g4.x + b4.x; y.y = (v[i].y - mean) * rstd * g4.y + b4.y; y.z = (v[i].z - mean) * rstd * g4.z + b4.z; y.w = (v[i].w - mean) * rstd * g4.w + b4.w;
            if (dst32) ((float4*)(dst32 + (dst_row0 + r) * 1024))[lane + 64 * i] = y;
            if (dst16) { u32x2 o; o.x = pk2(y.x, y.y); o.y = pk2(y.z, y.w); *(u32x2*)(dst16 + (dst_row0 + r) * 1024 + (lane + 64 * i) * 4) = o; }
        }
    }
}
__device__ __forceinline__ void phase0(const Params& p) {
    ln_rows(p.x, 0, NTOK, p.ln_in_g, p.ln_in_b, nullptr, (bf16_t*)(p.ws + OFF_HB), 0, (float2*)(p.ws + OFF_STATS));
    int tid_ = threadIdx.x; asm volatile("" : "+v"(tid_)); const int gt = blockIdx.x * NTHR + tid_, nt = gridDim.x * NTHR;
    float2* tw = (float2*)(p.ws + OFF_TW);
    for (int k = gt; k < FN; k += nt) { double s, c; sincospi(-2.0 * (double)k / (double)FN, &s, &c); float2 t; t.x = (float)c; t.y = (float)s; tw[k] = t; }
    bf16_t* mb = (bf16_t*)(p.ws + OFF_MEMBF);
    for (int i = gt; i < 2048 * 1024 / 4; i += nt) { const float4 v = ((const float4*)p.mem)[i]; u32x2 o; o.x = pk2(v.x, v.y); o.y = pk2(v.z, v.w); ((u32x2*)mb)[i] = o; }
    float* en = (float*)(p.ws + OFF_ENERGY);
    for (int i = gt; i < 1024; i += nt) en[i] = 0.f;
    float* ztab = (float*)(p.ws + OFF_ZT);
    for (int idx = gt; idx < 8192 * 33; idx += nt) {
        const int n = idx / 33, e = idx - n * 33;
        float v;
        if (e == 0) v = (float)n / 8191.0f;
        else {
            const int i = (e - 1) & 15;
            const double fr = 1e-4 + (double)i * ((15.0 - 1e-4) / 15.0);
            const double ang = (2.0 * 3.14159265358979323846 / 8192.0) * (double)n * fr;
            v = (e <= 16) ? (float)cos(ang) : (float)(-sin(ang));
        }
        ztab[idx] = v;
    }
}

__device__ __forceinline__ void wt_tile(const float* src, int src_ld, int k0, int on0, bf16_t* dst, int dst_ld, int dn0, bool zero, float* tile) {
    int tid_ = threadIdx.x; asm volatile("" : "+v"(tid_)); const int tid = tid_;
    if (!zero) {
#pragma unroll
        for (int i = 0; i < 2; ++i) {
            const int k = (tid >> 3) + 64 * i, c4 = (tid & 7) * 4;
            const float4 v = *(const float4*)(src + (size_t)(k0 + k) * src_ld + on0 + c4);
            float* t = tile + k * 33 + c4; t[0] = v.x; t[1] = v.y; t[2] = v.z; t[3] = v.w;
        }
    }
    __syncthreads();
    const int n = tid >> 4, kc = (tid & 15) * 8;
    float f[8];
#pragma unroll
    for (int e = 0; e < 8; ++e) f[e] = zero ? 0.f : tile[(kc + e) * 33 + n];
    u32x4 o; o.x = pk2(f[0], f[1]); o.y = pk2(f[2], f[3]); o.z = pk2(f[4], f[5]); o.w = pk2(f[6], f[7]);
    *(u32x4*)(dst + (size_t)(dn0 + n) * dst_ld + k0 + kc) = o;
    __syncthreads();
}
__device__ __forceinline__ void phase_weights(const Params& p, int l, unsigned char* lds) {
    float* tile = (float*)lds;
    for (int it = blockIdx.x; it < 3776; it += gridDim.x) {
        if (it < 2752) {
            const int nt = it >> 3, kt = it & 7, dn0 = nt * 32;
            wt_tile(p.w_in + (size_t)l * 1024 * NIN, NIN, kt * 128, orig_col(dn0), (bf16_t*)(p.ws + OFF_WTIN), 1024, dn0, dn0 >= NIN, tile);
        } else if (it < 3264) {
            const int r = it - 2752, j = r >> 7, nt = (r >> 2) & 31, kt = r & 3;
            wt_tile(p.w_br + (size_t)(l * 4 + j) * 512 * 1024, 1024, kt * 128, nt * 32, (bf16_t*)(p.ws + OFF_WTBR) + (size_t)j * 1024 * 512, 512, nt * 32, false, tile);
        } else if (it < 3520) {
            const int r = it - 3264, nt = r >> 3, kt = r & 7;
            wt_tile(p.w_out + (size_t)l * 1024 * 1024, 1024, kt * 128, nt * 32, (bf16_t*)(p.ws + OFF_WTOUT), 1024, nt * 32, false, tile);
        } else {
            const int r = it - 3520, nt = r >> 3, kt = r & 7;
            wt_tile(p.mem_w_kv + (size_t)l * 1024 * 1024, 1024, kt * 128, nt * 32, (bf16_t*)(p.ws + OFF_WTKV), 1024, nt * 32, false, tile);
        }
    }
}

__device__ __forceinline__ void phase_filter_gen(const Params& p, int l, unsigned char* lds) {
    float* zt = (float*)lds;
    float* ha = zt + 32 * 33;
    float* hbuf = ha + 32 * 64;
    int tid_ = threadIdx.x; asm volatile("" : "+v"(tid_)); const int tid = tid_;
    const float* w1 = p.hy_w1 + (size_t)l * 33 * 64; const float* b1 = p.hy_b1 + l * 64;
    const float* wm = p.hy_wm + (size_t)l * 2 * 64 * 64; const float* bm = p.hy_bm + l * 2 * 64;
    const float* w3 = p.hy_w3 + (size_t)l * 64 * 1024;
    float* hf = (float*)(p.ws + OFF_HFILT);
    float* en = (float*)(p.ws + OFF_ENERGY) + l * 512;
    const float* ztab = (const float*)(p.ws + OFF_ZT);
    for (int it = blockIdx.x; it < 256; it += gridDim.x) {
        const int n0 = it * 32;
        for (int idx = tid; idx < 32 * 33; idx += NTHR) zt[idx] = ztab[(size_t)n0 * 33 + idx];
        __syncthreads();
        for (int idx = tid; idx < 2048; idx += NTHR) {
            const int pos = idx >> 6, j = idx & 63; float s = b1[j];
            for (int e = 0; e < 33; ++e) s += zt[pos * 33 + e] * w1[e * 64 + j];
            ha[idx] = sinf(s);
        }
        __syncthreads();
        for (int idx = tid; idx < 2048; idx += NTHR) {
            const int pos = idx >> 6, j = idx & 63; float s = bm[j];
            for (int e = 0; e < 64; ++e) s += ha[pos * 64 + e] * wm[e * 64 + j];
            hbuf[idx] = sinf(s);
        }
        __syncthreads();
        for (int idx = tid; idx < 2048; idx += NTHR) {
            const int pos = idx >> 6, j = idx & 63; float s = bm[64 + j];
            for (int e = 0; e < 64; ++e) s += hbuf[pos * 64 + e] * wm[4096 + e * 64 + j];
            ha[idx] = sinf(s);
        }
        __syncthreads();
        {
            const int c = tid;
            float af[32], ab[32];
#pragma unroll
            for (int i = 0; i < 32; ++i) { af[i] = 0.f; ab[i] = 0.f; }
            for (int k = 0; k < 64; ++k) {
                const float wf = w3[k * 1024 + c], wb = w3[k * 1024 + 512 + c];
#pragma unroll
                for (int i = 0; i < 32; ++i) { const float h = ha[i * 64 + k]; af[i] += h * wf; ab[i] += h * wb; }
            }
            const float dmin = -3.0701134573253945f, dmax = -15.350567286626973f;
            const float delta = fabsf(dmin + (float)c * ((dmax - dmin) / 511.0f));
            float e = 0.f;
#pragma unroll
            for (int i = 0; i < 32; ++i) {
                const int n = n0 + i; const float t01 = (float)n / 8191.0f; const float win = expf(-t01 * delta);
                af[i] *= win; ab[i] *= win; e += af[i] * af[i]; if (n >= 1) e += ab[i] * ab[i];
            }
#pragma unroll
            for (int i = 0; i < 8; ++i) {
                float4 a; a.x = af[4 * i]; a.y = af[4 * i + 1]; a.z = af[4 * i + 2]; a.w = af[4 * i + 3];
                float4 b; b.x = ab[4 * i]; b.y = ab[4 * i + 1]; b.z = ab[4 * i + 2]; b.w = ab[4 * i + 3];
                *(float4*)(hf + (size_t)c * 8192 + n0 + 4 * i) = a;
                *(float4*)(hf + (size_t)(512 + c) * 8192 + n0 + 4 * i) = b;
            }
            atomicAdd(en + c, e);
        }
        __syncthreads();
    }
}

__device__ __forceinline__ void phase_filter_fft(const Params& p, int l, unsigned char* lds) {
    float2* d = (float2*)lds;
    const float2* tw = fft_lds_twiddles((const float2*)(p.ws + OFF_TW), lds);
    const float* hf = (const float*)(p.ws + OFF_HFILT);
    const float* en = (const float*)(p.ws + OFF_ENERGY) + l * 512;
    float4* pqa = (float4*)(p.ws + OFF_PQ);
    int tid_ = threadIdx.x; asm volatile("" : "+v"(tid_)); const int tid = tid_;
    for (int pr = blockIdx.x; pr < 256; pr += gridDim.x) {
        const int c0 = 2 * pr, c1 = c0 + 1;
        const float s0 = 1.0f / sqrtf(en[c0] + 1e-6f), s1 = 1.0f / sqrtf(en[c1] + 1e-6f);
        const float k0 = p.hy_skip[l * 512 + c0], k1 = p.hy_skip[l * 512 + c1];
        for (int n = tid; n < FN; n += NTHR) {
            float2 v;
            if (n < 8192) { v.x = hf[(size_t)c0 * 8192 + n] * s0; v.y = hf[(size_t)c1 * 8192 + n] * s1; if (n == 0) { v.x += k0; v.y += k1; } }
            else if (n == 8192) { v.x = 0.f; v.y = 0.f; }
            else { v.x = hf[(size_t)(512 + c0) * 8192 + (FN - n)] * s0; v.y = hf[(size_t)(512 + c1) * 8192 + (FN - n)] * s1; }
            d[n] = v;
        }
        __syncthreads();
        fft_forward<false>(d, tw, (const float2*)(p.ws + OFF_TW));
        for (int h = tid; h < FN / 2; h += NTHR) filt_pointwise(d, pqa + (size_t)pr * FN, 2 * h);
        if (tid == 0) filt_pointwise(d, pqa + (size_t)pr * FN, 1);
        __syncthreads();
    }
}

__device__ __forceinline__ void hy_pre_item(const Params& p, int l, const bf16_t* P, float* UT, bf16_t* GT, int bl, int tt, int ct, unsigned char* lds) {
    float* tU = (float*)lds;
    float* tG = tU + 64 * 65;
    int tid_ = threadIdx.x; asm volatile("" : "+v"(tid_)); const int tid = tid_;
    const int t = tid >> 3, cc = (tid & 7) * 8, c = ct * 64 + cc, tb = tt * 64 + t;
    const float* cw = p.hy_conv_w + (size_t)l * 3 * 1536; const float* cb = p.hy_conv_b + l * 1536;
    float av[8], a0[8], a1[8];
#pragma unroll
    for (int h = 0; h < 2; ++h) {
        const f32x4 bv = *(const f32x4*)(cb + c + 4 * h), b0 = *(const f32x4*)(cb + 512 + c + 4 * h), b1 = *(const f32x4*)(cb + 1024 + c + 4 * h);
#pragma unroll
        for (int e = 0; e < 4; ++e) { av[4 * h + e] = bv[e]; a0[4 * h + e] = b0[e]; a1[4 * h + e] = b1[e]; }
    }
#pragma unroll
    for (int j = 0; j < 3; ++j) {
        const int ts = tb + j - 1;
        if (ts >= 0 && ts < SEQ) {
            const bf16_t* row = P + (size_t)(bl * SEQ + ts) * PS + C_HY + c;
            const u32x4 rv = *(const u32x4*)row, r0 = *(const u32x4*)(row + 512), r1 = *(const u32x4*)(row + 1024);
#pragma unroll
            for (int h = 0; h < 2; ++h) {
                const f32x4 wv = *(const f32x4*)(cw + j * 1536 + c + 4 * h), w0 = *(const f32x4*)(cw + j * 1536 + 512 + c + 4 * h), w1 = *(const f32x4*)(cw + j * 1536 + 1024 + c + 4 * h);
#pragma unroll
                for (int e = 0; e < 4; ++e) {
                    const int k = 4 * h + e; const unsigned uv = rv[k >> 1], u0 = r0[k >> 1], u1 = r1[k >> 1];
                    av[k] += wv[e] * ((k & 1) ? hi16(uv) : lo16(uv)); a0[k] += w0[e] * ((k & 1) ? hi16(u0) : lo16(u0)); a1[k] += w1[e] * ((k & 1) ? hi16(u1) : lo16(u1));
                }
            }
        }
    }
    const u32x4 rz = *(const u32x4*)(P + (size_t)(bl * SEQ + tb) * PS + C_Z + 512 + c);
#pragma unroll
    for (int k = 0; k < 8; ++k) {
        const unsigned uz = rz[k >> 1]; const float z = (k & 1) ? hi16(uz) : lo16(uz);
        tU[(cc + k) * 65 + t] = av[k] * a1[k]; tG[(cc + k) * 65 + t] = a0[k] * z;
    }
    __syncthreads();
    const int c2 = tid >> 3, t8 = (tid & 7) * 8;
    const size_t o = (size_t)(bl * 512 + ct * 64 + c2) * SEQ + tt * 64 + t8;
    const float* su = tU + c2 * 65 + t8; const float* sg = tG + c2 * 65 + t8;
    f32x4 ua = {su[0], su[1], su[2], su[3]}, ub = {su[4], su[5], su[6], su[7]};
    *(f32x4*)(UT + o) = ua; *(f32x4*)(UT + o + 4) = ub;
    u32x4 g; g.x = pk2(sg[0], sg[1]); g.y = pk2(sg[2], sg[3]); g.z = pk2(sg[4], sg[5]); g.w = pk2(sg[6], sg[7]);
    *(u32x4*)(GT + o) = g;
    __syncthreads();
}
__device__ __forceinline__ void hy_post_item(bf16_t* P, const bf16_t* GT, int bl, int tt, int ct, unsigned char* lds, int dry = 0) {
    bf16_t* tl = (bf16_t*)lds;
    int tid_ = threadIdx.x; asm volatile("" : "+v"(tid_)); const int tid = tid_;
    const int c2 = tid >> 3, t8 = (tid & 7) * 8;
    const u32x4 v = *(const u32x4*)(GT + (size_t)(bl * 512 + ct * 64 + c2) * SEQ + tt * 64 + t8);
    bf16_t* d0 = tl + t8 * 72 + c2;
    d0[0 * 72] = (bf16_t)(v.x & 0xffffu); d0[1 * 72] = (bf16_t)(v.x >> 16); d0[2 * 72] = (bf16_t)(v.y & 0xffffu); d0[3 * 72] = (bf16_t)(v.y >> 16);
    d0[4 * 72] = (bf16_t)(v.z & 0xffffu); d0[5 * 72] = (bf16_t)(v.z >> 16); d0[6 * 72] = (bf16_t)(v.w & 0xffffu); d0[7 * 72] = (bf16_t)(v.w >> 16);
    __syncthreads();
    const int t = tid >> 3, cc = (tid & 7) * 8;
    const u32x4 ov = *(const u32x4*)(tl + t * 72 + cc);
    if (!dry) *(u32x4*)(P + (size_t)(bl * SEQ + tt * 64 + t) * PS + C_HY + ct * 64 + cc) = ov;
    __syncthreads();
}
__device__ __forceinline__ void hyena_conv_item(const Params& p, const float* UT, bf16_t* GT, int bl, int pr, unsigned char* lds, const float2* tw, int dry = 0) {
    float2* d = (float2*)lds;
    const float4* pq = (const float4*)(p.ws + OFF_PQ) + (size_t)pr * FN;
    int tid_ = threadIdx.x; asm volatile("" : "+v"(tid_)); const int tid = tid_;
    const float* u0 = UT + (size_t)(bl * 512 + 2 * pr) * SEQ; const float* u1 = u0 + SEQ;
    bf16_t* g0 = GT + (size_t)(bl * 512 + 2 * pr) * SEQ; bf16_t* g1 = g0 + SEQ;
    {
        float f0[16], f1[16];
#pragma unroll
        for (int i = 0; i < 16; ++i) { f0[i] = u0[tid + NTHR * i]; f1[i] = u1[tid + NTHR * i]; }
#pragma unroll
        for (int i = 0; i < 16; ++i) {
            float2 u; u.x = f0[i]; u.y = f1[i]; d[tid + NTHR * i] = u;
        }
    }
    __syncthreads();
    fft_forward<true>(d, tw, (const float2*)(p.ws + OFF_TW));
#pragma unroll 1
    for (int h = tid; h < FN / 2; h += 4 * NTHR) {
        PwIn w0, w1, w2, w3;
        pw_load(w0, d, pq, 2 * h); pw_load(w1, d, pq, 2 * (h + NTHR)); pw_load(w2, d, pq, 2 * (h + 2 * NTHR)); pw_load(w3, d, pq, 2 * (h + 3 * NTHR));
        pw_store(w0, d); pw_store(w1, d); pw_store(w2, d); pw_store(w3, d);
    }
    if (tid == 0) conv_pointwise(d, pq, 1);
    __syncthreads();
    fft_inverse<true>(d, tw, (const float2*)(p.ws + OFF_TW));
    {
        bf16_t a0[16], a1[16];
#pragma unroll
        for (int i = 0; i < 16; ++i) { a0[i] = g0[tid + NTHR * i]; a1[i] = g1[tid + NTHR * i]; }
#pragma unroll
        for (int i = 0; i < 16; ++i) {
            const int t = tid + NTHR * i;
            const float2 y = d[t];
            const bf16_t r0 = f2bf_d(y.x * bf2f(a0[i])), r1 = f2bf_d(y.y * bf2f(a1[i]));
            if (!dry) { g0[t] = r0; g1[t] = r1; }
        }
    }
    __syncthreads();
}

__device__ __forceinline__ void na_item(const Params& p, int l, bf16_t* P, int bl, int rp, int head, unsigned char* lds, int dry = 0) {
    bf16_t* Kimg = (bf16_t*)lds;
    bf16_t* VT = (bf16_t*)(lds + 82944);
    int tid_ = threadIdx.x; asm volatile("" : "+v"(tid_)); const int tid = tid_, lane = tid & 63, w = tid >> 6, l15 = lane & 15, q4 = lane >> 4;
    const int r0 = 2 * rp, rs0 = iclamp(r0 - 4, 0, 120);
#pragma unroll
    for (int i = 0; i < 9; ++i) {
        const int idx = tid + NTHR * i, key = idx >> 3, ch = idx & 7, grow = min(rs0 + (key >> 6), 127);
        const u32x4 kv = *(const u32x4*)(P + (size_t)(bl * SEQ + grow * 64 + (key & 63)) * PS + C_NAK + head * 64 + ch * 8);
        *(u32x4*)(Kimg + key * 72 + ch * 8) = kv;
    }
#pragma unroll
    for (int i = 0; i < 9; ++i) {
        const int idx = tid + NTHR * i, keyp = idx >> 2, chh = keyp >= 576 ? 1 : 0, key = keyp - chh * 576, ch = chh * 4 + (idx & 3), grow = min(rs0 + (key >> 6), 127);
        const u32x4 vv = *(const u32x4*)(P + (size_t)(bl * SEQ + grow * 64 + (key & 63)) * PS + C_NAV + head * 64 + ch * 8);
        bf16_t* vd = VT + (ch * 8) * 584 + key;
        vd[0 * 584] = (bf16_t)(vv.x & 0xffffu); vd[1 * 584] = (bf16_t)(vv.x >> 16);
        vd[2 * 584] = (bf16_t)(vv.y & 0xffffu); vd[3 * 584] = (bf16_t)(vv.y >> 16);
        vd[4 * 584] = (bf16_t)(vv.z & 0xffffu); vd[5 * 584] = (bf16_t)(vv.z >> 16);
        vd[6 * 584] = (bf16_t)(vv.w & 0xffffu); vd[7 * 584] = (bf16_t)(vv.w >> 16);
    }
    __syncthreads();
    const int rr = w >> 2, g = w & 3, r = r0 + rr, rs = iclamp(r - 4, 0, 120), lo = rs - rs0;
    const int cb = iclamp(16 * g - 8, 0, 32), c = 16 * g + l15, cs = iclamp(c - 8, 0, 48);
    bf16_t* qrow = P + (size_t)(bl * SEQ + r * 64 + c) * PS + head * 64;
    bf16x8 qf[2];
#pragma unroll
    for (int ks = 0; ks < 2; ++ks) qf[ks] = *(const bf16x8*)(qrow + ks * 32 + q4 * 8);
    f32x4 sc[16];
#pragma unroll
    for (int t = 0; t < 16; ++t) {
        const int kb = (lo + (t >> 1)) * 64 + cb + 16 * (t & 1);
        f32x4 a = {0.f, 0.f, 0.f, 0.f};
#pragma unroll
        for (int ks = 0; ks < 2; ++ks) { const bf16x8 kf = *(const bf16x8*)(Kimg + (kb + l15) * 72 + ks * 32 + q4 * 8); a = MFMA(kf, qf[ks], a); }
        sc[t] = a;
    }
    const float* rpb = p.na_rpb + (size_t)(l * 8 + head) * 15 * 31;
    float mx = -1e30f;
#pragma unroll
    for (int t = 0; t < 16; ++t) {
        const int drow = rs + (t >> 1) - r + 7;
#pragma unroll
        for (int e = 0; e < 4; ++e) {
            const int col = cb + 16 * (t & 1) + 4 * q4 + e;
            const bool ok = (col >= cs) && (col < cs + 16);
            const int dcol = ok ? (col - c + 15) : 0;
            const float v = ok ? (sc[t][e] + rpb[drow * 31 + dcol]) : -1e30f;
            sc[t][e] = v; mx = fmaxf(mx, v);
        }
    }
    mx = fmaxf(mx, __shfl_xor(mx, 16)); mx = fmaxf(mx, __shfl_xor(mx, 32));
    float sum = 0.f;
#pragma unroll
    for (int t = 0; t < 16; ++t)
#pragma unroll
        for (int e = 0; e < 4; ++e) { const float pe = __expf(sc[t][e] - mx); sc[t][e] = pe; sum += pe; }
    sum += __shfl_xor(sum, 16); sum += __shfl_xor(sum, 32);
    f32x4 o[4];
#pragma unroll
    for (int dt = 0; dt < 4; ++dt) o[dt] = (f32x4){0.f, 0.f, 0.f, 0.f};
#pragma unroll
    for (int kk = 0; kk < 8; ++kk) {
        u32x4 pu; pu.x = pk2(sc[2 * kk][0], sc[2 * kk][1]); pu.y = pk2(sc[2 * kk][2], sc[2 * kk][3]); pu.z = pk2(sc[2 * kk + 1][0], sc[2 * kk + 1][1]); pu.w = pk2(sc[2 * kk + 1][2], sc[2 * kk + 1][3]);
        const bf16x8 pf = mkfrag(pu);
        const int kbA = (lo + kk) * 64 + cb + 4 * q4;
#pragma unroll
        for (int dt = 0; dt < 4; ++dt) {
            const bf16_t* vr = VT + (dt * 16 + l15) * 584 + kbA;
            const bf16x8 vf = mkfrag2(*(const u32x2*)vr, *(const u32x2*)(vr + 16));
            o[dt] = MFMA(vf, pf, o[dt]);
        }
    }
    const float inv = 1.0f / sum;
    const bf16_t* zrow = P + (size_t)(bl * SEQ + r * 64 + c) * PS + C_Z + head * 64;
#pragma unroll
    for (int dt = 0; dt < 4; ++dt) {
        const int dd = dt * 16 + 4 * q4;
        const f32x4 z = ld_bf4(zrow + dd);
        if (!dry) st_bf4(qrow + dd, o[dt] * inv * z);
    }
    __syncthreads();
}

__device__ __forceinline__ void memattn_load(const Params& p, int b, int h, unsigned char* lds) {
    bf16_t* Kimg = (bf16_t*)lds;
    bf16_t* VT = (bf16_t*)(lds + 69632);
    const bf16_t* Km = (const bf16_t*)(p.ws + OFF_KMAT); const bf16_t* Vm = (const bf16_t*)(p.ws + OFF_VT);
    int tid_ = threadIdx.x; asm volatile("" : "+v"(tid_)); const int tid = tid_;
#pragma unroll
    for (int i = 0; i < 8; ++i) {
        const int idx = tid + NTHR * i;
        { const int key = idx >> 4, ch = idx & 15; *(u32x4*)(Kimg + key * 136 + ch * 8) = *(const u32x4*)(Km + (size_t)(b * 256 + key) * 512 + h * 128 + ch * 8); }
        { const int dd = idx >> 5, ch = idx & 31; *(u32x4*)(VT + dd * 264 + ch * 8) = *(const u32x4*)(Vm + (size_t)(h * 128 + dd) * 2048 + b * 256 + ch * 8); }
    }
    __syncthreads();
}
__device__ __forceinline__ void memattn_item(bf16_t* P, int bl, int h, int qt, unsigned char* lds, int dry = 0) {
    const bf16_t* Kimg = (const bf16_t*)lds; const bf16_t* VT = (const bf16_t*)(lds + 69632);
    int tid_ = threadIdx.x; asm volatile("" : "+v"(tid_)); const int tid = tid_, lane = tid & 63, w = tid >> 6, l15 = lane & 15, q4 = lane >> 4;
    const int tok = bl * SEQ + qt * 128 + w * 16 + l15;
    bf16_t* qrow = P + (size_t)tok * PS + C_MQ + h * 128;
    bf16x8 qf[4];
#pragma unroll
    for (int ks = 0; ks < 4; ++ks) qf[ks] = *(const bf16x8*)(qrow + ks * 32 + q4 * 8);
    f32x4 sc[16];
    float mx = -1e30f;
#pragma unroll
    for (int t = 0; t < 16; ++t) {
        f32x4 a = {0.f, 0.f, 0.f, 0.f};
#pragma unroll
        for (int ks = 0; ks < 4; ++ks) { const bf16x8 kf = *(const bf16x8*)(Kimg + (t * 16 + l15) * 136 + ks * 32 + q4 * 8); a = MFMA(kf, qf[ks], a); }
        sc[t] = a;
        mx = fmaxf(mx, fmaxf(fmaxf(a[0], a[1]), fmaxf(a[2], a[3])));
    }
    mx = fmaxf(mx, __shfl_xor(mx, 16)); mx = fmaxf(mx, __shfl_xor(mx, 32));
    float sum = 0.f;
#pragma unroll
    for (int t = 0; t < 16; ++t)
#pragma unroll
        for (int e = 0; e < 4; ++e) { const float pe = __expf(sc[t][e] - mx); sc[t][e] = pe; sum += pe; }
    sum += __shfl_xor(sum, 16); sum += __shfl_xor(sum, 32);
    f32x4 o[8];
#pragma unroll
    for (int dt = 0; dt < 8; ++dt) o[dt] = (f32x4){0.f, 0.f, 0.f, 0.f};
#pragma unroll
    for (int kk = 0; kk < 8; ++kk) {
        u32x4 pu; pu.x = pk2(sc[2 * kk][0], sc[2 * kk][1]); pu.y = pk2(sc[2 * kk][2], sc[2 * kk][3]); pu.z = pk2(sc[2 * kk + 1][0], sc[2 * kk + 1][1]); pu.w = pk2(sc[2 * kk + 1][2], sc[2 * kk + 1][3]);
        const bf16x8 pf = mkfrag(pu);
#pragma unroll
        for (int dt = 0; dt < 8; ++dt) {
            const bf16_t* vr = VT + (dt * 16 + l15) * 264 + kk * 32 + 4 * q4;
            const bf16x8 vf = mkfrag2(*(const u32x2*)vr, *(const u32x2*)(vr + 16));
            o[dt] = MFMA(vf, pf, o[dt]);
        }
    }
    const float inv = 1.0f / sum;
    const bf16_t* zrow = P + (size_t)tok * PS + C_Z + 3 * 512 + h * 128;
#pragma unroll
    for (int dt = 0; dt < 8; ++dt) {
        const int dd = dt * 16 + 4 * q4;
        const f32x4 z = ld_bf4(zrow + dd);
        if (!dry) st_bf4(qrow + dd, o[dt] * inv * z);
    }
}

constexpr int G_LRT = 0, G_BF = 8192, G_BB = 24576, G_TOT = 40960, G_IMG = 45056;
__device__ __forceinline__ void gla_tables(const Params& p, int l, const float* LR, int t0, int h, unsigned char* lds) {
    float* LRT = (float*)(lds + G_LRT); float* BF = (float*)(lds + G_BF); float* BB = (float*)(lds + G_BB); float* TOT = (float*)(lds + G_TOT);
    int tid_ = threadIdx.x; asm volatile("" : "+v"(tid_)); const int tid = tid_;
    ((float4*)LRT)[tid] = ((const float4*)(LR + (size_t)t0 * 32))[tid];
    __syncthreads();
    const int dk = tid & 63, cgp = tid >> 6;
    float uf[16], ub[16];
#pragma unroll
    for (int r = 0; r < 16; ++r) { uf[r] = p.gla_up_f[(size_t)(l * 16 + r) * 256 + h * 64 + dk]; ub[r] = p.gla_up_b[(size_t)(l * 16 + r) * 256 + h * 64 + dk]; }
    const float bif = p.gla_bias_f[l * 256 + h * 64 + dk], bib = p.gla_bias_b[l * 256 + h * 64 + dk];
    float lf[8], lb[8];
#pragma unroll
    for (int i = 0; i < 8; ++i) {
        const int c = cgp * 8 + i; float sf = bif, sb = bib;
#pragma unroll
        for (int r = 0; r < 16; ++r) { sf += LRT[c * 32 + r] * uf[r]; sb += LRT[c * 32 + 16 + r] * ub[r]; }
        lf[i] = logsigf_(sf) * (1.0f / 16.0f); lb[i] = logsigf_(sb) * (1.0f / 16.0f);
    }
#pragma unroll
    for (int i = 1; i < 8; ++i) lf[i] += lf[i - 1];
#pragma unroll
    for (int i = 6; i >= 0; --i) lb[i] += lb[i + 1];
    TOT[cgp * 64 + dk] = lf[7]; TOT[512 + cgp * 64 + dk] = lb[0];
    __syncthreads();
    float of = 0.f, ob = 0.f;
#pragma unroll
    for (int g2 = 0; g2 < 8; ++g2) { if (g2 < cgp) of += TOT[g2 * 64 + dk]; if (g2 > cgp) ob += TOT[512 + g2 * 64 + dk]; }
#pragma unroll
    for (int i = 0; i < 8; ++i) { BF[(cgp * 8 + i) * 64 + dk] = lf[i] + of; BB[(cgp * 8 + i) * 64 + dk] = lb[i] + ob; }
    __syncthreads();
}
struct GlaPre { u32x4 vv[2]; bf16_t q[8], k[8]; };
__device__ __forceinline__ void gla_prefetch(GlaPre& g, const bf16_t* P, int t0, int h, int tid) {
#pragma unroll
    for (int i = 0; i < 2; ++i) { const int idx = tid + NTHR * i, chn = idx >> 6, c = idx & 63; g.vv[i] = *(const u32x4*)(P + (size_t)(t0 + c) * PS + C_GV + h * 128 + chn * 8); }
#pragma unroll
    for (int i = 0; i < 8; ++i) { const int idx = tid + NTHR * i, c = idx >> 6, dk = idx & 63; g.q[i] = P[(size_t)(t0 + c) * PS + C_GQ + h * 64 + dk]; g.k[i] = P[(size_t)(t0 + c) * PS + C_GK + h * 64 + dk]; }
}
__device__ __forceinline__ void gla_vt_store(const GlaPre& g, bf16_t* VT, int tid) {
#pragma unroll
    for (int i = 0; i < 2; ++i) {
        const int idx = tid + NTHR * i, chn = idx >> 6, c = idx & 63;
        const u32x4 vv = g.vv[i];
        bf16_t* vd = VT + (chn * 8) * 72 + c;
        vd[0 * 72] = (bf16_t)(vv.x & 0xffffu); vd[1 * 72] = (bf16_t)(vv.x >> 16);
        vd[2 * 72] = (bf16_t)(vv.y & 0xffffu); vd[3 * 72] = (bf16_t)(vv.y >> 16);
        vd[4 * 72] = (bf16_t)(vv.z & 0xffffu); vd[5 * 72] = (bf16_t)(vv.z >> 16);
        vd[6 * 72] = (bf16_t)(vv.w & 0xffffu); vd[7 * 72] = (bf16_t)(vv.w >> 16);
    }
}
__device__ __forceinline__ void gla_part1_item(const Params& p, int l, const bf16_t* P, const float* LR, int item, unsigned char* lds) {
    const int h = item & 3, n = (item >> 2) & 127, bl = item >> 9, t0 = bl * SEQ + n * 64;
    const float* BF = (const float*)(lds + G_BF); const float* BB = (const float*)(lds + G_BB);
    bf16_t* KDT0 = (bf16_t*)(lds + G_IMG); bf16_t* KDT1 = KDT0 + 64 * 72; bf16_t* VT = KDT1 + 64 * 72;
    float* GS = (float*)(p.ws + OFF_GS); float* GD = (float*)(p.ws + OFF_GDEC);
    int tid_ = threadIdx.x; asm volatile("" : "+v"(tid_)); const int tid = tid_, lane = tid & 63, w = tid >> 6, l15 = lane & 15, q4 = lane >> 4;
    GlaPre gp; gla_prefetch(gp, P, t0, h, tid);
    gla_tables(p, l, LR, t0, h, lds);
#pragma unroll
    for (int i = 0; i < 8; ++i) {
        const int idx = tid + NTHR * i, c = idx >> 6, dk = idx & 63;
        const float kv = bf2f(gp.k[i]);
        KDT0[dk * 72 + c] = f2bf_d(kv * __expf(BF[63 * 64 + dk] - BF[c * 64 + dk]));
        KDT1[dk * 72 + c] = f2bf_d(kv * __expf(BB[dk] - BB[c * 64 + dk]));
    }
    gla_vt_store(gp, VT, tid);
    if (tid < 64) GD[(size_t)item * 64 + tid] = __expf(BF[63 * 64 + tid]);
    else if (tid < 128) GD[(size_t)(NITEM + item) * 64 + tid - 64] = __expf(BB[tid - 64]);
    __syncthreads();
    const int dir = w >> 2, dkt = w & 3;
    const bf16_t* KD = dir ? KDT1 : KDT0;
    bf16x8 kf[2];
#pragma unroll
    for (int ks = 0; ks < 2; ++ks) kf[ks] = *(const bf16x8*)(KD + (16 * dkt + l15) * 72 + 32 * ks + 8 * q4);
    float* dst = GS + ((size_t)dir * NITEM + item) * 8192;
#pragma unroll
    for (int dvt = 0; dvt < 8; ++dvt) {
        f32x4 a = {0.f, 0.f, 0.f, 0.f};
#pragma unroll
        for (int ks = 0; ks < 2; ++ks) { const bf16x8 vf = *(const bf16x8*)(VT + (16 * dvt + l15) * 72 + 32 * ks + 8 * q4); a = MFMA(kf[ks], vf, a); }
        *(f32x4*)(dst + (16 * dvt + l15) * 64 + 16 * dkt + 4 * q4) = a;
    }
    __syncthreads();
}
__device__ __forceinline__ void gla_scan(const Params& p, int dry = 0) {
    float* GS = (float*)(p.ws + OFF_GS); const float* GD = (const float*)(p.ws + OFF_GDEC);
    const int total = 2 * BG * 4 * 8192;
    int tid_ = threadIdx.x; asm volatile("" : "+v"(tid_));
    for (int id = blockIdx.x * NTHR + tid_; id < total; id += gridDim.x * NTHR) {
        const int e = id & 8191, comb = id >> 13, h = comb & 3, bl = (comb >> 2) % BG, dir = comb / (4 * BG), dk = e & 63;
        float S = 0.f;
        const size_t ibase = (size_t)dir * NITEM + (size_t)(bl * 128) * 4 + h;
        for (int s0 = 0; s0 < 128; s0 += 16) {
            float u[16], dc[16];
#pragma unroll
            for (int i = 0; i < 16; ++i) {
                const int n = dir ? 127 - (s0 + i) : s0 + i;
                const size_t item = ibase + (size_t)n * 4;
                u[i] = GS[item * 8192 + e]; dc[i] = GD[item * 64 + dk];
            }
#pragma unroll
            for (int i = 0; i < 16; ++i) {
                const int n = dir ? 127 - (s0 + i) : s0 + i;
                const size_t item = ibase + (size_t)n * 4;
                if (!dry) GS[item * 8192 + e] = S;
                S = dc[i] * S + u[i];
            }
        }
    }
}
__device__ __forceinline__ void gla_part2_item(const Params& p, int l, bf16_t* P, const float* LR, int item, unsigned char* lds, int dry = 0) {
    const int h = item & 3, n = (item >> 2) & 127, bl = item >> 9, t0 = bl * SEQ + n * 64;
    const float* BF = (const float*)(lds + G_BF); const float* BB = (const float*)(lds + G_BB);
    bf16_t* QF = (bf16_t*)(lds + G_IMG);
    bf16_t* KF = QF + 2 * 64 * 72;
    bf16_t* QD = KF + 2 * 64 * 72;
    bf16_t* VT = QD + 2 * 64 * 72;
    bf16_t* ST = VT + 128 * 72;
    float* OX = (float*)lds;
    const float* GS = (const float*)(p.ws + OFF_GS);
    int tid_ = threadIdx.x; asm volatile("" : "+v"(tid_)); const int tid = tid_, lane = tid & 63, w = tid >> 6, l15 = lane & 15, q4 = lane >> 4;
    GlaPre gp; gla_prefetch(gp, P, t0, h, tid);
    float4 sp[2][4];
#pragma unroll
    for (int dir = 0; dir < 2; ++dir)
#pragma unroll
        for (int i = 0; i < 4; ++i) { const int idx = tid + NTHR * i; sp[dir][i] = *(const float4*)(GS + ((size_t)dir * NITEM + item) * 8192 + (idx >> 4) * 64 + (idx & 15) * 4); }
    gla_tables(p, l, LR, t0, h, lds);
#pragma unroll
    for (int i = 0; i < 8; ++i) {
        const int idx = tid + NTHR * i, c = idx >> 6, dk = idx & 63;
        const float qv = bf2f(gp.q[i]);
        const float kv = bf2f(gp.k[i]);
        const float bf = BF[c * 64 + dk], mf = BF[31 * 64 + dk], bb = BB[c * 64 + dk], mb = BB[32 * 64 + dk];
        QF[c * 72 + dk] = f2bf_d(qv * __expf(bf - mf)); KF[c * 72 + dk] = f2bf_d(kv * __expf(mf - bf)); QD[c * 72 + dk] = f2bf_d(qv * __expf(bf));
        QF[4608 + c * 72 + dk] = f2bf_d(qv * __expf(bb - mb)); KF[4608 + c * 72 + dk] = f2bf_d(kv * __expf(mb - bb)); QD[4608 + c * 72 + dk] = f2bf_d(qv * __expf(bb));
    }
    gla_vt_store(gp, VT, tid);
#pragma unroll
    for (int dir = 0; dir < 2; ++dir) {
#pragma unroll
        for (int i = 0; i < 4; ++i) {
            const int idx = tid + NTHR * i, dv = idx >> 4, dk4 = (idx & 15) * 4;
            const float4 s = sp[dir][i];
            u32x2 o; o.x = pk2(s.x, s.y); o.y = pk2(s.z, s.w);
            *(u32x2*)(ST + dir * 9216 + dv * 72 + dk4) = o;
        }
    }
    __syncthreads();
    const int dir = w >> 2, ct = w & 3;
    const bf16_t* qfp = QF + dir * 4608; const bf16_t* kfp = KF + dir * 4608; const bf16_t* qdp = QD + dir * 4608; const bf16_t* stp = ST + dir * 9216;
    bf16x8 qf[2], qd[2];
#pragma unroll
    for (int ks = 0; ks < 2; ++ks) { qf[ks] = *(const bf16x8*)(qfp + (16 * ct + l15) * 72 + 32 * ks + 8 * q4); qd[ks] = *(const bf16x8*)(qdp + (16 * ct + l15) * 72 + 32 * ks + 8 * q4); }
    f32x4 sc[4];
    const int cq = 16 * ct + l15;
#pragma unroll
    for (int st = 0; st < 4; ++st) {
        f32x4 a = {0.f, 0.f, 0.f, 0.f};
#pragma unroll
        for (int ks = 0; ks < 2; ++ks) { const bf16x8 kf = *(const bf16x8*)(kfp + (16 * st + l15) * 72 + 32 * ks + 8 * q4); a = MFMA(kf, qf[ks], a); }
#pragma unroll
        for (int e = 0; e < 4; ++e) { const int s = 16 * st + 4 * q4 + e; const bool ok = dir ? (s > cq) : (s <= cq); a[e] = ok ? a[e] : 0.f; }
        sc[st] = a;
    }
    f32x4 o[8];
#pragma unroll
    for (int dt = 0; dt < 8; ++dt) o[dt] = (f32x4){0.f, 0.f, 0.f, 0.f};
#pragma unroll
    for (int kk = 0; kk < 2; ++kk) {
        u32x4 pu; pu.x = pk2(sc[2 * kk][0], sc[2 * kk][1]); pu.y = pk2(sc[2 * kk][2], sc[2 * kk][3]); pu.z = pk2(sc[2 * kk + 1][0], sc[2 * kk + 1][1]); pu.w = pk2(sc[2 * kk + 1][2], sc[2 * kk + 1][3]);
        const bf16x8 pf = mkfrag(pu);
#pragma unroll
        for (int dt = 0; dt < 8; ++dt) {
            const bf16_t* vr = VT + (dt * 16 + l15) * 72 + kk * 32 + 4 * q4;
            const bf16x8 vf = mkfrag2(*(const u32x2*)vr, *(const u32x2*)(vr + 16));
            o[dt] = MFMA(vf, pf, o[dt]);
        }
    }
#pragma unroll
    for (int ks = 0; ks < 2; ++ks)
#pragma unroll
        for (int dt = 0; dt < 8; ++dt) { const bf16x8 sf = *(const bf16x8*)(stp + (dt * 16 + l15) * 72 + 32 * ks + 8 * q4); o[dt] = MFMA(sf, qd[ks], o[dt]); }
    if (dir == 1) {
#pragma unroll
        for (int dt = 0; dt < 8; ++dt) *(f32x4*)(OX + cq * 132 + 16 * dt + 4 * q4) = o[dt];
    }
    __syncthreads();
    if (dir == 0) {
        float ss = 0.f;
#pragma unroll
        for (int dt = 0; dt < 8; ++dt) { o[dt] += *(const f32x4*)(OX + cq * 132 + 16 * dt + 4 * q4); ss += (o[dt][0] * o[dt][0] + o[dt][1] * o[dt][1]) + (o[dt][2] * o[dt][2] + o[dt][3] * o[dt][3]); }
        ss += __shfl_xor(ss, 16); ss += __shfl_xor(ss, 32);
        const float rms = 1.0f / sqrtf(ss * (1.0f / 128.0f) + 1e-6f);
        const float* ng = p.gla_norm_g + l * 512 + h * 128;
        const bf16_t* zrow = P + (size_t)(t0 + cq) * PS + C_Z + 2 * 512 + h * 128;
        bf16_t* orow = P + (size_t)(t0 + cq) * PS + C_GV + h * 128;
#pragma unroll
        for (int dt = 0; dt < 8; ++dt) {
            const int dd = 16 * dt + 4 * q4;
            const f32x4 z = ld_bf4(zrow + dd); const f32x4 g4 = *(const f32x4*)(ng + dd);
            if (!dry) st_bf4(orow + dd, o[dt] * rms * g4 * z);
        }
    }
    __syncthreads();
}

namespace pg8 {
#define PG8_LAS __attribute__((address_space(3)))
typedef unsigned short bf16_t;
typedef short bf16x8 __attribute__((ext_vector_type(8)));
typedef float f32x4 __attribute__((ext_vector_type(4)));
typedef unsigned u32x4 __attribute__((ext_vector_type(4)));
constexpr int BM = 256, BK = 64, HALF = 128, HTB = HALF * BK * 2  , STAGE_BYTES = 8 * HTB, NXCD = 8, WGM = 8;

__host__ __device__ __forceinline__ int lds_byte(int r, int c) { const int st = (r >> 4) * 2 + (c >> 5), rr = r & 15, cc = c & 31, ob = rr * 64 + cc * 2; return st * 1024 + (ob ^ (((ob >> 9) & 1) << 5)); }
__host__ __device__ __forceinline__ void stage_rc(int b, int& R, int& C) { const int st = b / 1024, sb = b % 1024, swz = sb ^ (((sb >> 9) & 1) << 5); R = (st >> 1) * 16 + swz / 64; C = (st & 1) * 32 + (swz % 64) / 2; }
__host__ __device__ __forceinline__ int perm32(int rho) { const int n = rho >> 4, i = rho & 15; return 8 * (i >> 2) + 4 * n + (i & 3); }

struct Unit { int pm, pn; };
struct Gemm { const bf16_t* A; const bf16_t* Bt; int M, N, K; };

struct StaticOrder {
    int nM, nN, nwg, G, c;
    __host__ __device__ __forceinline__ void init(int M, int N, int G_, int c_) { nM = M / BM; nN = N / BM; nwg = nM * nN; G = G_; c = c_; }
    __host__ __device__ bool next(int i, Unit& u) const {
        const long L = (long)i * G + c; if (L >= nwg) return false;
        int wgid = (int)L; { const int q = nwg / NXCD, r = nwg % NXCD, xcd = wgid % NXCD, off = wgid / NXCD; wgid = (xcd < r ? xcd * (q + 1) : r * (q + 1) + (xcd - r) * q) + off; }
        const int nig = WGM * nN, gid = wgid / nig, fm = gid * WGM, gsz = (nM - fm) < WGM ? (nM - fm) : WGM;
        u.pm = fm + ((wgid % nig) % gsz); u.pn = (wgid % nig) / gsz; return true;
    }
    __device__ __forceinline__ void a_ready(const Unit&) const {}
    __device__ __forceinline__ void done(const Unit&) const {}
};
__device__ __forceinline__ unsigned cvt_pk_bf16(float lo, float hi) { unsigned r; asm volatile("v_cvt_pk_bf16_f32 %0, %1, %2" : "=v"(r) : "v"(lo), "v"(hi)); return r; }
template <class Epi, class Sched, bool STAMP = false>
__device__ __forceinline__ void gemm_phase(PG8_LAS unsigned char* lds, const Gemm g, const Sched& S, const Epi& E, unsigned long long* stamps) {
    int tid_l = threadIdx.x; asm volatile("" : "+v"(tid_l)); const int tid = tid_l, wid = __builtin_amdgcn_readfirstlane(tid >> 6), lane = tid & 63, wr = wid >> 2, wc = wid & 3, fr = lane & 15, fq = lane >> 4;
    const int K = g.K, nt = K / BK;
    int ts_lo = 0, ts_hi = 0, nts = 0; const unsigned long long rt_entry = STAMP ? (unsigned long long)wall_clock64() : 0ull;
#define PG8_STAMP() do { if (STAMP && wid == 0 && nts < 64) { const unsigned long long _c = (unsigned long long)clock64(); \
        ts_lo = (lane == nts) ? (int)(unsigned)_c : ts_lo; ts_hi = (lane == nts) ? (int)(unsigned)(_c >> 32) : ts_hi; ++nts; } } while (0)
    PG8_STAMP();
    unsigned voffA[2], voffB[2];
#pragma unroll
    for (int i = 0; i < 2; ++i) { int R, C; stage_rc(tid * 16 + i * 8192, R, C); const int Rb = Epi::PERM ? ((R & ~31) + perm32(R & 31)) : R;
        voffA[i] = (unsigned)(R * K + C) * 2u; voffB[i] = (unsigned)(Rb * K + C) * 2u; }
    const size_t kstep = (size_t)(BK * 2);
    const size_t hstep = (size_t)HALF * K * 2;
    const size_t tstep = 2 * hstep;
    const unsigned ldsw = (unsigned)wid * 1024u;
    const int aoff = lds_byte(wr * 64 + fr, fq * 8), boff = lds_byte(wc * 32 + fr, fq * 8);
#define PG8_SA(b, h) (((b) * 2 + (h)) * HTB)
#define PG8_SB(b, h) ((4 + (b) * 2 + (h)) * HTB)
#define PG8_STAGE(bufoff, gbase, voff) do { _Pragma("unroll") for (int _i = 0; _i < 2; ++_i) \
        __builtin_amdgcn_global_load_lds((const unsigned*)((const char*)(gbase) + (voff)[_i]), (PG8_LAS unsigned*)(lds + (bufoff) + ldsw + _i * 8192), 16, 0, 0); } while (0)
#define PG8_LDA(dst, b, h) do { _Pragma("unroll") for (int m = 0; m < 4; ++m) _Pragma("unroll") for (int k = 0; k < 2; ++k) dst[m][k] = *(const PG8_LAS bf16x8*)(lds + PG8_SA(b, h) + aoff + m * 2048 + k * 1024); } while (0)
#define PG8_LDB(dst, b, h) do { _Pragma("unroll") for (int n = 0; n < 2; ++n) _Pragma("unroll") for (int k = 0; k < 2; ++k) dst[n][k] = *(const PG8_LAS bf16x8*)(lds + PG8_SB(b, h) + boff + n * 2048 + k * 1024); } while (0)
#define PG8_MMA(ai, bj, At, Bt) do { __builtin_amdgcn_s_setprio(1); _Pragma("unroll") for (int m = 0; m < 4; ++m) _Pragma("unroll") for (int n = 0; n < 2; ++n) _Pragma("unroll") for (int k = 0; k < 2; ++k) \
        acc[ai][bj][m][n] = __builtin_amdgcn_mfma_f32_16x16x32_bf16(Bt[n][k], At[m][k], acc[ai][bj][m][n], 0, 0, 0); __builtin_amdgcn_s_setprio(0); } while (0)
#define PG8_WAIT_V(n) asm volatile("s_waitcnt vmcnt(" #n ")" ::: "memory")
#define PG8_WAIT_L(n) asm volatile("s_waitcnt lgkmcnt(" #n ")" ::: "memory")
#define PG8_BAR __builtin_amdgcn_s_barrier()
#define PG8_SCHED __builtin_amdgcn_sched_barrier(0)
    Unit cur, nxt; int ui = 0;
    if (!S.next(0, cur)) return;
    f32x4 acc[2][2][4][2];
#pragma unroll
    for (int a = 0; a < 2; ++a)
#pragma unroll
        for (int b = 0; b < 2; ++b)
#pragma unroll
            for (int m = 0; m < 4; ++m)
#pragma unroll
                for (int n = 0; n < 2; ++n) acc[a][b][m][n] = (f32x4){0.f, 0.f, 0.f, 0.f};
    bf16x8 At[4][2], B0[2][2], B1[2][2];
    const char* cA = (const char*)g.A + (size_t)cur.pm * tstep; const char* cB = (const char*)g.Bt + (size_t)cur.pn * tstep;
    S.a_ready(cur);
    PG8_STAGE(PG8_SB(0, 0), cB, voffB); PG8_STAGE(PG8_SA(0, 0), cA, voffA); PG8_STAGE(PG8_SB(0, 1), cB + hstep, voffB); PG8_STAGE(PG8_SA(0, 1), cA + hstep, voffA);
    if (wr == 1) PG8_BAR;
    PG8_WAIT_V(4); PG8_BAR;
    PG8_STAGE(PG8_SB(1, 0), cB + kstep, voffB); PG8_STAGE(PG8_SA(1, 0), cA + kstep, voffA); PG8_STAGE(PG8_SB(1, 1), cB + hstep + kstep, voffB);
    PG8_WAIT_V(6); PG8_BAR;
    PG8_STAMP();
    for (;;) {
        const bool has_next = S.next(ui + 1, nxt);
        const char* nA = has_next ? (const char*)g.A + (size_t)nxt.pm * tstep : cA; const char* nB = has_next ? (const char*)g.Bt + (size_t)nxt.pn * tstep : cB;
        for (int t = 0; t < nt; t += 2) {
            const bool last = (t == nt - 2);
            const char* a1 = cA + (size_t)(t + 1) * kstep;
            const char* a2 = last ? nA : cA + (size_t)(t + 2) * kstep; const char* b2 = last ? nB : cB + (size_t)(t + 2) * kstep;
            const char* a3 = a2 + kstep; const char* b3 = b2 + kstep;
            if (last && has_next) S.a_ready(nxt);
            PG8_LDB(B0, 0, 0); PG8_SCHED; PG8_LDA(At, 0, 0); PG8_STAGE(PG8_SA(1, 1), a1 + hstep, voffA);
            PG8_WAIT_L(8); PG8_BAR; PG8_WAIT_L(0); PG8_MMA(0, 0, At, B0); PG8_BAR; PG8_SCHED;
            PG8_LDB(B1, 0, 1); PG8_STAGE(PG8_SB(0, 0), b2, voffB);
            PG8_BAR; PG8_WAIT_L(0); PG8_MMA(0, 1, At, B1); PG8_BAR;
            PG8_LDA(At, 0, 1); PG8_STAGE(PG8_SA(0, 0), a2, voffA);
            PG8_BAR; PG8_WAIT_L(0); PG8_MMA(1, 0, At, B0); PG8_BAR; PG8_SCHED;
            PG8_STAGE(PG8_SB(0, 1), b2 + hstep, voffB);
            PG8_WAIT_V(6); PG8_BAR; PG8_MMA(1, 1, At, B1); PG8_BAR;
            PG8_LDB(B0, 1, 0); PG8_SCHED; PG8_LDA(At, 1, 0); PG8_STAGE(PG8_SA(0, 1), a2 + hstep, voffA);
            PG8_WAIT_L(8); PG8_BAR; PG8_WAIT_L(0); PG8_MMA(0, 0, At, B0); PG8_BAR; PG8_SCHED;
            PG8_LDB(B1, 1, 1); PG8_STAGE(PG8_SB(1, 0), b3, voffB);
            PG8_BAR; PG8_WAIT_L(0); PG8_MMA(0, 1, At, B1); PG8_BAR;
            PG8_LDA(At, 1, 1); PG8_STAGE(PG8_SA(1, 0), a3, voffA);
            PG8_BAR; PG8_WAIT_L(0); PG8_MMA(1, 0, At, B0); PG8_BAR; PG8_SCHED;
            PG8_STAGE(PG8_SB(1, 1), b3 + hstep, voffB);
            PG8_WAIT_V(6); PG8_BAR; PG8_MMA(1, 1, At, B1); PG8_BAR;
        }
        PG8_STAMP();
        if constexpr (!Epi::AFTER_DRAIN) { E(acc, cur, wr, wc, fr, fq); S.done(cur); }
        PG8_STAMP();
        if (!has_next) break;
#pragma unroll
        for (int a = 0; a < 2; ++a)
#pragma unroll
            for (int b = 0; b < 2; ++b)
#pragma unroll
                for (int m = 0; m < 4; ++m)
#pragma unroll
                    for (int n = 0; n < 2; ++n) acc[a][b][m][n] = (f32x4){0.f, 0.f, 0.f, 0.f};
        cur = nxt; cA = nA; cB = nB; ++ui;
    }
    PG8_WAIT_V(0);
    if (wr == 0) PG8_BAR;
    PG8_BAR;
    if constexpr (Epi::AFTER_DRAIN) { E.fused(acc, cur, wr, wc, fr, fq, lds, wid, lane); S.done(cur); }
    PG8_STAMP();
    if (STAMP && wid == 0) { stamps[lane] = lane < nts ? (((unsigned long long)(unsigned)ts_hi << 32) | (unsigned)ts_lo) : 0ull;
        if (lane == 62) stamps[62] = rt_entry; if (lane == 63) stamps[63] = (unsigned long long)wall_clock64(); }
#undef PG8_STAMP
#undef PG8_SA
#undef PG8_SB
#undef PG8_STAGE
#undef PG8_LDA
#undef PG8_LDB
#undef PG8_MMA
#undef PG8_WAIT_V
#undef PG8_WAIT_L
#undef PG8_BAR
#undef PG8_SCHED
}
}

struct EpiInProj {
    static constexpr bool PERM = true, AFTER_DRAIN = false;
    bf16_t* P; const float* bias; float* LR;
    __device__ __forceinline__ void operator()(const f32x4 (&acc)[2][2][4][2], const pg8::Unit& u, int wr, int wc, int fr, int fq) const {
        const int row0 = u.pm * 256 + wr * 64 + fr, colt = u.pn * 256, col0 = colt + wc * 32 + 8 * fq;
        if (colt == C_LR) {
            if (wc == 0) {
                const int cl = 8 * fq;
                const f32x4 b0 = *(const f32x4*)(bias + 4096 + cl), b1 = *(const f32x4*)(bias + 4096 + cl + 4);
#pragma unroll
                for (int ai = 0; ai < 2; ++ai)
#pragma unroll
                    for (int m = 0; m < 4; ++m) {
                        float* d = LR + (size_t)(row0 + ai * 128 + m * 16) * 32 + cl;
                        *(f32x4*)d = acc[ai][0][m][0] + b0; *(f32x4*)(d + 4) = acc[ai][0][m][1] + b1;
                    }
            }
            return;
        }
        const int mode = (colt < 512 || colt == C_GQ) ? 1 : (colt >= C_MQ && colt < C_Z) ? 2 : (colt >= C_Z && colt < C_SG) ? 3 : (colt >= C_SG) ? 4 : 0;
#pragma unroll
        for (int bj = 0; bj < 2; ++bj) {
            const int col = col0 + bj * 128;
            const f32x4 b0 = *(const f32x4*)(bias + orig_col(col)), b1 = *(const f32x4*)(bias + orig_col(col) + 4);
#pragma unroll
            for (int ai = 0; ai < 2; ++ai)
#pragma unroll
                for (int m = 0; m < 4; ++m) {
                    f32x4 v0 = acc[ai][bj][m][0] + b0, v1 = acc[ai][bj][m][1] + b1;
                    if (mode == 1) { v0 *= 0.125f; v1 *= 0.125f; }
                    else if (mode == 2) { v0 *= 0.08838834764831845f; v1 *= 0.08838834764831845f; }
                    else if (mode == 3) {
#pragma unroll
                        for (int e = 0; e < 4; ++e) { v0[e] = siluf_(v0[e]); v1[e] = siluf_(v1[e]); }
                    } else if (mode == 4) {
#pragma unroll
                        for (int e = 0; e < 4; ++e) { v0[e] = sigmoidf_(v0[e]); v1[e] = sigmoidf_(v1[e]); }
                    }
                    u32x4 o; o.x = pk2(v0[0], v0[1]); o.y = pk2(v0[2], v0[3]); o.z = pk2(v1[0], v1[1]); o.w = pk2(v1[2], v1[3]);
                    *(u32x4*)(P + (size_t)(row0 + ai * 128 + m * 16) * PS + col) = o;
                }
        }
    }
};
struct EpiOut {
    static constexpr bool PERM = false, AFTER_DRAIN = false;
    float* pre; const float* bo; const float* x; const float2* stats; const float* g0; const float* b0; const float* hres; size_t tok0; int l;
    __device__ __forceinline__ void operator()(const f32x4 (&acc)[2][2][4][2], const pg8::Unit& u, int wr, int wc, int fr, int fq) const {
        const int row0 = u.pm * 256 + wr * 64 + fr, col0 = u.pn * 256 + wc * 32 + 4 * fq;
#pragma unroll
        for (int ai = 0; ai < 2; ++ai)
#pragma unroll
            for (int m = 0; m < 4; ++m) {
                const int row = row0 + ai * 128 + m * 16; const size_t T = tok0 + row;
                float2 st; st.x = 0.f; st.y = 0.f; if (l == 0) st = stats[T];
#pragma unroll
                for (int bj = 0; bj < 2; ++bj)
#pragma unroll
                    for (int n = 0; n < 2; ++n) {
                        const int col = col0 + bj * 128 + n * 16;
                        f32x4 res;
                        if (l == 0) res = (*(const f32x4*)(x + T * 1024 + col) - st.x) * st.y * *(const f32x4*)(g0 + col) + *(const f32x4*)(b0 + col);
                        else res = *(const f32x4*)(hres + T * 1024 + col);
                        *(f32x4*)(pre + (size_t)row * 1024 + col) = acc[ai][bj][m][n] + *(const f32x4*)(bo + col) + DN_ALPHA * res;
                    }
            }
    }
};

#define XB_TMO      128
#define XB_XCNT(j)  (256  + 64 * (j))
#define XB_XSUB(j)  (1280 + 64 * (j))
#define XB_XGEN(j)  (2304 + 64 * (j))
#define XB_TOP      3328
#define XB_TOPGEN   3392
#define XCD_BAR_WORDS 3456
#define XB_SPIN_CAP (1u << 18)
#define LAS __attribute__((address_space(3)))

__device__ __forceinline__ unsigned xb_ld(unsigned* p)              { return __hip_atomic_load(p, __ATOMIC_RELAXED, __HIP_MEMORY_SCOPE_AGENT); }
__device__ __forceinline__ unsigned xb_add(unsigned* p, unsigned v) { return __hip_atomic_fetch_add(p, v, __ATOMIC_RELAXED, __HIP_MEMORY_SCOPE_AGENT); }
__device__ __forceinline__ unsigned xb_xcc_id() { return (unsigned)__builtin_amdgcn_s_getreg((3 << 11) | 20) & 0xFu; }
#define XB_SPIN(cond, bar) do { unsigned _sp = 0; while (cond) { __builtin_amdgcn_s_sleep(1); \
    if ((++_sp & 255u) == 0u) { if (xb_ld(&(bar)[XB_TMO])) break; if (_sp > XB_SPIN_CAP) { atomicAdd(&(bar)[XB_TMO], 1u); break; } } } } while (0)

struct XcdBarrier {
    unsigned* bar; unsigned x;
    volatile LAS unsigned* st;
};

__device__ __forceinline__ XcdBarrier xcd_barrier_post(unsigned* bar, volatile LAS unsigned* st) {
    XcdBarrier b; b.bar = bar; b.x = xb_xcc_id(); b.st = st;
    if (threadIdx.x == 0) (void)xb_add(&bar[XB_XCNT(b.x)], 1u);
    return b;
}
__device__ __forceinline__ void xcd_barrier_complete(unsigned* bar, unsigned x, unsigned& nloc, unsigned& nx) {
    const unsigned G = gridDim.x * gridDim.y * gridDim.z;
    unsigned sum, cnt, mine, sp = 0u;
    for (;;) {
        sum = 0u; cnt = 0u; mine = 0u;
#pragma unroll
        for (unsigned j = 0; j < 16; ++j) { const unsigned c = xb_ld(&bar[XB_XCNT(j)]); sum += c; cnt += (c > 0u) ? 1u : 0u; mine = (j == x) ? c : mine; }
        if (sum == G) break;
        __builtin_amdgcn_s_sleep(1);
        if ((++sp & 255u) == 0u) { if (xb_ld(&bar[XB_TMO])) break; if (sp > XB_SPIN_CAP) { atomicAdd(&bar[XB_TMO], 1u); break; } }
    }
    nloc = mine > 0u ? mine : 1u; nx = cnt > 0u ? cnt : 1u;
}

__device__ __forceinline__ void xcd_barrier(unsigned* b_bar, unsigned b_x, volatile LAS unsigned* b_st) {
    asm volatile("s_waitcnt vmcnt(0)" ::: "memory");
    __syncthreads();
    if (threadIdx.x == 0) {
        unsigned* bar = b_bar;
        __builtin_amdgcn_s_waitcnt(0);
        unsigned nloc = b_st[0], nx = b_st[1];
        if (nloc == 0u) { xcd_barrier_complete(bar, b_x, nloc, nx); b_st[0] = nloc; b_st[1] = nx; }
        const unsigned old = xb_add(&bar[XB_XSUB(b_x)], 1u);
        const unsigned gen = old / nloc;
        if (old + 1u == (gen + 1u) * nloc) {
            __builtin_amdgcn_fence(__ATOMIC_RELEASE, "agent");
            asm volatile("s_waitcnt vmcnt(0)" ::: "memory");
            const unsigned og = xb_add(&bar[XB_TOP], 1u);
            const unsigned tg = og / nx;
            if (og + 1u == (tg + 1u) * nx) xb_add(&bar[XB_TOPGEN], 1u);
            else XB_SPIN(xb_ld(&bar[XB_TOPGEN]) == tg, bar);
            __builtin_amdgcn_fence(__ATOMIC_ACQUIRE, "agent");
            xb_add(&bar[XB_XGEN(b_x)], 1u);
            asm volatile("s_waitcnt vmcnt(0)" ::: "memory");
        } else {
            XB_SPIN(xb_ld(&bar[XB_XGEN(b_x)]) == gen, bar);
            __builtin_amdgcn_fence(__ATOMIC_ACQUIRE, "agent");
            asm volatile("s_waitcnt vmcnt(0)" ::: "memory");
        }
    }
    __syncthreads();
}

__device__ __forceinline__ void gbar(unsigned* ctr, unsigned& gen, int G) {
    __syncthreads();
    gen += (unsigned)G;
    if (threadIdx.x == 0) {
        __threadfence();
        __hip_atomic_fetch_add(ctr, 1u, __ATOMIC_RELAXED, __HIP_MEMORY_SCOPE_AGENT);
        while (__hip_atomic_load(ctr, __ATOMIC_RELAXED, __HIP_MEMORY_SCOPE_AGENT) < gen) __builtin_amdgcn_s_sleep(1);
        __threadfence();
    }
    __syncthreads();
}
typedef const Params __attribute__((address_space(4))) KParams;
#define KP4 __attribute__((address_space(4)))
__device__ __forceinline__ Params fresh_params() {
#if defined(__HIP_DEVICE_COMPILE__)
    KParams* kp = (KParams*)__builtin_amdgcn_kernarg_segment_ptr();
    asm volatile("" : "+s"(kp));
    Params r;
    const float* KP4 const* src = (const float* KP4 const*)kp;
    const float** dst = (const float**)&r;
#pragma unroll
    for (int i = 0; i < 28; ++i) dst[i] = src[i];
    return r;
#else
    return Params{};
#endif
}
__global__ void __launch_bounds__(NTHR) mega(Params p_unused) {
    extern __shared__ __attribute__((aligned(16))) unsigned char lds[];
    cg::grid_group grid = cg::this_grid();
    const int G = gridDim.x, bid = blockIdx.x;
    volatile LAS unsigned* xst = (volatile LAS unsigned*)((LAS unsigned char*)lds + (LDS_BYTES - 16));
    if (threadIdx.x == 0) { xst[0] = 0u; xst[1] = 0u; }
    __syncthreads();
    unsigned* xbar; unsigned xx;
    { const Params p = fresh_params(); xbar = (unsigned*)(p.ws + OFF_BAR); xx = xb_xcc_id(); if (threadIdx.x == 0) (void)xb_add(&xbar[XB_XCNT(xx)], 1u); }
    { const Params p = fresh_params(); phase0(p); }
    grid.sync();
#pragma unroll 1
    for (int l = 0; l < 2; ++l) {
        { const Params p = fresh_params(); phase_weights(p, l, lds); __syncthreads(); phase_filter_gen(p, l, lds); }
        xcd_barrier(xbar, xx, xst);
        {
            const Params p = fresh_params();
            phase_filter_fft(p, l, lds);
            const bf16_t* WtKV = (const bf16_t*)(p.ws + OFF_WTKV); const bf16_t* membf = (const bf16_t*)(p.ws + OFF_MEMBF);
            for (int t = bid; t < 64; t += G) {
                f32x4 acc[4][4];
                if (t < 32) {
                    const int m0 = (t >> 2) * 256, n0 = (t & 3) * 128;
                    gemm_core(acc, membf + (size_t)m0 * 1024, 1024, WtKV + (size_t)n0 * 1024, 1024, 1024, lds);
                    bf16_t* Km = (bf16_t*)(p.ws + OFF_KMAT);
                    EPI_LOOP(st_bf4(Km + (size_t)row * 512 + col, v);)
                } else {
                    const int t2 = t - 32, m0 = (t2 >> 4) * 256, n0 = (t2 & 15) * 128;
                    gemm_core(acc, WtKV + (size_t)(512 + m0) * 1024, 1024, membf + (size_t)n0 * 1024, 1024, 1024, lds);
                    bf16_t* Vm = (bf16_t*)(p.ws + OFF_VT);
                    EPI_LOOP(st_bf4(Vm + (size_t)row * 2048 + col, v);)
                }
            }
        }
        xcd_barrier(xbar, xx, xst);
#pragma unroll 1
        for (int g = 0; g < NGRP; ++g) {
            const size_t tok0 = (size_t)g * TG;
#pragma unroll 1
            for (int rep = 0; rep < PROBE_REP_INPROJ; ++rep) {
                const Params p = fresh_params();
                pg8::Gemm gm; gm.A = (const bf16_t*)(p.ws + OFF_HB) + tok0 * 1024; gm.Bt = (const bf16_t*)(p.ws + OFF_WTIN); gm.M = TG; gm.N = NINP; gm.K = 1024;
                pg8::StaticOrder S; S.init(TG, NINP, G, bid);
                EpiInProj E; E.P = (bf16_t*)(p.ws + OFF_P); E.bias = p.b_in + (size_t)l * NIN; E.LR = (float*)(p.ws + OFF_LR);
                pg8::gemm_phase<EpiInProj, pg8::StaticOrder, false>((PG8_LAS unsigned char*)lds, gm, S, E, nullptr);
                __syncthreads();
            }
            xcd_barrier(xbar, xx, xst);
#pragma unroll 1
            for (int rep = 0; rep < PROBE_REP_MIX; ++rep) {
            int dry = (rep + 1 < PROBE_REP_MIX) ? 1 : 0; asm volatile("" : "+s"(dry));
            {
                const Params p = fresh_params();
                bf16_t* P = (bf16_t*)(p.ws + OFF_P);
                for (int it = bid; it < BG * 64 * 8; it += G) na_item(p, l, P, it >> 9, (it >> 3) & 63, it & 7, lds, dry);
            }
            {
                const Params p = fresh_params();
                bf16_t* P = (bf16_t*)(p.ws + OFF_P);
                for (int it = bid; it < BG * 128 * 8; it += G) hy_pre_item(p, l, P, (float*)(p.ws + OFF_UT), (bf16_t*)(p.ws + OFF_GT), it >> 10, (it >> 3) & 127, it & 7, lds);
            }
            {
                const Params p = fresh_params();
                for (int it = bid; it < NITEM; it += G) gla_part1_item(p, l, (const bf16_t*)(p.ws + OFF_P), (const float*)(p.ws + OFF_LR), it, lds);
            }
            {
                const Params p = fresh_params();
                bf16_t* P = (bf16_t*)(p.ws + OFF_P);
                const int nit = BG * 4 * 64, per = (nit + G - 1) / G;
                int last = -1;
                for (int it = bid * per; it < min(nit, (bid + 1) * per); ++it) {
                    const int bh = it >> 6, bl = bh >> 2, h = bh & 3;
                    if (bh != last) { __syncthreads(); memattn_load(p, g * BG + bl, h, lds); last = bh; }
                    memattn_item(P, bl, h, it & 63, lds, dry);
                }
                __syncthreads();
            }
            xcd_barrier(xbar, xx, xst);
            {
                const Params p = fresh_params();
                const float2* twl = fft_lds_twiddles((const float2*)(p.ws + OFF_TW), lds);
                for (int it = bid; it < BG * 256; it += G) hyena_conv_item(p, (const float*)(p.ws + OFF_UT), (bf16_t*)(p.ws + OFF_GT), it >> 8, it & 255, lds, twl, dry);
                __syncthreads();
                gla_scan(p, dry);
            }
            xcd_barrier(xbar, xx, xst);
            {
                const Params p = fresh_params();
                for (int it = bid; it < NITEM; it += G) gla_part2_item(p, l, (bf16_t*)(p.ws + OFF_P), (const float*)(p.ws + OFF_LR), it, lds, dry);
            }
            {
                const Params p = fresh_params();
                for (int it = bid; it < BG * 128 * 8; it += G) hy_post_item((bf16_t*)(p.ws + OFF_P), (const bf16_t*)(p.ws + OFF_GT), it >> 10, (it >> 3) & 127, it & 7, lds, dry);
            }
            xcd_barrier(xbar, xx, xst);
            }
            {
                const Params p = fresh_params();
                const bf16_t* P = (const bf16_t*)(p.ws + OFF_P); const bf16_t* WtBr = (const bf16_t*)(p.ws + OFF_WTBR); bf16_t* merged = (bf16_t*)(p.ws + OFF_MERGED);
                for (int t = bid; t < 512; t += G) {
                    const int sr = t >> 8, sb = t & 255, sx = sb & 7, sk = sb >> 3;
                    const int m0 = (sr * 32 + (sk >> 3) * 8 + sx) * 256, n0 = (sk & 7) * 128;
                    merge_tile(P, WtBr, merged, m0, n0, lds);
                }
            }
            xcd_barrier(xbar, xx, xst);
            {
                const Params p = fresh_params();
                pg8::Gemm gm; gm.A = (const bf16_t*)(p.ws + OFF_MERGED); gm.Bt = (const bf16_t*)(p.ws + OFF_WTOUT); gm.M = TG; gm.N = 1024; gm.K = 1024;
                pg8::StaticOrder S; S.init(TG, 1024, G, bid);
                EpiOut E; E.pre = (float*)(p.ws + OFF_PRE); E.bo = p.b_out + l * 1024; E.x = p.x; E.stats = (const float2*)(p.ws + OFF_STATS); E.g0 = p.ln_in_g; E.b0 = p.ln_in_b; E.hres = p.out; E.tok0 = tok0; E.l = l;
                pg8::gemm_phase<EpiOut, pg8::StaticOrder, false>((PG8_LAS unsigned char*)lds, gm, S, E, nullptr);
                __syncthreads();
            }
            xcd_barrier(xbar, xx, xst);
            {
                const Params p = fresh_params();
                ln_rows((const float*)(p.ws + OFF_PRE), 0, TG, p.ln_g + l * 1024, p.ln_b + l * 1024, p.out, (bf16_t*)(p.ws + OFF_HB), tok0, nullptr);
            }
        }
        xcd_barrier(xbar, xx, xst);
    }
}

extern "C" void kernel_launch(void* const* d_in, const int* in_sizes, int n_in, void* d_out, int out_size, void* d_ws, size_t ws_size, hipStream_t stream) {
    static int grid_blocks = 0;
    if (!grid_blocks) {
        if (ws_size < WS_END) { fprintf(stderr, "kernel_launch: workspace too small: %zu < %zu\n", ws_size, (size_t)WS_END); grid_blocks = -1; return; }
        {
            const long long ex[26] = {67108864LL, 2097152LL, 1024, 1024, 2LL * 1024 * 10784, 2 * 10784, 2 * 8 * 15 * 31, 2 * 3 * 1536, 2 * 1536, 2 * 33 * 64, 2 * 64, 2 * 2 * 64 * 64, 2 * 2 * 64,
                                      2 * 64 * 1024, 2 * 512, 2 * 16 * 256, 2 * 256, 2 * 16 * 256, 2 * 256, 2 * 512, 2LL * 1024 * 1024, 2LL * 4 * 512 * 1024, 2LL * 1024 * 1024, 2 * 1024, 2 * 1024, 2 * 1024};
            bool bad = (n_in != 26) || (out_size != 67108864);
            for (int i = 0; i < 26 && !bad; ++i) if ((long long)in_sizes[i] != ex[i]) { fprintf(stderr, "kernel_launch: input %d has %d elements, expected %lld\n", i, in_sizes[i], ex[i]); bad = true; }
            if (bad) { fprintf(stderr, "kernel_launch: unexpected shapes; nothing launched\n"); grid_blocks = -1; return; }
        }
        int dev = 0, cus = 0, per_cu = 0;
        hipGetDevice(&dev);
        hipDeviceGetAttribute(&cus, hipDeviceAttributeMultiprocessorCount, dev);
        if (hipFuncSetAttribute((const void*)mega, hipFuncAttributeMaxDynamicSharedMemorySize, LDS_BYTES) != hipSuccess) fprintf(stderr, "kernel_launch: hipFuncSetAttribute failed\n");
        if (hipOccupancyMaxActiveBlocksPerMultiprocessor(&per_cu, (const void*)mega, NTHR, LDS_BYTES) != hipSuccess || per_cu < 1) { fprintf(stderr, "kernel_launch: occupancy query gave %d\n", per_cu); per_cu = 1; }
        (void)hipGetLastError();
        if (per_cu > 1) per_cu = 1;
        grid_blocks = cus * per_cu;
    }
    if (grid_blocks < 0) return;
    Params p{};
    const float** pp = (const float**)&p;
    for (int i = 0; i < 26; ++i) pp[i] = (const float*)d_in[i];
    p.out = (float*)d_out; p.ws = (unsigned char*)d_ws;
    if (hipMemsetAsync((unsigned char*)d_ws + OFF_BAR, 0, 16384, stream) != hipSuccess) fprintf(stderr, "kernel_launch: memset of the barrier word failed\n");
    void* args[] = {&p};
    hipError_t e = hipLaunchCooperativeKernel((const void*)mega, dim3(grid_blocks), dim3(NTHR), args, LDS_BYTES, stream);
    if (e != hipSuccess) fprintf(stderr, "cooperative launch failed: %s (grid %d)\n", hipGetErrorString(e), grid_blocks);
}
#endif
```

```cpp
#ifndef PROBE_REP_MIX
#define PROBE_REP_MIX 1
#endif
#ifndef PROBE_REP_INPROJ
#define PROBE_REP_INPROJ 1
#endif
#include <hip/hip_runtime.h>
#include <hip/hip_cooperative_groups.h>
#include <cstdio>
#include <unistd.h>
#include <cmath>
namespace cg = cooperative_groups;

#define HD __host__ __device__
typedef unsigned short bf16_t;
typedef short bf16x8 __attribute__((ext_vector_type(8)));
typedef float f32x4 __attribute__((ext_vector_type(4)));
typedef unsigned u32x2 __attribute__((ext_vector_type(2)));
typedef unsigned u32x4 __attribute__((ext_vector_type(4)));

constexpr int NTOK = 65536, DM = 1024, SEQ = 8192, NB = 8;
constexpr int BG = 2;
constexpr int NGRP = NB / BG;
constexpr int TG = BG * SEQ;
constexpr int PS = 10752;
constexpr int NIN = 10784, NINP = 11008;
constexpr int C_NAQ = 0, C_NAK = 512, C_NAV = 1024, C_HY = 1536, C_GQ = 3072, C_GK = 3328, C_GV = 3584, C_MQ = 4096, C_Z = 4608, C_SG = 6656, C_LR = 10752;
constexpr int FN = 16384;
constexpr int NITEM = BG * 128 * 4;
constexpr int LDS_BYTES = 160 * 1024;
constexpr int NTHR = 512;
constexpr float DN_ALPHA = 1.41421356237309515f;

constexpr size_t al256(size_t x) { return (x + 255) & ~(size_t)255; }
constexpr size_t OFF_HB = 0;
constexpr size_t OFF_STATS = OFF_HB + (size_t)NTOK * DM * 2;
constexpr size_t OFF_TW = OFF_STATS + (size_t)NTOK * 8;
constexpr size_t OFF_MEMBF = OFF_TW + (size_t)FN * 8;
constexpr size_t OFF_ENERGY = OFF_MEMBF + (size_t)2048 * 1024 * 2;
constexpr size_t OFF_WTIN = OFF_ENERGY + 4096;
constexpr size_t OFF_WTBR = OFF_WTIN + (size_t)NINP * 1024 * 2;
constexpr size_t OFF_WTOUT = OFF_WTBR + (size_t)4 * 1024 * 512 * 2;
constexpr size_t OFF_WTKV = OFF_WTOUT + (size_t)1024 * 1024 * 2;
constexpr size_t OFF_KMAT = OFF_WTKV + (size_t)2048 * 1024 * 2;
constexpr size_t OFF_VT = OFF_KMAT + (size_t)2048 * 1024 * 2;
constexpr size_t OFF_HFILT = OFF_VT + (size_t)2048 * 1024 * 2;
constexpr size_t OFF_PQ = OFF_HFILT + (size_t)1024 * 8192 * 4;
constexpr size_t OFF_P = OFF_PQ + (size_t)256 * FN * 16;
constexpr size_t OFF_LR = OFF_P + (size_t)TG * PS * 2;
constexpr size_t OFF_GS = OFF_LR + (size_t)TG * 32 * 4;
constexpr size_t OFF_GDEC = OFF_GS + (size_t)2 * NITEM * 8192 * 4;
constexpr size_t OFF_MERGED = OFF_GDEC + (size_t)2 * NITEM * 64 * 4;
constexpr size_t OFF_PRE = OFF_MERGED + (size_t)TG * 1024 * 2;
constexpr size_t OFF_UT = OFF_PRE + (size_t)TG * 1024 * 4;
constexpr size_t OFF_GT = OFF_UT + (size_t)BG * 512 * 8192 * 4;
constexpr size_t OFF_BAR = OFF_GT + (size_t)BG * 512 * 8192 * 2;
constexpr size_t OFF_ZT = OFF_BAR + 16384;
constexpr size_t WS_END = OFF_ZT + (size_t)8192 * 33 * 4;

struct Params {
    const float *x, *mem, *ln_in_g, *ln_in_b, *w_in, *b_in, *na_rpb, *hy_conv_w, *hy_conv_b, *hy_w1, *hy_b1, *hy_wm, *hy_bm, *hy_w3, *hy_skip,
        *gla_up_f, *gla_bias_f, *gla_up_b, *gla_bias_b, *gla_norm_g, *mem_w_kv, *w_br, *w_out, *b_out, *ln_g, *ln_b;
    float* out;
    unsigned char* ws;
};

HD inline float bf2f(bf16_t b) {
    union { unsigned u; float f; } c; c.u = (unsigned)b << 16; return c.f;
}
HD inline bf16_t f2bf(float f) {
    union { unsigned u; float f; } c; c.f = f; unsigned u = c.u; u += 0x7fffu + ((u >> 16) & 1u); return (bf16_t)(u >> 16);
}
typedef float f32x2_t __attribute__((ext_vector_type(2)));
typedef __bf16 bf16x2_t __attribute__((ext_vector_type(2)));
__device__ __forceinline__ unsigned pk2(float lo, float hi) { const f32x2_t v = {lo, hi}; const bf16x2_t b = __builtin_convertvector(v, bf16x2_t); return __builtin_bit_cast(unsigned, b); }
__device__ __forceinline__ bf16_t f2bf_d(float f) { return (bf16_t)(pk2(f, f) & 0xffffu); }
__device__ __forceinline__ float lo16(unsigned u) { return __uint_as_float(u << 16); }
__device__ __forceinline__ float hi16(unsigned u) { return __uint_as_float(u & 0xffff0000u); }
__device__ __forceinline__ float wave_sum(float v) {
#pragma unroll
    for (int o = 32; o >= 1; o >>= 1) v += __shfl_xor(v, o);
    return v;
}
__device__ __forceinline__ float sigmoidf_(float x) { return __builtin_amdgcn_rcpf(1.0f + __expf(-x)); }
__device__ __forceinline__ float siluf_(float x) { return x * __builtin_amdgcn_rcpf(1.0f + __expf(-x)); }
__device__ __forceinline__ float logsigf_(float x) { return fminf(x, 0.0f) - __logf(1.0f + __expf(-fabsf(x))); }
__device__ __forceinline__ bf16x8 mkfrag(u32x4 v) { return __builtin_bit_cast(bf16x8, v); }
__device__ __forceinline__ bf16x8 mkfrag2(u32x2 a, u32x2 b) { u32x4 v = {a.x, a.y, b.x, b.y}; return __builtin_bit_cast(bf16x8, v); }
#define MFMA(a, b, c) __builtin_amdgcn_mfma_f32_16x16x32_bf16((a), (b), (c), 0, 0, 0)
HD inline int iclamp(int v, int lo, int hi) { return v < lo ? lo : (v > hi ? hi : v); }

HD inline float2 cmulf(float2 a, float2 b) { float2 r; r.x = a.x * b.x - a.y * b.y; r.y = a.x * b.y + a.y * b.x; return r; }
HD inline float2 cmulcf(float2 a, float2 b) { float2 r; r.x = a.x * b.x + a.y * b.y; r.y = a.y * b.x - a.x * b.y; return r; }
struct Bfly { float2 x0, x1, x2, x3, W1; int i0; };
HD inline void bfly_load(Bfly& b, const float2* d, const float2* tw, int lgm, int q) {
    const int m = 1 << lgm, blk = q >> lgm, j = q & (m - 1);
    b.i0 = (blk << (lgm + 2)) + j;
    b.W1 = tw[j];
    b.x0 = d[b.i0]; b.x1 = d[b.i0 + m]; b.x2 = d[b.i0 + 2 * m]; b.x3 = d[b.i0 + 3 * m];
}
HD inline void bfly_fwd_store(const Bfly& b, float2* d, int lgm) {
    const int m = 1 << lgm, i0 = b.i0;
    const float2 W1 = b.W1, W2 = cmulf(W1, W1);
    const float2 x0 = b.x0, x1 = b.x1, x2 = b.x2, x3 = b.x3;
    float2 a0, a1, a2, a3, t;
    a0.x = x0.x + x2.x; a0.y = x0.y + x2.y;
    t.x = x0.x - x2.x; t.y = x0.y - x2.y; a2 = cmulf(t, W1);
    a1.x = x1.x + x3.x; a1.y = x1.y + x3.y;
    t.x = x1.x - x3.x; t.y = x1.y - x3.y; t = cmulf(t, W1); a3.x = t.y; a3.y = -t.x;
    float2 r;
    r.x = a0.x + a1.x; r.y = a0.y + a1.y; d[i0] = r;
    t.x = a0.x - a1.x; t.y = a0.y - a1.y; d[i0 + m] = cmulf(t, W2);
    r.x = a2.x + a3.x; r.y = a2.y + a3.y; d[i0 + 2 * m] = r;
    t.x = a2.x - a3.x; t.y = a2.y - a3.y; d[i0 + 3 * m] = cmulf(t, W2);
}
HD inline void bfly_inv_store(const Bfly& b, float2* d, int lgm) {
    const int m = 1 << lgm, i0 = b.i0;
    const float2 W1 = b.W1, W2 = cmulf(W1, W1);
    const float2 x0 = b.x0, x1 = b.x1, x2 = b.x2, x3 = b.x3;
    const float2 b1 = cmulcf(x1, W2), b3 = cmulcf(x3, W2);
    float2 y0, y1, y2, y3;
    y0.x = x0.x + b1.x; y0.y = x0.y + b1.y; y1.x = x0.x - b1.x; y1.y = x0.y - b1.y;
    y2.x = x2.x + b3.x; y2.y = x2.y + b3.y; y3.x = x2.x - b3.x; y3.y = x2.y - b3.y;
    const float2 c2 = cmulcf(y2, W1); float2 c3 = cmulcf(y3, W1); { const float tx = -c3.y, ty = c3.x; c3.x = tx; c3.y = ty; }
    float2 r;
    r.x = y0.x + c2.x; r.y = y0.y + c2.y; d[i0] = r;
    r.x = y0.x - c2.x; r.y = y0.y - c2.y; d[i0 + 2 * m] = r;
    r.x = y1.x + c3.x; r.y = y1.y + c3.y; d[i0 + m] = r;
    r.x = y1.x - c3.x; r.y = y1.y - c3.y; d[i0 + 3 * m] = r;
}
HD inline void fft_fwd_bfly(float2* d, const float2* tw, int lgm, int q) { Bfly b; bfly_load(b, d, tw, lgm, q); bfly_fwd_store(b, d, lgm); }
HD inline void fft_inv_bfly(float2* d, const float2* tw, int lgm, int q) { Bfly b; bfly_load(b, d, tw, lgm, q); bfly_inv_store(b, d, lgm); }
HD inline void r4_fwd(float2& x0, float2& x1, float2& x2, float2& x3, const float2 W1) {
    const float2 W2 = cmulf(W1, W1);
    float2 a0, a1, a2, a3, t;
    a0.x = x0.x + x2.x; a0.y = x0.y + x2.y;
    t.x = x0.x - x2.x; t.y = x0.y - x2.y; a2 = cmulf(t, W1);
    a1.x = x1.x + x3.x; a1.y = x1.y + x3.y;
    t.x = x1.x - x3.x; t.y = x1.y - x3.y; t = cmulf(t, W1); a3.x = t.y; a3.y = -t.x;
    x0.x = a0.x + a1.x; x0.y = a0.y + a1.y;
    t.x = a0.x - a1.x; t.y = a0.y - a1.y; x1 = cmulf(t, W2);
    x2.x = a2.x + a3.x; x2.y = a2.y + a3.y;
    t.x = a2.x - a3.x; t.y = a2.y - a3.y; x3 = cmulf(t, W2);
}
HD inline void r4_inv(float2& x0, float2& x1, float2& x2, float2& x3, const float2 W1) {
    const float2 W2 = cmulf(W1, W1);
    const float2 b1 = cmulcf(x1, W2), b3 = cmulcf(x3, W2);
    float2 y0, y1, y2, y3;
    y0.x = x0.x + b1.x; y0.y = x0.y + b1.y; y1.x = x0.x - b1.x; y1.y = x0.y - b1.y;
    y2.x = x2.x + b3.x; y2.y = x2.y + b3.y; y3.x = x2.x - b3.x; y3.y = x2.y - b3.y;
    const float2 c2 = cmulcf(y2, W1); float2 c3 = cmulcf(y3, W1); { const float tx = -c3.y, ty = c3.x; c3.x = tx; c3.y = ty; }
    x0.x = y0.x + c2.x; x0.y = y0.y + c2.y; x2.x = y0.x - c2.x; x2.y = y0.y - c2.y;
    x1.x = y1.x + c3.x; x1.y = y1.y + c3.y; x3.x = y1.x - c3.x; x3.y = y1.y - c3.y;
}
template <bool INV, bool HALF>
HD inline void r16_bfly(float2* d, const float2* twO, const float2* twI, int lgm, int q) {
    const int m = 1 << lgm, blk = q >> lgm, j = q & (m - 1), base = (blk << (lgm + 4)) + j;
    float2 e[4][4];
#pragma unroll
    for (int a = 0; a < 4; ++a)
#pragma unroll
        for (int b = 0; b < 4; ++b) {
            if (!INV && HALF && a >= 2) { e[a][b].x = 0.f; e[a][b].y = 0.f; }
            else e[a][b] = d[base + ((4 * a + b) << lgm)];
        }
    const float2 wI = twI[j];
    float2 wO[4];
#pragma unroll
    for (int b = 0; b < 4; ++b) wO[b] = twO[j + (b << lgm)];
    if (!INV) {
#pragma unroll
        for (int b = 0; b < 4; ++b) r4_fwd(e[0][b], e[1][b], e[2][b], e[3][b], wO[b]);
#pragma unroll
        for (int a = 0; a < 4; ++a) r4_fwd(e[a][0], e[a][1], e[a][2], e[a][3], wI);
    } else {
#pragma unroll
        for (int a = 0; a < 4; ++a) r4_inv(e[a][0], e[a][1], e[a][2], e[a][3], wI);
#pragma unroll
        for (int b = 0; b < 4; ++b) r4_inv(e[0][b], e[1][b], e[2][b], e[3][b], wO[b]);
    }
#pragma unroll
    for (int a = 0; a < 4; ++a)
#pragma unroll
        for (int b = 0; b < 4; ++b)
            if (!(INV && HALF && a >= 2)) d[base + ((4 * a + b) << lgm)] = e[a][b];
}
HD inline int brev14(int k) {
#if defined(__HIP_DEVICE_COMPILE__)
    return (int)(__brev((unsigned)k) >> 18);
#endif
    unsigned v = (unsigned)k;
    v = ((v >> 1) & 0x55555555u) | ((v & 0x55555555u) << 1);
    v = ((v >> 2) & 0x33333333u) | ((v & 0x33333333u) << 2);
    v = ((v >> 4) & 0x0f0f0f0fu) | ((v & 0x0f0f0f0fu) << 4);
    v = ((v >> 8) & 0x00ff00ffu) | ((v & 0x00ff00ffu) << 8);
    v = (v >> 16) | (v << 16);
    return (int)(v >> 18);
}
struct PwIn { float2 Z1, Z2; float4 A, B; int p1, p2; };
HD inline void pw_load(PwIn& w, const float2* d, const float4* pq, int p1) {
    const int kf = brev14(p1), k2 = (FN - kf) & (FN - 1); w.p1 = p1; w.p2 = brev14(k2);
    w.Z1 = d[w.p1]; w.Z2 = d[w.p2]; w.A = pq[w.p1]; w.B.x = w.A.x; w.B.y = -w.A.y; w.B.z = w.A.z; w.B.w = -w.A.w;
}
HD inline void pw_store(const PwIn& w, float2* d) {
    const float2 Z1 = w.Z1, Z2 = w.Z2;
    float2 P1, Q1, P2, Q2; P1.x = w.A.x; P1.y = w.A.y; Q1.x = w.A.z; Q1.y = w.A.w; P2.x = w.B.x; P2.y = w.B.y; Q2.x = w.B.z; Q2.y = w.B.w;
    float2 c1, c2; c1.x = Z1.x; c1.y = -Z1.y; c2.x = Z2.x; c2.y = -Z2.y;
    const float2 a = cmulf(Z1, P1), b = cmulf(c2, Q1), c = cmulf(Z2, P2), e = cmulf(c1, Q2);
    float2 w1, w2; w1.x = a.x + b.x; w1.y = a.y + b.y; w2.x = c.x + e.x; w2.y = c.y + e.y;
    d[w.p1] = w1;
    if (w.p2 != w.p1) d[w.p2] = w2;
}
HD inline void conv_pointwise(float2* d, const float4* pq, int p1) { PwIn w; pw_load(w, d, pq, p1); pw_store(w, d); }
HD inline void filt_pointwise(const float2* d, float4* pq, int p1) {
    const int kf = brev14(p1), k2 = (FN - kf) & (FN - 1), p2 = brev14(k2);
    const float2 Z1 = d[p1], Z2 = d[p2];
    const float gcx = 0.5f * (Z1.x + Z2.x), gcy = 0.5f * (Z1.y - Z2.y);
    const float gdx = 0.5f * (Z1.y + Z2.y), gdy = -0.5f * (Z1.x - Z2.x);
    const float s = 0.5f / (float)FN;
    float4 A; A.x = s * (gcx + gdx); A.y = s * (gcy + gdy); A.z = s * (gcx - gdx); A.w = s * (gcy - gdy);
    pq[p1] = A;
}
HD inline int tw_off(int lgm) { return lgm == 10 ? 0 : lgm == 8 ? 1024 : lgm == 6 ? 1280 : lgm == 4 ? 1344 : lgm == 2 ? 1360 : 1364; }
#ifndef FFT_HOST_TEST
template <int LGM, bool INV>
__device__ __forceinline__ void fft_pass(float2* d, const float2* twl, const float2* twg, int tid) {
    const float2* tw = (LGM == 12) ? twg : twl + tw_off(LGM);
#pragma unroll
    for (int it = 0; it < 2; ++it) {
        const int q = tid + it * 4 * NTHR;
        Bfly b0, b1, b2, b3;
        bfly_load(b0, d, tw, LGM, q); bfly_load(b1, d, tw, LGM, q + NTHR); bfly_load(b2, d, tw, LGM, q + 2 * NTHR); bfly_load(b3, d, tw, LGM, q + 3 * NTHR);
        if (INV) { bfly_inv_store(b0, d, LGM); bfly_inv_store(b1, d, LGM); bfly_inv_store(b2, d, LGM); bfly_inv_store(b3, d, LGM); }
        else { bfly_fwd_store(b0, d, LGM); bfly_fwd_store(b1, d, LGM); bfly_fwd_store(b2, d, LGM); bfly_fwd_store(b3, d, LGM); }
    }
    __syncthreads();
}
template <int LGM, bool INV, bool HALF>
__device__ __forceinline__ void fft_pass16(float2* d, const float2* twl, const float2* twg, int tid) {
    const float2* twO = (LGM + 2 == 12) ? twg : twl + tw_off(LGM + 2);
    const float2* twI = twl + tw_off(LGM);
    r16_bfly<INV, HALF>(d, twO, twI, LGM, tid);
    r16_bfly<INV, HALF>(d, twO, twI, LGM, tid + NTHR);
    __syncthreads();
}
template <bool HALF>
__device__ __forceinline__ void fft_forward(float2* d, const float2* twl, const float2* twg) {
    int tid = threadIdx.x; asm volatile("" : "+v"(tid));
    fft_pass16<10, false, HALF>(d, twl, twg, tid); fft_pass16<6, false, false>(d, twl, twg, tid);
    fft_pass<4, false>(d, twl, twg, tid); fft_pass<2, false>(d, twl, twg, tid); fft_pass<0, false>(d, twl, twg, tid);
}
template <bool HALF>
__device__ __forceinline__ void fft_inverse(float2* d, const float2* twl, const float2* twg) {
    int tid = threadIdx.x; asm volatile("" : "+v"(tid));
    fft_pass<0, true>(d, twl, twg, tid); fft_pass<2, true>(d, twl, twg, tid); fft_pass<4, true>(d, twl, twg, tid);
    fft_pass16<6, true, false>(d, twl, twg, tid); fft_pass16<10, true, HALF>(d, twl, twg, tid);
}
__device__ __forceinline__ float2* fft_lds_twiddles(const float2* twg, unsigned char* lds) {
    int tid = threadIdx.x; asm volatile("" : "+v"(tid));
    float2* t = (float2*)(lds + 131072);
    for (int k = tid; k < 1365; k += NTHR) {
        const int lgm = k < 1024 ? 10 : k < 1280 ? 8 : k < 1344 ? 6 : k < 1360 ? 4 : k < 1364 ? 2 : 0;
        t[k] = twg[(k - tw_off(lgm)) << (12 - lgm)];
    }
    __syncthreads();
    return t;
}

constexpr int STG = 49152;
__device__ __forceinline__ int swz(int row, int ch) { return row * 128 + ((ch ^ ((row >> 1) & 7)) << 4); }
__device__ __forceinline__ void gemm_core(f32x4 (&acc)[4][4], const bf16_t* A, int lda, const bf16_t* Bt, int ldb, int K, unsigned char* lds) {
    int tid_ = threadIdx.x; asm volatile("" : "+v"(tid_)); const int tid = tid_, lane = tid & 63, w = tid >> 6, wm = w & 3, wn = w >> 2, l15 = lane & 15, q4 = lane >> 4;
    const int wu = __builtin_amdgcn_readfirstlane(w);
    __attribute__((address_space(3))) unsigned char* l3 = (__attribute__((address_space(3))) unsigned char*)lds;
#pragma unroll
    for (int mi = 0; mi < 4; ++mi)
#pragma unroll
        for (int ni = 0; ni < 4; ++ni) acc[mi][ni] = (f32x4){0.f, 0.f, 0.f, 0.f};
    const int r8 = lane >> 3, sch = (lane & 7) ^ ((((w & 1) << 2) + (r8 >> 1)) & 7);
    const bf16_t* ap = A + (size_t)(w * 8 + r8) * lda + sch * 8;
    const bf16_t* bp = Bt + (size_t)(w * 8 + r8) * ldb + sch * 8;
#define GC_STAGE(buf, k0)                                                                                                                         \
    {                                                                                                                                             \
        _Pragma("unroll") for (int i = 0; i < 4; ++i)                                                                                             \
            __builtin_amdgcn_global_load_lds((const unsigned*)(ap + (size_t)(64 * i) * lda + (k0)), (__attribute__((address_space(3))) unsigned*)(l3 + (buf) * STG + (wu + 8 * i) * 1024), 16, 0, 0);          \
        _Pragma("unroll") for (int i = 0; i < 2; ++i)                                                                                             \
            __builtin_amdgcn_global_load_lds((const unsigned*)(bp + (size_t)(64 * i) * ldb + (k0)), (__attribute__((address_space(3))) unsigned*)(l3 + (buf) * STG + 32768 + (wu + 8 * i) * 1024), 16, 0, 0);  \
    }
    GC_STAGE(0, 0)
    asm volatile("s_waitcnt vmcnt(0)" ::: "memory");
    __syncthreads();
    const int nk = K >> 6;
    for (int kt = 0; kt < nk; ++kt) {
        if (kt + 1 < nk) GC_STAGE((kt + 1) & 1, (kt + 1) << 6)
        const unsigned char* sa = lds + (kt & 1) * STG;
        const unsigned char* sb = sa + 32768;
#pragma unroll
        for (int ks = 0; ks < 2; ++ks) {
            bf16x8 af[4], bfr[4];
#pragma unroll
            for (int mi = 0; mi < 4; ++mi) af[mi] = *(const bf16x8*)(sa + swz(wm * 64 + mi * 16 + l15, ks * 4 + q4));
#pragma unroll
            for (int ni = 0; ni < 4; ++ni) bfr[ni] = *(const bf16x8*)(sb + swz(wn * 64 + ni * 16 + l15, ks * 4 + q4));
#pragma unroll
            for (int mi = 0; mi < 4; ++mi)
#pragma unroll
                for (int ni = 0; ni < 4; ++ni) acc[mi][ni] = MFMA(bfr[ni], af[mi], acc[mi][ni]);
        }
        asm volatile("s_waitcnt vmcnt(0)" ::: "memory");
        __syncthreads();
    }
#undef GC_STAGE
}
#define EPI_LOOP(body)                                                                                                  \
    {                                                                                                                   \
        int e_t = threadIdx.x; asm volatile("" : "+v"(e_t)); const int e_lane = e_t & 63, e_w = e_t >> 6;                                                    \
        _Pragma("unroll") for (int mi = 0; mi < 4; ++mi) _Pragma("unroll") for (int ni = 0; ni < 4; ++ni) {             \
            const int row = m0 + (e_w & 3) * 64 + mi * 16 + (e_lane & 15);                                              \
            const int col = n0 + (e_w >> 2) * 64 + ni * 16 + 4 * (e_lane >> 4);                                         \
            f32x4& v = acc[mi][ni];                                                                                     \
            body                                                                                                        \
        }                                                                                                               \
    }
__device__ __forceinline__ void st_bf4(bf16_t* dst, f32x4 v) {
    u32x2 o; o.x = pk2(v[0], v[1]); o.y = pk2(v[2], v[3]); *(u32x2*)dst = o;
}
__device__ __forceinline__ f32x4 ld_bf4(const bf16_t* src) {
    const u32x2 u = *(const u32x2*)src; f32x4 r = {lo16(u.x), hi16(u.x), lo16(u.y), hi16(u.y)}; return r;
}


__device__ __forceinline__ void merge_tile(const bf16_t* P, const bf16_t* WtBr, bf16_t* merged, int m0, int n0, unsigned char* lds) {
    int tid_ = threadIdx.x; asm volatile("" : "+v"(tid_)); const int tid = tid_, lane = tid & 63, w = tid >> 6, wm = w & 3, wn = w >> 2, l15 = lane & 15, q4 = lane >> 4;
    const int wu = __builtin_amdgcn_readfirstlane(w);
    __attribute__((address_space(3))) unsigned char* l3 = (__attribute__((address_space(3))) unsigned char*)lds;
    f32x4 acc[4][4], macc[4][4];
#pragma unroll
    for (int mi = 0; mi < 4; ++mi)
#pragma unroll
        for (int ni = 0; ni < 4; ++ni) { acc[mi][ni] = (f32x4){0.f, 0.f, 0.f, 0.f}; macc[mi][ni] = (f32x4){0.f, 0.f, 0.f, 0.f}; }
    const int r8 = lane >> 3, sch = (lane & 7) ^ ((((w & 1) << 2) + (r8 >> 1)) & 7);
    const bf16_t* ap = P + (size_t)(m0 + w * 8 + r8) * PS + sch * 8;
    const bf16_t* bp = WtBr + (size_t)(n0 + w * 8 + r8) * 512 + sch * 8;
    const bf16_t* sgp = P + (size_t)(m0 + wm * 64 + l15) * PS + C_SG + n0 + wn * 64 + 4 * q4;
#define MG_STAGE(buf, kt_)                                                                                                                        \
    {                                                                                                                                             \
        const int j_ = (kt_) >> 3, k0_ = ((kt_) & 7) << 6;                                                                                        \
        const int acol_ = (j_ == 0) ? C_NAQ : (j_ == 1) ? C_HY : (j_ == 2) ? C_GV : C_MQ;                                                        \
        _Pragma("unroll") for (int i = 0; i < 4; ++i)                                                                                             \
            __builtin_amdgcn_global_load_lds((const unsigned*)(ap + (size_t)(64 * i) * PS + acol_ + k0_), (__attribute__((address_space(3))) unsigned*)(l3 + (buf) * STG + (wu + 8 * i) * 1024), 16, 0, 0);      \
        _Pragma("unroll") for (int i = 0; i < 2; ++i)                                                                                             \
            __builtin_amdgcn_global_load_lds((const unsigned*)(bp + (size_t)j_ * 1024 * 512 + (size_t)(64 * i) * 512 + k0_), (__attribute__((address_space(3))) unsigned*)(l3 + (buf) * STG + 32768 + (wu + 8 * i) * 1024), 16, 0, 0);  \
    }
    MG_STAGE(0, 0)
    MG_STAGE(1, 1)
    asm volatile("s_waitcnt vmcnt(6)" ::: "memory");
    __builtin_amdgcn_s_barrier(); asm volatile("" ::: "memory");
    int cb = 0;
#pragma unroll 1
    for (int kt = 0; kt < 32; ++kt) {
        const bool last = (kt & 7) == 7;
        u32x2 sg[4][4];
        if (last) {
            const bf16_t* sp = sgp + 1024 * (kt >> 3);
#pragma unroll
            for (int mi = 0; mi < 4; ++mi)
#pragma unroll
                for (int ni = 0; ni < 4; ++ni) sg[mi][ni] = *(const u32x2*)(sp + (size_t)(mi * 16) * PS + ni * 16);
        }
        const int nb = (cb == 0) ? 2 : cb - 1;
        if (kt + 2 < 32) MG_STAGE(nb, kt + 2)
        const unsigned char* sa = lds + cb * STG;
        const unsigned char* sb = sa + 32768;
#pragma unroll
        for (int ks = 0; ks < 2; ++ks) {
            bf16x8 af[4], bfr[4];
#pragma unroll
            for (int mi = 0; mi < 4; ++mi) af[mi] = *(const bf16x8*)(sa + swz(wm * 64 + mi * 16 + l15, ks * 4 + q4));
#pragma unroll
            for (int ni = 0; ni < 4; ++ni) bfr[ni] = *(const bf16x8*)(sb + swz(wn * 64 + ni * 16 + l15, ks * 4 + q4));
            __builtin_amdgcn_s_setprio(1);
#pragma unroll
            for (int mi = 0; mi < 4; ++mi)
#pragma unroll
                for (int ni = 0; ni < 4; ++ni) acc[mi][ni] = MFMA(bfr[ni], af[mi], acc[mi][ni]);
            __builtin_amdgcn_s_setprio(0);
        }
        if (kt + 2 < 32) asm volatile("s_waitcnt vmcnt(6)" ::: "memory"); else asm volatile("s_waitcnt vmcnt(0)" ::: "memory");
        if (last) {
#pragma unroll
            for (int mi = 0; mi < 4; ++mi)
#pragma unroll
                for (int ni = 0; ni < 4; ++ni) {
                    const u32x2 u = sg[mi][ni]; const f32x4 g4 = {lo16(u.x), hi16(u.x), lo16(u.y), hi16(u.y)};
                    macc[mi][ni] += g4 * acc[mi][ni]; acc[mi][ni] = (f32x4){0.f, 0.f, 0.f, 0.f};
                }
        }
        asm volatile("" ::: "memory"); __builtin_amdgcn_s_barrier(); asm volatile("" ::: "memory");
        cb = (cb == 2) ? 0 : cb + 1;
    }
#undef MG_STAGE
    __syncthreads();
#pragma unroll
    for (int mi = 0; mi < 4; ++mi)
#pragma unroll
        for (int ni = 0; ni < 4; ++ni) st_bf4(merged + (size_t)(m0 + wm * 64 + mi * 16 + l15) * 1024 + n0 + wn * 64 + ni * 16 + 4 * q4, macc[mi][ni]);
}

__device__ __forceinline__ int orig_col(int n) {
    if (n < 4096) return n;
    if (n < 4608) return n + 32;
    if (n < 6656) return n + 32;
    if (n < 10752) return n + 32;
    return n - 10752 + 4096;
}

__device__ __forceinline__ void ln_rows(const float* src, size_t src_row0, int nrows, const float* g, const float* b, float* dst32, bf16_t* dst16, size_t dst_row0, float2* stats) {
    int tid_ = threadIdx.x; asm volatile("" : "+v"(tid_));
    const int lane = tid_ & 63;
    const int gw = blockIdx.x * (NTHR / 64) + (tid_ >> 6), nw = gridDim.x * (NTHR / 64);
    for (int r = gw; r < nrows; r += nw) {
        const float4* xr = (const float4*)(src + (src_row0 + r) * 1024);
        float4 v[4]; float s = 0.f;
#pragma unroll
        for (int i = 0; i < 4; ++i) { v[i] = xr[lane + 64 * i]; s += (v[i].x + v[i].y) + (v[i].z + v[i].w); }
        s = wave_sum(s);
        const float mean = s * (1.0f / 1024.0f);
        float q = 0.f;
#pragma unroll
        for (int i = 0; i < 4; ++i) { const float a = v[i].x - mean, bb = v[i].y - mean, c = v[i].z - mean, d = v[i].w - mean; q += (a * a + bb * bb) + (c * c + d * d); }
        q = wave_sum(q);
        const float rstd = 1.0f / sqrtf(q * (1.0f / 1024.0f) + 1e-5f);
        if (stats && lane == 0) { float2 st; st.x = mean; st.y = rstd; stats[dst_row0 + r] = st; }
#pragma unroll
        for (int i = 0; i < 4; ++i) {
            const float4 g4 = ((const float4*)g)[lane + 64 * i], b4 = ((const float4*)b)[lane + 64 * i];
            float4 y; y.x = (v[i].x - mean) * rstd * g4.x + b4.x; y.y = (v[i].y - mean) * rstd * g4.y + b4.y; y.z = (v[i].z - mean) * rstd * g4.z + b4.z; y.w = (v[i].w - mean) * rstd * g4.w + b4.w;
            if (dst32) ((float4*)(dst32 + (dst_row0 + r) * 1024))[lane + 64 * i] = y;
            if (dst16) { u32x2 o; o.x = pk2(y.x, y.y); o.y = pk2(y.z, y.w); *(u32x2*)(dst16 + (dst_row0 + r) * 1024 + (lane + 64 * i) * 4) = o; }
        }
    }
}
__device__ __forceinline__ void phase0(const Params& p) {
    ln_rows(p.x, 0, NTOK, p.ln_in_g, p.ln_in_b, nullptr, (bf16_t*)(p.ws + OFF_HB), 0, (float2*)(p.ws + OFF_STATS));
    int tid_ = threadIdx.x; asm volatile("" : "+v"(tid_)); const int gt = blockIdx.x * NTHR + tid_, nt = gridDim.x * NTHR;
    float2* tw = (float2*)(p.ws + OFF_TW);
    for (int k = gt; k < FN; k += nt) { double s, c; sincospi(-2.0 * (double)k / (double)FN, &s, &c); float2 t; t.x = (float)c; t.y = (float)s; tw[k] = t; }
    bf16_t* mb = (bf16_t*)(p.ws + OFF_MEMBF);
    for (int i = gt; i < 2048 * 1024 / 4; i += nt) { const float4 v = ((const float4*)p.mem)[i]; u32x2 o; o.x = pk2(v.x, v.y); o.y = pk2(v.z, v.w); ((u32x2*)mb)[i] = o; }
    float* en = (float*)(p.ws + OFF_ENERGY);
    for (int i = gt; i < 1024; i += nt) en[i] = 0.f;
    float* ztab = (float*)(p.ws + OFF_ZT);
    for (int idx = gt; idx < 8192 * 33; idx += nt) {
        const int n = idx / 33, e = idx - n * 33;
        float v;
        if (e == 0) v = (float)n / 8191.0f;
        else {
            const int i = (e - 1) & 15;
            const double fr = 1e-4 + (double)i * ((15.0 - 1e-4) / 15.0);
            const double ang = (2.0 * 3.14159265358979323846 / 8192.0) * (double)n * fr;
            v = (e <= 16) ? (float)cos(ang) : (float)(-sin(ang));
        }
        ztab[idx] = v;
    }
}

__device__ __forceinline__ void wt_tile(const float* src, int src_ld, int k0, int on0, bf16_t* dst, int dst_ld, int dn0, bool zero, float* tile) {
    int tid_ = threadIdx.x; asm volatile("" : "+v"(tid_)); const int tid = tid_;
    if (!zero) {
#pragma unroll
        for (int i = 0; i < 2; ++i) {
            const int k = (tid >> 3) + 64 * i, c4 = (tid & 7) * 4;
            const float4 v = *(const float4*)(src + (size_t)(k0 + k) * src_ld + on0 + c4);
            float* t = tile + k * 33 + c4; t[0] = v.x; t[1] = v.y; t[2] = v.z; t[3] = v.w;
        }
    }
    __syncthreads();
    const int n = tid >> 4, kc = (tid & 15) * 8;
    float f[8];
#pragma unroll
    for (int e = 0; e < 8; ++e) f[e] = zero ? 0.f : tile[(kc + e) * 33 + n];
    u32x4 o; o.x = pk2(f[0], f[1]); o.y = pk2(f[2], f[3]); o.z = pk2(f[4], f[5]); o.w = pk2(f[6], f[7]);
    *(u32x4*)(dst + (size_t)(dn0 + n) * dst_ld + k0 + kc) = o;
    __syncthreads();
}
__device__ __forceinline__ void phase_weights(const Params& p, int l, unsigned char* lds) {
    float* tile = (float*)lds;
    for (int it = blockIdx.x; it < 3776; it += gridDim.x) {
        if (it < 2752) {
            const int nt = it >> 3, kt = it & 7, dn0 = nt * 32;
            wt_tile(p.w_in + (size_t)l * 1024 * NIN, NIN, kt * 128, orig_col(dn0), (bf16_t*)(p.ws + OFF_WTIN), 1024, dn0, dn0 >= NIN, tile);
        } else if (it < 3264) {
            const int r = it - 2752, j = r >> 7, nt = (r >> 2) & 31, kt = r & 3;
            wt_tile(p.w_br + (size_t)(l * 4 + j) * 512 * 1024, 1024, kt * 128, nt * 32, (bf16_t*)(p.ws + OFF_WTBR) + (size_t)j * 1024 * 512, 512, nt * 32, false, tile);
        } else if (it < 3520) {
            const int r = it - 3264, nt = r >> 3, kt = r & 7;
            wt_tile(p.w_out + (size_t)l * 1024 * 1024, 1024, kt * 128, nt * 32, (bf16_t*)(p.ws + OFF_WTOUT), 1024, nt * 32, false, tile);
        } else {
            const int r = it - 3520, nt = r >> 3, kt = r & 7;
            wt_tile(p.mem_w_kv + (size_t)l * 1024 * 1024, 1024, kt * 128, nt * 32, (bf16_t*)(p.ws + OFF_WTKV), 1024, nt * 32, false, tile);
        }
    }
}

__device__ __forceinline__ void phase_filter_gen(const Params& p, int l, unsigned char* lds) {
    float* zt = (float*)lds;
    float* ha = zt + 32 * 33;
    float* hbuf = ha + 32 * 64;
    int tid_ = threadIdx.x; asm volatile("" : "+v"(tid_)); const int tid = tid_;
    const float* w1 = p.hy_w1 + (size_t)l * 33 * 64; const float* b1 = p.hy_b1 + l * 64;
    const float* wm = p.hy_wm + (size_t)l * 2 * 64 * 64; const float* bm = p.hy_bm + l * 2 * 64;
    const float* w3 = p.hy_w3 + (size_t)l * 64 * 1024;
    float* hf = (float*)(p.ws + OFF_HFILT);
    float* en = (float*)(p.ws + OFF_ENERGY) + l * 512;
    const float* ztab = (const float*)(p.ws + OFF_ZT);
    for (int it = blockIdx.x; it < 256; it += gridDim.x) {
        const int n0 = it * 32;
        for (int idx = tid; idx < 32 * 33; idx += NTHR) zt[idx] = ztab[(size_t)n0 * 33 + idx];
        __syncthreads();
        for (int idx = tid; idx < 2048; idx += NTHR) {
            const int pos = idx >> 6, j = idx & 63; float s = b1[j];
            for (int e = 0; e < 33; ++e) s += zt[pos * 33 + e] * w1[e * 64 + j];
            ha[idx] = sinf(s);
        }
        __syncthreads();
        for (int idx = tid; idx < 2048; idx += NTHR) {
            const int pos = idx >> 6, j = idx & 63; float s = bm[j];
            for (int e = 0; e < 64; ++e) s += ha[pos * 64 + e] * wm[e * 64 + j];
            hbuf[idx] = sinf(s);
        }
        __syncthreads();
        for (int idx = tid; idx < 2048; idx += NTHR) {
            const int pos = idx >> 6, j = idx & 63; float s = bm[64 + j];
            for (int e = 0; e < 64; ++e) s += hbuf[pos * 64 + e] * wm[4096 + e * 64 + j];
            ha[idx] = sinf(s);
        }
        __syncthreads();
        {
            const int c = tid;
            float af[32], ab[32];
#pragma unroll
            for (int i = 0; i < 32; ++i) { af[i] = 0.f; ab[i] = 0.f; }
            for (int k = 0; k < 64; ++k) {
                const float wf = w3[k * 1024 + c], wb = w3[k * 1024 + 512 + c];
#pragma unroll
                for (int i = 0; i < 32; ++i) { const float h = ha[i * 64 + k]; af[i] += h * wf; ab[i] += h * wb; }
            }
            const float dmin = -3.0701134573253945f, dmax = -15.350567286626973f;
            const float delta = fabsf(dmin + (float)c * ((dmax - dmin) / 511.0f));
            float e = 0.f;
#pragma unroll
            for (int i = 0; i < 32; ++i) {
                const int n = n0 + i; const float t01 = (float)n / 8191.0f; const float win = expf(-t01 * delta);
                af[i] *= win; ab[i] *= win; e += af[i] * af[i]; if (n >= 1) e += ab[i] * ab[i];
            }
#pragma unroll
            for (int i = 0; i < 8; ++i) {
                float4 a; a.x = af[4 * i]; a.y = af[4 * i + 1]; a.z = af[4 * i + 2]; a.w = af[4 * i + 3];
                float4 b; b.x = ab[4 * i]; b.y = ab[4 * i + 1]; b.z = ab[4 * i + 2]; b.w = ab[4 * i + 3];
                *(float4*)(hf + (size_t)c * 8192 + n0 + 4 * i) = a;
                *(float4*)(hf + (size_t)(512 + c) * 8192 + n0 + 4 * i) = b;
            }
            atomicAdd(en + c, e);
        }
        __syncthreads();
    }
}

__device__ __forceinline__ void phase_filter_fft(const Params& p, int l, unsigned char* lds) {
    float2* d = (float2*)lds;
    const float2* tw = fft_lds_twiddles((const float2*)(p.ws + OFF_TW), lds);
    const float* hf = (const float*)(p.ws + OFF_HFILT);
    const float* en = (const float*)(p.ws + OFF_ENERGY) + l * 512;
    float4* pqa = (float4*)(p.ws + OFF_PQ);
    int tid_ = threadIdx.x; asm volatile("" : "+v"(tid_)); const int tid = tid_;
    for (int pr = blockIdx.x; pr < 256; pr += gridDim.x) {
        const int c0 = 2 * pr, c1 = c0 + 1;
        const float s0 = 1.0f / sqrtf(en[c0] + 1e-6f), s1 = 1.0f / sqrtf(en[c1] + 1e-6f);
        const float k0 = p.hy_skip[l * 512 + c0], k1 = p.hy_skip[l * 512 + c1];
        for (int n = tid; n < FN; n += NTHR) {
            float2 v;
            if (n < 8192) { v.x = hf[(size_t)c0 * 8192 + n] * s0; v.y = hf[(size_t)c1 * 8192 + n] * s1; if (n == 0) { v.x += k0; v.y += k1; } }
            else if (n == 8192) { v.x = 0.f; v.y = 0.f; }
            else { v.x = hf[(size_t)(512 + c0) * 8192 + (FN - n)] * s0; v.y = hf[(size_t)(512 + c1) * 8192 + (FN - n)] * s1; }
            d[n] = v;
        }
        __syncthreads();
        fft_forward<false>(d, tw, (const float2*)(p.ws + OFF_TW));
        for (int h = tid; h < FN / 2; h += NTHR) filt_pointwise(d, pqa + (size_t)pr * FN, 2 * h);
        if (tid == 0) filt_pointwise(d, pqa + (size_t)pr * FN, 1);
        __syncthreads();
    }
}

__device__ __forceinline__ void hy_pre_item(const Params& p, int l, const bf16_t* P, float* UT, bf16_t* GT, int bl, int tt, int ct, unsigned char* lds) {
    float* tU = (float*)lds;
    float* tG = tU + 64 * 65;
    int tid_ = threadIdx.x; asm volatile("" : "+v"(tid_)); const int tid = tid_;
    const int t = tid >> 3, cc = (tid & 7) * 8, c = ct * 64 + cc, tb = tt * 64 + t;
    const float* cw = p.hy_conv_w + (size_t)l * 3 * 1536; const float* cb = p.hy_conv_b + l * 1536;
    float av[8], a0[8], a1[8];
#pragma unroll
    for (int h = 0; h < 2; ++h) {
        const f32x4 bv = *(const f32x4*)(cb + c + 4 * h), b0 = *(const f32x4*)(cb + 512 + c + 4 * h), b1 = *(const f32x4*)(cb + 1024 + c + 4 * h);
#pragma unroll
        for (int e = 0; e < 4; ++e) { av[4 * h + e] = bv[e]; a0[4 * h + e] = b0[e]; a1[4 * h + e] = b1[e]; }
    }
#pragma unroll
    for (int j = 0; j < 3; ++j) {
        const int ts = tb + j - 1;
        if (ts >= 0 && ts < SEQ) {
            const bf16_t* row = P + (size_t)(bl * SEQ + ts) * PS + C_HY + c;
            const u32x4 rv = *(const u32x4*)row, r0 = *(const u32x4*)(row + 512), r1 = *(const u32x4*)(row + 1024);
#pragma unroll
            for (int h = 0; h < 2; ++h) {
                const f32x4 wv = *(const f32x4*)(cw + j * 1536 + c + 4 * h), w0 = *(const f32x4*)(cw + j * 1536 + 512 + c + 4 * h), w1 = *(const f32x4*)(cw + j * 1536 + 1024 + c + 4 * h);
#pragma unroll
                for (int e = 0; e < 4; ++e) {
                    const int k = 4 * h + e; const unsigned uv = rv[k >> 1], u0 = r0[k >> 1], u1 = r1[k >> 1];
                    av[k] += wv[e] * ((k & 1) ? hi16(uv) : lo16(uv)); a0[k] += w0[e] * ((k & 1) ? hi16(u0) : lo16(u0)); a1[k] += w1[e] * ((k & 1) ? hi16(u1) : lo16(u1));
                }
            }
        }
    }
    const u32x4 rz = *(const u32x4*)(P + (size_t)(bl * SEQ + tb) * PS + C_Z + 512 + c);
#pragma unroll
    for (int k = 0; k < 8; ++k) {
        const unsigned uz = rz[k >> 1]; const float z = (k & 1) ? hi16(uz) : lo16(uz);
        tU[(cc + k) * 65 + t] = av[k] * a1[k]; tG[(cc + k) * 65 + t] = a0[k] * z;
    }
    __syncthreads();
    const int c2 = tid >> 3, t8 = (tid & 7) * 8;
    const size_t o = (size_t)(bl * 512 + ct * 64 + c2) * SEQ + tt * 64 + t8;
    const float* su = tU + c2 * 65 + t8; const float* sg = tG + c2 * 65 + t8;
    f32x4 ua = {su[0], su[1], su[2], su[3]}, ub = {su[4], su[5], su[6], su[7]};
    *(f32x4*)(UT + o) = ua; *(f32x4*)(UT + o + 4) = ub;
    u32x4 g; g.x = pk2(sg[0], sg[1]); g.y = pk2(sg[2], sg[3]); g.z = pk2(sg[4], sg[5]); g.w = pk2(sg[6], sg[7]);
    *(u32x4*)(GT + o) = g;
    __syncthreads();
}
__device__ __forceinline__ void hy_post_item(bf16_t* P, const bf16_t* GT, int bl, int tt, int ct, unsigned char* lds, int dry = 0) {
    bf16_t* tl = (bf16_t*)lds;
    int tid_ = threadIdx.x; asm volatile("" : "+v"(tid_)); const int tid = tid_;
    const int c2 = tid >> 3, t8 = (tid & 7) * 8;
    const u32x4 v = *(const u32x4*)(GT + (size_t)(bl * 512 + ct * 64 + c2) * SEQ + tt * 64 + t8);
    bf16_t* d0 = tl + t8 * 72 + c2;
    d0[0 * 72] = (bf16_t)(v.x & 0xffffu); d0[1 * 72] = (bf16_t)(v.x >> 16); d0[2 * 72] = (bf16_t)(v.y & 0xffffu); d0[3 * 72] = (bf16_t)(v.y >> 16);
    d0[4 * 72] = (bf16_t)(v.z & 0xffffu); d0[5 * 72] = (bf16_t)(v.z >> 16); d0[6 * 72] = (bf16_t)(v.w & 0xffffu); d0[7 * 72] = (bf16_t)(v.w >> 16);
    __syncthreads();
    const int t = tid >> 3, cc = (tid & 7) * 8;
    const u32x4 ov = *(const u32x4*)(tl + t * 72 + cc);
    if (!dry) *(u32x4*)(P + (size_t)(bl * SEQ + tt * 64 + t) * PS + C_HY + ct * 64 + cc) = ov;
    __syncthreads();
}
__device__ __forceinline__ void hyena_conv_item(const Params& p, const float* UT, bf16_t* GT, int bl, int pr, unsigned char* lds, const float2* tw, int dry = 0) {
    float2* d = (float2*)lds;
    const float4* pq = (const float4*)(p.ws + OFF_PQ) + (size_t)pr * FN;
    int tid_ = threadIdx.x; asm volatile("" : "+v"(tid_)); const int tid = tid_;
    const float* u0 = UT + (size_t)(bl * 512 + 2 * pr) * SEQ; const float* u1 = u0 + SEQ;
    bf16_t* g0 = GT + (size_t)(bl * 512 + 2 * pr) * SEQ; bf16_t* g1 = g0 + SEQ;
    {
        float f0[16], f1[16];
#pragma unroll
        for (int i = 0; i < 16; ++i) { f0[i] = u0[tid + NTHR * i]; f1[i] = u1[tid + NTHR * i]; }
#pragma unroll
        for (int i = 0; i < 16; ++i) {
            float2 u; u.x = f0[i]; u.y = f1[i]; d[tid + NTHR * i] = u;
        }
    }
    __syncthreads();
    fft_forward<true>(d, tw, (const float2*)(p.ws + OFF_TW));
#pragma unroll 1
    for (int h = tid; h < FN / 2; h += 4 * NTHR) {
        PwIn w0, w1, w2, w3;
        pw_load(w0, d, pq, 2 * h); pw_load(w1, d, pq, 2 * (h + NTHR)); pw_load(w2, d, pq, 2 * (h + 2 * NTHR)); pw_load(w3, d, pq, 2 * (h + 3 * NTHR));
        pw_store(w0, d); pw_store(w1, d); pw_store(w2, d); pw_store(w3, d);
    }
    if (tid == 0) conv_pointwise(d, pq, 1);
    __syncthreads();
    fft_inverse<true>(d, tw, (const float2*)(p.ws + OFF_TW));
    {
        bf16_t a0[16], a1[16];
#pragma unroll
        for (int i = 0; i < 16; ++i) { a0[i] = g0[tid + NTHR * i]; a1[i] = g1[tid + NTHR * i]; }
#pragma unroll
        for (int i = 0; i < 16; ++i) {
            const int t = tid + NTHR * i;
            const float2 y = d[t];
            const bf16_t r0 = f2bf_d(y.x * bf2f(a0[i])), r1 = f2bf_d(y.y * bf2f(a1[i]));
            if (!dry) { g0[t] = r0; g1[t] = r1; }
        }
    }
    __syncthreads();
}

__device__ __forceinline__ void na_item(const Params& p, int l, bf16_t* P, int bl, int rp, int head, unsigned char* lds, int dry = 0) {
    bf16_t* Kimg = (bf16_t*)lds;
    bf16_t* VT = (bf16_t*)(lds + 82944);
    int tid_ = threadIdx.x; asm volatile("" : "+v"(tid_)); const int tid = tid_, lane = tid & 63, w = tid >> 6, l15 = lane & 15, q4 = lane >> 4;
    const int r0 = 2 * rp, rs0 = iclamp(r0 - 4, 0, 120);
#pragma unroll
    for (int i = 0; i < 9; ++i) {
        const int idx = tid + NTHR * i, key = idx >> 3, ch = idx & 7, grow = min(rs0 + (key >> 6), 127);
        const u32x4 kv = *(const u32x4*)(P + (size_t)(bl * SEQ + grow * 64 + (key & 63)) * PS + C_NAK + head * 64 + ch * 8);
        *(u32x4*)(Kimg + key * 72 + ch * 8) = kv;
    }
#pragma unroll
    for (int i = 0; i < 9; ++i) {
        const int idx = tid + NTHR * i, keyp = idx >> 2, chh = keyp >= 576 ? 1 : 0, key = keyp - chh * 576, ch = chh * 4 + (idx & 3), grow = min(rs0 + (key >> 6), 127);
        const u32x4 vv = *(const u32x4*)(P + (size_t)(bl * SEQ + grow * 64 + (key & 63)) * PS + C_NAV + head * 64 + ch * 8);
        bf16_t* vd = VT + (ch * 8) * 584 + key;
        vd[0 * 584] = (bf16_t)(vv.x & 0xffffu); vd[1 * 584] = (bf16_t)(vv.x >> 16);
        vd[2 * 584] = (bf16_t)(vv.y & 0xffffu); vd[3 * 584] = (bf16_t)(vv.y >> 16);
        vd[4 * 584] = (bf16_t)(vv.z & 0xffffu); vd[5 * 584] = (bf16_t)(vv.z >> 16);
        vd[6 * 584] = (bf16_t)(vv.w & 0xffffu); vd[7 * 584] = (bf16_t)(vv.w >> 16);
    }
    __syncthreads();
    const int rr = w >> 2, g = w & 3, r = r0 + rr, rs = iclamp(r - 4, 0, 120), lo = rs - rs0;
    const int cb = iclamp(16 * g - 8, 0, 32), c = 16 * g + l15, cs = iclamp(c - 8, 0, 48);
    bf16_t* qrow = P + (size_t)(bl * SEQ + r * 64 + c) * PS + head * 64;
    bf16x8 qf[2];
#pragma unroll
    for (int ks = 0; ks < 2; ++ks) qf[ks] = *(const bf16x8*)(qrow + ks * 32 + q4 * 8);
    f32x4 sc[16];
#pragma unroll
    for (int t = 0; t < 16; ++t) {
        const int kb = (lo + (t >> 1)) * 64 + cb + 16 * (t & 1);
        f32x4 a = {0.f, 0.f, 0.f, 0.f};
#pragma unroll
        for (int ks = 0; ks < 2; ++ks) { const bf16x8 kf = *(const bf16x8*)(Kimg + (kb + l15) * 72 + ks * 32 + q4 * 8); a = MFMA(kf, qf[ks], a); }
        sc[t] = a;
    }
    const float* rpb = p.na_rpb + (size_t)(l * 8 + head) * 15 * 31;
    float mx = -1e30f;
#pragma unroll
    for (int t = 0; t < 16; ++t) {
        const int drow = rs + (t >> 1) - r + 7;
#pragma unroll
        for (int e = 0; e < 4; ++e) {
            const int col = cb + 16 * (t & 1) + 4 * q4 + e;
            const bool ok = (col >= cs) && (col < cs + 16);
            const int dcol = ok ? (col - c + 15) : 0;
            const float v = ok ? (sc[t][e] + rpb[drow * 31 + dcol]) : -1e30f;
            sc[t][e] = v; mx = fmaxf(mx, v);
        }
    }
    mx = fmaxf(mx, __shfl_xor(mx, 16)); mx = fmaxf(mx, __shfl_xor(mx, 32));
    float sum = 0.f;
#pragma unroll
    for (int t = 0; t < 16; ++t)
#pragma unroll
        for (int e = 0; e < 4; ++e) { const float pe = __expf(sc[t][e] - mx); sc[t][e] = pe; sum += pe; }
    sum += __shfl_xor(sum, 16); sum += __shfl_xor(sum, 32);
    f32x4 o[4];
#pragma unroll
    for (int dt = 0; dt < 4; ++dt) o[dt] = (f32x4){0.f, 0.f, 0.f, 0.f};
#pragma unroll
    for (int kk = 0; kk < 8; ++kk) {
        u32x4 pu; pu.x = pk2(sc[2 * kk][0], sc[2 * kk][1]); pu.y = pk2(sc[2 * kk][2], sc[2 * kk][3]); pu.z = pk2(sc[2 * kk + 1][0], sc[2 * kk + 1][1]); pu.w = pk2(sc[2 * kk + 1][2], sc[2 * kk + 1][3]);
        const bf16x8 pf = mkfrag(pu);
        const int kbA = (lo + kk) * 64 + cb + 4 * q4;
#pragma unroll
        for (int dt = 0; dt < 4; ++dt) {
            const bf16_t* vr = VT + (dt * 16 + l15) * 584 + kbA;
            const bf16x8 vf = mkfrag2(*(const u32x2*)vr, *(const u32x2*)(vr + 16));
            o[dt] = MFMA(vf, pf, o[dt]);
        }
    }
    const float inv = 1.0f / sum;
    const bf16_t* zrow = P + (size_t)(bl * SEQ + r * 64 + c) * PS + C_Z + head * 64;
#pragma unroll
    for (int dt = 0; dt < 4; ++dt) {
        const int dd = dt * 16 + 4 * q4;
        const f32x4 z = ld_bf4(zrow + dd);
        if (!dry) st_bf4(qrow + dd, o[dt] * inv * z);
    }
    __syncthreads();
}

__device__ __forceinline__ void memattn_load(const Params& p, int b, int h, unsigned char* lds) {
    bf16_t* Kimg = (bf16_t*)lds;
    bf16_t* VT = (bf16_t*)(lds + 69632);
    const bf16_t* Km = (const bf16_t*)(p.ws + OFF_KMAT); const bf16_t* Vm = (const bf16_t*)(p.ws + OFF_VT);
    int tid_ = threadIdx.x; asm volatile("" : "+v"(tid_)); const int tid = tid_;
#pragma unroll
    for (int i = 0; i < 8; ++i) {
        const int idx = tid + NTHR * i;
        { const int key = idx >> 4, ch = idx & 15; *(u32x4*)(Kimg + key * 136 + ch * 8) = *(const u32x4*)(Km + (size_t)(b * 256 + key) * 512 + h * 128 + ch * 8); }
        { const int dd = idx >> 5, ch = idx & 31; *(u32x4*)(VT + dd * 264 + ch * 8) = *(const u32x4*)(Vm + (size_t)(h * 128 + dd) * 2048 + b * 256 + ch * 8); }
    }
    __syncthreads();
}
__device__ __forceinline__ void memattn_item(bf16_t* P, int bl, int h, int qt, unsigned char* lds, int dry = 0) {
    const bf16_t* Kimg = (const bf16_t*)lds; const bf16_t* VT = (const bf16_t*)(lds + 69632);
    int tid_ = threadIdx.x; asm volatile("" : "+v"(tid_)); const int tid = tid_, lane = tid & 63, w = tid >> 6, l15 = lane & 15, q4 = lane >> 4;
    const int tok = bl * SEQ + qt * 128 + w * 16 + l15;
    bf16_t* qrow = P + (size_t)tok * PS + C_MQ + h * 128;
    bf16x8 qf[4];
#pragma unroll
    for (int ks = 0; ks < 4; ++ks) qf[ks] = *(const bf16x8*)(qrow + ks * 32 + q4 * 8);
    f32x4 sc[16];
    float mx = -1e30f;
#pragma unroll
    for (int t = 0; t < 16; ++t) {
        f32x4 a = {0.f, 0.f, 0.f, 0.f};
#pragma unroll
        for (int ks = 0; ks < 4; ++ks) { const bf16x8 kf = *(const bf16x8*)(Kimg + (t * 16 + l15) * 136 + ks * 32 + q4 * 8); a = MFMA(kf, qf[ks], a); }
        sc[t] = a;
        mx = fmaxf(mx, fmaxf(fmaxf(a[0], a[1]), fmaxf(a[2], a[3])));
    }
    mx = fmaxf(mx, __shfl_xor(mx, 16)); mx = fmaxf(mx, __shfl_xor(mx, 32));
    float sum = 0.f;
#pragma unroll
    for (int t = 0; t < 16; ++t)
#pragma unroll
        for (int e = 0; e < 4; ++e) { const float pe = __expf(sc[t][e] - mx); sc[t][e] = pe; sum += pe; }
    sum += __shfl_xor(sum, 16); sum += __shfl_xor(sum, 32);
    f32x4 o[8];
#pragma unroll
    for (int dt = 0; dt < 8; ++dt) o[dt] = (f32x4){0.f, 0.f, 0.f, 0.f};
#pragma unroll
    for (int kk = 0; kk < 8; ++kk) {
        u32x4 pu; pu.x = pk2(sc[2 * kk][0], sc[2 * kk][1]); pu.y = pk2(sc[2 * kk][2], sc[2 * kk][3]); pu.z = pk2(sc[2 * kk + 1][0], sc[2 * kk + 1][1]); pu.w = pk2(sc[2 * kk + 1][2], sc[2 * kk + 1][3]);
        const bf16x8 pf = mkfrag(pu);
#pragma unroll
        for (int dt = 0; dt < 8; ++dt) {
            const bf16_t* vr = VT + (dt * 16 + l15) * 264 + kk * 32 + 4 * q4;
            const bf16x8 vf = mkfrag2(*(const u32x2*)vr, *(const u32x2*)(vr + 16));
            o[dt] = MFMA(vf, pf, o[dt]);
        }
    }
    const float inv = 1.0f / sum;
    const bf16_t* zrow = P + (size_t)tok * PS + C_Z + 3 * 512 + h * 128;
#pragma unroll
    for (int dt = 0; dt < 8; ++dt) {
        const int dd = dt * 16 + 4 * q4;
        const f32x4 z = ld_bf4(zrow + dd);
        if (!dry) st_bf4(qrow + dd, o[dt] * inv * z);
    }
}

constexpr int G_LRT = 0, G_BF = 8192, G_BB = 24576, G_TOT = 40960, G_IMG = 45056;
__device__ __forceinline__ void gla_tables(const Params& p, int l, const float* LR, int t0, int h, unsigned char* lds) {
    float* LRT = (float*)(lds + G_LRT); float* BF = (float*)(lds + G_BF); float* BB = (float*)(lds + G_BB); float* TOT = (float*)(lds + G_TOT);
    int tid_ = threadIdx.x; asm volatile("" : "+v"(tid_)); const int tid = tid_;
    ((float4*)LRT)[tid] = ((const float4*)(LR + (size_t)t0 * 32))[tid];
    __syncthreads();
    const int dk = tid & 63, cgp = tid >> 6;
    float uf[16], ub[16];
#pragma unroll
    for (int r = 0; r < 16; ++r) { uf[r] = p.gla_up_f[(size_t)(l * 16 + r) * 256 + h * 64 + dk]; ub[r] = p.gla_up_b[(size_t)(l * 16 + r) * 256 + h * 64 + dk]; }
    const float bif = p.gla_bias_f[l * 256 + h * 64 + dk], bib = p.gla_bias_b[l * 256 + h * 64 + dk];
    float lf[8], lb[8];
#pragma unroll
    for (int i = 0; i < 8; ++i) {
        const int c = cgp * 8 + i; float sf = bif, sb = bib;
#pragma unroll
        for (int r = 0; r < 16; ++r) { sf += LRT[c * 32 + r] * uf[r]; sb += LRT[c * 32 + 16 + r] * ub[r]; }
        lf[i] = logsigf_(sf) * (1.0f / 16.0f); lb[i] = logsigf_(sb) * (1.0f / 16.0f);
    }
#pragma unroll
    for (int i = 1; i < 8; ++i) lf[i] += lf[i - 1];
#pragma unroll
    for (int i = 6; i >= 0; --i) lb[i] += lb[i + 1];
    TOT[cgp * 64 + dk] = lf[7]; TOT[512 + cgp * 64 + dk] = lb[0];
    __syncthreads();
    float of = 0.f, ob = 0.f;
#pragma unroll
    for (int g2 = 0; g2 < 8; ++g2) { if (g2 < cgp) of += TOT[g2 * 64 + dk]; if (g2 > cgp) ob += TOT[512 + g2 * 64 + dk]; }
#pragma unroll
    for (int i = 0; i < 8; ++i) { BF[(cgp * 8 + i) * 64 + dk] = lf[i] + of; BB[(cgp * 8 + i) * 64 + dk] = lb[i] + ob; }
    __syncthreads();
}
struct GlaPre { u32x4 vv[2]; bf16_t q[8], k[8]; };
__device__ __forceinline__ void gla_prefetch(GlaPre& g, const bf16_t* P, int t0, int h, int tid) {
#pragma unroll
    for (int i = 0; i < 2; ++i) { const int idx = tid + NTHR * i, chn = idx >> 6, c = idx & 63; g.vv[i] = *(const u32x4*)(P + (size_t)(t0 + c) * PS + C_GV + h * 128 + chn * 8); }
#pragma unroll
    for (int i = 0; i < 8; ++i) { const int idx = tid + NTHR * i, c = idx >> 6, dk = idx & 63; g.q[i] = P[(size_t)(t0 + c) * PS + C_GQ + h * 64 + dk]; g.k[i] = P[(size_t)(t0 + c) * PS + C_GK + h * 64 + dk]; }
}
__device__ __forceinline__ void gla_vt_store(const GlaPre& g, bf16_t* VT, int tid) {
#pragma unroll
    for (int i = 0; i < 2; ++i) {
        const int idx = tid + NTHR * i, chn = idx >> 6, c = idx & 63;
        const u32x4 vv = g.vv[i];
        bf16_t* vd = VT + (chn * 8) * 72 + c;
        vd[0 * 72] = (bf16_t)(vv.x & 0xffffu); vd[1 * 72] = (bf16_t)(vv.x >> 16);
        vd[2 * 72] = (bf16_t)(vv.y & 0xffffu); vd[3 * 72] = (bf16_t)(vv.y >> 16);
        vd[4 * 72] = (bf16_t)(vv.z & 0xffffu); vd[5 * 72] = (bf16_t)(vv.z >> 16);
        vd[6 * 72] = (bf16_t)(vv.w & 0xffffu); vd[7 * 72] = (bf16_t)(vv.w >> 16);
    }
}
__device__ __forceinline__ void gla_part1_item(const Params& p, int l, const bf16_t* P, const float* LR, int item, unsigned char* lds) {
    const int h = item & 3, n = (item >> 2) & 127, bl = item >> 9, t0 = bl * SEQ + n * 64;
    const float* BF = (const float*)(lds + G_BF); const float* BB = (const float*)(lds + G_BB);
    bf16_t* KDT0 = (bf16_t*)(lds + G_IMG); bf16_t* KDT1 = KDT0 + 64 * 72; bf16_t* VT = KDT1 + 64 * 72;
    float* GS = (float*)(p.ws + OFF_GS); float* GD = (float*)(p.ws + OFF_GDEC);
    int tid_ = threadIdx.x; asm volatile("" : "+v"(tid_)); const int tid = tid_, lane = tid & 63, w = tid >> 6, l15 = lane & 15, q4 = lane >> 4;
    GlaPre gp; gla_prefetch(gp, P, t0, h, tid);
    gla_tables(p, l, LR, t0, h, lds);
#pragma unroll
    for (int i = 0; i < 8; ++i) {
        const int idx = tid + NTHR * i, c = idx >> 6, dk = idx & 63;
        const float kv = bf2f(gp.k[i]);
        KDT0[dk * 72 + c] = f2bf_d(kv * __expf(BF[63 * 64 + dk] - BF[c * 64 + dk]));
        KDT1[dk * 72 + c] = f2bf_d(kv * __expf(BB[dk] - BB[c * 64 + dk]));
    }
    gla_vt_store(gp, VT, tid);
    if (tid < 64) GD[(size_t)item * 64 + tid] = __expf(BF[63 * 64 + tid]);
    else if (tid < 128) GD[(size_t)(NITEM + item) * 64 + tid - 64] = __expf(BB[tid - 64]);
    __syncthreads();
    const int dir = w >> 2, dkt = w & 3;
    const bf16_t* KD = dir ? KDT1 : KDT0;
    bf16x8 kf[2];
#pragma unroll
    for (int ks = 0; ks < 2; ++ks) kf[ks] = *(const bf16x8*)(KD + (16 * dkt + l15) * 72 + 32 * ks + 8 * q4);
    float* dst = GS + ((size_t)dir * NITEM + item) * 8192;
#pragma unroll
    for (int dvt = 0; dvt < 8; ++dvt) {
        f32x4 a = {0.f, 0.f, 0.f, 0.f};
#pragma unroll
        for (int ks = 0; ks < 2; ++ks) { const bf16x8 vf = *(const bf16x8*)(VT + (16 * dvt + l15) * 72 + 32 * ks + 8 * q4); a = MFMA(kf[ks], vf, a); }
        *(f32x4*)(dst + (16 * dvt + l15) * 64 + 16 * dkt + 4 * q4) = a;
    }
    __syncthreads();
}
__device__ __forceinline__ void gla_scan(const Params& p, int dry = 0) {
    float* GS = (float*)(p.ws + OFF_GS); const float* GD = (const float*)(p.ws + OFF_GDEC);
    const int total = 2 * BG * 4 * 8192;
    int tid_ = threadIdx.x; asm volatile("" : "+v"(tid_));
    for (int id = blockIdx.x * NTHR + tid_; id < total; id += gridDim.x * NTHR) {
        const int e = id & 8191, comb = id >> 13, h = comb & 3, bl = (comb >> 2) % BG, dir = comb / (4 * BG), dk = e & 63;
        float S = 0.f;
        const size_t ibase = (size_t)dir * NITEM + (size_t)(bl * 128) * 4 + h;
        for (int s0 = 0; s0 < 128; s0 += 16) {
            float u[16], dc[16];
#pragma unroll
            for (int i = 0; i < 16; ++i) {
                const int n = dir ? 127 - (s0 + i) : s0 + i;
                const size_t item = ibase + (size_t)n * 4;
                u[i] = GS[item * 8192 + e]; dc[i] = GD[item * 64 + dk];
            }
#pragma unroll
            for (int i = 0; i < 16; ++i) {
                const int n = dir ? 127 - (s0 + i) : s0 + i;
                const size_t item = ibase + (size_t)n * 4;
                if (!dry) GS[item * 8192 + e] = S;
                S = dc[i] * S + u[i];
            }
        }
    }
}
__device__ __forceinline__ void gla_part2_item(const Params& p, int l, bf16_t* P, const float* LR, int item, unsigned char* lds, int dry = 0) {
    const int h = item & 3, n = (item >> 2) & 127, bl = item >> 9, t0 = bl * SEQ + n * 64;
    const float* BF = (const float*)(lds + G_BF); const float* BB = (const float*)(lds + G_BB);
    bf16_t* QF = (bf16_t*)(lds + G_IMG);
    bf16_t* KF = QF + 2 * 64 * 72;
    bf16_t* QD = KF + 2 * 64 * 72;
    bf16_t* VT = QD + 2 * 64 * 72;
    bf16_t* ST = VT + 128 * 72;
    float* OX = (float*)lds;
    const float* GS = (const float*)(p.ws + OFF_GS);
    int tid_ = threadIdx.x; asm volatile("" : "+v"(tid_)); const int tid = tid_, lane = tid & 63, w = tid >> 6, l15 = lane & 15, q4 = lane >> 4;
    GlaPre gp; gla_prefetch(gp, P, t0, h, tid);
    float4 sp[2][4];
#pragma unroll
    for (int dir = 0; dir < 2; ++dir)
#pragma unroll
        for (int i = 0; i < 4; ++i) { const int idx = tid + NTHR * i; sp[dir][i] = *(const float4*)(GS + ((size_t)dir * NITEM + item) * 8192 + (idx >> 4) * 64 + (idx & 15) * 4); }
    gla_tables(p, l, LR, t0, h, lds);
#pragma unroll
    for (int i = 0; i < 8; ++i) {
        const int idx = tid + NTHR * i, c = idx >> 6, dk = idx & 63;
        const float qv = bf2f(gp.q[i]);
        const float kv = bf2f(gp.k[i]);
        const float bf = BF[c * 64 + dk], mf = BF[31 * 64 + dk], bb = BB[c * 64 + dk], mb = BB[32 * 64 + dk];
        QF[c * 72 + dk] = f2bf_d(qv * __expf(bf - mf)); KF[c * 72 + dk] = f2bf_d(kv * __expf(mf - bf)); QD[c * 72 + dk] = f2bf_d(qv * __expf(bf));
        QF[4608 + c * 72 + dk] = f2bf_d(qv * __expf(bb - mb)); KF[4608 + c * 72 + dk] = f2bf_d(kv * __expf(mb - bb)); QD[4608 + c * 72 + dk] = f2bf_d(qv * __expf(bb));
    }
    gla_vt_store(gp, VT, tid);
#pragma unroll
    for (int dir = 0; dir < 2; ++dir) {
#pragma unroll
        for (int i = 0; i < 4; ++i) {
            const int idx = tid + NTHR * i, dv = idx >> 4, dk4 = (idx & 15) * 4;
            const float4 s = sp[dir][i];
            u32x2 o; o.x = pk2(s.x, s.y); o.y = pk2(s.z, s.w);
            *(u32x2*)(ST + dir * 9216 + dv * 72 + dk4) = o;
        }
    }
    __syncthreads();
    const int dir = w >> 2, ct = w & 3;
    const bf16_t* qfp = QF + dir * 4608; const bf16_t* kfp = KF + dir * 4608; const bf16_t* qdp = QD + dir * 4608; const bf16_t* stp = ST + dir * 9216;
    bf16x8 qf[2], qd[2];
#pragma unroll
    for (int ks = 0; ks < 2; ++ks) { qf[ks] = *(const bf16x8*)(qfp + (16 * ct + l15) * 72 + 32 * ks + 8 * q4); qd[ks] = *(const bf16x8*)(qdp + (16 * ct + l15) * 72 + 32 * ks + 8 * q4); }
    f32x4 sc[4];
    const int cq = 16 * ct + l15;
#pragma unroll
    for (int st = 0; st < 4; ++st) {
        f32x4 a = {0.f, 0.f, 0.f, 0.f};
#pragma unroll
        for (int ks = 0; ks < 2; ++ks) { const bf16x8 kf = *(const bf16x8*)(kfp + (16 * st + l15) * 72 + 32 * ks + 8 * q4); a = MFMA(kf, qf[ks], a); }
#pragma unroll
        for (int e = 0; e < 4; ++e) { const int s = 16 * st + 4 * q4 + e; const bool ok = dir ? (s > cq) : (s <= cq); a[e] = ok ? a[e] : 0.f; }
        sc[st] = a;
    }
    f32x4 o[8];
#pragma unroll
    for (int dt = 0; dt < 8; ++dt) o[dt] = (f32x4){0.f, 0.f, 0.f, 0.f};
#pragma unroll
    for (int kk = 0; kk < 2; ++kk) {
        u32x4 pu; pu.x = pk2(sc[2 * kk][0], sc[2 * kk][1]); pu.y = pk2(sc[2 * kk][2], sc[2 * kk][3]); pu.z = pk2(sc[2 * kk + 1][0], sc[2 * kk + 1][1]); pu.w = pk2(sc[2 * kk + 1][2], sc[2 * kk + 1][3]);
        const bf16x8 pf = mkfrag(pu);
#pragma unroll
        for (int dt = 0; dt < 8; ++dt) {
            const bf16_t* vr = VT + (dt * 16 + l15) * 72 + kk * 32 + 4 * q4;
            const bf16x8 vf = mkfrag2(*(const u32x2*)vr, *(const u32x2*)(vr + 16));
            o[dt] = MFMA(vf, pf, o[dt]);
        }
    }
#pragma unroll
    for (int ks = 0; ks < 2; ++ks)
#pragma unroll
        for (int dt = 0; dt < 8; ++dt) { const bf16x8 sf = *(const bf16x8*)(stp + (dt * 16 + l15) * 72 + 32 * ks + 8 * q4); o[dt] = MFMA(sf, qd[ks], o[dt]); }
    if (dir == 1) {
#pragma unroll
        for (int dt = 0; dt < 8; ++dt) *(f32x4*)(OX + cq * 132 + 16 * dt + 4 * q4) = o[dt];
    }
    __syncthreads();
    if (dir == 0) {
        float ss = 0.f;
#pragma unroll
        for (int dt = 0; dt < 8; ++dt) { o[dt] += *(const f32x4*)(OX + cq * 132 + 16 * dt + 4 * q4); ss += (o[dt][0] * o[dt][0] + o[dt][1] * o[dt][1]) + (o[dt][2] * o[dt][2] + o[dt][3] * o[dt][3]); }
        ss += __shfl_xor(ss, 16); ss += __shfl_xor(ss, 32);
        const float rms = 1.0f / sqrtf(ss * (1.0f / 128.0f) + 1e-6f);
        const float* ng = p.gla_norm_g + l * 512 + h * 128;
        const bf16_t* zrow = P + (size_t)(t0 + cq) * PS + C_Z + 2 * 512 + h * 128;
        bf16_t* orow = P + (size_t)(t0 + cq) * PS + C_GV + h * 128;
#pragma unroll
        for (int dt = 0; dt < 8; ++dt) {
            const int dd = 16 * dt + 4 * q4;
            const f32x4 z = ld_bf4(zrow + dd); const f32x4 g4 = *(const f32x4*)(ng + dd);
            if (!dry) st_bf4(orow + dd, o[dt] * rms * g4 * z);
        }
    }
    __syncthreads();
}

namespace pg8 {
#define PG8_LAS __attribute__((address_space(3)))
typedef unsigned short bf16_t;
typedef short bf16x8 __attribute__((ext_vector_type(8)));
typedef float f32x4 __attribute__((ext_vector_type(4)));
typedef unsigned u32x4 __attribute__((ext_vector_type(4)));
constexpr int BM = 256, BK = 64, HALF = 128, HTB = HALF * BK * 2  , STAGE_BYTES = 8 * HTB, NXCD = 8, WGM = 8;

__host__ __device__ __forceinline__ int lds_byte(int r, int c) { const int st = (r >> 4) * 2 + (c >> 5), rr = r & 15, cc = c & 31, ob = rr * 64 + cc * 2; return st * 1024 + (ob ^ (((ob >> 9) & 1) << 5)); }
__host__ __device__ __forceinline__ void stage_rc(int b, int& R, int& C) { const int st = b / 1024, sb = b % 1024, swz = sb ^ (((sb >> 9) & 1) << 5); R = (st >> 1) * 16 + swz / 64; C = (st & 1) * 32 + (swz % 64) / 2; }
__host__ __device__ __forceinline__ int perm32(int rho) { const int n = rho >> 4, i = rho & 15; return 8 * (i >> 2) + 4 * n + (i & 3); }

struct Unit { int pm, pn; };
struct Gemm { const bf16_t* A; const bf16_t* Bt; int M, N, K; };

struct StaticOrder {
    int nM, nN, nwg, G, c;
    __host__ __device__ __forceinline__ void init(int M, int N, int G_, int c_) { nM = M / BM; nN = N / BM; nwg = nM * nN; G = G_; c = c_; }
    __host__ __device__ bool next(int i, Unit& u) const {
        const long L = (long)i * G + c; if (L >= nwg) return false;
        int wgid = (int)L; { const int q = nwg / NXCD, r = nwg % NXCD, xcd = wgid % NXCD, off = wgid / NXCD; wgid = (xcd < r ? xcd * (q + 1) : r * (q + 1) + (xcd - r) * q) + off; }
        const int nig = WGM * nN, gid = wgid / nig, fm = gid * WGM, gsz = (nM - fm) < WGM ? (nM - fm) : WGM;
        u.pm = fm + ((wgid % nig) % gsz); u.pn = (wgid % nig) / gsz; return true;
    }
    __device__ __forceinline__ void a_ready(const Unit&) const {}
    __device__ __forceinline__ void done(const Unit&) const {}
};
__device__ __forceinline__ unsigned cvt_pk_bf16(float lo, float hi) { unsigned r; asm volatile("v_cvt_pk_bf16_f32 %0, %1, %2" : "=v"(r) : "v"(lo), "v"(hi)); return r; }
template <class Epi, class Sched, bool STAMP = false>
__device__ __forceinline__ void gemm_phase(PG8_LAS unsigned char* lds, const Gemm g, const Sched& S, const Epi& E, unsigned long long* stamps) {
    int tid_l = threadIdx.x; asm volatile("" : "+v"(tid_l)); const int tid = tid_l, wid = __builtin_amdgcn_readfirstlane(tid >> 6), lane = tid & 63, wr = wid >> 2, wc = wid & 3, fr = lane & 15, fq = lane >> 4;
    const int K = g.K, nt = K / BK;
    int ts_lo = 0, ts_hi = 0, nts = 0; const unsigned long long rt_entry = STAMP ? (unsigned long long)wall_clock64() : 0ull;
#define PG8_STAMP() do { if (STAMP && wid == 0 && nts < 64) { const unsigned long long _c = (unsigned long long)clock64(); \
        ts_lo = (lane == nts) ? (int)(unsigned)_c : ts_lo; ts_hi = (lane == nts) ? (int)(unsigned)(_c >> 32) : ts_hi; ++nts; } } while (0)
    PG8_STAMP();
    unsigned voffA[2], voffB[2];
#pragma unroll
    for (int i = 0; i < 2; ++i) { int R, C; stage_rc(tid * 16 + i * 8192, R, C); const int Rb = Epi::PERM ? ((R & ~31) + perm32(R & 31)) : R;
        voffA[i] = (unsigned)(R * K + C) * 2u; voffB[i] = (unsigned)(Rb * K + C) * 2u; }
    const size_t kstep = (size_t)(BK * 2);
    const size_t hstep = (size_t)HALF * K * 2;
    const size_t tstep = 2 * hstep;
    const unsigned ldsw = (unsigned)wid * 1024u;
    const int aoff = lds_byte(wr * 64 + fr, fq * 8), boff = lds_byte(wc * 32 + fr, fq * 8);
#define PG8_SA(b, h) (((b) * 2 + (h)) * HTB)
#define PG8_SB(b, h) ((4 + (b) * 2 + (h)) * HTB)
#define PG8_STAGE(bufoff, gbase, voff) do { _Pragma("unroll") for (int _i = 0; _i < 2; ++_i) \
        __builtin_amdgcn_global_load_lds((const unsigned*)((const char*)(gbase) + (voff)[_i]), (PG8_LAS unsigned*)(lds + (bufoff) + ldsw + _i * 8192), 16, 0, 0); } while (0)
#define PG8_LDA(dst, b, h) do { _Pragma("unroll") for (int m = 0; m < 4; ++m) _Pragma("unroll") for (int k = 0; k < 2; ++k) dst[m][k] = *(const PG8_LAS bf16x8*)(lds + PG8_SA(b, h) + aoff + m * 2048 + k * 1024); } while (0)
#define PG8_LDB(dst, b, h) do { _Pragma("unroll") for (int n = 0; n < 2; ++n) _Pragma("unroll") for (int k = 0; k < 2; ++k) dst[n][k] = *(const PG8_LAS bf16x8*)(lds + PG8_SB(b, h) + boff + n * 2048 + k * 1024); } while (0)
#define PG8_MMA(ai, bj, At, Bt) do { __builtin_amdgcn_s_setprio(1); _Pragma("unroll") for (int m = 0; m < 4; ++m) _Pragma("unroll") for (int n = 0; n < 2; ++n) _Pragma("unroll") for (int k = 0; k < 2; ++k) \
        acc[ai][bj][m][n] = __builtin_amdgcn_mfma_f32_16x16x32_bf16(Bt[n][k], At[m][k], acc[ai][bj][m][n], 0, 0, 0); __builtin_amdgcn_s_setprio(0); } while (0)
#define PG8_WAIT_V(n) asm volatile("s_waitcnt vmcnt(" #n ")" ::: "memory")
#define PG8_WAIT_L(n) asm volatile("s_waitcnt lgkmcnt(" #n ")" ::: "memory")
#define PG8_BAR __builtin_amdgcn_s_barrier()
#define PG8_SCHED __builtin_amdgcn_sched_barrier(0)
    Unit cur, nxt; int ui = 0;
    if (!S.next(0, cur)) return;
    f32x4 acc[2][2][4][2];
#pragma unroll
    for (int a = 0; a < 2; ++a)
#pragma unroll
        for (int b = 0; b < 2; ++b)
#pragma unroll
            for (int m = 0; m < 4; ++m)
#pragma unroll
                for (int n = 0; n < 2; ++n) acc[a][b][m][n] = (f32x4){0.f, 0.f, 0.f, 0.f};
    bf16x8 At[4][2], B0[2][2], B1[2][2];
    const char* cA = (const char*)g.A + (size_t)cur.pm * tstep; const char* cB = (const char*)g.Bt + (size_t)cur.pn * tstep;
    S.a_ready(cur);
    PG8_STAGE(PG8_SB(0, 0), cB, voffB); PG8_STAGE(PG8_SA(0, 0), cA, voffA); PG8_STAGE(PG8_SB(0, 1), cB + hstep, voffB); PG8_STAGE(PG8_SA(0, 1), cA + hstep, voffA);
    if (wr == 1) PG8_BAR;
    PG8_WAIT_V(4); PG8_BAR;
    PG8_STAGE(PG8_SB(1, 0), cB + kstep, voffB); PG8_STAGE(PG8_SA(1, 0), cA + kstep, voffA); PG8_STAGE(PG8_SB(1, 1), cB + hstep + kstep, voffB);
    PG8_WAIT_V(6); PG8_BAR;
    PG8_STAMP();
    for (;;) {
        const bool has_next = S.next(ui + 1, nxt);
        const char* nA = has_next ? (const char*)g.A + (size_t)nxt.pm * tstep : cA; const char* nB = has_next ? (const char*)g.Bt + (size_t)nxt.pn * tstep : cB;
        for (int t = 0; t < nt; t += 2) {
            const bool last = (t == nt - 2);
            const char* a1 = cA + (size_t)(t + 1) * kstep;
            const char* a2 = last ? nA : cA + (size_t)(t + 2) * kstep; const char* b2 = last ? nB : cB + (size_t)(t + 2) * kstep;
            const char* a3 = a2 + kstep; const char* b3 = b2 + kstep;
            if (last && has_next) S.a_ready(nxt);
            PG8_LDB(B0, 0, 0); PG8_SCHED; PG8_LDA(At, 0, 0); PG8_STAGE(PG8_SA(1, 1), a1 + hstep, voffA);
            PG8_WAIT_L(8); PG8_BAR; PG8_WAIT_L(0); PG8_MMA(0, 0, At, B0); PG8_BAR; PG8_SCHED;
            PG8_LDB(B1, 0, 1); PG8_STAGE(PG8_SB(0, 0), b2, voffB);
            PG8_BAR; PG8_WAIT_L(0); PG8_MMA(0, 1, At, B1); PG8_BAR;
            PG8_LDA(At, 0, 1); PG8_STAGE(PG8_SA(0, 0), a2, voffA);
            PG8_BAR; PG8_WAIT_L(0); PG8_MMA(1, 0, At, B0); PG8_BAR; PG8_SCHED;
            PG8_STAGE(PG8_SB(0, 1), b2 + hstep, voffB);
            PG8_WAIT_V(6); PG8_BAR; PG8_MMA(1, 1, At, B1); PG8_BAR;
            PG8_LDB(B0, 1, 0); PG8_SCHED; PG8_LDA(At, 1, 0); PG8_STAGE(PG8_SA(0, 1), a2 + hstep, voffA);
            PG8_WAIT_L(8); PG8_BAR; PG8_WAIT_L(0); PG8_MMA(0, 0, At, B0); PG8_BAR; PG8_SCHED;
            PG8_LDB(B1, 1, 1); PG8_STAGE(PG8_SB(1, 0), b3, voffB);
            PG8_BAR; PG8_WAIT_L(0); PG8_MMA(0, 1, At, B1); PG8_BAR;
            PG8_LDA(At, 1, 1); PG8_STAGE(PG8_SA(1, 0), a3, voffA);
            PG8_BAR; PG8_WAIT_L(0); PG8_MMA(1, 0, At, B0); PG8_BAR; PG8_SCHED;
            PG8_STAGE(PG8_SB(1, 1), b3 + hstep, voffB);
            PG8_WAIT_V(6); PG8_BAR; PG8_MMA(1, 1, At, B1); PG8_BAR;
        }
        PG8_STAMP();
        if constexpr (!Epi::AFTER_DRAIN) { E(acc, cur, wr, wc, fr, fq); S.done(cur); }
        PG8_STAMP();
        if (!has_next) break;
#pragma unroll
        for (int a = 0; a < 2; ++a)
#pragma unroll
            for (int b = 0; b < 2; ++b)
#pragma unroll
                for (int m = 0; m < 4; ++m)
#pragma unroll
                    for (int n = 0; n < 2; ++n) acc[a][b][m][n] = (f32x4){0.f, 0.f, 0.f, 0.f};
        cur = nxt; cA = nA; cB = nB; ++ui;
    }
    PG8_WAIT_V(0);
    if (wr == 0) PG8_BAR;
    PG8_BAR;
    if constexpr (Epi::AFTER_DRAIN) { E.fused(acc, cur, wr, wc, fr, fq, lds, wid, lane); S.done(cur); }
    PG8_STAMP();
    if (STAMP && wid == 0) { stamps[lane] = lane < nts ? (((unsigned long long)(unsigned)ts_hi << 32) | (unsigned)ts_lo) : 0ull;
        if (lane == 62) stamps[62] = rt_entry; if (lane == 63) stamps[63] = (unsigned long long)wall_clock64(); }
#undef PG8_STAMP
#undef PG8_SA
#undef PG8_SB
#undef PG8_STAGE
#undef PG8_LDA
#undef PG8_LDB
#undef PG8_MMA
#undef PG8_WAIT_V
#undef PG8_WAIT_L
#undef PG8_BAR
#undef PG8_SCHED
}
}

struct EpiInProj {
    static constexpr bool PERM = true, AFTER_DRAIN = false;
    bf16_t* P; const float* bias; float* LR;
    __device__ __forceinline__ void operator()(const f32x4 (&acc)[2][2][4][2], const pg8::Unit& u, int wr, int wc, int fr, int fq) const {
        const int row0 = u.pm * 256 + wr * 64 + fr, colt = u.pn * 256, col0 = colt + wc * 32 + 8 * fq;
        if (colt == C_LR) {
            if (wc == 0) {
                const int cl = 8 * fq;
                const f32x4 b0 = *(const f32x4*)(bias + 4096 + cl), b1 = *(const f32x4*)(bias + 4096 + cl + 4);
#pragma unroll
                for (int ai = 0; ai < 2; ++ai)
#pragma unroll
                    for (int m = 0; m < 4; ++m) {
                        float* d = LR + (size_t)(row0 + ai * 128 + m * 16) * 32 + cl;
                        *(f32x4*)d = acc[ai][0][m][0] + b0; *(f32x4*)(d + 4) = acc[ai][0][m][1] + b1;
                    }
            }
            return;
        }
        const int mode = (colt < 512 || colt == C_GQ) ? 1 : (colt >= C_MQ && colt < C_Z) ? 2 : (colt >= C_Z && colt < C_SG) ? 3 : (colt >= C_SG) ? 4 : 0;
#pragma unroll
        for (int bj = 0; bj < 2; ++bj) {
            const int col = col0 + bj * 128;
            const f32x4 b0 = *(const f32x4*)(bias + orig_col(col)), b1 = *(const f32x4*)(bias + orig_col(col) + 4);
#pragma unroll
            for (int ai = 0; ai < 2; ++ai)
#pragma unroll
                for (int m = 0; m < 4; ++m) {
                    f32x4 v0 = acc[ai][bj][m][0] + b0, v1 = acc[ai][bj][m][1] + b1;
                    if (mode == 1) { v0 *= 0.125f; v1 *= 0.125f; }
                    else if (mode == 2) { v0 *= 0.08838834764831845f; v1 *= 0.08838834764831845f; }
                    else if (mode == 3) {
#pragma unroll
                        for (int e = 0; e < 4; ++e) { v0[e] = siluf_(v0[e]); v1[e] = siluf_(v1[e]); }
                    } else if (mode == 4) {
#pragma unroll
                        for (int e = 0; e < 4; ++e) { v0[e] = sigmoidf_(v0[e]); v1[e] = sigmoidf_(v1[e]); }
                    }
                    u32x4 o; o.x = pk2(v0[0], v0[1]); o.y = pk2(v0[2], v0[3]); o.z = pk2(v1[0], v1[1]); o.w = pk2(v1[2], v1[3]);
                    *(u32x4*)(P + (size_t)(row0 + ai * 128 + m * 16) * PS + col) = o;
                }
        }
    }
};
struct EpiOut {
    static constexpr bool PERM = false, AFTER_DRAIN = false;
    float* pre; const float* bo; const float* x; const float2* stats; const float* g0; const float* b0; const float* hres; size_t tok0; int l;
    __device__ __forceinline__ void operator()(const f32x4 (&acc)[2][2][4][2], const pg8::Unit& u, int wr, int wc, int fr, int fq) const {
        const int row0 = u.pm * 256 + wr * 64 + fr, col0 = u.pn * 256 + wc * 32 + 4 * fq;
#pragma unroll
        for (int ai = 0; ai < 2; ++ai)
#pragma unroll
            for (int m = 0; m < 4; ++m) {
                const int row = row0 + ai * 128 + m * 16; const size_t T = tok0 + row;
                float2 st; st.x = 0.f; st.y = 0.f; if (l == 0) st = stats[T];
#pragma unroll
                for (int bj = 0; bj < 2; ++bj)
#pragma unroll
                    for (int n = 0; n < 2; ++n) {
                        const int col = col0 + bj * 128 + n * 16;
                        f32x4 res;
                        if (l == 0) res = (*(const f32x4*)(x + T * 1024 + col) - st.x) * st.y * *(const f32x4*)(g0 + col) + *(const f32x4*)(b0 + col);
                        else res = *(const f32x4*)(hres + T * 1024 + col);
                        *(f32x4*)(pre + (size_t)row * 1024 + col) = acc[ai][bj][m][n] + *(const f32x4*)(bo + col) + DN_ALPHA * res;
                    }
            }
    }
};

#define XB_TMO      128
#define XB_XCNT(j)  (256  + 64 * (j))
#define XB_XSUB(j)  (1280 + 64 * (j))
#define XB_XGEN(j)  (2304 + 64 * (j))
#define XB_TOP      3328
#define XB_TOPGEN   3392
#define XCD_BAR_WORDS 3456
#define XB_SPIN_CAP (1u << 18)
#define LAS __attribute__((address_space(3)))

__device__ __forceinline__ unsigned xb_ld(unsigned* p)              { return __hip_atomic_load(p, __ATOMIC_RELAXED, __HIP_MEMORY_SCOPE_AGENT); }
__device__ __forceinline__ unsigned xb_add(unsigned* p, unsigned v) { return __hip_atomic_fetch_add(p, v, __ATOMIC_RELAXED, __HIP_MEMORY_SCOPE_AGENT); }
__device__ __forceinline__ unsigned xb_xcc_id() { return (unsigned)__builtin_amdgcn_s_getreg((3 << 11) | 20) & 0xFu; }
#define XB_SPIN(cond, bar) do { unsigned _sp = 0; while (cond) { __builtin_amdgcn_s_sleep(1); \
    if ((++_sp & 255u) == 0u) { if (xb_ld(&(bar)[XB_TMO])) break; if (_sp > XB_SPIN_CAP) { atomicAdd(&(bar)[XB_TMO], 1u); break; } } } } while (0)

struct XcdBarrier {
    unsigned* bar; unsigned x;
    volatile LAS unsigned* st;
};

__device__ __forceinline__ XcdBarrier xcd_barrier_post(unsigned* bar, volatile LAS unsigned* st) {
    XcdBarrier b; b.bar = bar; b.x = xb_xcc_id(); b.st = st;
    if (threadIdx.x == 0) (void)xb_add(&bar[XB_XCNT(b.x)], 1u);
    return b;
}
__device__ __forceinline__ void xcd_barrier_complete(unsigned* bar, unsigned x, unsigned& nloc, unsigned& nx) {
    const unsigned G = gridDim.x * gridDim.y * gridDim.z;
    unsigned sum, cnt, mine, sp = 0u;
    for (;;) {
        sum = 0u; cnt = 0u; mine = 0u;
#pragma unroll
        for (unsigned j = 0; j < 16; ++j) { const unsigned c = xb_ld(&bar[XB_XCNT(j)]); sum += c; cnt += (c > 0u) ? 1u : 0u; mine = (j == x) ? c : mine; }
        if (sum == G) break;
        __builtin_amdgcn_s_sleep(1);
        if ((++sp & 255u) == 0u) { if (xb_ld(&bar[XB_TMO])) break; if (sp > XB_SPIN_CAP) { atomicAdd(&bar[XB_TMO], 1u); break; } }
    }
    nloc = mine > 0u ? mine : 1u; nx = cnt > 0u ? cnt : 1u;
}

__device__ __forceinline__ void xcd_barrier(unsigned* b_bar, unsigned b_x, volatile LAS unsigned* b_st) {
    asm volatile("s_waitcnt vmcnt(0)" ::: "memory");
    __syncthreads();
    if (threadIdx.x == 0) {
        unsigned* bar = b_bar;
        __builtin_amdgcn_s_waitcnt(0);
        unsigned nloc = b_st[0], nx = b_st[1];
        if (nloc == 0u) { xcd_barrier_complete(bar, b_x, nloc, nx); b_st[0] = nloc; b_st[1] = nx; }
        const unsigned old = xb_add(&bar[XB_XSUB(b_x)], 1u);
        const unsigned gen = old / nloc;
        if (old + 1u == (gen + 1u) * nloc) {
            __builtin_amdgcn_fence(__ATOMIC_RELEASE, "agent");
            asm volatile("s_waitcnt vmcnt(0)" ::: "memory");
            const unsigned og = xb_add(&bar[XB_TOP], 1u);
            const unsigned tg = og / nx;
            if (og + 1u == (tg + 1u) * nx) xb_add(&bar[XB_TOPGEN], 1u);
            else XB_SPIN(xb_ld(&bar[XB_TOPGEN]) == tg, bar);
            __builtin_amdgcn_fence(__ATOMIC_ACQUIRE, "agent");
            xb_add(&bar[XB_XGEN(b_x)], 1u);
            asm volatile("s_waitcnt vmcnt(0)" ::: "memory");
        } else {
            XB_SPIN(xb_ld(&bar[XB_XGEN(b_x)]) == gen, bar);
            __builtin_amdgcn_fence(__ATOMIC_ACQUIRE, "agent");
            asm volatile("s_waitcnt vmcnt(0)" ::: "memory");
        }
    }
    __syncthreads();
}

__device__ __forceinline__ void gbar(unsigned* ctr, unsigned& gen, int G) {
    __syncthreads();
    gen += (unsigned)G;
    if (threadIdx.x == 0) {
        __threadfence();
        __hip_atomic_fetch_add(ctr, 1u, __ATOMIC_RELAXED, __HIP_MEMORY_SCOPE_AGENT);
        while (__hip_atomic_load(ctr, __ATOMIC_RELAXED, __HIP_MEMORY_SCOPE_AGENT) < gen) __builtin_amdgcn_s_sleep(1);
        __threadfence();
    }
    __syncthreads();
}
typedef const Params __attribute__((address_space(4))) KParams;
#define KP4 __attribute__((address_space(4)))
__device__ __forceinline__ Params fresh_params() {
#if defined(__HIP_DEVICE_COMPILE__)
    KParams* kp = (KParams*)__builtin_amdgcn_kernarg_segment_ptr();
    asm volatile("" : "+s"(kp));
    Params r;
    const float* KP4 const* src = (const float* KP4 const*)kp;
    const float** dst = (const float**)&r;
#pragma unroll
    for (int i = 0; i < 28; ++i) dst[i] = src[i];
    return r;
#else
    return Params{};
#endif
}
__global__ void __launch_bounds__(NTHR) mega(Params p_unused) {
    extern __shared__ __attribute__((aligned(16))) unsigned char lds[];
    cg::grid_group grid = cg::this_grid();
    const int G = gridDim.x, bid = blockIdx.x;
    volatile LAS unsigned* xst = (volatile LAS unsigned*)((LAS unsigned char*)lds + (LDS_BYTES - 16));
    if (threadIdx.x == 0) { xst[0] = 0u; xst[1] = 0u; }
    __syncthreads();
    unsigned* xbar; unsigned xx;
    { const Params p = fresh_params(); xbar = (unsigned*)(p.ws + OFF_BAR); xx = xb_xcc_id(); if (threadIdx.x == 0) (void)xb_add(&xbar[XB_XCNT(xx)], 1u); }
    { const Params p = fresh_params(); phase0(p); }
    grid.sync();
#pragma unroll 1
    for (int l = 0; l < 2; ++l) {
        { const Params p = fresh_params(); phase_weights(p, l, lds); __syncthreads(); phase_filter_gen(p, l, lds); }
        xcd_barrier(xbar, xx, xst);
        {
            const Params p = fresh_params();
            phase_filter_fft(p, l, lds);
            const bf16_t* WtKV = (const bf16_t*)(p.ws + OFF_WTKV); const bf16_t* membf = (const bf16_t*)(p.ws + OFF_MEMBF);
            for (int t = bid; t < 64; t += G) {
                f32x4 acc[4][4];
                if (t < 32) {
                    const int m0 = (t >> 2) * 256, n0 = (t & 3) * 128;
                    gemm_core(acc, membf + (size_t)m0 * 1024, 1024, WtKV + (size_t)n0 * 1024, 1024, 1024, lds);
                    bf16_t* Km = (bf16_t*)(p.ws + OFF_KMAT);
                    EPI_LOOP(st_bf4(Km + (size_t)row * 512 + col, v);)
                } else {
                    const int t2 = t - 32, m0 = (t2 >> 4) * 256, n0 = (t2 & 15) * 128;
                    gemm_core(acc, WtKV + (size_t)(512 + m0) * 1024, 1024, membf + (size_t)n0 * 1024, 1024, 1024, lds);
                    bf16_t* Vm = (bf16_t*)(p.ws + OFF_VT);
                    EPI_LOOP(st_bf4(Vm + (size_t)row * 2048 + col, v);)
                }
            }
        }
        xcd_barrier(xbar, xx, xst);
#pragma unroll 1
        for (int g = 0; g < NGRP; ++g) {
            const size_t tok0 = (size_t)g * TG;
#pragma unroll 1
            for (int rep = 0; rep < PROBE_REP_INPROJ; ++rep) {
                const Params p = fresh_params();
                pg8::Gemm gm; gm.A = (const bf16_t*)(p.ws + OFF_HB) + tok0 * 1024; gm.Bt = (const bf16_t*)(p.ws + OFF_WTIN); gm.M = TG; gm.N = NINP; gm.K = 1024;
                pg8::StaticOrder S; S.init(TG, NINP, G, bid);
                EpiInProj E; E.P = (bf16_t*)(p.ws + OFF_P); E.bias = p.b_in + (size_t)l * NIN; E.LR = (float*)(p.ws + OFF_LR);
                pg8::gemm_phase<EpiInProj, pg8::StaticOrder, false>((PG8_LAS unsigned char*)lds, gm, S, E, nullptr);
                __syncthreads();
            }
            xcd_barrier(xbar, xx, xst);
#pragma unroll 1
            for (int rep = 0; rep < PROBE_REP_MIX; ++rep) {
            int dry = (rep + 1 < PROBE_REP_MIX) ? 1 : 0; asm volatile("" : "+s"(dry));
            {
                const Params p = fresh_params();
                bf16_t* P = (bf16_t*)(p.ws + OFF_P);
                for (int it = bid; it < BG * 64 * 8; it += G) na_item(p, l, P, it >> 9, (it >> 3) & 63, it & 7, lds, dry);
            }
            {
                const Params p = fresh_params();
                bf16_t* P = (bf16_t*)(p.ws + OFF_P);
                for (int it = bid; it < BG * 128 * 8; it += G) hy_pre_item(p, l, P, (float*)(p.ws + OFF_UT), (bf16_t*)(p.ws + OFF_GT), it >> 10, (it >> 3) & 127, it & 7, lds);
            }
            {
                const Params p = fresh_params();
                for (int it = bid; it < NITEM; it += G) gla_part1_item(p, l, (const bf16_t*)(p.ws + OFF_P), (const float*)(p.ws + OFF_LR), it, lds);
            }
            {
                const Params p = fresh_params();
                bf16_t* P = (bf16_t*)(p.ws + OFF_P);
                const int nit = BG * 4 * 64, per = (nit + G - 1) / G;
                int last = -1;
                for (int it = bid * per; it < min(nit, (bid + 1) * per); ++it) {
                    const int bh = it >> 6, bl = bh >> 2, h = bh & 3;
                    if (bh != last) { __syncthreads(); memattn_load(p, g * BG + bl, h, lds); last = bh; }
                    memattn_item(P, bl, h, it & 63, lds, dry);
                }
                __syncthreads();
            }
            xcd_barrier(xbar, xx, xst);
            {
                const Params p = fresh_params();
                const float2* twl = fft_lds_twiddles((const float2*)(p.ws + OFF_TW), lds);
                for (int it = bid; it < BG * 256; it += G) hyena_conv_item(p, (const float*)(p.ws + OFF_UT), (bf16_t*)(p.ws + OFF_GT), it >> 8, it & 255, lds, twl, dry);
                __syncthreads();
                gla_scan(p, dry);
            }
            xcd_barrier(xbar, xx, xst);
            {
                const Params p = fresh_params();
                for (int it = bid; it < NITEM; it += G) gla_part2_item(p, l, (bf16_t*)(p.ws + OFF_P), (const float*)(p.ws + OFF_LR), it, lds, dry);
            }
            {
                const Params p = fresh_params();
                for (int it = bid; it < BG * 128 * 8; it += G) hy_post_item((bf16_t*)(p.ws + OFF_P), (const bf16_t*)(p.ws + OFF_GT), it >> 10, (it >> 3) & 127, it & 7, lds, dry);
            }
            xcd_barrier(xbar, xx, xst);
            }
            {
                const Params p = fresh_params();
                const bf16_t* P = (const bf16_t*)(p.ws + OFF_P); const bf16_t* WtBr = (const bf16_t*)(p.ws + OFF_WTBR); bf16_t* merged = (bf16_t*)(p.ws + OFF_MERGED);
                for (int t = bid; t < 512; t += G) {
                    const int sr = t >> 8, sb = t & 255, sx = sb & 7, sk = sb >> 3;
                    const int m0 = (sr * 32 + (sk >> 3) * 8 + sx) * 256, n0 = (sk & 7) * 128;
                    merge_tile(P, WtBr, merged, m0, n0, lds);
                }
            }
            xcd_barrier(xbar, xx, xst);
            {
                const Params p = fresh_params();
                pg8::Gemm gm; gm.A = (const bf16_t*)(p.ws + OFF_MERGED); gm.Bt = (const bf16_t*)(p.ws + OFF_WTOUT); gm.M = TG; gm.N = 1024; gm.K = 1024;
                pg8::StaticOrder S; S.init(TG, 1024, G, bid);
                EpiOut E; E.pre = (float*)(p.ws + OFF_PRE); E.bo = p.b_out + l * 1024; E.x = p.x; E.stats = (const float2*)(p.ws + OFF_STATS); E.g0 = p.ln_in_g; E.b0 = p.ln_in_b; E.hres = p.out; E.tok0 = tok0; E.l = l;
                pg8::gemm_phase<EpiOut, pg8::StaticOrder, false>((PG8_LAS unsigned char*)lds, gm, S, E, nullptr);
                __syncthreads();
            }
            xcd_barrier(xbar, xx, xst);
            {
                const Params p = fresh_params();
                ln_rows((const float*)(p.ws + OFF_PRE), 0, TG, p.ln_g + l * 1024, p.ln_b + l * 1024, p.out, (bf16_t*)(p.ws + OFF_HB), tok0, nullptr);
            }
        }
        xcd_barrier(xbar, xx, xst);
    }
}

extern "C" void kernel_launch(void* const* d_in, const int* in_sizes, int n_in, void* d_out, int out_size, void* d_ws, size_t ws_size, hipStream_t stream) {
    static int grid_blocks = 0;
    if (!grid_blocks) {
        if (ws_size < WS_END) { fprintf(stderr, "kernel_launch: workspace too small: %zu < %zu\n", ws_size, (size_t)WS_END); grid_blocks = -1; return; }
        {
            const long long ex[26] = {67108864LL, 2097152LL, 1024, 1024, 2LL * 1024 * 10784, 2 * 10784, 2 * 8 * 15 * 31, 2 * 3 * 1536, 2 * 1536, 2 * 33 * 64, 2 * 64, 2 * 2 * 64 * 64, 2 * 2 * 64,
                                      2 * 64 * 1024, 2 * 512, 2 * 16 * 256, 2 * 256, 2 * 16 * 256, 2 * 256, 2 * 512, 2LL * 1024 * 1024, 2LL * 4 * 512 * 1024, 2LL * 1024 * 1024, 2 * 1024, 2 * 1024, 2 * 1024};
            bool bad = (n_in != 26) || (out_size != 67108864);
            for (int i = 0; i < 26 && !bad; ++i) if ((long long)in_sizes[i] != ex[i]) { fprintf(stderr, "kernel_launch: input %d has %d elements, expected %lld\n", i, in_sizes[i], ex[i]); bad = true; }
            if (bad) { fprintf(stderr, "kernel_launch: unexpected shapes; nothing launched\n"); grid_blocks = -1; return; }
        }
        int dev = 0, cus = 0, per_cu = 0;
        hipGetDevice(&dev);
        hipDeviceGetAttribute(&cus, hipDeviceAttributeMultiprocessorCount, dev);
        if (hipFuncSetAttribute((const void*)mega, hipFuncAttributeMaxDynamicSharedMemorySize, LDS_BYTES) != hipSuccess) fprintf(stderr, "kernel_launch: hipFuncSetAttribute failed\n");
        if (hipOccupancyMaxActiveBlocksPerMultiprocessor(&per_cu, (const void*)mega, NTHR, LDS_BYTES) != hipSuccess || per_cu < 1) { fprintf(stderr, "kernel_launch: occupancy query gave %d\n", per_cu); per_cu = 1; }
        (void)hipGetLastError();
        if (per_cu > 1) per_cu = 1;
        grid_blocks = cus * per_cu;
    }
    if (grid_blocks < 0) return;
    Params p{};
    const float** pp = (const float**)&p;
    for (int i = 0; i < 26; ++i) pp[i] = (const float*)d_in[i];
    p.out = (float*)d_out; p.ws = (unsigned char*)d_ws;
    if (hipMemsetAsync((unsigned char*)d_ws + OFF_BAR, 0, 16384, stream) != hipSuccess) fprintf(stderr, "kernel_launch: memset of the barrier word failed\n");
    void* args[] = {&p};
    hipError_t e = hipLaunchCooperativeKernel((const void*)mega, dim3(grid_blocks), dim3(NTHR), args, LDS_BYTES, stream);
    if (e != hipSuccess) fprintf(stderr, "cooperative launch failed: %s (grid %d)\n", hipGetErrorString(e), grid_blocks);
}
#endif
```

```cpp
#ifndef PROBE_REP_MIX
#define PROBE_REP_MIX 1
#endif
#ifndef PROBE_REP_INPROJ
#define PROBE_REP_INPROJ 1
#endif
#include <hip/hip_runtime.h>
#include <hip/hip_cooperative_groups.h>
#include <cstdio>
#include <unistd.h>
#include <cmath>
namespace cg = cooperative_groups;

#define HD __host__ __device__
typedef unsigned short bf16_t;
typedef short bf16x8 __attribute__((ext_vector_type(8)));
typedef float f32x4 __attribute__((ext_vector_type(4)));
typedef unsigned u32x2 __attribute__((ext_vector_type(2)));
typedef unsigned u32x4 __attribute__((ext_vector_type(4)));

constexpr int NTOK = 65536, DM = 1024, SEQ = 8192, NB = 8;
constexpr int BG = 2;
constexpr int NGRP = NB / BG;
constexpr int TG = BG * SEQ;
constexpr int PS = 10752;
constexpr int NIN = 10784, NINP = 11008;
constexpr int C_NAQ = 0, C_NAK = 512, C_NAV = 1024, C_HY = 1536, C_GQ = 3072, C_GK = 3328, C_GV = 3584, C_MQ = 4096, C_Z = 4608, C_SG = 6656, C_LR = 10752;
constexpr int FN = 16384;
constexpr int NITEM = BG * 128 * 4;
constexpr int LDS_BYTES = 160 * 1024;
constexpr int NTHR = 512;
constexpr float DN_ALPHA = 1.41421356237309515f;

constexpr size_t al256(size_t x) { return (x + 255) & ~(size_t)255; }
constexpr size_t OFF_HB = 0;
constexpr size_t OFF_STATS = OFF_HB + (size_t)NTOK * DM * 2;
constexpr size_t OFF_TW = OFF_STATS + (size_t)NTOK * 8;
constexpr size_t OFF_MEMBF = OFF_TW + (size_t)FN * 8;
constexpr size_t OFF_ENERGY = OFF_MEMBF + (size_t)2048 * 1024 * 2;
constexpr size_t OFF_WTIN = OFF_ENERGY + 4096;
constexpr size_t OFF_WTBR = OFF_WTIN + (size_t)NINP * 1024 * 2;
constexpr size_t OFF_WTOUT = OFF_WTBR + (size_t)4 * 1024 * 512 * 2;
constexpr size_t OFF_WTKV = OFF_WTOUT + (size_t)1024 * 1024 * 2;
constexpr size_t OFF_KMAT = OFF_WTKV + (size_t)2048 * 1024 * 2;
constexpr size_t OFF_VT = OFF_KMAT + (size_t)2048 * 1024 * 2;
constexpr size_t OFF_HFILT = OFF_VT + (size_t)2048 * 1024 * 2;
constexpr size_t OFF_PQ = OFF_HFILT + (size_t)1024 * 8192 * 4;
constexpr size_t OFF_P = OFF_PQ + (size_t)256 * FN * 16;
constexpr size_t OFF_LR = OFF_P + (size_t)TG * PS * 2;
constexpr size_t OFF_GS = OFF_LR + (size_t)TG * 32 * 4;
constexpr size_t OFF_GDEC = OFF_GS + (size_t)2 * NITEM * 8192 * 4;
constexpr size_t OFF_MERGED = OFF_GDEC + (size_t)2 * NITEM * 64 * 4;
constexpr size_t OFF_PRE = OFF_MERGED + (size_t)TG * 1024 * 2;
constexpr size_t OFF_UT = OFF_PRE + (size_t)TG * 1024 * 4;
constexpr size_t OFF_GT = OFF_UT + (size_t)BG * 512 * 8192 * 4;
constexpr size_t OFF_BAR = OFF_GT + (size_t)BG * 512 * 8192 * 2;
constexpr size_t OFF_ZT = OFF_BAR + 16384;
constexpr size_t WS_END = OFF_ZT + (size_t)8192 * 33 * 4;

struct Params {
    const float *x, *mem, *ln_in_g, *ln_in_b, *w_in, *b_in, *na_rpb, *hy_conv_w, *hy_conv_b, *hy_w1, *hy_b1, *hy_wm, *hy_bm, *hy_w3, *hy_skip,
        *gla_up_f, *gla_bias_f, *gla_up_b, *gla_bias_b, *gla_norm_g, *mem_w_kv, *w_br, *w_out, *b_out, *ln_g, *ln_b;
    float* out;
    unsigned char* ws;
};

HD inline float bf2f(bf16_t b) {
    union { unsigned u; float f; } c; c.u = (unsigned)b << 16; return c.f;
}
HD inline bf16_t f2bf(float f) {
    union { unsigned u; float f; } c; c.f = f; unsigned u = c.u; u += 0x7fffu + ((u >> 16) & 1u); return (bf16_t)(u >> 16);
}
typedef float f32x2_t __attribute__((ext_vector_type(2)));
typedef __bf16 bf16x2_t __attribute__((ext_vector_type(2)));
__device__ __forceinline__ unsigned pk2(float lo, float hi) { const f32x2_t v = {lo, hi}; const bf16x2_t b = __builtin_convertvector(v, bf16x2_t); return __builtin_bit_cast(unsigned, b); }
__device__ __forceinline__ bf16_t f2bf_d(float f) { return (bf16_t)(pk2(f, f) & 0xffffu); }
__device__ __forceinline__ float lo16(unsigned u) { return __uint_as_float(u << 16); }
__device__ __forceinline__ float hi16(unsigned u) { return __uint_as_float(u & 0xffff0000u); }
__device__ __forceinline__ float wave_sum(float v) {
#pragma unroll
    for (int o = 32; o >= 1; o >>= 1) v += __shfl_xor(v, o);
    return v;
}
__device__ __forceinline__ float sigmoidf_(float x) { return __builtin_amdgcn_rcpf(1.0f + __expf(-x)); }
__device__ __forceinline__ float siluf_(float x) { return x * __builtin_amdgcn_rcpf(1.0f + __expf(-x)); }
__device__ __forceinline__ float logsigf_(float x) { return fminf(x, 0.0f) - __logf(1.0f + __expf(-fabsf(x))); }
__device__ __forceinline__ bf16x8 mkfrag(u32x4 v) { return __builtin_bit_cast(bf16x8, v); }
__device__ __forceinline__ bf16x8 mkfrag2(u32x2 a, u32x2 b) { u32x4 v = {a.x, a.y, b.x, b.y}; return __builtin_bit_cast(bf16x8, v); }
#define MFMA(a, b, c) __builtin_amdgcn_mfma_f32_16x16x32_bf16((a), (b), (c), 0, 0, 0)
HD inline int iclamp(int v, int lo, int hi) { return v < lo ? lo : (v > hi ? hi : v); }

HD inline float2 cmulf(float2 a, float2 b) { float2 r; r.x = a.x * b.x - a.y * b.y; r.y = a.x * b.y + a.y * b.x; return r; }
HD inline float2 cmulcf(float2 a, float2 b) { float2 r; r.x = a.x * b.x + a.y * b.y; r.y = a.y * b.x - a.x * b.y; return r; }
struct Bfly { float2 x0, x1, x2, x3, W1; int i0; };
HD inline void bfly_load(Bfly& b, const float2* d, const float2* tw, int lgm, int q) {
    const int m = 1 << lgm, blk = q >> lgm, j = q & (m - 1);
    b.i0 = (blk << (lgm + 2)) + j;
    b.W1 = tw[j];
    b.x0 = d[b.i0]; b.x1 = d[b.i0 + m]; b.x2 = d[b.i0 + 2 * m]; b.x3 = d[b.i0 + 3 * m];
}
HD inline void bfly_fwd_store(const Bfly& b, float2* d, int lgm) {
    const int m = 1 << lgm, i0 = b.i0;
    const float2 W1 = b.W1, W2 = cmulf(W1, W1);
    const float2 x0 = b.x0, x1 = b.x1, x2 = b.x2, x3 = b.x3;
    float2 a0, a1, a2, a3, t;
    a0.x = x0.x + x2.x; a0.y = x0.y + x2.y;
    t.x = x0.x - x2.x; t.y = x0.y - x2.y; a2 = cmulf(t, W1);
    a1.x = x1.x + x3.x; a1.y = x1.y + x3.y;
    t.x = x1.x - x3.x; t.y = x1.y - x3.y; t = cmulf(t, W1); a3.x = t.y; a3.y = -t.x;
    float2 r;
    r.x = a0.x + a1.x; r.y = a0.y + a1.y; d[i0] = r;
    t.x = a0.x - a1.x; t.y = a0.y - a1.y; d[i0 + m] = cmulf(t, W2);
    r.x = a2.x + a3.x; r.y = a2.y + a3.y; d[i0 + 2 * m] = r;
    t.x = a2.x - a3.x; t.y = a2.y - a3.y; d[i0 + 3 * m] = cmulf(t, W2);
}
HD inline void bfly_inv_store(const Bfly& b, float2* d, int lgm) {
    const int m = 1 << lgm, i0 = b.i0;
    const float2 W1 = b.W1, W2 = cmulf(W1, W1);
    const float2 x0 = b.x0, x1 = b.x1, x2 = b.x2, x3 = b.x3;
    const float2 b1 = cmulcf(x1, W2), b3 = cmulcf(x3, W2);
    float2 y0, y1, y2, y3;
    y0.x = x0.x + b1.x; y0.y = x0.y + b1.y; y1.x = x0.x - b1.x; y1.y = x0.y - b1.y;
    y2.x = x2.x + b3.x; y2.y = x2.y + b3.y; y3.x = x2.x - b3.x; y3.y = x2.y - b3.y;
    const float2 c2 = cmulcf(y2, W1); float2 c3 = cmulcf(y3, W1); { const float tx = -c3.y, ty = c3.x; c3.x = tx; c3.y = ty; }
    float2 r;
    r.x = y0.x + c2.x; r.y = y0.y + c2.y; d[i0] = r;
    r.x = y0.x - c2.x; r.y = y0.y - c2.y; d[i0 + 2 * m] = r;
    r.x = y1.x + c3.x; r.y = y1.y + c3.y; d[i0 + m] = r;
    r.x = y1.x - c3.x; r.y = y1.y - c3.y; d[i0 + 3 * m] = r;
}
HD inline void fft_fwd_bfly(float2* d, const float2* tw, int lgm, int q) { Bfly b; bfly_load(b, d, tw, lgm, q); bfly_fwd_store(b, d, lgm); }
HD inline void fft_inv_bfly(float2* d, const float2* tw, int lgm, int q) { Bfly b; bfly_load(b, d, tw, lgm, q); bfly_inv_store(b, d, lgm); }
HD inline void r4_fwd(float2& x0, float2& x1, float2& x2, float2& x3, const float2 W1) {
    const float2 W2 = cmulf(W1, W1);
    float2 a0, a1, a2, a3, t;
    a0.x = x0.x + x2.x; a0.y = x0.y + x2.y;
    t.x = x0.x - x2.x; t.y = x0.y - x2.y; a2 = cmulf(t, W1);
    a1.x = x1.x + x3.x; a1.y = x1.y + x3.y;
    t.x = x1.x - x3.x; t.y = x1.y - x3.y; t = cmulf(t, W1); a3.x = t.y; a3.y = -t.x;
    x0.x = a0.x + a1.x; x0.y = a0.y + a1.y;
    t.x = a0.x - a1.x; t.y = a0.y - a1.y; x1 = cmulf(t, W2);
    x2.x = a2.x + a3.x; x2.y = a2.y + a3.y;
    t.x = a2.x - a3.x; t.y = a2.y - a3.y; x3 = cmulf(t, W2);
}
HD inline void r4_inv(float2& x0, float2& x1, float2& x2, float2& x3, const float2 W1) {
    const float2 W2 = cmulf(W1, W1);
    const float2 b1 = cmulcf(x1, W2), b3 = cmulcf(x3, W2);
    float2 y0, y1, y2, y3;
    y0.x = x0.x + b1.x; y0.y = x0.y + b1.y; y1.x = x0.x - b1.x; y1.y = x0.y - b1.y;
    y2.x = x2.x + b3.x; y2.y = x2.y + b3.y; y3.x = x2.x - b3.x; y3.y = x2.y - b3.y;
    const float2 c2 = cmulcf(y2, W1); float2 c3 = cmulcf(y3, W1); { const float tx = -c3.y, ty = c3.x; c3.x = tx; c3.y = ty; }
    x0.x = y0.x + c2.x; x0.y = y0.y + c2.y; x2.x = y0.x - c2.x; x2.y = y0.y - c2.y;
    x1.x = y1.x + c3.x; x1.y = y1.y + c3.y; x3.x = y1.x - c3.x; x3.y = y1.y - c3.y;
}
template <bool INV, bool HALF>
HD inline void r16_bfly(float2* d, const float2* twO, const float2* twI, int lgm, int q) {
    const int m = 1 << lgm, blk = q >> lgm, j = q & (m - 1), base = (blk << (lgm + 4)) + j;
    float2 e[4][4];
#pragma unroll
    for (int a = 0; a < 4; ++a)
#pragma unroll
        for (int b = 0; b < 4; ++b) {
            if (!INV && HALF && a >= 2) { e[a][b].x = 0.f; e[a][b].y = 0.f; }
            else e[a][b] = d[base + ((4 * a + b) << lgm)];
        }
    const float2 wI = twI[j];
    float2 wO[4];
#pragma unroll
    for (int b = 0; b < 4; ++b) wO[b] = twO[j + (b << lgm)];
    if (!INV) {
#pragma unroll
        for (int b = 0; b < 4; ++b) r4_fwd(e[0][b], e[1][b], e[2][b], e[3][b], wO[b]);
#pragma unroll
        for (int a = 0; a < 4; ++a) r4_fwd(e[a][0], e[a][1], e[a][2], e[a][3], wI);
    } else {
#pragma unroll
        for (int a = 0; a < 4; ++a) r4_inv(e[a][0], e[a][1], e[a][2], e[a][3], wI);
#pragma unroll
        for (int b = 0; b < 4; ++b) r4_inv(e[0][b], e[1][b], e[2][b], e[3][b], wO[b]);
    }
#pragma unroll
    for (int a = 0; a < 4; ++a)
#pragma unroll
        for (int b = 0; b < 4; ++b)
            if (!(INV && HALF && a >= 2)) d[base + ((4 * a + b) << lgm)] = e[a][b];
}
HD inline int brev14(int k) {
#if defined(__HIP_DEVICE_COMPILE__)
    return (int)(__brev((unsigned)k) >> 18);
#endif
    unsigned v = (unsigned)k;
    v = ((v >> 1) & 0x55555555u) | ((v & 0x55555555u) << 1);
    v = ((v >> 2) & 0x33333333u) | ((v & 0x33333333u) << 2);
    v = ((v >> 4) & 0x0f0f0f0fu) | ((v & 0x0f0f0f0fu) << 4);
    v = ((v >> 8) & 0x00ff00ffu) | ((v & 0x00ff00ffu) << 8);
    v = (v >> 16) | (v << 16);
    return (int)(v >> 18);
}
struct PwIn { float2 Z1, Z2; float4 A, B; int p1, p2; };
HD inline void pw_load(PwIn& w, const float2* d, const float4* pq, int p1) {
    const int kf = brev14(p1), k2 = (FN - kf) & (FN - 1); w.p1 = p1; w.p2 = brev14(k2);
    w.Z1 = d[w.p1]; w.Z2 = d[w.p2]; w.A = pq[w.p1]; w.B.x = w.A.x; w.B.y = -w.A.y; w.B.z = w.A.z; w.B.w = -w.A.w;
}
HD inline void pw_store(const PwIn& w, float2* d) {
    const float2 Z1 = w.Z1, Z2 = w.Z2;
    float2 P1, Q1, P2, Q2; P1.x = w.A.x; P1.y = w.A.y; Q1.x = w.A.z; Q1.y = w.A.w; P2.x = w.B.x; P2.y = w.B.y; Q2.x = w.B.z; Q2.y = w.B.w;
    float2 c1, c2; c1.x = Z1.x; c1.y = -Z1.y; c2.x = Z2.x; c2.y = -Z2.y;
    const float2 a = cmulf(Z1, P1), b = cmulf(c2, Q1), c = cmulf(Z2, P2), e = cmulf(c1, Q2);
    float2 w1, w2; w1.x = a.x + b.x; w1.y = a.y + b.y; w2.x = c.x + e.x; w2.y = c.y + e.y;
    d[w.p1] = w1;
    if (w.p2 != w.p1) d[w.p2] = w2;
}
HD inline void conv_pointwise(float2* d, const float4* pq, int p1) { PwIn w; pw_load(w, d, pq, p1); pw_store(w, d); }
HD inline void filt_pointwise(const float2* d, float4* pq, int p1) {
    const int kf = brev14(p1), k2 = (FN - kf) & (FN - 1), p2 = brev14(k2);
    const float2 Z1 = d[p1], Z2 = d[p2];
    const float gcx = 0.5f * (Z1.x + Z2.x), gcy = 0.5f * (Z1.y - Z2.y);
    const float gdx = 0.5f * (Z1.y + Z2.y), gdy = -0.5f * (Z1.x - Z2.x);
    const float s = 0.5f / (float)FN;
    float4 A; A.x = s * (gcx + gdx); A.y = s * (gcy + gdy); A.z = s * (gcx - gdx); A.w = s * (gcy - gdy);
    pq[p1] = A;
}
HD inline int tw_off(int lgm) { return lgm == 10 ? 0 : lgm == 8 ? 1024 : lgm == 6 ? 1280 : lgm == 4 ? 1344 : lgm == 2 ? 1360 : 1364; }
#ifndef FFT_HOST_TEST
template <int LGM, bool INV>
__device__ __forceinline__ void fft_pass(float2* d, const float2* twl, const float2* twg, int tid) {
    const float2* tw = (LGM == 12) ? twg : twl + tw_off(LGM);
#pragma unroll
    for (int it = 0; it < 2; ++it) {
        const int q = tid + it * 4 * NTHR;
        Bfly b0, b1, b2, b3;
        bfly_load(b0, d, tw, LGM, q); bfly_load(b1, d, tw, LGM, q + NTHR); bfly_load(b2, d, tw, LGM, q + 2 * NTHR); bfly_load(b3, d, tw, LGM, q + 3 * NTHR);
        if (INV) { bfly_inv_store(b0, d, LGM); bfly_inv_store(b1, d, LGM); bfly_inv_store(b2, d, LGM); bfly_inv_store(b3, d, LGM); }
        else { bfly_fwd_store(b0, d, LGM); bfly_fwd_store(b1, d, LGM); bfly_fwd_store(b2, d, LGM); bfly_fwd_store(b3, d, LGM); }
    }
    __syncthreads();
}
template <int LGM, bool INV, bool HALF>
__device__ __forceinline__ void fft_pass16(float2* d, const float2* twl, const float2* twg, int tid) {
    const float2* twO = (LGM + 2 == 12) ? twg : twl + tw_off(LGM + 2);
    const float2* twI = twl + tw_off(LGM);
    r16_bfly<INV, HALF>(d, twO, twI, LGM, tid);
    r16_bfly<INV, HALF>(d, twO, twI, LGM, tid + NTHR);
    __syncthreads();
}
template <bool HALF>
__device__ __forceinline__ void fft_forward(float2* d, const float2* twl, const float2* twg) {
    int tid = threadIdx.x; asm volatile("" : "+v"(tid));
    fft_pass16<10, false, HALF>(d, twl, twg, tid); fft_pass16<6, false, false>(d, twl, twg, tid);
    fft_pass<4, false>(d, twl, twg, tid); fft_pass<2, false>(d, twl, twg, tid); fft_pass<0, false>(d, twl, twg, tid);
}
template <bool HALF>
__device__ __forceinline__ void fft_inverse(float2* d, const float2* twl, const float2* twg) {
    int tid = threadIdx.x; asm volatile("" : "+v"(tid));
    fft_pass<0, true>(d, twl, twg, tid); fft_pass<2, true>(d, twl, twg, tid); fft_pass<4, true>(d, twl, twg, tid);
    fft_pass16<6, true, false>(d, twl, twg, tid); fft_pass16<10, true, HALF>(d, twl, twg, tid);
}
__device__ __forceinline__ float2* fft_lds_twiddles(const float2* twg, unsigned char* lds) {
    int tid = threadIdx.x; asm volatile("" : "+v"(tid));
    float2* t = (float2*)(lds + 131072);
    for (int k = tid; k < 1365; k += NTHR) {
        const int lgm = k < 1024 ? 10 : k < 1280 ? 8 : k < 1344 ? 6 : k < 1360 ? 4 : k < 1364 ? 2 : 0;
        t[k] = twg[(k - tw_off(lgm)) << (12 - lgm)];
    }
    __syncthreads();
    return t;
}

constexpr int STG = 49152;
__device__ __forceinline__ int swz(int row, int ch) { return row * 128 + ((ch ^ ((row >> 1) & 7)) << 4); }
__device__ __forceinline__ void gemm_core(f32x4 (&acc)[4][4], const bf16_t* A, int lda, const bf16_t* Bt, int ldb, int K, unsigned char* lds) {
    int tid_ = threadIdx.x; asm volatile("" : "+v"(tid_)); const int tid = tid_, lane = tid & 63, w = tid >> 6, wm = w & 3, wn = w >> 2, l15 = lane & 15, q4 = lane >> 4;
    const int wu = __builtin_amdgcn_readfirstlane(w);
    __attribute__((address_space(3))) unsigned char* l3 = (__attribute__((address_space(3))) unsigned char*)lds;
#pragma unroll
    for (int mi = 0; mi < 4; ++mi)
#pragma unroll
        for (int ni = 0; ni < 4; ++ni) acc[mi][ni] = (f32x4){0.f, 0.f, 0.f, 0.f};
    const int r8 = lane >> 3, sch = (lane & 7) ^ ((((w & 1) << 2) + (r8 >> 1)) & 7);
    const bf16_t* ap = A + (size_t)(w * 8 + r8) * lda + sch * 8;
    const bf16_t* bp = Bt + (size_t)(w * 8 + r8) * ldb + sch * 8;
#define GC_STAGE(buf, k0)                                                                                                                         \
    {                                                                                                                                             \
        _Pragma("unroll") for (int i = 0; i < 4; ++i)                                                                                             \
            __builtin_amdgcn_global_load_lds((const unsigned*)(ap + (size_t)(64 * i) * lda + (k0)), (__attribute__((address_space(3))) unsigned*)(l3 + (buf) * STG + (wu + 8 * i) * 1024), 16, 0, 0);          \
        _Pragma("unroll") for (int i = 0; i < 2; ++i)                                                                                             \
            __builtin_amdgcn_global_load_lds((const unsigned*)(bp + (size_t)(64 * i) * ldb + (k0)), (__attribute__((address_space(3))) unsigned*)(l3 + (buf) * STG + 32768 + (wu + 8 * i) * 1024), 16, 0, 0);  \
    }
    GC_STAGE(0, 0)
    asm volatile("s_waitcnt vmcnt(0)" ::: "memory");
    __syncthreads();
    const int nk = K >> 6;
    for (int kt = 0; kt < nk; ++kt) {
        if (kt + 1 < nk) GC_STAGE((kt + 1) & 1, (kt + 1) << 6)
        const unsigned char* sa = lds + (kt & 1) * STG;
        const unsigned char* sb = sa + 32768;
#pragma unroll
        for (int ks = 0; ks < 2; ++ks) {
            bf16x8 af[4], bfr[4];
#pragma unroll
            for (int mi = 0; mi < 4; ++mi) af[mi] = *(const bf16x8*)(sa + swz(wm * 64 + mi * 16 + l15, ks * 4 + q4));
#pragma unroll
            for (int ni = 0; ni < 4; ++ni) bfr[ni] = *(const bf16x8*)(sb + swz(wn * 64 + ni * 16 + l15, ks * 4 + q4));
#pragma unroll
            for (int mi = 0; mi < 4; ++mi)
#pragma unroll
                for (int ni = 0; ni < 4; ++ni) acc[mi][ni] = MFMA(bfr[ni], af[mi], acc[mi][ni]);
        }
        asm volatile("s_waitcnt vmcnt(0)" ::: "memory");
        __syncthreads();
    }
#undef GC_STAGE
}
#define EPI_LOOP(body)                                                                                                  \
    {                                                                                                                   \
        int e_t = threadIdx.x; asm volatile("" : "+v"(e_t)); const int e_lane = e_t & 63, e_w = e_t >> 6;                                                    \
        _Pragma("unroll") for (int mi = 0; mi < 4; ++mi) _Pragma("unroll") for (int ni = 0; ni < 4; ++ni) {             \
            const int row = m0 + (e_w & 3) * 64 + mi * 16 + (e_lane & 15);                                              \
            const int col = n0 + (e_w >> 2) * 64 + ni * 16 + 4 * (e_lane >> 4);                                         \
            f32x4& v = acc[mi][ni];                                                                                     \
            body                                                                                                        \
        }                                                                                                               \
    }
__device__ __forceinline__ void st_bf4(bf16_t* dst, f32x4 v) {
    u32x2 o; o.x = pk2(v[0], v[1]); o.y = pk2(v[2], v[3]); *(u32x2*)dst = o;
}
__device__ __forceinline__ f32x4 ld_bf4(const bf16_t* src) {
    const u32x2 u = *(const u32x2*)src; f32x4 r = {lo16(u.x), hi16(u.x), lo16(u.y), hi16(u.y)}; return r;
}


__device__ __forceinline__ void merge_tile(const bf16_t* P, const bf16_t* WtBr, bf16_t* merged, int m0, int n0, unsigned char* lds) {
    int tid_ = threadIdx.x; asm volatile("" : "+v"(tid_)); const int tid = tid_, lane = tid & 63, w = tid >> 6, wm = w & 3, wn = w >> 2, l15 = lane & 15, q4 = lane >> 4;
    const int wu = __builtin_amdgcn_readfirstlane(w);
    __attribute__((address_space(3))) unsigned char* l3 = (__attribute__((address_space(3))) unsigned char*)lds;
    f32x4 acc[4][4], macc[4][4];
#pragma unroll
    for (int mi = 0; mi < 4; ++mi)
#pragma unroll
        for (int ni = 0; ni < 4; ++ni) { acc[mi][ni] = (f32x4){0.f, 0.f, 0.f, 0.f}; macc[mi][ni] = (f32x4){0.f, 0.f, 0.f, 0.f}; }
    const int r8 = lane >> 3, sch = (lane & 7) ^ ((((w & 1) << 2) + (r8 >> 1)) & 7);
    const bf16_t* ap = P + (size_t)(m0 + w * 8 + r8) * PS + sch * 8;
    const bf16_t* bp = WtBr + (size_t)(n0 + w * 8 + r8) * 512 + sch * 8;
    const bf16_t* sgp = P + (size_t)(m0 + wm * 64 + l15) * PS + C_SG + n0 + wn * 64 + 4 * q4;
#define MG_STAGE(buf, kt_)                                                                                                                        \
    {                                                                                                                                             \
        const int j_ = (kt_) >> 3, k0_ = ((kt_) & 7) << 6;                                                                                        \
        const int acol_ = (j_ == 0) ? C_NAQ : (j_ == 1) ? C_HY : (j_ == 2) ? C_GV : C_MQ;                                                        \
        _Pragma("unroll") for (int i = 0; i < 4; ++i)                                                                                             \
            __builtin_amdgcn_global_load_lds((const unsigned*)(ap + (size_t)(64 * i) * PS + acol_ + k0_), (__attribute__((address_space(3))) unsigned*)(l3 + (buf) * STG + (wu + 8 * i) * 1024), 16, 0, 0);      \
        _Pragma("unroll") for (int i = 0; i < 2; ++i)                                                                                             \
            __builtin_amdgcn_global_load_lds((const unsigned*)(bp + (size_t)j_ * 1024 * 512 + (size_t)(64 * i) * 512 + k0_), (__attribute__((address_space(3))) unsigned*)(l3 + (buf) * STG + 32768 + (wu + 8 * i) * 1024), 16, 0, 0);  \
    }
    MG_STAGE(0, 0)
    MG_STAGE(1, 1)
    asm volatile("s_waitcnt vmcnt(6)" ::: "memory");
    __builtin_amdgcn_s_barrier(); asm volatile("" ::: "memory");
    int cb = 0;
#pragma unroll 1
    for (int kt = 0; kt < 32; ++kt) {
        const bool last = (kt & 7) == 7;
        u32x2 sg[4][4];
        if (last) {
            const bf16_t* sp = sgp + 1024 * (kt >> 3);
#pragma unroll
            for (int mi = 0; mi < 4; ++mi)
#pragma unroll
                for (int ni = 0; ni < 4; ++ni) sg[mi][ni] = *(const u32x2*)(sp + (size_t)(mi * 16) * PS + ni * 16);
        }
        const int nb = (cb == 0) ? 2 : cb - 1;
        if (kt + 2 < 32) MG_STAGE(nb, kt + 2)
        const unsigned char* sa = lds + cb * STG;
        const unsigned char* sb = sa + 32768;
#pragma unroll
        for (int ks = 0; ks < 2; ++ks) {
            bf16x8 af[4], bfr[4];
#pragma unroll
            for (int mi = 0; mi < 4; ++mi) af[mi] = *(const bf16x8*)(sa + swz(wm * 64 + mi * 16 + l15, ks * 4 + q4));
#pragma unroll
            for (int ni = 0; ni < 4; ++ni) bfr[ni] = *(const bf16x8*)(sb + swz(wn * 64 + ni * 16 + l15, ks * 4 + q4));
            __builtin_amdgcn_s_setprio(1);
#pragma unroll
            for (int mi = 0; mi < 4; ++mi)
#pragma unroll
                for (int ni = 0; ni < 4; ++ni) acc[mi][ni] = MFMA(bfr[ni], af[mi], acc[mi][ni]);
            __builtin_amdgcn_s_setprio(0);
        }
        if (kt + 2 < 32) asm volatile("s_waitcnt vmcnt(6)" ::: "memory"); else asm volatile("s_waitcnt vmcnt(0)" ::: "memory");
        if (last) {
#pragma unroll
            for (int mi = 0; mi < 4; ++mi)
#pragma unroll
                for (int ni = 0; ni < 4; ++ni) {
                    const u32x2 u = sg[mi][ni]; const f32x4 g4 = {lo16(u.x), hi16(u.x), lo16(u.y), hi16(u.y)};
                    macc[mi][ni] += g4 * acc[mi][ni]; acc[mi][ni] = (f32x4){0.f, 0.f, 0.f, 0.f};
                }
        }
        asm volatile("" ::: "memory"); __builtin_amdgcn_s_barrier(); asm volatile("" ::: "memory");
        cb = (cb == 2) ? 0 : cb + 1;
    }
#undef MG_STAGE
    __syncthreads();
#pragma unroll
    for (int mi = 0; mi < 4; ++mi)
#pragma unroll
        for (int ni = 0; ni < 4; ++ni) st_bf4(merged + (size_t)(m0 + wm * 64 + mi * 16 + l15) * 1024 + n0 + wn * 64 + ni * 16 + 4 * q4, macc[mi][ni]);
}

__device__ __forceinline__ int orig_col(int n) {
    if (n < 4096) return n;
    if (n < 4608) return n + 32;
    if (n < 6656) return n + 32;
    if (n < 10752) return n + 32;
    return n - 10752 + 4096;
}

__device__ __forceinline__ void ln_rows(const float* src, size_t src_row0, int nrows, const float* g, const float* b, float* dst32, bf16_t* dst16, size_t dst_row0, float2* stats) {
    int tid_ = threadIdx.x; asm volatile("" : "+v"(tid_));
    const int lane = tid_ & 63;
    const int gw = blockIdx.x * (NTHR / 64) + (tid_ >> 6), nw = gridDim.x * (NTHR / 64);
    for (int r = gw; r < nrows; r += nw) {
        const float4* xr = (const float4*)(src + (src_row0 + r) * 1024);
        float4 v[4]; float s = 0.f;
#pragma unroll
        for (int i = 0; i < 4; ++i) { v[i] = xr[lane + 64 * i]; s += (v[i].x + v[i].y) + (v[i].z + v[i].w); }
        s = wave_sum(s);
        const float mean = s * (1.0f / 1024.0f);
        float q = 0.f;
#pragma unroll
        for (int i = 0; i < 4; ++i) { const float a = v[i].x - mean, bb = v[i].y - mean, c = v[i].z - mean, d = v[i].w - mean; q += (a * a + bb * bb) + (c * c + d * d); }
        q = wave_sum(q);
        const float rstd = 1.0f / sqrtf(q * (1.0f / 1024.0f) + 1e-5f);
        if (stats && lane == 0) { float2 st; st.x = mean; st.y = rstd; stats[dst_row0 + r] = st; }
#pragma unroll
        for (int i = 0; i < 4; ++i) {
            const float4 g4 = ((const float4*)g)[lane + 64 * i], b4 = ((const float4*)b)[lane + 64 * i];
            float4 y; y.x = (v[i].x - mean) * rstd * g4.x + b4.x; y.y = (v[i].y - mean) * rstd * g4.y + b4.y; y.z = (v[i].z - mean) * rstd * g4.z + b4.z; y.w = (v[i].w - mean) * rstd * g4.w + b4.w;
            if (dst32) ((float4*)(dst32 + (dst_row0 + r) * 1024))[lane + 64 * i] = y;
            if (dst16) { u32x2 o; o.x = pk2(y.x, y.y); o.y = pk2(y.z, y.w); *(u32x2*)(dst16 + (dst_row0 + r) * 1024 + (lane + 64 * i) * 4) = o; }
        }
    }
}
__device__ __forceinline__ void phase0(const Params& p) {
    ln_rows(p.x, 0, NTOK, p.ln_in_g, p.ln_in_b, nullptr, (bf16_t*)(p.ws + OFF_HB), 0, (float2*)(p.ws + OFF_STATS));
    int tid_ = threadIdx.x; asm volatile("" : "+v"(tid_)); const int gt = blockIdx.x * NTHR + tid_, nt = gridDim.x * NTHR;
    float2* tw = (float2*)(p.ws + OFF_TW);
    for (int k = gt; k < FN; k += nt) { double s, c; sincospi(-2.0 * (double)k / (double)FN, &s, &c); float2 t; t.x = (float)c; t.y = (float)s; tw[k] = t; }
    bf16_t* mb = (bf16_t*)(p.ws + OFF_MEMBF);
    for (int i = gt; i < 2048 * 1024 / 4; i += nt) { const float4 v = ((const float4*)p.mem)[i]; u32x2 o; o.x = pk2(v.x, v.y); o.y = pk2(v.z, v.w); ((u32x2*)mb)[i] = o; }
    float* en = (float*)(p.ws + OFF_ENERGY);
    for (int i = gt; i < 1024; i += nt) en[i] = 0.f;
    float* ztab = (float*)(p.ws + OFF_ZT);
    for (int idx = gt; idx < 8192 * 33; idx += nt) {
        const int n = idx / 33, e = idx - n * 33;
        float v;
        if (e == 0) v = (float)n / 8191.0f;
        else {
            const int i = (e - 1) & 15;
            const double fr = 1e-4 + (double)i * ((15.0 - 1e-4) / 15.0);
            const double ang = (2.0 * 3.14159265358979323846 / 8192.0) * (double)n * fr;
            v = (e <= 16) ? (float)cos(ang) : (float)(-sin(ang));
        }
        ztab[idx] = v;
    }
}

__device__ __forceinline__ void wt_tile(const float* src, int src_ld, int k0, int on0, bf16_t* dst, int dst_ld, int dn0, bool zero, float* tile) {
    int tid_ = threadIdx.x; asm volatile("" : "+v"(tid_)); const int tid = tid_;
    if (!zero) {
#pragma unroll
        for (int i = 0; i < 2; ++i) {
            const int k = (tid >> 3) + 64 * i, c4 = (tid & 7) * 4;
            const float4 v = *(const float4*)(src + (size_t)(k0 + k) * src_ld + on0 + c4);
            float* t = tile + k * 33 + c4; t[0] = v.x; t[1] = v.y; t[2] = v.z; t[3] = v.w;
        }
    }
    __syncthreads();
    const int n = tid >> 4, kc = (tid & 15) * 8;
    float f[8];
#pragma unroll
    for (int e = 0; e < 8; ++e) f[e] = zero ? 0.f : tile[(kc + e) * 33 + n];
    u32x4 o; o.x = pk2(f[0], f[1]); o.y = pk2(f[2], f[3]); o.z = pk2(f[4], f[5]); o.w = pk2(f[6], f[7]);
    *(u32x4*)(dst + (size_t)(dn0 + n) * dst_ld + k0 + kc) = o;
    __syncthreads();
}
__device__ __forceinline__ void phase_weights(const Params& p, int l, unsigned char* lds) {
    float* tile = (float*)lds;
    for (int it = blockIdx.x; it < 3776; it += gridDim.x) {
        if (it < 2752) {
            const int nt = it >> 3, kt = it & 7, dn0 = nt * 32;
            wt_tile(p.w_in + (size_t)l * 1024 * NIN, NIN, kt * 128, orig_col(dn0), (bf16_t*)(p.ws + OFF_WTIN), 1024, dn0, dn0 >= NIN, tile);
        } else if (it < 3264) {
            const int r = it - 2752, j = r >> 7, nt = (r >> 2) & 31, kt = r & 3;
            wt_tile(p.w_br + (size_t)(l * 4 + j) * 512 * 1024, 1024, kt * 128, nt * 32, (bf16_t*)(p.ws + OFF_WTBR) + (size_t)j * 1024 * 512, 512, nt * 32, false, tile);
        } else if (it < 3520) {
            const int r = it - 3264, nt = r >> 3, kt = r & 7;
            wt_tile(p.w_out + (size_t)l * 1024 * 1024, 1024, kt * 128, nt * 32, (bf16_t*)(p.ws + OFF_WTOUT), 1024, nt * 32, false, tile);
        } else {
            const int r = it - 3520, nt = r >> 3, kt = r & 7;
            wt_tile(p.mem_w_kv + (size_t)l * 1024 * 1024, 1024, kt * 128, nt * 32, (bf16_t*)(p.ws + OFF_WTKV), 1024, nt * 32, false, tile);
        }
    }
}

__device__ __forceinline__ void phase_filter_gen(const Params& p, int l, unsigned char* lds) {
    float* zt = (float*)lds;
    float* ha = zt + 32 * 33;
    float* hbuf = ha + 32 * 64;
    int tid_ = threadIdx.x; asm volatile("" : "+v"(tid_)); const int tid = tid_;
    const float* w1 = p.hy_w1 + (size_t)l * 33 * 64; const float* b1 = p.hy_b1 + l * 64;
    const float* wm = p.hy_wm + (size_t)l * 2 * 64 * 64; const float* bm = p.hy_bm + l * 2 * 64;
    const float* w3 = p.hy_w3 + (size_t)l * 64 * 1024;
    float* hf = (float*)(p.ws + OFF_HFILT);
    float* en = (float*)(p.ws + OFF_ENERGY) + l * 512;
    const float* ztab = (const float*)(p.ws + OFF_ZT);
    for (int it = blockIdx.x; it < 256; it += gridDim.x) {
        const int n0 = it * 32;
        for (int idx = tid; idx < 32 * 33; idx += NTHR) zt[idx] = ztab[(size_t)n0 * 33 + idx];
        __syncthreads();
        for (int idx = tid; idx < 2048; idx += NTHR) {
            const int pos = idx >> 6, j = idx & 63; float s = b1[j];
            for (int e = 0; e < 33; ++e) s += zt[pos * 33 + e] * w1[e * 64 + j];
            ha[idx] = sinf(s);
        }
        __syncthreads();
        for (int idx = tid; idx < 2048; idx += NTHR) {
            const int pos = idx >> 6, j = idx & 63; float s = bm[j];
            for (int e = 0; e < 64; ++e) s += ha[pos * 64 + e] * wm[e * 64 + j];
            hbuf[idx] = sinf(s);
        }
        __syncthreads();
        for (int idx = tid; idx < 2048; idx += NTHR) {
            const int pos = idx >> 6, j = idx & 63; float s = bm[64 + j];
            for (int e = 0; e < 64; ++e) s += hbuf[pos * 64 + e] * wm[4096 + e * 64 + j];
            ha[idx] = sinf(s);
        }
        __syncthreads();
        {
            const int c = tid;
            float af[32], ab[32];
#pragma unroll
            for (int i = 0; i < 32; ++i) { af[i] = 0.f; ab[i] = 0.f; }
            for (int k = 0; k < 64; ++k) {
                const float wf = w3[k * 1024 + c], wb = w3[k * 1024 + 512 + c];
#pragma unroll
                for (int i = 0; i < 32; ++i) { const float h = ha[i * 64 + k]; af[i] += h * wf; ab[i] += h * wb; }
            }
            const float dmin = -3.0701134573253945f, dmax = -15.350567286626973f;
            const float delta = fabsf(dmin + (float)c * ((dmax - dmin) / 511.0f));
            float e = 0.f;
#pragma unroll
            for (int i = 0; i < 32; ++i) {
                const int n = n0 + i; const float t01 = (float)n / 8191.0f; const float win = expf(-t01 * delta);
                af[i] *= win; ab[i] *= win; e += af[i] * af[i]; if (n >= 1) e += ab[i] * ab[i];
            }
#pragma unroll
            for (int i = 0; i < 8; ++i) {
                float4 a; a.x = af[4 * i]; a.y = af[4 * i + 1]; a.z = af[4 * i + 2]; a.w = af[4 * i + 3];
                float4 b; b.x = ab[4 * i]; b.y = ab[4 * i + 1]; b.z = ab[4 * i + 2]; b.w = ab[4 * i + 3];
                *(float4*)(hf + (size_t)c * 8192 + n0 + 4 * i) = a;
                *(float4*)(hf + (size_t)(512 + c) * 8192 + n0 + 4 * i) = b;
            }
            atomicAdd(en + c, e);
        }
        __syncthreads();
    }
}

__device__ __forceinline__ void phase_filter_fft(const Params& p, int l, unsigned char* lds) {
    float2* d = (float2*)lds;
    const float2* tw = fft_lds_twiddles((const float2*)(p.ws + OFF_TW), lds);
    const float* hf = (const float*)(p.ws + OFF_HFILT);
    const float* en = (const float*)(p.ws + OFF_ENERGY) + l * 512;
    float4* pqa = (float4*)(p.ws + OFF_PQ);
    int tid_ = threadIdx.x; asm volatile("" : "+v"(tid_)); const int tid = tid_;
    for (int pr = blockIdx.x; pr < 256; pr += gridDim.x) {
        const int c0 = 2 * pr, c1 = c0 + 1;
        const float s0 = 1.0f / sqrtf(en[c0] + 1e-6f), s1 = 1.0f / sqrtf(en[c1] + 1e-6f);
        const float k0 = p.hy_skip[l * 512 + c0], k1 = p.hy_skip[l * 512 + c1];
        for (int n = tid; n < FN; n += NTHR) {
            float2 v;
            if (n < 8192) { v.x = hf[(size_t)c0 * 8192 + n] * s0; v.y = hf[(size_t)c1 * 8192 + n] * s1; if (n == 0) { v.x += k0; v.y += k1; } }
            else if (n == 8192) { v.x = 0.f; v.y = 0.f; }
            else { v.x = hf[(size_t)(512 + c0) * 8192 + (FN - n)] * s0; v.y = hf[(size_t)(512 + c1) * 8192 + (FN - n)] * s1; }
            d[n] = v;
        }
        __syncthreads();
        fft_forward<false>(d, tw, (const float2*)(p.ws + OFF_TW));
        for (int h = tid; h < FN / 2; h += NTHR) filt_pointwise(d, pqa + (size_t)pr * FN, 2 * h);
        if (tid == 0) filt_pointwise(d, pqa + (size_t)pr * FN, 1);
        __syncthreads();
    }
}

__device__ __forceinline__ void hy_pre_item(const Params& p, int l, const bf16_t* P, float* UT, bf16_t* GT, int bl, int tt, int ct, unsigned char* lds) {
    float* tU = (float*)lds;
    float* tG = tU + 64 * 65;
    int tid_ = threadIdx.x; asm volatile("" : "+v"(tid_)); const int tid = tid_;
    const int t = tid >> 3, cc = (tid & 7) * 8, c = ct * 64 + cc, tb = tt * 64 + t;
    const float* cw = p.hy_conv_w + (size_t)l * 3 * 1536; const float* cb = p.hy_conv_b + l * 1536;
    float av[8], a0[8], a1[8];
#pragma unroll
    for (int h = 0; h < 2; ++h) {
        const f32x4 bv = *(const f32x4*)(cb + c + 4 * h), b0 = *(const f32x4*)(cb + 512 + c + 4 * h), b1 = *(const f32x4*)(cb + 1024 + c + 4 * h);
#pragma unroll
        for (int e = 0; e < 4; ++e) { av[4 * h + e] = bv[e]; a0[4 * h + e] = b0[e]; a1[4 * h + e] = b1[e]; }
    }
#pragma unroll
    for (int j = 0; j < 3; ++j) {
        const int ts = tb + j - 1;
        if (ts >= 0 && ts < SEQ) {
            const bf16_t* row = P + (size_t)(bl * SEQ + ts) * PS + C_HY + c;
            const u32x4 rv = *(const u32x4*)row, r0 = *(const u32x4*)(row + 512), r1 = *(const u32x4*)(row + 1024);
#pragma unroll
            for (int h = 0; h < 2; ++h) {
                const f32x4 wv = *(const f32x4*)(cw + j * 1536 + c + 4 * h), w0 = *(const f32x4*)(cw + j * 1536 + 512 + c + 4 * h), w1 = *(const f32x4*)(cw + j * 1536 + 1024 + c + 4 * h);
#pragma unroll
                for (int e = 0; e < 4; ++e) {
                    const int k = 4 * h + e; const unsigned uv = rv[k >> 1], u0 = r0[k >> 1], u1 = r1[k >> 1];
                    av[k] += wv[e] * ((k & 1) ? hi16(uv) : lo16(uv)); a0[k] += w0[e] * ((k & 1) ? hi16(u0) : lo16(u0)); a1[k] += w1[e] * ((k & 1) ? hi16(u1) : lo16(u1));
                }
            }
        }
    }
    const u32x4 rz = *(const u32x4*)(P + (size_t)(bl * SEQ + tb) * PS + C_Z + 512 + c);
#pragma unroll
    for (int k = 0; k < 8; ++k) {
        const unsigned uz = rz[k >> 1]; const float z = (k & 1) ? hi16(uz) : lo16(uz);
        tU[(cc + k) * 65 + t] = av[k] * a1[k]; tG[(cc + k) * 65 + t] = a0[k] * z;
    }
    __syncthreads();
    const int c2 = tid >> 3, t8 = (tid & 7) * 8;
    const size_t o = (size_t)(bl * 512 + ct * 64 + c2) * SEQ + tt * 64 + t8;
    const float* su = tU + c2 * 65 + t8; const float* sg = tG + c2 * 65 + t8;
    f32x4 ua = {su[0], su[1], su[2], su[3]}, ub = {su[4], su[5], su[6], su[7]};
    *(f32x4*)(UT + o) = ua; *(f32x4*)(UT + o + 4) = ub;
    u32x4 g; g.x = pk2(sg[0], sg[1]); g.y = pk2(sg[2], sg[3]); g.z = pk2(sg[4], sg[5]); g.w = pk2(sg[6], sg[7]);
    *(u32x4*)(GT + o) = g;
    __syncthreads();
}
__device__ __forceinline__ void hy_post_item(bf16_t* P, const bf16_t* GT, int bl, int tt, int ct, unsigned char* lds, int dry = 0) {
    bf16_t* tl = (bf16_t*)lds;
    int tid_ = threadIdx.x; asm volatile("" : "+v"(tid_)); const int tid = tid_;
    const int c2 = tid >> 3, t8 = (tid & 7) * 8;
    const u32x4 v = *(const u32x4*)(GT + (size_t)(bl * 512 + ct * 64 + c2) * SEQ + tt * 64 + t8);
    bf16_t* d0 = tl + t8 * 72 + c2;
    d0[0 * 72] = (bf16_t)(v.x & 0xffffu); d0[1 * 72] = (bf16_t)(v.x >> 16); d0[2 * 72] = (bf16_t)(v.y & 0xffffu); d0[3 * 72] = (bf16_t)(v.y >> 16);
    d0[4 * 72] = (bf16_t)(v.z & 0xffffu); d0[5 * 72] = (bf16_t)(v.z >> 16); d0[6 * 72] = (bf16_t)(v.w & 0xffffu); d0[7 * 72] = (bf16_t)(v.w >> 16);
    __syncthreads();
    const int t = tid >> 3, cc = (tid & 7) * 8;
    const u32x4 ov = *(const u32x4*)(tl + t * 72 + cc);
    if (!dry) *(u32x4*)(P + (size_t)(bl * SEQ + tt * 64 + t) * PS + C_HY + ct * 64 + cc) = ov;
    __syncthreads();
}
__device__ __forceinline__ void hyena_conv_item(const Params& p, const float* UT, bf16_t* GT, int bl, int pr, unsigned char* lds, const float2* tw, int dry = 0) {
    float2* d = (float2*)lds;
    const float4* pq = (const float4*)(p.ws + OFF_PQ) + (size_t)pr * FN;
    int tid_ = threadIdx.x; asm volatile("" : "+v"(tid_)); const int tid = tid_;
    const float* u0 = UT + (size_t)(bl * 512 + 2 * pr) * SEQ; const float* u1 = u0 + SEQ;
    bf16_t* g0 = GT + (size_t)(bl * 512 + 2 * pr) * SEQ; bf16_t* g1 = g0 + SEQ;
    {
        float f0[16], f1[16];
#pragma unroll
        for (int i = 0; i < 16; ++i) { f0[i] = u0[tid + NTHR * i]; f1[i] = u1[tid + NTHR * i]; }
#pragma unroll
        for (int i = 0; i < 16; ++i) {
            float2 u; u.x = f0[i]; u.y = f1[i]; d[tid + NTHR * i] = u;
        }
    }
    __syncthreads();
    fft_forward<true>(d, tw, (const float2*)(p.ws + OFF_TW));
#pragma unroll 1
    for (int h = tid; h < FN / 2; h += 4 * NTHR) {
        PwIn w0, w1, w2, w3;
        pw_load(w0, d, pq, 2 * h); pw_load(w1, d, pq, 2 * (h + NTHR)); pw_load(w2, d, pq, 2 * (h + 2 * NTHR)); pw_load(w3, d, pq, 2 * (h + 3 * NTHR));
        pw_store(w0, d); pw_store(w1, d); pw_store(w2, d); pw_store(w3, d);
    }
    if (tid == 0) conv_pointwise(d, pq, 1);
    __syncthreads();
    fft_inverse<true>(d, tw, (const float2*)(p.ws + OFF_TW));
    {
        bf16_t a0[16], a1[16];
#pragma unroll
        for (int i = 0; i < 16; ++i) { a0[i] = g0[tid + NTHR * i]; a1[i] = g1[tid + NTHR * i]; }
#pragma unroll
        for (int i = 0; i < 16; ++i) {
            const int t = tid + NTHR * i;
            const float2 y = d[t];
            const bf16_t r0 = f2bf_d(y.x * bf2f(a0[i])), r1 = f2bf_d(y.y * bf2f(a1[i]));
            if (!dry) { g0[t] = r0; g1[t] = r1; }
        }
    }
    __syncthreads();
}

__device__ __forceinline__ void na_item(const Params& p, int l, bf16_t* P, int bl, int rp, int head, unsigned char* lds, int dry = 0) {
    bf16_t* Kimg = (bf16_t*)lds;
    bf16_t* VT = (bf16_t*)(lds + 82944);
    int tid_ = threadIdx.x; asm volatile("" : "+v"(tid_)); const int tid = tid_, lane = tid & 63, w = tid >> 6, l15 = lane & 15, q4 = lane >> 4;
    const int r0 = 2 * rp, rs0 = iclamp(r0 - 4, 0, 120);
#pragma unroll
    for (int i = 0; i < 9; ++i) {
        const int idx = tid + NTHR * i, key = idx >> 3, ch = idx & 7, grow = min(rs0 + (key >> 6), 127);
        const u32x4 kv = *(const u32x4*)(P + (size_t)(bl * SEQ + grow * 64 + (key & 63)) * PS + C_NAK + head * 64 + ch * 8);
        *(u32x4*)(Kimg + key * 72 + ch * 8) = kv;
    }
#pragma unroll
    for (int i = 0; i < 9; ++i) {
        const int idx = tid + NTHR * i, keyp = idx >> 2, chh = keyp >= 576 ? 1 : 0, key = keyp - chh * 576, ch = chh * 4 + (idx & 3), grow = min(rs0 + (key >> 6), 127);
        const u32x4 vv = *(const u32x4*)(P + (size_t)(bl * SEQ + grow * 64 + (key & 63)) * PS + C_NAV + head * 64 + ch * 8);
        bf16_t* vd = VT + (ch * 8) * 584 + key;
        vd[0 * 584] = (bf16_t)(vv.x & 0xffffu); vd[1 * 584] = (bf16_t)(vv.x >> 16);
        vd[2 * 584] = (bf16_t)(vv.y & 0xffffu); vd[3 * 584] = (bf16_t)(vv.y >> 16);
        vd[4 * 584] = (bf16_t)(vv.z & 0xffffu); vd[5 * 584] = (bf16_t)(vv.z >> 16);
        vd[6 * 584] = (bf16_t)(vv.w & 0xffffu); vd[7 * 584] = (bf16_t)(vv.w >> 16);
    }
    __syncthreads();
    const int rr = w >> 2, g = w & 3, r = r0 + rr, rs = iclamp(r - 4, 0, 120), lo = rs - rs0;
    const int cb = iclamp(16 * g - 8, 0, 32), c = 16 * g + l15, cs = iclamp(c - 8, 0, 48);
    bf16_t* qrow = P + (size_t)(bl * SEQ + r * 64 + c) * PS + head * 64;
    bf16x8 qf[2];
#pragma unroll
    for (int ks = 0; ks < 2; ++ks) qf[ks] = *(const bf16x8*)(qrow + ks * 32 + q4 * 8);
    f32x4 sc[16];
#pragma unroll
    for (int t = 0; t < 16; ++t) {
        const int kb = (lo + (t >> 1)) * 64 + cb + 16 * (t & 1);
        f32x4 a = {0.f, 0.f, 0.f, 0.f};
#pragma unroll
        for (int ks = 0; ks < 2; ++ks) { const bf16x8 kf = *(const bf16x8*)(Kimg + (kb + l15) * 72 + ks * 32 + q4 * 8); a = MFMA(kf, qf[ks], a); }
        sc[t] = a;
    }
    const float* rpb = p.na_rpb + (size_t)(l * 8 + head) * 15 * 31;
    float mx = -1e30f;
#pragma unroll
    for (int t = 0; t < 16; ++t) {
        const int drow = rs + (t >> 1) - r + 7;
#pragma unroll
        for (int e = 0; e < 4; ++e) {
            const int col = cb + 16 * (t & 1) + 4 * q4 + e;
            const bool ok = (col >= cs) && (col < cs + 16);
            const int dcol = ok ? (col - c + 15) : 0;
            const float v = ok ? (sc[t][e] + rpb[drow * 31 + dcol]) : -1e30f;
            sc[t][e] = v; mx = fmaxf(mx, v);
        }
    }
    mx = fmaxf(mx, __shfl_xor(mx, 16)); mx = fmaxf(mx, __shfl_xor(mx, 32));
    float sum = 0.f;
#pragma unroll
    for (int t = 0; t < 16; ++t)
#pragma unroll
        for (int e = 0; e < 4; ++e) { const float pe = __expf(sc[t][e] - mx); sc[t][e] = pe; sum += pe; }
    sum += __shfl_xor(sum, 16); sum += __shfl_xor(sum, 32);
    f32x4 o[4];
#pragma unroll
    for (int dt = 0; dt < 4; ++dt) o[dt] = (f32x4){0.f, 0.f, 0.f, 0.f};
#pragma unroll
    for (int kk = 0; kk < 8; ++kk) {
        u32x4 pu; pu.x = pk2(sc[2 * kk][0], sc[2 * kk][1]); pu.y = pk2(sc[2 * kk][2], sc[2 * kk][3]); pu.z = pk2(sc[2 * kk + 1][0], sc[2 * kk + 1][1]); pu.w = pk2(sc[2 * kk + 1][2], sc[2 * kk + 1][3]);
        const bf16x8 pf = mkfrag(pu);
        const int kbA = (lo + kk) * 64 + cb + 4 * q4;
#pragma unroll
        for (int dt = 0; dt < 4; ++dt) {
            const bf16_t* vr = VT + (dt * 16 + l15) * 584 + kbA;
            const bf16x8 vf = mkfrag2(*(const u32x2*)vr, *(const u32x2*)(vr + 16));
            o[dt] = MFMA(vf, pf, o[dt]);
        }
    }
    const float inv = 1.0f / sum;
    const bf16_t* zrow = P + (size_t)(bl * SEQ + r * 64 + c) * PS + C_Z + head * 64;
#pragma unroll
    for (int dt = 0; dt < 4; ++dt) {
        const int dd = dt * 16 + 4 * q4;
        const f32x4 z = ld_bf4(zrow + dd);
        if (!dry) st_bf4(qrow + dd, o[dt] * inv * z);
    }
    __syncthreads();
}

__device__ __forceinline__ void memattn_load(const Params& p, int b, int h, unsigned char* lds) {
    bf16_t* Kimg = (bf16_t*)lds;
    bf16_t* VT = (bf16_t*)(lds + 69632);
    const bf16_t* Km = (const bf16_t*)(p.ws + OFF_KMAT); const bf16_t* Vm = (const bf16_t*)(p.ws + OFF_VT);
    int tid_ = threadIdx.x; asm volatile("" : "+v"(tid_)); const int tid = tid_;
#pragma unroll
    for (int i = 0; i < 8; ++i) {
        const int idx = tid + NTHR * i;
        { const int key = idx >> 4, ch = idx & 15; *(u32x4*)(Kimg + key * 136 + ch * 8) = *(const u32x4*)(Km + (size_t)(b * 256 + key) * 512 + h * 128 + ch * 8); }
        { const int dd = idx >> 5, ch = idx & 31; *(u32x4*)(VT + dd * 264 + ch * 8) = *(const u32x4*)(Vm + (size_t)(h * 128 + dd) * 2048 + b * 256 + ch * 8); }
    }
    __syncthreads();
}
__device__ __forceinline__ void memattn_item(bf16_t* P, int bl, int h, int qt, unsigned char* lds, int dry = 0) {
    const bf16_t* Kimg = (const bf16_t*)lds; const bf16_t* VT = (const bf16_t*)(lds + 69632);
    int tid_ = threadIdx.x; asm volatile("" : "+v"(tid_)); const int tid = tid_, lane = tid & 63, w = tid >> 6, l15 = lane & 15, q4 = lane >> 4;
    const int tok = bl * SEQ + qt * 128 + w * 16 + l15;
    bf16_t* qrow = P + (size_t)tok * PS + C_MQ + h * 128;
    bf16x8 qf[4];
#pragma unroll
    for (int ks = 0; ks < 4; ++ks) qf[ks] = *(const bf16x8*)(qrow + ks * 32 + q4 * 8);
    f32x4 sc[16];
    float mx = -1e30f;
#pragma unroll
    for (int t = 0; t < 16; ++t) {
        f32x4 a = {0.f, 0.f, 0.f, 0.f};
#pragma unroll
        for (int ks = 0; ks < 4; ++ks) { const bf16x8 kf = *(const bf16x8*)(Kimg + (t * 16 + l15) * 136 + ks * 32 + q4 * 8); a = MFMA(kf, qf[ks], a); }
        sc[t] = a;
        mx = fmaxf(mx, fmaxf(fmaxf(a[0], a[1]), fmaxf(a[2], a[3])));
    }
    mx = fmaxf(mx, __shfl_xor(mx, 16)); mx = fmaxf(mx, __shfl_xor(mx, 32));
    float sum = 0.f;
#pragma unroll
    for (int t = 0; t < 16; ++t)
#pragma unroll
        for (int e = 0; e < 4; ++e) { const float pe = __expf(sc[t][e] - mx); sc[t][e] = pe; sum += pe; }
    sum += __shfl_xor(sum, 16); sum += __shfl_xor(sum, 32);
    f32x4 o[8];
#pragma unroll
    for (int dt = 0; dt < 8; ++dt) o[dt] = (f32x4){0.f, 0.f, 0.f, 0.f};
#pragma unroll
    for (int kk = 0; kk < 8; ++kk) {
        u32x4 pu; pu.x = pk2(sc[2 * kk][0], sc[2 * kk][1]); pu.y = pk2(sc[2 * kk][2], sc[2 * kk][3]); pu.z = pk2(sc[2 * kk + 1][0], sc[2 * kk + 1][1]); pu.w = pk2(sc[2 * kk + 1][2], sc[2 * kk + 1][3]);
        const bf16x8 pf = mkfrag(pu);
#pragma unroll
        for (int dt = 0; dt < 8; ++dt) {
            const bf16_t* vr = VT + (dt * 16 + l15) * 264 + kk * 32 + 4 * q4;
            const bf16x8 vf = mkfrag2(*(const u32x2*)vr, *(const u32x2*)(vr + 16));
            o[dt] = MFMA(vf, pf, o[dt]);
        }
    }
    const float inv = 1.0f / sum;
    const bf16_t* zrow = P + (size_t)tok * PS + C_Z + 3 * 512 + h * 128;
#pragma unroll
    for (int dt = 0; dt < 8; ++dt) {
        const int dd = dt * 16 + 4 * q4;
        const f32x4 z = ld_bf4(zrow + dd);
        if (!dry) st_bf4(qrow + dd, o[dt] * inv * z);
    }
}

constexpr int G_LRT = 0, G_BF = 8192, G_BB = 24576, G_TOT = 40960, G_IMG = 45056;
__device__ __forceinline__ void gla_tables(const Params& p, int l, const float* LR, int t0, int h, unsigned char* lds) {
    float* LRT = (float*)(lds + G_LRT); float* BF = (float*)(lds + G_BF); float* BB = (float*)(lds + G_BB); float* TOT = (float*)(lds + G_TOT);
    int tid_ = threadIdx.x; asm volatile("" : "+v"(tid_)); const int tid = tid_;
    ((float4*)LRT)[tid] = ((const float4*)(LR + (size_t)t0 * 32))[tid];
    __syncthreads();
    const int dk = tid & 63, cgp = tid >> 6;
    float uf[16], ub[16];
#pragma unroll
    for (int r = 0; r < 16; ++r) { uf[r] = p.gla_up_f[(size_t)(l * 16 + r) * 256 + h * 64 + dk]; ub[r] = p.gla_up_b[(size_t)(l * 16 + r) * 256 + h * 64 + dk]; }
    const float bif = p.gla_bias_f[l * 256 + h * 64 + dk], bib = p.gla_bias_b[l * 256 + h * 64 + dk];
    float lf[8], lb[8];
#pragma unroll
    for (int i = 0; i < 8; ++i) {
        const int c = cgp * 8 + i; float sf = bif, sb = bib;
#pragma unroll
        for (int r = 0; r < 16; ++r) { sf += LRT[c * 32 + r] * uf[r]; sb += LRT[c * 32 + 16 + r] * ub[r]; }
        lf[i] = logsigf_(sf) * (1.0f / 16.0f); lb[i] = logsigf_(sb) * (1.0f / 16.0f);
    }
#pragma unroll
    for (int i = 1; i < 8; ++i) lf[i] += lf[i - 1];
#pragma unroll
    for (int i = 6; i >= 0; --i) lb[i] += lb[i + 1];
    TOT[cgp * 64 + dk] = lf[7]; TOT[512 + cgp * 64 + dk] = lb[0];
    __syncthreads();
    float of = 0.f, ob = 0.f;
#pragma unroll
    for (int g2 = 0; g2 < 8; ++g2) { if (g2 < cgp) of += TOT[g2 * 64 + dk]; if (g2 > cgp) ob += TOT[512 + g2 * 64 + dk]; }
#pragma unroll
    for (int i = 0; i < 8; ++i) { BF[(cgp * 8 + i) * 64 + dk] = lf[i] + of; BB[(cgp * 8 + i) * 64 + dk] = lb[i] + ob; }
    __syncthreads();
}
struct GlaPre { u32x4 vv[2]; bf16_t q[8], k[8]; };
__device__ __forceinline__ void gla_prefetch(GlaPre& g, const bf16_t* P, int t0, int h, int tid) {
#pragma unroll
    for (int i = 0; i < 2; ++i) { const int idx = tid + NTHR * i, chn = idx >> 6, c = idx & 63; g.vv[i] = *(const u32x4*)(P + (size_t)(t0 + c) * PS + C_GV + h * 128 + chn * 8); }
#pragma unroll
    for (int i = 0; i < 8; ++i) { const int idx = tid + NTHR * i, c = idx >> 6, dk = idx & 63; g.q[i] = P[(size_t)(t0 + c) * PS + C_GQ + h * 64 + dk]; g.k[i] = P[(size_t)(t0 + c) * PS + C_GK + h * 64 + dk]; }
}
__device__ __forceinline__ void gla_vt_store(const GlaPre& g, bf16_t* VT, int tid) {
#pragma unroll
    for (int i = 0; i < 2; ++i) {
        const int idx = tid + NTHR * i, chn = idx >> 6, c = idx & 63;
        const u32x4 vv = g.vv[i];
        bf16_t* vd = VT + (chn * 8) * 72 + c;
        vd[0 * 72] = (bf16_t)(vv.x & 0xffffu); vd[1 * 72] = (bf16_t)(vv.x >> 16);
        vd[2 * 72] = (bf16_t)(vv.y & 0xffffu); vd[3 * 72] = (bf16_t)(vv.y >> 16);
        vd[4 * 72] = (bf16_t)(vv.z & 0xffffu); vd[5 * 72] = (bf16_t)(vv.z >> 16);
        vd[6 * 72] = (bf16_t)(vv.w & 0xffffu); vd[7 * 72] = (bf16_t)(vv.w >> 16);
    }
}
__device__ __forceinline__ void gla_part1_item(const Params& p, int l, const bf16_t* P, const float* LR, int item, unsigned char* lds) {
    const int h = item & 3, n = (item >> 2) & 127, bl = item >> 9, t0 = bl * SEQ + n * 64;
    const float* BF = (const float*)(lds + G_BF); const float* BB = (const float*)(lds + G_BB);
    bf16_t* KDT0 = (bf16_t*)(lds + G_IMG); bf16_t* KDT1 = KDT0 + 64 * 72; bf16_t* VT = KDT1 + 64 * 72;
    float* GS = (float*)(p.ws + OFF_GS); float* GD = (float*)(p.ws + OFF_GDEC);
    int tid_ = threadIdx.x; asm volatile("" : "+v"(tid_)); const int tid = tid_, lane = tid & 63, w = tid >> 6, l15 = lane & 15, q4 = lane >> 4;
    GlaPre gp; gla_prefetch(gp, P, t0, h, tid);
    gla_tables(p, l, LR, t0, h, lds);
#pragma unroll
    for (int i = 0; i < 8; ++i) {
        const int idx = tid + NTHR * i, c = idx >> 6, dk = idx & 63;
        const float kv = bf2f(gp.k[i]);
        KDT0[dk * 72 + c] = f2bf_d(kv * __expf(BF[63 * 64 + dk] - BF[c * 64 + dk]));
        KDT1[dk * 72 + c] = f2bf_d(kv * __expf(BB[dk] - BB[c * 64 + dk]));
    }
    gla_vt_store(gp, VT, tid);
    if (tid < 64) GD[(size_t)item * 64 + tid] = __expf(BF[63 * 64 + tid]);
    else if (tid < 128) GD[(size_t)(NITEM + item) * 64 + tid - 64] = __expf(BB[tid - 64]);
    __syncthreads();
    const int dir = w >> 2, dkt = w & 3;
    const bf16_t* KD = dir ? KDT1 : KDT0;
    bf16x8 kf[2];
#pragma unroll
    for (int ks = 0; ks < 2; ++ks) kf[ks] = *(const bf16x8*)(KD + (16 * dkt + l15) * 72 + 32 * ks + 8 * q4);
    float* dst = GS + ((size_t)dir * NITEM + item) * 8192;
#pragma unroll
    for (int dvt = 0; dvt < 8; ++dvt) {
        f32x4 a = {0.f, 0.f, 0.f, 0.f};
#pragma unroll
        for (int ks = 0; ks < 2; ++ks) { const bf16x8 vf = *(const bf16x8*)(VT + (16 * dvt + l15) * 72 + 32 * ks + 8 * q4); a = MFMA(kf[ks], vf, a); }
        *(f32x4*)(dst + (16 * dvt + l15) * 64 + 16 * dkt + 4 * q4) = a;
    }
    __syncthreads();
}
__device__ __forceinline__ void gla_scan(const Params& p, int dry = 0) {
    float* GS = (float*)(p.ws + OFF_GS); const float* GD = (const float*)(p.ws + OFF_GDEC);
    const int total = 2 * BG * 4 * 8192;
    int tid_ = threadIdx.x; asm volatile("" : "+v"(tid_));
    for (int id = blockIdx.x * NTHR + tid_; id < total; id += gridDim.x * NTHR) {
        const int e = id & 8191, comb = id >> 13, h = comb & 3, bl = (comb >> 2) % BG, dir = comb / (4 * BG), dk = e & 63;
        float S = 0.f;
        const size_t ibase = (size_t)dir * NITEM + (size_t)(bl * 128) * 4 + h;
        for (int s0 = 0; s0 < 128; s0 += 16) {
            float u[16], dc[16];
#pragma unroll
            for (int i = 0; i < 16; ++i) {
                const int n = dir ? 127 - (s0 + i) : s0 + i;
                const size_t item = ibase + (size_t)n * 4;
                u[i] = GS[item * 8192 + e]; dc[i] = GD[item * 64 + dk];
            }
#pragma unroll
            for (int i = 0; i < 16; ++i) {
                const int n = dir ? 127 - (s0 + i) : s0 + i;
                const size_t item = ibase + (size_t)n * 4;
                if (!dry) GS[item * 8192 + e] = S;
                S = dc[i] * S + u[i];
            }
        }
    }
}
__device__ __forceinline__ void gla_part2_item(const Params& p, int l, bf16_t* P, const float* LR, int item, unsigned char* lds, int dry = 0) {
    const int h = item & 3, n = (item >> 2) & 127, bl = item >> 9, t0 = bl * SEQ + n * 64;
    const float* BF = (const float*)(lds + G_BF); const float* BB = (const float*)(lds + G_BB);
    bf16_t* QF = (bf16_t*)(lds + G_IMG);
    bf16_t* KF = QF + 2 * 64 * 72;
    bf16_t* QD = KF + 2 * 64 * 72;
    bf16_t* VT = QD + 2 * 64 * 72;
    bf16_t* ST = VT + 128 * 72;
    float* OX = (float*)lds;
    const float* GS = (const float*)(p.ws + OFF_GS);
    int tid_ = threadIdx.x; asm volatile("" : "+v"(tid_)); const int tid = tid_, lane = tid & 63, w = tid >> 6, l15 = lane & 15, q4 = lane >> 4;
    GlaPre gp; gla_prefetch(gp, P, t0, h, tid);
    float4 sp[2][4];
#pragma unroll
    for (int dir = 0; dir < 2; ++dir)
#pragma unroll
        for (int i = 0; i < 4; ++i) { const int idx = tid + NTHR * i; sp[dir][i] = *(const float4*)(GS + ((size_t)dir * NITEM + item) * 8192 + (idx >> 4) * 64 + (idx & 15) * 4); }
    gla_tables(p, l, LR, t0, h, lds);
#pragma unroll
    for (int i = 0; i < 8; ++i) {
        const int idx = tid + NTHR * i, c = idx >> 6, dk = idx & 63;
        const float qv = bf2f(gp.q[i]);
        const float kv = bf2f(gp.k[i]);
        const float bf = BF[c * 64 + dk], mf = BF[31 * 64 + dk], bb = BB[c * 64 + dk], mb = BB[32 * 64 + dk];
        QF[c * 72 + dk] = f2bf_d(qv * __expf(bf - mf)); KF[c * 72 + dk] = f2bf_d(kv * __expf(mf - bf)); QD[c * 72 + dk] = f2bf_d(qv * __expf(bf));
        QF[4608 + c * 72 + dk] = f2bf_d(qv * __expf(bb - mb)); KF[4608 + c * 72 + dk] = f2bf_d(kv * __expf(mb - bb)); QD[4608 + c * 72 + dk] = f2bf_d(qv * __expf(bb));
    }
    gla_vt_store(gp, VT, tid);
#pragma unroll
    for (int dir = 0; dir < 2; ++dir) {
#pragma unroll
        for (int i = 0; i < 4; ++i) {
            const int idx = tid + NTHR * i, dv = idx >> 4, dk4 = (idx & 15) * 4;
            const float4 s = sp[dir][i];
            u32x2 o; o.x = pk2(s.x, s.y); o.y = pk2(s.z, s.w);
            *(u32x2*)(ST + dir * 9216 + dv * 72 + dk4) = o;
        }
    }
    __syncthreads();
    const int dir = w >> 2, ct = w & 3;
    const bf16_t* qfp = QF + dir * 4608; const bf16_t* kfp = KF + dir * 4608; const bf16_t* qdp = QD + dir * 4608; const bf16_t* stp = ST + dir * 9216;
    bf16x8 qf[2], qd[2];
#pragma unroll
    for (int ks = 0; ks < 2; ++ks) { qf[ks] = *(const bf16x8*)(qfp + (16 * ct + l15) * 72 + 32 * ks + 8 * q4); qd[ks] = *(const bf16x8*)(qdp + (16 * ct + l15) * 72 + 32 * ks + 8 * q4); }
    f32x4 sc[4];
    const int cq = 16 * ct + l15;
#pragma unroll
    for (int st = 0; st < 4; ++st) {
        f32x4 a = {0.f, 0.f, 0.f, 0.f};
#pragma unroll
        for (int ks = 0; ks < 2; ++ks) { const bf16x8 kf = *(const bf16x8*)(kfp + (16 * st + l15) * 72 + 32 * ks + 8 * q4); a = MFMA(kf, qf[ks], a); }
#pragma unroll
        for (int e = 0; e < 4; ++e) { const int s = 16 * st + 4 * q4 + e; const bool ok = dir ? (s > cq) : (s <= cq); a[e] = ok ? a[e] : 0.f; }
        sc[st] = a;
    }
    f32x4 o[8];
#pragma unroll
    for (int dt = 0; dt < 8; ++dt) o[dt] = (f32x4){0.f, 0.f, 0.f, 0.f};
#pragma unroll
    for (int kk = 0; kk < 2; ++kk) {
        u32x4 pu; pu.x = pk2(sc[2 * kk][0], sc[2 * kk][1]); pu.y = pk2(sc[2 * kk][2], sc[2 * kk][3]); pu.z = pk2(sc[2 * kk + 1][0], sc[2 * kk + 1][1]); pu.w = pk2(sc[2 * kk + 1][2], sc[2 * kk + 1][3]);
        const bf16x8 pf = mkfrag(pu);
#pragma unroll
        for (int dt = 0; dt < 8; ++dt) {
            const bf16_t* vr = VT + (dt * 16 + l15) * 72 + kk * 32 + 4 * q4;
            const bf16x8 vf = mkfrag2(*(const u32x2*)vr, *(const u32x2*)(vr + 16));
            o[dt] = MFMA(vf, pf, o[dt]);
        }
    }
#pragma unroll
    for (int ks = 0; ks < 2; ++ks)
#pragma unroll
        for (int dt = 0; dt < 8; ++dt) { const bf16x8 sf = *(const bf16x8*)(stp + (dt * 16 + l15) * 72 + 32 * ks + 8 * q4); o[dt] = MFMA(sf, qd[ks], o[dt]); }
    if (dir == 1) {
#pragma unroll
        for (int dt = 0; dt < 8; ++dt) *(f32x4*)(OX + cq * 132 + 16 * dt + 4 * q4) = o[dt];
    }
    __syncthreads();
    if (dir == 0) {
        float ss = 0.f;
#pragma unroll
        for (int dt = 0; dt < 8; ++dt) { o[dt] += *(const f32x4*)(OX + cq * 132 + 16 * dt + 4 * q4); ss += (o[dt][0] * o[dt][0] + o[dt][1] * o[dt][1]) + (o[dt][2] * o[dt][2] + o[dt][3] * o[dt][3]); }
        ss += __shfl_xor(ss, 16); ss += __shfl_xor(ss, 32);
        const float rms = 1.0f / sqrtf(ss * (1.0f / 128.0f) + 1e-6f);
        const float* ng = p.gla_norm_g + l * 512 + h * 128;
        const bf16_t* zrow = P + (size_t)(t0 + cq) * PS + C_Z + 2 * 512 + h * 128;
        bf16_t* orow = P + (size_t)(t0 + cq) * PS + C_GV + h * 128;
#pragma unroll
        for (int dt = 0; dt < 8; ++dt) {
            const int dd = 16 * dt + 4 * q4;
            const f32x4 z = ld_bf4(zrow + dd); const f32x4 g4 = *(const f32x4*)(ng + dd);
            if (!dry) st_bf4(orow + dd, o[dt] * rms * g4 * z);
        }
    }
    __syncthreads();
}

namespace pg8 {
#define PG8_LAS __attribute__((address_space(3)))
typedef unsigned short bf16_t;
typedef short bf16x8 __attribute__((ext_vector_type(8)));
typedef float f32x4 __attribute__((ext_vector_type(4)));
typedef unsigned u32x4 __attribute__((ext_vector_type(4)));
constexpr int BM = 256, BK = 64, HALF = 128, HTB = HALF * BK * 2  , STAGE_BYTES = 8 * HTB, NXCD = 8, WGM = 8;

__host__ __device__ __forceinline__ int lds_byte(int r, int c) { const int st = (r >> 4) * 2 + (c >> 5), rr = r & 15, cc = c & 31, ob = rr * 64 + cc * 2; return st * 1024 + (ob ^ (((ob >> 9) & 1) << 5)); }
__host__ __device__ __forceinline__ void stage_rc(int b, int& R, int& C) { const int st = b / 1024, sb = b % 1024, swz = sb ^ (((sb >> 9) & 1) << 5); R = (st >> 1) * 16 + swz / 64; C = (st & 1) * 32 + (swz % 64) / 2; }
__host__ __device__ __forceinline__ int perm32(int rho) { const int n = rho >> 4, i = rho & 15; return 8 * (i >> 2) + 4 * n + (i & 3); }

struct Unit { int pm, pn; };
struct Gemm { const bf16_t* A; const bf16_t* Bt; int M, N, K; };

struct StaticOrder {
    int nM, nN, nwg, G, c;
    __host__ __device__ __forceinline__ void init(int M, int N, int G_, int c_) { nM = M / BM; nN = N / BM; nwg = nM * nN; G = G_; c = c_; }
    __host__ __device__ bool next(int i, Unit& u) const {
        const long L = (long)i * G + c; if (L >= nwg) return false;
        int wgid = (int)L; { const int q = nwg / NXCD, r = nwg % NXCD, xcd = wgid % NXCD, off = wgid / NXCD; wgid = (xcd < r ? xcd * (q + 1) : r * (q + 1) + (xcd - r) * q) + off; }
        const int nig = WGM * nN, gid = wgid / nig, fm = gid * WGM, gsz = (nM - fm) < WGM ? (nM - fm) : WGM;
        u.pm = fm + ((wgid % nig) % gsz); u.pn = (wgid % nig) / gsz; return true;
    }
    __device__ __forceinline__ void a_ready(const Unit&) const {}
    __device__ __forceinline__ void done(const Unit&) const {}
};
__device__ __forceinline__ unsigned cvt_pk_bf16(float lo, float hi) { unsigned r; asm volatile("v_cvt_pk_bf16_f32 %0, %1, %2" : "=v"(r) : "v"(lo), "v"(hi)); return r; }
template <class Epi, class Sched, bool STAMP = false>
__device__ __forceinline__ void gemm_phase(PG8_LAS unsigned char* lds, const Gemm g, const Sched& S, const Epi& E, unsigned long long* stamps) {
    int tid_l = threadIdx.x; asm volatile("" : "+v"(tid_l)); const int tid = tid_l, wid = __builtin_amdgcn_readfirstlane(tid >> 6), lane = tid & 63, wr = wid >> 2, wc = wid & 3, fr = lane & 15, fq = lane >> 4;
    const int K = g.K, nt = K / BK;
    int ts_lo = 0, ts_hi = 0, nts = 0; const unsigned long long rt_entry = STAMP ? (unsigned long long)wall_clock64() : 0ull;
#define PG8_STAMP() do { if (STAMP && wid == 0 && nts < 64) { const unsigned long long _c = (unsigned long long)clock64(); \
        ts_lo = (lane == nts) ? (int)(unsigned)_c : ts_lo; ts_hi = (lane == nts) ? (int)(unsigned)(_c >> 32) : ts_hi; ++nts; } } while (0)
    PG8_STAMP();
    unsigned voffA[2], voffB[2];
#pragma unroll
    for (int i = 0; i < 2; ++i) { int R, C; stage_rc(tid * 16 + i * 8192, R, C); const int Rb = Epi::PERM ? ((R & ~31) + perm32(R & 31)) : R;
        voffA[i] = (unsigned)(R * K + C) * 2u; voffB[i] = (unsigned)(Rb * K + C) * 2u; }
    const size_t kstep = (size_t)(BK * 2);
    const size_t hstep = (size_t)HALF * K * 2;
    const size_t tstep = 2 * hstep;
    const unsigned ldsw = (unsigned)wid * 1024u;
    const int aoff = lds_byte(wr * 64 + fr, fq * 8), boff = lds_byte(wc * 32 + fr, fq * 8);
#define PG8_SA(b, h) (((b) * 2 + (h)) * HTB)
#define PG8_SB(b, h) ((4 + (b) * 2 + (h)) * HTB)
#define PG8_STAGE(bufoff, gbase, voff) do { _Pragma("unroll") for (int _i = 0; _i < 2; ++_i) \
        __builtin_amdgcn_global_load_lds((const unsigned*)((const char*)(gbase) + (voff)[_i]), (PG8_LAS unsigned*)(lds + (bufoff) + ldsw + _i * 8192), 16, 0, 0); } while (0)
#define PG8_LDA(dst, b, h) do { _Pragma("unroll") for (int m = 0; m < 4; ++m) _Pragma("unroll") for (int k = 0; k < 2; ++k) dst[m][k] = *(const PG8_LAS bf16x8*)(lds + PG8_SA(b, h) + aoff + m * 2048 + k * 1024); } while (0)
#define PG8_LDB(dst, b, h) do { _Pragma("unroll") for (int n = 0; n < 2; ++n) _Pragma("unroll") for (int k = 0; k < 2; ++k) dst[n][k] = *(const PG8_LAS bf16x8*)(lds + PG8_SB(b, h) + boff + n * 2048 + k * 1024); } while (0)
#define PG8_MMA(ai, bj, At, Bt) do { __builtin_amdgcn_s_setprio(1); _Pragma("unroll") for (int m = 0; m < 4; ++m) _Pragma("unroll") for (int n = 0; n < 2; ++n) _Pragma("unroll") for (int k = 0; k < 2; ++k) \
        acc[ai][bj][m][n] = __builtin_amdgcn_mfma_f32_16x16x32_bf16(Bt[n][k], At[m][k], acc[ai][bj][m][n], 0, 0, 0); __builtin_amdgcn_s_setprio(0); } while (0)
#define PG8_WAIT_V(n) asm volatile("s_waitcnt vmcnt(" #n ")" ::: "memory")
#define PG8_WAIT_L(n) asm volatile("s_waitcnt lgkmcnt(" #n ")" ::: "memory")
#define PG8_BAR __builtin_amdgcn_s_barrier()
#define PG8_SCHED __builtin_amdgcn_sched_barrier(0)
    Unit cur, nxt; int ui = 0;
    if (!S.next(0, cur)) return;
    f32x4 acc[2][2][4][2];
#pragma unroll
    for (int a = 0; a < 2; ++a)
#pragma unroll
        for (int b = 0; b < 2; ++b)
#pragma unroll
            for (int m = 0; m < 4; ++m)
#pragma unroll
                for (int n = 0; n < 2; ++n) acc[a][b][m][n] = (f32x4){0.f, 0.f, 0.f, 0.f};
    bf16x8 At[4][2], B0[2][2], B1[2][2];
    const char* cA = (const char*)g.A + (size_t)cur.pm * tstep; const char* cB = (const char*)g.Bt + (size_t)cur.pn * tstep;
    S.a_ready(cur);
    PG8_STAGE(PG8_SB(0, 0), cB, voffB); PG8_STAGE(PG8_SA(0, 0), cA, voffA); PG8_STAGE(PG8_SB(0, 1), cB + hstep, voffB); PG8_STAGE(PG8_SA(0, 1), cA + hstep, voffA);
    if (wr == 1) PG8_BAR;
    PG8_WAIT_V(4); PG8_BAR;
    PG8_STAGE(PG8_SB(1, 0), cB + kstep, voffB); PG8_STAGE(PG8_SA(1, 0), cA + kstep, voffA); PG8_STAGE(PG8_SB(1, 1), cB + hstep + kstep, voffB);
    PG8_WAIT_V(6); PG8_BAR;
    PG8_STAMP();
    for (;;) {
        const bool has_next = S.next(ui + 1, nxt);
        const char* nA = has_next ? (const char*)g.A + (size_t)nxt.pm * tstep : cA; const char* nB = has_next ? (const char*)g.Bt + (size_t)nxt.pn * tstep : cB;
        for (int t = 0; t < nt; t += 2) {
            const bool last = (t == nt - 2);
            const char* a1 = cA + (size_t)(t + 1) * kstep;
            const char* a2 = last ? nA : cA + (size_t)(t + 2) * kstep; const char* b2 = last ? nB : cB + (size_t)(t + 2) * kstep;
            const char* a3 = a2 + kstep; const char* b3 = b2 + kstep;
            if (last && has_next) S.a_ready(nxt);
            PG8_LDB(B0, 0, 0); PG8_SCHED; PG8_LDA(At, 0, 0); PG8_STAGE(PG8_SA(1, 1), a1 + hstep, voffA);
            PG8_WAIT_L(8); PG8_BAR; PG8_WAIT_L(0); PG8_MMA(0, 0, At, B0); PG8_BAR; PG8_SCHED;
            PG8_LDB(B1, 0, 1); PG8_STAGE(PG8_SB(0, 0), b2, voffB);
            PG8_BAR; PG8_WAIT_L(0); PG8_MMA(0, 1, At, B1); PG8_BAR;
            PG8_LDA(At, 0, 1); PG8_STAGE(PG8_SA(0, 0), a2, voffA);
            PG8_BAR; PG8_WAIT_L(0); PG8_MMA(1, 0, At, B0); PG8_BAR; PG8_SCHED;
            PG8_STAGE(PG8_SB(0, 1), b2 + hstep, voffB);
            PG8_WAIT_V(6); PG8_BAR; PG8_MMA(1, 1, At, B1); PG8_BAR;
            PG8_LDB(B0, 1, 0); PG8_SCHED; PG8_LDA(At, 1, 0); PG8_STAGE(PG8_SA(0, 1), a2 + hstep, voffA);
            PG8_WAIT_L(8); PG8_BAR; PG8_WAIT_L(0); PG8_MMA(0, 0, At, B0); PG8_BAR; PG8_SCHED;
            PG8_LDB(B1, 1, 1); PG8_STAGE(PG8_SB(1, 0), b3, voffB);
            PG8_BAR; PG8_WAIT_L(0); PG8_MMA(0, 1, At, B1); PG8_BAR;
            PG8_LDA(At, 1, 1); PG8_STAGE(PG8_SA(1, 0), a3, voffA);
            PG8_BAR; PG8_WAIT_L(0); PG8_MMA(1, 0, At, B0); PG8_BAR; PG8_SCHED;
            PG8_STAGE(PG8_SB(1, 1), b3 + hstep, voffB);
            PG8_WAIT_V(6); PG8_BAR; PG8_MMA(1, 1, At, B1); PG8_BAR;
        }
        PG8_STAMP();
        if constexpr (!Epi::AFTER_DRAIN) { E(acc, cur, wr, wc, fr, fq); S.done(cur); }
        PG8_STAMP();
        if (!has_next) break;
#pragma unroll
        for (int a = 0; a < 2; ++a)
#pragma unroll
            for (int b = 0; b < 2; ++b)
#pragma unroll
                for (int m = 0; m < 4; ++m)
#pragma unroll
                    for (int n = 0; n < 2; ++n) acc[a][b][m][n] = (f32x4){0.f, 0.f, 0.f, 0.f};
        cur = nxt; cA = nA; cB = nB; ++ui;
    }
    PG8_WAIT_V(0);
    if (wr == 0) PG8_BAR;
    PG8_BAR;
    if constexpr (Epi::AFTER_DRAIN) { E.fused(acc, cur, wr, wc, fr, fq, lds, wid, lane); S.done(cur); }
    PG8_STAMP();
    if (STAMP && wid == 0) { stamps[lane] = lane < nts ? (((unsigned long long)(unsigned)ts_hi << 32) | (unsigned)ts_lo) : 0ull;
        if (lane == 62) stamps[62] = rt_entry; if (lane == 63) stamps[63] = (unsigned long long)wall_clock64(); }
#undef PG8_STAMP
#undef PG8_SA
#undef PG8_SB
#undef PG8_STAGE
#undef PG8_LDA
#undef PG8_LDB
#undef PG8_MMA
#undef PG8_WAIT_V
#undef PG8_WAIT_L
#undef PG8_BAR
#undef PG8_SCHED
}
}

struct EpiInProj {
    static constexpr bool PERM = true, AFTER_DRAIN = false;
    bf16_t* P; const float* bias; float* LR;
    __device__ __forceinline__ void operator()(const f32x4 (&acc)[2][2][4][2], const pg8::Unit& u, int wr, int wc, int fr, int fq) const {
        const int row0 = u.pm * 256 + wr * 64 + fr, colt = u.pn * 256, col0 = colt + wc * 32 + 8 * fq;
        if (colt == C_LR) {
            if (wc == 0) {
                const int cl = 8 * fq;
                const f32x4 b0 = *(const f32x4*)(bias + 4096 + cl), b1 = *(const f32x4*)(bias + 4096 + cl + 4);
#pragma unroll
                for (int ai = 0; ai < 2; ++ai)
#pragma unroll
                    for (int m = 0; m < 4; ++m) {
                        float* d = LR + (size_t)(row0 + ai * 128 + m * 16) * 32 + cl;
                        *(f32x4*)d = acc[ai][0][m][0] + b0; *(f32x4*)(d + 4) = acc[ai][0][m][1] + b1;
                    }
            }
            return;
        }
        const int mode = (colt < 512 || colt == C_GQ) ? 1 : (colt >= C_MQ && colt < C_Z) ? 2 : (colt >= C_Z && colt < C_SG) ? 3 : (colt >= C_SG) ? 4 : 0;
#pragma unroll
        for (int bj = 0; bj < 2; ++bj) {
            const int col = col0 + bj * 128;
            const f32x4 b0 = *(const f32x4*)(bias + orig_col(col)), b1 = *(const f32x4*)(bias + orig_col(col) + 4);
#pragma unroll
            for (int ai = 0; ai < 2; ++ai)
#pragma unroll
                for (int m = 0; m < 4; ++m) {
                    f32x4 v0 = acc[ai][bj][m][0] + b0, v1 = acc[ai][bj][m][1] + b1;
                    if (mode == 1) { v0 *= 0.125f; v1 *= 0.125f; }
                    else if (mode == 2) { v0 *= 0.08838834764831845f; v1 *= 0.08838834764831845f; }
                    else if (mode == 3) {
#pragma unroll
                        for (int e = 0; e < 4; ++e) { v0[e] = siluf_(v0[e]); v1[e] = siluf_(v1[e]); }
                    } else if (mode == 4) {
#pragma unroll
                        for (int e = 0; e < 4; ++e) { v0[e] = sigmoidf_(v0[e]); v1[e] = sigmoidf_(v1[e]); }
                    }
                    u32x4 o; o.x = pk2(v0[0], v0[1]); o.y = pk2(v0[2], v0[3]); o.z = pk2(v1[0], v1[1]); o.w = pk2(v1[2], v1[3]);
                    *(u32x4*)(P + (size_t)(row0 + ai * 128 + m * 16) * PS + col) = o;
                }
        }
    }
};
struct EpiOut {
    static constexpr bool PERM = false, AFTER_DRAIN = false;
    float* pre; const float* bo;
    __device__ __forceinline__ void operator()(const f32x4 (&acc)[2][2][4][2], const pg8::Unit& u, int wr, int wc, int fr, int fq) const {
        const int row0 = u.pm * 256 + wr * 64 + fr, col0 = u.pn * 256 + wc * 32 + 4 * fq;
#pragma unroll
        for (int bj = 0; bj < 2; ++bj)
#pragma unroll
            for (int n = 0; n < 2; ++n) {
                const int col = col0 + bj * 128 + n * 16;
                const f32x4 b4 = *(const f32x4*)(bo + col);
#pragma unroll
                for (int ai = 0; ai < 2; ++ai)
#pragma unroll
                    for (int m = 0; m < 4; ++m) *(f32x4*)(pre + (size_t)(row0 + ai * 128 + m * 16) * 1024 + col) = acc[ai][bj][m][n] + b4;
            }
    }
};

__device__ __forceinline__ void ln_rows_res(const Params& p, int l, size_t tok0) {
    int tid_ = threadIdx.x; asm volatile("" : "+v"(tid_));
    const int lane = tid_ & 63;
    const int gw = blockIdx.x * (NTHR / 64) + (tid_ >> 6), nw = gridDim.x * (NTHR / 64);
    const float* pre = (const float*)(p.ws + OFF_PRE); const float2* stats = (const float2*)(p.ws + OFF_STATS); bf16_t* hb = (bf16_t*)(p.ws + OFF_HB);
    const float* g = p.ln_g + l * 1024; const float* b = p.ln_b + l * 1024;
    for (int r = gw; r < TG; r += nw) {
        const size_t T = tok0 + r;
        const float4* pr = (const float4*)(pre + (size_t)r * 1024);
        float4 v[4]; float s = 0.f;
        if (l == 0) {
            const float4* xr = (const float4*)(p.x + T * 1024); const float2 st = stats[T];
#pragma unroll
            for (int i = 0; i < 4; ++i) {
                const float4 a = pr[lane + 64 * i], x4 = xr[lane + 64 * i], g4 = ((const float4*)p.ln_in_g)[lane + 64 * i], b4 = ((const float4*)p.ln_in_b)[lane + 64 * i];
                v[i].x = a.x + DN_ALPHA * ((x4.x - st.x) * st.y * g4.x + b4.x); v[i].y = a.y + DN_ALPHA * ((x4.y - st.x) * st.y * g4.y + b4.y);
                v[i].z = a.z + DN_ALPHA * ((x4.z - st.x) * st.y * g4.z + b4.z); v[i].w = a.w + DN_ALPHA * ((x4.w - st.x) * st.y * g4.w + b4.w);
            }
        } else {
            const float4* hr = (const float4*)(p.out + T * 1024);
#pragma unroll
            for (int i = 0; i < 4; ++i) {
                const float4 a = pr[lane + 64 * i], h4 = hr[lane + 64 * i];
                v[i].x = a.x + DN_ALPHA * h4.x; v[i].y = a.y + DN_ALPHA * h4.y; v[i].z = a.z + DN_ALPHA * h4.z; v[i].w = a.w + DN_ALPHA * h4.w;
            }
        }
#pragma unroll
        for (int i = 0; i < 4; ++i) s += (v[i].x + v[i].y) + (v[i].z + v[i].w);
        s = wave_sum(s);
        const float mean = s * (1.0f / 1024.0f);
        float q = 0.f;
#pragma unroll
        for (int i = 0; i < 4; ++i) { const float a = v[i].x - mean, bb = v[i].y - mean, c = v[i].z - mean, d = v[i].w - mean; q += (a * a + bb * bb) + (c * c + d * d); }
        q = wave_sum(q);
        const float rstd = 1.0f / sqrtf(q * (1.0f / 1024.0f) + 1e-5f);
#pragma unroll
        for (int i = 0; i < 4; ++i) {
            const float4 g4 = ((const float4*)g)[lane + 64 * i], b4 = ((const float4*)b)[lane + 64 * i];
            float4 y; y.x = (v[i].x - mean) * rstd * g4.x + b4.x; y.y = (v[i].y - mean) * rstd * g4.y + b4.y; y.z = (v[i].z - mean) * rstd * g4.z + b4.z; y.w = (v[i].w - mean) * rstd * g4.w + b4.w;
            ((float4*)(p.out + T * 1024))[lane + 64 * i] = y;
            u32x2 o; o.x = pk2(y.x, y.y); o.y = pk2(y.z, y.w); *(u32x2*)(hb + T * 1024 + (lane + 64 * i) * 4) = o;
        }
    }
}

#define XB_TMO      128
#define XB_XCNT(j)  (256  + 64 * (j))
#define XB_XSUB(j)  (1280 + 64 * (j))
#define XB_XGEN(j)  (2304 + 64 * (j))
#define XB_TOP      3328
#define XB_TOPGEN   3392
#define XCD_BAR_WORDS 3456
#define XB_SPIN_CAP (1u << 18)
#define LAS __attribute__((address_space(3)))

__device__ __forceinline__ unsigned xb_ld(unsigned* p)              { return __hip_atomic_load(p, __ATOMIC_RELAXED, __HIP_MEMORY_SCOPE_AGENT); }
__device__ __forceinline__ unsigned xb_add(unsigned* p, unsigned v) { return __hip_atomic_fetch_add(p, v, __ATOMIC_RELAXED, __HIP_MEMORY_SCOPE_AGENT); }
__device__ __forceinline__ unsigned xb_xcc_id() { return (unsigned)__builtin_amdgcn_s_getreg((3 << 11) | 20) & 0xFu; }
#define XB_SPIN(cond, bar) do { unsigned _sp = 0; while (cond) { __builtin_amdgcn_s_sleep(1); \
    if ((++_sp & 255u) == 0u) { if (xb_ld(&(bar)[XB_TMO])) break; if (_sp > XB_SPIN_CAP) { atomicAdd(&(bar)[XB_TMO], 1u); break; } } } } while (0)

struct XcdBarrier {
    unsigned* bar; unsigned x;
    volatile LAS unsigned* st;
};

__device__ __forceinline__ XcdBarrier xcd_barrier_post(unsigned* bar, volatile LAS unsigned* st) {
    XcdBarrier b; b.bar = bar; b.x = xb_xcc_id(); b.st = st;
    if (threadIdx.x == 0) (void)xb_add(&bar[XB_XCNT(b.x)], 1u);
    return b;
}
__device__ __forceinline__ void xcd_barrier_complete(unsigned* bar, unsigned x, unsigned& nloc, unsigned& nx) {
    const unsigned G = gridDim.x * gridDim.y * gridDim.z;
    unsigned sum, cnt, mine, sp = 0u;
    for (;;) {
        sum = 0u; cnt = 0u; mine = 0u;
#pragma unroll
        for (unsigned j = 0; j < 16; ++j) { const unsigned c = xb_ld(&bar[XB_XCNT(j)]); sum += c; cnt += (c > 0u) ? 1u : 0u; mine = (j == x) ? c : mine; }
        if (sum == G) break;
        __builtin_amdgcn_s_sleep(1);
        if ((++sp & 255u) == 0u) { if (xb_ld(&bar[XB_TMO])) break; if (sp > XB_SPIN_CAP) { atomicAdd(&bar[XB_TMO], 1u); break; } }
    }
    nloc = mine > 0u ? mine : 1u; nx = cnt > 0u ? cnt : 1u;
}

__device__ __forceinline__ void xcd_barrier(unsigned* b_bar, unsigned b_x, volatile LAS unsigned* b_st) {
    asm volatile("s_waitcnt vmcnt(0)" ::: "memory");
    __syncthreads();
    if (threadIdx.x == 0) {
        unsigned* bar = b_bar;
        __builtin_amdgcn_s_waitcnt(0);
        unsigned nloc = b_st[0], nx = b_st[1];
        if (nloc == 0u) { xcd_barrier_complete(bar, b_x, nloc, nx); b_st[0] = nloc; b_st[1] = nx; }
        const unsigned old = xb_add(&bar[XB_XSUB(b_x)], 1u);
        const unsigned gen = old / nloc;
        if (old + 1u == (gen + 1u) * nloc) {
            __builtin_amdgcn_fence(__ATOMIC_RELEASE, "agent");
            asm volatile("s_waitcnt vmcnt(0)" ::: "memory");
            const unsigned og = xb_add(&bar[XB_TOP], 1u);
            const unsigned tg = og / nx;
            if (og + 1u == (tg + 1u) * nx) xb_add(&bar[XB_TOPGEN], 1u);
            else XB_SPIN(xb_ld(&bar[XB_TOPGEN]) == tg, bar);
            __builtin_amdgcn_fence(__ATOMIC_ACQUIRE, "agent");
            xb_add(&bar[XB_XGEN(b_x)], 1u);
            asm volatile("s_waitcnt vmcnt(0)" ::: "memory");
        } else {
            XB_SPIN(xb_ld(&bar[XB_XGEN(b_x)]) == gen, bar);
            __builtin_amdgcn_fence(__ATOMIC_ACQUIRE, "agent");
            asm volatile("s_waitcnt vmcnt(0)" ::: "memory");
        }
    }
    __syncthreads();
}

__device__ __forceinline__ void gbar(unsigned* ctr, unsigned& gen, int G) {
    __syncthreads();
    gen += (unsigned)G;
    if (threadIdx.x == 0) {
        __threadfence();
        __hip_atomic_fetch_add(ctr, 1u, __ATOMIC_RELAXED, __HIP_MEMORY_SCOPE_AGENT);
        while (__hip_atomic_load(ctr, __ATOMIC_RELAXED, __HIP_MEMORY_SCOPE_AGENT) < gen) __builtin_amdgcn_s_sleep(1);
        __threadfence();
    }
    __syncthreads();
}
typedef const Params __attribute__((address_space(4))) KParams;
#define KP4 __attribute__((address_space(4)))
__device__ __forceinline__ Params fresh_params() {
#if defined(__HIP_DEVICE_COMPILE__)
    KParams* kp = (KParams*)__builtin_amdgcn_kernarg_segment_ptr();
    asm volatile("" : "+s"(kp));
    Params r;
    const float* KP4 const* src = (const float* KP4 const*)kp;
    const float** dst = (const float**)&r;
#pragma unroll
    for (int i = 0; i < 28; ++i) dst[i] = src[i];
    return r;
#else
    return Params{};
#endif
}
__global__ void __launch_bounds__(NTHR) mega(Params p_unused) {
    extern __shared__ __attribute__((aligned(16))) unsigned char lds[];
    cg::grid_group grid = cg::this_grid();
    const int G = gridDim.x, bid = blockIdx.x;
    volatile LAS unsigned* xst = (volatile LAS unsigned*)((LAS unsigned char*)lds + (LDS_BYTES - 16));
    if (threadIdx.x == 0) { xst[0] = 0u; xst[1] = 0u; }
    __syncthreads();
    unsigned* xbar; unsigned xx;
    { const Params p = fresh_params(); xbar = (unsigned*)(p.ws + OFF_BAR); xx = xb_xcc_id(); if (threadIdx.x == 0) (void)xb_add(&xbar[XB_XCNT(xx)], 1u); }
    { const Params p = fresh_params(); phase0(p); }
    grid.sync();
#pragma unroll 1
    for (int l = 0; l < 2; ++l) {
        { const Params p = fresh_params(); phase_weights(p, l, lds); __syncthreads(); phase_filter_gen(p, l, lds); }
        xcd_barrier(xbar, xx, xst);
        {
            const Params p = fresh_params();
            phase_filter_fft(p, l, lds);
            const bf16_t* WtKV = (const bf16_t*)(p.ws + OFF_WTKV); const bf16_t* membf = (const bf16_t*)(p.ws + OFF_MEMBF);
            for (int t = bid; t < 64; t += G) {
                f32x4 acc[4][4];
                if (t < 32) {
                    const int m0 = (t >> 2) * 256, n0 = (t & 3) * 128;
                    gemm_core(acc, membf + (size_t)m0 * 1024, 1024, WtKV + (size_t)n0 * 1024, 1024, 1024, lds);
                    bf16_t* Km = (bf16_t*)(p.ws + OFF_KMAT);
                    EPI_LOOP(st_bf4(Km + (size_t)row * 512 + col, v);)
                } else {
                    const int t2 = t - 32, m0 = (t2 >> 4) * 256, n0 = (t2 & 15) * 128;
                    gemm_core(acc, WtKV + (size_t)(512 + m0) * 1024, 1024, membf + (size_t)n0 * 1024, 1024, 1024, lds);
                    bf16_t* Vm = (bf16_t*)(p.ws + OFF_VT);
                    EPI_LOOP(st_bf4(Vm + (size_t)row * 2048 + col, v);)
                }
            }
        }
        xcd_barrier(xbar, xx, xst);
#pragma unroll 1
        for (int g = 0; g < NGRP; ++g) {
            const size_t tok0 = (size_t)g * TG;
#pragma unroll 1
            for (int rep = 0; rep < PROBE_REP_INPROJ; ++rep) {
                const Params p = fresh_params();
                pg8::Gemm gm; gm.A = (const bf16_t*)(p.ws + OFF_HB) + tok0 * 1024; gm.Bt = (const bf16_t*)(p.ws + OFF_WTIN); gm.M = TG; gm.N = NINP; gm.K = 1024;
                pg8::StaticOrder S; S.init(TG, NINP, G, bid);
                EpiInProj E; E.P = (bf16_t*)(p.ws + OFF_P); E.bias = p.b_in + (size_t)l * NIN; E.LR = (float*)(p.ws + OFF_LR);
                pg8::gemm_phase<EpiInProj, pg8::StaticOrder, false>((PG8_LAS unsigned char*)lds, gm, S, E, nullptr);
                __syncthreads();
            }
            xcd_barrier(xbar, xx, xst);
#pragma unroll 1
            for (int rep = 0; rep < PROBE_REP_MIX; ++rep) {
            int dry = (rep + 1 < PROBE_REP_MIX) ? 1 : 0; asm volatile("" : "+s"(dry));
            {
                const Params p = fresh_params();
                bf16_t* P = (bf16_t*)(p.ws + OFF_P);
                for (int it = bid; it < BG * 64 * 8; it += G) na_item(p, l, P, it >> 9, (it >> 3) & 63, it & 7, lds, dry);
            }
            {
                const Params p = fresh_params();
                bf16_t* P = (bf16_t*)(p.ws + OFF_P);
                for (int it = bid; it < BG * 128 * 8; it += G) hy_pre_item(p, l, P, (float*)(p.ws + OFF_UT), (bf16_t*)(p.ws + OFF_GT), it >> 10, (it >> 3) & 127, it & 7, lds);
            }
            {
                const Params p = fresh_params();
                for (int it = bid; it < NITEM; it += G) gla_part1_item(p, l, (const bf16_t*)(p.ws + OFF_P), (const float*)(p.ws + OFF_LR), it, lds);
            }
            {
                const Params p = fresh_params();
                bf16_t* P = (bf16_t*)(p.ws + OFF_P);
                const int nit = BG * 4 * 64, per = (nit + G - 1) / G;
                int last = -1;
                for (int it = bid * per; it < min(nit, (bid + 1) * per); ++it) {
                    const int bh = it >> 6, bl = bh >> 2, h = bh & 3;
                    if (bh != last) { __syncthreads(); memattn_load(p, g * BG + bl, h, lds); last = bh; }
                    memattn_item(P, bl, h, it & 63, lds, dry);
                }
                __syncthreads();
            }
            xcd_barrier(xbar, xx, xst);
            {
                const Params p = fresh_params();
                const float2* twl = fft_lds_twiddles((const float2*)(p.ws + OFF_TW), lds);
                for (int it = bid; it < BG * 256; it += G) hyena_conv_item(p, (const float*)(p.ws + OFF_UT), (bf16_t*)(p.ws + OFF_GT), it >> 8, it & 255, lds, twl, dry);
                __syncthreads();
                gla_scan(p, dry);
            }
            xcd_barrier(xbar, xx, xst);
            {
                const Params p = fresh_params();
                for (int it = bid; it < NITEM; it += G) gla_part2_item(p, l, (bf16_t*)(p.ws + OFF_P), (const float*)(p.ws + OFF_LR), it, lds, dry);
            }
            {
                const Params p = fresh_params();
                for (int it = bid; it < BG * 128 * 8; it += G) hy_post_item((bf16_t*)(p.ws + OFF_P), (const bf16_t*)(p.ws + OFF_GT), it >> 10, (it >> 3) & 127, it & 7, lds, dry);
            }
            xcd_barrier(xbar, xx, xst);
            }
            {
                const Params p = fresh_params();
                const bf16_t* P = (const bf16_t*)(p.ws + OFF_P); const bf16_t* WtBr = (const bf16_t*)(p.ws + OFF_WTBR); bf16_t* merged = (bf16_t*)(p.ws + OFF_MERGED);
                for (int t = bid; t < 512; t += G) {
                    const int sr = t >> 8, sb = t & 255, sx = sb & 7, sk = sb >> 3;
                    const int m0 = (sr * 32 + (sk >> 3) * 8 + sx) * 256, n0 = (sk & 7) * 128;
                    merge_tile(P, WtBr, merged, m0, n0, lds);
                }
            }
            xcd_barrier(xbar, xx, xst);
            {
                const Params p = fresh_params();
                pg8::Gemm gm; gm.A = (const bf16_t*)(p.ws + OFF_MERGED); gm.Bt = (const bf16_t*)(p.ws + OFF_WTOUT); gm.M = TG; gm.N = 1024; gm.K = 1024;
                pg8::StaticOrder S; S.init(TG, 1024, G, bid);
                EpiOut E; E.pre = (float*)(p.ws + OFF_PRE); E.bo = p.b_out + l * 1024;
                pg8::gemm_phase<EpiOut, pg8::StaticOrder, false>((PG8_LAS unsigned char*)lds, gm, S, E, nullptr);
                __syncthreads();
            }
            xcd_barrier(xbar, xx, xst);
            {
                const Params p = fresh_params();
                ln_rows_res(p, l, tok0);
            }
        }
        xcd_barrier(xbar, xx, xst);
    }
}

extern "C" void kernel_launch(void* const* d_in, const int* in_sizes, int n_in, void* d_out, int out_size, void* d_ws, size_t ws_size, hipStream_t stream) {
    static int grid_blocks = 0;
    if (!grid_blocks) {
        if (ws_size < WS_END) { fprintf(stderr, "kernel_launch: workspace too small: %zu < %zu\n", ws_size, (size_t)WS_END); grid_blocks = -1; return; }
        {
            const long long ex[26] = {67108864LL, 2097152LL, 1024, 1024, 2LL * 1024 * 10784, 2 * 10784, 2 * 8 * 15 * 31, 2 * 3 * 1536, 2 * 1536, 2 * 33 * 64, 2 * 64, 2 * 2 * 64 * 64, 2 * 2 * 64,
                                      2 * 64 * 1024, 2 * 512, 2 * 16 * 256, 2 * 256, 2 * 16 * 256, 2 * 256, 2 * 512, 2LL * 1024 * 1024, 2LL * 4 * 512 * 1024, 2LL * 1024 * 1024, 2 * 1024, 2 * 1024, 2 * 1024};
            bool bad = (n_in != 26) || (out_size != 67108864);
            for (int i = 0; i < 26 && !bad; ++i) if ((long long)in_sizes[i] != ex[i]) { fprintf(stderr, "kernel_launch: input %d has %d elements, expected %lld\n", i, in_sizes[i], ex[i]); bad = true; }
            if (bad) { fprintf(stderr, "kernel_launch: unexpected shapes; nothing launched\n"); grid_blocks = -1; return; }
        }
        int dev = 0, cus = 0, per_cu = 0;
        hipGetDevice(&dev);
        hipDeviceGetAttribute(&cus, hipDeviceAttributeMultiprocessorCount, dev);
        if (hipFuncSetAttribute((const void*)mega, hipFuncAttributeMaxDynamicSharedMemorySize, LDS_BYTES) != hipSuccess) fprintf(stderr, "kernel_launch: hipFuncSetAttribute failed\n");
        if (hipOccupancyMaxActiveBlocksPerMultiprocessor(&per_cu, (const void*)mega, NTHR, LDS_BYTES) != hipSuccess || per_cu < 1) { fprintf(stderr, "kernel_launch: occupancy query gave %d\n", per_cu); per_cu = 1; }
        (void)hipGetLastError();
        if (per_cu > 1) per_cu = 1;
        grid_blocks = cus * per_cu;
    }
    if (grid_blocks < 0) return;
    Params p{};
    const float** pp = (const float**)&p;
    for (int i = 0; i < 26; ++i) pp[i] = (const float*)d_in[i];
    p.out = (float*)d_out; p.ws = (unsigned char*)d_ws;
    if (hipMemsetAsync((unsigned char*)d_ws + OFF_BAR, 0, 16384, stream) != hipSuccess) fprintf(stderr, "kernel_launch: memset of the barrier word failed\n");
    void* args[] = {&p};
    hipError_t e = hipLaunchCooperativeKernel((const void*)mega, dim3(grid_blocks), dim3(NTHR), args, LDS_BYTES, stream);
    if (e != hipSuccess) fprintf(stderr, "cooperative launch failed: %s (grid %d)\n", hipGetErrorString(e), grid_blocks);
}
#endif
```

```cpp
#ifndef PROBE_REP_MIX
#define PROBE_REP_MIX 1
#endif
#ifndef PROBE_REP_INPROJ
#define PROBE_REP_INPROJ 1
#endif
#include <hip/hip_runtime.h>
#include <hip/hip_cooperative_groups.h>
#include <cstdio>
#include <unistd.h>
#include <cmath>
namespace cg = cooperative_groups;

#define HD __host__ __device__
typedef unsigned short bf16_t;
typedef short bf16x8 __attribute__((ext_vector_type(8)));
typedef float f32x4 __attribute__((ext_vector_type(4)));
typedef unsigned u32x2 __attribute__((ext_vector_type(2)));
typedef unsigned u32x4 __attribute__((ext_vector_type(4)));

constexpr int NTOK = 65536, DM = 1024, SEQ = 8192, NB = 8;
constexpr int BG = 2;
constexpr int NGRP = NB / BG;
constexpr int TG = BG * SEQ;
constexpr int PS = 10752;
constexpr int NIN = 10784, NINP = 11008;
constexpr int C_NAQ = 0, C_NAK = 512, C_NAV = 1024, C_HY = 1536, C_GQ = 3072, C_GK = 3328, C_GV = 3584, C_MQ = 4096, C_Z = 4608, C_SG = 6656, C_LR = 10752;
constexpr int FN = 16384;
constexpr int NITEM = BG * 128 * 4;
constexpr int LDS_BYTES = 160 * 1024;
constexpr int NTHR = 512;
constexpr float DN_ALPHA = 1.41421356237309515f;

constexpr size_t al256(size_t x) { return (x + 255) & ~(size_t)255; }
constexpr size_t OFF_HB = 0;
constexpr size_t OFF_STATS = OFF_HB + (size_t)NTOK * DM * 2;
constexpr size_t OFF_TW = OFF_STATS + (size_t)NTOK * 8;
constexpr size_t OFF_MEMBF = OFF_TW + (size_t)FN * 8;
constexpr size_t OFF_ENERGY = OFF_MEMBF + (size_t)2048 * 1024 * 2;
constexpr size_t OFF_WTIN = OFF_ENERGY + 4096;
constexpr size_t OFF_WTBR = OFF_WTIN + (size_t)NINP * 1024 * 2;
constexpr size_t OFF_WTOUT = OFF_WTBR + (size_t)4 * 1024 * 512 * 2;
constexpr size_t OFF_WTKV = OFF_WTOUT + (size_t)1024 * 1024 * 2;
constexpr size_t OFF_KMAT = OFF_WTKV + (size_t)2048 * 1024 * 2;
constexpr size_t OFF_VT = OFF_KMAT + (size_t)2048 * 1024 * 2;
constexpr size_t OFF_HFILT = OFF_VT + (size_t)2048 * 1024 * 2;
constexpr size_t OFF_PQ = OFF_HFILT + (size_t)1024 * 8192 * 4;
constexpr size_t OFF_P = OFF_PQ + (size_t)256 * FN * 16;
constexpr size_t OFF_LR = OFF_P + (size_t)TG * PS * 2;
constexpr size_t OFF_GS = OFF_LR + (size_t)TG * 32 * 4;
constexpr size_t OFF_GDEC = OFF_GS + (size_t)2 * NITEM * 8192 * 4;
constexpr size_t OFF_MERGED = OFF_GDEC + (size_t)2 * NITEM * 64 * 4;
constexpr size_t OFF_PRE = OFF_MERGED + (size_t)TG * 1024 * 2;
constexpr size_t OFF_UT = OFF_PRE + (size_t)TG * 1024 * 4;
constexpr size_t OFF_GT = OFF_UT + (size_t)BG * 512 * 8192 * 4;
constexpr size_t OFF_BAR = OFF_GT + (size_t)BG * 512 * 8192 * 2;
constexpr size_t OFF_ZT = OFF_BAR + 16384;
constexpr size_t OFF_TB = al256(OFF_ZT + (size_t)8192 * 33 * 4);
constexpr size_t WS_END = OFF_TB + (size_t)NITEM * 8192 * 4;

struct Params {
    const float *x, *mem, *ln_in_g, *ln_in_b, *w_in, *b_in, *na_rpb, *hy_conv_w, *hy_conv_b, *hy_w1, *hy_b1, *hy_wm, *hy_bm, *hy_w3, *hy_skip,
        *gla_up_f, *gla_bias_f, *gla_up_b, *gla_bias_b, *gla_norm_g, *mem_w_kv, *w_br, *w_out, *b_out, *ln_g, *ln_b;
    float* out;
    unsigned char* ws;
};

HD inline float bf2f(bf16_t b) {
    union { unsigned u; float f; } c; c.u = (unsigned)b << 16; return c.f;
}
HD inline bf16_t f2bf(float f) {
    union { unsigned u; float f; } c; c.f = f; unsigned u = c.u; u += 0x7fffu + ((u >> 16) & 1u); return (bf16_t)(u >> 16);
}
typedef float f32x2_t __attribute__((ext_vector_type(2)));
typedef __bf16 bf16x2_t __attribute__((ext_vector_type(2)));
__device__ __forceinline__ unsigned pk2(float lo, float hi) { const f32x2_t v = {lo, hi}; const bf16x2_t b = __builtin_convertvector(v, bf16x2_t); return __builtin_bit_cast(unsigned, b); }
__device__ __forceinline__ bf16_t f2bf_d(float f) { return (bf16_t)(pk2(f, f) & 0xffffu); }
__device__ __forceinline__ float lo16(unsigned u) { return __uint_as_float(u << 16); }
__device__ __forceinline__ float hi16(unsigned u) { return __uint_as_float(u & 0xffff0000u); }
__device__ __forceinline__ float wave_sum(float v) {
#pragma unroll
    for (int o = 32; o >= 1; o >>= 1) v += __shfl_xor(v, o);
    return v;
}
__device__ __forceinline__ float sigmoidf_(float x) { return __builtin_amdgcn_rcpf(1.0f + __expf(-x)); }
__device__ __forceinline__ float siluf_(float x) { return x * __builtin_amdgcn_rcpf(1.0f + __expf(-x)); }
__device__ __forceinline__ float logsigf_(float x) { return fminf(x, 0.0f) - __logf(1.0f + __expf(-fabsf(x))); }
__device__ __forceinline__ bf16x8 mkfrag(u32x4 v) { return __builtin_bit_cast(bf16x8, v); }
__device__ __forceinline__ bf16x8 mkfrag2(u32x2 a, u32x2 b) { u32x4 v = {a.x, a.y, b.x, b.y}; return __builtin_bit_cast(bf16x8, v); }
#define MFMA(a, b, c) __builtin_amdgcn_mfma_f32_16x16x32_bf16((a), (b), (c), 0, 0, 0)
HD inline int iclamp(int v, int lo, int hi) { return v < lo ? lo : (v > hi ? hi : v); }

HD inline float2 cmulf(float2 a, float2 b) { float2 r; r.x = a.x * b.x - a.y * b.y; r.y = a.x * b.y + a.y * b.x; return r; }
HD inline float2 cmulcf(float2 a, float2 b) { float2 r; r.x = a.x * b.x + a.y * b.y; r.y = a.y * b.x - a.x * b.y; return r; }
struct Bfly { float2 x0, x1, x2, x3, W1; int i0; };
HD inline void bfly_load(Bfly& b, const float2* d, const float2* tw, int lgm, int q) {
    const int m = 1 << lgm, blk = q >> lgm, j = q & (m - 1);
    b.i0 = (blk << (lgm + 2)) + j;
    b.W1 = tw[j];
    b.x0 = d[b.i0]; b.x1 = d[b.i0 + m]; b.x2 = d[b.i0 + 2 * m]; b.x3 = d[b.i0 + 3 * m];
}
HD inline void bfly_fwd_store(const Bfly& b, float2* d, int lgm) {
    const int m = 1 << lgm, i0 = b.i0;
    const float2 W1 = b.W1, W2 = cmulf(W1, W1);
    const float2 x0 = b.x0, x1 = b.x1, x2 = b.x2, x3 = b.x3;
    float2 a0, a1, a2, a3, t;
    a0.x = x0.x + x2.x; a0.y = x0.y + x2.y;
    t.x = x0.x - x2.x; t.y = x0.y - x2.y; a2 = cmulf(t, W1);
    a1.x = x1.x + x3.x; a1.y = x1.y + x3.y;
    t.x = x1.x - x3.x; t.y = x1.y - x3.y; t = cmulf(t, W1); a3.x = t.y; a3.y = -t.x;
    float2 r;
    r.x = a0.x + a1.x; r.y = a0.y + a1.y; d[i0] = r;
    t.x = a0.x - a1.x; t.y = a0.y - a1.y; d[i0 + m] = cmulf(t, W2);
    r.x = a2.x + a3.x; r.y = a2.y + a3.y; d[i0 + 2 * m] = r;
    t.x = a2.x - a3.x; t.y = a2.y - a3.y; d[i0 + 3 * m] = cmulf(t, W2);
}
HD inline void bfly_inv_store(const Bfly& b, float2* d, int lgm) {
    const int m = 1 << lgm, i0 = b.i0;
    const float2 W1 = b.W1, W2 = cmulf(W1, W1);
    const float2 x0 = b.x0, x1 = b.x1, x2 = b.x2, x3 = b.x3;
    const float2 b1 = cmulcf(x1, W2), b3 = cmulcf(x3, W2);
    float2 y0, y1, y2, y3;
    y0.x = x0.x + b1.x; y0.y = x0.y + b1.y; y1.x = x0.x - b1.x; y1.y = x0.y - b1.y;
    y2.x = x2.x + b3.x; y2.y = x2.y + b3.y; y3.x = x2.x - b3.x; y3.y = x2.y - b3.y;
    const float2 c2 = cmulcf(y2, W1); float2 c3 = cmulcf(y3, W1); { const float tx = -c3.y, ty = c3.x; c3.x = tx; c3.y = ty; }
    float2 r;
    r.x = y0.x + c2.x; r.y = y0.y + c2.y; d[i0] = r;
    r.x = y0.x - c2.x; r.y = y0.y - c2.y; d[i0 + 2 * m] = r;
    r.x = y1.x + c3.x; r.y = y1.y + c3.y; d[i0 + m] = r;
    r.x = y1.x - c3.x; r.y = y1.y - c3.y; d[i0 + 3 * m] = r;
}
HD inline void fft_fwd_bfly(float2* d, const float2* tw, int lgm, int q) { Bfly b; bfly_load(b, d, tw, lgm, q); bfly_fwd_store(b, d, lgm); }
HD inline void fft_inv_bfly(float2* d, const float2* tw, int lgm, int q) { Bfly b; bfly_load(b, d, tw, lgm, q); bfly_inv_store(b, d, lgm); }
HD inline void r4_fwd(float2& x0, float2& x1, float2& x2, float2& x3, const float2 W1) {
    const float2 W2 = cmulf(W1, W1);
    float2 a0, a1, a2, a3, t;
    a0.x = x0.x + x2.x; a0.y = x0.y + x2.y;
    t.x = x0.x - x2.x; t.y = x0.y - x2.y; a2 = cmulf(t, W1);
    a1.x = x1.x + x3.x; a1.y = x1.y + x3.y;
    t.x = x1.x - x3.x; t.y = x1.y - x3.y; t = cmulf(t, W1); a3.x = t.y; a3.y = -t.x;
    x0.x = a0.x + a1.x; x0.y = a0.y + a1.y;
    t.x = a0.x - a1.x; t.y = a0.y - a1.y; x1 = cmulf(t, W2);
    x2.x = a2.x + a3.x; x2.y = a2.y + a3.y;
    t.x = a2.x - a3.x; t.y = a2.y - a3.y; x3 = cmulf(t, W2);
}
HD inline void r4_inv(float2& x0, float2& x1, float2& x2, float2& x3, const float2 W1) {
    const float2 W2 = cmulf(W1, W1);
    const float2 b1 = cmulcf(x1, W2), b3 = cmulcf(x3, W2);
    float2 y0, y1, y2, y3;
    y0.x = x0.x + b1.x; y0.y = x0.y + b1.y; y1.x = x0.x - b1.x; y1.y = x0.y - b1.y;
    y2.x = x2.x + b3.x; y2.y = x2.y + b3.y; y3.x = x2.x - b3.x; y3.y = x2.y - b3.y;
    const float2 c2 = cmulcf(y2, W1); float2 c3 = cmulcf(y3, W1); { const float tx = -c3.y, ty = c3.x; c3.x = tx; c3.y = ty; }
    x0.x = y0.x + c2.x; x0.y = y0.y + c2.y; x2.x = y0.x - c2.x; x2.y = y0.y - c2.y;
    x1.x = y1.x + c3.x; x1.y = y1.y + c3.y; x3.x = y1.x - c3.x; x3.y = y1.y - c3.y;
}
template <bool INV, bool HALF>
HD inline void r16_bfly(float2* d, const float2* twO, const float2* twI, int lgm, int q) {
    const int m = 1 << lgm, blk = q >> lgm, j = q & (m - 1), base = (blk << (lgm + 4)) + j;
    float2 e[4][4];
#pragma unroll
    for (int a = 0; a < 4; ++a)
#pragma unroll
        for (int b = 0; b < 4; ++b) {
            if (!INV && HALF && a >= 2) { e[a][b].x = 0.f; e[a][b].y = 0.f; }
            else e[a][b] = d[base + ((4 * a + b) << lgm)];
        }
    const float2 wI = twI[j];
    float2 wO[4];
#pragma unroll
    for (int b = 0; b < 4; ++b) wO[b] = twO[j + (b << lgm)];
    if (!INV) {
#pragma unroll
        for (int b = 0; b < 4; ++b) r4_fwd(e[0][b], e[1][b], e[2][b], e[3][b], wO[b]);
#pragma unroll
        for (int a = 0; a < 4; ++a) r4_fwd(e[a][0], e[a][1], e[a][2], e[a][3], wI);
    } else {
#pragma unroll
        for (int a = 0; a < 4; ++a) r4_inv(e[a][0], e[a][1], e[a][2], e[a][3], wI);
#pragma unroll
        for (int b = 0; b < 4; ++b) r4_inv(e[0][b], e[1][b], e[2][b], e[3][b], wO[b]);
    }
#pragma unroll
    for (int a = 0; a < 4; ++a)
#pragma unroll
        for (int b = 0; b < 4; ++b)
            if (!(INV && HALF && a >= 2)) d[base + ((4 * a + b) << lgm)] = e[a][b];
}
HD inline int brev14(int k) {
#if defined(__HIP_DEVICE_COMPILE__)
    return (int)(__brev((unsigned)k) >> 18);
#endif
    unsigned v = (unsigned)k;
    v = ((v >> 1) & 0x55555555u) | ((v & 0x55555555u) << 1);
    v = ((v >> 2) & 0x33333333u) | ((v & 0x33333333u) << 2);
    v = ((v >> 4) & 0x0f0f0f0fu) | ((v & 0x0f0f0f0fu) << 4);
    v = ((v >> 8) & 0x00ff00ffu) | ((v & 0x00ff00ffu) << 8);
    v = (v >> 16) | (v << 16);
    return (int)(v >> 18);
}
struct PwIn { float2 Z1, Z2; float4 A, B; int p1, p2; };
HD inline void pw_load(PwIn& w, const float2* d, const float4* pq, int p1) {
    const int kf = brev14(p1), k2 = (FN - kf) & (FN - 1); w.p1 = p1; w.p2 = brev14(k2);
    w.Z1 = d[w.p1]; w.Z2 = d[w.p2]; w.A = pq[w.p1]; w.B.x = w.A.x; w.B.y = -w.A.y; w.B.z = w.A.z; w.B.w = -w.A.w;
}
HD inline void pw_store(const PwIn& w, float2* d) {
    const float2 Z1 = w.Z1, Z2 = w.Z2;
    float2 P1, Q1, P2, Q2; P1.x = w.A.x; P1.y = w.A.y; Q1.x = w.A.z; Q1.y = w.A.w; P2.x = w.B.x; P2.y = w.B.y; Q2.x = w.B.z; Q2.y = w.B.w;
    float2 c1, c2; c1.x = Z1.x; c1.y = -Z1.y; c2.x = Z2.x; c2.y = -Z2.y;
    const float2 a = cmulf(Z1, P1), b = cmulf(c2, Q1), c = cmulf(Z2, P2), e = cmulf(c1, Q2);
    float2 w1, w2; w1.x = a.x + b.x; w1.y = a.y + b.y; w2.x = c.x + e.x; w2.y = c.y + e.y;
    d[w.p1] = w1;
    if (w.p2 != w.p1) d[w.p2] = w2;
}
HD inline void conv_pointwise(float2* d, const float4* pq, int p1) { PwIn w; pw_load(w, d, pq, p1); pw_store(w, d); }
HD inline void filt_pointwise(const float2* d, float4* pq, int p1) {
    const int kf = brev14(p1), k2 = (FN - kf) & (FN - 1), p2 = brev14(k2);
    const float2 Z1 = d[p1], Z2 = d[p2];
    const float gcx = 0.5f * (Z1.x + Z2.x), gcy = 0.5f * (Z1.y - Z2.y);
    const float gdx = 0.5f * (Z1.y + Z2.y), gdy = -0.5f * (Z1.x - Z2.x);
    const float s = 0.5f / (float)FN;
    float4 A; A.x = s * (gcx + gdx); A.y = s * (gcy + gdy); A.z = s * (gcx - gdx); A.w = s * (gcy - gdy);
    pq[p1] = A;
}
HD inline int tw_off(int lgm) { return lgm == 10 ? 0 : lgm == 8 ? 1024 : lgm == 6 ? 1280 : lgm == 4 ? 1344 : lgm == 2 ? 1360 : 1364; }
#ifndef FFT_HOST_TEST
template <int LGM, bool INV>
__device__ __forceinline__ void fft_pass(float2* d, const float2* twl, const float2* twg, int tid) {
    const float2* tw = (LGM == 12) ? twg : twl + tw_off(LGM);
#pragma unroll
    for (int it = 0; it < 2; ++it) {
        const int q = tid + it * 4 * NTHR;
        Bfly b0, b1, b2, b3;
        bfly_load(b0, d, tw, LGM, q); bfly_load(b1, d, tw, LGM, q + NTHR); bfly_load(b2, d, tw, LGM, q + 2 * NTHR); bfly_load(b3, d, tw, LGM, q + 3 * NTHR);
        if (INV) { bfly_inv_store(b0, d, LGM); bfly_inv_store(b1, d, LGM); bfly_inv_store(b2, d, LGM); bfly_inv_store(b3, d, LGM); }
        else { bfly_fwd_store(b0, d, LGM); bfly_fwd_store(b1, d, LGM); bfly_fwd_store(b2, d, LGM); bfly_fwd_store(b3, d, LGM); }
    }
    __syncthreads();
}
template <int LGM, bool INV, bool HALF>
__device__ __forceinline__ void fft_pass16(float2* d, const float2* twl, const float2* twg, int tid) {
    const float2* twO = (LGM + 2 == 12) ? twg : twl + tw_off(LGM + 2);
    const float2* twI = twl + tw_off(LGM);
    r16_bfly<INV, HALF>(d, twO, twI, LGM, tid);
    r16_bfly<INV, HALF>(d, twO, twI, LGM, tid + NTHR);
    __syncthreads();
}
template <bool HALF>
__device__ __forceinline__ void fft_forward(float2* d, const float2* twl, const float2* twg) {
    int tid = threadIdx.x; asm volatile("" : "+v"(tid));
    fft_pass16<10, false, HALF>(d, twl, twg, tid); fft_pass16<6, false, false>(d, twl, twg, tid);
    fft_pass<4, false>(d, twl, twg, tid); fft_pass<2, false>(d, twl, twg, tid); fft_pass<0, false>(d, twl, twg, tid);
}
template <bool HALF>
__device__ __forceinline__ void fft_inverse(float2* d, const float2* twl, const float2* twg) {
    int tid = threadIdx.x; asm volatile("" : "+v"(tid));
    fft_pass<0, true>(d, twl, twg, tid); fft_pass<2, true>(d, twl, twg, tid); fft_pass<4, true>(d, twl, twg, tid);
    fft_pass16<6, true, false>(d, twl, twg, tid); fft_pass16<10, true, HALF>(d, twl, twg, tid);
}
__device__ __forceinline__ float2* fft_lds_twiddles(const float2* twg, unsigned char* lds) {
    int tid = threadIdx.x; asm volatile("" : "+v"(tid));
    float2* t = (float2*)(lds + 131072);
    for (int k = tid; k < 1365; k += NTHR) {
        const int lgm = k < 1024 ? 10 : k < 1280 ? 8 : k < 1344 ? 6 : k < 1360 ? 4 : k < 1364 ? 2 : 0;
        t[k] = twg[(k - tw_off(lgm)) << (12 - lgm)];
    }
    __syncthreads();
    return t;
}

constexpr int STG = 49152;
__device__ __forceinline__ int swz(int row, int ch) { return row * 128 + ((ch ^ ((row >> 1) & 7)) << 4); }
__device__ __forceinline__ void gemm_core(f32x4 (&acc)[4][4], const bf16_t* A, int lda, const bf16_t* Bt, int ldb, int K, unsigned char* lds) {
    int tid_ = threadIdx.x; asm volatile("" : "+v"(tid_)); const int tid = tid_, lane = tid & 63, w = tid >> 6, wm = w & 3, wn = w >> 2, l15 = lane & 15, q4 = lane >> 4;
    const int wu = __builtin_amdgcn_readfirstlane(w);
    __attribute__((address_space(3))) unsigned char* l3 = (__attribute__((address_space(3))) unsigned char*)lds;
#pragma unroll
    for (int mi = 0; mi < 4; ++mi)
#pragma unroll
        for (int ni = 0; ni < 4; ++ni) acc[mi][ni] = (f32x4){0.f, 0.f, 0.f, 0.f};
    const int r8 = lane >> 3, sch = (lane & 7) ^ ((((w & 1) << 2) + (r8 >> 1)) & 7);
    const bf16_t* ap = A + (size_t)(w * 8 + r8) * lda + sch * 8;
    const bf16_t* bp = Bt + (size_t)(w * 8 + r8) * ldb + sch * 8;
#define GC_STAGE(buf, k0)                                                                                                                         \
    {                                                                                                                                             \
        _Pragma("unroll") for (int i = 0; i < 4; ++i)                                                                                             \
            __builtin_amdgcn_global_load_lds((const unsigned*)(ap + (size_t)(64 * i) * lda + (k0)), (__attribute__((address_space(3))) unsigned*)(l3 + (buf) * STG + (wu + 8 * i) * 1024), 16, 0, 0);          \
        _Pragma("unroll") for (int i = 0; i < 2; ++i)                                                                                             \
            __builtin_amdgcn_global_load_lds((const unsigned*)(bp + (size_t)(64 * i) * ldb + (k0)), (__attribute__((address_space(3))) unsigned*)(l3 + (buf) * STG + 32768 + (wu + 8 * i) * 1024), 16, 0, 0);  \
    }
    GC_STAGE(0, 0)
    asm volatile("s_waitcnt vmcnt(0)" ::: "memory");
    __syncthreads();
    const int nk = K >> 6;
    for (int kt = 0; kt < nk; ++kt) {
        if (kt + 1 < nk) GC_STAGE((kt + 1) & 1, (kt + 1) << 6)
        const unsigned char* sa = lds + (kt & 1) * STG;
        const unsigned char* sb = sa + 32768;
#pragma unroll
        for (int ks = 0; ks < 2; ++ks) {
            bf16x8 af[4], bfr[4];
#pragma unroll
            for (int mi = 0; mi < 4; ++mi) af[mi] = *(const bf16x8*)(sa + swz(wm * 64 + mi * 16 + l15, ks * 4 + q4));
#pragma unroll
            for (int ni = 0; ni < 4; ++ni) bfr[ni] = *(const bf16x8*)(sb + swz(wn * 64 + ni * 16 + l15, ks * 4 + q4));
#pragma unroll
            for (int mi = 0; mi < 4; ++mi)
#pragma unroll
                for (int ni = 0; ni < 4; ++ni) acc[mi][ni] = MFMA(bfr[ni], af[mi], acc[mi][ni]);
        }
        asm volatile("s_waitcnt vmcnt(0)" ::: "memory");
        __syncthreads();
    }
#undef GC_STAGE
}
#define EPI_LOOP(body)                                                                                                  \
    {                                                                                                                   \
        int e_t = threadIdx.x; asm volatile("" : "+v"(e_t)); const int e_lane = e_t & 63, e_w = e_t >> 6;                                                    \
        _Pragma("unroll") for (int mi = 0; mi < 4; ++mi) _Pragma("unroll") for (int ni = 0; ni < 4; ++ni) {             \
            const int row = m0 + (e_w & 3) * 64 + mi * 16 + (e_lane & 15);                                              \
            const int col = n0 + (e_w >> 2) * 64 + ni * 16 + 4 * (e_lane >> 4);                                         \
            f32x4& v = acc[mi][ni];                                                                                     \
            body                                                                                                        \
        }                                                                                                               \
    }
__device__ __forceinline__ void st_bf4(bf16_t* dst, f32x4 v) {
    u32x2 o; o.x = pk2(v[0], v[1]); o.y = pk2(v[2], v[3]); *(u32x2*)dst = o;
}
__device__ __forceinline__ f32x4 ld_bf4(const bf16_t* src) {
    const u32x2 u = *(const u32x2*)src; f32x4 r = {lo16(u.x), hi16(u.x), lo16(u.y), hi16(u.y)}; return r;
}


__device__ __forceinline__ void merge_tile(const bf16_t* P, const bf16_t* WtBr, bf16_t* merged, int m0, int n0, unsigned char* lds) {
    int tid_ = threadIdx.x; asm volatile("" : "+v"(tid_)); const int tid = tid_, lane = tid & 63, w = tid >> 6, wm = w & 3, wn = w >> 2, l15 = lane & 15, q4 = lane >> 4;
    const int wu = __builtin_amdgcn_readfirstlane(w);
    __attribute__((address_space(3))) unsigned char* l3 = (__attribute__((address_space(3))) unsigned char*)lds;
    f32x4 acc[4][4], macc[4][4];
#pragma unroll
    for (int mi = 0; mi < 4; ++mi)
#pragma unroll
        for (int ni = 0; ni < 4; ++ni) { acc[mi][ni] = (f32x4){0.f, 0.f, 0.f, 0.f}; macc[mi][ni] = (f32x4){0.f, 0.f, 0.f, 0.f}; }
    const int r8 = lane >> 3, sch = (lane & 7) ^ ((((w & 1) << 2) + (r8 >> 1)) & 7);
    const bf16_t* ap = P + (size_t)(m0 + w * 8 + r8) * PS + sch * 8;
    const bf16_t* bp = WtBr + (size_t)(n0 + w * 8 + r8) * 512 + sch * 8;
    const bf16_t* sgp = P + (size_t)(m0 + wm * 64 + l15) * PS + C_SG + n0 + wn * 64 + 4 * q4;
#define MG_STAGE(buf, kt_)                                                                                                                        \
    {                                                                                                                                             \
        const int j_ = (kt_) >> 3, k0_ = ((kt_) & 7) << 6;                                                                                        \
        const int acol_ = (j_ == 0) ? C_NAQ : (j_ == 1) ? C_HY : (j_ == 2) ? C_GV : C_MQ;                                                        \
        _Pragma("unroll") for (int i = 0; i < 4; ++i)                                                                                             \
            __builtin_amdgcn_global_load_lds((const unsigned*)(ap + (size_t)(64 * i) * PS + acol_ + k0_), (__attribute__((address_space(3))) unsigned*)(l3 + (buf) * STG + (wu + 8 * i) * 1024), 16, 0, 0);      \
        _Pragma("unroll") for (int i = 0; i < 2; ++i)                                                                                             \
            __builtin_amdgcn_global_load_lds((const unsigned*)(bp + (size_t)j_ * 1024 * 512 + (size_t)(64 * i) * 512 + k0_), (__attribute__((address_space(3))) unsigned*)(l3 + (buf) * STG + 32768 + (wu + 8 * i) * 1024), 16, 0, 0);  \
    }
    MG_STAGE(0, 0)
    MG_STAGE(1, 1)
    asm volatile("s_waitcnt vmcnt(6)" ::: "memory");
    __builtin_amdgcn_s_barrier(); asm volatile("" ::: "memory");
    int cb = 0;
#pragma unroll 1
    for (int kt = 0; kt < 32; ++kt) {
        const bool last = (kt & 7) == 7;
        u32x2 sg[4][4];
        if (last) {
            const bf16_t* sp = sgp + 1024 * (kt >> 3);
#pragma unroll
            for (int mi = 0; mi < 4; ++mi)
#pragma unroll
                for (int ni = 0; ni < 4; ++ni) sg[mi][ni] = *(const u32x2*)(sp + (size_t)(mi * 16) * PS + ni * 16);
        }
        const int nb = (cb == 0) ? 2 : cb - 1;
        if (kt + 2 < 32) MG_STAGE(nb, kt + 2)
        const unsigned char* sa = lds + cb * STG;
        const unsigned char* sb = sa + 32768;
#pragma unroll
        for (int ks = 0; ks < 2; ++ks) {
            bf16x8 af[4], bfr[4];
#pragma unroll
            for (int mi = 0; mi < 4; ++mi) af[mi] = *(const bf16x8*)(sa + swz(wm * 64 + mi * 16 + l15, ks * 4 + q4));
#pragma unroll
            for (int ni = 0; ni < 4; ++ni) bfr[ni] = *(const bf16x8*)(sb + swz(wn * 64 + ni * 16 + l15, ks * 4 + q4));
            __builtin_amdgcn_s_setprio(1);
#pragma unroll
            for (int mi = 0; mi < 4; ++mi)
#pragma unroll
                for (int ni = 0; ni < 4; ++ni) acc[mi][ni] = MFMA(bfr[ni], af[mi], acc[mi][ni]);
            __builtin_amdgcn_s_setprio(0);
        }
        if (kt + 2 < 32) asm volatile("s_waitcnt vmcnt(6)" ::: "memory"); else asm volatile("s_waitcnt vmcnt(0)" ::: "memory");
        if (last) {
#pragma unroll
            for (int mi = 0; mi < 4; ++mi)
#pragma unroll
                for (int ni = 0; ni < 4; ++ni) {
                    const u32x2 u = sg[mi][ni]; const f32x4 g4 = {lo16(u.x), hi16(u.x), lo16(u.y), hi16(u.y)};
                    macc[mi][ni] += g4 * acc[mi][ni]; acc[mi][ni] = (f32x4){0.f, 0.f, 0.f, 0.f};
                }
        }
        asm volatile("" ::: "memory"); __builtin_amdgcn_s_barrier(); asm volatile("" ::: "memory");
        cb = (cb == 2) ? 0 : cb + 1;
    }
#undef MG_STAGE
    __syncthreads();
#pragma unroll
    for (int mi = 0; mi < 4; ++mi)
#pragma unroll
        for (int ni = 0; ni < 4; ++ni) st_bf4(merged + (size_t)(m0 + wm * 64 + mi * 16 + l15) * 1024 + n0 + wn * 64 + ni * 16 + 4 * q4, macc[mi][ni]);
}

__device__ __forceinline__ int orig_col(int n) {
    if (n < 4096) return n;
    if (n < 4608) return n + 32;
    if (n < 6656) return n + 32;
    if (n < 10752) return n + 32;
    return n - 10752 + 4096;
}

__device__ __forceinline__ void ln_rows(const float* src, size_t src_row0, int nrows, const float* g, const float* b, float* dst32, bf16_t* dst16, size_t dst_row0, float2* stats) {
    int tid_ = threadIdx.x; asm volatile("" : "+v"(tid_));
    const int lane = tid_ & 63;
    const int gw = blockIdx.x * (NTHR / 64) + (tid_ >> 6), nw = gridDim.x * (NTHR / 64);
    for (int r = gw; r < nrows; r += nw) {
        const float4* xr = (const float4*)(src + (src_row0 + r) * 1024);
        float4 v[4]; float s = 0.f;
#pragma unroll
        for (int i = 0; i < 4; ++i) { v[i] = xr[lane + 64 * i]; s += (v[i].x + v[i].y) + (v[i].z + v[i].w); }
        s = wave_sum(s);
        const float mean = s * (1.0f / 1024.0f);
        float q = 0.f;
#pragma unroll
        for (int i = 0; i < 4; ++i) { const float a = v[i].x - mean, bb = v[i].y - mean, c = v[i].z - mean, d = v[i].w - mean; q += (a * a + bb * bb) + (c * c + d * d); }
        q = wave_sum(q);
        const float rstd = 1.0f / sqrtf(q * (1.0f / 1024.0f) + 1e-5f);
        if (stats && lane == 0) { float2 st; st.x = mean; st.y = rstd; stats[dst_row0 + r] = st; }
#pragma unroll
        for (int i = 0; i < 4; ++i) {
            const float4 g4 = ((const float4*)g)[lane + 64 * i], b4 = ((const float4*)b)[lane + 64 * i];
            float4 y; y.x = (v[i].x - mean) * rstd * g4.x + b4.x; y.y = (v[i].y - mean) * rstd * g4.y + b4.y; y.z = (v[i].z - mean) * rstd * g4.z + b4.z; y.w = (v[i].w - mean) * rstd * g4.w + b4.w;
            if (dst32) ((float4*)(dst32 + (dst_row0 + r) * 1024))[lane + 64 * i] = y;
            if (dst16) { u32x2 o; o.x = pk2(y.x, y.y); o.y = pk2(y.z, y.w); *(u32x2*)(dst16 + (dst_row0 + r) * 1024 + (lane + 64 * i) * 4) = o; }
        }
    }
}
__device__ __forceinline__ void phase0(const Params& p) {
    ln_rows(p.x, 0, NTOK, p.ln_in_g, p.ln_in_b, nullptr, (bf16_t*)(p.ws + OFF_HB), 0, (float2*)(p.ws + OFF_STATS));
    int tid_ = threadIdx.x; asm volatile("" : "+v"(tid_)); const int gt = blockIdx.x * NTHR + tid_, nt = gridDim.x * NTHR;
    float2* tw = (float2*)(p.ws + OFF_TW);
    for (int k = gt; k < FN; k += nt) { double s, c; sincospi(-2.0 * (double)k / (double)FN, &s, &c); float2 t; t.x = (float)c; t.y = (float)s; tw[k] = t; }
    bf16_t* mb = (bf16_t*)(p.ws + OFF_MEMBF);
    for (int i = gt; i < 2048 * 1024 / 4; i += nt) { const float4 v = ((const float4*)p.mem)[i]; u32x2 o; o.x = pk2(v.x, v.y); o.y = pk2(v.z, v.w); ((u32x2*)mb)[i] = o; }
    float* en = (float*)(p.ws + OFF_ENERGY);
    for (int i = gt; i < 1024; i += nt) en[i] = 0.f;
    float* ztab = (float*)(p.ws + OFF_ZT);
    for (int idx = gt; idx < 8192 * 33; idx += nt) {
        const int n = idx / 33, e = idx - n * 33;
        float v;
        if (e == 0) v = (float)n / 8191.0f;
        else {
            const int i = (e - 1) & 15;
            const double fr = 1e-4 + (double)i * ((15.0 - 1e-4) / 15.0);
            const double ang = (2.0 * 3.14159265358979323846 / 8192.0) * (double)n * fr;
            v = (e <= 16) ? (float)cos(ang) : (float)(-sin(ang));
        }
        ztab[idx] = v;
    }
}

__device__ __forceinline__ void wt_tile(const float* src, int src_ld, int k0, int on0, bf16_t* dst, int dst_ld, int dn0, bool zero, float* tile) {
    int tid_ = threadIdx.x; asm volatile("" : "+v"(tid_)); const int tid = tid_;
    if (!zero) {
#pragma unroll
        for (int i = 0; i < 2; ++i) {
            const int k = (tid >> 3) + 64 * i, c4 = (tid & 7) * 4;
            const float4 v = *(const float4*)(src + (size_t)(k0 + k) * src_ld + on0 + c4);
            float* t = tile + k * 33 + c4; t[0] = v.x; t[1] = v.y; t[2] = v.z; t[3] = v.w;
        }
    }
    __syncthreads();
    const int n = tid >> 4, kc = (tid & 15) * 8;
    float f[8];
#pragma unroll
    for (int e = 0; e < 8; ++e) f[e] = zero ? 0.f : tile[(kc + e) * 33 + n];
    u32x4 o; o.x = pk2(f[0], f[1]); o.y = pk2(f[2], f[3]); o.z = pk2(f[4], f[5]); o.w = pk2(f[6], f[7]);
    *(u32x4*)(dst + (size_t)(dn0 + n) * dst_ld + k0 + kc) = o;
    __syncthreads();
}
__device__ __forceinline__ void phase_weights(const Params& p, int l, unsigned char* lds) {
    float* tile = (float*)lds;
    for (int it = blockIdx.x; it < 3776; it += gridDim.x) {
        if (it < 2752) {
            const int nt = it >> 3, kt = it & 7, dn0 = nt * 32;
            wt_tile(p.w_in + (size_t)l * 1024 * NIN, NIN, kt * 128, orig_col(dn0), (bf16_t*)(p.ws + OFF_WTIN), 1024, dn0, dn0 >= NIN, tile);
        } else if (it < 3264) {
            const int r = it - 2752, j = r >> 7, nt = (r >> 2) & 31, kt = r & 3;
            wt_tile(p.w_br + (size_t)(l * 4 + j) * 512 * 1024, 1024, kt * 128, nt * 32, (bf16_t*)(p.ws + OFF_WTBR) + (size_t)j * 1024 * 512, 512, nt * 32, false, tile);
        } else if (it < 3520) {
            const int r = it - 3264, nt = r >> 3, kt = r & 7;
            wt_tile(p.w_out + (size_t)l * 1024 * 1024, 1024, kt * 128, nt * 32, (bf16_t*)(p.ws + OFF_WTOUT), 1024, nt * 32, false, tile);
        } else {
            const int r = it - 3520, nt = r >> 3, kt = r & 7;
            wt_tile(p.mem_w_kv + (size_t)l * 1024 * 1024, 1024, kt * 128, nt * 32, (bf16_t*)(p.ws + OFF_WTKV), 1024, nt * 32, false, tile);
        }
    }
}

__device__ __forceinline__ void phase_filter_gen(const Params& p, int l, unsigned char* lds) {
    float* zt = (float*)lds;
    float* ha = zt + 32 * 33;
    float* hbuf = ha + 32 * 64;
    int tid_ = threadIdx.x; asm volatile("" : "+v"(tid_)); const int tid = tid_;
    const float* w1 = p.hy_w1 + (size_t)l * 33 * 64; const float* b1 = p.hy_b1 + l * 64;
    const float* wm = p.hy_wm + (size_t)l * 2 * 64 * 64; const float* bm = p.hy_bm + l * 2 * 64;
    const float* w3 = p.hy_w3 + (size_t)l * 64 * 1024;
    float* hf = (float*)(p.ws + OFF_HFILT);
    float* en = (float*)(p.ws + OFF_ENERGY) + l * 512;
    const float* ztab = (const float*)(p.ws + OFF_ZT);
    for (int it = blockIdx.x; it < 256; it += gridDim.x) {
        const int n0 = it * 32;
        for (int idx = tid; idx < 32 * 33; idx += NTHR) zt[idx] = ztab[(size_t)n0 * 33 + idx];
        __syncthreads();
        for (int idx = tid; idx < 2048; idx += NTHR) {
            const int pos = idx >> 6, j = idx & 63; float s = b1[j];
            for (int e = 0; e < 33; ++e) s += zt[pos * 33 + e] * w1[e * 64 + j];
            ha[idx] = sinf(s);
        }
        __syncthreads();
        for (int idx = tid; idx < 2048; idx += NTHR) {
            const int pos = idx >> 6, j = idx & 63; float s = bm[j];
            for (int e = 0; e < 64; ++e) s += ha[pos * 64 + e] * wm[e * 64 + j];
            hbuf[idx] = sinf(s);
        }
        __syncthreads();
        for (int idx = tid; idx < 2048; idx += NTHR) {
            const int pos = idx >> 6, j = idx & 63; float s = bm[64 + j];
            for (int e = 0; e < 64; ++e) s += hbuf[pos * 64 + e] * wm[4096 + e * 64 + j];
            ha[idx] = sinf(s);
        }
        __syncthreads();
        {
            const int c = tid;
            float af[32], ab[32];
#pragma unroll
            for (int i = 0; i < 32; ++i) { af[i] = 0.f; ab[i] = 0.f; }
            for (int k = 0; k < 64; ++k) {
                const float wf = w3[k * 1024 + c], wb = w3[k * 1024 + 512 + c];
#pragma unroll
                for (int i = 0; i < 32; ++i) { const float h = ha[i * 64 + k]; af[i] += h * wf; ab[i] += h * wb; }
            }
            const float dmin = -3.0701134573253945f, dmax = -15.350567286626973f;
            const float delta = fabsf(dmin + (float)c * ((dmax - dmin) / 511.0f));
            float e = 0.f;
#pragma unroll
            for (int i = 0; i < 32; ++i) {
                const int n = n0 + i; const float t01 = (float)n / 8191.0f; const float win = expf(-t01 * delta);
                af[i] *= win; ab[i] *= win; e += af[i] * af[i]; if (n >= 1) e += ab[i] * ab[i];
            }
#pragma unroll
            for (int i = 0; i < 8; ++i) {
                float4 a; a.x = af[4 * i]; a.y = af[4 * i + 1]; a.z = af[4 * i + 2]; a.w = af[4 * i + 3];
                float4 b; b.x = ab[4 * i]; b.y = ab[4 * i + 1]; b.z = ab[4 * i + 2]; b.w = ab[4 * i + 3];
                *(float4*)(hf + (size_t)c * 8192 + n0 + 4 * i) = a;
                *(float4*)(hf + (size_t)(512 + c) * 8192 + n0 + 4 * i) = b;
            }
            atomicAdd(en + c, e);
        }
        __syncthreads();
    }
}

__device__ __forceinline__ void phase_filter_fft(const Params& p, int l, unsigned char* lds) {
    float2* d = (float2*)lds;
    const float2* tw = fft_lds_twiddles((const float2*)(p.ws + OFF_TW), lds);
    const float* hf = (const float*)(p.ws + OFF_HFILT);
    const float* en = (const float*)(p.ws + OFF_ENERGY) + l * 512;
    float4* pqa = (float4*)(p.ws + OFF_PQ);
    int tid_ = threadIdx.x; asm volatile("" : "+v"(tid_)); const int tid = tid_;
    for (int pr = blockIdx.x; pr < 256; pr += gridDim.x) {
        const int c0 = 2 * pr, c1 = c0 + 1;
        const float s0 = 1.0f / sqrtf(en[c0] + 1e-6f), s1 = 1.0f / sqrtf(en[c1] + 1e-6f);
        const float k0 = p.hy_skip[l * 512 + c0], k1 = p.hy_skip[l * 512 + c1];
        for (int n = tid; n < FN; n += NTHR) {
            float2 v;
            if (n < 8192) { v.x = hf[(size_t)c0 * 8192 + n] * s0; v.y = hf[(size_t)c1 * 8192 + n] * s1; if (n == 0) { v.x += k0; v.y += k1; } }
            else if (n == 8192) { v.x = 0.f; v.y = 0.f; }
            else { v.x = hf[(size_t)(512 + c0) * 8192 + (FN - n)] * s0; v.y = hf[(size_t)(512 + c1) * 8192 + (FN - n)] * s1; }
            d[n] = v;
        }
        __syncthreads();
        fft_forward<false>(d, tw, (const float2*)(p.ws + OFF_TW));
        for (int h = tid; h < FN / 2; h += NTHR) filt_pointwise(d, pqa + (size_t)pr * FN, 2 * h);
        if (tid == 0) filt_pointwise(d, pqa + (size_t)pr * FN, 1);
        __syncthreads();
    }
}

__device__ __forceinline__ void hy_pre_item(const Params& p, int l, const bf16_t* P, float* UT, bf16_t* GT, int bl, int tt, int ct, unsigned char* lds) {
    float* tU = (float*)lds;
    float* tG = tU + 64 * 65;
    int tid_ = threadIdx.x; asm volatile("" : "+v"(tid_)); const int tid = tid_;
    const int t = tid >> 3, cc = (tid & 7) * 8, c = ct * 64 + cc, tb = tt * 64 + t;
    const float* cw = p.hy_conv_w + (size_t)l * 3 * 1536; const float* cb = p.hy_conv_b + l * 1536;
    float av[8], a0[8], a1[8];
#pragma unroll
    for (int h = 0; h < 2; ++h) {
        const f32x4 bv = *(const f32x4*)(cb + c + 4 * h), b0 = *(const f32x4*)(cb + 512 + c + 4 * h), b1 = *(const f32x4*)(cb + 1024 + c + 4 * h);
#pragma unroll
        for (int e = 0; e < 4; ++e) { av[4 * h + e] = bv[e]; a0[4 * h + e] = b0[e]; a1[4 * h + e] = b1[e]; }
    }
#pragma unroll
    for (int j = 0; j < 3; ++j) {
        const int ts = tb + j - 1;
        if (ts >= 0 && ts < SEQ) {
            const bf16_t* row = P + (size_t)(bl * SEQ + ts) * PS + C_HY + c;
            const u32x4 rv = *(const u32x4*)row, r0 = *(const u32x4*)(row + 512), r1 = *(const u32x4*)(row + 1024);
#pragma unroll
            for (int h = 0; h < 2; ++h) {
                const f32x4 wv = *(const f32x4*)(cw + j * 1536 + c + 4 * h), w0 = *(const f32x4*)(cw + j * 1536 + 512 + c + 4 * h), w1 = *(const f32x4*)(cw + j * 1536 + 1024 + c + 4 * h);
#pragma unroll
                for (int e = 0; e < 4; ++e) {
                    const int k = 4 * h + e; const unsigned uv = rv[k >> 1], u0 = r0[k >> 1], u1 = r1[k >> 1];
                    av[k] += wv[e] * ((k & 1) ? hi16(uv) : lo16(uv)); a0[k] += w0[e] * ((k & 1) ? hi16(u0) : lo16(u0)); a1[k] += w1[e] * ((k & 1) ? hi16(u1) : lo16(u1));
                }
            }
        }
    }
    const u32x4 rz = *(const u32x4*)(P + (size_t)(bl * SEQ + tb) * PS + C_Z + 512 + c);
#pragma unroll
    for (int k = 0; k < 8; ++k) {
        const unsigned uz = rz[k >> 1]; const float z = (k & 1) ? hi16(uz) : lo16(uz);
        tU[(cc + k) * 65 + t] = av[k] * a1[k]; tG[(cc + k) * 65 + t] = a0[k] * z;
    }
    __syncthreads();
    const int c2 = tid >> 3, t8 = (tid & 7) * 8;
    const size_t o = (size_t)(bl * 512 + ct * 64 + c2) * SEQ + tt * 64 + t8;
    const float* su = tU + c2 * 65 + t8; const float* sg = tG + c2 * 65 + t8;
    f32x4 ua = {su[0], su[1], su[2], su[3]}, ub = {su[4], su[5], su[6], su[7]};
    *(f32x4*)(UT + o) = ua; *(f32x4*)(UT + o + 4) = ub;
    u32x4 g; g.x = pk2(sg[0], sg[1]); g.y = pk2(sg[2], sg[3]); g.z = pk2(sg[4], sg[5]); g.w = pk2(sg[6], sg[7]);
    *(u32x4*)(GT + o) = g;
    __syncthreads();
}
__device__ __forceinline__ void hy_post_item(bf16_t* P, const bf16_t* GT, int bl, int tt, int ct, unsigned char* lds, int dry = 0) {
    bf16_t* tl = (bf16_t*)lds;
    int tid_ = threadIdx.x; asm volatile("" : "+v"(tid_)); const int tid = tid_;
    const int c2 = tid >> 3, t8 = (tid & 7) * 8;
    const u32x4 v = *(const u32x4*)(GT + (size_t)(bl * 512 + ct * 64 + c2) * SEQ + tt * 64 + t8);
    bf16_t* d0 = tl + t8 * 72 + c2;
    d0[0 * 72] = (bf16_t)(v.x & 0xffffu); d0[1 * 72] = (bf16_t)(v.x >> 16); d0[2 * 72] = (bf16_t)(v.y & 0xffffu); d0[3 * 72] = (bf16_t)(v.y >> 16);
    d0[4 * 72] = (bf16_t)(v.z & 0xffffu); d0[5 * 72] = (bf16_t)(v.z >> 16); d0[6 * 72] = (bf16_t)(v.w & 0xffffu); d0[7 * 72] = (bf16_t)(v.w >> 16);
    __syncthreads();
    const int t = tid >> 3, cc = (tid & 7) * 8;
    const u32x4 ov = *(const u32x4*)(tl + t * 72 + cc);
    if (!dry) *(u32x4*)(P + (size_t)(bl * SEQ + tt * 64 + t) * PS + C_HY + ct * 64 + cc) = ov;
    __syncthreads();
}
__device__ __forceinline__ void hyena_conv_item(const Params& p, const float* UT, bf16_t* GT, int bl, int pr, unsigned char* lds, const float2* tw, int dry = 0) {
    float2* d = (float2*)lds;
    const float4* pq = (const float4*)(p.ws + OFF_PQ) + (size_t)pr * FN;
    int tid_ = threadIdx.x; asm volatile("" : "+v"(tid_)); const int tid = tid_;
    const float* u0 = UT + (size_t)(bl * 512 + 2 * pr) * SEQ; const float* u1 = u0 + SEQ;
    bf16_t* g0 = GT + (size_t)(bl * 512 + 2 * pr) * SEQ; bf16_t* g1 = g0 + SEQ;
    {
        float f0[16], f1[16];
#pragma unroll
        for (int i = 0; i < 16; ++i) { f0[i] = u0[tid + NTHR * i]; f1[i] = u1[tid + NTHR * i]; }
#pragma unroll
        for (int i = 0; i < 16; ++i) {
            float2 u; u.x = f0[i]; u.y = f1[i]; d[tid + NTHR * i] = u;
        }
    }
    __syncthreads();
    fft_forward<true>(d, tw, (const float2*)(p.ws + OFF_TW));
#pragma unroll 1
    for (int h = tid; h < FN / 2; h += 4 * NTHR) {
        PwIn w0, w1, w2, w3;
        pw_load(w0, d, pq, 2 * h); pw_load(w1, d, pq, 2 * (h + NTHR)); pw_load(w2, d, pq, 2 * (h + 2 * NTHR)); pw_load(w3, d, pq, 2 * (h + 3 * NTHR));
        pw_store(w0, d); pw_store(w1, d); pw_store(w2, d); pw_store(w3, d);
    }
    if (tid == 0) conv_pointwise(d, pq, 1);
    __syncthreads();
    fft_inverse<true>(d, tw, (const float2*)(p.ws + OFF_TW));
    {
        bf16_t a0[16], a1[16];
#pragma unroll
        for (int i = 0; i < 16; ++i) { a0[i] = g0[tid + NTHR * i]; a1[i] = g1[tid + NTHR * i]; }
#pragma unroll
        for (int i = 0; i < 16; ++i) {
            const int t = tid + NTHR * i;
            const float2 y = d[t];
            const bf16_t r0 = f2bf_d(y.x * bf2f(a0[i])), r1 = f2bf_d(y.y * bf2f(a1[i]));
            if (!dry) { g0[t] = r0; g1[t] = r1; }
        }
    }
    __syncthreads();
}

__device__ __forceinline__ void na_item(const Params& p, int l, bf16_t* P, int bl, int rp, int head, unsigned char* lds, int dry = 0) {
    bf16_t* Kimg = (bf16_t*)lds;
    bf16_t* VT = (bf16_t*)(lds + 82944);
    int tid_ = threadIdx.x; asm volatile("" : "+v"(tid_)); const int tid = tid_, lane = tid & 63, w = tid >> 6, l15 = lane & 15, q4 = lane >> 4;
    const int r0 = 2 * rp, rs0 = iclamp(r0 - 4, 0, 120);
#pragma unroll
    for (int i = 0; i < 9; ++i) {
        const int idx = tid + NTHR * i, key = idx >> 3, ch = idx & 7, grow = min(rs0 + (key >> 6), 127);
        const u32x4 kv = *(const u32x4*)(P + (size_t)(bl * SEQ + grow * 64 + (key & 63)) * PS + C_NAK + head * 64 + ch * 8);
        *(u32x4*)(Kimg + key * 72 + ch * 8) = kv;
    }
#pragma unroll
    for (int i = 0; i < 9; ++i) {
        const int idx = tid + NTHR * i, keyp = idx >> 2, chh = keyp >= 576 ? 1 : 0, key = keyp - chh * 576, ch = chh * 4 + (idx & 3), grow = min(rs0 + (key >> 6), 127);
        const u32x4 vv = *(const u32x4*)(P + (size_t)(bl * SEQ + grow * 64 + (key & 63)) * PS + C_NAV + head * 64 + ch * 8);
        bf16_t* vd = VT + (ch * 8) * 584 + key;
        vd[0 * 584] = (bf16_t)(vv.x & 0xffffu); vd[1 * 584] = (bf16_t)(vv.x >> 16);
        vd[2 * 584] = (bf16_t)(vv.y & 0xffffu); vd[3 * 584] = (bf16_t)(vv.y >> 16);
        vd[4 * 584] = (bf16_t)(vv.z & 0xffffu); vd[5 * 584] = (bf16_t)(vv.z >> 16);
        vd[6 * 584] = (bf16_t)(vv.w & 0xffffu); vd[7 * 584] = (bf16_t)(vv.w >> 16);
    }
    __syncthreads();
    const int rr = w >> 2, g = w & 3, r = r0 + rr, rs = iclamp(r - 4, 0, 120), lo = rs - rs0;
    const int cb = iclamp(16 * g - 8, 0, 32), c = 16 * g + l15, cs = iclamp(c - 8, 0, 48);
    bf16_t* qrow = P + (size_t)(bl * SEQ + r * 64 + c) * PS + head * 64;
    bf16x8 qf[2];
#pragma unroll
    for (int ks = 0; ks < 2; ++ks) qf[ks] = *(const bf16x8*)(qrow + ks * 32 + q4 * 8);
    f32x4 sc[16];
#pragma unroll
    for (int t = 0; t < 16; ++t) {
        const int kb = (lo + (t >> 1)) * 64 + cb + 16 * (t & 1);
        f32x4 a = {0.f, 0.f, 0.f, 0.f};
#pragma unroll
        for (int ks = 0; ks < 2; ++ks) { const bf16x8 kf = *(const bf16x8*)(Kimg + (kb + l15) * 72 + ks * 32 + q4 * 8); a = MFMA(kf, qf[ks], a); }
        sc[t] = a;
    }
    const float* rpb = p.na_rpb + (size_t)(l * 8 + head) * 15 * 31;
    float mx = -1e30f;
#pragma unroll
    for (int t = 0; t < 16; ++t) {
        const int drow = rs + (t >> 1) - r + 7;
#pragma unroll
        for (int e = 0; e < 4; ++e) {
            const int col = cb + 16 * (t & 1) + 4 * q4 + e;
            const bool ok = (col >= cs) && (col < cs + 16);
            const int dcol = ok ? (col - c + 15) : 0;
            const float v = ok ? (sc[t][e] + rpb[drow * 31 + dcol]) : -1e30f;
            sc[t][e] = v; mx = fmaxf(mx, v);
        }
    }
    mx = fmaxf(mx, __shfl_xor(mx, 16)); mx = fmaxf(mx, __shfl_xor(mx, 32));
    float sum = 0.f;
#pragma unroll
    for (int t = 0; t < 16; ++t)
#pragma unroll
        for (int e = 0; e < 4; ++e) { const float pe = __expf(sc[t][e] - mx); sc[t][e] = pe; sum += pe; }
    sum += __shfl_xor(sum, 16); sum += __shfl_xor(sum, 32);
    f32x4 o[4];
#pragma unroll
    for (int dt = 0; dt < 4; ++dt) o[dt] = (f32x4){0.f, 0.f, 0.f, 0.f};
#pragma unroll
    for (int kk = 0; kk < 8; ++kk) {
        u32x4 pu; pu.x = pk2(sc[2 * kk][0], sc[2 * kk][1]); pu.y = pk2(sc[2 * kk][2], sc[2 * kk][3]); pu.z = pk2(sc[2 * kk + 1][0], sc[2 * kk + 1][1]); pu.w = pk2(sc[2 * kk + 1][2], sc[2 * kk + 1][3]);
        const bf16x8 pf = mkfrag(pu);
        const int kbA = (lo + kk) * 64 + cb + 4 * q4;
#pragma unroll
        for (int dt = 0; dt < 4; ++dt) {
            const bf16_t* vr = VT + (dt * 16 + l15) * 584 + kbA;
            const bf16x8 vf = mkfrag2(*(const u32x2*)vr, *(const u32x2*)(vr + 16));
            o[dt] = MFMA(vf, pf, o[dt]);
        }
    }
    const float inv = 1.0f / sum;
    const bf16_t* zrow = P + (size_t)(bl * SEQ + r * 64 + c) * PS + C_Z + head * 64;
#pragma unroll
    for (int dt = 0; dt < 4; ++dt) {
        const int dd = dt * 16 + 4 * q4;
        const f32x4 z = ld_bf4(zrow + dd);
        if (!dry) st_bf4(qrow + dd, o[dt] * inv * z);
    }
    __syncthreads();
}

__device__ __forceinline__ void memattn_load(const Params& p, int b, int h, unsigned char* lds) {
    bf16_t* Kimg = (bf16_t*)lds;
    bf16_t* VT = (bf16_t*)(lds + 69632);
    const bf16_t* Km = (const bf16_t*)(p.ws + OFF_KMAT); const bf16_t* Vm = (const bf16_t*)(p.ws + OFF_VT);
    int tid_ = threadIdx.x; asm volatile("" : "+v"(tid_)); const int tid = tid_;
#pragma unroll
    for (int i = 0; i < 8; ++i) {
        const int idx = tid + NTHR * i;
        { const int key = idx >> 4, ch = idx & 15; *(u32x4*)(Kimg + key * 136 + ch * 8) = *(const u32x4*)(Km + (size_t)(b * 256 + key) * 512 + h * 128 + ch * 8); }
        { const int dd = idx >> 5, ch = idx & 31; *(u32x4*)(VT + dd * 264 + ch * 8) = *(const u32x4*)(Vm + (size_t)(h * 128 + dd) * 2048 + b * 256 + ch * 8); }
    }
    __syncthreads();
}
__device__ __forceinline__ void memattn_item(bf16_t* P, int bl, int h, int qt, unsigned char* lds, int dry = 0) {
    const bf16_t* Kimg = (const bf16_t*)lds; const bf16_t* VT = (const bf16_t*)(lds + 69632);
    int tid_ = threadIdx.x; asm volatile("" : "+v"(tid_)); const int tid = tid_, lane = tid & 63, w = tid >> 6, l15 = lane & 15, q4 = lane >> 4;
    const int tok = bl * SEQ + qt * 128 + w * 16 + l15;
    bf16_t* qrow = P + (size_t)tok * PS + C_MQ + h * 128;
    bf16x8 qf[4];
#pragma unroll
    for (int ks = 0; ks < 4; ++ks) qf[ks] = *(const bf16x8*)(qrow + ks * 32 + q4 * 8);
    f32x4 sc[16];
    float mx = -1e30f;
#pragma unroll
    for (int t = 0; t < 16; ++t) {
        f32x4 a = {0.f, 0.f, 0.f, 0.f};
#pragma unroll
        for (int ks = 0; ks < 4; ++ks) { const bf16x8 kf = *(const bf16x8*)(Kimg + (t * 16 + l15) * 136 + ks * 32 + q4 * 8); a = MFMA(kf, qf[ks], a); }
        sc[t] = a;
        mx = fmaxf(mx, fmaxf(fmaxf(a[0], a[1]), fmaxf(a[2], a[3])));
    }
    mx = fmaxf(mx, __shfl_xor(mx, 16)); mx = fmaxf(mx, __shfl_xor(mx, 32));
    float sum = 0.f;
#pragma unroll
    for (int t = 0; t < 16; ++t)
#pragma unroll
        for (int e = 0; e < 4; ++e) { const float pe = __expf(sc[t][e] - mx); sc[t][e] = pe; sum += pe; }
    sum += __shfl_xor(sum, 16); sum += __shfl_xor(sum, 32);
    f32x4 o[8];
#pragma unroll
    for (int dt = 0; dt < 8; ++dt) o[dt] = (f32x4){0.f, 0.f, 0.f, 0.f};
#pragma unroll
    for (int kk = 0; kk < 8; ++kk) {
        u32x4 pu; pu.x = pk2(sc[2 * kk][0], sc[2 * kk][1]); pu.y = pk2(sc[2 * kk][2], sc[2 * kk][3]); pu.z = pk2(sc[2 * kk + 1][0], sc[2 * kk + 1][1]); pu.w = pk2(sc[2 * kk + 1][2], sc[2 * kk + 1][3]);
        const bf16x8 pf = mkfrag(pu);
#pragma unroll
        for (int dt = 0; dt < 8; ++dt) {
            const bf16_t* vr = VT + (dt * 16 + l15) * 264 + kk * 32 + 4 * q4;
            const bf16x8 vf = mkfrag2(*(const u32x2*)vr, *(const u32x2*)(vr + 16));
            o[dt] = MFMA(vf, pf, o[dt]);
        }
    }
    const float inv = 1.0f / sum;
    const bf16_t* zrow = P + (size_t)tok * PS + C_Z + 3 * 512 + h * 128;
#pragma unroll
    for (int dt = 0; dt < 8; ++dt) {
        const int dd = dt * 16 + 4 * q4;
        const f32x4 z = ld_bf4(zrow + dd);
        if (!dry) st_bf4(qrow + dd, o[dt] * inv * z);
    }
}

constexpr int G_LRT = 0, G_BF = 8192, G_BB = 24576, G_TOT = 40960, G_IMG = 45056;
__device__ __forceinline__ void gla_tables(const Params& p, int l, const float* LR, int t0, int h, unsigned char* lds) {
    float* LRT = (float*)(lds + G_LRT); float* BF = (float*)(lds + G_BF); float* BB = (float*)(lds + G_BB); float* TOT = (float*)(lds + G_TOT);
    int tid_ = threadIdx.x; asm volatile("" : "+v"(tid_)); const int tid = tid_;
    ((float4*)LRT)[tid] = ((const float4*)(LR + (size_t)t0 * 32))[tid];
    __syncthreads();
    const int dk = tid & 63, cgp = tid >> 6;
    float uf[16], ub[16];
#pragma unroll
    for (int r = 0; r < 16; ++r) { uf[r] = p.gla_up_f[(size_t)(l * 16 + r) * 256 + h * 64 + dk]; ub[r] = p.gla_up_b[(size_t)(l * 16 + r) * 256 + h * 64 + dk]; }
    const float bif = p.gla_bias_f[l * 256 + h * 64 + dk], bib = p.gla_bias_b[l * 256 + h * 64 + dk];
    float lf[8], lb[8];
#pragma unroll
    for (int i = 0; i < 8; ++i) {
        const int c = cgp * 8 + i; float sf = bif, sb = bib;
#pragma unroll
        for (int r = 0; r < 16; ++r) { sf += LRT[c * 32 + r] * uf[r]; sb += LRT[c * 32 + 16 + r] * ub[r]; }
        lf[i] = logsigf_(sf) * (1.0f / 16.0f); lb[i] = logsigf_(sb) * (1.0f / 16.0f);
    }
#pragma unroll
    for (int i = 1; i < 8; ++i) lf[i] += lf[i - 1];
#pragma unroll
    for (int i = 6; i >= 0; --i) lb[i] += lb[i + 1];
    TOT[cgp * 64 + dk] = lf[7]; TOT[512 + cgp * 64 + dk] = lb[0];
    __syncthreads();
    float of = 0.f, ob = 0.f;
#pragma unroll
    for (int g2 = 0; g2 < 8; ++g2) { if (g2 < cgp) of += TOT[g2 * 64 + dk]; if (g2 > cgp) ob += TOT[512 + g2 * 64 + dk]; }
#pragma unroll
    for (int i = 0; i < 8; ++i) { BF[(cgp * 8 + i) * 64 + dk] = lf[i] + of; BB[(cgp * 8 + i) * 64 + dk] = lb[i] + ob; }
    __syncthreads();
}
struct GlaPre { u32x4 vv[2]; bf16_t q[8], k[8]; };
__device__ __forceinline__ void gla_prefetch(GlaPre& g, const bf16_t* P, int t0, int h, int tid) {
#pragma unroll
    for (int i = 0; i < 2; ++i) { const int idx = tid + NTHR * i, chn = idx >> 6, c = idx & 63; g.vv[i] = *(const u32x4*)(P + (size_t)(t0 + c) * PS + C_GV + h * 128 + chn * 8); }
#pragma unroll
    for (int i = 0; i < 8; ++i) { const int idx = tid + NTHR * i, c = idx >> 6, dk = idx & 63; g.q[i] = P[(size_t)(t0 + c) * PS + C_GQ + h * 64 + dk]; g.k[i] = P[(size_t)(t0 + c) * PS + C_GK + h * 64 + dk]; }
}
__device__ __forceinline__ void gla_vt_store(const GlaPre& g, bf16_t* VT, int tid) {
#pragma unroll
    for (int i = 0; i < 2; ++i) {
        const int idx = tid + NTHR * i, chn = idx >> 6, c = idx & 63;
        const u32x4 vv = g.vv[i];
        bf16_t* vd = VT + (chn * 8) * 72 + c;
        vd[0 * 72] = (bf16_t)(vv.x & 0xffffu); vd[1 * 72] = (bf16_t)(vv.x >> 16);
        vd[2 * 72] = (bf16_t)(vv.y & 0xffffu); vd[3 * 72] = (bf16_t)(vv.y >> 16);
        vd[4 * 72] = (bf16_t)(vv.z & 0xffffu); vd[5 * 72] = (bf16_t)(vv.z >> 16);
        vd[6 * 72] = (bf16_t)(vv.w & 0xffffu); vd[7 * 72] = (bf16_t)(vv.w >> 16);
    }
}
__device__ __forceinline__ void gla_part1_item(const Params& p, int l, const bf16_t* P, const float* LR, int item, unsigned char* lds) {
    const int h = item & 3, n = (item >> 2) & 127, bl = item >> 9, t0 = bl * SEQ + n * 64;
    const float* BF = (const float*)(lds + G_BF); const float* BB = (const float*)(lds + G_BB);
    bf16_t* KDT0 = (bf16_t*)(lds + G_IMG); bf16_t* KDT1 = KDT0 + 64 * 72; bf16_t* VT = KDT1 + 64 * 72;
    float* GS = (float*)(p.ws + OFF_GS); float* GD = (float*)(p.ws + OFF_GDEC);
    int tid_ = threadIdx.x; asm volatile("" : "+v"(tid_)); const int tid = tid_, lane = tid & 63, w = tid >> 6, l15 = lane & 15, q4 = lane >> 4;
    GlaPre gp; gla_prefetch(gp, P, t0, h, tid);
    gla_tables(p, l, LR, t0, h, lds);
    {
        float4* tb = (float4*)((float*)(p.ws + OFF_TB) + (size_t)item * 8192); const float4* ts = (const float4*)(lds + G_BF);
#pragma unroll
        for (int i = 0; i < 4; ++i) tb[tid + NTHR * i] = ts[tid + NTHR * i];
    }
#pragma unroll
    for (int i = 0; i < 8; ++i) {
        const int idx = tid + NTHR * i, c = idx >> 6, dk = idx & 63;
        const float kv = bf2f(gp.k[i]);
        KDT0[dk * 72 + c] = f2bf_d(kv * __expf(BF[63 * 64 + dk] - BF[c * 64 + dk]));
        KDT1[dk * 72 + c] = f2bf_d(kv * __expf(BB[dk] - BB[c * 64 + dk]));
    }
    gla_vt_store(gp, VT, tid);
    if (tid < 64) GD[(size_t)item * 64 + tid] = __expf(BF[63 * 64 + tid]);
    else if (tid < 128) GD[(size_t)(NITEM + item) * 64 + tid - 64] = __expf(BB[tid - 64]);
    __syncthreads();
    const int dir = w >> 2, dkt = w & 3;
    const bf16_t* KD = dir ? KDT1 : KDT0;
    bf16x8 kf[2];
#pragma unroll
    for (int ks = 0; ks < 2; ++ks) kf[ks] = *(const bf16x8*)(KD + (16 * dkt + l15) * 72 + 32 * ks + 8 * q4);
    float* dst = GS + ((size_t)dir * NITEM + item) * 8192;
#pragma unroll
    for (int dvt = 0; dvt < 8; ++dvt) {
        f32x4 a = {0.f, 0.f, 0.f, 0.f};
#pragma unroll
        for (int ks = 0; ks < 2; ++ks) { const bf16x8 vf = *(const bf16x8*)(VT + (16 * dvt + l15) * 72 + 32 * ks + 8 * q4); a = MFMA(kf[ks], vf, a); }
        *(f32x4*)(dst + (16 * dvt + l15) * 64 + 16 * dkt + 4 * q4) = a;
    }
    __syncthreads();
}
__device__ __forceinline__ void gla_scan(const Params& p, int dry = 0) {
    float* GS = (float*)(p.ws + OFF_GS); const float* GD = (const float*)(p.ws + OFF_GDEC);
    const int total = 2 * BG * 4 * 8192;
    int tid_ = threadIdx.x; asm volatile("" : "+v"(tid_));
    for (int id = blockIdx.x * NTHR + tid_; id < total; id += gridDim.x * NTHR) {
        const int e = id & 8191, comb = id >> 13, h = comb & 3, bl = (comb >> 2) % BG, dir = comb / (4 * BG), dk = e & 63;
        float S = 0.f;
        const size_t ibase = (size_t)dir * NITEM + (size_t)(bl * 128) * 4 + h;
        for (int s0 = 0; s0 < 128; s0 += 16) {
            float u[16], dc[16];
#pragma unroll
            for (int i = 0; i < 16; ++i) {
                const int n = dir ? 127 - (s0 + i) : s0 + i;
                const size_t item = ibase + (size_t)n * 4;
                u[i] = GS[item * 8192 + e]; dc[i] = GD[item * 64 + dk];
            }
#pragma unroll
            for (int i = 0; i < 16; ++i) {
                const int n = dir ? 127 - (s0 + i) : s0 + i;
                const size_t item = ibase + (size_t)n * 4;
                if (!dry) GS[item * 8192 + e] = S;
                S = dc[i] * S + u[i];
            }
        }
    }
}
__device__ __forceinline__ void gla_part2_item(const Params& p, int l, bf16_t* P, const float* LR, int item, unsigned char* lds, int dry = 0) {
    const int h = item & 3, n = (item >> 2) & 127, bl = item >> 9, t0 = bl * SEQ + n * 64;
    const float* BF = (const float*)(lds + G_BF); const float* BB = (const float*)(lds + G_BB);
    bf16_t* QF = (bf16_t*)(lds + G_IMG);
    bf16_t* KF = QF + 2 * 64 * 72;
    bf16_t* QD = KF + 2 * 64 * 72;
    bf16_t* VT = QD + 2 * 64 * 72;
    bf16_t* ST = VT + 128 * 72;
    float* OX = (float*)lds;
    const float* GS = (const float*)(p.ws + OFF_GS);
    int tid_ = threadIdx.x; asm volatile("" : "+v"(tid_)); const int tid = tid_, lane = tid & 63, w = tid >> 6, l15 = lane & 15, q4 = lane >> 4;
    GlaPre gp; gla_prefetch(gp, P, t0, h, tid);
    float4 sp[2][4];
#pragma unroll
    for (int dir = 0; dir < 2; ++dir)
#pragma unroll
        for (int i = 0; i < 4; ++i) { const int idx = tid + NTHR * i; sp[dir][i] = *(const float4*)(GS + ((size_t)dir * NITEM + item) * 8192 + (idx >> 4) * 64 + (idx & 15) * 4); }
    {
        const float4* tb = (const float4*)((const float*)(p.ws + OFF_TB) + (size_t)item * 8192); float4* ts = (float4*)(lds + G_BF);
        float4 tv[4];
#pragma unroll
        for (int i = 0; i < 4; ++i) tv[i] = tb[tid + NTHR * i];
#pragma unroll
        for (int i = 0; i < 4; ++i) ts[tid + NTHR * i] = tv[i];
        __syncthreads();
    }
#pragma unroll
    for (int i = 0; i < 8; ++i) {
        const int idx = tid + NTHR * i, c = idx >> 6, dk = idx & 63;
        const float qv = bf2f(gp.q[i]);
        const float kv = bf2f(gp.k[i]);
        const float bf = BF[c * 64 + dk], mf = BF[31 * 64 + dk], bb = BB[c * 64 + dk], mb = BB[32 * 64 + dk];
        QF[c * 72 + dk] = f2bf_d(qv * __expf(bf - mf)); KF[c * 72 + dk] = f2bf_d(kv * __expf(mf - bf)); QD[c * 72 + dk] = f2bf_d(qv * __expf(bf));
        QF[4608 + c * 72 + dk] = f2bf_d(qv * __expf(bb - mb)); KF[4608 + c * 72 + dk] = f2bf_d(kv * __expf(mb - bb)); QD[4608 + c * 72 + dk] = f2bf_d(qv * __expf(bb));
    }
    gla_vt_store(gp, VT, tid);
#pragma unroll
    for (int dir = 0; dir < 2; ++dir) {
#pragma unroll
        for (int i = 0; i < 4; ++i) {
            const int idx = tid + NTHR * i, dv = idx >> 4, dk4 = (idx & 15) * 4;
            const float4 s = sp[dir][i];
            u32x2 o; o.x = pk2(s.x, s.y); o.y = pk2(s.z, s.w);
            *(u32x2*)(ST + dir * 9216 + dv * 72 + dk4) = o;
        }
    }
    __syncthreads();
    const int dir = w >> 2, ct = w & 3;
    const bf16_t* qfp = QF + dir * 4608; const bf16_t* kfp = KF + dir * 4608; const bf16_t* qdp = QD + dir * 4608; const bf16_t* stp = ST + dir * 9216;
    bf16x8 qf[2], qd[2];
#pragma unroll
    for (int ks = 0; ks < 2; ++ks) { qf[ks] = *(const bf16x8*)(qfp + (16 * ct + l15) * 72 + 32 * ks + 8 * q4); qd[ks] = *(const bf16x8*)(qdp + (16 * ct + l15) * 72 + 32 * ks + 8 * q4); }
    f32x4 sc[4];
    const int cq = 16 * ct + l15;
#pragma unroll
    for (int st = 0; st < 4; ++st) {
        f32x4 a = {0.f, 0.f, 0.f, 0.f};
#pragma unroll
        for (int ks = 0; ks < 2; ++ks) { const bf16x8 kf = *(const bf16x8*)(kfp + (16 * st + l15) * 72 + 32 * ks + 8 * q4); a = MFMA(kf, qf[ks], a); }
#pragma unroll
        for (int e = 0; e < 4; ++e) { const int s = 16 * st + 4 * q4 + e; const bool ok = dir ? (s > cq) : (s <= cq); a[e] = ok ? a[e] : 0.f; }
        sc[st] = a;
    }
    f32x4 o[8];
#pragma unroll
    for (int dt = 0; dt < 8; ++dt) o[dt] = (f32x4){0.f, 0.f, 0.f, 0.f};
#pragma unroll
    for (int kk = 0; kk < 2; ++kk) {
        u32x4 pu; pu.x = pk2(sc[2 * kk][0], sc[2 * kk][1]); pu.y = pk2(sc[2 * kk][2], sc[2 * kk][3]); pu.z = pk2(sc[2 * kk + 1][0], sc[2 * kk + 1][1]); pu.w = pk2(sc[2 * kk + 1][2], sc[2 * kk + 1][3]);
        const bf16x8 pf = mkfrag(pu);
#pragma unroll
        for (int dt = 0; dt < 8; ++dt) {
            const bf16_t* vr = VT + (dt * 16 + l15) * 72 + kk * 32 + 4 * q4;
            const bf16x8 vf = mkfrag2(*(const u32x2*)vr, *(const u32x2*)(vr + 16));
            o[dt] = MFMA(vf, pf, o[dt]);
        }
    }
#pragma unroll
    for (int ks = 0; ks < 2; ++ks)
#pragma unroll
        for (int dt = 0; dt < 8; ++dt) { const bf16x8 sf = *(const bf16x8*)(stp + (dt * 16 + l15) * 72 + 32 * ks + 8 * q4); o[dt] = MFMA(sf, qd[ks], o[dt]); }
    if (dir == 1) {
#pragma unroll
        for (int dt = 0; dt < 8; ++dt) *(f32x4*)(OX + cq * 132 + 16 * dt + 4 * q4) = o[dt];
    }
    __syncthreads();
    if (dir == 0) {
        float ss = 0.f;
#pragma unroll
        for (int dt = 0; dt < 8; ++dt) { o[dt] += *(const f32x4*)(OX + cq * 132 + 16 * dt + 4 * q4); ss += (o[dt][0] * o[dt][0] + o[dt][1] * o[dt][1]) + (o[dt][2] * o[dt][2] + o[dt][3] * o[dt][3]); }
        ss += __shfl_xor(ss, 16); ss += __shfl_xor(ss, 32);
        const float rms = 1.0f / sqrtf(ss * (1.0f / 128.0f) + 1e-6f);
        const float* ng = p.gla_norm_g + l * 512 + h * 128;
        const bf16_t* zrow = P + (size_t)(t0 + cq) * PS + C_Z + 2 * 512 + h * 128;
        bf16_t* orow = P + (size_t)(t0 + cq) * PS + C_GV + h * 128;
#pragma unroll
        for (int dt = 0; dt < 8; ++dt) {
            const int dd = 16 * dt + 4 * q4;
            const f32x4 z = ld_bf4(zrow + dd); const f32x4 g4 = *(const f32x4*)(ng + dd);
            if (!dry) st_bf4(orow + dd, o[dt] * rms * g4 * z);
        }
    }
    __syncthreads();
}

namespace pg8 {
#define PG8_LAS __attribute__((address_space(3)))
typedef unsigned short bf16_t;
typedef short bf16x8 __attribute__((ext_vector_type(8)));
typedef float f32x4 __attribute__((ext_vector_type(4)));
typedef unsigned u32x4 __attribute__((ext_vector_type(4)));
constexpr int BM = 256, BK = 64, HALF = 128, HTB = HALF * BK * 2  , STAGE_BYTES = 8 * HTB, NXCD = 8, WGM = 8;

__host__ __device__ __forceinline__ int lds_byte(int r, int c) { const int st = (r >> 4) * 2 + (c >> 5), rr = r & 15, cc = c & 31, ob = rr * 64 + cc * 2; return st * 1024 + (ob ^ (((ob >> 9) & 1) << 5)); }
__host__ __device__ __forceinline__ void stage_rc(int b, int& R, int& C) { const int st = b / 1024, sb = b % 1024, swz = sb ^ (((sb >> 9) & 1) << 5); R = (st >> 1) * 16 + swz / 64; C = (st & 1) * 32 + (swz % 64) / 2; }
__host__ __device__ __forceinline__ int perm32(int rho) { const int n = rho >> 4, i = rho & 15; return 8 * (i >> 2) + 4 * n + (i & 3); }

struct Unit { int pm, pn; };
struct Gemm { const bf16_t* A; const bf16_t* Bt; int M, N, K; };

struct StaticOrder {
    int nM, nN, nwg, G, c;
    __host__ __device__ __forceinline__ void init(int M, int N, int G_, int c_) { nM = M / BM; nN = N / BM; nwg = nM * nN; G = G_; c = c_; }
    __host__ __device__ bool next(int i, Unit& u) const {
        const long L = (long)i * G + c; if (L >= nwg) return false;
        int wgid = (int)L; { const int q = nwg / NXCD, r = nwg % NXCD, xcd = wgid % NXCD, off = wgid / NXCD; wgid = (xcd < r ? xcd * (q + 1) : r * (q + 1) + (xcd - r) * q) + off; }
        const int nig = WGM * nN, gid = wgid / nig, fm = gid * WGM, gsz = (nM - fm) < WGM ? (nM - fm) : WGM;
        u.pm = fm + ((wgid % nig) % gsz); u.pn = (wgid % nig) / gsz; return true;
    }
    __device__ __forceinline__ void a_ready(const Unit&) const {}
    __device__ __forceinline__ void done(const Unit&) const {}
};
__device__ __forceinline__ unsigned cvt_pk_bf16(float lo, float hi) { unsigned r; asm volatile("v_cvt_pk_bf16_f32 %0, %1, %2" : "=v"(r) : "v"(lo), "v"(hi)); return r; }
template <class Epi, class Sched, bool STAMP = false>
__device__ __forceinline__ void gemm_phase(PG8_LAS unsigned char* lds, const Gemm g, const Sched& S, const Epi& E, unsigned long long* stamps) {
    int tid_l = threadIdx.x; asm volatile("" : "+v"(tid_l)); const int tid = tid_l, wid = __builtin_amdgcn_readfirstlane(tid >> 6), lane = tid & 63, wr = wid >> 2, wc = wid & 3, fr = lane & 15, fq = lane >> 4;
    const int K = g.K, nt = K / BK;
    int ts_lo = 0, ts_hi = 0, nts = 0; const unsigned long long rt_entry = STAMP ? (unsigned long long)wall_clock64() : 0ull;
#define PG8_STAMP() do { if (STAMP && wid == 0 && nts < 64) { const unsigned long long _c = (unsigned long long)clock64(); \
        ts_lo = (lane == nts) ? (int)(unsigned)_c : ts_lo; ts_hi = (lane == nts) ? (int)(unsigned)(_c >> 32) : ts_hi; ++nts; } } while (0)
    PG8_STAMP();
    unsigned voffA[2], voffB[2];
#pragma unroll
    for (int i = 0; i < 2; ++i) { int R, C; stage_rc(tid * 16 + i * 8192, R, C); const int Rb = Epi::PERM ? ((R & ~31) + perm32(R & 31)) : R;
        voffA[i] = (unsigned)(R * K + C) * 2u; voffB[i] = (unsigned)(Rb * K + C) * 2u; }
    const size_t kstep = (size_t)(BK * 2);
    const size_t hstep = (size_t)HALF * K * 2;
    const size_t tstep = 2 * hstep;
    const unsigned ldsw = (unsigned)wid * 1024u;
    const int aoff = lds_byte(wr * 64 + fr, fq * 8), boff = lds_byte(wc * 32 + fr, fq * 8);
#define PG8_SA(b, h) (((b) * 2 + (h)) * HTB)
#define PG8_SB(b, h) ((4 + (b) * 2 + (h)) * HTB)
#define PG8_STAGE(bufoff, gbase, voff) do { _Pragma("unroll") for (int _i = 0; _i < 2; ++_i) \
        __builtin_amdgcn_global_load_lds((const unsigned*)((const char*)(gbase) + (voff)[_i]), (PG8_LAS unsigned*)(lds + (bufoff) + ldsw + _i * 8192), 16, 0, 0); } while (0)
#define PG8_LDA(dst, b, h) do { _Pragma("unroll") for (int m = 0; m < 4; ++m) _Pragma("unroll") for (int k = 0; k < 2; ++k) dst[m][k] = *(const PG8_LAS bf16x8*)(lds + PG8_SA(b, h) + aoff + m * 2048 + k * 1024); } while (0)
#define PG8_LDB(dst, b, h) do { _Pragma("unroll") for (int n = 0; n < 2; ++n) _Pragma("unroll") for (int k = 0; k < 2; ++k) dst[n][k] = *(const PG8_LAS bf16x8*)(lds + PG8_SB(b, h) + boff + n * 2048 + k * 1024); } while (0)
#define PG8_MMA(ai, bj, At, Bt) do { __builtin_amdgcn_s_setprio(1); _Pragma("unroll") for (int m = 0; m < 4; ++m) _Pragma("unroll") for (int n = 0; n < 2; ++n) _Pragma("unroll") for (int k = 0; k < 2; ++k) \
        acc[ai][bj][m][n] = __builtin_amdgcn_mfma_f32_16x16x32_bf16(Bt[n][k], At[m][k], acc[ai][bj][m][n], 0, 0, 0); __builtin_amdgcn_s_setprio(0); } while (0)
#define PG8_WAIT_V(n) asm volatile("s_waitcnt vmcnt(" #n ")" ::: "memory")
#define PG8_WAIT_L(n) asm volatile("s_waitcnt lgkmcnt(" #n ")" ::: "memory")
#define PG8_BAR __builtin_amdgcn_s_barrier()
#define PG8_SCHED __builtin_amdgcn_sched_barrier(0)
    Unit cur, nxt; int ui = 0;
    if (!S.next(0, cur)) return;
    f32x4 acc[2][2][4][2];
#pragma unroll
    for (int a = 0; a < 2; ++a)
#pragma unroll
        for (int b = 0; b < 2; ++b)
#pragma unroll
            for (int m = 0; m < 4; ++m)
#pragma unroll
                for (int n = 0; n < 2; ++n) acc[a][b][m][n] = (f32x4){0.f, 0.f, 0.f, 0.f};
    bf16x8 At[4][2], B0[2][2], B1[2][2];
    const char* cA = (const char*)g.A + (size_t)cur.pm * tstep; const char* cB = (const char*)g.Bt + (size_t)cur.pn * tstep;
    S.a_ready(cur);
    PG8_STAGE(PG8_SB(0, 0), cB, voffB); PG8_STAGE(PG8_SA(0, 0), cA, voffA); PG8_STAGE(PG8_SB(0, 1), cB + hstep, voffB); PG8_STAGE(PG8_SA(0, 1), cA + hstep, voffA);
    if (wr == 1) PG8_BAR;
    PG8_WAIT_V(4); PG8_BAR;
    PG8_STAGE(PG8_SB(1, 0), cB + kstep, voffB); PG8_STAGE(PG8_SA(1, 0), cA + kstep, voffA); PG8_STAGE(PG8_SB(1, 1), cB + hstep + kstep, voffB);
    PG8_WAIT_V(6); PG8_BAR;
    PG8_STAMP();
    for (;;) {
        const bool has_next = S.next(ui + 1, nxt);
        const char* nA = has_next ? (const char*)g.A + (size_t)nxt.pm * tstep : cA; const char* nB = has_next ? (const char*)g.Bt + (size_t)nxt.pn * tstep : cB;
        for (int t = 0; t < nt; t += 2) {
            const bool last = (t == nt - 2);
            const char* a1 = cA + (size_t)(t + 1) * kstep;
            const char* a2 = last ? nA : cA + (size_t)(t + 2) * kstep; const char* b2 = last ? nB : cB + (size_t)(t + 2) * kstep;
            const char* a3 = a2 + kstep; const char* b3 = b2 + kstep;
            if (last && has_next) S.a_ready(nxt);
            PG8_LDB(B0, 0, 0); PG8_SCHED; PG8_LDA(At, 0, 0); PG8_STAGE(PG8_SA(1, 1), a1 + hstep, voffA);
            PG8_WAIT_L(8); PG8_BAR; PG8_WAIT_L(0); PG8_MMA(0, 0, At, B0); PG8_BAR; PG8_SCHED;
            PG8_LDB(B1, 0, 1); PG8_STAGE(PG8_SB(0, 0), b2, voffB);
            PG8_BAR; PG8_WAIT_L(0); PG8_MMA(0, 1, At, B1); PG8_BAR;
            PG8_LDA(At, 0, 1); PG8_STAGE(PG8_SA(0, 0), a2, voffA);
            PG8_BAR; PG8_WAIT_L(0); PG8_MMA(1, 0, At, B0); PG8_BAR; PG8_SCHED;
            PG8_STAGE(PG8_SB(0, 1), b2 + hstep, voffB);
            PG8_WAIT_V(6); PG8_BAR; PG8_MMA(1, 1, At, B1); PG8_BAR;
            PG8_LDB(B0, 1, 0); PG8_SCHED; PG8_LDA(At, 1, 0); PG8_STAGE(PG8_SA(0, 1), a2 + hstep, voffA);
            PG8_WAIT_L(8); PG8_BAR; PG8_WAIT_L(0); PG8_MMA(0, 0, At, B0); PG8_BAR; PG8_SCHED;
            PG8_LDB(B1, 1, 1); PG8_STAGE(PG8_SB(1, 0), b3, voffB);
            PG8_BAR; PG8_WAIT_L(0); PG8_MMA(0, 1, At, B1); PG8_BAR;
            PG8_LDA(At, 1, 1); PG8_STAGE(PG8_SA(1, 0), a3, voffA);
            PG8_BAR; PG8_WAIT_L(0); PG8_MMA(1, 0, At, B0); PG8_BAR; PG8_SCHED;
            PG8_STAGE(PG8_SB(1, 1), b3 + hstep, voffB);
            PG8_WAIT_V(6); PG8_BAR; PG8_MMA(1, 1, At, B1); PG8_BAR;
        }
        PG8_STAMP();
        if constexpr (!Epi::AFTER_DRAIN) { E(acc, cur, wr, wc, fr, fq); S.done(cur); }
        PG8_STAMP();
        if (!has_next) break;
#pragma unroll
        for (int a = 0; a < 2; ++a)
#pragma unroll
            for (int b = 0; b < 2; ++b)
#pragma unroll
                for (int m = 0; m < 4; ++m)
#pragma unroll
                    for (int n = 0; n < 2; ++n) acc[a][b][m][n] = (f32x4){0.f, 0.f, 0.f, 0.f};
        cur = nxt; cA = nA; cB = nB; ++ui;
    }
    PG8_WAIT_V(0);
    if (wr == 0) PG8_BAR;
    PG8_BAR;
    if constexpr (Epi::AFTER_DRAIN) { E.fused(acc, cur, wr, wc, fr, fq, lds, wid, lane); S.done(cur); }
    PG8_STAMP();
    if (STAMP && wid == 0) { stamps[lane] = lane < nts ? (((unsigned long long)(unsigned)ts_hi << 32) | (unsigned)ts_lo) : 0ull;
        if (lane == 62) stamps[62] = rt_entry; if (lane == 63) stamps[63] = (unsigned long long)wall_clock64(); }
#undef PG8_STAMP
#undef PG8_SA
#undef PG8_SB
#undef PG8_STAGE
#undef PG8_LDA
#undef PG8_LDB
#undef PG8_MMA
#undef PG8_WAIT_V
#undef PG8_WAIT_L
#undef PG8_BAR
#undef PG8_SCHED
}
}

struct EpiInProj {
    static constexpr bool PERM = true, AFTER_DRAIN = false;
    bf16_t* P; const float* bias; float* LR;
    __device__ __forceinline__ void operator()(const f32x4 (&acc)[2][2][4][2], const pg8::Unit& u, int wr, int wc, int fr, int fq) const {
        const int row0 = u.pm * 256 + wr * 64 + fr, colt = u.pn * 256, col0 = colt + wc * 32 + 8 * fq;
        if (colt == C_LR) {
            if (wc == 0) {
                const int cl = 8 * fq;
                const f32x4 b0 = *(const f32x4*)(bias + 4096 + cl), b1 = *(const f32x4*)(bias + 4096 + cl + 4);
#pragma unroll
                for (int ai = 0; ai < 2; ++ai)
#pragma unroll
                    for (int m = 0; m < 4; ++m) {
                        float* d = LR + (size_t)(row0 + ai * 128 + m * 16) * 32 + cl;
                        *(f32x4*)d = acc[ai][0][m][0] + b0; *(f32x4*)(d + 4) = acc[ai][0][m][1] + b1;
                    }
            }
            return;
        }
        const int mode = (colt < 512 || colt == C_GQ) ? 1 : (colt >= C_MQ && colt < C_Z) ? 2 : (colt >= C_Z && colt < C_SG) ? 3 : (colt >= C_SG) ? 4 : 0;
#pragma unroll
        for (int bj = 0; bj < 2; ++bj) {
            const int col = col0 + bj * 128;
            const f32x4 b0 = *(const f32x4*)(bias + orig_col(col)), b1 = *(const f32x4*)(bias + orig_col(col) + 4);
#pragma unroll
            for (int ai = 0; ai < 2; ++ai)
#pragma unroll
                for (int m = 0; m < 4; ++m) {
                    f32x4 v0 = acc[ai][bj][m][0] + b0, v1 = acc[ai][bj][m][1] + b1;
                    if (mode == 1) { v0 *= 0.125f; v1 *= 0.125f; }
                    else if (mode == 2) { v0 *= 0.08838834764831845f; v1 *= 0.08838834764831845f; }
                    else if (mode == 3) {
#pragma unroll
                        for (int e = 0; e < 4; ++e) { v0[e] = siluf_(v0[e]); v1[e] = siluf_(v1[e]); }
                    } else if (mode == 4) {
#pragma unroll
                        for (int e = 0; e < 4; ++e) { v0[e] = sigmoidf_(v0[e]); v1[e] = sigmoidf_(v1[e]); }
                    }
                    u32x4 o; o.x = pk2(v0[0], v0[1]); o.y = pk2(v0[2], v0[3]); o.z = pk2(v1[0], v1[1]); o.w = pk2(v1[2], v1[3]);
                    *(u32x4*)(P + (size_t)(row0 + ai * 128 + m * 16) * PS + col) = o;
                }
        }
    }
};
struct EpiOut {
    static constexpr bool PERM = false, AFTER_DRAIN = false;
    float* pre; const float* bo;
    __device__ __forceinline__ void operator()(const f32x4 (&acc)[2][2][4][2], const pg8::Unit& u, int wr, int wc, int fr, int fq) const {
        const int row0 = u.pm * 256 + wr * 64 + fr, col0 = u.pn * 256 + wc * 32 + 4 * fq;
#pragma unroll
        for (int bj = 0; bj < 2; ++bj)
#pragma unroll
            for (int n = 0; n < 2; ++n) {
                const int col = col0 + bj * 128 + n * 16;
                const f32x4 b4 = *(const f32x4*)(bo + col);
#pragma unroll
                for (int ai = 0; ai < 2; ++ai)
#pragma unroll
                    for (int m = 0; m < 4; ++m) *(f32x4*)(pre + (size_t)(row0 + ai * 128 + m * 16) * 1024 + col) = acc[ai][bj][m][n] + b4;
            }
    }
};

__device__ __forceinline__ void ln_rows_res(const Params& p, int l, size_t tok0) {
    int tid_ = threadIdx.x; asm volatile("" : "+v"(tid_));
    const int lane = tid_ & 63;
    const int gw = blockIdx.x * (NTHR / 64) + (tid_ >> 6), nw = gridDim.x * (NTHR / 64);
    const float* pre = (const float*)(p.ws + OFF_PRE); const float2* stats = (const float2*)(p.ws + OFF_STATS); bf16_t* hb = (bf16_t*)(p.ws + OFF_HB);
    const float* g = p.ln_g + l * 1024; const float* b = p.ln_b + l * 1024;
    for (int r = gw; r < TG; r += nw) {
        const size_t T = tok0 + r;
        const float4* pr = (const float4*)(pre + (size_t)r * 1024);
        float4 v[4]; float s = 0.f;
        if (l == 0) {
            const float4* xr = (const float4*)(p.x + T * 1024); const float2 st = stats[T];
#pragma unroll
            for (int i = 0; i < 4; ++i) {
                const float4 a = pr[lane + 64 * i], x4 = xr[lane + 64 * i], g4 = ((const float4*)p.ln_in_g)[lane + 64 * i], b4 = ((const float4*)p.ln_in_b)[lane + 64 * i];
                v[i].x = a.x + DN_ALPHA * ((x4.x - st.x) * st.y * g4.x + b4.x); v[i].y = a.y + DN_ALPHA * ((x4.y - st.x) * st.y * g4.y + b4.y);
                v[i].z = a.z + DN_ALPHA * ((x4.z - st.x) * st.y * g4.z + b4.z); v[i].w = a.w + DN_ALPHA * ((x4.w - st.x) * st.y * g4.w + b4.w);
            }
        } else {
            const float4* hr = (const float4*)(p.out + T * 1024);
#pragma unroll
            for (int i = 0; i < 4; ++i) {
                const float4 a = pr[lane + 64 * i], h4 = hr[lane + 64 * i];
                v[i].x = a.x + DN_ALPHA * h4.x; v[i].y = a.y + DN_ALPHA * h4.y; v[i].z = a.z + DN_ALPHA * h4.z; v[i].w = a.w + DN_ALPHA * h4.w;
            }
        }
#pragma unroll
        for (int i = 0; i < 4; ++i) s += (v[i].x + v[i].y) + (v[i].z + v[i].w);
        s = wave_sum(s);
        const float mean = s * (1.0f / 1024.0f);
        float q = 0.f;
#pragma unroll
        for (int i = 0; i < 4; ++i) { const float a = v[i].x - mean, bb = v[i].y - mean, c = v[i].z - mean, d = v[i].w - mean; q += (a * a + bb * bb) + (c * c + d * d); }
        q = wave_sum(q);
        const float rstd = 1.0f / sqrtf(q * (1.0f / 1024.0f) + 1e-5f);
#pragma unroll
        for (int i = 0; i < 4; ++i) {
            const float4 g4 = ((const float4*)g)[lane + 64 * i], b4 = ((const float4*)b)[lane + 64 * i];
            float4 y; y.x = (v[i].x - mean) * rstd * g4.x + b4.x; y.y = (v[i].y - mean) * rstd * g4.y + b4.y; y.z = (v[i].z - mean) * rstd * g4.z + b4.z; y.w = (v[i].w - mean) * rstd * g4.w + b4.w;
            ((float4*)(p.out + T * 1024))[lane + 64 * i] = y;
            u32x2 o; o.x = pk2(y.x, y.y); o.y = pk2(y.z, y.w); *(u32x2*)(hb + T * 1024 + (lane + 64 * i) * 4) = o;
        }
    }
}

#define XB_TMO      128
#define XB_XCNT(j)  (256  + 64 * (j))
#define XB_XSUB(j)  (1280 + 64 * (j))
#define XB_XGEN(j)  (2304 + 64 * (j))
#define XB_TOP      3328
#define XB_TOPGEN   3392
#define XCD_BAR_WORDS 3456
#define XB_SPIN_CAP (1u << 18)
#define LAS __attribute__((address_space(3)))

__device__ __forceinline__ unsigned xb_ld(unsigned* p)              { return __hip_atomic_load(p, __ATOMIC_RELAXED, __HIP_MEMORY_SCOPE_AGENT); }
__device__ __forceinline__ unsigned xb_add(unsigned* p, unsigned v) { return __hip_atomic_fetch_add(p, v, __ATOMIC_RELAXED, __HIP_MEMORY_SCOPE_AGENT); }
__device__ __forceinline__ unsigned xb_xcc_id() { return (unsigned)__builtin_amdgcn_s_getreg((3 << 11) | 20) & 0xFu; }
#define XB_SPIN(cond, bar) do { unsigned _sp = 0; while (cond) { __builtin_amdgcn_s_sleep(1); \
    if ((++_sp & 255u) == 0u) { if (xb_ld(&(bar)[XB_TMO])) break; if (_sp > XB_SPIN_CAP) { atomicAdd(&(bar)[XB_TMO], 1u); break; } } } } while (0)

struct XcdBarrier {
    unsigned* bar; unsigned x;
    volatile LAS unsigned* st;
};

__device__ __forceinline__ XcdBarrier xcd_barrier_post(unsigned* bar, volatile LAS unsigned* st) {
    XcdBarrier b; b.bar = bar; b.x = xb_xcc_id(); b.st = st;
    if (threadIdx.x == 0) (void)xb_add(&bar[XB_XCNT(b.x)], 1u);
    return b;
}
__device__ __forceinline__ void xcd_barrier_complete(unsigned* bar, unsigned x, unsigned& nloc, unsigned& nx) {
    const unsigned G = gridDim.x * gridDim.y * gridDim.z;
    unsigned sum, cnt, mine, sp = 0u;
    for (;;) {
        sum = 0u; cnt = 0u; mine = 0u;
#pragma unroll
        for (unsigned j = 0; j < 16; ++j) { const unsigned c = xb_ld(&bar[XB_XCNT(j)]); sum += c; cnt += (c > 0u) ? 1u : 0u; mine = (j == x) ? c : mine; }
        if (sum == G) break;
        __builtin_amdgcn_s_sleep(1);
        if ((++sp & 255u) == 0u) { if (xb_ld(&bar[XB_TMO])) break; if (sp > XB_SPIN_CAP) { atomicAdd(&bar[XB_TMO], 1u); break; } }
    }
    nloc = mine > 0u ? mine : 1u; nx = cnt > 0u ? cnt : 1u;
}

__device__ __forceinline__ void xcd_barrier(unsigned* b_bar, unsigned b_x, volatile LAS unsigned* b_st) {
    asm volatile("s_waitcnt vmcnt(0)" ::: "memory");
    __syncthreads();
    if (threadIdx.x == 0) {
        unsigned* bar = b_bar;
        __builtin_amdgcn_s_waitcnt(0);
        unsigned nloc = b_st[0], nx = b_st[1];
        if (nloc == 0u) { xcd_barrier_complete(bar, b_x, nloc, nx); b_st[0] = nloc; b_st[1] = nx; }
        const unsigned old = xb_add(&bar[XB_XSUB(b_x)], 1u);
        const unsigned gen = old / nloc;
        if (old + 1u == (gen + 1u) * nloc) {
            __builtin_amdgcn_fence(__ATOMIC_RELEASE, "agent");
            asm volatile("s_waitcnt vmcnt(0)" ::: "memory");
            const unsigned og = xb_add(&bar[XB_TOP], 1u);
            const unsigned tg = og / nx;
            if (og + 1u == (tg + 1u) * nx) xb_add(&bar[XB_TOPGEN], 1u);
            else XB_SPIN(xb_ld(&bar[XB_TOPGEN]) == tg, bar);
            __builtin_amdgcn_fence(__ATOMIC_ACQUIRE, "agent");
            xb_add(&bar[XB_XGEN(b_x)], 1u);
            asm volatile("s_waitcnt vmcnt(0)" ::: "memory");
        } else {
            XB_SPIN(xb_ld(&bar[XB_XGEN(b_x)]) == gen, bar);
            __builtin_amdgcn_fence(__ATOMIC_ACQUIRE, "agent");
            asm volatile("s_waitcnt vmcnt(0)" ::: "memory");
        }
    }
    __syncthreads();
}

__device__ __forceinline__ void gbar(unsigned* ctr, unsigned& gen, int G) {
    __syncthreads();
    gen += (unsigned)G;
    if (threadIdx.x == 0) {
        __threadfence();
        __hip_atomic_fetch_add(ctr, 1u, __ATOMIC_RELAXED, __HIP_MEMORY_SCOPE_AGENT);
        while (__hip_atomic_load(ctr, __ATOMIC_RELAXED, __HIP_MEMORY_SCOPE_AGENT) < gen) __builtin_amdgcn_s_sleep(1);
        __threadfence();
    }
    __syncthreads();
}
typedef const Params __attribute__((address_space(4))) KParams;
#define KP4 __attribute__((address_space(4)))
__device__ __forceinline__ Params fresh_params() {
#if defined(__HIP_DEVICE_COMPILE__)
    KParams* kp = (KParams*)__builtin_amdgcn_kernarg_segment_ptr();
    asm volatile("" : "+s"(kp));
    Params r;
    const float* KP4 const* src = (const float* KP4 const*)kp;
    const float** dst = (const float**)&r;
#pragma unroll
    for (int i = 0; i < 28; ++i) dst[i] = src[i];
    return r;
#else
    return Params{};
#endif
}
__global__ void __launch_bounds__(NTHR) mega(Params p_unused) {
    extern __shared__ __attribute__((aligned(16))) unsigned char lds[];
    cg::grid_group grid = cg::this_grid();
    const int G = gridDim.x, bid = blockIdx.x;
    volatile LAS unsigned* xst = (volatile LAS unsigned*)((LAS unsigned char*)lds + (LDS_BYTES - 16));
    if (threadIdx.x == 0) { xst[0] = 0u; xst[1] = 0u; }
    __syncthreads();
    unsigned* xbar; unsigned xx;
    { const Params p = fresh_params(); xbar = (unsigned*)(p.ws + OFF_BAR); xx = xb_xcc_id(); if (threadIdx.x == 0) (void)xb_add(&xbar[XB_XCNT(xx)], 1u); }
    { const Params p = fresh_params(); phase0(p); }
    grid.sync();
#pragma unroll 1
    for (int l = 0; l < 2; ++l) {
        { const Params p = fresh_params(); phase_weights(p, l, lds); __syncthreads(); phase_filter_gen(p, l, lds); }
        xcd_barrier(xbar, xx, xst);
        {
            const Params p = fresh_params();
            phase_filter_fft(p, l, lds);
            const bf16_t* WtKV = (const bf16_t*)(p.ws + OFF_WTKV); const bf16_t* membf = (const bf16_t*)(p.ws + OFF_MEMBF);
            for (int t = bid; t < 64; t += G) {
                f32x4 acc[4][4];
                if (t < 32) {
                    const int m0 = (t >> 2) * 256, n0 = (t & 3) * 128;
                    gemm_core(acc, membf + (size_t)m0 * 1024, 1024, WtKV + (size_t)n0 * 1024, 1024, 1024, lds);
                    bf16_t* Km = (bf16_t*)(p.ws + OFF_KMAT);
                    EPI_LOOP(st_bf4(Km + (size_t)row * 512 + col, v);)
                } else {
                    const int t2 = t - 32, m0 = (t2 >> 4) * 256, n0 = (t2 & 15) * 128;
                    gemm_core(acc, WtKV + (size_t)(512 + m0) * 1024, 1024, membf + (size_t)n0 * 1024, 1024, 1024, lds);
                    bf16_t* Vm = (bf16_t*)(p.ws + OFF_VT);
                    EPI_LOOP(st_bf4(Vm + (size_t)row * 2048 + col, v);)
                }
            }
        }
        xcd_barrier(xbar, xx, xst);
#pragma unroll 1
        for (int g = 0; g < NGRP; ++g) {
            const size_t tok0 = (size_t)g * TG;
#pragma unroll 1
            for (int rep = 0; rep < PROBE_REP_INPROJ; ++rep) {
                const Params p = fresh_params();
                pg8::Gemm gm; gm.A = (const bf16_t*)(p.ws + OFF_HB) + tok0 * 1024; gm.Bt = (const bf16_t*)(p.ws + OFF_WTIN); gm.M = TG; gm.N = NINP; gm.K = 1024;
                pg8::StaticOrder S; S.init(TG, NINP, G, bid);
                EpiInProj E; E.P = (bf16_t*)(p.ws + OFF_P); E.bias = p.b_in + (size_t)l * NIN; E.LR = (float*)(p.ws + OFF_LR);
                pg8::gemm_phase<EpiInProj, pg8::StaticOrder, false>((PG8_LAS unsigned char*)lds, gm, S, E, nullptr);
                __syncthreads();
            }
            xcd_barrier(xbar, xx, xst);
#pragma unroll 1
            for (int rep = 0; rep < PROBE_REP_MIX; ++rep) {
            int dry = (rep + 1 < PROBE_REP_MIX) ? 1 : 0; asm volatile("" : "+s"(dry));
            {
                const Params p = fresh_params();
                bf16_t* P = (bf16_t*)(p.ws + OFF_P);
                for (int it = bid; it < BG * 64 * 8; it += G) na_item(p, l, P, it >> 9, (it >> 3) & 63, it & 7, lds, dry);
            }
            {
                const Params p = fresh_params();
                bf16_t* P = (bf16_t*)(p.ws + OFF_P);
                for (int it = bid; it < BG * 128 * 8; it += G) hy_pre_item(p, l, P, (float*)(p.ws + OFF_UT), (bf16_t*)(p.ws + OFF_GT), it >> 10, (it >> 3) & 127, it & 7, lds);
            }
            {
                const Params p = fresh_params();
                for (int it = bid; it < NITEM; it += G) gla_part1_item(p, l, (const bf16_t*)(p.ws + OFF_P), (const float*)(p.ws + OFF_LR), it, lds);
            }
            {
                const Params p = fresh_params();
                bf16_t* P = (bf16_t*)(p.ws + OFF_P);
                const int nit = BG * 4 * 64, per = (nit + G - 1) / G;
                int last = -1;
                for (int it = bid * per; it < min(nit, (bid + 1) * per); ++it) {
                    const int bh = it >> 6, bl = bh >> 2, h = bh & 3;
                    if (bh != last) { __syncthreads(); memattn_load(p, g * BG + bl, h, lds); last = bh; }
                    memattn_item(P, bl, h, it & 63, lds, dry);
                }
                __syncthreads();
            }
            xcd_barrier(xbar, xx, xst);
            {
                const Params p = fresh_params();
                const float2* twl = fft_lds_twiddles((const float2*)(p.ws + OFF_TW), lds);
                for (int it = bid; it < BG * 256; it += G) hyena_conv_item(p, (const float*)(p.ws + OFF_UT), (bf16_t*)(p.ws + OFF_GT), it >> 8, it & 255, lds, twl, dry);
                __syncthreads();
                gla_scan(p, dry);
            }
            xcd_barrier(xbar, xx, xst);
            {
                const Params p = fresh_params();
                for (int it = bid; it < NITEM; it += G) gla_part2_item(p, l, (bf16_t*)(p.ws + OFF_P), (const float*)(p.ws + OFF_LR), it, lds, dry);
            }
            {
                const Params p = fresh_params();
                for (int it = bid; it < BG * 128 * 8; it += G) hy_post_item((bf16_t*)(p.ws + OFF_P), (const bf16_t*)(p.ws + OFF_GT), it >> 10, (it >> 3) & 127, it & 7, lds, dry);
            }
            xcd_barrier(xbar, xx, xst);
            }
            {
                const Params p = fresh_params();
                const bf16_t* P = (const bf16_t*)(p.ws + OFF_P); const bf16_t* WtBr = (const bf16_t*)(p.ws + OFF_WTBR); bf16_t* merged = (bf16_t*)(p.ws + OFF_MERGED);
                for (int t = bid; t < 512; t += G) {
                    const int sr = t >> 8, sb = t & 255, sx = sb & 7, sk = sb >> 3;
                    const int m0 = (sr * 32 + (sk >> 3) * 8 + sx) * 256, n0 = (sk & 7) * 128;
                    merge_tile(P, WtBr, merged, m0, n0, lds);
                }
            }
            xcd_barrier(xbar, xx, xst);
            {
                const Params p = fresh_params();
                pg8::Gemm gm; gm.A = (const bf16_t*)(p.ws + OFF_MERGED); gm.Bt = (const bf16_t*)(p.ws + OFF_WTOUT); gm.M = TG; gm.N = 1024; gm.K = 1024;
                pg8::StaticOrder S; S.init(TG, 1024, G, bid);
                EpiOut E; E.pre = (float*)(p.ws + OFF_PRE); E.bo = p.b_out + l * 1024;
                pg8::gemm_phase<EpiOut, pg8::StaticOrder, false>((PG8_LAS unsigned char*)lds, gm, S, E, nullptr);
                __syncthreads();
            }
            xcd_barrier(xbar, xx, xst);
            {
                const Params p = fresh_params();
                ln_rows_res(p, l, tok0);
            }
        }
        xcd_barrier(xbar, xx, xst);
    }
}

extern "C" void kernel_launch(void* const* d_in, const int* in_sizes, int n_in, void* d_out, int out_size, void* d_ws, size_t ws_size, hipStream_t stream) {
    static int grid_blocks = 0;
    if (!grid_blocks) {
        if (ws_size < WS_END) { fprintf(stderr, "kernel_launch: workspace too small: %zu < %zu\n", ws_size, (size_t)WS_END); grid_blocks = -1; return; }
        {
            const long long ex[26] = {67108864LL, 2097152LL, 1024, 1024, 2LL * 1024 * 10784, 2 * 10784, 2 * 8 * 15 * 31, 2 * 3 * 1536, 2 * 1536, 2 * 33 * 64, 2 * 64, 2 * 2 * 64 * 64, 2 * 2 * 64,
                                      2 * 64 * 1024, 2 * 512, 2 * 16 * 256, 2 * 256, 2 * 16 * 256, 2 * 256, 2 * 512, 2LL * 1024 * 1024, 2LL * 4 * 512 * 1024, 2LL * 1024 * 1024, 2 * 1024, 2 * 1024, 2 * 1024};
            bool bad = (n_in != 26) || (out_size != 67108864);
            for (int i = 0; i < 26 && !bad; ++i) if ((long long)in_sizes[i] != ex[i]) { fprintf(stderr, "kernel_launch: input %d has %d elements, expected %lld\n", i, in_sizes[i], ex[i]); bad = true; }
            if (bad) { fprintf(stderr, "kernel_launch: unexpected shapes; nothing launched\n"); grid_blocks = -1; return; }
        }
        int dev = 0, cus = 0, per_cu = 0;
        hipGetDevice(&dev);
        hipDeviceGetAttribute(&cus, hipDeviceAttributeMultiprocessorCount, dev);
        if (hipFuncSetAttribute((const void*)mega, hipFuncAttributeMaxDynamicSharedMemorySize, LDS_BYTES) != hipSuccess) fprintf(stderr, "kernel_launch: hipFuncSetAttribute failed\n");
        if (hipOccupancyMaxActiveBlocksPerMultiprocessor(&per_cu, (const void*)mega, NTHR, LDS_BYTES) != hipSuccess || per_cu < 1) { fprintf(stderr, "kernel_launch: occupancy query gave %d\n", per_cu); per_cu = 1; }
        (void)hipGetLastError();
        if (per_cu > 1) per_cu = 1;
        grid_blocks = cus * per_cu;
    }
    if (grid_blocks < 0) return;
    Params p{};
    const float** pp = (const float**)&p;
    for (int i = 0; i < 26; ++i) pp[i] = (const float*)d_in[i];
    p.out = (float*)d_out; p.ws = (unsigned char*)d_ws;
    if (hipMemsetAsync((unsigned char*)d_ws + OFF_BAR, 0, 16384, stream) != hipSuccess) fprintf(stderr, "kernel_launch: memset of the barrier word failed\n");
    void* args[] = {&p};
    hipError_t e = hipLaunchCooperativeKernel((const void*)mega, dim3(grid_blocks), dim3(NTHR), args, LDS_BYTES, stream);
    if (e != hipSuccess) fprintf(stderr, "cooperative launch failed: %s (grid %d)\n", hipGetErrorString(e), grid_blocks);
}
#endif
```

```cpp
#ifndef PROBE_REP_MIX
#define PROBE_REP_MIX 1
#endif
#ifndef PROBE_REP_INPROJ
#define PROBE_REP_INPROJ 1
#endif
#include <hip/hip_runtime.h>
#include <hip/hip_cooperative_groups.h>
#include <cstdio>
#include <unistd.h>
#include <cmath>
namespace cg = cooperative_groups;

#define HD __host__ __device__
typedef unsigned short bf16_t;
typedef short bf16x8 __attribute__((ext_vector_type(8)));
typedef float f32x4 __attribute__((ext_vector_type(4)));
typedef unsigned u32x2 __attribute__((ext_vector_type(2)));
typedef unsigned u32x4 __attribute__((ext_vector_type(4)));

constexpr int NTOK = 65536, DM = 1024, SEQ = 8192, NB = 8;
constexpr int BG = 2;
constexpr int NGRP = NB / BG;
constexpr int TG = BG * SEQ;
constexpr int PS = 10752;
constexpr int NIN = 10784, NINP = 11008;
constexpr int C_NAQ = 0, C_NAK = 512, C_NAV = 1024, C_HY = 1536, C_GQ = 3072, C_GK = 3328, C_GV = 3584, C_MQ = 4096, C_Z = 4608, C_SG = 6656, C_LR = 10752;
constexpr int FN = 16384;
constexpr int NITEM = BG * 128 * 4;
constexpr int LDS_BYTES = 160 * 1024;
constexpr int NTHR = 512;
constexpr float DN_ALPHA = 1.41421356237309515f;

constexpr size_t al256(size_t x) { return (x + 255) & ~(size_t)255; }
constexpr size_t OFF_HB = 0;
constexpr size_t OFF_STATS = OFF_HB + (size_t)NTOK * DM * 2;
constexpr size_t OFF_TW = OFF_STATS + (size_t)NTOK * 8;
constexpr size_t OFF_MEMBF = OFF_TW + (size_t)FN * 8;
constexpr size_t OFF_ENERGY = OFF_MEMBF + (size_t)2048 * 1024 * 2;
constexpr size_t OFF_WTIN = OFF_ENERGY + 4096;
constexpr size_t OFF_WTBR = OFF_WTIN + (size_t)NINP * 1024 * 2;
constexpr size_t OFF_WTOUT = OFF_WTBR + (size_t)4 * 1024 * 512 * 2;
constexpr size_t OFF_WTKV = OFF_WTOUT + (size_t)1024 * 1024 * 2;
constexpr size_t OFF_KMAT = OFF_WTKV + (size_t)2048 * 1024 * 2;
constexpr size_t OFF_VT = OFF_KMAT + (size_t)2048 * 1024 * 2;
constexpr size_t OFF_HFILT = OFF_VT + (size_t)2048 * 1024 * 2;
constexpr size_t OFF_PQ = OFF_HFILT + (size_t)1024 * 8192 * 4;
constexpr size_t OFF_P = OFF_PQ + (size_t)256 * FN * 16;
constexpr size_t OFF_LR = OFF_P + (size_t)TG * PS * 2;
constexpr size_t OFF_GS = OFF_LR + (size_t)TG * 32 * 4;
constexpr size_t OFF_GDEC = OFF_GS + (size_t)2 * NITEM * 8192 * 4;
constexpr size_t OFF_MERGED = OFF_GDEC + (size_t)2 * NITEM * 64 * 4;
constexpr size_t OFF_PRE = OFF_MERGED + (size_t)TG * 1024 * 2;
constexpr size_t OFF_UT = OFF_PRE + (size_t)TG * 1024 * 4;
constexpr size_t OFF_GT = OFF_UT + (size_t)BG * 512 * 8192 * 4;
constexpr size_t OFF_BAR = OFF_GT + (size_t)BG * 512 * 8192 * 2;
constexpr size_t OFF_ZT = OFF_BAR + 16384;
constexpr size_t OFF_TB = al256(OFF_ZT + (size_t)8192 * 33 * 4);
constexpr size_t WS_END = OFF_TB + (size_t)NITEM * 8192 * 4;

struct Params {
    const float *x, *mem, *ln_in_g, *ln_in_b, *w_in, *b_in, *na_rpb, *hy_conv_w, *hy_conv_b, *hy_w1, *hy_b1, *hy_wm, *hy_bm, *hy_w3, *hy_skip,
        *gla_up_f, *gla_bias_f, *gla_up_b, *gla_bias_b, *gla_norm_g, *mem_w_kv, *w_br, *w_out, *b_out, *ln_g, *ln_b;
    float* out;
    unsigned char* ws;
};

HD inline float bf2f(bf16_t b) {
    union { unsigned u; float f; } c; c.u = (unsigned)b << 16; return c.f;
}
HD inline bf16_t f2bf(float f) {
    union { unsigned u; float f; } c; c.f = f; unsigned u = c.u; u += 0x7fffu + ((u >> 16) & 1u); return (bf16_t)(u >> 16);
}
typedef float f32x2_t __attribute__((ext_vector_type(2)));
typedef __bf16 bf16x2_t __attribute__((ext_vector_type(2)));
__device__ __forceinline__ unsigned pk2(float lo, float hi) { const f32x2_t v = {lo, hi}; const bf16x2_t b = __builtin_convertvector(v, bf16x2_t); return __builtin_bit_cast(unsigned, b); }
__device__ __forceinline__ bf16_t f2bf_d(float f) { return (bf16_t)(pk2(f, f) & 0xffffu); }
__device__ __forceinline__ float lo16(unsigned u) { return __uint_as_float(u << 16); }
__device__ __forceinline__ float hi16(unsigned u) { return __uint_as_float(u & 0xffff0000u); }
__device__ __forceinline__ float wave_sum(float v) {
#pragma unroll
    for (int o = 32; o >= 1; o >>= 1) v += __shfl_xor(v, o);
    return v;
}
__device__ __forceinline__ float sigmoidf_(float x) { return __builtin_amdgcn_rcpf(1.0f + __expf(-x)); }
__device__ __forceinline__ float siluf_(float x) { return x * __builtin_amdgcn_rcpf(1.0f + __expf(-x)); }
__device__ __forceinline__ float logsigf_(float x) { return fminf(x, 0.0f) - __logf(1.0f + __expf(-fabsf(x))); }
__device__ __forceinline__ bf16x8 mkfrag(u32x4 v) { return __builtin_bit_cast(bf16x8, v); }
__device__ __forceinline__ bf16x8 mkfrag2(u32x2 a, u32x2 b) { u32x4 v = {a.x, a.y, b.x, b.y}; return __builtin_bit_cast(bf16x8, v); }
#define MFMA(a, b, c) __builtin_amdgcn_mfma_f32_16x16x32_bf16((a), (b), (c), 0, 0, 0)
HD inline int iclamp(int v, int lo, int hi) { return v < lo ? lo : (v > hi ? hi : v); }

HD inline float2 cmulf(float2 a, float2 b) { float2 r; r.x = a.x * b.x - a.y * b.y; r.y = a.x * b.y + a.y * b.x; return r; }
HD inline float2 cmulcf(float2 a, float2 b) { float2 r; r.x = a.x * b.x + a.y * b.y; r.y = a.y * b.x - a.x * b.y; return r; }
struct Bfly { float2 x0, x1, x2, x3, W1; int i0; };
HD inline void bfly_load(Bfly& b, const float2* d, const float2* tw, int lgm, int q) {
    const int m = 1 << lgm, blk = q >> lgm, j = q & (m - 1);
    b.i0 = (blk << (lgm + 2)) + j;
    b.W1 = tw[j];
    b.x0 = d[b.i0]; b.x1 = d[b.i0 + m]; b.x2 = d[b.i0 + 2 * m]; b.x3 = d[b.i0 + 3 * m];
}
HD inline void bfly_fwd_store(const Bfly& b, float2* d, int lgm) {
    const int m = 1 << lgm, i0 = b.i0;
    const float2 W1 = b.W1, W2 = cmulf(W1, W1);
    const float2 x0 = b.x0, x1 = b.x1, x2 = b.x2, x3 = b.x3;
    float2 a0, a1, a2, a3, t;
    a0.x = x0.x + x2.x; a0.y = x0.y + x2.y;
    t.x = x0.x - x2.x; t.y = x0.y - x2.y; a2 = cmulf(t, W1);
    a1.x = x1.x + x3.x; a1.y = x1.y + x3.y;
    t.x = x1.x - x3.x; t.y = x1.y - x3.y; t = cmulf(t, W1); a3.x = t.y; a3.y = -t.x;
    float2 r;
    r.x = a0.x + a1.x; r.y = a0.y + a1.y; d[i0] = r;
    t.x = a0.x - a1.x; t.y = a0.y - a1.y; d[i0 + m] = cmulf(t, W2);
    r.x = a2.x + a3.x; r.y = a2.y + a3.y; d[i0 + 2 * m] = r;
    t.x = a2.x - a3.x; t.y = a2.y - a3.y; d[i0 + 3 * m] = cmulf(t, W2);
}
HD inline void bfly_inv_store(const Bfly& b, float2* d, int lgm) {
    const int m = 1 << lgm, i0 = b.i0;
    const float2 W1 = b.W1, W2 = cmulf(W1, W1);
    const float2 x0 = b.x0, x1 = b.x1, x2 = b.x2, x3 = b.x3;
    const float2 b1 = cmulcf(x1, W2), b3 = cmulcf(x3, W2);
    float2 y0, y1, y2, y3;
    y0.x = x0.x + b1.x; y0.y = x0.y + b1.y; y1.x = x0.x - b1.x; y1.y = x0.y - b1.y;
    y2.x = x2.x + b3.x; y2.y = x2.y + b3.y; y3.x = x2.x - b3.x; y3.y = x2.y - b3.y;
    const float2 c2 = cmulcf(y2, W1); float2 c3 = cmulcf(y3, W1); { const float tx = -c3.y, ty = c3.x; c3.x = tx; c3.y = ty; }
    float2 r;
    r.x = y0.x + c2.x; r.y = y0.y + c2.y; d[i0] = r;
    r.x = y0.x - c2.x; r.y = y0.y - c2.y; d[i0 + 2 * m] = r;
    r.x = y1.x + c3.x; r.y = y1.y + c3.y; d[i0 + m] = r;
    r.x = y1.x - c3.x; r.y = y1.y - c3.y; d[i0 + 3 * m] = r;
}
HD inline void fft_fwd_bfly(float2* d, const float2* tw, int lgm, int q) { Bfly b; bfly_load(b, d, tw, lgm, q); bfly_fwd_store(b, d, lgm); }
HD inline void fft_inv_bfly(float2* d, const float2* tw, int lgm, int q) { Bfly b; bfly_load(b, d, tw, lgm, q); bfly_inv_store(b, d, lgm); }
HD inline void r4_fwd(float2& x0, float2& x1, float2& x2, float2& x3, const float2 W1) {
    const float2 W2 = cmulf(W1, W1);
    float2 a0, a1, a2, a3, t;
    a0.x = x0.x + x2.x; a0.y = x0.y + x2.y;
    t.x = x0.x - x2.x; t.y = x0.y - x2.y; a2 = cmulf(t, W1);
    a1.x = x1.x + x3.x; a1.y = x1.y + x3.y;
    t.x = x1.x - x3.x; t.y = x1.y - x3.y; t = cmulf(t, W1); a3.x = t.y; a3.y = -t.x;
    x0.x = a0.x + a1.x; x0.y = a0.y + a1.y;
    t.x = a0.x - a1.x; t.y = a0.y - a1.y; x1 = cmulf(t, W2);
    x2.x = a2.x + a3.x; x2.y = a2.y + a3.y;
    t.x = a2.x - a3.x; t.y = a2.y - a3.y; x3 = cmulf(t, W2);
}
HD inline void r4_inv(float2& x0, float2& x1, float2& x2, float2& x3, const float2 W1) {
    const float2 W2 = cmulf(W1, W1);
    const float2 b1 = cmulcf(x1, W2), b3 = cmulcf(x3, W2);
    float2 y0, y1, y2, y3;
    y0.x = x0.x + b1.x; y0.y = x0.y + b1.y; y1.x = x0.x - b1.x; y1.y = x0.y - b1.y;
    y2.x = x2.x + b3.x; y2.y = x2.y + b3.y; y3.x = x2.x - b3.x; y3.y = x2.y - b3.y;
    const float2 c2 = cmulcf(y2, W1); float2 c3 = cmulcf(y3, W1); { const float tx = -c3.y, ty = c3.x; c3.x = tx; c3.y = ty; }
    x0.x = y0.x + c2.x; x0.y = y0.y + c2.y; x2.x = y0.x - c2.x; x2.y = y0.y - c2.y;
    x1.x = y1.x + c3.x; x1.y = y1.y + c3.y; x3.x = y1.x - c3.x; x3.y = y1.y - c3.y;
}
template <bool INV, bool HALF>
HD inline void r16_bfly(float2* d, const float2* twO, const float2* twI, int lgm, int q) {
    const int m = 1 << lgm, blk = q >> lgm, j = q & (m - 1), base = (blk << (lgm + 4)) + j;
    float2 e[4][4];
#pragma unroll
    for (int a = 0; a < 4; ++a)
#pragma unroll
        for (int b = 0; b < 4; ++b) {
            if (!INV && HALF && a >= 2) { e[a][b].x = 0.f; e[a][b].y = 0.f; }
            else e[a][b] = d[base + ((4 * a + b) << lgm)];
        }
    const float2 wI = twI[j];
    float2 wO[4];
#pragma unroll
    for (int b = 0; b < 4; ++b) wO[b] = twO[j + (b << lgm)];
    if (!INV) {
#pragma unroll
        for (int b = 0; b < 4; ++b) r4_fwd(e[0][b], e[1][b], e[2][b], e[3][b], wO[b]);
#pragma unroll
        for (int a = 0; a < 4; ++a) r4_fwd(e[a][0], e[a][1], e[a][2], e[a][3], wI);
    } else {
#pragma unroll
        for (int a = 0; a < 4; ++a) r4_inv(e[a][0], e[a][1], e[a][2], e[a][3], wI);
#pragma unroll
        for (int b = 0; b < 4; ++b) r4_inv(e[0][b], e[1][b], e[2][b], e[3][b], wO[b]);
    }
#pragma unroll
    for (int a = 0; a < 4; ++a)
#pragma unroll
        for (int b = 0; b < 4; ++b)
            if (!(INV && HALF && a >= 2)) d[base + ((4 * a + b) << lgm)] = e[a][b];
}
HD inline int brev14(int k) {
#if defined(__HIP_DEVICE_COMPILE__)
    return (int)(__brev((unsigned)k) >> 18);
#endif
    unsigned v = (unsigned)k;
    v = ((v >> 1) & 0x55555555u) | ((v & 0x55555555u) << 1);
    v = ((v >> 2) & 0x33333333u) | ((v & 0x33333333u) << 2);
    v = ((v >> 4) & 0x0f0f0f0fu) | ((v & 0x0f0f0f0fu) << 4);
    v = ((v >> 8) & 0x00ff00ffu) | ((v & 0x00ff00ffu) << 8);
    v = (v >> 16) | (v << 16);
    return (int)(v >> 18);
}
struct PwIn { float2 Z1, Z2; float4 A, B; int p1, p2; };
HD inline void pw_load(PwIn& w, const float2* d, const float4* pq, int p1) {
    const int kf = brev14(p1), k2 = (FN - kf) & (FN - 1); w.p1 = p1; w.p2 = brev14(k2);
    w.Z1 = d[w.p1]; w.Z2 = d[w.p2]; w.A = pq[w.p1]; w.B.x = w.A.x; w.B.y = -w.A.y; w.B.z = w.A.z; w.B.w = -w.A.w;
}
HD inline void pw_store(const PwIn& w, float2* d) {
    const float2 Z1 = w.Z1, Z2 = w.Z2;
    float2 P1, Q1, P2, Q2; P1.x = w.A.x; P1.y = w.A.y; Q1.x = w.A.z; Q1.y = w.A.w; P2.x = w.B.x; P2.y = w.B.y; Q2.x = w.B.z; Q2.y = w.B.w;
    float2 c1, c2; c1.x = Z1.x; c1.y = -Z1.y; c2.x = Z2.x; c2.y = -Z2.y;
    const float2 a = cmulf(Z1, P1), b = cmulf(c2, Q1), c = cmulf(Z2, P2), e = cmulf(c1, Q2);
    float2 w1, w2; w1.x = a.x + b.x; w1.y = a.y + b.y; w2.x = c.x + e.x; w2.y = c.y + e.y;
    d[w.p1] = w1;
    if (w.p2 != w.p1) d[w.p2] = w2;
}
HD inline void conv_pointwise(float2* d, const float4* pq, int p1) { PwIn w; pw_load(w, d, pq, p1); pw_store(w, d); }
HD inline void filt_pointwise(const float2* d, float4* pq, int p1) {
    const int kf = brev14(p1), k2 = (FN - kf) & (FN - 1), p2 = brev14(k2);
    const float2 Z1 = d[p1], Z2 = d[p2];
    const float gcx = 0.5f * (Z1.x + Z2.x), gcy = 0.5f * (Z1.y - Z2.y);
    const float gdx = 0.5f * (Z1.y + Z2.y), gdy = -0.5f * (Z1.x - Z2.x);
    const float s = 0.5f / (float)FN;
    float4 A; A.x = s * (gcx + gdx); A.y = s * (gcy + gdy); A.z = s * (gcx - gdx); A.w = s * (gcy - gdy);
    pq[p1] = A;
}
HD inline int tw_off(int lgm) { return lgm == 10 ? 0 : lgm == 8 ? 1024 : lgm == 6 ? 1280 : lgm == 4 ? 1344 : lgm == 2 ? 1360 : 1364; }
#ifndef FFT_HOST_TEST
template <int LGM, bool INV>
__device__ __forceinline__ void fft_pass(float2* d, const float2* twl, const float2* twg, int tid) {
    const float2* tw = (LGM == 12) ? twg : twl + tw_off(LGM);
#pragma unroll
    for (int it = 0; it < 2; ++it) {
        const int q = tid + it * 4 * NTHR;
        Bfly b0, b1, b2, b3;
        bfly_load(b0, d, tw, LGM, q); bfly_load(b1, d, tw, LGM, q + NTHR); bfly_load(b2, d, tw, LGM, q + 2 * NTHR); bfly_load(b3, d, tw, LGM, q + 3 * NTHR);
        if (INV) { bfly_inv_store(b0, d, LGM); bfly_inv_store(b1, d, LGM); bfly_inv_store(b2, d, LGM); bfly_inv_store(b3, d, LGM); }
        else { bfly_fwd_store(b0, d, LGM); bfly_fwd_store(b1, d, LGM); bfly_fwd_store(b2, d, LGM); bfly_fwd_store(b3, d, LGM); }
    }
    __syncthreads();
}
template <int LGM, bool INV, bool HALF>
__device__ __forceinline__ void fft_pass16(float2* d, const float2* twl, const float2* twg, int tid) {
    const float2* twO = (LGM + 2 == 12) ? twg : twl + tw_off(LGM + 2);
    const float2* twI = twl + tw_off(LGM);
    r16_bfly<INV, HALF>(d, twO, twI, LGM, tid);
    r16_bfly<INV, HALF>(d, twO, twI, LGM, tid + NTHR);
    __syncthreads();
}
template <bool HALF>
__device__ __forceinline__ void fft_forward(float2* d, const float2* twl, const float2* twg) {
    int tid = threadIdx.x; asm volatile("" : "+v"(tid));
    fft_pass16<10, false, HALF>(d, twl, twg, tid); fft_pass16<6, false, false>(d, twl, twg, tid);
    fft_pass<4, false>(d, twl, twg, tid); fft_pass<2, false>(d, twl, twg, tid); fft_pass<0, false>(d, twl, twg, tid);
}
template <bool HALF>
__device__ __forceinline__ void fft_inverse(float2* d, const float2* twl, const float2* twg) {
    int tid = threadIdx.x; asm volatile("" : "+v"(tid));
    fft_pass<0, true>(d, twl, twg, tid); fft_pass<2, true>(d, twl, twg, tid); fft_pass<4, true>(d, twl, twg, tid);
    fft_pass16<6, true, false>(d, twl, twg, tid); fft_pass16<10, true, HALF>(d, twl, twg, tid);
}
__device__ __forceinline__ float2* fft_lds_twiddles(const float2* twg, unsigned char* lds) {
    int tid = threadIdx.x; asm volatile("" : "+v"(tid));
    float2* t = (float2*)(lds + 131072);
    for (int k = tid; k < 1365; k += NTHR) {
        const int lgm = k < 1024 ? 10 : k < 1280 ? 8 : k < 1344 ? 6 : k < 1360 ? 4 : k < 1364 ? 2 : 0;
        t[k] = twg[(k - tw_off(lgm)) << (12 - lgm)];
    }
    __syncthreads();
    return t;
}

constexpr int STG = 49152;
__device__ __forceinline__ int swz(int row, int ch) { return row * 128 + ((ch ^ ((row >> 1) & 7)) << 4); }
__device__ __forceinline__ void gemm_core(f32x4 (&acc)[4][4], const bf16_t* A, int lda, const bf16_t* Bt, int ldb, int K, unsigned char* lds) {
    int tid_ = threadIdx.x; asm volatile("" : "+v"(tid_)); const int tid = tid_, lane = tid & 63, w = tid >> 6, wm = w & 3, wn = w >> 2, l15 = lane & 15, q4 = lane >> 4;
    const int wu = __builtin_amdgcn_readfirstlane(w);
    __attribute__((address_space(3))) unsigned char* l3 = (__attribute__((address_space(3))) unsigned char*)lds;
#pragma unroll
    for (int mi = 0; mi < 4; ++mi)
#pragma unroll
        for (int ni = 0; ni < 4; ++ni) acc[mi][ni] = (f32x4){0.f, 0.f, 0.f, 0.f};
    const int r8 = lane >> 3, sch = (lane & 7) ^ ((((w & 1) << 2) + (r8 >> 1)) & 7);
    const bf16_t* ap = A + (size_t)(w * 8 + r8) * lda + sch * 8;
    const bf16_t* bp = Bt + (size_t)(w * 8 + r8) * ldb + sch * 8;
#define GC_STAGE(buf, k0)                                                                                                                         \
    {                                                                                                                                             \
        _Pragma("unroll") for (int i = 0; i < 4; ++i)                                                                                             \
            __builtin_amdgcn_global_load_lds((const unsigned*)(ap + (size_t)(64 * i) * lda + (k0)), (__attribute__((address_space(3))) unsigned*)(l3 + (buf) * STG + (wu + 8 * i) * 1024), 16, 0, 0);          \
        _Pragma("unroll") for (int i = 0; i < 2; ++i)                                                                                             \
            __builtin_amdgcn_global_load_lds((const unsigned*)(bp + (size_t)(64 * i) * ldb + (k0)), (__attribute__((address_space(3))) unsigned*)(l3 + (buf) * STG + 32768 + (wu + 8 * i) * 1024), 16, 0, 0);  \
    }
    GC_STAGE(0, 0)
    asm volatile("s_waitcnt vmcnt(0)" ::: "memory");
    __syncthreads();
    const int nk = K >> 6;
    for (int kt = 0; kt < nk; ++kt) {
        if (kt + 1 < nk) GC_STAGE((kt + 1) & 1, (kt + 1) << 6)
        const unsigned char* sa = lds + (kt & 1) * STG;
        const unsigned char* sb = sa + 32768;
#pragma unroll
        for (int ks = 0; ks < 2; ++ks) {
            bf16x8 af[4], bfr[4];
#pragma unroll
            for (int mi = 0; mi < 4; ++mi) af[mi] = *(const bf16x8*)(sa + swz(wm * 64 + mi * 16 + l15, ks * 4 + q4));
#pragma unroll
            for (int ni = 0; ni < 4; ++ni) bfr[ni] = *(const bf16x8*)(sb + swz(wn * 64 + ni * 16 + l15, ks * 4 + q4));
#pragma unroll
            for (int mi = 0; mi < 4; ++mi)
#pragma unroll
                for (int ni = 0; ni < 4; ++ni) acc[mi][ni] = MFMA(bfr[ni], af[mi], acc[mi][ni]);
        }
        asm volatile("s_waitcnt vmcnt(0)" ::: "memory");
        __syncthreads();
    }
#undef GC_STAGE
}
#define EPI_LOOP(body)                                                                                                  \
    {                                                                                                                   \
        int e_t = threadIdx.x; asm volatile("" : "+v"(e_t)); const int e_lane = e_t & 63, e_w = e_t >> 6;                                                    \
        _Pragma("unroll") for (int mi = 0; mi < 4; ++mi) _Pragma("unroll") for (int ni = 0; ni < 4; ++ni) {             \
            const int row = m0 + (e_w & 3) * 64 + mi * 16 + (e_lane & 15);                                              \
            const int col = n0 + (e_w >> 2) * 64 + ni * 16 + 4 * (e_lane >> 4);                                         \
            f32x4& v = acc[mi][ni];                                                                                     \
            body                                                                                                        \
        }                                                                                                               \
    }
__device__ __forceinline__ void st_bf4(bf16_t* dst, f32x4 v) {
    u32x2 o; o.x = pk2(v[0], v[1]); o.y = pk2(v[2], v[3]); *(u32x2*)dst = o;
}
__device__ __forceinline__ f32x4 ld_bf4(const bf16_t* src) {
    const u32x2 u = *(const u32x2*)src; f32x4 r = {lo16(u.x), hi16(u.x), lo16(u.y), hi16(u.y)}; return r;
}


__device__ __forceinline__ void merge_tile(const bf16_t* P, const bf16_t* WtBr, bf16_t* merged, int m0, int n0, unsigned char* lds) {
    int tid_ = threadIdx.x; asm volatile("" : "+v"(tid_)); const int tid = tid_, lane = tid & 63, w = tid >> 6, wm = w & 3, wn = w >> 2, l15 = lane & 15, q4 = lane >> 4;
    const int wu = __builtin_amdgcn_readfirstlane(w);
    __attribute__((address_space(3))) unsigned char* l3 = (__attribute__((address_space(3))) unsigned char*)lds;
    f32x4 acc[4][4], macc[4][4];
#pragma unroll
    for (int mi = 0; mi < 4; ++mi)
#pragma unroll
        for (int ni = 0; ni < 4; ++ni) { acc[mi][ni] = (f32x4){0.f, 0.f, 0.f, 0.f}; macc[mi][ni] = (f32x4){0.f, 0.f, 0.f, 0.f}; }
    const int r8 = lane >> 3, sch = (lane & 7) ^ ((((w & 1) << 2) + (r8 >> 1)) & 7);
    const bf16_t* ap = P + (size_t)(m0 + w * 8 + r8) * PS + sch * 8;
    const bf16_t* bp = WtBr + (size_t)(n0 + w * 8 + r8) * 512 + sch * 8;
    const bf16_t* sgp = P + (size_t)(m0 + wm * 64 + l15) * PS + C_SG + n0 + wn * 64 + 4 * q4;
#define MG_STAGE(buf, kt_)                                                                                                                        \
    {                                                                                                                                             \
        const int j_ = (kt_) >> 3, k0_ = ((kt_) & 7) << 6;                                                                                        \
        const int acol_ = (j_ == 0) ? C_NAQ : (j_ == 1) ? C_HY : (j_ == 2) ? C_GV : C_MQ;                                                        \
        _Pragma("unroll") for (int i = 0; i < 4; ++i)                                                                                             \
            __builtin_amdgcn_global_load_lds((const unsigned*)(ap + (size_t)(64 * i) * PS + acol_ + k0_), (__attribute__((address_space(3))) unsigned*)(l3 + (buf) * STG + (wu + 8 * i) * 1024), 16, 0, 0);      \
        _Pragma("unroll") for (int i = 0; i < 2; ++i)                                                                                             \
            __builtin_amdgcn_global_load_lds((const unsigned*)(bp + (size_t)j_ * 1024 * 512 + (size_t)(64 * i) * 512 + k0_), (__attribute__((address_space(3))) unsigned*)(l3 + (buf) * STG + 32768 + (wu + 8 * i) * 1024), 16, 0, 0);  \
    }
    MG_STAGE(0, 0)
    MG_STAGE(1, 1)
    asm volatile("s_waitcnt vmcnt(6)" ::: "memory");
    __builtin_amdgcn_s_barrier(); asm volatile("" ::: "memory");
    int cb = 0;
#pragma unroll 1
    for (int kt = 0; kt < 32; ++kt) {
        const bool last = (kt & 7) == 7;
        u32x2 sg[4][4];
        if (last) {
            const bf16_t* sp = sgp + 1024 * (kt >> 3);
#pragma unroll
            for (int mi = 0; mi < 4; ++mi)
#pragma unroll
                for (int ni = 0; ni < 4; ++ni) sg[mi][ni] = *(const u32x2*)(sp + (size_t)(mi * 16) * PS + ni * 16);
        }
        const int nb = (cb == 0) ? 2 : cb - 1;
        if (kt + 2 < 32) MG_STAGE(nb, kt + 2)
        const unsigned char* sa = lds + cb * STG;
        const unsigned char* sb = sa + 32768;
#pragma unroll
        for (int ks = 0; ks < 2; ++ks) {
            bf16x8 af[4], bfr[4];
#pragma unroll
            for (int mi = 0; mi < 4; ++mi) af[mi] = *(const bf16x8*)(sa + swz(wm * 64 + mi * 16 + l15, ks * 4 + q4));
#pragma unroll
            for (int ni = 0; ni < 4; ++ni) bfr[ni] = *(const bf16x8*)(sb + swz(wn * 64 + ni * 16 + l15, ks * 4 + q4));
            __builtin_amdgcn_s_setprio(1);
#pragma unroll
            for (int mi = 0; mi < 4; ++mi)
#pragma unroll
                for (int ni = 0; ni < 4; ++ni) acc[mi][ni] = MFMA(bfr[ni], af[mi], acc[mi][ni]);
            __builtin_amdgcn_s_setprio(0);
        }
        if (kt + 2 < 32) asm volatile("s_waitcnt vmcnt(6)" ::: "memory"); else asm volatile("s_waitcnt vmcnt(0)" ::: "memory");
        if (last) {
#pragma unroll
            for (int mi = 0; mi < 4; ++mi)
#pragma unroll
                for (int ni = 0; ni < 4; ++ni) {
                    const u32x2 u = sg[mi][ni]; const f32x4 g4 = {lo16(u.x), hi16(u.x), lo16(u.y), hi16(u.y)};
                    macc[mi][ni] += g4 * acc[mi][ni]; acc[mi][ni] = (f32x4){0.f, 0.f, 0.f, 0.f};
                }
        }
        asm volatile("" ::: "memory"); __builtin_amdgcn_s_barrier(); asm volatile("" ::: "memory");
        cb = (cb == 2) ? 0 : cb + 1;
    }
#undef MG_STAGE
    __syncthreads();
#pragma unroll
    for (int mi = 0; mi < 4; ++mi)
#pragma unroll
        for (int ni = 0; ni < 4; ++ni) st_bf4(merged + (size_t)(m0 + wm * 64 + mi * 16 + l15) * 1024 + n0 + wn * 64 + ni * 16 + 4 * q4, macc[mi][ni]);
}

__device__ __forceinline__ int orig_col(int n) {
    if (n < 4096) return n;
    if (n < 4608) return n + 32;
    if (n < 6656) return n + 32;
    if (n < 10752) return n + 32;
    return n - 10752 + 4096;
}

__device__ __forceinline__ void ln_rows(const float* src, size_t src_row0, int nrows, const float* g, const float* b, float* dst32, bf16_t* dst16, size_t dst_row0, float2* stats) {
    int tid_ = threadIdx.x; asm volatile("" : "+v"(tid_));
    const int lane = tid_ & 63;
    const int gw = blockIdx.x * (NTHR / 64) + (tid_ >> 6), nw = gridDim.x * (NTHR / 64);
    for (int r = gw; r < nrows; r += nw) {
        const float4* xr = (const float4*)(src + (src_row0 + r) * 1024);
        float4 v[4]; float s = 0.f;
#pragma unroll
        for (int i = 0; i < 4; ++i) { v[i] = xr[lane + 64 * i]; s += (v[i].x + v[i].y) + (v[i].z + v[i].w); }
        s = wave_sum(s);
        const float mean = s * (1.0f / 1024.0f);
        float q = 0.f;
#pragma unroll
        for (int i = 0; i < 4; ++i) { const float a = v[i].x - mean, bb = v[i].y - mean, c = v[i].z - mean, d = v[i].w - mean; q += (a * a + bb * bb) + (c * c + d * d); }
        q = wave_sum(q);
        const float rstd = 1.0f / sqrtf(q * (1.0f / 1024.0f) + 1e-5f);
        if (stats && lane == 0) { float2 st; st.x = mean; st.y = rstd; stats[dst_row0 + r] = st; }
#pragma unroll
        for (int i = 0; i < 4; ++i) {
            const float4 g4 = ((const float4*)g)[lane + 64 * i], b4 = ((const float4*)b)[lane + 64 * i];
            float4 y; y.x = (v[i].x - mean) * rstd * g4.x + b4.x; y.y = (v[i].y - mean) * rstd * g4.y + b4.y; y.z = (v[i].z - mean) * rstd * g4.z + b4.z; y.w = (v[i].w - mean) * rstd * g4.w + b4.w;
            if (dst32) ((float4*)(dst32 + (dst_row0 + r) * 1024))[lane + 64 * i] = y;
            if (dst16) { u32x2 o; o.x = pk2(y.x, y.y); o.y = pk2(y.z, y.w); *(u32x2*)(dst16 + (dst_row0 + r) * 1024 + (lane + 64 * i) * 4) = o; }
        }
    }
}
__device__ __forceinline__ void phase0(const Params& p) {
    ln_rows(p.x, 0, NTOK, p.ln_in_g, p.ln_in_b, nullptr, (bf16_t*)(p.ws + OFF_HB), 0, (float2*)(p.ws + OFF_STATS));
    int tid_ = threadIdx.x; asm volatile("" : "+v"(tid_)); const int gt = blockIdx.x * NTHR + tid_, nt = gridDim.x * NTHR;
    float2* tw = (float2*)(p.ws + OFF_TW);
    for (int k = gt; k < FN; k += nt) { double s, c; sincospi(-2.0 * (double)k / (double)FN, &s, &c); float2 t; t.x = (float)c; t.y = (float)s; tw[k] = t; }
    bf16_t* mb = (bf16_t*)(p.ws + OFF_MEMBF);
    for (int i = gt; i < 2048 * 1024 / 4; i += nt) { const float4 v = ((const float4*)p.mem)[i]; u32x2 o; o.x = pk2(v.x, v.y); o.y = pk2(v.z, v.w); ((u32x2*)mb)[i] = o; }
    float* en = (float*)(p.ws + OFF_ENERGY);
    for (int i = gt; i < 1024; i += nt) en[i] = 0.f;
    float* ztab = (float*)(p.ws + OFF_ZT);
    for (int idx = gt; idx < 8192 * 33; idx += nt) {
        const int n = idx / 33, e = idx - n * 33;
        float v;
        if (e == 0) v = (float)n / 8191.0f;
        else {
            const int i = (e - 1) & 15;
            const double fr = 1e-4 + (double)i * ((15.0 - 1e-4) / 15.0);
            const double ang = (2.0 * 3.14159265358979323846 / 8192.0) * (double)n * fr;
            v = (e <= 16) ? (float)cos(ang) : (float)(-sin(ang));
        }
        ztab[idx] = v;
    }
}

__device__ __forceinline__ void wt_tile(const float* src, int src_ld, int k0, int on0, bf16_t* dst, int dst_ld, int dn0, bool zero, float* tile) {
    int tid_ = threadIdx.x; asm volatile("" : "+v"(tid_)); const int tid = tid_;
    if (!zero) {
#pragma unroll
        for (int i = 0; i < 2; ++i) {
            const int k = (tid >> 3) + 64 * i, c4 = (tid & 7) * 4;
            const float4 v = *(const float4*)(src + (size_t)(k0 + k) * src_ld + on0 + c4);
            float* t = tile + k * 33 + c4; t[0] = v.x; t[1] = v.y; t[2] = v.z; t[3] = v.w;
        }
    }
    __syncthreads();
    const int n = tid >> 4, kc = (tid & 15) * 8;
    float f[8];
#pragma unroll
    for (int e = 0; e < 8; ++e) f[e] = zero ? 0.f : tile[(kc + e) * 33 + n];
    u32x4 o; o.x = pk2(f[0], f[1]); o.y = pk2(f[2], f[3]); o.z = pk2(f[4], f[5]); o.w = pk2(f[6], f[7]);
    *(u32x4*)(dst + (size_t)(dn0 + n) * dst_ld + k0 + kc) = o;
    __syncthreads();
}
__device__ __forceinline__ void phase_weights(const Params& p, int l, unsigned char* lds) {
    float* tile = (float*)lds;
    for (int it = blockIdx.x; it < 3776; it += gridDim.x) {
        if (it < 2752) {
            const int nt = it >> 3, kt = it & 7, dn0 = nt * 32;
            wt_tile(p.w_in + (size_t)l * 1024 * NIN, NIN, kt * 128, orig_col(dn0), (bf16_t*)(p.ws + OFF_WTIN), 1024, dn0, dn0 >= NIN, tile);
        } else if (it < 3264) {
            const int r = it - 2752, j = r >> 7, nt = (r >> 2) & 31, kt = r & 3;
            wt_tile(p.w_br + (size_t)(l * 4 + j) * 512 * 1024, 1024, kt * 128, nt * 32, (bf16_t*)(p.ws + OFF_WTBR) + (size_t)j * 1024 * 512, 512, nt * 32, false, tile);
        } else if (it < 3520) {
            const int r = it - 3264, nt = r >> 3, kt = r & 7;
            wt_tile(p.w_out + (size_t)l * 1024 * 1024, 1024, kt * 128, nt * 32, (bf16_t*)(p.ws + OFF_WTOUT), 1024, nt * 32, false, tile);
        } else {
            const int r = it - 3520, nt = r >> 3, kt = r & 7;
            wt_tile(p.mem_w_kv + (size_t)l * 1024 * 1024, 1024, kt * 128, nt * 32, (bf16_t*)(p.ws + OFF_WTKV), 1024, nt * 32, false, tile);
        }
    }
}

__device__ __forceinline__ void phase_filter_gen(const Params& p, int l, unsigned char* lds) {
    float* zt = (float*)lds;
    float* ha = zt + 32 * 33;
    float* hbuf = ha + 32 * 64;
    int tid_ = threadIdx.x; asm volatile("" : "+v"(tid_)); const int tid = tid_;
    const float* w1 = p.hy_w1 + (size_t)l * 33 * 64; const float* b1 = p.hy_b1 + l * 64;
    const float* wm = p.hy_wm + (size_t)l * 2 * 64 * 64; const float* bm = p.hy_bm + l * 2 * 64;
    const float* w3 = p.hy_w3 + (size_t)l * 64 * 1024;
    float* hf = (float*)(p.ws + OFF_HFILT);
    float* en = (float*)(p.ws + OFF_ENERGY) + l * 512;
    const float* ztab = (const float*)(p.ws + OFF_ZT);
    for (int it = blockIdx.x; it < 256; it += gridDim.x) {
        const int n0 = it * 32;
        for (int idx = tid; idx < 32 * 33; idx += NTHR) zt[idx] = ztab[(size_t)n0 * 33 + idx];
        __syncthreads();
        for (int idx = tid; idx < 2048; idx += NTHR) {
            const int pos = idx >> 6, j = idx & 63; float s = b1[j];
            for (int e = 0; e < 33; ++e) s += zt[pos * 33 + e] * w1[e * 64 + j];
            ha[idx] = sinf(s);
        }
        __syncthreads();
        for (int idx = tid; idx < 2048; idx += NTHR) {
            const int pos = idx >> 6, j = idx & 63; float s = bm[j];
            for (int e = 0; e < 64; ++e) s += ha[pos * 64 + e] * wm[e * 64 + j];
            hbuf[idx] = sinf(s);
        }
        __syncthreads();
        for (int idx = tid; idx < 2048; idx += NTHR) {
            const int pos = idx >> 6, j = idx & 63; float s = bm[64 + j];
            for (int e = 0; e < 64; ++e) s += hbuf[pos * 64 + e] * wm[4096 + e * 64 + j];
            ha[idx] = sinf(s);
        }
        __syncthreads();
        {
            const int c = tid;
            float af[32], ab[32];
#pragma unroll
            for (int i = 0; i < 32; ++i) { af[i] = 0.f; ab[i] = 0.f; }
            for (int k = 0; k < 64; ++k) {
                const float wf = w3[k * 1024 + c], wb = w3[k * 1024 + 512 + c];
#pragma unroll
                for (int i = 0; i < 32; ++i) { const float h = ha[i * 64 + k]; af[i] += h * wf; ab[i] += h * wb; }
            }
            const float dmin = -3.0701134573253945f, dmax = -15.350567286626973f;
            const float delta = fabsf(dmin + (float)c * ((dmax - dmin) / 511.0f));
            float e = 0.f;
#pragma unroll
            for (int i = 0; i < 32; ++i) {
                const int n = n0 + i; const float t01 = (float)n / 8191.0f; const float win = expf(-t01 * delta);
                af[i] *= win; ab[i] *= win; e += af[i] * af[i]; if (n >= 1) e += ab[i] * ab[i];
            }
#pragma unroll
            for (int i = 0; i < 8; ++i) {
                float4 a; a.x = af[4 * i]; a.y = af[4 * i + 1]; a.z = af[4 * i + 2]; a.w = af[4 * i + 3];
                float4 b; b.x = ab[4 * i]; b.y = ab[4 * i + 1]; b.z = ab[4 * i + 2]; b.w = ab[4 * i + 3];
                *(float4*)(hf + (size_t)c * 8192 + n0 + 4 * i) = a;
                *(float4*)(hf + (size_t)(512 + c) * 8192 + n0 + 4 * i) = b;
            }
            atomicAdd(en + c, e);
        }
        __syncthreads();
    }
}

__device__ __forceinline__ void phase_filter_fft(const Params& p, int l, unsigned char* lds) {
    float2* d = (float2*)lds;
    const float2* tw = fft_lds_twiddles((const float2*)(p.ws + OFF_TW), lds);
    const float* hf = (const float*)(p.ws + OFF_HFILT);
    const float* en = (const float*)(p.ws + OFF_ENERGY) + l * 512;
    float4* pqa = (float4*)(p.ws + OFF_PQ);
    int tid_ = threadIdx.x; asm volatile("" : "+v"(tid_)); const int tid = tid_;
    for (int pr = blockIdx.x; pr < 256; pr += gridDim.x) {
        const int c0 = 2 * pr, c1 = c0 + 1;
        const float s0 = 1.0f / sqrtf(en[c0] + 1e-6f), s1 = 1.0f / sqrtf(en[c1] + 1e-6f);
        const float k0 = p.hy_skip[l * 512 + c0], k1 = p.hy_skip[l * 512 + c1];
        for (int n = tid; n < FN; n += NTHR) {
            float2 v;
            if (n < 8192) { v.x = hf[(size_t)c0 * 8192 + n] * s0; v.y = hf[(size_t)c1 * 8192 + n] * s1; if (n == 0) { v.x += k0; v.y += k1; } }
            else if (n == 8192) { v.x = 0.f; v.y = 0.f; }
            else { v.x = hf[(size_t)(512 + c0) * 8192 + (FN - n)] * s0; v.y = hf[(size_t)(512 + c1) * 8192 + (FN - n)] * s1; }
            d[n] = v;
        }
        __syncthreads();
        fft_forward<false>(d, tw, (const float2*)(p.ws + OFF_TW));
        for (int h = tid; h < FN / 2; h += NTHR) filt_pointwise(d, pqa + (size_t)pr * FN, 2 * h);
        if (tid == 0) filt_pointwise(d, pqa + (size_t)pr * FN, 1);
        __syncthreads();
    }
}

__device__ __forceinline__ void hy_pre_item(const Params& p, int l, const bf16_t* P, float* UT, bf16_t* GT, int bl, int tt, int ct, unsigned char* lds) {
    float* tU = (float*)lds;
    float* tG = tU + 64 * 65;
    int tid_ = threadIdx.x; asm volatile("" : "+v"(tid_)); const int tid = tid_;
    const int t = tid >> 3, cc = (tid & 7) * 8, c = ct * 64 + cc, tb = tt * 64 + t;
    const float* cw = p.hy_conv_w + (size_t)l * 3 * 1536; const float* cb = p.hy_conv_b + l * 1536;
    float av[8], a0[8], a1[8];
#pragma unroll
    for (int h = 0; h < 2; ++h) {
        const f32x4 bv = *(const f32x4*)(cb + c + 4 * h), b0 = *(const f32x4*)(cb + 512 + c + 4 * h), b1 = *(const f32x4*)(cb + 1024 + c + 4 * h);
#pragma unroll
        for (int e = 0; e < 4; ++e) { av[4 * h + e] = bv[e]; a0[4 * h + e] = b0[e]; a1[4 * h + e] = b1[e]; }
    }
#pragma unroll
    for (int j = 0; j < 3; ++j) {
        const int ts = tb + j - 1;
        if (ts >= 0 && ts < SEQ) {
            const bf16_t* row = P + (size_t)(bl * SEQ + ts) * PS + C_HY + c;
            const u32x4 rv = *(const u32x4*)row, r0 = *(const u32x4*)(row + 512), r1 = *(const u32x4*)(row + 1024);
#pragma unroll
            for (int h = 0; h < 2; ++h) {
                const f32x4 wv = *(const f32x4*)(cw + j * 1536 + c + 4 * h), w0 = *(const f32x4*)(cw + j * 1536 + 512 + c + 4 * h), w1 = *(const f32x4*)(cw + j * 1536 + 1024 + c + 4 * h);
#pragma unroll
                for (int e = 0; e < 4; ++e) {
                    const int k = 4 * h + e; const unsigned uv = rv[k >> 1], u0 = r0[k >> 1], u1 = r1[k >> 1];
                    av[k] += wv[e] * ((k & 1) ? hi16(uv) : lo16(uv)); a0[k] += w0[e] * ((k & 1) ? hi16(u0) : lo16(u0)); a1[k] += w1[e] * ((k & 1) ? hi16(u1) : lo16(u1));
                }
            }
        }
    }
    const u32x4 rz = *(const u32x4*)(P + (size_t)(bl * SEQ + tb) * PS + C_Z + 512 + c);
#pragma unroll
    for (int k = 0; k < 8; ++k) {
        const unsigned uz = rz[k >> 1]; const float z = (k & 1) ? hi16(uz) : lo16(uz);
        tU[(cc + k) * 65 + t] = av[k] * a1[k]; tG[(cc + k) * 65 + t] = a0[k] * z;
    }
    __syncthreads();
    const int c2 = tid >> 3, t8 = (tid & 7) * 8;
    const size_t o = (size_t)(bl * 512 + ct * 64 + c2) * SEQ + tt * 64 + t8;
    const float* su = tU + c2 * 65 + t8; const float* sg = tG + c2 * 65 + t8;
    f32x4 ua = {su[0], su[1], su[2], su[3]}, ub = {su[4], su[5], su[6], su[7]};
    *(f32x4*)(UT + o) = ua; *(f32x4*)(UT + o + 4) = ub;
    u32x4 g; g.x = pk2(sg[0], sg[1]); g.y = pk2(sg[2], sg[3]); g.z = pk2(sg[4], sg[5]); g.w = pk2(sg[6], sg[7]);
    *(u32x4*)(GT + o) = g;
    __syncthreads();
}
__device__ __forceinline__ void hy_post_item(bf16_t* P, const bf16_t* GT, int bl, int tt, int ct, unsigned char* lds, int dry = 0) {
    bf16_t* tl = (bf16_t*)lds;
    int tid_ = threadIdx.x; asm volatile("" : "+v"(tid_)); const int tid = tid_;
    const int c2 = tid >> 3, t8 = (tid & 7) * 8;
    const u32x4 v = *(const u32x4*)(GT + (size_t)(bl * 512 + ct * 64 + c2) * SEQ + tt * 64 + t8);
    bf16_t* d0 = tl + t8 * 72 + c2;
    d0[0 * 72] = (bf16_t)(v.x & 0xffffu); d0[1 * 72] = (bf16_t)(v.x >> 16); d0[2 * 72] = (bf16_t)(v.y & 0xffffu); d0[3 * 72] = (bf16_t)(v.y >> 16);
    d0[4 * 72] = (bf16_t)(v.z & 0xffffu); d0[5 * 72] = (bf16_t)(v.z >> 16); d0[6 * 72] = (bf16_t)(v.w & 0xffffu); d0[7 * 72] = (bf16_t)(v.w >> 16);
    __syncthreads();
    const int t = tid >> 3, cc = (tid & 7) * 8;
    const u32x4 ov = *(const u32x4*)(tl + t * 72 + cc);
    if (!dry) *(u32x4*)(P + (size_t)(bl * SEQ + tt * 64 + t) * PS + C_HY + ct * 64 + cc) = ov;
    __syncthreads();
}
__device__ __forceinline__ void hyena_conv_item(const Params& p, const float* UT, bf16_t* GT, int bl, int pr, unsigned char* lds, const float2* tw, int dry = 0) {
    float2* d = (float2*)lds;
    const float4* pq = (const float4*)(p.ws + OFF_PQ) + (size_t)pr * FN;
    int tid_ = threadIdx.x; asm volatile("" : "+v"(tid_)); const int tid = tid_;
    const float* u0 = UT + (size_t)(bl * 512 + 2 * pr) * SEQ; const float* u1 = u0 + SEQ;
    bf16_t* g0 = GT + (size_t)(bl * 512 + 2 * pr) * SEQ; bf16_t* g1 = g0 + SEQ;
    {
        float f0[16], f1[16];
#pragma unroll
        for (int i = 0; i < 16; ++i) { f0[i] = u0[tid + NTHR * i]; f1[i] = u1[tid + NTHR * i]; }
#pragma unroll
        for (int i = 0; i < 16; ++i) {
            float2 u; u.x = f0[i]; u.y = f1[i]; d[tid + NTHR * i] = u;
        }
    }
    __syncthreads();
    fft_forward<true>(d, tw, (const float2*)(p.ws + OFF_TW));
#pragma unroll 1
    for (int h = tid; h < FN / 2; h += 4 * NTHR) {
        PwIn w0, w1, w2, w3;
        pw_load(w0, d, pq, 2 * h); pw_load(w1, d, pq, 2 * (h + NTHR)); pw_load(w2, d, pq, 2 * (h + 2 * NTHR)); pw_load(w3, d, pq, 2 * (h + 3 * NTHR));
        pw_store(w0, d); pw_store(w1, d); pw_store(w2, d); pw_store(w3, d);
    }
    if (tid == 0) conv_pointwise(d, pq, 1);
    __syncthreads();
    fft_inverse<true>(d, tw, (const float2*)(p.ws + OFF_TW));
    {
        bf16_t a0[16], a1[16];
#pragma unroll
        for (int i = 0; i < 16; ++i) { a0[i] = g0[tid + NTHR * i]; a1[i] = g1[tid + NTHR * i]; }
#pragma unroll
        for (int i = 0; i < 16; ++i) {
            const int t = tid + NTHR * i;
            const float2 y = d[t];
            const bf16_t r0 = f2bf_d(y.x * bf2f(a0[i])), r1 = f2bf_d(y.y * bf2f(a1[i]));
            if (!dry) { g0[t] = r0; g1[t] = r1; }
        }
    }
    __syncthreads();
}

__device__ __forceinline__ void na_item(const Params& p, int l, bf16_t* P, int bl, int rp, int head, unsigned char* lds, int dry = 0) {
    bf16_t* Kimg = (bf16_t*)lds;
    bf16_t* VT = (bf16_t*)(lds + 82944);
    int tid_ = threadIdx.x; asm volatile("" : "+v"(tid_)); const int tid = tid_, lane = tid & 63, w = tid >> 6, l15 = lane & 15, q4 = lane >> 4;
    const int r0 = 2 * rp, rs0 = iclamp(r0 - 4, 0, 120);
#pragma unroll
    for (int i = 0; i < 9; ++i) {
        const int idx = tid + NTHR * i, key = idx >> 3, ch = idx & 7, grow = min(rs0 + (key >> 6), 127);
        const u32x4 kv = *(const u32x4*)(P + (size_t)(bl * SEQ + grow * 64 + (key & 63)) * PS + C_NAK + head * 64 + ch * 8);
        *(u32x4*)(Kimg + key * 72 + ch * 8) = kv;
    }
#pragma unroll
    for (int i = 0; i < 9; ++i) {
        const int idx = tid + NTHR * i, keyp = idx >> 2, chh = keyp >= 576 ? 1 : 0, key = keyp - chh * 576, ch = chh * 4 + (idx & 3), grow = min(rs0 + (key >> 6), 127);
        const u32x4 vv = *(const u32x4*)(P + (size_t)(bl * SEQ + grow * 64 + (key & 63)) * PS + C_NAV + head * 64 + ch * 8);
        bf16_t* vd = VT + (ch * 8) * 584 + key;
        vd[0 * 584] = (bf16_t)(vv.x & 0xffffu); vd[1 * 584] = (bf16_t)(vv.x >> 16);
        vd[2 * 584] = (bf16_t)(vv.y & 0xffffu); vd[3 * 584] = (bf16_t)(vv.y >> 16);
        vd[4 * 584] = (bf16_t)(vv.z & 0xffffu); vd[5 * 584] = (bf16_t)(vv.z >> 16);
        vd[6 * 584] = (bf16_t)(vv.w & 0xffffu); vd[7 * 584] = (bf16_t)(vv.w >> 16);
    }
    __syncthreads();
    const int rr = w >> 2, g = w & 3, r = r0 + rr, rs = iclamp(r - 4, 0, 120), lo = rs - rs0;
    const int cb = iclamp(16 * g - 8, 0, 32), c = 16 * g + l15, cs = iclamp(c - 8, 0, 48);
    bf16_t* qrow = P + (size_t)(bl * SEQ + r * 64 + c) * PS + head * 64;
    bf16x8 qf[2];
#pragma unroll
    for (int ks = 0; ks < 2; ++ks) qf[ks] = *(const bf16x8*)(qrow + ks * 32 + q4 * 8);
    f32x4 sc[16];
#pragma unroll
    for (int t = 0; t < 16; ++t) {
        const int kb = (lo + (t >> 1)) * 64 + cb + 16 * (t & 1);
        f32x4 a = {0.f, 0.f, 0.f, 0.f};
#pragma unroll
        for (int ks = 0; ks < 2; ++ks) { const bf16x8 kf = *(const bf16x8*)(Kimg + (kb + l15) * 72 + ks * 32 + q4 * 8); a = MFMA(kf, qf[ks], a); }
        sc[t] = a;
    }
    const float* rpb = p.na_rpb + (size_t)(l * 8 + head) * 15 * 31;
    float mx = -1e30f;
#pragma unroll
    for (int t = 0; t < 16; ++t) {
        const int drow = rs + (t >> 1) - r + 7;
#pragma unroll
        for (int e = 0; e < 4; ++e) {
            const int col = cb + 16 * (t & 1) + 4 * q4 + e;
            const bool ok = (col >= cs) && (col < cs + 16);
            const int dcol = ok ? (col - c + 15) : 0;
            const float v = ok ? (sc[t][e] + rpb[drow * 31 + dcol]) : -1e30f;
            sc[t][e] = v; mx = fmaxf(mx, v);
        }
    }
    mx = fmaxf(mx, __shfl_xor(mx, 16)); mx = fmaxf(mx, __shfl_xor(mx, 32));
    float sum = 0.f;
#pragma unroll
    for (int t = 0; t < 16; ++t)
#pragma unroll
        for (int e = 0; e < 4; ++e) { const float pe = __expf(sc[t][e] - mx); sc[t][e] = pe; sum += pe; }
    sum += __shfl_xor(sum, 16); sum += __shfl_xor(sum, 32);
    f32x4 o[4];
#pragma unroll
    for (int dt = 0; dt < 4; ++dt) o[dt] = (f32x4){0.f, 0.f, 0.f, 0.f};
#pragma unroll
    for (int kk = 0; kk < 8; ++kk) {
        u32x4 pu; pu.x = pk2(sc[2 * kk][0], sc[2 * kk][1]); pu.y = pk2(sc[2 * kk][2], sc[2 * kk][3]); pu.z = pk2(sc[2 * kk + 1][0], sc[2 * kk + 1][1]); pu.w = pk2(sc[2 * kk + 1][2], sc[2 * kk + 1][3]);
        const bf16x8 pf = mkfrag(pu);
        const int kbA = (lo + kk) * 64 + cb + 4 * q4;
#pragma unroll
        for (int dt = 0; dt < 4; ++dt) {
            const bf16_t* vr = VT + (dt * 16 + l15) * 584 + kbA;
            const bf16x8 vf = mkfrag2(*(const u32x2*)vr, *(const u32x2*)(vr + 16));
            o[dt] = MFMA(vf, pf, o[dt]);
        }
    }
    const float inv = 1.0f / sum;
    const bf16_t* zrow = P + (size_t)(bl * SEQ + r * 64 + c) * PS + C_Z + head * 64;
#pragma unroll
    for (int dt = 0; dt < 4; ++dt) {
        const int dd = dt * 16 + 4 * q4;
        const f32x4 z = ld_bf4(zrow + dd);
        if (!dry) st_bf4(qrow + dd, o[dt] * inv * z);
    }
    __syncthreads();
}

__device__ __forceinline__ void memattn_load(const Params& p, int b, int h, unsigned char* lds) {
    bf16_t* Kimg = (bf16_t*)lds;
    bf16_t* VT = (bf16_t*)(lds + 69632);
    const bf16_t* Km = (const bf16_t*)(p.ws + OFF_KMAT); const bf16_t* Vm = (const bf16_t*)(p.ws + OFF_VT);
    int tid_ = threadIdx.x; asm volatile("" : "+v"(tid_)); const int tid = tid_;
#pragma unroll
    for (int i = 0; i < 8; ++i) {
        const int idx = tid + NTHR * i;
        { const int key = idx >> 4, ch = idx & 15; *(u32x4*)(Kimg + key * 136 + ch * 8) = *(const u32x4*)(Km + (size_t)(b * 256 + key) * 512 + h * 128 + ch * 8); }
        { const int dd = idx >> 5, ch = idx & 31; *(u32x4*)(VT + dd * 264 + ch * 8) = *(const u32x4*)(Vm + (size_t)(h * 128 + dd) * 2048 + b * 256 + ch * 8); }
    }
    __syncthreads();
}
__device__ __forceinline__ void memattn_item(bf16_t* P, int bl, int h, int qt, unsigned char* lds, int dry = 0) {
    const bf16_t* Kimg = (const bf16_t*)lds; const bf16_t* VT = (const bf16_t*)(lds + 69632);
    int tid_ = threadIdx.x; asm volatile("" : "+v"(tid_)); const int tid = tid_, lane = tid & 63, w = tid >> 6, l15 = lane & 15, q4 = lane >> 4;
    const int tok = bl * SEQ + qt * 128 + w * 16 + l15;
    bf16_t* qrow = P + (size_t)tok * PS + C_MQ + h * 128;
    bf16x8 qf[4];
#pragma unroll
    for (int ks = 0; ks < 4; ++ks) qf[ks] = *(const bf16x8*)(qrow + ks * 32 + q4 * 8);
    f32x4 sc[16];
    float mx = -1e30f;
#pragma unroll
    for (int t = 0; t < 16; ++t) {
        f32x4 a = {0.f, 0.f, 0.f, 0.f};
#pragma unroll
        for (int ks = 0; ks < 4; ++ks) { const bf16x8 kf = *(const bf16x8*)(Kimg + (t * 16 + l15) * 136 + ks * 32 + q4 * 8); a = MFMA(kf, qf[ks], a); }
        sc[t] = a;
        mx = fmaxf(mx, fmaxf(fmaxf(a[0], a[1]), fmaxf(a[2], a[3])));
    }
    mx = fmaxf(mx, __shfl_xor(mx, 16)); mx = fmaxf(mx, __shfl_xor(mx, 32));
    float sum = 0.f;
#pragma unroll
    for (int t = 0; t < 16; ++t)
#pragma unroll
        for (int e = 0; e < 4; ++e) { const float pe = __expf(sc[t][e] - mx); sc[t][e] = pe; sum += pe; }
    sum += __shfl_xor(sum, 16); sum += __shfl_xor(sum, 32);
    f32x4 o[8];
#pragma unroll
    for (int dt = 0; dt < 8; ++dt) o[dt] = (f32x4){0.f, 0.f, 0.f, 0.f};
#pragma unroll
    for (int kk = 0; kk < 8; ++kk) {
        u32x4 pu; pu.x = pk2(sc[2 * kk][0], sc[2 * kk][1]); pu.y = pk2(sc[2 * kk][2], sc[2 * kk][3]); pu.z = pk2(sc[2 * kk + 1][0], sc[2 * kk + 1][1]); pu.w = pk2(sc[2 * kk + 1][2], sc[2 * kk + 1][3]);
        const bf16x8 pf = mkfrag(pu);
#pragma unroll
        for (int dt = 0; dt < 8; ++dt) {
            const bf16_t* vr = VT + (dt * 16 + l15) * 264 + kk * 32 + 4 * q4;
            const bf16x8 vf = mkfrag2(*(const u32x2*)vr, *(const u32x2*)(vr + 16));
            o[dt] = MFMA(vf, pf, o[dt]);
        }
    }
    const float inv = 1.0f / sum;
    const bf16_t* zrow = P + (size_t)tok * PS + C_Z + 3 * 512 + h * 128;
#pragma unroll
    for (int dt = 0; dt < 8; ++dt) {
        const int dd = dt * 16 + 4 * q4;
        const f32x4 z = ld_bf4(zrow + dd);
        if (!dry) st_bf4(qrow + dd, o[dt] * inv * z);
    }
}

constexpr int G_LRT = 0, G_BF = 8192, G_BB = 24576, G_TOT = 40960, G_IMG = 45056;
__device__ __forceinline__ void gla_tables(const Params& p, int l, const float* LR, int t0, int h, unsigned char* lds) {
    float* LRT = (float*)(lds + G_LRT); float* BF = (float*)(lds + G_BF); float* BB = (float*)(lds + G_BB); float* TOT = (float*)(lds + G_TOT);
    int tid_ = threadIdx.x; asm volatile("" : "+v"(tid_)); const int tid = tid_;
    ((float4*)LRT)[tid] = ((const float4*)(LR + (size_t)t0 * 32))[tid];
    __syncthreads();
    const int dk = tid & 63, cgp = tid >> 6;
    float uf[16], ub[16];
#pragma unroll
    for (int r = 0; r < 16; ++r) { uf[r] = p.gla_up_f[(size_t)(l * 16 + r) * 256 + h * 64 + dk]; ub[r] = p.gla_up_b[(size_t)(l * 16 + r) * 256 + h * 64 + dk]; }
    const float bif = p.gla_bias_f[l * 256 + h * 64 + dk], bib = p.gla_bias_b[l * 256 + h * 64 + dk];
    float lf[8], lb[8];
#pragma unroll
    for (int i = 0; i < 8; ++i) {
        const int c = cgp * 8 + i; float sf = bif, sb = bib;
#pragma unroll
        for (int r = 0; r < 16; ++r) { sf += LRT[c * 32 + r] * uf[r]; sb += LRT[c * 32 + 16 + r] * ub[r]; }
        lf[i] = logsigf_(sf) * (1.0f / 16.0f); lb[i] = logsigf_(sb) * (1.0f / 16.0f);
    }
#pragma unroll
    for (int i = 1; i < 8; ++i) lf[i] += lf[i - 1];
#pragma unroll
    for (int i = 6; i >= 0; --i) lb[i] += lb[i + 1];
    TOT[cgp * 64 + dk] = lf[7]; TOT[512 + cgp * 64 + dk] = lb[0];
    __syncthreads();
    float of = 0.f, ob = 0.f;
#pragma unroll
    for (int g2 = 0; g2 < 8; ++g2) { if (g2 < cgp) of += TOT[g2 * 64 + dk]; if (g2 > cgp) ob += TOT[512 + g2 * 64 + dk]; }
#pragma unroll
    for (int i = 0; i < 8; ++i) { BF[(cgp * 8 + i) * 64 + dk] = lf[i] + of; BB[(cgp * 8 + i) * 64 + dk] = lb[i] + ob; }
    __syncthreads();
}
struct GlaPre { u32x4 vv[2]; bf16_t q[8], k[8]; };
__device__ __forceinline__ void gla_prefetch(GlaPre& g, const bf16_t* P, int t0, int h, int tid) {
#pragma unroll
    for (int i = 0; i < 2; ++i) { const int idx = tid + NTHR * i, chn = idx >> 6, c = idx & 63; g.vv[i] = *(const u32x4*)(P + (size_t)(t0 + c) * PS + C_GV + h * 128 + chn * 8); }
#pragma unroll
    for (int i = 0; i < 8; ++i) { const int idx = tid + NTHR * i, c = idx >> 6, dk = idx & 63; g.q[i] = P[(size_t)(t0 + c) * PS + C_GQ + h * 64 + dk]; g.k[i] = P[(size_t)(t0 + c) * PS + C_GK + h * 64 + dk]; }
}
__device__ __forceinline__ void gla_vt_store(const GlaPre& g, bf16_t* VT, int tid) {
#pragma unroll
    for (int i = 0; i < 2; ++i) {
        const int idx = tid + NTHR * i, chn = idx >> 6, c = idx & 63;
        const u32x4 vv = g.vv[i];
        bf16_t* vd = VT + (chn * 8) * 72 + c;
        vd[0 * 72] = (bf16_t)(vv.x & 0xffffu); vd[1 * 72] = (bf16_t)(vv.x >> 16);
        vd[2 * 72] = (bf16_t)(vv.y & 0xffffu); vd[3 * 72] = (bf16_t)(vv.y >> 16);
        vd[4 * 72] = (bf16_t)(vv.z & 0xffffu); vd[5 * 72] = (bf16_t)(vv.z >> 16);
        vd[6 * 72] = (bf16_t)(vv.w & 0xffffu); vd[7 * 72] = (bf16_t)(vv.w >> 16);
    }
}
__device__ __forceinline__ void gla_part1_item(const Params& p, int l, const bf16_t* P, const float* LR, int item, unsigned char* lds) {
    const int h = item & 3, n = (item >> 2) & 127, bl = item >> 9, t0 = bl * SEQ + n * 64;
    const float* BF = (const float*)(lds + G_BF); const float* BB = (const float*)(lds + G_BB);
    bf16_t* KDT0 = (bf16_t*)(lds + G_IMG); bf16_t* KDT1 = KDT0 + 64 * 72; bf16_t* VT = KDT1 + 64 * 72;
    float* GS = (float*)(p.ws + OFF_GS); float* GD = (float*)(p.ws + OFF_GDEC);
    int tid_ = threadIdx.x; asm volatile("" : "+v"(tid_)); const int tid = tid_, lane = tid & 63, w = tid >> 6, l15 = lane & 15, q4 = lane >> 4;
    GlaPre gp; gla_prefetch(gp, P, t0, h, tid);
    gla_tables(p, l, LR, t0, h, lds);
    {
        float4* tb = (float4*)((float*)(p.ws + OFF_TB) + (size_t)item * 8192); const float4* ts = (const float4*)(lds + G_BF);
#pragma unroll
        for (int i = 0; i < 4; ++i) tb[tid + NTHR * i] = ts[tid + NTHR * i];
    }
#pragma unroll
    for (int i = 0; i < 8; ++i) {
        const int idx = tid + NTHR * i, c = idx >> 6, dk = idx & 63;
        const float kv = bf2f(gp.k[i]);
        KDT0[dk * 72 + c] = f2bf_d(kv * __expf(BF[63 * 64 + dk] - BF[c * 64 + dk]));
        KDT1[dk * 72 + c] = f2bf_d(kv * __expf(BB[dk] - BB[c * 64 + dk]));
    }
    gla_vt_store(gp, VT, tid);
    if (tid < 64) GD[(size_t)item * 64 + tid] = __expf(BF[63 * 64 + tid]);
    else if (tid < 128) GD[(size_t)(NITEM + item) * 64 + tid - 64] = __expf(BB[tid - 64]);
    __syncthreads();
    const int dir = w >> 2, dkt = w & 3;
    const bf16_t* KD = dir ? KDT1 : KDT0;
    bf16x8 kf[2];
#pragma unroll
    for (int ks = 0; ks < 2; ++ks) kf[ks] = *(const bf16x8*)(KD + (16 * dkt + l15) * 72 + 32 * ks + 8 * q4);
    float* dst = GS + ((size_t)dir * NITEM + item) * 8192;
#pragma unroll
    for (int dvt = 0; dvt < 8; ++dvt) {
        f32x4 a = {0.f, 0.f, 0.f, 0.f};
#pragma unroll
        for (int ks = 0; ks < 2; ++ks) { const bf16x8 vf = *(const bf16x8*)(VT + (16 * dvt + l15) * 72 + 32 * ks + 8 * q4); a = MFMA(kf[ks], vf, a); }
        *(f32x4*)(dst + (16 * dvt + l15) * 64 + 16 * dkt + 4 * q4) = a;
    }
    __syncthreads();
}
__device__ __forceinline__ void gla_scan(const Params& p, int dry = 0) {
    float* GS = (float*)(p.ws + OFF_GS); const float* GD = (const float*)(p.ws + OFF_GDEC);
    const int total = 2 * BG * 4 * 8192;
    int tid_ = threadIdx.x; asm volatile("" : "+v"(tid_));
    for (int id = blockIdx.x * NTHR + tid_; id < total; id += gridDim.x * NTHR) {
        const int e = id & 8191, comb = id >> 13, h = comb & 3, bl = (comb >> 2) % BG, dir = comb / (4 * BG), dk = e & 63;
        float S = 0.f;
        const size_t ibase = (size_t)dir * NITEM + (size_t)(bl * 128) * 4 + h;
        for (int s0 = 0; s0 < 128; s0 += 16) {
            float u[16], dc[16];
#pragma unroll
            for (int i = 0; i < 16; ++i) {
                const int n = dir ? 127 - (s0 + i) : s0 + i;
                const size_t item = ibase + (size_t)n * 4;
                u[i] = GS[item * 8192 + e]; dc[i] = GD[item * 64 + dk];
            }
#pragma unroll
            for (int i = 0; i < 16; ++i) {
                const int n = dir ? 127 - (s0 + i) : s0 + i;
                const size_t item = ibase + (size_t)n * 4;
                if (!dry) GS[item * 8192 + e] = S;
                S = dc[i] * S + u[i];
            }
        }
    }
}
__device__ __forceinline__ void gla_part2_item(const Params& p, int l, bf16_t* P, const float* LR, int item, unsigned char* lds, int dry = 0) {
    const int h = item & 3, n = (item >> 2) & 127, bl = item >> 9, t0 = bl * SEQ + n * 64;
    const float* BF = (const float*)(lds + G_BF); const float* BB = (const float*)(lds + G_BB);
    bf16_t* QF = (bf16_t*)(lds + G_IMG);
    bf16_t* KF = QF + 2 * 64 * 72;
    bf16_t* QD = KF + 2 * 64 * 72;
    bf16_t* VT = QD + 2 * 64 * 72;
    bf16_t* ST = VT + 128 * 72;
    float* OX = (float*)lds;
    const float* GS = (const float*)(p.ws + OFF_GS);
    int tid_ = threadIdx.x; asm volatile("" : "+v"(tid_)); const int tid = tid_, lane = tid & 63, w = tid >> 6, l15 = lane & 15, q4 = lane >> 4;
    GlaPre gp; gla_prefetch(gp, P, t0, h, tid);
    float4 sp[2][4];
#pragma unroll
    for (int dir = 0; dir < 2; ++dir)
#pragma unroll
        for (int i = 0; i < 4; ++i) { const int idx = tid + NTHR * i; sp[dir][i] = *(const float4*)(GS + ((size_t)dir * NITEM + item) * 8192 + (idx >> 4) * 64 + (idx & 15) * 4); }
    {
        const float4* tb = (const float4*)((const float*)(p.ws + OFF_TB) + (size_t)item * 8192); float4* ts = (float4*)(lds + G_BF);
        float4 tv[4];
#pragma unroll
        for (int i = 0; i < 4; ++i) tv[i] = tb[tid + NTHR * i];
#pragma unroll
        for (int i = 0; i < 4; ++i) ts[tid + NTHR * i] = tv[i];
        __syncthreads();
    }
#pragma unroll
    for (int i = 0; i < 8; ++i) {
        const int idx = tid + NTHR * i, c = idx >> 6, dk = idx & 63;
        const float qv = bf2f(gp.q[i]);
        const float kv = bf2f(gp.k[i]);
        const float bf = BF[c * 64 + dk], mf = BF[31 * 64 + dk], bb = BB[c * 64 + dk], mb = BB[32 * 64 + dk];
        QF[c * 72 + dk] = f2bf_d(qv * __expf(bf - mf)); KF[c * 72 + dk] = f2bf_d(kv * __expf(mf - bf)); QD[c * 72 + dk] = f2bf_d(qv * __expf(bf));
        QF[4608 + c * 72 + dk] = f2bf_d(qv * __expf(bb - mb)); KF[4608 + c * 72 + dk] = f2bf_d(kv * __expf(mb - bb)); QD[4608 + c * 72 + dk] = f2bf_d(qv * __expf(bb));
    }
    gla_vt_store(gp, VT, tid);
#pragma unroll
    for (int dir = 0; dir < 2; ++dir) {
#pragma unroll
        for (int i = 0; i < 4; ++i) {
            const int idx = tid + NTHR * i, dv = idx >> 4, dk4 = (idx & 15) * 4;
            const float4 s = sp[dir][i];
            u32x2 o; o.x = pk2(s.x, s.y); o.y = pk2(s.z, s.w);
            *(u32x2*)(ST + dir * 9216 + dv * 72 + dk4) = o;
        }
    }
    __syncthreads();
    const int dir = w >> 2, ct = w & 3;
    const bf16_t* qfp = QF + dir * 4608; const bf16_t* kfp = KF + dir * 4608; const bf16_t* qdp = QD + dir * 4608; const bf16_t* stp = ST + dir * 9216;
    bf16x8 qf[2], qd[2];
#pragma unroll
    for (int ks = 0; ks < 2; ++ks) { qf[ks] = *(const bf16x8*)(qfp + (16 * ct + l15) * 72 + 32 * ks + 8 * q4); qd[ks] = *(const bf16x8*)(qdp + (16 * ct + l15) * 72 + 32 * ks + 8 * q4); }
    f32x4 sc[4];
    const int cq = 16 * ct + l15;
#pragma unroll
    for (int st = 0; st < 4; ++st) {
        f32x4 a = {0.f, 0.f, 0.f, 0.f};
#pragma unroll
        for (int ks = 0; ks < 2; ++ks) { const bf16x8 kf = *(const bf16x8*)(kfp + (16 * st + l15) * 72 + 32 * ks + 8 * q4); a = MFMA(kf, qf[ks], a); }
#pragma unroll
        for (int e = 0; e < 4; ++e) { const int s = 16 * st + 4 * q4 + e; const bool ok = dir ? (s > cq) : (s <= cq); a[e] = ok ? a[e] : 0.f; }
        sc[st] = a;
    }
    f32x4 o[8];
#pragma unroll
    for (int dt = 0; dt < 8; ++dt) o[dt] = (f32x4){0.f, 0.f, 0.f, 0.f};
#pragma unroll
    for (int kk = 0; kk < 2; ++kk) {
        u32x4 pu; pu.x = pk2(sc[2 * kk][0], sc[2 * kk][1]); pu.y = pk2(sc[2 * kk][2], sc[2 * kk][3]); pu.z = pk2(sc[2 * kk + 1][0], sc[2 * kk + 1][1]); pu.w = pk2(sc[2 * kk + 1][2], sc[2 * kk + 1][3]);
        const bf16x8 pf = mkfrag(pu);
#pragma unroll
        for (int dt = 0; dt < 8; ++dt) {
            const bf16_t* vr = VT + (dt * 16 + l15) * 72 + kk * 32 + 4 * q4;
            const bf16x8 vf = mkfrag2(*(const u32x2*)vr, *(const u32x2*)(vr + 16));
            o[dt] = MFMA(vf, pf, o[dt]);
        }
    }
#pragma unroll
    for (int ks = 0; ks < 2; ++ks)
#pragma unroll
        for (int dt = 0; dt < 8; ++dt) { const bf16x8 sf = *(const bf16x8*)(stp + (dt * 16 + l15) * 72 + 32 * ks + 8 * q4); o[dt] = MFMA(sf, qd[ks], o[dt]); }
    if (dir == 1) {
#pragma unroll
        for (int dt = 0; dt < 8; ++dt) *(f32x4*)(OX + cq * 132 + 16 * dt + 4 * q4) = o[dt];
    }
    __syncthreads();
    if (dir == 0) {
        float ss = 0.f;
#pragma unroll
        for (int dt = 0; dt < 8; ++dt) { o[dt] += *(const f32x4*)(OX + cq * 132 + 16 * dt + 4 * q4); ss += (o[dt][0] * o[dt][0] + o[dt][1] * o[dt][1]) + (o[dt][2] * o[dt][2] + o[dt][3] * o[dt][3]); }
        ss += __shfl_xor(ss, 16); ss += __shfl_xor(ss, 32);
        const float rms = 1.0f / sqrtf(ss * (1.0f / 128.0f) + 1e-6f);
        const float* ng = p.gla_norm_g + l * 512 + h * 128;
        const bf16_t* zrow = P + (size_t)(t0 + cq) * PS + C_Z + 2 * 512 + h * 128;
        bf16_t* orow = P + (size_t)(t0 + cq) * PS + C_GV + h * 128;
#pragma unroll
        for (int dt = 0; dt < 8; ++dt) {
            const int dd = 16 * dt + 4 * q4;
            const f32x4 z = ld_bf4(zrow + dd); const f32x4 g4 = *(const f32x4*)(ng + dd);
            if (!dry) st_bf4(orow + dd, o[dt] * rms * g4 * z);
        }
    }
    __syncthreads();
}

namespace pg8 {
#define PG8_LAS __attribute__((address_space(3)))
typedef unsigned short bf16_t;
typedef short bf16x8 __attribute__((ext_vector_type(8)));
typedef float f32x4 __attribute__((ext_vector_type(4)));
typedef unsigned u32x4 __attribute__((ext_vector_type(4)));
constexpr int BM = 256, BK = 64, HALF = 128, HTB = HALF * BK * 2  , STAGE_BYTES = 8 * HTB, NXCD = 8, WGM = 8;

__host__ __device__ __forceinline__ int lds_byte(int r, int c) { const int st = (r >> 4) * 2 + (c >> 5), rr = r & 15, cc = c & 31, ob = rr * 64 + cc * 2; return st * 1024 + (ob ^ (((ob >> 9) & 1) << 5)); }
__host__ __device__ __forceinline__ void stage_rc(int b, int& R, int& C) { const int st = b / 1024, sb = b % 1024, swz = sb ^ (((sb >> 9) & 1) << 5); R = (st >> 1) * 16 + swz / 64; C = (st & 1) * 32 + (swz % 64) / 2; }
__host__ __device__ __forceinline__ int perm32(int rho) { const int n = rho >> 4, i = rho & 15; return 8 * (i >> 2) + 4 * n + (i & 3); }

struct Unit { int pm, pn; };
struct Gemm { const bf16_t* A; const bf16_t* Bt; int M, N, K; };

struct StaticOrder {
    int nM, nN, nwg, G, c;
    __host__ __device__ __forceinline__ void init(int M, int N, int G_, int c_) { nM = M / BM; nN = N / BM; nwg = nM * nN; G = G_; c = c_; }
    __host__ __device__ bool next(int i, Unit& u) const {
        const long L = (long)i * G + c; if (L >= nwg) return false;
        int wgid = (int)L; { const int q = nwg / NXCD, r = nwg % NXCD, xcd = wgid % NXCD, off = wgid / NXCD; wgid = (xcd < r ? xcd * (q + 1) : r * (q + 1) + (xcd - r) * q) + off; }
        const int nig = WGM * nN, gid = wgid / nig, fm = gid * WGM, gsz = (nM - fm) < WGM ? (nM - fm) : WGM;
        u.pm = fm + ((wgid % nig) % gsz); u.pn = (wgid % nig) / gsz; return true;
    }
    __device__ __forceinline__ void a_ready(const Unit&) const {}
    __device__ __forceinline__ void done(const Unit&) const {}
};
__device__ __forceinline__ unsigned cvt_pk_bf16(float lo, float hi) { unsigned r; asm volatile("v_cvt_pk_bf16_f32 %0, %1, %2" : "=v"(r) : "v"(lo), "v"(hi)); return r; }
template <class Epi, class Sched, bool STAMP = false>
__device__ __forceinline__ void gemm_phase(PG8_LAS unsigned char* lds, const Gemm g, const Sched& S, const Epi& E, unsigned long long* stamps) {
    int tid_l = threadIdx.x; asm volatile("" : "+v"(tid_l)); const int tid = tid_l, wid = __builtin_amdgcn_readfirstlane(tid >> 6), lane = tid & 63, wr = wid >> 2, wc = wid & 3, fr = lane & 15, fq = lane >> 4;
    const int K = g.K, nt = K / BK;
    int ts_lo = 0, ts_hi = 0, nts = 0; const unsigned long long rt_entry = STAMP ? (unsigned long long)wall_clock64() : 0ull;
#define PG8_STAMP() do { if (STAMP && wid == 0 && nts < 64) { const unsigned long long _c = (unsigned long long)clock64(); \
        ts_lo = (lane == nts) ? (int)(unsigned)_c : ts_lo; ts_hi = (lane == nts) ? (int)(unsigned)(_c >> 32) : ts_hi; ++nts; } } while (0)
    PG8_STAMP();
    unsigned voffA[2], voffB[2];
#pragma unroll
    for (int i = 0; i < 2; ++i) { int R, C; stage_rc(tid * 16 + i * 8192, R, C); const int Rb = Epi::PERM ? ((R & ~31) + perm32(R & 31)) : R;
        voffA[i] = (unsigned)(R * K + C) * 2u; voffB[i] = (unsigned)(Rb * K + C) * 2u; }
    const size_t kstep = (size_t)(BK * 2);
    const size_t hstep = (size_t)HALF * K * 2;
    const size_t tstep = 2 * hstep;
    const unsigned ldsw = (unsigned)wid * 1024u;
    const int aoff = lds_byte(wr * 64 + fr, fq * 8), boff = lds_byte(wc * 32 + fr, fq * 8);
#define PG8_SA(b, h) (((b) * 2 + (h)) * HTB)
#define PG8_SB(b, h) ((4 + (b) * 2 + (h)) * HTB)
#define PG8_STAGE(bufoff, gbase, voff) do { _Pragma("unroll") for (int _i = 0; _i < 2; ++_i) \
        __builtin_amdgcn_global_load_lds((const unsigned*)((const char*)(gbase) + (voff)[_i]), (PG8_LAS unsigned*)(lds + (bufoff) + ldsw + _i * 8192), 16, 0, 0); } while (0)
#define PG8_LDA(dst, b, h) do { _Pragma("unroll") for (int m = 0; m < 4; ++m) _Pragma("unroll") for (int k = 0; k < 2; ++k) dst[m][k] = *(const PG8_LAS bf16x8*)(lds + PG8_SA(b, h) + aoff + m * 2048 + k * 1024); } while (0)
#define PG8_LDB(dst, b, h) do { _Pragma("unroll") for (int n = 0; n < 2; ++n) _Pragma("unroll") for (int k = 0; k < 2; ++k) dst[n][k] = *(const PG8_LAS bf16x8*)(lds + PG8_SB(b, h) + boff + n * 2048 + k * 1024); } while (0)
#define PG8_MMA(ai, bj, At, Bt) do { __builtin_amdgcn_s_setprio(1); _Pragma("unroll") for (int m = 0; m < 4; ++m) _Pragma("unroll") for (int n = 0; n < 2; ++n) _Pragma("unroll") for (int k = 0; k < 2; ++k) \
        acc[ai][bj][m][n] = __builtin_amdgcn_mfma_f32_16x16x32_bf16(Bt[n][k], At[m][k], acc[ai][bj][m][n], 0, 0, 0); __builtin_amdgcn_s_setprio(0); } while (0)
#define PG8_WAIT_V(n) asm volatile("s_waitcnt vmcnt(" #n ")" ::: "memory")
#define PG8_WAIT_L(n) asm volatile("s_waitcnt lgkmcnt(" #n ")" ::: "memory")
#define PG8_BAR __builtin_amdgcn_s_barrier()
#define PG8_SCHED __builtin_amdgcn_sched_barrier(0)
    Unit cur, nxt; int ui = 0;
    if (!S.next(0, cur)) return;
    f32x4 acc[2][2][4][2];
#pragma unroll
    for (int a = 0; a < 2; ++a)
#pragma unroll
        for (int b = 0; b < 2; ++b)
#pragma unroll
            for (int m = 0; m < 4; ++m)
#pragma unroll
                for (int n = 0; n < 2; ++n) acc[a][b][m][n] = (f32x4){0.f, 0.f, 0.f, 0.f};
    bf16x8 At[4][2], B0[2][2], B1[2][2];
    const char* cA = (const char*)g.A + (size_t)cur.pm * tstep; const char* cB = (const char*)g.Bt + (size_t)cur.pn * tstep;
    S.a_ready(cur);
    PG8_STAGE(PG8_SB(0, 0), cB, voffB); PG8_STAGE(PG8_SA(0, 0), cA, voffA); PG8_STAGE(PG8_SB(0, 1), cB + hstep, voffB); PG8_STAGE(PG8_SA(0, 1), cA + hstep, voffA);
    if (wr == 1) PG8_BAR;
    PG8_WAIT_V(4); PG8_BAR;
    PG8_STAGE(PG8_SB(1, 0), cB + kstep, voffB); PG8_STAGE(PG8_SA(1, 0), cA + kstep, voffA); PG8_STAGE(PG8_SB(1, 1), cB + hstep + kstep, voffB);
    PG8_WAIT_V(6); PG8_BAR;
    PG8_STAMP();
    for (;;) {
        const bool has_next = S.next(ui + 1, nxt);
        const char* nA = has_next ? (const char*)g.A + (size_t)nxt.pm * tstep : cA; const char* nB = has_next ? (const char*)g.Bt + (size_t)nxt.pn * tstep : cB;
        for (int t = 0; t < nt; t += 2) {
            const bool last = (t == nt - 2);
            const char* a1 = cA + (size_t)(t + 1) * kstep;
            const char* a2 = last ? nA : cA + (size_t)(t + 2) * kstep; const char* b2 = last ? nB : cB + (size_t)(t + 2) * kstep;
            const char* a3 = a2 + kstep; const char* b3 = b2 + kstep;
            if (last && has_next) S.a_ready(nxt);
            PG8_LDB(B0, 0, 0); PG8_SCHED; PG8_LDA(At, 0, 0); PG8_STAGE(PG8_SA(1, 1), a1 + hstep, voffA);
            PG8_WAIT_L(8); PG8_BAR; PG8_WAIT_L(0); PG8_MMA(0, 0, At, B0); PG8_BAR; PG8_SCHED;
            PG8_LDB(B1, 0, 1); PG8_STAGE(PG8_SB(0, 0), b2, voffB);
            PG8_BAR; PG8_WAIT_L(0); PG8_MMA(0, 1, At, B1); PG8_BAR;
            PG8_LDA(At, 0, 1); PG8_STAGE(PG8_SA(0, 0), a2, voffA);
            PG8_BAR; PG8_WAIT_L(0); PG8_MMA(1, 0, At, B0); PG8_BAR; PG8_SCHED;
            PG8_STAGE(PG8_SB(0, 1), b2 + hstep, voffB);
            PG8_WAIT_V(6); PG8_BAR; PG8_MMA(1, 1, At, B1); PG8_BAR;
            PG8_LDB(B0, 1, 0); PG8_SCHED; PG8_LDA(At, 1, 0); PG8_STAGE(PG8_SA(0, 1), a2 + hstep, voffA);
            PG8_WAIT_L(8); PG8_BAR; PG8_WAIT_L(0); PG8_MMA(0, 0, At, B0); PG8_BAR; PG8_SCHED;
            PG8_LDB(B1, 1, 1); PG8_STAGE(PG8_SB(1, 0), b3, voffB);
            PG8_BAR; PG8_WAIT_L(0); PG8_MMA(0, 1, At, B1); PG8_BAR;
            PG8_LDA(At, 1, 1); PG8_STAGE(PG8_SA(1, 0), a3, voffA);
            PG8_BAR; PG8_WAIT_L(0); PG8_MMA(1, 0, At, B0); PG8_BAR; PG8_SCHED;
            PG8_STAGE(PG8_SB(1, 1), b3 + hstep, voffB);
            PG8_WAIT_V(6); PG8_BAR; PG8_MMA(1, 1, At, B1); PG8_BAR;
        }
        PG8_STAMP();
        if constexpr (!Epi::AFTER_DRAIN) { E(acc, cur, wr, wc, fr, fq); S.done(cur); }
        PG8_STAMP();
        if (!has_next) break;
#pragma unroll
        for (int a = 0; a < 2; ++a)
#pragma unroll
            for (int b = 0; b < 2; ++b)
#pragma unroll
                for (int m = 0; m < 4; ++m)
#pragma unroll
                    for (int n = 0; n < 2; ++n) acc[a][b][m][n] = (f32x4){0.f, 0.f, 0.f, 0.f};
        cur = nxt; cA = nA; cB = nB; ++ui;
    }
    PG8_WAIT_V(0);
    if (wr == 0) PG8_BAR;
    PG8_BAR;
    if constexpr (Epi::AFTER_DRAIN) { E.fused(acc, cur, wr, wc, fr, fq, lds, wid, lane); S.done(cur); }
    PG8_STAMP();
    if (STAMP && wid == 0) { stamps[lane] = lane < nts ? (((unsigned long long)(unsigned)ts_hi << 32) | (unsigned)ts_lo) : 0ull;
        if (lane == 62) stamps[62] = rt_entry; if (lane == 63) stamps[63] = (unsigned long long)wall_clock64(); }
#undef PG8_STAMP
#undef PG8_SA
#undef PG8_SB
#undef PG8_STAGE
#undef PG8_LDA
#undef PG8_LDB
#undef PG8_MMA
#undef PG8_WAIT_V
#undef PG8_WAIT_L
#undef PG8_BAR
#undef PG8_SCHED
}
}

struct EpiInProj {
    static constexpr bool PERM = true, AFTER_DRAIN = false;
    bf16_t* P; const float* bias; float* LR;
    __device__ __forceinline__ void operator()(const f32x4 (&acc)[2][2][4][2], const pg8::Unit& u, int wr, int wc, int fr, int fq) const {
        const int row0 = u.pm * 256 + wr * 64 + fr, colt = u.pn * 256, col0 = colt + wc * 32 + 8 * fq;
        if (colt == C_LR) {
            if (wc == 0) {
                const int cl = 8 * fq;
                const f32x4 b0 = *(const f32x4*)(bias + 4096 + cl), b1 = *(const f32x4*)(bias + 4096 + cl + 4);
#pragma unroll
                for (int ai = 0; ai < 2; ++ai)
#pragma unroll
                    for (int m = 0; m < 4; ++m) {
                        float* d = LR + (size_t)(row0 + ai * 128 + m * 16) * 32 + cl;
                        *(f32x4*)d = acc[ai][0][m][0] + b0; *(f32x4*)(d + 4) = acc[ai][0][m][1] + b1;
                    }
            }
            return;
        }
        const int mode = (colt < 512 || colt == C_GQ) ? 1 : (colt >= C_MQ && colt < C_Z) ? 2 : (colt >= C_Z && colt < C_SG) ? 3 : (colt >= C_SG) ? 4 : 0;
#pragma unroll
        for (int bj = 0; bj < 2; ++bj) {
            const int col = col0 + bj * 128;
            const f32x4 b0 = *(const f32x4*)(bias + orig_col(col)), b1 = *(const f32x4*)(bias + orig_col(col) + 4);
#pragma unroll
            for (int ai = 0; ai < 2; ++ai)
#pragma unroll
                for (int m = 0; m < 4; ++m) {
                    f32x4 v0 = acc[ai][bj][m][0] + b0, v1 = acc[ai][bj][m][1] + b1;
                    if (mode == 1) { v0 *= 0.125f; v1 *= 0.125f; }
                    else if (mode == 2) { v0 *= 0.08838834764831845f; v1 *= 0.08838834764831845f; }
                    else if (mode == 3) {
#pragma unroll
                        for (int e = 0; e < 4; ++e) { v0[e] = siluf_(v0[e]); v1[e] = siluf_(v1[e]); }
                    } else if (mode == 4) {
#pragma unroll
                        for (int e = 0; e < 4; ++e) { v0[e] = sigmoidf_(v0[e]); v1[e] = sigmoidf_(v1[e]); }
                    }
                    u32x4 o; o.x = pk2(v0[0], v0[1]); o.y = pk2(v0[2], v0[3]); o.z = pk2(v1[0], v1[1]); o.w = pk2(v1[2], v1[3]);
                    *(u32x4*)(P + (size_t)(row0 + ai * 128 + m * 16) * PS + col) = o;
                }
        }
    }
};
struct EpiOut {
    static constexpr bool PERM = false, AFTER_DRAIN = false;
    bf16_t* pre; const float* bo;
    __device__ __forceinline__ void operator()(const f32x4 (&acc)[2][2][4][2], const pg8::Unit& u, int wr, int wc, int fr, int fq) const {
        const int row0 = u.pm * 256 + wr * 64 + fr, col0 = u.pn * 256 + wc * 32 + 4 * fq;
#pragma unroll
        for (int bj = 0; bj < 2; ++bj)
#pragma unroll
            for (int n = 0; n < 2; ++n) {
                const int col = col0 + bj * 128 + n * 16;
                const f32x4 b4 = *(const f32x4*)(bo + col);
#pragma unroll
                for (int ai = 0; ai < 2; ++ai)
#pragma unroll
                    for (int m = 0; m < 4; ++m) st_bf4(pre + (size_t)(row0 + ai * 128 + m * 16) * 1024 + col, acc[ai][bj][m][n] + b4);
            }
    }
};

__device__ __forceinline__ void ln_rows_res(const Params& p, int l, size_t tok0) {
    int tid_ = threadIdx.x; asm volatile("" : "+v"(tid_));
    const int lane = tid_ & 63;
    const int gw = blockIdx.x * (NTHR / 64) + (tid_ >> 6), nw = gridDim.x * (NTHR / 64);
    const bf16_t* pre = (const bf16_t*)(p.ws + OFF_PRE); const float2* stats = (const float2*)(p.ws + OFF_STATS); bf16_t* hb = (bf16_t*)(p.ws + OFF_HB);
    const float* g = p.ln_g + l * 1024; const float* b = p.ln_b + l * 1024;
    for (int r = gw; r < TG; r += nw) {
        const size_t T = tok0 + r;
        const bf16_t* pr = pre + (size_t)r * 1024;
        float4 v[4]; float s = 0.f;
        if (l == 0) {
            const float4* xr = (const float4*)(p.x + T * 1024); const float2 st = stats[T];
#pragma unroll
            for (int i = 0; i < 4; ++i) {
                const f32x4 a4 = ld_bf4(pr + (lane + 64 * i) * 4); float4 a; a.x = a4[0]; a.y = a4[1]; a.z = a4[2]; a.w = a4[3]; const float4 x4 = xr[lane + 64 * i], g4 = ((const float4*)p.ln_in_g)[lane + 64 * i], b4 = ((const float4*)p.ln_in_b)[lane + 64 * i];
                v[i].x = a.x + DN_ALPHA * ((x4.x - st.x) * st.y * g4.x + b4.x); v[i].y = a.y + DN_ALPHA * ((x4.y - st.x) * st.y * g4.y + b4.y);
                v[i].z = a.z + DN_ALPHA * ((x4.z - st.x) * st.y * g4.z + b4.z); v[i].w = a.w + DN_ALPHA * ((x4.w - st.x) * st.y * g4.w + b4.w);
            }
        } else {
            const float4* hr = (const float4*)(p.out + T * 1024);
#pragma unroll
            for (int i = 0; i < 4; ++i) {
                const f32x4 a4 = ld_bf4(pr + (lane + 64 * i) * 4); float4 a; a.x = a4[0]; a.y = a4[1]; a.z = a4[2]; a.w = a4[3]; const float4 h4 = hr[lane + 64 * i];
                v[i].x = a.x + DN_ALPHA * h4.x; v[i].y = a.y + DN_ALPHA * h4.y; v[i].z = a.z + DN_ALPHA * h4.z; v[i].w = a.w + DN_ALPHA * h4.w;
            }
        }
#pragma unroll
        for (int i = 0; i < 4; ++i) s += (v[i].x + v[i].y) + (v[i].z + v[i].w);
        s = wave_sum(s);
        const float mean = s * (1.0f / 1024.0f);
        float q = 0.f;
#pragma unroll
        for (int i = 0; i < 4; ++i) { const float a = v[i].x - mean, bb = v[i].y - mean, c = v[i].z - mean, d = v[i].w - mean; q += (a * a + bb * bb) + (c * c + d * d); }
        q = wave_sum(q);
        const float rstd = 1.0f / sqrtf(q * (1.0f / 1024.0f) + 1e-5f);
#pragma unroll
        for (int i = 0; i < 4; ++i) {
            const float4 g4 = ((const float4*)g)[lane + 64 * i], b4 = ((const float4*)b)[lane + 64 * i];
            float4 y; y.x = (v[i].x - mean) * rstd * g4.x + b4.x; y.y = (v[i].y - mean) * rstd * g4.y + b4.y; y.z = (v[i].z - mean) * rstd * g4.z + b4.z; y.w = (v[i].w - mean) * rstd * g4.w + b4.w;
            ((float4*)(p.out + T * 1024))[lane + 64 * i] = y;
            u32x2 o; o.x = pk2(y.x, y.y); o.y = pk2(y.z, y.w); *(u32x2*)(hb + T * 1024 + (lane + 64 * i) * 4) = o;
        }
    }
}

#define XB_TMO      128
#define XB_XCNT(j)  (256  + 64 * (j))
#define XB_XSUB(j)  (1280 + 64 * (j))
#define XB_XGEN(j)  (2304 + 64 * (j))
#define XB_TOP      3328
#define XB_TOPGEN   3392
#define XCD_BAR_WORDS 3456
#define XB_SPIN_CAP (1u << 18)
#define LAS __attribute__((address_space(3)))

__device__ __forceinline__ unsigned xb_ld(unsigned* p)              { return __hip_atomic_load(p, __ATOMIC_RELAXED, __HIP_MEMORY_SCOPE_AGENT); }
__device__ __forceinline__ unsigned xb_add(unsigned* p, unsigned v) { return __hip_atomic_fetch_add(p, v, __ATOMIC_RELAXED, __HIP_MEMORY_SCOPE_AGENT); }
__device__ __forceinline__ unsigned xb_xcc_id() { return (unsigned)__builtin_amdgcn_s_getreg((3 << 11) | 20) & 0xFu; }
#define XB_SPIN(cond, bar) do { unsigned _sp = 0; while (cond) { __builtin_amdgcn_s_sleep(1); \
    if ((++_sp & 255u) == 0u) { if (xb_ld(&(bar)[XB_TMO])) break; if (_sp > XB_SPIN_CAP) { atomicAdd(&(bar)[XB_TMO], 1u); break; } } } } while (0)

struct XcdBarrier {
    unsigned* bar; unsigned x;
    volatile LAS unsigned* st;
};

__device__ __forceinline__ XcdBarrier xcd_barrier_post(unsigned* bar, volatile LAS unsigned* st) {
    XcdBarrier b; b.bar = bar; b.x = xb_xcc_id(); b.st = st;
    if (threadIdx.x == 0) (void)xb_add(&bar[XB_XCNT(b.x)], 1u);
    return b;
}
__device__ __forceinline__ void xcd_barrier_complete(unsigned* bar, unsigned x, unsigned& nloc, unsigned& nx) {
    const unsigned G = gridDim.x * gridDim.y * gridDim.z;
    unsigned sum, cnt, mine, sp = 0u;
    for (;;) {
        sum = 0u; cnt = 0u; mine = 0u;
#pragma unroll
        for (unsigned j = 0; j < 16; ++j) { const unsigned c = xb_ld(&bar[XB_XCNT(j)]); sum += c; cnt += (c > 0u) ? 1u : 0u; mine = (j == x) ? c : mine; }
        if (sum == G) break;
        __builtin_amdgcn_s_sleep(1);
        if ((++sp & 255u) == 0u) { if (xb_ld(&bar[XB_TMO])) break; if (sp > XB_SPIN_CAP) { atomicAdd(&bar[XB_TMO], 1u); break; } }
    }
    nloc = mine > 0u ? mine : 1u; nx = cnt > 0u ? cnt : 1u;
}

__device__ __forceinline__ void xcd_barrier(unsigned* b_bar, unsigned b_x, volatile LAS unsigned* b_st) {
    asm volatile("s_waitcnt vmcnt(0)" ::: "memory");
    __syncthreads();
    if (threadIdx.x == 0) {
        unsigned* bar = b_bar;
        __builtin_amdgcn_s_waitcnt(0);
        unsigned nloc = b_st[0], nx = b_st[1];
        if (nloc == 0u) { xcd_barrier_complete(bar, b_x, nloc, nx); b_st[0] = nloc; b_st[1] = nx; }
        const unsigned old = xb_add(&bar[XB_XSUB(b_x)], 1u);
        const unsigned gen = old / nloc;
        if (old + 1u == (gen + 1u) * nloc) {
            __builtin_amdgcn_fence(__ATOMIC_RELEASE, "agent");
            asm volatile("s_waitcnt vmcnt(0)" ::: "memory");
            const unsigned og = xb_add(&bar[XB_TOP], 1u);
            const unsigned tg = og / nx;
            if (og + 1u == (tg + 1u) * nx) xb_add(&bar[XB_TOPGEN], 1u);
            else XB_SPIN(xb_ld(&bar[XB_TOPGEN]) == tg, bar);
            __builtin_amdgcn_fence(__ATOMIC_ACQUIRE, "agent");
            xb_add(&bar[XB_XGEN(b_x)], 1u);
            asm volatile("s_waitcnt vmcnt(0)" ::: "memory");
        } else {
            XB_SPIN(xb_ld(&bar[XB_XGEN(b_x)]) == gen, bar);
            __builtin_amdgcn_fence(__ATOMIC_ACQUIRE, "agent");
            asm volatile("s_waitcnt vmcnt(0)" ::: "memory");
        }
    }
    __syncthreads();
}

__device__ __forceinline__ void gbar(unsigned* ctr, unsigned& gen, int G) {
    __syncthreads();
    gen += (unsigned)G;
    if (threadIdx.x == 0) {
        __threadfence();
        __hip_atomic_fetch_add(ctr, 1u, __ATOMIC_RELAXED, __HIP_MEMORY_SCOPE_AGENT);
        while (__hip_atomic_load(ctr, __ATOMIC_RELAXED, __HIP_MEMORY_SCOPE_AGENT) < gen) __builtin_amdgcn_s_sleep(1);
        __threadfence();
    }
    __syncthreads();
}
typedef const Params __attribute__((address_space(4))) KParams;
#define KP4 __attribute__((address_space(4)))
__device__ __forceinline__ Params fresh_params() {
#if defined(__HIP_DEVICE_COMPILE__)
    KParams* kp = (KParams*)__builtin_amdgcn_kernarg_segment_ptr();
    asm volatile("" : "+s"(kp));
    Params r;
    const float* KP4 const* src = (const float* KP4 const*)kp;
    const float** dst = (const float**)&r;
#pragma unroll
    for (int i = 0; i < 28; ++i) dst[i] = src[i];
    return r;
#else
    return Params{};
#endif
}
__global__ void __launch_bounds__(NTHR) mega(Params p_unused) {
    extern __shared__ __attribute__((aligned(16))) unsigned char lds[];
    cg::grid_group grid = cg::this_grid();
    const int G = gridDim.x, bid = blockIdx.x;
    volatile LAS unsigned* xst = (volatile LAS unsigned*)((LAS unsigned char*)lds + (LDS_BYTES - 16));
    if (threadIdx.x == 0) { xst[0] = 0u; xst[1] = 0u; }
    __syncthreads();
    unsigned* xbar; unsigned xx;
    { const Params p = fresh_params(); xbar = (unsigned*)(p.ws + OFF_BAR); xx = xb_xcc_id(); if (threadIdx.x == 0) (void)xb_add(&xbar[XB_XCNT(xx)], 1u); }
    { const Params p = fresh_params(); phase0(p); }
    grid.sync();
#pragma unroll 1
    for (int l = 0; l < 2; ++l) {
        { const Params p = fresh_params(); phase_weights(p, l, lds); __syncthreads(); phase_filter_gen(p, l, lds); }
        xcd_barrier(xbar, xx, xst);
        {
            const Params p = fresh_params();
            phase_filter_fft(p, l, lds);
            const bf16_t* WtKV = (const bf16_t*)(p.ws + OFF_WTKV); const bf16_t* membf = (const bf16_t*)(p.ws + OFF_MEMBF);
            for (int t = bid; t < 64; t += G) {
                f32x4 acc[4][4];
                if (t < 32) {
                    const int m0 = (t >> 2) * 256, n0 = (t & 3) * 128;
                    gemm_core(acc, membf + (size_t)m0 * 1024, 1024, WtKV + (size_t)n0 * 1024, 1024, 1024, lds);
                    bf16_t* Km = (bf16_t*)(p.ws + OFF_KMAT);
                    EPI_LOOP(st_bf4(Km + (size_t)row * 512 + col, v);)
                } else {
                    const int t2 = t - 32, m0 = (t2 >> 4) * 256, n0 = (t2 & 15) * 128;
                    gemm_core(acc, WtKV + (size_t)(512 + m0) * 1024, 1024, membf + (size_t)n0 * 1024, 1024, 1024, lds);
                    bf16_t* Vm = (bf16_t*)(p.ws + OFF_VT);
                    EPI_LOOP(st_bf4(Vm + (size_t)row * 2048 + col, v);)
                }
            }
        }
        xcd_barrier(xbar, xx, xst);
#pragma unroll 1
        for (int g = 0; g < NGRP; ++g) {
            const size_t tok0 = (size_t)g * TG;
#pragma unroll 1
            for (int rep = 0; rep < PROBE_REP_INPROJ; ++rep) {
                const Params p = fresh_params();
                pg8::Gemm gm; gm.A = (const bf16_t*)(p.ws + OFF_HB) + tok0 * 1024; gm.Bt = (const bf16_t*)(p.ws + OFF_WTIN); gm.M = TG; gm.N = NINP; gm.K = 1024;
                pg8::StaticOrder S; S.init(TG, NINP, G, bid);
                EpiInProj E; E.P = (bf16_t*)(p.ws + OFF_P); E.bias = p.b_in + (size_t)l * NIN; E.LR = (float*)(p.ws + OFF_LR);
                pg8::gemm_phase<EpiInProj, pg8::StaticOrder, false>((PG8_LAS unsigned char*)lds, gm, S, E, nullptr);
                __syncthreads();
            }
            xcd_barrier(xbar, xx, xst);
#pragma unroll 1
            for (int rep = 0; rep < PROBE_REP_MIX; ++rep) {
            int dry = (rep + 1 < PROBE_REP_MIX) ? 1 : 0; asm volatile("" : "+s"(dry));
            {
                const Params p = fresh_params();
                bf16_t* P = (bf16_t*)(p.ws + OFF_P);
                for (int it = bid; it < BG * 64 * 8; it += G) na_item(p, l, P, it >> 9, (it >> 3) & 63, it & 7, lds, dry);
            }
            {
                const Params p = fresh_params();
                bf16_t* P = (bf16_t*)(p.ws + OFF_P);
                for (int it = bid; it < BG * 128 * 8; it += G) hy_pre_item(p, l, P, (float*)(p.ws + OFF_UT), (bf16_t*)(p.ws + OFF_GT), it >> 10, (it >> 3) & 127, it & 7, lds);
            }
            {
                const Params p = fresh_params();
                for (int it = bid; it < NITEM; it += G) gla_part1_item(p, l, (const bf16_t*)(p.ws + OFF_P), (const float*)(p.ws + OFF_LR), it, lds);
            }
            {
                const Params p = fresh_params();
                bf16_t* P = (bf16_t*)(p.ws + OFF_P);
                const int nit = BG * 4 * 64, per = (nit + G - 1) / G;
                int last = -1;
                for (int it = bid * per; it < min(nit, (bid + 1) * per); ++it) {
                    const int bh = it >> 6, bl = bh >> 2, h = bh & 3;
                    if (bh != last) { __syncthreads(); memattn_load(p, g * BG + bl, h, lds); last = bh; }
                    memattn_item(P, bl, h, it & 63, lds, dry);
                }
                __syncthreads();
            }
            xcd_barrier(xbar, xx, xst);
            {
                const Params p = fresh_params();
                const float2* twl = fft_lds_twiddles((const float2*)(p.ws + OFF_TW), lds);
                for (int it = bid; it < BG * 256; it += G) hyena_conv_item(p, (const float*)(p.ws + OFF_UT), (bf16_t*)(p.ws + OFF_GT), it >> 8, it & 255, lds, twl, dry);
                __syncthreads();
                gla_scan(p, dry);
            }
            xcd_barrier(xbar, xx, xst);
            {
                const Params p = fresh_params();
                for (int it = bid; it < NITEM; it += G) gla_part2_item(p, l, (bf16_t*)(p.ws + OFF_P), (const float*)(p.ws + OFF_LR), it, lds, dry);
            }
            {
                const Params p = fresh_params();
                for (int it = bid; it < BG * 128 * 8; it += G) hy_post_item((bf16_t*)(p.ws + OFF_P), (const bf16_t*)(p.ws + OFF_GT), it >> 10, (it >> 3) & 127, it & 7, lds, dry);
            }
            xcd_barrier(xbar, xx, xst);
            }
            {
                const Params p = fresh_params();
                const bf16_t* P = (const bf16_t*)(p.ws + OFF_P); const bf16_t* WtBr = (const bf16_t*)(p.ws + OFF_WTBR); bf16_t* merged = (bf16_t*)(p.ws + OFF_MERGED);
                for (int t = bid; t < 512; t += G) {
                    const int sr = t >> 8, sb = t & 255, sx = sb & 7, sk = sb >> 3;
                    const int m0 = (sr * 32 + (sk >> 3) * 8 + sx) * 256, n0 = (sk & 7) * 128;
                    merge_tile(P, WtBr, merged, m0, n0, lds);
                }
            }
            xcd_barrier(xbar, xx, xst);
            {
                const Params p = fresh_params();
                pg8::Gemm gm; gm.A = (const bf16_t*)(p.ws + OFF_MERGED); gm.Bt = (const bf16_t*)(p.ws + OFF_WTOUT); gm.M = TG; gm.N = 1024; gm.K = 1024;
                pg8::StaticOrder S; S.init(TG, 1024, G, bid);
                EpiOut E; E.pre = (bf16_t*)(p.ws + OFF_PRE); E.bo = p.b_out + l * 1024;
                pg8::gemm_phase<EpiOut, pg8::StaticOrder, false>((PG8_LAS unsigned char*)lds, gm, S, E, nullptr);
                __syncthreads();
            }
            xcd_barrier(xbar, xx, xst);
            {
                const Params p = fresh_params();
                ln_rows_res(p, l, tok0);
            }
        }
        xcd_barrier(xbar, xx, xst);
    }
}

extern "C" void kernel_launch(void* const* d_in, const int* in_sizes, int n_in, void* d_out, int out_size, void* d_ws, size_t ws_size, hipStream_t stream) {
    static int grid_blocks = 0;
    if (!grid_blocks) {
        if (ws_size < WS_END) { fprintf(stderr, "kernel_launch: workspace too small: %zu < %zu\n", ws_size, (size_t)WS_END); grid_blocks = -1; return; }
        {
            const long long ex[26] = {67108864LL, 2097152LL, 1024, 1024, 2LL * 1024 * 10784, 2 * 10784, 2 * 8 * 15 * 31, 2 * 3 * 1536, 2 * 1536, 2 * 33 * 64, 2 * 64, 2 * 2 * 64 * 64, 2 * 2 * 64,
                                      2 * 64 * 1024, 2 * 512, 2 * 16 * 256, 2 * 256, 2 * 16 * 256, 2 * 256, 2 * 512, 2LL * 1024 * 1024, 2LL * 4 * 512 * 1024, 2LL * 1024 * 1024, 2 * 1024, 2 * 1024, 2 * 1024};
            bool bad = (n_in != 26) || (out_size != 67108864);
            for (int i = 0; i < 26 && !bad; ++i) if ((long long)in_sizes[i] != ex[i]) { fprintf(stderr, "kernel_launch: input %d has %d elements, expected %lld\n", i, in_sizes[i], ex[i]); bad = true; }
            if (bad) { fprintf(stderr, "kernel_launch: unexpected shapes; nothing launched\n"); grid_blocks = -1; return; }
        }
        int dev = 0, cus = 0, per_cu = 0;
        hipGetDevice(&dev);
        hipDeviceGetAttribute(&cus, hipDeviceAttributeMultiprocessorCount, dev);
        if (hipFuncSetAttribute((const void*)mega, hipFuncAttributeMaxDynamicSharedMemorySize, LDS_BYTES) != hipSuccess) fprintf(stderr, "kernel_launch: hipFuncSetAttribute failed\n");
        if (hipOccupancyMaxActiveBlocksPerMultiprocessor(&per_cu, (const void*)mega, NTHR, LDS_BYTES) != hipSuccess || per_cu < 1) { fprintf(stderr, "kernel_launch: occupancy query gave %d\n", per_cu); per_cu = 1; }
        (void)hipGetLastError();
        if (per_cu > 1) per_cu = 1;
        grid_blocks = cus * per_cu;
    }
    if (grid_blocks < 0) return;
    Params p{};
    const float** pp = (const float**)&p;
    for (int i = 0; i < 26; ++i) pp[i] = (const float*)d_in[i];
    p.out = (float*)d_out; p.ws = (unsigned char*)d_ws;
    if (hipMemsetAsync((unsigned char*)d_ws + OFF_BAR, 0, 16384, stream) != hipSuccess) fprintf(stderr, "kernel_launch: memset of the barrier word failed\n");
    void* args[] = {&p};
    hipError_t e = hipLaunchCooperativeKernel((const void*)mega, dim3(grid_blocks), dim3(NTHR), args, LDS_BYTES, stream);
    if (e != hipSuccess) fprintf(stderr, "cooperative launch failed: %s (grid %d)\n", hipGetErrorString(e), grid_blocks);
}
#endif
```

```cpp
#ifndef PROBE_REP_MIX
#define PROBE_REP_MIX 1
#endif
#ifndef PROBE_REP_INPROJ
#define PROBE_REP_INPROJ 1
#endif
#include <hip/hip_runtime.h>
#include <hip/hip_cooperative_groups.h>
#include <cstdio>
#include <unistd.h>
#include <cmath>
namespace cg = cooperative_groups;

#define HD __host__ __device__
typedef unsigned short bf16_t;
typedef short bf16x8 __attribute__((ext_vector_type(8)));
typedef float f32x4 __attribute__((ext_vector_type(4)));
typedef unsigned u32x2 __attribute__((ext_vector_type(2)));
typedef unsigned u32x4 __attribute__((ext_vector_type(4)));

constexpr int NTOK = 65536, DM = 1024, SEQ = 8192, NB = 8;
constexpr int BG = 2;
constexpr int NGRP = NB / BG;
constexpr int TG = BG * SEQ;
constexpr int PS = 10752;
constexpr int NIN = 10784, NINP = 11008;
constexpr int C_NAQ = 0, C_NAK = 512, C_NAV = 1024, C_HY = 1536, C_GQ = 3072, C_GK = 3328, C_GV = 3584, C_MQ = 4096, C_Z = 4608, C_SG = 6656, C_LR = 10752;
constexpr int FN = 16384;
constexpr int NITEM = BG * 128 * 4;
constexpr int LDS_BYTES = 160 * 1024;
constexpr int NTHR = 512;
constexpr float DN_ALPHA = 1.41421356237309515f;

constexpr size_t al256(size_t x) { return (x + 255) & ~(size_t)255; }
constexpr size_t OFF_HB = 0;
constexpr size_t OFF_STATS = OFF_HB + (size_t)NTOK * DM * 2;
constexpr size_t OFF_TW = OFF_STATS + (size_t)NTOK * 8;
constexpr size_t OFF_MEMBF = OFF_TW + (size_t)FN * 8;
constexpr size_t OFF_ENERGY = OFF_MEMBF + (size_t)2048 * 1024 * 2;
constexpr size_t OFF_WTIN = OFF_ENERGY + 4096;
constexpr size_t OFF_WTBR = OFF_WTIN + (size_t)NINP * 1024 * 2;
constexpr size_t OFF_WTOUT = OFF_WTBR + (size_t)4 * 1024 * 512 * 2;
constexpr size_t OFF_WTKV = OFF_WTOUT + (size_t)1024 * 1024 * 2;
constexpr size_t OFF_KMAT = OFF_WTKV + (size_t)2048 * 1024 * 2;
constexpr size_t OFF_VT = OFF_KMAT + (size_t)2048 * 1024 * 2;
constexpr size_t OFF_HFILT = OFF_VT + (size_t)2048 * 1024 * 2;
constexpr size_t OFF_PQ = OFF_HFILT + (size_t)1024 * 8192 * 4;
constexpr size_t OFF_P = OFF_PQ + (size_t)256 * FN * 16;
constexpr size_t OFF_LR = OFF_P + (size_t)TG * PS * 2;
constexpr size_t OFF_GS = OFF_LR + (size_t)TG * 32 * 4;
constexpr size_t OFF_GDEC = OFF_GS + (size_t)2 * NITEM * 8192 * 4;
constexpr size_t OFF_MERGED = OFF_GDEC + (size_t)2 * NITEM * 64 * 4;
constexpr size_t OFF_PRE = OFF_MERGED + (size_t)TG * 1024 * 2;
constexpr size_t OFF_UT = OFF_PRE + (size_t)TG * 1024 * 4;
constexpr size_t OFF_GT = OFF_UT + (size_t)BG * 512 * 8192 * 4;
constexpr size_t OFF_BAR = OFF_GT + (size_t)BG * 512 * 8192 * 2;
constexpr size_t OFF_ZT = OFF_BAR + 16384;
constexpr size_t OFF_TB = al256(OFF_ZT + (size_t)8192 * 33 * 4);
constexpr size_t OFF_SB = OFF_TB + (size_t)NITEM * 8192 * 4;
constexpr size_t WS_END = OFF_SB + (size_t)2 * NITEM * 8192 * 2;

struct Params {
    const float *x, *mem, *ln_in_g, *ln_in_b, *w_in, *b_in, *na_rpb, *hy_conv_w, *hy_conv_b, *hy_w1, *hy_b1, *hy_wm, *hy_bm, *hy_w3, *hy_skip,
        *gla_up_f, *gla_bias_f, *gla_up_b, *gla_bias_b, *gla_norm_g, *mem_w_kv, *w_br, *w_out, *b_out, *ln_g, *ln_b;
    float* out;
    unsigned char* ws;
};

HD inline float bf2f(bf16_t b) {
    union { unsigned u; float f; } c; c.u = (unsigned)b << 16; return c.f;
}
HD inline bf16_t f2bf(float f) {
    union { unsigned u; float f; } c; c.f = f; unsigned u = c.u; u += 0x7fffu + ((u >> 16) & 1u); return (bf16_t)(u >> 16);
}
typedef float f32x2_t __attribute__((ext_vector_type(2)));
typedef __bf16 bf16x2_t __attribute__((ext_vector_type(2)));
__device__ __forceinline__ unsigned pk2(float lo, float hi) { const f32x2_t v = {lo, hi}; const bf16x2_t b = __builtin_convertvector(v, bf16x2_t); return __builtin_bit_cast(unsigned, b); }
__device__ __forceinline__ bf16_t f2bf_d(float f) { return (bf16_t)(pk2(f, f) & 0xffffu); }
__device__ __forceinline__ float lo16(unsigned u) { return __uint_as_float(u << 16); }
__device__ __forceinline__ float hi16(unsigned u) { return __uint_as_float(u & 0xffff0000u); }
__device__ __forceinline__ float wave_sum(float v) {
#pragma unroll
    for (int o = 32; o >= 1; o >>= 1) v += __shfl_xor(v, o);
    return v;
}
__device__ __forceinline__ float sigmoidf_(float x) { return __builtin_amdgcn_rcpf(1.0f + __expf(-x)); }
__device__ __forceinline__ float siluf_(float x) { return x * __builtin_amdgcn_rcpf(1.0f + __expf(-x)); }
__device__ __forceinline__ float logsigf_(float x) { return fminf(x, 0.0f) - __logf(1.0f + __expf(-fabsf(x))); }
__device__ __forceinline__ bf16x8 mkfrag(u32x4 v) { return __builtin_bit_cast(bf16x8, v); }
__device__ __forceinline__ bf16x8 mkfrag2(u32x2 a, u32x2 b) { u32x4 v = {a.x, a.y, b.x, b.y}; return __builtin_bit_cast(bf16x8, v); }
#define MFMA(a, b, c) __builtin_amdgcn_mfma_f32_16x16x32_bf16((a), (b), (c), 0, 0, 0)
HD inline int iclamp(int v, int lo, int hi) { return v < lo ? lo : (v > hi ? hi : v); }

HD inline float2 cmulf(float2 a, float2 b) { float2 r; r.x = a.x * b.x - a.y * b.y; r.y = a.x * b.y + a.y * b.x; return r; }
HD inline float2 cmulcf(float2 a, float2 b) { float2 r; r.x = a.x * b.x + a.y * b.y; r.y = a.y * b.x - a.x * b.y; return r; }
struct Bfly { float2 x0, x1, x2, x3, W1; int i0; };
HD inline void bfly_load(Bfly& b, const float2* d, const float2* tw, int lgm, int q) {
    const int m = 1 << lgm, blk = q >> lgm, j = q & (m - 1);
    b.i0 = (blk << (lgm + 2)) + j;
    b.W1 = tw[j];
    b.x0 = d[b.i0]; b.x1 = d[b.i0 + m]; b.x2 = d[b.i0 + 2 * m]; b.x3 = d[b.i0 + 3 * m];
}
HD inline void bfly_fwd_store(const Bfly& b, float2* d, int lgm) {
    const int m = 1 << lgm, i0 = b.i0;
    const float2 W1 = b.W1, W2 = cmulf(W1, W1);
    const float2 x0 = b.x0, x1 = b.x1, x2 = b.x2, x3 = b.x3;
    float2 a0, a1, a2, a3, t;
    a0.x = x0.x + x2.x; a0.y = x0.y + x2.y;
    t.x = x0.x - x2.x; t.y = x0.y - x2.y; a2 = cmulf(t, W1);
    a1.x = x1.x + x3.x; a1.y = x1.y + x3.y;
    t.x = x1.x - x3.x; t.y = x1.y - x3.y; t = cmulf(t, W1); a3.x = t.y; a3.y = -t.x;
    float2 r;
    r.x = a0.x + a1.x; r.y = a0.y + a1.y; d[i0] = r;
    t.x = a0.x - a1.x; t.y = a0.y - a1.y; d[i0 + m] = cmulf(t, W2);
    r.x = a2.x + a3.x; r.y = a2.y + a3.y; d[i0 + 2 * m] = r;
    t.x = a2.x - a3.x; t.y = a2.y - a3.y; d[i0 + 3 * m] = cmulf(t, W2);
}
HD inline void bfly_inv_store(const Bfly& b, float2* d, int lgm) {
    const int m = 1 << lgm, i0 = b.i0;
    const float2 W1 = b.W1, W2 = cmulf(W1, W1);
    const float2 x0 = b.x0, x1 = b.x1, x2 = b.x2, x3 = b.x3;
    const float2 b1 = cmulcf(x1, W2), b3 = cmulcf(x3, W2);
    float2 y0, y1, y2, y3;
    y0.x = x0.x + b1.x; y0.y = x0.y + b1.y; y1.x = x0.x - b1.x; y1.y = x0.y - b1.y;
    y2.x = x2.x + b3.x; y2.y = x2.y + b3.y; y3.x = x2.x - b3.x; y3.y = x2.y - b3.y;
    const float2 c2 = cmulcf(y2, W1); float2 c3 = cmulcf(y3, W1); { const float tx = -c3.y, ty = c3.x; c3.x = tx; c3.y = ty; }
    float2 r;
    r.x = y0.x + c2.x; r.y = y0.y + c2.y; d[i0] = r;
    r.x = y0.x - c2.x; r.y = y0.y - c2.y; d[i0 + 2 * m] = r;
    r.x = y1.x + c3.x; r.y = y1.y + c3.y; d[i0 + m] = r;
    r.x = y1.x - c3.x; r.y = y1.y - c3.y; d[i0 + 3 * m] = r;
}
HD inline void fft_fwd_bfly(float2* d, const float2* tw, int lgm, int q) { Bfly b; bfly_load(b, d, tw, lgm, q); bfly_fwd_store(b, d, lgm); }
HD inline void fft_inv_bfly(float2* d, const float2* tw, int lgm, int q) { Bfly b; bfly_load(b, d, tw, lgm, q); bfly_inv_store(b, d, lgm); }
HD inline void r4_fwd(float2& x0, float2& x1, float2& x2, float2& x3, const float2 W1) {
    const float2 W2 = cmulf(W1, W1);
    float2 a0, a1, a2, a3, t;
    a0.x = x0.x + x2.x; a0.y = x0.y + x2.y;
    t.x = x0.x - x2.x; t.y = x0.y - x2.y; a2 = cmulf(t, W1);
    a1.x = x1.x + x3.x; a1.y = x1.y + x3.y;
    t.x = x1.x - x3.x; t.y = x1.y - x3.y; t = cmulf(t, W1); a3.x = t.y; a3.y = -t.x;
    x0.x = a0.x + a1.x; x0.y = a0.y + a1.y;
    t.x = a0.x - a1.x; t.y = a0.y - a1.y; x1 = cmulf(t, W2);
    x2.x = a2.x + a3.x; x2.y = a2.y + a3.y;
    t.x = a2.x - a3.x; t.y = a2.y - a3.y; x3 = cmulf(t, W2);
}
HD inline void r4_inv(float2& x0, float2& x1, float2& x2, float2& x3, const float2 W1) {
    const float2 W2 = cmulf(W1, W1);
    const float2 b1 = cmulcf(x1, W2), b3 = cmulcf(x3, W2);
    float2 y0, y1, y2, y3;
    y0.x = x0.x + b1.x; y0.y = x0.y + b1.y; y1.x = x0.x - b1.x; y1.y = x0.y - b1.y;
    y2.x = x2.x + b3.x; y2.y = x2.y + b3.y; y3.x = x2.x - b3.x; y3.y = x2.y - b3.y;
    const float2 c2 = cmulcf(y2, W1); float2 c3 = cmulcf(y3, W1); { const float tx = -c3.y, ty = c3.x; c3.x = tx; c3.y = ty; }
    x0.x = y0.x + c2.x; x0.y = y0.y + c2.y; x2.x = y0.x - c2.x; x2.y = y0.y - c2.y;
    x1.x = y1.x + c3.x; x1.y = y1.y + c3.y; x3.x = y1.x - c3.x; x3.y = y1.y - c3.y;
}
template <bool INV, bool HALF>
HD inline void r16_bfly(float2* d, const float2* twO, const float2* twI, int lgm, int q) {
    const int m = 1 << lgm, blk = q >> lgm, j = q & (m - 1), base = (blk << (lgm + 4)) + j;
    float2 e[4][4];
#pragma unroll
    for (int a = 0; a < 4; ++a)
#pragma unroll
        for (int b = 0; b < 4; ++b) {
            if (!INV && HALF && a >= 2) { e[a][b].x = 0.f; e[a][b].y = 0.f; }
            else e[a][b] = d[base + ((4 * a + b) << lgm)];
        }
    const float2 wI = twI[j];
    float2 wO[4];
#pragma unroll
    for (int b = 0; b < 4; ++b) wO[b] = twO[j + (b << lgm)];
    if (!INV) {
#pragma unroll
        for (int b = 0; b < 4; ++b) r4_fwd(e[0][b], e[1][b], e[2][b], e[3][b], wO[b]);
#pragma unroll
        for (int a = 0; a < 4; ++a) r4_fwd(e[a][0], e[a][1], e[a][2], e[a][3], wI);
    } else {
#pragma unroll
        for (int a = 0; a < 4; ++a) r4_inv(e[a][0], e[a][1], e[a][2], e[a][3], wI);
#pragma unroll
        for (int b = 0; b < 4; ++b) r4_inv(e[0][b], e[1][b], e[2][b], e[3][b], wO[b]);
    }
#pragma unroll
    for (int a = 0; a < 4; ++a)
#pragma unroll
        for (int b = 0; b < 4; ++b)
            if (!(INV && HALF && a >= 2)) d[base + ((4 * a + b) << lgm)] = e[a][b];
}
HD inline int brev14(int k) {
#if defined(__HIP_DEVICE_COMPILE__)
    return (int)(__brev((unsigned)k) >> 18);
#endif
    unsigned v = (unsigned)k;
    v = ((v >> 1) & 0x55555555u) | ((v & 0x55555555u) << 1);
    v = ((v >> 2) & 0x33333333u) | ((v & 0x33333333u) << 2);
    v = ((v >> 4) & 0x0f0f0f0fu) | ((v & 0x0f0f0f0fu) << 4);
    v = ((v >> 8) & 0x00ff00ffu) | ((v & 0x00ff00ffu) << 8);
    v = (v >> 16) | (v << 16);
    return (int)(v >> 18);
}
struct PwIn { float2 Z1, Z2; float4 A, B; int p1, p2; };
HD inline void pw_load(PwIn& w, const float2* d, const float4* pq, int p1) {
    const int kf = brev14(p1), k2 = (FN - kf) & (FN - 1); w.p1 = p1; w.p2 = brev14(k2);
    w.Z1 = d[w.p1]; w.Z2 = d[w.p2]; w.A = pq[w.p1]; w.B.x = w.A.x; w.B.y = -w.A.y; w.B.z = w.A.z; w.B.w = -w.A.w;
}
HD inline void pw_store(const PwIn& w, float2* d) {
    const float2 Z1 = w.Z1, Z2 = w.Z2;
    float2 P1, Q1, P2, Q2; P1.x = w.A.x; P1.y = w.A.y; Q1.x = w.A.z; Q1.y = w.A.w; P2.x = w.B.x; P2.y = w.B.y; Q2.x = w.B.z; Q2.y = w.B.w;
    float2 c1, c2; c1.x = Z1.x; c1.y = -Z1.y; c2.x = Z2.x; c2.y = -Z2.y;
    const float2 a = cmulf(Z1, P1), b = cmulf(c2, Q1), c = cmulf(Z2, P2), e = cmulf(c1, Q2);
    float2 w1, w2; w1.x = a.x + b.x; w1.y = a.y + b.y; w2.x = c.x + e.x; w2.y = c.y + e.y;
    d[w.p1] = w1;
    if (w.p2 != w.p1) d[w.p2] = w2;
}
HD inline void conv_pointwise(float2* d, const float4* pq, int p1) { PwIn w; pw_load(w, d, pq, p1); pw_store(w, d); }
HD inline void filt_pointwise(const float2* d, float4* pq, int p1) {
    const int kf = brev14(p1), k2 = (FN - kf) & (FN - 1), p2 = brev14(k2);
    const float2 Z1 = d[p1], Z2 = d[p2];
    const float gcx = 0.5f * (Z1.x + Z2.x), gcy = 0.5f * (Z1.y - Z2.y);
    const float gdx = 0.5f * (Z1.y + Z2.y), gdy = -0.5f * (Z1.x - Z2.x);
    const float s = 0.5f / (float)FN;
    float4 A; A.x = s * (gcx + gdx); A.y = s * (gcy + gdy); A.z = s * (gcx - gdx); A.w = s * (gcy - gdy);
    pq[p1] = A;
}
HD inline int tw_off(int lgm) { return lgm == 10 ? 0 : lgm == 8 ? 1024 : lgm == 6 ? 1280 : lgm == 4 ? 1344 : lgm == 2 ? 1360 : 1364; }
#ifndef FFT_HOST_TEST
template <int LGM, bool INV>
__device__ __forceinline__ void fft_pass(float2* d, const float2* twl, const float2* twg, int tid) {
    const float2* tw = (LGM == 12) ? twg : twl + tw_off(LGM);
#pragma unroll
    for (int it = 0; it < 2; ++it) {
        const int q = tid + it * 4 * NTHR;
        Bfly b0, b1, b2, b3;
        bfly_load(b0, d, tw, LGM, q); bfly_load(b1, d, tw, LGM, q + NTHR); bfly_load(b2, d, tw, LGM, q + 2 * NTHR); bfly_load(b3, d, tw, LGM, q + 3 * NTHR);
        if (INV) { bfly_inv_store(b0, d, LGM); bfly_inv_store(b1, d, LGM); bfly_inv_store(b2, d, LGM); bfly_inv_store(b3, d, LGM); }
        else { bfly_fwd_store(b0, d, LGM); bfly_fwd_store(b1, d, LGM); bfly_fwd_store(b2, d, LGM); bfly_fwd_store(b3, d, LGM); }
    }
    __syncthreads();
}
template <int LGM, bool INV, bool HALF>
__device__ __forceinline__ void fft_pass16(float2* d, const float2* twl, const float2* twg, int tid) {
    const float2* twO = (LGM + 2 == 12) ? twg : twl + tw_off(LGM + 2);
    const float2* twI = twl + tw_off(LGM);
    r16_bfly<INV, HALF>(d, twO, twI, LGM, tid);
    r16_bfly<INV, HALF>(d, twO, twI, LGM, tid + NTHR);
    __syncthreads();
}
template <bool HALF>
__device__ __forceinline__ void fft_forward(float2* d, const float2* twl, const float2* twg) {
    int tid = threadIdx.x; asm volatile("" : "+v"(tid));
    fft_pass16<10, false, HALF>(d, twl, twg, tid); fft_pass16<6, false, false>(d, twl, twg, tid);
    fft_pass<4, false>(d, twl, twg, tid); fft_pass<2, false>(d, twl, twg, tid); fft_pass<0, false>(d, twl, twg, tid);
}
template <bool HALF>
__device__ __forceinline__ void fft_inverse(float2* d, const float2* twl, const float2* twg) {
    int tid = threadIdx.x; asm volatile("" : "+v"(tid));
    fft_pass<0, true>(d, twl, twg, tid); fft_pass<2, true>(d, twl, twg, tid); fft_pass<4, true>(d, twl, twg, tid);
    fft_pass16<6, true, false>(d, twl, twg, tid); fft_pass16<10, true, HALF>(d, twl, twg, tid);
}
__device__ __forceinline__ float2* fft_lds_twiddles(const float2* twg, unsigned char* lds) {
    int tid = threadIdx.x; asm volatile("" : "+v"(tid));
    float2* t = (float2*)(lds + 131072);
    for (int k = tid; k < 1365; k += NTHR) {
        const int lgm = k < 1024 ? 10 : k < 1280 ? 8 : k < 1344 ? 6 : k < 1360 ? 4 : k < 1364 ? 2 : 0;
        t[k] = twg[(k - tw_off(lgm)) << (12 - lgm)];
    }
    __syncthreads();
    return t;
}

constexpr int STG = 49152;
__device__ __forceinline__ int swz(int row, int ch) { return row * 128 + ((ch ^ ((row >> 1) & 7)) << 4); }
__device__ __forceinline__ void gemm_core(f32x4 (&acc)[4][4], const bf16_t* A, int lda, const bf16_t* Bt, int ldb, int K, unsigned char* lds) {
    int tid_ = threadIdx.x; asm volatile("" : "+v"(tid_)); const int tid = tid_, lane = tid & 63, w = tid >> 6, wm = w & 3, wn = w >> 2, l15 = lane & 15, q4 = lane >> 4;
    const int wu = __builtin_amdgcn_readfirstlane(w);
    __attribute__((address_space(3))) unsigned char* l3 = (__attribute__((address_space(3))) unsigned char*)lds;
#pragma unroll
    for (int mi = 0; mi < 4; ++mi)
#pragma unroll
        for (int ni = 0; ni < 4; ++ni) acc[mi][ni] = (f32x4){0.f, 0.f, 0.f, 0.f};
    const int r8 = lane >> 3, sch = (lane & 7) ^ ((((w & 1) << 2) + (r8 >> 1)) & 7);
    const bf16_t* ap = A + (size_t)(w * 8 + r8) * lda + sch * 8;
    const bf16_t* bp = Bt + (size_t)(w * 8 + r8) * ldb + sch * 8;
#define GC_STAGE(buf, k0)                                                                                                                         \
    {                                                                                                                                             \
        _Pragma("unroll") for (int i = 0; i < 4; ++i)                                                                                             \
            __builtin_amdgcn_global_load_lds((const unsigned*)(ap + (size_t)(64 * i) * lda + (k0)), (__attribute__((address_space(3))) unsigned*)(l3 + (buf) * STG + (wu + 8 * i) * 1024), 16, 0, 0);          \
        _Pragma("unroll") for (int i = 0; i < 2; ++i)                                                                                             \
            __builtin_amdgcn_global_load_lds((const unsigned*)(bp + (size_t)(64 * i) * ldb + (k0)), (__attribute__((address_space(3))) unsigned*)(l3 + (buf) * STG + 32768 + (wu + 8 * i) * 1024), 16, 0, 0);  \
    }
    GC_STAGE(0, 0)
    asm volatile("s_waitcnt vmcnt(0)" ::: "memory");
    __syncthreads();
    const int nk = K >> 6;
    for (int kt = 0; kt < nk; ++kt) {
        if (kt + 1 < nk) GC_STAGE((kt + 1) & 1, (kt + 1) << 6)
        const unsigned char* sa = lds + (kt & 1) * STG;
        const unsigned char* sb = sa + 32768;
#pragma unroll
        for (int ks = 0; ks < 2; ++ks) {
            bf16x8 af[4], bfr[4];
#pragma unroll
            for (int mi = 0; mi < 4; ++mi) af[mi] = *(const bf16x8*)(sa + swz(wm * 64 + mi * 16 + l15, ks * 4 + q4));
#pragma unroll
            for (int ni = 0; ni < 4; ++ni) bfr[ni] = *(const bf16x8*)(sb + swz(wn * 64 + ni * 16 + l15, ks * 4 + q4));
#pragma unroll
            for (int mi = 0; mi < 4; ++mi)
#pragma unroll
                for (int ni = 0; ni < 4; ++ni) acc[mi][ni] = MFMA(bfr[ni], af[mi], acc[mi][ni]);
        }
        asm volatile("s_waitcnt vmcnt(0)" ::: "memory");
        __syncthreads();
    }
#undef GC_STAGE
}
#define EPI_LOOP(body)                                                                                                  \
    {                                                                                                                   \
        int e_t = threadIdx.x; asm volatile("" : "+v"(e_t)); const int e_lane = e_t & 63, e_w = e_t >> 6;                                                    \
        _Pragma("unroll") for (int mi = 0; mi < 4; ++mi) _Pragma("unroll") for (int ni = 0; ni < 4; ++ni) {             \
            const int row = m0 + (e_w & 3) * 64 + mi * 16 + (e_lane & 15);                                              \
            const int col = n0 + (e_w >> 2) * 64 + ni * 16 + 4 * (e_lane >> 4);                                         \
            f32x4& v = acc[mi][ni];                                                                                     \
            body                                                                                                        \
        }                                                                                                               \
    }
__device__ __forceinline__ void st_bf4(bf16_t* dst, f32x4 v) {
    u32x2 o; o.x = pk2(v[0], v[1]); o.y = pk2(v[2], v[3]); *(u32x2*)dst = o;
}
__device__ __forceinline__ f32x4 ld_bf4(const bf16_t* src) {
    const u32x2 u = *(const u32x2*)src; f32x4 r = {lo16(u.x), hi16(u.x), lo16(u.y), hi16(u.y)}; return r;
}


__device__ __forceinline__ void merge_tile(const bf16_t* P, const bf16_t* WtBr, bf16_t* merged, int m0, int n0, unsigned char* lds) {
    int tid_ = threadIdx.x; asm volatile("" : "+v"(tid_)); const int tid = tid_, lane = tid & 63, w = tid >> 6, wm = w & 3, wn = w >> 2, l15 = lane & 15, q4 = lane >> 4;
    const int wu = __builtin_amdgcn_readfirstlane(w);
    __attribute__((address_space(3))) unsigned char* l3 = (__attribute__((address_space(3))) unsigned char*)lds;
    f32x4 acc[4][4], macc[4][4];
#pragma unroll
    for (int mi = 0; mi < 4; ++mi)
#pragma unroll
        for (int ni = 0; ni < 4; ++ni) { acc[mi][ni] = (f32x4){0.f, 0.f, 0.f, 0.f}; macc[mi][ni] = (f32x4){0.f, 0.f, 0.f, 0.f}; }
    const int r8 = lane >> 3, sch = (lane & 7) ^ ((((w & 1) << 2) + (r8 >> 1)) & 7);
    const bf16_t* ap = P + (size_t)(m0 + w * 8 + r8) * PS + sch * 8;
    const bf16_t* bp = WtBr + (size_t)(n0 + w * 8 + r8) * 512 + sch * 8;
    const bf16_t* sgp = P + (size_t)(m0 + wm * 64 + l15) * PS + C_SG + n0 + wn * 64 + 4 * q4;
#define MG_STAGE(buf, kt_)                                                                                                                        \
    {                                                                                                                                             \
        const int j_ = (kt_) >> 3, k0_ = ((kt_) & 7) << 6;                                                                                        \
        const int acol_ = (j_ == 0) ? C_NAQ : (j_ == 1) ? C_HY : (j_ == 2) ? C_GV : C_MQ;                                                        \
        _Pragma("unroll") for (int i = 0; i < 4; ++i)                                                                                             \
            __builtin_amdgcn_global_load_lds((const unsigned*)(ap + (size_t)(64 * i) * PS + acol_ + k0_), (__attribute__((address_space(3))) unsigned*)(l3 + (buf) * STG + (wu + 8 * i) * 1024), 16, 0, 0);      \
        _Pragma("unroll") for (int i = 0; i < 2; ++i)                                                                                             \
            __builtin_amdgcn_global_load_lds((const unsigned*)(bp + (size_t)j_ * 1024 * 512 + (size_t)(64 * i) * 512 + k0_), (__attribute__((address_space(3))) unsigned*)(l3 + (buf) * STG + 32768 + (wu + 8 * i) * 1024), 16, 0, 0);  \
    }
    MG_STAGE(0, 0)
    MG_STAGE(1, 1)
    asm volatile("s_waitcnt vmcnt(6)" ::: "memory");
    __builtin_amdgcn_s_barrier(); asm volatile("" ::: "memory");
    int cb = 0;
#pragma unroll 1
    for (int kt = 0; kt < 32; ++kt) {
        const bool last = (kt & 7) == 7;
        u32x2 sg[4][4];
        if (last) {
            const bf16_t* sp = sgp + 1024 * (kt >> 3);
#pragma unroll
            for (int mi = 0; mi < 4; ++mi)
#pragma unroll
                for (int ni = 0; ni < 4; ++ni) sg[mi][ni] = *(const u32x2*)(sp + (size_t)(mi * 16) * PS + ni * 16);
        }
        const int nb = (cb == 0) ? 2 : cb - 1;
        if (kt + 2 < 32) MG_STAGE(nb, kt + 2)
        const unsigned char* sa = lds + cb * STG;
        const unsigned char* sb = sa + 32768;
#pragma unroll
        for (int ks = 0; ks < 2; ++ks) {
            bf16x8 af[4], bfr[4];
#pragma unroll
            for (int mi = 0; mi < 4; ++mi) af[mi] = *(const bf16x8*)(sa + swz(wm * 64 + mi * 16 + l15, ks * 4 + q4));
#pragma unroll
            for (int ni = 0; ni < 4; ++ni) bfr[ni] = *(const bf16x8*)(sb + swz(wn * 64 + ni * 16 + l15, ks * 4 + q4));
            __builtin_amdgcn_s_setprio(1);
#pragma unroll
            for (int mi = 0; mi < 4; ++mi)
#pragma unroll
                for (int ni = 0; ni < 4; ++ni) acc[mi][ni] = MFMA(bfr[ni], af[mi], acc[mi][ni]);
            __builtin_amdgcn_s_setprio(0);
        }
        if (kt + 2 < 32) asm volatile("s_waitcnt vmcnt(6)" ::: "memory"); else asm volatile("s_waitcnt vmcnt(0)" ::: "memory");
        if (last) {
#pragma unroll
            for (int mi = 0; mi < 4; ++mi)
#pragma unroll
                for (int ni = 0; ni < 4; ++ni) {
                    const u32x2 u = sg[mi][ni]; const f32x4 g4 = {lo16(u.x), hi16(u.x), lo16(u.y), hi16(u.y)};
                    macc[mi][ni] += g4 * acc[mi][ni]; acc[mi][ni] = (f32x4){0.f, 0.f, 0.f, 0.f};
                }
        }
        asm volatile("" ::: "memory"); __builtin_amdgcn_s_barrier(); asm volatile("" ::: "memory");
        cb = (cb == 2) ? 0 : cb + 1;
    }
#undef MG_STAGE
    __syncthreads();
#pragma unroll
    for (int mi = 0; mi < 4; ++mi)
#pragma unroll
        for (int ni = 0; ni < 4; ++ni) st_bf4(merged + (size_t)(m0 + wm * 64 + mi * 16 + l15) * 1024 + n0 + wn * 64 + ni * 16 + 4 * q4, macc[mi][ni]);
}

__device__ __forceinline__ int orig_col(int n) {
    if (n < 4096) return n;
    if (n < 4608) return n + 32;
    if (n < 6656) return n + 32;
    if (n < 10752) return n + 32;
    return n - 10752 + 4096;
}

__device__ __forceinline__ void ln_rows(const float* src, size_t src_row0, int nrows, const float* g, const float* b, float* dst32, bf16_t* dst16, size_t dst_row0, float2* stats) {
    int tid_ = threadIdx.x; asm volatile("" : "+v"(tid_));
    const int lane = tid_ & 63;
    const int gw = blockIdx.x * (NTHR / 64) + (tid_ >> 6), nw = gridDim.x * (NTHR / 64);
    for (int r = gw; r < nrows; r += nw) {
        const float4* xr = (const float4*)(src + (src_row0 + r) * 1024);
        float4 v[4]; float s = 0.f;
#pragma unroll
        for (int i = 0; i < 4; ++i) { v[i] = xr[lane + 64 * i]; s += (v[i].x + v[i].y) + (v[i].z + v[i].w); }
        s = wave_sum(s);
        const float mean = s * (1.0f / 1024.0f);
        float q = 0.f;
#pragma unroll
        for (int i = 0; i < 4; ++i) { const float a = v[i].x - mean, bb = v[i].y - mean, c = v[i].z - mean, d = v[i].w - mean; q += (a * a + bb * bb) + (c * c + d * d); }
        q = wave_sum(q);
        const float rstd = 1.0f / sqrtf(q * (1.0f / 1024.0f) + 1e-5f);
        if (stats && lane == 0) { float2 st; st.x = mean; st.y = rstd; stats[dst_row0 + r] = st; }
#pragma unroll
        for (int i = 0; i < 4; ++i) {
            const float4 g4 = ((const float4*)g)[lane + 64 * i], b4 = ((const float4*)b)[lane + 64 * i];
            float4 y; y.x = (v[i].x - mean) * rstd * g4.x + b4.x; y.y = (v[i].y - mean) * rstd * g4.y + b4.y; y.z = (v[i].z - mean) * rstd * g4.z + b4.z; y.w = (v[i].w - mean) * rstd * g4.w + b4.w;
            if (dst32) ((float4*)(dst32 + (dst_row0 + r) * 1024))[lane + 64 * i] = y;
            if (dst16) { u32x2 o; o.x = pk2(y.x, y.y); o.y = pk2(y.z, y.w); *(u32x2*)(dst16 + (dst_row0 + r) * 1024 + (lane + 64 * i) * 4) = o; }
        }
    }
}
__device__ __forceinline__ void phase0(const Params& p) {
    ln_rows(p.x, 0, NTOK, p.ln_in_g, p.ln_in_b, nullptr, (bf16_t*)(p.ws + OFF_HB), 0, (float2*)(p.ws + OFF_STATS));
    int tid_ = threadIdx.x; asm volatile("" : "+v"(tid_)); const int gt = blockIdx.x * NTHR + tid_, nt = gridDim.x * NTHR;
    float2* tw = (float2*)(p.ws + OFF_TW);
    for (int k = gt; k < FN; k += nt) { double s, c; sincospi(-2.0 * (double)k / (double)FN, &s, &c); float2 t; t.x = (float)c; t.y = (float)s; tw[k] = t; }
    bf16_t* mb = (bf16_t*)(p.ws + OFF_MEMBF);
    for (int i = gt; i < 2048 * 1024 / 4; i += nt) { const float4 v = ((const float4*)p.mem)[i]; u32x2 o; o.x = pk2(v.x, v.y); o.y = pk2(v.z, v.w); ((u32x2*)mb)[i] = o; }
    float* en = (float*)(p.ws + OFF_ENERGY);
    for (int i = gt; i < 1024; i += nt) en[i] = 0.f;
    float* ztab = (float*)(p.ws + OFF_ZT);
    for (int idx = gt; idx < 8192 * 33; idx += nt) {
        const int n = idx / 33, e = idx - n * 33;
        float v;
        if (e == 0) v = (float)n / 8191.0f;
        else {
            const int i = (e - 1) & 15;
            const double fr = 1e-4 + (double)i * ((15.0 - 1e-4) / 15.0);
            const double ang = (2.0 * 3.14159265358979323846 / 8192.0) * (double)n * fr;
            v = (e <= 16) ? (float)cos(ang) : (float)(-sin(ang));
        }
        ztab[idx] = v;
    }
}

__device__ __forceinline__ void wt_tile(const float* src, int src_ld, int k0, int on0, bf16_t* dst, int dst_ld, int dn0, bool zero, float* tile) {
    int tid_ = threadIdx.x; asm volatile("" : "+v"(tid_)); const int tid = tid_;
    if (!zero) {
#pragma unroll
        for (int i = 0; i < 2; ++i) {
            const int k = (tid >> 3) + 64 * i, c4 = (tid & 7) * 4;
            const float4 v = *(const float4*)(src + (size_t)(k0 + k) * src_ld + on0 + c4);
            float* t = tile + k * 33 + c4; t[0] = v.x; t[1] = v.y; t[2] = v.z; t[3] = v.w;
        }
    }
    __syncthreads();
    const int n = tid >> 4, kc = (tid & 15) * 8;
    float f[8];
#pragma unroll
    for (int e = 0; e < 8; ++e) f[e] = zero ? 0.f : tile[(kc + e) * 33 + n];
    u32x4 o; o.x = pk2(f[0], f[1]); o.y = pk2(f[2], f[3]); o.z = pk2(f[4], f[5]); o.w = pk2(f[6], f[7]);
    *(u32x4*)(dst + (size_t)(dn0 + n) * dst_ld + k0 + kc) = o;
    __syncthreads();
}
__device__ __forceinline__ void phase_weights(const Params& p, int l, unsigned char* lds) {
    float* tile = (float*)lds;
    for (int it = blockIdx.x; it < 3776; it += gridDim.x) {
        if (it < 2752) {
            const int nt = it >> 3, kt = it & 7, dn0 = nt * 32;
            wt_tile(p.w_in + (size_t)l * 1024 * NIN, NIN, kt * 128, orig_col(dn0), (bf16_t*)(p.ws + OFF_WTIN), 1024, dn0, dn0 >= NIN, tile);
        } else if (it < 3264) {
            const int r = it - 2752, j = r >> 7, nt = (r >> 2) & 31, kt = r & 3;
            wt_tile(p.w_br + (size_t)(l * 4 + j) * 512 * 1024, 1024, kt * 128, nt * 32, (bf16_t*)(p.ws + OFF_WTBR) + (size_t)j * 1024 * 512, 512, nt * 32, false, tile);
        } else if (it < 3520) {
            const int r = it - 3264, nt = r >> 3, kt = r & 7;
            wt_tile(p.w_out + (size_t)l * 1024 * 1024, 1024, kt * 128, nt * 32, (bf16_t*)(p.ws + OFF_WTOUT), 1024, nt * 32, false, tile);
        } else {
            const int r = it - 3520, nt = r >> 3, kt = r & 7;
            wt_tile(p.mem_w_kv + (size_t)l * 1024 * 1024, 1024, kt * 128, nt * 32, (bf16_t*)(p.ws + OFF_WTKV), 1024, nt * 32, false, tile);
        }
    }
}

__device__ __forceinline__ void phase_filter_gen(const Params& p, int l, unsigned char* lds) {
    float* zt = (float*)lds;
    float* ha = zt + 32 * 33;
    float* hbuf = ha + 32 * 64;
    int tid_ = threadIdx.x; asm volatile("" : "+v"(tid_)); const int tid = tid_;
    const float* w1 = p.hy_w1 + (size_t)l * 33 * 64; const float* b1 = p.hy_b1 + l * 64;
    const float* wm = p.hy_wm + (size_t)l * 2 * 64 * 64; const float* bm = p.hy_bm + l * 2 * 64;
    const float* w3 = p.hy_w3 + (size_t)l * 64 * 1024;
    float* hf = (float*)(p.ws + OFF_HFILT);
    float* en = (float*)(p.ws + OFF_ENERGY) + l * 512;
    const float* ztab = (const float*)(p.ws + OFF_ZT);
    for (int it = blockIdx.x; it < 256; it += gridDim.x) {
        const int n0 = it * 32;
        for (int idx = tid; idx < 32 * 33; idx += NTHR) zt[idx] = ztab[(size_t)n0 * 33 + idx];
        __syncthreads();
        for (int idx = tid; idx < 2048; idx += NTHR) {
            const int pos = idx >> 6, j = idx & 63; float s = b1[j];
            for (int e = 0; e < 33; ++e) s += zt[pos * 33 + e] * w1[e * 64 + j];
            ha[idx] = sinf(s);
        }
        __syncthreads();
        for (int idx = tid; idx < 2048; idx += NTHR) {
            const int pos = idx >> 6, j = idx & 63; float s = bm[j];
            for (int e = 0; e < 64; ++e) s += ha[pos * 64 + e] * wm[e * 64 + j];
            hbuf[idx] = sinf(s);
        }
        __syncthreads();
        for (int idx = tid; idx < 2048; idx += NTHR) {
            const int pos = idx >> 6, j = idx & 63; float s = bm[64 + j];
            for (int e = 0; e < 64; ++e) s += hbuf[pos * 64 + e] * wm[4096 + e * 64 + j];
            ha[idx] = sinf(s);
        }
        __syncthreads();
        {
            const int c = tid;
            float af[32], ab[32];
#pragma unroll
            for (int i = 0; i < 32; ++i) { af[i] = 0.f; ab[i] = 0.f; }
            for (int k = 0; k < 64; ++k) {
                const float wf = w3[k * 1024 + c], wb = w3[k * 1024 + 512 + c];
#pragma unroll
                for (int i = 0; i < 32; ++i) { const float h = ha[i * 64 + k]; af[i] += h * wf; ab[i] += h * wb; }
            }
            const float dmin = -3.0701134573253945f, dmax = -15.350567286626973f;
            const float delta = fabsf(dmin + (float)c * ((dmax - dmin) / 511.0f));
            float e = 0.f;
#pragma unroll
            for (int i = 0; i < 32; ++i) {
                const int n = n0 + i; const float t01 = (float)n / 8191.0f; const float win = expf(-t01 * delta);
                af[i] *= win; ab[i] *= win; e += af[i] * af[i]; if (n >= 1) e += ab[i] * ab[i];
            }
#pragma unroll
            for (int i = 0; i < 8; ++i) {
                float4 a; a.x = af[4 * i]; a.y = af[4 * i + 1]; a.z = af[4 * i + 2]; a.w = af[4 * i + 3];
                float4 b; b.x = ab[4 * i]; b.y = ab[4 * i + 1]; b.z = ab[4 * i + 2]; b.w = ab[4 * i + 3];
                *(float4*)(hf + (size_t)c * 8192 + n0 + 4 * i) = a;
                *(float4*)(hf + (size_t)(512 + c) * 8192 + n0 + 4 * i) = b;
            }
            atomicAdd(en + c, e);
        }
        __syncthreads();
    }
}

__device__ __forceinline__ void phase_filter_fft(const Params& p, int l, unsigned char* lds) {
    float2* d = (float2*)lds;
    const float2* tw = fft_lds_twiddles((const float2*)(p.ws + OFF_TW), lds);
    const float* hf = (const float*)(p.ws + OFF_HFILT);
    const float* en = (const float*)(p.ws + OFF_ENERGY) + l * 512;
    float4* pqa = (float4*)(p.ws + OFF_PQ);
    int tid_ = threadIdx.x; asm volatile("" : "+v"(tid_)); const int tid = tid_;
    for (int pr = blockIdx.x; pr < 256; pr += gridDim.x) {
        const int c0 = 2 * pr, c1 = c0 + 1;
        const float s0 = 1.0f / sqrtf(en[c0] + 1e-6f), s1 = 1.0f / sqrtf(en[c1] + 1e-6f);
        const float k0 = p.hy_skip[l * 512 + c0], k1 = p.hy_skip[l * 512 + c1];
        for (int n = tid; n < FN; n += NTHR) {
            float2 v;
            if (n < 8192) { v.x = hf[(size_t)c0 * 8192 + n] * s0; v.y = hf[(size_t)c1 * 8192 + n] * s1; if (n == 0) { v.x += k0; v.y += k1; } }
            else if (n == 8192) { v.x = 0.f; v.y = 0.f; }
            else { v.x = hf[(size_t)(512 + c0) * 8192 + (FN - n)] * s0; v.y = hf[(size_t)(512 + c1) * 8192 + (FN - n)] * s1; }
            d[n] = v;
        }
        __syncthreads();
        fft_forward<false>(d, tw, (const float2*)(p.ws + OFF_TW));
        for (int h = tid; h < FN / 2; h += NTHR) filt_pointwise(d, pqa + (size_t)pr * FN, 2 * h);
        if (tid == 0) filt_pointwise(d, pqa + (size_t)pr * FN, 1);
        __syncthreads();
    }
}

__device__ __forceinline__ void hy_pre_item(const Params& p, int l, const bf16_t* P, float* UT, bf16_t* GT, int bl, int tt, int ct, unsigned char* lds) {
    float* tU = (float*)lds;
    float* tG = tU + 64 * 65;
    int tid_ = threadIdx.x; asm volatile("" : "+v"(tid_)); const int tid = tid_;
    const int t = tid >> 3, cc = (tid & 7) * 8, c = ct * 64 + cc, tb = tt * 64 + t;
    const float* cw = p.hy_conv_w + (size_t)l * 3 * 1536; const float* cb = p.hy_conv_b + l * 1536;
    float av[8], a0[8], a1[8];
#pragma unroll
    for (int h = 0; h < 2; ++h) {
        const f32x4 bv = *(const f32x4*)(cb + c + 4 * h), b0 = *(const f32x4*)(cb + 512 + c + 4 * h), b1 = *(const f32x4*)(cb + 1024 + c + 4 * h);
#pragma unroll
        for (int e = 0; e < 4; ++e) { av[4 * h + e] = bv[e]; a0[4 * h + e] = b0[e]; a1[4 * h + e] = b1[e]; }
    }
#pragma unroll
    for (int j = 0; j < 3; ++j) {
        const int ts = tb + j - 1;
        if (ts >= 0 && ts < SEQ) {
            const bf16_t* row = P + (size_t)(bl * SEQ + ts) * PS + C_HY + c;
            const u32x4 rv = *(const u32x4*)row, r0 = *(const u32x4*)(row + 512), r1 = *(const u32x4*)(row + 1024);
#pragma unroll
            for (int h = 0; h < 2; ++h) {
                const f32x4 wv = *(const f32x4*)(cw + j * 1536 + c + 4 * h), w0 = *(const f32x4*)(cw + j * 1536 + 512 + c + 4 * h), w1 = *(const f32x4*)(cw + j * 1536 + 1024 + c + 4 * h);
#pragma unroll
                for (int e = 0; e < 4; ++e) {
                    const int k = 4 * h + e; const unsigned uv = rv[k >> 1], u0 = r0[k >> 1], u1 = r1[k >> 1];
                    av[k] += wv[e] * ((k & 1) ? hi16(uv) : lo16(uv)); a0[k] += w0[e] * ((k & 1) ? hi16(u0) : lo16(u0)); a1[k] += w1[e] * ((k & 1) ? hi16(u1) : lo16(u1));
                }
            }
        }
    }
    const u32x4 rz = *(const u32x4*)(P + (size_t)(bl * SEQ + tb) * PS + C_Z + 512 + c);
#pragma unroll
    for (int k = 0; k < 8; ++k) {
        const unsigned uz = rz[k >> 1]; const float z = (k & 1) ? hi16(uz) : lo16(uz);
        tU[(cc + k) * 65 + t] = av[k] * a1[k]; tG[(cc + k) * 65 + t] = a0[k] * z;
    }
    __syncthreads();
    const int c2 = tid >> 3, t8 = (tid & 7) * 8;
    const size_t o = (size_t)(bl * 512 + ct * 64 + c2) * SEQ + tt * 64 + t8;
    const float* su = tU + c2 * 65 + t8; const float* sg = tG + c2 * 65 + t8;
    f32x4 ua = {su[0], su[1], su[2], su[3]}, ub = {su[4], su[5], su[6], su[7]};
    *(f32x4*)(UT + o) = ua; *(f32x4*)(UT + o + 4) = ub;
    u32x4 g; g.x = pk2(sg[0], sg[1]); g.y = pk2(sg[2], sg[3]); g.z = pk2(sg[4], sg[5]); g.w = pk2(sg[6], sg[7]);
    *(u32x4*)(GT + o) = g;
    __syncthreads();
}
__device__ __forceinline__ void hy_post_item(bf16_t* P, const bf16_t* GT, int bl, int tt, int ct, unsigned char* lds, int dry = 0) {
    bf16_t* tl = (bf16_t*)lds;
    int tid_ = threadIdx.x; asm volatile("" : "+v"(tid_)); const int tid = tid_;
    const int c2 = tid >> 3, t8 = (tid & 7) * 8;
    const u32x4 v = *(const u32x4*)(GT + (size_t)(bl * 512 + ct * 64 + c2) * SEQ + tt * 64 + t8);
    bf16_t* d0 = tl + t8 * 72 + c2;
    d0[0 * 72] = (bf16_t)(v.x & 0xffffu); d0[1 * 72] = (bf16_t)(v.x >> 16); d0[2 * 72] = (bf16_t)(v.y & 0xffffu); d0[3 * 72] = (bf16_t)(v.y >> 16);
    d0[4 * 72] = (bf16_t)(v.z & 0xffffu); d0[5 * 72] = (bf16_t)(v.z >> 16); d0[6 * 72] = (bf16_t)(v.w & 0xffffu); d0[7 * 72] = (bf16_t)(v.w >> 16);
    __syncthreads();
    const int t = tid >> 3, cc = (tid & 7) * 8;
    const u32x4 ov = *(const u32x4*)(tl + t * 72 + cc);
    if (!dry) *(u32x4*)(P + (size_t)(bl * SEQ + tt * 64 + t) * PS + C_HY + ct * 64 + cc) = ov;
    __syncthreads();
}
__device__ __forceinline__ void hyena_conv_item(const Params& p, const float* UT, bf16_t* GT, int bl, int pr, unsigned char* lds, const float2* tw, int dry = 0) {
    float2* d = (float2*)lds;
    const float4* pq = (const float4*)(p.ws + OFF_PQ) + (size_t)pr * FN;
    int tid_ = threadIdx.x; asm volatile("" : "+v"(tid_)); const int tid = tid_;
    const float* u0 = UT + (size_t)(bl * 512 + 2 * pr) * SEQ; const float* u1 = u0 + SEQ;
    bf16_t* g0 = GT + (size_t)(bl * 512 + 2 * pr) * SEQ; bf16_t* g1 = g0 + SEQ;
    {
        float f0[16], f1[16];
#pragma unroll
        for (int i = 0; i < 16; ++i) { f0[i] = u0[tid + NTHR * i]; f1[i] = u1[tid + NTHR * i]; }
#pragma unroll
        for (int i = 0; i < 16; ++i) {
            float2 u; u.x = f0[i]; u.y = f1[i]; d[tid + NTHR * i] = u;
        }
    }
    __syncthreads();
    fft_forward<true>(d, tw, (const float2*)(p.ws + OFF_TW));
#pragma unroll 1
    for (int h = tid; h < FN / 2; h += 4 * NTHR) {
        PwIn w0, w1, w2, w3;
        pw_load(w0, d, pq, 2 * h); pw_load(w1, d, pq, 2 * (h + NTHR)); pw_load(w2, d, pq, 2 * (h + 2 * NTHR)); pw_load(w3, d, pq, 2 * (h + 3 * NTHR));
        pw_store(w0, d); pw_store(w1, d); pw_store(w2, d); pw_store(w3, d);
    }
    if (tid == 0) conv_pointwise(d, pq, 1);
    __syncthreads();
    fft_inverse<true>(d, tw, (const float2*)(p.ws + OFF_TW));
    {
        bf16_t a0[16], a1[16];
#pragma unroll
        for (int i = 0; i < 16; ++i) { a0[i] = g0[tid + NTHR * i]; a1[i] = g1[tid + NTHR * i]; }
#pragma unroll
        for (int i = 0; i < 16; ++i) {
            const int t = tid + NTHR * i;
            const float2 y = d[t];
            const bf16_t r0 = f2bf_d(y.x * bf2f(a0[i])), r1 = f2bf_d(y.y * bf2f(a1[i]));
            if (!dry) { g0[t] = r0; g1[t] = r1; }
        }
    }
    __syncthreads();
}

__device__ __forceinline__ void na_item(const Params& p, int l, bf16_t* P, int bl, int rp, int head, unsigned char* lds, int dry = 0) {
    bf16_t* Kimg = (bf16_t*)lds;
    bf16_t* VT = (bf16_t*)(lds + 82944);
    int tid_ = threadIdx.x; asm volatile("" : "+v"(tid_)); const int tid = tid_, lane = tid & 63, w = tid >> 6, l15 = lane & 15, q4 = lane >> 4;
    const int r0 = 2 * rp, rs0 = iclamp(r0 - 4, 0, 120);
#pragma unroll
    for (int i = 0; i < 9; ++i) {
        const int idx = tid + NTHR * i, key = idx >> 3, ch = idx & 7, grow = min(rs0 + (key >> 6), 127);
        const u32x4 kv = *(const u32x4*)(P + (size_t)(bl * SEQ + grow * 64 + (key & 63)) * PS + C_NAK + head * 64 + ch * 8);
        *(u32x4*)(Kimg + key * 72 + ch * 8) = kv;
    }
#pragma unroll
    for (int i = 0; i < 9; ++i) {
        const int idx = tid + NTHR * i, keyp = idx >> 2, chh = keyp >= 576 ? 1 : 0, key = keyp - chh * 576, ch = chh * 4 + (idx & 3), grow = min(rs0 + (key >> 6), 127);
        const u32x4 vv = *(const u32x4*)(P + (size_t)(bl * SEQ + grow * 64 + (key & 63)) * PS + C_NAV + head * 64 + ch * 8);
        bf16_t* vd = VT + (ch * 8) * 584 + key;
        vd[0 * 584] = (bf16_t)(vv.x & 0xffffu); vd[1 * 584] = (bf16_t)(vv.x >> 16);
        vd[2 * 584] = (bf16_t)(vv.y & 0xffffu); vd[3 * 584] = (bf16_t)(vv.y >> 16);
        vd[4 * 584] = (bf16_t)(vv.z & 0xffffu); vd[5 * 584] = (bf16_t)(vv.z >> 16);
        vd[6 * 584] = (bf16_t)(vv.w & 0xffffu); vd[7 * 584] = (bf16_t)(vv.w >> 16);
    }
    __syncthreads();
    const int rr = w >> 2, g = w & 3, r = r0 + rr, rs = iclamp(r - 4, 0, 120), lo = rs - rs0;
    const int cb = iclamp(16 * g - 8, 0, 32), c = 16 * g + l15, cs = iclamp(c - 8, 0, 48);
    bf16_t* qrow = P + (size_t)(bl * SEQ + r * 64 + c) * PS + head * 64;
    bf16x8 qf[2];
#pragma unroll
    for (int ks = 0; ks < 2; ++ks) qf[ks] = *(const bf16x8*)(qrow + ks * 32 + q4 * 8);
    f32x4 sc[16];
#pragma unroll
    for (int t = 0; t < 16; ++t) {
        const int kb = (lo + (t >> 1)) * 64 + cb + 16 * (t & 1);
        f32x4 a = {0.f, 0.f, 0.f, 0.f};
#pragma unroll
        for (int ks = 0; ks < 2; ++ks) { const bf16x8 kf = *(const bf16x8*)(Kimg + (kb + l15) * 72 + ks * 32 + q4 * 8); a = MFMA(kf, qf[ks], a); }
        sc[t] = a;
    }
    const float* rpb = p.na_rpb + (size_t)(l * 8 + head) * 15 * 31;
    float mx = -1e30f;
#pragma unroll
    for (int t = 0; t < 16; ++t) {
        const int drow = rs + (t >> 1) - r + 7;
#pragma unroll
        for (int e = 0; e < 4; ++e) {
            const int col = cb + 16 * (t & 1) + 4 * q4 + e;
            const bool ok = (col >= cs) && (col < cs + 16);
            const int dcol = ok ? (col - c + 15) : 0;
            const float v = ok ? (sc[t][e] + rpb[drow * 31 + dcol]) : -1e30f;
            sc[t][e] = v; mx = fmaxf(mx, v);
        }
    }
    mx = fmaxf(mx, __shfl_xor(mx, 16)); mx = fmaxf(mx, __shfl_xor(mx, 32));
    float sum = 0.f;
#pragma unroll
    for (int t = 0; t < 16; ++t)
#pragma unroll
        for (int e = 0; e < 4; ++e) { const float pe = __expf(sc[t][e] - mx); sc[t][e] = pe; sum += pe; }
    sum += __shfl_xor(sum, 16); sum += __shfl_xor(sum, 32);
    f32x4 o[4];
#pragma unroll
    for (int dt = 0; dt < 4; ++dt) o[dt] = (f32x4){0.f, 0.f, 0.f, 0.f};
#pragma unroll
    for (int kk = 0; kk < 8; ++kk) {
        u32x4 pu; pu.x = pk2(sc[2 * kk][0], sc[2 * kk][1]); pu.y = pk2(sc[2 * kk][2], sc[2 * kk][3]); pu.z = pk2(sc[2 * kk + 1][0], sc[2 * kk + 1][1]); pu.w = pk2(sc[2 * kk + 1][2], sc[2 * kk + 1][3]);
        const bf16x8 pf = mkfrag(pu);
        const int kbA = (lo + kk) * 64 + cb + 4 * q4;
#pragma unroll
        for (int dt = 0; dt < 4; ++dt) {
            const bf16_t* vr = VT + (dt * 16 + l15) * 584 + kbA;
            const bf16x8 vf = mkfrag2(*(const u32x2*)vr, *(const u32x2*)(vr + 16));
            o[dt] = MFMA(vf, pf, o[dt]);
        }
    }
    const float inv = 1.0f / sum;
    const bf16_t* zrow = P + (size_t)(bl * SEQ + r * 64 + c) * PS + C_Z + head * 64;
#pragma unroll
    for (int dt = 0; dt < 4; ++dt) {
        const int dd = dt * 16 + 4 * q4;
        const f32x4 z = ld_bf4(zrow + dd);
        if (!dry) st_bf4(qrow + dd, o[dt] * inv * z);
    }
    __syncthreads();
}

__device__ __forceinline__ void memattn_load(const Params& p, int b, int h, unsigned char* lds) {
    bf16_t* Kimg = (bf16_t*)lds;
    bf16_t* VT = (bf16_t*)(lds + 69632);
    const bf16_t* Km = (const bf16_t*)(p.ws + OFF_KMAT); const bf16_t* Vm = (const bf16_t*)(p.ws + OFF_VT);
    int tid_ = threadIdx.x; asm volatile("" : "+v"(tid_)); const int tid = tid_;
#pragma unroll
    for (int i = 0; i < 8; ++i) {
        const int idx = tid + NTHR * i;
        { const int key = idx >> 4, ch = idx & 15; *(u32x4*)(Kimg + key * 136 + ch * 8) = *(const u32x4*)(Km + (size_t)(b * 256 + key) * 512 + h * 128 + ch * 8); }
        { const int dd = idx >> 5, ch = idx & 31; *(u32x4*)(VT + dd * 264 + ch * 8) = *(const u32x4*)(Vm + (size_t)(h * 128 + dd) * 2048 + b * 256 + ch * 8); }
    }
    __syncthreads();
}
__device__ __forceinline__ void memattn_item(bf16_t* P, int bl, int h, int qt, unsigned char* lds, int dry = 0) {
    const bf16_t* Kimg = (const bf16_t*)lds; const bf16_t* VT = (const bf16_t*)(lds + 69632);
    int tid_ = threadIdx.x; asm volatile("" : "+v"(tid_)); const int tid = tid_, lane = tid & 63, w = tid >> 6, l15 = lane & 15, q4 = lane >> 4;
    const int tok = bl * SEQ + qt * 128 + w * 16 + l15;
    bf16_t* qrow = P + (size_t)tok * PS + C_MQ + h * 128;
    bf16x8 qf[4];
#pragma unroll
    for (int ks = 0; ks < 4; ++ks) qf[ks] = *(const bf16x8*)(qrow + ks * 32 + q4 * 8);
    f32x4 sc[16];
    float mx = -1e30f;
#pragma unroll
    for (int t = 0; t < 16; ++t) {
        f32x4 a = {0.f, 0.f, 0.f, 0.f};
#pragma unroll
        for (int ks = 0; ks < 4; ++ks) { const bf16x8 kf = *(const bf16x8*)(Kimg + (t * 16 + l15) * 136 + ks * 32 + q4 * 8); a = MFMA(kf, qf[ks], a); }
        sc[t] = a;
        mx = fmaxf(mx, fmaxf(fmaxf(a[0], a[1]), fmaxf(a[2], a[3])));
    }
    mx = fmaxf(mx, __shfl_xor(mx, 16)); mx = fmaxf(mx, __shfl_xor(mx, 32));
    float sum = 0.f;
#pragma unroll
    for (int t = 0; t < 16; ++t)
#pragma unroll
        for (int e = 0; e < 4; ++e) { const float pe = __expf(sc[t][e] - mx); sc[t][e] = pe; sum += pe; }
    sum += __shfl_xor(sum, 16); sum += __shfl_xor(sum, 32);
    f32x4 o[8];
#pragma unroll
    for (int dt = 0; dt < 8; ++dt) o[dt] = (f32x4){0.f, 0.f, 0.f, 0.f};
#pragma unroll
    for (int kk = 0; kk < 8; ++kk) {
        u32x4 pu; pu.x = pk2(sc[2 * kk][0], sc[2 * kk][1]); pu.y = pk2(sc[2 * kk][2], sc[2 * kk][3]); pu.z = pk2(sc[2 * kk + 1][0], sc[2 * kk + 1][1]); pu.w = pk2(sc[2 * kk + 1][2], sc[2 * kk + 1][3]);
        const bf16x8 pf = mkfrag(pu);
#pragma unroll
        for (int dt = 0; dt < 8; ++dt) {
            const bf16_t* vr = VT + (dt * 16 + l15) * 264 + kk * 32 + 4 * q4;
            const bf16x8 vf = mkfrag2(*(const u32x2*)vr, *(const u32x2*)(vr + 16));
            o[dt] = MFMA(vf, pf, o[dt]);
        }
    }
    const float inv = 1.0f / sum;
    const bf16_t* zrow = P + (size_t)tok * PS + C_Z + 3 * 512 + h * 128;
#pragma unroll
    for (int dt = 0; dt < 8; ++dt) {
        const int dd = dt * 16 + 4 * q4;
        const f32x4 z = ld_bf4(zrow + dd);
        if (!dry) st_bf4(qrow + dd, o[dt] * inv * z);
    }
}

constexpr int G_LRT = 0, G_BF = 8192, G_BB = 24576, G_TOT = 40960, G_IMG = 45056;
__device__ __forceinline__ void gla_tables(const Params& p, int l, const float* LR, int t0, int h, unsigned char* lds) {
    float* LRT = (float*)(lds + G_LRT); float* BF = (float*)(lds + G_BF); float* BB = (float*)(lds + G_BB); float* TOT = (float*)(lds + G_TOT);
    int tid_ = threadIdx.x; asm volatile("" : "+v"(tid_)); const int tid = tid_;
    ((float4*)LRT)[tid] = ((const float4*)(LR + (size_t)t0 * 32))[tid];
    __syncthreads();
    const int dk = tid & 63, cgp = tid >> 6;
    float uf[16], ub[16];
#pragma unroll
    for (int r = 0; r < 16; ++r) { uf[r] = p.gla_up_f[(size_t)(l * 16 + r) * 256 + h * 64 + dk]; ub[r] = p.gla_up_b[(size_t)(l * 16 + r) * 256 + h * 64 + dk]; }
    const float bif = p.gla_bias_f[l * 256 + h * 64 + dk], bib = p.gla_bias_b[l * 256 + h * 64 + dk];
    float lf[8], lb[8];
#pragma unroll
    for (int i = 0; i < 8; ++i) {
        const int c = cgp * 8 + i; float sf = bif, sb = bib;
#pragma unroll
        for (int r = 0; r < 16; ++r) { sf += LRT[c * 32 + r] * uf[r]; sb += LRT[c * 32 + 16 + r] * ub[r]; }
        lf[i] = logsigf_(sf) * (1.0f / 16.0f); lb[i] = logsigf_(sb) * (1.0f / 16.0f);
    }
#pragma unroll
    for (int i = 1; i < 8; ++i) lf[i] += lf[i - 1];
#pragma unroll
    for (int i = 6; i >= 0; --i) lb[i] += lb[i + 1];
    TOT[cgp * 64 + dk] = lf[7]; TOT[512 + cgp * 64 + dk] = lb[0];
    __syncthreads();
    float of = 0.f, ob = 0.f;
#pragma unroll
    for (int g2 = 0; g2 < 8; ++g2) { if (g2 < cgp) of += TOT[g2 * 64 + dk]; if (g2 > cgp) ob += TOT[512 + g2 * 64 + dk]; }
#pragma unroll
    for (int i = 0; i < 8; ++i) { BF[(cgp * 8 + i) * 64 + dk] = lf[i] + of; BB[(cgp * 8 + i) * 64 + dk] = lb[i] + ob; }
    __syncthreads();
}
struct GlaPre { u32x4 vv[2]; bf16_t q[8], k[8]; };
__device__ __forceinline__ void gla_prefetch(GlaPre& g, const bf16_t* P, int t0, int h, int tid) {
#pragma unroll
    for (int i = 0; i < 2; ++i) { const int idx = tid + NTHR * i, chn = idx >> 6, c = idx & 63; g.vv[i] = *(const u32x4*)(P + (size_t)(t0 + c) * PS + C_GV + h * 128 + chn * 8); }
#pragma unroll
    for (int i = 0; i < 8; ++i) { const int idx = tid + NTHR * i, c = idx >> 6, dk = idx & 63; g.q[i] = P[(size_t)(t0 + c) * PS + C_GQ + h * 64 + dk]; g.k[i] = P[(size_t)(t0 + c) * PS + C_GK + h * 64 + dk]; }
}
__device__ __forceinline__ void gla_vt_store(const GlaPre& g, bf16_t* VT, int tid) {
#pragma unroll
    for (int i = 0; i < 2; ++i) {
        const int idx = tid + NTHR * i, chn = idx >> 6, c = idx & 63;
        const u32x4 vv = g.vv[i];
        bf16_t* vd = VT + (chn * 8) * 72 + c;
        vd[0 * 72] = (bf16_t)(vv.x & 0xffffu); vd[1 * 72] = (bf16_t)(vv.x >> 16);
        vd[2 * 72] = (bf16_t)(vv.y & 0xffffu); vd[3 * 72] = (bf16_t)(vv.y >> 16);
        vd[4 * 72] = (bf16_t)(vv.z & 0xffffu); vd[5 * 72] = (bf16_t)(vv.z >> 16);
        vd[6 * 72] = (bf16_t)(vv.w & 0xffffu); vd[7 * 72] = (bf16_t)(vv.w >> 16);
    }
}
__device__ __forceinline__ void gla_part1_item(const Params& p, int l, const bf16_t* P, const float* LR, int item, unsigned char* lds) {
    const int h = item & 3, n = (item >> 2) & 127, bl = item >> 9, t0 = bl * SEQ + n * 64;
    const float* BF = (const float*)(lds + G_BF); const float* BB = (const float*)(lds + G_BB);
    bf16_t* KDT0 = (bf16_t*)(lds + G_IMG); bf16_t* KDT1 = KDT0 + 64 * 72; bf16_t* VT = KDT1 + 64 * 72;
    float* GS = (float*)(p.ws + OFF_GS); float* GD = (float*)(p.ws + OFF_GDEC);
    int tid_ = threadIdx.x; asm volatile("" : "+v"(tid_)); const int tid = tid_, lane = tid & 63, w = tid >> 6, l15 = lane & 15, q4 = lane >> 4;
    GlaPre gp; gla_prefetch(gp, P, t0, h, tid);
    gla_tables(p, l, LR, t0, h, lds);
    {
        float4* tb = (float4*)((float*)(p.ws + OFF_TB) + (size_t)item * 8192); const float4* ts = (const float4*)(lds + G_BF);
#pragma unroll
        for (int i = 0; i < 4; ++i) tb[tid + NTHR * i] = ts[tid + NTHR * i];
    }
#pragma unroll
    for (int i = 0; i < 8; ++i) {
        const int idx = tid + NTHR * i, c = idx >> 6, dk = idx & 63;
        const float kv = bf2f(gp.k[i]);
        KDT0[dk * 72 + c] = f2bf_d(kv * __expf(BF[63 * 64 + dk] - BF[c * 64 + dk]));
        KDT1[dk * 72 + c] = f2bf_d(kv * __expf(BB[dk] - BB[c * 64 + dk]));
    }
    gla_vt_store(gp, VT, tid);
    if (tid < 64) GD[(size_t)item * 64 + tid] = __expf(BF[63 * 64 + tid]);
    else if (tid < 128) GD[(size_t)(NITEM + item) * 64 + tid - 64] = __expf(BB[tid - 64]);
    __syncthreads();
    const int dir = w >> 2, dkt = w & 3;
    const bf16_t* KD = dir ? KDT1 : KDT0;
    bf16x8 kf[2];
#pragma unroll
    for (int ks = 0; ks < 2; ++ks) kf[ks] = *(const bf16x8*)(KD + (16 * dkt + l15) * 72 + 32 * ks + 8 * q4);
    float* dst = GS + ((size_t)dir * NITEM + item) * 8192;
#pragma unroll
    for (int dvt = 0; dvt < 8; ++dvt) {
        f32x4 a = {0.f, 0.f, 0.f, 0.f};
#pragma unroll
        for (int ks = 0; ks < 2; ++ks) { const bf16x8 vf = *(const bf16x8*)(VT + (16 * dvt + l15) * 72 + 32 * ks + 8 * q4); a = MFMA(kf[ks], vf, a); }
        *(f32x4*)(dst + (16 * dvt + l15) * 64 + 16 * dkt + 4 * q4) = a;
    }
    __syncthreads();
}
__device__ __forceinline__ void gla_scan(const Params& p, int dry = 0) {
    const float* GS = (const float*)(p.ws + OFF_GS); const float* GD = (const float*)(p.ws + OFF_GDEC); bf16_t* SB = (bf16_t*)(p.ws + OFF_SB);
    const int total = 2 * BG * 4 * 8192;
    int tid_ = threadIdx.x; asm volatile("" : "+v"(tid_));
    for (int id = blockIdx.x * NTHR + tid_; id < total; id += gridDim.x * NTHR) {
        const int e = id & 8191, comb = id >> 13, h = comb & 3, bl = (comb >> 2) % BG, dir = comb / (4 * BG), dk = e & 63;
        float S = 0.f;
        const size_t ibase = (size_t)dir * NITEM + (size_t)(bl * 128) * 4 + h;
        for (int s0 = 0; s0 < 128; s0 += 16) {
            float u[16], dc[16];
#pragma unroll
            for (int i = 0; i < 16; ++i) {
                const int n = dir ? 127 - (s0 + i) : s0 + i;
                const size_t item = ibase + (size_t)n * 4;
                u[i] = GS[item * 8192 + e]; dc[i] = GD[item * 64 + dk];
            }
#pragma unroll
            for (int i = 0; i < 16; ++i) {
                const int n = dir ? 127 - (s0 + i) : s0 + i;
                const size_t item = ibase + (size_t)n * 4;
                if (!dry) SB[item * 8192 + e] = f2bf_d(S);
                S = dc[i] * S + u[i];
            }
        }
    }
}
__device__ __forceinline__ void gla_part2_item(const Params& p, int l, bf16_t* P, const float* LR, int item, unsigned char* lds, int dry = 0) {
    const int h = item & 3, n = (item >> 2) & 127, bl = item >> 9, t0 = bl * SEQ + n * 64;
    const float* BF = (const float*)(lds + G_BF); const float* BB = (const float*)(lds + G_BB);
    bf16_t* QF = (bf16_t*)(lds + G_IMG);
    bf16_t* KF = QF + 2 * 64 * 72;
    bf16_t* QD = KF + 2 * 64 * 72;
    bf16_t* VT = QD + 2 * 64 * 72;
    bf16_t* ST = VT + 128 * 72;
    float* OX = (float*)lds;
    const float* GS = (const float*)(p.ws + OFF_GS);
    int tid_ = threadIdx.x; asm volatile("" : "+v"(tid_)); const int tid = tid_, lane = tid & 63, w = tid >> 6, l15 = lane & 15, q4 = lane >> 4;
    GlaPre gp; gla_prefetch(gp, P, t0, h, tid);
    u32x4 sp[2][2];
#pragma unroll
    for (int dir = 0; dir < 2; ++dir)
#pragma unroll
        for (int i = 0; i < 2; ++i) { const int idx = tid + NTHR * i; sp[dir][i] = *(const u32x4*)((const bf16_t*)(p.ws + OFF_SB) + ((size_t)dir * NITEM + item) * 8192 + (size_t)idx * 8); }
    {
        const float4* tb = (const float4*)((const float*)(p.ws + OFF_TB) + (size_t)item * 8192); float4* ts = (float4*)(lds + G_BF);
        float4 tv[4];
#pragma unroll
        for (int i = 0; i < 4; ++i) tv[i] = tb[tid + NTHR * i];
#pragma unroll
        for (int i = 0; i < 4; ++i) ts[tid + NTHR * i] = tv[i];
        __syncthreads();
    }
#pragma unroll
    for (int i = 0; i < 8; ++i) {
        const int idx = tid + NTHR * i, c = idx >> 6, dk = idx & 63;
        const float qv = bf2f(gp.q[i]);
        const float kv = bf2f(gp.k[i]);
        const float bf = BF[c * 64 + dk], mf = BF[31 * 64 + dk], bb = BB[c * 64 + dk], mb = BB[32 * 64 + dk];
        QF[c * 72 + dk] = f2bf_d(qv * __expf(bf - mf)); KF[c * 72 + dk] = f2bf_d(kv * __expf(mf - bf)); QD[c * 72 + dk] = f2bf_d(qv * __expf(bf));
        QF[4608 + c * 72 + dk] = f2bf_d(qv * __expf(bb - mb)); KF[4608 + c * 72 + dk] = f2bf_d(kv * __expf(mb - bb)); QD[4608 + c * 72 + dk] = f2bf_d(qv * __expf(bb));
    }
    gla_vt_store(gp, VT, tid);
#pragma unroll
    for (int dir = 0; dir < 2; ++dir) {
#pragma unroll
        for (int i = 0; i < 2; ++i) {
            const int idx = tid + NTHR * i, dv = idx >> 3, dk8 = (idx & 7) * 8;
            *(u32x4*)(ST + dir * 9216 + dv * 72 + dk8) = sp[dir][i];
        }
    }
    __syncthreads();
    const int dir = w >> 2, ct = w & 3;
    const bf16_t* qfp = QF + dir * 4608; const bf16_t* kfp = KF + dir * 4608; const bf16_t* qdp = QD + dir * 4608; const bf16_t* stp = ST + dir * 9216;
    bf16x8 qf[2], qd[2];
#pragma unroll
    for (int ks = 0; ks < 2; ++ks) { qf[ks] = *(const bf16x8*)(qfp + (16 * ct + l15) * 72 + 32 * ks + 8 * q4); qd[ks] = *(const bf16x8*)(qdp + (16 * ct + l15) * 72 + 32 * ks + 8 * q4); }
    f32x4 sc[4];
    const int cq = 16 * ct + l15;
#pragma unroll
    for (int st = 0; st < 4; ++st) {
        f32x4 a = {0.f, 0.f, 0.f, 0.f};
#pragma unroll
        for (int ks = 0; ks < 2; ++ks) { const bf16x8 kf = *(const bf16x8*)(kfp + (16 * st + l15) * 72 + 32 * ks + 8 * q4); a = MFMA(kf, qf[ks], a); }
#pragma unroll
        for (int e = 0; e < 4; ++e) { const int s = 16 * st + 4 * q4 + e; const bool ok = dir ? (s > cq) : (s <= cq); a[e] = ok ? a[e] : 0.f; }
        sc[st] = a;
    }
    f32x4 o[8];
#pragma unroll
    for (int dt = 0; dt < 8; ++dt) o[dt] = (f32x4){0.f, 0.f, 0.f, 0.f};
#pragma unroll
    for (int kk = 0; kk < 2; ++kk) {
        u32x4 pu; pu.x = pk2(sc[2 * kk][0], sc[2 * kk][1]); pu.y = pk2(sc[2 * kk][2], sc[2 * kk][3]); pu.z = pk2(sc[2 * kk + 1][0], sc[2 * kk + 1][1]); pu.w = pk2(sc[2 * kk + 1][2], sc[2 * kk + 1][3]);
        const bf16x8 pf = mkfrag(pu);
#pragma unroll
        for (int dt = 0; dt < 8; ++dt) {
            const bf16_t* vr = VT + (dt * 16 + l15) * 72 + kk * 32 + 4 * q4;
            const bf16x8 vf = mkfrag2(*(const u32x2*)vr, *(const u32x2*)(vr + 16));
            o[dt] = MFMA(vf, pf, o[dt]);
        }
    }
#pragma unroll
    for (int ks = 0; ks < 2; ++ks)
#pragma unroll
        for (int dt = 0; dt < 8; ++dt) { const bf16x8 sf = *(const bf16x8*)(stp + (dt * 16 + l15) * 72 + 32 * ks + 8 * q4); o[dt] = MFMA(sf, qd[ks], o[dt]); }
    if (dir == 1) {
#pragma unroll
        for (int dt = 0; dt < 8; ++dt) *(f32x4*)(OX + cq * 132 + 16 * dt + 4 * q4) = o[dt];
    }
    __syncthreads();
    if (dir == 0) {
        float ss = 0.f;
#pragma unroll
        for (int dt = 0; dt < 8; ++dt) { o[dt] += *(const f32x4*)(OX + cq * 132 + 16 * dt + 4 * q4); ss += (o[dt][0] * o[dt][0] + o[dt][1] * o[dt][1]) + (o[dt][2] * o[dt][2] + o[dt][3] * o[dt][3]); }
        ss += __shfl_xor(ss, 16); ss += __shfl_xor(ss, 32);
        const float rms = 1.0f / sqrtf(ss * (1.0f / 128.0f) + 1e-6f);
        const float* ng = p.gla_norm_g + l * 512 + h * 128;
        const bf16_t* zrow = P + (size_t)(t0 + cq) * PS + C_Z + 2 * 512 + h * 128;
        bf16_t* orow = P + (size_t)(t0 + cq) * PS + C_GV + h * 128;
#pragma unroll
        for (int dt = 0; dt < 8; ++dt) {
            const int dd = 16 * dt + 4 * q4;
            const f32x4 z = ld_bf4(zrow + dd); const f32x4 g4 = *(const f32x4*)(ng + dd);
            if (!dry) st_bf4(orow + dd, o[dt] * rms * g4 * z);
        }
    }
    __syncthreads();
}

namespace pg8 {
#define PG8_LAS __attribute__((address_space(3)))
typedef unsigned short bf16_t;
typedef short bf16x8 __attribute__((ext_vector_type(8)));
typedef float f32x4 __attribute__((ext_vector_type(4)));
typedef unsigned u32x4 __attribute__((ext_vector_type(4)));
constexpr int BM = 256, BK = 64, HALF = 128, HTB = HALF * BK * 2  , STAGE_BYTES = 8 * HTB, NXCD = 8, WGM = 8;

__host__ __device__ __forceinline__ int lds_byte(int r, int c) { const int st = (r >> 4) * 2 + (c >> 5), rr = r & 15, cc = c & 31, ob = rr * 64 + cc * 2; return st * 1024 + (ob ^ (((ob >> 9) & 1) << 5)); }
__host__ __device__ __forceinline__ void stage_rc(int b, int& R, int& C) { const int st = b / 1024, sb = b % 1024, swz = sb ^ (((sb >> 9) & 1) << 5); R = (st >> 1) * 16 + swz / 64; C = (st & 1) * 32 + (swz % 64) / 2; }
__host__ __device__ __forceinline__ int perm32(int rho) { const int n = rho >> 4, i = rho & 15; return 8 * (i >> 2) + 4 * n + (i & 3); }

struct Unit { int pm, pn; };
struct Gemm { const bf16_t* A; const bf16_t* Bt; int M, N, K; };

struct StaticOrder {
    int nM, nN, nwg, G, c;
    __host__ __device__ __forceinline__ void init(int M, int N, int G_, int c_) { nM = M / BM; nN = N / BM; nwg = nM * nN; G = G_; c = c_; }
    __host__ __device__ bool next(int i, Unit& u) const {
        const long L = (long)i * G + c; if (L >= nwg) return false;
        int wgid = (int)L; { const int q = nwg / NXCD, r = nwg % NXCD, xcd = wgid % NXCD, off = wgid / NXCD; wgid = (xcd < r ? xcd * (q + 1) : r * (q + 1) + (xcd - r) * q) + off; }
        const int nig = WGM * nN, gid = wgid / nig, fm = gid * WGM, gsz = (nM - fm) < WGM ? (nM - fm) : WGM;
        u.pm = fm + ((wgid % nig) % gsz); u.pn = (wgid % nig) / gsz; return true;
    }
    __device__ __forceinline__ void a_ready(const Unit&) const {}
    __device__ __forceinline__ void done(const Unit&) const {}
};
__device__ __forceinline__ unsigned cvt_pk_bf16(float lo, float hi) { unsigned r; asm volatile("v_cvt_pk_bf16_f32 %0, %1, %2" : "=v"(r) : "v"(lo), "v"(hi)); return r; }
template <class Epi, class Sched, bool STAMP = false>
__device__ __forceinline__ void gemm_phase(PG8_LAS unsigned char* lds, const Gemm g, const Sched& S, const Epi& E, unsigned long long* stamps) {
    int tid_l = threadIdx.x; asm volatile("" : "+v"(tid_l)); const int tid = tid_l, wid = __builtin_amdgcn_readfirstlane(tid >> 6), lane = tid & 63, wr = wid >> 2, wc = wid & 3, fr = lane & 15, fq = lane >> 4;
    const int K = g.K, nt = K / BK;
    int ts_lo = 0, ts_hi = 0, nts = 0; const unsigned long long rt_entry = STAMP ? (unsigned long long)wall_clock64() : 0ull;
#define PG8_STAMP() do { if (STAMP && wid == 0 && nts < 64) { const unsigned long long _c = (unsigned long long)clock64(); \
        ts_lo = (lane == nts) ? (int)(unsigned)_c : ts_lo; ts_hi = (lane == nts) ? (int)(unsigned)(_c >> 32) : ts_hi; ++nts; } } while (0)
    PG8_STAMP();
    unsigned voffA[2], voffB[2];
#pragma unroll
    for (int i = 0; i < 2; ++i) { int R, C; stage_rc(tid * 16 + i * 8192, R, C); const int Rb = Epi::PERM ? ((R & ~31) + perm32(R & 31)) : R;
        voffA[i] = (unsigned)(R * K + C) * 2u; voffB[i] = (unsigned)(Rb * K + C) * 2u; }
    const size_t kstep = (size_t)(BK * 2);
    const size_t hstep = (size_t)HALF * K * 2;
    const size_t tstep = 2 * hstep;
    const unsigned ldsw = (unsigned)wid * 1024u;
    const int aoff = lds_byte(wr * 64 + fr, fq * 8), boff = lds_byte(wc * 32 + fr, fq * 8);
#define PG8_SA(b, h) (((b) * 2 + (h)) * HTB)
#define PG8_SB(b, h) ((4 + (b) * 2 + (h)) * HTB)
#define PG8_STAGE(bufoff, gbase, voff) do { _Pragma("unroll") for (int _i = 0; _i < 2; ++_i) \
        __builtin_amdgcn_global_load_lds((const unsigned*)((const char*)(gbase) + (voff)[_i]), (PG8_LAS unsigned*)(lds + (bufoff) + ldsw + _i * 8192), 16, 0, 0); } while (0)
#define PG8_LDA(dst, b, h) do { _Pragma("unroll") for (int m = 0; m < 4; ++m) _Pragma("unroll") for (int k = 0; k < 2; ++k) dst[m][k] = *(const PG8_LAS bf16x8*)(lds + PG8_SA(b, h) + aoff + m * 2048 + k * 1024); } while (0)
#define PG8_LDB(dst, b, h) do { _Pragma("unroll") for (int n = 0; n < 2; ++n) _Pragma("unroll") for (int k = 0; k < 2; ++k) dst[n][k] = *(const PG8_LAS bf16x8*)(lds + PG8_SB(b, h) + boff + n * 2048 + k * 1024); } while (0)
#define PG8_MMA(ai, bj, At, Bt) do { __builtin_amdgcn_s_setprio(1); _Pragma("unroll") for (int m = 0; m < 4; ++m) _Pragma("unroll") for (int n = 0; n < 2; ++n) _Pragma("unroll") for (int k = 0; k < 2; ++k) \
        acc[ai][bj][m][n] = __builtin_amdgcn_mfma_f32_16x16x32_bf16(Bt[n][k], At[m][k], acc[ai][bj][m][n], 0, 0, 0); __builtin_amdgcn_s_setprio(0); } while (0)
#define PG8_WAIT_V(n) asm volatile("s_waitcnt vmcnt(" #n ")" ::: "memory")
#define PG8_WAIT_L(n) asm volatile("s_waitcnt lgkmcnt(" #n ")" ::: "memory")
#define PG8_BAR __builtin_amdgcn_s_barrier()
#define PG8_SCHED __builtin_amdgcn_sched_barrier(0)
    Unit cur, nxt; int ui = 0;
    if (!S.next(0, cur)) return;
    f32x4 acc[2][2][4][2];
#pragma unroll
    for (int a = 0; a < 2; ++a)
#pragma unroll
        for (int b = 0; b < 2; ++b)
#pragma unroll
            for (int m = 0; m < 4; ++m)
#pragma unroll
                for (int n = 0; n < 2; ++n) acc[a][b][m][n] = (f32x4){0.f, 0.f, 0.f, 0.f};
    bf16x8 At[4][2], B0[2][2], B1[2][2];
    const char* cA = (const char*)g.A + (size_t)cur.pm * tstep; const char* cB = (const char*)g.Bt + (size_t)cur.pn * tstep;
    S.a_ready(cur);
    PG8_STAGE(PG8_SB(0, 0), cB, voffB); PG8_STAGE(PG8_SA(0, 0), cA, voffA); PG8_STAGE(PG8_SB(0, 1), cB + hstep, voffB); PG8_STAGE(PG8_SA(0, 1), cA + hstep, voffA);
    if (wr == 1) PG8_BAR;
    PG8_WAIT_V(4); PG8_BAR;
    PG8_STAGE(PG8_SB(1, 0), cB + kstep, voffB); PG8_STAGE(PG8_SA(1, 0), cA + kstep, voffA); PG8_STAGE(PG8_SB(1, 1), cB + hstep + kstep, voffB);
    PG8_WAIT_V(6); PG8_BAR;
    PG8_STAMP();
    for (;;) {
        const bool has_next = S.next(ui + 1, nxt);
        const char* nA = has_next ? (const char*)g.A + (size_t)nxt.pm * tstep : cA; const char* nB = has_next ? (const char*)g.Bt + (size_t)nxt.pn * tstep : cB;
        for (int t = 0; t < nt; t += 2) {
            const bool last = (t == nt - 2);
            const char* a1 = cA + (size_t)(t + 1) * kstep;
            const char* a2 = last ? nA : cA + (size_t)(t + 2) * kstep; const char* b2 = last ? nB : cB + (size_t)(t + 2) * kstep;
            const char* a3 = a2 + kstep; const char* b3 = b2 + kstep;
            if (last && has_next) S.a_ready(nxt);
            PG8_LDB(B0, 0, 0); PG8_SCHED; PG8_LDA(At, 0, 0); PG8_STAGE(PG8_SA(1, 1), a1 + hstep, voffA);
            PG8_WAIT_L(8); PG8_BAR; PG8_WAIT_L(0); PG8_MMA(0, 0, At, B0); PG8_BAR; PG8_SCHED;
            PG8_LDB(B1, 0, 1); PG8_STAGE(PG8_SB(0, 0), b2, voffB);
            PG8_BAR; PG8_WAIT_L(0); PG8_MMA(0, 1, At, B1); PG8_BAR;
            PG8_LDA(At, 0, 1); PG8_STAGE(PG8_SA(0, 0), a2, voffA);
            PG8_BAR; PG8_WAIT_L(0); PG8_MMA(1, 0, At, B0); PG8_BAR; PG8_SCHED;
            PG8_STAGE(PG8_SB(0, 1), b2 + hstep, voffB);
            PG8_WAIT_V(6); PG8_BAR; PG8_MMA(1, 1, At, B1); PG8_BAR;
            PG8_LDB(B0, 1, 0); PG8_SCHED; PG8_LDA(At, 1, 0); PG8_STAGE(PG8_SA(0, 1), a2 + hstep, voffA);
            PG8_WAIT_L(8); PG8_BAR; PG8_WAIT_L(0); PG8_MMA(0, 0, At, B0); PG8_BAR; PG8_SCHED;
            PG8_LDB(B1, 1, 1); PG8_STAGE(PG8_SB(1, 0), b3, voffB);
            PG8_BAR; PG8_WAIT_L(0); PG8_MMA(0, 1, At, B1); PG8_BAR;
            PG8_LDA(At, 1, 1); PG8_STAGE(PG8_SA(1, 0), a3, voffA);
            PG8_BAR; PG8_WAIT_L(0); PG8_MMA(1, 0, At, B0); PG8_BAR; PG8_SCHED;
            PG8_STAGE(PG8_SB(1, 1), b3 + hstep, voffB);
            PG8_WAIT_V(6); PG8_BAR; PG8_MMA(1, 1, At, B1); PG8_BAR;
        }
        PG8_STAMP();
        if constexpr (!Epi::AFTER_DRAIN) { E(acc, cur, wr, wc, fr, fq); S.done(cur); }
        PG8_STAMP();
        if (!has_next) break;
#pragma unroll
        for (int a = 0; a < 2; ++a)
#pragma unroll
            for (int b = 0; b < 2; ++b)
#pragma unroll
                for (int m = 0; m < 4; ++m)
#pragma unroll
                    for (int n = 0; n < 2; ++n) acc[a][b][m][n] = (f32x4){0.f, 0.f, 0.f, 0.f};
        cur = nxt; cA = nA; cB = nB; ++ui;
    }
    PG8_WAIT_V(0);
    if (wr == 0) PG8_BAR;
    PG8_BAR;
    if constexpr (Epi::AFTER_DRAIN) { E.fused(acc, cur, wr, wc, fr, fq, lds, wid, lane); S.done(cur); }
    PG8_STAMP();
    if (STAMP && wid == 0) { stamps[lane] = lane < nts ? (((unsigned long long)(unsigned)ts_hi << 32) | (unsigned)ts_lo) : 0ull;
        if (lane == 62) stamps[62] = rt_entry; if (lane == 63) stamps[63] = (unsigned long long)wall_clock64(); }
#undef PG8_STAMP
#undef PG8_SA
#undef PG8_SB
#undef PG8_STAGE
#undef PG8_LDA
#undef PG8_LDB
#undef PG8_MMA
#undef PG8_WAIT_V
#undef PG8_WAIT_L
#undef PG8_BAR
#undef PG8_SCHED
}
}

struct EpiInProj {
    static constexpr bool PERM = true, AFTER_DRAIN = false;
    bf16_t* P; const float* bias; float* LR;
    __device__ __forceinline__ void operator()(const f32x4 (&acc)[2][2][4][2], const pg8::Unit& u, int wr, int wc, int fr, int fq) const {
        const int row0 = u.pm * 256 + wr * 64 + fr, colt = u.pn * 256, col0 = colt + wc * 32 + 8 * fq;
        if (colt == C_LR) {
            if (wc == 0) {
                const int cl = 8 * fq;
                const f32x4 b0 = *(const f32x4*)(bias + 4096 + cl), b1 = *(const f32x4*)(bias + 4096 + cl + 4);
#pragma unroll
                for (int ai = 0; ai < 2; ++ai)
#pragma unroll
                    for (int m = 0; m < 4; ++m) {
                        float* d = LR + (size_t)(row0 + ai * 128 + m * 16) * 32 + cl;
                        *(f32x4*)d = acc[ai][0][m][0] + b0; *(f32x4*)(d + 4) = acc[ai][0][m][1] + b1;
                    }
            }
            return;
        }
        const int mode = (colt < 512 || colt == C_GQ) ? 1 : (colt >= C_MQ && colt < C_Z) ? 2 : (colt >= C_Z && colt < C_SG) ? 3 : (colt >= C_SG) ? 4 : 0;
#pragma unroll
        for (int bj = 0; bj < 2; ++bj) {
            const int col = col0 + bj * 128;
            const f32x4 b0 = *(const f32x4*)(bias + orig_col(col)), b1 = *(const f32x4*)(bias + orig_col(col) + 4);
#pragma unroll
            for (int ai = 0; ai < 2; ++ai)
#pragma unroll
                for (int m = 0; m < 4; ++m) {
                    f32x4 v0 = acc[ai][bj][m][0] + b0, v1 = acc[ai][bj][m][1] + b1;
                    if (mode == 1) { v0 *= 0.125f; v1 *= 0.125f; }
                    else if (mode == 2) { v0 *= 0.08838834764831845f; v1 *= 0.08838834764831845f; }
                    else if (mode == 3) {
#pragma unroll
                        for (int e = 0; e < 4; ++e) { v0[e] = siluf_(v0[e]); v1[e] = siluf_(v1[e]); }
                    } else if (mode == 4) {
#pragma unroll
                        for (int e = 0; e < 4; ++e) { v0[e] = sigmoidf_(v0[e]); v1[e] = sigmoidf_(v1[e]); }
                    }
                    u32x4 o; o.x = pk2(v0[0], v0[1]); o.y = pk2(v0[2], v0[3]); o.z = pk2(v1[0], v1[1]); o.w = pk2(v1[2], v1[3]);
                    *(u32x4*)(P + (size_t)(row0 + ai * 128 + m * 16) * PS + col) = o;
                }
        }
    }
};
struct EpiOut {
    static constexpr bool PERM = false, AFTER_DRAIN = false;
    bf16_t* pre; const float* bo;
    __device__ __forceinline__ void operator()(const f32x4 (&acc)[2][2][4][2], const pg8::Unit& u, int wr, int wc, int fr, int fq) const {
        const int row0 = u.pm * 256 + wr * 64 + fr, col0 = u.pn * 256 + wc * 32 + 4 * fq;
#pragma unroll
        for (int bj = 0; bj < 2; ++bj)
#pragma unroll
            for (int n = 0; n < 2; ++n) {
                const int col = col0 + bj * 128 + n * 16;
                const f32x4 b4 = *(const f32x4*)(bo + col);
#pragma unroll
                for (int ai = 0; ai < 2; ++ai)
#pragma unroll
                    for (int m = 0; m < 4; ++m) st_bf4(pre + (size_t)(row0 + ai * 128 + m * 16) * 1024 + col, acc[ai][bj][m][n] + b4);
            }
    }
};

__device__ __forceinline__ void ln_rows_res(const Params& p, int l, size_t tok0) {
    int tid_ = threadIdx.x; asm volatile("" : "+v"(tid_));
    const int lane = tid_ & 63;
    const int gw = blockIdx.x * (NTHR / 64) + (tid_ >> 6), nw = gridDim.x * (NTHR / 64);
    const bf16_t* pre = (const bf16_t*)(p.ws + OFF_PRE); const float2* stats = (const float2*)(p.ws + OFF_STATS); bf16_t* hb = (bf16_t*)(p.ws + OFF_HB);
    const float* g = p.ln_g + l * 1024; const float* b = p.ln_b + l * 1024;
    for (int r = gw; r < TG; r += nw) {
        const size_t T = tok0 + r;
        const bf16_t* pr = pre + (size_t)r * 1024;
        float4 v[4]; float s = 0.f;
        if (l == 0) {
            const float4* xr = (const float4*)(p.x + T * 1024); const float2 st = stats[T];
#pragma unroll
            for (int i = 0; i < 4; ++i) {
                const f32x4 a4 = ld_bf4(pr + (lane + 64 * i) * 4); float4 a; a.x = a4[0]; a.y = a4[1]; a.z = a4[2]; a.w = a4[3]; const float4 x4 = xr[lane + 64 * i], g4 = ((const float4*)p.ln_in_g)[lane + 64 * i], b4 = ((const float4*)p.ln_in_b)[lane + 64 * i];
                v[i].x = a.x + DN_ALPHA * ((x4.x - st.x) * st.y * g4.x + b4.x); v[i].y = a.y + DN_ALPHA * ((x4.y - st.x) * st.y * g4.y + b4.y);
                v[i].z = a.z + DN_ALPHA * ((x4.z - st.x) * st.y * g4.z + b4.z); v[i].w = a.w + DN_ALPHA * ((x4.w - st.x) * st.y * g4.w + b4.w);
            }
        } else {
            const float4* hr = (const float4*)(p.out + T * 1024);
#pragma unroll
            for (int i = 0; i < 4; ++i) {
                const f32x4 a4 = ld_bf4(pr + (lane + 64 * i) * 4); float4 a; a.x = a4[0]; a.y = a4[1]; a.z = a4[2]; a.w = a4[3]; const float4 h4 = hr[lane + 64 * i];
                v[i].x = a.x + DN_ALPHA * h4.x; v[i].y = a.y + DN_ALPHA * h4.y; v[i].z = a.z + DN_ALPHA * h4.z; v[i].w = a.w + DN_ALPHA * h4.w;
            }
        }
#pragma unroll
        for (int i = 0; i < 4; ++i) s += (v[i].x + v[i].y) + (v[i].z + v[i].w);
        s = wave_sum(s);
        const float mean = s * (1.0f / 1024.0f);
        float q = 0.f;
#pragma unroll
        for (int i = 0; i < 4; ++i) { const float a = v[i].x - mean, bb = v[i].y - mean, c = v[i].z - mean, d = v[i].w - mean; q += (a * a + bb * bb) + (c * c + d * d); }
        q = wave_sum(q);
        const float rstd = 1.0f / sqrtf(q * (1.0f / 1024.0f) + 1e-5f);
#pragma unroll
        for (int i = 0; i < 4; ++i) {
            const float4 g4 = ((const float4*)g)[lane + 64 * i], b4 = ((const float4*)b)[lane + 64 * i];
            float4 y; y.x = (v[i].x - mean) * rstd * g4.x + b4.x; y.y = (v[i].y - mean) * rstd * g4.y + b4.y; y.z = (v[i].z - mean) * rstd * g4.z + b4.z; y.w = (v[i].w - mean) * rstd * g4.w + b4.w;
            ((float4*)(p.out + T * 1024))[lane + 64 * i] = y;
            u32x2 o; o.x = pk2(y.x, y.y); o.y = pk2(y.z, y.w); *(u32x2*)(hb + T * 1024 + (lane + 64 * i) * 4) = o;
        }
    }
}

#define XB_TMO      128
#define XB_XCNT(j)  (256  + 64 * (j))
#define XB_XSUB(j)  (1280 + 64 * (j))
#define XB_XGEN(j)  (2304 + 64 * (j))
#define XB_TOP      3328
#define XB_TOPGEN   3392
#define XCD_BAR_WORDS 3456
#define XB_SPIN_CAP (1u << 18)
#define LAS __attribute__((address_space(3)))

__device__ __forceinline__ unsigned xb_ld(unsigned* p)              { return __hip_atomic_load(p, __ATOMIC_RELAXED, __HIP_MEMORY_SCOPE_AGENT); }
__device__ __forceinline__ unsigned xb_add(unsigned* p, unsigned v) { return __hip_atomic_fetch_add(p, v, __ATOMIC_RELAXED, __HIP_MEMORY_SCOPE_AGENT); }
__device__ __forceinline__ unsigned xb_xcc_id() { return (unsigned)__builtin_amdgcn_s_getreg((3 << 11) | 20) & 0xFu; }
#define XB_SPIN(cond, bar) do { unsigned _sp = 0; while (cond) { __builtin_amdgcn_s_sleep(1); \
    if ((++_sp & 255u) == 0u) { if (xb_ld(&(bar)[XB_TMO])) break; if (_sp > XB_SPIN_CAP) { atomicAdd(&(bar)[XB_TMO], 1u); break; } } } } while (0)

struct XcdBarrier {
    unsigned* bar; unsigned x;
    volatile LAS unsigned* st;
};

__device__ __forceinline__ XcdBarrier xcd_barrier_post(unsigned* bar, volatile LAS unsigned* st) {
    XcdBarrier b; b.bar = bar; b.x = xb_xcc_id(); b.st = st;
    if (threadIdx.x == 0) (void)xb_add(&bar[XB_XCNT(b.x)], 1u);
    return b;
}
__device__ __forceinline__ void xcd_barrier_complete(unsigned* bar, unsigned x, unsigned& nloc, unsigned& nx) {
    const unsigned G = gridDim.x * gridDim.y * gridDim.z;
    unsigned sum, cnt, mine, sp = 0u;
    for (;;) {
        sum = 0u; cnt = 0u; mine = 0u;
#pragma unroll
        for (unsigned j = 0; j < 16; ++j) { const unsigned c = xb_ld(&bar[XB_XCNT(j)]); sum += c; cnt += (c > 0u) ? 1u : 0u; mine = (j == x) ? c : mine; }
        if (sum == G) break;
        __builtin_amdgcn_s_sleep(1);
        if ((++sp & 255u) == 0u) { if (xb_ld(&bar[XB_TMO])) break; if (sp > XB_SPIN_CAP) { atomicAdd(&bar[XB_TMO], 1u); break; } }
    }
    nloc = mine > 0u ? mine : 1u; nx = cnt > 0u ? cnt : 1u;
}

__device__ __forceinline__ void xcd_barrier(unsigned* b_bar, unsigned b_x, volatile LAS unsigned* b_st) {
    asm volatile("s_waitcnt vmcnt(0)" ::: "memory");
    __syncthreads();
    if (threadIdx.x == 0) {
        unsigned* bar = b_bar;
        __builtin_amdgcn_s_waitcnt(0);
        unsigned nloc = b_st[0], nx = b_st[1];
        if (nloc == 0u) { xcd_barrier_complete(bar, b_x, nloc, nx); b_st[0] = nloc; b_st[1] = nx; }
        const unsigned old = xb_add(&bar[XB_XSUB(b_x)], 1u);
        const unsigned gen = old / nloc;
        if (old + 1u == (gen + 1u) * nloc) {
            __builtin_amdgcn_fence(__ATOMIC_RELEASE, "agent");
            asm volatile("s_waitcnt vmcnt(0)" ::: "memory");
            const unsigned og = xb_add(&bar[XB_TOP], 1u);
            const unsigned tg = og / nx;
            if (og + 1u == (tg + 1u) * nx) xb_add(&bar[XB_TOPGEN], 1u);
            else XB_SPIN(xb_ld(&bar[XB_TOPGEN]) == tg, bar);
            __builtin_amdgcn_fence(__ATOMIC_ACQUIRE, "agent");
            xb_add(&bar[XB_XGEN(b_x)], 1u);
            asm volatile("s_waitcnt vmcnt(0)" ::: "memory");
        } else {
            XB_SPIN(xb_ld(&bar[XB_XGEN(b_x)]) == gen, bar);
            __builtin_amdgcn_fence(__ATOMIC_ACQUIRE, "agent");
            asm volatile("s_waitcnt vmcnt(0)" ::: "memory");
        }
    }
    __syncthreads();
}

__device__ __forceinline__ void gbar(unsigned* ctr, unsigned& gen, int G) {
    __syncthreads();
    gen += (unsigned)G;
    if (threadIdx.x == 0) {
        __threadfence();
        __hip_atomic_fetch_add(ctr, 1u, __ATOMIC_RELAXED, __HIP_MEMORY_SCOPE_AGENT);
        while (__hip_atomic_load(ctr, __ATOMIC_RELAXED, __HIP_MEMORY_SCOPE_AGENT) < gen) __builtin_amdgcn_s_sleep(1);
        __threadfence();
    }
    __syncthreads();
}
typedef const Params __attribute__((address_space(4))) KParams;
#define KP4 __attribute__((address_space(4)))
__device__ __forceinline__ Params fresh_params() {
#if defined(__HIP_DEVICE_COMPILE__)
    KParams* kp = (KParams*)__builtin_amdgcn_kernarg_segment_ptr();
    asm volatile("" : "+s"(kp));
    Params r;
    const float* KP4 const* src = (const float* KP4 const*)kp;
    const float** dst = (const float**)&r;
#pragma unroll
    for (int i = 0; i < 28; ++i) dst[i] = src[i];
    return r;
#else
    return Params{};
#endif
}
__global__ void __launch_bounds__(NTHR) mega(Params p_unused) {
    extern __shared__ __attribute__((aligned(16))) unsigned char lds[];
    cg::grid_group grid = cg::this_grid();
    const int G = gridDim.x, bid = blockIdx.x;
    volatile LAS unsigned* xst = (volatile LAS unsigned*)((LAS unsigned char*)lds + (LDS_BYTES - 16));
    if (threadIdx.x == 0) { xst[0] = 0u; xst[1] = 0u; }
    __syncthreads();
    unsigned* xbar; unsigned xx;
    { const Params p = fresh_params(); xbar = (unsigned*)(p.ws + OFF_BAR); xx = xb_xcc_id(); if (threadIdx.x == 0) (void)xb_add(&xbar[XB_XCNT(xx)], 1u); }
    { const Params p = fresh_params(); phase0(p); }
    grid.sync();
#pragma unroll 1
    for (int l = 0; l < 2; ++l) {
        { const Params p = fresh_params(); phase_weights(p, l, lds); __syncthreads(); phase_filter_gen(p, l, lds); }
        xcd_barrier(xbar, xx, xst);
        {
            const Params p = fresh_params();
            phase_filter_fft(p, l, lds);
            const bf16_t* WtKV = (const bf16_t*)(p.ws + OFF_WTKV); const bf16_t* membf = (const bf16_t*)(p.ws + OFF_MEMBF);
            for (int t = bid; t < 64; t += G) {
                f32x4 acc[4][4];
                if (t < 32) {
                    const int m0 = (t >> 2) * 256, n0 = (t & 3) * 128;
                    gemm_core(acc, membf + (size_t)m0 * 1024, 1024, WtKV + (size_t)n0 * 1024, 1024, 1024, lds);
                    bf16_t* Km = (bf16_t*)(p.ws + OFF_KMAT);
                    EPI_LOOP(st_bf4(Km + (size_t)row * 512 + col, v);)
                } else {
                    const int t2 = t - 32, m0 = (t2 >> 4) * 256, n0 = (t2 & 15) * 128;
                    gemm_core(acc, WtKV + (size_t)(512 + m0) * 1024, 1024, membf + (size_t)n0 * 1024, 1024, 1024, lds);
                    bf16_t* Vm = (bf16_t*)(p.ws + OFF_VT);
                    EPI_LOOP(st_bf4(Vm + (size_t)row * 2048 + col, v);)
                }
            }
        }
        xcd_barrier(xbar, xx, xst);
#pragma unroll 1
        for (int g = 0; g < NGRP; ++g) {
            const size_t tok0 = (size_t)g * TG;
#pragma unroll 1
            for (int rep = 0; rep < PROBE_REP_INPROJ; ++rep) {
                const Params p = fresh_params();
                pg8::Gemm gm; gm.A = (const bf16_t*)(p.ws + OFF_HB) + tok0 * 1024; gm.Bt = (const bf16_t*)(p.ws + OFF_WTIN); gm.M = TG; gm.N = NINP; gm.K = 1024;
                pg8::StaticOrder S; S.init(TG, NINP, G, bid);
                EpiInProj E; E.P = (bf16_t*)(p.ws + OFF_P); E.bias = p.b_in + (size_t)l * NIN; E.LR = (float*)(p.ws + OFF_LR);
                pg8::gemm_phase<EpiInProj, pg8::StaticOrder, false>((PG8_LAS unsigned char*)lds, gm, S, E, nullptr);
                __syncthreads();
            }
            xcd_barrier(xbar, xx, xst);
#pragma unroll 1
            for (int rep = 0; rep < PROBE_REP_MIX; ++rep) {
            int dry = (rep + 1 < PROBE_REP_MIX) ? 1 : 0; asm volatile("" : "+s"(dry));
            {
                const Params p = fresh_params();
                bf16_t* P = (bf16_t*)(p.ws + OFF_P);
                for (int it = bid; it < BG * 64 * 8; it += G) na_item(p, l, P, it >> 9, (it >> 3) & 63, it & 7, lds, dry);
            }
            {
                const Params p = fresh_params();
                bf16_t* P = (bf16_t*)(p.ws + OFF_P);
                for (int it = bid; it < BG * 128 * 8; it += G) hy_pre_item(p, l, P, (float*)(p.ws + OFF_UT), (bf16_t*)(p.ws + OFF_GT), it >> 10, (it >> 3) & 127, it & 7, lds);
            }
            {
                const Params p = fresh_params();
                for (int it = bid; it < NITEM; it += G) gla_part1_item(p, l, (const bf16_t*)(p.ws + OFF_P), (const float*)(p.ws + OFF_LR), it, lds);
            }
            {
                const Params p = fresh_params();
                bf16_t* P = (bf16_t*)(p.ws + OFF_P);
                const int nit = BG * 4 * 64, per = (nit + G - 1) / G;
                int last = -1;
                for (int it = bid * per; it < min(nit, (bid + 1) * per); ++it) {
                    const int bh = it >> 6, bl = bh >> 2, h = bh & 3;
                    if (bh != last) { __syncthreads(); memattn_load(p, g * BG + bl, h, lds); last = bh; }
                    memattn_item(P, bl, h, it & 63, lds, dry);
                }
                __syncthreads();
            }
            xcd_barrier(xbar, xx, xst);
            {
                const Params p = fresh_params();
                const float2* twl = fft_lds_twiddles((const float2*)(p.ws + OFF_TW), lds);
                for (int it = bid; it < BG * 256; it += G) hyena_conv_item(p, (const float*)(p.ws + OFF_UT), (bf16_t*)(p.ws + OFF_GT), it >> 8, it & 255, lds, twl, dry);
                __syncthreads();
                gla_scan(p, dry);
            }
            xcd_barrier(xbar, xx, xst);
            {
                const Params p = fresh_params();
                for (int it = bid; it < NITEM; it += G) gla_part2_item(p, l, (bf16_t*)(p.ws + OFF_P), (const float*)(p.ws + OFF_LR), it, lds, dry);
            }
            {
                const Params p = fresh_params();
                for (int it = bid; it < BG * 128 * 8; it += G) hy_post_item((bf16_t*)(p.ws + OFF_P), (const bf16_t*)(p.ws + OFF_GT), it >> 10, (it >> 3) & 127, it & 7, lds, dry);
            }
            xcd_barrier(xbar, xx, xst);
            }
            {
                const Params p = fresh_params();
                const bf16_t* P = (const bf16_t*)(p.ws + OFF_P); const bf16_t* WtBr = (const bf16_t*)(p.ws + OFF_WTBR); bf16_t* merged = (bf16_t*)(p.ws + OFF_MERGED);
                for (int t = bid; t < 512; t += G) {
                    const int sr = t >> 8, sb = t & 255, sx = sb & 7, sk = sb >> 3;
                    const int m0 = (sr * 32 + (sk >> 3) * 8 + sx) * 256, n0 = (sk & 7) * 128;
                    merge_tile(P, WtBr, merged, m0, n0, lds);
                }
            }
            xcd_barrier(xbar, xx, xst);
            {
                const Params p = fresh_params();
                pg8::Gemm gm; gm.A = (const bf16_t*)(p.ws + OFF_MERGED); gm.Bt = (const bf16_t*)(p.ws + OFF_WTOUT); gm.M = TG; gm.N = 1024; gm.K = 1024;
                pg8::StaticOrder S; S.init(TG, 1024, G, bid);
                EpiOut E; E.pre = (bf16_t*)(p.ws + OFF_PRE); E.bo = p.b_out + l * 1024;
                pg8::gemm_phase<EpiOut, pg8::StaticOrder, false>((PG8_LAS unsigned char*)lds, gm, S, E, nullptr);
                __syncthreads();
            }
            xcd_barrier(xbar, xx, xst);
            {
                const Params p = fresh_params();
                ln_rows_res(p, l, tok0);
            }
        }
        xcd_barrier(xbar, xx, xst);
    }
}

extern "C" void kernel_launch(void* const* d_in, const int* in_sizes, int n_in, void* d_out, int out_size, void* d_ws, size_t ws_size, hipStream_t stream) {
    static int grid_blocks = 0;
    if (!grid_blocks) {
        if (ws_size < WS_END) { fprintf(stderr, "kernel_launch: workspace too small: %zu < %zu\n", ws_size, (size_t)WS_END); grid_blocks = -1; return; }
        {
            const long long ex[26] = {67108864LL, 2097152LL, 1024, 1024, 2LL * 1024 * 10784, 2 * 10784, 2 * 8 * 15 * 31, 2 * 3 * 1536, 2 * 1536, 2 * 33 * 64, 2 * 64, 2 * 2 * 64 * 64, 2 * 2 * 64,
                                      2 * 64 * 1024, 2 * 512, 2 * 16 * 256, 2 * 256, 2 * 16 * 256, 2 * 256, 2 * 512, 2LL * 1024 * 1024, 2LL * 4 * 512 * 1024, 2LL * 1024 * 1024, 2 * 1024, 2 * 1024, 2 * 1024};
            bool bad = (n_in != 26) || (out_size != 67108864);
            for (int i = 0; i < 26 && !bad; ++i) if ((long long)in_sizes[i] != ex[i]) { fprintf(stderr, "kernel_launch: input %d has %d elements, expected %lld\n", i, in_sizes[i], ex[i]); bad = true; }
            if (bad) { fprintf(stderr, "kernel_launch: unexpected shapes; nothing launched\n"); grid_blocks = -1; return; }
        }
        int dev = 0, cus = 0, per_cu = 0;
        hipGetDevice(&dev);
        hipDeviceGetAttribute(&cus, hipDeviceAttributeMultiprocessorCount, dev);
        if (hipFuncSetAttribute((const void*)mega, hipFuncAttributeMaxDynamicSharedMemorySize, LDS_BYTES) != hipSuccess) fprintf(stderr, "kernel_launch: hipFuncSetAttribute failed\n");
        if (hipOccupancyMaxActiveBlocksPerMultiprocessor(&per_cu, (const void*)mega, NTHR, LDS_BYTES) != hipSuccess || per_cu < 1) { fprintf(stderr, "kernel_launch: occupancy query gave %d\n", per_cu); per_cu = 1; }
        (void)hipGetLastError();
        if (per_cu > 1) per_cu = 1;
        grid_blocks = cus * per_cu;
    }
    if (grid_blocks < 0) return;
    Params p{};
    const float** pp = (const float**)&p;
    for (int i = 0; i < 26; ++i) pp[i] = (const float*)d_in[i];
    p.out = (float*)d_out; p.ws = (unsigned char*)d_ws;
    if (hipMemsetAsync((unsigned char*)d_ws + OFF_BAR, 0, 16384, stream) != hipSuccess) fprintf(stderr, "kernel_launch: memset of the barrier word failed\n");
    void* args[] = {&p};
    hipError_t e = hipLaunchCooperativeKernel((const void*)mega, dim3(grid_blocks), dim3(NTHR), args, LDS_BYTES, stream);
    if (e != hipSuccess) fprintf(stderr, "cooperative launch failed: %s (grid %d)\n", hipGetErrorString(e), grid_blocks);
}
#endif
```

```cpp
#ifndef PROBE_REP_MIX
#define PROBE_REP_MIX 1
#endif
#ifndef PROBE_REP_INPROJ
#define PROBE_REP_INPROJ 1
#endif
#include <hip/hip_runtime.h>
#include <hip/hip_cooperative_groups.h>
#include <cstdio>
#include <unistd.h>
#include <cmath>
namespace cg = cooperative_groups;

#define HD __host__ __device__
typedef unsigned short bf16_t;
typedef short bf16x8 __attribute__((ext_vector_type(8)));
typedef float f32x4 __attribute__((ext_vector_type(4)));
typedef unsigned u32x2 __attribute__((ext_vector_type(2)));
typedef unsigned u32x4 __attribute__((ext_vector_type(4)));

constexpr int NTOK = 65536, DM = 1024, SEQ = 8192, NB = 8;
constexpr int BG = 2;
constexpr int NGRP = NB / BG;
constexpr int TG = BG * SEQ;
constexpr int PS = 10752;
constexpr int NIN = 10784, NINP = 11008;
constexpr int C_NAQ = 0, C_NAK = 512, C_NAV = 1024, C_HY = 1536, C_GQ = 3072, C_GK = 3328, C_GV = 3584, C_MQ = 4096, C_Z = 4608, C_SG = 6656, C_LR = 10752;
constexpr int FN = 16384;
constexpr int NITEM = BG * 128 * 4;
constexpr int LDS_BYTES = 160 * 1024;
constexpr int NTHR = 512;
constexpr float DN_ALPHA = 1.41421356237309515f;

constexpr size_t al256(size_t x) { return (x + 255) & ~(size_t)255; }
constexpr size_t OFF_HB = 0;
constexpr size_t OFF_STATS = OFF_HB + (size_t)NTOK * DM * 2;
constexpr size_t OFF_TW = OFF_STATS + (size_t)NTOK * 8;
constexpr size_t OFF_MEMBF = OFF_TW + (size_t)FN * 8;
constexpr size_t OFF_ENERGY = OFF_MEMBF + (size_t)2048 * 1024 * 2;
constexpr size_t OFF_WTIN = OFF_ENERGY + 4096;
constexpr size_t OFF_WTBR = OFF_WTIN + (size_t)NINP * 1024 * 2;
constexpr size_t OFF_WTOUT = OFF_WTBR + (size_t)4 * 1024 * 512 * 2;
constexpr size_t OFF_WTKV = OFF_WTOUT + (size_t)1024 * 1024 * 2;
constexpr size_t OFF_KMAT = OFF_WTKV + (size_t)2048 * 1024 * 2;
constexpr size_t OFF_VT = OFF_KMAT + (size_t)2048 * 1024 * 2;
constexpr size_t OFF_HFILT = OFF_VT + (size_t)2048 * 1024 * 2;
constexpr size_t OFF_PQ = OFF_HFILT + (size_t)1024 * 8192 * 4;
constexpr size_t OFF_P = OFF_PQ + (size_t)256 * FN * 16;
constexpr size_t OFF_LR = OFF_P + (size_t)TG * PS * 2;
constexpr size_t OFF_GS = OFF_LR + (size_t)TG * 32 * 4;
constexpr size_t OFF_GDEC = OFF_GS + (size_t)2 * NITEM * 8192 * 4;
constexpr size_t OFF_MERGED = OFF_GDEC + (size_t)2 * NITEM * 64 * 4;
constexpr size_t OFF_PRE = OFF_MERGED + (size_t)TG * 1024 * 2;
constexpr size_t OFF_UT = OFF_PRE + (size_t)TG * 1024 * 4;
constexpr size_t OFF_GT = OFF_UT + (size_t)BG * 512 * 8192 * 4;
constexpr size_t OFF_BAR = OFF_GT + (size_t)BG * 512 * 8192 * 2;
constexpr size_t OFF_ZT = OFF_BAR + 16384;
constexpr size_t OFF_TB = al256(OFF_ZT + (size_t)8192 * 33 * 4);
constexpr size_t OFF_SB = OFF_TB + (size_t)NITEM * 8192 * 4;
constexpr size_t WS_END = OFF_SB + (size_t)2 * NITEM * 8192 * 2;

struct Params {
    const float *x, *mem, *ln_in_g, *ln_in_b, *w_in, *b_in, *na_rpb, *hy_conv_w, *hy_conv_b, *hy_w1, *hy_b1, *hy_wm, *hy_bm, *hy_w3, *hy_skip,
        *gla_up_f, *gla_bias_f, *gla_up_b, *gla_bias_b, *gla_norm_g, *mem_w_kv, *w_br, *w_out, *b_out, *ln_g, *ln_b;
    float* out;
    unsigned char* ws;
};

HD inline float bf2f(bf16_t b) {
    union { unsigned u; float f; } c; c.u = (unsigned)b << 16; return c.f;
}
HD inline bf16_t f2bf(float f) {
    union { unsigned u; float f; } c; c.f = f; unsigned u = c.u; u += 0x7fffu + ((u >> 16) & 1u); return (bf16_t)(u >> 16);
}
typedef float f32x2_t __attribute__((ext_vector_type(2)));
typedef __bf16 bf16x2_t __attribute__((ext_vector_type(2)));
__device__ __forceinline__ unsigned pk2(float lo, float hi) { const f32x2_t v = {lo, hi}; const bf16x2_t b = __builtin_convertvector(v, bf16x2_t); return __builtin_bit_cast(unsigned, b); }
__device__ __forceinline__ bf16_t f2bf_d(float f) { return (bf16_t)(pk2(f, f) & 0xffffu); }
__device__ __forceinline__ float lo16(unsigned u) { return __uint_as_float(u << 16); }
__device__ __forceinline__ float hi16(unsigned u) { return __uint_as_float(u & 0xffff0000u); }
__device__ __forceinline__ float wave_sum(float v) {
#pragma unroll
    for (int o = 32; o >= 1; o >>= 1) v += __shfl_xor(v, o);
    return v;
}
__device__ __forceinline__ float sigmoidf_(float x) { return __builtin_amdgcn_rcpf(1.0f + __expf(-x)); }
__device__ __forceinline__ float siluf_(float x) { return x * __builtin_amdgcn_rcpf(1.0f + __expf(-x)); }
__device__ __forceinline__ float logsigf_(float x) { return fminf(x, 0.0f) - __logf(1.0f + __expf(-fabsf(x))); }
__device__ __forceinline__ bf16x8 mkfrag(u32x4 v) { return __builtin_bit_cast(bf16x8, v); }
__device__ __forceinline__ bf16x8 mkfrag2(u32x2 a, u32x2 b) { u32x4 v = {a.x, a.y, b.x, b.y}; return __builtin_bit_cast(bf16x8, v); }
#define MFMA(a, b, c) __builtin_amdgcn_mfma_f32_16x16x32_bf16((a), (b), (c), 0, 0, 0)
HD inline int iclamp(int v, int lo, int hi) { return v < lo ? lo : (v > hi ? hi : v); }

HD inline float2 cmulf(float2 a, float2 b) { float2 r; r.x = a.x * b.x - a.y * b.y; r.y = a.x * b.y + a.y * b.x; return r; }
HD inline float2 cmulcf(float2 a, float2 b) { float2 r; r.x = a.x * b.x + a.y * b.y; r.y = a.y * b.x - a.x * b.y; return r; }
struct Bfly { float2 x0, x1, x2, x3, W1; int i0; };
HD inline void bfly_load(Bfly& b, const float2* d, const float2* tw, int lgm, int q) {
    const int m = 1 << lgm, blk = q >> lgm, j = q & (m - 1);
    b.i0 = (blk << (lgm + 2)) + j;
    b.W1 = tw[j];
    b.x0 = d[b.i0]; b.x1 = d[b.i0 + m]; b.x2 = d[b.i0 + 2 * m]; b.x3 = d[b.i0 + 3 * m];
}
HD inline void bfly_fwd_store(const Bfly& b, float2* d, int lgm) {
    const int m = 1 << lgm, i0 = b.i0;
    const float2 W1 = b.W1, W2 = cmulf(W1, W1);
    const float2 x0 = b.x0, x1 = b.x1, x2 = b.x2, x3 = b.x3;
    float2 a0, a1, a2, a3, t;
    a0.x = x0.x + x2.x; a0.y = x0.y + x2.y;
    t.x = x0.x - x2.x; t.y = x0.y - x2.y; a2 = cmulf(t, W1);
    a1.x = x1.x + x3.x; a1.y = x1.y + x3.y;
    t.x = x1.x - x3.x; t.y = x1.y - x3.y; t = cmulf(t, W1); a3.x = t.y; a3.y = -t.x;
    float2 r;
    r.x = a0.x + a1.x; r.y = a0.y + a1.y; d[i0] = r;
    t.x = a0.x - a1.x; t.y = a0.y - a1.y; d[i0 + m] = cmulf(t, W2);
    r.x = a2.x + a3.x; r.y = a2.y + a3.y; d[i0 + 2 * m] = r;
    t.x = a2.x - a3.x; t.y = a2.y - a3.y; d[i0 + 3 * m] = cmulf(t, W2);
}
HD inline void bfly_inv_store(const Bfly& b, float2* d, int lgm) {
    const int m = 1 << lgm, i0 = b.i0;
    const float2 W1 = b.W1, W2 = cmulf(W1, W1);
    const float2 x0 = b.x0, x1 = b.x1, x2 = b.x2, x3 = b.x3;
    const float2 b1 = cmulcf(x1, W2), b3 = cmulcf(x3, W2);
    float2 y0, y1, y2, y3;
    y0.x = x0.x + b1.x; y0.y = x0.y + b1.y; y1.x = x0.x - b1.x; y1.y = x0.y - b1.y;
    y2.x = x2.x + b3.x; y2.y = x2.y + b3.y; y3.x = x2.x - b3.x; y3.y = x2.y - b3.y;
    const float2 c2 = cmulcf(y2, W1); float2 c3 = cmulcf(y3, W1); { const float tx = -c3.y, ty = c3.x; c3.x = tx; c3.y = ty; }
    float2 r;
    r.x = y0.x + c2.x; r.y = y0.y + c2.y; d[i0] = r;
    r.x = y0.x - c2.x; r.y = y0.y - c2.y; d[i0 + 2 * m] = r;
    r.x = y1.x + c3.x; r.y = y1.y + c3.y; d[i0 + m] = r;
    r.x = y1.x - c3.x; r.y = y1.y - c3.y; d[i0 + 3 * m] = r;
}
HD inline void fft_fwd_bfly(float2* d, const float2* tw, int lgm, int q) { Bfly b; bfly_load(b, d, tw, lgm, q); bfly_fwd_store(b, d, lgm); }
HD inline void fft_inv_bfly(float2* d, const float2* tw, int lgm, int q) { Bfly b; bfly_load(b, d, tw, lgm, q); bfly_inv_store(b, d, lgm); }
HD inline void r4_fwd(float2& x0, float2& x1, float2& x2, float2& x3, const float2 W1) {
    const float2 W2 = cmulf(W1, W1);
    float2 a0, a1, a2, a3, t;
    a0.x = x0.x + x2.x; a0.y = x0.y + x2.y;
    t.x = x0.x - x2.x; t.y = x0.y - x2.y; a2 = cmulf(t, W1);
    a1.x = x1.x + x3.x; a1.y = x1.y + x3.y;
    t.x = x1.x - x3.x; t.y = x1.y - x3.y; t = cmulf(t, W1); a3.x = t.y; a3.y = -t.x;
    x0.x = a0.x + a1.x; x0.y = a0.y + a1.y;
    t.x = a0.x - a1.x; t.y = a0.y - a1.y; x1 = cmulf(t, W2);
    x2.x = a2.x + a3.x; x2.y = a2.y + a3.y;
    t.x = a2.x - a3.x; t.y = a2.y - a3.y; x3 = cmulf(t, W2);
}
HD inline void r4_inv(float2& x0, float2& x1, float2& x2, float2& x3, const float2 W1) {
    const float2 W2 = cmulf(W1, W1);
    const float2 b1 = cmulcf(x1, W2), b3 = cmulcf(x3, W2);
    float2 y0, y1, y2, y3;
    y0.x = x0.x + b1.x; y0.y = x0.y + b1.y; y1.x = x0.x - b1.x; y1.y = x0.y - b1.y;
    y2.x = x2.x + b3.x; y2.y = x2.y + b3.y; y3.x = x2.x - b3.x; y3.y = x2.y - b3.y;
    const float2 c2 = cmulcf(y2, W1); float2 c3 = cmulcf(y3, W1); { const float tx = -c3.y, ty = c3.x; c3.x = tx; c3.y = ty; }
    x0.x = y0.x + c2.x; x0.y = y0.y + c2.y; x2.x = y0.x - c2.x; x2.y = y0.y - c2.y;
    x1.x = y1.x + c3.x; x1.y = y1.y + c3.y; x3.x = y1.x - c3.x; x3.y = y1.y - c3.y;
}
template <bool INV, bool HALF>
HD inline void r16_bfly(float2* d, const float2* twO, const float2* twI, int lgm, int q) {
    const int m = 1 << lgm, blk = q >> lgm, j = q & (m - 1), base = (blk << (lgm + 4)) + j;
    float2 e[4][4];
#pragma unroll
    for (int a = 0; a < 4; ++a)
#pragma unroll
        for (int b = 0; b < 4; ++b) {
            if (!INV && HALF && a >= 2) { e[a][b].x = 0.f; e[a][b].y = 0.f; }
            else e[a][b] = d[base + ((4 * a + b) << lgm)];
        }
    const float2 wI = twI[j];
    float2 wO[4];
#pragma unroll
    for (int b = 0; b < 4; ++b) wO[b] = twO[j + (b << lgm)];
    if (!INV) {
#pragma unroll
        for (int b = 0; b < 4; ++b) r4_fwd(e[0][b], e[1][b], e[2][b], e[3][b], wO[b]);
#pragma unroll
        for (int a = 0; a < 4; ++a) r4_fwd(e[a][0], e[a][1], e[a][2], e[a][3], wI);
    } else {
#pragma unroll
        for (int a = 0; a < 4; ++a) r4_inv(e[a][0], e[a][1], e[a][2], e[a][3], wI);
#pragma unroll
        for (int b = 0; b < 4; ++b) r4_inv(e[0][b], e[1][b], e[2][b], e[3][b], wO[b]);
    }
#pragma unroll
    for (int a = 0; a < 4; ++a)
#pragma unroll
        for (int b = 0; b < 4; ++b)
            if (!(INV && HALF && a >= 2)) d[base + ((4 * a + b) << lgm)] = e[a][b];
}
HD inline int brev14(int k) {
#if defined(__HIP_DEVICE_COMPILE__)
    return (int)(__brev((unsigned)k) >> 18);
#endif
    unsigned v = (unsigned)k;
    v = ((v >> 1) & 0x55555555u) | ((v & 0x55555555u) << 1);
    v = ((v >> 2) & 0x33333333u) | ((v & 0x33333333u) << 2);
    v = ((v >> 4) & 0x0f0f0f0fu) | ((v & 0x0f0f0f0fu) << 4);
    v = ((v >> 8) & 0x00ff00ffu) | ((v & 0x00ff00ffu) << 8);
    v = (v >> 16) | (v << 16);
    return (int)(v >> 18);
}
struct PwIn { float2 Z1, Z2; float4 A, B; int p1, p2; };
HD inline void pw_load(PwIn& w, const float2* d, const float4* pq, int p1) {
    const int kf = brev14(p1), k2 = (FN - kf) & (FN - 1); w.p1 = p1; w.p2 = brev14(k2);
    w.Z1 = d[w.p1]; w.Z2 = d[w.p2]; w.A = pq[w.p1]; w.B.x = w.A.x; w.B.y = -w.A.y; w.B.z = w.A.z; w.B.w = -w.A.w;
}
HD inline void pw_store(const PwIn& w, float2* d) {
    const float2 Z1 = w.Z1, Z2 = w.Z2;
    float2 P1, Q1, P2, Q2; P1.x = w.A.x; P1.y = w.A.y; Q1.x = w.A.z; Q1.y = w.A.w; P2.x = w.B.x; P2.y = w.B.y; Q2.x = w.B.z; Q2.y = w.B.w;
    float2 c1, c2; c1.x = Z1.x; c1.y = -Z1.y; c2.x = Z2.x; c2.y = -Z2.y;
    const float2 a = cmulf(Z1, P1), b = cmulf(c2, Q1), c = cmulf(Z2, P2), e = cmulf(c1, Q2);
    float2 w1, w2; w1.x = a.x + b.x; w1.y = a.y + b.y; w2.x = c.x + e.x; w2.y = c.y + e.y;
    d[w.p1] = w1;
    if (w.p2 != w.p1) d[w.p2] = w2;
}
HD inline void conv_pointwise(float2* d, const float4* pq, int p1) { PwIn w; pw_load(w, d, pq, p1); pw_store(w, d); }
HD inline void filt_pointwise(const float2* d, float4* pq, int p1) {
    const int kf = brev14(p1), k2 = (FN - kf) & (FN - 1), p2 = brev14(k2);
    const float2 Z1 = d[p1], Z2 = d[p2];
    const float gcx = 0.5f * (Z1.x + Z2.x), gcy = 0.5f * (Z1.y - Z2.y);
    const float gdx = 0.5f * (Z1.y + Z2.y), gdy = -0.5f * (Z1.x - Z2.x);
    const float s = 0.5f / (float)FN;
    float4 A; A.x = s * (gcx + gdx); A.y = s * (gcy + gdy); A.z = s * (gcx - gdx); A.w = s * (gcy - gdy);
    pq[p1] = A;
}
HD inline int tw_off(int lgm) { return lgm == 10 ? 0 : lgm == 8 ? 1024 : lgm == 6 ? 1280 : lgm == 4 ? 1344 : lgm == 2 ? 1360 : 1364; }
#ifndef FFT_HOST_TEST
template <int LGM, bool INV>
__device__ __forceinline__ void fft_pass(float2* d, const float2* twl, const float2* twg, int tid) {
    const float2* tw = (LGM == 12) ? twg : twl + tw_off(LGM);
#pragma unroll
    for (int it = 0; it < 2; ++it) {
        const int q = tid + it * 4 * NTHR;
        Bfly b0, b1, b2, b3;
        bfly_load(b0, d, tw, LGM, q); bfly_load(b1, d, tw, LGM, q + NTHR); bfly_load(b2, d, tw, LGM, q + 2 * NTHR); bfly_load(b3, d, tw, LGM, q + 3 * NTHR);
        if (INV) { bfly_inv_store(b0, d, LGM); bfly_inv_store(b1, d, LGM); bfly_inv_store(b2, d, LGM); bfly_inv_store(b3, d, LGM); }
        else { bfly_fwd_store(b0, d, LGM); bfly_fwd_store(b1, d, LGM); bfly_fwd_store(b2, d, LGM); bfly_fwd_store(b3, d, LGM); }
    }
    __syncthreads();
}
template <int LGM, bool INV, bool HALF>
__device__ __forceinline__ void fft_pass16(float2* d, const float2* twl, const float2* twg, int tid) {
    const float2* twO = (LGM + 2 == 12) ? twg : twl + tw_off(LGM + 2);
    const float2* twI = twl + tw_off(LGM);
    r16_bfly<INV, HALF>(d, twO, twI, LGM, tid);
    r16_bfly<INV, HALF>(d, twO, twI, LGM, tid + NTHR);
    __syncthreads();
}
template <bool HALF>
__device__ __forceinline__ void fft_forward(float2* d, const float2* twl, const float2* twg) {
    int tid = threadIdx.x; asm volatile("" : "+v"(tid));
    fft_pass16<10, false, HALF>(d, twl, twg, tid); fft_pass16<6, false, false>(d, twl, twg, tid);
    fft_pass<4, false>(d, twl, twg, tid); fft_pass<2, false>(d, twl, twg, tid); fft_pass<0, false>(d, twl, twg, tid);
}
template <bool HALF>
__device__ __forceinline__ void fft_inverse(float2* d, const float2* twl, const float2* twg) {
    int tid = threadIdx.x; asm volatile("" : "+v"(tid));
    fft_pass<0, true>(d, twl, twg, tid); fft_pass<2, true>(d, twl, twg, tid); fft_pass<4, true>(d, twl, twg, tid);
    fft_pass16<6, true, false>(d, twl, twg, tid); fft_pass16<10, true, HALF>(d, twl, twg, tid);
}
__device__ __forceinline__ float2* fft_lds_twiddles(const float2* twg, unsigned char* lds) {
    int tid = threadIdx.x; asm volatile("" : "+v"(tid));
    float2* t = (float2*)(lds + 131072);
    for (int k = tid; k < 1365; k += NTHR) {
        const int lgm = k < 1024 ? 10 : k < 1280 ? 8 : k < 1344 ? 6 : k < 1360 ? 4 : k < 1364 ? 2 : 0;
        t[k] = twg[(k - tw_off(lgm)) << (12 - lgm)];
    }
    __syncthreads();
    return t;
}

constexpr int STG = 49152;
__device__ __forceinline__ int swz(int row, int ch) { return row * 128 + ((ch ^ ((row >> 1) & 7)) << 4); }
__device__ __forceinline__ void gemm_core(f32x4 (&acc)[4][4], const bf16_t* A, int lda, const bf16_t* Bt, int ldb, int K, unsigned char* lds) {
    int tid_ = threadIdx.x; asm volatile("" : "+v"(tid_)); const int tid = tid_, lane = tid & 63, w = tid >> 6, wm = w & 3, wn = w >> 2, l15 = lane & 15, q4 = lane >> 4;
    const int wu = __builtin_amdgcn_readfirstlane(w);
    __attribute__((address_space(3))) unsigned char* l3 = (__attribute__((address_space(3))) unsigned char*)lds;
#pragma unroll
    for (int mi = 0; mi < 4; ++mi)
#pragma unroll
        for (int ni = 0; ni < 4; ++ni) acc[mi][ni] = (f32x4){0.f, 0.f, 0.f, 0.f};
    const int r8 = lane >> 3, sch = (lane & 7) ^ ((((w & 1) << 2) + (r8 >> 1)) & 7);
    const bf16_t* ap = A + (size_t)(w * 8 + r8) * lda + sch * 8;
    const bf16_t* bp = Bt + (size_t)(w * 8 + r8) * ldb + sch * 8;
#define GC_STAGE(buf, k0)                                                                                                                         \
    {                                                                                                                                             \
        _Pragma("unroll") for (int i = 0; i < 4; ++i)                                                                                             \
            __builtin_amdgcn_global_load_lds((const unsigned*)(ap + (size_t)(64 * i) * lda + (k0)), (__attribute__((address_space(3))) unsigned*)(l3 + (buf) * STG + (wu + 8 * i) * 1024), 16, 0, 0);          \
        _Pragma("unroll") for (int i = 0; i < 2; ++i)                                                                                             \
            __builtin_amdgcn_global_load_lds((const unsigned*)(bp + (size_t)(64 * i) * ldb + (k0)), (__attribute__((address_space(3))) unsigned*)(l3 + (buf) * STG + 32768 + (wu + 8 * i) * 1024), 16, 0, 0);  \
    }
    GC_STAGE(0, 0)
    asm volatile("s_waitcnt vmcnt(0)" ::: "memory");
    __syncthreads();
    const int nk = K >> 6;
    for (int kt = 0; kt < nk; ++kt) {
        if (kt + 1 < nk) GC_STAGE((kt + 1) & 1, (kt + 1) << 6)
        const unsigned char* sa = lds + (kt & 1) * STG;
        const unsigned char* sb = sa + 32768;
#pragma unroll
        for (int ks = 0; ks < 2; ++ks) {
            bf16x8 af[4], bfr[4];
#pragma unroll
            for (int mi = 0; mi < 4; ++mi) af[mi] = *(const bf16x8*)(sa + swz(wm * 64 + mi * 16 + l15, ks * 4 + q4));
#pragma unroll
            for (int ni = 0; ni < 4; ++ni) bfr[ni] = *(const bf16x8*)(sb + swz(wn * 64 + ni * 16 + l15, ks * 4 + q4));
#pragma unroll
            for (int mi = 0; mi < 4; ++mi)
#pragma unroll
                for (int ni = 0; ni < 4; ++ni) acc[mi][ni] = MFMA(bfr[ni], af[mi], acc[mi][ni]);
        }
        asm volatile("s_waitcnt vmcnt(0)" ::: "memory");
        __syncthreads();
    }
#undef GC_STAGE
}
#define EPI_LOOP(body)                                                                                                  \
    {                                                                                                                   \
        int e_t = threadIdx.x; asm volatile("" : "+v"(e_t)); const int e_lane = e_t & 63, e_w = e_t >> 6;                                                    \
        _Pragma("unroll") for (int mi = 0; mi < 4; ++mi) _Pragma("unroll") for (int ni = 0; ni < 4; ++ni) {             \
            const int row = m0 + (e_w & 3) * 64 + mi * 16 + (e_lane & 15);                                              \
            const int col = n0 + (e_w >> 2) * 64 + ni * 16 + 4 * (e_lane >> 4);                                         \
            f32x4& v = acc[mi][ni];                                                                                     \
            body                                                                                                        \
        }                                                                                                               \
    }
__device__ __forceinline__ void st_bf4(bf16_t* dst, f32x4 v) {
    u32x2 o; o.x = pk2(v[0], v[1]); o.y = pk2(v[2], v[3]); *(u32x2*)dst = o;
}
__device__ __forceinline__ f32x4 ld_bf4(const bf16_t* src) {
    const u32x2 u = *(const u32x2*)src; f32x4 r = {lo16(u.x), hi16(u.x), lo16(u.y), hi16(u.y)}; return r;
}


__device__ __forceinline__ void merge_tile(const bf16_t* P, const bf16_t* WtBr, bf16_t* merged, int m0, int n0, unsigned char* lds) {
    int tid_ = threadIdx.x; asm volatile("" : "+v"(tid_)); const int tid = tid_, lane = tid & 63, w = tid >> 6, wm = w & 3, wn = w >> 2, l15 = lane & 15, q4 = lane >> 4;
    const int wu = __builtin_amdgcn_readfirstlane(w);
    __attribute__((address_space(3))) unsigned char* l3 = (__attribute__((address_space(3))) unsigned char*)lds;
    f32x4 acc[4][4], macc[4][4];
#pragma unroll
    for (int mi = 0; mi < 4; ++mi)
#pragma unroll
        for (int ni = 0; ni < 4; ++ni) { acc[mi][ni] = (f32x4){0.f, 0.f, 0.f, 0.f}; macc[mi][ni] = (f32x4){0.f, 0.f, 0.f, 0.f}; }
    const int r8 = lane >> 3, sch = (lane & 7) ^ ((((w & 1) << 2) + (r8 >> 1)) & 7);
    const bf16_t* ap = P + (size_t)(m0 + w * 8 + r8) * PS + sch * 8;
    const bf16_t* bp = WtBr + (size_t)(n0 + w * 8 + r8) * 512 + sch * 8;
    const bf16_t* sgp = P + (size_t)(m0 + wm * 64 + l15) * PS + C_SG + n0 + wn * 64 + 4 * q4;
#define MG_STAGE(buf, kt_)                                                                                                                        \
    {                                                                                                                                             \
        const int j_ = (kt_) >> 3, k0_ = ((kt_) & 7) << 6;                                                                                        \
        const int acol_ = (j_ == 0) ? C_NAQ : (j_ == 1) ? C_HY : (j_ == 2) ? C_GV : C_MQ;                                                        \
        _Pragma("unroll") for (int i = 0; i < 4; ++i)                                                                                             \
            __builtin_amdgcn_global_load_lds((const unsigned*)(ap + (size_t)(64 * i) * PS + acol_ + k0_), (__attribute__((address_space(3))) unsigned*)(l3 + (buf) * STG + (wu + 8 * i) * 1024), 16, 0, 0);      \
        _Pragma("unroll") for (int i = 0; i < 2; ++i)                                                                                             \
            __builtin_amdgcn_global_load_lds((const unsigned*)(bp + (size_t)j_ * 1024 * 512 + (size_t)(64 * i) * 512 + k0_), (__attribute__((address_space(3))) unsigned*)(l3 + (buf) * STG + 32768 + (wu + 8 * i) * 1024), 16, 0, 0);  \
    }
    MG_STAGE(0, 0)
    MG_STAGE(1, 1)
    asm volatile("s_waitcnt vmcnt(6)" ::: "memory");
    __builtin_amdgcn_s_barrier(); asm volatile("" ::: "memory");
    int cb = 0;
#pragma unroll 1
    for (int kt = 0; kt < 32; ++kt) {
        const bool last = (kt & 7) == 7;
        u32x2 sg[4][4];
        if (last) {
            const bf16_t* sp = sgp + 1024 * (kt >> 3);
#pragma unroll
            for (int mi = 0; mi < 4; ++mi)
#pragma unroll
                for (int ni = 0; ni < 4; ++ni) sg[mi][ni] = *(const u32x2*)(sp + (size_t)(mi * 16) * PS + ni * 16);
        }
        const int nb = (cb == 0) ? 2 : cb - 1;
        if (kt + 2 < 32) MG_STAGE(nb, kt + 2)
        const unsigned char* sa = lds + cb * STG;
        const unsigned char* sb = sa + 32768;
#pragma unroll
        for (int ks = 0; ks < 2; ++ks) {
            bf16x8 af[4], bfr[4];
#pragma unroll
            for (int mi = 0; mi < 4; ++mi) af[mi] = *(const bf16x8*)(sa + swz(wm * 64 + mi * 16 + l15, ks * 4 + q4));
#pragma unroll
            for (int ni = 0; ni < 4; ++ni) bfr[ni] = *(const bf16x8*)(sb + swz(wn * 64 + ni * 16 + l15, ks * 4 + q4));
            __builtin_amdgcn_s_setprio(1);
#pragma unroll
            for (int mi = 0; mi < 4; ++mi)
#pragma unroll
                for (int ni = 0; ni < 4; ++ni) acc[mi][ni] = MFMA(bfr[ni], af[mi], acc[mi][ni]);
            __builtin_amdgcn_s_setprio(0);
        }
        if (kt + 2 < 32) asm volatile("s_waitcnt vmcnt(6)" ::: "memory"); else asm volatile("s_waitcnt vmcnt(0)" ::: "memory");
        if (last) {
#pragma unroll
            for (int mi = 0; mi < 4; ++mi)
#pragma unroll
                for (int ni = 0; ni < 4; ++ni) {
                    const u32x2 u = sg[mi][ni]; const f32x4 g4 = {lo16(u.x), hi16(u.x), lo16(u.y), hi16(u.y)};
                    macc[mi][ni] += g4 * acc[mi][ni]; acc[mi][ni] = (f32x4){0.f, 0.f, 0.f, 0.f};
                }
        }
        asm volatile("" ::: "memory"); __builtin_amdgcn_s_barrier(); asm volatile("" ::: "memory");
        cb = (cb == 2) ? 0 : cb + 1;
    }
#undef MG_STAGE
    __syncthreads();
#pragma unroll
    for (int mi = 0; mi < 4; ++mi)
#pragma unroll
        for (int ni = 0; ni < 4; ++ni) st_bf4(merged + (size_t)(m0 + wm * 64 + mi * 16 + l15) * 1024 + n0 + wn * 64 + ni * 16 + 4 * q4, macc[mi][ni]);
}

__device__ __forceinline__ int orig_col(int n) {
    if (n < 4096) return n;
    if (n < 4608) return n + 32;
    if (n < 6656) return n + 32;
    if (n < 10752) return n + 32;
    return n - 10752 + 4096;
}

__device__ __forceinline__ void ln_rows(const float* src, size_t src_row0, int nrows, const float* g, const float* b, float* dst32, bf16_t* dst16, size_t dst_row0, float2* stats) {
    int tid_ = threadIdx.x; asm volatile("" : "+v"(tid_));
    const int lane = tid_ & 63;
    const int gw = blockIdx.x * (NTHR / 64) + (tid_ >> 6), nw = gridDim.x * (NTHR / 64);
    for (int r = gw; r < nrows; r += nw) {
        const float4* xr = (const float4*)(src + (src_row0 + r) * 1024);
        float4 v[4]; float s = 0.f;
#pragma unroll
        for (int i = 0; i < 4; ++i) { v[i] = xr[lane + 64 * i]; s += (v[i].x + v[i].y) + (v[i].z + v[i].w); }
        s = wave_sum(s);
        const float mean = s * (1.0f / 1024.0f);
        float q = 0.f;
#pragma unroll
        for (int i = 0; i < 4; ++i) { const float a = v[i].x - mean, bb = v[i].y - mean, c = v[i].z - mean, d = v[i].w - mean; q += (a * a + bb * bb) + (c * c + d * d); }
        q = wave_sum(q);
        const float rstd = 1.0f / sqrtf(q * (1.0f / 1024.0f) + 1e-5f);
        if (stats && lane == 0) { float2 st; st.x = mean; st.y = rstd; stats[dst_row0 + r] = st; }
#pragma unroll
        for (int i = 0; i < 4; ++i) {
            const float4 g4 = ((const float4*)g)[lane + 64 * i], b4 = ((const float4*)b)[lane + 64 * i];
            float4 y; y.x = (v[i].x - mean) * rstd * g4.x + b4.x; y.y = (v[i].y - mean) * rstd * g4.y + b4.y; y.z = (v[i].z - mean) * rstd * g4.z + b4.z; y.w = (v[i].w - mean) * rstd * g4.w + b4.w;
            if (dst32) ((float4*)(dst32 + (dst_row0 + r) * 1024))[lane + 64 * i] = y;
            if (dst16) { u32x2 o; o.x = pk2(y.x, y.y); o.y = pk2(y.z, y.w); *(u32x2*)(dst16 + (dst_row0 + r) * 1024 + (lane + 64 * i) * 4) = o; }
        }
    }
}
__device__ __forceinline__ void phase0(const Params& p) {
    ln_rows(p.x, 0, NTOK, p.ln_in_g, p.ln_in_b, nullptr, (bf16_t*)(p.ws + OFF_HB), 0, (float2*)(p.ws + OFF_STATS));
    int tid_ = threadIdx.x; asm volatile("" : "+v"(tid_)); const int gt = blockIdx.x * NTHR + tid_, nt = gridDim.x * NTHR;
    float2* tw = (float2*)(p.ws + OFF_TW);
    for (int k = gt; k < FN; k += nt) { double s, c; sincospi(-2.0 * (double)k / (double)FN, &s, &c); float2 t; t.x = (float)c; t.y = (float)s; tw[k] = t; }
    bf16_t* mb = (bf16_t*)(p.ws + OFF_MEMBF);
    for (int i = gt; i < 2048 * 1024 / 4; i += nt) { const float4 v = ((const float4*)p.mem)[i]; u32x2 o; o.x = pk2(v.x, v.y); o.y = pk2(v.z, v.w); ((u32x2*)mb)[i] = o; }
    float* en = (float*)(p.ws + OFF_ENERGY);
    for (int i = gt; i < 1024; i += nt) en[i] = 0.f;
    float* ztab = (float*)(p.ws + OFF_ZT);
    for (int idx = gt; idx < 8192 * 33; idx += nt) {
        const int n = idx / 33, e = idx - n * 33;
        float v;
        if (e == 0) v = (float)n / 8191.0f;
        else {
            const int i = (e - 1) & 15;
            const double fr = 1e-4 + (double)i * ((15.0 - 1e-4) / 15.0);
            const double ang = (2.0 * 3.14159265358979323846 / 8192.0) * (double)n * fr;
            v = (e <= 16) ? (float)cos(ang) : (float)(-sin(ang));
        }
        ztab[idx] = v;
    }
}

__device__ __forceinline__ void wt_tile(const float* src, int src_ld, int k0, int on0, bf16_t* dst, int dst_ld, int dn0, bool zero, float* tile) {
    int tid_ = threadIdx.x; asm volatile("" : "+v"(tid_)); const int tid = tid_;
    if (!zero) {
#pragma unroll
        for (int i = 0; i < 2; ++i) {
            const int k = (tid >> 3) + 64 * i, c4 = (tid & 7) * 4;
            const float4 v = *(const float4*)(src + (size_t)(k0 + k) * src_ld + on0 + c4);
            float* t = tile + k * 33 + c4; t[0] = v.x; t[1] = v.y; t[2] = v.z; t[3] = v.w;
        }
    }
    __syncthreads();
    const int n = tid >> 4, kc = (tid & 15) * 8;
    float f[8];
#pragma unroll
    for (int e = 0; e < 8; ++e) f[e] = zero ? 0.f : tile[(kc + e) * 33 + n];
    u32x4 o; o.x = pk2(f[0], f[1]); o.y = pk2(f[2], f[3]); o.z = pk2(f[4], f[5]); o.w = pk2(f[6], f[7]);
    *(u32x4*)(dst + (size_t)(dn0 + n) * dst_ld + k0 + kc) = o;
    __syncthreads();
}
__device__ __forceinline__ void phase_weights(const Params& p, int l, unsigned char* lds) {
    float* tile = (float*)lds;
    for (int it = blockIdx.x; it < 3776; it += gridDim.x) {
        if (it < 2752) {
            const int nt = it >> 3, kt = it & 7, dn0 = nt * 32;
            wt_tile(p.w_in + (size_t)l * 1024 * NIN, NIN, kt * 128, orig_col(dn0), (bf16_t*)(p.ws + OFF_WTIN), 1024, dn0, dn0 >= NIN, tile);
        } else if (it < 3264) {
            const int r = it - 2752, j = r >> 7, nt = (r >> 2) & 31, kt = r & 3;
            wt_tile(p.w_br + (size_t)(l * 4 + j) * 512 * 1024, 1024, kt * 128, nt * 32, (bf16_t*)(p.ws + OFF_WTBR) + (size_t)j * 1024 * 512, 512, nt * 32, false, tile);
        } else if (it < 3520) {
            const int r = it - 3264, nt = r >> 3, kt = r & 7;
            wt_tile(p.w_out + (size_t)l * 1024 * 1024, 1024, kt * 128, nt * 32, (bf16_t*)(p.ws + OFF_WTOUT), 1024, nt * 32, false, tile);
        } else {
            const int r = it - 3520, nt = r >> 3, kt = r & 7;
            wt_tile(p.mem_w_kv + (size_t)l * 1024 * 1024, 1024, kt * 128, nt * 32, (bf16_t*)(p.ws + OFF_WTKV), 1024, nt * 32, false, tile);
        }
    }
}

__device__ __forceinline__ void phase_filter_gen(const Params& p, int l, unsigned char* lds) {
    float* zt = (float*)lds;
    float* ha = zt + 32 * 33;
    float* hbuf = ha + 32 * 64;
    int tid_ = threadIdx.x; asm volatile("" : "+v"(tid_)); const int tid = tid_;
    const float* w1 = p.hy_w1 + (size_t)l * 33 * 64; const float* b1 = p.hy_b1 + l * 64;
    const float* wm = p.hy_wm + (size_t)l * 2 * 64 * 64; const float* bm = p.hy_bm + l * 2 * 64;
    const float* w3 = p.hy_w3 + (size_t)l * 64 * 1024;
    float* hf = (float*)(p.ws + OFF_HFILT);
    float* en = (float*)(p.ws + OFF_ENERGY) + l * 512;
    const float* ztab = (const float*)(p.ws + OFF_ZT);
    for (int it = blockIdx.x; it < 256; it += gridDim.x) {
        const int n0 = it * 32;
        for (int idx = tid; idx < 32 * 33; idx += NTHR) zt[idx] = ztab[(size_t)n0 * 33 + idx];
        __syncthreads();
        for (int idx = tid; idx < 2048; idx += NTHR) {
            const int pos = idx >> 6, j = idx & 63; float s = b1[j];
            for (int e = 0; e < 33; ++e) s += zt[pos * 33 + e] * w1[e * 64 + j];
            ha[idx] = sinf(s);
        }
        __syncthreads();
        for (int idx = tid; idx < 2048; idx += NTHR) {
            const int pos = idx >> 6, j = idx & 63; float s = bm[j];
            for (int e = 0; e < 64; ++e) s += ha[pos * 64 + e] * wm[e * 64 + j];
            hbuf[idx] = sinf(s);
        }
        __syncthreads();
        for (int idx = tid; idx < 2048; idx += NTHR) {
            const int pos = idx >> 6, j = idx & 63; float s = bm[64 + j];
            for (int e = 0; e < 64; ++e) s += hbuf[pos * 64 + e] * wm[4096 + e * 64 + j];
            ha[idx] = sinf(s);
        }
        __syncthreads();
        {
            const int c = tid;
            float af[32], ab[32];
#pragma unroll
            for (int i = 0; i < 32; ++i) { af[i] = 0.f; ab[i] = 0.f; }
            for (int k = 0; k < 64; ++k) {
                const float wf = w3[k * 1024 + c], wb = w3[k * 1024 + 512 + c];
#pragma unroll
                for (int i = 0; i < 32; ++i) { const float h = ha[i * 64 + k]; af[i] += h * wf; ab[i] += h * wb; }
            }
            const float dmin = -3.0701134573253945f, dmax = -15.350567286626973f;
            const float delta = fabsf(dmin + (float)c * ((dmax - dmin) / 511.0f));
            float e = 0.f;
#pragma unroll
            for (int i = 0; i < 32; ++i) {
                const int n = n0 + i; const float t01 = (float)n / 8191.0f; const float win = expf(-t01 * delta);
                af[i] *= win; ab[i] *= win; e += af[i] * af[i]; if (n >= 1) e += ab[i] * ab[i];
            }
#pragma unroll
            for (int i = 0; i < 8; ++i) {
                float4 a; a.x = af[4 * i]; a.y = af[4 * i + 1]; a.z = af[4 * i + 2]; a.w = af[4 * i + 3];
                float4 b; b.x = ab[4 * i]; b.y = ab[4 * i + 1]; b.z = ab[4 * i + 2]; b.w = ab[4 * i + 3];
                *(float4*)(hf + (size_t)c * 8192 + n0 + 4 * i) = a;
                *(float4*)(hf + (size_t)(512 + c) * 8192 + n0 + 4 * i) = b;
            }
            atomicAdd(en + c, e);
        }
        __syncthreads();
    }
}

__device__ __forceinline__ void phase_filter_fft(const Params& p, int l, unsigned char* lds) {
    float2* d = (float2*)lds;
    const float2* tw = fft_lds_twiddles((const float2*)(p.ws + OFF_TW), lds);
    const float* hf = (const float*)(p.ws + OFF_HFILT);
    const float* en = (const float*)(p.ws + OFF_ENERGY) + l * 512;
    float4* pqa = (float4*)(p.ws + OFF_PQ);
    int tid_ = threadIdx.x; asm volatile("" : "+v"(tid_)); const int tid = tid_;
    for (int pr = blockIdx.x; pr < 256; pr += gridDim.x) {
        const int c0 = 2 * pr, c1 = c0 + 1;
        const float s0 = 1.0f / sqrtf(en[c0] + 1e-6f), s1 = 1.0f / sqrtf(en[c1] + 1e-6f);
        const float k0 = p.hy_skip[l * 512 + c0], k1 = p.hy_skip[l * 512 + c1];
        for (int n = tid; n < FN; n += NTHR) {
            float2 v;
            if (n < 8192) { v.x = hf[(size_t)c0 * 8192 + n] * s0; v.y = hf[(size_t)c1 * 8192 + n] * s1; if (n == 0) { v.x += k0; v.y += k1; } }
            else if (n == 8192) { v.x = 0.f; v.y = 0.f; }
            else { v.x = hf[(size_t)(512 + c0) * 8192 + (FN - n)] * s0; v.y = hf[(size_t)(512 + c1) * 8192 + (FN - n)] * s1; }
            d[n] = v;
        }
        __syncthreads();
        fft_forward<false>(d, tw, (const float2*)(p.ws + OFF_TW));
        for (int h = tid; h < FN / 2; h += NTHR) filt_pointwise(d, pqa + (size_t)pr * FN, 2 * h);
        if (tid == 0) filt_pointwise(d, pqa + (size_t)pr * FN, 1);
        __syncthreads();
    }
}

__device__ __forceinline__ void hy_pre_item(const Params& p, int l, const bf16_t* P, float* UT, bf16_t* GT, int bl, int tt, int ct, unsigned char* lds) {
    float* tU = (float*)lds;
    float* tG = tU + 64 * 65;
    int tid_ = threadIdx.x; asm volatile("" : "+v"(tid_)); const int tid = tid_;
    const int t = tid >> 3, cc = (tid & 7) * 8, c = ct * 64 + cc, tb = tt * 64 + t;
    const float* cw = p.hy_conv_w + (size_t)l * 3 * 1536; const float* cb = p.hy_conv_b + l * 1536;
    float av[8], a0[8], a1[8];
#pragma unroll
    for (int h = 0; h < 2; ++h) {
        const f32x4 bv = *(const f32x4*)(cb + c + 4 * h), b0 = *(const f32x4*)(cb + 512 + c + 4 * h), b1 = *(const f32x4*)(cb + 1024 + c + 4 * h);
#pragma unroll
        for (int e = 0; e < 4; ++e) { av[4 * h + e] = bv[e]; a0[4 * h + e] = b0[e]; a1[4 * h + e] = b1[e]; }
    }
#pragma unroll
    for (int j = 0; j < 3; ++j) {
        const int ts = tb + j - 1;
        if (ts >= 0 && ts < SEQ) {
            const bf16_t* row = P + (size_t)(bl * SEQ + ts) * PS + C_HY + c;
            const u32x4 rv = *(const u32x4*)row, r0 = *(const u32x4*)(row + 512), r1 = *(const u32x4*)(row + 1024);
#pragma unroll
            for (int h = 0; h < 2; ++h) {
                const f32x4 wv = *(const f32x4*)(cw + j * 1536 + c + 4 * h), w0 = *(const f32x4*)(cw + j * 1536 + 512 + c + 4 * h), w1 = *(const f32x4*)(cw + j * 1536 + 1024 + c + 4 * h);
#pragma unroll
                for (int e = 0; e < 4; ++e) {
                    const int k = 4 * h + e; const unsigned uv = rv[k >> 1], u0 = r0[k >> 1], u1 = r1[k >> 1];
                    av[k] += wv[e] * ((k & 1) ? hi16(uv) : lo16(uv)); a0[k] += w0[e] * ((k & 1) ? hi16(u0) : lo16(u0)); a1[k] += w1[e] * ((k & 1) ? hi16(u1) : lo16(u1));
                }
            }
        }
    }
    const u32x4 rz = *(const u32x4*)(P + (size_t)(bl * SEQ + tb) * PS + C_Z + 512 + c);
#pragma unroll
    for (int k = 0; k < 8; ++k) {
        const unsigned uz = rz[k >> 1]; const float z = (k & 1) ? hi16(uz) : lo16(uz);
        tU[(cc + k) * 65 + t] = av[k] * a1[k]; tG[(cc + k) * 65 + t] = a0[k] * z;
    }
    __syncthreads();
    const int c2 = tid >> 3, t8 = (tid & 7) * 8;
    const size_t o = (size_t)(bl * 512 + ct * 64 + c2) * SEQ + tt * 64 + t8;
    const float* su = tU + c2 * 65 + t8; const float* sg = tG + c2 * 65 + t8;
    f32x4 ua = {su[0], su[1], su[2], su[3]}, ub = {su[4], su[5], su[6], su[7]};
    *(f32x4*)(UT + o) = ua; *(f32x4*)(UT + o + 4) = ub;
    u32x4 g; g.x = pk2(sg[0], sg[1]); g.y = pk2(sg[2], sg[3]); g.z = pk2(sg[4], sg[5]); g.w = pk2(sg[6], sg[7]);
    *(u32x4*)(GT + o) = g;
    __syncthreads();
}
__device__ __forceinline__ void hy_post_item(bf16_t* P, const bf16_t* GT, int bl, int tt, int ct, unsigned char* lds, int dry = 0) {
    bf16_t* tl = (bf16_t*)lds;
    int tid_ = threadIdx.x; asm volatile("" : "+v"(tid_)); const int tid = tid_;
    const int c2 = tid >> 3, t8 = (tid & 7) * 8;
    const u32x4 v = *(const u32x4*)(GT + (size_t)(bl * 512 + ct * 64 + c2) * SEQ + tt * 64 + t8);
    bf16_t* d0 = tl + t8 * 72 + c2;
    d0[0 * 72] = (bf16_t)(v.x & 0xffffu); d0[1 * 72] = (bf16_t)(v.x >> 16); d0[2 * 72] = (bf16_t)(v.y & 0xffffu); d0[3 * 72] = (bf16_t)(v.y >> 16);
    d0[4 * 72] = (bf16_t)(v.z & 0xffffu); d0[5 * 72] = (bf16_t)(v.z >> 16); d0[6 * 72] = (bf16_t)(v.w & 0xffffu); d0[7 * 72] = (bf16_t)(v.w >> 16);
    __syncthreads();
    const int t = tid >> 3, cc = (tid & 7) * 8;
    const u32x4 ov = *(const u32x4*)(tl + t * 72 + cc);
    if (!dry) *(u32x4*)(P + (size_t)(bl * SEQ + tt * 64 + t) * PS + C_HY + ct * 64 + cc) = ov;
    __syncthreads();
}
__device__ __forceinline__ void hyena_conv_item(const Params& p, const float* UT, bf16_t* GT, int bl, int pr, unsigned char* lds, const float2* tw, int dry = 0) {
    float2* d = (float2*)lds;
    const float4* pq = (const float4*)(p.ws + OFF_PQ) + (size_t)pr * FN;
    int tid_ = threadIdx.x; asm volatile("" : "+v"(tid_)); const int tid = tid_;
    const float* u0 = UT + (size_t)(bl * 512 + 2 * pr) * SEQ; const float* u1 = u0 + SEQ;
    bf16_t* g0 = GT + (size_t)(bl * 512 + 2 * pr) * SEQ; bf16_t* g1 = g0 + SEQ;
    {
        float f0[16], f1[16];
#pragma unroll
        for (int i = 0; i < 16; ++i) { f0[i] = u0[tid + NTHR * i]; f1[i] = u1[tid + NTHR * i]; }
#pragma unroll
        for (int i = 0; i < 16; ++i) {
            float2 u; u.x = f0[i]; u.y = f1[i]; d[tid + NTHR * i] = u;
        }
    }
    __syncthreads();
    fft_forward<true>(d, tw, (const float2*)(p.ws + OFF_TW));
#pragma unroll 1
    for (int h = tid; h < FN / 2; h += 4 * NTHR) {
        PwIn w0, w1, w2, w3;
        pw_load(w0, d, pq, 2 * h); pw_load(w1, d, pq, 2 * (h + NTHR)); pw_load(w2, d, pq, 2 * (h + 2 * NTHR)); pw_load(w3, d, pq, 2 * (h + 3 * NTHR));
        pw_store(w0, d); pw_store(w1, d); pw_store(w2, d); pw_store(w3, d);
    }
    if (tid == 0) conv_pointwise(d, pq, 1);
    __syncthreads();
    fft_inverse<true>(d, tw, (const float2*)(p.ws + OFF_TW));
    {
        bf16_t a0[16], a1[16];
#pragma unroll
        for (int i = 0; i < 16; ++i) { a0[i] = g0[tid + NTHR * i]; a1[i] = g1[tid + NTHR * i]; }
#pragma unroll
        for (int i = 0; i < 16; ++i) {
            const int t = tid + NTHR * i;
            const float2 y = d[t];
            const bf16_t r0 = f2bf_d(y.x * bf2f(a0[i])), r1 = f2bf_d(y.y * bf2f(a1[i]));
            if (!dry) { g0[t] = r0; g1[t] = r1; }
        }
    }
    __syncthreads();
}

__device__ __forceinline__ void na_item(const Params& p, int l, bf16_t* P, int bl, int rp, int head, unsigned char* lds, int dry = 0) {
    bf16_t* Kimg = (bf16_t*)lds;
    bf16_t* VT = (bf16_t*)(lds + 82944);
    int tid_ = threadIdx.x; asm volatile("" : "+v"(tid_)); const int tid = tid_, lane = tid & 63, w = tid >> 6, l15 = lane & 15, q4 = lane >> 4;
    const int r0 = 2 * rp, rs0 = iclamp(r0 - 4, 0, 120);
#pragma unroll
    for (int i = 0; i < 9; ++i) {
        const int idx = tid + NTHR * i, key = idx >> 3, ch = idx & 7, grow = min(rs0 + (key >> 6), 127);
        const u32x4 kv = *(const u32x4*)(P + (size_t)(bl * SEQ + grow * 64 + (key & 63)) * PS + C_NAK + head * 64 + ch * 8);
        *(u32x4*)(Kimg + key * 72 + ch * 8) = kv;
    }
#pragma unroll
    for (int i = 0; i < 9; ++i) {
        const int idx = tid + NTHR * i, keyp = idx >> 2, chh = keyp >= 576 ? 1 : 0, key = keyp - chh * 576, ch = chh * 4 + (idx & 3), grow = min(rs0 + (key >> 6), 127);
        const u32x4 vv = *(const u32x4*)(P + (size_t)(bl * SEQ + grow * 64 + (key & 63)) * PS + C_NAV + head * 64 + ch * 8);
        bf16_t* vd = VT + (ch * 8) * 584 + key;
        vd[0 * 584] = (bf16_t)(vv.x & 0xffffu); vd[1 * 584] = (bf16_t)(vv.x >> 16);
        vd[2 * 584] = (bf16_t)(vv.y & 0xffffu); vd[3 * 584] = (bf16_t)(vv.y >> 16);
        vd[4 * 584] = (bf16_t)(vv.z & 0xffffu); vd[5 * 584] = (bf16_t)(vv.z >> 16);
        vd[6 * 584] = (bf16_t)(vv.w & 0xffffu); vd[7 * 584] = (bf16_t)(vv.w >> 16);
    }
    __syncthreads();
    const int rr = w >> 2, g = w & 3, r = r0 + rr, rs = iclamp(r - 4, 0, 120), lo = rs - rs0;
    const int cb = iclamp(16 * g - 8, 0, 32), c = 16 * g + l15, cs = iclamp(c - 8, 0, 48);
    bf16_t* qrow = P + (size_t)(bl * SEQ + r * 64 + c) * PS + head * 64;
    bf16x8 qf[2];
#pragma unroll
    for (int ks = 0; ks < 2; ++ks) qf[ks] = *(const bf16x8*)(qrow + ks * 32 + q4 * 8);
    f32x4 sc[16];
#pragma unroll
    for (int t = 0; t < 16; ++t) {
        const int kb = (lo + (t >> 1)) * 64 + cb + 16 * (t & 1);
        f32x4 a = {0.f, 0.f, 0.f, 0.f};
#pragma unroll
        for (int ks = 0; ks < 2; ++ks) { const bf16x8 kf = *(const bf16x8*)(Kimg + (kb + l15) * 72 + ks * 32 + q4 * 8); a = MFMA(kf, qf[ks], a); }
        sc[t] = a;
    }
    const float* rpb = p.na_rpb + (size_t)(l * 8 + head) * 15 * 31;
    float mx = -1e30f;
#pragma unroll
    for (int t = 0; t < 16; ++t) {
        const int drow = rs + (t >> 1) - r + 7;
#pragma unroll
        for (int e = 0; e < 4; ++e) {
            const int col = cb + 16 * (t & 1) + 4 * q4 + e;
            const bool ok = (col >= cs) && (col < cs + 16);
            const int dcol = ok ? (col - c + 15) : 0;
            const float v = ok ? (sc[t][e] + rpb[drow * 31 + dcol]) : -1e30f;
            sc[t][e] = v; mx = fmaxf(mx, v);
        }
    }
    mx = fmaxf(mx, __shfl_xor(mx, 16)); mx = fmaxf(mx, __shfl_xor(mx, 32));
    float sum = 0.f;
#pragma unroll
    for (int t = 0; t < 16; ++t)
#pragma unroll
        for (int e = 0; e < 4; ++e) { const float pe = __expf(sc[t][e] - mx); sc[t][e] = pe; sum += pe; }
    sum += __shfl_xor(sum, 16); sum += __shfl_xor(sum, 32);
    f32x4 o[4];
#pragma unroll
    for (int dt = 0; dt < 4; ++dt) o[dt] = (f32x4){0.f, 0.f, 0.f, 0.f};
#pragma unroll
    for (int kk = 0; kk < 8; ++kk) {
        u32x4 pu; pu.x = pk2(sc[2 * kk][0], sc[2 * kk][1]); pu.y = pk2(sc[2 * kk][2], sc[2 * kk][3]); pu.z = pk2(sc[2 * kk + 1][0], sc[2 * kk + 1][1]); pu.w = pk2(sc[2 * kk + 1][2], sc[2 * kk + 1][3]);
        const bf16x8 pf = mkfrag(pu);
        const int kbA = (lo + kk) * 64 + cb + 4 * q4;
#pragma unroll
        for (int dt = 0; dt < 4; ++dt) {
            const bf16_t* vr = VT + (dt * 16 + l15) * 584 + kbA;
            const bf16x8 vf = mkfrag2(*(const u32x2*)vr, *(const u32x2*)(vr + 16));
            o[dt] = MFMA(vf, pf, o[dt]);
        }
    }
    const float inv = 1.0f / sum;
    const bf16_t* zrow = P + (size_t)(bl * SEQ + r * 64 + c) * PS + C_Z + head * 64;
#pragma unroll
    for (int dt = 0; dt < 4; ++dt) {
        const int dd = dt * 16 + 4 * q4;
        const f32x4 z = ld_bf4(zrow + dd);
        if (!dry) st_bf4(qrow + dd, o[dt] * inv * z);
    }
    __syncthreads();
}

__device__ __forceinline__ void memattn_load(const Params& p, int b, int h, unsigned char* lds) {
    bf16_t* Kimg = (bf16_t*)lds;
    bf16_t* VT = (bf16_t*)(lds + 69632);
    const bf16_t* Km = (const bf16_t*)(p.ws + OFF_KMAT); const bf16_t* Vm = (const bf16_t*)(p.ws + OFF_VT);
    int tid_ = threadIdx.x; asm volatile("" : "+v"(tid_)); const int tid = tid_;
#pragma unroll
    for (int i = 0; i < 8; ++i) {
        const int idx = tid + NTHR * i;
        { const int key = idx >> 4, ch = idx & 15; *(u32x4*)(Kimg + key * 136 + ch * 8) = *(const u32x4*)(Km + (size_t)(b * 256 + key) * 512 + h * 128 + ch * 8); }
        { const int dd = idx >> 5, ch = idx & 31; *(u32x4*)(VT + dd * 264 + ch * 8) = *(const u32x4*)(Vm + (size_t)(h * 128 + dd) * 2048 + b * 256 + ch * 8); }
    }
    __syncthreads();
}
__device__ __forceinline__ void memattn_item(bf16_t* P, int bl, int h, int qt, unsigned char* lds, int dry = 0) {
    const bf16_t* Kimg = (const bf16_t*)lds; const bf16_t* VT = (const bf16_t*)(lds + 69632);
    int tid_ = threadIdx.x; asm volatile("" : "+v"(tid_)); const int tid = tid_, lane = tid & 63, w = tid >> 6, l15 = lane & 15, q4 = lane >> 4;
    const int tok = bl * SEQ + qt * 128 + w * 16 + l15;
    bf16_t* qrow = P + (size_t)tok * PS + C_MQ + h * 128;
    bf16x8 qf[4];
#pragma unroll
    for (int ks = 0; ks < 4; ++ks) qf[ks] = *(const bf16x8*)(qrow + ks * 32 + q4 * 8);
    f32x4 sc[16];
    float mx = -1e30f;
#pragma unroll
    for (int t = 0; t < 16; ++t) {
        f32x4 a = {0.f, 0.f, 0.f, 0.f};
#pragma unroll
        for (int ks = 0; ks < 4; ++ks) { const bf16x8 kf = *(const bf16x8*)(Kimg + (t * 16 + l15) * 136 + ks * 32 + q4 * 8); a = MFMA(kf, qf[ks], a); }
        sc[t] = a;
        mx = fmaxf(mx, fmaxf(fmaxf(a[0], a[1]), fmaxf(a[2], a[3])));
    }
    mx = fmaxf(mx, __shfl_xor(mx, 16)); mx = fmaxf(mx, __shfl_xor(mx, 32));
    float sum = 0.f;
#pragma unroll
    for (int t = 0; t < 16; ++t)
#pragma unroll
        for (int e = 0; e < 4; ++e) { const float pe = __expf(sc[t][e] - mx); sc[t][e] = pe; sum += pe; }
    sum += __shfl_xor(sum, 16); sum += __shfl_xor(sum, 32);
    f32x4 o[8];
#pragma unroll
    for (int dt = 0; dt < 8; ++dt) o[dt] = (f32x4){0.f, 0.f, 0.f, 0.f};
#pragma unroll
    for (int kk = 0; kk < 8; ++kk) {
        u32x4 pu; pu.x = pk2(sc[2 * kk][0], sc[2 * kk][1]); pu.y = pk2(sc[2 * kk][2], sc[2 * kk][3]); pu.z = pk2(sc[2 * kk + 1][0], sc[2 * kk + 1][1]); pu.w = pk2(sc[2 * kk + 1][2], sc[2 * kk + 1][3]);
        const bf16x8 pf = mkfrag(pu);
#pragma unroll
        for (int dt = 0; dt < 8; ++dt) {
            const bf16_t* vr = VT + (dt * 16 + l15) * 264 + kk * 32 + 4 * q4;
            const bf16x8 vf = mkfrag2(*(const u32x2*)vr, *(const u32x2*)(vr + 16));
            o[dt] = MFMA(vf, pf, o[dt]);
        }
    }
    const float inv = 1.0f / sum;
    const bf16_t* zrow = P + (size_t)tok * PS + C_Z + 3 * 512 + h * 128;
#pragma unroll
    for (int dt = 0; dt < 8; ++dt) {
        const int dd = dt * 16 + 4 * q4;
        const f32x4 z = ld_bf4(zrow + dd);
        if (!dry) st_bf4(qrow + dd, o[dt] * inv * z);
    }
}

constexpr int G_LRT = 0, G_BF = 8192, G_BB = 24576, G_TOT = 40960, G_IMG = 45056;
__device__ __forceinline__ void gla_tables(const Params& p, int l, const float* LR, int t0, int h, unsigned char* lds) {
    float* LRT = (float*)(lds + G_LRT); float* BF = (float*)(lds + G_BF); float* BB = (float*)(lds + G_BB); float* TOT = (float*)(lds + G_TOT);
    int tid_ = threadIdx.x; asm volatile("" : "+v"(tid_)); const int tid = tid_;
    ((float4*)LRT)[tid] = ((const float4*)(LR + (size_t)t0 * 32))[tid];
    __syncthreads();
    const int dk = tid & 63, cgp = tid >> 6;
    float uf[16], ub[16];
#pragma unroll
    for (int r = 0; r < 16; ++r) { uf[r] = p.gla_up_f[(size_t)(l * 16 + r) * 256 + h * 64 + dk]; ub[r] = p.gla_up_b[(size_t)(l * 16 + r) * 256 + h * 64 + dk]; }
    const float bif = p.gla_bias_f[l * 256 + h * 64 + dk], bib = p.gla_bias_b[l * 256 + h * 64 + dk];
    float lf[8], lb[8];
#pragma unroll
    for (int i = 0; i < 8; ++i) {
        const int c = cgp * 8 + i; float sf = bif, sb = bib;
#pragma unroll
        for (int r = 0; r < 16; ++r) { sf += LRT[c * 32 + r] * uf[r]; sb += LRT[c * 32 + 16 + r] * ub[r]; }
        lf[i] = logsigf_(sf) * (1.0f / 16.0f); lb[i] = logsigf_(sb) * (1.0f / 16.0f);
    }
#pragma unroll
    for (int i = 1; i < 8; ++i) lf[i] += lf[i - 1];
#pragma unroll
    for (int i = 6; i >= 0; --i) lb[i] += lb[i + 1];
    TOT[cgp * 64 + dk] = lf[7]; TOT[512 + cgp * 64 + dk] = lb[0];
    __syncthreads();
    float of = 0.f, ob = 0.f;
#pragma unroll
    for (int g2 = 0; g2 < 8; ++g2) { if (g2 < cgp) of += TOT[g2 * 64 + dk]; if (g2 > cgp) ob += TOT[512 + g2 * 64 + dk]; }
#pragma unroll
    for (int i = 0; i < 8; ++i) { BF[(cgp * 8 + i) * 64 + dk] = lf[i] + of; BB[(cgp * 8 + i) * 64 + dk] = lb[i] + ob; }
    __syncthreads();
}
struct GlaPre { u32x4 vv[2]; bf16_t q[8], k[8]; };
__device__ __forceinline__ void gla_prefetch(GlaPre& g, const bf16_t* P, int t0, int h, int tid) {
#pragma unroll
    for (int i = 0; i < 2; ++i) { const int idx = tid + NTHR * i, chn = idx >> 6, c = idx & 63; g.vv[i] = *(const u32x4*)(P + (size_t)(t0 + c) * PS + C_GV + h * 128 + chn * 8); }
#pragma unroll
    for (int i = 0; i < 8; ++i) { const int idx = tid + NTHR * i, c = idx >> 6, dk = idx & 63; g.q[i] = P[(size_t)(t0 + c) * PS + C_GQ + h * 64 + dk]; g.k[i] = P[(size_t)(t0 + c) * PS + C_GK + h * 64 + dk]; }
}
__device__ __forceinline__ void gla_vt_store(const GlaPre& g, bf16_t* VT, int tid) {
#pragma unroll
    for (int i = 0; i < 2; ++i) {
        const int idx = tid + NTHR * i, chn = idx >> 6, c = idx & 63;
        const u32x4 vv = g.vv[i];
        bf16_t* vd = VT + (chn * 8) * 72 + c;
        vd[0 * 72] = (bf16_t)(vv.x & 0xffffu); vd[1 * 72] = (bf16_t)(vv.x >> 16);
        vd[2 * 72] = (bf16_t)(vv.y & 0xffffu); vd[3 * 72] = (bf16_t)(vv.y >> 16);
        vd[4 * 72] = (bf16_t)(vv.z & 0xffffu); vd[5 * 72] = (bf16_t)(vv.z >> 16);
        vd[6 * 72] = (bf16_t)(vv.w & 0xffffu); vd[7 * 72] = (bf16_t)(vv.w >> 16);
    }
}
__device__ __forceinline__ void gla_part1_item(const Params& p, int l, const bf16_t* P, const float* LR, int item, unsigned char* lds) {
    const int h = item & 3, n = (item >> 2) & 127, bl = item >> 9, t0 = bl * SEQ + n * 64;
    const float* BF = (const float*)(lds + G_BF); const float* BB = (const float*)(lds + G_BB);
    bf16_t* KDT0 = (bf16_t*)(lds + G_IMG); bf16_t* KDT1 = KDT0 + 64 * 72; bf16_t* VT = KDT1 + 64 * 72;
    bf16_t* GS = (bf16_t*)(p.ws + OFF_GS); float* GD = (float*)(p.ws + OFF_GDEC);
    int tid_ = threadIdx.x; asm volatile("" : "+v"(tid_)); const int tid = tid_, lane = tid & 63, w = tid >> 6, l15 = lane & 15, q4 = lane >> 4;
    GlaPre gp; gla_prefetch(gp, P, t0, h, tid);
    gla_tables(p, l, LR, t0, h, lds);
    {
        float4* tb = (float4*)((float*)(p.ws + OFF_TB) + (size_t)item * 8192); const float4* ts = (const float4*)(lds + G_BF);
#pragma unroll
        for (int i = 0; i < 4; ++i) tb[tid + NTHR * i] = ts[tid + NTHR * i];
    }
#pragma unroll
    for (int i = 0; i < 8; ++i) {
        const int idx = tid + NTHR * i, c = idx >> 6, dk = idx & 63;
        const float kv = bf2f(gp.k[i]);
        KDT0[dk * 72 + c] = f2bf_d(kv * __expf(BF[63 * 64 + dk] - BF[c * 64 + dk]));
        KDT1[dk * 72 + c] = f2bf_d(kv * __expf(BB[dk] - BB[c * 64 + dk]));
    }
    gla_vt_store(gp, VT, tid);
    if (tid < 64) GD[(size_t)item * 64 + tid] = __expf(BF[63 * 64 + tid]);
    else if (tid < 128) GD[(size_t)(NITEM + item) * 64 + tid - 64] = __expf(BB[tid - 64]);
    __syncthreads();
    const int dir = w >> 2, dkt = w & 3;
    const bf16_t* KD = dir ? KDT1 : KDT0;
    bf16x8 kf[2];
#pragma unroll
    for (int ks = 0; ks < 2; ++ks) kf[ks] = *(const bf16x8*)(KD + (16 * dkt + l15) * 72 + 32 * ks + 8 * q4);
    bf16_t* dst = GS + ((size_t)dir * NITEM + item) * 8192;
#pragma unroll
    for (int dvt = 0; dvt < 8; ++dvt) {
        f32x4 a = {0.f, 0.f, 0.f, 0.f};
#pragma unroll
        for (int ks = 0; ks < 2; ++ks) { const bf16x8 vf = *(const bf16x8*)(VT + (16 * dvt + l15) * 72 + 32 * ks + 8 * q4); a = MFMA(kf[ks], vf, a); }
        st_bf4(dst + (16 * dvt + l15) * 64 + 16 * dkt + 4 * q4, a);
    }
    __syncthreads();
}
__device__ __forceinline__ void gla_scan(const Params& p, int dry = 0) {
    const bf16_t* GS = (const bf16_t*)(p.ws + OFF_GS); const float* GD = (const float*)(p.ws + OFF_GDEC); bf16_t* SB = (bf16_t*)(p.ws + OFF_SB);
    const int total = 2 * BG * 4 * 8192;
    int tid_ = threadIdx.x; asm volatile("" : "+v"(tid_));
    for (int id = blockIdx.x * NTHR + tid_; id < total; id += gridDim.x * NTHR) {
        const int e = id & 8191, comb = id >> 13, h = comb & 3, bl = (comb >> 2) % BG, dir = comb / (4 * BG), dk = e & 63;
        float S = 0.f;
        const size_t ibase = (size_t)dir * NITEM + (size_t)(bl * 128) * 4 + h;
        for (int s0 = 0; s0 < 128; s0 += 16) {
            float u[16], dc[16];
#pragma unroll
            for (int i = 0; i < 16; ++i) {
                const int n = dir ? 127 - (s0 + i) : s0 + i;
                const size_t item = ibase + (size_t)n * 4;
                u[i] = bf2f(GS[item * 8192 + e]); dc[i] = GD[item * 64 + dk];
            }
#pragma unroll
            for (int i = 0; i < 16; ++i) {
                const int n = dir ? 127 - (s0 + i) : s0 + i;
                const size_t item = ibase + (size_t)n * 4;
                if (!dry) SB[item * 8192 + e] = f2bf_d(S);
                S = dc[i] * S + u[i];
            }
        }
    }
}
__device__ __forceinline__ void gla_part2_item(const Params& p, int l, bf16_t* P, const float* LR, int item, unsigned char* lds, int dry = 0) {
    const int h = item & 3, n = (item >> 2) & 127, bl = item >> 9, t0 = bl * SEQ + n * 64;
    const float* BF = (const float*)(lds + G_BF); const float* BB = (const float*)(lds + G_BB);
    bf16_t* QF = (bf16_t*)(lds + G_IMG);
    bf16_t* KF = QF + 2 * 64 * 72;
    bf16_t* QD = KF + 2 * 64 * 72;
    bf16_t* VT = QD + 2 * 64 * 72;
    bf16_t* ST = VT + 128 * 72;
    float* OX = (float*)lds;
    const float* GS = (const float*)(p.ws + OFF_GS);
    int tid_ = threadIdx.x; asm volatile("" : "+v"(tid_)); const int tid = tid_, lane = tid & 63, w = tid >> 6, l15 = lane & 15, q4 = lane >> 4;
    GlaPre gp; gla_prefetch(gp, P, t0, h, tid);
    u32x4 sp[2][2];
#pragma unroll
    for (int dir = 0; dir < 2; ++dir)
#pragma unroll
        for (int i = 0; i < 2; ++i) { const int idx = tid + NTHR * i; sp[dir][i] = *(const u32x4*)((const bf16_t*)(p.ws + OFF_SB) + ((size_t)dir * NITEM + item) * 8192 + (size_t)idx * 8); }
    {
        const float4* tb = (const float4*)((const float*)(p.ws + OFF_TB) + (size_t)item * 8192); float4* ts = (float4*)(lds + G_BF);
        float4 tv[4];
#pragma unroll
        for (int i = 0; i < 4; ++i) tv[i] = tb[tid + NTHR * i];
#pragma unroll
        for (int i = 0; i < 4; ++i) ts[tid + NTHR * i] = tv[i];
        __syncthreads();
    }
#pragma unroll
    for (int i = 0; i < 8; ++i) {
        const int idx = tid + NTHR * i, c = idx >> 6, dk = idx & 63;
        const float qv = bf2f(gp.q[i]);
        const float kv = bf2f(gp.k[i]);
        const float bf = BF[c * 64 + dk], mf = BF[31 * 64 + dk], bb = BB[c * 64 + dk], mb = BB[32 * 64 + dk];
        QF[c * 72 + dk] = f2bf_d(qv * __expf(bf - mf)); KF[c * 72 + dk] = f2bf_d(kv * __expf(mf - bf)); QD[c * 72 + dk] = f2bf_d(qv * __expf(bf));
        QF[4608 + c * 72 + dk] = f2bf_d(qv * __expf(bb - mb)); KF[4608 + c * 72 + dk] = f2bf_d(kv * __expf(mb - bb)); QD[4608 + c * 72 + dk] = f2bf_d(qv * __expf(bb));
    }
    gla_vt_store(gp, VT, tid);
#pragma unroll
    for (int dir = 0; dir < 2; ++dir) {
#pragma unroll
        for (int i = 0; i < 2; ++i) {
            const int idx = tid + NTHR * i, dv = idx >> 3, dk8 = (idx & 7) * 8;
            *(u32x4*)(ST + dir * 9216 + dv * 72 + dk8) = sp[dir][i];
        }
    }
    __syncthreads();
    const int dir = w >> 2, ct = w & 3;
    const bf16_t* qfp = QF + dir * 4608; const bf16_t* kfp = KF + dir * 4608; const bf16_t* qdp = QD + dir * 4608; const bf16_t* stp = ST + dir * 9216;
    bf16x8 qf[2], qd[2];
#pragma unroll
    for (int ks = 0; ks < 2; ++ks) { qf[ks] = *(const bf16x8*)(qfp + (16 * ct + l15) * 72 + 32 * ks + 8 * q4); qd[ks] = *(const bf16x8*)(qdp + (16 * ct + l15) * 72 + 32 * ks + 8 * q4); }
    f32x4 sc[4];
    const int cq = 16 * ct + l15;
#pragma unroll
    for (int st = 0; st < 4; ++st) {
        f32x4 a = {0.f, 0.f, 0.f, 0.f};
#pragma unroll
        for (int ks = 0; ks < 2; ++ks) { const bf16x8 kf = *(const bf16x8*)(kfp + (16 * st + l15) * 72 + 32 * ks + 8 * q4); a = MFMA(kf, qf[ks], a); }
#pragma unroll
        for (int e = 0; e < 4; ++e) { const int s = 16 * st + 4 * q4 + e; const bool ok = dir ? (s > cq) : (s <= cq); a[e] = ok ? a[e] : 0.f; }
        sc[st] = a;
    }
    f32x4 o[8];
#pragma unroll
    for (int dt = 0; dt < 8; ++dt) o[dt] = (f32x4){0.f, 0.f, 0.f, 0.f};
#pragma unroll
    for (int kk = 0; kk < 2; ++kk) {
        u32x4 pu; pu.x = pk2(sc[2 * kk][0], sc[2 * kk][1]); pu.y = pk2(sc[2 * kk][2], sc[2 * kk][3]); pu.z = pk2(sc[2 * kk + 1][0], sc[2 * kk + 1][1]); pu.w = pk2(sc[2 * kk + 1][2], sc[2 * kk + 1][3]);
        const bf16x8 pf = mkfrag(pu);
#pragma unroll
        for (int dt = 0; dt < 8; ++dt) {
            const bf16_t* vr = VT + (dt * 16 + l15) * 72 + kk * 32 + 4 * q4;
            const bf16x8 vf = mkfrag2(*(const u32x2*)vr, *(const u32x2*)(vr + 16));
            o[dt] = MFMA(vf, pf, o[dt]);
        }
    }
#pragma unroll
    for (int ks = 0; ks < 2; ++ks)
#pragma unroll
        for (int dt = 0; dt < 8; ++dt) { const bf16x8 sf = *(const bf16x8*)(stp + (dt * 16 + l15) * 72 + 32 * ks + 8 * q4); o[dt] = MFMA(sf, qd[ks], o[dt]); }
    if (dir == 1) {
#pragma unroll
        for (int dt = 0; dt < 8; ++dt) *(f32x4*)(OX + cq * 132 + 16 * dt + 4 * q4) = o[dt];
    }
    __syncthreads();
    if (dir == 0) {
        float ss = 0.f;
#pragma unroll
        for (int dt = 0; dt < 8; ++dt) { o[dt] += *(const f32x4*)(OX + cq * 132 + 16 * dt + 4 * q4); ss += (o[dt][0] * o[dt][0] + o[dt][1] * o[dt][1]) + (o[dt][2] * o[dt][2] + o[dt][3] * o[dt][3]); }
        ss += __shfl_xor(ss, 16); ss += __shfl_xor(ss, 32);
        const float rms = 1.0f / sqrtf(ss * (1.0f / 128.0f) + 1e-6f);
        const float* ng = p.gla_norm_g + l * 512 + h * 128;
        const bf16_t* zrow = P + (size_t)(t0 + cq) * PS + C_Z + 2 * 512 + h * 128;
        bf16_t* orow = P + (size_t)(t0 + cq) * PS + C_GV + h * 128;
#pragma unroll
        for (int dt = 0; dt < 8; ++dt) {
            const int dd = 16 * dt + 4 * q4;
            const f32x4 z = ld_bf4(zrow + dd); const f32x4 g4 = *(const f32x4*)(ng + dd);
            if (!dry) st_bf4(orow + dd, o[dt] * rms * g4 * z);
        }
    }
    __syncthreads();
}

namespace pg8 {
#define PG8_LAS __attribute__((address_space(3)))
typedef unsigned short bf16_t;
typedef short bf16x8 __attribute__((ext_vector_type(8)));
typedef float f32x4 __attribute__((ext_vector_type(4)));
typedef unsigned u32x4 __attribute__((ext_vector_type(4)));
constexpr int BM = 256, BK = 64, HALF = 128, HTB = HALF * BK * 2  , STAGE_BYTES = 8 * HTB, NXCD = 8, WGM = 8;

__host__ __device__ __forceinline__ int lds_byte(int r, int c) { const int st = (r >> 4) * 2 + (c >> 5), rr = r & 15, cc = c & 31, ob = rr * 64 + cc * 2; return st * 1024 + (ob ^ (((ob >> 9) & 1) << 5)); }
__host__ __device__ __forceinline__ void stage_rc(int b, int& R, int& C) { const int st = b / 1024, sb = b % 1024, swz = sb ^ (((sb >> 9) & 1) << 5); R = (st >> 1) * 16 + swz / 64; C = (st & 1) * 32 + (swz % 64) / 2; }
__host__ __device__ __forceinline__ int perm32(int rho) { const int n = rho >> 4, i = rho & 15; return 8 * (i >> 2) + 4 * n + (i & 3); }

struct Unit { int pm, pn; };
struct Gemm { const bf16_t* A; const bf16_t* Bt; int M, N, K; };

struct StaticOrder {
    int nM, nN, nwg, G, c;
    __host__ __device__ __forceinline__ void init(int M, int N, int G_, int c_) { nM = M / BM; nN = N / BM; nwg = nM * nN; G = G_; c = c_; }
    __host__ __device__ bool next(int i, Unit& u) const {
        const long L = (long)i * G + c; if (L >= nwg) return false;
        int wgid = (int)L; { const int q = nwg / NXCD, r = nwg % NXCD, xcd = wgid % NXCD, off = wgid / NXCD; wgid = (xcd < r ? xcd * (q + 1) : r * (q + 1) + (xcd - r) * q) + off; }
        const int nig = WGM * nN, gid = wgid / nig, fm = gid * WGM, gsz = (nM - fm) < WGM ? (nM - fm) : WGM;
        u.pm = fm + ((wgid % nig) % gsz); u.pn = (wgid % nig) / gsz; return true;
    }
    __device__ __forceinline__ void a_ready(const Unit&) const {}
    __device__ __forceinline__ void done(const Unit&) const {}
};
__device__ __forceinline__ unsigned cvt_pk_bf16(float lo, float hi) { unsigned r; asm volatile("v_cvt_pk_bf16_f32 %0, %1, %2" : "=v"(r) : "v"(lo), "v"(hi)); return r; }
template <class Epi, class Sched, bool STAMP = false>
__device__ __forceinline__ void gemm_phase(PG8_LAS unsigned char* lds, const Gemm g, const Sched& S, const Epi& E, unsigned long long* stamps) {
    int tid_l = threadIdx.x; asm volatile("" : "+v"(tid_l)); const int tid = tid_l, wid = __builtin_amdgcn_readfirstlane(tid >> 6), lane = tid & 63, wr = wid >> 2, wc = wid & 3, fr = lane & 15, fq = lane >> 4;
    const int K = g.K, nt = K / BK;
    int ts_lo = 0, ts_hi = 0, nts = 0; const unsigned long long rt_entry = STAMP ? (unsigned long long)wall_clock64() : 0ull;
#define PG8_STAMP() do { if (STAMP && wid == 0 && nts < 64) { const unsigned long long _c = (unsigned long long)clock64(); \
        ts_lo = (lane == nts) ? (int)(unsigned)_c : ts_lo; ts_hi = (lane == nts) ? (int)(unsigned)(_c >> 32) : ts_hi; ++nts; } } while (0)
    PG8_STAMP();
    unsigned voffA[2], voffB[2];
#pragma unroll
    for (int i = 0; i < 2; ++i) { int R, C; stage_rc(tid * 16 + i * 8192, R, C); const int Rb = Epi::PERM ? ((R & ~31) + perm32(R & 31)) : R;
        voffA[i] = (unsigned)(R * K + C) * 2u; voffB[i] = (unsigned)(Rb * K + C) * 2u; }
    const size_t kstep = (size_t)(BK * 2);
    const size_t hstep = (size_t)HALF * K * 2;
    const size_t tstep = 2 * hstep;
    const unsigned ldsw = (unsigned)wid * 1024u;
    const int aoff = lds_byte(wr * 64 + fr, fq * 8), boff = lds_byte(wc * 32 + fr, fq * 8);
#define PG8_SA(b, h) (((b) * 2 + (h)) * HTB)
#define PG8_SB(b, h) ((4 + (b) * 2 + (h)) * HTB)
#define PG8_STAGE(bufoff, gbase, voff) do { _Pragma("unroll") for (int _i = 0; _i < 2; ++_i) \
        __builtin_amdgcn_global_load_lds((const unsigned*)((const char*)(gbase) + (voff)[_i]), (PG8_LAS unsigned*)(lds + (bufoff) + ldsw + _i * 8192), 16, 0, 0); } while (0)
#define PG8_LDA(dst, b, h) do { _Pragma("unroll") for (int m = 0; m < 4; ++m) _Pragma("unroll") for (int k = 0; k < 2; ++k) dst[m][k] = *(const PG8_LAS bf16x8*)(lds + PG8_SA(b, h) + aoff + m * 2048 + k * 1024); } while (0)
#define PG8_LDB(dst, b, h) do { _Pragma("unroll") for (int n = 0; n < 2; ++n) _Pragma("unroll") for (int k = 0; k < 2; ++k) dst[n][k] = *(const PG8_LAS bf16x8*)(lds + PG8_SB(b, h) + boff + n * 2048 + k * 1024); } while (0)
#define PG8_MMA(ai, bj, At, Bt) do { __builtin_amdgcn_s_setprio(1); _Pragma("unroll") for (int m = 0; m < 4; ++m) _Pragma("unroll") for (int n = 0; n < 2; ++n) _Pragma("unroll") for (int k = 0; k < 2; ++k) \
        acc[ai][bj][m][n] = __builtin_amdgcn_mfma_f32_16x16x32_bf16(Bt[n][k], At[m][k], acc[ai][bj][m][n], 0, 0, 0); __builtin_amdgcn_s_setprio(0); } while (0)
#define PG8_WAIT_V(n) asm volatile("s_waitcnt vmcnt(" #n ")" ::: "memory")
#define PG8_WAIT_L(n) asm volatile("s_waitcnt lgkmcnt(" #n ")" ::: "memory")
#define PG8_BAR __builtin_amdgcn_s_barrier()
#define PG8_SCHED __builtin_amdgcn_sched_barrier(0)
    Unit cur, nxt; int ui = 0;
    if (!S.next(0, cur)) return;
    f32x4 acc[2][2][4][2];
#pragma unroll
    for (int a = 0; a < 2; ++a)
#pragma unroll
        for (int b = 0; b < 2; ++b)
#pragma unroll
            for (int m = 0; m < 4; ++m)
#pragma unroll
                for (int n = 0; n < 2; ++n) acc[a][b][m][n] = (f32x4){0.f, 0.f, 0.f, 0.f};
    bf16x8 At[4][2], B0[2][2], B1[2][2];
    const char* cA = (const char*)g.A + (size_t)cur.pm * tstep; const char* cB = (const char*)g.Bt + (size_t)cur.pn * tstep;
    S.a_ready(cur);
    PG8_STAGE(PG8_SB(0, 0), cB, voffB); PG8_STAGE(PG8_SA(0, 0), cA, voffA); PG8_STAGE(PG8_SB(0, 1), cB + hstep, voffB); PG8_STAGE(PG8_SA(0, 1), cA + hstep, voffA);
    if (wr == 1) PG8_BAR;
    PG8_WAIT_V(4); PG8_BAR;
    PG8_STAGE(PG8_SB(1, 0), cB + kstep, voffB); PG8_STAGE(PG8_SA(1, 0), cA + kstep, voffA); PG8_STAGE(PG8_SB(1, 1), cB + hstep + kstep, voffB);
    PG8_WAIT_V(6); PG8_BAR;
    PG8_STAMP();
    for (;;) {
        const bool has_next = S.next(ui + 1, nxt);
        const char* nA = has_next ? (const char*)g.A + (size_t)nxt.pm * tstep : cA; const char* nB = has_next ? (const char*)g.Bt + (size_t)nxt.pn * tstep : cB;
        for (int t = 0; t < nt; t += 2) {
            const bool last = (t == nt - 2);
            const char* a1 = cA + (size_t)(t + 1) * kstep;
            const char* a2 = last ? nA : cA + (size_t)(t + 2) * kstep; const char* b2 = last ? nB : cB + (size_t)(t + 2) * kstep;
            const char* a3 = a2 + kstep; const char* b3 = b2 + kstep;
            if (last && has_next) S.a_ready(nxt);
            PG8_LDB(B0, 0, 0); PG8_SCHED; PG8_LDA(At, 0, 0); PG8_STAGE(PG8_SA(1, 1), a1 + hstep, voffA);
            PG8_WAIT_L(8); PG8_BAR; PG8_WAIT_L(0); PG8_MMA(0, 0, At, B0); PG8_BAR; PG8_SCHED;
            PG8_LDB(B1, 0, 1); PG8_STAGE(PG8_SB(0, 0), b2, voffB);
            PG8_BAR; PG8_WAIT_L(0); PG8_MMA(0, 1, At, B1); PG8_BAR;
            PG8_LDA(At, 0, 1); PG8_STAGE(PG8_SA(0, 0), a2, voffA);
            PG8_BAR; PG8_WAIT_L(0); PG8_MMA(1, 0, At, B0); PG8_BAR; PG8_SCHED;
            PG8_STAGE(PG8_SB(0, 1), b2 + hstep, voffB);
            PG8_WAIT_V(6); PG8_BAR; PG8_MMA(1, 1, At, B1); PG8_BAR;
            PG8_LDB(B0, 1, 0); PG8_SCHED; PG8_LDA(At, 1, 0); PG8_STAGE(PG8_SA(0, 1), a2 + hstep, voffA);
            PG8_WAIT_L(8); PG8_BAR; PG8_WAIT_L(0); PG8_MMA(0, 0, At, B0); PG8_BAR; PG8_SCHED;
            PG8_LDB(B1, 1, 1); PG8_STAGE(PG8_SB(1, 0), b3, voffB);
            PG8_BAR; PG8_WAIT_L(0); PG8_MMA(0, 1, At, B1); PG8_BAR;
            PG8_LDA(At, 1, 1); PG8_STAGE(PG8_SA(1, 0), a3, voffA);
            PG8_BAR; PG8_WAIT_L(0); PG8_MMA(1, 0, At, B0); PG8_BAR; PG8_SCHED;
            PG8_STAGE(PG8_SB(1, 1), b3 + hstep, voffB);
            PG8_WAIT_V(6); PG8_BAR; PG8_MMA(1, 1, At, B1); PG8_BAR;
        }
        PG8_STAMP();
        if constexpr (!Epi::AFTER_DRAIN) { E(acc, cur, wr, wc, fr, fq); S.done(cur); }
        PG8_STAMP();
        if (!has_next) break;
#pragma unroll
        for (int a = 0; a < 2; ++a)
#pragma unroll
            for (int b = 0; b < 2; ++b)
#pragma unroll
                for (int m = 0; m < 4; ++m)
#pragma unroll
                    for (int n = 0; n < 2; ++n) acc[a][b][m][n] = (f32x4){0.f, 0.f, 0.f, 0.f};
        cur = nxt; cA = nA; cB = nB; ++ui;
    }
    PG8_WAIT_V(0);
    if (wr == 0) PG8_BAR;
    PG8_BAR;
    if constexpr (Epi::AFTER_DRAIN) { E.fused(acc, cur, wr, wc, fr, fq, lds, wid, lane); S.done(cur); }
    PG8_STAMP();
    if (STAMP && wid == 0) { stamps[lane] = lane < nts ? (((unsigned long long)(unsigned)ts_hi << 32) | (unsigned)ts_lo) : 0ull;
        if (lane == 62) stamps[62] = rt_entry; if (lane == 63) stamps[63] = (unsigned long long)wall_clock64(); }
#undef PG8_STAMP
#undef PG8_SA
#undef PG8_SB
#undef PG8_STAGE
#undef PG8_LDA
#undef PG8_LDB
#undef PG8_MMA
#undef PG8_WAIT_V
#undef PG8_WAIT_L
#undef PG8_BAR
#undef PG8_SCHED
}
}

struct EpiInProj {
    static constexpr bool PERM = true, AFTER_DRAIN = false;
    bf16_t* P; const float* bias; float* LR;
    __device__ __forceinline__ void operator()(const f32x4 (&acc)[2][2][4][2], const pg8::Unit& u, int wr, int wc, int fr, int fq) const {
        const int row0 = u.pm * 256 + wr * 64 + fr, colt = u.pn * 256, col0 = colt + wc * 32 + 8 * fq;
        if (colt == C_LR) {
            if (wc == 0) {
                const int cl = 8 * fq;
                const f32x4 b0 = *(const f32x4*)(bias + 4096 + cl), b1 = *(const f32x4*)(bias + 4096 + cl + 4);
#pragma unroll
                for (int ai = 0; ai < 2; ++ai)
#pragma unroll
                    for (int m = 0; m < 4; ++m) {
                        float* d = LR + (size_t)(row0 + ai * 128 + m * 16) * 32 + cl;
                        *(f32x4*)d = acc[ai][0][m][0] + b0; *(f32x4*)(d + 4) = acc[ai][0][m][1] + b1;
                    }
            }
            return;
        }
        const int mode = (colt < 512 || colt == C_GQ) ? 1 : (colt >= C_MQ && colt < C_Z) ? 2 : (colt >= C_Z && colt < C_SG) ? 3 : (colt >= C_SG) ? 4 : 0;
#pragma unroll
        for (int bj = 0; bj < 2; ++bj) {
            const int col = col0 + bj * 128;
            const f32x4 b0 = *(const f32x4*)(bias + orig_col(col)), b1 = *(const f32x4*)(bias + orig_col(col) + 4);
#pragma unroll
            for (int ai = 0; ai < 2; ++ai)
#pragma unroll
                for (int m = 0; m < 4; ++m) {
                    f32x4 v0 = acc[ai][bj][m][0] + b0, v1 = acc[ai][bj][m][1] + b1;
                    if (mode == 1) { v0 *= 0.125f; v1 *= 0.125f; }
                    else if (mode == 2) { v0 *= 0.08838834764831845f; v1 *= 0.08838834764831845f; }
                    else if (mode == 3) {
#pragma unroll
                        for (int e = 0; e < 4; ++e) { v0[e] = siluf_(v0[e]); v1[e] = siluf_(v1[e]); }
                    } else if (mode == 4) {
#pragma unroll
                        for (int e = 0; e < 4; ++e) { v0[e] = sigmoidf_(v0[e]); v1[e] = sigmoidf_(v1[e]); }
                    }
                    u32x4 o; o.x = pk2(v0[0], v0[1]); o.y = pk2(v0[2], v0[3]); o.z = pk2(v1[0], v1[1]); o.w = pk2(v1[2], v1[3]);
                    *(u32x4*)(P + (size_t)(row0 + ai * 128 + m * 16) * PS + col) = o;
                }
        }
    }
};
struct EpiOut {
    static constexpr bool PERM = false, AFTER_DRAIN = false;
    bf16_t* pre; const float* bo;
    __device__ __forceinline__ void operator()(const f32x4 (&acc)[2][2][4][2], const pg8::Unit& u, int wr, int wc, int fr, int fq) const {
        const int row0 = u.pm * 256 + wr * 64 + fr, col0 = u.pn * 256 + wc * 32 + 4 * fq;
#pragma unroll
        for (int bj = 0; bj < 2; ++bj)
#pragma unroll
            for (int n = 0; n < 2; ++n) {
                const int col = col0 + bj * 128 + n * 16;
                const f32x4 b4 = *(const f32x4*)(bo + col);
#pragma unroll
                for (int ai = 0; ai < 2; ++ai)
#pragma unroll
                    for (int m = 0; m < 4; ++m) st_bf4(pre + (size_t)(row0 + ai * 128 + m * 16) * 1024 + col, acc[ai][bj][m][n] + b4);
            }
    }
};

__device__ __forceinline__ void ln_rows_res(const Params& p, int l, size_t tok0) {
    int tid_ = threadIdx.x; asm volatile("" : "+v"(tid_));
    const int lane = tid_ & 63;
    const int gw = blockIdx.x * (NTHR / 64) + (tid_ >> 6), nw = gridDim.x * (NTHR / 64);
    const bf16_t* pre = (const bf16_t*)(p.ws + OFF_PRE); const float2* stats = (const float2*)(p.ws + OFF_STATS); bf16_t* hb = (bf16_t*)(p.ws + OFF_HB);
    const float* g = p.ln_g + l * 1024; const float* b = p.ln_b + l * 1024;
    for (int r = gw; r < TG; r += nw) {
        const size_t T = tok0 + r;
        const bf16_t* pr = pre + (size_t)r * 1024;
        float4 v[4]; float s = 0.f;
        if (l == 0) {
            const float4* xr = (const float4*)(p.x + T * 1024); const float2 st = stats[T];
#pragma unroll
            for (int i = 0; i < 4; ++i) {
                const f32x4 a4 = ld_bf4(pr + (lane + 64 * i) * 4); float4 a; a.x = a4[0]; a.y = a4[1]; a.z = a4[2]; a.w = a4[3]; const float4 x4 = xr[lane + 64 * i], g4 = ((const float4*)p.ln_in_g)[lane + 64 * i], b4 = ((const float4*)p.ln_in_b)[lane + 64 * i];
                v[i].x = a.x + DN_ALPHA * ((x4.x - st.x) * st.y * g4.x + b4.x); v[i].y = a.y + DN_ALPHA * ((x4.y - st.x) * st.y * g4.y + b4.y);
                v[i].z = a.z + DN_ALPHA * ((x4.z - st.x) * st.y * g4.z + b4.z); v[i].w = a.w + DN_ALPHA * ((x4.w - st.x) * st.y * g4.w + b4.w);
            }
        } else {
            const float4* hr = (const float4*)(p.out + T * 1024);
#pragma unroll
            for (int i = 0; i < 4; ++i) {
                const f32x4 a4 = ld_bf4(pr + (lane + 64 * i) * 4); float4 a; a.x = a4[0]; a.y = a4[1]; a.z = a4[2]; a.w = a4[3]; const float4 h4 = hr[lane + 64 * i];
                v[i].x = a.x + DN_ALPHA * h4.x; v[i].y = a.y + DN_ALPHA * h4.y; v[i].z = a.z + DN_ALPHA * h4.z; v[i].w = a.w + DN_ALPHA * h4.w;
            }
        }
#pragma unroll
        for (int i = 0; i < 4; ++i) s += (v[i].x + v[i].y) + (v[i].z + v[i].w);
        s = wave_sum(s);
        const float mean = s * (1.0f / 1024.0f);
        float q = 0.f;
#pragma unroll
        for (int i = 0; i < 4; ++i) { const float a = v[i].x - mean, bb = v[i].y - mean, c = v[i].z - mean, d = v[i].w - mean; q += (a * a + bb * bb) + (c * c + d * d); }
        q = wave_sum(q);
        const float rstd = 1.0f / sqrtf(q * (1.0f / 1024.0f) + 1e-5f);
#pragma unroll
        for (int i = 0; i < 4; ++i) {
            const float4 g4 = ((const float4*)g)[lane + 64 * i], b4 = ((const float4*)b)[lane + 64 * i];
            float4 y; y.x = (v[i].x - mean) * rstd * g4.x + b4.x; y.y = (v[i].y - mean) * rstd * g4.y + b4.y; y.z = (v[i].z - mean) * rstd * g4.z + b4.z; y.w = (v[i].w - mean) * rstd * g4.w + b4.w;
            ((float4*)(p.out + T * 1024))[lane + 64 * i] = y;
            u32x2 o; o.x = pk2(y.x, y.y); o.y = pk2(y.z, y.w); *(u32x2*)(hb + T * 1024 + (lane + 64 * i) * 4) = o;
        }
    }
}

#define XB_TMO      128
#define XB_XCNT(j)  (256  + 64 * (j))
#define XB_XSUB(j)  (1280 + 64 * (j))
#define XB_XGEN(j)  (2304 + 64 * (j))
#define XB_TOP      3328
#define XB_TOPGEN   3392
#define XCD_BAR_WORDS 3456
#define XB_SPIN_CAP (1u << 18)
#define LAS __attribute__((address_space(3)))

__device__ __forceinline__ unsigned xb_ld(unsigned* p)              { return __hip_atomic_load(p, __ATOMIC_RELAXED, __HIP_MEMORY_SCOPE_AGENT); }
__device__ __forceinline__ unsigned xb_add(unsigned* p, unsigned v) { return __hip_atomic_fetch_add(p, v, __ATOMIC_RELAXED, __HIP_MEMORY_SCOPE_AGENT); }
__device__ __forceinline__ unsigned xb_xcc_id() { return (unsigned)__builtin_amdgcn_s_getreg((3 << 11) | 20) & 0xFu; }
#define XB_SPIN(cond, bar) do { unsigned _sp = 0; while (cond) { __builtin_amdgcn_s_sleep(1); \
    if ((++_sp & 255u) == 0u) { if (xb_ld(&(bar)[XB_TMO])) break; if (_sp > XB_SPIN_CAP) { atomicAdd(&(bar)[XB_TMO], 1u); break; } } } } while (0)

struct XcdBarrier {
    unsigned* bar; unsigned x;
    volatile LAS unsigned* st;
};

__device__ __forceinline__ XcdBarrier xcd_barrier_post(unsigned* bar, volatile LAS unsigned* st) {
    XcdBarrier b; b.bar = bar; b.x = xb_xcc_id(); b.st = st;
    if (threadIdx.x == 0) (void)xb_add(&bar[XB_XCNT(b.x)], 1u);
    return b;
}
__device__ __forceinline__ void xcd_barrier_complete(unsigned* bar, unsigned x, unsigned& nloc, unsigned& nx) {
    const unsigned G = gridDim.x * gridDim.y * gridDim.z;
    unsigned sum, cnt, mine, sp = 0u;
    for (;;) {
        sum = 0u; cnt = 0u; mine = 0u;
#pragma unroll
        for (unsigned j = 0; j < 16; ++j) { const unsigned c = xb_ld(&bar[XB_XCNT(j)]); sum += c; cnt += (c > 0u) ? 1u : 0u; mine = (j == x) ? c : mine; }
        if (sum == G) break;
        __builtin_amdgcn_s_sleep(1);
        if ((++sp & 255u) == 0u) { if (xb_ld(&bar[XB_TMO])) break; if (sp > XB_SPIN_CAP) { atomicAdd(&bar[XB_TMO], 1u); break; } }
    }
    nloc = mine > 0u ? mine : 1u; nx = cnt > 0u ? cnt : 1u;
}

__device__ __forceinline__ void xcd_barrier(unsigned* b_bar, unsigned b_x, volatile LAS unsigned* b_st) {
    asm volatile("s_waitcnt vmcnt(0)" ::: "memory");
    __syncthreads();
    if (threadIdx.x == 0) {
        unsigned* bar = b_bar;
        __builtin_amdgcn_s_waitcnt(0);
        unsigned nloc = b_st[0], nx = b_st[1];
        if (nloc == 0u) { xcd_barrier_complete(bar, b_x, nloc, nx); b_st[0] = nloc; b_st[1] = nx; }
        const unsigned old = xb_add(&bar[XB_XSUB(b_x)], 1u);
        const unsigned gen = old / nloc;
        if (old + 1u == (gen + 1u) * nloc) {
            __builtin_amdgcn_fence(__ATOMIC_RELEASE, "agent");
            asm volatile("s_waitcnt vmcnt(0)" ::: "memory");
            const unsigned og = xb_add(&bar[XB_TOP], 1u);
            const unsigned tg = og / nx;
            if (og + 1u == (tg + 1u) * nx) xb_add(&bar[XB_TOPGEN], 1u);
            else XB_SPIN(xb_ld(&bar[XB_TOPGEN]) == tg, bar);
            __builtin_amdgcn_fence(__ATOMIC_ACQUIRE, "agent");
            xb_add(&bar[XB_XGEN(b_x)], 1u);
            asm volatile("s_waitcnt vmcnt(0)" ::: "memory");
        } else {
            XB_SPIN(xb_ld(&bar[XB_XGEN(b_x)]) == gen, bar);
            __builtin_amdgcn_fence(__ATOMIC_ACQUIRE, "agent");
            asm volatile("s_waitcnt vmcnt(0)" ::: "memory");
        }
    }
    __syncthreads();
}

__device__ __forceinline__ void gbar(unsigned* ctr, unsigned& gen, int G) {
    __syncthreads();
    gen += (unsigned)G;
    if (threadIdx.x == 0) {
        __threadfence();
        __hip_atomic_fetch_add(ctr, 1u, __ATOMIC_RELAXED, __HIP_MEMORY_SCOPE_AGENT);
        while (__hip_atomic_load(ctr, __ATOMIC_RELAXED, __HIP_MEMORY_SCOPE_AGENT) < gen) __builtin_amdgcn_s_sleep(1);
        __threadfence();
    }
    __syncthreads();
}
typedef const Params __attribute__((address_space(4))) KParams;
#define KP4 __attribute__((address_space(4)))
__device__ __forceinline__ Params fresh_params() {
#if defined(__HIP_DEVICE_COMPILE__)
    KParams* kp = (KParams*)__builtin_amdgcn_kernarg_segment_ptr();
    asm volatile("" : "+s"(kp));
    Params r;
    const float* KP4 const* src = (const float* KP4 const*)kp;
    const float** dst = (const float**)&r;
#pragma unroll
    for (int i = 0; i < 28; ++i) dst[i] = src[i];
    return r;
#else
    return Params{};
#endif
}
__global__ void __launch_bounds__(NTHR) mega(Params p_unused) {
    extern __shared__ __attribute__((aligned(16))) unsigned char lds[];
    cg::grid_group grid = cg::this_grid();
    const int G = gridDim.x, bid = blockIdx.x;
    volatile LAS unsigned* xst = (volatile LAS unsigned*)((LAS unsigned char*)lds + (LDS_BYTES - 16));
    if (threadIdx.x == 0) { xst[0] = 0u; xst[1] = 0u; }
    __syncthreads();
    unsigned* xbar; unsigned xx;
    { const Params p = fresh_params(); xbar = (unsigned*)(p.ws + OFF_BAR); xx = xb_xcc_id(); if (threadIdx.x == 0) (void)xb_add(&xbar[XB_XCNT(xx)], 1u); }
    { const Params p = fresh_params(); phase0(p); }
    grid.sync();
#pragma unroll 1
    for (int l = 0; l < 2; ++l) {
        { const Params p = fresh_params(); phase_weights(p, l, lds); __syncthreads(); phase_filter_gen(p, l, lds); }
        xcd_barrier(xbar, xx, xst);
        {
            const Params p = fresh_params();
            phase_filter_fft(p, l, lds);
            const bf16_t* WtKV = (const bf16_t*)(p.ws + OFF_WTKV); const bf16_t* membf = (const bf16_t*)(p.ws + OFF_MEMBF);
            for (int t = bid; t < 64; t += G) {
                f32x4 acc[4][4];
                if (t < 32) {
                    const int m0 = (t >> 2) * 256, n0 = (t & 3) * 128;
                    gemm_core(acc, membf + (size_t)m0 * 1024, 1024, WtKV + (size_t)n0 * 1024, 1024, 1024, lds);
                    bf16_t* Km = (bf16_t*)(p.ws + OFF_KMAT);
                    EPI_LOOP(st_bf4(Km + (size_t)row * 512 + col, v);)
                } else {
                    const int t2 = t - 32, m0 = (t2 >> 4) * 256, n0 = (t2 & 15) * 128;
                    gemm_core(acc, WtKV + (size_t)(512 + m0) * 1024, 1024, membf + (size_t)n0 * 1024, 1024, 1024, lds);
                    bf16_t* Vm = (bf16_t*)(p.ws + OFF_VT);
                    EPI_LOOP(st_bf4(Vm + (size_t)row * 2048 + col, v);)
                }
            }
        }
        xcd_barrier(xbar, xx, xst);
#pragma unroll 1
        for (int g = 0; g < NGRP; ++g) {
            const size_t tok0 = (size_t)g * TG;
#pragma unroll 1
            for (int rep = 0; rep < PROBE_REP_INPROJ; ++rep) {
                const Params p = fresh_params();
                pg8::Gemm gm; gm.A = (const bf16_t*)(p.ws + OFF_HB) + tok0 * 1024; gm.Bt = (const bf16_t*)(p.ws + OFF_WTIN); gm.M = TG; gm.N = NINP; gm.K = 1024;
                pg8::StaticOrder S; S.init(TG, NINP, G, bid);
                EpiInProj E; E.P = (bf16_t*)(p.ws + OFF_P); E.bias = p.b_in + (size_t)l * NIN; E.LR = (float*)(p.ws + OFF_LR);
                pg8::gemm_phase<EpiInProj, pg8::StaticOrder, false>((PG8_LAS unsigned char*)lds, gm, S, E, nullptr);
                __syncthreads();
            }
            xcd_barrier(xbar, xx, xst);
#pragma unroll 1
            for (int rep = 0; rep < PROBE_REP_MIX; ++rep) {
            int dry = (rep + 1 < PROBE_REP_MIX) ? 1 : 0; asm volatile("" : "+s"(dry));
            {
                const Params p = fresh_params();
                bf16_t* P = (bf16_t*)(p.ws + OFF_P);
                for (int it = bid; it < BG * 64 * 8; it += G) na_item(p, l, P, it >> 9, (it >> 3) & 63, it & 7, lds, dry);
            }
            {
                const Params p = fresh_params();
                bf16_t* P = (bf16_t*)(p.ws + OFF_P);
                for (int it = bid; it < BG * 128 * 8; it += G) hy_pre_item(p, l, P, (float*)(p.ws + OFF_UT), (bf16_t*)(p.ws + OFF_GT), it >> 10, (it >> 3) & 127, it & 7, lds);
            }
            {
                const Params p = fresh_params();
                for (int it = bid; it < NITEM; it += G) gla_part1_item(p, l, (const bf16_t*)(p.ws + OFF_P), (const float*)(p.ws + OFF_LR), it, lds);
            }
            {
                const Params p = fresh_params();
                bf16_t* P = (bf16_t*)(p.ws + OFF_P);
                const int nit = BG * 4 * 64, per = (nit + G - 1) / G;
                int last = -1;
                for (int it = bid * per; it < min(nit, (bid + 1) * per); ++it) {
                    const int bh = it >> 6, bl = bh >> 2, h = bh & 3;
                    if (bh != last) { __syncthreads(); memattn_load(p, g * BG + bl, h, lds); last = bh; }
                    memattn_item(P, bl, h, it & 63, lds, dry);
                }
                __syncthreads();
            }
            xcd_barrier(xbar, xx, xst);
            {
                const Params p = fresh_params();
                const float2* twl = fft_lds_twiddles((const float2*)(p.ws + OFF_TW), lds);
                for (int it = bid; it < BG * 256; it += G) hyena_conv_item(p, (const float*)(p.ws + OFF_UT), (bf16_t*)(p.ws + OFF_GT), it >> 8, it & 255, lds, twl, dry);
                __syncthreads();
                gla_scan(p, dry);
            }
            xcd_barrier(xbar, xx, xst);
            {
                const Params p = fresh_params();
                for (int it = bid; it < NITEM; it += G) gla_part2_item(p, l, (bf16_t*)(p.ws + OFF_P), (const float*)(p.ws + OFF_LR), it, lds, dry);
            }
            {
                const Params p = fresh_params();
                for (int it = bid; it < BG * 128 * 8; it += G) hy_post_item((bf16_t*)(p.ws + OFF_P), (const bf16_t*)(p.ws + OFF_GT), it >> 10, (it >> 3) & 127, it & 7, lds, dry);
            }
            xcd_barrier(xbar, xx, xst);
            }
            {
                const Params p = fresh_params();
                const bf16_t* P = (const bf16_t*)(p.ws + OFF_P); const bf16_t* WtBr = (const bf16_t*)(p.ws + OFF_WTBR); bf16_t* merged = (bf16_t*)(p.ws + OFF_MERGED);
                for (int t = bid; t < 512; t += G) {
                    const int sr = t >> 8, sb = t & 255, sx = sb & 7, sk = sb >> 3;
                    const int m0 = (sr * 32 + (sk >> 3) * 8 + sx) * 256, n0 = (sk & 7) * 128;
                    merge_tile(P, WtBr, merged, m0, n0, lds);
                }
            }
            xcd_barrier(xbar, xx, xst);
            {
                const Params p = fresh_params();
                pg8::Gemm gm; gm.A = (const bf16_t*)(p.ws + OFF_MERGED); gm.Bt = (const bf16_t*)(p.ws + OFF_WTOUT); gm.M = TG; gm.N = 1024; gm.K = 1024;
                pg8::StaticOrder S; S.init(TG, 1024, G, bid);
                EpiOut E; E.pre = (bf16_t*)(p.ws + OFF_PRE); E.bo = p.b_out + l * 1024;
                pg8::gemm_phase<EpiOut, pg8::StaticOrder, false>((PG8_LAS unsigned char*)lds, gm, S, E, nullptr);
                __syncthreads();
            }
            xcd_barrier(xbar, xx, xst);
            {
                const Params p = fresh_params();
                ln_rows_res(p, l, tok0);
            }
        }
        xcd_barrier(xbar, xx, xst);
    }
}

extern "C" void kernel_launch(void* const* d_in, const int* in_sizes, int n_in, void* d_out, int out_size, void* d_ws, size_t ws_size, hipStream_t stream) {
    static int grid_blocks = 0;
    if (!grid_blocks) {
        if (ws_size < WS_END) { fprintf(stderr, "kernel_launch: workspace too small: %zu < %zu\n", ws_size, (size_t)WS_END); grid_blocks = -1; return; }
        {
            const long long ex[26] = {67108864LL, 2097152LL, 1024, 1024, 2LL * 1024 * 10784, 2 * 10784, 2 * 8 * 15 * 31, 2 * 3 * 1536, 2 * 1536, 2 * 33 * 64, 2 * 64, 2 * 2 * 64 * 64, 2 * 2 * 64,
                                      2 * 64 * 1024, 2 * 512, 2 * 16 * 256, 2 * 256, 2 * 16 * 256, 2 * 256, 2 * 512, 2LL * 1024 * 1024, 2LL * 4 * 512 * 1024, 2LL * 1024 * 1024, 2 * 1024, 2 * 1024, 2 * 1024};
            bool bad = (n_in != 26) || (out_size != 67108864);
            for (int i = 0; i < 26 && !bad; ++i) if ((long long)in_sizes[i] != ex[i]) { fprintf(stderr, "kernel_launch: input %d has %d elements, expected %lld\n", i, in_sizes[i], ex[i]); bad = true; }
            if (bad) { fprintf(stderr, "kernel_launch: unexpected shapes; nothing launched\n"); grid_blocks = -1; return; }
        }
        int dev = 0, cus = 0, per_cu = 0;
        hipGetDevice(&dev);
        hipDeviceGetAttribute(&cus, hipDeviceAttributeMultiprocessorCount, dev);
        if (hipFuncSetAttribute((const void*)mega, hipFuncAttributeMaxDynamicSharedMemorySize, LDS_BYTES) != hipSuccess) fprintf(stderr, "kernel_launch: hipFuncSetAttribute failed\n");
        if (hipOccupancyMaxActiveBlocksPerMultiprocessor(&per_cu, (const void*)mega, NTHR, LDS_BYTES) != hipSuccess || per_cu < 1) { fprintf(stderr, "kernel_launch: occupancy query gave %d\n", per_cu); per_cu = 1; }
        (void)hipGetLastError();
        if (per_cu > 1) per_cu = 1;
        grid_blocks = cus * per_cu;
    }
    if (grid_blocks < 0) return;
    Params p{};
    const float** pp = (const float**)&p;
    for (int i = 0; i < 26; ++i) pp[i] = (const float*)d_in[i];
    p.out = (float*)d_out; p.ws = (unsigned char*)d_ws;
    if (hipMemsetAsync((unsigned char*)d_ws + OFF_BAR, 0, 16384, stream) != hipSuccess) fprintf(stderr, "kernel_launch: memset of the barrier word failed\n");
    void* args[] = {&p};
    hipError_t e = hipLaunchCooperativeKernel((const void*)mega, dim3(grid_blocks), dim3(NTHR), args, LDS_BYTES, stream);
    if (e != hipSuccess) fprintf(stderr, "cooperative launch failed: %s (grid %d)\n", hipGetErrorString(e), grid_blocks);
}
#endif
```

```cpp
#ifndef PROBE_REP_MIX
#define PROBE_REP_MIX 1
#endif
#ifndef PROBE_REP_INPROJ
#define PROBE_REP_INPROJ 1
#endif
#include <hip/hip_runtime.h>
#include <hip/hip_cooperative_groups.h>
#include <cstdio>
#include <unistd.h>
#include <cmath>
namespace cg = cooperative_groups;

#define HD __host__ __device__
typedef unsigned short bf16_t;
typedef short bf16x8 __attribute__((ext_vector_type(8)));
typedef float f32x4 __attribute__((ext_vector_type(4)));
typedef unsigned u32x2 __attribute__((ext_vector_type(2)));
typedef unsigned u32x4 __attribute__((ext_vector_type(4)));

constexpr int NTOK = 65536, DM = 1024, SEQ = 8192, NB = 8;
constexpr int BG = 2;
constexpr int NGRP = NB / BG;
constexpr int TG = BG * SEQ;
constexpr int PS = 10752;
constexpr int NIN = 10784, NINP = 11008;
constexpr int C_NAQ = 0, C_NAK = 512, C_NAV = 1024, C_HY = 1536, C_GQ = 3072, C_GK = 3328, C_GV = 3584, C_MQ = 4096, C_Z = 4608, C_SG = 6656, C_LR = 10752;
constexpr int FN = 16384;
constexpr int NITEM = BG * 128 * 4;
constexpr int LDS_BYTES = 160 * 1024;
constexpr int NTHR = 512;
constexpr float DN_ALPHA = 1.41421356237309515f;

constexpr size_t al256(size_t x) { return (x + 255) & ~(size_t)255; }
constexpr size_t OFF_HB = 0;
constexpr size_t OFF_STATS = OFF_HB + (size_t)NTOK * DM * 2;
constexpr size_t OFF_TW = OFF_STATS + (size_t)NTOK * 8;
constexpr size_t OFF_MEMBF = OFF_TW + (size_t)FN * 8;
constexpr size_t OFF_ENERGY = OFF_MEMBF + (size_t)2048 * 1024 * 2;
constexpr size_t OFF_WTIN = OFF_ENERGY + 4096;
constexpr size_t OFF_WTBR = OFF_WTIN + (size_t)NINP * 1024 * 2;
constexpr size_t OFF_WTOUT = OFF_WTBR + (size_t)4 * 1024 * 512 * 2;
constexpr size_t OFF_WTKV = OFF_WTOUT + (size_t)1024 * 1024 * 2;
constexpr size_t OFF_KMAT = OFF_WTKV + (size_t)2048 * 1024 * 2;
constexpr size_t OFF_VT = OFF_KMAT + (size_t)2048 * 1024 * 2;
constexpr size_t OFF_HFILT = OFF_VT + (size_t)2048 * 1024 * 2;
constexpr size_t OFF_PQ = OFF_HFILT + (size_t)1024 * 8192 * 4;
constexpr size_t OFF_P = OFF_PQ + (size_t)256 * FN * 16;
constexpr size_t OFF_LR = OFF_P + (size_t)TG * PS * 2;
constexpr size_t OFF_GS = OFF_LR + (size_t)TG * 32 * 4;
constexpr size_t OFF_GDEC = OFF_GS + (size_t)2 * NITEM * 8192 * 4;
constexpr size_t OFF_MERGED = OFF_GDEC + (size_t)2 * NITEM * 64 * 4;
constexpr size_t OFF_PRE = OFF_MERGED + (size_t)TG * 1024 * 2;
constexpr size_t OFF_UT = OFF_PRE + (size_t)TG * 1024 * 4;
constexpr size_t OFF_GT = OFF_UT + (size_t)BG * 512 * 8192 * 4;
constexpr size_t OFF_BAR = OFF_GT + (size_t)BG * 512 * 8192 * 2;
constexpr size_t OFF_ZT = OFF_BAR + 16384;
constexpr size_t OFF_TB = al256(OFF_ZT + (size_t)8192 * 33 * 4);
constexpr size_t OFF_SB = OFF_TB + (size_t)NITEM * 8192 * 4;
constexpr size_t WS_END = OFF_SB + (size_t)2 * NITEM * 8192 * 2;

struct Params {
    const float *x, *mem, *ln_in_g, *ln_in_b, *w_in, *b_in, *na_rpb, *hy_conv_w, *hy_conv_b, *hy_w1, *hy_b1, *hy_wm, *hy_bm, *hy_w3, *hy_skip,
        *gla_up_f, *gla_bias_f, *gla_up_b, *gla_bias_b, *gla_norm_g, *mem_w_kv, *w_br, *w_out, *b_out, *ln_g, *ln_b;
    float* out;
    unsigned char* ws;
};

HD inline float bf2f(bf16_t b) {
    union { unsigned u; float f; } c; c.u = (unsigned)b << 16; return c.f;
}
HD inline bf16_t f2bf(float f) {
    union { unsigned u; float f; } c; c.f = f; unsigned u = c.u; u += 0x7fffu + ((u >> 16) & 1u); return (bf16_t)(u >> 16);
}
typedef float f32x2_t __attribute__((ext_vector_type(2)));
typedef __bf16 bf16x2_t __attribute__((ext_vector_type(2)));
__device__ __forceinline__ unsigned pk2(float lo, float hi) { const f32x2_t v = {lo, hi}; const bf16x2_t b = __builtin_convertvector(v, bf16x2_t); return __builtin_bit_cast(unsigned, b); }
__device__ __forceinline__ bf16_t f2bf_d(float f) { return (bf16_t)(pk2(f, f) & 0xffffu); }
__device__ __forceinline__ float lo16(unsigned u) { return __uint_as_float(u << 16); }
__device__ __forceinline__ float hi16(unsigned u) { return __uint_as_float(u & 0xffff0000u); }
__device__ __forceinline__ float wave_sum(float v) {
#pragma unroll
    for (int o = 32; o >= 1; o >>= 1) v += __shfl_xor(v, o);
    return v;
}
__device__ __forceinline__ float sigmoidf_(float x) { return __builtin_amdgcn_rcpf(1.0f + __expf(-x)); }
__device__ __forceinline__ float siluf_(float x) { return x * __builtin_amdgcn_rcpf(1.0f + __expf(-x)); }
__device__ __forceinline__ float logsigf_(float x) { return fminf(x, 0.0f) - __logf(1.0f + __expf(-fabsf(x))); }
__device__ __forceinline__ bf16x8 mkfrag(u32x4 v) { return __builtin_bit_cast(bf16x8, v); }
__device__ __forceinline__ bf16x8 mkfrag2(u32x2 a, u32x2 b) { u32x4 v = {a.x, a.y, b.x, b.y}; return __builtin_bit_cast(bf16x8, v); }
#define MFMA(a, b, c) __builtin_amdgcn_mfma_f32_16x16x32_bf16((a), (b), (c), 0, 0, 0)
HD inline int iclamp(int v, int lo, int hi) { return v < lo ? lo : (v > hi ? hi : v); }

HD inline float2 cmulf(float2 a, float2 b) { float2 r; r.x = a.x * b.x - a.y * b.y; r.y = a.x * b.y + a.y * b.x; return r; }
HD inline float2 cmulcf(float2 a, float2 b) { float2 r; r.x = a.x * b.x + a.y * b.y; r.y = a.y * b.x - a.x * b.y; return r; }
struct Bfly { float2 x0, x1, x2, x3, W1; int i0; };
HD inline void bfly_load(Bfly& b, const float2* d, const float2* tw, int lgm, int q) {
    const int m = 1 << lgm, blk = q >> lgm, j = q & (m - 1);
    b.i0 = (blk << (lgm + 2)) + j;
    b.W1 = tw[j];
    b.x0 = d[b.i0]; b.x1 = d[b.i0 + m]; b.x2 = d[b.i0 + 2 * m]; b.x3 = d[b.i0 + 3 * m];
}
HD inline void bfly_fwd_store(const Bfly& b, float2* d, int lgm) {
    const int m = 1 << lgm, i0 = b.i0;
    const float2 W1 = b.W1, W2 = cmulf(W1, W1);
    const float2 x0 = b.x0, x1 = b.x1, x2 = b.x2, x3 = b.x3;
    float2 a0, a1, a2, a3, t;
    a0.x = x0.x + x2.x; a0.y = x0.y + x2.y;
    t.x = x0.x - x2.x; t.y = x0.y - x2.y; a2 = cmulf(t, W1);
    a1.x = x1.x + x3.x; a1.y = x1.y + x3.y;
    t.x = x1.x - x3.x; t.y = x1.y - x3.y; t = cmulf(t, W1); a3.x = t.y; a3.y = -t.x;
    float2 r;
    r.x = a0.x + a1.x; r.y = a0.y + a1.y; d[i0] = r;
    t.x = a0.x - a1.x; t.y = a0.y - a1.y; d[i0 + m] = cmulf(t, W2);
    r.x = a2.x + a3.x; r.y = a2.y + a3.y; d[i0 + 2 * m] = r;
    t.x = a2.x - a3.x; t.y = a2.y - a3.y; d[i0 + 3 * m] = cmulf(t, W2);
}
HD inline void bfly_inv_store(const Bfly& b, float2* d, int lgm) {
    const int m = 1 << lgm, i0 = b.i0;
    const float2 W1 = b.W1, W2 = cmulf(W1, W1);
    const float2 x0 = b.x0, x1 = b.x1, x2 = b.x2, x3 = b.x3;
    const float2 b1 = cmulcf(x1, W2), b3 = cmulcf(x3, W2);
    float2 y0, y1, y2, y3;
    y0.x = x0.x + b1.x; y0.y = x0.y + b1.y; y1.x = x0.x - b1.x; y1.y = x0.y - b1.y;
    y2.x = x2.x + b3.x; y2.y = x2.y + b3.y; y3.x = x2.x - b3.x; y3.y = x2.y - b3.y;
    const float2 c2 = cmulcf(y2, W1); float2 c3 = cmulcf(y3, W1); { const float tx = -c3.y, ty = c3.x; c3.x = tx; c3.y = ty; }
    float2 r;
    r.x = y0.x + c2.x; r.y = y0.y + c2.y; d[i0] = r;
    r.x = y0.x - c2.x; r.y = y0.y - c2.y; d[i0 + 2 * m] = r;
    r.x = y1.x + c3.x; r.y = y1.y + c3.y; d[i0 + m] = r;
    r.x = y1.x - c3.x; r.y = y1.y - c3.y; d[i0 + 3 * m] = r;
}
HD inline void fft_fwd_bfly(float2* d, const float2* tw, int lgm, int q) { Bfly b; bfly_load(b, d, tw, lgm, q); bfly_fwd_store(b, d, lgm); }
HD inline void fft_inv_bfly(float2* d, const float2* tw, int lgm, int q) { Bfly b; bfly_load(b, d, tw, lgm, q); bfly_inv_store(b, d, lgm); }
HD inline void r4_fwd(float2& x0, float2& x1, float2& x2, float2& x3, const float2 W1) {
    const float2 W2 = cmulf(W1, W1);
    float2 a0, a1, a2, a3, t;
    a0.x = x0.x + x2.x; a0.y = x0.y + x2.y;
    t.x = x0.x - x2.x; t.y = x0.y - x2.y; a2 = cmulf(t, W1);
    a1.x = x1.x + x3.x; a1.y = x1.y + x3.y;
    t.x = x1.x - x3.x; t.y = x1.y - x3.y; t = cmulf(t, W1); a3.x = t.y; a3.y = -t.x;
    x0.x = a0.x + a1.x; x0.y = a0.y + a1.y;
    t.x = a0.x - a1.x; t.y = a0.y - a1.y; x1 = cmulf(t, W2);
    x2.x = a2.x + a3.x; x2.y = a2.y + a3.y;
    t.x = a2.x - a3.x; t.y = a2.y - a3.y; x3 = cmulf(t, W2);
}
HD inline void r4_inv(float2& x0, float2& x1, float2& x2, float2& x3, const float2 W1) {
    const float2 W2 = cmulf(W1, W1);
    const float2 b1 = cmulcf(x1, W2), b3 = cmulcf(x3, W2);
    float2 y0, y1, y2, y3;
    y0.x = x0.x + b1.x; y0.y = x0.y + b1.y; y1.x = x0.x - b1.x; y1.y = x0.y - b1.y;
    y2.x = x2.x + b3.x; y2.y = x2.y + b3.y; y3.x = x2.x - b3.x; y3.y = x2.y - b3.y;
    const float2 c2 = cmulcf(y2, W1); float2 c3 = cmulcf(y3, W1); { const float tx = -c3.y, ty = c3.x; c3.x = tx; c3.y = ty; }
    x0.x = y0.x + c2.x; x0.y = y0.y + c2.y; x2.x = y0.x - c2.x; x2.y = y0.y - c2.y;
    x1.x = y1.x + c3.x; x1.y = y1.y + c3.y; x3.x = y1.x - c3.x; x3.y = y1.y - c3.y;
}
template <bool INV, bool HALF>
HD inline void r16_bfly(float2* d, const float2* twO, const float2* twI, int lgm, int q) {
    const int m = 1 << lgm, blk = q >> lgm, j = q & (m - 1), base = (blk << (lgm + 4)) + j;
    float2 e[4][4];
#pragma unroll
    for (int a = 0; a < 4; ++a)
#pragma unroll
        for (int b = 0; b < 4; ++b) {
            if (!INV && HALF && a >= 2) { e[a][b].x = 0.f; e[a][b].y = 0.f; }
            else e[a][b] = d[base + ((4 * a + b) << lgm)];
        }
    const float2 wI = twI[j];
    float2 wO[4];
#pragma unroll
    for (int b = 0; b < 4; ++b) wO[b] = twO[j + (b << lgm)];
    if (!INV) {
#pragma unroll
        for (int b = 0; b < 4; ++b) r4_fwd(e[0][b], e[1][b], e[2][b], e[3][b], wO[b]);
#pragma unroll
        for (int a = 0; a < 4; ++a) r4_fwd(e[a][0], e[a][1], e[a][2], e[a][3], wI);
    } else {
#pragma unroll
        for (int a = 0; a < 4; ++a) r4_inv(e[a][0], e[a][1], e[a][2], e[a][3], wI);
#pragma unroll
        for (int b = 0; b < 4; ++b) r4_inv(e[0][b], e[1][b], e[2][b], e[3][b], wO[b]);
    }
#pragma unroll
    for (int a = 0; a < 4; ++a)
#pragma unroll
        for (int b = 0; b < 4; ++b)
            if (!(INV && HALF && a >= 2)) d[base + ((4 * a + b) << lgm)] = e[a][b];
}
HD inline int brev14(int k) {
#if defined(__HIP_DEVICE_COMPILE__)
    return (int)(__brev((unsigned)k) >> 18);
#endif
    unsigned v = (unsigned)k;
    v = ((v >> 1) & 0x55555555u) | ((v & 0x55555555u) << 1);
    v = ((v >> 2) & 0x33333333u) | ((v & 0x33333333u) << 2);
    v = ((v >> 4) & 0x0f0f0f0fu) | ((v & 0x0f0f0f0fu) << 4);
    v = ((v >> 8) & 0x00ff00ffu) | ((v & 0x00ff00ffu) << 8);
    v = (v >> 16) | (v << 16);
    return (int)(v >> 18);
}
struct PwIn { float2 Z1, Z2; float4 A, B; int p1, p2; };
HD inline void pw_load(PwIn& w, const float2* d, const float4* pq, int p1) {
    const int kf = brev14(p1), k2 = (FN - kf) & (FN - 1); w.p1 = p1; w.p2 = brev14(k2);
    w.Z1 = d[w.p1]; w.Z2 = d[w.p2]; w.A = pq[w.p1]; w.B.x = w.A.x; w.B.y = -w.A.y; w.B.z = w.A.z; w.B.w = -w.A.w;
}
HD inline void pw_store(const PwIn& w, float2* d) {
    const float2 Z1 = w.Z1, Z2 = w.Z2;
    float2 P1, Q1, P2, Q2; P1.x = w.A.x; P1.y = w.A.y; Q1.x = w.A.z; Q1.y = w.A.w; P2.x = w.B.x; P2.y = w.B.y; Q2.x = w.B.z; Q2.y = w.B.w;
    float2 c1, c2; c1.x = Z1.x; c1.y = -Z1.y; c2.x = Z2.x; c2.y = -Z2.y;
    const float2 a = cmulf(Z1, P1), b = cmulf(c2, Q1), c = cmulf(Z2, P2), e = cmulf(c1, Q2);
    float2 w1, w2; w1.x = a.x + b.x; w1.y = a.y + b.y; w2.x = c.x + e.x; w2.y = c.y + e.y;
    d[w.p1] = w1;
    if (w.p2 != w.p1) d[w.p2] = w2;
}
HD inline void conv_pointwise(float2* d, const float4* pq, int p1) { PwIn w; pw_load(w, d, pq, p1); pw_store(w, d); }
HD inline void filt_pointwise(const float2* d, float4* pq, int p1) {
    const int kf = brev14(p1), k2 = (FN - kf) & (FN - 1), p2 = brev14(k2);
    const float2 Z1 = d[p1], Z2 = d[p2];
    const float gcx = 0.5f * (Z1.x + Z2.x), gcy = 0.5f * (Z1.y - Z2.y);
    const float gdx = 0.5f * (Z1.y + Z2.y), gdy = -0.5f * (Z1.x - Z2.x);
    const float s = 0.5f / (float)FN;
    float4 A; A.x = s * (gcx + gdx); A.y = s * (gcy + gdy); A.z = s * (gcx - gdx); A.w = s * (gcy - gdy);
    pq[p1] = A;
}
HD inline int tw_off(int lgm) { return lgm == 10 ? 0 : lgm == 8 ? 1024 : lgm == 6 ? 1280 : lgm == 4 ? 1344 : lgm == 2 ? 1360 : 1364; }
#ifndef FFT_HOST_TEST
template <int LGM, bool INV>
__device__ __forceinline__ void fft_pass(float2* d, const float2* twl, const float2* twg, int tid) {
    const float2* tw = (LGM == 12) ? twg : twl + tw_off(LGM);
#pragma unroll
    for (int it = 0; it < 2; ++it) {
        const int q = tid + it * 4 * NTHR;
        Bfly b0, b1, b2, b3;
        bfly_load(b0, d, tw, LGM, q); bfly_load(b1, d, tw, LGM, q + NTHR); bfly_load(b2, d, tw, LGM, q + 2 * NTHR); bfly_load(b3, d, tw, LGM, q + 3 * NTHR);
        if (INV) { bfly_inv_store(b0, d, LGM); bfly_inv_store(b1, d, LGM); bfly_inv_store(b2, d, LGM); bfly_inv_store(b3, d, LGM); }
        else { bfly_fwd_store(b0, d, LGM); bfly_fwd_store(b1, d, LGM); bfly_fwd_store(b2, d, LGM); bfly_fwd_store(b3, d, LGM); }
    }
    __syncthreads();
}
template <int LGM, bool INV, bool HALF>
__device__ __forceinline__ void fft_pass16(float2* d, const float2* twl, const float2* twg, int tid) {
    const float2* twO = (LGM + 2 == 12) ? twg : twl + tw_off(LGM + 2);
    const float2* twI = twl + tw_off(LGM);
    r16_bfly<INV, HALF>(d, twO, twI, LGM, tid);
    r16_bfly<INV, HALF>(d, twO, twI, LGM, tid + NTHR);
    __syncthreads();
}
template <bool HALF>
__device__ __forceinline__ void fft_forward(float2* d, const float2* twl, const float2* twg) {
    int tid = threadIdx.x; asm volatile("" : "+v"(tid));
    fft_pass16<10, false, HALF>(d, twl, twg, tid); fft_pass16<6, false, false>(d, twl, twg, tid);
    fft_pass<4, false>(d, twl, twg, tid); fft_pass<2, false>(d, twl, twg, tid); fft_pass<0, false>(d, twl, twg, tid);
}
template <bool HALF>
__device__ __forceinline__ void fft_inverse(float2* d, const float2* twl, const float2* twg) {
    int tid = threadIdx.x; asm volatile("" : "+v"(tid));
    fft_pass<0, true>(d, twl, twg, tid); fft_pass<2, true>(d, twl, twg, tid); fft_pass<4, true>(d, twl, twg, tid);
    fft_pass16<6, true, false>(d, twl, twg, tid); fft_pass16<10, true, HALF>(d, twl, twg, tid);
}
__device__ __forceinline__ float2* fft_lds_twiddles(const float2* twg, unsigned char* lds) {
    int tid = threadIdx.x; asm volatile("" : "+v"(tid));
    float2* t = (float2*)(lds + 131072);
    for (int k = tid; k < 1365; k += NTHR) {
        const int lgm = k < 1024 ? 10 : k < 1280 ? 8 : k < 1344 ? 6 : k < 1360 ? 4 : k < 1364 ? 2 : 0;
        t[k] = twg[(k - tw_off(lgm)) << (12 - lgm)];
    }
    __syncthreads();
    return t;
}

constexpr int STG = 49152;
__device__ __forceinline__ int swz(int row, int ch) { return row * 128 + ((ch ^ ((row >> 1) & 7)) << 4); }
__device__ __forceinline__ void gemm_core(f32x4 (&acc)[4][4], const bf16_t* A, int lda, const bf16_t* Bt, int ldb, int K, unsigned char* lds) {
    int tid_ = threadIdx.x; asm volatile("" : "+v"(tid_)); const int tid = tid_, lane = tid & 63, w = tid >> 6, wm = w & 3, wn = w >> 2, l15 = lane & 15, q4 = lane >> 4;
    const int wu = __builtin_amdgcn_readfirstlane(w);
    __attribute__((address_space(3))) unsigned char* l3 = (__attribute__((address_space(3))) unsigned char*)lds;
#pragma unroll
    for (int mi = 0; mi < 4; ++mi)
#pragma unroll
        for (int ni = 0; ni < 4; ++ni) acc[mi][ni] = (f32x4){0.f, 0.f, 0.f, 0.f};
    const int r8 = lane >> 3, sch = (lane & 7) ^ ((((w & 1) << 2) + (r8 >> 1)) & 7);
    const bf16_t* ap = A + (size_t)(w * 8 + r8) * lda + sch * 8;
    const bf16_t* bp = Bt + (size_t)(w * 8 + r8) * ldb + sch * 8;
#define GC_STAGE(buf, k0)                                                                                                                         \
    {                                                                                                                                             \
        _Pragma("unroll") for (int i = 0; i < 4; ++i)                                                                                             \
            __builtin_amdgcn_global_load_lds((const unsigned*)(ap + (size_t)(64 * i) * lda + (k0)), (__attribute__((address_space(3))) unsigned*)(l3 + (buf) * STG + (wu + 8 * i) * 1024), 16, 0, 0);          \
        _Pragma("unroll") for (int i = 0; i < 2; ++i)                                                                                             \
            __builtin_amdgcn_global_load_lds((const unsigned*)(bp + (size_t)(64 * i) * ldb + (k0)), (__attribute__((address_space(3))) unsigned*)(l3 + (buf) * STG + 32768 + (wu + 8 * i) * 1024), 16, 0, 0);  \
    }
    GC_STAGE(0, 0)
    asm volatile("s_waitcnt vmcnt(0)" ::: "memory");
    __syncthreads();
    const int nk = K >> 6;
    for (int kt = 0; kt < nk; ++kt) {
        if (kt + 1 < nk) GC_STAGE((kt + 1) & 1, (kt + 1) << 6)
        const unsigned char* sa = lds + (kt & 1) * STG;
        const unsigned char* sb = sa + 32768;
#pragma unroll
        for (int ks = 0; ks < 2; ++ks) {
            bf16x8 af[4], bfr[4];
#pragma unroll
            for (int mi = 0; mi < 4; ++mi) af[mi] = *(const bf16x8*)(sa + swz(wm * 64 + mi * 16 + l15, ks * 4 + q4));
#pragma unroll
            for (int ni = 0; ni < 4; ++ni) bfr[ni] = *(const bf16x8*)(sb + swz(wn * 64 + ni * 16 + l15, ks * 4 + q4));
#pragma unroll
            for (int mi = 0; mi < 4; ++mi)
#pragma unroll
                for (int ni = 0; ni < 4; ++ni) acc[mi][ni] = MFMA(bfr[ni], af[mi], acc[mi][ni]);
        }
        asm volatile("s_waitcnt vmcnt(0)" ::: "memory");
        __syncthreads();
    }
#undef GC_STAGE
}
#define EPI_LOOP(body)                                                                                                  \
    {                                                                                                                   \
        int e_t = threadIdx.x; asm volatile("" : "+v"(e_t)); const int e_lane = e_t & 63, e_w = e_t >> 6;                                                    \
        _Pragma("unroll") for (int mi = 0; mi < 4; ++mi) _Pragma("unroll") for (int ni = 0; ni < 4; ++ni) {             \
            const int row = m0 + (e_w & 3) * 64 + mi * 16 + (e_lane & 15);                                              \
            const int col = n0 + (e_w >> 2) * 64 + ni * 16 + 4 * (e_lane >> 4);                                         \
            f32x4& v = acc[mi][ni];                                                                                     \
            body                                                                                                        \
        }                                                                                                               \
    }
__device__ __forceinline__ void st_bf4(bf16_t* dst, f32x4 v) {
    u32x2 o; o.x = pk2(v[0], v[1]); o.y = pk2(v[2], v[3]); *(u32x2*)dst = o;
}
__device__ __forceinline__ f32x4 ld_bf4(const bf16_t* src) {
    const u32x2 u = *(const u32x2*)src; f32x4 r = {lo16(u.x), hi16(u.x), lo16(u.y), hi16(u.y)}; return r;
}


__device__ __forceinline__ void merge_tile(const bf16_t* P, const bf16_t* WtBr, bf16_t* merged, int m0, int n0, unsigned char* lds) {
    int tid_ = threadIdx.x; asm volatile("" : "+v"(tid_)); const int tid = tid_, lane = tid & 63, w = tid >> 6, wm = w & 3, wn = w >> 2, l15 = lane & 15, q4 = lane >> 4;
    const int wu = __builtin_amdgcn_readfirstlane(w);
    __attribute__((address_space(3))) unsigned char* l3 = (__attribute__((address_space(3))) unsigned char*)lds;
    f32x4 acc[4][4], macc[4][4];
#pragma unroll
    for (int mi = 0; mi < 4; ++mi)
#pragma unroll
        for (int ni = 0; ni < 4; ++ni) { acc[mi][ni] = (f32x4){0.f, 0.f, 0.f, 0.f}; macc[mi][ni] = (f32x4){0.f, 0.f, 0.f, 0.f}; }
    const int r8 = lane >> 3, sch = (lane & 7) ^ ((((w & 1) << 2) + (r8 >> 1)) & 7);
    const bf16_t* ap = P + (size_t)(m0 + w * 8 + r8) * PS + sch * 8;
    const bf16_t* bp = WtBr + (size_t)(n0 + w * 8 + r8) * 512 + sch * 8;
    const bf16_t* sgp = P + (size_t)(m0 + wm * 64 + l15) * PS + C_SG + n0 + wn * 64 + 4 * q4;
#define MG_STAGE(buf, kt_)                                                                                                                        \
    {                                                                                                                                             \
        const int j_ = (kt_) >> 3, k0_ = ((kt_) & 7) << 6;                                                                                        \
        const int acol_ = (j_ == 0) ? C_NAQ : (j_ == 1) ? C_HY : (j_ == 2) ? C_GV : C_MQ;                                                        \
        _Pragma("unroll") for (int i = 0; i < 4; ++i)                                                                                             \
            __builtin_amdgcn_global_load_lds((const unsigned*)(ap + (size_t)(64 * i) * PS + acol_ + k0_), (__attribute__((address_space(3))) unsigned*)(l3 + (buf) * STG + (wu + 8 * i) * 1024), 16, 0, 0);      \
        _Pragma("unroll") for (int i = 0; i < 2; ++i)                                                                                             \
            __builtin_amdgcn_global_load_lds((const unsigned*)(bp + (size_t)j_ * 1024 * 512 + (size_t)(64 * i) * 512 + k0_), (__attribute__((address_space(3))) unsigned*)(l3 + (buf) * STG + 32768 + (wu + 8 * i) * 1024), 16, 0, 0);  \
    }
    MG_STAGE(0, 0)
    MG_STAGE(1, 1)
    asm volatile("s_waitcnt vmcnt(6)" ::: "memory");
    __builtin_amdgcn_s_barrier(); asm volatile("" ::: "memory");
    int cb = 0;
#pragma unroll 1
    for (int kt = 0; kt < 32; ++kt) {
        const bool last = (kt & 7) == 7;
        u32x2 sg[4][4];
        if (last) {
            const bf16_t* sp = sgp + 1024 * (kt >> 3);
#pragma unroll
            for (int mi = 0; mi < 4; ++mi)
#pragma unroll
                for (int ni = 0; ni < 4; ++ni) sg[mi][ni] = *(const u32x2*)(sp + (size_t)(mi * 16) * PS + ni * 16);
        }
        const int nb = (cb == 0) ? 2 : cb - 1;
        if (kt + 2 < 32) MG_STAGE(nb, kt + 2)
        const unsigned char* sa = lds + cb * STG;
        const unsigned char* sb = sa + 32768;
#pragma unroll
        for (int ks = 0; ks < 2; ++ks) {
            bf16x8 af[4], bfr[4];
#pragma unroll
            for (int mi = 0; mi < 4; ++mi) af[mi] = *(const bf16x8*)(sa + swz(wm * 64 + mi * 16 + l15, ks * 4 + q4));
#pragma unroll
            for (int ni = 0; ni < 4; ++ni) bfr[ni] = *(const bf16x8*)(sb + swz(wn * 64 + ni * 16 + l15, ks * 4 + q4));
            __builtin_amdgcn_s_setprio(1);
#pragma unroll
            for (int mi = 0; mi < 4; ++mi)
#pragma unroll
                for (int ni = 0; ni < 4; ++ni) acc[mi][ni] = MFMA(bfr[ni], af[mi], acc[mi][ni]);
            __builtin_amdgcn_s_setprio(0);
        }
        if (kt + 2 < 32) asm volatile("s_waitcnt vmcnt(6)" ::: "memory"); else asm volatile("s_waitcnt vmcnt(0)" ::: "memory");
        if (last) {
#pragma unroll
            for (int mi = 0; mi < 4; ++mi)
#pragma unroll
                for (int ni = 0; ni < 4; ++ni) {
                    const u32x2 u = sg[mi][ni]; const f32x4 g4 = {lo16(u.x), hi16(u.x), lo16(u.y), hi16(u.y)};
                    macc[mi][ni] += g4 * acc[mi][ni]; acc[mi][ni] = (f32x4){0.f, 0.f, 0.f, 0.f};
                }
        }
        asm volatile("" ::: "memory"); __builtin_amdgcn_s_barrier(); asm volatile("" ::: "memory");
        cb = (cb == 2) ? 0 : cb + 1;
    }
#undef MG_STAGE
    __syncthreads();
#pragma unroll
    for (int mi = 0; mi < 4; ++mi)
#pragma unroll
        for (int ni = 0; ni < 4; ++ni) st_bf4(merged + (size_t)(m0 + wm * 64 + mi * 16 + l15) * 1024 + n0 + wn * 64 + ni * 16 + 4 * q4, macc[mi][ni]);
}

__device__ __forceinline__ int orig_col(int n) {
    if (n < 4096) return n;
    if (n < 4608) return n + 32;
    if (n < 6656) return n + 32;
    if (n < 10752) return n + 32;
    return n - 10752 + 4096;
}

__device__ __forceinline__ void ln_rows(const float* src, size_t src_row0, int nrows, const float* g, const float* b, float* dst32, bf16_t* dst16, size_t dst_row0, float2* stats) {
    int tid_ = threadIdx.x; asm volatile("" : "+v"(tid_));
    const int lane = tid_ & 63;
    const int gw = blockIdx.x * (NTHR / 64) + (tid_ >> 6), nw = gridDim.x * (NTHR / 64);
    for (int r = gw; r < nrows; r += nw) {
        const float4* xr = (const float4*)(src + (src_row0 + r) * 1024);
        float4 v[4]; float s = 0.f;
#pragma unroll
        for (int i = 0; i < 4; ++i) { v[i] = xr[lane + 64 * i]; s += (v[i].x + v[i].y) + (v[i].z + v[i].w); }
        s = wave_sum(s);
        const float mean = s * (1.0f / 1024.0f);
        float q = 0.f;
#pragma unroll
        for (int i = 0; i < 4; ++i) { const float a = v[i].x - mean, bb = v[i].y - mean, c = v[i].z - mean, d = v[i].w - mean; q += (a * a + bb * bb) + (c * c + d * d); }
        q = wave_sum(q);
        const float rstd = 1.0f / sqrtf(q * (1.0f / 1024.0f) + 1e-5f);
        if (stats && lane == 0) { float2 st; st.x = mean; st.y = rstd; stats[dst_row0 + r] = st; }
#pragma unroll
        for (int i = 0; i < 4; ++i) {
            const float4 g4 = ((const float4*)g)[lane + 64 * i], b4 = ((const float4*)b)[lane + 64 * i];
            float4 y; y.x = (v[i].x - mean) * rstd * g4.x + b4.x; y.y = (v[i].y - mean) * rstd * g4.y + b4.y; y.z = (v[i].z - mean) * rstd * g4.z + b4.z; y.w = (v[i].w - mean) * rstd * g4.w + b4.w;
            if (dst32) ((float4*)(dst32 + (dst_row0 + r) * 1024))[lane + 64 * i] = y;
            if (dst16) { u32x2 o; o.x = pk2(y.x, y.y); o.y = pk2(y.z, y.w); *(u32x2*)(dst16 + (dst_row0 + r) * 1024 + (lane + 64 * i) * 4) = o; }
        }
    }
}
__device__ __forceinline__ void phase0(const Params& p) {
    ln_rows(p.x, 0, NTOK, p.ln_in_g, p.ln_in_b, nullptr, (bf16_t*)(p.ws + OFF_HB), 0, (float2*)(p.ws + OFF_STATS));
    int tid_ = threadIdx.x; asm volatile("" : "+v"(tid_)); const int gt = blockIdx.x * NTHR + tid_, nt = gridDim.x * NTHR;
    float2* tw = (float2*)(p.ws + OFF_TW);
    for (int k = gt; k < FN; k += nt) { double s, c; sincospi(-2.0 * (double)k / (double)FN, &s, &c); float2 t; t.x = (float)c; t.y = (float)s; tw[k] = t; }
    bf16_t* mb = (bf16_t*)(p.ws + OFF_MEMBF);
    for (int i = gt; i < 2048 * 1024 / 4; i += nt) { const float4 v = ((const float4*)p.mem)[i]; u32x2 o; o.x = pk2(v.x, v.y); o.y = pk2(v.z, v.w); ((u32x2*)mb)[i] = o; }
    float* en = (float*)(p.ws + OFF_ENERGY);
    for (int i = gt; i < 1024; i += nt) en[i] = 0.f;
    float* ztab = (float*)(p.ws + OFF_ZT);
    for (int idx = gt; idx < 8192 * 33; idx += nt) {
        const int n = idx / 33, e = idx - n * 33;
        float v;
        if (e == 0) v = (float)n / 8191.0f;
        else {
            const int i = (e - 1) & 15;
            const double fr = 1e-4 + (double)i * ((15.0 - 1e-4) / 15.0);
            const double ang = (2.0 * 3.14159265358979323846 / 8192.0) * (double)n * fr;
            v = (e <= 16) ? (float)cos(ang) : (float)(-sin(ang));
        }
        ztab[idx] = v;
    }
}

__device__ __forceinline__ void wt_tile(const float* src, int src_ld, int k0, int on0, bf16_t* dst, int dst_ld, int dn0, bool zero, float* tile) {
    int tid_ = threadIdx.x; asm volatile("" : "+v"(tid_)); const int tid = tid_;
    if (!zero) {
#pragma unroll
        for (int i = 0; i < 2; ++i) {
            const int k = (tid >> 3) + 64 * i, c4 = (tid & 7) * 4;
            const float4 v = *(const float4*)(src + (size_t)(k0 + k) * src_ld + on0 + c4);
            float* t = tile + k * 33 + c4; t[0] = v.x; t[1] = v.y; t[2] = v.z; t[3] = v.w;
        }
    }
    __syncthreads();
    const int n = tid >> 4, kc = (tid & 15) * 8;
    float f[8];
#pragma unroll
    for (int e = 0; e < 8; ++e) f[e] = zero ? 0.f : tile[(kc + e) * 33 + n];
    u32x4 o; o.x = pk2(f[0], f[1]); o.y = pk2(f[2], f[3]); o.z = pk2(f[4], f[5]); o.w = pk2(f[6], f[7]);
    *(u32x4*)(dst + (size_t)(dn0 + n) * dst_ld + k0 + kc) = o;
    __syncthreads();
}
__device__ __forceinline__ void phase_weights(const Params& p, int l, unsigned char* lds) {
    float* tile = (float*)lds;
    for (int it = blockIdx.x; it < 3776; it += gridDim.x) {
        if (it < 2752) {
            const int nt = it >> 3, kt = it & 7, dn0 = nt * 32;
            wt_tile(p.w_in + (size_t)l * 1024 * NIN, NIN, kt * 128, orig_col(dn0), (bf16_t*)(p.ws + OFF_WTIN), 1024, dn0, dn0 >= NIN, tile);
        } else if (it < 3264) {
            const int r = it - 2752, j = r >> 7, nt = (r >> 2) & 31, kt = r & 3;
            wt_tile(p.w_br + (size_t)(l * 4 + j) * 512 * 1024, 1024, kt * 128, nt * 32, (bf16_t*)(p.ws + OFF_WTBR) + (size_t)j * 1024 * 512, 512, nt * 32, false, tile);
        } else if (it < 3520) {
            const int r = it - 3264, nt = r >> 3, kt = r & 7;
            wt_tile(p.w_out + (size_t)l * 1024 * 1024, 1024, kt * 128, nt * 32, (bf16_t*)(p.ws + OFF_WTOUT), 1024, nt * 32, false, tile);
        } else {
            const int r = it - 3520, nt = r >> 3, kt = r & 7;
            wt_tile(p.mem_w_kv + (size_t)l * 1024 * 1024, 1024, kt * 128, nt * 32, (bf16_t*)(p.ws + OFF_WTKV), 1024, nt * 32, false, tile);
        }
    }
}

__device__ __forceinline__ void phase_filter_gen(const Params& p, int l, unsigned char* lds) {
    float* zt = (float*)lds;
    float* ha = zt + 32 * 33;
    float* hbuf = ha + 32 * 64;
    int tid_ = threadIdx.x; asm volatile("" : "+v"(tid_)); const int tid = tid_;
    const float* w1 = p.hy_w1 + (size_t)l * 33 * 64; const float* b1 = p.hy_b1 + l * 64;
    const float* wm = p.hy_wm + (size_t)l * 2 * 64 * 64; const float* bm = p.hy_bm + l * 2 * 64;
    const float* w3 = p.hy_w3 + (size_t)l * 64 * 1024;
    float* hf = (float*)(p.ws + OFF_HFILT);
    float* en = (float*)(p.ws + OFF_ENERGY) + l * 512;
    const float* ztab = (const float*)(p.ws + OFF_ZT);
    for (int it = blockIdx.x; it < 256; it += gridDim.x) {
        const int n0 = it * 32;
        for (int idx = tid; idx < 32 * 33; idx += NTHR) zt[idx] = ztab[(size_t)n0 * 33 + idx];
        __syncthreads();
        for (int idx = tid; idx < 2048; idx += NTHR) {
            const int pos = idx >> 6, j = idx & 63; float s = b1[j];
            for (int e = 0; e < 33; ++e) s += zt[pos * 33 + e] * w1[e * 64 + j];
            ha[idx] = sinf(s);
        }
        __syncthreads();
        for (int idx = tid; idx < 2048; idx += NTHR) {
            const int pos = idx >> 6, j = idx & 63; float s = bm[j];
            for (int e = 0; e < 64; ++e) s += ha[pos * 64 + e] * wm[e * 64 + j];
            hbuf[idx] = sinf(s);
        }
        __syncthreads();
        for (int idx = tid; idx < 2048; idx += NTHR) {
            const int pos = idx >> 6, j = idx & 63; float s = bm[64 + j];
            for (int e = 0; e < 64; ++e) s += hbuf[pos * 64 + e] * wm[4096 + e * 64 + j];
            ha[idx] = sinf(s);
        }
        __syncthreads();
        {
            const int c = tid;
            float af[32], ab[32];
#pragma unroll
            for (int i = 0; i < 32; ++i) { af[i] = 0.f; ab[i] = 0.f; }
            for (int k = 0; k < 64; ++k) {
                const float wf = w3[k * 1024 + c], wb = w3[k * 1024 + 512 + c];
#pragma unroll
                for (int i = 0; i < 32; ++i) { const float h = ha[i * 64 + k]; af[i] += h * wf; ab[i] += h * wb; }
            }
            const float dmin = -3.0701134573253945f, dmax = -15.350567286626973f;
            const float delta = fabsf(dmin + (float)c * ((dmax - dmin) / 511.0f));
            float e = 0.f;
#pragma unroll
            for (int i = 0; i < 32; ++i) {
                const int n = n0 + i; const float t01 = (float)n / 8191.0f; const float win = expf(-t01 * delta);
                af[i] *= win; ab[i] *= win; e += af[i] * af[i]; if (n >= 1) e += ab[i] * ab[i];
            }
#pragma unroll
            for (int i = 0; i < 8; ++i) {
                float4 a; a.x = af[4 * i]; a.y = af[4 * i + 1]; a.z = af[4 * i + 2]; a.w = af[4 * i + 3];
                float4 b; b.x = ab[4 * i]; b.y = ab[4 * i + 1]; b.z = ab[4 * i + 2]; b.w = ab[4 * i + 3];
                *(float4*)(hf + (size_t)c * 8192 + n0 + 4 * i) = a;
                *(float4*)(hf + (size_t)(512 + c) * 8192 + n0 + 4 * i) = b;
            }
            atomicAdd(en + c, e);
        }
        __syncthreads();
    }
}

__device__ __forceinline__ void phase_filter_fft(const Params& p, int l, unsigned char* lds) {
    float2* d = (float2*)lds;
    const float2* tw = fft_lds_twiddles((const float2*)(p.ws + OFF_TW), lds);
    const float* hf = (const float*)(p.ws + OFF_HFILT);
    const float* en = (const float*)(p.ws + OFF_ENERGY) + l * 512;
    float4* pqa = (float4*)(p.ws + OFF_PQ);
    int tid_ = threadIdx.x; asm volatile("" : "+v"(tid_)); const int tid = tid_;
    for (int pr = blockIdx.x; pr < 256; pr += gridDim.x) {
        const int c0 = 2 * pr, c1 = c0 + 1;
        const float s0 = 1.0f / sqrtf(en[c0] + 1e-6f), s1 = 1.0f / sqrtf(en[c1] + 1e-6f);
        const float k0 = p.hy_skip[l * 512 + c0], k1 = p.hy_skip[l * 512 + c1];
        for (int n = tid; n < FN; n += NTHR) {
            float2 v;
            if (n < 8192) { v.x = hf[(size_t)c0 * 8192 + n] * s0; v.y = hf[(size_t)c1 * 8192 + n] * s1; if (n == 0) { v.x += k0; v.y += k1; } }
            else if (n == 8192) { v.x = 0.f; v.y = 0.f; }
            else { v.x = hf[(size_t)(512 + c0) * 8192 + (FN - n)] * s0; v.y = hf[(size_t)(512 + c1) * 8192 + (FN - n)] * s1; }
            d[n] = v;
        }
        __syncthreads();
        fft_forward<false>(d, tw, (const float2*)(p.ws + OFF_TW));
        for (int h = tid; h < FN / 2; h += NTHR) filt_pointwise(d, pqa + (size_t)pr * FN, 2 * h);
        if (tid == 0) filt_pointwise(d, pqa + (size_t)pr * FN, 1);
        __syncthreads();
    }
}

__device__ __forceinline__ void hy_pre_item(const Params& p, int l, const bf16_t* P, bf16_t* UT, bf16_t* GT, int bl, int tt, int ct, unsigned char* lds) {
    float* tU = (float*)lds;
    float* tG = tU + 64 * 65;
    int tid_ = threadIdx.x; asm volatile("" : "+v"(tid_)); const int tid = tid_;
    const int t = tid >> 3, cc = (tid & 7) * 8, c = ct * 64 + cc, tb = tt * 64 + t;
    const float* cw = p.hy_conv_w + (size_t)l * 3 * 1536; const float* cb = p.hy_conv_b + l * 1536;
    float av[8], a0[8], a1[8];
#pragma unroll
    for (int h = 0; h < 2; ++h) {
        const f32x4 bv = *(const f32x4*)(cb + c + 4 * h), b0 = *(const f32x4*)(cb + 512 + c + 4 * h), b1 = *(const f32x4*)(cb + 1024 + c + 4 * h);
#pragma unroll
        for (int e = 0; e < 4; ++e) { av[4 * h + e] = bv[e]; a0[4 * h + e] = b0[e]; a1[4 * h + e] = b1[e]; }
    }
#pragma unroll
    for (int j = 0; j < 3; ++j) {
        const int ts = tb + j - 1;
        if (ts >= 0 && ts < SEQ) {
            const bf16_t* row = P + (size_t)(bl * SEQ + ts) * PS + C_HY + c;
            const u32x4 rv = *(const u32x4*)row, r0 = *(const u32x4*)(row + 512), r1 = *(const u32x4*)(row + 1024);
#pragma unroll
            for (int h = 0; h < 2; ++h) {
                const f32x4 wv = *(const f32x4*)(cw + j * 1536 + c + 4 * h), w0 = *(const f32x4*)(cw + j * 1536 + 512 + c + 4 * h), w1 = *(const f32x4*)(cw + j * 1536 + 1024 + c + 4 * h);
#pragma unroll
                for (int e = 0; e < 4; ++e) {
                    const int k = 4 * h + e; const unsigned uv = rv[k >> 1], u0 = r0[k >> 1], u1 = r1[k >> 1];
                    av[k] += wv[e] * ((k & 1) ? hi16(uv) : lo16(uv)); a0[k] += w0[e] * ((k & 1) ? hi16(u0) : lo16(u0)); a1[k] += w1[e] * ((k & 1) ? hi16(u1) : lo16(u1));
                }
            }
        }
    }
    const u32x4 rz = *(const u32x4*)(P + (size_t)(bl * SEQ + tb) * PS + C_Z + 512 + c);
#pragma unroll
    for (int k = 0; k < 8; ++k) {
        const unsigned uz = rz[k >> 1]; const float z = (k & 1) ? hi16(uz) : lo16(uz);
        tU[(cc + k) * 65 + t] = av[k] * a1[k]; tG[(cc + k) * 65 + t] = a0[k] * z;
    }
    __syncthreads();
    const int c2 = tid >> 3, t8 = (tid & 7) * 8;
    const size_t o = (size_t)(bl * 512 + ct * 64 + c2) * SEQ + tt * 64 + t8;
    const float* su = tU + c2 * 65 + t8; const float* sg = tG + c2 * 65 + t8;
    f32x4 ua = {su[0], su[1], su[2], su[3]}, ub = {su[4], su[5], su[6], su[7]};
    { u32x4 uo; uo.x = pk2(ua[0], ua[1]); uo.y = pk2(ua[2], ua[3]); uo.z = pk2(ub[0], ub[1]); uo.w = pk2(ub[2], ub[3]); *(u32x4*)(UT + o) = uo; }
    u32x4 g; g.x = pk2(sg[0], sg[1]); g.y = pk2(sg[2], sg[3]); g.z = pk2(sg[4], sg[5]); g.w = pk2(sg[6], sg[7]);
    *(u32x4*)(GT + o) = g;
    __syncthreads();
}
__device__ __forceinline__ void hy_post_item(bf16_t* P, const bf16_t* GT, int bl, int tt, int ct, unsigned char* lds, int dry = 0) {
    bf16_t* tl = (bf16_t*)lds;
    int tid_ = threadIdx.x; asm volatile("" : "+v"(tid_)); const int tid = tid_;
    const int c2 = tid >> 3, t8 = (tid & 7) * 8;
    const u32x4 v = *(const u32x4*)(GT + (size_t)(bl * 512 + ct * 64 + c2) * SEQ + tt * 64 + t8);
    bf16_t* d0 = tl + t8 * 72 + c2;
    d0[0 * 72] = (bf16_t)(v.x & 0xffffu); d0[1 * 72] = (bf16_t)(v.x >> 16); d0[2 * 72] = (bf16_t)(v.y & 0xffffu); d0[3 * 72] = (bf16_t)(v.y >> 16);
    d0[4 * 72] = (bf16_t)(v.z & 0xffffu); d0[5 * 72] = (bf16_t)(v.z >> 16); d0[6 * 72] = (bf16_t)(v.w & 0xffffu); d0[7 * 72] = (bf16_t)(v.w >> 16);
    __syncthreads();
    const int t = tid >> 3, cc = (tid & 7) * 8;
    const u32x4 ov = *(const u32x4*)(tl + t * 72 + cc);
    if (!dry) *(u32x4*)(P + (size_t)(bl * SEQ + tt * 64 + t) * PS + C_HY + ct * 64 + cc) = ov;
    __syncthreads();
}
__device__ __forceinline__ void hyena_conv_item(const Params& p, const bf16_t* UT, bf16_t* GT, int bl, int pr, unsigned char* lds, const float2* tw, int dry = 0) {
    float2* d = (float2*)lds;
    const float4* pq = (const float4*)(p.ws + OFF_PQ) + (size_t)pr * FN;
    int tid_ = threadIdx.x; asm volatile("" : "+v"(tid_)); const int tid = tid_;
    const bf16_t* u0 = UT + (size_t)(bl * 512 + 2 * pr) * SEQ; const bf16_t* u1 = u0 + SEQ;
    bf16_t* g0 = GT + (size_t)(bl * 512 + 2 * pr) * SEQ; bf16_t* g1 = g0 + SEQ;
    {
        float f0[16], f1[16];
#pragma unroll
        for (int i = 0; i < 16; ++i) { f0[i] = bf2f(u0[tid + NTHR * i]); f1[i] = bf2f(u1[tid + NTHR * i]); }
#pragma unroll
        for (int i = 0; i < 16; ++i) {
            float2 u; u.x = f0[i]; u.y = f1[i]; d[tid + NTHR * i] = u;
        }
    }
    __syncthreads();
    fft_forward<true>(d, tw, (const float2*)(p.ws + OFF_TW));
#pragma unroll 1
    for (int h = tid; h < FN / 2; h += 4 * NTHR) {
        PwIn w0, w1, w2, w3;
        pw_load(w0, d, pq, 2 * h); pw_load(w1, d, pq, 2 * (h + NTHR)); pw_load(w2, d, pq, 2 * (h + 2 * NTHR)); pw_load(w3, d, pq, 2 * (h + 3 * NTHR));
        pw_store(w0, d); pw_store(w1, d); pw_store(w2, d); pw_store(w3, d);
    }
    if (tid == 0) conv_pointwise(d, pq, 1);
    __syncthreads();
    fft_inverse<true>(d, tw, (const float2*)(p.ws + OFF_TW));
    {
        bf16_t a0[16], a1[16];
#pragma unroll
        for (int i = 0; i < 16; ++i) { a0[i] = g0[tid + NTHR * i]; a1[i] = g1[tid + NTHR * i]; }
#pragma unroll
        for (int i = 0; i < 16; ++i) {
            const int t = tid + NTHR * i;
            const float2 y = d[t];
            const bf16_t r0 = f2bf_d(y.x * bf2f(a0[i])), r1 = f2bf_d(y.y * bf2f(a1[i]));
            if (!dry) { g0[t] = r0; g1[t] = r1; }
        }
    }
    __syncthreads();
}

__device__ __forceinline__ void na_item(const Params& p, int l, bf16_t* P, int bl, int rp, int head, unsigned char* lds, int dry = 0) {
    bf16_t* Kimg = (bf16_t*)lds;
    bf16_t* VT = (bf16_t*)(lds + 82944);
    int tid_ = threadIdx.x; asm volatile("" : "+v"(tid_)); const int tid = tid_, lane = tid & 63, w = tid >> 6, l15 = lane & 15, q4 = lane >> 4;
    const int r0 = 2 * rp, rs0 = iclamp(r0 - 4, 0, 120);
#pragma unroll
    for (int i = 0; i < 9; ++i) {
        const int idx = tid + NTHR * i, key = idx >> 3, ch = idx & 7, grow = min(rs0 + (key >> 6), 127);
        const u32x4 kv = *(const u32x4*)(P + (size_t)(bl * SEQ + grow * 64 + (key & 63)) * PS + C_NAK + head * 64 + ch * 8);
        *(u32x4*)(Kimg + key * 72 + ch * 8) = kv;
    }
#pragma unroll
    for (int i = 0; i < 9; ++i) {
        const int idx = tid + NTHR * i, keyp = idx >> 2, chh = keyp >= 576 ? 1 : 0, key = keyp - chh * 576, ch = chh * 4 + (idx & 3), grow = min(rs0 + (key >> 6), 127);
        const u32x4 vv = *(const u32x4*)(P + (size_t)(bl * SEQ + grow * 64 + (key & 63)) * PS + C_NAV + head * 64 + ch * 8);
        bf16_t* vd = VT + (ch * 8) * 584 + key;
        vd[0 * 584] = (bf16_t)(vv.x & 0xffffu); vd[1 * 584] = (bf16_t)(vv.x >> 16);
        vd[2 * 584] = (bf16_t)(vv.y & 0xffffu); vd[3 * 584] = (bf16_t)(vv.y >> 16);
        vd[4 * 584] = (bf16_t)(vv.z & 0xffffu); vd[5 * 584] = (bf16_t)(vv.z >> 16);
        vd[6 * 584] = (bf16_t)(vv.w & 0xffffu); vd[7 * 584] = (bf16_t)(vv.w >> 16);
    }
    __syncthreads();
    const int rr = w >> 2, g = w & 3, r = r0 + rr, rs = iclamp(r - 4, 0, 120), lo = rs - rs0;
    const int cb = iclamp(16 * g - 8, 0, 32), c = 16 * g + l15, cs = iclamp(c - 8, 0, 48);
    bf16_t* qrow = P + (size_t)(bl * SEQ + r * 64 + c) * PS + head * 64;
    bf16x8 qf[2];
#pragma unroll
    for (int ks = 0; ks < 2; ++ks) qf[ks] = *(const bf16x8*)(qrow + ks * 32 + q4 * 8);
    f32x4 sc[16];
#pragma unroll
    for (int t = 0; t < 16; ++t) {
        const int kb = (lo + (t >> 1)) * 64 + cb + 16 * (t & 1);
        f32x4 a = {0.f, 0.f, 0.f, 0.f};
#pragma unroll
        for (int ks = 0; ks < 2; ++ks) { const bf16x8 kf = *(const bf16x8*)(Kimg + (kb + l15) * 72 + ks * 32 + q4 * 8); a = MFMA(kf, qf[ks], a); }
        sc[t] = a;
    }
    const float* rpb = p.na_rpb + (size_t)(l * 8 + head) * 15 * 31;
    float mx = -1e30f;
#pragma unroll
    for (int t = 0; t < 16; ++t) {
        const int drow = rs + (t >> 1) - r + 7;
#pragma unroll
        for (int e = 0; e < 4; ++e) {
            const int col = cb + 16 * (t & 1) + 4 * q4 + e;
            const bool ok = (col >= cs) && (col < cs + 16);
            const int dcol = ok ? (col - c + 15) : 0;
            const float v = ok ? (sc[t][e] + rpb[drow * 31 + dcol]) : -1e30f;
            sc[t][e] = v; mx = fmaxf(mx, v);
        }
    }
    mx = fmaxf(mx, __shfl_xor(mx, 16)); mx = fmaxf(mx, __shfl_xor(mx, 32));
    float sum = 0.f;
#pragma unroll
    for (int t = 0; t < 16; ++t)
#pragma unroll
        for (int e = 0; e < 4; ++e) { const float pe = __expf(sc[t][e] - mx); sc[t][e] = pe; sum += pe; }
    sum += __shfl_xor(sum, 16); sum += __shfl_xor(sum, 32);
    f32x4 o[4];
#pragma unroll
    for (int dt = 0; dt < 4; ++dt) o[dt] = (f32x4){0.f, 0.f, 0.f, 0.f};
#pragma unroll
    for (int kk = 0; kk < 8; ++kk) {
        u32x4 pu; pu.x = pk2(sc[2 * kk][0], sc[2 * kk][1]); pu.y = pk2(sc[2 * kk][2], sc[2 * kk][3]); pu.z = pk2(sc[2 * kk + 1][0], sc[2 * kk + 1][1]); pu.w = pk2(sc[2 * kk + 1][2], sc[2 * kk + 1][3]);
        const bf16x8 pf = mkfrag(pu);
        const int kbA = (lo + kk) * 64 + cb + 4 * q4;
#pragma unroll
        for (int dt = 0; dt < 4; ++dt) {
            const bf16_t* vr = VT + (dt * 16 + l15) * 584 + kbA;
            const bf16x8 vf = mkfrag2(*(const u32x2*)vr, *(const u32x2*)(vr + 16));
            o[dt] = MFMA(vf, pf, o[dt]);
        }
    }
    const float inv = 1.0f / sum;
    const bf16_t* zrow = P + (size_t)(bl * SEQ + r * 64 + c) * PS + C_Z + head * 64;
#pragma unroll
    for (int dt = 0; dt < 4; ++dt) {
        const int dd = dt * 16 + 4 * q4;
        const f32x4 z = ld_bf4(zrow + dd);
        if (!dry) st_bf4(qrow + dd, o[dt] * inv * z);
    }
    __syncthreads();
}

__device__ __forceinline__ void memattn_load(const Params& p, int b, int h, unsigned char* lds) {
    bf16_t* Kimg = (bf16_t*)lds;
    bf16_t* VT = (bf16_t*)(lds + 69632);
    const bf16_t* Km = (const bf16_t*)(p.ws + OFF_KMAT); const bf16_t* Vm = (const bf16_t*)(p.ws + OFF_VT);
    int tid_ = threadIdx.x; asm volatile("" : "+v"(tid_)); const int tid = tid_;
#pragma unroll
    for (int i = 0; i < 8; ++i) {
        const int idx = tid + NTHR * i;
        { const int key = idx >> 4, ch = idx & 15; *(u32x4*)(Kimg + key * 136 + ch * 8) = *(const u32x4*)(Km + (size_t)(b * 256 + key) * 512 + h * 128 + ch * 8); }
        { const int dd = idx >> 5, ch = idx & 31; *(u32x4*)(VT + dd * 264 + ch * 8) = *(const u32x4*)(Vm + (size_t)(h * 128 + dd) * 2048 + b * 256 + ch * 8); }
    }
    __syncthreads();
}
__device__ __forceinline__ void memattn_item(bf16_t* P, int bl, int h, int qt, unsigned char* lds, int dry = 0) {
    const bf16_t* Kimg = (const bf16_t*)lds; const bf16_t* VT = (const bf16_t*)(lds + 69632);
    int tid_ = threadIdx.x; asm volatile("" : "+v"(tid_)); const int tid = tid_, lane = tid & 63, w = tid >> 6, l15 = lane & 15, q4 = lane >> 4;
    const int tok = bl * SEQ + qt * 128 + w * 16 + l15;
    bf16_t* qrow = P + (size_t)tok * PS + C_MQ + h * 128;
    bf16x8 qf[4];
#pragma unroll
    for (int ks = 0; ks < 4; ++ks) qf[ks] = *(const bf16x8*)(qrow + ks * 32 + q4 * 8);
    f32x4 sc[16];
    float mx = -1e30f;
#pragma unroll
    for (int t = 0; t < 16; ++t) {
        f32x4 a = {0.f, 0.f, 0.f, 0.f};
#pragma unroll
        for (int ks = 0; ks < 4; ++ks) { const bf16x8 kf = *(const bf16x8*)(Kimg + (t * 16 + l15) * 136 + ks * 32 + q4 * 8); a = MFMA(kf, qf[ks], a); }
        sc[t] = a;
        mx = fmaxf(mx, fmaxf(fmaxf(a[0], a[1]), fmaxf(a[2], a[3])));
    }
    mx = fmaxf(mx, __shfl_xor(mx, 16)); mx = fmaxf(mx, __shfl_xor(mx, 32));
    float sum = 0.f;
#pragma unroll
    for (int t = 0; t < 16; ++t)
#pragma unroll
        for (int e = 0; e < 4; ++e) { const float pe = __expf(sc[t][e] - mx); sc[t][e] = pe; sum += pe; }
    sum += __shfl_xor(sum, 16); sum += __shfl_xor(sum, 32);
    f32x4 o[8];
#pragma unroll
    for (int dt = 0; dt < 8; ++dt) o[dt] = (f32x4){0.f, 0.f, 0.f, 0.f};
#pragma unroll
    for (int kk = 0; kk < 8; ++kk) {
        u32x4 pu; pu.x = pk2(sc[2 * kk][0], sc[2 * kk][1]); pu.y = pk2(sc[2 * kk][2], sc[2 * kk][3]); pu.z = pk2(sc[2 * kk + 1][0], sc[2 * kk + 1][1]); pu.w = pk2(sc[2 * kk + 1][2], sc[2 * kk + 1][3]);
        const bf16x8 pf = mkfrag(pu);
#pragma unroll
        for (int dt = 0; dt < 8; ++dt) {
            const bf16_t* vr = VT + (dt * 16 + l15) * 264 + kk * 32 + 4 * q4;
            const bf16x8 vf = mkfrag2(*(const u32x2*)vr, *(const u32x2*)(vr + 16));
            o[dt] = MFMA(vf, pf, o[dt]);
        }
    }
    const float inv = 1.0f / sum;
    const bf16_t* zrow = P + (size_t)tok * PS + C_Z + 3 * 512 + h * 128;
#pragma unroll
    for (int dt = 0; dt < 8; ++dt) {
        const int dd = dt * 16 + 4 * q4;
        const f32x4 z = ld_bf4(zrow + dd);
        if (!dry) st_bf4(qrow + dd, o[dt] * inv * z);
    }
}

constexpr int G_LRT = 0, G_BF = 8192, G_BB = 24576, G_TOT = 40960, G_IMG = 45056;
__device__ __forceinline__ void gla_tables(const Params& p, int l, const float* LR, int t0, int h, unsigned char* lds) {
    float* LRT = (float*)(lds + G_LRT); float* BF = (float*)(lds + G_BF); float* BB = (float*)(lds + G_BB); float* TOT = (float*)(lds + G_TOT);
    int tid_ = threadIdx.x; asm volatile("" : "+v"(tid_)); const int tid = tid_;
    ((float4*)LRT)[tid] = ((const float4*)(LR + (size_t)t0 * 32))[tid];
    __syncthreads();
    const int dk = tid & 63, cgp = tid >> 6;
    float uf[16], ub[16];
#pragma unroll
    for (int r = 0; r < 16; ++r) { uf[r] = p.gla_up_f[(size_t)(l * 16 + r) * 256 + h * 64 + dk]; ub[r] = p.gla_up_b[(size_t)(l * 16 + r) * 256 + h * 64 + dk]; }
    const float bif = p.gla_bias_f[l * 256 + h * 64 + dk], bib = p.gla_bias_b[l * 256 + h * 64 + dk];
    float lf[8], lb[8];
#pragma unroll
    for (int i = 0; i < 8; ++i) {
        const int c = cgp * 8 + i; float sf = bif, sb = bib;
#pragma unroll
        for (int r = 0; r < 16; ++r) { sf += LRT[c * 32 + r] * uf[r]; sb += LRT[c * 32 + 16 + r] * ub[r]; }
        lf[i] = logsigf_(sf) * (1.0f / 16.0f); lb[i] = logsigf_(sb) * (1.0f / 16.0f);
    }
#pragma unroll
    for (int i = 1; i < 8; ++i) lf[i] += lf[i - 1];
#pragma unroll
    for (int i = 6; i >= 0; --i) lb[i] += lb[i + 1];
    TOT[cgp * 64 + dk] = lf[7]; TOT[512 + cgp * 64 + dk] = lb[0];
    __syncthreads();
    float of = 0.f, ob = 0.f;
#pragma unroll
    for (int g2 = 0; g2 < 8; ++g2) { if (g2 < cgp) of += TOT[g2 * 64 + dk]; if (g2 > cgp) ob += TOT[512 + g2 * 64 + dk]; }
#pragma unroll
    for (int i = 0; i < 8; ++i) { BF[(cgp * 8 + i) * 64 + dk] = lf[i] + of; BB[(cgp * 8 + i) * 64 + dk] = lb[i] + ob; }
    __syncthreads();
}
struct GlaPre { u32x4 vv[2]; bf16_t q[8], k[8]; };
__device__ __forceinline__ void gla_prefetch(GlaPre& g, const bf16_t* P, int t0, int h, int tid) {
#pragma unroll
    for (int i = 0; i < 2; ++i) { const int idx = tid + NTHR * i, chn = idx >> 6, c = idx & 63; g.vv[i] = *(const u32x4*)(P + (size_t)(t0 + c) * PS + C_GV + h * 128 + chn * 8); }
#pragma unroll
    for (int i = 0; i < 8; ++i) { const int idx = tid + NTHR * i, c = idx >> 6, dk = idx & 63; g.q[i] = P[(size_t)(t0 + c) * PS + C_GQ + h * 64 + dk]; g.k[i] = P[(size_t)(t0 + c) * PS + C_GK + h * 64 + dk]; }
}
__device__ __forceinline__ void gla_vt_store(const GlaPre& g, bf16_t* VT, int tid) {
#pragma unroll
    for (int i = 0; i < 2; ++i) {
        const int idx = tid + NTHR * i, chn = idx >> 6, c = idx & 63;
        const u32x4 vv = g.vv[i];
        bf16_t* vd = VT + (chn * 8) * 72 + c;
        vd[0 * 72] = (bf16_t)(vv.x & 0xffffu); vd[1 * 72] = (bf16_t)(vv.x >> 16);
        vd[2 * 72] = (bf16_t)(vv.y & 0xffffu); vd[3 * 72] = (bf16_t)(vv.y >> 16);
        vd[4 * 72] = (bf16_t)(vv.z & 0xffffu); vd[5 * 72] = (bf16_t)(vv.z >> 16);
        vd[6 * 72] = (bf16_t)(vv.w & 0xffffu); vd[7 * 72] = (bf16_t)(vv.w >> 16);
    }
}
__device__ __forceinline__ void gla_part1_item(const Params& p, int l, const bf16_t* P, const float* LR, int item, unsigned char* lds) {
    const int h = item & 3, n = (item >> 2) & 127, bl = item >> 9, t0 = bl * SEQ + n * 64;
    const float* BF = (const float*)(lds + G_BF); const float* BB = (const float*)(lds + G_BB);
    bf16_t* KDT0 = (bf16_t*)(lds + G_IMG); bf16_t* KDT1 = KDT0 + 64 * 72; bf16_t* VT = KDT1 + 64 * 72;
    bf16_t* GS = (bf16_t*)(p.ws + OFF_GS); float* GD = (float*)(p.ws + OFF_GDEC);
    int tid_ = threadIdx.x; asm volatile("" : "+v"(tid_)); const int tid = tid_, lane = tid & 63, w = tid >> 6, l15 = lane & 15, q4 = lane >> 4;
    GlaPre gp; gla_prefetch(gp, P, t0, h, tid);
    gla_tables(p, l, LR, t0, h, lds);
    {
        float4* tb = (float4*)((float*)(p.ws + OFF_TB) + (size_t)item * 8192); const float4* ts = (const float4*)(lds + G_BF);
#pragma unroll
        for (int i = 0; i < 4; ++i) tb[tid + NTHR * i] = ts[tid + NTHR * i];
    }
#pragma unroll
    for (int i = 0; i < 8; ++i) {
        const int idx = tid + NTHR * i, c = idx >> 6, dk = idx & 63;
        const float kv = bf2f(gp.k[i]);
        KDT0[dk * 72 + c] = f2bf_d(kv * __expf(BF[63 * 64 + dk] - BF[c * 64 + dk]));
        KDT1[dk * 72 + c] = f2bf_d(kv * __expf(BB[dk] - BB[c * 64 + dk]));
    }
    gla_vt_store(gp, VT, tid);
    if (tid < 64) GD[(size_t)item * 64 + tid] = __expf(BF[63 * 64 + tid]);
    else if (tid < 128) GD[(size_t)(NITEM + item) * 64 + tid - 64] = __expf(BB[tid - 64]);
    __syncthreads();
    const int dir = w >> 2, dkt = w & 3;
    const bf16_t* KD = dir ? KDT1 : KDT0;
    bf16x8 kf[2];
#pragma unroll
    for (int ks = 0; ks < 2; ++ks) kf[ks] = *(const bf16x8*)(KD + (16 * dkt + l15) * 72 + 32 * ks + 8 * q4);
    bf16_t* dst = GS + ((size_t)dir * NITEM + item) * 8192;
#pragma unroll
    for (int dvt = 0; dvt < 8; ++dvt) {
        f32x4 a = {0.f, 0.f, 0.f, 0.f};
#pragma unroll
        for (int ks = 0; ks < 2; ++ks) { const bf16x8 vf = *(const bf16x8*)(VT + (16 * dvt + l15) * 72 + 32 * ks + 8 * q4); a = MFMA(kf[ks], vf, a); }
        st_bf4(dst + (16 * dvt + l15) * 64 + 16 * dkt + 4 * q4, a);
    }
    __syncthreads();
}
__device__ __forceinline__ void gla_scan(const Params& p, int dry = 0) {
    const bf16_t* GS = (const bf16_t*)(p.ws + OFF_GS); const float* GD = (const float*)(p.ws + OFF_GDEC); bf16_t* SB = (bf16_t*)(p.ws + OFF_SB);
    const int total = 2 * BG * 4 * 8192;
    int tid_ = threadIdx.x; asm volatile("" : "+v"(tid_));
    for (int id = blockIdx.x * NTHR + tid_; id < total; id += gridDim.x * NTHR) {
        const int e = id & 8191, comb = id >> 13, h = comb & 3, bl = (comb >> 2) % BG, dir = comb / (4 * BG), dk = e & 63;
        float S = 0.f;
        const size_t ibase = (size_t)dir * NITEM + (size_t)(bl * 128) * 4 + h;
        for (int s0 = 0; s0 < 128; s0 += 16) {
            float u[16], dc[16];
#pragma unroll
            for (int i = 0; i < 16; ++i) {
                const int n = dir ? 127 - (s0 + i) : s0 + i;
                const size_t item = ibase + (size_t)n * 4;
                u[i] = bf2f(GS[item * 8192 + e]); dc[i] = GD[item * 64 + dk];
            }
#pragma unroll
            for (int i = 0; i < 16; ++i) {
                const int n = dir ? 127 - (s0 + i) : s0 + i;
                const size_t item = ibase + (size_t)n * 4;
                if (!dry) SB[item * 8192 + e] = f2bf_d(S);
                S = dc[i] * S + u[i];
            }
        }
    }
}
__device__ __forceinline__ void gla_part2_item(const Params& p, int l, bf16_t* P, const float* LR, int item, unsigned char* lds, int dry = 0) {
    const int h = item & 3, n = (item >> 2) & 127, bl = item >> 9, t0 = bl * SEQ + n * 64;
    const float* BF = (const float*)(lds + G_BF); const float* BB = (const float*)(lds + G_BB);
    bf16_t* QF = (bf16_t*)(lds + G_IMG);
    bf16_t* KF = QF + 2 * 64 * 72;
    bf16_t* QD = KF + 2 * 64 * 72;
    bf16_t* VT = QD + 2 * 64 * 72;
    bf16_t* ST = VT + 128 * 72;
    float* OX = (float*)lds;
    const float* GS = (const float*)(p.ws + OFF_GS);
    int tid_ = threadIdx.x; asm volatile("" : "+v"(tid_)); const int tid = tid_, lane = tid & 63, w = tid >> 6, l15 = lane & 15, q4 = lane >> 4;
    GlaPre gp; gla_prefetch(gp, P, t0, h, tid);
    u32x4 sp[2][2];
#pragma unroll
    for (int dir = 0; dir < 2; ++dir)
#pragma unroll
        for (int i = 0; i < 2; ++i) { const int idx = tid + NTHR * i; sp[dir][i] = *(const u32x4*)((const bf16_t*)(p.ws + OFF_SB) + ((size_t)dir * NITEM + item) * 8192 + (size_t)idx * 8); }
    {
        const float4* tb = (const float4*)((const float*)(p.ws + OFF_TB) + (size_t)item * 8192); float4* ts = (float4*)(lds + G_BF);
        float4 tv[4];
#pragma unroll
        for (int i = 0; i < 4; ++i) tv[i] = tb[tid + NTHR * i];
#pragma unroll
        for (int i = 0; i < 4; ++i) ts[tid + NTHR * i] = tv[i];
        __syncthreads();
    }
#pragma unroll
    for (int i = 0; i < 8; ++i) {
        const int idx = tid + NTHR * i, c = idx >> 6, dk = idx & 63;
        const float qv = bf2f(gp.q[i]);
        const float kv = bf2f(gp.k[i]);
        const float bf = BF[c * 64 + dk], mf = BF[31 * 64 + dk], bb = BB[c * 64 + dk], mb = BB[32 * 64 + dk];
        QF[c * 72 + dk] = f2bf_d(qv * __expf(bf - mf)); KF[c * 72 + dk] = f2bf_d(kv * __expf(mf - bf)); QD[c * 72 + dk] = f2bf_d(qv * __expf(bf));
        QF[4608 + c * 72 + dk] = f2bf_d(qv * __expf(bb - mb)); KF[4608 + c * 72 + dk] = f2bf_d(kv * __expf(mb - bb)); QD[4608 + c * 72 + dk] = f2bf_d(qv * __expf(bb));
    }
    gla_vt_store(gp, VT, tid);
#pragma unroll
    for (int dir = 0; dir < 2; ++dir) {
#pragma unroll
        for (int i = 0; i < 2; ++i) {
            const int idx = tid + NTHR * i, dv = idx >> 3, dk8 = (idx & 7) * 8;
            *(u32x4*)(ST + dir * 9216 + dv * 72 + dk8) = sp[dir][i];
        }
    }
    __syncthreads();
    const int dir = w >> 2, ct = w & 3;
    const bf16_t* qfp = QF + dir * 4608; const bf16_t* kfp = KF + dir * 4608; const bf16_t* qdp = QD + dir * 4608; const bf16_t* stp = ST + dir * 9216;
    bf16x8 qf[2], qd[2];
#pragma unroll
    for (int ks = 0; ks < 2; ++ks) { qf[ks] = *(const bf16x8*)(qfp + (16 * ct + l15) * 72 + 32 * ks + 8 * q4); qd[ks] = *(const bf16x8*)(qdp + (16 * ct + l15) * 72 + 32 * ks + 8 * q4); }
    f32x4 sc[4];
    const int cq = 16 * ct + l15;
#pragma unroll
    for (int st = 0; st < 4; ++st) {
        f32x4 a = {0.f, 0.f, 0.f, 0.f};
#pragma unroll
        for (int ks = 0; ks < 2; ++ks) { const bf16x8 kf = *(const bf16x8*)(kfp + (16 * st + l15) * 72 + 32 * ks + 8 * q4); a = MFMA(kf, qf[ks], a); }
#pragma unroll
        for (int e = 0; e < 4; ++e) { const int s = 16 * st + 4 * q4 + e; const bool ok = dir ? (s > cq) : (s <= cq); a[e] = ok ? a[e] : 0.f; }
        sc[st] = a;
    }
    f32x4 o[8];
#pragma unroll
    for (int dt = 0; dt < 8; ++dt) o[dt] = (f32x4){0.f, 0.f, 0.f, 0.f};
#pragma unroll
    for (int kk = 0; kk < 2; ++kk) {
        u32x4 pu; pu.x = pk2(sc[2 * kk][0], sc[2 * kk][1]); pu.y = pk2(sc[2 * kk][2], sc[2 * kk][3]); pu.z = pk2(sc[2 * kk + 1][0], sc[2 * kk + 1][1]); pu.w = pk2(sc[2 * kk + 1][2], sc[2 * kk + 1][3]);
        const bf16x8 pf = mkfrag(pu);
#pragma unroll
        for (int dt = 0; dt < 8; ++dt) {
            const bf16_t* vr = VT + (dt * 16 + l15) * 72 + kk * 32 + 4 * q4;
            const bf16x8 vf = mkfrag2(*(const u32x2*)vr, *(const u32x2*)(vr + 16));
            o[dt] = MFMA(vf, pf, o[dt]);
        }
    }
#pragma unroll
    for (int ks = 0; ks < 2; ++ks)
#pragma unroll
        for (int dt = 0; dt < 8; ++dt) { const bf16x8 sf = *(const bf16x8*)(stp + (dt * 16 + l15) * 72 + 32 * ks + 8 * q4); o[dt] = MFMA(sf, qd[ks], o[dt]); }
    if (dir == 1) {
#pragma unroll
        for (int dt = 0; dt < 8; ++dt) *(f32x4*)(OX + cq * 132 + 16 * dt + 4 * q4) = o[dt];
    }
    __syncthreads();
    if (dir == 0) {
        float ss = 0.f;
#pragma unroll
        for (int dt = 0; dt < 8; ++dt) { o[dt] += *(const f32x4*)(OX + cq * 132 + 16 * dt + 4 * q4); ss += (o[dt][0] * o[dt][0] + o[dt][1] * o[dt][1]) + (o[dt][2] * o[dt][2] + o[dt][3] * o[dt][3]); }
        ss += __shfl_xor(ss, 16); ss += __shfl_xor(ss, 32);
        const float rms = 1.0f / sqrtf(ss * (1.0f / 128.0f) + 1e-6f);
        const float* ng = p.gla_norm_g + l * 512 + h * 128;
        const bf16_t* zrow = P + (size_t)(t0 + cq) * PS + C_Z + 2 * 512 + h * 128;
        bf16_t* orow = P + (size_t)(t0 + cq) * PS + C_GV + h * 128;
#pragma unroll
        for (int dt = 0; dt < 8; ++dt) {
            const int dd = 16 * dt + 4 * q4;
            const f32x4 z = ld_bf4(zrow + dd); const f32x4 g4 = *(const f32x4*)(ng + dd);
            if (!dry) st_bf4(orow + dd, o[dt] * rms * g4 * z);
        }
    }
    __syncthreads();
}

namespace pg8 {
#define PG8_LAS __attribute__((address_space(3)))
typedef unsigned short bf16_t;
typedef short bf16x8 __attribute__((ext_vector_type(8)));
typedef float f32x4 __attribute__((ext_vector_type(4)));
typedef unsigned u32x4 __attribute__((ext_vector_type(4)));
constexpr int BM = 256, BK = 64, HALF = 128, HTB = HALF * BK * 2  , STAGE_BYTES = 8 * HTB, NXCD = 8, WGM = 8;

__host__ __device__ __forceinline__ int lds_byte(int r, int c) { const int st = (r >> 4) * 2 + (c >> 5), rr = r & 15, cc = c & 31, ob = rr * 64 + cc * 2; return st * 1024 + (ob ^ (((ob >> 9) & 1) << 5)); }
__host__ __device__ __forceinline__ void stage_rc(int b, int& R, int& C) { const int st = b / 1024, sb = b % 1024, swz = sb ^ (((sb >> 9) & 1) << 5); R = (st >> 1) * 16 + swz / 64; C = (st & 1) * 32 + (swz % 64) / 2; }
__host__ __device__ __forceinline__ int perm32(int rho) { const int n = rho >> 4, i = rho & 15; return 8 * (i >> 2) + 4 * n + (i & 3); }

struct Unit { int pm, pn; };
struct Gemm { const bf16_t* A; const bf16_t* Bt; int M, N, K; };

struct StaticOrder {
    int nM, nN, nwg, G, c;
    __host__ __device__ __forceinline__ void init(int M, int N, int G_, int c_) { nM = M / BM; nN = N / BM; nwg = nM * nN; G = G_; c = c_; }
    __host__ __device__ bool next(int i, Unit& u) const {
        const long L = (long)i * G + c; if (L >= nwg) return false;
        int wgid = (int)L; { const int q = nwg / NXCD, r = nwg % NXCD, xcd = wgid % NXCD, off = wgid / NXCD; wgid = (xcd < r ? xcd * (q + 1) : r * (q + 1) + (xcd - r) * q) + off; }
        const int nig = WGM * nN, gid = wgid / nig, fm = gid * WGM, gsz = (nM - fm) < WGM ? (nM - fm) : WGM;
        u.pm = fm + ((wgid % nig) % gsz); u.pn = (wgid % nig) / gsz; return true;
    }
    __device__ __forceinline__ void a_ready(const Unit&) const {}
    __device__ __forceinline__ void done(const Unit&) const {}
};
__device__ __forceinline__ unsigned cvt_pk_bf16(float lo, float hi) { unsigned r; asm volatile("v_cvt_pk_bf16_f32 %0, %1, %2" : "=v"(r) : "v"(lo), "v"(hi)); return r; }
template <class Epi, class Sched, bool STAMP = false>
__device__ __forceinline__ void gemm_phase(PG8_LAS unsigned char* lds, const Gemm g, const Sched& S, const Epi& E, unsigned long long* stamps) {
    int tid_l = threadIdx.x; asm volatile("" : "+v"(tid_l)); const int tid = tid_l, wid = __builtin_amdgcn_readfirstlane(tid >> 6), lane = tid & 63, wr = wid >> 2, wc = wid & 3, fr = lane & 15, fq = lane >> 4;
    const int K = g.K, nt = K / BK;
    int ts_lo = 0, ts_hi = 0, nts = 0; const unsigned long long rt_entry = STAMP ? (unsigned long long)wall_clock64() : 0ull;
#define PG8_STAMP() do { if (STAMP && wid == 0 && nts < 64) { const unsigned long long _c = (unsigned long long)clock64(); \
        ts_lo = (lane == nts) ? (int)(unsigned)_c : ts_lo; ts_hi = (lane == nts) ? (int)(unsigned)(_c >> 32) : ts_hi; ++nts; } } while (0)
    PG8_STAMP();
    unsigned voffA[2], voffB[2];
#pragma unroll
    for (int i = 0; i < 2; ++i) { int R, C; stage_rc(tid * 16 + i * 8192, R, C); const int Rb = Epi::PERM ? ((R & ~31) + perm32(R & 31)) : R;
        voffA[i] = (unsigned)(R * K + C) * 2u; voffB[i] = (unsigned)(Rb * K + C) * 2u; }
    const size_t kstep = (size_t)(BK * 2);
    const size_t hstep = (size_t)HALF * K * 2;
    const size_t tstep = 2 * hstep;
    const unsigned ldsw = (unsigned)wid * 1024u;
    const int aoff = lds_byte(wr * 64 + fr, fq * 8), boff = lds_byte(wc * 32 + fr, fq * 8);
#define PG8_SA(b, h) (((b) * 2 + (h)) * HTB)
#define PG8_SB(b, h) ((4 + (b) * 2 + (h)) * HTB)
#define PG8_STAGE(bufoff, gbase, voff) do { _Pragma("unroll") for (int _i = 0; _i < 2; ++_i) \
        __builtin_amdgcn_global_load_lds((const unsigned*)((const char*)(gbase) + (voff)[_i]), (PG8_LAS unsigned*)(lds + (bufoff) + ldsw + _i * 8192), 16, 0, 0); } while (0)
#define PG8_LDA(dst, b, h) do { _Pragma("unroll") for (int m = 0; m < 4; ++m) _Pragma("unroll") for (int k = 0; k < 2; ++k) dst[m][k] = *(const PG8_LAS bf16x8*)(lds + PG8_SA(b, h) + aoff + m * 2048 + k * 1024); } while (0)
#define PG8_LDB(dst, b, h) do { _Pragma("unroll") for (int n = 0; n < 2; ++n) _Pragma("unroll") for (int k = 0; k < 2; ++k) dst[n][k] = *(const PG8_LAS bf16x8*)(lds + PG8_SB(b, h) + boff + n * 2048 + k * 1024); } while (0)
#define PG8_MMA(ai, bj, At, Bt) do { __builtin_amdgcn_s_setprio(1); _Pragma("unroll") for (int m = 0; m < 4; ++m) _Pragma("unroll") for (int n = 0; n < 2; ++n) _Pragma("unroll") for (int k = 0; k < 2; ++k) \
        acc[ai][bj][m][n] = __builtin_amdgcn_mfma_f32_16x16x32_bf16(Bt[n][k], At[m][k], acc[ai][bj][m][n], 0, 0, 0); __builtin_amdgcn_s_setprio(0); } while (0)
#define PG8_WAIT_V(n) asm volatile("s_waitcnt vmcnt(" #n ")" ::: "memory")
#define PG8_WAIT_L(n) asm volatile("s_waitcnt lgkmcnt(" #n ")" ::: "memory")
#define PG8_BAR __builtin_amdgcn_s_barrier()
#define PG8_SCHED __builtin_amdgcn_sched_barrier(0)
    Unit cur, nxt; int ui = 0;
    if (!S.next(0, cur)) return;
    f32x4 acc[2][2][4][2];
#pragma unroll
    for (int a = 0; a < 2; ++a)
#pragma unroll
        for (int b = 0; b < 2; ++b)
#pragma unroll
            for (int m = 0; m < 4; ++m)
#pragma unroll
                for (int n = 0; n < 2; ++n) acc[a][b][m][n] = (f32x4){0.f, 0.f, 0.f, 0.f};
    bf16x8 At[4][2], B0[2][2], B1[2][2];
    const char* cA = (const char*)g.A + (size_t)cur.pm * tstep; const char* cB = (const char*)g.Bt + (size_t)cur.pn * tstep;
    S.a_ready(cur);
    PG8_STAGE(PG8_SB(0, 0), cB, voffB); PG8_STAGE(PG8_SA(0, 0), cA, voffA); PG8_STAGE(PG8_SB(0, 1), cB + hstep, voffB); PG8_STAGE(PG8_SA(0, 1), cA + hstep, voffA);
    if (wr == 1) PG8_BAR;
    PG8_WAIT_V(4); PG8_BAR;
    PG8_STAGE(PG8_SB(1, 0), cB + kstep, voffB); PG8_STAGE(PG8_SA(1, 0), cA + kstep, voffA); PG8_STAGE(PG8_SB(1, 1), cB + hstep + kstep, voffB);
    PG8_WAIT_V(6); PG8_BAR;
    PG8_STAMP();
    for (;;) {
        const bool has_next = S.next(ui + 1, nxt);
        const char* nA = has_next ? (const char*)g.A + (size_t)nxt.pm * tstep : cA; const char* nB = has_next ? (const char*)g.Bt + (size_t)nxt.pn * tstep : cB;
        for (int t = 0; t < nt; t += 2) {
            const bool last = (t == nt - 2);
            const char* a1 = cA + (size_t)(t + 1) * kstep;
            const char* a2 = last ? nA : cA + (size_t)(t + 2) * kstep; const char* b2 = last ? nB : cB + (size_t)(t + 2) * kstep;
            const char* a3 = a2 + kstep; const char* b3 = b2 + kstep;
            if (last && has_next) S.a_ready(nxt);
            PG8_LDB(B0, 0, 0); PG8_SCHED; PG8_LDA(At, 0, 0); PG8_STAGE(PG8_SA(1, 1), a1 + hstep, voffA);
            PG8_WAIT_L(8); PG8_BAR; PG8_WAIT_L(0); PG8_MMA(0, 0, At, B0); PG8_BAR; PG8_SCHED;
            PG8_LDB(B1, 0, 1); PG8_STAGE(PG8_SB(0, 0), b2, voffB);
            PG8_BAR; PG8_WAIT_L(0); PG8_MMA(0, 1, At, B1); PG8_BAR;
            PG8_LDA(At, 0, 1); PG8_STAGE(PG8_SA(0, 0), a2, voffA);
            PG8_BAR; PG8_WAIT_L(0); PG8_MMA(1, 0, At, B0); PG8_BAR; PG8_SCHED;
            PG8_STAGE(PG8_SB(0, 1), b2 + hstep, voffB);
            PG8_WAIT_V(6); PG8_BAR; PG8_MMA(1, 1, At, B1); PG8_BAR;
            PG8_LDB(B0, 1, 0); PG8_SCHED; PG8_LDA(At, 1, 0); PG8_STAGE(PG8_SA(0, 1), a2 + hstep, voffA);
            PG8_WAIT_L(8); PG8_BAR; PG8_WAIT_L(0); PG8_MMA(0, 0, At, B0); PG8_BAR; PG8_SCHED;
            PG8_LDB(B1, 1, 1); PG8_STAGE(PG8_SB(1, 0), b3, voffB);
            PG8_BAR; PG8_WAIT_L(0); PG8_MMA(0, 1, At, B1); PG8_BAR;
            PG8_LDA(At, 1, 1); PG8_STAGE(PG8_SA(1, 0), a3, voffA);
            PG8_BAR; PG8_WAIT_L(0); PG8_MMA(1, 0, At, B0); PG8_BAR; PG8_SCHED;
            PG8_STAGE(PG8_SB(1, 1), b3 + hstep, voffB);
            PG8_WAIT_V(6); PG8_BAR; PG8_MMA(1, 1, At, B1); PG8_BAR;
        }
        PG8_STAMP();
        if constexpr (!Epi::AFTER_DRAIN) { E(acc, cur, wr, wc, fr, fq); S.done(cur); }
        PG8_STAMP();
        if (!has_next) break;
#pragma unroll
        for (int a = 0; a < 2; ++a)
#pragma unroll
            for (int b = 0; b < 2; ++b)
#pragma unroll
                for (int m = 0; m < 4; ++m)
#pragma unroll
                    for (int n = 0; n < 2; ++n) acc[a][b][m][n] = (f32x4){0.f, 0.f, 0.f, 0.f};
        cur = nxt; cA = nA; cB = nB; ++ui;
    }
    PG8_WAIT_V(0);
    if (wr == 0) PG8_BAR;
    PG8_BAR;
    if constexpr (Epi::AFTER_DRAIN) { E.fused(acc, cur, wr, wc, fr, fq, lds, wid, lane); S.done(cur); }
    PG8_STAMP();
    if (STAMP && wid == 0) { stamps[lane] = lane < nts ? (((unsigned long long)(unsigned)ts_hi << 32) | (unsigned)ts_lo) : 0ull;
        if (lane == 62) stamps[62] = rt_entry; if (lane == 63) stamps[63] = (unsigned long long)wall_clock64(); }
#undef PG8_STAMP
#undef PG8_SA
#undef PG8_SB
#undef PG8_STAGE
#undef PG8_LDA
#undef PG8_LDB
#undef PG8_MMA
#undef PG8_WAIT_V
#undef PG8_WAIT_L
#undef PG8_BAR
#undef PG8_SCHED
}
}

struct EpiInProj {
    static constexpr bool PERM = true, AFTER_DRAIN = false;
    bf16_t* P; const float* bias; float* LR;
    __device__ __forceinline__ void operator()(const f32x4 (&acc)[2][2][4][2], const pg8::Unit& u, int wr, int wc, int fr, int fq) const {
        const int row0 = u.pm * 256 + wr * 64 + fr, colt = u.pn * 256, col0 = colt + wc * 32 + 8 * fq;
        if (colt == C_LR) {
            if (wc == 0) {
                const int cl = 8 * fq;
                const f32x4 b0 = *(const f32x4*)(bias + 4096 + cl), b1 = *(const f32x4*)(bias + 4096 + cl + 4);
#pragma unroll
                for (int ai = 0; ai < 2; ++ai)
#pragma unroll
                    for (int m = 0; m < 4; ++m) {
                        float* d = LR + (size_t)(row0 + ai * 128 + m * 16) * 32 + cl;
                        *(f32x4*)d = acc[ai][0][m][0] + b0; *(f32x4*)(d + 4) = acc[ai][0][m][1] + b1;
                    }
            }
            return;
        }
        const int mode = (colt < 512 || colt == C_GQ) ? 1 : (colt >= C_MQ && colt < C_Z) ? 2 : (colt >= C_Z && colt < C_SG) ? 3 : (colt >= C_SG) ? 4 : 0;
#pragma unroll
        for (int bj = 0; bj < 2; ++bj) {
            const int col = col0 + bj * 128;
            const f32x4 b0 = *(const f32x4*)(bias + orig_col(col)), b1 = *(const f32x4*)(bias + orig_col(col) + 4);
#pragma unroll
            for (int ai = 0; ai < 2; ++ai)
#pragma unroll
                for (int m = 0; m < 4; ++m) {
                    f32x4 v0 = acc[ai][bj][m][0] + b0, v1 = acc[ai][bj][m][1] + b1;
                    if (mode == 1) { v0 *= 0.125f; v1 *= 0.125f; }
                    else if (mode == 2) { v0 *= 0.08838834764831845f; v1 *= 0.08838834764831845f; }
                    else if (mode == 3) {
#pragma unroll
                        for (int e = 0; e < 4; ++e) { v0[e] = siluf_(v0[e]); v1[e] = siluf_(v1[e]); }
                    } else if (mode == 4) {
#pragma unroll
                        for (int e = 0; e < 4; ++e) { v0[e] = sigmoidf_(v0[e]); v1[e] = sigmoidf_(v1[e]); }
                    }
                    u32x4 o; o.x = pk2(v0[0], v0[1]); o.y = pk2(v0[2], v0[3]); o.z = pk2(v1[0], v1[1]); o.w = pk2(v1[2], v1[3]);
                    *(u32x4*)(P + (size_t)(row0 + ai * 128 + m * 16) * PS + col) = o;
                }
        }
    }
};
struct EpiOut {
    static constexpr bool PERM = false, AFTER_DRAIN = false;
    bf16_t* pre; const float* bo;
    __device__ __forceinline__ void operator()(const f32x4 (&acc)[2][2][4][2], const pg8::Unit& u, int wr, int wc, int fr, int fq) const {
        const int row0 = u.pm * 256 + wr * 64 + fr, col0 = u.pn * 256 + wc * 32 + 4 * fq;
#pragma unroll
        for (int bj = 0; bj < 2; ++bj)
#pragma unroll
            for (int n = 0; n < 2; ++n) {
                const int col = col0 + bj * 128 + n * 16;
                const f32x4 b4 = *(const f32x4*)(bo + col);
#pragma unroll
                for (int ai = 0; ai < 2; ++ai)
#pragma unroll
                    for (int m = 0; m < 4; ++m) st_bf4(pre + (size_t)(row0 + ai * 128 + m * 16) * 1024 + col, acc[ai][bj][m][n] + b4);
            }
    }
};

__device__ __forceinline__ void ln_rows_res(const Params& p, int l, size_t tok0) {
    int tid_ = threadIdx.x; asm volatile("" : "+v"(tid_));
    const int lane = tid_ & 63;
    const int gw = blockIdx.x * (NTHR / 64) + (tid_ >> 6), nw = gridDim.x * (NTHR / 64);
    const bf16_t* pre = (const bf16_t*)(p.ws + OFF_PRE); const float2* stats = (const float2*)(p.ws + OFF_STATS); bf16_t* hb = (bf16_t*)(p.ws + OFF_HB);
    const float* g = p.ln_g + l * 1024; const float* b = p.ln_b + l * 1024;
    for (int r = gw; r < TG; r += nw) {
        const size_t T = tok0 + r;
        const bf16_t* pr = pre + (size_t)r * 1024;
        float4 v[4]; float s = 0.f;
        if (l == 0) {
            const float4* xr = (const float4*)(p.x + T * 1024); const float2 st = stats[T];
#pragma unroll
            for (int i = 0; i < 4; ++i) {
                const f32x4 a4 = ld_bf4(pr + (lane + 64 * i) * 4); float4 a; a.x = a4[0]; a.y = a4[1]; a.z = a4[2]; a.w = a4[3]; const float4 x4 = xr[lane + 64 * i], g4 = ((const float4*)p.ln_in_g)[lane + 64 * i], b4 = ((const float4*)p.ln_in_b)[lane + 64 * i];
                v[i].x = a.x + DN_ALPHA * ((x4.x - st.x) * st.y * g4.x + b4.x); v[i].y = a.y + DN_ALPHA * ((x4.y - st.x) * st.y * g4.y + b4.y);
                v[i].z = a.z + DN_ALPHA * ((x4.z - st.x) * st.y * g4.z + b4.z); v[i].w = a.w + DN_ALPHA * ((x4.w - st.x) * st.y * g4.w + b4.w);
            }
        } else {
            const float4* hr = (const float4*)(p.out + T * 1024);
#pragma unroll
            for (int i = 0; i < 4; ++i) {
                const f32x4 a4 = ld_bf4(pr + (lane + 64 * i) * 4); float4 a; a.x = a4[0]; a.y = a4[1]; a.z = a4[2]; a.w = a4[3]; const float4 h4 = hr[lane + 64 * i];
                v[i].x = a.x + DN_ALPHA * h4.x; v[i].y = a.y + DN_ALPHA * h4.y; v[i].z = a.z + DN_ALPHA * h4.z; v[i].w = a.w + DN_ALPHA * h4.w;
            }
        }
#pragma unroll
        for (int i = 0; i < 4; ++i) s += (v[i].x + v[i].y) + (v[i].z + v[i].w);
        s = wave_sum(s);
        const float mean = s * (1.0f / 1024.0f);
        float q = 0.f;
#pragma unroll
        for (int i = 0; i < 4; ++i) { const float a = v[i].x - mean, bb = v[i].y - mean, c = v[i].z - mean, d = v[i].w - mean; q += (a * a + bb * bb) + (c * c + d * d); }
        q = wave_sum(q);
        const float rstd = 1.0f / sqrtf(q * (1.0f / 1024.0f) + 1e-5f);
#pragma unroll
        for (int i = 0; i < 4; ++i) {
            const float4 g4 = ((const float4*)g)[lane + 64 * i], b4 = ((const float4*)b)[lane + 64 * i];
            float4 y; y.x = (v[i].x - mean) * rstd * g4.x + b4.x; y.y = (v[i].y - mean) * rstd * g4.y + b4.y; y.z = (v[i].z - mean) * rstd * g4.z + b4.z; y.w = (v[i].w - mean) * rstd * g4.w + b4.w;
            ((float4*)(p.out + T * 1024))[lane + 64 * i] = y;
            u32x2 o; o.x = pk2(y.x, y.y); o.y = pk2(y.z, y.w); *(u32x2*)(hb + T * 1024 + (lane + 64 * i) * 4) = o;
        }
    }
}

#define XB_TMO      128
#define XB_XCNT(j)  (256  + 64 * (j))
#define XB_XSUB(j)  (1280 + 64 * (j))
#define XB_XGEN(j)  (2304 + 64 * (j))
#define XB_TOP      3328
#define XB_TOPGEN   3392
#define XCD_BAR_WORDS 3456
#define XB_SPIN_CAP (1u << 18)
#define LAS __attribute__((address_space(3)))

__device__ __forceinline__ unsigned xb_ld(unsigned* p)              { return __hip_atomic_load(p, __ATOMIC_RELAXED, __HIP_MEMORY_SCOPE_AGENT); }
__device__ __forceinline__ unsigned xb_add(unsigned* p, unsigned v) { return __hip_atomic_fetch_add(p, v, __ATOMIC_RELAXED, __HIP_MEMORY_SCOPE_AGENT); }
__device__ __forceinline__ unsigned xb_xcc_id() { return (unsigned)__builtin_amdgcn_s_getreg((3 << 11) | 20) & 0xFu; }
#define XB_SPIN(cond, bar) do { unsigned _sp = 0; while (cond) { __builtin_amdgcn_s_sleep(1); \
    if ((++_sp & 255u) == 0u) { if (xb_ld(&(bar)[XB_TMO])) break; if (_sp > XB_SPIN_CAP) { atomicAdd(&(bar)[XB_TMO], 1u); break; } } } } while (0)

struct XcdBarrier {
    unsigned* bar; unsigned x;
    volatile LAS unsigned* st;
};

__device__ __forceinline__ XcdBarrier xcd_barrier_post(unsigned* bar, volatile LAS unsigned* st) {
    XcdBarrier b; b.bar = bar; b.x = xb_xcc_id(); b.st = st;
    if (threadIdx.x == 0) (void)xb_add(&bar[XB_XCNT(b.x)], 1u);
    return b;
}
__device__ __forceinline__ void xcd_barrier_complete(unsigned* bar, unsigned x, unsigned& nloc, unsigned& nx) {
    const unsigned G = gridDim.x * gridDim.y * gridDim.z;
    unsigned sum, cnt, mine, sp = 0u;
    for (;;) {
        sum = 0u; cnt = 0u; mine = 0u;
#pragma unroll
        for (unsigned j = 0; j < 16; ++j) { const unsigned c = xb_ld(&bar[XB_XCNT(j)]); sum += c; cnt += (c > 0u) ? 1u : 0u; mine = (j == x) ? c : mine; }
        if (sum == G) break;
        __builtin_amdgcn_s_sleep(1);
        if ((++sp & 255u) == 0u) { if (xb_ld(&bar[XB_TMO])) break; if (sp > XB_SPIN_CAP) { atomicAdd(&bar[XB_TMO], 1u); break; } }
    }
    nloc = mine > 0u ? mine : 1u; nx = cnt > 0u ? cnt : 1u;
}

__device__ __forceinline__ void xcd_barrier(unsigned* b_bar, unsigned b_x, volatile LAS unsigned* b_st) {
    asm volatile("s_waitcnt vmcnt(0)" ::: "memory");
    __syncthreads();
    if (threadIdx.x == 0) {
        unsigned* bar = b_bar;
        __builtin_amdgcn_s_waitcnt(0);
        unsigned nloc = b_st[0], nx = b_st[1];
        if (nloc == 0u) { xcd_barrier_complete(bar, b_x, nloc, nx); b_st[0] = nloc; b_st[1] = nx; }
        const unsigned old = xb_add(&bar[XB_XSUB(b_x)], 1u);
        const unsigned gen = old / nloc;
        if (old + 1u == (gen + 1u) * nloc) {
            __builtin_amdgcn_fence(__ATOMIC_RELEASE, "agent");
            asm volatile("s_waitcnt vmcnt(0)" ::: "memory");
            const unsigned og = xb_add(&bar[XB_TOP], 1u);
            const unsigned tg = og / nx;
            if (og + 1u == (tg + 1u) * nx) xb_add(&bar[XB_TOPGEN], 1u);
            else XB_SPIN(xb_ld(&bar[XB_TOPGEN]) == tg, bar);
            __builtin_amdgcn_fence(__ATOMIC_ACQUIRE, "agent");
            xb_add(&bar[XB_XGEN(b_x)], 1u);
            asm volatile("s_waitcnt vmcnt(0)" ::: "memory");
        } else {
            XB_SPIN(xb_ld(&bar[XB_XGEN(b_x)]) == gen, bar);
            __builtin_amdgcn_fence(__ATOMIC_ACQUIRE, "agent");
            asm volatile("s_waitcnt vmcnt(0)" ::: "memory");
        }
    }
    __syncthreads();
}

__device__ __forceinline__ void gbar(unsigned* ctr, unsigned& gen, int G) {
    __syncthreads();
    gen += (unsigned)G;
    if (threadIdx.x == 0) {
        __threadfence();
        __hip_atomic_fetch_add(ctr, 1u, __ATOMIC_RELAXED, __HIP_MEMORY_SCOPE_AGENT);
        while (__hip_atomic_load(ctr, __ATOMIC_RELAXED, __HIP_MEMORY_SCOPE_AGENT) < gen) __builtin_amdgcn_s_sleep(1);
        __threadfence();
    }
    __syncthreads();
}
typedef const Params __attribute__((address_space(4))) KParams;
#define KP4 __attribute__((address_space(4)))
__device__ __forceinline__ Params fresh_params() {
#if defined(__HIP_DEVICE_COMPILE__)
    KParams* kp = (KParams*)__builtin_amdgcn_kernarg_segment_ptr();
    asm volatile("" : "+s"(kp));
    Params r;
    const float* KP4 const* src = (const float* KP4 const*)kp;
    const float** dst = (const float**)&r;
#pragma unroll
    for (int i = 0; i < 28; ++i) dst[i] = src[i];
    return r;
#else
    return Params{};
#endif
}
__global__ void __launch_bounds__(NTHR) mega(Params p_unused) {
    extern __shared__ __attribute__((aligned(16))) unsigned char lds[];
    cg::grid_group grid = cg::this_grid();
    const int G = gridDim.x, bid = blockIdx.x;
    volatile LAS unsigned* xst = (volatile LAS unsigned*)((LAS unsigned char*)lds + (LDS_BYTES - 16));
    if (threadIdx.x == 0) { xst[0] = 0u; xst[1] = 0u; }
    __syncthreads();
    unsigned* xbar; unsigned xx;
    { const Params p = fresh_params(); xbar = (unsigned*)(p.ws + OFF_BAR); xx = xb_xcc_id(); if (threadIdx.x == 0) (void)xb_add(&xbar[XB_XCNT(xx)], 1u); }
    { const Params p = fresh_params(); phase0(p); }
    grid.sync();
#pragma unroll 1
    for (int l = 0; l < 2; ++l) {
        { const Params p = fresh_params(); phase_weights(p, l, lds); __syncthreads(); phase_filter_gen(p, l, lds); }
        xcd_barrier(xbar, xx, xst);
        {
            const Params p = fresh_params();
            phase_filter_fft(p, l, lds);
            const bf16_t* WtKV = (const bf16_t*)(p.ws + OFF_WTKV); const bf16_t* membf = (const bf16_t*)(p.ws + OFF_MEMBF);
            for (int t = bid; t < 64; t += G) {
                f32x4 acc[4][4];
                if (t < 32) {
                    const int m0 = (t >> 2) * 256, n0 = (t & 3) * 128;
                    gemm_core(acc, membf + (size_t)m0 * 1024, 1024, WtKV + (size_t)n0 * 1024, 1024, 1024, lds);
                    bf16_t* Km = (bf16_t*)(p.ws + OFF_KMAT);
                    EPI_LOOP(st_bf4(Km + (size_t)row * 512 + col, v);)
                } else {
                    const int t2 = t - 32, m0 = (t2 >> 4) * 256, n0 = (t2 & 15) * 128;
                    gemm_core(acc, WtKV + (size_t)(512 + m0) * 1024, 1024, membf + (size_t)n0 * 1024, 1024, 1024, lds);
                    bf16_t* Vm = (bf16_t*)(p.ws + OFF_VT);
                    EPI_LOOP(st_bf4(Vm + (size_t)row * 2048 + col, v);)
                }
            }
        }
        xcd_barrier(xbar, xx, xst);
#pragma unroll 1
        for (int g = 0; g < NGRP; ++g) {
            const size_t tok0 = (size_t)g * TG;
#pragma unroll 1
            for (int rep = 0; rep < PROBE_REP_INPROJ; ++rep) {
                const Params p = fresh_params();
                pg8::Gemm gm; gm.A = (const bf16_t*)(p.ws + OFF_HB) + tok0 * 1024; gm.Bt = (const bf16_t*)(p.ws + OFF_WTIN); gm.M = TG; gm.N = NINP; gm.K = 1024;
                pg8::StaticOrder S; S.init(TG, NINP, G, bid);
                EpiInProj E; E.P = (bf16_t*)(p.ws + OFF_P); E.bias = p.b_in + (size_t)l * NIN; E.LR = (float*)(p.ws + OFF_LR);
                pg8::gemm_phase<EpiInProj, pg8::StaticOrder, false>((PG8_LAS unsigned char*)lds, gm, S, E, nullptr);
                __syncthreads();
            }
            xcd_barrier(xbar, xx, xst);
#pragma unroll 1
            for (int rep = 0; rep < PROBE_REP_MIX; ++rep) {
            int dry = (rep + 1 < PROBE_REP_MIX) ? 1 : 0; asm volatile("" : "+s"(dry));
            {
                const Params p = fresh_params();
                bf16_t* P = (bf16_t*)(p.ws + OFF_P);
                for (int it = bid; it < BG * 64 * 8; it += G) na_item(p, l, P, it >> 9, (it >> 3) & 63, it & 7, lds, dry);
            }
            {
                const Params p = fresh_params();
                bf16_t* P = (bf16_t*)(p.ws + OFF_P);
                for (int it = bid; it < BG * 128 * 8; it += G) hy_pre_item(p, l, P, (bf16_t*)(p.ws + OFF_UT), (bf16_t*)(p.ws + OFF_GT), it >> 10, (it >> 3) & 127, it & 7, lds);
            }
            {
                const Params p = fresh_params();
                for (int it = bid; it < NITEM; it += G) gla_part1_item(p, l, (const bf16_t*)(p.ws + OFF_P), (const float*)(p.ws + OFF_LR), it, lds);
            }
            {
                const Params p = fresh_params();
                bf16_t* P = (bf16_t*)(p.ws + OFF_P);
                const int nit = BG * 4 * 64, per = (nit + G - 1) / G;
                int last = -1;
                for (int it = bid * per; it < min(nit, (bid + 1) * per); ++it) {
                    const int bh = it >> 6, bl = bh >> 2, h = bh & 3;
                    if (bh != last) { __syncthreads(); memattn_load(p, g * BG + bl, h, lds); last = bh; }
                    memattn_item(P, bl, h, it & 63, lds, dry);
                }
                __syncthreads();
            }
            xcd_barrier(xbar, xx, xst);
            {
                const Params p = fresh_params();
                const float2* twl = fft_lds_twiddles((const float2*)(p.ws + OFF_TW), lds);
                for (int it = bid; it < BG * 256; it += G) hyena_conv_item(p, (const bf16_t*)(p.ws + OFF_UT), (bf16_t*)(p.ws + OFF_GT), it >> 8, it & 255, lds, twl, dry);
                __syncthreads();
                gla_scan(p, dry);
            }
            xcd_barrier(xbar, xx, xst);
            {
                const Params p = fresh_params();
                for (int it = bid; it < NITEM; it += G) gla_part2_item(p, l, (bf16_t*)(p.ws + OFF_P), (const float*)(p.ws + OFF_LR), it, lds, dry);
            }
            {
                const Params p = fresh_params();
                for (int it = bid; it < BG * 128 * 8; it += G) hy_post_item((bf16_t*)(p.ws + OFF_P), (const bf16_t*)(p.ws + OFF_GT), it >> 10, (it >> 3) & 127, it & 7, lds, dry);
            }
            xcd_barrier(xbar, xx, xst);
            }
            {
                const Params p = fresh_params();
                const bf16_t* P = (const bf16_t*)(p.ws + OFF_P); const bf16_t* WtBr = (const bf16_t*)(p.ws + OFF_WTBR); bf16_t* merged = (bf16_t*)(p.ws + OFF_MERGED);
                for (int t = bid; t < 512; t += G) {
                    const int sr = t >> 8, sb = t & 255, sx = sb & 7, sk = sb >> 3;
                    const int m0 = (sr * 32 + (sk >> 3) * 8 + sx) * 256, n0 = (sk & 7) * 128;
                    merge_tile(P, WtBr, merged, m0, n0, lds);
                }
            }
            xcd_barrier(xbar, xx, xst);
            {
                const Params p = fresh_params();
                pg8::Gemm gm; gm.A = (const bf16_t*)(p.ws + OFF_MERGED); gm.Bt = (const bf16_t*)(p.ws + OFF_WTOUT); gm.M = TG; gm.N = 1024; gm.K = 1024;
                pg8::StaticOrder S; S.init(TG, 1024, G, bid);
                EpiOut E; E.pre = (bf16_t*)(p.ws + OFF_PRE); E.bo = p.b_out + l * 1024;
                pg8::gemm_phase<EpiOut, pg8::StaticOrder, false>((PG8_LAS unsigned char*)lds, gm, S, E, nullptr);
                __syncthreads();
            }
            xcd_barrier(xbar, xx, xst);
            {
                const Params p = fresh_params();
                ln_rows_res(p, l, tok0);
            }
        }
        xcd_barrier(xbar, xx, xst);
    }
}

extern "C" void kernel_launch(void* const* d_in, const int* in_sizes, int n_in, void* d_out, int out_size, void* d_ws, size_t ws_size, hipStream_t stream) {
    static int grid_blocks = 0;
    if (!grid_blocks) {
        if (ws_size < WS_END) { fprintf(stderr, "kernel_launch: workspace too small: %zu < %zu\n", ws_size, (size_t)WS_END); grid_blocks = -1; return; }
        {
            const long long ex[26] = {67108864LL, 2097152LL, 1024, 1024, 2LL * 1024 * 10784, 2 * 10784, 2 * 8 * 15 * 31, 2 * 3 * 1536, 2 * 1536, 2 * 33 * 64, 2 * 64, 2 * 2 * 64 * 64, 2 * 2 * 64,
                                      2 * 64 * 1024, 2 * 512, 2 * 16 * 256, 2 * 256, 2 * 16 * 256, 2 * 256, 2 * 512, 2LL * 1024 * 1024, 2LL * 4 * 512 * 1024, 2LL * 1024 * 1024, 2 * 1024, 2 * 1024, 2 * 1024};
            bool bad = (n_in != 26) || (out_size != 67108864);
            for (int i = 0; i < 26 && !bad; ++i) if ((long long)in_sizes[i] != ex[i]) { fprintf(stderr, "kernel_launch: input %d has %d elements, expected %lld\n", i, in_sizes[i], ex[i]); bad = true; }
            if (bad) { fprintf(stderr, "kernel_launch: unexpected shapes; nothing launched\n"); grid_blocks = -1; return; }
        }
        int dev = 0, cus = 0, per_cu = 0;
        hipGetDevice(&dev);
        hipDeviceGetAttribute(&cus, hipDeviceAttributeMultiprocessorCount, dev);
        if (hipFuncSetAttribute((const void*)mega, hipFuncAttributeMaxDynamicSharedMemorySize, LDS_BYTES) != hipSuccess) fprintf(stderr, "kernel_launch: hipFuncSetAttribute failed\n");
        if (hipOccupancyMaxActiveBlocksPerMultiprocessor(&per_cu, (const void*)mega, NTHR, LDS_BYTES) != hipSuccess || per_cu < 1) { fprintf(stderr, "kernel_launch: occupancy query gave %d\n", per_cu); per_cu = 1; }
        (void)hipGetLastError();
        if (per_cu > 1) per_cu = 1;
        grid_blocks = cus * per_cu;
    }
    if (grid_blocks < 0) return;
    Params p{};
    const float** pp = (const float**)&p;
    for (int i = 0; i < 26; ++i) pp[i] = (const float*)d_in[i];
    p.out = (float*)d_out; p.ws = (unsigned char*)d_ws;
    if (hipMemsetAsync((unsigned char*)d_ws + OFF_BAR, 0, 16384, stream) != hipSuccess) fprintf(stderr, "kernel_launch: memset of the barrier word failed\n");
    void* args[] = {&p};
    hipError_t e = hipLaunchCooperativeKernel((const void*)mega, dim3(grid_blocks), dim3(NTHR), args, LDS_BYTES, stream);
    if (e != hipSuccess) fprintf(stderr, "cooperative launch failed: %s (grid %d)\n", hipGetErrorString(e), grid_blocks);
}
#endif
```

```cpp
#ifndef PROBE_REP_MIX
#define PROBE_REP_MIX 1
#endif
#ifndef PROBE_REP_INPROJ
#define PROBE_REP_INPROJ 1
#endif
#include <hip/hip_runtime.h>
#include <hip/hip_cooperative_groups.h>
#include <cstdio>
#include <unistd.h>
#include <cmath>
namespace cg = cooperative_groups;

#define HD __host__ __device__
typedef unsigned short bf16_t;
typedef short bf16x8 __attribute__((ext_vector_type(8)));
typedef float f32x4 __attribute__((ext_vector_type(4)));
typedef unsigned u32x2 __attribute__((ext_vector_type(2)));
typedef unsigned u32x4 __attribute__((ext_vector_type(4)));

constexpr int NTOK = 65536, DM = 1024, SEQ = 8192, NB = 8;
constexpr int BG = 2;
constexpr int NGRP = NB / BG;
constexpr int TG = BG * SEQ;
constexpr int PS = 10752;
constexpr int NIN = 10784, NINP = 11008;
constexpr int C_NAQ = 0, C_NAK = 512, C_NAV = 1024, C_HY = 1536, C_GQ = 3072, C_GK = 3328, C_GV = 3584, C_MQ = 4096, C_Z = 4608, C_SG = 6656, C_LR = 10752;
constexpr int FN = 16384;
constexpr int NITEM = BG * 128 * 4;
constexpr int LDS_BYTES = 160 * 1024;
constexpr int NTHR = 512;
constexpr float DN_ALPHA = 1.41421356237309515f;

constexpr size_t al256(size_t x) { return (x + 255) & ~(size_t)255; }
constexpr size_t OFF_HB = 0;
constexpr size_t OFF_STATS = OFF_HB + (size_t)NTOK * DM * 2;
constexpr size_t OFF_TW = OFF_STATS + (size_t)NTOK * 8;
constexpr size_t OFF_MEMBF = OFF_TW + (size_t)FN * 8;
constexpr size_t OFF_ENERGY = OFF_MEMBF + (size_t)2048 * 1024 * 2;
constexpr size_t OFF_WTIN = OFF_ENERGY + 4096;
constexpr size_t OFF_WTBR = OFF_WTIN + (size_t)NINP * 1024 * 2;
constexpr size_t OFF_WTOUT = OFF_WTBR + (size_t)4 * 1024 * 512 * 2;
constexpr size_t OFF_WTKV = OFF_WTOUT + (size_t)1024 * 1024 * 2;
constexpr size_t OFF_KMAT = OFF_WTKV + (size_t)2048 * 1024 * 2;
constexpr size_t OFF_VT = OFF_KMAT + (size_t)2048 * 1024 * 2;
constexpr size_t OFF_HFILT = OFF_VT + (size_t)2048 * 1024 * 2;
constexpr size_t OFF_PQ = OFF_HFILT + (size_t)1024 * 8192 * 4;
constexpr size_t OFF_P = OFF_PQ + (size_t)256 * FN * 16;
constexpr size_t OFF_LR = OFF_P + (size_t)TG * PS * 2;
constexpr size_t OFF_GS = OFF_LR + (size_t)TG * 32 * 4;
constexpr size_t OFF_GDEC = OFF_GS + (size_t)2 * NITEM * 8192 * 4;
constexpr size_t OFF_MERGED = OFF_GDEC + (size_t)2 * NITEM * 64 * 4;
constexpr size_t OFF_PRE = OFF_MERGED + (size_t)TG * 1024 * 2;
constexpr size_t OFF_UT = OFF_PRE + (size_t)TG * 1024 * 4;
constexpr size_t OFF_GT = OFF_UT + (size_t)BG * 512 * 8192 * 4;
constexpr size_t OFF_BAR = OFF_GT + (size_t)BG * 512 * 8192 * 2;
constexpr size_t OFF_ZT = OFF_BAR + 16384;
constexpr size_t OFF_TB = al256(OFF_ZT + (size_t)8192 * 33 * 4);
constexpr size_t OFF_SB = OFF_TB + (size_t)NITEM * 8192 * 4;
constexpr size_t WS_END = OFF_SB + (size_t)2 * NITEM * 8192 * 2;

struct Params {
    const float *x, *mem, *ln_in_g, *ln_in_b, *w_in, *b_in, *na_rpb, *hy_conv_w, *hy_conv_b, *hy_w1, *hy_b1, *hy_wm, *hy_bm, *hy_w3, *hy_skip,
        *gla_up_f, *gla_bias_f, *gla_up_b, *gla_bias_b, *gla_norm_g, *mem_w_kv, *w_br, *w_out, *b_out, *ln_g, *ln_b;
    float* out;
    unsigned char* ws;
};

HD inline float bf2f(bf16_t b) {
    union { unsigned u; float f; } c; c.u = (unsigned)b << 16; return c.f;
}
HD inline bf16_t f2bf(float f) {
    union { unsigned u; float f; } c; c.f = f; unsigned u = c.u; u += 0x7fffu + ((u >> 16) & 1u); return (bf16_t)(u >> 16);
}
typedef float f32x2_t __attribute__((ext_vector_type(2)));
typedef __bf16 bf16x2_t __attribute__((ext_vector_type(2)));
__device__ __forceinline__ unsigned pk2(float lo, float hi) { const f32x2_t v = {lo, hi}; const bf16x2_t b = __builtin_convertvector(v, bf16x2_t); return __builtin_bit_cast(unsigned, b); }
__device__ __forceinline__ bf16_t f2bf_d(float f) { return (bf16_t)(pk2(f, f) & 0xffffu); }
__device__ __forceinline__ float lo16(unsigned u) { return __uint_as_float(u << 16); }
__device__ __forceinline__ float hi16(unsigned u) { return __uint_as_float(u & 0xffff0000u); }
__device__ __forceinline__ float wave_sum(float v) {
#pragma unroll
    for (int o = 32; o >= 1; o >>= 1) v += __shfl_xor(v, o);
    return v;
}
__device__ __forceinline__ float sigmoidf_(float x) { return __builtin_amdgcn_rcpf(1.0f + __expf(-x)); }
__device__ __forceinline__ float siluf_(float x) { return x * __builtin_amdgcn_rcpf(1.0f + __expf(-x)); }
__device__ __forceinline__ float logsigf_(float x) { return fminf(x, 0.0f) - __logf(1.0f + __expf(-fabsf(x))); }
__device__ __forceinline__ bf16x8 mkfrag(u32x4 v) { return __builtin_bit_cast(bf16x8, v); }
__device__ __forceinline__ bf16x8 mkfrag2(u32x2 a, u32x2 b) { u32x4 v = {a.x, a.y, b.x, b.y}; return __builtin_bit_cast(bf16x8, v); }
#define MFMA(a, b, c) __builtin_amdgcn_mfma_f32_16x16x32_bf16((a), (b), (c), 0, 0, 0)
HD inline int iclamp(int v, int lo, int hi) { return v < lo ? lo : (v > hi ? hi : v); }

HD inline float2 cmulf(float2 a, float2 b) { float2 r; r.x = a.x * b.x - a.y * b.y; r.y = a.x * b.y + a.y * b.x; return r; }
HD inline float2 cmulcf(float2 a, float2 b) { float2 r; r.x = a.x * b.x + a.y * b.y; r.y = a.y * b.x - a.x * b.y; return r; }
struct Bfly { float2 x0, x1, x2, x3, W1; int i0; };
HD inline void bfly_load(Bfly& b, const float2* d, const float2* tw, int lgm, int q) {
    const int m = 1 << lgm, blk = q >> lgm, j = q & (m - 1);
    b.i0 = (blk << (lgm + 2)) + j;
    b.W1 = tw[j];
    b.x0 = d[b.i0]; b.x1 = d[b.i0 + m]; b.x2 = d[b.i0 + 2 * m]; b.x3 = d[b.i0 + 3 * m];
}
HD inline void bfly_fwd_store(const Bfly& b, float2* d, int lgm) {
    const int m = 1 << lgm, i0 = b.i0;
    const float2 W1 = b.W1, W2 = cmulf(W1, W1);
    const float2 x0 = b.x0, x1 = b.x1, x2 = b.x2, x3 = b.x3;
    float2 a0, a1, a2, a3, t;
    a0.x = x0.x + x2.x; a0.y = x0.y + x2.y;
    t.x = x0.x - x2.x; t.y = x0.y - x2.y; a2 = cmulf(t, W1);
    a1.x = x1.x + x3.x; a1.y = x1.y + x3.y;
    t.x = x1.x - x3.x; t.y = x1.y - x3.y; t = cmulf(t, W1); a3.x = t.y; a3.y = -t.x;
    float2 r;
    r.x = a0.x + a1.x; r.y = a0.y + a1.y; d[i0] = r;
    t.x = a0.x - a1.x; t.y = a0.y - a1.y; d[i0 + m] = cmulf(t, W2);
    r.x = a2.x + a3.x; r.y = a2.y + a3.y; d[i0 + 2 * m] = r;
    t.x = a2.x - a3.x; t.y = a2.y - a3.y; d[i0 + 3 * m] = cmulf(t, W2);
}
HD inline void bfly_inv_store(const Bfly& b, float2* d, int lgm) {
    const int m = 1 << lgm, i0 = b.i0;
    const float2 W1 = b.W1, W2 = cmulf(W1, W1);
    const float2 x0 = b.x0, x1 = b.x1, x2 = b.x2, x3 = b.x3;
    const float2 b1 = cmulcf(x1, W2), b3 = cmulcf(x3, W2);
    float2 y0, y1, y2, y3;
    y0.x = x0.x + b1.x; y0.y = x0.y + b1.y; y1.x = x0.x - b1.x; y1.y = x0.y - b1.y;
    y2.x = x2.x + b3.x; y2.y = x2.y + b3.y; y3.x = x2.x - b3.x; y3.y = x2.y - b3.y;
    const float2 c2 = cmulcf(y2, W1); float2 c3 = cmulcf(y3, W1); { const float tx = -c3.y, ty = c3.x; c3.x = tx; c3.y = ty; }
    float2 r;
    r.x = y0.x + c2.x; r.y = y0.y + c2.y; d[i0] = r;
    r.x = y0.x - c2.x; r.y = y0.y - c2.y; d[i0 + 2 * m] = r;
    r.x = y1.x + c3.x; r.y = y1.y + c3.y; d[i0 + m] = r;
    r.x = y1.x - c3.x; r.y = y1.y - c3.y; d[i0 + 3 * m] = r;
}
HD inline void fft_fwd_bfly(float2* d, const float2* tw, int lgm, int q) { Bfly b; bfly_load(b, d, tw, lgm, q); bfly_fwd_store(b, d, lgm); }
HD inline void fft_inv_bfly(float2* d, const float2* tw, int lgm, int q) { Bfly b; bfly_load(b, d, tw, lgm, q); bfly_inv_store(b, d, lgm); }
HD inline void r4_fwd(float2& x0, float2& x1, float2& x2, float2& x3, const float2 W1) {
    const float2 W2 = cmulf(W1, W1);
    float2 a0, a1, a2, a3, t;
    a0.x = x0.x + x2.x; a0.y = x0.y + x2.y;
    t.x = x0.x - x2.x; t.y = x0.y - x2.y; a2 = cmulf(t, W1);
    a1.x = x1.x + x3.x; a1.y = x1.y + x3.y;
    t.x = x1.x - x3.x; t.y = x1.y - x3.y; t = cmulf(t, W1); a3.x = t.y; a3.y = -t.x;
    x0.x = a0.x + a1.x; x0.y = a0.y + a1.y;
    t.x = a0.x - a1.x; t.y = a0.y - a1.y; x1 = cmulf(t, W2);
    x2.x = a2.x + a3.x; x2.y = a2.y + a3.y;
    t.x = a2.x - a3.x; t.y = a2.y - a3.y; x3 = cmulf(t, W2);
}
HD inline void r4_inv(float2& x0, float2& x1, float2& x2, float2& x3, const float2 W1) {
    const float2 W2 = cmulf(W1, W1);
    const float2 b1 = cmulcf(x1, W2), b3 = cmulcf(x3, W2);
    float2 y0, y1, y2, y3;
    y0.x = x0.x + b1.x; y0.y = x0.y + b1.y; y1.x = x0.x - b1.x; y1.y = x0.y - b1.y;
    y2.x = x2.x + b3.x; y2.y = x2.y + b3.y; y3.x = x2.x - b3.x; y3.y = x2.y - b3.y;
    const float2 c2 = cmulcf(y2, W1); float2 c3 = cmulcf(y3, W1); { const float tx = -c3.y, ty = c3.x; c3.x = tx; c3.y = ty; }
    x0.x = y0.x + c2.x; x0.y = y0.y + c2.y; x2.x = y0.x - c2.x; x2.y = y0.y - c2.y;
    x1.x = y1.x + c3.x; x1.y = y1.y + c3.y; x3.x = y1.x - c3.x; x3.y = y1.y - c3.y;
}
template <bool INV, bool HALF>
HD inline void r16_bfly(float2* d, const float2* twO, const float2* twI, int lgm, int q) {
    const int m = 1 << lgm, blk = q >> lgm, j = q & (m - 1), base = (blk << (lgm + 4)) + j;
    float2 e[4][4];
#pragma unroll
    for (int a = 0; a < 4; ++a)
#pragma unroll
        for (int b = 0; b < 4; ++b) {
            if (!INV && HALF && a >= 2) { e[a][b].x = 0.f; e[a][b].y = 0.f; }
            else e[a][b] = d[base + ((4 * a + b) << lgm)];
        }
    const float2 wI = twI[j];
    float2 wO[4];
#pragma unroll
    for (int b = 0; b < 4; ++b) wO[b] = twO[j + (b << lgm)];
    if (!INV) {
#pragma unroll
        for (int b = 0; b < 4; ++b) r4_fwd(e[0][b], e[1][b], e[2][b], e[3][b], wO[b]);
#pragma unroll
        for (int a = 0; a < 4; ++a) r4_fwd(e[a][0], e[a][1], e[a][2], e[a][3], wI);
    } else {
#pragma unroll
        for (int a = 0; a < 4; ++a) r4_inv(e[a][0], e[a][1], e[a][2], e[a][3], wI);
#pragma unroll
        for (int b = 0; b < 4; ++b) r4_inv(e[0][b], e[1][b], e[2][b], e[3][b], wO[b]);
    }
#pragma unroll
    for (int a = 0; a < 4; ++a)
#pragma unroll
        for (int b = 0; b < 4; ++b)
            if (!(INV && HALF && a >= 2)) d[base + ((4 * a + b) << lgm)] = e[a][b];
}
HD inline int brev14(int k) {
#if defined(__HIP_DEVICE_COMPILE__)
    return (int)(__brev((unsigned)k) >> 18);
#endif
    unsigned v = (unsigned)k;
    v = ((v >> 1) & 0x55555555u) | ((v & 0x55555555u) << 1);
    v = ((v >> 2) & 0x33333333u) | ((v & 0x33333333u) << 2);
    v = ((v >> 4) & 0x0f0f0f0fu) | ((v & 0x0f0f0f0fu) << 4);
    v = ((v >> 8) & 0x00ff00ffu) | ((v & 0x00ff00ffu) << 8);
    v = (v >> 16) | (v << 16);
    return (int)(v >> 18);
}
struct PwIn { float2 Z1, Z2; float4 A, B; int p1, p2; };
HD inline void pw_load(PwIn& w, const float2* d, const float4* pq, int p1) {
    const int kf = brev14(p1), k2 = (FN - kf) & (FN - 1); w.p1 = p1; w.p2 = brev14(k2);
    w.Z1 = d[w.p1]; w.Z2 = d[w.p2]; w.A = pq[(p1 & 1) ? (FN / 2) : (p1 >> 1)];   w.B.x = w.A.x; w.B.y = -w.A.y; w.B.z = w.A.z; w.B.w = -w.A.w;
}
HD inline void pw_store(const PwIn& w, float2* d) {
    const float2 Z1 = w.Z1, Z2 = w.Z2;
    float2 P1, Q1, P2, Q2; P1.x = w.A.x; P1.y = w.A.y; Q1.x = w.A.z; Q1.y = w.A.w; P2.x = w.B.x; P2.y = w.B.y; Q2.x = w.B.z; Q2.y = w.B.w;
    float2 c1, c2; c1.x = Z1.x; c1.y = -Z1.y; c2.x = Z2.x; c2.y = -Z2.y;
    const float2 a = cmulf(Z1, P1), b = cmulf(c2, Q1), c = cmulf(Z2, P2), e = cmulf(c1, Q2);
    float2 w1, w2; w1.x = a.x + b.x; w1.y = a.y + b.y; w2.x = c.x + e.x; w2.y = c.y + e.y;
    d[w.p1] = w1;
    if (w.p2 != w.p1) d[w.p2] = w2;
}
HD inline void conv_pointwise(float2* d, const float4* pq, int p1) { PwIn w; pw_load(w, d, pq, p1); pw_store(w, d); }
HD inline void filt_pointwise(const float2* d, float4* pq, int p1) {
    const int kf = brev14(p1), k2 = (FN - kf) & (FN - 1), p2 = brev14(k2);
    const float2 Z1 = d[p1], Z2 = d[p2];
    const float gcx = 0.5f * (Z1.x + Z2.x), gcy = 0.5f * (Z1.y - Z2.y);
    const float gdx = 0.5f * (Z1.y + Z2.y), gdy = -0.5f * (Z1.x - Z2.x);
    const float s = 0.5f / (float)FN;
    float4 A; A.x = s * (gcx + gdx); A.y = s * (gcy + gdy); A.z = s * (gcx - gdx); A.w = s * (gcy - gdy);
    pq[(p1 & 1) ? (FN / 2) : (p1 >> 1)] = A;
}
HD inline int tw_off(int lgm) { return lgm == 10 ? 0 : lgm == 8 ? 1024 : lgm == 6 ? 1280 : lgm == 4 ? 1344 : lgm == 2 ? 1360 : 1364; }
#ifndef FFT_HOST_TEST
template <int LGM, bool INV>
__device__ __forceinline__ void fft_pass(float2* d, const float2* twl, const float2* twg, int tid) {
    const float2* tw = (LGM == 12) ? twg : twl + tw_off(LGM);
#pragma unroll
    for (int it = 0; it < 2; ++it) {
        const int q = tid + it * 4 * NTHR;
        Bfly b0, b1, b2, b3;
        bfly_load(b0, d, tw, LGM, q); bfly_load(b1, d, tw, LGM, q + NTHR); bfly_load(b2, d, tw, LGM, q + 2 * NTHR); bfly_load(b3, d, tw, LGM, q + 3 * NTHR);
        if (INV) { bfly_inv_store(b0, d, LGM); bfly_inv_store(b1, d, LGM); bfly_inv_store(b2, d, LGM); bfly_inv_store(b3, d, LGM); }
        else { bfly_fwd_store(b0, d, LGM); bfly_fwd_store(b1, d, LGM); bfly_fwd_store(b2, d, LGM); bfly_fwd_store(b3, d, LGM); }
    }
    __syncthreads();
}
template <int LGM, bool INV, bool HALF>
__device__ __forceinline__ void fft_pass16(float2* d, const float2* twl, const float2* twg, int tid) {
    const float2* twO = (LGM + 2 == 12) ? twg : twl + tw_off(LGM + 2);
    const float2* twI = twl + tw_off(LGM);
    r16_bfly<INV, HALF>(d, twO, twI, LGM, tid);
    r16_bfly<INV, HALF>(d, twO, twI, LGM, tid + NTHR);
    __syncthreads();
}
template <bool HALF>
__device__ __forceinline__ void fft_forward(float2* d, const float2* twl, const float2* twg) {
    int tid = threadIdx.x; asm volatile("" : "+v"(tid));
    fft_pass16<10, false, HALF>(d, twl, twg, tid); fft_pass16<6, false, false>(d, twl, twg, tid);
    fft_pass<4, false>(d, twl, twg, tid); fft_pass<2, false>(d, twl, twg, tid); fft_pass<0, false>(d, twl, twg, tid);
}
template <bool HALF>
__device__ __forceinline__ void fft_inverse(float2* d, const float2* twl, const float2* twg) {
    int tid = threadIdx.x; asm volatile("" : "+v"(tid));
    fft_pass<0, true>(d, twl, twg, tid); fft_pass<2, true>(d, twl, twg, tid); fft_pass<4, true>(d, twl, twg, tid);
    fft_pass16<6, true, false>(d, twl, twg, tid); fft_pass16<10, true, HALF>(d, twl, twg, tid);
}
__device__ __forceinline__ float2* fft_lds_twiddles(const float2* twg, unsigned char* lds) {
    int tid = threadIdx.x; asm volatile("" : "+v"(tid));
    float2* t = (float2*)(lds + 131072);
    for (int k = tid; k < 1365; k += NTHR) {
        const int lgm = k < 1024 ? 10 : k < 1280 ? 8 : k < 1344 ? 6 : k < 1360 ? 4 : k < 1364 ? 2 : 0;
        t[k] = twg[(k - tw_off(lgm)) << (12 - lgm)];
    }
    __syncthreads();
    return t;
}

constexpr int STG = 49152;
__device__ __forceinline__ int swz(int row, int ch) { return row * 128 + ((ch ^ ((row >> 1) & 7)) << 4); }
__device__ __forceinline__ void gemm_core(f32x4 (&acc)[4][4], const bf16_t* A, int lda, const bf16_t* Bt, int ldb, int K, unsigned char* lds) {
    int tid_ = threadIdx.x; asm volatile("" : "+v"(tid_)); const int tid = tid_, lane = tid & 63, w = tid >> 6, wm = w & 3, wn = w >> 2, l15 = lane & 15, q4 = lane >> 4;
    const int wu = __builtin_amdgcn_readfirstlane(w);
    __attribute__((address_space(3))) unsigned char* l3 = (__attribute__((address_space(3))) unsigned char*)lds;
#pragma unroll
    for (int mi = 0; mi < 4; ++mi)
#pragma unroll
        for (int ni = 0; ni < 4; ++ni) acc[mi][ni] = (f32x4){0.f, 0.f, 0.f, 0.f};
    const int r8 = lane >> 3, sch = (lane & 7) ^ ((((w & 1) << 2) + (r8 >> 1)) & 7);
    const bf16_t* ap = A + (size_t)(w * 8 + r8) * lda + sch * 8;
    const bf16_t* bp = Bt + (size_t)(w * 8 + r8) * ldb + sch * 8;
#define GC_STAGE(buf, k0)                                                                                                                         \
    {                                                                                                                                             \
        _Pragma("unroll") for (int i = 0; i < 4; ++i)                                                                                             \
            __builtin_amdgcn_global_load_lds((const unsigned*)(ap + (size_t)(64 * i) * lda + (k0)), (__attribute__((address_space(3))) unsigned*)(l3 + (buf) * STG + (wu + 8 * i) * 1024), 16, 0, 0);          \
        _Pragma("unroll") for (int i = 0; i < 2; ++i)                                                                                             \
            __builtin_amdgcn_global_load_lds((const unsigned*)(bp + (size_t)(64 * i) * ldb + (k0)), (__attribute__((address_space(3))) unsigned*)(l3 + (buf) * STG + 32768 + (wu + 8 * i) * 1024), 16, 0, 0);  \
    }
    GC_STAGE(0, 0)
    asm volatile("s_waitcnt vmcnt(0)" ::: "memory");
    __syncthreads();
    const int nk = K >> 6;
    for (int kt = 0; kt < nk; ++kt) {
        if (kt + 1 < nk) GC_STAGE((kt + 1) & 1, (kt + 1) << 6)
        const unsigned char* sa = lds + (kt & 1) * STG;
        const unsigned char* sb = sa + 32768;
#pragma unroll
        for (int ks = 0; ks < 2; ++ks) {
            bf16x8 af[4], bfr[4];
#pragma unroll
            for (int mi = 0; mi < 4; ++mi) af[mi] = *(const bf16x8*)(sa + swz(wm * 64 + mi * 16 + l15, ks * 4 + q4));
#pragma unroll
            for (int ni = 0; ni < 4; ++ni) bfr[ni] = *(const bf16x8*)(sb + swz(wn * 64 + ni * 16 + l15, ks * 4 + q4));
#pragma unroll
            for (int mi = 0; mi < 4; ++mi)
#pragma unroll
                for (int ni = 0; ni < 4; ++ni) acc[mi][ni] = MFMA(bfr[ni], af[mi], acc[mi][ni]);
        }
        asm volatile("s_waitcnt vmcnt(0)" ::: "memory");
        __syncthreads();
    }
#undef GC_STAGE
}
#define EPI_LOOP(body)                                                                                                  \
    {                                                                                                                   \
        int e_t = threadIdx.x; asm volatile("" : "+v"(e_t)); const int e_lane = e_t & 63, e_w = e_t >> 6;                                                    \
        _Pragma("unroll") for (int mi = 0; mi < 4; ++mi) _Pragma("unroll") for (int ni = 0; ni < 4; ++ni) {             \
            const int row = m0 + (e_w & 3) * 64 + mi * 16 + (e_lane & 15);                                              \
            const int col = n0 + (e_w >> 2) * 64 + ni * 16 + 4 * (e_lane >> 4);                                         \
            f32x4& v = acc[mi][ni];                                                                                     \
            body                                                                                                        \
        }                                                                                                               \
    }
__device__ __forceinline__ void st_bf4(bf16_t* dst, f32x4 v) {
    u32x2 o; o.x = pk2(v[0], v[1]); o.y = pk2(v[2], v[3]); *(u32x2*)dst = o;
}
__device__ __forceinline__ f32x4 ld_bf4(const bf16_t* src) {
    const u32x2 u = *(const u32x2*)src; f32x4 r = {lo16(u.x), hi16(u.x), lo16(u.y), hi16(u.y)}; return r;
}


__device__ __forceinline__ void merge_tile(const bf16_t* P, const bf16_t* WtBr, bf16_t* merged, int m0, int n0, unsigned char* lds) {
    int tid_ = threadIdx.x; asm volatile("" : "+v"(tid_)); const int tid = tid_, lane = tid & 63, w = tid >> 6, wm = w & 3, wn = w >> 2, l15 = lane & 15, q4 = lane >> 4;
    const int wu = __builtin_amdgcn_readfirstlane(w);
    __attribute__((address_space(3))) unsigned char* l3 = (__attribute__((address_space(3))) unsigned char*)lds;
    f32x4 acc[4][4], macc[4][4];
#pragma unroll
    for (int mi = 0; mi < 4; ++mi)
#pragma unroll
        for (int ni = 0; ni < 4; ++ni) { acc[mi][ni] = (f32x4){0.f, 0.f, 0.f, 0.f}; macc[mi][ni] = (f32x4){0.f, 0.f, 0.f, 0.f}; }
    const int r8 = lane >> 3, sch = (lane & 7) ^ ((((w & 1) << 2) + (r8 >> 1)) & 7);
    const bf16_t* ap = P + (size_t)(m0 + w * 8 + r8) * PS + sch * 8;
    const bf16_t* bp = WtBr + (size_t)(n0 + w * 8 + r8) * 512 + sch * 8;
    const bf16_t* sgp = P + (size_t)(m0 + wm * 64 + l15) * PS + C_SG + n0 + wn * 64 + 4 * q4;
#define MG_STAGE(buf, kt_)                                                                                                                        \
    {                                                                                                                                             \
        const int j_ = (kt_) >> 3, k0_ = ((kt_) & 7) << 6;                                                                                        \
        const int acol_ = (j_ == 0) ? C_NAQ : (j_ == 1) ? C_HY : (j_ == 2) ? C_GV : C_MQ;                                                        \
        _Pragma("unroll") for (int i = 0; i < 4; ++i)                                                                                             \
            __builtin_amdgcn_global_load_lds((const unsigned*)(ap + (size_t)(64 * i) * PS + acol_ + k0_), (__attribute__((address_space(3))) unsigned*)(l3 + (buf) * STG + (wu + 8 * i) * 1024), 16, 0, 0);      \
        _Pragma("unroll") for (int i = 0; i < 2; ++i)                                                                                             \
            __builtin_amdgcn_global_load_lds((const unsigned*)(bp + (size_t)j_ * 1024 * 512 + (size_t)(64 * i) * 512 + k0_), (__attribute__((address_space(3))) unsigned*)(l3 + (buf) * STG + 32768 + (wu + 8 * i) * 1024), 16, 0, 0);  \
    }
    MG_STAGE(0, 0)
    MG_STAGE(1, 1)
    asm volatile("s_waitcnt vmcnt(6)" ::: "memory");
    __builtin_amdgcn_s_barrier(); asm volatile("" ::: "memory");
    int cb = 0;
#pragma unroll 1
    for (int kt = 0; kt < 32; ++kt) {
        const bool last = (kt & 7) == 7;
        u32x2 sg[4][4];
        if (last) {
            const bf16_t* sp = sgp + 1024 * (kt >> 3);
#pragma unroll
            for (int mi = 0; mi < 4; ++mi)
#pragma unroll
                for (int ni = 0; ni < 4; ++ni) sg[mi][ni] = *(const u32x2*)(sp + (size_t)(mi * 16) * PS + ni * 16);
        }
        const int nb = (cb == 0) ? 2 : cb - 1;
        if (kt + 2 < 32) MG_STAGE(nb, kt + 2)
        const unsigned char* sa = lds + cb * STG;
        const unsigned char* sb = sa + 32768;
#pragma unroll
        for (int ks = 0; ks < 2; ++ks) {
            bf16x8 af[4], bfr[4];
#pragma unroll
            for (int mi = 0; mi < 4; ++mi) af[mi] = *(const bf16x8*)(sa + swz(wm * 64 + mi * 16 + l15, ks * 4 + q4));
#pragma unroll
            for (int ni = 0; ni < 4; ++ni) bfr[ni] = *(const bf16x8*)(sb + swz(wn * 64 + ni * 16 + l15, ks * 4 + q4));
            __builtin_amdgcn_s_setprio(1);
#pragma unroll
            for (int mi = 0; mi < 4; ++mi)
#pragma unroll
                for (int ni = 0; ni < 4; ++ni) acc[mi][ni] = MFMA(bfr[ni], af[mi], acc[mi][ni]);
            __builtin_amdgcn_s_setprio(0);
        }
        if (kt + 2 < 32) asm volatile("s_waitcnt vmcnt(6)" ::: "memory"); else asm volatile("s_waitcnt vmcnt(0)" ::: "memory");
        if (last) {
#pragma unroll
            for (int mi = 0; mi < 4; ++mi)
#pragma unroll
                for (int ni = 0; ni < 4; ++ni) {
                    const u32x2 u = sg[mi][ni]; const f32x4 g4 = {lo16(u.x), hi16(u.x), lo16(u.y), hi16(u.y)};
                    macc[mi][ni] += g4 * acc[mi][ni]; acc[mi][ni] = (f32x4){0.f, 0.f, 0.f, 0.f};
                }
        }
        asm volatile("" ::: "memory"); __builtin_amdgcn_s_barrier(); asm volatile("" ::: "memory");
        cb = (cb == 2) ? 0 : cb + 1;
    }
#undef MG_STAGE
    __syncthreads();
#pragma unroll
    for (int mi = 0; mi < 4; ++mi)
#pragma unroll
        for (int ni = 0; ni < 4; ++ni) st_bf4(merged + (size_t)(m0 + wm * 64 + mi * 16 + l15) * 1024 + n0 + wn * 64 + ni * 16 + 4 * q4, macc[mi][ni]);
}

__device__ __forceinline__ int orig_col(int n) {
    if (n < 4096) return n;
    if (n < 4608) return n + 32;
    if (n < 6656) return n + 32;
    if (n < 10752) return n + 32;
    return n - 10752 + 4096;
}

__device__ __forceinline__ void ln_rows(const float* src, size_t src_row0, int nrows, const float* g, const float* b, float* dst32, bf16_t* dst16, size_t dst_row0, float2* stats) {
    int tid_ = threadIdx.x; asm volatile("" : "+v"(tid_));
    const int lane = tid_ & 63;
    const int gw = blockIdx.x * (NTHR / 64) + (tid_ >> 6), nw = gridDim.x * (NTHR / 64);
    for (int r = gw; r < nrows; r += nw) {
        const float4* xr = (const float4*)(src + (src_row0 + r) * 1024);
        float4 v[4]; float s = 0.f;
#pragma unroll
        for (int i = 0; i < 4; ++i) { v[i] = xr[lane + 64 * i]; s += (v[i].x + v[i].y) + (v[i].z + v[i].w); }
        s = wave_sum(s);
        const float mean = s * (1.0f / 1024.0f);
        float q = 0.f;
#pragma unroll
        for (int i = 0; i < 4; ++i) { const float a = v[i].x - mean, bb = v[i].y - mean, c = v[i].z - mean, d = v[i].w - mean; q += (a * a + bb * bb) + (c * c + d * d); }
        q = wave_sum(q);
        const float rstd = 1.0f / sqrtf(q * (1.0f / 1024.0f) + 1e-5f);
        if (stats && lane == 0) { float2 st; st.x = mean; st.y = rstd; stats[dst_row0 + r] = st; }
#pragma unroll
        for (int i = 0; i < 4; ++i) {
            const float4 g4 = ((const float4*)g)[lane + 64 * i], b4 = ((const float4*)b)[lane + 64 * i];
            float4 y; y.x = (v[i].x - mean) * rstd * g4.x + b4.x; y.y = (v[i].y - mean) * rstd * g4.y + b4.y; y.z = (v[i].z - mean) * rstd * g4.z + b4.z; y.w = (v[i].w - mean) * rstd * g4.w + b4.w;
            if (dst32) ((float4*)(dst32 + (dst_row0 + r) * 1024))[lane + 64 * i] = y;
            if (dst16) { u32x2 o; o.x = pk2(y.x, y.y); o.y = pk2(y.z, y.w); *(u32x2*)(dst16 + (dst_row0 + r) * 1024 + (lane + 64 * i) * 4) = o; }
        }
    }
}
__device__ __forceinline__ void phase0(const Params& p) {
    ln_rows(p.x, 0, NTOK, p.ln_in_g, p.ln_in_b, nullptr, (bf16_t*)(p.ws + OFF_HB), 0, (float2*)(p.ws + OFF_STATS));
    int tid_ = threadIdx.x; asm volatile("" : "+v"(tid_)); const int gt = blockIdx.x * NTHR + tid_, nt = gridDim.x * NTHR;
    float2* tw = (float2*)(p.ws + OFF_TW);
    for (int k = gt; k < FN; k += nt) { double s, c; sincospi(-2.0 * (double)k / (double)FN, &s, &c); float2 t; t.x = (float)c; t.y = (float)s; tw[k] = t; }
    bf16_t* mb = (bf16_t*)(p.ws + OFF_MEMBF);
    for (int i = gt; i < 2048 * 1024 / 4; i += nt) { const float4 v = ((const float4*)p.mem)[i]; u32x2 o; o.x = pk2(v.x, v.y); o.y = pk2(v.z, v.w); ((u32x2*)mb)[i] = o; }
    float* en = (float*)(p.ws + OFF_ENERGY);
    for (int i = gt; i < 1024; i += nt) en[i] = 0.f;
    float* ztab = (float*)(p.ws + OFF_ZT);
    for (int idx = gt; idx < 8192 * 33; idx += nt) {
        const int n = idx / 33, e = idx - n * 33;
        float v;
        if (e == 0) v = (float)n / 8191.0f;
        else {
            const int i = (e - 1) & 15;
            const double fr = 1e-4 + (double)i * ((15.0 - 1e-4) / 15.0);
            const double ang = (2.0 * 3.14159265358979323846 / 8192.0) * (double)n * fr;
            v = (e <= 16) ? (float)cos(ang) : (float)(-sin(ang));
        }
        ztab[idx] = v;
    }
}

__device__ __forceinline__ void wt_tile(const float* src, int src_ld, int k0, int on0, bf16_t* dst, int dst_ld, int dn0, bool zero, float* tile) {
    int tid_ = threadIdx.x; asm volatile("" : "+v"(tid_)); const int tid = tid_;
    if (!zero) {
#pragma unroll
        for (int i = 0; i < 2; ++i) {
            const int k = (tid >> 3) + 64 * i, c4 = (tid & 7) * 4;
            const float4 v = *(const float4*)(src + (size_t)(k0 + k) * src_ld + on0 + c4);
            float* t = tile + k * 33 + c4; t[0] = v.x; t[1] = v.y; t[2] = v.z; t[3] = v.w;
        }
    }
    __syncthreads();
    const int n = tid >> 4, kc = (tid & 15) * 8;
    float f[8];
#pragma unroll
    for (int e = 0; e < 8; ++e) f[e] = zero ? 0.f : tile[(kc + e) * 33 + n];
    u32x4 o; o.x = pk2(f[0], f[1]); o.y = pk2(f[2], f[3]); o.z = pk2(f[4], f[5]); o.w = pk2(f[6], f[7]);
    *(u32x4*)(dst + (size_t)(dn0 + n) * dst_ld + k0 + kc) = o;
    __syncthreads();
}
__device__ __forceinline__ void phase_weights(const Params& p, int l, unsigned char* lds) {
    float* tile = (float*)lds;
    for (int it = blockIdx.x; it < 3776; it += gridDim.x) {
        if (it < 2752) {
            const int nt = it >> 3, kt = it & 7, dn0 = nt * 32;
            wt_tile(p.w_in + (size_t)l * 1024 * NIN, NIN, kt * 128, orig_col(dn0), (bf16_t*)(p.ws + OFF_WTIN), 1024, dn0, dn0 >= NIN, tile);
        } else if (it < 3264) {
            const int r = it - 2752, j = r >> 7, nt = (r >> 2) & 31, kt = r & 3;
            wt_tile(p.w_br + (size_t)(l * 4 + j) * 512 * 1024, 1024, kt * 128, nt * 32, (bf16_t*)(p.ws + OFF_WTBR) + (size_t)j * 1024 * 512, 512, nt * 32, false, tile);
        } else if (it < 3520) {
            const int r = it - 3264, nt = r >> 3, kt = r & 7;
            wt_tile(p.w_out + (size_t)l * 1024 * 1024, 1024, kt * 128, nt * 32, (bf16_t*)(p.ws + OFF_WTOUT), 1024, nt * 32, false, tile);
        } else {
            const int r = it - 3520, nt = r >> 3, kt = r & 7;
            wt_tile(p.mem_w_kv + (size_t)l * 1024 * 1024, 1024, kt * 128, nt * 32, (bf16_t*)(p.ws + OFF_WTKV), 1024, nt * 32, false, tile);
        }
    }
}

__device__ __forceinline__ void phase_filter_gen(const Params& p, int l, unsigned char* lds) {
    float* zt = (float*)lds;
    float* ha = zt + 32 * 33;
    float* hbuf = ha + 32 * 64;
    int tid_ = threadIdx.x; asm volatile("" : "+v"(tid_)); const int tid = tid_;
    const float* w1 = p.hy_w1 + (size_t)l * 33 * 64; const float* b1 = p.hy_b1 + l * 64;
    const float* wm = p.hy_wm + (size_t)l * 2 * 64 * 64; const float* bm = p.hy_bm + l * 2 * 64;
    const float* w3 = p.hy_w3 + (size_t)l * 64 * 1024;
    float* hf = (float*)(p.ws + OFF_HFILT);
    float* en = (float*)(p.ws + OFF_ENERGY) + l * 512;
    const float* ztab = (const float*)(p.ws + OFF_ZT);
    for (int it = blockIdx.x; it < 256; it += gridDim.x) {
        const int n0 = it * 32;
        for (int idx = tid; idx < 32 * 33; idx += NTHR) zt[idx] = ztab[(size_t)n0 * 33 + idx];
        __syncthreads();
        for (int idx = tid; idx < 2048; idx += NTHR) {
            const int pos = idx >> 6, j = idx & 63; float s = b1[j];
            for (int e = 0; e < 33; ++e) s += zt[pos * 33 + e] * w1[e * 64 + j];
            ha[idx] = sinf(s);
        }
        __syncthreads();
        for (int idx = tid; idx < 2048; idx += NTHR) {
            const int pos = idx >> 6, j = idx & 63; float s = bm[j];
            for (int e = 0; e < 64; ++e) s += ha[pos * 64 + e] * wm[e * 64 + j];
            hbuf[idx] = sinf(s);
        }
        __syncthreads();
        for (int idx = tid; idx < 2048; idx += NTHR) {
            const int pos = idx >> 6, j = idx & 63; float s = bm[64 + j];
            for (int e = 0; e < 64; ++e) s += hbuf[pos * 64 + e] * wm[4096 + e * 64 + j];
            ha[idx] = sinf(s);
        }
        __syncthreads();
        {
            const int c = tid;
            float af[32], ab[32];
#pragma unroll
            for (int i = 0; i < 32; ++i) { af[i] = 0.f; ab[i] = 0.f; }
            for (int k = 0; k < 64; ++k) {
                const float wf = w3[k * 1024 + c], wb = w3[k * 1024 + 512 + c];
#pragma unroll
                for (int i = 0; i < 32; ++i) { const float h = ha[i * 64 + k]; af[i] += h * wf; ab[i] += h * wb; }
            }
            const float dmin = -3.0701134573253945f, dmax = -15.350567286626973f;
            const float delta = fabsf(dmin + (float)c * ((dmax - dmin) / 511.0f));
            float e = 0.f;
#pragma unroll
            for (int i = 0; i < 32; ++i) {
                const int n = n0 + i; const float t01 = (float)n / 8191.0f; const float win = expf(-t01 * delta);
                af[i] *= win; ab[i] *= win; e += af[i] * af[i]; if (n >= 1) e += ab[i] * ab[i];
            }
#pragma unroll
            for (int i = 0; i < 8; ++i) {
                float4 a; a.x = af[4 * i]; a.y = af[4 * i + 1]; a.z = af[4 * i + 2]; a.w = af[4 * i + 3];
                float4 b; b.x = ab[4 * i]; b.y = ab[4 * i + 1]; b.z = ab[4 * i + 2]; b.w = ab[4 * i + 3];
                *(float4*)(hf + (size_t)c * 8192 + n0 + 4 * i) = a;
                *(float4*)(hf + (size_t)(512 + c) * 8192 + n0 + 4 * i) = b;
            }
            atomicAdd(en + c, e);
        }
        __syncthreads();
    }
}

__device__ __forceinline__ void phase_filter_fft(const Params& p, int l, unsigned char* lds) {
    float2* d = (float2*)lds;
    const float2* tw = fft_lds_twiddles((const float2*)(p.ws + OFF_TW), lds);
    const float* hf = (const float*)(p.ws + OFF_HFILT);
    const float* en = (const float*)(p.ws + OFF_ENERGY) + l * 512;
    float4* pqa = (float4*)(p.ws + OFF_PQ);
    int tid_ = threadIdx.x; asm volatile("" : "+v"(tid_)); const int tid = tid_;
    for (int pr = blockIdx.x; pr < 256; pr += gridDim.x) {
        const int c0 = 2 * pr, c1 = c0 + 1;
        const float s0 = 1.0f / sqrtf(en[c0] + 1e-6f), s1 = 1.0f / sqrtf(en[c1] + 1e-6f);
        const float k0 = p.hy_skip[l * 512 + c0], k1 = p.hy_skip[l * 512 + c1];
        for (int n = tid; n < FN; n += NTHR) {
            float2 v;
            if (n < 8192) { v.x = hf[(size_t)c0 * 8192 + n] * s0; v.y = hf[(size_t)c1 * 8192 + n] * s1; if (n == 0) { v.x += k0; v.y += k1; } }
            else if (n == 8192) { v.x = 0.f; v.y = 0.f; }
            else { v.x = hf[(size_t)(512 + c0) * 8192 + (FN - n)] * s0; v.y = hf[(size_t)(512 + c1) * 8192 + (FN - n)] * s1; }
            d[n] = v;
        }
        __syncthreads();
        fft_forward<false>(d, tw, (const float2*)(p.ws + OFF_TW));
        for (int h = tid; h < FN / 2; h += NTHR) filt_pointwise(d, pqa + (size_t)pr * FN, 2 * h);
        if (tid == 0) filt_pointwise(d, pqa + (size_t)pr * FN, 1);
        __syncthreads();
    }
}

__device__ __forceinline__ void hy_pre_item(const Params& p, int l, const bf16_t* P, bf16_t* UT, bf16_t* GT, int bl, int tt, int ct, unsigned char* lds) {
    float* tU = (float*)lds;
    float* tG = tU + 64 * 65;
    int tid_ = threadIdx.x; asm volatile("" : "+v"(tid_)); const int tid = tid_;
    const int t = tid >> 3, cc = (tid & 7) * 8, c = ct * 64 + cc, tb = tt * 64 + t;
    const float* cw = p.hy_conv_w + (size_t)l * 3 * 1536; const float* cb = p.hy_conv_b + l * 1536;
    float av[8], a0[8], a1[8];
#pragma unroll
    for (int h = 0; h < 2; ++h) {
        const f32x4 bv = *(const f32x4*)(cb + c + 4 * h), b0 = *(const f32x4*)(cb + 512 + c + 4 * h), b1 = *(const f32x4*)(cb + 1024 + c + 4 * h);
#pragma unroll
        for (int e = 0; e < 4; ++e) { av[4 * h + e] = bv[e]; a0[4 * h + e] = b0[e]; a1[4 * h + e] = b1[e]; }
    }
#pragma unroll
    for (int j = 0; j < 3; ++j) {
        const int ts = tb + j - 1;
        if (ts >= 0 && ts < SEQ) {
            const bf16_t* row = P + (size_t)(bl * SEQ + ts) * PS + C_HY + c;
            const u32x4 rv = *(const u32x4*)row, r0 = *(const u32x4*)(row + 512), r1 = *(const u32x4*)(row + 1024);
#pragma unroll
            for (int h = 0; h < 2; ++h) {
                const f32x4 wv = *(const f32x4*)(cw + j * 1536 + c + 4 * h), w0 = *(const f32x4*)(cw + j * 1536 + 512 + c + 4 * h), w1 = *(const f32x4*)(cw + j * 1536 + 1024 + c + 4 * h);
#pragma unroll
                for (int e = 0; e < 4; ++e) {
                    const int k = 4 * h + e; const unsigned uv = rv[k >> 1], u0 = r0[k >> 1], u1 = r1[k >> 1];
                    av[k] += wv[e] * ((k & 1) ? hi16(uv) : lo16(uv)); a0[k] += w0[e] * ((k & 1) ? hi16(u0) : lo16(u0)); a1[k] += w1[e] * ((k & 1) ? hi16(u1) : lo16(u1));
                }
            }
        }
    }
    const u32x4 rz = *(const u32x4*)(P + (size_t)(bl * SEQ + tb) * PS + C_Z + 512 + c);
#pragma unroll
    for (int k = 0; k < 8; ++k) {
        const unsigned uz = rz[k >> 1]; const float z = (k & 1) ? hi16(uz) : lo16(uz);
        tU[(cc + k) * 65 + t] = av[k] * a1[k]; tG[(cc + k) * 65 + t] = a0[k] * z;
    }
    __syncthreads();
    const int c2 = tid >> 3, t8 = (tid & 7) * 8;
    const size_t o = (size_t)(bl * 512 + ct * 64 + c2) * SEQ + tt * 64 + t8;
    const float* su = tU + c2 * 65 + t8; const float* sg = tG + c2 * 65 + t8;
    f32x4 ua = {su[0], su[1], su[2], su[3]}, ub = {su[4], su[5], su[6], su[7]};
    { u32x4 uo; uo.x = pk2(ua[0], ua[1]); uo.y = pk2(ua[2], ua[3]); uo.z = pk2(ub[0], ub[1]); uo.w = pk2(ub[2], ub[3]); *(u32x4*)(UT + o) = uo; }
    u32x4 g; g.x = pk2(sg[0], sg[1]); g.y = pk2(sg[2], sg[3]); g.z = pk2(sg[4], sg[5]); g.w = pk2(sg[6], sg[7]);
    *(u32x4*)(GT + o) = g;
    __syncthreads();
}
__device__ __forceinline__ void hy_post_item(bf16_t* P, const bf16_t* GT, int bl, int tt, int ct, unsigned char* lds, int dry = 0) {
    bf16_t* tl = (bf16_t*)lds;
    int tid_ = threadIdx.x; asm volatile("" : "+v"(tid_)); const int tid = tid_;
    const int c2 = tid >> 3, t8 = (tid & 7) * 8;
    const u32x4 v = *(const u32x4*)(GT + (size_t)(bl * 512 + ct * 64 + c2) * SEQ + tt * 64 + t8);
    bf16_t* d0 = tl + t8 * 72 + c2;
    d0[0 * 72] = (bf16_t)(v.x & 0xffffu); d0[1 * 72] = (bf16_t)(v.x >> 16); d0[2 * 72] = (bf16_t)(v.y & 0xffffu); d0[3 * 72] = (bf16_t)(v.y >> 16);
    d0[4 * 72] = (bf16_t)(v.z & 0xffffu); d0[5 * 72] = (bf16_t)(v.z >> 16); d0[6 * 72] = (bf16_t)(v.w & 0xffffu); d0[7 * 72] = (bf16_t)(v.w >> 16);
    __syncthreads();
    const int t = tid >> 3, cc = (tid & 7) * 8;
    const u32x4 ov = *(const u32x4*)(tl + t * 72 + cc);
    if (!dry) *(u32x4*)(P + (size_t)(bl * SEQ + tt * 64 + t) * PS + C_HY + ct * 64 + cc) = ov;
    __syncthreads();
}
__device__ __forceinline__ void hyena_conv_item(const Params& p, const bf16_t* UT, bf16_t* GT, int bl, int pr, unsigned char* lds, const float2* tw, int dry = 0) {
    float2* d = (float2*)lds;
    const float4* pq = (const float4*)(p.ws + OFF_PQ) + (size_t)pr * FN;
    int tid_ = threadIdx.x; asm volatile("" : "+v"(tid_)); const int tid = tid_;
    const bf16_t* u0 = UT + (size_t)(bl * 512 + 2 * pr) * SEQ; const bf16_t* u1 = u0 + SEQ;
    bf16_t* g0 = GT + (size_t)(bl * 512 + 2 * pr) * SEQ; bf16_t* g1 = g0 + SEQ;
    {
        float f0[16], f1[16];
#pragma unroll
        for (int i = 0; i < 16; ++i) { f0[i] = bf2f(u0[tid + NTHR * i]); f1[i] = bf2f(u1[tid + NTHR * i]); }
#pragma unroll
        for (int i = 0; i < 16; ++i) {
            float2 u; u.x = f0[i]; u.y = f1[i]; d[tid + NTHR * i] = u;
        }
    }
    __syncthreads();
    fft_forward<true>(d, tw, (const float2*)(p.ws + OFF_TW));
#pragma unroll 1
    for (int h = tid; h < FN / 2; h += 4 * NTHR) {
        PwIn w0, w1, w2, w3;
        pw_load(w0, d, pq, 2 * h); pw_load(w1, d, pq, 2 * (h + NTHR)); pw_load(w2, d, pq, 2 * (h + 2 * NTHR)); pw_load(w3, d, pq, 2 * (h + 3 * NTHR));
        pw_store(w0, d); pw_store(w1, d); pw_store(w2, d); pw_store(w3, d);
    }
    if (tid == 0) conv_pointwise(d, pq, 1);
    __syncthreads();
    fft_inverse<true>(d, tw, (const float2*)(p.ws + OFF_TW));
    {
        bf16_t a0[16], a1[16];
#pragma unroll
        for (int i = 0; i < 16; ++i) { a0[i] = g0[tid + NTHR * i]; a1[i] = g1[tid + NTHR * i]; }
#pragma unroll
        for (int i = 0; i < 16; ++i) {
            const int t = tid + NTHR * i;
            const float2 y = d[t];
            const bf16_t r0 = f2bf_d(y.x * bf2f(a0[i])), r1 = f2bf_d(y.y * bf2f(a1[i]));
            if (!dry) { g0[t] = r0; g1[t] = r1; }
        }
    }
    __syncthreads();
}

__device__ __forceinline__ void na_item(const Params& p, int l, bf16_t* P, int bl, int rp, int head, unsigned char* lds, int dry = 0) {
    bf16_t* Kimg = (bf16_t*)lds;
    bf16_t* VT = (bf16_t*)(lds + 82944);
    int tid_ = threadIdx.x; asm volatile("" : "+v"(tid_)); const int tid = tid_, lane = tid & 63, w = tid >> 6, l15 = lane & 15, q4 = lane >> 4;
    const int r0 = 2 * rp, rs0 = iclamp(r0 - 4, 0, 120);
#pragma unroll
    for (int i = 0; i < 9; ++i) {
        const int idx = tid + NTHR * i, key = idx >> 3, ch = idx & 7, grow = min(rs0 + (key >> 6), 127);
        const u32x4 kv = *(const u32x4*)(P + (size_t)(bl * SEQ + grow * 64 + (key & 63)) * PS + C_NAK + head * 64 + ch * 8);
        *(u32x4*)(Kimg + key * 72 + ch * 8) = kv;
    }
#pragma unroll
    for (int i = 0; i < 9; ++i) {
        const int idx = tid + NTHR * i, keyp = idx >> 2, chh = keyp >= 576 ? 1 : 0, key = keyp - chh * 576, ch = chh * 4 + (idx & 3), grow = min(rs0 + (key >> 6), 127);
        const u32x4 vv = *(const u32x4*)(P + (size_t)(bl * SEQ + grow * 64 + (key & 63)) * PS + C_NAV + head * 64 + ch * 8);
        bf16_t* vd = VT + (ch * 8) * 584 + key;
        vd[0 * 584] = (bf16_t)(vv.x & 0xffffu); vd[1 * 584] = (bf16_t)(vv.x >> 16);
        vd[2 * 584] = (bf16_t)(vv.y & 0xffffu); vd[3 * 584] = (bf16_t)(vv.y >> 16);
        vd[4 * 584] = (bf16_t)(vv.z & 0xffffu); vd[5 * 584] = (bf16_t)(vv.z >> 16);
        vd[6 * 584] = (bf16_t)(vv.w & 0xffffu); vd[7 * 584] = (bf16_t)(vv.w >> 16);
    }
    __syncthreads();
    const int rr = w >> 2, g = w & 3, r = r0 + rr, rs = iclamp(r - 4, 0, 120), lo = rs - rs0;
    const int cb = iclamp(16 * g - 8, 0, 32), c = 16 * g + l15, cs = iclamp(c - 8, 0, 48);
    bf16_t* qrow = P + (size_t)(bl * SEQ + r * 64 + c) * PS + head * 64;
    bf16x8 qf[2];
#pragma unroll
    for (int ks = 0; ks < 2; ++ks) qf[ks] = *(const bf16x8*)(qrow + ks * 32 + q4 * 8);
    f32x4 sc[16];
#pragma unroll
    for (int t = 0; t < 16; ++t) {
        const int kb = (lo + (t >> 1)) * 64 + cb + 16 * (t & 1);
        f32x4 a = {0.f, 0.f, 0.f, 0.f};
#pragma unroll
        for (int ks = 0; ks < 2; ++ks) { const bf16x8 kf = *(const bf16x8*)(Kimg + (kb + l15) * 72 + ks * 32 + q4 * 8); a = MFMA(kf, qf[ks], a); }
        sc[t] = a;
    }
    const float* rpb = p.na_rpb + (size_t)(l * 8 + head) * 15 * 31;
    float mx = -1e30f;
#pragma unroll
    for (int t = 0; t < 16; ++t) {
        const int drow = rs + (t >> 1) - r + 7;
#pragma unroll
        for (int e = 0; e < 4; ++e) {
            const int col = cb + 16 * (t & 1) + 4 * q4 + e;
            const bool ok = (col >= cs) && (col < cs + 16);
            const int dcol = ok ? (col - c + 15) : 0;
            const float v = ok ? (sc[t][e] + rpb[drow * 31 + dcol]) : -1e30f;
            sc[t][e] = v; mx = fmaxf(mx, v);
        }
    }
    mx = fmaxf(mx, __shfl_xor(mx, 16)); mx = fmaxf(mx, __shfl_xor(mx, 32));
    float sum = 0.f;
#pragma unroll
    for (int t = 0; t < 16; ++t)
#pragma unroll
        for (int e = 0; e < 4; ++e) { const float pe = __expf(sc[t][e] - mx); sc[t][e] = pe; sum += pe; }
    sum += __shfl_xor(sum, 16); sum += __shfl_xor(sum, 32);
    f32x4 o[4];
#pragma unroll
    for (int dt = 0; dt < 4; ++dt) o[dt] = (f32x4){0.f, 0.f, 0.f, 0.f};
#pragma unroll
    for (int kk = 0; kk < 8; ++kk) {
        u32x4 pu; pu.x = pk2(sc[2 * kk][0], sc[2 * kk][1]); pu.y = pk2(sc[2 * kk][2], sc[2 * kk][3]); pu.z = pk2(sc[2 * kk + 1][0], sc[2 * kk + 1][1]); pu.w = pk2(sc[2 * kk + 1][2], sc[2 * kk + 1][3]);
        const bf16x8 pf = mkfrag(pu);
        const int kbA = (lo + kk) * 64 + cb + 4 * q4;
#pragma unroll
        for (int dt = 0; dt < 4; ++dt) {
            const bf16_t* vr = VT + (dt * 16 + l15) * 584 + kbA;
            const bf16x8 vf = mkfrag2(*(const u32x2*)vr, *(const u32x2*)(vr + 16));
            o[dt] = MFMA(vf, pf, o[dt]);
        }
    }
    const float inv = 1.0f / sum;
    const bf16_t* zrow = P + (size_t)(bl * SEQ + r * 64 + c) * PS + C_Z + head * 64;
#pragma unroll
    for (int dt = 0; dt < 4; ++dt) {
        const int dd = dt * 16 + 4 * q4;
        const f32x4 z = ld_bf4(zrow + dd);
        if (!dry) st_bf4(qrow + dd, o[dt] * inv * z);
    }
    __syncthreads();
}

__device__ __forceinline__ void memattn_load(const Params& p, int b, int h, unsigned char* lds) {
    bf16_t* Kimg = (bf16_t*)lds;
    bf16_t* VT = (bf16_t*)(lds + 69632);
    const bf16_t* Km = (const bf16_t*)(p.ws + OFF_KMAT); const bf16_t* Vm = (const bf16_t*)(p.ws + OFF_VT);
    int tid_ = threadIdx.x; asm volatile("" : "+v"(tid_)); const int tid = tid_;
#pragma unroll
    for (int i = 0; i < 8; ++i) {
        const int idx = tid + NTHR * i;
        { const int key = idx >> 4, ch = idx & 15; *(u32x4*)(Kimg + key * 136 + ch * 8) = *(const u32x4*)(Km + (size_t)(b * 256 + key) * 512 + h * 128 + ch * 8); }
        { const int dd = idx >> 5, ch = idx & 31; *(u32x4*)(VT + dd * 264 + ch * 8) = *(const u32x4*)(Vm + (size_t)(h * 128 + dd) * 2048 + b * 256 + ch * 8); }
    }
    __syncthreads();
}
__device__ __forceinline__ void memattn_item(bf16_t* P, int bl, int h, int qt, unsigned char* lds, int dry = 0) {
    const bf16_t* Kimg = (const bf16_t*)lds; const bf16_t* VT = (const bf16_t*)(lds + 69632);
    int tid_ = threadIdx.x; asm volatile("" : "+v"(tid_)); const int tid = tid_, lane = tid & 63, w = tid >> 6, l15 = lane & 15, q4 = lane >> 4;
    const int tok = bl * SEQ + qt * 128 + w * 16 + l15;
    bf16_t* qrow = P + (size_t)tok * PS + C_MQ + h * 128;
    bf16x8 qf[4];
#pragma unroll
    for (int ks = 0; ks < 4; ++ks) qf[ks] = *(const bf16x8*)(qrow + ks * 32 + q4 * 8);
    f32x4 sc[16];
    float mx = -1e30f;
#pragma unroll
    for (int t = 0; t < 16; ++t) {
        f32x4 a = {0.f, 0.f, 0.f, 0.f};
#pragma unroll
        for (int ks = 0; ks < 4; ++ks) { const bf16x8 kf = *(const bf16x8*)(Kimg + (t * 16 + l15) * 136 + ks * 32 + q4 * 8); a = MFMA(kf, qf[ks], a); }
        sc[t] = a;
        mx = fmaxf(mx, fmaxf(fmaxf(a[0], a[1]), fmaxf(a[2], a[3])));
    }
    mx = fmaxf(mx, __shfl_xor(mx, 16)); mx = fmaxf(mx, __shfl_xor(mx, 32));
    float sum = 0.f;
#pragma unroll
    for (int t = 0; t < 16; ++t)
#pragma unroll
        for (int e = 0; e < 4; ++e) { const float pe = __expf(sc[t][e] - mx); sc[t][e] = pe; sum += pe; }
    sum += __shfl_xor(sum, 16); sum += __shfl_xor(sum, 32);
    f32x4 o[8];
#pragma unroll
    for (int dt = 0; dt < 8; ++dt) o[dt] = (f32x4){0.f, 0.f, 0.f, 0.f};
#pragma unroll
    for (int kk = 0; kk < 8; ++kk) {
        u32x4 pu; pu.x = pk2(sc[2 * kk][0], sc[2 * kk][1]); pu.y = pk2(sc[2 * kk][2], sc[2 * kk][3]); pu.z = pk2(sc[2 * kk + 1][0], sc[2 * kk + 1][1]); pu.w = pk2(sc[2 * kk + 1][2], sc[2 * kk + 1][3]);
        const bf16x8 pf = mkfrag(pu);
#pragma unroll
        for (int dt = 0; dt < 8; ++dt) {
            const bf16_t* vr = VT + (dt * 16 + l15) * 264 + kk * 32 + 4 * q4;
            const bf16x8 vf = mkfrag2(*(const u32x2*)vr, *(const u32x2*)(vr + 16));
            o[dt] = MFMA(vf, pf, o[dt]);
        }
    }
    const float inv = 1.0f / sum;
    const bf16_t* zrow = P + (size_t)tok * PS + C_Z + 3 * 512 + h * 128;
#pragma unroll
    for (int dt = 0; dt < 8; ++dt) {
        const int dd = dt * 16 + 4 * q4;
        const f32x4 z = ld_bf4(zrow + dd);
        if (!dry) st_bf4(qrow + dd, o[dt] * inv * z);
    }
}

constexpr int G_LRT = 0, G_BF = 8192, G_BB = 24576, G_TOT = 40960, G_IMG = 45056;
__device__ __forceinline__ void gla_tables(const Params& p, int l, const float* LR, int t0, int h, unsigned char* lds) {
    float* LRT = (float*)(lds + G_LRT); float* BF = (float*)(lds + G_BF); float* BB = (float*)(lds + G_BB); float* TOT = (float*)(lds + G_TOT);
    int tid_ = threadIdx.x; asm volatile("" : "+v"(tid_)); const int tid = tid_;
    ((float4*)LRT)[tid] = ((const float4*)(LR + (size_t)t0 * 32))[tid];
    __syncthreads();
    const int dk = tid & 63, cgp = tid >> 6;
    float uf[16], ub[16];
#pragma unroll
    for (int r = 0; r < 16; ++r) { uf[r] = p.gla_up_f[(size_t)(l * 16 + r) * 256 + h * 64 + dk]; ub[r] = p.gla_up_b[(size_t)(l * 16 + r) * 256 + h * 64 + dk]; }
    const float bif = p.gla_bias_f[l * 256 + h * 64 + dk], bib = p.gla_bias_b[l * 256 + h * 64 + dk];
    float lf[8], lb[8];
#pragma unroll
    for (int i = 0; i < 8; ++i) {
        const int c = cgp * 8 + i; float sf = bif, sb = bib;
#pragma unroll
        for (int r = 0; r < 16; ++r) { sf += LRT[c * 32 + r] * uf[r]; sb += LRT[c * 32 + 16 + r] * ub[r]; }
        lf[i] = logsigf_(sf) * (1.0f / 16.0f); lb[i] = logsigf_(sb) * (1.0f / 16.0f);
    }
#pragma unroll
    for (int i = 1; i < 8; ++i) lf[i] += lf[i - 1];
#pragma unroll
    for (int i = 6; i >= 0; --i) lb[i] += lb[i + 1];
    TOT[cgp * 64 + dk] = lf[7]; TOT[512 + cgp * 64 + dk] = lb[0];
    __syncthreads();
    float of = 0.f, ob = 0.f;
#pragma unroll
    for (int g2 = 0; g2 < 8; ++g2) { if (g2 < cgp) of += TOT[g2 * 64 + dk]; if (g2 > cgp) ob += TOT[512 + g2 * 64 + dk]; }
#pragma unroll
    for (int i = 0; i < 8; ++i) { BF[(cgp * 8 + i) * 64 + dk] = lf[i] + of; BB[(cgp * 8 + i) * 64 + dk] = lb[i] + ob; }
    __syncthreads();
}
struct GlaPre { u32x4 vv[2]; bf16_t q[8], k[8]; };
__device__ __forceinline__ void gla_prefetch(GlaPre& g, const bf16_t* P, int t0, int h, int tid) {
#pragma unroll
    for (int i = 0; i < 2; ++i) { const int idx = tid + NTHR * i, chn = idx >> 6, c = idx & 63; g.vv[i] = *(const u32x4*)(P + (size_t)(t0 + c) * PS + C_GV + h * 128 + chn * 8); }
#pragma unroll
    for (int i = 0; i < 8; ++i) { const int idx = tid + NTHR * i, c = idx >> 6, dk = idx & 63; g.q[i] = P[(size_t)(t0 + c) * PS + C_GQ + h * 64 + dk]; g.k[i] = P[(size_t)(t0 + c) * PS + C_GK + h * 64 + dk]; }
}
__device__ __forceinline__ void gla_vt_store(const GlaPre& g, bf16_t* VT, int tid) {
#pragma unroll
    for (int i = 0; i < 2; ++i) {
        const int idx = tid + NTHR * i, chn = idx >> 6, c = idx & 63;
        const u32x4 vv = g.vv[i];
        bf16_t* vd = VT + (chn * 8) * 72 + c;
        vd[0 * 72] = (bf16_t)(vv.x & 0xffffu); vd[1 * 72] = (bf16_t)(vv.x >> 16);
        vd[2 * 72] = (bf16_t)(vv.y & 0xffffu); vd[3 * 72] = (bf16_t)(vv.y >> 16);
        vd[4 * 72] = (bf16_t)(vv.z & 0xffffu); vd[5 * 72] = (bf16_t)(vv.z >> 16);
        vd[6 * 72] = (bf16_t)(vv.w & 0xffffu); vd[7 * 72] = (bf16_t)(vv.w >> 16);
    }
}
__device__ __forceinline__ void gla_part1_item(const Params& p, int l, const bf16_t* P, const float* LR, int item, unsigned char* lds) {
    const int h = item & 3, n = (item >> 2) & 127, bl = item >> 9, t0 = bl * SEQ + n * 64;
    const float* BF = (const float*)(lds + G_BF); const float* BB = (const float*)(lds + G_BB);
    bf16_t* KDT0 = (bf16_t*)(lds + G_IMG); bf16_t* KDT1 = KDT0 + 64 * 72; bf16_t* VT = KDT1 + 64 * 72;
    bf16_t* GS = (bf16_t*)(p.ws + OFF_GS); float* GD = (float*)(p.ws + OFF_GDEC);
    int tid_ = threadIdx.x; asm volatile("" : "+v"(tid_)); const int tid = tid_, lane = tid & 63, w = tid >> 6, l15 = lane & 15, q4 = lane >> 4;
    GlaPre gp; gla_prefetch(gp, P, t0, h, tid);
    gla_tables(p, l, LR, t0, h, lds);
    {
        float4* tb = (float4*)((float*)(p.ws + OFF_TB) + (size_t)item * 8192); const float4* ts = (const float4*)(lds + G_BF);
#pragma unroll
        for (int i = 0; i < 4; ++i) tb[tid + NTHR * i] = ts[tid + NTHR * i];
    }
#pragma unroll
    for (int i = 0; i < 8; ++i) {
        const int idx = tid + NTHR * i, c = idx >> 6, dk = idx & 63;
        const float kv = bf2f(gp.k[i]);
        KDT0[dk * 72 + c] = f2bf_d(kv * __expf(BF[63 * 64 + dk] - BF[c * 64 + dk]));
        KDT1[dk * 72 + c] = f2bf_d(kv * __expf(BB[dk] - BB[c * 64 + dk]));
    }
    gla_vt_store(gp, VT, tid);
    if (tid < 64) GD[(size_t)item * 64 + tid] = __expf(BF[63 * 64 + tid]);
    else if (tid < 128) GD[(size_t)(NITEM + item) * 64 + tid - 64] = __expf(BB[tid - 64]);
    __syncthreads();
    const int dir = w >> 2, dkt = w & 3;
    const bf16_t* KD = dir ? KDT1 : KDT0;
    bf16x8 kf[2];
#pragma unroll
    for (int ks = 0; ks < 2; ++ks) kf[ks] = *(const bf16x8*)(KD + (16 * dkt + l15) * 72 + 32 * ks + 8 * q4);
    bf16_t* dst = GS + ((size_t)dir * NITEM + item) * 8192;
#pragma unroll
    for (int dvt = 0; dvt < 8; ++dvt) {
        f32x4 a = {0.f, 0.f, 0.f, 0.f};
#pragma unroll
        for (int ks = 0; ks < 2; ++ks) { const bf16x8 vf = *(const bf16x8*)(VT + (16 * dvt + l15) * 72 + 32 * ks + 8 * q4); a = MFMA(kf[ks], vf, a); }
        st_bf4(dst + (16 * dvt + l15) * 64 + 16 * dkt + 4 * q4, a);
    }
    __syncthreads();
}
__device__ __forceinline__ void gla_scan(const Params& p, int dry = 0) {
    const bf16_t* GS = (const bf16_t*)(p.ws + OFF_GS); const float* GD = (const float*)(p.ws + OFF_GDEC); bf16_t* SB = (bf16_t*)(p.ws + OFF_SB);
    const int total = 2 * BG * 4 * 8192;
    int tid_ = threadIdx.x; asm volatile("" : "+v"(tid_));
    for (int id = blockIdx.x * NTHR + tid_; id < total; id += gridDim.x * NTHR) {
        const int e = id & 8191, comb = id >> 13, h = comb & 3, bl = (comb >> 2) % BG, dir = comb / (4 * BG), dk = e & 63;
        float S = 0.f;
        const size_t ibase = (size_t)dir * NITEM + (size_t)(bl * 128) * 4 + h;
        for (int s0 = 0; s0 < 128; s0 += 16) {
            float u[16], dc[16];
#pragma unroll
            for (int i = 0; i < 16; ++i) {
                const int n = dir ? 127 - (s0 + i) : s0 + i;
                const size_t item = ibase + (size_t)n * 4;
                u[i] = bf2f(GS[item * 8192 + e]); dc[i] = GD[item * 64 + dk];
            }
#pragma unroll
            for (int i = 0; i < 16; ++i) {
                const int n = dir ? 127 - (s0 + i) : s0 + i;
                const size_t item = ibase + (size_t)n * 4;
                if (!dry) SB[item * 8192 + e] = f2bf_d(S);
                S = dc[i] * S + u[i];
            }
        }
    }
}
__device__ __forceinline__ void gla_part2_item(const Params& p, int l, bf16_t* P, const float* LR, int item, unsigned char* lds, int dry = 0) {
    const int h = item & 3, n = (item >> 2) & 127, bl = item >> 9, t0 = bl * SEQ + n * 64;
    const float* BF = (const float*)(lds + G_BF); const float* BB = (const float*)(lds + G_BB);
    bf16_t* QF = (bf16_t*)(lds + G_IMG);
    bf16_t* KF = QF + 2 * 64 * 72;
    bf16_t* QD = KF + 2 * 64 * 72;
    bf16_t* VT = QD + 2 * 64 * 72;
    bf16_t* ST = VT + 128 * 72;
    float* OX = (float*)lds;
    const float* GS = (const float*)(p.ws + OFF_GS);
    int tid_ = threadIdx.x; asm volatile("" : "+v"(tid_)); const int tid = tid_, lane = tid & 63, w = tid >> 6, l15 = lane & 15, q4 = lane >> 4;
    GlaPre gp; gla_prefetch(gp, P, t0, h, tid);
    u32x4 sp[2][2];
#pragma unroll
    for (int dir = 0; dir < 2; ++dir)
#pragma unroll
        for (int i = 0; i < 2; ++i) { const int idx = tid + NTHR * i; sp[dir][i] = *(const u32x4*)((const bf16_t*)(p.ws + OFF_SB) + ((size_t)dir * NITEM + item) * 8192 + (size_t)idx * 8); }
    {
        const float4* tb = (const float4*)((const float*)(p.ws + OFF_TB) + (size_t)item * 8192); float4* ts = (float4*)(lds + G_BF);
        float4 tv[4];
#pragma unroll
        for (int i = 0; i < 4; ++i) tv[i] = tb[tid + NTHR * i];
#pragma unroll
        for (int i = 0; i < 4; ++i) ts[tid + NTHR * i] = tv[i];
        __syncthreads();
    }
#pragma unroll
    for (int i = 0; i < 8; ++i) {
        const int idx = tid + NTHR * i, c = idx >> 6, dk = idx & 63;
        const float qv = bf2f(gp.q[i]);
        const float kv = bf2f(gp.k[i]);
        const float bf = BF[c * 64 + dk], mf = BF[31 * 64 + dk], bb = BB[c * 64 + dk], mb = BB[32 * 64 + dk];
        QF[c * 72 + dk] = f2bf_d(qv * __expf(bf - mf)); KF[c * 72 + dk] = f2bf_d(kv * __expf(mf - bf)); QD[c * 72 + dk] = f2bf_d(qv * __expf(bf));
        QF[4608 + c * 72 + dk] = f2bf_d(qv * __expf(bb - mb)); KF[4608 + c * 72 + dk] = f2bf_d(kv * __expf(mb - bb)); QD[4608 + c * 72 + dk] = f2bf_d(qv * __expf(bb));
    }
    gla_vt_store(gp, VT, tid);
#pragma unroll
    for (int dir = 0; dir < 2; ++dir) {
#pragma unroll
        for (int i = 0; i < 2; ++i) {
            const int idx = tid + NTHR * i, dv = idx >> 3, dk8 = (idx & 7) * 8;
            *(u32x4*)(ST + dir * 9216 + dv * 72 + dk8) = sp[dir][i];
        }
    }
    __syncthreads();
    const int dir = w >> 2, ct = w & 3;
    const bf16_t* qfp = QF + dir * 4608; const bf16_t* kfp = KF + dir * 4608; const bf16_t* qdp = QD + dir * 4608; const bf16_t* stp = ST + dir * 9216;
    bf16x8 qf[2], qd[2];
#pragma unroll
    for (int ks = 0; ks < 2; ++ks) { qf[ks] = *(const bf16x8*)(qfp + (16 * ct + l15) * 72 + 32 * ks + 8 * q4); qd[ks] = *(const bf16x8*)(qdp + (16 * ct + l15) * 72 + 32 * ks + 8 * q4); }
    f32x4 sc[4];
    const int cq = 16 * ct + l15;
#pragma unroll
    for (int st = 0; st < 4; ++st) {
        f32x4 a = {0.f, 0.f, 0.f, 0.f};
#pragma unroll
        for (int ks = 0; ks < 2; ++ks) { const bf16x8 kf = *(const bf16x8*)(kfp + (16 * st + l15) * 72 + 32 * ks + 8 * q4); a = MFMA(kf, qf[ks], a); }
#pragma unroll
        for (int e = 0; e < 4; ++e) { const int s = 16 * st + 4 * q4 + e; const bool ok = dir ? (s > cq) : (s <= cq); a[e] = ok ? a[e] : 0.f; }
        sc[st] = a;
    }
    f32x4 o[8];
#pragma unroll
    for (int dt = 0; dt < 8; ++dt) o[dt] = (f32x4){0.f, 0.f, 0.f, 0.f};
#pragma unroll
    for (int kk = 0; kk < 2; ++kk) {
        u32x4 pu; pu.x = pk2(sc[2 * kk][0], sc[2 * kk][1]); pu.y = pk2(sc[2 * kk][2], sc[2 * kk][3]); pu.z = pk2(sc[2 * kk + 1][0], sc[2 * kk + 1][1]); pu.w = pk2(sc[2 * kk + 1][2], sc[2 * kk + 1][3]);
        const bf16x8 pf = mkfrag(pu);
#pragma unroll
        for (int dt = 0; dt < 8; ++dt) {
            const bf16_t* vr = VT + (dt * 16 + l15) * 72 + kk * 32 + 4 * q4;
            const bf16x8 vf = mkfrag2(*(const u32x2*)vr, *(const u32x2*)(vr + 16));
            o[dt] = MFMA(vf, pf, o[dt]);
        }
    }
#pragma unroll
    for (int ks = 0; ks < 2; ++ks)
#pragma unroll
        for (int dt = 0; dt < 8; ++dt) { const bf16x8 sf = *(const bf16x8*)(stp + (dt * 16 + l15) * 72 + 32 * ks + 8 * q4); o[dt] = MFMA(sf, qd[ks], o[dt]); }
    if (dir == 1) {
#pragma unroll
        for (int dt = 0; dt < 8; ++dt) *(f32x4*)(OX + cq * 132 + 16 * dt + 4 * q4) = o[dt];
    }
    __syncthreads();
    if (dir == 0) {
        float ss = 0.f;
#pragma unroll
        for (int dt = 0; dt < 8; ++dt) { o[dt] += *(const f32x4*)(OX + cq * 132 + 16 * dt + 4 * q4); ss += (o[dt][0] * o[dt][0] + o[dt][1] * o[dt][1]) + (o[dt][2] * o[dt][2] + o[dt][3] * o[dt][3]); }
        ss += __shfl_xor(ss, 16); ss += __shfl_xor(ss, 32);
        const float rms = 1.0f / sqrtf(ss * (1.0f / 128.0f) + 1e-6f);
        const float* ng = p.gla_norm_g + l * 512 + h * 128;
        const bf16_t* zrow = P + (size_t)(t0 + cq) * PS + C_Z + 2 * 512 + h * 128;
        bf16_t* orow = P + (size_t)(t0 + cq) * PS + C_GV + h * 128;
#pragma unroll
        for (int dt = 0; dt < 8; ++dt) {
            const int dd = 16 * dt + 4 * q4;
            const f32x4 z = ld_bf4(zrow + dd); const f32x4 g4 = *(const f32x4*)(ng + dd);
            if (!dry) st_bf4(orow + dd, o[dt] * rms * g4 * z);
        }
    }
    __syncthreads();
}

namespace pg8 {
#define PG8_LAS __attribute__((address_space(3)))
typedef unsigned short bf16_t;
typedef short bf16x8 __attribute__((ext_vector_type(8)));
typedef float f32x4 __attribute__((ext_vector_type(4)));
typedef unsigned u32x4 __attribute__((ext_vector_type(4)));
constexpr int BM = 256, BK = 64, HALF = 128, HTB = HALF * BK * 2  , STAGE_BYTES = 8 * HTB, NXCD = 8, WGM = 8;

__host__ __device__ __forceinline__ int lds_byte(int r, int c) { const int st = (r >> 4) * 2 + (c >> 5), rr = r & 15, cc = c & 31, ob = rr * 64 + cc * 2; return st * 1024 + (ob ^ (((ob >> 9) & 1) << 5)); }
__host__ __device__ __forceinline__ void stage_rc(int b, int& R, int& C) { const int st = b / 1024, sb = b % 1024, swz = sb ^ (((sb >> 9) & 1) << 5); R = (st >> 1) * 16 + swz / 64; C = (st & 1) * 32 + (swz % 64) / 2; }
__host__ __device__ __forceinline__ int perm32(int rho) { const int n = rho >> 4, i = rho & 15; return 8 * (i >> 2) + 4 * n + (i & 3); }

struct Unit { int pm, pn; };
struct Gemm { const bf16_t* A; const bf16_t* Bt; int M, N, K; };

struct StaticOrder {
    int nM, nN, nwg, G, c;
    __host__ __device__ __forceinline__ void init(int M, int N, int G_, int c_) { nM = M / BM; nN = N / BM; nwg = nM * nN; G = G_; c = c_; }
    __host__ __device__ bool next(int i, Unit& u) const {
        const long L = (long)i * G + c; if (L >= nwg) return false;
        int wgid = (int)L; { const int q = nwg / NXCD, r = nwg % NXCD, xcd = wgid % NXCD, off = wgid / NXCD; wgid = (xcd < r ? xcd * (q + 1) : r * (q + 1) + (xcd - r) * q) + off; }
        const int nig = WGM * nN, gid = wgid / nig, fm = gid * WGM, gsz = (nM - fm) < WGM ? (nM - fm) : WGM;
        u.pm = fm + ((wgid % nig) % gsz); u.pn = (wgid % nig) / gsz; return true;
    }
    __device__ __forceinline__ void a_ready(const Unit&) const {}
    __device__ __forceinline__ void done(const Unit&) const {}
};
__device__ __forceinline__ unsigned cvt_pk_bf16(float lo, float hi) { unsigned r; asm volatile("v_cvt_pk_bf16_f32 %0, %1, %2" : "=v"(r) : "v"(lo), "v"(hi)); return r; }
template <class Epi, class Sched, bool STAMP = false>
__device__ __forceinline__ void gemm_phase(PG8_LAS unsigned char* lds, const Gemm g, const Sched& S, const Epi& E, unsigned long long* stamps) {
    int tid_l = threadIdx.x; asm volatile("" : "+v"(tid_l)); const int tid = tid_l, wid = __builtin_amdgcn_readfirstlane(tid >> 6), lane = tid & 63, wr = wid >> 2, wc = wid & 3, fr = lane & 15, fq = lane >> 4;
    const int K = g.K, nt = K / BK;
    int ts_lo = 0, ts_hi = 0, nts = 0; const unsigned long long rt_entry = STAMP ? (unsigned long long)wall_clock64() : 0ull;
#define PG8_STAMP() do { if (STAMP && wid == 0 && nts < 64) { const unsigned long long _c = (unsigned long long)clock64(); \
        ts_lo = (lane == nts) ? (int)(unsigned)_c : ts_lo; ts_hi = (lane == nts) ? (int)(unsigned)(_c >> 32) : ts_hi; ++nts; } } while (0)
    PG8_STAMP();
    unsigned voffA[2], voffB[2];
#pragma unroll
    for (int i = 0; i < 2; ++i) { int R, C; stage_rc(tid * 16 + i * 8192, R, C); const int Rb = Epi::PERM ? ((R & ~31) + perm32(R & 31)) : R;
        voffA[i] = (unsigned)(R * K + C) * 2u; voffB[i] = (unsigned)(Rb * K + C) * 2u; }
    const size_t kstep = (size_t)(BK * 2);
    const size_t hstep = (size_t)HALF * K * 2;
    const size_t tstep = 2 * hstep;
    const unsigned ldsw = (unsigned)wid * 1024u;
    const int aoff = lds_byte(wr * 64 + fr, fq * 8), boff = lds_byte(wc * 32 + fr, fq * 8);
#define PG8_SA(b, h) (((b) * 2 + (h)) * HTB)
#define PG8_SB(b, h) ((4 + (b) * 2 + (h)) * HTB)
#define PG8_STAGE(bufoff, gbase, voff) do { _Pragma("unroll") for (int _i = 0; _i < 2; ++_i) \
        __builtin_amdgcn_global_load_lds((const unsigned*)((const char*)(gbase) + (voff)[_i]), (PG8_LAS unsigned*)(lds + (bufoff) + ldsw + _i * 8192), 16, 0, 0); } while (0)
#define PG8_LDA(dst, b, h) do { _Pragma("unroll") for (int m = 0; m < 4; ++m) _Pragma("unroll") for (int k = 0; k < 2; ++k) dst[m][k] = *(const PG8_LAS bf16x8*)(lds + PG8_SA(b, h) + aoff + m * 2048 + k * 1024); } while (0)
#define PG8_LDB(dst, b, h) do { _Pragma("unroll") for (int n = 0; n < 2; ++n) _Pragma("unroll") for (int k = 0; k < 2; ++k) dst[n][k] = *(const PG8_LAS bf16x8*)(lds + PG8_SB(b, h) + boff + n * 2048 + k * 1024); } while (0)
#define PG8_MMA(ai, bj, At, Bt) do { __builtin_amdgcn_s_setprio(1); _Pragma("unroll") for (int m = 0; m < 4; ++m) _Pragma("unroll") for (int n = 0; n < 2; ++n) _Pragma("unroll") for (int k = 0; k < 2; ++k) \
        acc[ai][bj][m][n] = __builtin_amdgcn_mfma_f32_16x16x32_bf16(Bt[n][k], At[m][k], acc[ai][bj][m][n], 0, 0, 0); __builtin_amdgcn_s_setprio(0); } while (0)
#define PG8_WAIT_V(n) asm volatile("s_waitcnt vmcnt(" #n ")" ::: "memory")
#define PG8_WAIT_L(n) asm volatile("s_waitcnt lgkmcnt(" #n ")" ::: "memory")
#define PG8_BAR __builtin_amdgcn_s_barrier()
#define PG8_SCHED __builtin_amdgcn_sched_barrier(0)
    Unit cur, nxt; int ui = 0;
    if (!S.next(0, cur)) return;
    f32x4 acc[2][2][4][2];
#pragma unroll
    for (int a = 0; a < 2; ++a)
#pragma unroll
        for (int b = 0; b < 2; ++b)
#pragma unroll
            for (int m = 0; m < 4; ++m)
#pragma unroll
                for (int n = 0; n < 2; ++n) acc[a][b][m][n] = (f32x4){0.f, 0.f, 0.f, 0.f};
    bf16x8 At[4][2], B0[2][2], B1[2][2];
    const char* cA = (const char*)g.A + (size_t)cur.pm * tstep; const char* cB = (const char*)g.Bt + (size_t)cur.pn * tstep;
    S.a_ready(cur);
    PG8_STAGE(PG8_SB(0, 0), cB, voffB); PG8_STAGE(PG8_SA(0, 0), cA, voffA); PG8_STAGE(PG8_SB(0, 1), cB + hstep, voffB); PG8_STAGE(PG8_SA(0, 1), cA + hstep, voffA);
    if (wr == 1) PG8_BAR;
    PG8_WAIT_V(4); PG8_BAR;
    PG8_STAGE(PG8_SB(1, 0), cB + kstep, voffB); PG8_STAGE(PG8_SA(1, 0), cA + kstep, voffA); PG8_STAGE(PG8_SB(1, 1), cB + hstep + kstep, voffB);
    PG8_WAIT_V(6); PG8_BAR;
    PG8_STAMP();
    for (;;) {
        const bool has_next = S.next(ui + 1, nxt);
        const char* nA = has_next ? (const char*)g.A + (size_t)nxt.pm * tstep : cA; const char* nB = has_next ? (const char*)g.Bt + (size_t)nxt.pn * tstep : cB;
        for (int t = 0; t < nt; t += 2) {
            const bool last = (t == nt - 2);
            const char* a1 = cA + (size_t)(t + 1) * kstep;
            const char* a2 = last ? nA : cA + (size_t)(t + 2) * kstep; const char* b2 = last ? nB : cB + (size_t)(t + 2) * kstep;
            const char* a3 = a2 + kstep; const char* b3 = b2 + kstep;
            if (last && has_next) S.a_ready(nxt);
            PG8_LDB(B0, 0, 0); PG8_SCHED; PG8_LDA(At, 0, 0); PG8_STAGE(PG8_SA(1, 1), a1 + hstep, voffA);
            PG8_WAIT_L(8); PG8_BAR; PG8_WAIT_L(0); PG8_MMA(0, 0, At, B0); PG8_BAR; PG8_SCHED;
            PG8_LDB(B1, 0, 1); PG8_STAGE(PG8_SB(0, 0), b2, voffB);
            PG8_BAR; PG8_WAIT_L(0); PG8_MMA(0, 1, At, B1); PG8_BAR;
            PG8_LDA(At, 0, 1); PG8_STAGE(PG8_SA(0, 0), a2, voffA);
            PG8_BAR; PG8_WAIT_L(0); PG8_MMA(1, 0, At, B0); PG8_BAR; PG8_SCHED;
            PG8_STAGE(PG8_SB(0, 1), b2 + hstep, voffB);
            PG8_WAIT_V(6); PG8_BAR; PG8_MMA(1, 1, At, B1); PG8_BAR;
            PG8_LDB(B0, 1, 0); PG8_SCHED; PG8_LDA(At, 1, 0); PG8_STAGE(PG8_SA(0, 1), a2 + hstep, voffA);
            PG8_WAIT_L(8); PG8_BAR; PG8_WAIT_L(0); PG8_MMA(0, 0, At, B0); PG8_BAR; PG8_SCHED;
            PG8_LDB(B1, 1, 1); PG8_STAGE(PG8_SB(1, 0), b3, voffB);
            PG8_BAR; PG8_WAIT_L(0); PG8_MMA(0, 1, At, B1); PG8_BAR;
            PG8_LDA(At, 1, 1); PG8_STAGE(PG8_SA(1, 0), a3, voffA);
            PG8_BAR; PG8_WAIT_L(0); PG8_MMA(1, 0, At, B0); PG8_BAR; PG8_SCHED;
            PG8_STAGE(PG8_SB(1, 1), b3 + hstep, voffB);
            PG8_WAIT_V(6); PG8_BAR; PG8_MMA(1, 1, At, B1); PG8_BAR;
        }
        PG8_STAMP();
        if constexpr (!Epi::AFTER_DRAIN) { E(acc, cur, wr, wc, fr, fq); S.done(cur); }
        PG8_STAMP();
        if (!has_next) break;
#pragma unroll
        for (int a = 0; a < 2; ++a)
#pragma unroll
            for (int b = 0; b < 2; ++b)
#pragma unroll
                for (int m = 0; m < 4; ++m)
#pragma unroll
                    for (int n = 0; n < 2; ++n) acc[a][b][m][n] = (f32x4){0.f, 0.f, 0.f, 0.f};
        cur = nxt; cA = nA; cB = nB; ++ui;
    }
    PG8_WAIT_V(0);
    if (wr == 0) PG8_BAR;
    PG8_BAR;
    if constexpr (Epi::AFTER_DRAIN) { E.fused(acc, cur, wr, wc, fr, fq, lds, wid, lane); S.done(cur); }
    PG8_STAMP();
    if (STAMP && wid == 0) { stamps[lane] = lane < nts ? (((unsigned long long)(unsigned)ts_hi << 32) | (unsigned)ts_lo) : 0ull;
        if (lane == 62) stamps[62] = rt_entry; if (lane == 63) stamps[63] = (unsigned long long)wall_clock64(); }
#undef PG8_STAMP
#undef PG8_SA
#undef PG8_SB
#undef PG8_STAGE
#undef PG8_LDA
#undef PG8_LDB
#undef PG8_MMA
#undef PG8_WAIT_V
#undef PG8_WAIT_L
#undef PG8_BAR
#undef PG8_SCHED
}
}

struct EpiInProj {
    static constexpr bool PERM = true, AFTER_DRAIN = false;
    bf16_t* P; const float* bias; float* LR;
    __device__ __forceinline__ void operator()(const f32x4 (&acc)[2][2][4][2], const pg8::Unit& u, int wr, int wc, int fr, int fq) const {
        const int row0 = u.pm * 256 + wr * 64 + fr, colt = u.pn * 256, col0 = colt + wc * 32 + 8 * fq;
        if (colt == C_LR) {
            if (wc == 0) {
                const int cl = 8 * fq;
                const f32x4 b0 = *(const f32x4*)(bias + 4096 + cl), b1 = *(const f32x4*)(bias + 4096 + cl + 4);
#pragma unroll
                for (int ai = 0; ai < 2; ++ai)
#pragma unroll
                    for (int m = 0; m < 4; ++m) {
                        float* d = LR + (size_t)(row0 + ai * 128 + m * 16) * 32 + cl;
                        *(f32x4*)d = acc[ai][0][m][0] + b0; *(f32x4*)(d + 4) = acc[ai][0][m][1] + b1;
                    }
            }
            return;
        }
        const int mode = (colt < 512 || colt == C_GQ) ? 1 : (colt >= C_MQ && colt < C_Z) ? 2 : (colt >= C_Z && colt < C_SG) ? 3 : (colt >= C_SG) ? 4 : 0;
#pragma unroll
        for (int bj = 0; bj < 2; ++bj) {
            const int col = col0 + bj * 128;
            const f32x4 b0 = *(const f32x4*)(bias + orig_col(col)), b1 = *(const f32x4*)(bias + orig_col(col) + 4);
#pragma unroll
            for (int ai = 0; ai < 2; ++ai)
#pragma unroll
                for (int m = 0; m < 4; ++m) {
                    f32x4 v0 = acc[ai][bj][m][0] + b0, v1 = acc[ai][bj][m][1] + b1;
                    if (mode == 1) { v0 *= 0.125f; v1 *= 0.125f; }
                    else if (mode == 2) { v0 *= 0.08838834764831845f; v1 *= 0.08838834764831845f; }
                    else if (mode == 3) {
#pragma unroll
                        for (int e = 0; e < 4; ++e) { v0[e] = siluf_(v0[e]); v1[e] = siluf_(v1[e]); }
                    } else if (mode == 4) {
#pragma unroll
                        for (int e = 0; e < 4; ++e) { v0[e] = sigmoidf_(v0[e]); v1[e] = sigmoidf_(v1[e]); }
                    }
                    u32x4 o; o.x = pk2(v0[0], v0[1]); o.y = pk2(v0[2], v0[3]); o.z = pk2(v1[0], v1[1]); o.w = pk2(v1[2], v1[3]);
                    *(u32x4*)(P + (size_t)(row0 + ai * 128 + m * 16) * PS + col) = o;
                }
        }
    }
};
struct EpiOut {
    static constexpr bool PERM = false, AFTER_DRAIN = false;
    bf16_t* pre; const float* bo;
    __device__ __forceinline__ void operator()(const f32x4 (&acc)[2][2][4][2], const pg8::Unit& u, int wr, int wc, int fr, int fq) const {
        const int row0 = u.pm * 256 + wr * 64 + fr, col0 = u.pn * 256 + wc * 32 + 4 * fq;
#pragma unroll
        for (int bj = 0; bj < 2; ++bj)
#pragma unroll
            for (int n = 0; n < 2; ++n) {
                const int col = col0 + bj * 128 + n * 16;
                const f32x4 b4 = *(const f32x4*)(bo + col);
#pragma unroll
                for (int ai = 0; ai < 2; ++ai)
#pragma unroll
                    for (int m = 0; m < 4; ++m) st_bf4(pre + (size_t)(row0 + ai * 128 + m * 16) * 1024 + col, acc[ai][bj][m][n] + b4);
            }
    }
};

__device__ __forceinline__ void ln_rows_res(const Params& p, int l, size_t tok0) {
    int tid_ = threadIdx.x; asm volatile("" : "+v"(tid_));
    const int lane = tid_ & 63;
    const int gw = blockIdx.x * (NTHR / 64) + (tid_ >> 6), nw = gridDim.x * (NTHR / 64);
    const bf16_t* pre = (const bf16_t*)(p.ws + OFF_PRE); const float2* stats = (const float2*)(p.ws + OFF_STATS); bf16_t* hb = (bf16_t*)(p.ws + OFF_HB);
    const float* g = p.ln_g + l * 1024; const float* b = p.ln_b + l * 1024;
    for (int r = gw; r < TG; r += nw) {
        const size_t T = tok0 + r;
        const bf16_t* pr = pre + (size_t)r * 1024;
        float4 v[4]; float s = 0.f;
        if (l == 0) {
            const float4* xr = (const float4*)(p.x + T * 1024); const float2 st = stats[T];
#pragma unroll
            for (int i = 0; i < 4; ++i) {
                const f32x4 a4 = ld_bf4(pr + (lane + 64 * i) * 4); float4 a; a.x = a4[0]; a.y = a4[1]; a.z = a4[2]; a.w = a4[3]; const float4 x4 = xr[lane + 64 * i], g4 = ((const float4*)p.ln_in_g)[lane + 64 * i], b4 = ((const float4*)p.ln_in_b)[lane + 64 * i];
                v[i].x = a.x + DN_ALPHA * ((x4.x - st.x) * st.y * g4.x + b4.x); v[i].y = a.y + DN_ALPHA * ((x4.y - st.x) * st.y * g4.y + b4.y);
                v[i].z = a.z + DN_ALPHA * ((x4.z - st.x) * st.y * g4.z + b4.z); v[i].w = a.w + DN_ALPHA * ((x4.w - st.x) * st.y * g4.w + b4.w);
            }
        } else {
            const float4* hr = (const float4*)(p.out + T * 1024);
#pragma unroll
            for (int i = 0; i < 4; ++i) {
                const f32x4 a4 = ld_bf4(pr + (lane + 64 * i) * 4); float4 a; a.x = a4[0]; a.y = a4[1]; a.z = a4[2]; a.w = a4[3]; const float4 h4 = hr[lane + 64 * i];
                v[i].x = a.x + DN_ALPHA * h4.x; v[i].y = a.y + DN_ALPHA * h4.y; v[i].z = a.z + DN_ALPHA * h4.z; v[i].w = a.w + DN_ALPHA * h4.w;
            }
        }
#pragma unroll
        for (int i = 0; i < 4; ++i) s += (v[i].x + v[i].y) + (v[i].z + v[i].w);
        s = wave_sum(s);
        const float mean = s * (1.0f / 1024.0f);
        float q = 0.f;
#pragma unroll
        for (int i = 0; i < 4; ++i) { const float a = v[i].x - mean, bb = v[i].y - mean, c = v[i].z - mean, d = v[i].w - mean; q += (a * a + bb * bb) + (c * c + d * d); }
        q = wave_sum(q);
        const float rstd = 1.0f / sqrtf(q * (1.0f / 1024.0f) + 1e-5f);
#pragma unroll
        for (int i = 0; i < 4; ++i) {
            const float4 g4 = ((const float4*)g)[lane + 64 * i], b4 = ((const float4*)b)[lane + 64 * i];
            float4 y; y.x = (v[i].x - mean) * rstd * g4.x + b4.x; y.y = (v[i].y - mean) * rstd * g4.y + b4.y; y.z = (v[i].z - mean) * rstd * g4.z + b4.z; y.w = (v[i].w - mean) * rstd * g4.w + b4.w;
            ((float4*)(p.out + T * 1024))[lane + 64 * i] = y;
            u32x2 o; o.x = pk2(y.x, y.y); o.y = pk2(y.z, y.w); *(u32x2*)(hb + T * 1024 + (lane + 64 * i) * 4) = o;
        }
    }
}

#define XB_TMO      128
#define XB_XCNT(j)  (256  + 64 * (j))
#define XB_XSUB(j)  (1280 + 64 * (j))
#define XB_XGEN(j)  (2304 + 64 * (j))
#define XB_TOP      3328
#define XB_TOPGEN   3392
#define XCD_BAR_WORDS 3456
#define XB_SPIN_CAP (1u << 18)
#define LAS __attribute__((address_space(3)))

__device__ __forceinline__ unsigned xb_ld(unsigned* p)              { return __hip_atomic_load(p, __ATOMIC_RELAXED, __HIP_MEMORY_SCOPE_AGENT); }
__device__ __forceinline__ unsigned xb_add(unsigned* p, unsigned v) { return __hip_atomic_fetch_add(p, v, __ATOMIC_RELAXED, __HIP_MEMORY_SCOPE_AGENT); }
__device__ __forceinline__ unsigned xb_xcc_id() { return (unsigned)__builtin_amdgcn_s_getreg((3 << 11) | 20) & 0xFu; }
#define XB_SPIN(cond, bar) do { unsigned _sp = 0; while (cond) { __builtin_amdgcn_s_sleep(1); \
    if ((++_sp & 255u) == 0u) { if (xb_ld(&(bar)[XB_TMO])) break; if (_sp > XB_SPIN_CAP) { atomicAdd(&(bar)[XB_TMO], 1u); break; } } } } while (0)

struct XcdBarrier {
    unsigned* bar; unsigned x;
    volatile LAS unsigned* st;
};

__device__ __forceinline__ XcdBarrier xcd_barrier_post(unsigned* bar, volatile LAS unsigned* st) {
    XcdBarrier b; b.bar = bar; b.x = xb_xcc_id(); b.st = st;
    if (threadIdx.x == 0) (void)xb_add(&bar[XB_XCNT(b.x)], 1u);
    return b;
}
__device__ __forceinline__ void xcd_barrier_complete(unsigned* bar, unsigned x, unsigned& nloc, unsigned& nx) {
    const unsigned G = gridDim.x * gridDim.y * gridDim.z;
    unsigned sum, cnt, mine, sp = 0u;
    for (;;) {
        sum = 0u; cnt = 0u; mine = 0u;
#pragma unroll
        for (unsigned j = 0; j < 16; ++j) { const unsigned c = xb_ld(&bar[XB_XCNT(j)]); sum += c; cnt += (c > 0u) ? 1u : 0u; mine = (j == x) ? c : mine; }
        if (sum == G) break;
        __builtin_amdgcn_s_sleep(1);
        if ((++sp & 255u) == 0u) { if (xb_ld(&bar[XB_TMO])) break; if (sp > XB_SPIN_CAP) { atomicAdd(&bar[XB_TMO], 1u); break; } }
    }
    nloc = mine > 0u ? mine : 1u; nx = cnt > 0u ? cnt : 1u;
}

__device__ __forceinline__ void xcd_barrier(unsigned* b_bar, unsigned b_x, volatile LAS unsigned* b_st) {
    asm volatile("s_waitcnt vmcnt(0)" ::: "memory");
    __syncthreads();
    if (threadIdx.x == 0) {
        unsigned* bar = b_bar;
        __builtin_amdgcn_s_waitcnt(0);
        unsigned nloc = b_st[0], nx = b_st[1];
        if (nloc == 0u) { xcd_barrier_complete(bar, b_x, nloc, nx); b_st[0] = nloc; b_st[1] = nx; }
        const unsigned old = xb_add(&bar[XB_XSUB(b_x)], 1u);
        const unsigned gen = old / nloc;
        if (old + 1u == (gen + 1u) * nloc) {
            __builtin_amdgcn_fence(__ATOMIC_RELEASE, "agent");
            asm volatile("s_waitcnt vmcnt(0)" ::: "memory");
            const unsigned og = xb_add(&bar[XB_TOP], 1u);
            const unsigned tg = og / nx;
            if (og + 1u == (tg + 1u) * nx) xb_add(&bar[XB_TOPGEN], 1u);
            else XB_SPIN(xb_ld(&bar[XB_TOPGEN]) == tg, bar);
            __builtin_amdgcn_fence(__ATOMIC_ACQUIRE, "agent");
            xb_add(&bar[XB_XGEN(b_x)], 1u);
            asm volatile("s_waitcnt vmcnt(0)" ::: "memory");
        } else {
            XB_SPIN(xb_ld(&bar[XB_XGEN(b_x)]) == gen, bar);
            __builtin_amdgcn_fence(__ATOMIC_ACQUIRE, "agent");
            asm volatile("s_waitcnt vmcnt(0)" ::: "memory");
        }
    }
    __syncthreads();
}

__device__ __forceinline__ void gbar(unsigned* ctr, unsigned& gen, int G) {
    __syncthreads();
    gen += (unsigned)G;
    if (threadIdx.x == 0) {
        __threadfence();
        __hip_atomic_fetch_add(ctr, 1u, __ATOMIC_RELAXED, __HIP_MEMORY_SCOPE_AGENT);
        while (__hip_atomic_load(ctr, __ATOMIC_RELAXED, __HIP_MEMORY_SCOPE_AGENT) < gen) __builtin_amdgcn_s_sleep(1);
        __threadfence();
    }
    __syncthreads();
}
typedef const Params __attribute__((address_space(4))) KParams;
#define KP4 __attribute__((address_space(4)))
__device__ __forceinline__ Params fresh_params() {
#if defined(__HIP_DEVICE_COMPILE__)
    KParams* kp = (KParams*)__builtin_amdgcn_kernarg_segment_ptr();
    asm volatile("" : "+s"(kp));
    Params r;
    const float* KP4 const* src = (const float* KP4 const*)kp;
    const float** dst = (const float**)&r;
#pragma unroll
    for (int i = 0; i < 28; ++i) dst[i] = src[i];
    return r;
#else
    return Params{};
#endif
}
__global__ void __launch_bounds__(NTHR) mega(Params p_unused) {
    extern __shared__ __attribute__((aligned(16))) unsigned char lds[];
    cg::grid_group grid = cg::this_grid();
    const int G = gridDim.x, bid = blockIdx.x;
    volatile LAS unsigned* xst = (volatile LAS unsigned*)((LAS unsigned char*)lds + (LDS_BYTES - 16));
    if (threadIdx.x == 0) { xst[0] = 0u; xst[1] = 0u; }
    __syncthreads();
    unsigned* xbar; unsigned xx;
    { const Params p = fresh_params(); xbar = (unsigned*)(p.ws + OFF_BAR); xx = xb_xcc_id(); if (threadIdx.x == 0) (void)xb_add(&xbar[XB_XCNT(xx)], 1u); }
    { const Params p = fresh_params(); phase0(p); }
    grid.sync();
#pragma unroll 1
    for (int l = 0; l < 2; ++l) {
        { const Params p = fresh_params(); phase_weights(p, l, lds); __syncthreads(); phase_filter_gen(p, l, lds); }
        xcd_barrier(xbar, xx, xst);
        {
            const Params p = fresh_params();
            phase_filter_fft(p, l, lds);
            const bf16_t* WtKV = (const bf16_t*)(p.ws + OFF_WTKV); const bf16_t* membf = (const bf16_t*)(p.ws + OFF_MEMBF);
            for (int t = bid; t < 64; t += G) {
                f32x4 acc[4][4];
                if (t < 32) {
                    const int m0 = (t >> 2) * 256, n0 = (t & 3) * 128;
                    gemm_core(acc, membf + (size_t)m0 * 1024, 1024, WtKV + (size_t)n0 * 1024, 1024, 1024, lds);
                    bf16_t* Km = (bf16_t*)(p.ws + OFF_KMAT);
                    EPI_LOOP(st_bf4(Km + (size_t)row * 512 + col, v);)
                } else {
                    const int t2 = t - 32, m0 = (t2 >> 4) * 256, n0 = (t2 & 15) * 128;
                    gemm_core(acc, WtKV + (size_t)(512 + m0) * 1024, 1024, membf + (size_t)n0 * 1024, 1024, 1024, lds);
                    bf16_t* Vm = (bf16_t*)(p.ws + OFF_VT);
                    EPI_LOOP(st_bf4(Vm + (size_t)row * 2048 + col, v);)
                }
            }
        }
        xcd_barrier(xbar, xx, xst);
#pragma unroll 1
        for (int g = 0; g < NGRP; ++g) {
            const size_t tok0 = (size_t)g * TG;
#pragma unroll 1
            for (int rep = 0; rep < PROBE_REP_INPROJ; ++rep) {
                const Params p = fresh_params();
                pg8::Gemm gm; gm.A = (const bf16_t*)(p.ws + OFF_HB) + tok0 * 1024; gm.Bt = (const bf16_t*)(p.ws + OFF_WTIN); gm.M = TG; gm.N = NINP; gm.K = 1024;
                pg8::StaticOrder S; S.init(TG, NINP, G, bid);
                EpiInProj E; E.P = (bf16_t*)(p.ws + OFF_P); E.bias = p.b_in + (size_t)l * NIN; E.LR = (float*)(p.ws + OFF_LR);
                pg8::gemm_phase<EpiInProj, pg8::StaticOrder, false>((PG8_LAS unsigned char*)lds, gm, S, E, nullptr);
                __syncthreads();
            }
            xcd_barrier(xbar, xx, xst);
#pragma unroll 1
            for (int rep = 0; rep < PROBE_REP_MIX; ++rep) {
            int dry = (rep + 1 < PROBE_REP_MIX) ? 1 : 0; asm volatile("" : "+s"(dry));
            {
                const Params p = fresh_params();
                bf16_t* P = (bf16_t*)(p.ws + OFF_P);
                for (int it = bid; it < BG * 64 * 8; it += G) na_item(p, l, P, it >> 9, (it >> 3) & 63, it & 7, lds, dry);
            }
            {
                const Params p = fresh_params();
                bf16_t* P = (bf16_t*)(p.ws + OFF_P);
                for (int it = bid; it < BG * 128 * 8; it += G) hy_pre_item(p, l, P, (bf16_t*)(p.ws + OFF_UT), (bf16_t*)(p.ws + OFF_GT), it >> 10, (it >> 3) & 127, it & 7, lds);
            }
            {
                const Params p = fresh_params();
                for (int it = bid; it < NITEM; it += G) gla_part1_item(p, l, (const bf16_t*)(p.ws + OFF_P), (const float*)(p.ws + OFF_LR), it, lds);
            }
            {
                const Params p = fresh_params();
                bf16_t* P = (bf16_t*)(p.ws + OFF_P);
                const int nit = BG * 4 * 64, per = (nit + G - 1) / G;
                int last = -1;
                for (int it = bid * per; it < min(nit, (bid + 1) * per); ++it) {
                    const int bh = it >> 6, bl = bh >> 2, h = bh & 3;
                    if (bh != last) { __syncthreads(); memattn_load(p, g * BG + bl, h, lds); last = bh; }
                    memattn_item(P, bl, h, it & 63, lds, dry);
                }
                __syncthreads();
            }
            xcd_barrier(xbar, xx, xst);
            {
                const Params p = fresh_params();
                const float2* twl = fft_lds_twiddles((const float2*)(p.ws + OFF_TW), lds);
                for (int it = bid; it < BG * 256; it += G) hyena_conv_item(p, (const bf16_t*)(p.ws + OFF_UT), (bf16_t*)(p.ws + OFF_GT), it >> 8, it & 255, lds, twl, dry);
                __syncthreads();
                gla_scan(p, dry);
            }
            xcd_barrier(xbar, xx, xst);
            {
                const Params p = fresh_params();
                for (int it = bid; it < NITEM; it += G) gla_part2_item(p, l, (bf16_t*)(p.ws + OFF_P), (const float*)(p.ws + OFF_LR), it, lds, dry);
            }
            {
                const Params p = fresh_params();
                for (int it = bid; it < BG * 128 * 8; it += G) hy_post_item((bf16_t*)(p.ws + OFF_P), (const bf16_t*)(p.ws + OFF_GT), it >> 10, (it >> 3) & 127, it & 7, lds, dry);
            }
            xcd_barrier(xbar, xx, xst);
            }
            {
                const Params p = fresh_params();
                const bf16_t* P = (const bf16_t*)(p.ws + OFF_P); const bf16_t* WtBr = (const bf16_t*)(p.ws + OFF_WTBR); bf16_t* merged = (bf16_t*)(p.ws + OFF_MERGED);
                for (int t = bid; t < 512; t += G) {
                    const int sr = t >> 8, sb = t & 255, sx = sb & 7, sk = sb >> 3;
                    const int m0 = (sr * 32 + (sk >> 3) * 8 + sx) * 256, n0 = (sk & 7) * 128;
                    merge_tile(P, WtBr, merged, m0, n0, lds);
                }
            }
            xcd_barrier(xbar, xx, xst);
            {
                const Params p = fresh_params();
                pg8::Gemm gm; gm.A = (const bf16_t*)(p.ws + OFF_MERGED); gm.Bt = (const bf16_t*)(p.ws + OFF_WTOUT); gm.M = TG; gm.N = 1024; gm.K = 1024;
                pg8::StaticOrder S; S.init(TG, 1024, G, bid);
                EpiOut E; E.pre = (bf16_t*)(p.ws + OFF_PRE); E.bo = p.b_out + l * 1024;
                pg8::gemm_phase<EpiOut, pg8::StaticOrder, false>((PG8_LAS unsigned char*)lds, gm, S, E, nullptr);
                __syncthreads();
            }
            xcd_barrier(xbar, xx, xst);
            {
                const Params p = fresh_params();
                ln_rows_res(p, l, tok0);
            }
        }
        xcd_barrier(xbar, xx, xst);
    }
}

extern "C" void kernel_launch(void* const* d_in, const int* in_sizes, int n_in, void* d_out, int out_size, void* d_ws, size_t ws_size, hipStream_t stream) {
    static int grid_blocks = 0;
    if (!grid_blocks) {
        if (ws_size < WS_END) { fprintf(stderr, "kernel_launch: workspace too small: %zu < %zu\n", ws_size, (size_t)WS_END); grid_blocks = -1; return; }
        {
            const long long ex[26] = {67108864LL, 2097152LL, 1024, 1024, 2LL * 1024 * 10784, 2 * 10784, 2 * 8 * 15 * 31, 2 * 3 * 1536, 2 * 1536, 2 * 33 * 64, 2 * 64, 2 * 2 * 64 * 64, 2 * 2 * 64,
                                      2 * 64 * 1024, 2 * 512, 2 * 16 * 256, 2 * 256, 2 * 16 * 256, 2 * 256, 2 * 512, 2LL * 1024 * 1024, 2LL * 4 * 512 * 1024, 2LL * 1024 * 1024, 2 * 1024, 2 * 1024, 2 * 1024};
            bool bad = (n_in != 26) || (out_size != 67108864);
            for (int i = 0; i < 26 && !bad; ++i) if ((long long)in_sizes[i] != ex[i]) { fprintf(stderr, "kernel_launch: input %d has %d elements, expected %lld\n", i, in_sizes[i], ex[i]); bad = true; }
            if (bad) { fprintf(stderr, "kernel_launch: unexpected shapes; nothing launched\n"); grid_blocks = -1; return; }
        }
        int dev = 0, cus = 0, per_cu = 0;
        hipGetDevice(&dev);
        hipDeviceGetAttribute(&cus, hipDeviceAttributeMultiprocessorCount, dev);
        if (hipFuncSetAttribute((const void*)mega, hipFuncAttributeMaxDynamicSharedMemorySize, LDS_BYTES) != hipSuccess) fprintf(stderr, "kernel_launch: hipFuncSetAttribute failed\n");
        if (hipOccupancyMaxActiveBlocksPerMultiprocessor(&per_cu, (const void*)mega, NTHR, LDS_BYTES) != hipSuccess || per_cu < 1) { fprintf(stderr, "kernel_launch: occupancy query gave %d\n", per_cu); per_cu = 1; }
        (void)hipGetLastError();
        if (per_cu > 1) per_cu = 1;
        grid_blocks = cus * per_cu;
    }
    if (grid_blocks < 0) return;
    Params p{};
    const float** pp = (const float**)&p;
    for (int i = 0; i < 26; ++i) pp[i] = (const float*)d_in[i];
    p.out = (float*)d_out; p.ws = (unsigned char*)d_ws;
    if (hipMemsetAsync((unsigned char*)d_ws + OFF_BAR, 0, 16384, stream) != hipSuccess) fprintf(stderr, "kernel_launch: memset of the barrier word failed\n");
    void* args[] = {&p};
    hipError_t e = hipLaunchCooperativeKernel((const void*)mega, dim3(grid_blocks), dim3(NTHR), args, LDS_BYTES, stream);
    if (e != hipSuccess) fprintf(stderr, "cooperative launch failed: %s (grid %d)\n", hipGetErrorString(e), grid_blocks);
}
#endif
```

```cpp
#ifndef PROBE_REP_MIX
#define PROBE_REP_MIX 1
#endif
#ifndef PROBE_REP_INPROJ
#define PROBE_REP_INPROJ 1
#endif
#include <hip/hip_runtime.h>
#include <hip/hip_cooperative_groups.h>
#include <cstdio>
#include <unistd.h>
#include <cmath>
namespace cg = cooperative_groups;

#define HD __host__ __device__
typedef unsigned short bf16_t;
typedef short bf16x8 __attribute__((ext_vector_type(8)));
typedef float f32x4 __attribute__((ext_vector_type(4)));
typedef unsigned u32x2 __attribute__((ext_vector_type(2)));
typedef unsigned u32x4 __attribute__((ext_vector_type(4)));

constexpr int NTOK = 65536, DM = 1024, SEQ = 8192, NB = 8;
constexpr int BG = 2;
constexpr int NGRP = NB / BG;
constexpr int TG = BG * SEQ;
constexpr int PS = 10752;
constexpr int NIN = 10784, NINP = 11008;
constexpr int C_NAQ = 0, C_NAK = 512, C_NAV = 1024, C_HY = 1536, C_GQ = 3072, C_GK = 3328, C_GV = 3584, C_MQ = 4096, C_Z = 4608, C_SG = 6656, C_LR = 10752;
constexpr int FN = 16384;
constexpr int NITEM = BG * 128 * 4;
constexpr int LDS_BYTES = 160 * 1024;
constexpr int NTHR = 512;
constexpr float DN_ALPHA = 1.41421356237309515f;

constexpr size_t al256(size_t x) { return (x + 255) & ~(size_t)255; }
constexpr size_t OFF_HB = 0;
constexpr size_t OFF_STATS = OFF_HB + (size_t)NTOK * DM * 2;
constexpr size_t OFF_TW = OFF_STATS + (size_t)NTOK * 8;
constexpr size_t OFF_MEMBF = OFF_TW + (size_t)FN * 8;
constexpr size_t OFF_ENERGY = OFF_MEMBF + (size_t)2048 * 1024 * 2;
constexpr size_t OFF_WTIN = OFF_ENERGY + 4096;
constexpr size_t OFF_WTBR = OFF_WTIN + (size_t)NINP * 1024 * 2;
constexpr size_t OFF_WTOUT = OFF_WTBR + (size_t)4 * 1024 * 512 * 2;
constexpr size_t OFF_WTKV = OFF_WTOUT + (size_t)1024 * 1024 * 2;
constexpr size_t OFF_KMAT = OFF_WTKV + (size_t)2048 * 1024 * 2;
constexpr size_t OFF_VT = OFF_KMAT + (size_t)2048 * 1024 * 2;
constexpr size_t OFF_HFILT = OFF_VT + (size_t)2048 * 1024 * 2;
constexpr size_t OFF_PQ = OFF_HFILT + (size_t)1024 * 8192 * 4;
constexpr size_t OFF_P = OFF_PQ + (size_t)256 * FN * 16;
constexpr size_t OFF_LR = OFF_P + (size_t)TG * PS * 2;
constexpr size_t OFF_GS = OFF_LR + (size_t)TG * 32 * 4;
constexpr size_t OFF_GDEC = OFF_GS + (size_t)2 * NITEM * 8192 * 4;
constexpr size_t OFF_MERGED = OFF_GDEC + (size_t)2 * NITEM * 64 * 4;
constexpr size_t OFF_PRE = OFF_MERGED + (size_t)TG * 1024 * 2;
constexpr size_t OFF_UT = OFF_PRE + (size_t)TG * 1024 * 4;
constexpr size_t OFF_GT = OFF_UT + (size_t)BG * 512 * 8192 * 4;
constexpr size_t OFF_BAR = OFF_GT + (size_t)BG * 512 * 8192 * 2;
constexpr size_t OFF_ZT = OFF_BAR + 16384;
constexpr size_t OFF_TB = al256(OFF_ZT + (size_t)8192 * 33 * 4);
constexpr size_t OFF_SB = OFF_TB + (size_t)NITEM * 8192 * 4;
constexpr size_t WS_END = OFF_SB + (size_t)2 * NITEM * 8192 * 2;

struct Params {
    const float *x, *mem, *ln_in_g, *ln_in_b, *w_in, *b_in, *na_rpb, *hy_conv_w, *hy_conv_b, *hy_w1, *hy_b1, *hy_wm, *hy_bm, *hy_w3, *hy_skip,
        *gla_up_f, *gla_bias_f, *gla_up_b, *gla_bias_b, *gla_norm_g, *mem_w_kv, *w_br, *w_out, *b_out, *ln_g, *ln_b;
    float* out;
    unsigned char* ws;
};

HD inline float bf2f(bf16_t b) {
    union { unsigned u; float f; } c; c.u = (unsigned)b << 16; return c.f;
}
HD inline bf16_t f2bf(float f) {
    union { unsigned u; float f; } c; c.f = f; unsigned u = c.u; u += 0x7fffu + ((u >> 16) & 1u); return (bf16_t)(u >> 16);
}
typedef float f32x2_t __attribute__((ext_vector_type(2)));
typedef __bf16 bf16x2_t __attribute__((ext_vector_type(2)));
__device__ __forceinline__ unsigned pk2(float lo, float hi) { const f32x2_t v = {lo, hi}; const bf16x2_t b = __builtin_convertvector(v, bf16x2_t); return __builtin_bit_cast(unsigned, b); }
__device__ __forceinline__ bf16_t f2bf_d(float f) { return (bf16_t)(pk2(f, f) & 0xffffu); }
__device__ __forceinline__ float lo16(unsigned u) { return __uint_as_float(u << 16); }
__device__ __forceinline__ float hi16(unsigned u) { return __uint_as_float(u & 0xffff0000u); }
__device__ __forceinline__ float wave_sum(float v) {
#pragma unroll
    for (int o = 32; o >= 1; o >>= 1) v += __shfl_xor(v, o);
    return v;
}
__device__ __forceinline__ float sigmoidf_(float x) { return __builtin_amdgcn_rcpf(1.0f + __expf(-x)); }
__device__ __forceinline__ float siluf_(float x) { return x * __builtin_amdgcn_rcpf(1.0f + __expf(-x)); }
__device__ __forceinline__ float logsigf_(float x) { return fminf(x, 0.0f) - __logf(1.0f + __expf(-fabsf(x))); }
__device__ __forceinline__ bf16x8 mkfrag(u32x4 v) { return __builtin_bit_cast(bf16x8, v); }
__device__ __forceinline__ bf16x8 mkfrag2(u32x2 a, u32x2 b) { u32x4 v = {a.x, a.y, b.x, b.y}; return __builtin_bit_cast(bf16x8, v); }
#define MFMA(a, b, c) __builtin_amdgcn_mfma_f32_16x16x32_bf16((a), (b), (c), 0, 0, 0)
HD inline int iclamp(int v, int lo, int hi) { return v < lo ? lo : (v > hi ? hi : v); }

HD inline float2 cmulf(float2 a, float2 b) { float2 r; r.x = a.x * b.x - a.y * b.y; r.y = a.x * b.y + a.y * b.x; return r; }
HD inline float2 cmulcf(float2 a, float2 b) { float2 r; r.x = a.x * b.x + a.y * b.y; r.y = a.y * b.x - a.x * b.y; return r; }
struct Bfly { float2 x0, x1, x2, x3, W1; int i0; };
HD inline void bfly_load(Bfly& b, const float2* d, const float2* tw, int lgm, int q) {
    const int m = 1 << lgm, blk = q >> lgm, j = q & (m - 1);
    b.i0 = (blk << (lgm + 2)) + j;
    b.W1 = tw[j];
    b.x0 = d[b.i0]; b.x1 = d[b.i0 + m]; b.x2 = d[b.i0 + 2 * m]; b.x3 = d[b.i0 + 3 * m];
}
HD inline void bfly_fwd_store(const Bfly& b, float2* d, int lgm) {
    const int m = 1 << lgm, i0 = b.i0;
    const float2 W1 = b.W1, W2 = cmulf(W1, W1);
    const float2 x0 = b.x0, x1 = b.x1, x2 = b.x2, x3 = b.x3;
    float2 a0, a1, a2, a3, t;
    a0.x = x0.x + x2.x; a0.y = x0.y + x2.y;
    t.x = x0.x - x2.x; t.y = x0.y - x2.y; a2 = cmulf(t, W1);
    a1.x = x1.x + x3.x; a1.y = x1.y + x3.y;
    t.x = x1.x - x3.x; t.y = x1.y - x3.y; t = cmulf(t, W1); a3.x = t.y; a3.y = -t.x;
    float2 r;
    r.x = a0.x + a1.x; r.y = a0.y + a1.y; d[i0] = r;
    t.x = a0.x - a1.x; t.y = a0.y - a1.y; d[i0 + m] = cmulf(t, W2);
    r.x = a2.x + a3.x; r.y = a2.y + a3.y; d[i0 + 2 * m] = r;
    t.x = a2.x - a3.x; t.y = a2.y - a3.y; d[i0 + 3 * m] = cmulf(t, W2);
}
HD inline void bfly_inv_store(const Bfly& b, float2* d, int lgm) {
    const int m = 1 << lgm, i0 = b.i0;
    const float2 W1 = b.W1, W2 = cmulf(W1, W1);
    const float2 x0 = b.x0, x1 = b.x1, x2 = b.x2, x3 = b.x3;
    const float2 b1 = cmulcf(x1, W2), b3 = cmulcf(x3, W2);
    float2 y0, y1, y2, y3;
    y0.x = x0.x + b1.x; y0.y = x0.y + b1.y; y1.x = x0.x - b1.x; y1.y = x0.y - b1.y;
    y2.x = x2.x + b3.x; y2.y = x2.y + b3.y; y3.x = x2.x - b3.x; y3.y = x2.y - b3.y;
    const float2 c2 = cmulcf(y2, W1); float2 c3 = cmulcf(y3, W1); { const float tx = -c3.y, ty = c3.x; c3.x = tx; c3.y = ty; }
    float2 r;
    r.x = y0.x + c2.x; r.y = y0.y + c2.y; d[i0] = r;
    r.x = y0.x - c2.x; r.y = y0.y - c2.y; d[i0 + 2 * m] = r;
    r.x = y1.x + c3.x; r.y = y1.y + c3.y; d[i0 + m] = r;
    r.x = y1.x - c3.x; r.y = y1.y - c3.y; d[i0 + 3 * m] = r;
}
HD inline void fft_fwd_bfly(float2* d, const float2* tw, int lgm, int q) { Bfly b; bfly_load(b, d, tw, lgm, q); bfly_fwd_store(b, d, lgm); }
HD inline void fft_inv_bfly(float2* d, const float2* tw, int lgm, int q) { Bfly b; bfly_load(b, d, tw, lgm, q); bfly_inv_store(b, d, lgm); }
HD inline void r4_fwd(float2& x0, float2& x1, float2& x2, float2& x3, const float2 W1) {
    const float2 W2 = cmulf(W1, W1);
    float2 a0, a1, a2, a3, t;
    a0.x = x0.x + x2.x; a0.y = x0.y + x2.y;
    t.x = x0.x - x2.x; t.y = x0.y - x2.y; a2 = cmulf(t, W1);
    a1.x = x1.x + x3.x; a1.y = x1.y + x3.y;
    t.x = x1.x - x3.x; t.y = x1.y - x3.y; t = cmulf(t, W1); a3.x = t.y; a3.y = -t.x;
    x0.x = a0.x + a1.x; x0.y = a0.y + a1.y;
    t.x = a0.x - a1.x; t.y = a0.y - a1.y; x1 = cmulf(t, W2);
    x2.x = a2.x + a3.x; x2.y = a2.y + a3.y;
    t.x = a2.x - a3.x; t.y = a2.y - a3.y; x3 = cmulf(t, W2);
}
HD inline void r4_inv(float2& x0, float2& x1, float2& x2, float2& x3, const float2 W1) {
    const float2 W2 = cmulf(W1, W1);
    const float2 b1 = cmulcf(x1, W2), b3 = cmulcf(x3, W2);
    float2 y0, y1, y2, y3;
    y0.x = x0.x + b1.x; y0.y = x0.y + b1.y; y1.x = x0.x - b1.x; y1.y = x0.y - b1.y;
    y2.x = x2.x + b3.x; y2.y = x2.y + b3.y; y3.x = x2.x - b3.x; y3.y = x2.y - b3.y;
    const float2 c2 = cmulcf(y2, W1); float2 c3 = cmulcf(y3, W1); { const float tx = -c3.y, ty = c3.x; c3.x = tx; c3.y = ty; }
    x0.x = y0.x + c2.x; x0.y = y0.y + c2.y; x2.x = y0.x - c2.x; x2.y = y0.y - c2.y;
    x1.x = y1.x + c3.x; x1.y = y1.y + c3.y; x3.x = y1.x - c3.x; x3.y = y1.y - c3.y;
}
template <bool INV, bool HALF>
HD inline void r16_bfly(float2* d, const float2* twO, const float2* twI, int lgm, int q) {
    const int m = 1 << lgm, blk = q >> lgm, j = q & (m - 1), base = (blk << (lgm + 4)) + j;
    float2 e[4][4];
#pragma unroll
    for (int a = 0; a < 4; ++a)
#pragma unroll
        for (int b = 0; b < 4; ++b) {
            if (!INV && HALF && a >= 2) { e[a][b].x = 0.f; e[a][b].y = 0.f; }
            else e[a][b] = d[base + ((4 * a + b) << lgm)];
        }
    const float2 wI = twI[j];
    float2 wO[4];
#pragma unroll
    for (int b = 0; b < 4; ++b) wO[b] = twO[j + (b << lgm)];
    if (!INV) {
#pragma unroll
        for (int b = 0; b < 4; ++b) r4_fwd(e[0][b], e[1][b], e[2][b], e[3][b], wO[b]);
#pragma unroll
        for (int a = 0; a < 4; ++a) r4_fwd(e[a][0], e[a][1], e[a][2], e[a][3], wI);
    } else {
#pragma unroll
        for (int a = 0; a < 4; ++a) r4_inv(e[a][0], e[a][1], e[a][2], e[a][3], wI);
#pragma unroll
        for (int b = 0; b < 4; ++b) r4_inv(e[0][b], e[1][b], e[2][b], e[3][b], wO[b]);
    }
#pragma unroll
    for (int a = 0; a < 4; ++a)
#pragma unroll
        for (int b = 0; b < 4; ++b)
            if (!(INV && HALF && a >= 2)) d[base + ((4 * a + b) << lgm)] = e[a][b];
}
HD inline int brev14(int k) {
#if defined(__HIP_DEVICE_COMPILE__)
    return (int)(__brev((unsigned)k) >> 18);
#endif
    unsigned v = (unsigned)k;
    v = ((v >> 1) & 0x55555555u) | ((v & 0x55555555u) << 1);
    v = ((v >> 2) & 0x33333333u) | ((v & 0x33333333u) << 2);
    v = ((v >> 4) & 0x0f0f0f0fu) | ((v & 0x0f0f0f0fu) << 4);
    v = ((v >> 8) & 0x00ff00ffu) | ((v & 0x00ff00ffu) << 8);
    v = (v >> 16) | (v << 16);
    return (int)(v >> 18);
}
struct PwIn { float2 Z1, Z2; float4 A, B; int p1, p2; };
HD inline void pw_load(PwIn& w, const float2* d, const float4* pq, int p1) {
    const int kf = brev14(p1), k2 = (FN - kf) & (FN - 1); w.p1 = p1; w.p2 = brev14(k2);
    w.Z1 = d[w.p1]; w.Z2 = d[w.p2]; w.A = pq[(p1 & 1) ? (FN / 2) : (p1 >> 1)];   w.B.x = w.A.x; w.B.y = -w.A.y; w.B.z = w.A.z; w.B.w = -w.A.w;
}
HD inline void pw_store(const PwIn& w, float2* d) {
    const float2 Z1 = w.Z1, Z2 = w.Z2;
    float2 P1, Q1, P2, Q2; P1.x = w.A.x; P1.y = w.A.y; Q1.x = w.A.z; Q1.y = w.A.w; P2.x = w.B.x; P2.y = w.B.y; Q2.x = w.B.z; Q2.y = w.B.w;
    float2 c1, c2; c1.x = Z1.x; c1.y = -Z1.y; c2.x = Z2.x; c2.y = -Z2.y;
    const float2 a = cmulf(Z1, P1), b = cmulf(c2, Q1), c = cmulf(Z2, P2), e = cmulf(c1, Q2);
    float2 w1, w2; w1.x = a.x + b.x; w1.y = a.y + b.y; w2.x = c.x + e.x; w2.y = c.y + e.y;
    d[w.p1] = w1;
    if (w.p2 != w.p1) d[w.p2] = w2;
}
HD inline void conv_pointwise(float2* d, const float4* pq, int p1) { PwIn w; pw_load(w, d, pq, p1); pw_store(w, d); }
HD inline void filt_pointwise(const float2* d, float4* pq, int p1) {
    const int kf = brev14(p1), k2 = (FN - kf) & (FN - 1), p2 = brev14(k2);
    const float2 Z1 = d[p1], Z2 = d[p2];
    const float gcx = 0.5f * (Z1.x + Z2.x), gcy = 0.5f * (Z1.y - Z2.y);
    const float gdx = 0.5f * (Z1.y + Z2.y), gdy = -0.5f * (Z1.x - Z2.x);
    const float s = 0.5f / (float)FN;
    float4 A; A.x = s * (gcx + gdx); A.y = s * (gcy + gdy); A.z = s * (gcx - gdx); A.w = s * (gcy - gdy);
    pq[(p1 & 1) ? (FN / 2) : (p1 >> 1)] = A;
}
HD inline int tw_off(int lgm) { return lgm == 10 ? 0 : lgm == 8 ? 1024 : lgm == 6 ? 1280 : lgm == 4 ? 1344 : lgm == 2 ? 1360 : 1364; }
#ifndef FFT_HOST_TEST
template <int LGM, bool INV>
__device__ __forceinline__ void fft_pass(float2* d, const float2* twl, const float2* twg, int tid) {
    const float2* tw = (LGM == 12) ? twg : twl + tw_off(LGM);
#pragma unroll
    for (int it = 0; it < 2; ++it) {
        const int q = tid + it * 4 * NTHR;
        Bfly b0, b1, b2, b3;
        bfly_load(b0, d, tw, LGM, q); bfly_load(b1, d, tw, LGM, q + NTHR); bfly_load(b2, d, tw, LGM, q + 2 * NTHR); bfly_load(b3, d, tw, LGM, q + 3 * NTHR);
        if (INV) { bfly_inv_store(b0, d, LGM); bfly_inv_store(b1, d, LGM); bfly_inv_store(b2, d, LGM); bfly_inv_store(b3, d, LGM); }
        else { bfly_fwd_store(b0, d, LGM); bfly_fwd_store(b1, d, LGM); bfly_fwd_store(b2, d, LGM); bfly_fwd_store(b3, d, LGM); }
    }
    __syncthreads();
}
template <int LGM, bool INV, bool HALF>
__device__ __forceinline__ void fft_pass16(float2* d, const float2* twl, const float2* twg, int tid) {
    const float2* twO = (LGM + 2 == 12) ? twg : twl + tw_off(LGM + 2);
    const float2* twI = twl + tw_off(LGM);
    r16_bfly<INV, HALF>(d, twO, twI, LGM, tid);
    r16_bfly<INV, HALF>(d, twO, twI, LGM, tid + NTHR);
    __syncthreads();
}
template <bool HALF>
__device__ __forceinline__ void fft_forward(float2* d, const float2* twl, const float2* twg) {
    int tid = threadIdx.x; asm volatile("" : "+v"(tid));
    fft_pass16<10, false, HALF>(d, twl, twg, tid); fft_pass16<6, false, false>(d, twl, twg, tid);
    fft_pass<4, false>(d, twl, twg, tid); fft_pass<2, false>(d, twl, twg, tid); fft_pass<0, false>(d, twl, twg, tid);
}
template <bool HALF>
__device__ __forceinline__ void fft_inverse(float2* d, const float2* twl, const float2* twg) {
    int tid = threadIdx.x; asm volatile("" : "+v"(tid));
    fft_pass<0, true>(d, twl, twg, tid); fft_pass<2, true>(d, twl, twg, tid); fft_pass<4, true>(d, twl, twg, tid);
    fft_pass16<6, true, false>(d, twl, twg, tid); fft_pass16<10, true, HALF>(d, twl, twg, tid);
}
__device__ __forceinline__ float2* fft_lds_twiddles(const float2* twg, unsigned char* lds) {
    int tid = threadIdx.x; asm volatile("" : "+v"(tid));
    float2* t = (float2*)(lds + 131072);
    for (int k = tid; k < 1365; k += NTHR) {
        const int lgm = k < 1024 ? 10 : k < 1280 ? 8 : k < 1344 ? 6 : k < 1360 ? 4 : k < 1364 ? 2 : 0;
        t[k] = twg[(k - tw_off(lgm)) << (12 - lgm)];
    }
    __syncthreads();
    return t;
}

constexpr int STG = 49152;
__device__ __forceinline__ int swz(int row, int ch) { return row * 128 + ((ch ^ ((row >> 1) & 7)) << 4); }
__device__ __forceinline__ void gemm_core(f32x4 (&acc)[4][4], const bf16_t* A, int lda, const bf16_t* Bt, int ldb, int K, unsigned char* lds) {
    int tid_ = threadIdx.x; asm volatile("" : "+v"(tid_)); const int tid = tid_, lane = tid & 63, w = tid >> 6, wm = w & 3, wn = w >> 2, l15 = lane & 15, q4 = lane >> 4;
    const int wu = __builtin_amdgcn_readfirstlane(w);
    __attribute__((address_space(3))) unsigned char* l3 = (__attribute__((address_space(3))) unsigned char*)lds;
#pragma unroll
    for (int mi = 0; mi < 4; ++mi)
#pragma unroll
        for (int ni = 0; ni < 4; ++ni) acc[mi][ni] = (f32x4){0.f, 0.f, 0.f, 0.f};
    const int r8 = lane >> 3, sch = (lane & 7) ^ ((((w & 1) << 2) + (r8 >> 1)) & 7);
    const bf16_t* ap = A + (size_t)(w * 8 + r8) * lda + sch * 8;
    const bf16_t* bp = Bt + (size_t)(w * 8 + r8) * ldb + sch * 8;
#define GC_STAGE(buf, k0)                                                                                                                         \
    {                                                                                                                                             \
        _Pragma("unroll") for (int i = 0; i < 4; ++i)                                                                                             \
            __builtin_amdgcn_global_load_lds((const unsigned*)(ap + (size_t)(64 * i) * lda + (k0)), (__attribute__((address_space(3))) unsigned*)(l3 + (buf) * STG + (wu + 8 * i) * 1024), 16, 0, 0);          \
        _Pragma("unroll") for (int i = 0; i < 2; ++i)                                                                                             \
            __builtin_amdgcn_global_load_lds((const unsigned*)(bp + (size_t)(64 * i) * ldb + (k0)), (__attribute__((address_space(3))) unsigned*)(l3 + (buf) * STG + 32768 + (wu + 8 * i) * 1024), 16, 0, 0);  \
    }
    GC_STAGE(0, 0)
    asm volatile("s_waitcnt vmcnt(0)" ::: "memory");
    __syncthreads();
    const int nk = K >> 6;
    for (int kt = 0; kt < nk; ++kt) {
        if (kt + 1 < nk) GC_STAGE((kt + 1) & 1, (kt + 1) << 6)
        const unsigned char* sa = lds + (kt & 1) * STG;
        const unsigned char* sb = sa + 32768;
#pragma unroll
        for (int ks = 0; ks < 2; ++ks) {
            bf16x8 af[4], bfr[4];
#pragma unroll
            for (int mi = 0; mi < 4; ++mi) af[mi] = *(const bf16x8*)(sa + swz(wm * 64 + mi * 16 + l15, ks * 4 + q4));
#pragma unroll
            for (int ni = 0; ni < 4; ++ni) bfr[ni] = *(const bf16x8*)(sb + swz(wn * 64 + ni * 16 + l15, ks * 4 + q4));
#pragma unroll
            for (int mi = 0; mi < 4; ++mi)
#pragma unroll
                for (int ni = 0; ni < 4; ++ni) acc[mi][ni] = MFMA(bfr[ni], af[mi], acc[mi][ni]);
        }
        asm volatile("s_waitcnt vmcnt(0)" ::: "memory");
        __syncthreads();
    }
#undef GC_STAGE
}
#define EPI_LOOP(body)                                                                                                  \
    {                                                                                                                   \
        int e_t = threadIdx.x; asm volatile("" : "+v"(e_t)); const int e_lane = e_t & 63, e_w = e_t >> 6;                                                    \
        _Pragma("unroll") for (int mi = 0; mi < 4; ++mi) _Pragma("unroll") for (int ni = 0; ni < 4; ++ni) {             \
            const int row = m0 + (e_w & 3) * 64 + mi * 16 + (e_lane & 15);                                              \
            const int col = n0 + (e_w >> 2) * 64 + ni * 16 + 4 * (e_lane >> 4);                                         \
            f32x4& v = acc[mi][ni];                                                                                     \
            body                                                                                                        \
        }                                                                                                               \
    }
__device__ __forceinline__ void st_bf4(bf16_t* dst, f32x4 v) {
    u32x2 o; o.x = pk2(v[0], v[1]); o.y = pk2(v[2], v[3]); *(u32x2*)dst = o;
}
__device__ __forceinline__ f32x4 ld_bf4(const bf16_t* src) {
    const u32x2 u = *(const u32x2*)src; f32x4 r = {lo16(u.x), hi16(u.x), lo16(u.y), hi16(u.y)}; return r;
}


__device__ __forceinline__ void merge_tile(const bf16_t* P, const bf16_t* WtBr, bf16_t* merged, int m0, int n0, unsigned char* lds) {
    int tid_ = threadIdx.x; asm volatile("" : "+v"(tid_)); const int tid = tid_, lane = tid & 63, w = tid >> 6, wm = w & 3, wn = w >> 2, l15 = lane & 15, q4 = lane >> 4;
    const int wu = __builtin_amdgcn_readfirstlane(w);
    __attribute__((address_space(3))) unsigned char* l3 = (__attribute__((address_space(3))) unsigned char*)lds;
    f32x4 acc[4][4], macc[4][4];
#pragma unroll
    for (int mi = 0; mi < 4; ++mi)
#pragma unroll
        for (int ni = 0; ni < 4; ++ni) { acc[mi][ni] = (f32x4){0.f, 0.f, 0.f, 0.f}; macc[mi][ni] = (f32x4){0.f, 0.f, 0.f, 0.f}; }
    const int r8 = lane >> 3, sch = (lane & 7) ^ ((((w & 1) << 2) + (r8 >> 1)) & 7);
    const bf16_t* ap = P + (size_t)(m0 + w * 8 + r8) * PS + sch * 8;
    const bf16_t* bp = WtBr + (size_t)(n0 + w * 8 + r8) * 512 + sch * 8;
    const bf16_t* sgp = P + (size_t)(m0 + wm * 64 + l15) * PS + C_SG + n0 + wn * 64 + 4 * q4;
#define MG_STAGE(buf, kt_)                                                                                                                        \
    {                                                                                                                                             \
        const int j_ = (kt_) >> 3, k0_ = ((kt_) & 7) << 6;                                                                                        \
        const int acol_ = (j_ == 0) ? C_NAQ : (j_ == 1) ? C_HY : (j_ == 2) ? C_GV : C_MQ;                                                        \
        _Pragma("unroll") for (int i = 0; i < 4; ++i)                                                                                             \
            __builtin_amdgcn_global_load_lds((const unsigned*)(ap + (size_t)(64 * i) * PS + acol_ + k0_), (__attribute__((address_space(3))) unsigned*)(l3 + (buf) * STG + (wu + 8 * i) * 1024), 16, 0, 0);      \
        _Pragma("unroll") for (int i = 0; i < 2; ++i)                                                                                             \
            __builtin_amdgcn_global_load_lds((const unsigned*)(bp + (size_t)j_ * 1024 * 512 + (size_t)(64 * i) * 512 + k0_), (__attribute__((address_space(3))) unsigned*)(l3 + (buf) * STG + 32768 + (wu + 8 * i) * 1024), 16, 0, 0);  \
    }
    MG_STAGE(0, 0)
    MG_STAGE(1, 1)
    asm volatile("s_waitcnt vmcnt(6)" ::: "memory");
    __builtin_amdgcn_s_barrier(); asm volatile("" ::: "memory");
    int cb = 0;
#pragma unroll 1
    for (int kt = 0; kt < 32; ++kt) {
        const bool last = (kt & 7) == 7;
        u32x2 sg[4][4];
        if (last) {
            const bf16_t* sp = sgp + 1024 * (kt >> 3);
#pragma unroll
            for (int mi = 0; mi < 4; ++mi)
#pragma unroll
                for (int ni = 0; ni < 4; ++ni) sg[mi][ni] = *(const u32x2*)(sp + (size_t)(mi * 16) * PS + ni * 16);
        }
        const int nb = (cb == 0) ? 2 : cb - 1;
        if (kt + 2 < 32) MG_STAGE(nb, kt + 2)
        const unsigned char* sa = lds + cb * STG;
        const unsigned char* sb = sa + 32768;
#pragma unroll
        for (int ks = 0; ks < 2; ++ks) {
            bf16x8 af[4], bfr[4];
#pragma unroll
            for (int mi = 0; mi < 4; ++mi) af[mi] = *(const bf16x8*)(sa + swz(wm * 64 + mi * 16 + l15, ks * 4 + q4));
#pragma unroll
            for (int ni = 0; ni < 4; ++ni) bfr[ni] = *(const bf16x8*)(sb + swz(wn * 64 + ni * 16 + l15, ks * 4 + q4));
            __builtin_amdgcn_s_setprio(1);
#pragma unroll
            for (int mi = 0; mi < 4; ++mi)
#pragma unroll
                for (int ni = 0; ni < 4; ++ni) acc[mi][ni] = MFMA(bfr[ni], af[mi], acc[mi][ni]);
            __builtin_amdgcn_s_setprio(0);
        }
        if (kt + 2 < 32) asm volatile("s_waitcnt vmcnt(6)" ::: "memory"); else asm volatile("s_waitcnt vmcnt(0)" ::: "memory");
        if (last) {
#pragma unroll
            for (int mi = 0; mi < 4; ++mi)
#pragma unroll
                for (int ni = 0; ni < 4; ++ni) {
                    const u32x2 u = sg[mi][ni]; const f32x4 g4 = {lo16(u.x), hi16(u.x), lo16(u.y), hi16(u.y)};
                    macc[mi][ni] += g4 * acc[mi][ni]; acc[mi][ni] = (f32x4){0.f, 0.f, 0.f, 0.f};
                }
        }
        asm volatile("" ::: "memory"); __builtin_amdgcn_s_barrier(); asm volatile("" ::: "memory");
        cb = (cb == 2) ? 0 : cb + 1;
    }
#undef MG_STAGE
    __syncthreads();
#pragma unroll
    for (int mi = 0; mi < 4; ++mi)
#pragma unroll
        for (int ni = 0; ni < 4; ++ni) st_bf4(merged + (size_t)(m0 + wm * 64 + mi * 16 + l15) * 1024 + n0 + wn * 64 + ni * 16 + 4 * q4, macc[mi][ni]);
}

__device__ __forceinline__ int orig_col(int n) {
    if (n < 4096) return n;
    if (n < 4608) return n + 32;
    if (n < 6656) return n + 32;
    if (n < 10752) return n + 32;
    return n - 10752 + 4096;
}

__device__ __forceinline__ void ln_rows(const float* src, size_t src_row0, int nrows, const float* g, const float* b, float* dst32, bf16_t* dst16, size_t dst_row0, float2* stats) {
    int tid_ = threadIdx.x; asm volatile("" : "+v"(tid_));
    const int lane = tid_ & 63;
    const int gw = blockIdx.x * (NTHR / 64) + (tid_ >> 6), nw = gridDim.x * (NTHR / 64);
    for (int r = gw; r < nrows; r += nw) {
        const float4* xr = (const float4*)(src + (src_row0 + r) * 1024);
        float4 v[4]; float s = 0.f;
#pragma unroll
        for (int i = 0; i < 4; ++i) { v[i] = xr[lane + 64 * i]; s += (v[i].x + v[i].y) + (v[i].z + v[i].w); }
        s = wave_sum(s);
        const float mean = s * (1.0f / 1024.0f);
        float q = 0.f;
#pragma unroll
        for (int i = 0; i < 4; ++i) { const float a = v[i].x - mean, bb = v[i].y - mean, c = v[i].z - mean, d = v[i].w - mean; q += (a * a + bb * bb) + (c * c + d * d); }
        q = wave_sum(q);
        const float rstd = 1.0f / sqrtf(q * (1.0f / 1024.0f) + 1e-5f);
        if (stats && lane == 0) { float2 st; st.x = mean; st.y = rstd; stats[dst_row0 + r] = st; }
#pragma unroll
        for (int i = 0; i < 4; ++i) {
            const float4 g4 = ((const float4*)g)[lane + 64 * i], b4 = ((const float4*)b)[lane + 64 * i];
            float4 y; y.x = (v[i].x - mean) * rstd * g4.x + b4.x; y.y = (v[i].y - mean) * rstd * g4.y + b4.y; y.z = (v[i].z - mean) * rstd * g4.z + b4.z; y.w = (v[i].w - mean) * rstd * g4.w + b4.w;
            if (dst32) ((float4*)(dst32 + (dst_row0 + r) * 1024))[lane + 64 * i] = y;
            if (dst16) { u32x2 o; o.x = pk2(y.x, y.y); o.y = pk2(y.z, y.w); *(u32x2*)(dst16 + (dst_row0 + r) * 1024 + (lane + 64 * i) * 4) = o; }
        }
    }
}
__device__ __forceinline__ void phase0(const Params& p) {
    ln_rows(p.x, 0, NTOK, p.ln_in_g, p.ln_in_b, nullptr, (bf16_t*)(p.ws + OFF_HB), 0, (float2*)(p.ws + OFF_STATS));
    int tid_ = threadIdx.x; asm volatile("" : "+v"(tid_)); const int gt = blockIdx.x * NTHR + tid_, nt = gridDim.x * NTHR;
    float2* tw = (float2*)(p.ws + OFF_TW);
    for (int k = gt; k < FN; k += nt) { double s, c; sincospi(-2.0 * (double)k / (double)FN, &s, &c); float2 t; t.x = (float)c; t.y = (float)s; tw[k] = t; }
    bf16_t* mb = (bf16_t*)(p.ws + OFF_MEMBF);
    for (int i = gt; i < 2048 * 1024 / 4; i += nt) { const float4 v = ((const float4*)p.mem)[i]; u32x2 o; o.x = pk2(v.x, v.y); o.y = pk2(v.z, v.w); ((u32x2*)mb)[i] = o; }
    float* en = (float*)(p.ws + OFF_ENERGY);
    for (int i = gt; i < 1024; i += nt) en[i] = 0.f;
    float* ztab = (float*)(p.ws + OFF_ZT);
    for (int idx = gt; idx < 8192 * 33; idx += nt) {
        const int n = idx / 33, e = idx - n * 33;
        float v;
        if (e == 0) v = (float)n / 8191.0f;
        else {
            const int i = (e - 1) & 15;
            const double fr = 1e-4 + (double)i * ((15.0 - 1e-4) / 15.0);
            const double ang = (2.0 * 3.14159265358979323846 / 8192.0) * (double)n * fr;
            v = (e <= 16) ? (float)cos(ang) : (float)(-sin(ang));
        }
        ztab[idx] = v;
    }
}

__device__ __forceinline__ void wt_tile(const float* src, int src_ld, int k0, int on0, bf16_t* dst, int dst_ld, int dn0, bool zero, float* tile) {
    int tid_ = threadIdx.x; asm volatile("" : "+v"(tid_)); const int tid = tid_;
    if (!zero) {
#pragma unroll
        for (int i = 0; i < 2; ++i) {
            const int k = (tid >> 3) + 64 * i, c4 = (tid & 7) * 4;
            const float4 v = *(const float4*)(src + (size_t)(k0 + k) * src_ld + on0 + c4);
            float* t = tile + k * 33 + c4; t[0] = v.x; t[1] = v.y; t[2] = v.z; t[3] = v.w;
        }
    }
    __syncthreads();
    const int n = tid >> 4, kc = (tid & 15) * 8;
    float f[8];
#pragma unroll
    for (int e = 0; e < 8; ++e) f[e] = zero ? 0.f : tile[(kc + e) * 33 + n];
    u32x4 o; o.x = pk2(f[0], f[1]); o.y = pk2(f[2], f[3]); o.z = pk2(f[4], f[5]); o.w = pk2(f[6], f[7]);
    *(u32x4*)(dst + (size_t)(dn0 + n) * dst_ld + k0 + kc) = o;
    __syncthreads();
}
__device__ __forceinline__ void phase_weights(const Params& p, int l, unsigned char* lds) {
    float* tile = (float*)lds;
    for (int it = blockIdx.x; it < 3776; it += gridDim.x) {
        if (it < 2752) {
            const int nt = it >> 3, kt = it & 7, dn0 = nt * 32;
            wt_tile(p.w_in + (size_t)l * 1024 * NIN, NIN, kt * 128, orig_col(dn0), (bf16_t*)(p.ws + OFF_WTIN), 1024, dn0, dn0 >= NIN, tile);
        } else if (it < 3264) {
            const int r = it - 2752, j = r >> 7, nt = (r >> 2) & 31, kt = r & 3;
            wt_tile(p.w_br + (size_t)(l * 4 + j) * 512 * 1024, 1024, kt * 128, nt * 32, (bf16_t*)(p.ws + OFF_WTBR) + (size_t)j * 1024 * 512, 512, nt * 32, false, tile);
        } else if (it < 3520) {
            const int r = it - 3264, nt = r >> 3, kt = r & 7;
            wt_tile(p.w_out + (size_t)l * 1024 * 1024, 1024, kt * 128, nt * 32, (bf16_t*)(p.ws + OFF_WTOUT), 1024, nt * 32, false, tile);
        } else {
            const int r = it - 3520, nt = r >> 3, kt = r & 7;
            wt_tile(p.mem_w_kv + (size_t)l * 1024 * 1024, 1024, kt * 128, nt * 32, (bf16_t*)(p.ws + OFF_WTKV), 1024, nt * 32, false, tile);
        }
    }
}

__device__ __forceinline__ void phase_filter_gen(const Params& p, int l, unsigned char* lds) {
    float* zt = (float*)lds;
    float* ha = zt + 32 * 33;
    float* hbuf = ha + 32 * 64;
    int tid_ = threadIdx.x; asm volatile("" : "+v"(tid_)); const int tid = tid_;
    const float* w1 = p.hy_w1 + (size_t)l * 33 * 64; const float* b1 = p.hy_b1 + l * 64;
    const float* wm = p.hy_wm + (size_t)l * 2 * 64 * 64; const float* bm = p.hy_bm + l * 2 * 64;
    const float* w3 = p.hy_w3 + (size_t)l * 64 * 1024;
    float* hf = (float*)(p.ws + OFF_HFILT);
    float* en = (float*)(p.ws + OFF_ENERGY) + l * 512;
    const float* ztab = (const float*)(p.ws + OFF_ZT);
    for (int it = blockIdx.x; it < 256; it += gridDim.x) {
        const int n0 = it * 32;
        for (int idx = tid; idx < 32 * 33; idx += NTHR) zt[idx] = ztab[(size_t)n0 * 33 + idx];
        __syncthreads();
        for (int idx = tid; idx < 2048; idx += NTHR) {
            const int pos = idx >> 6, j = idx & 63; float s = b1[j];
            for (int e = 0; e < 33; ++e) s += zt[pos * 33 + e] * w1[e * 64 + j];
            ha[idx] = sinf(s);
        }
        __syncthreads();
        for (int idx = tid; idx < 2048; idx += NTHR) {
            const int pos = idx >> 6, j = idx & 63; float s = bm[j];
            for (int e = 0; e < 64; ++e) s += ha[pos * 64 + e] * wm[e * 64 + j];
            hbuf[idx] = sinf(s);
        }
        __syncthreads();
        for (int idx = tid; idx < 2048; idx += NTHR) {
            const int pos = idx >> 6, j = idx & 63; float s = bm[64 + j];
            for (int e = 0; e < 64; ++e) s += hbuf[pos * 64 + e] * wm[4096 + e * 64 + j];
            ha[idx] = sinf(s);
        }
        __syncthreads();
        {
            const int c = tid;
            float af[32], ab[32];
#pragma unroll
            for (int i = 0; i < 32; ++i) { af[i] = 0.f; ab[i] = 0.f; }
            for (int k = 0; k < 64; ++k) {
                const float wf = w3[k * 1024 + c], wb = w3[k * 1024 + 512 + c];
#pragma unroll
                for (int i = 0; i < 32; ++i) { const float h = ha[i * 64 + k]; af[i] += h * wf; ab[i] += h * wb; }
            }
            const float dmin = -3.0701134573253945f, dmax = -15.350567286626973f;
            const float delta = fabsf(dmin + (float)c * ((dmax - dmin) / 511.0f));
            float e = 0.f;
#pragma unroll
            for (int i = 0; i < 32; ++i) {
                const int n = n0 + i; const float t01 = (float)n / 8191.0f; const float win = expf(-t01 * delta);
                af[i] *= win; ab[i] *= win; e += af[i] * af[i]; if (n >= 1) e += ab[i] * ab[i];
            }
#pragma unroll
            for (int i = 0; i < 8; ++i) {
                float4 a; a.x = af[4 * i]; a.y = af[4 * i + 1]; a.z = af[4 * i + 2]; a.w = af[4 * i + 3];
                float4 b; b.x = ab[4 * i]; b.y = ab[4 * i + 1]; b.z = ab[4 * i + 2]; b.w = ab[4 * i + 3];
                *(float4*)(hf + (size_t)c * 8192 + n0 + 4 * i) = a;
                *(float4*)(hf + (size_t)(512 + c) * 8192 + n0 + 4 * i) = b;
            }
            atomicAdd(en + c, e);
        }
        __syncthreads();
    }
}

__device__ __forceinline__ void phase_filter_fft(const Params& p, int l, unsigned char* lds) {
    float2* d = (float2*)lds;
    const float2* tw = fft_lds_twiddles((const float2*)(p.ws + OFF_TW), lds);
    const float* hf = (const float*)(p.ws + OFF_HFILT);
    const float* en = (const float*)(p.ws + OFF_ENERGY) + l * 512;
    float4* pqa = (float4*)(p.ws + OFF_PQ);
    int tid_ = threadIdx.x; asm volatile("" : "+v"(tid_)); const int tid = tid_;
    for (int pr = blockIdx.x; pr < 256; pr += gridDim.x) {
        const int c0 = 2 * pr, c1 = c0 + 1;
        const float s0 = 1.0f / sqrtf(en[c0] + 1e-6f), s1 = 1.0f / sqrtf(en[c1] + 1e-6f);
        const float k0 = p.hy_skip[l * 512 + c0], k1 = p.hy_skip[l * 512 + c1];
        for (int n = tid; n < FN; n += NTHR) {
            float2 v;
            if (n < 8192) { v.x = hf[(size_t)c0 * 8192 + n] * s0; v.y = hf[(size_t)c1 * 8192 + n] * s1; if (n == 0) { v.x += k0; v.y += k1; } }
            else if (n == 8192) { v.x = 0.f; v.y = 0.f; }
            else { v.x = hf[(size_t)(512 + c0) * 8192 + (FN - n)] * s0; v.y = hf[(size_t)(512 + c1) * 8192 + (FN - n)] * s1; }
            d[n] = v;
        }
        __syncthreads();
        fft_forward<false>(d, tw, (const float2*)(p.ws + OFF_TW));
        for (int h = tid; h < FN / 2; h += NTHR) filt_pointwise(d, pqa + (size_t)pr * FN, 2 * h);
        if (tid == 0) filt_pointwise(d, pqa + (size_t)pr * FN, 1);
        __syncthreads();
    }
}

__device__ __forceinline__ void hy_pre_item(const Params& p, int l, const bf16_t* P, bf16_t* UT, bf16_t* GT, int bl, int tt, int ct, unsigned char* lds) {
    float* tU = (float*)lds;
    float* tG = tU + 64 * 65;
    int tid_ = threadIdx.x; asm volatile("" : "+v"(tid_)); const int tid = tid_;
    const int t = tid >> 3, cc = (tid & 7) * 8, c = ct * 64 + cc, tb = tt * 64 + t;
    const float* cw = p.hy_conv_w + (size_t)l * 3 * 1536; const float* cb = p.hy_conv_b + l * 1536;
    float av[8], a0[8], a1[8];
#pragma unroll
    for (int h = 0; h < 2; ++h) {
        const f32x4 bv = *(const f32x4*)(cb + c + 4 * h), b0 = *(const f32x4*)(cb + 512 + c + 4 * h), b1 = *(const f32x4*)(cb + 1024 + c + 4 * h);
#pragma unroll
        for (int e = 0; e < 4; ++e) { av[4 * h + e] = bv[e]; a0[4 * h + e] = b0[e]; a1[4 * h + e] = b1[e]; }
    }
#pragma unroll
    for (int j = 0; j < 3; ++j) {
        const int ts = tb + j - 1;
        if (ts >= 0 && ts < SEQ) {
            const bf16_t* row = P + (size_t)(bl * SEQ + ts) * PS + C_HY + c;
            const u32x4 rv = *(const u32x4*)row, r0 = *(const u32x4*)(row + 512), r1 = *(const u32x4*)(row + 1024);
#pragma unroll
            for (int h = 0; h < 2; ++h) {
                const f32x4 wv = *(const f32x4*)(cw + j * 1536 + c + 4 * h), w0 = *(const f32x4*)(cw + j * 1536 + 512 + c + 4 * h), w1 = *(const f32x4*)(cw + j * 1536 + 1024 + c + 4 * h);
#pragma unroll
                for (int e = 0; e < 4; ++e) {
                    const int k = 4 * h + e; const unsigned uv = rv[k >> 1], u0 = r0[k >> 1], u1 = r1[k >> 1];
                    av[k] += wv[e] * ((k & 1) ? hi16(uv) : lo16(uv)); a0[k] += w0[e] * ((k & 1) ? hi16(u0) : lo16(u0)); a1[k] += w1[e] * ((k & 1) ? hi16(u1) : lo16(u1));
                }
            }
        }
    }
    const u32x4 rz = *(const u32x4*)(P + (size_t)(bl * SEQ + tb) * PS + C_Z + 512 + c);
#pragma unroll
    for (int k = 0; k < 8; ++k) {
        const unsigned uz = rz[k >> 1]; const float z = (k & 1) ? hi16(uz) : lo16(uz);
        tU[(cc + k) * 65 + t] = av[k] * a1[k]; tG[(cc + k) * 65 + t] = a0[k] * z;
    }
    __syncthreads();
    const int c2 = tid >> 3, t8 = (tid & 7) * 8;
    const size_t o = (size_t)(bl * 512 + ct * 64 + c2) * SEQ + tt * 64 + t8;
    const float* su = tU + c2 * 65 + t8; const float* sg = tG + c2 * 65 + t8;
    f32x4 ua = {su[0], su[1], su[2], su[3]}, ub = {su[4], su[5], su[6], su[7]};
    { u32x4 uo; uo.x = pk2(ua[0], ua[1]); uo.y = pk2(ua[2], ua[3]); uo.z = pk2(ub[0], ub[1]); uo.w = pk2(ub[2], ub[3]); *(u32x4*)(UT + o) = uo; }
    u32x4 g; g.x = pk2(sg[0], sg[1]); g.y = pk2(sg[2], sg[3]); g.z = pk2(sg[4], sg[5]); g.w = pk2(sg[6], sg[7]);
    *(u32x4*)(GT + o) = g;
    __syncthreads();
}
__device__ __forceinline__ void hy_post_item(bf16_t* P, const bf16_t* GT, int bl, int tt, int ct, unsigned char* lds, int dry = 0) {
    bf16_t* tl = (bf16_t*)lds;
    int tid_ = threadIdx.x; asm volatile("" : "+v"(tid_)); const int tid = tid_;
    const int c2 = tid >> 3, t8 = (tid & 7) * 8;
    const u32x4 v = *(const u32x4*)(GT + (size_t)(bl * 512 + ct * 64 + c2) * SEQ + tt * 64 + t8);
    bf16_t* d0 = tl + t8 * 72 + c2;
    d0[0 * 72] = (bf16_t)(v.x & 0xffffu); d0[1 * 72] = (bf16_t)(v.x >> 16); d0[2 * 72] = (bf16_t)(v.y & 0xffffu); d0[3 * 72] = (bf16_t)(v.y >> 16);
    d0[4 * 72] = (bf16_t)(v.z & 0xffffu); d0[5 * 72] = (bf16_t)(v.z >> 16); d0[6 * 72] = (bf16_t)(v.w & 0xffffu); d0[7 * 72] = (bf16_t)(v.w >> 16);
    __syncthreads();
    const int t = tid >> 3, cc = (tid & 7) * 8;
    const u32x4 ov = *(const u32x4*)(tl + t * 72 + cc);
    if (!dry) *(u32x4*)(P + (size_t)(bl * SEQ + tt * 64 + t) * PS + C_HY + ct * 64 + cc) = ov;
    __syncthreads();
}
__device__ __forceinline__ void hyena_conv_item(const Params& p, const bf16_t* UT, bf16_t* GT, int bl, int pr, unsigned char* lds, const float2* tw, int dry = 0) {
    float2* d = (float2*)lds;
    const float4* pq = (const float4*)(p.ws + OFF_PQ) + (size_t)pr * FN;
    int tid_ = threadIdx.x; asm volatile("" : "+v"(tid_)); const int tid = tid_;
    const bf16_t* u0 = UT + (size_t)(bl * 512 + 2 * pr) * SEQ; const bf16_t* u1 = u0 + SEQ;
    bf16_t* g0 = GT + (size_t)(bl * 512 + 2 * pr) * SEQ; bf16_t* g1 = g0 + SEQ;
    {
        float f0[16], f1[16];
#pragma unroll
        for (int i = 0; i < 16; ++i) { f0[i] = bf2f(u0[tid + NTHR * i]); f1[i] = bf2f(u1[tid + NTHR * i]); }
#pragma unroll
        for (int i = 0; i < 16; ++i) {
            float2 u; u.x = f0[i]; u.y = f1[i]; d[tid + NTHR * i] = u;
        }
    }
    __syncthreads();
    fft_forward<true>(d, tw, (const float2*)(p.ws + OFF_TW));
#pragma unroll 1
    for (int h = tid; h < FN / 2; h += 4 * NTHR) {
        PwIn w0, w1, w2, w3;
        pw_load(w0, d, pq, 2 * h); pw_load(w1, d, pq, 2 * (h + NTHR)); pw_load(w2, d, pq, 2 * (h + 2 * NTHR)); pw_load(w3, d, pq, 2 * (h + 3 * NTHR));
        pw_store(w0, d); pw_store(w1, d); pw_store(w2, d); pw_store(w3, d);
    }
    if (tid == 0) conv_pointwise(d, pq, 1);
    __syncthreads();
    fft_inverse<true>(d, tw, (const float2*)(p.ws + OFF_TW));
    {
        bf16_t a0[16], a1[16];
#pragma unroll
        for (int i = 0; i < 16; ++i) { a0[i] = g0[tid + NTHR * i]; a1[i] = g1[tid + NTHR * i]; }
#pragma unroll
        for (int i = 0; i < 16; ++i) {
            const int t = tid + NTHR * i;
            const float2 y = d[t];
            const bf16_t r0 = f2bf_d(y.x * bf2f(a0[i])), r1 = f2bf_d(y.y * bf2f(a1[i]));
            if (!dry) { g0[t] = r0; g1[t] = r1; }
        }
    }
    __syncthreads();
}

__device__ __forceinline__ void na_item(const Params& p, int l, bf16_t* P, int bl, int rp, int head, unsigned char* lds, int dry = 0) {
    bf16_t* Kimg = (bf16_t*)lds;
    bf16_t* VT = (bf16_t*)(lds + 82944);
    int tid_ = threadIdx.x; asm volatile("" : "+v"(tid_)); const int tid = tid_, lane = tid & 63, w = tid >> 6, l15 = lane & 15, q4 = lane >> 4;
    const int r0 = 2 * rp, rs0 = iclamp(r0 - 4, 0, 120);
#pragma unroll
    for (int i = 0; i < 9; ++i) {
        const int idx = tid + NTHR * i, key = idx >> 3, ch = idx & 7, grow = min(rs0 + (key >> 6), 127);
        const u32x4 kv = *(const u32x4*)(P + (size_t)(bl * SEQ + grow * 64 + (key & 63)) * PS + C_NAK + head * 64 + ch * 8);
        *(u32x4*)(Kimg + key * 72 + ch * 8) = kv;
    }
#pragma unroll
    for (int i = 0; i < 9; ++i) {
        const int idx = tid + NTHR * i, keyp = idx >> 2, chh = keyp >= 576 ? 1 : 0, key = keyp - chh * 576, ch = chh * 4 + (idx & 3), grow = min(rs0 + (key >> 6), 127);
        const u32x4 vv = *(const u32x4*)(P + (size_t)(bl * SEQ + grow * 64 + (key & 63)) * PS + C_NAV + head * 64 + ch * 8);
        bf16_t* vd = VT + (ch * 8) * 584 + key;
        vd[0 * 584] = (bf16_t)(vv.x & 0xffffu); vd[1 * 584] = (bf16_t)(vv.x >> 16);
        vd[2 * 584] = (bf16_t)(vv.y & 0xffffu); vd[3 * 584] = (bf16_t)(vv.y >> 16);
        vd[4 * 584] = (bf16_t)(vv.z & 0xffffu); vd[5 * 584] = (bf16_t)(vv.z >> 16);
        vd[6 * 584] = (bf16_t)(vv.w & 0xffffu); vd[7 * 584] = (bf16_t)(vv.w >> 16);
    }
    __syncthreads();
    const int rr = w >> 2, g = w & 3, r = r0 + rr, rs = iclamp(r - 4, 0, 120), lo = rs - rs0;
    const int cb = iclamp(16 * g - 8, 0, 32), c = 16 * g + l15, cs = iclamp(c - 8, 0, 48);
    bf16_t* qrow = P + (size_t)(bl * SEQ + r * 64 + c) * PS + head * 64;
    bf16x8 qf[2];
#pragma unroll
    for (int ks = 0; ks < 2; ++ks) qf[ks] = *(const bf16x8*)(qrow + ks * 32 + q4 * 8);
    f32x4 sc[16];
#pragma unroll
    for (int t = 0; t < 16; ++t) {
        const int kb = (lo + (t >> 1)) * 64 + cb + 16 * (t & 1);
        f32x4 a = {0.f, 0.f, 0.f, 0.f};
#pragma unroll
        for (int ks = 0; ks < 2; ++ks) { const bf16x8 kf = *(const bf16x8*)(Kimg + (kb + l15) * 72 + ks * 32 + q4 * 8); a = MFMA(kf, qf[ks], a); }
        sc[t] = a;
    }
    const float* rpb = p.na_rpb + (size_t)(l * 8 + head) * 15 * 31;
    float mx = -1e30f;
#pragma unroll
    for (int t = 0; t < 16; ++t) {
        const int drow = rs + (t >> 1) - r + 7;
#pragma unroll
        for (int e = 0; e < 4; ++e) {
            const int col = cb + 16 * (t & 1) + 4 * q4 + e;
            const bool ok = (col >= cs) && (col < cs + 16);
            const int dcol = ok ? (col - c + 15) : 0;
            const float v = ok ? (sc[t][e] + rpb[drow * 31 + dcol]) : -1e30f;
            sc[t][e] = v; mx = fmaxf(mx, v);
        }
    }
    mx = fmaxf(mx, __shfl_xor(mx, 16)); mx = fmaxf(mx, __shfl_xor(mx, 32));
    float sum = 0.f;
#pragma unroll
    for (int t = 0; t < 16; ++t)
#pragma unroll
        for (int e = 0; e < 4; ++e) { const float pe = __expf(sc[t][e] - mx); sc[t][e] = pe; sum += pe; }
    sum += __shfl_xor(sum, 16); sum += __shfl_xor(sum, 32);
    f32x4 o[4];
#pragma unroll
    for (int dt = 0; dt < 4; ++dt) o[dt] = (f32x4){0.f, 0.f, 0.f, 0.f};
#pragma unroll
    for (int kk = 0; kk < 8; ++kk) {
        u32x4 pu; pu.x = pk2(sc[2 * kk][0], sc[2 * kk][1]); pu.y = pk2(sc[2 * kk][2], sc[2 * kk][3]); pu.z = pk2(sc[2 * kk + 1][0], sc[2 * kk + 1][1]); pu.w = pk2(sc[2 * kk + 1][2], sc[2 * kk + 1][3]);
        const bf16x8 pf = mkfrag(pu);
        const int kbA = (lo + kk) * 64 + cb + 4 * q4;
#pragma unroll
        for (int dt = 0; dt < 4; ++dt) {
            const bf16_t* vr = VT + (dt * 16 + l15) * 584 + kbA;
            const bf16x8 vf = mkfrag2(*(const u32x2*)vr, *(const u32x2*)(vr + 16));
            o[dt] = MFMA(vf, pf, o[dt]);
        }
    }
    const float inv = 1.0f / sum;
    const bf16_t* zrow = P + (size_t)(bl * SEQ + r * 64 + c) * PS + C_Z + head * 64;
#pragma unroll
    for (int dt = 0; dt < 4; ++dt) {
        const int dd = dt * 16 + 4 * q4;
        const f32x4 z = ld_bf4(zrow + dd);
        if (!dry) st_bf4(qrow + dd, o[dt] * inv * z);
    }
    __syncthreads();
}

__device__ __forceinline__ void memattn_load(const Params& p, int b, int h, unsigned char* lds) {
    bf16_t* Kimg = (bf16_t*)lds;
    bf16_t* VT = (bf16_t*)(lds + 69632);
    const bf16_t* Km = (const bf16_t*)(p.ws + OFF_KMAT); const bf16_t* Vm = (const bf16_t*)(p.ws + OFF_VT);
    int tid_ = threadIdx.x; asm volatile("" : "+v"(tid_)); const int tid = tid_;
#pragma unroll
    for (int i = 0; i < 8; ++i) {
        const int idx = tid + NTHR * i;
        { const int key = idx >> 4, ch = idx & 15; *(u32x4*)(Kimg + key * 136 + ch * 8) = *(const u32x4*)(Km + (size_t)(b * 256 + key) * 512 + h * 128 + ch * 8); }
        { const int dd = idx >> 5, ch = idx & 31; *(u32x4*)(VT + dd * 264 + ch * 8) = *(const u32x4*)(Vm + (size_t)(h * 128 + dd) * 2048 + b * 256 + ch * 8); }
    }
    __syncthreads();
}
__device__ __forceinline__ void memattn_item(bf16_t* P, int bl, int h, int qt, unsigned char* lds, int dry = 0) {
    const bf16_t* Kimg = (const bf16_t*)lds; const bf16_t* VT = (const bf16_t*)(lds + 69632);
    int tid_ = threadIdx.x; asm volatile("" : "+v"(tid_)); const int tid = tid_, lane = tid & 63, w = tid >> 6, l15 = lane & 15, q4 = lane >> 4;
    const int tok = bl * SEQ + qt * 128 + w * 16 + l15;
    bf16_t* qrow = P + (size_t)tok * PS + C_MQ + h * 128;
    bf16x8 qf[4];
#pragma unroll
    for (int ks = 0; ks < 4; ++ks) qf[ks] = *(const bf16x8*)(qrow + ks * 32 + q4 * 8);
    f32x4 sc[16];
    float mx = -1e30f;
#pragma unroll
    for (int t = 0; t < 16; ++t) {
        f32x4 a = {0.f, 0.f, 0.f, 0.f};
#pragma unroll
        for (int ks = 0; ks < 4; ++ks) { const bf16x8 kf = *(const bf16x8*)(Kimg + (t * 16 + l15) * 136 + ks * 32 + q4 * 8); a = MFMA(kf, qf[ks], a); }
        sc[t] = a;
        mx = fmaxf(mx, fmaxf(fmaxf(a[0], a[1]), fmaxf(a[2], a[3])));
    }
    mx = fmaxf(mx, __shfl_xor(mx, 16)); mx = fmaxf(mx, __shfl_xor(mx, 32));
    float sum = 0.f;
#pragma unroll
    for (int t = 0; t < 16; ++t)
#pragma unroll
        for (int e = 0; e < 4; ++e) { const float pe = __expf(sc[t][e] - mx); sc[t][e] = pe; sum += pe; }
    sum += __shfl_xor(sum, 16); sum += __shfl_xor(sum, 32);
    f32x4 o[8];
#pragma unroll
    for (int dt = 0; dt < 8; ++dt) o[dt] = (f32x4){0.f, 0.f, 0.f, 0.f};
#pragma unroll
    for (int kk = 0; kk < 8; ++kk) {
        u32x4 pu; pu.x = pk2(sc[2 * kk][0], sc[2 * kk][1]); pu.y = pk2(sc[2 * kk][2], sc[2 * kk][3]); pu.z = pk2(sc[2 * kk + 1][0], sc[2 * kk + 1][1]); pu.w = pk2(sc[2 * kk + 1][2], sc[2 * kk + 1][3]);
        const bf16x8 pf = mkfrag(pu);
#pragma unroll
        for (int dt = 0; dt < 8; ++dt) {
            const bf16_t* vr = VT + (dt * 16 + l15) * 264 + kk * 32 + 4 * q4;
            const bf16x8 vf = mkfrag2(*(const u32x2*)vr, *(const u32x2*)(vr + 16));
            o[dt] = MFMA(vf, pf, o[dt]);
        }
    }
    const float inv = 1.0f / sum;
    const bf16_t* zrow = P + (size_t)tok * PS + C_Z + 3 * 512 + h * 128;
#pragma unroll
    for (int dt = 0; dt < 8; ++dt) {
        const int dd = dt * 16 + 4 * q4;
        const f32x4 z = ld_bf4(zrow + dd);
        if (!dry) st_bf4(qrow + dd, o[dt] * inv * z);
    }
}

constexpr int G_LRT = 0, G_BF = 8192, G_BB = 24576, G_TOT = 40960, G_IMG = 45056;
__device__ __forceinline__ void gla_tables(const Params& p, int l, const float* LR, int t0, int h, unsigned char* lds) {
    float* LRT = (float*)(lds + G_LRT); float* BF = (float*)(lds + G_BF); float* BB = (float*)(lds + G_BB); float* TOT = (float*)(lds + G_TOT);
    int tid_ = threadIdx.x; asm volatile("" : "+v"(tid_)); const int tid = tid_;
    ((float4*)LRT)[tid] = ((const float4*)(LR + (size_t)t0 * 32))[tid];
    __syncthreads();
    const int dk = tid & 63, cgp = tid >> 6;
    float uf[16], ub[16];
#pragma unroll
    for (int r = 0; r < 16; ++r) { uf[r] = p.gla_up_f[(size_t)(l * 16 + r) * 256 + h * 64 + dk]; ub[r] = p.gla_up_b[(size_t)(l * 16 + r) * 256 + h * 64 + dk]; }
    const float bif = p.gla_bias_f[l * 256 + h * 64 + dk], bib = p.gla_bias_b[l * 256 + h * 64 + dk];
    float lf[8], lb[8];
#pragma unroll
    for (int i = 0; i < 8; ++i) {
        const int c = cgp * 8 + i; float sf = bif, sb = bib;
#pragma unroll
        for (int r = 0; r < 16; ++r) { sf += LRT[c * 32 + r] * uf[r]; sb += LRT[c * 32 + 16 + r] * ub[r]; }
        lf[i] = logsigf_(sf) * (1.0f / 16.0f); lb[i] = logsigf_(sb) * (1.0f / 16.0f);
    }
#pragma unroll
    for (int i = 1; i < 8; ++i) lf[i] += lf[i - 1];
#pragma unroll
    for (int i = 6; i >= 0; --i) lb[i] += lb[i + 1];
    TOT[cgp * 64 + dk] = lf[7]; TOT[512 + cgp * 64 + dk] = lb[0];
    __syncthreads();
    float of = 0.f, ob = 0.f;
#pragma unroll
    for (int g2 = 0; g2 < 8; ++g2) { if (g2 < cgp) of += TOT[g2 * 64 + dk]; if (g2 > cgp) ob += TOT[512 + g2 * 64 + dk]; }
#pragma unroll
    for (int i = 0; i < 8; ++i) { BF[(cgp * 8 + i) * 64 + dk] = lf[i] + of; BB[(cgp * 8 + i) * 64 + dk] = lb[i] + ob; }
    __syncthreads();
}
struct GlaPre { u32x4 vv[2]; bf16_t q[8], k[8]; };
__device__ __forceinline__ void gla_prefetch(GlaPre& g, const bf16_t* P, int t0, int h, int tid) {
#pragma unroll
    for (int i = 0; i < 2; ++i) { const int idx = tid + NTHR * i, chn = idx >> 6, c = idx & 63; g.vv[i] = *(const u32x4*)(P + (size_t)(t0 + c) * PS + C_GV + h * 128 + chn * 8); }
#pragma unroll
    for (int i = 0; i < 8; ++i) { const int idx = tid + NTHR * i, c = idx >> 6, dk = idx & 63; g.q[i] = P[(size_t)(t0 + c) * PS + C_GQ + h * 64 + dk]; g.k[i] = P[(size_t)(t0 + c) * PS + C_GK + h * 64 + dk]; }
}
__device__ __forceinline__ void gla_vt_store(const GlaPre& g, bf16_t* VT, int tid) {
#pragma unroll
    for (int i = 0; i < 2; ++i) {
        const int idx = tid + NTHR * i, chn = idx >> 6, c = idx & 63;
        const u32x4 vv = g.vv[i];
        bf16_t* vd = VT + (chn * 8) * 72 + c;
        vd[0 * 72] = (bf16_t)(vv.x & 0xffffu); vd[1 * 72] = (bf16_t)(vv.x >> 16);
        vd[2 * 72] = (bf16_t)(vv.y & 0xffffu); vd[3 * 72] = (bf16_t)(vv.y >> 16);
        vd[4 * 72] = (bf16_t)(vv.z & 0xffffu); vd[5 * 72] = (bf16_t)(vv.z >> 16);
        vd[6 * 72] = (bf16_t)(vv.w & 0xffffu); vd[7 * 72] = (bf16_t)(vv.w >> 16);
    }
}
__device__ __forceinline__ void gla_part1_item(const Params& p, int l, const bf16_t* P, const float* LR, int item, unsigned char* lds) {
    const int h = item & 3, n = (item >> 2) & 127, bl = item >> 9, t0 = bl * SEQ + n * 64;
    const float* BF = (const float*)(lds + G_BF); const float* BB = (const float*)(lds + G_BB);
    bf16_t* KDT0 = (bf16_t*)(lds + G_IMG); bf16_t* KDT1 = KDT0 + 64 * 72; bf16_t* VT = KDT1 + 64 * 72;
    bf16_t* GS = (bf16_t*)(p.ws + OFF_GS); float* GD = (float*)(p.ws + OFF_GDEC);
    int tid_ = threadIdx.x; asm volatile("" : "+v"(tid_)); const int tid = tid_, lane = tid & 63, w = tid >> 6, l15 = lane & 15, q4 = lane >> 4;
    GlaPre gp; gla_prefetch(gp, P, t0, h, tid);
    gla_tables(p, l, LR, t0, h, lds);
    {
        float4* tb = (float4*)((float*)(p.ws + OFF_TB) + (size_t)item * 8192); const float4* ts = (const float4*)(lds + G_BF);
#pragma unroll
        for (int i = 0; i < 4; ++i) tb[tid + NTHR * i] = ts[tid + NTHR * i];
    }
#pragma unroll
    for (int i = 0; i < 8; ++i) {
        const int idx = tid + NTHR * i, c = idx >> 6, dk = idx & 63;
        const float kv = bf2f(gp.k[i]);
        KDT0[dk * 72 + c] = f2bf_d(kv * __expf(BF[63 * 64 + dk] - BF[c * 64 + dk]));
        KDT1[dk * 72 + c] = f2bf_d(kv * __expf(BB[dk] - BB[c * 64 + dk]));
    }
    gla_vt_store(gp, VT, tid);
    if (tid < 64) GD[(size_t)item * 64 + tid] = __expf(BF[63 * 64 + tid]);
    else if (tid < 128) GD[(size_t)(NITEM + item) * 64 + tid - 64] = __expf(BB[tid - 64]);
    __syncthreads();
    const int dir = w >> 2, dkt = w & 3;
    const bf16_t* KD = dir ? KDT1 : KDT0;
    bf16x8 kf[2];
#pragma unroll
    for (int ks = 0; ks < 2; ++ks) kf[ks] = *(const bf16x8*)(KD + (16 * dkt + l15) * 72 + 32 * ks + 8 * q4);
    bf16_t* dst = GS + ((size_t)dir * NITEM + item) * 8192;
#pragma unroll
    for (int dvt = 0; dvt < 8; ++dvt) {
        f32x4 a = {0.f, 0.f, 0.f, 0.f};
#pragma unroll
        for (int ks = 0; ks < 2; ++ks) { const bf16x8 vf = *(const bf16x8*)(VT + (16 * dvt + l15) * 72 + 32 * ks + 8 * q4); a = MFMA(kf[ks], vf, a); }
        st_bf4(dst + (16 * dvt + l15) * 64 + 16 * dkt + 4 * q4, a);
    }
    __syncthreads();
}
__device__ __forceinline__ void gla_scan(const Params& p, int dry = 0) {
    const bf16_t* GS = (const bf16_t*)(p.ws + OFF_GS); const float* GD = (const float*)(p.ws + OFF_GDEC); bf16_t* SB = (bf16_t*)(p.ws + OFF_SB);
    const int total = 2 * BG * 4 * 8192;
    int tid_ = threadIdx.x; asm volatile("" : "+v"(tid_));
    for (int id = blockIdx.x * NTHR + tid_; id < total; id += gridDim.x * NTHR) {
        const int e = id & 8191, comb = id >> 13, h = comb & 3, bl = (comb >> 2) % BG, dir = comb / (4 * BG), dk = e & 63;
        float S = 0.f;
        const size_t ibase = (size_t)dir * NITEM + (size_t)(bl * 128) * 4 + h;
        for (int s0 = 0; s0 < 128; s0 += 16) {
            float u[16], dc[16];
#pragma unroll
            for (int i = 0; i < 16; ++i) {
                const int n = dir ? 127 - (s0 + i) : s0 + i;
                const size_t item = ibase + (size_t)n * 4;
                u[i] = bf2f(GS[item * 8192 + e]); dc[i] = GD[item * 64 + dk];
            }
#pragma unroll
            for (int i = 0; i < 16; ++i) {
                const int n = dir ? 127 - (s0 + i) : s0 + i;
                const size_t item = ibase + (size_t)n * 4;
                if (!dry) SB[item * 8192 + e] = f2bf_d(S);
                S = dc[i] * S + u[i];
            }
        }
    }
}
__device__ __forceinline__ void gla_part2_item(const Params& p, int l, bf16_t* P, const float* LR, int item, unsigned char* lds, int dry = 0) {
    const int h = item & 3, n = (item >> 2) & 127, bl = item >> 9, t0 = bl * SEQ + n * 64;
    const float* BF = (const float*)(lds + G_BF); const float* BB = (const float*)(lds + G_BB);
    bf16_t* QF = (bf16_t*)(lds + G_IMG);
    bf16_t* KF = QF + 2 * 64 * 72;
    bf16_t* QD = KF + 2 * 64 * 72;
    bf16_t* VT = QD + 2 * 64 * 72;
    bf16_t* ST = VT + 128 * 72;
    float* OX = (float*)lds;
    const float* GS = (const float*)(p.ws + OFF_GS);
    int tid_ = threadIdx.x; asm volatile("" : "+v"(tid_)); const int tid = tid_, lane = tid & 63, w = tid >> 6, l15 = lane & 15, q4 = lane >> 4;
    GlaPre gp; gla_prefetch(gp, P, t0, h, tid);
    u32x4 sp[2][2];
#pragma unroll
    for (int dir = 0; dir < 2; ++dir)
#pragma unroll
        for (int i = 0; i < 2; ++i) { const int idx = tid + NTHR * i; sp[dir][i] = *(const u32x4*)((const bf16_t*)(p.ws + OFF_SB) + ((size_t)dir * NITEM + item) * 8192 + (size_t)idx * 8); }
    {
        const float4* tb = (const float4*)((const float*)(p.ws + OFF_TB) + (size_t)item * 8192); float4* ts = (float4*)(lds + G_BF);
        float4 tv[4];
#pragma unroll
        for (int i = 0; i < 4; ++i) tv[i] = tb[tid + NTHR * i];
#pragma unroll
        for (int i = 0; i < 4; ++i) ts[tid + NTHR * i] = tv[i];
        __syncthreads();
    }
#pragma unroll
    for (int i = 0; i < 8; ++i) {
        const int idx = tid + NTHR * i, c = idx >> 6, dk = idx & 63;
        const float qv = bf2f(gp.q[i]);
        const float kv = bf2f(gp.k[i]);
        const float bf = BF[c * 64 + dk], mf = BF[31 * 64 + dk], bb = BB[c * 64 + dk], mb = BB[32 * 64 + dk];
        QF[c * 72 + dk] = f2bf_d(qv * __expf(bf - mf)); KF[c * 72 + dk] = f2bf_d(kv * __expf(mf - bf)); QD[c * 72 + dk] = f2bf_d(qv * __expf(bf));
        QF[4608 + c * 72 + dk] = f2bf_d(qv * __expf(bb - mb)); KF[4608 + c * 72 + dk] = f2bf_d(kv * __expf(mb - bb)); QD[4608 + c * 72 + dk] = f2bf_d(qv * __expf(bb));
    }
    gla_vt_store(gp, VT, tid);
#pragma unroll
    for (int dir = 0; dir < 2; ++dir) {
#pragma unroll
        for (int i = 0; i < 2; ++i) {
            const int idx = tid + NTHR * i, dv = idx >> 3, dk8 = (idx & 7) * 8;
            *(u32x4*)(ST + dir * 9216 + dv * 72 + dk8) = sp[dir][i];
        }
    }
    __syncthreads();
    const int dir = w >> 2, ct = w & 3;
    const bf16_t* qfp = QF + dir * 4608; const bf16_t* kfp = KF + dir * 4608; const bf16_t* qdp = QD + dir * 4608; const bf16_t* stp = ST + dir * 9216;
    bf16x8 qf[2], qd[2];
#pragma unroll
    for (int ks = 0; ks < 2; ++ks) { qf[ks] = *(const bf16x8*)(qfp + (16 * ct + l15) * 72 + 32 * ks + 8 * q4); qd[ks] = *(const bf16x8*)(qdp + (16 * ct + l15) * 72 + 32 * ks + 8 * q4); }
    f32x4 sc[4];
    const int cq = 16 * ct + l15;
#pragma unroll
    for (int st = 0; st < 4; ++st) {
        f32x4 a = {0.f, 0.f, 0.f, 0.f};
#pragma unroll
        for (int ks = 0; ks < 2; ++ks) { const bf16x8 kf = *(const bf16x8*)(kfp + (16 * st + l15) * 72 + 32 * ks + 8 * q4); a = MFMA(kf, qf[ks], a); }
#pragma unroll
        for (int e = 0; e < 4; ++e) { const int s = 16 * st + 4 * q4 + e; const bool ok = dir ? (s > cq) : (s <= cq); a[e] = ok ? a[e] : 0.f; }
        sc[st] = a;
    }
    f32x4 o[8];
#pragma unroll
    for (int dt = 0; dt < 8; ++dt) o[dt] = (f32x4){0.f, 0.f, 0.f, 0.f};
#pragma unroll
    for (int kk = 0; kk < 2; ++kk) {
        u32x4 pu; pu.x = pk2(sc[2 * kk][0], sc[2 * kk][1]); pu.y = pk2(sc[2 * kk][2], sc[2 * kk][3]); pu.z = pk2(sc[2 * kk + 1][0], sc[2 * kk + 1][1]); pu.w = pk2(sc[2 * kk + 1][2], sc[2 * kk + 1][3]);
        const bf16x8 pf = mkfrag(pu);
#pragma unroll
        for (int dt = 0; dt < 8; ++dt) {
            const bf16_t* vr = VT + (dt * 16 + l15) * 72 + kk * 32 + 4 * q4;
            const bf16x8 vf = mkfrag2(*(const u32x2*)vr, *(const u32x2*)(vr + 16));
            o[dt] = MFMA(vf, pf, o[dt]);
        }
    }
#pragma unroll
    for (int ks = 0; ks < 2; ++ks)
#pragma unroll
        for (int dt = 0; dt < 8; ++dt) { const bf16x8 sf = *(const bf16x8*)(stp + (dt * 16 + l15) * 72 + 32 * ks + 8 * q4); o[dt] = MFMA(sf, qd[ks], o[dt]); }
    if (dir == 1) {
#pragma unroll
        for (int dt = 0; dt < 8; ++dt) *(f32x4*)(OX + cq * 132 + 16 * dt + 4 * q4) = o[dt];
    }
    __syncthreads();
    if (dir == 0) {
        float ss = 0.f;
#pragma unroll
        for (int dt = 0; dt < 8; ++dt) { o[dt] += *(const f32x4*)(OX + cq * 132 + 16 * dt + 4 * q4); ss += (o[dt][0] * o[dt][0] + o[dt][1] * o[dt][1]) + (o[dt][2] * o[dt][2] + o[dt][3] * o[dt][3]); }
        ss += __shfl_xor(ss, 16); ss += __shfl_xor(ss, 32);
        const float rms = 1.0f / sqrtf(ss * (1.0f / 128.0f) + 1e-6f);
        const float* ng = p.gla_norm_g + l * 512 + h * 128;
        const bf16_t* zrow = P + (size_t)(t0 + cq) * PS + C_Z + 2 * 512 + h * 128;
        bf16_t* orow = P + (size_t)(t0 + cq) * PS + C_GV + h * 128;
#pragma unroll
        for (int dt = 0; dt < 8; ++dt) {
            const int dd = 16 * dt + 4 * q4;
            const f32x4 z = ld_bf4(zrow + dd); const f32x4 g4 = *(const f32x4*)(ng + dd);
            if (!dry) st_bf4(orow + dd, o[dt] * rms * g4 * z);
        }
    }
    __syncthreads();
}

namespace pg8 {
#define PG8_LAS __attribute__((address_space(3)))
typedef unsigned short bf16_t;
typedef short bf16x8 __attribute__((ext_vector_type(8)));
typedef float f32x4 __attribute__((ext_vector_type(4)));
typedef unsigned u32x4 __attribute__((ext_vector_type(4)));
constexpr int BM = 256, BK = 64, HALF = 128, HTB = HALF * BK * 2  , STAGE_BYTES = 8 * HTB, NXCD = 8, WGM = 8;

__host__ __device__ __forceinline__ int lds_byte(int r, int c) { const int st = (r >> 4) * 2 + (c >> 5), rr = r & 15, cc = c & 31, ob = rr * 64 + cc * 2; return st * 1024 + (ob ^ (((ob >> 9) & 1) << 5)); }
__host__ __device__ __forceinline__ void stage_rc(int b, int& R, int& C) { const int st = b / 1024, sb = b % 1024, swz = sb ^ (((sb >> 9) & 1) << 5); R = (st >> 1) * 16 + swz / 64; C = (st & 1) * 32 + (swz % 64) / 2; }
__host__ __device__ __forceinline__ int perm32(int rho) { const int n = rho >> 4, i = rho & 15; return 8 * (i >> 2) + 4 * n + (i & 3); }

struct Unit { int pm, pn; };
struct Gemm { const bf16_t* A; const bf16_t* Bt; int M, N, K; };

struct StaticOrder {
    int nM, nN, nwg, G, c;
    __host__ __device__ __forceinline__ void init(int M, int N, int G_, int c_) { nM = M / BM; nN = N / BM; nwg = nM * nN; G = G_; c = c_; }
    __host__ __device__ bool next(int i, Unit& u) const {
        const long L = (long)i * G + c; if (L >= nwg) return false;
        int wgid = (int)L; { const int q = nwg / NXCD, r = nwg % NXCD, xcd = wgid % NXCD, off = wgid / NXCD; wgid = (xcd < r ? xcd * (q + 1) : r * (q + 1) + (xcd - r) * q) + off; }
        const int nig = WGM * nN, gid = wgid / nig, fm = gid * WGM, gsz = (nM - fm) < WGM ? (nM - fm) : WGM;
        u.pm = fm + ((wgid % nig) % gsz); u.pn = (wgid % nig) / gsz; return true;
    }
    __device__ __forceinline__ void a_ready(const Unit&) const {}
    __device__ __forceinline__ void done(const Unit&) const {}
};
__device__ __forceinline__ unsigned cvt_pk_bf16(float lo, float hi) { unsigned r; asm volatile("v_cvt_pk_bf16_f32 %0, %1, %2" : "=v"(r) : "v"(lo), "v"(hi)); return r; }
template <class Epi, class Sched, bool STAMP = false>
__device__ __forceinline__ void gemm_phase(PG8_LAS unsigned char* lds, const Gemm g, const Sched& S, const Epi& E, unsigned long long* stamps) {
    int tid_l = threadIdx.x; asm volatile("" : "+v"(tid_l)); const int tid = tid_l, wid = __builtin_amdgcn_readfirstlane(tid >> 6), lane = tid & 63, wr = wid >> 2, wc = wid & 3, fr = lane & 15, fq = lane >> 4;
    const int K = g.K, nt = K / BK;
    int ts_lo = 0, ts_hi = 0, nts = 0; const unsigned long long rt_entry = STAMP ? (unsigned long long)wall_clock64() : 0ull;
#define PG8_STAMP() do { if (STAMP && wid == 0 && nts < 64) { const unsigned long long _c = (unsigned long long)clock64(); \
        ts_lo = (lane == nts) ? (int)(unsigned)_c : ts_lo; ts_hi = (lane == nts) ? (int)(unsigned)(_c >> 32) : ts_hi; ++nts; } } while (0)
    PG8_STAMP();
    unsigned voffA[2], voffB[2];
#pragma unroll
    for (int i = 0; i < 2; ++i) { int R, C; stage_rc(tid * 16 + i * 8192, R, C); const int Rb = Epi::PERM ? ((R & ~31) + perm32(R & 31)) : R;
        voffA[i] = (unsigned)(R * K + C) * 2u; voffB[i] = (unsigned)(Rb * K + C) * 2u; }
    const size_t kstep = (size_t)(BK * 2);
    const size_t hstep = (size_t)HALF * K * 2;
    const size_t tstep = 2 * hstep;
    const unsigned ldsw = (unsigned)wid * 1024u;
    const int aoff = lds_byte(wr * 64 + fr, fq * 8), boff = lds_byte(wc * 32 + fr, fq * 8);
#define PG8_SA(b, h) (((b) * 2 + (h)) * HTB)
#define PG8_SB(b, h) ((4 + (b) * 2 + (h)) * HTB)
#define PG8_STAGE(bufoff, gbase, voff) do { _Pragma("unroll") for (int _i = 0; _i < 2; ++_i) \
        __builtin_amdgcn_global_load_lds((const unsigned*)((const char*)(gbase) + (voff)[_i]), (PG8_LAS unsigned*)(lds + (bufoff) + ldsw + _i * 8192), 16, 0, 0); } while (0)
#define PG8_LDA(dst, b, h) do { _Pragma("unroll") for (int m = 0; m < 4; ++m) _Pragma("unroll") for (int k = 0; k < 2; ++k) dst[m][k] = *(const PG8_LAS bf16x8*)(lds + PG8_SA(b, h) + aoff + m * 2048 + k * 1024); } while (0)
#define PG8_LDB(dst, b, h) do { _Pragma("unroll") for (int n = 0; n < 2; ++n) _Pragma("unroll") for (int k = 0; k < 2; ++k) dst[n][k] = *(const PG8_LAS bf16x8*)(lds + PG8_SB(b, h) + boff + n * 2048 + k * 1024); } while (0)
#define PG8_MMA(ai, bj, At, Bt) do { __builtin_amdgcn_s_setprio(1); _Pragma("unroll") for (int m = 0; m < 4; ++m) _Pragma("unroll") for (int n = 0; n < 2; ++n) _Pragma("unroll") for (int k = 0; k < 2; ++k) \
        acc[ai][bj][m][n] = __builtin_amdgcn_mfma_f32_16x16x32_bf16(Bt[n][k], At[m][k], acc[ai][bj][m][n], 0, 0, 0); __builtin_amdgcn_s_setprio(0); } while (0)
#define PG8_WAIT_V(n) asm volatile("s_waitcnt vmcnt(" #n ")" ::: "memory")
#define PG8_WAIT_L(n) asm volatile("s_waitcnt lgkmcnt(" #n ")" ::: "memory")
#define PG8_BAR __builtin_amdgcn_s_barrier()
#define PG8_SCHED __builtin_amdgcn_sched_barrier(0)
    Unit cur, nxt; int ui = 0;
    if (!S.next(0, cur)) return;
    f32x4 acc[2][2][4][2];
#pragma unroll
    for (int a = 0; a < 2; ++a)
#pragma unroll
        for (int b = 0; b < 2; ++b)
#pragma unroll
            for (int m = 0; m < 4; ++m)
#pragma unroll
                for (int n = 0; n < 2; ++n) acc[a][b][m][n] = (f32x4){0.f, 0.f, 0.f, 0.f};
    bf16x8 At[4][2], B0[2][2], B1[2][2];
    const char* cA = (const char*)g.A + (size_t)cur.pm * tstep; const char* cB = (const char*)g.Bt + (size_t)cur.pn * tstep;
    S.a_ready(cur);
    PG8_STAGE(PG8_SB(0, 0), cB, voffB); PG8_STAGE(PG8_SA(0, 0), cA, voffA); PG8_STAGE(PG8_SB(0, 1), cB + hstep, voffB); PG8_STAGE(PG8_SA(0, 1), cA + hstep, voffA);
    if (wr == 1) PG8_BAR;
    PG8_WAIT_V(4); PG8_BAR;
    PG8_STAGE(PG8_SB(1, 0), cB + kstep, voffB); PG8_STAGE(PG8_SA(1, 0), cA + kstep, voffA); PG8_STAGE(PG8_SB(1, 1), cB + hstep + kstep, voffB);
    PG8_WAIT_V(6); PG8_BAR;
    PG8_STAMP();
    for (;;) {
        const bool has_next = S.next(ui + 1, nxt);
        const char* nA = has_next ? (const char*)g.A + (size_t)nxt.pm * tstep : cA; const char* nB = has_next ? (const char*)g.Bt + (size_t)nxt.pn * tstep : cB;
        for (int t = 0; t < nt; t += 2) {
            const bool last = (t == nt - 2);
            const char* a1 = cA + (size_t)(t + 1) * kstep;
            const char* a2 = last ? nA : cA + (size_t)(t + 2) * kstep; const char* b2 = last ? nB : cB + (size_t)(t + 2) * kstep;
            const char* a3 = a2 + kstep; const char* b3 = b2 + kstep;
            if (last && has_next) S.a_ready(nxt);
            PG8_LDB(B0, 0, 0); PG8_SCHED; PG8_LDA(At, 0, 0); PG8_STAGE(PG8_SA(1, 1), a1 + hstep, voffA);
            PG8_WAIT_L(8); PG8_BAR; PG8_WAIT_L(0); PG8_MMA(0, 0, At, B0); PG8_BAR; PG8_SCHED;
            PG8_LDB(B1, 0, 1); PG8_STAGE(PG8_SB(0, 0), b2, voffB);
            PG8_BAR; PG8_WAIT_L(0); PG8_MMA(0, 1, At, B1); PG8_BAR;
            PG8_LDA(At, 0, 1); PG8_STAGE(PG8_SA(0, 0), a2, voffA);
            PG8_BAR; PG8_WAIT_L(0); PG8_MMA(1, 0, At, B0); PG8_BAR; PG8_SCHED;
            PG8_STAGE(PG8_SB(0, 1), b2 + hstep, voffB);
            PG8_WAIT_V(6); PG8_BAR; PG8_MMA(1, 1, At, B1); PG8_BAR;
            PG8_LDB(B0, 1, 0); PG8_SCHED; PG8_LDA(At, 1, 0); PG8_STAGE(PG8_SA(0, 1), a2 + hstep, voffA);
            PG8_WAIT_L(8); PG8_BAR; PG8_WAIT_L(0); PG8_MMA(0, 0, At, B0); PG8_BAR; PG8_SCHED;
            PG8_LDB(B1, 1, 1); PG8_STAGE(PG8_SB(1, 0), b3, voffB);
            PG8_BAR; PG8_WAIT_L(0); PG8_MMA(0, 1, At, B1); PG8_BAR;
            PG8_LDA(At, 1, 1); PG8_STAGE(PG8_SA(1, 0), a3, voffA);
            PG8_BAR; PG8_WAIT_L(0); PG8_MMA(1, 0, At, B0); PG8_BAR; PG8_SCHED;
            PG8_STAGE(PG8_SB(1, 1), b3 + hstep, voffB);
            PG8_WAIT_V(6); PG8_BAR; PG8_MMA(1, 1, At, B1); PG8_BAR;
        }
        PG8_STAMP();
        if constexpr (!Epi::AFTER_DRAIN) { E(acc, cur, wr, wc, fr, fq); S.done(cur); }
        PG8_STAMP();
        if (!has_next) break;
#pragma unroll
        for (int a = 0; a < 2; ++a)
#pragma unroll
            for (int b = 0; b < 2; ++b)
#pragma unroll
                for (int m = 0; m < 4; ++m)
#pragma unroll
                    for (int n = 0; n < 2; ++n) acc[a][b][m][n] = (f32x4){0.f, 0.f, 0.f, 0.f};
        cur = nxt; cA = nA; cB = nB; ++ui;
    }
    PG8_WAIT_V(0);
    if (wr == 0) PG8_BAR;
    PG8_BAR;
    if constexpr (Epi::AFTER_DRAIN) { E.fused(acc, cur, wr, wc, fr, fq, lds, wid, lane); S.done(cur); }
    PG8_STAMP();
    if (STAMP && wid == 0) { stamps[lane] = lane < nts ? (((unsigned long long)(unsigned)ts_hi << 32) | (unsigned)ts_lo) : 0ull;
        if (lane == 62) stamps[62] = rt_entry; if (lane == 63) stamps[63] = (unsigned long long)wall_clock64(); }
#undef PG8_STAMP
#undef PG8_SA
#undef PG8_SB
#undef PG8_STAGE
#undef PG8_LDA
#undef PG8_LDB
#undef PG8_MMA
#undef PG8_WAIT_V
#undef PG8_WAIT_L
#undef PG8_BAR
#undef PG8_SCHED
}
}

struct EpiInProj {
    static constexpr bool PERM = true, AFTER_DRAIN = false;
    bf16_t* P; const float* bias; float* LR;
    __device__ __forceinline__ void operator()(const f32x4 (&acc)[2][2][4][2], const pg8::Unit& u, int wr, int wc, int fr, int fq) const {
        const int row0 = u.pm * 256 + wr * 64 + fr, colt = u.pn * 256, col0 = colt + wc * 32 + 8 * fq;
        if (colt == C_LR) {
            if (wc == 0) {
                const int cl = 8 * fq;
                const f32x4 b0 = *(const f32x4*)(bias + 4096 + cl), b1 = *(const f32x4*)(bias + 4096 + cl + 4);
#pragma unroll
                for (int ai = 0; ai < 2; ++ai)
#pragma unroll
                    for (int m = 0; m < 4; ++m) {
                        float* d = LR + (size_t)(row0 + ai * 128 + m * 16) * 32 + cl;
                        *(f32x4*)d = acc[ai][0][m][0] + b0; *(f32x4*)(d + 4) = acc[ai][0][m][1] + b1;
                    }
            }
            return;
        }
        const int mode = (colt < 512 || colt == C_GQ) ? 1 : (colt >= C_MQ && colt < C_Z) ? 2 : (colt >= C_Z && colt < C_SG) ? 3 : (colt >= C_SG) ? 4 : 0;
#pragma unroll
        for (int bj = 0; bj < 2; ++bj) {
            const int col = col0 + bj * 128;
            const f32x4 b0 = *(const f32x4*)(bias + orig_col(col)), b1 = *(const f32x4*)(bias + orig_col(col) + 4);
#pragma unroll
            for (int ai = 0; ai < 2; ++ai)
#pragma unroll
                for (int m = 0; m < 4; ++m) {
                    f32x4 v0 = acc[ai][bj][m][0] + b0, v1 = acc[ai][bj][m][1] + b1;
                    if (mode == 1) { v0 *= 0.125f; v1 *= 0.125f; }
                    else if (mode == 2) { v0 *= 0.08838834764831845f; v1 *= 0.08838834764831845f; }
                    else if (mode == 3) {
#pragma unroll
                        for (int e = 0; e < 4; ++e) { v0[e] = siluf_(v0[e]); v1[e] = siluf_(v1[e]); }
                    } else if (mode == 4) {
#pragma unroll
                        for (int e = 0; e < 4; ++e) { v0[e] = sigmoidf_(v0[e]); v1[e] = sigmoidf_(v1[e]); }
                    }
                    u32x4 o; o.x = pk2(v0[0], v0[1]); o.y = pk2(v0[2], v0[3]); o.z = pk2(v1[0], v1[1]); o.w = pk2(v1[2], v1[3]);
                    *(u32x4*)(P + (size_t)(row0 + ai * 128 + m * 16) * PS + col) = o;
                }
        }
    }
};
struct EpiOut {
    static constexpr bool PERM = false, AFTER_DRAIN = false;
    bf16_t* pre; const float* bo;
    __device__ __forceinline__ void operator()(const f32x4 (&acc)[2][2][4][2], const pg8::Unit& u, int wr, int wc, int fr, int fq) const {
        const int row0 = u.pm * 256 + wr * 64 + fr, col0 = u.pn * 256 + wc * 32 + 4 * fq;
#pragma unroll
        for (int bj = 0; bj < 2; ++bj)
#pragma unroll
            for (int n = 0; n < 2; ++n) {
                const int col = col0 + bj * 128 + n * 16;
                const f32x4 b4 = *(const f32x4*)(bo + col);
#pragma unroll
                for (int ai = 0; ai < 2; ++ai)
#pragma unroll
                    for (int m = 0; m < 4; ++m) st_bf4(pre + (size_t)(row0 + ai * 128 + m * 16) * 1024 + col, acc[ai][bj][m][n] + b4);
            }
    }
};

__device__ __forceinline__ void ln_rows_res(const Params& p, int l, size_t tok0) {
    int tid_ = threadIdx.x; asm volatile("" : "+v"(tid_));
    const int lane = tid_ & 63;
    const int gw = blockIdx.x * (NTHR / 64) + (tid_ >> 6), nw = gridDim.x * (NTHR / 64);
    const bf16_t* pre = (const bf16_t*)(p.ws + OFF_PRE); const float2* stats = (const float2*)(p.ws + OFF_STATS); bf16_t* hb = (bf16_t*)(p.ws + OFF_HB);
    const float* g = p.ln_g + l * 1024; const float* b = p.ln_b + l * 1024;
    for (int r = gw; r < TG; r += nw) {
        const size_t T = tok0 + r;
        const bf16_t* pr = pre + (size_t)r * 1024;
        float4 v[4]; float s = 0.f;
        if (l == 0) {
            const float4* xr = (const float4*)(p.x + T * 1024); const float2 st = stats[T];
#pragma unroll
            for (int i = 0; i < 4; ++i) {
                const f32x4 a4 = ld_bf4(pr + (lane + 64 * i) * 4); float4 a; a.x = a4[0]; a.y = a4[1]; a.z = a4[2]; a.w = a4[3]; const float4 x4 = xr[lane + 64 * i], g4 = ((const float4*)p.ln_in_g)[lane + 64 * i], b4 = ((const float4*)p.ln_in_b)[lane + 64 * i];
                v[i].x = a.x + DN_ALPHA * ((x4.x - st.x) * st.y * g4.x + b4.x); v[i].y = a.y + DN_ALPHA * ((x4.y - st.x) * st.y * g4.y + b4.y);
                v[i].z = a.z + DN_ALPHA * ((x4.z - st.x) * st.y * g4.z + b4.z); v[i].w = a.w + DN_ALPHA * ((x4.w - st.x) * st.y * g4.w + b4.w);
            }
        } else {
            const float4* hr = (const float4*)(p.out + T * 1024);
#pragma unroll
            for (int i = 0; i < 4; ++i) {
                const f32x4 a4 = ld_bf4(pr + (lane + 64 * i) * 4); float4 a; a.x = a4[0]; a.y = a4[1]; a.z = a4[2]; a.w = a4[3]; const float4 h4 = hr[lane + 64 * i];
                v[i].x = a.x + DN_ALPHA * h4.x; v[i].y = a.y + DN_ALPHA * h4.y; v[i].z = a.z + DN_ALPHA * h4.z; v[i].w = a.w + DN_ALPHA * h4.w;
            }
        }
#pragma unroll
        for (int i = 0; i < 4; ++i) s += (v[i].x + v[i].y) + (v[i].z + v[i].w);
        s = wave_sum(s);
        const float mean = s * (1.0f / 1024.0f);
        float q = 0.f;
#pragma unroll
        for (int i = 0; i < 4; ++i) { const float a = v[i].x - mean, bb = v[i].y - mean, c = v[i].z - mean, d = v[i].w - mean; q += (a * a + bb * bb) + (c * c + d * d); }
        q = wave_sum(q);
        const float rstd = 1.0f / sqrtf(q * (1.0f / 1024.0f) + 1e-5f);
#pragma unroll
        for (int i = 0; i < 4; ++i) {
            const float4 g4 = ((const float4*)g)[lane + 64 * i], b4 = ((const float4*)b)[lane + 64 * i];
            float4 y; y.x = (v[i].x - mean) * rstd * g4.x + b4.x; y.y = (v[i].y - mean) * rstd * g4.y + b4.y; y.z = (v[i].z - mean) * rstd * g4.z + b4.z; y.w = (v[i].w - mean) * rstd * g4.w + b4.w;
            ((float4*)(p.out + T * 1024))[lane + 64 * i] = y;
            if (l == 0) { u32x2 o; o.x = pk2(y.x, y.y); o.y = pk2(y.z, y.w); *(u32x2*)(hb + T * 1024 + (lane + 64 * i) * 4) = o; }
        }
    }
}

#define XB_TMO      128
#define XB_XCNT(j)  (256  + 64 * (j))
#define XB_XSUB(j)  (1280 + 64 * (j))
#define XB_XGEN(j)  (2304 + 64 * (j))
#define XB_TOP      3328
#define XB_TOPGEN   3392
#define XCD_BAR_WORDS 3456
#define XB_SPIN_CAP (1u << 18)
#define LAS __attribute__((address_space(3)))

__device__ __forceinline__ unsigned xb_ld(unsigned* p)              { return __hip_atomic_load(p, __ATOMIC_RELAXED, __HIP_MEMORY_SCOPE_AGENT); }
__device__ __forceinline__ unsigned xb_add(unsigned* p, unsigned v) { return __hip_atomic_fetch_add(p, v, __ATOMIC_RELAXED, __HIP_MEMORY_SCOPE_AGENT); }
__device__ __forceinline__ unsigned xb_xcc_id() { return (unsigned)__builtin_amdgcn_s_getreg((3 << 11) | 20) & 0xFu; }
#define XB_SPIN(cond, bar) do { unsigned _sp = 0; while (cond) { __builtin_amdgcn_s_sleep(1); \
    if ((++_sp & 255u) == 0u) { if (xb_ld(&(bar)[XB_TMO])) break; if (_sp > XB_SPIN_CAP) { atomicAdd(&(bar)[XB_TMO], 1u); break; } } } } while (0)

struct XcdBarrier {
    unsigned* bar; unsigned x;
    volatile LAS unsigned* st;
};

__device__ __forceinline__ XcdBarrier xcd_barrier_post(unsigned* bar, volatile LAS unsigned* st) {
    XcdBarrier b; b.bar = bar; b.x = xb_xcc_id(); b.st = st;
    if (threadIdx.x == 0) (void)xb_add(&bar[XB_XCNT(b.x)], 1u);
    return b;
}
__device__ __forceinline__ void xcd_barrier_complete(unsigned* bar, unsigned x, unsigned& nloc, unsigned& nx) {
    const unsigned G = gridDim.x * gridDim.y * gridDim.z;
    unsigned sum, cnt, mine, sp = 0u;
    for (;;) {
        sum = 0u; cnt = 0u; mine = 0u;
#pragma unroll
        for (unsigned j = 0; j < 16; ++j) { const unsigned c = xb_ld(&bar[XB_XCNT(j)]); sum += c; cnt += (c > 0u) ? 1u : 0u; mine = (j == x) ? c : mine; }
        if (sum == G) break;
        __builtin_amdgcn_s_sleep(1);
        if ((++sp & 255u) == 0u) { if (xb_ld(&bar[XB_TMO])) break; if (sp > XB_SPIN_CAP) { atomicAdd(&bar[XB_TMO], 1u); break; } }
    }
    nloc = mine > 0u ? mine : 1u; nx = cnt > 0u ? cnt : 1u;
}

__device__ __forceinline__ void xcd_barrier(unsigned* b_bar, unsigned b_x, volatile LAS unsigned* b_st) {
    asm volatile("s_waitcnt vmcnt(0)" ::: "memory");
    __syncthreads();
    if (threadIdx.x == 0) {
        unsigned* bar = b_bar;
        __builtin_amdgcn_s_waitcnt(0);
        unsigned nloc = b_st[0], nx = b_st[1];
        if (nloc == 0u) { xcd_barrier_complete(bar, b_x, nloc, nx); b_st[0] = nloc; b_st[1] = nx; }
        const unsigned old = xb_add(&bar[XB_XSUB(b_x)], 1u);
        const unsigned gen = old / nloc;
        if (old + 1u == (gen + 1u) * nloc) {
            __builtin_amdgcn_fence(__ATOMIC_RELEASE, "agent");
            asm volatile("s_waitcnt vmcnt(0)" ::: "memory");
            const unsigned og = xb_add(&bar[XB_TOP], 1u);
            const unsigned tg = og / nx;
            if (og + 1u == (tg + 1u) * nx) xb_add(&bar[XB_TOPGEN], 1u);
            else XB_SPIN(xb_ld(&bar[XB_TOPGEN]) == tg, bar);
            __builtin_amdgcn_fence(__ATOMIC_ACQUIRE, "agent");
            xb_add(&bar[XB_XGEN(b_x)], 1u);
            asm volatile("s_waitcnt vmcnt(0)" ::: "memory");
        } else {
            XB_SPIN(xb_ld(&bar[XB_XGEN(b_x)]) == gen, bar);
            __builtin_amdgcn_fence(__ATOMIC_ACQUIRE, "agent");
            asm volatile("s_waitcnt vmcnt(0)" ::: "memory");
        }
    }
    __syncthreads();
}

__device__ __forceinline__ void gbar(unsigned* ctr, unsigned& gen, int G) {
    __syncthreads();
    gen += (unsigned)G;
    if (threadIdx.x == 0) {
        __threadfence();
        __hip_atomic_fetch_add(ctr, 1u, __ATOMIC_RELAXED, __HIP_MEMORY_SCOPE_AGENT);
        while (__hip_atomic_load(ctr, __ATOMIC_RELAXED, __HIP_MEMORY_SCOPE_AGENT) < gen) __builtin_amdgcn_s_sleep(1);
        __threadfence();
    }
    __syncthreads();
}
typedef const Params __attribute__((address_space(4))) KParams;
#define KP4 __attribute__((address_space(4)))
__device__ __forceinline__ Params fresh_params() {
#if defined(__HIP_DEVICE_COMPILE__)
    KParams* kp = (KParams*)__builtin_amdgcn_kernarg_segment_ptr();
    asm volatile("" : "+s"(kp));
    Params r;
    const float* KP4 const* src = (const float* KP4 const*)kp;
    const float** dst = (const float**)&r;
#pragma unroll
    for (int i = 0; i < 28; ++i) dst[i] = src[i];
    return r;
#else
    return Params{};
#endif
}
__global__ void __launch_bounds__(NTHR) mega(Params p_unused) {
    extern __shared__ __attribute__((aligned(16))) unsigned char lds[];
    cg::grid_group grid = cg::this_grid();
    const int G = gridDim.x, bid = blockIdx.x;
    volatile LAS unsigned* xst = (volatile LAS unsigned*)((LAS unsigned char*)lds + (LDS_BYTES - 16));
    if (threadIdx.x == 0) { xst[0] = 0u; xst[1] = 0u; }
    __syncthreads();
    unsigned* xbar; unsigned xx;
    { const Params p = fresh_params(); xbar = (unsigned*)(p.ws + OFF_BAR); xx = xb_xcc_id(); if (threadIdx.x == 0) (void)xb_add(&xbar[XB_XCNT(xx)], 1u); }
    { const Params p = fresh_params(); phase0(p); }
    grid.sync();
#pragma unroll 1
    for (int l = 0; l < 2; ++l) {
        { const Params p = fresh_params(); phase_weights(p, l, lds); __syncthreads(); phase_filter_gen(p, l, lds); }
        xcd_barrier(xbar, xx, xst);
        {
            const Params p = fresh_params();
            phase_filter_fft(p, l, lds);
            const bf16_t* WtKV = (const bf16_t*)(p.ws + OFF_WTKV); const bf16_t* membf = (const bf16_t*)(p.ws + OFF_MEMBF);
            for (int t = bid; t < 64; t += G) {
                f32x4 acc[4][4];
                if (t < 32) {
                    const int m0 = (t >> 2) * 256, n0 = (t & 3) * 128;
                    gemm_core(acc, membf + (size_t)m0 * 1024, 1024, WtKV + (size_t)n0 * 1024, 1024, 1024, lds);
                    bf16_t* Km = (bf16_t*)(p.ws + OFF_KMAT);
                    EPI_LOOP(st_bf4(Km + (size_t)row * 512 + col, v);)
                } else {
                    const int t2 = t - 32, m0 = (t2 >> 4) * 256, n0 = (t2 & 15) * 128;
                    gemm_core(acc, WtKV + (size_t)(512 + m0) * 1024, 1024, membf + (size_t)n0 * 1024, 1024, 1024, lds);
                    bf16_t* Vm = (bf16_t*)(p.ws + OFF_VT);
                    EPI_LOOP(st_bf4(Vm + (size_t)row * 2048 + col, v);)
                }
            }
        }
        xcd_barrier(xbar, xx, xst);
#pragma unroll 1
        for (int g = 0; g < NGRP; ++g) {
            const size_t tok0 = (size_t)g * TG;
#pragma unroll 1
            for (int rep = 0; rep < PROBE_REP_INPROJ; ++rep) {
                const Params p = fresh_params();
                pg8::Gemm gm; gm.A = (const bf16_t*)(p.ws + OFF_HB) + tok0 * 1024; gm.Bt = (const bf16_t*)(p.ws + OFF_WTIN); gm.M = TG; gm.N = NINP; gm.K = 1024;
                pg8::StaticOrder S; S.init(TG, NINP, G, bid);
                EpiInProj E; E.P = (bf16_t*)(p.ws + OFF_P); E.bias = p.b_in + (size_t)l * NIN; E.LR = (float*)(p.ws + OFF_LR);
                pg8::gemm_phase<EpiInProj, pg8::StaticOrder, false>((PG8_LAS unsigned char*)lds, gm, S, E, nullptr);
                __syncthreads();
            }
            xcd_barrier(xbar, xx, xst);
#pragma unroll 1
            for (int rep = 0; rep < PROBE_REP_MIX; ++rep) {
            int dry = (rep + 1 < PROBE_REP_MIX) ? 1 : 0; asm volatile("" : "+s"(dry));
            {
                const Params p = fresh_params();
                bf16_t* P = (bf16_t*)(p.ws + OFF_P);
                for (int it = bid; it < BG * 64 * 8; it += G) na_item(p, l, P, it >> 9, (it >> 3) & 63, it & 7, lds, dry);
            }
            {
                const Params p = fresh_params();
                bf16_t* P = (bf16_t*)(p.ws + OFF_P);
                for (int it = bid; it < BG * 128 * 8; it += G) hy_pre_item(p, l, P, (bf16_t*)(p.ws + OFF_UT), (bf16_t*)(p.ws + OFF_GT), it >> 10, (it >> 3) & 127, it & 7, lds);
            }
            {
                const Params p = fresh_params();
                for (int it = bid; it < NITEM; it += G) gla_part1_item(p, l, (const bf16_t*)(p.ws + OFF_P), (const float*)(p.ws + OFF_LR), it, lds);
            }
            {
                const Params p = fresh_params();
                bf16_t* P = (bf16_t*)(p.ws + OFF_P);
                const int nit = BG * 4 * 64, per = (nit + G - 1) / G;
                int last = -1;
                for (int it = bid * per; it < min(nit, (bid + 1) * per); ++it) {
                    const int bh = it >> 6, bl = bh >> 2, h = bh & 3;
                    if (bh != last) { __syncthreads(); memattn_load(p, g * BG + bl, h, lds); last = bh; }
                    memattn_item(P, bl, h, it & 63, lds, dry);
                }
                __syncthreads();
            }
            xcd_barrier(xbar, xx, xst);
            {
                const Params p = fresh_params();
                const float2* twl = fft_lds_twiddles((const float2*)(p.ws + OFF_TW), lds);
                for (int it = bid; it < BG * 256; it += G) hyena_conv_item(p, (const bf16_t*)(p.ws + OFF_UT), (bf16_t*)(p.ws + OFF_GT), it >> 8, it & 255, lds, twl, dry);
                __syncthreads();
                gla_scan(p, dry);
            }
            xcd_barrier(xbar, xx, xst);
            {
                const Params p = fresh_params();
                for (int it = bid; it < NITEM; it += G) gla_part2_item(p, l, (bf16_t*)(p.ws + OFF_P), (const float*)(p.ws + OFF_LR), it, lds, dry);
            }
            {
                const Params p = fresh_params();
                for (int it = bid; it < BG * 128 * 8; it += G) hy_post_item((bf16_t*)(p.ws + OFF_P), (const bf16_t*)(p.ws + OFF_GT), it >> 10, (it >> 3) & 127, it & 7, lds, dry);
            }
            xcd_barrier(xbar, xx, xst);
            }
            {
                const Params p = fresh_params();
                const bf16_t* P = (const bf16_t*)(p.ws + OFF_P); const bf16_t* WtBr = (const bf16_t*)(p.ws + OFF_WTBR); bf16_t* merged = (bf16_t*)(p.ws + OFF_MERGED);
                for (int t = bid; t < 512; t += G) {
                    const int sr = t >> 8, sb = t & 255, sx = sb & 7, sk = sb >> 3;
                    const int m0 = (sr * 32 + (sk >> 3) * 8 + sx) * 256, n0 = (sk & 7) * 128;
                    merge_tile(P, WtBr, merged, m0, n0, lds);
                }
            }
            xcd_barrier(xbar, xx, xst);
            {
                const Params p = fresh_params();
                pg8::Gemm gm; gm.A = (const bf16_t*)(p.ws + OFF_MERGED); gm.Bt = (const bf16_t*)(p.ws + OFF_WTOUT); gm.M = TG; gm.N = 1024; gm.K = 1024;
                pg8::StaticOrder S; S.init(TG, 1024, G, bid);
                EpiOut E; E.pre = (bf16_t*)(p.ws + OFF_PRE); E.bo = p.b_out + l * 1024;
                pg8::gemm_phase<EpiOut, pg8::StaticOrder, false>((PG8_LAS unsigned char*)lds, gm, S, E, nullptr);
                __syncthreads();
            }
            xcd_barrier(xbar, xx, xst);
            {
                const Params p = fresh_params();
                ln_rows_res(p, l, tok0);
            }
        }
        xcd_barrier(xbar, xx, xst);
    }
}

extern "C" void kernel_launch(void* const* d_in, const int* in_sizes, int n_in, void* d_out, int out_size, void* d_ws, size_t ws_size, hipStream_t stream) {
    static int grid_blocks = 0;
    if (!grid_blocks) {
        if (ws_size < WS_END) { fprintf(stderr, "kernel_launch: workspace too small: %zu < %zu\n", ws_size, (size_t)WS_END); grid_blocks = -1; return; }
        {
            const long long ex[26] = {67108864LL, 2097152LL, 1024, 1024, 2LL * 1024 * 10784, 2 * 10784, 2 * 8 * 15 * 31, 2 * 3 * 1536, 2 * 1536, 2 * 33 * 64, 2 * 64, 2 * 2 * 64 * 64, 2 * 2 * 64,
                                      2 * 64 * 1024, 2 * 512, 2 * 16 * 256, 2 * 256, 2 * 16 * 256, 2 * 256, 2 * 512, 2LL * 1024 * 1024, 2LL * 4 * 512 * 1024, 2LL * 1024 * 1024, 2 * 1024, 2 * 1024, 2 * 1024};
            bool bad = (n_in != 26) || (out_size != 67108864);
            for (int i = 0; i < 26 && !bad; ++i) if ((long long)in_sizes[i] != ex[i]) { fprintf(stderr, "kernel_launch: input %d has %d elements, expected %lld\n", i, in_sizes[i], ex[i]); bad = true; }
            if (bad) { fprintf(stderr, "kernel_launch: unexpected shapes; nothing launched\n"); grid_blocks = -1; return; }
        }
        int dev = 0, cus = 0, per_cu = 0;
        hipGetDevice(&dev);
        hipDeviceGetAttribute(&cus, hipDeviceAttributeMultiprocessorCount, dev);
        if (hipFuncSetAttribute((const void*)mega, hipFuncAttributeMaxDynamicSharedMemorySize, LDS_BYTES) != hipSuccess) fprintf(stderr, "kernel_launch: hipFuncSetAttribute failed\n");
        if (hipOccupancyMaxActiveBlocksPerMultiprocessor(&per_cu, (const void*)mega, NTHR, LDS_BYTES) != hipSuccess || per_cu < 1) { fprintf(stderr, "kernel_launch: occupancy query gave %d\n", per_cu); per_cu = 1; }
        (void)hipGetLastError();
        if (per_cu > 1) per_cu = 1;
        grid_blocks = cus * per_cu;
    }
    if (grid_blocks < 0) return;
    Params p{};
    const float** pp = (const float**)&p;
    for (int i = 0; i < 26; ++i) pp[i] = (const float*)d_in[i];
    p.out = (float*)d_out; p.ws = (unsigned char*)d_ws;
    if (hipMemsetAsync((unsigned char*)d_ws + OFF_BAR, 0, 16384, stream) != hipSuccess) fprintf(stderr, "kernel_launch: memset of the barrier word failed\n");
    void* args[] = {&p};
    hipError_t e = hipLaunchCooperativeKernel((const void*)mega, dim3(grid_blocks), dim3(NTHR), args, LDS_BYTES, stream);
    if (e != hipSuccess) fprintf(stderr, "cooperative launch failed: %s (grid %d)\n", hipGetErrorString(e), grid_blocks);
}
#endif
```
